# Optimizing an MI355X kernel written in HIP

```python
import math
import jax
import jax.numpy as jnp
from jax import lax
import numpy as np

D_MODEL = 2048
BATCH = 8
SEQ = 4096
DEPTH = 2

CTX_LEN = 256
GRID_W = 64
D_MIX = D_MODEL
A_HEAD_DIM = 128
A_WIDTH = D_MIX // 4
A_HEADS = A_WIDTH // A_HEAD_DIM
GMLP_CHUNK = 128
B_HEAD_DIM = 128
B_WIDTH = 3 * D_MIX // 8
B_HEADS = B_WIDTH // B_HEAD_DIM
HGRN_CHUNK = 64
C_HEAD_DIM = 64
C_WIDTH = D_MIX - A_WIDTH - B_WIDTH
C_HEADS = C_WIDTH // C_HEAD_DIM
DECAY_LORA = 64
AAA_LORA = 64
GATE_LORA = 128
A_COLS = 2 * A_WIDTH
B_COLS = 5 * B_WIDTH
C_COLS = 3 * C_WIDTH + DECAY_LORA + AAA_LORA + GATE_LORA
IN_COLS = A_COLS + B_COLS + C_COLS
C_SPLITS = (C_WIDTH, 2 * C_WIDTH, 3 * C_WIDTH, 3 * C_WIDTH + DECAY_LORA, 3 * C_WIDTH + DECAY_LORA + AAA_LORA)
N_EXPERTS = 16
N_EXPERT_GROUPS = 4
EXPERTS_PER_GROUP = N_EXPERTS // N_EXPERT_GROUPS
TOP_K = 2
D_EXPERT = D_MODEL // 2
NORM_EPS = 1e-6
RWKV_GN_EPS = 64e-5
DECAY_SCALE = math.exp(-0.5)

kernel_name = "hybrid_gmlp_hgrn2_rwkv7_moe_dit"


def rmsnorm(x, g):
    xf = x.astype(jnp.float32)
    y = xf * lax.rsqrt(jnp.mean(xf * xf, axis=-1, keepdims=True) + NORM_EPS)
    return (y * g.astype(jnp.float32)).astype(x.dtype)


def head_layernorm(x, g, b):
    xf = x.astype(jnp.float32)
    xc = xf - jnp.mean(xf, axis=-1, keepdims=True)
    var = jnp.mean(xc * xc, axis=-1, keepdims=True)
    return xc * lax.rsqrt(var + RWKV_GN_EPS) * g.astype(jnp.float32) + b.astype(jnp.float32)


def gmlp_spatial_gating(cols, norm_g, ws, wb):
    bsz, t, _ = cols.shape
    u, v = jnp.split(jax.nn.gelu(cols, approximate=False), 2, axis=-1)
    v = rmsnorm(v.reshape(bsz, t, A_HEADS, A_HEAD_DIM), norm_g.reshape(A_HEADS, A_HEAD_DIM))
    v = v.reshape(bsz, t // GMLP_CHUNK, GMLP_CHUNK, A_HEADS, A_HEAD_DIM)
    s = jnp.einsum('hts,bnshc->bnthc', ws, v) + wb.T[:, :, None]
    return u * s.reshape(bsz, t, A_WIDTH)


def to_dir_chunks(fwd, bwd):
    s = jnp.stack([fwd, bwd], axis=0)
    z, bsz, t, h, d = s.shape
    return s.reshape(z, bsz, t // HGRN_CHUNK, HGRN_CHUNK, h, d).transpose(2, 0, 1, 4, 3, 5)


def from_dir_chunks(ys):
    n, z, bsz, h, c, d = ys.shape
    return ys.transpose(1, 2, 0, 4, 3, 5).reshape(z, bsz, n * c, h, d)


def hgrn2_chunk_step(state, inp):
    q, k, v, log_f = inp
    cl = q.shape[-2]
    lower = jnp.tril(jnp.ones((cl, cl), dtype=bool))[:, :, None]
    b = jnp.cumsum(log_f, axis=-2)
    diff = b[..., :, None, :] - b[..., None, :, :]
    decay = jnp.where(lower, jnp.exp(jnp.where(lower, diff, 0.0)), 0.0)
    scores = jnp.einsum('zbhtd,zbhsd,zbhtsd->zbhts', q, k, decay)
    out = jnp.einsum('zbhts,zbhsv->zbhtv', scores, v) + jnp.einsum('zbhtd,zbhdv->zbhtv', q * jnp.exp(b), state)
    b_last = b[..., -1:, :]
    state = jnp.exp(b_last)[..., 0, :, None] * state + jnp.einsum('zbhsd,zbhsv->zbhdv', k * jnp.exp(b_last - b), v)
    return state, out


def hgrn2_mixer(cols, lb, norm_g, state0):
    bsz, t, _ = cols.shape
    heads = lambda y: y.reshape(bsz, t, B_HEADS, B_HEAD_DIM)
    q, i, zf, zb, og = jnp.split(cols.astype(jnp.float32), 5, axis=-1)
    q = heads(jax.nn.silu(q))
    v = heads(i)
    lb = lb.astype(jnp.float32).reshape(2, B_HEADS, B_HEAD_DIM)

    def forget(z, lbd):
        z = heads(z)
        log_f = jnp.logaddexp(jnp.log(lbd), jnp.log1p(-lbd) + jax.nn.log_sigmoid(z))
        return log_f, (1.0 - lbd) * jax.nn.sigmoid(-z)

    lf_f, k_f = forget(zf, lb[0])
    lf_b, k_b = forget(zb, lb[1])
    rev = lambda y: y[:, ::-1]
    xs = (to_dir_chunks(q, rev(q)), to_dir_chunks(k_f, rev(k_b)), to_dir_chunks(v, rev(v)), to_dir_chunks(lf_f, rev(lf_b)))
    state, ys = lax.scan(hgrn2_chunk_step, state0, xs)
    y = from_dir_chunks(ys)
    o = y[0] + rev(y[1])
    o = rmsnorm(o, norm_g.reshape(B_HEADS, B_HEAD_DIM)).reshape(bsz, t, B_WIDTH) * jax.nn.sigmoid(og)
    return o.astype(cols.dtype), state


def shift_grid(z):
    bsz, t, c = z.shape
    rows = t // GRID_W
    g = z.reshape(bsz, rows, GRID_W, c // 4, 4)
    left = jnp.pad(g[:, :, :-1, :, 0], ((0, 0), (0, 0), (1, 0), (0, 0)))
    right = jnp.pad(g[:, :, 1:, :, 1], ((0, 0), (0, 0), (0, 1), (0, 0)))
    up = jnp.pad(g[:, :-1, :, :, 2], ((0, 0), (1, 0), (0, 0), (0, 0)))
    down = jnp.pad(g[:, 1:, :, :, 3], ((0, 0), (0, 1), (0, 0), (0, 0)))
    return jnp.stack([left, right, up, down], axis=-1).reshape(bsz, t, c)


def shift_seq(z):
    bsz, t, c = z.shape
    g = z.reshape(bsz, t, c // 4, 4)
    prev = jnp.pad(g[:, :-1], ((0, 0), (1, 0), (0, 0), (0, 0)))
    nxt = jnp.pad(g[:, 1:], ((0, 0), (0, 1), (0, 0), (0, 0)))
    return jnp.stack([prev[..., 0], nxt[..., 1], prev[..., 2], nxt[..., 3]], axis=-1).reshape(bsz, t, c)


def rwkv7_step(state, inp):
    r, w, k, v, kk, a = inp
    sa = jnp.einsum('zbhvk,zbhk->zbhv', state, kk)
    state = state * w[..., None, :] - sa[..., :, None] * (kk * a)[..., None, :] + v[..., :, None] * k[..., None, :]
    return state, jnp.einsum('zbhvk,zbhk->zbhv', state, r)


def rwkv7_mixer(cols, shift_fn, mu, w0, w_up, a0, a_up, g_up, k_k, k_a, r_k, gn_g, gn_b, state0):
    bsz, t, _ = cols.shape
    z = cols.astype(jnp.float32)
    z = z + mu * (shift_fn(z) - z)
    r, k, v, wd, ad, gd = jnp.split(z, C_SPLITS, axis=-1)
    heads = lambda y: y.reshape(y.shape[:-1] + (C_HEADS, C_HEAD_DIM))
    decay = jnp.exp(-DECAY_SCALE * jax.nn.sigmoid(w0[:, None, None, :] + jnp.einsum('btr,zrc->zbtc', jnp.tanh(wd), w_up)))
    a = jax.nn.sigmoid(a0 + ad @ a_up)
    g = jax.nn.sigmoid(gd) @ g_up
    kk = heads(k * k_k)
    kk = kk / jnp.maximum(jnp.sqrt(jnp.sum(kk * kk, axis=-1, keepdims=True)), 1e-12)
    k2 = heads(k * (1.0 + (a - 1.0) * k_a))
    r, v, a, decay = heads(r), heads(v), heads(a), heads(decay)

    def to_time(fwd, bwd):
        return jnp.stack([fwd, bwd[:, ::-1]], axis=0).transpose(2, 0, 1, 3, 4)

    xs = (to_time(r, r), to_time(decay[0], decay[1]), to_time(k2, k2), to_time(v, v), to_time(kk, kk), to_time(a, a))
    state, ys = lax.scan(rwkv7_step, state0, xs)
    o = ys[:, 0].transpose(1, 0, 2, 3) + ys[::-1, 1].transpose(1, 0, 2, 3)
    o = head_layernorm(o, heads(gn_g), heads(gn_b))
    bonus = jnp.sum(r * k2 * heads(r_k), axis=-1, keepdims=True) * v
    y = (o + bonus).reshape(bsz, t, C_WIDTH) * g
    return y.astype(cols.dtype), state


def grouped_moe(h, router_w, router_b, w_gate_up, w_down):
    n = h.shape[0]
    logits = jnp.dot(h, router_w).astype(jnp.float32) + router_b.astype(jnp.float32)
    probs = jax.nn.softmax(logits, axis=-1)
    group_score = lax.top_k(probs.reshape(n, N_EXPERT_GROUPS, EXPERTS_PER_GROUP), TOP_K)[0].sum(-1)
    sel = jnp.argmax(group_score, axis=-1)
    in_group = (jnp.arange(N_EXPERTS) // EXPERTS_PER_GROUP)[None, :] == sel[:, None]
    top_p, top_i = lax.top_k(jnp.where(in_group, probs, -1.0), TOP_K)
    top_w = top_p / jnp.sum(top_p, axis=-1, keepdims=True)
    gates = jnp.sum(jax.nn.one_hot(top_i, N_EXPERTS, dtype=jnp.float32) * top_w[..., None], axis=1).astype(h.dtype)
    y = jnp.zeros_like(h)
    for e in range(N_EXPERTS):
        gt, up = jnp.split(h @ w_gate_up[e], 2, axis=-1)
        y = y + gates[:, e:e + 1] * ((jax.nn.silu(gt) * up) @ w_down[e])
    return y


def setup_inputs(seed: int = 0) -> dict:
    key = jax.random.key(seed)
    keys = list(jax.random.split(key, 32))

    def nrm(shape, scale):
        return jax.random.normal(keys.pop(), shape, jnp.float32) * scale

    d = D_MODEL
    return {
        'x': nrm((BATCH, SEQ, d), 1.0),
        'c': nrm((BATCH, d), 1.0),
        'ctx': nrm((BATCH, CTX_LEN, d), 1.0),
        'c_ctx': nrm((d,), 1.0),
        'ada_w': nrm((DEPTH, d, 6 * d), 0.5 * d ** -0.5),
        'ada_b': nrm((DEPTH, 6 * d), 0.02),
        'norm1_g': 1.0 + nrm((DEPTH, d), 0.02),
        'norm2_g': 1.0 + nrm((DEPTH, d), 0.02),
        'w_in': nrm((DEPTH, d, IN_COLS), d ** -0.5),
        'w_out': nrm((DEPTH, D_MIX, d), D_MIX ** -0.5),
        'gmlp_norm_g': 1.0 + nrm((DEPTH, A_WIDTH), 0.02),
        'gmlp_ws': nrm((DEPTH, A_HEADS, GMLP_CHUNK, GMLP_CHUNK), GMLP_CHUNK ** -0.5),
        'gmlp_b': 1.0 + nrm((DEPTH, A_HEADS, GMLP_CHUNK), 0.1),
        'hgrn_lb_logits': nrm((2, DEPTH, B_WIDTH), 1.0),
        'hgrn_norm_g': 1.0 + nrm((DEPTH, B_WIDTH), 0.02),
        'rwkv_mu': jax.random.uniform(keys.pop(), (DEPTH, C_COLS), jnp.float32),
        'rwkv_w0': nrm((DEPTH, 2, C_WIDTH), 1.0),
        'rwkv_w_up': nrm((DEPTH, 2, DECAY_LORA, C_WIDTH), DECAY_LORA ** -0.5),
        'rwkv_a0': nrm((DEPTH, C_WIDTH), 0.5),
        'rwkv_a_up': nrm((DEPTH, AAA_LORA, C_WIDTH), AAA_LORA ** -0.5),
        'rwkv_g_up': nrm((DEPTH, GATE_LORA, C_WIDTH), GATE_LORA ** -0.5),
        'rwkv_k_k': 0.85 + nrm((DEPTH, C_WIDTH), 0.05),
        'rwkv_k_a': 1.0 + nrm((DEPTH, C_WIDTH), 0.05),
        'rwkv_r_k': nrm((DEPTH, C_WIDTH), 0.1),
        'rwkv_gn_g': 1.0 + nrm((DEPTH, C_WIDTH), 0.02),
        'rwkv_gn_b': nrm((DEPTH, C_WIDTH), 0.02),
        'router_w': nrm((d, N_EXPERTS), d ** -0.5),
        'router_b': nrm((N_EXPERTS,), 0.01),
        'moe_w_gate_up': nrm((DEPTH, N_EXPERTS, d, 2 * D_EXPERT), d ** -0.5),
        'moe_w_down': nrm((DEPTH, N_EXPERTS, D_EXPERT, d), D_EXPERT ** -0.5),
        'final_norm_g': 1.0 + nrm((d,), 0.02),
    }


def reference(x, c, ctx, c_ctx, ada_w, ada_b, norm1_g, norm2_g, w_in, w_out, gmlp_norm_g, gmlp_ws, gmlp_b,
              hgrn_lb_logits, hgrn_norm_g, rwkv_mu, rwkv_w0, rwkv_w_up, rwkv_a0, rwkv_a_up, rwkv_g_up,
              rwkv_k_k, rwkv_k_a, rwkv_r_k, rwkv_gn_g, rwkv_gn_b, router_w, router_b, moe_w_gate_up,
              moe_w_down, final_norm_g):
    bsz, t, d = x.shape
    ctx_len = ctx.shape[1]
    x_lat, x_ctx = x, ctx
    lbs = jnp.cumsum(jax.nn.softmax(hgrn_lb_logits.astype(jnp.float32), axis=1), axis=1)
    lbs = lbs - lbs[:, :1]
    hgrn_s0 = jnp.zeros((2, bsz, B_HEADS, B_HEAD_DIM, B_HEAD_DIM), jnp.float32)
    rwkv_s0 = jnp.zeros((2, bsz, C_HEADS, C_HEAD_DIM, C_HEAD_DIM), jnp.float32)
    for l in range(DEPTH):
        last = l == DEPTH - 1
        m_lat = jax.nn.silu(c) @ ada_w[l] + ada_b[l]
        m_ctx = jax.nn.silu(c_ctx) @ ada_w[l] + ada_b[l]
        sh1, sc1, g1, sh2, sc2, g2 = jnp.split(m_lat[:, None, :], 6, axis=-1)
        sh1c, sc1c, g1c, sh2c, sc2c, g2c = jnp.split(m_ctx, 6)
        h_lat = rmsnorm(x_lat, norm1_g[l]) * (1.0 + sc1) + sh1
        h_ctx = rmsnorm(x_ctx, norm1_g[l]) * (1.0 + sc1c) + sh1c
        pa_lat, pb_lat, pc_lat = jnp.split(h_lat @ w_in[l], (A_COLS, A_COLS + B_COLS), axis=-1)
        pa_ctx, pb_ctx, pc_ctx = jnp.split(h_ctx @ w_in[l], (A_COLS, A_COLS + B_COLS), axis=-1)
        ya_lat = gmlp_spatial_gating(pa_lat, gmlp_norm_g[l], gmlp_ws[l], gmlp_b[l])
        yb_ctx, hgrn_state = hgrn2_mixer(pb_ctx, lbs[:, l], hgrn_norm_g[l], hgrn_s0)
        yb_lat, _ = hgrn2_mixer(pb_lat, lbs[:, l], hgrn_norm_g[l], hgrn_state)
        rw = (rwkv_mu[l], rwkv_w0[l], rwkv_w_up[l], rwkv_a0[l], rwkv_a_up[l], rwkv_g_up[l],
              rwkv_k_k[l], rwkv_k_a[l], rwkv_r_k[l], rwkv_gn_g[l], rwkv_gn_b[l])
        yc_ctx, rwkv_state = rwkv7_mixer(pc_ctx, shift_seq, *rw, rwkv_s0)
        yc_lat, _ = rwkv7_mixer(pc_lat, shift_grid, *rw, rwkv_state)
        y_lat = jnp.concatenate([ya_lat, yb_lat, yc_lat], axis=-1) @ w_out[l]
        x_lat = x_lat + g1 * y_lat
        h2_lat = rmsnorm(x_lat, norm2_g[l]) * (1.0 + sc2) + sh2
        if last:
            f_lat = grouped_moe(h2_lat.reshape(-1, d), router_w, router_b, moe_w_gate_up[l], moe_w_down[l])
            x_lat = x_lat + g2 * f_lat.reshape(bsz, t, d)
        else:
            ya_ctx = gmlp_spatial_gating(pa_ctx, gmlp_norm_g[l], gmlp_ws[l], gmlp_b[l])
            y_ctx = jnp.concatenate([ya_ctx, yb_ctx, yc_ctx], axis=-1) @ w_out[l]
            x_ctx = x_ctx + g1c * y_ctx
            h2_ctx = rmsnorm(x_ctx, norm2_g[l]) * (1.0 + sc2c) + sh2c
            tokens = jnp.concatenate([h2_ctx.reshape(-1, d), h2_lat.reshape(-1, d)], axis=0)
            f = grouped_moe(tokens, router_w, router_b, moe_w_gate_up[l], moe_w_down[l])
            n_ctx = bsz * ctx_len
            x_ctx = x_ctx + g2c * f[:n_ctx].reshape(bsz, ctx_len, d)
            x_lat = x_lat + g2 * f[n_ctx:].reshape(bsz, t, d)
    return rmsnorm(x_lat, final_norm_g)
```

```cpp
#include <hip/hip_runtime.h>
#include <cstdio>
#include <cstdint>

#ifndef PHMASK
#define PHMASK 0xFFFF
#endif
#ifndef MK_MULTI
#define MK_MULTI 0
#endif

#define GAS __attribute__((address_space(1)))
#define LAS __attribute__((address_space(3)))
typedef unsigned short bf16;
typedef short bf16x8 __attribute__((ext_vector_type(8)));
typedef float f32x4 __attribute__((ext_vector_type(4)));
typedef float f32x2 __attribute__((ext_vector_type(2)));
typedef unsigned u32x4 __attribute__((ext_vector_type(4)));
typedef unsigned u32x2 __attribute__((ext_vector_type(2)));

constexpr int D = 2048, NB = 8, T = 4096, CTXL = 256, DEPTH = 2;
constexpr int NLAT = NB * T, NCTX = NB * CTXL, MALL = NLAT + NCTX;
constexpr int INC = 7424;
constexpr int OFF_U = 0, OFF_V = 512, OFF_Q = 1024, OFF_I = 1792, OFF_ZF = 2560, OFF_ZB = 3328, OFF_OG = 4096;
constexpr int OFF_C = 4864;
constexpr int BW = 768, CW = 768, CCOLS = 2560;
constexpr int NE = 16, DE = 1024;
constexpr int PC2W = 7 * 768;
constexpr int NTHREADS = 512;
constexpr float NORM_EPS = 1e-6f, GN_EPS = 64e-5f, DECAY_SCALE = 0.60653065971263342f;

constexpr size_t MiB = 1u << 20;
constexpr size_t WS_CTL = 0, CTL_ZERO_BYTES = 1 * MiB;
constexpr size_t WS_MOD = 1 * MiB;
constexpr size_t WS_SMALLW = 2 * MiB;
constexpr size_t SW_WUP = 0, SW_AUP = SW_WUP + (size_t)2 * 2 * 768 * 64 * 2, SW_GUP = SW_AUP + (size_t)2 * 768 * 64 * 2, SW_GWS = SW_GUP + (size_t)2 * 768 * 128 * 2;
constexpr size_t WS_WIN = 4 * MiB, WS_WOUT = 62 * MiB, WS_WGU = 78 * MiB, WS_WDN = 334 * MiB;
constexpr size_t WS_X = 462 * MiB, WS_H = 734 * MiB, WS_Y = 870 * MiB, WS_P = 1006 * MiB, WS_PC2 = 1499 * MiB, WS_OC = 1856 * MiB, WS_END = 1958 * MiB;
constexpr size_t WS_OB = WS_H;
constexpr size_t WS_ACT = WS_P, WS_YK = WS_P + 144 * MiB, WS_RIDX = WS_P + 416 * MiB, WS_RW = WS_RIDX + 3 * MiB;
static_assert(WS_RW + 3 * MiB <= WS_PC2, "moe overlay");
constexpr int MAXSLOT_TILES = 288;
constexpr int CW_BAR = 4096;
constexpr int CW_CNT = 16384;

constexpr int LDS_STAGE = 0, LDS_TAB = 131072, LDS_TABW = LDS_TAB + 9 * 1024, LDS_TP = LDS_TABW + 9 * 1024, LDS_MISC = 150528, LDS_BYTES = 152 * 1024;
static_assert(LDS_TP + 128 <= LDS_MISC, "lds map");

__device__ __forceinline__ unsigned f2bf(float f) { unsigned u = __builtin_bit_cast(unsigned, f); return (u + 0x7fffu + ((u >> 16) & 1u)) >> 16; }
__device__ __forceinline__ unsigned pk2(float lo, float hi) { return f2bf(lo) | (f2bf(hi) << 16); }
__device__ __forceinline__ float bflo(unsigned u) { return __builtin_bit_cast(float, u << 16); }
__device__ __forceinline__ float bfhi(unsigned u) { return __builtin_bit_cast(float, u & 0xffff0000u); }
__device__ __forceinline__ float bf1(bf16 b) { return __builtin_bit_cast(float, ((unsigned)b) << 16); }
__device__ __forceinline__ float sigmoidf_(float x) { return 1.0f / (1.0f + __expf(-x)); }
__device__ __forceinline__ float siluf_(float x) { return x / (1.0f + __expf(-x)); }
__device__ __forceinline__ float geluf_(float x) { return 0.5f * x * (1.0f + erff(x * 0.70710678118654752f)); }
__device__ __forceinline__ float wave_sum(float v) {
#pragma unroll
    for (int o = 1; o < 64; o <<= 1) v += __shfl_xor(v, o);
    return v;
}
__device__ __forceinline__ int tid_fresh() { int t = threadIdx.x; asm volatile("" : "+v"(t)); return t; }
__device__ __forceinline__ void unpack8(const u32x4 v, float (&f)[8]) {
    f[0] = bflo(v.x); f[1] = bfhi(v.x); f[2] = bflo(v.y); f[3] = bfhi(v.y); f[4] = bflo(v.z); f[5] = bfhi(v.z); f[6] = bflo(v.w); f[7] = bfhi(v.w);
}
__device__ __forceinline__ u32x4 pack8(const float (&f)[8]) { u32x4 v; v.x = pk2(f[0], f[1]); v.y = pk2(f[2], f[3]); v.z = pk2(f[4], f[5]); v.w = pk2(f[6], f[7]); return v; }
__device__ __forceinline__ int modrow_of(int row) { return row < NLAT ? (row >> 12) : 8; }

#define XB_TMO      128
#define XB_XCNT(j)  (256  + 64 * (j))
#define XB_XSUB(j)  (1280 + 64 * (j))
#define XB_XGEN(j)  (2304 + 64 * (j))
#define XB_TOP      3328
#define XB_TOPGEN   3392
#define XCD_BAR_WORDS 3456
#define XB_SPIN_CAP (1u << 18)
__device__ __forceinline__ unsigned xb_ld(unsigned* p)              { return __hip_atomic_load(p, __ATOMIC_RELAXED, __HIP_MEMORY_SCOPE_AGENT); }
__device__ __forceinline__ unsigned xb_add(unsigned* p, unsigned v) { return __hip_atomic_fetch_add(p, v, __ATOMIC_RELAXED, __HIP_MEMORY_SCOPE_AGENT); }
__device__ __forceinline__ unsigned xb_xcc_id() { return (unsigned)__builtin_amdgcn_s_getreg((3 << 11) | 20) & 0xFu; }
#define XB_SPIN(cond, bar) do { unsigned _sp = 0; while (cond) { __builtin_amdgcn_s_sleep(1); \
    if ((++_sp & 255u) == 0u) { if (xb_ld(&(bar)[XB_TMO])) break; if (_sp > XB_SPIN_CAP) { atomicAdd(&(bar)[XB_TMO], 1u); break; } } } } while (0)
struct XcdBarrier { unsigned* bar; unsigned x; volatile LAS unsigned* st; };
__device__ __forceinline__ XcdBarrier xcd_barrier_post(unsigned* bar, volatile LAS unsigned* st) {
    XcdBarrier b; b.bar = bar; b.x = xb_xcc_id(); b.st = st;
    if (threadIdx.x == 0) (void)xb_add(&bar[XB_XCNT(b.x)], 1u);
    return b;
}
__device__ __forceinline__ void xcd_barrier_complete(unsigned* bar, unsigned x, unsigned& nloc, unsigned& nx) {
    const unsigned G = gridDim.x * gridDim.y * gridDim.z;
    unsigned sum, cnt, mine, sp = 0u;
    for (;;) {
        sum = 0u; cnt = 0u; mine = 0u;
#pragma unroll
        for (unsigned j = 0; j < 16; ++j) { const unsigned c = xb_ld(&bar[XB_XCNT(j)]); sum += c; cnt += (c > 0u) ? 1u : 0u; mine = (j == x) ? c : mine; }
        if (sum == G) break;
        __builtin_amdgcn_s_sleep(1);
        if ((++sp & 255u) == 0u) { if (xb_ld(&bar[XB_TMO])) break; if (sp > XB_SPIN_CAP) { atomicAdd(&bar[XB_TMO], 1u); break; } }
    }
    nloc = mine > 0u ? mine : 1u; nx = cnt > 0u ? cnt : 1u;
}
__device__ __forceinline__ void xcd_barrier(const XcdBarrier& b) {
    asm volatile("s_waitcnt vmcnt(0)" ::: "memory");
    __syncthreads();
    if (threadIdx.x == 0) {
        unsigned* bar = b.bar;
        __builtin_amdgcn_s_waitcnt(0);
        unsigned nloc = b.st[0], nx = b.st[1];
        if (nloc == 0u) { xcd_barrier_complete(bar, b.x, nloc, nx); b.st[0] = nloc; b.st[1] = nx; }
        const unsigned old = xb_add(&bar[XB_XSUB(b.x)], 1u);
        const unsigned gen = old / nloc;
        if (old + 1u == (gen + 1u) * nloc) {
            __builtin_amdgcn_fence(__ATOMIC_RELEASE, "agent");
            asm volatile("s_waitcnt vmcnt(0)" ::: "memory");
            const unsigned og = xb_add(&bar[XB_TOP], 1u);
            const unsigned tg = og / nx;
            if (og + 1u == (tg + 1u) * nx) xb_add(&bar[XB_TOPGEN], 1u);
            else XB_SPIN(xb_ld(&bar[XB_TOPGEN]) == tg, bar);
            __builtin_amdgcn_fence(__ATOMIC_ACQUIRE, "agent");
            xb_add(&bar[XB_XGEN(b.x)], 1u);
            asm volatile("s_waitcnt vmcnt(0)" ::: "memory");
        } else {
            XB_SPIN(xb_ld(&bar[XB_XGEN(b.x)]) == gen, bar);
            __builtin_amdgcn_fence(__ATOMIC_ACQUIRE, "agent");
            asm volatile("s_waitcnt vmcnt(0)" ::: "memory");
        }
    }
    __syncthreads();
}

namespace pg8 {
constexpr int BM = 256, BK = 64, HALF = 128, HTB = HALF * BK * 2, STAGE_BYTES = 8 * HTB, NXCD = 8, WGM = 8;
__host__ __device__ __forceinline__ int lds_byte(int r, int c) { const int st = (r >> 4) * 2 + (c >> 5), rr = r & 15, cc = c & 31, ob = rr * 64 + cc * 2; return st * 1024 + (ob ^ (((ob >> 9) & 1) << 5)); }
__host__ __device__ __forceinline__ void stage_rc(int b, int& R, int& C) { const int st = b / 1024, sb = b % 1024, swz = sb ^ (((sb >> 9) & 1) << 5); R = (st >> 1) * 16 + swz / 64; C = (st & 1) * 32 + (swz % 64) / 2; }
__host__ __device__ __forceinline__ int perm32(int rho) { const int n = rho >> 4, i = rho & 15; return 8 * (i >> 2) + 4 * n + (i & 3); }

struct Unit { int pm, pn, e, aux; };
struct Gemm { const bf16* A; const bf16* Bt; int M, N, K; };

struct StaticOrder {
    int nM, nN, nwg, G, c;
    __device__ void init(int M, int N, int G_, int c_) { nM = M / BM; nN = N / BM; nwg = nM * nN; G = G_; c = c_; }
    __device__ bool next(int i, Unit& u) const {
        const long L = (long)i * G + c; if (L >= nwg) return false;
        int wgid = (int)L; { const int q = nwg / NXCD, r = nwg % NXCD, xcd = wgid % NXCD, off = wgid / NXCD; wgid = (xcd < r ? xcd * (q + 1) : r * (q + 1) + (xcd - r) * q) + off; }
        const int nig = WGM * nN, gid = wgid / nig, fm = gid * WGM, gsz = (nM - fm) < WGM ? (nM - fm) : WGM;
        u.pm = fm + ((wgid % nig) % gsz); u.pn = (wgid % nig) / gsz; u.e = 0; u.aux = 0; return true;
    }
    __device__ __forceinline__ unsigned b_off(const Unit& u, unsigned tstep) const { return (unsigned)u.pn * tstep; }
};
struct MoeOrder {
    const LAS int* tp; int G, c; unsigned estride;
    __device__ bool next(int i, Unit& u) const {
        const int L = i * G + c; const int ntot = tp[16] * 8; if (L >= ntot) return false;
        const int tile = L >> 3; int e = 0;
#pragma unroll
        for (int j = 1; j < 16; ++j) e += (tile >= tp[j]) ? 1 : 0;
        u.pm = tile; u.pn = L & 7; u.e = e; u.aux = i; return true;
    }
    __device__ __forceinline__ unsigned b_off(const Unit& u, unsigned tstep) const { return (unsigned)u.e * estride + (unsigned)u.pn * tstep; }
};

#define PG8_LAS __attribute__((address_space(3)))
template <class Epi, class Sched, bool ALIGN_EPI, bool GATHER>
__device__ __forceinline__ void gemm_phase(PG8_LAS unsigned char* lds, const Gemm g, const Sched& S, const Epi& E, const PG8_LAS unsigned* tabA) {
    const int tid = tid_fresh(), wid = __builtin_amdgcn_readfirstlane(tid >> 6), lane = tid & 63, wr = wid >> 2, wc = wid & 3, fr = lane & 15, fq = lane >> 4;
    const int K = g.K, nt = K / BK;
    int sR[2], sC[2];
    unsigned voffB[2];
#pragma unroll
    for (int i = 0; i < 2; ++i) { int R, C; stage_rc(tid * 16 + i * 8192, R, C); sR[i] = R; sC[i] = C; const int Rb = Epi::PERM ? ((R & ~31) + perm32(R & 31)) : R;
        voffB[i] = (unsigned)(Rb * K + C) * 2u; }
    const unsigned kstep = (unsigned)(BK * 2);
    const unsigned hstep = (unsigned)(HALF * K * 2);
    const unsigned tstep = 2u * hstep;
    const unsigned ldsw = (unsigned)wid * 1024u;
    const char* const baseA = (const char*)g.A; const char* const baseB = (const char*)g.Bt;
    const int aoff = lds_byte(wr * 64 + fr, fq * 8), boff = lds_byte(wc * 32 + fr, fq * 8);
#define PG8_SA(b, h) (((b) * 2 + (h)) * HTB)
#define PG8_SB(b, h) ((4 + (b) * 2 + (h)) * HTB)
#define PG8_STAGE(bufoff, gbase, uoff, voff) do { _Pragma("unroll") for (int _i = 0; _i < 2; ++_i) \
        __builtin_amdgcn_global_load_lds((const unsigned*)((gbase) + (size_t)(unsigned)((uoff) + (voff)[_i])), (PG8_LAS unsigned*)(lds + (bufoff) + ldsw + _i * 8192), 16, 0, 0); } while (0)
#define PG8_LDA(dst, b, h) do { _Pragma("unroll") for (int m = 0; m < 4; ++m) _Pragma("unroll") for (int k = 0; k < 2; ++k) dst[m][k] = *(const PG8_LAS bf16x8*)(lds + PG8_SA(b, h) + aoff + m * 2048 + k * 1024); } while (0)
#define PG8_LDB(dst, b, h) do { _Pragma("unroll") for (int n = 0; n < 2; ++n) _Pragma("unroll") for (int k = 0; k < 2; ++k) dst[n][k] = *(const PG8_LAS bf16x8*)(lds + PG8_SB(b, h) + boff + n * 2048 + k * 1024); } while (0)
#define PG8_MMA(ai, bj, At, Bt) do { __builtin_amdgcn_s_setprio(1); _Pragma("unroll") for (int m = 0; m < 4; ++m) _Pragma("unroll") for (int n = 0; n < 2; ++n) _Pragma("unroll") for (int k = 0; k < 2; ++k) \
        acc[ai][bj][m][n] = __builtin_amdgcn_mfma_f32_16x16x32_bf16(Bt[n][k], At[m][k], acc[ai][bj][m][n], 0, 0, 0); __builtin_amdgcn_s_setprio(0); } while (0)
#define PG8_WAIT_V(n) asm volatile("s_waitcnt vmcnt(" #n ")" ::: "memory")
#define PG8_WAIT_L(n) asm volatile("s_waitcnt lgkmcnt(" #n ")" ::: "memory")
#define PG8_BAR __builtin_amdgcn_s_barrier()
#define PG8_SCHED __builtin_amdgcn_sched_barrier(0)
    Unit cur, nxt; int ui = 0;
    if (!S.next(0, cur)) return;
    f32x4 acc[2][2][4][2];
#pragma unroll
    for (int a = 0; a < 2; ++a)
#pragma unroll
        for (int b = 0; b < 2; ++b)
#pragma unroll
            for (int m = 0; m < 4; ++m)
#pragma unroll
                for (int n = 0; n < 2; ++n) acc[a][b][m][n] = (f32x4){0.f, 0.f, 0.f, 0.f};
    bf16x8 At[4][2], B0[2][2], B1[2][2];
    unsigned vA0[2], vA1[2], nA0[2], nA1[2];
    unsigned uA, uB = S.b_off(cur, tstep);
    if constexpr (GATHER) { uA = 0u;
#pragma unroll
        for (int i = 0; i < 2; ++i) { vA0[i] = tabA[cur.aux * 256 + sR[i]] + (unsigned)sC[i] * 2u; vA1[i] = tabA[cur.aux * 256 + 128 + sR[i]] + (unsigned)sC[i] * 2u; }
    } else { uA = (unsigned)cur.pm * tstep;
#pragma unroll
        for (int i = 0; i < 2; ++i) { vA0[i] = (unsigned)(sR[i] * K + sC[i]) * 2u; vA1[i] = vA0[i] + hstep; }
    }
    PG8_STAGE(PG8_SB(0, 0), baseB, uB, voffB); PG8_STAGE(PG8_SB(0, 1), baseB, uB + hstep, voffB); PG8_STAGE(PG8_SA(0, 0), baseA, uA, vA0); PG8_STAGE(PG8_SA(0, 1), baseA, uA, vA1);
    if (wr == 1) PG8_BAR;
    PG8_WAIT_V(2); PG8_BAR;
    PG8_STAGE(PG8_SB(1, 0), baseB, uB + kstep, voffB); PG8_STAGE(PG8_SA(1, 0), baseA, uA + kstep, vA0); PG8_STAGE(PG8_SB(1, 1), baseB, uB + hstep + kstep, voffB);
    PG8_WAIT_V(6); PG8_BAR;
    for (;;) {
        const bool has_next = S.next(ui + 1, nxt);
        unsigned nuA, nuB = has_next ? S.b_off(nxt, tstep) : uB;
        if constexpr (GATHER) { nuA = 0u;
#pragma unroll
            for (int i = 0; i < 2; ++i) { if (has_next) { nA0[i] = tabA[nxt.aux * 256 + sR[i]] + (unsigned)sC[i] * 2u; nA1[i] = tabA[nxt.aux * 256 + 128 + sR[i]] + (unsigned)sC[i] * 2u; } else { nA0[i] = vA0[i]; nA1[i] = vA1[i]; } }
        } else { nuA = has_next ? (unsigned)nxt.pm * tstep : uA;
#pragma unroll
            for (int i = 0; i < 2; ++i) { nA0[i] = vA0[i]; nA1[i] = vA1[i]; }
        }
        for (int t = 0; t < nt; t += 2) {
            const bool last = (t == nt - 2);
            const unsigned a1 = uA + (unsigned)(t + 1) * kstep;
            const unsigned a2 = last ? nuA : uA + (unsigned)(t + 2) * kstep; const unsigned b2 = last ? nuB : uB + (unsigned)(t + 2) * kstep;
            const unsigned a3 = a2 + kstep; const unsigned b3 = b2 + kstep;
            unsigned w0[2], w1[2];
#pragma unroll
            for (int i = 0; i < 2; ++i) { w0[i] = (GATHER && last) ? nA0[i] : vA0[i]; w1[i] = (GATHER && last) ? nA1[i] : vA1[i]; }
            PG8_LDB(B0, 0, 0); PG8_LDB(B1, 0, 1); PG8_SCHED; PG8_LDA(At, 0, 0); PG8_STAGE(PG8_SA(1, 1), baseA, a1, vA1);
            PG8_WAIT_V(8); PG8_WAIT_L(0); PG8_BAR; PG8_MMA(0, 0, At, B0); PG8_MMA(0, 1, At, B1); PG8_BAR; PG8_SCHED;
            PG8_LDA(At, 0, 1); PG8_STAGE(PG8_SB(0, 0), baseB, b2, voffB); PG8_STAGE(PG8_SB(0, 1), baseB, b2 + hstep, voffB); PG8_STAGE(PG8_SA(0, 0), baseA, a2, w0);
            PG8_WAIT_V(8); PG8_WAIT_L(0); PG8_BAR; PG8_MMA(1, 0, At, B0); PG8_MMA(1, 1, At, B1); PG8_BAR; PG8_SCHED;
            PG8_LDB(B0, 1, 0); PG8_LDB(B1, 1, 1); PG8_SCHED; PG8_LDA(At, 1, 0); PG8_STAGE(PG8_SA(0, 1), baseA, a2, w1);
            PG8_WAIT_V(8); PG8_WAIT_L(0); PG8_BAR; PG8_MMA(0, 0, At, B0); PG8_MMA(0, 1, At, B1); PG8_BAR; PG8_SCHED;
            PG8_LDA(At, 1, 1); PG8_STAGE(PG8_SB(1, 0), baseB, b3, voffB); PG8_STAGE(PG8_SB(1, 1), baseB, b3 + hstep, voffB); PG8_STAGE(PG8_SA(1, 0), baseA, a3, w0);
            PG8_WAIT_V(8); PG8_WAIT_L(0); PG8_BAR; PG8_MMA(1, 0, At, B0); PG8_MMA(1, 1, At, B1); PG8_BAR; PG8_SCHED;
        }
        if constexpr (ALIGN_EPI) { if (wr == 0) PG8_BAR; }
        E(acc, cur, wr, wc, fr, fq);
        if (!has_next) break;
#pragma unroll
        for (int a = 0; a < 2; ++a)
#pragma unroll
            for (int b = 0; b < 2; ++b)
#pragma unroll
                for (int m = 0; m < 4; ++m)
#pragma unroll
                    for (int n = 0; n < 2; ++n) acc[a][b][m][n] = (f32x4){0.f, 0.f, 0.f, 0.f};
        cur = nxt; uA = nuA; uB = nuB; ++ui;
#pragma unroll
        for (int i = 0; i < 2; ++i) { vA0[i] = nA0[i]; vA1[i] = nA1[i]; }
        if constexpr (ALIGN_EPI) { if (wr == 1) PG8_BAR; }
    }
    PG8_WAIT_V(0);
    if constexpr (!ALIGN_EPI) { if (wr == 0) PG8_BAR; }
    PG8_BAR;
#undef PG8_SA
#undef PG8_SB
#undef PG8_STAGE
#undef PG8_LDA
#undef PG8_LDB
#undef PG8_MMA
#undef PG8_WAIT_V
#undef PG8_WAIT_L
#undef PG8_BAR
#undef PG8_SCHED
}

__device__ __forceinline__ unsigned cvt_pk_bf16(float lo, float hi) { unsigned r; asm volatile("v_cvt_pk_bf16_f32 %0, %1, %2" : "=v"(r) : "v"(lo), "v"(hi)); return r; }

struct EpiBf16 {
    static constexpr bool PERM = true;
    bf16* O; int ldc;
    __device__ __forceinline__ void operator()(const f32x4 (&acc)[2][2][4][2], const Unit& u, int wr, int wc, int fr, int fq) const {
        const int row0 = u.pm * BM + wr * 64 + fr; const int col0 = u.pn * BM + wc * 32 + 8 * fq;
#pragma unroll
        for (int ai = 0; ai < 2; ++ai)
#pragma unroll
            for (int m = 0; m < 4; ++m) { bf16* rowp = O + (size_t)(row0 + ai * HALF + m * 16) * ldc + col0;
#pragma unroll
                for (int bj = 0; bj < 2; ++bj) { const f32x4 v0 = acc[ai][bj][m][0], v1 = acc[ai][bj][m][1];
                    u32x4 w; w.x = cvt_pk_bf16(v0[0], v0[1]); w.y = cvt_pk_bf16(v0[2], v0[3]); w.z = cvt_pk_bf16(v1[0], v1[1]); w.w = cvt_pk_bf16(v1[2], v1[3]);
                    *(u32x4*)(rowp + bj * HALF) = w; } }
    }
};
struct EpiResid {
    static constexpr bool PERM = false;
    const float* xl; const float* xc; float* out; const float* gate;
    __device__ __forceinline__ void operator()(const f32x4 (&acc)[2][2][4][2], const Unit& u, int wr, int wc, int fr, int fq) const {
        const int rt = u.pm * BM; const bool isl = rt < NLAT;
        const float* base = isl ? xl + (size_t)rt * D : xc + (size_t)(rt - NLAT) * D;
        const float* gp = gate + (size_t)(isl ? (rt >> 12) : 8) * 12288;
        const int rl0 = wr * 64 + fr, col0 = u.pn * BM + wc * 32 + 4 * fq;
#pragma unroll
        for (int ai = 0; ai < 2; ++ai)
#pragma unroll
            for (int m = 0; m < 4; ++m) { const int rl = rl0 + ai * HALF + m * 16; const float* bp = base + (size_t)rl * D + col0; float* op = out + (size_t)(rt + rl) * D + col0;
#pragma unroll
                for (int bj = 0; bj < 2; ++bj)
#pragma unroll
                    for (int n = 0; n < 2; ++n) { const f32x4 b = *(const f32x4*)(bp + bj * HALF + n * 16); const f32x4 gv = *(const f32x4*)(gp + col0 + bj * HALF + n * 16); *(f32x4*)(op + bj * HALF + n * 16) = b + gv * acc[ai][bj][m][n]; }
                asm volatile("" ::: "memory"); }
    }
};
struct EpiSwiglu {
    static constexpr bool PERM = true;
    bf16* O;
    __device__ __forceinline__ void operator()(const f32x4 (&acc)[2][2][4][2], const Unit& u, int wr, int wc, int fr, int fq) const {
        const int row0 = u.pm * BM + wr * 64 + fr; const int col0 = u.pn * 128 + wc * 32 + 8 * fq;
#pragma unroll
        for (int ai = 0; ai < 2; ++ai)
#pragma unroll
            for (int m = 0; m < 4; ++m) { bf16* rowp = O + (size_t)(row0 + ai * HALF + m * 16) * DE + col0;
                float o[8];
#pragma unroll
                for (int n = 0; n < 2; ++n)
#pragma unroll
                    for (int j = 0; j < 4; ++j) { const float gt = acc[ai][0][m][n][j], up = acc[ai][1][m][n][j]; o[n * 4 + j] = gt / (1.0f + __expf(-gt)) * up; }
                u32x4 w; w.x = cvt_pk_bf16(o[0], o[1]); w.y = cvt_pk_bf16(o[2], o[3]); w.z = cvt_pk_bf16(o[4], o[5]); w.w = cvt_pk_bf16(o[6], o[7]);
                *(u32x4*)rowp = w; }
    }
};
struct EpiDown {
    static constexpr bool PERM = true;
    bf16* YK; const PG8_LAS unsigned* tab; const PG8_LAS float* tabw;
    __device__ __forceinline__ void operator()(const f32x4 (&acc)[2][2][4][2], const Unit& u, int wr, int wc, int fr, int fq) const {
        const int rl0 = wr * 64 + fr; const int col0 = u.pn * BM + wc * 32 + 8 * fq;
#pragma unroll
        for (int ai = 0; ai < 2; ++ai)
#pragma unroll
            for (int m = 0; m < 4; ++m) { const int rl = rl0 + ai * HALF + m * 16; const unsigned ent = tab[u.aux * 256 + rl]; const float w = tabw[u.aux * 256 + rl];
                if (!(ent & 0x40000000u)) { bf16* rowp = YK + ((size_t)(ent >> 31) * MALL + (ent & 0xffffu)) * D + col0;
#pragma unroll
                    for (int bj = 0; bj < 2; ++bj) { const f32x4 v0 = acc[ai][bj][m][0] * w, v1 = acc[ai][bj][m][1] * w;
                        u32x4 q; q.x = cvt_pk_bf16(v0[0], v0[1]); q.y = cvt_pk_bf16(v0[2], v0[3]); q.z = cvt_pk_bf16(v1[0], v1[1]); q.w = cvt_pk_bf16(v1[2], v1[3]);
                        *(u32x4*)(rowp + bj * HALF) = q; } }
                asm volatile("" ::: "memory"); }
    }
};
}

struct Args { const float* in[31]; float* out; unsigned char* ws; int ph_lo, ph_hi; };
typedef const __attribute__((address_space(4))) Args* KArgs;
__device__ __forceinline__ KArgs kargs() { KArgs p = (KArgs)__builtin_amdgcn_kernarg_segment_ptr(); asm volatile("" : "+s"(p)); return p; }
#define AIN(i) (a->in[i])
enum { I_X = 0, I_C, I_CTX, I_CCTX, I_ADAW, I_ADAB, I_N1G, I_N2G, I_WIN, I_WOUT, I_GNG, I_GWS, I_GB, I_LB, I_HNG, I_MU, I_W0, I_WUP, I_A0, I_AUP, I_GUP, I_KK, I_KA, I_RK, I_GNGG, I_GNB, I_RW, I_RB, I_WGU, I_WDN, I_FNG };

__device__ __forceinline__ void p0_transpose_item(const float* W, int K, int N, bf16* WT, int n_row0, LAS float* scr, int kb, int nb, int lane) {
    const int k0 = 64 * kb, n0 = 32 * nb;
#pragma unroll 8
    for (int i = 0; i < 32; ++i) { const int kk = 2 * i + (lane >> 5); scr[kk * 33 + (lane & 31)] = W[(size_t)(k0 + kk) * N + n0 + (lane & 31)]; }
    asm volatile("s_waitcnt lgkmcnt(0)" ::: "memory");
    const int c = lane & 7;
#pragma unroll
    for (int j = 0; j < 4; ++j) { const int n = (lane >> 3) + 8 * j; const LAS float* s = scr + (8 * c) * 33 + n;
        u32x4 o; o.x = pk2(s[0 * 33], s[1 * 33]); o.y = pk2(s[2 * 33], s[3 * 33]); o.z = pk2(s[4 * 33], s[5 * 33]); o.w = pk2(s[6 * 33], s[7 * 33]);
        *(u32x4*)(WT + (size_t)(n_row0 + n) * K + k0 + 8 * c) = o; }
    asm volatile("s_waitcnt lgkmcnt(0)" ::: "memory");
}

__device__ __forceinline__ void phase_prologue(KArgs a, LAS unsigned char* lds) {
    const int tid = tid_fresh(), lane = tid & 63, wave = tid >> 6;
    const int G = gridDim.x, gw = blockIdx.x * 8 + wave, NGW = G * 8;
    unsigned char* ws = a->ws;
    LAS float* scr = (LAS float*)(lds + wave * 16384);
    constexpr int I_IN = 32 * 232, I_OUT = 32 * 64, I_GU = 32 * 64, I_DN = 16 * 64;
    constexpr int N0 = 2 * I_IN, N1 = N0 + 2 * I_OUT, N2 = N1 + 32 * I_GU, N3 = N2 + 32 * I_DN;
    for (int it = gw; it < N3; it += NGW) {
        if (it < N0) { const int l = it / I_IN, r = it % I_IN, kb = r / 232, nb = r % 232;
            p0_transpose_item(a->in[I_WIN] + (size_t)l * D * INC, D, INC, (bf16*)(ws + WS_WIN) + (size_t)l * INC * D, 32 * nb, scr, kb, nb, lane); }
        else if (it < N1) { const int q = it - N0, l = q / I_OUT, r = q % I_OUT, kb = r / 64, nb = r % 64;
            p0_transpose_item(a->in[I_WOUT] + (size_t)l * D * D, D, D, (bf16*)(ws + WS_WOUT) + (size_t)l * D * D, 32 * nb, scr, kb, nb, lane); }
        else if (it < N2) { const int q = it - N1, le = q / I_GU, r = q % I_GU, kb = r / 64, nb = r % 64;
            const int n0 = 32 * nb, hh = n0 >> 10, nn = n0 & 1023, row0 = 256 * (nn >> 7) + 128 * hh + (nn & 127);
            p0_transpose_item(a->in[I_WGU] + (size_t)le * D * 2048, D, 2048, (bf16*)(ws + WS_WGU) + (size_t)le * 2048 * D, row0, scr, kb, nb, lane); }
        else { const int q = it - N2, le = q / I_DN, r = q % I_DN, kb = r / 64, nb = r % 64;
            p0_transpose_item(a->in[I_WDN] + (size_t)le * DE * D, DE, D, (bf16*)(ws + WS_WDN) + (size_t)le * D * DE, 32 * nb, scr, kb, nb, lane); }
    }
    {
        const int gt = blockIdx.x * NTHREADS + tid, NGT = G * NTHREADS;
        bf16* wup = (bf16*)(ws + WS_SMALLW + SW_WUP); bf16* aup = (bf16*)(ws + WS_SMALLW + SW_AUP); bf16* gup = (bf16*)(ws + WS_SMALLW + SW_GUP); bf16* gws = (bf16*)(ws + WS_SMALLW + SW_GWS);
        for (int i = gt; i < 2 * 2 * 768 * 64; i += NGT) { const int k = i & 63, n = (i >> 6) % 768, ld = i / (768 * 64); wup[i] = (bf16)f2bf(a->in[I_WUP][((size_t)ld * 64 + k) * 768 + n]); }
        for (int i = gt; i < 2 * 768 * 64; i += NGT) { const int k = i & 63, n = (i >> 6) % 768, l = i / (768 * 64); aup[i] = (bf16)f2bf(a->in[I_AUP][((size_t)l * 64 + k) * 768 + n]); }
        for (int i = gt; i < 2 * 768 * 128; i += NGT) { const int k = i & 127, n = (i >> 7) % 768, l = i / (768 * 128); gup[i] = (bf16)f2bf(a->in[I_GUP][((size_t)l * 128 + k) * 768 + n]); }
        for (int i = gt; i < 2 * 4 * 128 * 128; i += NGT) gws[i] = (bf16)f2bf(a->in[I_GWS][i]);
    }
    __syncthreads();
    {
        LAS float* sv = (LAS float*)lds;
        LAS float* red = (LAS float*)(lds + 73728);
        for (int i = tid; i < 9 * D; i += NTHREADS) { const int r = i / D, k = i % D; const float v = r < 8 ? a->in[I_C][r * D + k] : a->in[I_CCTX][k]; sv[i] = siluf_(v); }
        __syncthreads();
        float* mod = (float*)(ws + WS_MOD);
        for (int it = blockIdx.x; it < 2 * 96; it += G) {
            const int l = it / 96, cb = it % 96, cq = tid & 31, kg = tid >> 5;
            const float* wp = a->in[I_ADAW] + (size_t)l * D * 12288 + (size_t)(kg * 128) * 12288 + cb * 128 + cq * 4;
            f32x4 acc[9];
#pragma unroll
            for (int r = 0; r < 9; ++r) acc[r] = (f32x4){0.f, 0.f, 0.f, 0.f};
#pragma unroll 4
            for (int k = 0; k < 128; ++k) { const f32x4 w = *(const f32x4*)(wp + (size_t)k * 12288);
#pragma unroll
                for (int r = 0; r < 9; ++r) acc[r] += w * sv[r * D + kg * 128 + k]; }
#pragma unroll
            for (int r = 0; r < 9; ++r) *(LAS f32x4*)(red + ((kg * 9 + r) * 128 + cq * 4)) = acc[r];
            __syncthreads();
            for (int o = tid; o < 9 * 128; o += NTHREADS) { const int r = o / 128, c = o % 128; float s = a->in[I_ADAB][(size_t)l * 12288 + cb * 128 + c];
#pragma unroll
                for (int q = 0; q < 16; ++q) s += red[(q * 9 + r) * 128 + c];
                mod[((size_t)l * 9 + r) * 12288 + cb * 128 + c] = s; }
            __syncthreads();
        }
    }
}

template <int MODE>
__device__ __forceinline__ void phase_norm1(KArgs a, int l) {
    const int tid_ = tid_fresh(); const int lane = tid_ & 63, wave = tid_ >> 6, gw = blockIdx.x * 8 + wave, NGW = gridDim.x * 8;
    unsigned char* ws = a->ws;
    const float* mod = (const float*)(ws + WS_MOD);
    float* X = (float*)(ws + WS_X); bf16* H = (bf16*)(ws + WS_H); const bf16* YK = (const bf16*)(ws + WS_YK);
    const int nrows = (MODE == 2) ? NLAT : MALL;
    for (int row = gw; row < nrows; row += NGW) {
        const int mr = modrow_of(row);
        f32x4 v[8];
        if (MODE == 0) { const float* xr = row < NLAT ? a->in[I_X] + (size_t)row * D : a->in[I_CTX] + (size_t)(row - NLAT) * D;
#pragma unroll
            for (int j = 0; j < 8; ++j) v[j] = *(const f32x4*)(xr + 4 * lane + 256 * j);
        } else {
            const float* xr = X + (size_t)row * D; const float* g2 = mod + ((size_t)(l - 1) * 9 + mr) * 12288 + 5 * D;
            const bf16* y0 = YK + (size_t)row * D; const bf16* y1 = YK + ((size_t)MALL + row) * D;
#pragma unroll
            for (int j = 0; j < 8; ++j) { const int c = 4 * lane + 256 * j; const f32x4 x = *(const f32x4*)(xr + c); const f32x4 g = *(const f32x4*)(g2 + c);
                const u32x2 p0 = *(const u32x2*)(y0 + c), p1 = *(const u32x2*)(y1 + c);
                f32x4 f; f[0] = bflo(p0.x) + bflo(p1.x); f[1] = bfhi(p0.x) + bfhi(p1.x); f[2] = bflo(p0.y) + bflo(p1.y); f[3] = bfhi(p0.y) + bfhi(p1.y);
                v[j] = x + g * f; }
            if (MODE == 1) {
#pragma unroll
                for (int j = 0; j < 8; ++j) *(f32x4*)(X + (size_t)row * D + 4 * lane + 256 * j) = v[j];
            }
        }
        float ss = 0.f;
#pragma unroll
        for (int j = 0; j < 8; ++j) ss += (v[j][0] * v[j][0] + v[j][1] * v[j][1]) + (v[j][2] * v[j][2] + v[j][3] * v[j][3]);
        const float rstd = 1.0f / sqrtf(wave_sum(ss) * (1.0f / D) + NORM_EPS);
        if (MODE == 2) {
#pragma unroll
            for (int j = 0; j < 8; ++j) { const int c = 4 * lane + 256 * j; const f32x4 g = *(const f32x4*)(a->in[I_FNG] + c); *(f32x4*)(a->out + (size_t)row * D + c) = v[j] * rstd * g; }
        } else {
            const float* m = mod + ((size_t)l * 9 + mr) * 12288; const float* ng = a->in[I_N1G] + (size_t)l * D;
#pragma unroll
            for (int j = 0; j < 8; ++j) { const int c = 4 * lane + 256 * j; const f32x4 g = *(const f32x4*)(ng + c), sh = *(const f32x4*)(m + c), sc = *(const f32x4*)(m + D + c);
                const f32x4 h = v[j] * rstd * g * (sc + 1.0f) + sh; u32x2 o; o.x = pk2(h[0], h[1]); o.y = pk2(h[2], h[3]); *(u32x2*)(H + (size_t)row * D + c) = o; }
        }
    }
}

__device__ __forceinline__ void phase_norm2_router(KArgs a, int l) {
    const int tid_ = tid_fresh(); const int lane = tid_ & 63, wave = tid_ >> 6, gw = blockIdx.x * 8 + wave, NGW = gridDim.x * 8;
    unsigned char* ws = a->ws;
    const float* mod = (const float*)(ws + WS_MOD);
    const float* X = (const float*)(ws + WS_X); bf16* H = (bf16*)(ws + WS_H);
    unsigned* cnt = (unsigned*)(ws + WS_CTL) + CW_CNT + l * 16 * 64;
    unsigned* ridx = (unsigned*)(ws + WS_RIDX); float* rwt = (float*)(ws + WS_RW);
    const int nrows = (l == DEPTH - 1) ? NLAT : MALL;
    const float* rw = a->in[I_RW];
    for (int row = gw; row < nrows; row += NGW) {
        const int mr = modrow_of(row);
        const float* xr = X + (size_t)row * D; const float* m = mod + ((size_t)l * 9 + mr) * 12288; const float* ng = a->in[I_N2G] + (size_t)l * D;
        f32x4 v[8]; float ss = 0.f;
#pragma unroll
        for (int j = 0; j < 8; ++j) { v[j] = *(const f32x4*)(xr + 4 * lane + 256 * j); ss += (v[j][0] * v[j][0] + v[j][1] * v[j][1]) + (v[j][2] * v[j][2] + v[j][3] * v[j][3]); }
        const float rstd = 1.0f / sqrtf(wave_sum(ss) * (1.0f / D) + NORM_EPS);
        float lg[16];
#pragma unroll
        for (int e = 0; e < 16; ++e) lg[e] = 0.f;
#pragma unroll
        for (int j = 0; j < 8; ++j) { const int c = 4 * lane + 256 * j; const f32x4 g = *(const f32x4*)(ng + c), sh = *(const f32x4*)(m + 3 * D + c), sc = *(const f32x4*)(m + 4 * D + c);
            const f32x4 h = v[j] * rstd * g * (sc + 1.0f) + sh; u32x2 o; o.x = pk2(h[0], h[1]); o.y = pk2(h[2], h[3]); *(u32x2*)(H + (size_t)row * D + c) = o;
#pragma unroll
            for (int i = 0; i < 4; ++i) { const float* rr = rw + (size_t)(c + i) * 16;
#pragma unroll
                for (int q = 0; q < 4; ++q) { const f32x4 w = *(const f32x4*)(rr + 4 * q); lg[4 * q + 0] += h[i] * w[0]; lg[4 * q + 1] += h[i] * w[1]; lg[4 * q + 2] += h[i] * w[2]; lg[4 * q + 3] += h[i] * w[3]; } } }
#pragma unroll
        for (int e = 0; e < 16; ++e) lg[e] = wave_sum(lg[e]) + a->in[I_RB][e];
        float mx = lg[0];
#pragma unroll
        for (int e = 1; e < 16; ++e) mx = fmaxf(mx, lg[e]);
        float p[16], sum = 0.f;
#pragma unroll
        for (int e = 0; e < 16; ++e) { p[e] = __expf(lg[e] - mx); sum += p[e]; }
        const float inv = 1.0f / sum;
#pragma unroll
        for (int e = 0; e < 16; ++e) p[e] *= inv;
        int sel = 0; float best = -1.f;
#pragma unroll
        for (int gI = 0; gI < 4; ++gI) { float m1 = -1.f, m2 = -1.f;
#pragma unroll
            for (int i = 0; i < 4; ++i) { const float q = p[4 * gI + i]; if (q > m1) { m2 = m1; m1 = q; } else if (q > m2) m2 = q; }
            const float s = m1 + m2; if (s > best) { best = s; sel = gI; } }
        int i1 = 0, i2 = 0; float p1 = -2.f, p2 = -2.f;
#pragma unroll
        for (int gI = 0; gI < 4; ++gI)
#pragma unroll
            for (int i = 0; i < 4; ++i) { const float q = (gI == sel) ? p[4 * gI + i] : -1.0f; const int e = 4 * gI + i;
                if (gI == sel) { if (q > p1) { p2 = p1; i2 = i1; p1 = q; i1 = e; } else if (q > p2) { p2 = q; i2 = e; } } }
        const float wsum = p1 + p2, w1 = p1 / wsum, w2 = p2 / wsum;
        if (lane == 0) {
            const unsigned q1 = atomicAdd(cnt + i1 * 64, 1u); ridx[(size_t)i1 * MALL + q1] = (unsigned)row; rwt[(size_t)i1 * MALL + q1] = w1;
            const unsigned q2 = atomicAdd(cnt + i2 * 64, 1u); ridx[(size_t)i2 * MALL + q2] = (unsigned)row | 0x80000000u; rwt[(size_t)i2 * MALL + q2] = w2;
        }
    }
}

template <bool FOR_DOWN>
__device__ __forceinline__ void moe_tables(KArgs a, int l, LAS unsigned char* lds, int cvirt) {
    const int tid = tid_fresh(), G = gridDim.x;
    unsigned char* ws = a->ws;
    const unsigned* cnt = (const unsigned*)(ws + WS_CTL) + CW_CNT + l * 16 * 64;
    const unsigned* ridx = (const unsigned*)(ws + WS_RIDX); const float* rwt = (const float*)(ws + WS_RW);
    LAS int* tp = (LAS int*)(lds + LDS_TP); LAS unsigned* tab = (LAS unsigned*)(lds + LDS_TAB); LAS float* tabw = (LAS float*)(lds + LDS_TABW);
    if (tid == 0) { int acc = 0; for (int e = 0; e < 16; ++e) { tp[e] = acc; acc += (int)((cnt[e * 64] + 255u) >> 8); } tp[16] = acc; }
    __syncthreads();
    const int ntot = tp[16] * 8;
    for (int i = 0; i < 9; ++i) { const int L = i * G + cvirt; if (L >= ntot) break;
        const int tile = L >> 3; int e = 0;
        for (int j = 1; j < 16; ++j) e += (tile >= tp[j]) ? 1 : 0;
        const int pos0 = (tile - tp[e]) * 256; const unsigned ce = cnt[e * 64];
        if (tid < 256) { const int pos = pos0 + tid; const bool valid = (unsigned)pos < ce; const unsigned ent = ridx[(size_t)e * MALL + (valid ? pos : 0)];
            if (FOR_DOWN) { tab[i * 256 + tid] = valid ? ent : (ent | 0x40000000u); tabw[i * 256 + tid] = valid ? rwt[(size_t)e * MALL + pos] : 0.f; }
            else tab[i * 256 + tid] = (ent & 0xffffu) * (unsigned)(D * 2); }
    }
    __syncthreads();
}

__device__ __forceinline__ void gmlp_item(KArgs a, int l, int item, LAS unsigned char* lds) {
    const int tid = tid_fresh(), lane = tid & 63, wave = tid >> 6;
    unsigned char* ws = a->ws;
    const bf16* P = (const bf16*)(ws + WS_P); bf16* Y = (bf16*)(ws + WS_Y);
    const int chunk = item >> 2, h = item & 3;
    const int row0 = chunk < 256 ? chunk * 128 : NLAT + (chunk - 256) * 128;
    LAS bf16* wsl = (LAS bf16*)lds;
    LAS bf16* vT = (LAS bf16*)(lds + 128 * 136 * 2);
    const bf16* gws = (const bf16*)(ws + WS_SMALLW + SW_GWS) + ((size_t)l * 4 + h) * 128 * 128;
    for (int p = tid; p < 2048; p += NTHREADS) { const int t = p >> 4, c8 = p & 15; *(LAS u32x4*)(wsl + t * 136 + c8 * 8) = *(const u32x4*)(gws + t * 128 + c8 * 8); }
    {
        const int s = tid >> 2, qd = tid & 3; const bf16* vp = P + (size_t)(row0 + s) * INC + OFF_V + h * 128 + qd * 32;
        float g[32]; float ss = 0.f;
#pragma unroll
        for (int q = 0; q < 4; ++q) { float f[8]; unpack8(*(const u32x4*)(vp + 8 * q), f);
#pragma unroll
            for (int j = 0; j < 8; ++j) { const float x = geluf_(f[j]); g[8 * q + j] = x; ss += x * x; } }
        ss += __shfl_xor(ss, 1); ss += __shfl_xor(ss, 2);
        const float rstd = 1.0f / sqrtf(ss * (1.0f / 128.0f) + NORM_EPS);
        const float* ng = a->in[I_GNG] + (size_t)l * 512 + h * 128 + qd * 32;
#pragma unroll
        for (int j = 0; j < 32; ++j) vT[(qd * 32 + j) * 136 + s] = (bf16)f2bf(g[j] * rstd * ng[j]);
    }
    __syncthreads();
    f32x4 acc[8];
#pragma unroll
    for (int ct = 0; ct < 8; ++ct) acc[ct] = (f32x4){0.f, 0.f, 0.f, 0.f};
    const int fr = lane & 15, fq = lane >> 4;
#pragma unroll
    for (int ks = 0; ks < 4; ++ks) {
        const bf16x8 bfrag = *(const LAS bf16x8*)(wsl + (16 * wave + fr) * 136 + ks * 32 + fq * 8);
#pragma unroll
        for (int ct = 0; ct < 8; ++ct) { const bf16x8 afrag = *(const LAS bf16x8*)(vT + (16 * ct + fr) * 136 + ks * 32 + fq * 8);
            acc[ct] = __builtin_amdgcn_mfma_f32_16x16x32_bf16(afrag, bfrag, acc[ct], 0, 0, 0); }
    }
    const int t = 16 * wave + fr; const float wb = a->in[I_GB][((size_t)l * 4 + h) * 128 + t];
    const bf16* up = P + (size_t)(row0 + t) * INC + OFF_U + h * 128; bf16* yp = Y + (size_t)(row0 + t) * D + h * 128;
#pragma unroll
    for (int ct = 0; ct < 8; ++ct) { const int c = 16 * ct + 4 * fq; const u32x2 uu = *(const u32x2*)(up + c);
        const float y0 = geluf_(bflo(uu.x)) * (acc[ct][0] + wb), y1 = geluf_(bfhi(uu.x)) * (acc[ct][1] + wb), y2 = geluf_(bflo(uu.y)) * (acc[ct][2] + wb), y3 = geluf_(bfhi(uu.y)) * (acc[ct][3] + wb);
        u32x2 o; o.x = pk2(y0, y1); o.y = pk2(y2, y3); *(u32x2*)(yp + c) = o; }
    __syncthreads();
}

constexpr int KLP = 776;
__device__ __forceinline__ void rwkv_prep_item(KArgs a, int l, int tile, LAS unsigned char* lds) {
    const int tid = tid_fresh(), lane = tid & 63, wave = tid >> 6;
    unsigned char* ws = a->ws;
    const bf16* P = (const bf16*)(ws + WS_P); bf16* PC2 = (bf16*)(ws + WS_PC2); bf16* Y = (bf16*)(ws + WS_Y);
    LAS bf16* kl = (LAS bf16*)lds;
    LAS bf16* tw = (LAS bf16*)(lds + 64 * KLP * 2);
    LAS bf16* adl = tw + 64 * 72;
    LAS bf16* sg = adl + 64 * 72;
    LAS float* invn = (LAS float*)(sg + 64 * 136);
    const int row0 = tile * 64; const bool isl = row0 < NLAT;
    const float* mu = a->in[I_MU] + (size_t)l * CCOLS; const float* kkw = a->in[I_KK] + (size_t)l * CW;
    for (int g = tid; g < 64 * 320; g += NTHREADS) {
        const int tk = g / 320, cg = g % 320, col = cg * 8, row = row0 + tk;
        const bf16* pp = P + (size_t)row * INC + OFF_C + col;
        float own[8], z[8];
        unpack8(*(const u32x4*)pp, own);
        float nl[8], nr[8];
        if (isl) {
            const int gr = (row >> 6) & 63;
            float lf[8], rt[8], upv[8], dn[8];
            if (tk > 0) unpack8(*(const u32x4*)(pp - INC), lf); else { for (int j = 0; j < 8; ++j) lf[j] = 0.f; }
            if (tk < 63) unpack8(*(const u32x4*)(pp + INC), rt); else { for (int j = 0; j < 8; ++j) rt[j] = 0.f; }
            if (gr > 0) unpack8(*(const u32x4*)(pp - (size_t)64 * INC), upv); else { for (int j = 0; j < 8; ++j) upv[j] = 0.f; }
            if (gr < 63) unpack8(*(const u32x4*)(pp + (size_t)64 * INC), dn); else { for (int j = 0; j < 8; ++j) dn[j] = 0.f; }
            nl[0] = lf[0]; nl[1] = rt[1]; nl[2] = upv[2]; nl[3] = dn[3]; nl[4] = lf[4]; nl[5] = rt[5]; nl[6] = upv[6]; nl[7] = dn[7];
        } else {
            const int tc = (row - NLAT) & 255;
            if (tc > 0) unpack8(*(const u32x4*)(pp - INC), nl); else { for (int j = 0; j < 8; ++j) nl[j] = 0.f; }
            if (tc < 255) unpack8(*(const u32x4*)(pp + INC), nr); else { for (int j = 0; j < 8; ++j) nr[j] = 0.f; }
            nl[1] = nr[1]; nl[3] = nr[3]; nl[5] = nr[5]; nl[7] = nr[7];
        }
        const f32x4 m0 = *(const f32x4*)(mu + col), m1 = *(const f32x4*)(mu + col + 4);
#pragma unroll
        for (int j = 0; j < 8; ++j) { const float mm = j < 4 ? m0[j] : m1[j - 4]; z[j] = own[j] + mm * (nl[j] - own[j]); }
        if (col < 768) { *(u32x4*)(PC2 + (size_t)row * PC2W + col) = pack8(z); }
        else if (col < 1536) { const int c = col - 768; *(LAS u32x4*)(kl + tk * KLP + c) = pack8(z);
            const f32x4 k0 = *(const f32x4*)(kkw + c), k1 = *(const f32x4*)(kkw + c + 4); float ss = 0.f;
#pragma unroll
            for (int j = 0; j < 8; ++j) { const float q = z[j] * (j < 4 ? k0[j] : k1[j - 4]); ss += q * q; }
            ss += __shfl_xor(ss, 1); ss += __shfl_xor(ss, 2); ss += __shfl_xor(ss, 4);
            if ((lane & 7) == 0) invn[tk * 12 + (c >> 6)] = 1.0f / fmaxf(sqrtf(ss), 1e-12f); }
        else if (col < 2304) { *(u32x4*)(PC2 + (size_t)row * PC2W + 2 * 768 + (col - 1536)) = pack8(z); }
        else if (col < 2368) { float t8[8];
#pragma unroll
            for (int j = 0; j < 8; ++j) t8[j] = tanhf(z[j]);
            *(LAS u32x4*)(tw + tk * 72 + (col - 2304)) = pack8(t8); }
        else if (col < 2432) { *(LAS u32x4*)(adl + tk * 72 + (col - 2368)) = pack8(z); }
        else { float t8[8];
#pragma unroll
            for (int j = 0; j < 8; ++j) t8[j] = sigmoidf_(z[j]);
            *(LAS u32x4*)(sg + tk * 136 + (col - 2432)) = pack8(t8); }
    }
    __syncthreads();
    const int fr = lane & 15, fq = lane >> 4;
    const bf16* wupT = (const bf16*)(ws + WS_SMALLW + SW_WUP) + (size_t)l * 2 * 768 * 64;
    const bf16* aupT = (const bf16*)(ws + WS_SMALLW + SW_AUP) + (size_t)l * 768 * 64;
    const bf16* gupT = (const bf16*)(ws + WS_SMALLW + SW_GUP) + (size_t)l * 768 * 128;
    const float* a0 = a->in[I_A0] + (size_t)l * CW; const float* kaw = a->in[I_KA] + (size_t)l * CW; const float* w0 = a->in[I_W0] + (size_t)l * 2 * CW;
#pragma unroll 1
    for (int mat = 0; mat < 4; ++mat) {
        const bf16* WT = mat == 0 ? aupT : (mat == 1 ? wupT : (mat == 2 ? wupT + 768 * 64 : gupT));
        const int KK = mat == 3 ? 128 : 64; const LAS bf16* act = mat == 0 ? adl : (mat == 3 ? sg : tw); const int apitch = mat == 3 ? 136 : 72;
#pragma unroll 1
        for (int th = 0; th < 2; ++th) {
        f32x4 acc[6][2];
#pragma unroll
        for (int nt = 0; nt < 6; ++nt)
#pragma unroll
            for (int tt = 0; tt < 2; ++tt) acc[nt][tt] = (f32x4){0.f, 0.f, 0.f, 0.f};
        for (int ks = 0; ks < KK / 32; ++ks) {
            bf16x8 bfr[2];
#pragma unroll
            for (int tt = 0; tt < 2; ++tt) bfr[tt] = *(const LAS bf16x8*)(act + (16 * (2 * th + tt) + fr) * apitch + ks * 32 + fq * 8);
#pragma unroll
            for (int nt = 0; nt < 6; ++nt) { const bf16x8 afr = *(const bf16x8*)(WT + (size_t)(96 * wave + 16 * nt + fr) * KK + ks * 32 + fq * 8);
#pragma unroll
                for (int tt = 0; tt < 2; ++tt) acc[nt][tt] = __builtin_amdgcn_mfma_f32_16x16x32_bf16(afr, bfr[tt], acc[nt][tt], 0, 0, 0); }
        }
#pragma unroll
        for (int nt = 0; nt < 6; ++nt) { const int n = 96 * wave + 16 * nt + 4 * fq;
#pragma unroll
            for (int tt = 0; tt < 2; ++tt) { const int tk = 16 * (2 * th + tt) + fr, row = row0 + tk; const f32x4 v = acc[nt][tt];
                if (mat == 0) {
                    const f32x4 a0v = *(const f32x4*)(a0 + n), kav = *(const f32x4*)(kaw + n), kkv = *(const f32x4*)(kkw + n);
                    const u32x2 kp = *(const LAS u32x2*)(kl + tk * KLP + n); const float kf[4] = {bflo(kp.x), bfhi(kp.x), bflo(kp.y), bfhi(kp.y)};
                    const float inn = invn[tk * 12 + (n >> 6)];
                    float k2[4], kk[4], bb[4];
#pragma unroll
                    for (int j = 0; j < 4; ++j) { const float av = sigmoidf_(a0v[j] + v[j]); kk[j] = kf[j] * kkv[j] * inn; k2[j] = kf[j] * (1.0f + (av - 1.0f) * kav[j]); bb[j] = kk[j] * av; }
                    bf16* o = PC2 + (size_t)row * PC2W + n;
                    u32x2 q; q.x = pk2(k2[0], k2[1]); q.y = pk2(k2[2], k2[3]); *(u32x2*)(o + 1 * 768) = q;
                    q.x = pk2(kk[0], kk[1]); q.y = pk2(kk[2], kk[3]); *(u32x2*)(o + 3 * 768) = q;
                    q.x = pk2(bb[0], bb[1]); q.y = pk2(bb[2], bb[3]); *(u32x2*)(o + 4 * 768) = q;
                } else if (mat <= 2) {
                    const f32x4 w0v = *(const f32x4*)(w0 + (mat - 1) * CW + n); float d[4];
#pragma unroll
                    for (int j = 0; j < 4; ++j) d[j] = __expf(-DECAY_SCALE * sigmoidf_(w0v[j] + v[j]));
                    u32x2 q; q.x = pk2(d[0], d[1]); q.y = pk2(d[2], d[3]); *(u32x2*)(PC2 + (size_t)row * PC2W + (4 + mat) * 768 + n) = q;
                } else {
                    u32x2 q; q.x = pk2(v[0], v[1]); q.y = pk2(v[2], v[3]); *(u32x2*)(Y + (size_t)row * D + 1280 + n) = q;
                }
            } }
        }
    }
    __syncthreads();
}

__device__ __forceinline__ float dpp_xor1(float x) { return __builtin_bit_cast(float, __builtin_amdgcn_update_dpp(0, __builtin_bit_cast(int, x), 0xB1, 0xF, 0xF, false)); }
__device__ __forceinline__ float dpp_xor2(float x) { return __builtin_bit_cast(float, __builtin_amdgcn_update_dpp(0, __builtin_bit_cast(int, x), 0x4E, 0xF, 0xF, false)); }
__device__ __forceinline__ int chain_row(int dir, int b, int s) {
    if (s < CTXL) return NLAT + b * CTXL + (dir ? (CTXL - 1 - s) : s);
    const int t = s - CTXL; return b * T + (dir ? (T - 1 - t) : t);
}
__device__ __forceinline__ void rwkv_chain_pair(KArgs a, int pair, LAS unsigned char* lds) {
    const int tid = tid_fresh(), half = tid >> 8, ht = tid & 255;
    unsigned char* ws = a->ws;
    const bf16* PC2 = (const bf16*)(ws + WS_PC2); bf16* OC = (bf16*)(ws + WS_OC);
    const int cid = pair * 2 + half, dir = cid / 96, b = (cid % 96) / 12, h = cid % 12;
    LAS float* tile = (LAS float*)(lds + half * 32768);
    LAS float* ot = (LAS float*)(lds + 65536 + half * 4096);
    const int v = ht >> 2, q = ht & 3;
    float S[16];
#pragma unroll
    for (int j = 0; j < 16; ++j) S[j] = 0.f;
    for (int s0 = 0; s0 < CTXL + T; s0 += 16) {
#pragma unroll
        for (int j = 0; j < 3; ++j) { const int p = ht + 256 * j, st = p / 48, rem = p % 48, sm = rem >> 3, part = rem & 7;
            const int row = chain_row(dir, b, s0 + st); const int scol = (sm < 5 ? sm : 5 + dir) * 768 + h * 64 + part * 8;
            float f[8]; unpack8(*(const u32x4*)(PC2 + (size_t)row * PC2W + scol), f);
            LAS float* d = tile + (st * 6 + sm) * 64 + part * 8; *(LAS f32x4*)d = (f32x4){f[0], f[1], f[2], f[3]}; *(LAS f32x4*)(d + 4) = (f32x4){f[4], f[5], f[6], f[7]}; }
        __syncthreads();
#pragma unroll 2
        for (int st = 0; st < 16; ++st) {
            const LAS float* tp = tile + st * 6 * 64 + q * 16;
            float r[16], k2[16], kk[16], bb[16], w[16];
#pragma unroll
            for (int j = 0; j < 4; ++j) { const f32x4 x0 = *(const LAS f32x4*)(tp + 0 * 64 + 4 * j), x1 = *(const LAS f32x4*)(tp + 1 * 64 + 4 * j), x3 = *(const LAS f32x4*)(tp + 3 * 64 + 4 * j), x4 = *(const LAS f32x4*)(tp + 4 * 64 + 4 * j), x5 = *(const LAS f32x4*)(tp + 5 * 64 + 4 * j);
#pragma unroll
                for (int i = 0; i < 4; ++i) { r[4 * j + i] = x0[i]; k2[4 * j + i] = x1[i]; kk[4 * j + i] = x3[i]; bb[4 * j + i] = x4[i]; w[4 * j + i] = x5[i]; } }
            const float vv = tile[(st * 6 + 2) * 64 + v];
            float sa0 = 0.f, sa1 = 0.f, sa2 = 0.f, sa3 = 0.f;
#pragma unroll
            for (int j = 0; j < 4; ++j) { sa0 += S[4 * j] * kk[4 * j]; sa1 += S[4 * j + 1] * kk[4 * j + 1]; sa2 += S[4 * j + 2] * kk[4 * j + 2]; sa3 += S[4 * j + 3] * kk[4 * j + 3]; }
            float sa = (sa0 + sa1) + (sa2 + sa3); sa += dpp_xor1(sa); sa += dpp_xor2(sa);
            float o0 = 0.f, o1 = 0.f, o2 = 0.f, o3 = 0.f;
#pragma unroll
            for (int j = 0; j < 16; ++j) { S[j] = S[j] * w[j] + (vv * k2[j] - sa * bb[j]); }
#pragma unroll
            for (int j = 0; j < 4; ++j) { o0 += S[4 * j] * r[4 * j]; o1 += S[4 * j + 1] * r[4 * j + 1]; o2 += S[4 * j + 2] * r[4 * j + 2]; o3 += S[4 * j + 3] * r[4 * j + 3]; }
            float o = (o0 + o1) + (o2 + o3); o += dpp_xor1(o); o += dpp_xor2(o);
            if (q == 0) ot[st * 64 + v] = o;
        }
        __syncthreads();
        if (ht < 128) { const int st = ht >> 3, part = ht & 7; const int row = chain_row(dir, b, s0 + st); const LAS float* op = ot + st * 64 + part * 8;
            float f[8];
#pragma unroll
            for (int j = 0; j < 8; ++j) f[j] = op[j];
            *(u32x4*)(OC + ((size_t)dir * MALL + row) * CW + h * 64 + part * 8) = pack8(f); }
    }
    __syncthreads();
}
__device__ __forceinline__ void hgrn_chain(KArgs a, int l, int cid, LAS unsigned char* lds) {
    const int tid = tid_fresh();
    unsigned char* ws = a->ws;
    const bf16* P = (const bf16*)(ws + WS_P); bf16* OB = (bf16*)(ws + WS_OB);
    const int dir = cid / 48, b = (cid % 48) / 6, h = cid % 6;
    LAS float* tq = (LAS float*)lds;
    LAS float* tk = tq + 16 * 128;
    LAS float* tf = tk + 16 * 128;
    LAS float* tv = tf + 16 * 128;
    LAS float* ot = tv + 16 * 128;
    const int v = tid >> 2, q = tid & 3;
    float S[32];
#pragma unroll
    for (int j = 0; j < 32; ++j) S[j] = 0.f;
    const int sst = tid >> 5, sc4 = (tid & 31) * 4;
    float lb[4];
#pragma unroll
    for (int j = 0; j < 4; ++j) { const int ch = h * 128 + sc4 + j;
        if (l == 0) lb[j] = 0.f; else { const float l0 = a->in[I_LB][((size_t)dir * DEPTH + 0) * BW + ch], l1 = a->in[I_LB][((size_t)dir * DEPTH + 1) * BW + ch]; lb[j] = 1.0f / (1.0f + __expf(l0 - l1)); } }
    for (int s0 = 0; s0 < CTXL + T; s0 += 16) {
        { const int row = chain_row(dir, b, s0 + sst); const bf16* pr = P + (size_t)row * INC + h * 128 + sc4;
          const u32x2 pq = *(const u32x2*)(pr + OFF_Q), pi = *(const u32x2*)(pr + OFF_I), pz = *(const u32x2*)(pr + (dir ? OFF_ZB : OFF_ZF));
          const float qf[4] = {bflo(pq.x), bfhi(pq.x), bflo(pq.y), bfhi(pq.y)}, vf[4] = {bflo(pi.x), bfhi(pi.x), bflo(pi.y), bfhi(pi.y)}, zf[4] = {bflo(pz.x), bfhi(pz.x), bflo(pz.y), bfhi(pz.y)};
          f32x4 oq, ok, of, ov;
#pragma unroll
          for (int j = 0; j < 4; ++j) { const float f = lb[j] + (1.0f - lb[j]) * sigmoidf_(zf[j]); oq[j] = siluf_(qf[j]); of[j] = f; ok[j] = 1.0f - f; ov[j] = vf[j]; }
          *(LAS f32x4*)(tq + sst * 128 + sc4) = oq; *(LAS f32x4*)(tk + sst * 128 + sc4) = ok; *(LAS f32x4*)(tf + sst * 128 + sc4) = of; *(LAS f32x4*)(tv + sst * 128 + sc4) = ov; }
        __syncthreads();
        for (int st = 0; st < 16; ++st) {
            const float vv = tv[st * 128 + v]; float o0 = 0.f, o1 = 0.f;
#pragma unroll
            for (int j = 0; j < 8; ++j) { const f32x4 fq4 = *(const LAS f32x4*)(tf + st * 128 + q * 32 + 4 * j), kq4 = *(const LAS f32x4*)(tk + st * 128 + q * 32 + 4 * j), qq4 = *(const LAS f32x4*)(tq + st * 128 + q * 32 + 4 * j);
#pragma unroll
                for (int i = 0; i < 4; ++i) { const float sn = fq4[i] * S[4 * j + i] + kq4[i] * vv; S[4 * j + i] = sn; if (i & 1) o1 += qq4[i] * sn; else o0 += qq4[i] * sn; } }
            float o = o0 + o1; o += dpp_xor1(o); o += dpp_xor2(o);
            if (q == 0) ot[st * 128 + v] = o;
        }
        __syncthreads();
        if (tid < 256) { const int st = tid >> 4, part = tid & 15; const int row = chain_row(dir, b, s0 + st); const LAS float* op = ot + st * 128 + part * 8;
            float f[8];
#pragma unroll
            for (int j = 0; j < 8; ++j) f[j] = op[j];
            *(u32x4*)(OB + ((size_t)dir * MALL + row) * BW + h * 128 + part * 8) = pack8(f); }
    }
    __syncthreads();
}

__device__ __forceinline__ void phase_finalize(KArgs a, int l) {
    const int tid_ = tid_fresh(); const int lane = tid_ & 63, wave = tid_ >> 6, gw = blockIdx.x * 8 + wave, NGW = gridDim.x * 8;
    unsigned char* ws = a->ws;
    const bf16* P = (const bf16*)(ws + WS_P); const bf16* PC2 = (const bf16*)(ws + WS_PC2); const bf16* OB = (const bf16*)(ws + WS_OB); const bf16* OC = (const bf16*)(ws + WS_OC); bf16* Y = (bf16*)(ws + WS_Y);
    const int nrows = (l == DEPTH - 1) ? NLAT : MALL;
    const float* hng = a->in[I_HNG] + (size_t)l * BW; const float* rk = a->in[I_RK] + (size_t)l * CW; const float* gng = a->in[I_GNGG] + (size_t)l * CW; const float* gnb = a->in[I_GNB] + (size_t)l * CW;
    for (int row = gw; row < nrows; row += NGW) {
#pragma unroll
        for (int h = 0; h < 6; ++h) { const int c = h * 128 + 2 * lane;
            const unsigned pf = *(const unsigned*)(OB + (size_t)row * BW + c), pb = *(const unsigned*)(OB + ((size_t)MALL + row) * BW + c), pg = *(const unsigned*)(P + (size_t)row * INC + OFF_OG + c);
            const float o0 = bflo(pf) + bflo(pb), o1 = bfhi(pf) + bfhi(pb);
            const float ss = wave_sum(o0 * o0 + o1 * o1); const float rstd = 1.0f / sqrtf(ss * (1.0f / 128.0f) + NORM_EPS);
            const float y0 = o0 * rstd * hng[c] * sigmoidf_(bflo(pg)), y1 = o1 * rstd * hng[c + 1] * sigmoidf_(bfhi(pg));
            *(unsigned*)(Y + (size_t)row * D + 512 + c) = pk2(y0, y1); }
#pragma unroll
        for (int h = 0; h < 12; ++h) { const int c = h * 64 + lane;
            const float o = bf1(OC[(size_t)row * CW + c]) + bf1(OC[((size_t)MALL + row) * CW + c]);
            const bf16* pr = PC2 + (size_t)row * PC2W + c; const float r = bf1(pr[0]), k2 = bf1(pr[768]), vv = bf1(pr[2 * 768]);
            const float mean = wave_sum(o) * (1.0f / 64.0f); const float dlt = o - mean; const float var = wave_sum(dlt * dlt) * (1.0f / 64.0f);
            const float ln = dlt / sqrtf(var + GN_EPS) * gng[c] + gnb[c];
            const float bonus = wave_sum(r * k2 * rk[c]) * vv;
            const float g = bf1(Y[(size_t)row * D + 1280 + c]);
            Y[(size_t)row * D + 1280 + c] = (bf16)f2bf((ln + bonus) * g); }
    }
}

__global__ void __launch_bounds__(NTHREADS, 2) mk_fwd(Args args_unused) {
    extern __shared__ __attribute__((aligned(16))) unsigned char lds_raw[];
    LAS unsigned char* lds = (LAS unsigned char*)lds_raw;
    volatile LAS unsigned* misc = (volatile LAS unsigned*)(lds + LDS_MISC);
    const int tid = threadIdx.x, G = gridDim.x;
    if (tid < 64) misc[tid] = 0u;
    __syncthreads();
    XcdBarrier bar; bar.bar = nullptr; bar.x = 0; bar.st = nullptr;
    int lo, hi;
    { KArgs a = kargs(); lo = a->ph_lo; hi = a->ph_hi; unsigned* ctl = (unsigned*)(a->ws + WS_CTL); bar.bar = ctl + CW_BAR; if (!MK_MULTI) bar = xcd_barrier_post(ctl + CW_BAR, misc + 8); }
    const int cvirt = (G % 8 == 0) ? ((int)blockIdx.x % 8) * (G / 8) + (int)blockIdx.x / 8 : (int)blockIdx.x;
#define IN(k) (lo <= (k) && (k) < hi)
#define PM(b) ((PHMASK >> (b)) & 1)
#define SEAM(k) do { if (!MK_MULTI && IN(k) && IN((k) + 1)) xcd_barrier(bar); } while (0)

    if (PM(0) && IN(0)) { phase_prologue(kargs(), lds); } SEAM(0);

#pragma unroll 1
    for (int l = 0; l < DEPTH; ++l) {
        const int pb = 1 + 9 * l;
        const bool lastl = (l == DEPTH - 1);
        if (PM(1) && IN(pb + 0)) { if (l == 0) phase_norm1<0>(kargs(), l); else phase_norm1<1>(kargs(), l); } SEAM(pb + 0);
        if (PM(2) && IN(pb + 1)) {
            KArgs a = kargs(); unsigned char* ws = a->ws;
            pg8::Gemm g{(const bf16*)(ws + WS_H), (const bf16*)(ws + WS_WIN) + (size_t)l * INC * D, MALL, INC, D};
            pg8::StaticOrder S; S.init(MALL, INC, G, (int)blockIdx.x);
            pg8::EpiBf16 E{(bf16*)(ws + WS_P), INC};
            pg8::gemm_phase<pg8::EpiBf16, pg8::StaticOrder, true, false>(lds, g, S, E, nullptr);
        } SEAM(pb + 1);
        if (PM(3) && IN(pb + 2)) {
            const int ngm = lastl ? 1024 : 1088;
            for (int it = blockIdx.x; it < ngm + 544; it += G) { if (it < ngm) gmlp_item(kargs(), l, it, lds); else rwkv_prep_item(kargs(), l, it - ngm, lds); }
        } SEAM(pb + 2);
        if (PM(4) && IN(pb + 3)) {
            for (int it = blockIdx.x; it < 192; it += G) { if (it < 96) rwkv_chain_pair(kargs(), it, lds); else hgrn_chain(kargs(), l, it - 96, lds); }
        } SEAM(pb + 3);
        if (PM(5) && IN(pb + 4)) { phase_finalize(kargs(), l); } SEAM(pb + 4);
        if (PM(6) && IN(pb + 5)) {
            KArgs a = kargs(); unsigned char* ws = a->ws;
            const int Mo = lastl ? NLAT : MALL;
            pg8::Gemm g{(const bf16*)(ws + WS_Y), (const bf16*)(ws + WS_WOUT) + (size_t)l * D * D, Mo, D, D};
            pg8::StaticOrder S; S.init(Mo, D, G, (int)blockIdx.x);
            const float* xl = l == 0 ? a->in[I_X] : (const float*)(ws + WS_X); const float* xc = l == 0 ? a->in[I_CTX] : (const float*)(ws + WS_X) + (size_t)NLAT * D;
            pg8::EpiResid E{xl, xc, (float*)(ws + WS_X), (const float*)(ws + WS_MOD) + (size_t)l * 9 * 12288 + 2 * D};
            pg8::gemm_phase<pg8::EpiResid, pg8::StaticOrder, true, false>(lds, g, S, E, nullptr);
        } SEAM(pb + 5);
        if (PM(7) && IN(pb + 6)) { phase_norm2_router(kargs(), l); } SEAM(pb + 6);
        if (PM(8) && IN(pb + 7)) {
            KArgs a = kargs(); unsigned char* ws = a->ws;
            moe_tables<false>(a, l, lds, cvirt);
            pg8::Gemm g{(const bf16*)(ws + WS_H), (const bf16*)(ws + WS_WGU) + (size_t)l * NE * 2048 * D, 0, 2048, D};
            pg8::MoeOrder S{(const LAS int*)(lds + LDS_TP), G, cvirt, (unsigned)(2048 * D * 2)};
            pg8::EpiSwiglu E{(bf16*)(ws + WS_ACT)};
            pg8::gemm_phase<pg8::EpiSwiglu, pg8::MoeOrder, false, true>(lds, g, S, E, (const LAS unsigned*)(lds + LDS_TAB));
        } SEAM(pb + 7);
        if (PM(9) && IN(pb + 8)) {
            KArgs a = kargs(); unsigned char* ws = a->ws;
            moe_tables<true>(a, l, lds, cvirt);
            pg8::Gemm g{(const bf16*)(ws + WS_ACT), (const bf16*)(ws + WS_WDN) + (size_t)l * NE * D * DE, 0, D, DE};
            pg8::MoeOrder S{(const LAS int*)(lds + LDS_TP), G, cvirt, (unsigned)(D * DE * 2)};
            pg8::EpiDown E{(bf16*)(ws + WS_YK), (const LAS unsigned*)(lds + LDS_TAB), (const LAS float*)(lds + LDS_TABW)};
            pg8::gemm_phase<pg8::EpiDown, pg8::MoeOrder, false, false>(lds, g, S, E, nullptr);
        } SEAM(pb + 8);
    }
    if (PM(10) && IN(1 + 9 * DEPTH)) { phase_norm1<2>(kargs(), DEPTH); }
#undef IN
#undef SEAM
}

extern "C" void kernel_launch(void* const* d_in, const int* in_sizes, int n_in, void* d_out, int out_size, void* d_ws, size_t ws_size, hipStream_t stream) {
    static int grid = 0;
    if (grid == 0) {
        if (n_in != 31 || ws_size < WS_END) { fprintf(stderr, "kernel_launch: unexpected n_in %d / ws %zu (need %zu)\n", n_in, ws_size, (size_t)WS_END); grid = -1; return; }
        int dev = 0, cus = 0, per_cu = 0;
        hipGetDevice(&dev); hipDeviceGetAttribute(&cus, hipDeviceAttributeMultiprocessorCount, dev);
        if (hipFuncSetAttribute((const void*)mk_fwd, hipFuncAttributeMaxDynamicSharedMemorySize, LDS_BYTES) != hipSuccess) { fprintf(stderr, "kernel_launch: hipFuncSetAttribute failed\n"); grid = -1; return; }
        if (hipOccupancyMaxActiveBlocksPerMultiprocessor(&per_cu, (const void*)mk_fwd, NTHREADS, LDS_BYTES) != hipSuccess || per_cu < 1) fprintf(stderr, "kernel_launch: occupancy query says %d\n", per_cu);
        (void)hipGetLastError();
        grid = cus > 0 ? cus : 256;
    }
    if (grid < 0) return;
    hipMemsetAsync((char*)d_ws + WS_CTL, 0, CTL_ZERO_BYTES, stream);
    Args a{};
    for (int i = 0; i < 31; ++i) a.in[i] = (const float*)d_in[i];
    a.out = (float*)d_out; a.ws = (unsigned char*)d_ws;
    constexpr int NPH = 2 + 9 * DEPTH;
#if MK_MULTI
    for (int p = 0; p < NPH; ++p) { a.ph_lo = p; a.ph_hi = p + 1; hipLaunchKernelGGL(mk_fwd, dim3(grid), dim3(NTHREADS), LDS_BYTES, stream, a); }
#else
    a.ph_lo = 0; a.ph_hi = NPH; hipLaunchKernelGGL(mk_fwd, dim3(grid), dim3(NTHREADS), LDS_BYTES, stream, a);
#endif
}
```

```cpp
#include <hip/hip_runtime.h>
#include <cstdio>
#include <cstdint>

#ifndef PHMASK
#define PHMASK 0xFFFF
#endif
#ifndef PROBE_DUP
#define PROBE_DUP 0
#endif
#ifndef MK_MULTI
#define MK_MULTI 0
#endif

#define GAS __attribute__((address_space(1)))
#define LAS __attribute__((address_space(3)))
typedef unsigned short bf16;
typedef short bf16x8 __attribute__((ext_vector_type(8)));
typedef float f32x4 __attribute__((ext_vector_type(4)));
typedef float f32x2 __attribute__((ext_vector_type(2)));
typedef unsigned u32x4 __attribute__((ext_vector_type(4)));
typedef unsigned u32x2 __attribute__((ext_vector_type(2)));

constexpr int D = 2048, NB = 8, T = 4096, CTXL = 256, DEPTH = 2;
constexpr int NLAT = NB * T, NCTX = NB * CTXL, MALL = NLAT + NCTX;
constexpr int INC = 7424;
constexpr int OFF_U = 0, OFF_V = 512, OFF_Q = 1024, OFF_I = 1792, OFF_ZF = 2560, OFF_ZB = 3328, OFF_OG = 4096;
constexpr int OFF_C = 4864;
constexpr int BW = 768, CW = 768, CCOLS = 2560;
constexpr int NE = 16, DE = 1024;
constexpr int PC2W = 7 * 768;
constexpr int NTHREADS = 512;
constexpr float NORM_EPS = 1e-6f, GN_EPS = 64e-5f, DECAY_SCALE = 0.60653065971263342f;

constexpr size_t MiB = 1u << 20;
constexpr size_t WS_CTL = 0, CTL_ZERO_BYTES = 1 * MiB;
constexpr size_t WS_MOD = 1 * MiB;
constexpr size_t WS_SMALLW = 2 * MiB;
constexpr size_t SW_WUP = 0, SW_AUP = SW_WUP + (size_t)2 * 2 * 768 * 64 * 2, SW_GUP = SW_AUP + (size_t)2 * 768 * 64 * 2, SW_GWS = SW_GUP + (size_t)2 * 768 * 128 * 2;
constexpr size_t WS_WIN = 4 * MiB, WS_WOUT = 62 * MiB, WS_WGU = 78 * MiB, WS_WDN = 334 * MiB;
constexpr size_t WS_X = 462 * MiB, WS_H = 734 * MiB, WS_Y = 870 * MiB, WS_P = 1006 * MiB, WS_PC2 = 1499 * MiB, WS_OC = 1856 * MiB, WS_END = 1958 * MiB;
constexpr size_t WS_OB = WS_H;
constexpr size_t WS_ACT = WS_P, WS_YK = WS_P + 144 * MiB, WS_RIDX = WS_P + 416 * MiB, WS_RW = WS_RIDX + 3 * MiB;
static_assert(WS_RW + 3 * MiB <= WS_PC2, "moe overlay");
constexpr int MAXSLOT_TILES = 288;
constexpr int CW_BAR = 4096;
constexpr int CW_CNT = 16384;

constexpr int LDS_STAGE = 0, LDS_TAB = 131072, LDS_TABW = LDS_TAB + 9 * 1024, LDS_TP = LDS_TABW + 9 * 1024, LDS_MISC = 150528, LDS_BYTES = 152 * 1024;
static_assert(LDS_TP + 128 <= LDS_MISC, "lds map");

__device__ __forceinline__ unsigned f2bf(float f) { unsigned u = __builtin_bit_cast(unsigned, f); return (u + 0x7fffu + ((u >> 16) & 1u)) >> 16; }
__device__ __forceinline__ unsigned pk2(float lo, float hi) { return f2bf(lo) | (f2bf(hi) << 16); }
__device__ __forceinline__ float bflo(unsigned u) { return __builtin_bit_cast(float, u << 16); }
__device__ __forceinline__ float bfhi(unsigned u) { return __builtin_bit_cast(float, u & 0xffff0000u); }
__device__ __forceinline__ float bf1(bf16 b) { return __builtin_bit_cast(float, ((unsigned)b) << 16); }
__device__ __forceinline__ float sigmoidf_(float x) { return __builtin_amdgcn_rcpf(1.0f + __expf(-x)); }
__device__ __forceinline__ float siluf_(float x) { return x * __builtin_amdgcn_rcpf(1.0f + __expf(-x)); }
__device__ __forceinline__ float geluf_(float v) {
    const float av = fabsf(v), t = __builtin_amdgcn_rcpf(av * 0.2316418882f + 1.0f);
    float q = t * 0.5307027145f + (-0.7265760135f); q = q * t + 0.7107068705f; q = q * t + (-0.142248368f); q = q * t + 0.127414796f; q = q * t;
    const float e = __builtin_amdgcn_exp2f((v * v) * (-0.72134752044f)); const float m = v * (q * e); return v < 0.f ? m : v - m; }
__device__ __forceinline__ float wave_sum(float v) {
#pragma unroll
    for (int o = 1; o < 64; o <<= 1) v += __shfl_xor(v, o);
    return v;
}
__device__ __forceinline__ int tid_fresh() { int t = threadIdx.x; asm volatile("" : "+v"(t)); return t; }
__device__ __forceinline__ void unpack8(const u32x4 v, float (&f)[8]) {
    f[0] = bflo(v.x); f[1] = bfhi(v.x); f[2] = bflo(v.y); f[3] = bfhi(v.y); f[4] = bflo(v.z); f[5] = bfhi(v.z); f[6] = bflo(v.w); f[7] = bfhi(v.w);
}
__device__ __forceinline__ u32x4 pack8(const float (&f)[8]) { u32x4 v; v.x = pk2(f[0], f[1]); v.y = pk2(f[2], f[3]); v.z = pk2(f[4], f[5]); v.w = pk2(f[6], f[7]); return v; }
__device__ __forceinline__ int modrow_of(int row) { return row < NLAT ? (row >> 12) : 8; }

#define XB_TMO      128
#define XB_XCNT(j)  (256  + 64 * (j))
#define XB_XSUB(j)  (1280 + 64 * (j))
#define XB_XGEN(j)  (2304 + 64 * (j))
#define XB_TOP      3328
#define XB_TOPGEN   3392
#define XCD_BAR_WORDS 3456
#define XB_SPIN_CAP (1u << 18)
__device__ __forceinline__ unsigned xb_ld(unsigned* p)              { return __hip_atomic_load(p, __ATOMIC_RELAXED, __HIP_MEMORY_SCOPE_AGENT); }
__device__ __forceinline__ unsigned xb_add(unsigned* p, unsigned v) { return __hip_atomic_fetch_add(p, v, __ATOMIC_RELAXED, __HIP_MEMORY_SCOPE_AGENT); }
__device__ __forceinline__ unsigned xb_xcc_id() { return (unsigned)__builtin_amdgcn_s_getreg((3 << 11) | 20) & 0xFu; }
#define XB_SPIN(cond, bar) do { unsigned _sp = 0; while (cond) { __builtin_amdgcn_s_sleep(1); \
    if ((++_sp & 255u) == 0u) { if (xb_ld(&(bar)[XB_TMO])) break; if (_sp > XB_SPIN_CAP) { atomicAdd(&(bar)[XB_TMO], 1u); break; } } } } while (0)
struct XcdBarrier { unsigned* bar; unsigned x; volatile LAS unsigned* st; };
__device__ __forceinline__ XcdBarrier xcd_barrier_post(unsigned* bar, volatile LAS unsigned* st) {
    XcdBarrier b; b.bar = bar; b.x = xb_xcc_id(); b.st = st;
    if (threadIdx.x == 0) (void)xb_add(&bar[XB_XCNT(b.x)], 1u);
    return b;
}
__device__ __forceinline__ void xcd_barrier_complete(unsigned* bar, unsigned x, unsigned& nloc, unsigned& nx) {
    const unsigned G = gridDim.x * gridDim.y * gridDim.z;
    unsigned sum, cnt, mine, sp = 0u;
    for (;;) {
        sum = 0u; cnt = 0u; mine = 0u;
#pragma unroll
        for (unsigned j = 0; j < 16; ++j) { const unsigned c = xb_ld(&bar[XB_XCNT(j)]); sum += c; cnt += (c > 0u) ? 1u : 0u; mine = (j == x) ? c : mine; }
        if (sum == G) break;
        __builtin_amdgcn_s_sleep(1);
        if ((++sp & 255u) == 0u) { if (xb_ld(&bar[XB_TMO])) break; if (sp > XB_SPIN_CAP) { atomicAdd(&bar[XB_TMO], 1u); break; } }
    }
    nloc = mine > 0u ? mine : 1u; nx = cnt > 0u ? cnt : 1u;
}
__device__ __forceinline__ void xcd_barrier(const XcdBarrier& b) {
    asm volatile("s_waitcnt vmcnt(0)" ::: "memory");
    __syncthreads();
    if (threadIdx.x == 0) {
        unsigned* bar = b.bar;
        __builtin_amdgcn_s_waitcnt(0);
        unsigned nloc = b.st[0], nx = b.st[1];
        if (nloc == 0u) { xcd_barrier_complete(bar, b.x, nloc, nx); b.st[0] = nloc; b.st[1] = nx; }
        const unsigned old = xb_add(&bar[XB_XSUB(b.x)], 1u);
        const unsigned gen = old / nloc;
        if (old + 1u == (gen + 1u) * nloc) {
            __builtin_amdgcn_fence(__ATOMIC_RELEASE, "agent");
            asm volatile("s_waitcnt vmcnt(0)" ::: "memory");
            const unsigned og = xb_add(&bar[XB_TOP], 1u);
            const unsigned tg = og / nx;
            if (og + 1u == (tg + 1u) * nx) xb_add(&bar[XB_TOPGEN], 1u);
            else XB_SPIN(xb_ld(&bar[XB_TOPGEN]) == tg, bar);
            __builtin_amdgcn_fence(__ATOMIC_ACQUIRE, "agent");
            xb_add(&bar[XB_XGEN(b.x)], 1u);
            asm volatile("s_waitcnt vmcnt(0)" ::: "memory");
        } else {
            XB_SPIN(xb_ld(&bar[XB_XGEN(b.x)]) == gen, bar);
            __builtin_amdgcn_fence(__ATOMIC_ACQUIRE, "agent");
            asm volatile("s_waitcnt vmcnt(0)" ::: "memory");
        }
    }
    __syncthreads();
}

namespace pg8 {
constexpr int BM = 256, BK = 64, HALF = 128, HTB = HALF * BK * 2, STAGE_BYTES = 8 * HTB, NXCD = 8, WGM = 8;
__host__ __device__ __forceinline__ int lds_byte(int r, int c) { const int st = (r >> 4) * 2 + (c >> 5), rr = r & 15, cc = c & 31, ob = rr * 64 + cc * 2; return st * 1024 + (ob ^ (((ob >> 9) & 1) << 5)); }
__host__ __device__ __forceinline__ void stage_rc(int b, int& R, int& C) { const int st = b / 1024, sb = b % 1024, swz = sb ^ (((sb >> 9) & 1) << 5); R = (st >> 1) * 16 + swz / 64; C = (st & 1) * 32 + (swz % 64) / 2; }
__host__ __device__ __forceinline__ int perm32(int rho) { const int n = rho >> 4, i = rho & 15; return 8 * (i >> 2) + 4 * n + (i & 3); }

struct Unit { int pm, pn, e, aux; };
struct Gemm { const bf16* A; const bf16* Bt; int M, N, K; };

struct StaticOrder {
    int nM, nN, nwg, G, c;
    __device__ void init(int M, int N, int G_, int c_) { nM = M / BM; nN = N / BM; nwg = nM * nN; G = G_; c = c_; }
    __device__ bool next(int i, Unit& u) const {
        const long L = (long)i * G + c; if (L >= nwg) return false;
        int wgid = (int)L; { const int q = nwg / NXCD, r = nwg % NXCD, xcd = wgid % NXCD, off = wgid / NXCD; wgid = (xcd < r ? xcd * (q + 1) : r * (q + 1) + (xcd - r) * q) + off; }
        const int nig = WGM * nN, gid = wgid / nig, fm = gid * WGM, gsz = (nM - fm) < WGM ? (nM - fm) : WGM;
        u.pm = fm + ((wgid % nig) % gsz); u.pn = (wgid % nig) / gsz; u.e = 0; u.aux = 0; return true;
    }
    __device__ __forceinline__ unsigned b_off(const Unit& u, unsigned tstep) const { return (unsigned)u.pn * tstep; }
};
struct MoeOrder {
    const LAS int* tp; int G, c; unsigned estride;
    __device__ bool next(int i, Unit& u) const {
        const int L = i * G + c; const int ntot = tp[16] * 8; if (L >= ntot) return false;
        const int tile = L >> 3; int e = 0;
#pragma unroll
        for (int j = 1; j < 16; ++j) e += (tile >= tp[j]) ? 1 : 0;
        u.pm = tile; u.pn = L & 7; u.e = e; u.aux = i; return true;
    }
    __device__ __forceinline__ unsigned b_off(const Unit& u, unsigned tstep) const { return (unsigned)u.e * estride + (unsigned)u.pn * tstep; }
};

#define PG8_LAS __attribute__((address_space(3)))
template <class Epi, class Sched, bool ALIGN_EPI, bool GATHER>
__device__ __forceinline__ void gemm_phase(PG8_LAS unsigned char* lds, const Gemm g, const Sched& S, const Epi& E, const PG8_LAS unsigned* tabA) {
    const int tid = tid_fresh(), wid = __builtin_amdgcn_readfirstlane(tid >> 6), lane = tid & 63, wr = wid >> 2, wc = wid & 3, fr = lane & 15, fq = lane >> 4;
    const int K = g.K, nt = K / BK;
    int sR[2], sC[2];
    unsigned voffB[2];
#pragma unroll
    for (int i = 0; i < 2; ++i) { int R, C; stage_rc(tid * 16 + i * 8192, R, C); sR[i] = R; sC[i] = C; const int Rb = Epi::PERM ? ((R & ~31) + perm32(R & 31)) : R;
        voffB[i] = (unsigned)(Rb * K + C) * 2u; }
    const unsigned kstep = (unsigned)(BK * 2);
    const unsigned hstep = (unsigned)(HALF * K * 2);
    const unsigned tstep = 2u * hstep;
    const unsigned ldsw = (unsigned)wid * 1024u;
    const char* const baseA = (const char*)g.A; const char* const baseB = (const char*)g.Bt;
    const int aoff = lds_byte(wr * 64 + fr, fq * 8), boff = lds_byte(wc * 32 + fr, fq * 8);
#define PG8_SA(b, h) (((b) * 2 + (h)) * HTB)
#define PG8_SB(b, h) ((4 + (b) * 2 + (h)) * HTB)
#define PG8_STAGE(bufoff, gbase, uoff, voff) do { _Pragma("unroll") for (int _i = 0; _i < 2; ++_i) \
        __builtin_amdgcn_global_load_lds((const unsigned*)((gbase) + (size_t)(unsigned)((uoff) + (voff)[_i])), (PG8_LAS unsigned*)(lds + (bufoff) + ldsw + _i * 8192), 16, 0, 0); } while (0)
#define PG8_LDA(dst, b, h) do { _Pragma("unroll") for (int m = 0; m < 4; ++m) _Pragma("unroll") for (int k = 0; k < 2; ++k) dst[m][k] = *(const PG8_LAS bf16x8*)(lds + PG8_SA(b, h) + aoff + m * 2048 + k * 1024); } while (0)
#define PG8_LDB(dst, b, h) do { _Pragma("unroll") for (int n = 0; n < 2; ++n) _Pragma("unroll") for (int k = 0; k < 2; ++k) dst[n][k] = *(const PG8_LAS bf16x8*)(lds + PG8_SB(b, h) + boff + n * 2048 + k * 1024); } while (0)
#define PG8_MMA(ai, bj, At, Bt) do { __builtin_amdgcn_s_setprio(1); _Pragma("unroll") for (int m = 0; m < 4; ++m) _Pragma("unroll") for (int n = 0; n < 2; ++n) _Pragma("unroll") for (int k = 0; k < 2; ++k) \
        acc[ai][bj][m][n] = __builtin_amdgcn_mfma_f32_16x16x32_bf16(Bt[n][k], At[m][k], acc[ai][bj][m][n], 0, 0, 0); __builtin_amdgcn_s_setprio(0); } while (0)
#define PG8_WAIT_V(n) asm volatile("s_waitcnt vmcnt(" #n ")" ::: "memory")
#define PG8_WAIT_L(n) asm volatile("s_waitcnt lgkmcnt(" #n ")" ::: "memory")
#define PG8_BAR __builtin_amdgcn_s_barrier()
#define PG8_SCHED __builtin_amdgcn_sched_barrier(0)
    Unit cur, nxt; int ui = 0;
    if (!S.next(0, cur)) return;
    f32x4 acc[2][2][4][2];
#pragma unroll
    for (int a = 0; a < 2; ++a)
#pragma unroll
        for (int b = 0; b < 2; ++b)
#pragma unroll
            for (int m = 0; m < 4; ++m)
#pragma unroll
                for (int n = 0; n < 2; ++n) acc[a][b][m][n] = (f32x4){0.f, 0.f, 0.f, 0.f};
    bf16x8 At[4][2], B0[2][2], B1[2][2];
    unsigned vA0[2], vA1[2], nA0[2], nA1[2];
    unsigned uA, uB = S.b_off(cur, tstep);
    if constexpr (GATHER) { uA = 0u;
#pragma unroll
        for (int i = 0; i < 2; ++i) { vA0[i] = tabA[cur.aux * 256 + sR[i]] + (unsigned)sC[i] * 2u; vA1[i] = tabA[cur.aux * 256 + 128 + sR[i]] + (unsigned)sC[i] * 2u; }
    } else { uA = (unsigned)cur.pm * tstep;
#pragma unroll
        for (int i = 0; i < 2; ++i) { vA0[i] = (unsigned)(sR[i] * K + sC[i]) * 2u; vA1[i] = vA0[i] + hstep; }
    }
    PG8_STAGE(PG8_SB(0, 0), baseB, uB, voffB); PG8_STAGE(PG8_SB(0, 1), baseB, uB + hstep, voffB); PG8_STAGE(PG8_SA(0, 0), baseA, uA, vA0); PG8_STAGE(PG8_SA(0, 1), baseA, uA, vA1);
    if (wr == 1) PG8_BAR;
    PG8_WAIT_V(2); PG8_BAR;
    PG8_STAGE(PG8_SB(1, 0), baseB, uB + kstep, voffB); PG8_STAGE(PG8_SA(1, 0), baseA, uA + kstep, vA0); PG8_STAGE(PG8_SB(1, 1), baseB, uB + hstep + kstep, voffB);
    PG8_WAIT_V(6); PG8_BAR;
    for (;;) {
        const bool has_next = S.next(ui + 1, nxt);
        unsigned nuA, nuB = has_next ? S.b_off(nxt, tstep) : uB;
        if constexpr (GATHER) { nuA = 0u;
#pragma unroll
            for (int i = 0; i < 2; ++i) { if (has_next) { nA0[i] = tabA[nxt.aux * 256 + sR[i]] + (unsigned)sC[i] * 2u; nA1[i] = tabA[nxt.aux * 256 + 128 + sR[i]] + (unsigned)sC[i] * 2u; } else { nA0[i] = vA0[i]; nA1[i] = vA1[i]; } }
        } else { nuA = has_next ? (unsigned)nxt.pm * tstep : uA;
#pragma unroll
            for (int i = 0; i < 2; ++i) { nA0[i] = vA0[i]; nA1[i] = vA1[i]; }
        }
        for (int t = 0; t < nt; t += 2) {
            const bool last = (t == nt - 2);
            const unsigned a1 = uA + (unsigned)(t + 1) * kstep;
            const unsigned a2 = last ? nuA : uA + (unsigned)(t + 2) * kstep; const unsigned b2 = last ? nuB : uB + (unsigned)(t + 2) * kstep;
            const unsigned a3 = a2 + kstep; const unsigned b3 = b2 + kstep;
            unsigned w0[2], w1[2];
#pragma unroll
            for (int i = 0; i < 2; ++i) { w0[i] = (GATHER && last) ? nA0[i] : vA0[i]; w1[i] = (GATHER && last) ? nA1[i] : vA1[i]; }
            PG8_LDB(B0, 0, 0); PG8_LDB(B1, 0, 1); PG8_SCHED; PG8_LDA(At, 0, 0); PG8_STAGE(PG8_SA(1, 1), baseA, a1, vA1);
            PG8_WAIT_V(8); PG8_WAIT_L(0); PG8_BAR; PG8_MMA(0, 0, At, B0); PG8_MMA(0, 1, At, B1); PG8_BAR; PG8_SCHED;
            PG8_LDA(At, 0, 1); PG8_STAGE(PG8_SB(0, 0), baseB, b2, voffB); PG8_STAGE(PG8_SB(0, 1), baseB, b2 + hstep, voffB); PG8_STAGE(PG8_SA(0, 0), baseA, a2, w0);
            PG8_WAIT_V(8); PG8_WAIT_L(0); PG8_BAR; PG8_MMA(1, 0, At, B0); PG8_MMA(1, 1, At, B1); PG8_BAR; PG8_SCHED;
            PG8_LDB(B0, 1, 0); PG8_LDB(B1, 1, 1); PG8_SCHED; PG8_LDA(At, 1, 0); PG8_STAGE(PG8_SA(0, 1), baseA, a2, w1);
            PG8_WAIT_V(8); PG8_WAIT_L(0); PG8_BAR; PG8_MMA(0, 0, At, B0); PG8_MMA(0, 1, At, B1); PG8_BAR; PG8_SCHED;
            PG8_LDA(At, 1, 1); PG8_STAGE(PG8_SB(1, 0), baseB, b3, voffB); PG8_STAGE(PG8_SB(1, 1), baseB, b3 + hstep, voffB); PG8_STAGE(PG8_SA(1, 0), baseA, a3, w0);
            PG8_WAIT_V(8); PG8_WAIT_L(0); PG8_BAR; PG8_MMA(1, 0, At, B0); PG8_MMA(1, 1, At, B1); PG8_BAR; PG8_SCHED;
        }
        if constexpr (ALIGN_EPI) { if (wr == 0) PG8_BAR; }
        E(acc, cur, wr, wc, fr, fq);
        if (!has_next) break;
#pragma unroll
        for (int a = 0; a < 2; ++a)
#pragma unroll
            for (int b = 0; b < 2; ++b)
#pragma unroll
                for (int m = 0; m < 4; ++m)
#pragma unroll
                    for (int n = 0; n < 2; ++n) acc[a][b][m][n] = (f32x4){0.f, 0.f, 0.f, 0.f};
        cur = nxt; uA = nuA; uB = nuB; ++ui;
#pragma unroll
        for (int i = 0; i < 2; ++i) { vA0[i] = nA0[i]; vA1[i] = nA1[i]; }
        if constexpr (ALIGN_EPI) { if (wr == 1) PG8_BAR; }
    }
    PG8_WAIT_V(0);
    if constexpr (!ALIGN_EPI) { if (wr == 0) PG8_BAR; }
    PG8_BAR;
#undef PG8_SA
#undef PG8_SB
#undef PG8_STAGE
#undef PG8_LDA
#undef PG8_LDB
#undef PG8_MMA
#undef PG8_WAIT_V
#undef PG8_WAIT_L
#undef PG8_BAR
#undef PG8_SCHED
}

__device__ __forceinline__ unsigned cvt_pk_bf16(float lo, float hi) { unsigned r; asm volatile("v_cvt_pk_bf16_f32 %0, %1, %2" : "=v"(r) : "v"(lo), "v"(hi)); return r; }

struct EpiBf16 {
    static constexpr bool PERM = true;
    bf16* O; int ldc;
    __device__ __forceinline__ void operator()(const f32x4 (&acc)[2][2][4][2], const Unit& u, int wr, int wc, int fr, int fq) const {
        const int row0 = u.pm * BM + wr * 64 + fr; const int col0 = u.pn * BM + wc * 32 + 8 * fq;
#pragma unroll
        for (int ai = 0; ai < 2; ++ai)
#pragma unroll
            for (int m = 0; m < 4; ++m) { bf16* rowp = O + (size_t)(row0 + ai * HALF + m * 16) * ldc + col0;
#pragma unroll
                for (int bj = 0; bj < 2; ++bj) { const f32x4 v0 = acc[ai][bj][m][0], v1 = acc[ai][bj][m][1];
                    u32x4 w; w.x = cvt_pk_bf16(v0[0], v0[1]); w.y = cvt_pk_bf16(v0[2], v0[3]); w.z = cvt_pk_bf16(v1[0], v1[1]); w.w = cvt_pk_bf16(v1[2], v1[3]);
                    *(u32x4*)(rowp + bj * HALF) = w; } }
    }
};
struct EpiResid {
    static constexpr bool PERM = false;
    const float* xl; const float* xc; float* out; const float* gate;
    __device__ __forceinline__ void operator()(const f32x4 (&acc)[2][2][4][2], const Unit& u, int wr, int wc, int fr, int fq) const {
        const int rt = u.pm * BM; const bool isl = rt < NLAT;
        const float* base = isl ? xl + (size_t)rt * D : xc + (size_t)(rt - NLAT) * D;
        const float* gp = gate + (size_t)(isl ? (rt >> 12) : 8) * 12288;
        const int rl0 = wr * 64 + fr, col0 = u.pn * BM + wc * 32 + 4 * fq;
#pragma unroll
        for (int ai = 0; ai < 2; ++ai)
#pragma unroll
            for (int m = 0; m < 4; ++m) { const int rl = rl0 + ai * HALF + m * 16; const float* bp = base + (size_t)rl * D + col0; float* op = out + (size_t)(rt + rl) * D + col0;
#pragma unroll
                for (int bj = 0; bj < 2; ++bj)
#pragma unroll
                    for (int n = 0; n < 2; ++n) { const f32x4 b = *(const f32x4*)(bp + bj * HALF + n * 16); const f32x4 gv = *(const f32x4*)(gp + col0 + bj * HALF + n * 16); *(f32x4*)(op + bj * HALF + n * 16) = b + gv * acc[ai][bj][m][n]; }
                asm volatile("" ::: "memory"); }
    }
};
struct EpiSwiglu {
    static constexpr bool PERM = true;
    bf16* O;
    __device__ __forceinline__ void operator()(const f32x4 (&acc)[2][2][4][2], const Unit& u, int wr, int wc, int fr, int fq) const {
        const int row0 = u.pm * BM + wr * 64 + fr; const int col0 = u.pn * 128 + wc * 32 + 8 * fq;
#pragma unroll
        for (int ai = 0; ai < 2; ++ai)
#pragma unroll
            for (int m = 0; m < 4; ++m) { bf16* rowp = O + (size_t)(row0 + ai * HALF + m * 16) * DE + col0;
                float o[8];
#pragma unroll
                for (int n = 0; n < 2; ++n)
#pragma unroll
                    for (int j = 0; j < 4; ++j) { const float gt = acc[ai][0][m][n][j], up = acc[ai][1][m][n][j]; o[n * 4 + j] = gt * __builtin_amdgcn_rcpf(1.0f + __expf(-gt)) * up; }
                u32x4 w; w.x = cvt_pk_bf16(o[0], o[1]); w.y = cvt_pk_bf16(o[2], o[3]); w.z = cvt_pk_bf16(o[4], o[5]); w.w = cvt_pk_bf16(o[6], o[7]);
                *(u32x4*)rowp = w; }
    }
};
struct EpiDown {
    static constexpr bool PERM = true;
    bf16* YK; const PG8_LAS unsigned* tab; const PG8_LAS float* tabw;
    __device__ __forceinline__ void operator()(const f32x4 (&acc)[2][2][4][2], const Unit& u, int wr, int wc, int fr, int fq) const {
        const int rl0 = wr * 64 + fr; const int col0 = u.pn * BM + wc * 32 + 8 * fq;
#pragma unroll
        for (int ai = 0; ai < 2; ++ai)
#pragma unroll
            for (int m = 0; m < 4; ++m) { const int rl = rl0 + ai * HALF + m * 16; const unsigned ent = tab[u.aux * 256 + rl]; const float w = tabw[u.aux * 256 + rl];
                if (!(ent & 0x40000000u)) { bf16* rowp = YK + ((size_t)(ent >> 31) * MALL + (ent & 0xffffu)) * D + col0;
#pragma unroll
                    for (int bj = 0; bj < 2; ++bj) { const f32x4 v0 = acc[ai][bj][m][0] * w, v1 = acc[ai][bj][m][1] * w;
                        u32x4 q; q.x = cvt_pk_bf16(v0[0], v0[1]); q.y = cvt_pk_bf16(v0[2], v0[3]); q.z = cvt_pk_bf16(v1[0], v1[1]); q.w = cvt_pk_bf16(v1[2], v1[3]);
                        *(u32x4*)(rowp + bj * HALF) = q; } }
                asm volatile("" ::: "memory"); }
    }
};
}

struct Args { const float* in[31]; float* out; unsigned char* ws; int ph_lo, ph_hi; };
typedef const __attribute__((address_space(4))) Args* KArgs;
__device__ __forceinline__ KArgs kargs() { KArgs p = (KArgs)__builtin_amdgcn_kernarg_segment_ptr(); asm volatile("" : "+s"(p)); return p; }
#define AIN(i) (a->in[i])
enum { I_X = 0, I_C, I_CTX, I_CCTX, I_ADAW, I_ADAB, I_N1G, I_N2G, I_WIN, I_WOUT, I_GNG, I_GWS, I_GB, I_LB, I_HNG, I_MU, I_W0, I_WUP, I_A0, I_AUP, I_GUP, I_KK, I_KA, I_RK, I_GNGG, I_GNB, I_RW, I_RB, I_WGU, I_WDN, I_FNG };

__device__ __forceinline__ void p0_transpose_item(const float* W, int K, int N, bf16* WT, int n_row0, LAS float* scr, int kb, int nb, int lane) {
    const int k0 = 64 * kb, n0 = 32 * nb;
#pragma unroll 8
    for (int i = 0; i < 32; ++i) { const int kk = 2 * i + (lane >> 5); scr[kk * 33 + (lane & 31)] = W[(size_t)(k0 + kk) * N + n0 + (lane & 31)]; }
    asm volatile("s_waitcnt lgkmcnt(0)" ::: "memory");
    const int c = lane & 7;
#pragma unroll
    for (int j = 0; j < 4; ++j) { const int n = (lane >> 3) + 8 * j; const LAS float* s = scr + (8 * c) * 33 + n;
        u32x4 o; o.x = pk2(s[0 * 33], s[1 * 33]); o.y = pk2(s[2 * 33], s[3 * 33]); o.z = pk2(s[4 * 33], s[5 * 33]); o.w = pk2(s[6 * 33], s[7 * 33]);
        *(u32x4*)(WT + (size_t)(n_row0 + n) * K + k0 + 8 * c) = o; }
    asm volatile("s_waitcnt lgkmcnt(0)" ::: "memory");
}

__device__ __forceinline__ void phase_prologue(KArgs a, LAS unsigned char* lds) {
    const int tid = tid_fresh(), lane = tid & 63, wave = tid >> 6;
    const int G = gridDim.x, gw = blockIdx.x * 8 + wave, NGW = G * 8;
    unsigned char* ws = a->ws;
    LAS float* scr = (LAS float*)(lds + wave * 16384);
    constexpr int I_IN = 32 * 232, I_OUT = 32 * 64, I_GU = 32 * 64, I_DN = 16 * 64;
    constexpr int N0 = 2 * I_IN, N1 = N0 + 2 * I_OUT, N2 = N1 + 32 * I_GU, N3 = N2 + 32 * I_DN;
    for (int it = gw; it < N3; it += NGW) {
        if (it < N0) { const int l = it / I_IN, r = it % I_IN, kb = r / 232, nb = r % 232;
            p0_transpose_item(a->in[I_WIN] + (size_t)l * D * INC, D, INC, (bf16*)(ws + WS_WIN) + (size_t)l * INC * D, 32 * nb, scr, kb, nb, lane); }
        else if (it < N1) { const int q = it - N0, l = q / I_OUT, r = q % I_OUT, kb = r / 64, nb = r % 64;
            p0_transpose_item(a->in[I_WOUT] + (size_t)l * D * D, D, D, (bf16*)(ws + WS_WOUT) + (size_t)l * D * D, 32 * nb, scr, kb, nb, lane); }
        else if (it < N2) { const int q = it - N1, le = q / I_GU, r = q % I_GU, kb = r / 64, nb = r % 64;
            const int n0 = 32 * nb, hh = n0 >> 10, nn = n0 & 1023, row0 = 256 * (nn >> 7) + 128 * hh + (nn & 127);
            p0_transpose_item(a->in[I_WGU] + (size_t)le * D * 2048, D, 2048, (bf16*)(ws + WS_WGU) + (size_t)le * 2048 * D, row0, scr, kb, nb, lane); }
        else { const int q = it - N2, le = q / I_DN, r = q % I_DN, kb = r / 64, nb = r % 64;
            p0_transpose_item(a->in[I_WDN] + (size_t)le * DE * D, DE, D, (bf16*)(ws + WS_WDN) + (size_t)le * D * DE, 32 * nb, scr, kb, nb, lane); }
    }
    {
        const int gt = blockIdx.x * NTHREADS + tid, NGT = G * NTHREADS;
        bf16* wup = (bf16*)(ws + WS_SMALLW + SW_WUP); bf16* aup = (bf16*)(ws + WS_SMALLW + SW_AUP); bf16* gup = (bf16*)(ws + WS_SMALLW + SW_GUP); bf16* gws = (bf16*)(ws + WS_SMALLW + SW_GWS);
        for (int i = gt; i < 2 * 2 * 768 * 64; i += NGT) { const int k = i & 63, n = (i >> 6) % 768, ld = i / (768 * 64); wup[i] = (bf16)f2bf(a->in[I_WUP][((size_t)ld * 64 + k) * 768 + n]); }
        for (int i = gt; i < 2 * 768 * 64; i += NGT) { const int k = i & 63, n = (i >> 6) % 768, l = i / (768 * 64); aup[i] = (bf16)f2bf(a->in[I_AUP][((size_t)l * 64 + k) * 768 + n]); }
        for (int i = gt; i < 2 * 768 * 128; i += NGT) { const int k = i & 127, n = (i >> 7) % 768, l = i / (768 * 128); gup[i] = (bf16)f2bf(a->in[I_GUP][((size_t)l * 128 + k) * 768 + n]); }
        for (int i = gt; i < 2 * 4 * 128 * 128; i += NGT) gws[i] = (bf16)f2bf(a->in[I_GWS][i]);
    }
    __syncthreads();
    {
        LAS float* sv = (LAS float*)lds;
        LAS float* red = (LAS float*)(lds + 73728);
        for (int i = tid; i < 9 * D; i += NTHREADS) { const int r = i / D, k = i % D; const float v = r < 8 ? a->in[I_C][r * D + k] : a->in[I_CCTX][k]; sv[i] = siluf_(v); }
        __syncthreads();
        float* mod = (float*)(ws + WS_MOD);
        for (int it = blockIdx.x; it < 2 * 96; it += G) {
            const int l = it / 96, cb = it % 96, cq = tid & 31, kg = tid >> 5;
            const float* wp = a->in[I_ADAW] + (size_t)l * D * 12288 + (size_t)(kg * 128) * 12288 + cb * 128 + cq * 4;
            f32x4 acc[9];
#pragma unroll
            for (int r = 0; r < 9; ++r) acc[r] = (f32x4){0.f, 0.f, 0.f, 0.f};
#pragma unroll 4
            for (int k = 0; k < 128; ++k) { const f32x4 w = *(const f32x4*)(wp + (size_t)k * 12288);
#pragma unroll
                for (int r = 0; r < 9; ++r) acc[r] += w * sv[r * D + kg * 128 + k]; }
#pragma unroll
            for (int r = 0; r < 9; ++r) *(LAS f32x4*)(red + ((kg * 9 + r) * 128 + cq * 4)) = acc[r];
            __syncthreads();
            for (int o = tid; o < 9 * 128; o += NTHREADS) { const int r = o / 128, c = o % 128; float s = a->in[I_ADAB][(size_t)l * 12288 + cb * 128 + c];
#pragma unroll
                for (int q = 0; q < 16; ++q) s += red[(q * 9 + r) * 128 + c];
                mod[((size_t)l * 9 + r) * 12288 + cb * 128 + c] = s; }
            __syncthreads();
        }
    }
}

template <int MODE>
__device__ __forceinline__ void phase_norm1(KArgs a, int l, bool dry) {
    const int tid_ = tid_fresh(); const int lane = tid_ & 63, wave = tid_ >> 6, gw = blockIdx.x * 8 + wave, NGW = gridDim.x * 8;
    unsigned char* ws = a->ws;
    const float* mod = (const float*)(ws + WS_MOD);
    float* X = (float*)(ws + WS_X); bf16* H = (bf16*)(ws + WS_H); const bf16* YK = (const bf16*)(ws + WS_YK);
    float* Xo = dry ? (float*)(ws + WS_END) : X; bf16* Ho = dry ? (bf16*)(ws + WS_END) : H; float* Oo = dry ? (float*)(ws + WS_END) : a->out;
    const int nrows = (MODE == 2) ? NLAT : MALL;
    const int rpw = (nrows + NGW - 1) / NGW; const int r0 = gw * rpw, r1 = (r0 + rpw < nrows) ? r0 + rpw : nrows;
    f32x4 ck[8], cs[8], cg[8]; int cur_mr = -1;
    for (int row = r0; row < r1; ++row) {
        const int mr = modrow_of(row); const int orow = dry ? (row & 8191) : row;
        if (mr != cur_mr) { cur_mr = mr;
#pragma unroll
            for (int j = 0; j < 8; ++j) { const int c = 4 * lane + 256 * j;
                if (MODE == 2) ck[j] = *(const f32x4*)(a->in[I_FNG] + c);
                else { const float* m = mod + ((size_t)l * 9 + mr) * 12288; const f32x4 g = *(const f32x4*)(a->in[I_N1G] + (size_t)l * D + c); ck[j] = g * (*(const f32x4*)(m + D + c) + 1.0f); cs[j] = *(const f32x4*)(m + c); }
                if (MODE != 0) cg[j] = *(const f32x4*)(mod + ((size_t)(l - 1) * 9 + mr) * 12288 + 5 * D + c); } }
        f32x4 v[8];
        if (MODE == 0) { const float* xr = row < NLAT ? a->in[I_X] + (size_t)row * D : a->in[I_CTX] + (size_t)(row - NLAT) * D;
#pragma unroll
            for (int j = 0; j < 8; ++j) v[j] = *(const f32x4*)(xr + 4 * lane + 256 * j);
        } else {
            const float* xr = X + (size_t)row * D; const bf16* y0 = YK + (size_t)row * D; const bf16* y1 = YK + ((size_t)MALL + row) * D;
            u32x2 p0[8], p1[8];
#pragma unroll
            for (int j = 0; j < 8; ++j) { const int c = 4 * lane + 256 * j; v[j] = *(const f32x4*)(xr + c); p0[j] = *(const u32x2*)(y0 + c); p1[j] = *(const u32x2*)(y1 + c); }
#pragma unroll
            for (int j = 0; j < 8; ++j) { f32x4 f; f[0] = bflo(p0[j].x) + bflo(p1[j].x); f[1] = bfhi(p0[j].x) + bfhi(p1[j].x); f[2] = bflo(p0[j].y) + bflo(p1[j].y); f[3] = bfhi(p0[j].y) + bfhi(p1[j].y);
                v[j] = v[j] + cg[j] * f; }
            if (MODE == 1) {
#pragma unroll
                for (int j = 0; j < 8; ++j) *(f32x4*)(Xo + (size_t)orow * D + 4 * lane + 256 * j) = v[j];
            }
        }
        float ss = 0.f;
#pragma unroll
        for (int j = 0; j < 8; ++j) ss += (v[j][0] * v[j][0] + v[j][1] * v[j][1]) + (v[j][2] * v[j][2] + v[j][3] * v[j][3]);
        const float rstd = 1.0f / sqrtf(wave_sum(ss) * (1.0f / D) + NORM_EPS);
        if (MODE == 2) {
#pragma unroll
            for (int j = 0; j < 8; ++j) *(f32x4*)(Oo + (size_t)orow * D + 4 * lane + 256 * j) = v[j] * rstd * ck[j];
        } else {
#pragma unroll
            for (int j = 0; j < 8; ++j) { const f32x4 h = v[j] * rstd * ck[j] + cs[j]; u32x2 o; o.x = pk2(h[0], h[1]); o.y = pk2(h[2], h[3]); *(u32x2*)(Ho + (size_t)orow * D + 4 * lane + 256 * j) = o; }
        }
    }
}

__device__ __forceinline__ void phase_norm2_router(KArgs a, int l, bool dry, LAS unsigned char* lds) {
    const int tid_ = tid_fresh(); const int lane = tid_ & 63, wave = tid_ >> 6, gw = blockIdx.x * 8 + wave, NGW = gridDim.x * 8;
    unsigned char* ws = a->ws;
    const float* mod = (const float*)(ws + WS_MOD);
    const float* X = (const float*)(ws + WS_X); bf16* H = (bf16*)(ws + WS_H);
    unsigned* cnt = (unsigned*)(ws + WS_CTL) + CW_CNT + l * 16 * 64 + (dry ? 4096 : 0);
    unsigned* ridx = (unsigned*)(ws + (dry ? WS_END : WS_RIDX)); float* rwt = (float*)(ws + (dry ? WS_END + 4 * MiB : WS_RW)); bf16* Ho = dry ? (bf16*)(ws + WS_END + 8 * MiB) : H;
    const int nrows = (l == DEPTH - 1) ? NLAT : MALL;
    LAS f32x4* rwl = (LAS f32x4*)lds;
    { const float* rw = a->in[I_RW];
      for (int idx = tid_; idx < 8192; idx += NTHREADS) { const int ln = idx & 63, q = (idx >> 6) & 3, i = (idx >> 8) & 3, j = idx >> 10; rwl[idx] = *(const f32x4*)(rw + (size_t)(4 * ln + 256 * j + i) * 16 + 4 * q); } }
    __syncthreads();
    const int rpw = (nrows + NGW - 1) / NGW; const int r0 = gw * rpw, r1 = (r0 + rpw < nrows) ? r0 + rpw : nrows;
    f32x4 ck[8], cs[8]; int cur_mr = -1;
    float rb[16];
#pragma unroll
    for (int e = 0; e < 16; ++e) rb[e] = a->in[I_RB][e];
    for (int row = r0; row < r1; ++row) {
        const int mr = modrow_of(row); const int orow = dry ? (row & 8191) : row;
        if (mr != cur_mr) { cur_mr = mr; const float* m = mod + ((size_t)l * 9 + mr) * 12288;
#pragma unroll
            for (int j = 0; j < 8; ++j) { const int c = 4 * lane + 256 * j; const f32x4 g = *(const f32x4*)(a->in[I_N2G] + (size_t)l * D + c); ck[j] = g * (*(const f32x4*)(m + 4 * D + c) + 1.0f); cs[j] = *(const f32x4*)(m + 3 * D + c); } }
        const float* xr = X + (size_t)row * D;
        f32x4 v[8]; float ss = 0.f;
#pragma unroll
        for (int j = 0; j < 8; ++j) { v[j] = *(const f32x4*)(xr + 4 * lane + 256 * j); ss += (v[j][0] * v[j][0] + v[j][1] * v[j][1]) + (v[j][2] * v[j][2] + v[j][3] * v[j][3]); }
        const float rstd = 1.0f / sqrtf(wave_sum(ss) * (1.0f / D) + NORM_EPS);
        f32x4 lg4[4];
#pragma unroll
        for (int q = 0; q < 4; ++q) lg4[q] = (f32x4){0.f, 0.f, 0.f, 0.f};
#pragma unroll
        for (int j = 0; j < 8; ++j) { const f32x4 h = v[j] * rstd * ck[j] + cs[j]; u32x2 o; o.x = pk2(h[0], h[1]); o.y = pk2(h[2], h[3]); *(u32x2*)(Ho + (size_t)orow * D + 4 * lane + 256 * j) = o;
#pragma unroll
            for (int i = 0; i < 4; ++i)
#pragma unroll
                for (int q = 0; q < 4; ++q) lg4[q] += rwl[((j * 4 + i) * 4 + q) * 64 + lane] * h[i];
            asm volatile("" ::: "memory"); }
        float lg[16];
#pragma unroll
        for (int e = 0; e < 16; ++e) lg[e] = wave_sum(lg4[e >> 2][e & 3]) + rb[e];
        float mx = lg[0];
#pragma unroll
        for (int e = 1; e < 16; ++e) mx = fmaxf(mx, lg[e]);
        float p[16], sum = 0.f;
#pragma unroll
        for (int e = 0; e < 16; ++e) { p[e] = __expf(lg[e] - mx); sum += p[e]; }
        const float inv = 1.0f / sum;
#pragma unroll
        for (int e = 0; e < 16; ++e) p[e] *= inv;
        int sel = 0; float best = -1.f;
#pragma unroll
        for (int gI = 0; gI < 4; ++gI) { float m1 = -1.f, m2 = -1.f;
#pragma unroll
            for (int i = 0; i < 4; ++i) { const float q = p[4 * gI + i]; if (q > m1) { m2 = m1; m1 = q; } else if (q > m2) m2 = q; }
            const float s = m1 + m2; if (s > best) { best = s; sel = gI; } }
        int i1 = 0, i2 = 0; float p1 = -2.f, p2 = -2.f;
#pragma unroll
        for (int gI = 0; gI < 4; ++gI)
#pragma unroll
            for (int i = 0; i < 4; ++i) { const float q = (gI == sel) ? p[4 * gI + i] : -1.0f; const int e = 4 * gI + i;
                if (gI == sel) { if (q > p1) { p2 = p1; i2 = i1; p1 = q; i1 = e; } else if (q > p2) { p2 = q; i2 = e; } } }
        const float wsum = p1 + p2, w1 = p1 / wsum, w2 = p2 / wsum;
        if (lane == 0) {
            const unsigned q1 = atomicAdd(cnt + i1 * 64, 1u); ridx[(size_t)i1 * MALL + q1] = (unsigned)row; rwt[(size_t)i1 * MALL + q1] = w1;
            const unsigned q2 = atomicAdd(cnt + i2 * 64, 1u); ridx[(size_t)i2 * MALL + q2] = (unsigned)row | 0x80000000u; rwt[(size_t)i2 * MALL + q2] = w2;
        }
    }
    __syncthreads();
}

template <bool FOR_DOWN>
__device__ __forceinline__ void moe_tables(KArgs a, int l, LAS unsigned char* lds, int cvirt) {
    const int tid = tid_fresh(), G = gridDim.x;
    unsigned char* ws = a->ws;
    const unsigned* cnt = (const unsigned*)(ws + WS_CTL) + CW_CNT + l * 16 * 64;
    const unsigned* ridx = (const unsigned*)(ws + WS_RIDX); const float* rwt = (const float*)(ws + WS_RW);
    LAS int* tp = (LAS int*)(lds + LDS_TP); LAS unsigned* tab = (LAS unsigned*)(lds + LDS_TAB); LAS float* tabw = (LAS float*)(lds + LDS_TABW);
    if (tid == 0) { int acc = 0; for (int e = 0; e < 16; ++e) { tp[e] = acc; acc += (int)((cnt[e * 64] + 255u) >> 8); } tp[16] = acc; }
    __syncthreads();
    const int ntot = tp[16] * 8;
    for (int i = 0; i < 9; ++i) { const int L = i * G + cvirt; if (L >= ntot) break;
        const int tile = L >> 3; int e = 0;
        for (int j = 1; j < 16; ++j) e += (tile >= tp[j]) ? 1 : 0;
        const int pos0 = (tile - tp[e]) * 256; const unsigned ce = cnt[e * 64];
        if (tid < 256) { const int pos = pos0 + tid; const bool valid = (unsigned)pos < ce; const unsigned ent = ridx[(size_t)e * MALL + (valid ? pos : 0)];
            if (FOR_DOWN) { tab[i * 256 + tid] = valid ? ent : (ent | 0x40000000u); tabw[i * 256 + tid] = valid ? rwt[(size_t)e * MALL + pos] : 0.f; }
            else tab[i * 256 + tid] = (ent & 0xffffu) * (unsigned)(D * 2); }
    }
    __syncthreads();
}

__device__ __forceinline__ void gmlp_item(KArgs a, int l, int item, LAS unsigned char* lds) {
    const int tid = tid_fresh(), lane = tid & 63, wave = tid >> 6;
    unsigned char* ws = a->ws;
    const bf16* P = (const bf16*)(ws + WS_P); bf16* Y = (bf16*)(ws + WS_Y);
    const int chunk = item >> 2, h = item & 3;
    const int row0 = chunk < 256 ? chunk * 128 : NLAT + (chunk - 256) * 128;
    LAS bf16* wsl = (LAS bf16*)lds;
    LAS bf16* vT = (LAS bf16*)(lds + 128 * 136 * 2);
    const bf16* gws = (const bf16*)(ws + WS_SMALLW + SW_GWS) + ((size_t)l * 4 + h) * 128 * 128;
    for (int p = tid; p < 2048; p += NTHREADS) { const int t = p >> 4, c8 = p & 15; *(LAS u32x4*)(wsl + t * 136 + c8 * 8) = *(const u32x4*)(gws + t * 128 + c8 * 8); }
    {
        const int s = tid >> 2, qd = tid & 3; const bf16* vp = P + (size_t)(row0 + s) * INC + OFF_V + h * 128 + qd * 32;
        float g[32]; float ss = 0.f;
#pragma unroll
        for (int q = 0; q < 4; ++q) { float f[8]; unpack8(*(const u32x4*)(vp + 8 * q), f);
#pragma unroll
            for (int j = 0; j < 8; ++j) { const float x = geluf_(f[j]); g[8 * q + j] = x; ss += x * x; } }
        ss += __shfl_xor(ss, 1); ss += __shfl_xor(ss, 2);
        const float rstd = 1.0f / sqrtf(ss * (1.0f / 128.0f) + NORM_EPS);
        const float* ng = a->in[I_GNG] + (size_t)l * 512 + h * 128 + qd * 32;
#pragma unroll
        for (int j = 0; j < 32; ++j) vT[(qd * 32 + j) * 136 + s] = (bf16)f2bf(g[j] * rstd * ng[j]);
    }
    __syncthreads();
    f32x4 acc[8];
#pragma unroll
    for (int ct = 0; ct < 8; ++ct) acc[ct] = (f32x4){0.f, 0.f, 0.f, 0.f};
    const int fr = lane & 15, fq = lane >> 4;
#pragma unroll
    for (int ks = 0; ks < 4; ++ks) {
        const bf16x8 bfrag = *(const LAS bf16x8*)(wsl + (16 * wave + fr) * 136 + ks * 32 + fq * 8);
#pragma unroll
        for (int ct = 0; ct < 8; ++ct) { const bf16x8 afrag = *(const LAS bf16x8*)(vT + (16 * ct + fr) * 136 + ks * 32 + fq * 8);
            acc[ct] = __builtin_amdgcn_mfma_f32_16x16x32_bf16(afrag, bfrag, acc[ct], 0, 0, 0); }
    }
    const int t = 16 * wave + fr; const float wb = a->in[I_GB][((size_t)l * 4 + h) * 128 + t];
    const bf16* up = P + (size_t)(row0 + t) * INC + OFF_U + h * 128; bf16* yp = Y + (size_t)(row0 + t) * D + h * 128;
#pragma unroll
    for (int ct = 0; ct < 8; ++ct) { const int c = 16 * ct + 4 * fq; const u32x2 uu = *(const u32x2*)(up + c);
        const float y0 = geluf_(bflo(uu.x)) * (acc[ct][0] + wb), y1 = geluf_(bfhi(uu.x)) * (acc[ct][1] + wb), y2 = geluf_(bflo(uu.y)) * (acc[ct][2] + wb), y3 = geluf_(bfhi(uu.y)) * (acc[ct][3] + wb);
        u32x2 o; o.x = pk2(y0, y1); o.y = pk2(y2, y3); *(u32x2*)(yp + c) = o; }
    __syncthreads();
}

constexpr int KLP = 776;
__device__ __forceinline__ void rwkv_prep_item(KArgs a, int l, int tile, LAS unsigned char* lds) {
    const int tid = tid_fresh(), lane = tid & 63, wave = tid >> 6;
    unsigned char* ws = a->ws;
    const bf16* P = (const bf16*)(ws + WS_P); bf16* PC2 = (bf16*)(ws + WS_PC2); bf16* Y = (bf16*)(ws + WS_Y);
    LAS bf16* kl = (LAS bf16*)lds;
    LAS bf16* tw = (LAS bf16*)(lds + 64 * KLP * 2);
    LAS bf16* adl = tw + 64 * 72;
    LAS bf16* sg = adl + 64 * 72;
    LAS float* invn = (LAS float*)(sg + 64 * 136);
    const int row0 = tile * 64; const bool isl = row0 < NLAT;
    const float* mu = a->in[I_MU] + (size_t)l * CCOLS; const float* kkw = a->in[I_KK] + (size_t)l * CW;
    for (int g = tid; g < 64 * 320; g += NTHREADS) {
        const int tk = g / 320, cg = g % 320, col = cg * 8, row = row0 + tk;
        const bf16* pp = P + (size_t)row * INC + OFF_C + col;
        float own[8], z[8];
        unpack8(*(const u32x4*)pp, own);
        float nl[8], nr[8];
        if (isl) {
            const int gr = (row >> 6) & 63;
            float lf[8], rt[8], upv[8], dn[8];
            if (tk > 0) unpack8(*(const u32x4*)(pp - INC), lf); else { for (int j = 0; j < 8; ++j) lf[j] = 0.f; }
            if (tk < 63) unpack8(*(const u32x4*)(pp + INC), rt); else { for (int j = 0; j < 8; ++j) rt[j] = 0.f; }
            if (gr > 0) unpack8(*(const u32x4*)(pp - (size_t)64 * INC), upv); else { for (int j = 0; j < 8; ++j) upv[j] = 0.f; }
            if (gr < 63) unpack8(*(const u32x4*)(pp + (size_t)64 * INC), dn); else { for (int j = 0; j < 8; ++j) dn[j] = 0.f; }
            nl[0] = lf[0]; nl[1] = rt[1]; nl[2] = upv[2]; nl[3] = dn[3]; nl[4] = lf[4]; nl[5] = rt[5]; nl[6] = upv[6]; nl[7] = dn[7];
        } else {
            const int tc = (row - NLAT) & 255;
            if (tc > 0) unpack8(*(const u32x4*)(pp - INC), nl); else { for (int j = 0; j < 8; ++j) nl[j] = 0.f; }
            if (tc < 255) unpack8(*(const u32x4*)(pp + INC), nr); else { for (int j = 0; j < 8; ++j) nr[j] = 0.f; }
            nl[1] = nr[1]; nl[3] = nr[3]; nl[5] = nr[5]; nl[7] = nr[7];
        }
        const f32x4 m0 = *(const f32x4*)(mu + col), m1 = *(const f32x4*)(mu + col + 4);
#pragma unroll
        for (int j = 0; j < 8; ++j) { const float mm = j < 4 ? m0[j] : m1[j - 4]; z[j] = own[j] + mm * (nl[j] - own[j]); }
        if (col < 768) { *(u32x4*)(PC2 + (size_t)row * PC2W + col) = pack8(z); }
        else if (col < 1536) { const int c = col - 768; *(LAS u32x4*)(kl + tk * KLP + c) = pack8(z);
            const f32x4 k0 = *(const f32x4*)(kkw + c), k1 = *(const f32x4*)(kkw + c + 4); float ss = 0.f;
#pragma unroll
            for (int j = 0; j < 8; ++j) { const float q = z[j] * (j < 4 ? k0[j] : k1[j - 4]); ss += q * q; }
            ss += __shfl_xor(ss, 1); ss += __shfl_xor(ss, 2); ss += __shfl_xor(ss, 4);
            if ((lane & 7) == 0) invn[tk * 12 + (c >> 6)] = 1.0f / fmaxf(sqrtf(ss), 1e-12f); }
        else if (col < 2304) { *(u32x4*)(PC2 + (size_t)row * PC2W + 2 * 768 + (col - 1536)) = pack8(z); }
        else if (col < 2368) { float t8[8];
#pragma unroll
            for (int j = 0; j < 8; ++j) t8[j] = tanhf(z[j]);
            *(LAS u32x4*)(tw + tk * 72 + (col - 2304)) = pack8(t8); }
        else if (col < 2432) { *(LAS u32x4*)(adl + tk * 72 + (col - 2368)) = pack8(z); }
        else { float t8[8];
#pragma unroll
            for (int j = 0; j < 8; ++j) t8[j] = sigmoidf_(z[j]);
            *(LAS u32x4*)(sg + tk * 136 + (col - 2432)) = pack8(t8); }
    }
    __syncthreads();
    const int fr = lane & 15, fq = lane >> 4;
    const bf16* wupT = (const bf16*)(ws + WS_SMALLW + SW_WUP) + (size_t)l * 2 * 768 * 64;
    const bf16* aupT = (const bf16*)(ws + WS_SMALLW + SW_AUP) + (size_t)l * 768 * 64;
    const bf16* gupT = (const bf16*)(ws + WS_SMALLW + SW_GUP) + (size_t)l * 768 * 128;
    const float* a0 = a->in[I_A0] + (size_t)l * CW; const float* kaw = a->in[I_KA] + (size_t)l * CW; const float* w0 = a->in[I_W0] + (size_t)l * 2 * CW;
#pragma unroll 1
    for (int mat = 0; mat < 4; ++mat) {
        const bf16* WT = mat == 0 ? aupT : (mat == 1 ? wupT : (mat == 2 ? wupT + 768 * 64 : gupT));
        const int KK = mat == 3 ? 128 : 64; const LAS bf16* act = mat == 0 ? adl : (mat == 3 ? sg : tw); const int apitch = mat == 3 ? 136 : 72;
#pragma unroll 1
        for (int th = 0; th < 2; ++th) {
        f32x4 acc[6][2];
#pragma unroll
        for (int nt = 0; nt < 6; ++nt)
#pragma unroll
            for (int tt = 0; tt < 2; ++tt) acc[nt][tt] = (f32x4){0.f, 0.f, 0.f, 0.f};
        for (int ks = 0; ks < KK / 32; ++ks) {
            bf16x8 bfr[2];
#pragma unroll
            for (int tt = 0; tt < 2; ++tt) bfr[tt] = *(const LAS bf16x8*)(act + (16 * (2 * th + tt) + fr) * apitch + ks * 32 + fq * 8);
#pragma unroll
            for (int nt = 0; nt < 6; ++nt) { const bf16x8 afr = *(const bf16x8*)(WT + (size_t)(96 * wave + 16 * nt + fr) * KK + ks * 32 + fq * 8);
#pragma unroll
                for (int tt = 0; tt < 2; ++tt) acc[nt][tt] = __builtin_amdgcn_mfma_f32_16x16x32_bf16(afr, bfr[tt], acc[nt][tt], 0, 0, 0); }
        }
#pragma unroll
        for (int nt = 0; nt < 6; ++nt) { const int n = 96 * wave + 16 * nt + 4 * fq;
#pragma unroll
            for (int tt = 0; tt < 2; ++tt) { const int tk = 16 * (2 * th + tt) + fr, row = row0 + tk; const f32x4 v = acc[nt][tt];
                if (mat == 0) {
                    const f32x4 a0v = *(const f32x4*)(a0 + n), kav = *(const f32x4*)(kaw + n), kkv = *(const f32x4*)(kkw + n);
                    const u32x2 kp = *(const LAS u32x2*)(kl + tk * KLP + n); const float kf[4] = {bflo(kp.x), bfhi(kp.x), bflo(kp.y), bfhi(kp.y)};
                    const float inn = invn[tk * 12 + (n >> 6)];
                    float k2[4], kk[4], bb[4];
#pragma unroll
                    for (int j = 0; j < 4; ++j) { const float av = sigmoidf_(a0v[j] + v[j]); kk[j] = kf[j] * kkv[j] * inn; k2[j] = kf[j] * (1.0f + (av - 1.0f) * kav[j]); bb[j] = kk[j] * av; }
                    bf16* o = PC2 + (size_t)row * PC2W + n;
                    u32x2 q; q.x = pk2(k2[0], k2[1]); q.y = pk2(k2[2], k2[3]); *(u32x2*)(o + 1 * 768) = q;
                    q.x = pk2(kk[0], kk[1]); q.y = pk2(kk[2], kk[3]); *(u32x2*)(o + 3 * 768) = q;
                    q.x = pk2(bb[0], bb[1]); q.y = pk2(bb[2], bb[3]); *(u32x2*)(o + 4 * 768) = q;
                } else if (mat <= 2) {
                    const f32x4 w0v = *(const f32x4*)(w0 + (mat - 1) * CW + n); float d[4];
#pragma unroll
                    for (int j = 0; j < 4; ++j) d[j] = __expf(-DECAY_SCALE * sigmoidf_(w0v[j] + v[j]));
                    u32x2 q; q.x = pk2(d[0], d[1]); q.y = pk2(d[2], d[3]); *(u32x2*)(PC2 + (size_t)row * PC2W + (4 + mat) * 768 + n) = q;
                } else {
                    u32x2 q; q.x = pk2(v[0], v[1]); q.y = pk2(v[2], v[3]); *(u32x2*)(Y + (size_t)row * D + 1280 + n) = q;
                }
            } }
        }
    }
    __syncthreads();
}

__device__ __forceinline__ float dpp_xor1(float x) { return __builtin_bit_cast(float, __builtin_amdgcn_update_dpp(0, __builtin_bit_cast(int, x), 0xB1, 0xF, 0xF, false)); }
__device__ __forceinline__ float dpp_xor2(float x) { return __builtin_bit_cast(float, __builtin_amdgcn_update_dpp(0, __builtin_bit_cast(int, x), 0x4E, 0xF, 0xF, false)); }
__device__ __forceinline__ int chain_row(int dir, int b, int s) {
    if (s < CTXL) return NLAT + b * CTXL + (dir ? (CTXL - 1 - s) : s);
    const int t = s - CTXL; return b * T + (dir ? (T - 1 - t) : t);
}
__device__ __forceinline__ float dpp_hmirror(float x) { return __builtin_bit_cast(float, __builtin_amdgcn_update_dpp(0, __builtin_bit_cast(int, x), 0x141, 0xF, 0xF, false)); }
__device__ __forceinline__ void rwkv_chain(KArgs a, int cid, LAS unsigned char* lds) {
    const int tid = tid_fresh();
    unsigned char* ws = a->ws;
    const bf16* PC2 = (const bf16*)(ws + WS_PC2); bf16* OC = (bf16*)(ws + WS_OC);
    const int dir = cid / 96, b = (cid % 96) / 12, h = cid % 12;
    const bool stager = tid >= 256; const int ht = tid & 255;
    const int v = ht >> 2, q = ht & 3;
    constexpr int TILE_B = 16 * 6 * 64 * 4;
    f32x2 S[8];
#pragma unroll
    for (int j = 0; j < 8; ++j) S[j] = (f32x2){0.f, 0.f};
    int pst[3], pcol[3]; u32x4 pre[3];
#pragma unroll
    for (int j = 0; j < 3; ++j) { const int p = ht + 256 * j, sm = (p % 48) >> 3; pst[j] = p / 48; pcol[j] = (sm < 5 ? sm : 5 + dir) * 768 + h * 64 + (p & 7) * 8; }
    if (stager) {
#pragma unroll
        for (int j = 0; j < 3; ++j) { pre[j] = *(const u32x4*)(PC2 + (size_t)chain_row(dir, b, pst[j]) * PC2W + pcol[j]);
            float f[8]; unpack8(pre[j], f); LAS float* dp = (LAS float*)(lds + (ht + 256 * j) * 32); *(LAS f32x4*)dp = (f32x4){f[0], f[1], f[2], f[3]}; *(LAS f32x4*)(dp + 4) = (f32x4){f[4], f[5], f[6], f[7]}; }
    }
    __syncthreads();
    constexpr int NT = (CTXL + T) / 16;
    for (int t = 0; t < NT; ++t) {
        const int s0 = t * 16;
        LAS float* ot = (LAS float*)(lds + 2 * TILE_B + (t & 1) * 4096);
        if (stager) {
            if (t + 1 < NT) {
#pragma unroll
                for (int j = 0; j < 3; ++j) pre[j] = *(const u32x4*)(PC2 + (size_t)chain_row(dir, b, s0 + 16 + pst[j]) * PC2W + pcol[j]);
                LAS unsigned char* nb = lds + ((t + 1) & 1) * TILE_B;
#pragma unroll
                for (int j = 0; j < 3; ++j) { float f[8]; unpack8(pre[j], f); LAS float* dp = (LAS float*)(nb + (ht + 256 * j) * 32); *(LAS f32x4*)dp = (f32x4){f[0], f[1], f[2], f[3]}; *(LAS f32x4*)(dp + 4) = (f32x4){f[4], f[5], f[6], f[7]}; }
            }
        } else {
            const LAS float* tb = (const LAS float*)(lds + (t & 1) * TILE_B);
#pragma unroll 2
            for (int st = 0; st < 16; ++st) {
                const LAS float* sp = tb + st * 384 + q * 16;
                f32x2 kk[8], bb[8], w[8], k2[8], r[8];
#pragma unroll
                for (int j = 0; j < 4; ++j) { const f32x4 x3 = *(const LAS f32x4*)(sp + 3 * 64 + 4 * j), x4 = *(const LAS f32x4*)(sp + 4 * 64 + 4 * j), x5 = *(const LAS f32x4*)(sp + 5 * 64 + 4 * j), x1 = *(const LAS f32x4*)(sp + 1 * 64 + 4 * j), x0 = *(const LAS f32x4*)(sp + 4 * j);
                    kk[2 * j] = (f32x2){x3[0], x3[1]}; kk[2 * j + 1] = (f32x2){x3[2], x3[3]}; bb[2 * j] = (f32x2){x4[0], x4[1]}; bb[2 * j + 1] = (f32x2){x4[2], x4[3]};
                    w[2 * j] = (f32x2){x5[0], x5[1]}; w[2 * j + 1] = (f32x2){x5[2], x5[3]}; k2[2 * j] = (f32x2){x1[0], x1[1]}; k2[2 * j + 1] = (f32x2){x1[2], x1[3]};
                    r[2 * j] = (f32x2){x0[0], x0[1]}; r[2 * j + 1] = (f32x2){x0[2], x0[3]}; }
                const float vv = tb[st * 384 + 2 * 64 + v];
                f32x2 sa2 = S[0] * kk[0], sb2 = S[1] * kk[1];
#pragma unroll
                for (int j = 1; j < 4; ++j) { sa2 = __builtin_elementwise_fma(S[2 * j], kk[2 * j], sa2); sb2 = __builtin_elementwise_fma(S[2 * j + 1], kk[2 * j + 1], sb2); }
                sa2 = sa2 + sb2; float sa = sa2[0] + sa2[1]; sa += dpp_xor1(sa); sa += dpp_xor2(sa);
                const f32x2 vv2 = (f32x2){vv, vv}, nsa2 = (f32x2){-sa, -sa};
#pragma unroll
                for (int j = 0; j < 8; ++j) { f32x2 t2 = vv2 * k2[j]; t2 = __builtin_elementwise_fma(nsa2, bb[j], t2); S[j] = __builtin_elementwise_fma(S[j], w[j], t2); }
                f32x2 oa2 = S[0] * r[0], ob2 = S[1] * r[1];
#pragma unroll
                for (int j = 1; j < 4; ++j) { oa2 = __builtin_elementwise_fma(S[2 * j], r[2 * j], oa2); ob2 = __builtin_elementwise_fma(S[2 * j + 1], r[2 * j + 1], ob2); }
                oa2 = oa2 + ob2; float o = oa2[0] + oa2[1]; o += dpp_xor1(o); o += dpp_xor2(o);
                if (q == 0) ot[st * 64 + v] = o;
            }
        }
        __syncthreads();
        if (tid >= 256 && tid < 384) { const int st = (tid - 256) >> 3, part = tid & 7; const int row = chain_row(dir, b, s0 + st); const LAS float* op = ot + st * 64 + part * 8;
            float f[8];
#pragma unroll
            for (int j = 0; j < 8; ++j) f[j] = op[j];
            *(u32x4*)(OC + ((size_t)dir * MALL + row) * CW + h * 64 + part * 8) = pack8(f); }
    }
    __syncthreads();
}
#define LDS_BAR() do { asm volatile("s_waitcnt lgkmcnt(0)" ::: "memory"); __builtin_amdgcn_s_barrier(); asm volatile("" ::: "memory"); } while (0)
__device__ __forceinline__ void hgrn_chain_mfma(KArgs a, int l, int cid, LAS unsigned char* lds) {
    const int tid = tid_fresh(), lane = tid & 63, wave = tid >> 6, fr = lane & 15, fq = lane >> 4;
    unsigned char* ws = a->ws;
    const bf16* P = (const bf16*)(ws + WS_P); bf16* OB = (bf16*)(ws + WS_OB);
    const int dir = cid / 48, b = (cid % 48) / 6, h = cid % 6;
    constexpr int QP = 136, SP = 72;
    LAS bf16* qs = (LAS bf16*)lds;
    LAS bf16* ks = qs + 64 * QP;
    LAS bf16* kT = ks + 64 * QP;
    LAS bf16* vT = kT + 128 * SP;
    LAS bf16* pl = vT + 128 * SP;
    LAS bf16* sT = pl + 64 * SP;
    LAS float* tot = (LAS float*)(sT + 128 * QP);
    LAS float* gmid = tot + 512;
    LAS float* gend = gmid + 128;
    LAS float* lbs = gend + 128;
    LAS float* lfb = (LAS float*)sT;
    const int d = tid & 127, qt = tid >> 7;
    const int tau_a = tid >> 3, d0 = (tid & 7) * 16;
    if (tid < 128) { const int ch = h * 128 + tid; float lb = 0.f;
        if (l != 0) { const float l0 = a->in[I_LB][((size_t)dir * DEPTH + 0) * BW + ch], l1 = a->in[I_LB][((size_t)dir * DEPTH + 1) * BW + ch]; lb = 1.0f / (1.0f + __expf(l0 - l1)); }
        lbs[tid] = lb; }
    f32x4 S[8];
#pragma unroll
    for (int vt = 0; vt < 8; ++vt) S[vt] = (f32x4){0.f, 0.f, 0.f, 0.f};
    const int zoff = dir ? OFF_ZB : OFF_ZF;
    u32x4 rq[2], ri[2], rz[2];
    { const bf16* pr = P + (size_t)chain_row(dir, b, tau_a) * INC + h * 128 + d0;
      rq[0] = *(const u32x4*)(pr + OFF_Q); rq[1] = *(const u32x4*)(pr + OFF_Q + 8); ri[0] = *(const u32x4*)(pr + OFF_I); ri[1] = *(const u32x4*)(pr + OFF_I + 8); rz[0] = *(const u32x4*)(pr + zoff); rz[1] = *(const u32x4*)(pr + zoff + 8); }
    __syncthreads();
    constexpr int NCH = (CTXL + T) / 64;
    for (int n = 0; n < NCH; ++n) {
        const int s0 = n * 64;
#pragma unroll
        for (int hf = 0; hf < 2; ++hf) { float qf[8], zf[8], oq[8], ok[8]; unpack8(rq[hf], qf); unpack8(rz[hf], zf);
            const int dd = d0 + 8 * hf; const f32x4 lb0 = *(const LAS f32x4*)(lbs + dd), lb1 = *(const LAS f32x4*)(lbs + dd + 4); f32x4 lf0, lf1;
#pragma unroll
            for (int j = 0; j < 8; ++j) { const float lb = j < 4 ? lb0[j] : lb1[j - 4]; const float f = lb + (1.0f - lb) * sigmoidf_(zf[j]); const float lf = fmaxf(__logf(f), -60.0f);
                if (j < 4) lf0[j] = lf; else lf1[j - 4] = lf; oq[j] = siluf_(qf[j]); ok[j] = 1.0f - f; }
            *(LAS u32x4*)(qs + tau_a * QP + dd) = pack8(oq); *(LAS u32x4*)(ks + tau_a * QP + dd) = pack8(ok);
            *(LAS f32x4*)(lfb + tau_a * 128 + dd) = lf0; *(LAS f32x4*)(lfb + tau_a * 128 + dd + 4) = lf1;
            const u32x4 vv = ri[hf];
            vT[(dd + 0) * SP + tau_a] = (bf16)(vv.x & 0xffffu); vT[(dd + 1) * SP + tau_a] = (bf16)(vv.x >> 16); vT[(dd + 2) * SP + tau_a] = (bf16)(vv.y & 0xffffu); vT[(dd + 3) * SP + tau_a] = (bf16)(vv.y >> 16);
            vT[(dd + 4) * SP + tau_a] = (bf16)(vv.z & 0xffffu); vT[(dd + 5) * SP + tau_a] = (bf16)(vv.z >> 16); vT[(dd + 6) * SP + tau_a] = (bf16)(vv.w & 0xffffu); vT[(dd + 7) * SP + tau_a] = (bf16)(vv.w >> 16); }
        if (n + 1 < NCH) { const bf16* pr = P + (size_t)chain_row(dir, b, s0 + 64 + tau_a) * INC + h * 128 + d0;
            rq[0] = *(const u32x4*)(pr + OFF_Q); rq[1] = *(const u32x4*)(pr + OFF_Q + 8); ri[0] = *(const u32x4*)(pr + OFF_I); ri[1] = *(const u32x4*)(pr + OFF_I + 8); rz[0] = *(const u32x4*)(pr + zoff); rz[1] = *(const u32x4*)(pr + zoff + 8); }
        LDS_BAR();
        float cs[16];
        { float run = 0.f;
#pragma unroll
          for (int i = 0; i < 16; ++i) { run += lfb[(16 * qt + i) * 128 + d]; cs[i] = run; }
          tot[qt * 128 + d] = run; }
        LDS_BAR();
        { const float t0 = tot[d], t1 = tot[128 + d], t2 = tot[256 + d], t3 = tot[384 + d];
          const float bmid = t0 + t1, btot = bmid + t2 + t3; const float base = (qt > 0 ? t0 : 0.f) + (qt > 1 ? t1 : 0.f) + (qt > 2 ? t2 : 0.f);
          if (qt == 0) { gmid[d] = __expf(bmid); gend[d] = __expf(btot - bmid); }
#pragma unroll
          for (int i = 0; i < 16; ++i) { const int tau = 16 * qt + i; const float bt = base + cs[i];
              const float eq = __expf(fminf(bt - bmid, 80.0f)), ek = __expf(fminf(bmid - bt, 80.0f));
              const bf16 qb = (bf16)f2bf(bf1(qs[tau * QP + d]) * eq), kb = (bf16)f2bf(bf1(ks[tau * QP + d]) * ek);
              qs[tau * QP + d] = qb; ks[tau * QP + d] = kb; kT[d * SP + tau] = kb; } }
        LDS_BAR();
        { const f32x4 gm = *(const LAS f32x4*)(gmid + 16 * wave + 4 * fq);
#pragma unroll
          for (int vt = 0; vt < 8; ++vt) { S[vt] = S[vt] * gm; u32x2 o; o.x = pk2(S[vt][0], S[vt][1]); o.y = pk2(S[vt][2], S[vt][3]); *(LAS u32x2*)(sT + (16 * vt + fr) * QP + 16 * wave + 4 * fq) = o; } }
        { const int tt = wave >> 1;
#pragma unroll
          for (int u = 0; u < 2; ++u) { const int sg = 2 * (wave & 1) + u; f32x4 acc = (f32x4){0.f, 0.f, 0.f, 0.f};
              if (sg <= tt) {
#pragma unroll
                  for (int kq = 0; kq < 4; ++kq) { const bf16x8 af = *(const LAS bf16x8*)(ks + (16 * sg + fr) * QP + 32 * kq + 8 * fq), bfm = *(const LAS bf16x8*)(qs + (16 * tt + fr) * QP + 32 * kq + 8 * fq);
                      acc = __builtin_amdgcn_mfma_f32_16x16x32_bf16(af, bfm, acc, 0, 0, 0); }
                  if (sg == tt) {
#pragma unroll
                      for (int j = 0; j < 4; ++j) if (4 * fq + j > fr) acc[j] = 0.f; }
              }
              u32x2 o; o.x = pk2(acc[0], acc[1]); o.y = pk2(acc[2], acc[3]); *(LAS u32x2*)(pl + (16 * tt + fr) * SP + 16 * sg + 4 * fq) = o; } }
        LDS_BAR();
#pragma unroll
        for (int tt = 0; tt < 4; ++tt) { f32x4 acc = (f32x4){0.f, 0.f, 0.f, 0.f};
#pragma unroll
            for (int kq = 0; kq < 2; ++kq) { const bf16x8 af = *(const LAS bf16x8*)(vT + (16 * wave + fr) * SP + 32 * kq + 8 * fq), bfm = *(const LAS bf16x8*)(pl + (16 * tt + fr) * SP + 32 * kq + 8 * fq);
                acc = __builtin_amdgcn_mfma_f32_16x16x32_bf16(af, bfm, acc, 0, 0, 0); }
#pragma unroll
            for (int kq = 0; kq < 4; ++kq) { const bf16x8 af = *(const LAS bf16x8*)(sT + (16 * wave + fr) * QP + 32 * kq + 8 * fq), bfm = *(const LAS bf16x8*)(qs + (16 * tt + fr) * QP + 32 * kq + 8 * fq);
                acc = __builtin_amdgcn_mfma_f32_16x16x32_bf16(af, bfm, acc, 0, 0, 0); }
            const int row = chain_row(dir, b, s0 + 16 * tt + fr);
            u32x2 o; o.x = pk2(acc[0], acc[1]); o.y = pk2(acc[2], acc[3]); *(u32x2*)(OB + ((size_t)dir * MALL + row) * BW + h * 128 + 16 * wave + 4 * fq) = o; }
        { const f32x4 ge = *(const LAS f32x4*)(gend + 16 * wave + 4 * fq);
#pragma unroll
          for (int kq = 0; kq < 2; ++kq) { const bf16x8 af = *(const LAS bf16x8*)(kT + (16 * wave + fr) * SP + 32 * kq + 8 * fq);
#pragma unroll
              for (int vt = 0; vt < 8; ++vt) { const bf16x8 bfm = *(const LAS bf16x8*)(vT + (16 * vt + fr) * SP + 32 * kq + 8 * fq); S[vt] = __builtin_amdgcn_mfma_f32_16x16x32_bf16(af, bfm, S[vt], 0, 0, 0); } }
#pragma unroll
          for (int vt = 0; vt < 8; ++vt) S[vt] = S[vt] * ge; }
        LDS_BAR();
    }
}
__device__ __forceinline__ void hgrn_chain(KArgs a, int l, int cid, LAS unsigned char* lds) {
    const int tid = tid_fresh();
    unsigned char* ws = a->ws;
    const bf16* P = (const bf16*)(ws + WS_P); bf16* OB = (bf16*)(ws + WS_OB);
    const int dir = cid / 48, b = (cid % 48) / 6, h = cid % 6;
    LAS float* tq = (LAS float*)lds;
    LAS float* tk = tq + 16 * 128;
    LAS float* tf = tk + 16 * 128;
    LAS float* tv = tf + 16 * 128;
    LAS float* ot = tv + 16 * 128;
    const int v = tid >> 2, q = tid & 3;
    float S[32];
#pragma unroll
    for (int j = 0; j < 32; ++j) S[j] = 0.f;
    const int sst = tid >> 5, sc4 = (tid & 31) * 4;
    float lb[4];
#pragma unroll
    for (int j = 0; j < 4; ++j) { const int ch = h * 128 + sc4 + j;
        if (l == 0) lb[j] = 0.f; else { const float l0 = a->in[I_LB][((size_t)dir * DEPTH + 0) * BW + ch], l1 = a->in[I_LB][((size_t)dir * DEPTH + 1) * BW + ch]; lb[j] = 1.0f / (1.0f + __expf(l0 - l1)); } }
    for (int s0 = 0; s0 < CTXL + T; s0 += 16) {
        { const int row = chain_row(dir, b, s0 + sst); const bf16* pr = P + (size_t)row * INC + h * 128 + sc4;
          const u32x2 pq = *(const u32x2*)(pr + OFF_Q), pi = *(const u32x2*)(pr + OFF_I), pz = *(const u32x2*)(pr + (dir ? OFF_ZB : OFF_ZF));
          const float qf[4] = {bflo(pq.x), bfhi(pq.x), bflo(pq.y), bfhi(pq.y)}, vf[4] = {bflo(pi.x), bfhi(pi.x), bflo(pi.y), bfhi(pi.y)}, zf[4] = {bflo(pz.x), bfhi(pz.x), bflo(pz.y), bfhi(pz.y)};
          f32x4 oq, ok, of, ov;
#pragma unroll
          for (int j = 0; j < 4; ++j) { const float f = lb[j] + (1.0f - lb[j]) * sigmoidf_(zf[j]); oq[j] = siluf_(qf[j]); of[j] = f; ok[j] = 1.0f - f; ov[j] = vf[j]; }
          *(LAS f32x4*)(tq + sst * 128 + sc4) = oq; *(LAS f32x4*)(tk + sst * 128 + sc4) = ok; *(LAS f32x4*)(tf + sst * 128 + sc4) = of; *(LAS f32x4*)(tv + sst * 128 + sc4) = ov; }
        LDS_BAR();
        for (int st = 0; st < 16; ++st) {
            const float vv = tv[st * 128 + v]; float o0 = 0.f, o1 = 0.f;
#pragma unroll
            for (int j = 0; j < 8; ++j) { const f32x4 fq4 = *(const LAS f32x4*)(tf + st * 128 + q * 32 + 4 * j), kq4 = *(const LAS f32x4*)(tk + st * 128 + q * 32 + 4 * j), qq4 = *(const LAS f32x4*)(tq + st * 128 + q * 32 + 4 * j);
#pragma unroll
                for (int i = 0; i < 4; ++i) { const float sn = fq4[i] * S[4 * j + i] + kq4[i] * vv; S[4 * j + i] = sn; if (i & 1) o1 += qq4[i] * sn; else o0 += qq4[i] * sn; } }
            float o = o0 + o1; o += dpp_xor1(o); o += dpp_xor2(o);
            if (q == 0) ot[st * 128 + v] = o;
        }
        LDS_BAR();
        if (tid < 256) { const int st = tid >> 4, part = tid & 15; const int row = chain_row(dir, b, s0 + st); const LAS float* op = ot + st * 128 + part * 8;
            float f[8];
#pragma unroll
            for (int j = 0; j < 8; ++j) f[j] = op[j];
            *(u32x4*)(OB + ((size_t)dir * MALL + row) * BW + h * 128 + part * 8) = pack8(f); }
    }
    LDS_BAR();
}

__device__ __forceinline__ float grp_sum32(float v) { v += __shfl_xor(v, 1); v += __shfl_xor(v, 2); v += __shfl_xor(v, 4); v += __shfl_xor(v, 8); v += __shfl_xor(v, 16); return v; }
__device__ __forceinline__ float grp_sum16(float v) { v += __shfl_xor(v, 1); v += __shfl_xor(v, 2); v += __shfl_xor(v, 4); v += __shfl_xor(v, 8); return v; }
__device__ __forceinline__ void phase_finalize(KArgs a, int l, bool dry) {
    const int tid_ = tid_fresh(); const int lane = tid_ & 63, wave = tid_ >> 6, gw = blockIdx.x * 8 + wave, NGW = gridDim.x * 8;
    unsigned char* ws = a->ws;
    const bf16* P = (const bf16*)(ws + WS_P); const bf16* PC2 = (const bf16*)(ws + WS_PC2); const bf16* OB = (const bf16*)(ws + WS_OB); const bf16* OC = (const bf16*)(ws + WS_OC); bf16* Y = (bf16*)(ws + WS_Y);
    bf16* Yo = dry ? (bf16*)(ws + WS_END) : Y;
    const int nrows = (l == DEPTH - 1) ? NLAT : MALL;
    const int rpw = (nrows + NGW - 1) / NGW; const int r0 = gw * rpw, r1 = (r0 + rpw < nrows) ? r0 + rpw : nrows;
    f32x4 hng[3], rk[3], gng[3], gnb[3];
#pragma unroll
    for (int k = 0; k < 3; ++k) { const int c = 256 * k + 4 * lane; hng[k] = *(const f32x4*)(a->in[I_HNG] + (size_t)l * BW + c); rk[k] = *(const f32x4*)(a->in[I_RK] + (size_t)l * CW + c);
        gng[k] = *(const f32x4*)(a->in[I_GNGG] + (size_t)l * CW + c); gnb[k] = *(const f32x4*)(a->in[I_GNB] + (size_t)l * CW + c); }
    for (int row = r0; row < r1; ++row) {
        const int orow = dry ? (row & 8191) : row;
        u32x2 bf_[3], bb_[3], bg_[3], cf_[3], cb_[3], cr_[3], ck_[3], cv_[3], cg_[3];
#pragma unroll
        for (int k = 0; k < 3; ++k) { const int c = 256 * k + 4 * lane;
            bf_[k] = *(const u32x2*)(OB + (size_t)row * BW + c); bb_[k] = *(const u32x2*)(OB + ((size_t)MALL + row) * BW + c); bg_[k] = *(const u32x2*)(P + (size_t)row * INC + OFF_OG + c);
            cf_[k] = *(const u32x2*)(OC + (size_t)row * CW + c); cb_[k] = *(const u32x2*)(OC + ((size_t)MALL + row) * CW + c);
            cr_[k] = *(const u32x2*)(PC2 + (size_t)row * PC2W + c); ck_[k] = *(const u32x2*)(PC2 + (size_t)row * PC2W + 768 + c); cv_[k] = *(const u32x2*)(PC2 + (size_t)row * PC2W + 1536 + c);
            cg_[k] = *(const u32x2*)(Y + (size_t)row * D + 1280 + c); }
#pragma unroll
        for (int k = 0; k < 3; ++k) { const int c = 256 * k + 4 * lane;
            { float o[4] = {bflo(bf_[k].x) + bflo(bb_[k].x), bfhi(bf_[k].x) + bfhi(bb_[k].x), bflo(bf_[k].y) + bflo(bb_[k].y), bfhi(bf_[k].y) + bfhi(bb_[k].y)};
              const float ss = grp_sum32((o[0] * o[0] + o[1] * o[1]) + (o[2] * o[2] + o[3] * o[3])); const float rstd = 1.0f / sqrtf(ss * (1.0f / 128.0f) + NORM_EPS);
              const float g4[4] = {bflo(bg_[k].x), bfhi(bg_[k].x), bflo(bg_[k].y), bfhi(bg_[k].y)}; float y[4];
#pragma unroll
              for (int j = 0; j < 4; ++j) y[j] = o[j] * rstd * hng[k][j] * sigmoidf_(g4[j]);
              u32x2 q; q.x = pk2(y[0], y[1]); q.y = pk2(y[2], y[3]); *(u32x2*)(Yo + (size_t)orow * D + 512 + c) = q; }
            { float o[4] = {bflo(cf_[k].x) + bflo(cb_[k].x), bfhi(cf_[k].x) + bfhi(cb_[k].x), bflo(cf_[k].y) + bflo(cb_[k].y), bfhi(cf_[k].y) + bfhi(cb_[k].y)};
              const float r4[4] = {bflo(cr_[k].x), bfhi(cr_[k].x), bflo(cr_[k].y), bfhi(cr_[k].y)}, k4[4] = {bflo(ck_[k].x), bfhi(ck_[k].x), bflo(ck_[k].y), bfhi(ck_[k].y)};
              const float v4[4] = {bflo(cv_[k].x), bfhi(cv_[k].x), bflo(cv_[k].y), bfhi(cv_[k].y)}, g4[4] = {bflo(cg_[k].x), bfhi(cg_[k].x), bflo(cg_[k].y), bfhi(cg_[k].y)};
              const float mean = grp_sum16((o[0] + o[1]) + (o[2] + o[3])) * (1.0f / 64.0f);
              float dl[4]; float sq = 0.f, bs = 0.f;
#pragma unroll
              for (int j = 0; j < 4; ++j) { dl[j] = o[j] - mean; sq += dl[j] * dl[j]; bs += r4[j] * k4[j] * rk[k][j]; }
              const float var = grp_sum16(sq) * (1.0f / 64.0f); const float bonus = grp_sum16(bs); const float rs = 1.0f / sqrtf(var + GN_EPS); float y[4];
#pragma unroll
              for (int j = 0; j < 4; ++j) y[j] = (dl[j] * rs * gng[k][j] + gnb[k][j] + bonus * v4[j]) * g4[j];
              u32x2 q; q.x = pk2(y[0], y[1]); q.y = pk2(y[2], y[3]); *(u32x2*)(Yo + (size_t)orow * D + 1280 + c) = q; }
        }
    }
}

__global__ void __launch_bounds__(NTHREADS, 2) mk_fwd(Args args_unused) {
    extern __shared__ __attribute__((aligned(16))) unsigned char lds_raw[];
    LAS unsigned char* lds = (LAS unsigned char*)lds_raw;
    volatile LAS unsigned* misc = (volatile LAS unsigned*)(lds + LDS_MISC);
    const int tid = threadIdx.x, G = gridDim.x;
    if (tid < 64) misc[tid] = 0u;
    __syncthreads();
    XcdBarrier bar; bar.bar = nullptr; bar.x = 0; bar.st = nullptr;
    int lo, hi;
    { KArgs a = kargs(); lo = a->ph_lo; hi = a->ph_hi; unsigned* ctl = (unsigned*)(a->ws + WS_CTL); bar.bar = ctl + CW_BAR; if (!MK_MULTI) bar = xcd_barrier_post(ctl + CW_BAR, misc + 8); }
    const int cvirt = (G % 8 == 0) ? ((int)blockIdx.x % 8) * (G / 8) + (int)blockIdx.x / 8 : (int)blockIdx.x;
#define IN(k) (lo <= (k) && (k) < hi)
#define PM(b) ((PHMASK >> (b)) & 1)
#define REP(b) _Pragma("unroll 1") for (int rep_ = 0; rep_ < 1 + ((PROBE_DUP >> (b)) & 1); ++rep_)
#define SEAM(k) do { if (!MK_MULTI && IN(k) && IN((k) + 1)) { xcd_barrier(bar); if ((PROBE_DUP >> 13) & 1) xcd_barrier(bar); } } while (0)

    if (PM(0) && IN(0)) REP(0) { phase_prologue(kargs(), lds); } SEAM(0);

#pragma unroll 1
    for (int l = 0; l < DEPTH; ++l) {
        const int pb = 1 + 9 * l;
        const bool lastl = (l == DEPTH - 1);
        if (PM(1) && IN(pb + 0)) { if ((PROBE_DUP >> 1) & 1) { if (l == 0) phase_norm1<0>(kargs(), l, true); else phase_norm1<1>(kargs(), l, true); } if (l == 0) phase_norm1<0>(kargs(), l, false); else phase_norm1<1>(kargs(), l, false); } SEAM(pb + 0);
        if (PM(2) && IN(pb + 1)) REP(2) {
            KArgs a = kargs(); unsigned char* ws = a->ws;
            pg8::Gemm g{(const bf16*)(ws + WS_H), (const bf16*)(ws + WS_WIN) + (size_t)l * INC * D, MALL, INC, D};
            pg8::StaticOrder S; S.init(MALL, INC, G, (int)blockIdx.x);
            pg8::EpiBf16 E{(bf16*)(ws + WS_P), INC};
            pg8::gemm_phase<pg8::EpiBf16, pg8::StaticOrder, true, false>(lds, g, S, E, nullptr);
        } SEAM(pb + 1);
        if (PM(3) && IN(pb + 2)) REP(3) {
            const int ngm = lastl ? 1024 : 1088;
            for (int it = blockIdx.x; it < ngm + 544; it += G) { if (it < ngm) gmlp_item(kargs(), l, it, lds); else rwkv_prep_item(kargs(), l, it - ngm, lds); }
        } SEAM(pb + 2);
        if (PM(4) && IN(pb + 3)) REP(4) {
            if (G == 256) { const int bx = blockIdx.x;
                if (bx < 192) { _Pragma("unroll 1") for (int r2 = 0; r2 < 1 + ((PROBE_DUP >> 12) & 1); ++r2) rwkv_chain(kargs(), bx, lds); }
                else { _Pragma("unroll 1") for (int r2 = 0; r2 < 1 + ((PROBE_DUP >> 11) & 1); ++r2) { hgrn_chain_mfma(kargs(), l, bx - 192, lds); if (bx - 192 < 32) hgrn_chain_mfma(kargs(), l, bx - 192 + 64, lds); } } }
            else { for (int it = blockIdx.x; it < 288; it += G) { if (it < 192) rwkv_chain(kargs(), it, lds); else hgrn_chain_mfma(kargs(), l, it - 192, lds); } }
        } SEAM(pb + 3);
        if (PM(5) && IN(pb + 4)) { if ((PROBE_DUP >> 5) & 1) phase_finalize(kargs(), l, true); phase_finalize(kargs(), l, false); } SEAM(pb + 4);
        if (PM(6) && IN(pb + 5)) REP(6) {
            KArgs a = kargs(); unsigned char* ws = a->ws;
            const int Mo = lastl ? NLAT : MALL;
            pg8::Gemm g{(const bf16*)(ws + WS_Y), (const bf16*)(ws + WS_WOUT) + (size_t)l * D * D, Mo, D, D};
            pg8::StaticOrder S; S.init(Mo, D, G, (int)blockIdx.x);
            const float* xl = l == 0 ? a->in[I_X] : (const float*)(ws + WS_X); const float* xc = l == 0 ? a->in[I_CTX] : (const float*)(ws + WS_X) + (size_t)NLAT * D;
            pg8::EpiResid E{xl, xc, (float*)(ws + WS_X), (const float*)(ws + WS_MOD) + (size_t)l * 9 * 12288 + 2 * D};
            pg8::gemm_phase<pg8::EpiResid, pg8::StaticOrder, true, false>(lds, g, S, E, nullptr);
        } SEAM(pb + 5);
        if (PM(7) && IN(pb + 6)) { if ((PROBE_DUP >> 7) & 1) phase_norm2_router(kargs(), l, true, lds); phase_norm2_router(kargs(), l, false, lds); } SEAM(pb + 6);
        if (PM(8) && IN(pb + 7)) REP(8) {
            KArgs a = kargs(); unsigned char* ws = a->ws;
            moe_tables<false>(a, l, lds, cvirt);
            pg8::Gemm g{(const bf16*)(ws + WS_H), (const bf16*)(ws + WS_WGU) + (size_t)l * NE * 2048 * D, 0, 2048, D};
            pg8::MoeOrder S{(const LAS int*)(lds + LDS_TP), G, cvirt, (unsigned)(2048 * D * 2)};
            pg8::EpiSwiglu E{(bf16*)(ws + WS_ACT)};
            pg8::gemm_phase<pg8::EpiSwiglu, pg8::MoeOrder, false, true>(lds, g, S, E, (const LAS unsigned*)(lds + LDS_TAB));
        } SEAM(pb + 7);
        if (PM(9) && IN(pb + 8)) REP(9) {
            KArgs a = kargs(); unsigned char* ws = a->ws;
            moe_tables<true>(a, l, lds, cvirt);
            pg8::Gemm g{(const bf16*)(ws + WS_ACT), (const bf16*)(ws + WS_WDN) + (size_t)l * NE * D * DE, 0, D, DE};
            pg8::MoeOrder S{(const LAS int*)(lds + LDS_TP), G, cvirt, (unsigned)(D * DE * 2)};
            pg8::EpiDown E{(bf16*)(ws + WS_YK), (const LAS unsigned*)(lds + LDS_TAB), (const LAS float*)(lds + LDS_TABW)};
            pg8::gemm_phase<pg8::EpiDown, pg8::MoeOrder, false, false>(lds, g, S, E, nullptr);
        } SEAM(pb + 8);
    }
    if (PM(10) && IN(1 + 9 * DEPTH)) { if ((PROBE_DUP >> 10) & 1) phase_norm1<2>(kargs(), DEPTH, true); phase_norm1<2>(kargs(), DEPTH, false); }
#undef IN
#undef SEAM
}

extern "C" void kernel_launch(void* const* d_in, const int* in_sizes, int n_in, void* d_out, int out_size, void* d_ws, size_t ws_size, hipStream_t stream) {
    static int grid = 0;
    if (grid == 0) {
        if (n_in != 31 || ws_size < WS_END) { fprintf(stderr, "kernel_launch: unexpected n_in %d / ws %zu (need %zu)\n", n_in, ws_size, (size_t)WS_END); grid = -1; return; }
        int dev = 0, cus = 0, per_cu = 0;
        hipGetDevice(&dev); hipDeviceGetAttribute(&cus, hipDeviceAttributeMultiprocessorCount, dev);
        if (hipFuncSetAttribute((const void*)mk_fwd, hipFuncAttributeMaxDynamicSharedMemorySize, LDS_BYTES) != hipSuccess) { fprintf(stderr, "kernel_launch: hipFuncSetAttribute failed\n"); grid = -1; return; }
        if (hipOccupancyMaxActiveBlocksPerMultiprocessor(&per_cu, (const void*)mk_fwd, NTHREADS, LDS_BYTES) != hipSuccess || per_cu < 1) fprintf(stderr, "kernel_launch: occupancy query says %d\n", per_cu);
        (void)hipGetLastError();
        grid = cus > 0 ? cus : 256;
    }
    if (grid < 0) return;
    hipMemsetAsync((char*)d_ws + WS_CTL, 0, CTL_ZERO_BYTES, stream);
    Args a{};
    for (int i = 0; i < 31; ++i) a.in[i] = (const float*)d_in[i];
    a.out = (float*)d_out; a.ws = (unsigned char*)d_ws;
    constexpr int NPH = 2 + 9 * DEPTH;
#if MK_MULTI
    for (int p = 0; p < NPH; ++p) { a.ph_lo = p; a.ph_hi = p + 1; hipLaunchKernelGGL(mk_fwd, dim3(grid), dim3(NTHREADS), LDS_BYTES, stream, a); }
#else
    a.ph_lo = 0; a.ph_hi = NPH; hipLaunchKernelGGL(mk_fwd, dim3(grid), dim3(NTHREADS), LDS_BYTES, stream, a);
#endif
}
```

```cpp
#include <hip/hip_runtime.h>
#include <cstdio>
#include <cstdint>

#ifndef PHMASK
#define PHMASK 0xFFFF
#endif
#ifndef PROBE_DUP
#define PROBE_DUP 0
#endif
#ifndef MK_MULTI
#define MK_MULTI 0
#endif

#define GAS __attribute__((address_space(1)))
#define LAS __attribute__((address_space(3)))
typedef unsigned short bf16;
typedef short bf16x8 __attribute__((ext_vector_type(8)));
typedef float f32x4 __attribute__((ext_vector_type(4)));
typedef float f32x2 __attribute__((ext_vector_type(2)));
typedef unsigned u32x4 __attribute__((ext_vector_type(4)));
typedef unsigned u32x2 __attribute__((ext_vector_type(2)));

constexpr int D = 2048, NB = 8, T = 4096, CTXL = 256, DEPTH = 2;
constexpr int NLAT = NB * T, NCTX = NB * CTXL, MALL = NLAT + NCTX;
constexpr int INC = 7424;
constexpr int OFF_U = 0, OFF_V = 512, OFF_Q = 1024, OFF_I = 1792, OFF_ZF = 2560, OFF_ZB = 3328, OFF_OG = 4096;
constexpr int OFF_C = 4864;
constexpr int BW = 768, CW = 768, CCOLS = 2560;
constexpr int NE = 16, DE = 1024;
constexpr int PC2W = 7 * 768;
constexpr int NTHREADS = 512;
constexpr float NORM_EPS = 1e-6f, GN_EPS = 64e-5f, DECAY_SCALE = 0.60653065971263342f;

constexpr size_t MiB = 1u << 20;
constexpr size_t WS_CTL = 0, CTL_ZERO_BYTES = 1 * MiB;
constexpr size_t WS_MOD = 1 * MiB;
constexpr size_t WS_SMALLW = 2 * MiB;
constexpr size_t SW_WUP = 0, SW_AUP = SW_WUP + (size_t)2 * 2 * 768 * 64 * 2, SW_GUP = SW_AUP + (size_t)2 * 768 * 64 * 2, SW_GWS = SW_GUP + (size_t)2 * 768 * 128 * 2;
constexpr size_t WS_WIN = 4 * MiB, WS_WOUT = 62 * MiB, WS_WGU = 78 * MiB, WS_WDN = 206 * MiB;
constexpr size_t WS_X = 270 * MiB, WS_H = 542 * MiB, WS_Y = 678 * MiB, WS_P = 814 * MiB, WS_PRE = 1307 * MiB, WS_VT = 1817 * MiB, WS_OC = 1868 * MiB, WS_HQB = 1970 * MiB, WS_END = 2021 * MiB;
constexpr int PRE_REC = 10240, PR_WP = 0, PR_RP = 2048, PR_BK = 4096, PR_ARBK = 8192, PR_MAK = 9216, PR_GAM = 9728, NCHUNK16 = 272;
constexpr size_t WS_OB = WS_H;
constexpr size_t WS_ACT = WS_P, WS_YK = WS_P + 144 * MiB, WS_RIDX = WS_P + 416 * MiB, WS_RW = WS_RIDX + 3 * MiB;
static_assert(WS_RW + 3 * MiB <= WS_PRE, "moe overlay");
constexpr int MAXSLOT_TILES = 288;
constexpr int CW_BAR = 4096;
constexpr int CW_CNT = 16384;

constexpr int LDS_STAGE = 0, LDS_TAB = 131072, LDS_TABW = LDS_TAB + 9 * 1024, LDS_TP = LDS_TABW + 9 * 1024, LDS_MISC = 150528, LDS_BYTES = 152 * 1024;
static_assert(LDS_TP + 128 <= LDS_MISC, "lds map");

__device__ __forceinline__ unsigned f2bf(float f) { unsigned u = __builtin_bit_cast(unsigned, f); return (u + 0x7fffu + ((u >> 16) & 1u)) >> 16; }
__device__ __forceinline__ unsigned pk2(float lo, float hi) { return f2bf(lo) | (f2bf(hi) << 16); }
__device__ __forceinline__ float bflo(unsigned u) { return __builtin_bit_cast(float, u << 16); }
__device__ __forceinline__ float bfhi(unsigned u) { return __builtin_bit_cast(float, u & 0xffff0000u); }
__device__ __forceinline__ float bf1(bf16 b) { return __builtin_bit_cast(float, ((unsigned)b) << 16); }
__device__ __forceinline__ float sigmoidf_(float x) { return __builtin_amdgcn_rcpf(1.0f + __expf(-x)); }
__device__ __forceinline__ float siluf_(float x) { return x * __builtin_amdgcn_rcpf(1.0f + __expf(-x)); }
__device__ __forceinline__ float geluf_(float v) {
    const float av = fabsf(v), t = __builtin_amdgcn_rcpf(av * 0.2316418882f + 1.0f);
    float q = t * 0.5307027145f + (-0.7265760135f); q = q * t + 0.7107068705f; q = q * t + (-0.142248368f); q = q * t + 0.127414796f; q = q * t;
    const float e = __builtin_amdgcn_exp2f((v * v) * (-0.72134752044f)); const float m = v * (q * e); return v < 0.f ? m : v - m; }
__device__ __forceinline__ float wave_sum(float v) {
#pragma unroll
    for (int o = 1; o < 64; o <<= 1) v += __shfl_xor(v, o);
    return v;
}
__device__ __forceinline__ int tid_fresh() { int t = threadIdx.x; asm volatile("" : "+v"(t)); return t; }
__device__ __forceinline__ void unpack8(const u32x4 v, float (&f)[8]) {
    f[0] = bflo(v.x); f[1] = bfhi(v.x); f[2] = bflo(v.y); f[3] = bfhi(v.y); f[4] = bflo(v.z); f[5] = bfhi(v.z); f[6] = bflo(v.w); f[7] = bfhi(v.w);
}
__device__ __forceinline__ u32x4 pack8(const float (&f)[8]) { u32x4 v; v.x = pk2(f[0], f[1]); v.y = pk2(f[2], f[3]); v.z = pk2(f[4], f[5]); v.w = pk2(f[6], f[7]); return v; }
__device__ __forceinline__ int modrow_of(int row) { return row < NLAT ? (row >> 12) : 8; }

#define XB_TMO      128
#define XB_XCNT(j)  (256  + 64 * (j))
#define XB_XSUB(j)  (1280 + 64 * (j))
#define XB_XGEN(j)  (2304 + 64 * (j))
#define XB_TOP      3328
#define XB_TOPGEN   3392
#define XCD_BAR_WORDS 3456
#define XB_SPIN_CAP (1u << 18)
__device__ __forceinline__ unsigned xb_ld(unsigned* p)              { return __hip_atomic_load(p, __ATOMIC_RELAXED, __HIP_MEMORY_SCOPE_AGENT); }
__device__ __forceinline__ unsigned xb_add(unsigned* p, unsigned v) { return __hip_atomic_fetch_add(p, v, __ATOMIC_RELAXED, __HIP_MEMORY_SCOPE_AGENT); }
__device__ __forceinline__ unsigned xb_xcc_id() { return (unsigned)__builtin_amdgcn_s_getreg((3 << 11) | 20) & 0xFu; }
#define XB_SPIN(cond, bar) do { unsigned _sp = 0; while (cond) { __builtin_amdgcn_s_sleep(1); \
    if ((++_sp & 255u) == 0u) { if (xb_ld(&(bar)[XB_TMO])) break; if (_sp > XB_SPIN_CAP) { atomicAdd(&(bar)[XB_TMO], 1u); break; } } } } while (0)
struct XcdBarrier { unsigned* bar; unsigned x; volatile LAS unsigned* st; };
__device__ __forceinline__ XcdBarrier xcd_barrier_post(unsigned* bar, volatile LAS unsigned* st) {
    XcdBarrier b; b.bar = bar; b.x = xb_xcc_id(); b.st = st;
    if (threadIdx.x == 0) (void)xb_add(&bar[XB_XCNT(b.x)], 1u);
    return b;
}
__device__ __forceinline__ void xcd_barrier_complete(unsigned* bar, unsigned x, unsigned& nloc, unsigned& nx) {
    const unsigned G = gridDim.x * gridDim.y * gridDim.z;
    unsigned sum, cnt, mine, sp = 0u;
    for (;;) {
        sum = 0u; cnt = 0u; mine = 0u;
#pragma unroll
        for (unsigned j = 0; j < 16; ++j) { const unsigned c = xb_ld(&bar[XB_XCNT(j)]); sum += c; cnt += (c > 0u) ? 1u : 0u; mine = (j == x) ? c : mine; }
        if (sum == G) break;
        __builtin_amdgcn_s_sleep(1);
        if ((++sp & 255u) == 0u) { if (xb_ld(&bar[XB_TMO])) break; if (sp > XB_SPIN_CAP) { atomicAdd(&bar[XB_TMO], 1u); break; } }
    }
    nloc = mine > 0u ? mine : 1u; nx = cnt > 0u ? cnt : 1u;
}
__device__ __forceinline__ void xcd_barrier(const XcdBarrier& b) {
    asm volatile("s_waitcnt vmcnt(0)" ::: "memory");
    __syncthreads();
    if (threadIdx.x == 0) {
        unsigned* bar = b.bar;
        __builtin_amdgcn_s_waitcnt(0);
        unsigned nloc = b.st[0], nx = b.st[1];
        if (nloc == 0u) { xcd_barrier_complete(bar, b.x, nloc, nx); b.st[0] = nloc; b.st[1] = nx; }
        const unsigned old = xb_add(&bar[XB_XSUB(b.x)], 1u);
        const unsigned gen = old / nloc;
        if (old + 1u == (gen + 1u) * nloc) {
            __builtin_amdgcn_fence(__ATOMIC_RELEASE, "agent");
            asm volatile("s_waitcnt vmcnt(0)" ::: "memory");
            const unsigned og = xb_add(&bar[XB_TOP], 1u);
            const unsigned tg = og / nx;
            if (og + 1u == (tg + 1u) * nx) xb_add(&bar[XB_TOPGEN], 1u);
            else XB_SPIN(xb_ld(&bar[XB_TOPGEN]) == tg, bar);
            __builtin_amdgcn_fence(__ATOMIC_ACQUIRE, "agent");
            xb_add(&bar[XB_XGEN(b.x)], 1u);
            asm volatile("s_waitcnt vmcnt(0)" ::: "memory");
        } else {
            XB_SPIN(xb_ld(&bar[XB_XGEN(b.x)]) == gen, bar);
            __builtin_amdgcn_fence(__ATOMIC_ACQUIRE, "agent");
            asm volatile("s_waitcnt vmcnt(0)" ::: "memory");
        }
    }
    __syncthreads();
}

namespace pg8 {
constexpr int BM = 256, BK = 64, HALF = 128, HTB = HALF * BK * 2, STAGE_BYTES = 8 * HTB, NXCD = 8, WGM = 8;
__host__ __device__ __forceinline__ int lds_byte(int r, int c) { const int st = (r >> 4) * 2 + (c >> 5), rr = r & 15, cc = c & 31, ob = rr * 64 + cc * 2; return st * 1024 + (ob ^ (((ob >> 9) & 1) << 5)); }
__host__ __device__ __forceinline__ void stage_rc(int b, int& R, int& C) { const int st = b / 1024, sb = b % 1024, swz = sb ^ (((sb >> 9) & 1) << 5); R = (st >> 1) * 16 + swz / 64; C = (st & 1) * 32 + (swz % 64) / 2; }
__host__ __device__ __forceinline__ int perm32(int rho) { const int n = rho >> 4, i = rho & 15; return 8 * (i >> 2) + 4 * n + (i & 3); }

struct Unit { int pm, pn, e, aux; };
struct Gemm { const bf16* A; const bf16* Bt; int M, N, K; };

struct StaticOrder {
    int nM, nN, nwg, G, c;
    __device__ void init(int M, int N, int G_, int c_) { nM = M / BM; nN = N / BM; nwg = nM * nN; G = G_; c = c_; }
    __device__ bool next(int i, Unit& u) const {
        const long L = (long)i * G + c; if (L >= nwg) return false;
        int wgid = (int)L; { const int q = nwg / NXCD, r = nwg % NXCD, xcd = wgid % NXCD, off = wgid / NXCD; wgid = (xcd < r ? xcd * (q + 1) : r * (q + 1) + (xcd - r) * q) + off; }
        const int nig = WGM * nN, gid = wgid / nig, fm = gid * WGM, gsz = (nM - fm) < WGM ? (nM - fm) : WGM;
        u.pm = fm + ((wgid % nig) % gsz); u.pn = (wgid % nig) / gsz; u.e = 0; u.aux = 0; return true;
    }
    __device__ __forceinline__ unsigned b_off(const Unit& u, unsigned tstep) const { return (unsigned)u.pn * tstep; }
};
struct MoeOrder {
    const LAS int* tp; int G, c; unsigned estride;
    __device__ bool next(int i, Unit& u) const {
        const int L = i * G + c; const int ntot = tp[16] * 8; if (L >= ntot) return false;
        const int tile = L >> 3; int e = 0;
#pragma unroll
        for (int j = 1; j < 16; ++j) e += (tile >= tp[j]) ? 1 : 0;
        u.pm = tile; u.pn = L & 7; u.e = e; u.aux = i; return true;
    }
    __device__ __forceinline__ unsigned b_off(const Unit& u, unsigned tstep) const { return (unsigned)u.e * estride + (unsigned)u.pn * tstep; }
};

#define PG8_LAS __attribute__((address_space(3)))
template <class Epi, class Sched, bool ALIGN_EPI, bool GATHER>
__device__ __forceinline__ void gemm_phase(PG8_LAS unsigned char* lds, const Gemm g, const Sched& S, const Epi& E, const PG8_LAS unsigned* tabA) {
    const int tid = tid_fresh(), wid = __builtin_amdgcn_readfirstlane(tid >> 6), lane = tid & 63, wr = wid >> 2, wc = wid & 3, fr = lane & 15, fq = lane >> 4;
    const int K = g.K, nt = K / BK;
    int sR[2], sC[2];
    unsigned voffB[2];
#pragma unroll
    for (int i = 0; i < 2; ++i) { int R, C; stage_rc(tid * 16 + i * 8192, R, C); sR[i] = R; sC[i] = C; const int Rb = Epi::PERM ? ((R & ~31) + perm32(R & 31)) : R;
        voffB[i] = (unsigned)(Rb * K + C) * 2u; }
    const unsigned kstep = (unsigned)(BK * 2);
    const unsigned hstep = (unsigned)(HALF * K * 2);
    const unsigned tstep = 2u * hstep;
    const unsigned ldsw = (unsigned)wid * 1024u;
    const char* const baseA = (const char*)g.A; const char* const baseB = (const char*)g.Bt;
    const int aoff = lds_byte(wr * 64 + fr, fq * 8), boff = lds_byte(wc * 32 + fr, fq * 8);
#define PG8_SA(b, h) (((b) * 2 + (h)) * HTB)
#define PG8_SB(b, h) ((4 + (b) * 2 + (h)) * HTB)
#define PG8_STAGE(bufoff, gbase, uoff, voff) do { _Pragma("unroll") for (int _i = 0; _i < 2; ++_i) \
        __builtin_amdgcn_global_load_lds((const unsigned*)((gbase) + (size_t)(unsigned)((uoff) + (voff)[_i])), (PG8_LAS unsigned*)(lds + (bufoff) + ldsw + _i * 8192), 16, 0, 0); } while (0)
#define PG8_LDA(dst, b, h) do { _Pragma("unroll") for (int m = 0; m < 4; ++m) _Pragma("unroll") for (int k = 0; k < 2; ++k) dst[m][k] = *(const PG8_LAS bf16x8*)(lds + PG8_SA(b, h) + aoff + m * 2048 + k * 1024); } while (0)
#define PG8_LDB(dst, b, h) do { _Pragma("unroll") for (int n = 0; n < 2; ++n) _Pragma("unroll") for (int k = 0; k < 2; ++k) dst[n][k] = *(const PG8_LAS bf16x8*)(lds + PG8_SB(b, h) + boff + n * 2048 + k * 1024); } while (0)
#define PG8_MMA(ai, bj, At, Bt) do { __builtin_amdgcn_s_setprio(1); _Pragma("unroll") for (int m = 0; m < 4; ++m) _Pragma("unroll") for (int n = 0; n < 2; ++n) _Pragma("unroll") for (int k = 0; k < 2; ++k) \
        acc[ai][bj][m][n] = __builtin_amdgcn_mfma_f32_16x16x32_bf16(Bt[n][k], At[m][k], acc[ai][bj][m][n], 0, 0, 0); __builtin_amdgcn_s_setprio(0); } while (0)
#define PG8_WAIT_V(n) asm volatile("s_waitcnt vmcnt(" #n ")" ::: "memory")
#define PG8_WAIT_L(n) asm volatile("s_waitcnt lgkmcnt(" #n ")" ::: "memory")
#define PG8_BAR __builtin_amdgcn_s_barrier()
#define PG8_SCHED __builtin_amdgcn_sched_barrier(0)
    Unit cur, nxt; int ui = 0;
    if (!S.next(0, cur)) return;
    f32x4 acc[2][2][4][2];
#pragma unroll
    for (int a = 0; a < 2; ++a)
#pragma unroll
        for (int b = 0; b < 2; ++b)
#pragma unroll
            for (int m = 0; m < 4; ++m)
#pragma unroll
                for (int n = 0; n < 2; ++n) acc[a][b][m][n] = (f32x4){0.f, 0.f, 0.f, 0.f};
    bf16x8 At[4][2], B0[2][2], B1[2][2];
    unsigned vA0[2], vA1[2], nA0[2], nA1[2];
    unsigned uA, uB = S.b_off(cur, tstep);
    if constexpr (GATHER) { uA = 0u;
#pragma unroll
        for (int i = 0; i < 2; ++i) { vA0[i] = tabA[cur.aux * 256 + sR[i]] + (unsigned)sC[i] * 2u; vA1[i] = tabA[cur.aux * 256 + 128 + sR[i]] + (unsigned)sC[i] * 2u; }
    } else { uA = (unsigned)cur.pm * tstep;
#pragma unroll
        for (int i = 0; i < 2; ++i) { vA0[i] = (unsigned)(sR[i] * K + sC[i]) * 2u; vA1[i] = vA0[i] + hstep; }
    }
    PG8_STAGE(PG8_SB(0, 0), baseB, uB, voffB); PG8_STAGE(PG8_SB(0, 1), baseB, uB + hstep, voffB); PG8_STAGE(PG8_SA(0, 0), baseA, uA, vA0); PG8_STAGE(PG8_SA(0, 1), baseA, uA, vA1);
    if (wr == 1) PG8_BAR;
    PG8_WAIT_V(2); PG8_BAR;
    PG8_STAGE(PG8_SB(1, 0), baseB, uB + kstep, voffB); PG8_STAGE(PG8_SA(1, 0), baseA, uA + kstep, vA0); PG8_STAGE(PG8_SB(1, 1), baseB, uB + hstep + kstep, voffB);
    PG8_WAIT_V(6); PG8_BAR;
    for (;;) {
        const bool has_next = S.next(ui + 1, nxt);
        unsigned nuA, nuB = has_next ? S.b_off(nxt, tstep) : uB;
        if constexpr (GATHER) { nuA = 0u;
#pragma unroll
            for (int i = 0; i < 2; ++i) { if (has_next) { nA0[i] = tabA[nxt.aux * 256 + sR[i]] + (unsigned)sC[i] * 2u; nA1[i] = tabA[nxt.aux * 256 + 128 + sR[i]] + (unsigned)sC[i] * 2u; } else { nA0[i] = vA0[i]; nA1[i] = vA1[i]; } }
        } else { nuA = has_next ? (unsigned)nxt.pm * tstep : uA;
#pragma unroll
            for (int i = 0; i < 2; ++i) { nA0[i] = vA0[i]; nA1[i] = vA1[i]; }
        }
        for (int t = 0; t < nt; t += 2) {
            const bool last = (t == nt - 2);
            const unsigned a1 = uA + (unsigned)(t + 1) * kstep;
            const unsigned a2 = last ? nuA : uA + (unsigned)(t + 2) * kstep; const unsigned b2 = last ? nuB : uB + (unsigned)(t + 2) * kstep;
            const unsigned a3 = a2 + kstep; const unsigned b3 = b2 + kstep;
            unsigned w0[2], w1[2];
#pragma unroll
            for (int i = 0; i < 2; ++i) { w0[i] = (GATHER && last) ? nA0[i] : vA0[i]; w1[i] = (GATHER && last) ? nA1[i] : vA1[i]; }
            PG8_LDB(B0, 0, 0); PG8_LDB(B1, 0, 1); PG8_SCHED; PG8_LDA(At, 0, 0); PG8_STAGE(PG8_SA(1, 1), baseA, a1, vA1);
            PG8_WAIT_V(8); PG8_WAIT_L(0); PG8_BAR; PG8_MMA(0, 0, At, B0); PG8_MMA(0, 1, At, B1); PG8_BAR; PG8_SCHED;
            PG8_LDA(At, 0, 1); PG8_STAGE(PG8_SB(0, 0), baseB, b2, voffB); PG8_STAGE(PG8_SB(0, 1), baseB, b2 + hstep, voffB); PG8_STAGE(PG8_SA(0, 0), baseA, a2, w0);
            PG8_WAIT_V(8); PG8_WAIT_L(0); PG8_BAR; PG8_MMA(1, 0, At, B0); PG8_MMA(1, 1, At, B1); PG8_BAR; PG8_SCHED;
            PG8_LDB(B0, 1, 0); PG8_LDB(B1, 1, 1); PG8_SCHED; PG8_LDA(At, 1, 0); PG8_STAGE(PG8_SA(0, 1), baseA, a2, w1);
            PG8_WAIT_V(8); PG8_WAIT_L(0); PG8_BAR; PG8_MMA(0, 0, At, B0); PG8_MMA(0, 1, At, B1); PG8_BAR; PG8_SCHED;
            PG8_LDA(At, 1, 1); PG8_STAGE(PG8_SB(1, 0), baseB, b3, voffB); PG8_STAGE(PG8_SB(1, 1), baseB, b3 + hstep, voffB); PG8_STAGE(PG8_SA(1, 0), baseA, a3, w0);
            PG8_WAIT_V(8); PG8_WAIT_L(0); PG8_BAR; PG8_MMA(1, 0, At, B0); PG8_MMA(1, 1, At, B1); PG8_BAR; PG8_SCHED;
        }
        if constexpr (ALIGN_EPI) { if (wr == 0) PG8_BAR; }
        E(acc, cur, wr, wc, fr, fq);
        if (!has_next) break;
#pragma unroll
        for (int a = 0; a < 2; ++a)
#pragma unroll
            for (int b = 0; b < 2; ++b)
#pragma unroll
                for (int m = 0; m < 4; ++m)
#pragma unroll
                    for (int n = 0; n < 2; ++n) acc[a][b][m][n] = (f32x4){0.f, 0.f, 0.f, 0.f};
        cur = nxt; uA = nuA; uB = nuB; ++ui;
#pragma unroll
        for (int i = 0; i < 2; ++i) { vA0[i] = nA0[i]; vA1[i] = nA1[i]; }
        if constexpr (ALIGN_EPI) { if (wr == 1) PG8_BAR; }
    }
    PG8_WAIT_V(0);
    if constexpr (!ALIGN_EPI) { if (wr == 0) PG8_BAR; }
    PG8_BAR;
#undef PG8_SA
#undef PG8_SB
#undef PG8_STAGE
#undef PG8_LDA
#undef PG8_LDB
#undef PG8_MMA
#undef PG8_WAIT_V
#undef PG8_WAIT_L
#undef PG8_BAR
#undef PG8_SCHED
}

__device__ __forceinline__ unsigned cvt_pk_bf16(float lo, float hi) { unsigned r; asm volatile("v_cvt_pk_bf16_f32 %0, %1, %2" : "=v"(r) : "v"(lo), "v"(hi)); return r; }

struct EpiBf16 {
    static constexpr bool PERM = true;
    bf16* O; int ldc;
    __device__ __forceinline__ void operator()(const f32x4 (&acc)[2][2][4][2], const Unit& u, int wr, int wc, int fr, int fq) const {
        const int row0 = u.pm * BM + wr * 64 + fr; const int col0 = u.pn * BM + wc * 32 + 8 * fq;
#pragma unroll
        for (int ai = 0; ai < 2; ++ai)
#pragma unroll
            for (int m = 0; m < 4; ++m) { bf16* rowp = O + (size_t)(row0 + ai * HALF + m * 16) * ldc + col0;
#pragma unroll
                for (int bj = 0; bj < 2; ++bj) { const f32x4 v0 = acc[ai][bj][m][0], v1 = acc[ai][bj][m][1];
                    u32x4 w; w.x = cvt_pk_bf16(v0[0], v0[1]); w.y = cvt_pk_bf16(v0[2], v0[3]); w.z = cvt_pk_bf16(v1[0], v1[1]); w.w = cvt_pk_bf16(v1[2], v1[3]);
                    *(u32x4*)(rowp + bj * HALF) = w; } }
    }
};
struct EpiResid {
    static constexpr bool PERM = false;
    const float* xl; const float* xc; float* out; const float* gate;
    __device__ __forceinline__ void operator()(const f32x4 (&acc)[2][2][4][2], const Unit& u, int wr, int wc, int fr, int fq) const {
        const int rt = u.pm * BM; const bool isl = rt < NLAT;
        const float* base = isl ? xl + (size_t)rt * D : xc + (size_t)(rt - NLAT) * D;
        const float* gp = gate + (size_t)(isl ? (rt >> 12) : 8) * 12288;
        const int rl0 = wr * 64 + fr, col0 = u.pn * BM + wc * 32 + 4 * fq;
#pragma unroll
        for (int ai = 0; ai < 2; ++ai)
#pragma unroll
            for (int m = 0; m < 4; ++m) { const int rl = rl0 + ai * HALF + m * 16; const float* bp = base + (size_t)rl * D + col0; float* op = out + (size_t)(rt + rl) * D + col0;
#pragma unroll
                for (int bj = 0; bj < 2; ++bj)
#pragma unroll
                    for (int n = 0; n < 2; ++n) { const f32x4 b = *(const f32x4*)(bp + bj * HALF + n * 16); const f32x4 gv = *(const f32x4*)(gp + col0 + bj * HALF + n * 16); *(f32x4*)(op + bj * HALF + n * 16) = b + gv * acc[ai][bj][m][n]; }
                asm volatile("" ::: "memory"); }
    }
};
struct EpiSwiglu {
    static constexpr bool PERM = true;
    bf16* O;
    __device__ __forceinline__ void operator()(const f32x4 (&acc)[2][2][4][2], const Unit& u, int wr, int wc, int fr, int fq) const {
        const int row0 = u.pm * BM + wr * 64 + fr; const int col0 = u.pn * 128 + wc * 32 + 8 * fq;
#pragma unroll
        for (int ai = 0; ai < 2; ++ai)
#pragma unroll
            for (int m = 0; m < 4; ++m) { bf16* rowp = O + (size_t)(row0 + ai * HALF + m * 16) * DE + col0;
                float o[8];
#pragma unroll
                for (int n = 0; n < 2; ++n)
#pragma unroll
                    for (int j = 0; j < 4; ++j) { const float gt = acc[ai][0][m][n][j], up = acc[ai][1][m][n][j]; o[n * 4 + j] = gt * __builtin_amdgcn_rcpf(1.0f + __expf(-gt)) * up; }
                u32x4 w; w.x = cvt_pk_bf16(o[0], o[1]); w.y = cvt_pk_bf16(o[2], o[3]); w.z = cvt_pk_bf16(o[4], o[5]); w.w = cvt_pk_bf16(o[6], o[7]);
                *(u32x4*)rowp = w; }
    }
};
struct EpiDown {
    static constexpr bool PERM = true;
    bf16* YK; const PG8_LAS unsigned* tab; const PG8_LAS float* tabw;
    __device__ __forceinline__ void operator()(const f32x4 (&acc)[2][2][4][2], const Unit& u, int wr, int wc, int fr, int fq) const {
        const int rl0 = wr * 64 + fr; const int col0 = u.pn * BM + wc * 32 + 8 * fq;
#pragma unroll
        for (int ai = 0; ai < 2; ++ai)
#pragma unroll
            for (int m = 0; m < 4; ++m) { const int rl = rl0 + ai * HALF + m * 16; const unsigned ent = tab[u.aux * 256 + rl]; const float w = tabw[u.aux * 256 + rl];
                if (!(ent & 0x40000000u)) { bf16* rowp = YK + ((size_t)(ent >> 31) * MALL + (ent & 0xffffu)) * D + col0;
#pragma unroll
                    for (int bj = 0; bj < 2; ++bj) { const f32x4 v0 = acc[ai][bj][m][0] * w, v1 = acc[ai][bj][m][1] * w;
                        u32x4 q; q.x = cvt_pk_bf16(v0[0], v0[1]); q.y = cvt_pk_bf16(v0[2], v0[3]); q.z = cvt_pk_bf16(v1[0], v1[1]); q.w = cvt_pk_bf16(v1[2], v1[3]);
                        *(u32x4*)(rowp + bj * HALF) = q; } }
                asm volatile("" ::: "memory"); }
    }
};
}

struct Args { const float* in[31]; float* out; unsigned char* ws; int ph_lo, ph_hi; };
typedef const __attribute__((address_space(4))) Args* KArgs;
__device__ __forceinline__ KArgs kargs() { KArgs p = (KArgs)__builtin_amdgcn_kernarg_segment_ptr(); asm volatile("" : "+s"(p)); return p; }
#define AIN(i) (a->in[i])
enum { I_X = 0, I_C, I_CTX, I_CCTX, I_ADAW, I_ADAB, I_N1G, I_N2G, I_WIN, I_WOUT, I_GNG, I_GWS, I_GB, I_LB, I_HNG, I_MU, I_W0, I_WUP, I_A0, I_AUP, I_GUP, I_KK, I_KA, I_RK, I_GNGG, I_GNB, I_RW, I_RB, I_WGU, I_WDN, I_FNG };

__device__ __forceinline__ void p0_transpose_item(const float* W, int K, int N, bf16* WT, int n_row0, LAS float* scr, int kb, int nb, int lane) {
    const int k0 = 64 * kb, n0 = 32 * nb;
#pragma unroll 8
    for (int i = 0; i < 32; ++i) { const int kk = 2 * i + (lane >> 5); scr[kk * 33 + (lane & 31)] = W[(size_t)(k0 + kk) * N + n0 + (lane & 31)]; }
    asm volatile("s_waitcnt lgkmcnt(0)" ::: "memory");
    const int c = lane & 7;
#pragma unroll
    for (int j = 0; j < 4; ++j) { const int n = (lane >> 3) + 8 * j; const LAS float* s = scr + (8 * c) * 33 + n;
        u32x4 o; o.x = pk2(s[0 * 33], s[1 * 33]); o.y = pk2(s[2 * 33], s[3 * 33]); o.z = pk2(s[4 * 33], s[5 * 33]); o.w = pk2(s[6 * 33], s[7 * 33]);
        *(u32x4*)(WT + (size_t)(n_row0 + n) * K + k0 + 8 * c) = o; }
    asm volatile("s_waitcnt lgkmcnt(0)" ::: "memory");
}

__device__ __forceinline__ void convert_moe(KArgs a, int l, LAS unsigned char* lds) {
    const int tid = tid_fresh(), lane = tid & 63, wave = tid >> 6;
    const int gw = blockIdx.x * 8 + wave, NGW = gridDim.x * 8;
    unsigned char* ws = a->ws;
    LAS float* scr = (LAS float*)(lds + wave * 16384);
    constexpr int I_GU = 32 * 64, I_DN = 16 * 64, N2 = 16 * I_GU, N3 = N2 + 16 * I_DN;
    for (int it = gw; it < N3; it += NGW) {
        if (it < N2) { const int e = it / I_GU, r = it % I_GU, kb = r / 64, nb = r % 64;
            const int n0 = 32 * nb, hh = n0 >> 10, nn = n0 & 1023, row0 = 256 * (nn >> 7) + 128 * hh + (nn & 127);
            p0_transpose_item(a->in[I_WGU] + (size_t)(l * NE + e) * D * 2048, D, 2048, (bf16*)(ws + WS_WGU) + (size_t)e * 2048 * D, row0, scr, kb, nb, lane); }
        else { const int q = it - N2, e = q / I_DN, r = q % I_DN, kb = r / 64, nb = r % 64;
            p0_transpose_item(a->in[I_WDN] + (size_t)(l * NE + e) * DE * D, DE, D, (bf16*)(ws + WS_WDN) + (size_t)e * D * DE, 32 * nb, scr, kb, nb, lane); }
    }
}
__device__ __forceinline__ void phase_prologue(KArgs a, LAS unsigned char* lds) {
    const int tid = tid_fresh(), lane = tid & 63, wave = tid >> 6;
    const int G = gridDim.x, gw = blockIdx.x * 8 + wave, NGW = G * 8;
    unsigned char* ws = a->ws;
    LAS float* scr = (LAS float*)(lds + wave * 16384);
    constexpr int I_IN = 32 * 232, I_OUT = 32 * 64;
    constexpr int N0 = 2 * I_IN, N1 = N0 + 2 * I_OUT;
    for (int it = gw; it < N1; it += NGW) {
        if (it < N0) { const int l = it / I_IN, r = it % I_IN, kb = r / 232, nb = r % 232;
            p0_transpose_item(a->in[I_WIN] + (size_t)l * D * INC, D, INC, (bf16*)(ws + WS_WIN) + (size_t)l * INC * D, 32 * nb, scr, kb, nb, lane); }
        else { const int q = it - N0, l = q / I_OUT, r = q % I_OUT, kb = r / 64, nb = r % 64;
            p0_transpose_item(a->in[I_WOUT] + (size_t)l * D * D, D, D, (bf16*)(ws + WS_WOUT) + (size_t)l * D * D, 32 * nb, scr, kb, nb, lane); }
    }
    convert_moe(a, 0, lds);
    {
        const int gt = blockIdx.x * NTHREADS + tid, NGT = G * NTHREADS;
        bf16* wup = (bf16*)(ws + WS_SMALLW + SW_WUP); bf16* aup = (bf16*)(ws + WS_SMALLW + SW_AUP); bf16* gup = (bf16*)(ws + WS_SMALLW + SW_GUP); bf16* gws = (bf16*)(ws + WS_SMALLW + SW_GWS);
        for (int i = gt; i < 2 * 2 * 768 * 64; i += NGT) { const int k = i & 63, n = (i >> 6) % 768, ld = i / (768 * 64); wup[i] = (bf16)f2bf(a->in[I_WUP][((size_t)ld * 64 + k) * 768 + n]); }
        for (int i = gt; i < 2 * 768 * 64; i += NGT) { const int k = i & 63, n = (i >> 6) % 768, l = i / (768 * 64); aup[i] = (bf16)f2bf(a->in[I_AUP][((size_t)l * 64 + k) * 768 + n]); }
        for (int i = gt; i < 2 * 768 * 128; i += NGT) { const int k = i & 127, n = (i >> 7) % 768, l = i / (768 * 128); gup[i] = (bf16)f2bf(a->in[I_GUP][((size_t)l * 128 + k) * 768 + n]); }
        for (int i = gt; i < 2 * 4 * 128 * 128; i += NGT) gws[i] = (bf16)f2bf(a->in[I_GWS][i]);
    }
    __syncthreads();
    {
        LAS float* sv = (LAS float*)lds;
        LAS float* red = (LAS float*)(lds + 73728);
        for (int i = tid; i < 9 * D; i += NTHREADS) { const int r = i / D, k = i % D; const float v = r < 8 ? a->in[I_C][r * D + k] : a->in[I_CCTX][k]; sv[i] = siluf_(v); }
        __syncthreads();
        float* mod = (float*)(ws + WS_MOD);
        for (int it = blockIdx.x; it < 2 * 96; it += G) {
            const int l = it / 96, cb = it % 96, cq = tid & 31, kg = tid >> 5;
            const float* wp = a->in[I_ADAW] + (size_t)l * D * 12288 + (size_t)(kg * 128) * 12288 + cb * 128 + cq * 4;
            f32x4 acc[9];
#pragma unroll
            for (int r = 0; r < 9; ++r) acc[r] = (f32x4){0.f, 0.f, 0.f, 0.f};
#pragma unroll 4
            for (int k = 0; k < 128; ++k) { const f32x4 w = *(const f32x4*)(wp + (size_t)k * 12288);
#pragma unroll
                for (int r = 0; r < 9; ++r) acc[r] += w * sv[r * D + kg * 128 + k]; }
#pragma unroll
            for (int r = 0; r < 9; ++r) *(LAS f32x4*)(red + ((kg * 9 + r) * 128 + cq * 4)) = acc[r];
            __syncthreads();
            for (int o = tid; o < 9 * 128; o += NTHREADS) { const int r = o / 128, c = o % 128; float s = a->in[I_ADAB][(size_t)l * 12288 + cb * 128 + c];
#pragma unroll
                for (int q = 0; q < 16; ++q) s += red[(q * 9 + r) * 128 + c];
                mod[((size_t)l * 9 + r) * 12288 + cb * 128 + c] = s; }
            __syncthreads();
        }
    }
}

template <int MODE>
__device__ __forceinline__ void phase_norm1(KArgs a, int l, bool dry) {
    const int tid_ = tid_fresh(); const int lane = tid_ & 63, wave = tid_ >> 6, gw = blockIdx.x * 8 + wave, NGW = gridDim.x * 8;
    unsigned char* ws = a->ws;
    const float* mod = (const float*)(ws + WS_MOD);
    float* X = (float*)(ws + WS_X); bf16* H = (bf16*)(ws + WS_H); const bf16* YK = (const bf16*)(ws + WS_YK);
    float* Xo = dry ? (float*)(ws + WS_END) : X; bf16* Ho = dry ? (bf16*)(ws + WS_END) : H; float* Oo = dry ? (float*)(ws + WS_END) : a->out;
    const int nrows = (MODE == 2) ? NLAT : MALL;
    const int rpw = (nrows + NGW - 1) / NGW; const int r0 = gw * rpw, r1 = (r0 + rpw < nrows) ? r0 + rpw : nrows;
    f32x4 ck[8], cs[8], cg[8]; int cur_mr = -1;
    for (int row = r0; row < r1; ++row) {
        const int mr = modrow_of(row); const int orow = dry ? (row & 2047) : row;
        if (mr != cur_mr) { cur_mr = mr;
#pragma unroll
            for (int j = 0; j < 8; ++j) { const int c = 4 * lane + 256 * j;
                if (MODE == 2) ck[j] = *(const f32x4*)(a->in[I_FNG] + c);
                else { const float* m = mod + ((size_t)l * 9 + mr) * 12288; const f32x4 g = *(const f32x4*)(a->in[I_N1G] + (size_t)l * D + c); ck[j] = g * (*(const f32x4*)(m + D + c) + 1.0f); cs[j] = *(const f32x4*)(m + c); }
                if (MODE != 0) cg[j] = *(const f32x4*)(mod + ((size_t)(l - 1) * 9 + mr) * 12288 + 5 * D + c); } }
        f32x4 v[8];
        if (MODE == 0) { const float* xr = row < NLAT ? a->in[I_X] + (size_t)row * D : a->in[I_CTX] + (size_t)(row - NLAT) * D;
#pragma unroll
            for (int j = 0; j < 8; ++j) v[j] = *(const f32x4*)(xr + 4 * lane + 256 * j);
        } else {
            const float* xr = X + (size_t)row * D; const bf16* y0 = YK + (size_t)row * D; const bf16* y1 = YK + ((size_t)MALL + row) * D;
            u32x2 p0[8], p1[8];
#pragma unroll
            for (int j = 0; j < 8; ++j) { const int c = 4 * lane + 256 * j; v[j] = *(const f32x4*)(xr + c); p0[j] = *(const u32x2*)(y0 + c); p1[j] = *(const u32x2*)(y1 + c); }
#pragma unroll
            for (int j = 0; j < 8; ++j) { f32x4 f; f[0] = bflo(p0[j].x) + bflo(p1[j].x); f[1] = bfhi(p0[j].x) + bfhi(p1[j].x); f[2] = bflo(p0[j].y) + bflo(p1[j].y); f[3] = bfhi(p0[j].y) + bfhi(p1[j].y);
                v[j] = v[j] + cg[j] * f; }
            if (MODE == 1) {
#pragma unroll
                for (int j = 0; j < 8; ++j) *(f32x4*)(Xo + (size_t)orow * D + 4 * lane + 256 * j) = v[j];
            }
        }
        float ss = 0.f;
#pragma unroll
        for (int j = 0; j < 8; ++j) ss += (v[j][0] * v[j][0] + v[j][1] * v[j][1]) + (v[j][2] * v[j][2] + v[j][3] * v[j][3]);
        const float rstd = 1.0f / sqrtf(wave_sum(ss) * (1.0f / D) + NORM_EPS);
        if (MODE == 2) {
#pragma unroll
            for (int j = 0; j < 8; ++j) *(f32x4*)(Oo + (size_t)orow * D + 4 * lane + 256 * j) = v[j] * rstd * ck[j];
        } else {
#pragma unroll
            for (int j = 0; j < 8; ++j) { const f32x4 h = v[j] * rstd * ck[j] + cs[j]; u32x2 o; o.x = pk2(h[0], h[1]); o.y = pk2(h[2], h[3]); *(u32x2*)(Ho + (size_t)orow * D + 4 * lane + 256 * j) = o; }
        }
    }
}

__device__ __forceinline__ void phase_norm2_router(KArgs a, int l, bool dry, LAS unsigned char* lds) {
    const int tid_ = tid_fresh(); const int lane = tid_ & 63, wave = tid_ >> 6, gw = blockIdx.x * 8 + wave, NGW = gridDim.x * 8;
    unsigned char* ws = a->ws;
    const float* mod = (const float*)(ws + WS_MOD);
    const float* X = (const float*)(ws + WS_X); bf16* H = (bf16*)(ws + WS_H);
    unsigned* cnt = (unsigned*)(ws + WS_CTL) + CW_CNT + l * 16 * 64 + (dry ? 4096 : 0);
    unsigned* ridx = (unsigned*)(ws + (dry ? WS_END : WS_RIDX)); float* rwt = (float*)(ws + (dry ? WS_END + 4 * MiB : WS_RW)); bf16* Ho = dry ? (bf16*)(ws + WS_END + 8 * MiB) : H;
    const int nrows = (l == DEPTH - 1) ? NLAT : MALL;
    LAS f32x4* rwl = (LAS f32x4*)lds;
    { const float* rw = a->in[I_RW];
      for (int idx = tid_; idx < 8192; idx += NTHREADS) { const int ln = idx & 63, q = (idx >> 6) & 3, i = (idx >> 8) & 3, j = idx >> 10; rwl[idx] = *(const f32x4*)(rw + (size_t)(4 * ln + 256 * j + i) * 16 + 4 * q); } }
    __syncthreads();
    const int rpw = (nrows + NGW - 1) / NGW; const int r0 = gw * rpw, r1 = (r0 + rpw < nrows) ? r0 + rpw : nrows;
    f32x4 ck[8], cs[8]; int cur_mr = -1;
    float rb[16];
#pragma unroll
    for (int e = 0; e < 16; ++e) rb[e] = a->in[I_RB][e];
    for (int row = r0; row < r1; ++row) {
        const int mr = modrow_of(row); const int orow = dry ? (row & 2047) : row;
        if (mr != cur_mr) { cur_mr = mr; const float* m = mod + ((size_t)l * 9 + mr) * 12288;
#pragma unroll
            for (int j = 0; j < 8; ++j) { const int c = 4 * lane + 256 * j; const f32x4 g = *(const f32x4*)(a->in[I_N2G] + (size_t)l * D + c); ck[j] = g * (*(const f32x4*)(m + 4 * D + c) + 1.0f); cs[j] = *(const f32x4*)(m + 3 * D + c); } }
        const float* xr = X + (size_t)row * D;
        f32x4 v[8]; float ss = 0.f;
#pragma unroll
        for (int j = 0; j < 8; ++j) { v[j] = *(const f32x4*)(xr + 4 * lane + 256 * j); ss += (v[j][0] * v[j][0] + v[j][1] * v[j][1]) + (v[j][2] * v[j][2] + v[j][3] * v[j][3]); }
        const float rstd = 1.0f / sqrtf(wave_sum(ss) * (1.0f / D) + NORM_EPS);
        f32x4 lg4[4];
#pragma unroll
        for (int q = 0; q < 4; ++q) lg4[q] = (f32x4){0.f, 0.f, 0.f, 0.f};
#pragma unroll
        for (int j = 0; j < 8; ++j) { const f32x4 h = v[j] * rstd * ck[j] + cs[j]; u32x2 o; o.x = pk2(h[0], h[1]); o.y = pk2(h[2], h[3]); *(u32x2*)(Ho + (size_t)orow * D + 4 * lane + 256 * j) = o;
#pragma unroll
            for (int i = 0; i < 4; ++i)
#pragma unroll
                for (int q = 0; q < 4; ++q) lg4[q] += rwl[((j * 4 + i) * 4 + q) * 64 + lane] * h[i];
            asm volatile("" ::: "memory"); }
        float lg[16];
#pragma unroll
        for (int e = 0; e < 16; ++e) lg[e] = wave_sum(lg4[e >> 2][e & 3]) + rb[e];
        float mx = lg[0];
#pragma unroll
        for (int e = 1; e < 16; ++e) mx = fmaxf(mx, lg[e]);
        float p[16], sum = 0.f;
#pragma unroll
        for (int e = 0; e < 16; ++e) { p[e] = __expf(lg[e] - mx); sum += p[e]; }
        const float inv = 1.0f / sum;
#pragma unroll
        for (int e = 0; e < 16; ++e) p[e] *= inv;
        int sel = 0; float best = -1.f;
#pragma unroll
        for (int gI = 0; gI < 4; ++gI) { float m1 = -1.f, m2 = -1.f;
#pragma unroll
            for (int i = 0; i < 4; ++i) { const float q = p[4 * gI + i]; if (q > m1) { m2 = m1; m1 = q; } else if (q > m2) m2 = q; }
            const float s = m1 + m2; if (s > best) { best = s; sel = gI; } }
        int i1 = 0, i2 = 0; float p1 = -2.f, p2 = -2.f;
#pragma unroll
        for (int gI = 0; gI < 4; ++gI)
#pragma unroll
            for (int i = 0; i < 4; ++i) { const float q = (gI == sel) ? p[4 * gI + i] : -1.0f; const int e = 4 * gI + i;
                if (gI == sel) { if (q > p1) { p2 = p1; i2 = i1; p1 = q; i1 = e; } else if (q > p2) { p2 = q; i2 = e; } } }
        const float wsum = p1 + p2, w1 = p1 / wsum, w2 = p2 / wsum;
        if (lane == 0) {
            const unsigned q1 = atomicAdd(cnt + i1 * 64, 1u); ridx[(size_t)i1 * MALL + q1] = (unsigned)row; rwt[(size_t)i1 * MALL + q1] = w1;
            const unsigned q2 = atomicAdd(cnt + i2 * 64, 1u); ridx[(size_t)i2 * MALL + q2] = (unsigned)row | 0x80000000u; rwt[(size_t)i2 * MALL + q2] = w2;
        }
    }
    __syncthreads();
}

template <bool FOR_DOWN>
__device__ __forceinline__ void moe_tables(KArgs a, int l, LAS unsigned char* lds, int cvirt) {
    const int tid = tid_fresh(), G = gridDim.x;
    unsigned char* ws = a->ws;
    const unsigned* cnt = (const unsigned*)(ws + WS_CTL) + CW_CNT + l * 16 * 64;
    const unsigned* ridx = (const unsigned*)(ws + WS_RIDX); const float* rwt = (const float*)(ws + WS_RW);
    LAS int* tp = (LAS int*)(lds + LDS_TP); LAS unsigned* tab = (LAS unsigned*)(lds + LDS_TAB); LAS float* tabw = (LAS float*)(lds + LDS_TABW);
    if (tid == 0) { int acc = 0; for (int e = 0; e < 16; ++e) { tp[e] = acc; acc += (int)((cnt[e * 64] + 255u) >> 8); } tp[16] = acc; }
    __syncthreads();
    const int ntot = tp[16] * 8;
    for (int i = 0; i < 9; ++i) { const int L = i * G + cvirt; if (L >= ntot) break;
        const int tile = L >> 3; int e = 0;
        for (int j = 1; j < 16; ++j) e += (tile >= tp[j]) ? 1 : 0;
        const int pos0 = (tile - tp[e]) * 256; const unsigned ce = cnt[e * 64];
        if (tid < 256) { const int pos = pos0 + tid; const bool valid = (unsigned)pos < ce; const unsigned ent = ridx[(size_t)e * MALL + (valid ? pos : 0)];
            if (FOR_DOWN) { tab[i * 256 + tid] = valid ? ent : (ent | 0x40000000u); tabw[i * 256 + tid] = valid ? rwt[(size_t)e * MALL + pos] : 0.f; }
            else tab[i * 256 + tid] = (ent & 0xffffu) * (unsigned)(D * 2); }
    }
    __syncthreads();
}

__device__ __forceinline__ void gmlp_item(KArgs a, int l, int item, LAS unsigned char* lds) {
    const int tid = tid_fresh(), lane = tid & 63, wave = tid >> 6;
    unsigned char* ws = a->ws;
    const bf16* P = (const bf16*)(ws + WS_P); bf16* Y = (bf16*)(ws + WS_Y);
    const int chunk = item >> 2, h = item & 3;
    const int row0 = chunk < 256 ? chunk * 128 : NLAT + (chunk - 256) * 128;
    LAS bf16* wsl = (LAS bf16*)lds;
    LAS bf16* vT = (LAS bf16*)(lds + 128 * 136 * 2);
    const bf16* gws = (const bf16*)(ws + WS_SMALLW + SW_GWS) + ((size_t)l * 4 + h) * 128 * 128;
    for (int p = tid; p < 2048; p += NTHREADS) { const int t = p >> 4, c8 = p & 15; *(LAS u32x4*)(wsl + t * 136 + c8 * 8) = *(const u32x4*)(gws + t * 128 + c8 * 8); }
    {
        const int s = tid >> 2, qd = tid & 3; const bf16* vp = P + (size_t)(row0 + s) * INC + OFF_V + h * 128 + qd * 32;
        float g[32]; float ss = 0.f;
#pragma unroll
        for (int q = 0; q < 4; ++q) { float f[8]; unpack8(*(const u32x4*)(vp + 8 * q), f);
#pragma unroll
            for (int j = 0; j < 8; ++j) { const float x = geluf_(f[j]); g[8 * q + j] = x; ss += x * x; } }
        ss += __shfl_xor(ss, 1); ss += __shfl_xor(ss, 2);
        const float rstd = 1.0f / sqrtf(ss * (1.0f / 128.0f) + NORM_EPS);
        const float* ng = a->in[I_GNG] + (size_t)l * 512 + h * 128 + qd * 32;
#pragma unroll
        for (int j = 0; j < 32; ++j) vT[(qd * 32 + j) * 136 + s] = (bf16)f2bf(g[j] * rstd * ng[j]);
    }
    __syncthreads();
    f32x4 acc[8];
#pragma unroll
    for (int ct = 0; ct < 8; ++ct) acc[ct] = (f32x4){0.f, 0.f, 0.f, 0.f};
    const int fr = lane & 15, fq = lane >> 4;
#pragma unroll
    for (int ks = 0; ks < 4; ++ks) {
        const bf16x8 bfrag = *(const LAS bf16x8*)(wsl + (16 * wave + fr) * 136 + ks * 32 + fq * 8);
#pragma unroll
        for (int ct = 0; ct < 8; ++ct) { const bf16x8 afrag = *(const LAS bf16x8*)(vT + (16 * ct + fr) * 136 + ks * 32 + fq * 8);
            acc[ct] = __builtin_amdgcn_mfma_f32_16x16x32_bf16(afrag, bfrag, acc[ct], 0, 0, 0); }
    }
    const int t = 16 * wave + fr; const float wb = a->in[I_GB][((size_t)l * 4 + h) * 128 + t];
    const bf16* up = P + (size_t)(row0 + t) * INC + OFF_U + h * 128; bf16* yp = Y + (size_t)(row0 + t) * D + h * 128;
#pragma unroll
    for (int ct = 0; ct < 8; ++ct) { const int c = 16 * ct + 4 * fq; const u32x2 uu = *(const u32x2*)(up + c);
        const float y0 = geluf_(bflo(uu.x)) * (acc[ct][0] + wb), y1 = geluf_(bfhi(uu.x)) * (acc[ct][1] + wb), y2 = geluf_(bflo(uu.y)) * (acc[ct][2] + wb), y3 = geluf_(bfhi(uu.y)) * (acc[ct][3] + wb);
        u32x2 o; o.x = pk2(y0, y1); o.y = pk2(y2, y3); *(u32x2*)(yp + c) = o; }
    __syncthreads();
}

constexpr int SP_ = 72;
__device__ __forceinline__ int kperm_pos(int k) { const int s5 = k & 31; return (k & 32) + 8 * ((s5 >> 2) & 3) + 4 * (s5 >> 4) + (s5 & 3); }
__device__ __forceinline__ void rwkv_prep_item(KArgs a, int l, int tile, int head, LAS unsigned char* lds) {
    const int tid = tid_fresh(), lane = tid & 63, wave = tid >> 6;
    unsigned char* ws = a->ws;
    const bf16* P = (const bf16*)(ws + WS_P); bf16* Y = (bf16*)(ws + WS_Y);
    LAS bf16* SR = (LAS bf16*)lds; LAS bf16* SK = SR + 64 * SP_; LAS bf16* SV = SK + 64 * SP_; LAS bf16* SKK = SV + 64 * SP_; LAS bf16* SB = SKK + 64 * SP_; LAS bf16* SWF = SB + 64 * SP_; LAS bf16* SWB = SWF + 64 * SP_;
    LAS bf16* tw = SWB + 64 * SP_;
    LAS bf16* adl = tw + 64 * SP_;
    LAS bf16* sg = adl + 64 * SP_;
    LAS float* invn = (LAS float*)(sg + 64 * 136);
    LAS unsigned char* wpriv = (LAS unsigned char*)(invn + 64) + wave * 6144;
    const int row0 = tile * 64; const bool isl = row0 < NLAT;
    const float* mu = a->in[I_MU] + (size_t)l * CCOLS; const float* kkw = a->in[I_KK] + (size_t)l * CW + head * 64;
    auto shift_group = [&](int tk, int col, float (&z)[8]) {
        const int row = row0 + tk; int o0, o1, o2, o3; bool v0, v1, v2, v3;
        if (isl) { const int gr = (row >> 6) & 63; o0 = -1; o1 = 1; o2 = -64; o3 = 64; v0 = tk > 0; v1 = tk < 63; v2 = gr > 0; v3 = gr < 63; }
        else { const int tc = (row - NLAT) & 255; o0 = -1; o1 = 1; o2 = -1; o3 = 1; v0 = tc > 0; v1 = tc < 255; v2 = v0; v3 = v1; }
        const bf16* pp = P + (size_t)row * INC + OFF_C + col;
        const u32x4 uo = *(const u32x4*)pp, u0 = *(const u32x4*)(pp + (v0 ? o0 : 0) * INC), u1 = *(const u32x4*)(pp + (v1 ? o1 : 0) * INC), u2 = *(const u32x4*)(pp + (v2 ? o2 : 0) * INC), u3 = *(const u32x4*)(pp + (v3 ? o3 : 0) * INC);
        const f32x4 m0 = *(const f32x4*)(mu + col), m1 = *(const f32x4*)(mu + col + 4);
        float own[8], n0[8], n1[8], n2[8], n3[8]; unpack8(uo, own); unpack8(u0, n0); unpack8(u1, n1); unpack8(u2, n2); unpack8(u3, n3);
        const float f0 = v0 ? 1.f : 0.f, f1 = v1 ? 1.f : 0.f, f2 = v2 ? 1.f : 0.f, f3 = v3 ? 1.f : 0.f;
        const float nb[8] = {n0[0] * f0, n1[1] * f1, n2[2] * f2, n3[3] * f3, n0[4] * f0, n1[5] * f1, n2[6] * f2, n3[7] * f3};
#pragma unroll
        for (int j = 0; j < 8; ++j) { const float mm = j < 4 ? m0[j] : m1[j - 4]; z[j] = own[j] + mm * (nb[j] - own[j]); }
    };
#pragma unroll
    for (int it = 0; it < 3; ++it) { const int g = tid + NTHREADS * it, tk = g / 24, gi = g % 24, c8 = (gi & 7) * 8;
        float z[8]; shift_group(tk, (gi >> 3) * 768 + head * 64 + c8, z);
        if (gi < 8) *(LAS u32x4*)(SR + tk * SP_ + c8) = pack8(z);
        else if (gi < 16) { *(LAS u32x4*)(SK + tk * SP_ + c8) = pack8(z);
            const f32x4 k0 = *(const f32x4*)(kkw + c8), k1 = *(const f32x4*)(kkw + c8 + 4); float ss = 0.f;
#pragma unroll
            for (int j = 0; j < 8; ++j) { const float q = z[j] * (j < 4 ? k0[j] : k1[j - 4]); ss += q * q; }
            ss += __shfl_xor(ss, 1); ss += __shfl_xor(ss, 2); ss += __shfl_xor(ss, 4);
            if ((gi & 7) == 0) invn[tk] = 1.0f / fmaxf(sqrtf(ss), 1e-12f); }
        else *(LAS u32x4*)(SV + tk * SP_ + c8) = pack8(z); }
#pragma unroll
    for (int it = 0; it < 4; ++it) { const int g = tid + NTHREADS * it, tk = g >> 5, gi = g & 31;
        float z[8]; shift_group(tk, 2304 + gi * 8, z);
        if (gi < 8) { float t8[8];
#pragma unroll
            for (int j = 0; j < 8; ++j) t8[j] = tanhf(z[j]);
            *(LAS u32x4*)(tw + tk * SP_ + gi * 8) = pack8(t8); }
        else if (gi < 16) *(LAS u32x4*)(adl + tk * SP_ + (gi - 8) * 8) = pack8(z);
        else { float t8[8];
#pragma unroll
            for (int j = 0; j < 8; ++j) t8[j] = sigmoidf_(z[j]);
            *(LAS u32x4*)(sg + tk * 136 + (gi - 16) * 8) = pack8(t8); } }
    __syncthreads();
    {
        const int fr = lane & 15, fq = lane >> 4, nt = wave & 3, th = wave >> 2;
        const bf16* wupT = (const bf16*)(ws + WS_SMALLW + SW_WUP) + (size_t)l * 2 * 768 * 64;
        const bf16* aupT = (const bf16*)(ws + WS_SMALLW + SW_AUP) + (size_t)l * 768 * 64;
        const bf16* gupT = (const bf16*)(ws + WS_SMALLW + SW_GUP) + (size_t)l * 768 * 128;
        const float* a0 = a->in[I_A0] + (size_t)l * CW + head * 64; const float* kaw = a->in[I_KA] + (size_t)l * CW + head * 64; const float* w0 = a->in[I_W0] + (size_t)l * 2 * CW + head * 64;
        const int nloc = 16 * nt + 4 * fq;
#pragma unroll 1
        for (int mat = 0; mat < 4; ++mat) {
            const bf16* WT = mat == 0 ? aupT : (mat == 1 ? wupT : (mat == 2 ? wupT + 768 * 64 : gupT));
            const int KK = mat == 3 ? 128 : 64; const LAS bf16* act = mat == 0 ? adl : (mat == 3 ? sg : tw); const int apitch = mat == 3 ? 136 : SP_;
            f32x4 acc[2];
            acc[0] = (f32x4){0.f, 0.f, 0.f, 0.f}; acc[1] = acc[0];
            for (int ks = 0; ks < KK / 32; ++ks) { const bf16x8 afr = *(const bf16x8*)(WT + (size_t)(head * 64 + 16 * nt + fr) * KK + ks * 32 + fq * 8);
#pragma unroll
                for (int tt = 0; tt < 2; ++tt) { const bf16x8 bfr = *(const LAS bf16x8*)(act + (16 * (2 * th + tt) + fr) * apitch + ks * 32 + fq * 8); acc[tt] = __builtin_amdgcn_mfma_f32_16x16x32_bf16(afr, bfr, acc[tt], 0, 0, 0); } }
#pragma unroll
            for (int tt = 0; tt < 2; ++tt) { const int tk = 16 * (2 * th + tt) + fr; const f32x4 v = acc[tt];
                if (mat == 0) {
                    const f32x4 a0v = *(const f32x4*)(a0 + nloc), kav = *(const f32x4*)(kaw + nloc), kkv = *(const f32x4*)(kkw + nloc);
                    const u32x2 kp = *(const LAS u32x2*)(SK + tk * SP_ + nloc); const float kf[4] = {bflo(kp.x), bfhi(kp.x), bflo(kp.y), bfhi(kp.y)};
                    const float inn = invn[tk]; float k2[4], kk[4], bb[4];
#pragma unroll
                    for (int j = 0; j < 4; ++j) { const float av = sigmoidf_(a0v[j] + v[j]); kk[j] = kf[j] * kkv[j] * inn; k2[j] = kf[j] * (1.0f + (av - 1.0f) * kav[j]); bb[j] = kk[j] * av; }
                    u32x2 q; q.x = pk2(k2[0], k2[1]); q.y = pk2(k2[2], k2[3]); *(LAS u32x2*)(SK + tk * SP_ + nloc) = q;
                    q.x = pk2(kk[0], kk[1]); q.y = pk2(kk[2], kk[3]); *(LAS u32x2*)(SKK + tk * SP_ + nloc) = q;
                    q.x = pk2(bb[0], bb[1]); q.y = pk2(bb[2], bb[3]); *(LAS u32x2*)(SB + tk * SP_ + nloc) = q;
                } else if (mat <= 2) {
                    const f32x4 w0v = *(const f32x4*)(w0 + (mat - 1) * CW + nloc); float d[4];
#pragma unroll
                    for (int j = 0; j < 4; ++j) d[j] = __expf(-DECAY_SCALE * sigmoidf_(w0v[j] + v[j]));
                    u32x2 q; q.x = pk2(d[0], d[1]); q.y = pk2(d[2], d[3]); *(LAS u32x2*)((mat == 1 ? SWF : SWB) + tk * SP_ + nloc) = q;
                } else {
                    u32x2 q; q.x = pk2(v[0], v[1]); q.y = pk2(v[2], v[3]); *(u32x2*)(Y + (size_t)(row0 + tk) * D + 1280 + head * 64 + nloc) = q;
                }
            }
        }
    }
    __syncthreads();
    { const int tk = tid >> 3, c8 = (tid & 7) * 8; float r8[8], k8[8], v8[8];
      unpack8(*(const LAS u32x4*)(SR + tk * SP_ + c8), r8); unpack8(*(const LAS u32x4*)(SK + tk * SP_ + c8), k8); unpack8(*(const LAS u32x4*)(SV + tk * SP_ + c8), v8);
      const float* rkp = a->in[I_RK] + (size_t)l * CW + head * 64 + c8; const f32x4 rk0 = *(const f32x4*)rkp, rk1 = *(const f32x4*)(rkp + 4);
      float bs = 0.f;
#pragma unroll
      for (int j = 0; j < 8; ++j) bs += r8[j] * k8[j] * (j < 4 ? rk0[j] : rk1[j - 4]);
      bs += __shfl_xor(bs, 1); bs += __shfl_xor(bs, 2); bs += __shfl_xor(bs, 4);
#pragma unroll
      for (int j = 0; j < 8; ++j) v8[j] *= bs;
      *(u32x4*)(Y + (size_t)(row0 + tk) * D + 512 + head * 64 + c8) = pack8(v8); }
    {
        const int c4 = wave & 3, dir = wave >> 2, fr = lane & 15, fq = lane >> 4;
        LAS float* CB = (LAS float*)wpriv;
        LAS float* AA = CB + 16 * 64;
        const LAS bf16* SW = dir ? SWB : SWF;
        auto trow = [&](int tau) { return 16 * c4 + (dir ? 15 - tau : tau); };
        float c[16];
        { float run = 0.f;
#pragma unroll
          for (int t = 0; t < 16; ++t) { run += __logf(bf1(SW[trow(t) * SP_ + lane])); c[t] = run; CB[t * 64 + lane] = run; } }
        const int rec_dir = dir, bidx = isl ? (row0 >> 12) : ((row0 - NLAT) >> 8);
        const int tcl = isl ? 4 * ((row0 >> 6) & 63) + c4 : 4 * (((row0 - NLAT) >> 6) & 3) + c4;
        const int nproc = isl ? 16 + (dir ? 255 - tcl : tcl) : (dir ? 15 - tcl : tcl);
        unsigned char* rec = ws + WS_PRE + ((size_t)((rec_dir * 8 + bidx) * 12 + head) * NCHUNK16 + nproc) * PRE_REC;
        { const float cl = c[15]; float bk[32];
#pragma unroll
          for (int t = 0; t < 16; ++t) { const float e = __expf(cl - c[t]); const int pos = 8 * (t >> 2) + (t & 3); bk[pos] = bf1(SB[trow(t) * SP_ + lane]) * e; bk[pos + 4] = bf1(SK[trow(t) * SP_ + lane]) * e; }
#pragma unroll
          for (int q4 = 0; q4 < 4; ++q4) { u32x4 o; o.x = pk2(bk[8 * q4], bk[8 * q4 + 1]); o.y = pk2(bk[8 * q4 + 2], bk[8 * q4 + 3]); o.z = pk2(bk[8 * q4 + 4], bk[8 * q4 + 5]); o.w = pk2(bk[8 * q4 + 6], bk[8 * q4 + 7]);
              *(u32x4*)(rec + PR_BK + lane * 64 + q4 * 16) = o; }
          *(float*)(rec + PR_GAM + lane * 4) = __expf(cl); }
        asm volatile("s_waitcnt lgkmcnt(0)" ::: "memory");
        bf16x8 fa[2], frr[2], fb[2], fk[2];
        { const int tr = trow(fr);
#pragma unroll
          for (int sx = 0; sx < 2; ++sx) { const int ch = 32 * sx + 8 * fq; float kk8[8], r8[8], b8[8], k8[8];
              unpack8(*(const LAS u32x4*)(SKK + tr * SP_ + ch), kk8); unpack8(*(const LAS u32x4*)(SR + tr * SP_ + ch), r8); unpack8(*(const LAS u32x4*)(SB + tr * SP_ + ch), b8); unpack8(*(const LAS u32x4*)(SK + tr * SP_ + ch), k8);
              const f32x4 c0 = *(const LAS f32x4*)(CB + fr * 64 + ch), c1 = *(const LAS f32x4*)(CB + fr * 64 + ch + 4);
              f32x4 p0 = (f32x4){0.f, 0.f, 0.f, 0.f}, p1 = p0; if (fr > 0) { p0 = *(const LAS f32x4*)(CB + (fr - 1) * 64 + ch); p1 = *(const LAS f32x4*)(CB + (fr - 1) * 64 + ch + 4); }
              float xa[8], xr[8], xb[8], xk[8];
#pragma unroll
              for (int j = 0; j < 8; ++j) { const float cc = j < 4 ? c0[j] : c1[j - 4], cp = j < 4 ? p0[j] : p1[j - 4]; const float ep = __expf(cp), ec = __expf(cc), en = __builtin_amdgcn_rcpf(ec);
                  xa[j] = -kk8[j] * ep; xr[j] = r8[j] * ec; xb[j] = b8[j] * en; xk[j] = k8[j] * en; }
              const u32x4 ua = pack8(xa), ur = pack8(xr), ub = pack8(xb), uk = pack8(xk);
              fa[sx] = __builtin_bit_cast(bf16x8, ua); frr[sx] = __builtin_bit_cast(bf16x8, ur); fb[sx] = __builtin_bit_cast(bf16x8, ub); fk[sx] = __builtin_bit_cast(bf16x8, uk); } }
        f32x4 gab = (f32x4){0.f, 0.f, 0.f, 0.f}, gak = gab, grb = gab, grk = gab;
#pragma unroll
        for (int sx = 0; sx < 2; ++sx) { gab = __builtin_amdgcn_mfma_f32_16x16x32_bf16(fa[sx], fb[sx], gab, 0, 0, 0); gak = __builtin_amdgcn_mfma_f32_16x16x32_bf16(fa[sx], fk[sx], gak, 0, 0, 0);
            grb = __builtin_amdgcn_mfma_f32_16x16x32_bf16(frr[sx], fb[sx], grb, 0, 0, 0); grk = __builtin_amdgcn_mfma_f32_16x16x32_bf16(frr[sx], fk[sx], grk, 0, 0, 0); }
#pragma unroll
        for (int j = 0; j < 4; ++j) { const int tau = 4 * fq + j; const bool lo = fr < tau, le = fr <= tau;
            AA[tau * 16 + fr] = lo ? gab[j] : 0.f; AA[256 + tau * 16 + fr] = lo ? gak[j] : 0.f; grb[j] = le ? grb[j] : 0.f; grk[j] = le ? grk[j] : 0.f; }
        asm volatile("s_waitcnt lgkmcnt(0)" ::: "memory");
        float wv[16], mv[16];
#pragma unroll
        for (int t = 0; t < 16; ++t) { const float ab = -bf1(SKK[trow(t) * SP_ + lane]) * (t > 0 ? __expf(c[t - 1]) : 1.0f); float accw = ab, accm = AA[256 + t * 16 + fr];
#pragma unroll
            for (int q4 = 0; q4 < 4; ++q4) { if (4 * q4 < t) { const f32x4 cf = *(const LAS f32x4*)(AA + t * 16 + 4 * q4);
#pragma unroll
                for (int j = 0; j < 4; ++j) if (4 * q4 + j < t) { accw += cf[j] * wv[4 * q4 + j]; accm += cf[j] * mv[4 * q4 + j]; } } }
            wv[t] = accw; mv[t] = accm; }
        { LAS bf16* stg = (LAS bf16*)CB; const int pp = kperm_pos(lane);
#pragma unroll
          for (int t = 0; t < 16; ++t) { stg[t * 64 + pp] = (bf16)f2bf(wv[t]); stg[1024 + t * 64 + pp] = (bf16)f2bf(bf1(SR[trow(t) * SP_ + lane]) * __expf(c[t])); }
          asm volatile("s_waitcnt lgkmcnt(0)" ::: "memory");
#pragma unroll
          for (int q4 = 0; q4 < 4; ++q4) *(u32x4*)(rec + PR_WP + (q4 * 64 + lane) * 16) = *(const LAS u32x4*)((LAS unsigned char*)stg + (q4 * 64 + lane) * 16); }
        { LAS bf16* stg = (LAS bf16*)AA; const int ps = 8 * (fr >> 2) + (fr & 3);
          asm volatile("s_waitcnt lgkmcnt(0)" ::: "memory");
#pragma unroll
          for (int j = 0; j < 4; ++j) { const int tau = 4 * fq + j; stg[tau * 32 + ps] = (bf16)f2bf(grb[j]); stg[tau * 32 + ps + 4] = (bf16)f2bf(grk[j]); }
          if (lane < 16) {
#pragma unroll
              for (int t = 0; t < 16; ++t) stg[512 + t * 16 + lane] = (bf16)f2bf(mv[t]); }
          asm volatile("s_waitcnt lgkmcnt(0)" ::: "memory");
          *(u32x4*)(rec + PR_ARBK + lane * 16) = *(const LAS u32x4*)((LAS unsigned char*)stg + lane * 16);
          if (lane < 32) *(u32x4*)(rec + PR_ARBK + 1024 + lane * 16) = *(const LAS u32x4*)((LAS unsigned char*)stg + 1024 + lane * 16); }
        if (dir == 0) { float v16[16];
#pragma unroll
            for (int t = 0; t < 16; ++t) v16[t] = bf1(SV[(16 * c4 + t) * SP_ + lane]);
            const int tcg = isl ? 16 + tcl : tcl;
            unsigned char* vrec = ws + WS_VT + ((size_t)(bidx * 12 + head) * NCHUNK16 + tcg) * 2048 + lane * 32;
            u32x4 o; o.x = pk2(v16[0], v16[1]); o.y = pk2(v16[2], v16[3]); o.z = pk2(v16[4], v16[5]); o.w = pk2(v16[6], v16[7]); *(u32x4*)vrec = o;
            o.x = pk2(v16[8], v16[9]); o.y = pk2(v16[10], v16[11]); o.z = pk2(v16[12], v16[13]); o.w = pk2(v16[14], v16[15]); *(u32x4*)(vrec + 16) = o; }
    }
    __syncthreads();
}

__device__ __forceinline__ float dpp_xor1(float x) { return __builtin_bit_cast(float, __builtin_amdgcn_update_dpp(0, __builtin_bit_cast(int, x), 0xB1, 0xF, 0xF, false)); }
__device__ __forceinline__ float dpp_xor2(float x) { return __builtin_bit_cast(float, __builtin_amdgcn_update_dpp(0, __builtin_bit_cast(int, x), 0x4E, 0xF, 0xF, false)); }
__device__ __forceinline__ int chain_row(int dir, int b, int s) {
    if (s < CTXL) return NLAT + b * CTXL + (dir ? (CTXL - 1 - s) : s);
    const int t = s - CTXL; return b * T + (dir ? (T - 1 - t) : t);
}
__device__ __forceinline__ float dpp_hmirror(float x) { return __builtin_bit_cast(float, __builtin_amdgcn_update_dpp(0, __builtin_bit_cast(int, x), 0x141, 0xF, 0xF, false)); }
struct RwRec { u32x4 wp[2], rp[2], bk[4], arbk; u32x2 mak, vt; f32x4 gam[4]; };
__device__ __forceinline__ void rw_load(RwRec& r, const unsigned char* rec, const unsigned char* vrec, int fr, int kg, int qv, int dir) {
#pragma unroll
    for (int sx = 0; sx < 2; ++sx) { r.wp[sx] = *(const u32x4*)(rec + PR_WP + fr * 128 + sx * 64 + kg * 16); r.rp[sx] = *(const u32x4*)(rec + PR_RP + fr * 128 + sx * 64 + kg * 16); }
#pragma unroll
    for (int i = 0; i < 4; ++i) { r.bk[i] = *(const u32x4*)(rec + PR_BK + (16 * i + fr) * 64 + kg * 16); r.gam[i] = *(const f32x4*)(rec + PR_GAM + (16 * i + 4 * kg) * 4); }
    r.arbk = *(const u32x4*)(rec + PR_ARBK + fr * 64 + kg * 16);
    r.mak = *(const u32x2*)(rec + PR_MAK + fr * 32 + kg * 8);
    r.vt = *(const u32x2*)(vrec + (16 * qv + fr) * 32 + (dir ? (12 - 4 * kg) : 4 * kg) * 2);
}
__device__ __forceinline__ void rwkv_chain_mfma(KArgs a, int task_base) {
    const int t_ = tid_fresh(); const int lane = t_ & 63, fr = lane & 15, kg = lane >> 4; const int task = task_base + __builtin_amdgcn_readfirstlane(t_ >> 6);
    unsigned char* ws = a->ws;
    bf16* OC = (bf16*)(ws + WS_OC);
    const int cid = task >> 2, qv = task & 3, dir = cid / 96, b = (cid % 96) / 12, h = cid % 12;
    const unsigned char* rec0 = ws + WS_PRE + (size_t)((dir * 8 + b) * 12 + h) * NCHUNK16 * PRE_REC;
    const unsigned char* vrec0 = ws + WS_VT + (size_t)(b * 12 + h) * NCHUNK16 * 2048;
    auto tchunk = [&](int n) { return n < 16 ? (dir ? 15 - n : n) : 16 + (dir ? 255 - (n - 16) : (n - 16)); };
    f32x4 ST[4];
#pragma unroll
    for (int i = 0; i < 4; ++i) ST[i] = (f32x4){0.f, 0.f, 0.f, 0.f};
    unsigned uvU0 = 0u, uvU1 = 0u;
    RwRec cur, nxt;
    rw_load(cur, rec0, vrec0 + (size_t)tchunk(0) * 2048, fr, kg, qv, dir);
    for (int n = 0; n < NCHUNK16; ++n) {
        if (n + 1 < NCHUNK16) rw_load(nxt, rec0 + (size_t)(n + 1) * PRE_REC, vrec0 + (size_t)tchunk(n + 1) * 2048, fr, kg, qv, dir); else nxt = cur;
        u32x4 fs[2];
#pragma unroll
        for (int sx = 0; sx < 2; ++sx) { fs[sx].x = pk2(ST[2 * sx][0], ST[2 * sx][1]); fs[sx].y = pk2(ST[2 * sx][2], ST[2 * sx][3]); fs[sx].z = pk2(ST[2 * sx + 1][0], ST[2 * sx + 1][1]); fs[sx].w = pk2(ST[2 * sx + 1][2], ST[2 * sx + 1][3]); }
        u32x2 vt = cur.vt; if (dir) { const unsigned x = vt.x, y = vt.y; vt.x = (y >> 16) | (y << 16); vt.y = (x >> 16) | (x << 16); }
        u32x4 fuv; fuv.x = uvU0; fuv.y = uvU1; fuv.z = vt.x; fuv.w = vt.y;
        u32x4 fmak; fmak.x = 0u; fmak.y = 0u; fmak.z = cur.mak.x; fmak.w = cur.mak.y;
        f32x4 U = (f32x4){0.f, 0.f, 0.f, 0.f};
        U = __builtin_amdgcn_mfma_f32_16x16x32_bf16(__builtin_bit_cast(bf16x8, cur.wp[0]), __builtin_bit_cast(bf16x8, fs[0]), U, 0, 0, 0);
        U = __builtin_amdgcn_mfma_f32_16x16x32_bf16(__builtin_bit_cast(bf16x8, cur.wp[1]), __builtin_bit_cast(bf16x8, fs[1]), U, 0, 0, 0);
        U = __builtin_amdgcn_mfma_f32_16x16x32_bf16(__builtin_bit_cast(bf16x8, fmak), __builtin_bit_cast(bf16x8, fuv), U, 0, 0, 0);
        uvU0 = pk2(U[0], U[1]); uvU1 = pk2(U[2], U[3]); fuv.x = uvU0; fuv.y = uvU1;
        f32x4 OT = (f32x4){0.f, 0.f, 0.f, 0.f};
        OT = __builtin_amdgcn_mfma_f32_16x16x32_bf16(__builtin_bit_cast(bf16x8, fs[0]), __builtin_bit_cast(bf16x8, cur.rp[0]), OT, 0, 0, 0);
        OT = __builtin_amdgcn_mfma_f32_16x16x32_bf16(__builtin_bit_cast(bf16x8, fs[1]), __builtin_bit_cast(bf16x8, cur.rp[1]), OT, 0, 0, 0);
        OT = __builtin_amdgcn_mfma_f32_16x16x32_bf16(__builtin_bit_cast(bf16x8, fuv), __builtin_bit_cast(bf16x8, cur.arbk), OT, 0, 0, 0);
#pragma unroll
        for (int i = 0; i < 4; ++i) ST[i] = __builtin_amdgcn_mfma_f32_16x16x32_bf16(__builtin_bit_cast(bf16x8, cur.bk[i]), __builtin_bit_cast(bf16x8, fuv), ST[i] * cur.gam[i], 0, 0, 0);
        const int row = chain_row(dir, b, 16 * n + fr);
        u32x2 o; o.x = pk2(OT[0], OT[1]); o.y = pk2(OT[2], OT[3]); *(u32x2*)(OC + ((size_t)dir * MALL + row) * CW + h * 64 + 16 * qv + 4 * kg) = o;
        cur = nxt;
    }
}
#define LDS_BAR() do { asm volatile("s_waitcnt lgkmcnt(0)" ::: "memory"); __builtin_amdgcn_s_barrier(); asm volatile("" ::: "memory"); } while (0)
__device__ __forceinline__ void hgrn_chain_mfma(KArgs a, int l, int cid, LAS unsigned char* lds) {
    const int tid = tid_fresh(), lane = tid & 63, wave = tid >> 6, fr = lane & 15, fq = lane >> 4;
    unsigned char* ws = a->ws;
    const bf16* P = (const bf16*)(ws + WS_P); bf16* OB = (bf16*)(ws + WS_OB);
    const int dir = cid / 48, b = (cid % 48) / 6, h = cid % 6;
    constexpr int QP = 136, SP = 72;
    LAS bf16* qs = (LAS bf16*)lds;
    LAS bf16* ks = qs + 64 * QP;
    LAS bf16* kT = ks + 64 * QP;
    LAS bf16* vT = kT + 128 * SP;
    LAS bf16* pl = vT + 128 * SP;
    LAS bf16* sT = pl + 64 * SP;
    LAS float* tot = (LAS float*)(sT + 128 * QP);
    LAS float* gmid = tot + 512;
    LAS float* gend = gmid + 128;
    LAS float* lbs = gend + 128;
    LAS float* lfb = (LAS float*)sT;
    const int d = tid & 127, qt = tid >> 7;
    const int tau_a = tid >> 3, d0 = (tid & 7) * 16;
    if (tid < 128) { const int ch = h * 128 + tid; float lb = 0.f;
        if (l != 0) { const float l0 = a->in[I_LB][((size_t)dir * DEPTH + 0) * BW + ch], l1 = a->in[I_LB][((size_t)dir * DEPTH + 1) * BW + ch]; lb = 1.0f / (1.0f + __expf(l0 - l1)); }
        lbs[tid] = lb; }
    f32x4 S[8];
#pragma unroll
    for (int vt = 0; vt < 8; ++vt) S[vt] = (f32x4){0.f, 0.f, 0.f, 0.f};
    const int zoff = dir ? OFF_ZB : OFF_ZF;
    u32x4 rq[2], ri[2], rz[2];
    { const bf16* pr = P + (size_t)chain_row(dir, b, tau_a) * INC + h * 128 + d0;
      rq[0] = *(const u32x4*)(pr + OFF_Q); rq[1] = *(const u32x4*)(pr + OFF_Q + 8); ri[0] = *(const u32x4*)(pr + OFF_I); ri[1] = *(const u32x4*)(pr + OFF_I + 8); rz[0] = *(const u32x4*)(pr + zoff); rz[1] = *(const u32x4*)(pr + zoff + 8); }
    __syncthreads();
    constexpr int NCH = (CTXL + T) / 64;
    for (int n = 0; n < NCH; ++n) {
        const int s0 = n * 64;
#pragma unroll
        for (int hf = 0; hf < 2; ++hf) { float qf[8], zf[8], oq[8], ok[8]; unpack8(rq[hf], qf); unpack8(rz[hf], zf);
            const int dd = d0 + 8 * hf; const f32x4 lb0 = *(const LAS f32x4*)(lbs + dd), lb1 = *(const LAS f32x4*)(lbs + dd + 4); f32x4 lf0, lf1;
#pragma unroll
            for (int j = 0; j < 8; ++j) { const float lb = j < 4 ? lb0[j] : lb1[j - 4]; const float f = lb + (1.0f - lb) * sigmoidf_(zf[j]); const float lf = fmaxf(__logf(f), -60.0f);
                if (j < 4) lf0[j] = lf; else lf1[j - 4] = lf; oq[j] = siluf_(qf[j]); ok[j] = 1.0f - f; }
            *(LAS u32x4*)(qs + tau_a * QP + dd) = pack8(oq); *(LAS u32x4*)(ks + tau_a * QP + dd) = pack8(ok);
            *(LAS f32x4*)(lfb + tau_a * 128 + dd) = lf0; *(LAS f32x4*)(lfb + tau_a * 128 + dd + 4) = lf1;
            const u32x4 vv = ri[hf];
            vT[(dd + 0) * SP + tau_a] = (bf16)(vv.x & 0xffffu); vT[(dd + 1) * SP + tau_a] = (bf16)(vv.x >> 16); vT[(dd + 2) * SP + tau_a] = (bf16)(vv.y & 0xffffu); vT[(dd + 3) * SP + tau_a] = (bf16)(vv.y >> 16);
            vT[(dd + 4) * SP + tau_a] = (bf16)(vv.z & 0xffffu); vT[(dd + 5) * SP + tau_a] = (bf16)(vv.z >> 16); vT[(dd + 6) * SP + tau_a] = (bf16)(vv.w & 0xffffu); vT[(dd + 7) * SP + tau_a] = (bf16)(vv.w >> 16); }
        if (n + 1 < NCH) { const bf16* pr = P + (size_t)chain_row(dir, b, s0 + 64 + tau_a) * INC + h * 128 + d0;
            rq[0] = *(const u32x4*)(pr + OFF_Q); rq[1] = *(const u32x4*)(pr + OFF_Q + 8); ri[0] = *(const u32x4*)(pr + OFF_I); ri[1] = *(const u32x4*)(pr + OFF_I + 8); rz[0] = *(const u32x4*)(pr + zoff); rz[1] = *(const u32x4*)(pr + zoff + 8); }
        LDS_BAR();
        float cs[16];
        { float run = 0.f;
#pragma unroll
          for (int i = 0; i < 16; ++i) { run += lfb[(16 * qt + i) * 128 + d]; cs[i] = run; }
          tot[qt * 128 + d] = run; }
        LDS_BAR();
        { const float t0 = tot[d], t1 = tot[128 + d], t2 = tot[256 + d], t3 = tot[384 + d];
          const float bmid = t0 + t1, btot = bmid + t2 + t3; const float base = (qt > 0 ? t0 : 0.f) + (qt > 1 ? t1 : 0.f) + (qt > 2 ? t2 : 0.f);
          if (qt == 0) { gmid[d] = __expf(bmid); gend[d] = __expf(btot - bmid); }
#pragma unroll
          for (int i = 0; i < 16; ++i) { const int tau = 16 * qt + i; const float bt = base + cs[i];
              const float eq = __expf(fminf(bt - bmid, 80.0f)), ek = __expf(fminf(bmid - bt, 80.0f));
              const bf16 qb = (bf16)f2bf(bf1(qs[tau * QP + d]) * eq), kb = (bf16)f2bf(bf1(ks[tau * QP + d]) * ek);
              qs[tau * QP + d] = qb; ks[tau * QP + d] = kb; kT[d * SP + tau] = kb; } }
        LDS_BAR();
        { const f32x4 gm = *(const LAS f32x4*)(gmid + 16 * wave + 4 * fq);
#pragma unroll
          for (int vt = 0; vt < 8; ++vt) { S[vt] = S[vt] * gm; u32x2 o; o.x = pk2(S[vt][0], S[vt][1]); o.y = pk2(S[vt][2], S[vt][3]); *(LAS u32x2*)(sT + (16 * vt + fr) * QP + 16 * wave + 4 * fq) = o; } }
        { const int tt = wave >> 1;
#pragma unroll
          for (int u = 0; u < 2; ++u) { const int sg = 2 * (wave & 1) + u; f32x4 acc = (f32x4){0.f, 0.f, 0.f, 0.f};
              if (sg <= tt) {
#pragma unroll
                  for (int kq = 0; kq < 4; ++kq) { const bf16x8 af = *(const LAS bf16x8*)(ks + (16 * sg + fr) * QP + 32 * kq + 8 * fq), bfm = *(const LAS bf16x8*)(qs + (16 * tt + fr) * QP + 32 * kq + 8 * fq);
                      acc = __builtin_amdgcn_mfma_f32_16x16x32_bf16(af, bfm, acc, 0, 0, 0); }
                  if (sg == tt) {
#pragma unroll
                      for (int j = 0; j < 4; ++j) if (4 * fq + j > fr) acc[j] = 0.f; }
              }
              u32x2 o; o.x = pk2(acc[0], acc[1]); o.y = pk2(acc[2], acc[3]); *(LAS u32x2*)(pl + (16 * tt + fr) * SP + 16 * sg + 4 * fq) = o; } }
        LDS_BAR();
#pragma unroll
        for (int tt = 0; tt < 4; ++tt) { f32x4 acc = (f32x4){0.f, 0.f, 0.f, 0.f};
#pragma unroll
            for (int kq = 0; kq < 2; ++kq) { const bf16x8 af = *(const LAS bf16x8*)(vT + (16 * wave + fr) * SP + 32 * kq + 8 * fq), bfm = *(const LAS bf16x8*)(pl + (16 * tt + fr) * SP + 32 * kq + 8 * fq);
                acc = __builtin_amdgcn_mfma_f32_16x16x32_bf16(af, bfm, acc, 0, 0, 0); }
#pragma unroll
            for (int kq = 0; kq < 4; ++kq) { const bf16x8 af = *(const LAS bf16x8*)(sT + (16 * wave + fr) * QP + 32 * kq + 8 * fq), bfm = *(const LAS bf16x8*)(qs + (16 * tt + fr) * QP + 32 * kq + 8 * fq);
                acc = __builtin_amdgcn_mfma_f32_16x16x32_bf16(af, bfm, acc, 0, 0, 0); }
            const int row = chain_row(dir, b, s0 + 16 * tt + fr);
            u32x2 o; o.x = pk2(acc[0], acc[1]); o.y = pk2(acc[2], acc[3]); *(u32x2*)(OB + ((size_t)dir * MALL + row) * BW + h * 128 + 16 * wave + 4 * fq) = o; }
        { const f32x4 ge = *(const LAS f32x4*)(gend + 16 * wave + 4 * fq);
#pragma unroll
          for (int kq = 0; kq < 2; ++kq) { const bf16x8 af = *(const LAS bf16x8*)(kT + (16 * wave + fr) * SP + 32 * kq + 8 * fq);
#pragma unroll
              for (int vt = 0; vt < 8; ++vt) { const bf16x8 bfm = *(const LAS bf16x8*)(vT + (16 * vt + fr) * SP + 32 * kq + 8 * fq); S[vt] = __builtin_amdgcn_mfma_f32_16x16x32_bf16(af, bfm, S[vt], 0, 0, 0); } }
#pragma unroll
          for (int vt = 0; vt < 8; ++vt) S[vt] = S[vt] * ge; }
        LDS_BAR();
    }
}
__device__ __forceinline__ void hgrn_chain(KArgs a, int l, int cid, LAS unsigned char* lds) {
    const int tid = tid_fresh();
    unsigned char* ws = a->ws;
    const bf16* P = (const bf16*)(ws + WS_P); bf16* OB = (bf16*)(ws + WS_OB);
    const int dir = cid / 48, b = (cid % 48) / 6, h = cid % 6;
    LAS float* tq = (LAS float*)lds;
    LAS float* tk = tq + 16 * 128;
    LAS float* tf = tk + 16 * 128;
    LAS float* tv = tf + 16 * 128;
    LAS float* ot = tv + 16 * 128;
    const int v = tid >> 2, q = tid & 3;
    float S[32];
#pragma unroll
    for (int j = 0; j < 32; ++j) S[j] = 0.f;
    const int sst = tid >> 5, sc4 = (tid & 31) * 4;
    float lb[4];
#pragma unroll
    for (int j = 0; j < 4; ++j) { const int ch = h * 128 + sc4 + j;
        if (l == 0) lb[j] = 0.f; else { const float l0 = a->in[I_LB][((size_t)dir * DEPTH + 0) * BW + ch], l1 = a->in[I_LB][((size_t)dir * DEPTH + 1) * BW + ch]; lb[j] = 1.0f / (1.0f + __expf(l0 - l1)); } }
    for (int s0 = 0; s0 < CTXL + T; s0 += 16) {
        { const int row = chain_row(dir, b, s0 + sst); const bf16* pr = P + (size_t)row * INC + h * 128 + sc4;
          const u32x2 pq = *(const u32x2*)(pr + OFF_Q), pi = *(const u32x2*)(pr + OFF_I), pz = *(const u32x2*)(pr + (dir ? OFF_ZB : OFF_ZF));
          const float qf[4] = {bflo(pq.x), bfhi(pq.x), bflo(pq.y), bfhi(pq.y)}, vf[4] = {bflo(pi.x), bfhi(pi.x), bflo(pi.y), bfhi(pi.y)}, zf[4] = {bflo(pz.x), bfhi(pz.x), bflo(pz.y), bfhi(pz.y)};
          f32x4 oq, ok, of, ov;
#pragma unroll
          for (int j = 0; j < 4; ++j) { const float f = lb[j] + (1.0f - lb[j]) * sigmoidf_(zf[j]); oq[j] = siluf_(qf[j]); of[j] = f; ok[j] = 1.0f - f; ov[j] = vf[j]; }
          *(LAS f32x4*)(tq + sst * 128 + sc4) = oq; *(LAS f32x4*)(tk + sst * 128 + sc4) = ok; *(LAS f32x4*)(tf + sst * 128 + sc4) = of; *(LAS f32x4*)(tv + sst * 128 + sc4) = ov; }
        LDS_BAR();
        for (int st = 0; st < 16; ++st) {
            const float vv = tv[st * 128 + v]; float o0 = 0.f, o1 = 0.f;
#pragma unroll
            for (int j = 0; j < 8; ++j) { const f32x4 fq4 = *(const LAS f32x4*)(tf + st * 128 + q * 32 + 4 * j), kq4 = *(const LAS f32x4*)(tk + st * 128 + q * 32 + 4 * j), qq4 = *(const LAS f32x4*)(tq + st * 128 + q * 32 + 4 * j);
#pragma unroll
                for (int i = 0; i < 4; ++i) { const float sn = fq4[i] * S[4 * j + i] + kq4[i] * vv; S[4 * j + i] = sn; if (i & 1) o1 += qq4[i] * sn; else o0 += qq4[i] * sn; } }
            float o = o0 + o1; o += dpp_xor1(o); o += dpp_xor2(o);
            if (q == 0) ot[st * 128 + v] = o;
        }
        LDS_BAR();
        if (tid < 256) { const int st = tid >> 4, part = tid & 15; const int row = chain_row(dir, b, s0 + st); const LAS float* op = ot + st * 128 + part * 8;
            float f[8];
#pragma unroll
            for (int j = 0; j < 8; ++j) f[j] = op[j];
            *(u32x4*)(OB + ((size_t)dir * MALL + row) * BW + h * 128 + part * 8) = pack8(f); }
    }
    LDS_BAR();
}

__device__ __forceinline__ float grp_sum32(float v) { v += __shfl_xor(v, 1); v += __shfl_xor(v, 2); v += __shfl_xor(v, 4); v += __shfl_xor(v, 8); v += __shfl_xor(v, 16); return v; }
__device__ __forceinline__ float grp_sum16(float v) { v += __shfl_xor(v, 1); v += __shfl_xor(v, 2); v += __shfl_xor(v, 4); v += __shfl_xor(v, 8); return v; }
__device__ __forceinline__ void phase_finalize(KArgs a, int l, bool dry) {
    const int tid_ = tid_fresh(); const int lane = tid_ & 63, wave = tid_ >> 6, gw = blockIdx.x * 8 + wave, NGW = gridDim.x * 8;
    unsigned char* ws = a->ws;
    const bf16* P = (const bf16*)(ws + WS_P); const bf16* OB = (const bf16*)(ws + WS_OB); const bf16* OC = (const bf16*)(ws + WS_OC); bf16* Y = (bf16*)(ws + WS_Y);
    bf16* Yo = dry ? (bf16*)(ws + WS_END) : Y;
    const int nrows = (l == DEPTH - 1) ? NLAT : MALL;
    const int rpw = (nrows + NGW - 1) / NGW; const int r0 = gw * rpw, r1 = (r0 + rpw < nrows) ? r0 + rpw : nrows;
    f32x4 hng[3], gng[3], gnb[3];
#pragma unroll
    for (int k = 0; k < 3; ++k) { const int c = 256 * k + 4 * lane; hng[k] = *(const f32x4*)(a->in[I_HNG] + (size_t)l * BW + c);
        gng[k] = *(const f32x4*)(a->in[I_GNGG] + (size_t)l * CW + c); gnb[k] = *(const f32x4*)(a->in[I_GNB] + (size_t)l * CW + c); }
    for (int row = r0; row < r1; ++row) {
        const int orow = dry ? (row & 2047) : row;
        u32x2 bf_[3], bb_[3], bg_[3], cf_[3], cb_[3], cv_[3], cg_[3];
#pragma unroll
        for (int k = 0; k < 3; ++k) { const int c = 256 * k + 4 * lane;
            bf_[k] = *(const u32x2*)(OB + (size_t)row * BW + c); bb_[k] = *(const u32x2*)(OB + ((size_t)MALL + row) * BW + c); bg_[k] = *(const u32x2*)(P + (size_t)row * INC + OFF_OG + c);
            cf_[k] = *(const u32x2*)(OC + (size_t)row * CW + c); cb_[k] = *(const u32x2*)(OC + ((size_t)MALL + row) * CW + c);
            cv_[k] = *(const u32x2*)(Y + (size_t)row * D + 512 + c);
            cg_[k] = *(const u32x2*)(Y + (size_t)row * D + 1280 + c); }
#pragma unroll
        for (int k = 0; k < 3; ++k) { const int c = 256 * k + 4 * lane;
            { float o[4] = {bflo(bf_[k].x) + bflo(bb_[k].x), bfhi(bf_[k].x) + bfhi(bb_[k].x), bflo(bf_[k].y) + bflo(bb_[k].y), bfhi(bf_[k].y) + bfhi(bb_[k].y)};
              const float ss = grp_sum32((o[0] * o[0] + o[1] * o[1]) + (o[2] * o[2] + o[3] * o[3])); const float rstd = 1.0f / sqrtf(ss * (1.0f / 128.0f) + NORM_EPS);
              const float g4[4] = {bflo(bg_[k].x), bfhi(bg_[k].x), bflo(bg_[k].y), bfhi(bg_[k].y)}; float y[4];
#pragma unroll
              for (int j = 0; j < 4; ++j) y[j] = o[j] * rstd * hng[k][j] * sigmoidf_(g4[j]);
              u32x2 q; q.x = pk2(y[0], y[1]); q.y = pk2(y[2], y[3]); *(u32x2*)(Yo + (size_t)orow * D + 512 + c) = q; }
            { float o[4] = {bflo(cf_[k].x) + bflo(cb_[k].x), bfhi(cf_[k].x) + bfhi(cb_[k].x), bflo(cf_[k].y) + bflo(cb_[k].y), bfhi(cf_[k].y) + bfhi(cb_[k].y)};
              const float v4[4] = {bflo(cv_[k].x), bfhi(cv_[k].x), bflo(cv_[k].y), bfhi(cv_[k].y)}, g4[4] = {bflo(cg_[k].x), bfhi(cg_[k].x), bflo(cg_[k].y), bfhi(cg_[k].y)};
              const float mean = grp_sum16((o[0] + o[1]) + (o[2] + o[3])) * (1.0f / 64.0f);
              float dl[4]; float sq = 0.f;
#pragma unroll
              for (int j = 0; j < 4; ++j) { dl[j] = o[j] - mean; sq += dl[j] * dl[j]; }
              const float var = grp_sum16(sq) * (1.0f / 64.0f); const float rs = 1.0f / sqrtf(var + GN_EPS); float y[4];
#pragma unroll
              for (int j = 0; j < 4; ++j) y[j] = (dl[j] * rs * gng[k][j] + gnb[k][j] + v4[j]) * g4[j];
              u32x2 q; q.x = pk2(y[0], y[1]); q.y = pk2(y[2], y[3]); *(u32x2*)(Yo + (size_t)orow * D + 1280 + c) = q; }
        }
    }
}

__global__ void __launch_bounds__(NTHREADS, 2) mk_fwd(Args args_unused) {
    extern __shared__ __attribute__((aligned(16))) unsigned char lds_raw[];
    LAS unsigned char* lds = (LAS unsigned char*)lds_raw;
    volatile LAS unsigned* misc = (volatile LAS unsigned*)(lds + LDS_MISC);
    const int tid = threadIdx.x, G = gridDim.x;
    if (tid < 64) misc[tid] = 0u;
    __syncthreads();
    XcdBarrier bar; bar.bar = nullptr; bar.x = 0; bar.st = nullptr;
    int lo, hi;
    { KArgs a = kargs(); lo = a->ph_lo; hi = a->ph_hi; unsigned* ctl = (unsigned*)(a->ws + WS_CTL); bar.bar = ctl + CW_BAR; if (!MK_MULTI) bar = xcd_barrier_post(ctl + CW_BAR, misc + 8); }
    const int cvirt = (G % 8 == 0) ? ((int)blockIdx.x % 8) * (G / 8) + (int)blockIdx.x / 8 : (int)blockIdx.x;
#define IN(k) (lo <= (k) && (k) < hi)
#define PM(b) ((PHMASK >> (b)) & 1)
#define REP(b) _Pragma("unroll 1") for (int rep_ = 0; rep_ < 1 + ((PROBE_DUP >> (b)) & 1); ++rep_)
#define SEAM(k) do { if (!MK_MULTI && IN(k) && IN((k) + 1)) { xcd_barrier(bar); if ((PROBE_DUP >> 13) & 1) xcd_barrier(bar); } } while (0)

    if (PM(0) && IN(0)) REP(0) { phase_prologue(kargs(), lds); } SEAM(0);

#pragma unroll 1
    for (int l = 0; l < DEPTH; ++l) {
        const int pb = 1 + 9 * l;
        const bool lastl = (l == DEPTH - 1);
        if (PM(1) && IN(pb + 0)) { if ((PROBE_DUP >> 1) & 1) { if (l == 0) phase_norm1<0>(kargs(), l, true); else phase_norm1<1>(kargs(), l, true); } if (l == 0) phase_norm1<0>(kargs(), l, false); else { phase_norm1<1>(kargs(), l, false); __syncthreads(); convert_moe(kargs(), l, lds); __syncthreads(); } } SEAM(pb + 0);
        if (PM(2) && IN(pb + 1)) REP(2) {
            KArgs a = kargs(); unsigned char* ws = a->ws;
            pg8::Gemm g{(const bf16*)(ws + WS_H), (const bf16*)(ws + WS_WIN) + (size_t)l * INC * D, MALL, INC, D};
            pg8::StaticOrder S; S.init(MALL, INC, G, (int)blockIdx.x);
            pg8::EpiBf16 E{(bf16*)(ws + WS_P), INC};
            pg8::gemm_phase<pg8::EpiBf16, pg8::StaticOrder, true, false>(lds, g, S, E, nullptr);
        } SEAM(pb + 1);
        if (PM(3) && IN(pb + 2)) REP(3) {
            const int ngm = lastl ? 1024 : 1088;
            for (int it = blockIdx.x; it < ngm + 544 * 12; it += G) { if (it < ngm) gmlp_item(kargs(), l, it, lds); else { const int q = it - ngm; rwkv_prep_item(kargs(), l, q / 12, q % 12, lds); } }
        } SEAM(pb + 2);
        if (PM(4) && IN(pb + 3)) REP(4) {
            if (G == 256) { const int bx = blockIdx.x;
                if (bx < 96) rwkv_chain_mfma(kargs(), bx * 8);
                else if (bx < 192) hgrn_chain_mfma(kargs(), l, bx - 96, lds); }
            else { for (int it = blockIdx.x; it < 192; it += G) { if (it < 96) rwkv_chain_mfma(kargs(), it * 8); else hgrn_chain_mfma(kargs(), l, it - 96, lds); } }
        } SEAM(pb + 3);
        if (PM(5) && IN(pb + 4)) { if ((PROBE_DUP >> 5) & 1) phase_finalize(kargs(), l, true); phase_finalize(kargs(), l, false); } SEAM(pb + 4);
        if (PM(6) && IN(pb + 5)) REP(6) {
            KArgs a = kargs(); unsigned char* ws = a->ws;
            const int Mo = lastl ? NLAT : MALL;
            pg8::Gemm g{(const bf16*)(ws + WS_Y), (const bf16*)(ws + WS_WOUT) + (size_t)l * D * D, Mo, D, D};
            pg8::StaticOrder S; S.init(Mo, D, G, (int)blockIdx.x);
            const float* xl = l == 0 ? a->in[I_X] : (const float*)(ws + WS_X); const float* xc = l == 0 ? a->in[I_CTX] : (const float*)(ws + WS_X) + (size_t)NLAT * D;
            pg8::EpiResid E{xl, xc, (float*)(ws + WS_X), (const float*)(ws + WS_MOD) + (size_t)l * 9 * 12288 + 2 * D};
            pg8::gemm_phase<pg8::EpiResid, pg8::StaticOrder, true, false>(lds, g, S, E, nullptr);
        } SEAM(pb + 5);
        if (PM(7) && IN(pb + 6)) { if ((PROBE_DUP >> 7) & 1) phase_norm2_router(kargs(), l, true, lds); phase_norm2_router(kargs(), l, false, lds); } SEAM(pb + 6);
        if (PM(8) && IN(pb + 7)) REP(8) {
            KArgs a = kargs(); unsigned char* ws = a->ws;
            moe_tables<false>(a, l, lds, cvirt);
            pg8::Gemm g{(const bf16*)(ws + WS_H), (const bf16*)(ws + WS_WGU), 0, 2048, D};
            pg8::MoeOrder S{(const LAS int*)(lds + LDS_TP), G, cvirt, (unsigned)(2048 * D * 2)};
            pg8::EpiSwiglu E{(bf16*)(ws + WS_ACT)};
            pg8::gemm_phase<pg8::EpiSwiglu, pg8::MoeOrder, false, true>(lds, g, S, E, (const LAS unsigned*)(lds + LDS_TAB));
        } SEAM(pb + 7);
        if (PM(9) && IN(pb + 8)) REP(9) {
            KArgs a = kargs(); unsigned char* ws = a->ws;
            moe_tables<true>(a, l, lds, cvirt);
            pg8::Gemm g{(const bf16*)(ws + WS_ACT), (const bf16*)(ws + WS_WDN), 0, D, DE};
            pg8::MoeOrder S{(const LAS int*)(lds + LDS_TP), G, cvirt, (unsigned)(D * DE * 2)};
            pg8::EpiDown E{(bf16*)(ws + WS_YK), (const LAS unsigned*)(lds + LDS_TAB), (const LAS float*)(lds + LDS_TABW)};
            pg8::gemm_phase<pg8::EpiDown, pg8::MoeOrder, false, false>(lds, g, S, E, nullptr);
        } SEAM(pb + 8);
    }
    if (PM(10) && IN(1 + 9 * DEPTH)) { if ((PROBE_DUP >> 10) & 1) phase_norm1<2>(kargs(), DEPTH, true); phase_norm1<2>(kargs(), DEPTH, false); }
#undef IN
#undef SEAM
}

extern "C" void kernel_launch(void* const* d_in, const int* in_sizes, int n_in, void* d_out, int out_size, void* d_ws, size_t ws_size, hipStream_t stream) {
    static int grid = 0;
    if (grid == 0) {
        if (n_in != 31 || ws_size < WS_END) { fprintf(stderr, "kernel_launch: unexpected n_in %d / ws %zu (need %zu)\n", n_in, ws_size, (size_t)WS_END); grid = -1; return; }
        int dev = 0, cus = 0, per_cu = 0;
        hipGetDevice(&dev); hipDeviceGetAttribute(&cus, hipDeviceAttributeMultiprocessorCount, dev);
        if (hipFuncSetAttribute((const void*)mk_fwd, hipFuncAttributeMaxDynamicSharedMemorySize, LDS_BYTES) != hipSuccess) { fprintf(stderr, "kernel_launch: hipFuncSetAttribute failed\n"); grid = -1; return; }
        if (hipOccupancyMaxActiveBlocksPerMultiprocessor(&per_cu, (const void*)mk_fwd, NTHREADS, LDS_BYTES) != hipSuccess || per_cu < 1) fprintf(stderr, "kernel_launch: occupancy query says %d\n", per_cu);
        (void)hipGetLastError();
        grid = cus > 0 ? cus : 256;
    }
    if (grid < 0) return;
    hipMemsetAsync((char*)d_ws + WS_CTL, 0, CTL_ZERO_BYTES, stream);
    Args a{};
    for (int i = 0; i < 31; ++i) a.in[i] = (const float*)d_in[i];
    a.out = (float*)d_out; a.ws = (unsigned char*)d_ws;
    constexpr int NPH = 2 + 9 * DEPTH;
#if MK_MULTI
    for (int p = 0; p < NPH; ++p) { a.ph_lo = p; a.ph_hi = p + 1; hipLaunchKernelGGL(mk_fwd, dim3(grid), dim3(NTHREADS), LDS_BYTES, stream, a); }
#else
    a.ph_lo = 0; a.ph_hi = NPH; hipLaunchKernelGGL(mk_fwd, dim3(grid), dim3(NTHREADS), LDS_BYTES, stream, a);
#endif
}
```

```cpp
#include <hip/hip_runtime.h>
#include <cstdio>
#include <cstdint>

#ifndef PHMASK
#define PHMASK 0xFFFF
#endif
#ifndef PROBE_DUP
#define PROBE_DUP 0
#endif
#ifndef MK_MULTI
#define MK_MULTI 0
#endif

#define GAS __attribute__((address_space(1)))
#define LAS __attribute__((address_space(3)))
typedef unsigned short bf16;
typedef short bf16x8 __attribute__((ext_vector_type(8)));
typedef float f32x4 __attribute__((ext_vector_type(4)));
typedef float f32x2 __attribute__((ext_vector_type(2)));
typedef unsigned u32x4 __attribute__((ext_vector_type(4)));
typedef unsigned u32x2 __attribute__((ext_vector_type(2)));

constexpr int D = 2048, NB = 8, T = 4096, CTXL = 256, DEPTH = 2;
constexpr int NLAT = NB * T, NCTX = NB * CTXL, MALL = NLAT + NCTX;
constexpr int INC = 7424;
constexpr int OFF_U = 0, OFF_V = 512, OFF_Q = 1024, OFF_I = 1792, OFF_ZF = 2560, OFF_ZB = 3328, OFF_OG = 4096;
constexpr int OFF_C = 4864;
constexpr int BW = 768, CW = 768, CCOLS = 2560;
constexpr int NE = 16, DE = 1024;
constexpr int PC2W = 7 * 768;
constexpr int NTHREADS = 512;
constexpr float NORM_EPS = 1e-6f, GN_EPS = 64e-5f, DECAY_SCALE = 0.60653065971263342f;

constexpr size_t MiB = 1u << 20;
constexpr size_t WS_CTL = 0, CTL_ZERO_BYTES = 1 * MiB;
constexpr size_t WS_MOD = 1 * MiB;
constexpr size_t WS_SMALLW = 2 * MiB;
constexpr size_t SW_WUP = 0, SW_AUP = SW_WUP + (size_t)2 * 2 * 768 * 64 * 2, SW_GUP = SW_AUP + (size_t)2 * 768 * 64 * 2, SW_GWS = SW_GUP + (size_t)2 * 768 * 128 * 2;
constexpr size_t WS_WIN = 4 * MiB, WS_WOUT = 62 * MiB, WS_WGU = 78 * MiB, WS_WDN = 206 * MiB;
constexpr size_t WS_X = 270 * MiB, WS_H = 542 * MiB, WS_Y = 678 * MiB, WS_P = 814 * MiB, WS_PRE = 1307 * MiB, WS_VT = 1817 * MiB, WS_OC = 1868 * MiB, WS_HQB = 1970 * MiB, WS_HG = 2021 * MiB, WS_END = 2028 * MiB;
constexpr int PRE_REC = 10240, PR_WP = 0, PR_RP = 2048, PR_BK = 4096, PR_ARBK = 8192, PR_MAK = 9216, PR_GAM = 9728, NCHUNK16 = 272;
constexpr size_t WS_OB = WS_H;
constexpr size_t WS_ACT = WS_P, WS_YK = WS_P + 144 * MiB, WS_RIDX = WS_P + 416 * MiB, WS_RW = WS_RIDX + 3 * MiB;
static_assert(WS_RW + 3 * MiB <= WS_PRE, "moe overlay");
constexpr int MAXSLOT_TILES = 288;
constexpr int CW_BAR = 4096;
constexpr int CW_CNT = 16384;

constexpr int LDS_STAGE = 0, LDS_TAB = 131072, LDS_TABW = LDS_TAB + 9 * 1024, LDS_TP = LDS_TABW + 9 * 1024, LDS_MISC = 150528, LDS_BYTES = 152 * 1024;
static_assert(LDS_TP + 128 <= LDS_MISC, "lds map");

typedef __bf16 bf16x2_t __attribute__((ext_vector_type(2)));
__device__ __forceinline__ unsigned pk2(float lo, float hi) { const f32x2 v = {lo, hi}; return __builtin_bit_cast(unsigned, __builtin_convertvector(v, bf16x2_t)); }
__device__ __forceinline__ unsigned f2bf(float f) { return pk2(f, f) & 0xffffu; }
__device__ __forceinline__ float bflo(unsigned u) { return __builtin_bit_cast(float, u << 16); }
__device__ __forceinline__ float bfhi(unsigned u) { return __builtin_bit_cast(float, u & 0xffff0000u); }
__device__ __forceinline__ float bf1(bf16 b) { return __builtin_bit_cast(float, ((unsigned)b) << 16); }
__device__ __forceinline__ float sigmoidf_(float x) { return __builtin_amdgcn_rcpf(1.0f + __expf(-x)); }
__device__ __forceinline__ float siluf_(float x) { return x * __builtin_amdgcn_rcpf(1.0f + __expf(-x)); }
__device__ __forceinline__ float geluf_(float v) {
    const float av = fabsf(v), t = __builtin_amdgcn_rcpf(av * 0.2316418882f + 1.0f);
    float q = t * 0.5307027145f + (-0.7265760135f); q = q * t + 0.7107068705f; q = q * t + (-0.142248368f); q = q * t + 0.127414796f; q = q * t;
    const float e = __builtin_amdgcn_exp2f((v * v) * (-0.72134752044f)); const float m = v * (q * e); return v < 0.f ? m : v - m; }
__device__ __forceinline__ float wave_sum(float v) {
#pragma unroll
    for (int o = 1; o < 64; o <<= 1) v += __shfl_xor(v, o);
    return v;
}
__device__ __forceinline__ int tid_fresh() { int t = threadIdx.x; asm volatile("" : "+v"(t)); return t; }
__device__ __forceinline__ void unpack8(const u32x4 v, float (&f)[8]) {
    f[0] = bflo(v.x); f[1] = bfhi(v.x); f[2] = bflo(v.y); f[3] = bfhi(v.y); f[4] = bflo(v.z); f[5] = bfhi(v.z); f[6] = bflo(v.w); f[7] = bfhi(v.w);
}
__device__ __forceinline__ u32x4 pack8(const float (&f)[8]) { u32x4 v; v.x = pk2(f[0], f[1]); v.y = pk2(f[2], f[3]); v.z = pk2(f[4], f[5]); v.w = pk2(f[6], f[7]); return v; }
__device__ __forceinline__ int modrow_of(int row) { return row < NLAT ? (row >> 12) : 8; }

#define XB_TMO      128
#define XB_XCNT(j)  (256  + 64 * (j))
#define XB_XSUB(j)  (1280 + 64 * (j))
#define XB_XGEN(j)  (2304 + 64 * (j))
#define XB_TOP      3328
#define XB_TOPGEN   3392
#define XCD_BAR_WORDS 3456
#define XB_SPIN_CAP (1u << 18)
__device__ __forceinline__ unsigned xb_ld(unsigned* p)              { return __hip_atomic_load(p, __ATOMIC_RELAXED, __HIP_MEMORY_SCOPE_AGENT); }
__device__ __forceinline__ unsigned xb_add(unsigned* p, unsigned v) { return __hip_atomic_fetch_add(p, v, __ATOMIC_RELAXED, __HIP_MEMORY_SCOPE_AGENT); }
__device__ __forceinline__ unsigned xb_xcc_id() { return (unsigned)__builtin_amdgcn_s_getreg((3 << 11) | 20) & 0xFu; }
#define XB_SPIN(cond, bar) do { unsigned _sp = 0; while (cond) { __builtin_amdgcn_s_sleep(1); \
    if ((++_sp & 255u) == 0u) { if (xb_ld(&(bar)[XB_TMO])) break; if (_sp > XB_SPIN_CAP) { atomicAdd(&(bar)[XB_TMO], 1u); break; } } } } while (0)
struct XcdBarrier { unsigned* bar; unsigned x; volatile LAS unsigned* st; };
__device__ __forceinline__ XcdBarrier xcd_barrier_post(unsigned* bar, volatile LAS unsigned* st) {
    XcdBarrier b; b.bar = bar; b.x = xb_xcc_id(); b.st = st;
    if (threadIdx.x == 0) (void)xb_add(&bar[XB_XCNT(b.x)], 1u);
    return b;
}
__device__ __forceinline__ void xcd_barrier_complete(unsigned* bar, unsigned x, unsigned& nloc, unsigned& nx) {
    const unsigned G = gridDim.x * gridDim.y * gridDim.z;
    unsigned sum, cnt, mine, sp = 0u;
    for (;;) {
        sum = 0u; cnt = 0u; mine = 0u;
#pragma unroll
        for (unsigned j = 0; j < 16; ++j) { const unsigned c = xb_ld(&bar[XB_XCNT(j)]); sum += c; cnt += (c > 0u) ? 1u : 0u; mine = (j == x) ? c : mine; }
        if (sum == G) break;
        __builtin_amdgcn_s_sleep(1);
        if ((++sp & 255u) == 0u) { if (xb_ld(&bar[XB_TMO])) break; if (sp > XB_SPIN_CAP) { atomicAdd(&bar[XB_TMO], 1u); break; } }
    }
    nloc = mine > 0u ? mine : 1u; nx = cnt > 0u ? cnt : 1u;
}
__device__ __forceinline__ void xcd_barrier(const XcdBarrier& b) {
    asm volatile("s_waitcnt vmcnt(0)" ::: "memory");
    __syncthreads();
    if (threadIdx.x == 0) {
        unsigned* bar = b.bar;
        __builtin_amdgcn_s_waitcnt(0);
        unsigned nloc = b.st[0], nx = b.st[1];
        if (nloc == 0u) { xcd_barrier_complete(bar, b.x, nloc, nx); b.st[0] = nloc; b.st[1] = nx; }
        const unsigned old = xb_add(&bar[XB_XSUB(b.x)], 1u);
        const unsigned gen = old / nloc;
        if (old + 1u == (gen + 1u) * nloc) {
            __builtin_amdgcn_fence(__ATOMIC_RELEASE, "agent");
            asm volatile("s_waitcnt vmcnt(0)" ::: "memory");
            const unsigned og = xb_add(&bar[XB_TOP], 1u);
            const unsigned tg = og / nx;
            if (og + 1u == (tg + 1u) * nx) xb_add(&bar[XB_TOPGEN], 1u);
            else XB_SPIN(xb_ld(&bar[XB_TOPGEN]) == tg, bar);
            __builtin_amdgcn_fence(__ATOMIC_ACQUIRE, "agent");
            xb_add(&bar[XB_XGEN(b.x)], 1u);
            asm volatile("s_waitcnt vmcnt(0)" ::: "memory");
        } else {
            XB_SPIN(xb_ld(&bar[XB_XGEN(b.x)]) == gen, bar);
            __builtin_amdgcn_fence(__ATOMIC_ACQUIRE, "agent");
            asm volatile("s_waitcnt vmcnt(0)" ::: "memory");
        }
    }
    __syncthreads();
}

namespace pg8 {
constexpr int BM = 256, BK = 64, HALF = 128, HTB = HALF * BK * 2, STAGE_BYTES = 8 * HTB, NXCD = 8, WGM = 8;
__host__ __device__ __forceinline__ int lds_byte(int r, int c) { const int st = (r >> 4) * 2 + (c >> 5), rr = r & 15, cc = c & 31, ob = rr * 64 + cc * 2; return st * 1024 + (ob ^ (((ob >> 9) & 1) << 5)); }
__host__ __device__ __forceinline__ void stage_rc(int b, int& R, int& C) { const int st = b / 1024, sb = b % 1024, swz = sb ^ (((sb >> 9) & 1) << 5); R = (st >> 1) * 16 + swz / 64; C = (st & 1) * 32 + (swz % 64) / 2; }
__host__ __device__ __forceinline__ int perm32(int rho) { const int n = rho >> 4, i = rho & 15; return 8 * (i >> 2) + 4 * n + (i & 3); }

struct Unit { int pm, pn, e, aux; };
struct Gemm { const bf16* A; const bf16* Bt; int M, N, K; };

struct StaticOrder {
    int nM, nN, nwg, G, c;
    __device__ void init(int M, int N, int G_, int c_) { nM = M / BM; nN = N / BM; nwg = nM * nN; G = G_; c = c_; }
    __device__ bool next(int i, Unit& u) const {
        const long L = (long)i * G + c; if (L >= nwg) return false;
        int wgid = (int)L; { const int q = nwg / NXCD, r = nwg % NXCD, xcd = wgid % NXCD, off = wgid / NXCD; wgid = (xcd < r ? xcd * (q + 1) : r * (q + 1) + (xcd - r) * q) + off; }
        const int nig = WGM * nN, gid = wgid / nig, fm = gid * WGM, gsz = (nM - fm) < WGM ? (nM - fm) : WGM;
        u.pm = fm + ((wgid % nig) % gsz); u.pn = (wgid % nig) / gsz; u.e = 0; u.aux = 0; return true;
    }
    __device__ __forceinline__ unsigned b_off(const Unit& u, unsigned tstep) const { return (unsigned)u.pn * tstep; }
};
struct MoeOrder {
    const LAS int* tp; int G, c; unsigned estride;
    __device__ bool next(int i, Unit& u) const {
        const int L = i * G + c; const int ntot = tp[16] * 8; if (L >= ntot) return false;
        const int tile = L >> 3; int e = 0;
#pragma unroll
        for (int j = 1; j < 16; ++j) e += (tile >= tp[j]) ? 1 : 0;
        u.pm = tile; u.pn = L & 7; u.e = e; u.aux = i; return true;
    }
    __device__ __forceinline__ unsigned b_off(const Unit& u, unsigned tstep) const { return (unsigned)u.e * estride + (unsigned)u.pn * tstep; }
};

#define PG8_LAS __attribute__((address_space(3)))
template <class Epi, class Sched, bool ALIGN_EPI, bool GATHER>
__device__ __forceinline__ void gemm_phase(PG8_LAS unsigned char* lds, const Gemm g, const Sched& S, const Epi& E, const PG8_LAS unsigned* tabA) {
    const int tid = tid_fresh(), wid = __builtin_amdgcn_readfirstlane(tid >> 6), lane = tid & 63, wr = wid >> 2, wc = wid & 3, fr = lane & 15, fq = lane >> 4;
    const int K = g.K, nt = K / BK;
    int sR[2], sC[2];
    unsigned voffB[2];
#pragma unroll
    for (int i = 0; i < 2; ++i) { int R, C; stage_rc(tid * 16 + i * 8192, R, C); sR[i] = R; sC[i] = C; const int Rb = Epi::PERM ? ((R & ~31) + perm32(R & 31)) : R;
        voffB[i] = (unsigned)(Rb * K + C) * 2u; }
    const unsigned kstep = (unsigned)(BK * 2);
    const unsigned hstep = (unsigned)(HALF * K * 2);
    const unsigned tstep = 2u * hstep;
    const unsigned ldsw = (unsigned)wid * 1024u;
    const char* const baseA = (const char*)g.A; const char* const baseB = (const char*)g.Bt;
    const int aoff = lds_byte(wr * 64 + fr, fq * 8), boff = lds_byte(wc * 32 + fr, fq * 8);
#define PG8_SA(b, h) (((b) * 2 + (h)) * HTB)
#define PG8_SB(b, h) ((4 + (b) * 2 + (h)) * HTB)
#define PG8_STAGE(bufoff, gbase, uoff, voff) do { _Pragma("unroll") for (int _i = 0; _i < 2; ++_i) \
        __builtin_amdgcn_global_load_lds((const unsigned*)((gbase) + (size_t)(unsigned)((uoff) + (voff)[_i])), (PG8_LAS unsigned*)(lds + (bufoff) + ldsw + _i * 8192), 16, 0, 0); } while (0)
#define PG8_LDA(dst, b, h) do { _Pragma("unroll") for (int m = 0; m < 4; ++m) _Pragma("unroll") for (int k = 0; k < 2; ++k) dst[m][k] = *(const PG8_LAS bf16x8*)(lds + PG8_SA(b, h) + aoff + m * 2048 + k * 1024); } while (0)
#define PG8_LDB(dst, b, h) do { _Pragma("unroll") for (int n = 0; n < 2; ++n) _Pragma("unroll") for (int k = 0; k < 2; ++k) dst[n][k] = *(const PG8_LAS bf16x8*)(lds + PG8_SB(b, h) + boff + n * 2048 + k * 1024); } while (0)
#define PG8_MMA(ai, bj, At, Bt) do { __builtin_amdgcn_s_setprio(1); _Pragma("unroll") for (int m = 0; m < 4; ++m) _Pragma("unroll") for (int n = 0; n < 2; ++n) _Pragma("unroll") for (int k = 0; k < 2; ++k) \
        acc[ai][bj][m][n] = __builtin_amdgcn_mfma_f32_16x16x32_bf16(Bt[n][k], At[m][k], acc[ai][bj][m][n], 0, 0, 0); __builtin_amdgcn_s_setprio(0); } while (0)
#define PG8_WAIT_V(n) asm volatile("s_waitcnt vmcnt(" #n ")" ::: "memory")
#define PG8_WAIT_L(n) asm volatile("s_waitcnt lgkmcnt(" #n ")" ::: "memory")
#define PG8_BAR __builtin_amdgcn_s_barrier()
#define PG8_SCHED __builtin_amdgcn_sched_barrier(0)
    Unit cur, nxt; int ui = 0;
    if (!S.next(0, cur)) return;
    f32x4 acc[2][2][4][2];
#pragma unroll
    for (int a = 0; a < 2; ++a)
#pragma unroll
        for (int b = 0; b < 2; ++b)
#pragma unroll
            for (int m = 0; m < 4; ++m)
#pragma unroll
                for (int n = 0; n < 2; ++n) acc[a][b][m][n] = (f32x4){0.f, 0.f, 0.f, 0.f};
    bf16x8 At[4][2], B0[2][2], B1[2][2];
    unsigned vA0[2], vA1[2], nA0[2], nA1[2];
    unsigned uA, uB = S.b_off(cur, tstep);
    if constexpr (GATHER) { uA = 0u;
#pragma unroll
        for (int i = 0; i < 2; ++i) { vA0[i] = tabA[cur.aux * 256 + sR[i]] + (unsigned)sC[i] * 2u; vA1[i] = tabA[cur.aux * 256 + 128 + sR[i]] + (unsigned)sC[i] * 2u; }
    } else { uA = (unsigned)cur.pm * tstep;
#pragma unroll
        for (int i = 0; i < 2; ++i) { vA0[i] = (unsigned)(sR[i] * K + sC[i]) * 2u; vA1[i] = vA0[i] + hstep; }
    }
    PG8_STAGE(PG8_SB(0, 0), baseB, uB, voffB); PG8_STAGE(PG8_SB(0, 1), baseB, uB + hstep, voffB); PG8_STAGE(PG8_SA(0, 0), baseA, uA, vA0); PG8_STAGE(PG8_SA(0, 1), baseA, uA, vA1);
    if (wr == 1) PG8_BAR;
    PG8_WAIT_V(2); PG8_BAR;
    PG8_STAGE(PG8_SB(1, 0), baseB, uB + kstep, voffB); PG8_STAGE(PG8_SA(1, 0), baseA, uA + kstep, vA0); PG8_STAGE(PG8_SB(1, 1), baseB, uB + hstep + kstep, voffB);
    PG8_WAIT_V(6); PG8_BAR;
    for (;;) {
        const bool has_next = S.next(ui + 1, nxt);
        unsigned nuA, nuB = has_next ? S.b_off(nxt, tstep) : uB;
        if constexpr (GATHER) { nuA = 0u;
#pragma unroll
            for (int i = 0; i < 2; ++i) { if (has_next) { nA0[i] = tabA[nxt.aux * 256 + sR[i]] + (unsigned)sC[i] * 2u; nA1[i] = tabA[nxt.aux * 256 + 128 + sR[i]] + (unsigned)sC[i] * 2u; } else { nA0[i] = vA0[i]; nA1[i] = vA1[i]; } }
        } else { nuA = has_next ? (unsigned)nxt.pm * tstep : uA;
#pragma unroll
            for (int i = 0; i < 2; ++i) { nA0[i] = vA0[i]; nA1[i] = vA1[i]; }
        }
        for (int t = 0; t < nt; t += 2) {
            const bool last = (t == nt - 2);
            const unsigned a1 = uA + (unsigned)(t + 1) * kstep;
            const unsigned a2 = last ? nuA : uA + (unsigned)(t + 2) * kstep; const unsigned b2 = last ? nuB : uB + (unsigned)(t + 2) * kstep;
            const unsigned a3 = a2 + kstep; const unsigned b3 = b2 + kstep;
            unsigned w0[2], w1[2];
#pragma unroll
            for (int i = 0; i < 2; ++i) { w0[i] = (GATHER && last) ? nA0[i] : vA0[i]; w1[i] = (GATHER && last) ? nA1[i] : vA1[i]; }
            PG8_LDB(B0, 0, 0); PG8_LDB(B1, 0, 1); PG8_SCHED; PG8_LDA(At, 0, 0); PG8_STAGE(PG8_SA(1, 1), baseA, a1, vA1);
            PG8_WAIT_V(8); PG8_WAIT_L(0); PG8_BAR; PG8_MMA(0, 0, At, B0); PG8_MMA(0, 1, At, B1); PG8_BAR; PG8_SCHED;
            PG8_LDA(At, 0, 1); PG8_STAGE(PG8_SB(0, 0), baseB, b2, voffB); PG8_STAGE(PG8_SB(0, 1), baseB, b2 + hstep, voffB); PG8_STAGE(PG8_SA(0, 0), baseA, a2, w0);
            PG8_WAIT_V(8); PG8_WAIT_L(0); PG8_BAR; PG8_MMA(1, 0, At, B0); PG8_MMA(1, 1, At, B1); PG8_BAR; PG8_SCHED;
            PG8_LDB(B0, 1, 0); PG8_LDB(B1, 1, 1); PG8_SCHED; PG8_LDA(At, 1, 0); PG8_STAGE(PG8_SA(0, 1), baseA, a2, w1);
            PG8_WAIT_V(8); PG8_WAIT_L(0); PG8_BAR; PG8_MMA(0, 0, At, B0); PG8_MMA(0, 1, At, B1); PG8_BAR; PG8_SCHED;
            PG8_LDA(At, 1, 1); PG8_STAGE(PG8_SB(1, 0), baseB, b3, voffB); PG8_STAGE(PG8_SB(1, 1), baseB, b3 + hstep, voffB); PG8_STAGE(PG8_SA(1, 0), baseA, a3, w0);
            PG8_WAIT_V(8); PG8_WAIT_L(0); PG8_BAR; PG8_MMA(1, 0, At, B0); PG8_MMA(1, 1, At, B1); PG8_BAR; PG8_SCHED;
        }
        if constexpr (ALIGN_EPI) { if (wr == 0) PG8_BAR; }
        E(acc, cur, wr, wc, fr, fq);
        if (!has_next) break;
#pragma unroll
        for (int a = 0; a < 2; ++a)
#pragma unroll
            for (int b = 0; b < 2; ++b)
#pragma unroll
                for (int m = 0; m < 4; ++m)
#pragma unroll
                    for (int n = 0; n < 2; ++n) acc[a][b][m][n] = (f32x4){0.f, 0.f, 0.f, 0.f};
        cur = nxt; uA = nuA; uB = nuB; ++ui;
#pragma unroll
        for (int i = 0; i < 2; ++i) { vA0[i] = nA0[i]; vA1[i] = nA1[i]; }
        if constexpr (ALIGN_EPI) { if (wr == 1) PG8_BAR; }
    }
    PG8_WAIT_V(0);
    if constexpr (!ALIGN_EPI) { if (wr == 0) PG8_BAR; }
    PG8_BAR;
#undef PG8_SA
#undef PG8_SB
#undef PG8_STAGE
#undef PG8_LDA
#undef PG8_LDB
#undef PG8_MMA
#undef PG8_WAIT_V
#undef PG8_WAIT_L
#undef PG8_BAR
#undef PG8_SCHED
}

__device__ __forceinline__ unsigned cvt_pk_bf16(float lo, float hi) { return pk2(lo, hi); }

struct EpiBf16 {
    static constexpr bool PERM = true;
    bf16* O; int ldc;
    __device__ __forceinline__ void operator()(const f32x4 (&acc)[2][2][4][2], const Unit& u, int wr, int wc, int fr, int fq) const {
        const int row0 = u.pm * BM + wr * 64 + fr; const int col0 = u.pn * BM + wc * 32 + 8 * fq;
#pragma unroll
        for (int ai = 0; ai < 2; ++ai)
#pragma unroll
            for (int m = 0; m < 4; ++m) { bf16* rowp = O + (size_t)(row0 + ai * HALF + m * 16) * ldc + col0;
#pragma unroll
                for (int bj = 0; bj < 2; ++bj) { const f32x4 v0 = acc[ai][bj][m][0], v1 = acc[ai][bj][m][1];
                    u32x4 w; w.x = cvt_pk_bf16(v0[0], v0[1]); w.y = cvt_pk_bf16(v0[2], v0[3]); w.z = cvt_pk_bf16(v1[0], v1[1]); w.w = cvt_pk_bf16(v1[2], v1[3]);
                    *(u32x4*)(rowp + bj * HALF) = w; } }
    }
};
struct EpiResid {
    static constexpr bool PERM = false;
    const float* xl; const float* xc; float* out; const float* gate;
    __device__ __forceinline__ void operator()(const f32x4 (&acc)[2][2][4][2], const Unit& u, int wr, int wc, int fr, int fq) const {
        const int rt = u.pm * BM; const bool isl = rt < NLAT;
        const float* base = isl ? xl + (size_t)rt * D : xc + (size_t)(rt - NLAT) * D;
        const float* gp = gate + (size_t)(isl ? (rt >> 12) : 8) * 12288;
        const int rl0 = wr * 64 + fr, col0 = u.pn * BM + wc * 32 + 4 * fq;
#pragma unroll
        for (int ai = 0; ai < 2; ++ai)
#pragma unroll
            for (int m = 0; m < 4; ++m) { const int rl = rl0 + ai * HALF + m * 16; const float* bp = base + (size_t)rl * D + col0; float* op = out + (size_t)(rt + rl) * D + col0;
#pragma unroll
                for (int bj = 0; bj < 2; ++bj)
#pragma unroll
                    for (int n = 0; n < 2; ++n) { const f32x4 b = *(const f32x4*)(bp + bj * HALF + n * 16); const f32x4 gv = *(const f32x4*)(gp + col0 + bj * HALF + n * 16); *(f32x4*)(op + bj * HALF + n * 16) = b + gv * acc[ai][bj][m][n]; }
                asm volatile("" ::: "memory"); }
    }
};
struct EpiSwiglu {
    static constexpr bool PERM = true;
    bf16* O;
    __device__ __forceinline__ void operator()(const f32x4 (&acc)[2][2][4][2], const Unit& u, int wr, int wc, int fr, int fq) const {
        const int row0 = u.pm * BM + wr * 64 + fr; const int col0 = u.pn * 128 + wc * 32 + 8 * fq;
#pragma unroll
        for (int ai = 0; ai < 2; ++ai)
#pragma unroll
            for (int m = 0; m < 4; ++m) { bf16* rowp = O + (size_t)(row0 + ai * HALF + m * 16) * DE + col0;
                float o[8];
#pragma unroll
                for (int n = 0; n < 2; ++n)
#pragma unroll
                    for (int j = 0; j < 4; ++j) { const float gt = acc[ai][0][m][n][j], up = acc[ai][1][m][n][j]; o[n * 4 + j] = gt * __builtin_amdgcn_rcpf(1.0f + __expf(-gt)) * up; }
                u32x4 w; w.x = cvt_pk_bf16(o[0], o[1]); w.y = cvt_pk_bf16(o[2], o[3]); w.z = cvt_pk_bf16(o[4], o[5]); w.w = cvt_pk_bf16(o[6], o[7]);
                *(u32x4*)rowp = w; }
    }
};
struct EpiDown {
    static constexpr bool PERM = true;
    bf16* YK; const PG8_LAS unsigned* tab; const PG8_LAS float* tabw;
    __device__ __forceinline__ void operator()(const f32x4 (&acc)[2][2][4][2], const Unit& u, int wr, int wc, int fr, int fq) const {
        const int rl0 = wr * 64 + fr; const int col0 = u.pn * BM + wc * 32 + 8 * fq;
#pragma unroll
        for (int ai = 0; ai < 2; ++ai)
#pragma unroll
            for (int m = 0; m < 4; ++m) { const int rl = rl0 + ai * HALF + m * 16; const unsigned ent = tab[u.aux * 256 + rl]; const float w = tabw[u.aux * 256 + rl];
                if (!(ent & 0x40000000u)) { bf16* rowp = YK + ((size_t)(ent >> 31) * MALL + (ent & 0xffffu)) * D + col0;
#pragma unroll
                    for (int bj = 0; bj < 2; ++bj) { const f32x4 v0 = acc[ai][bj][m][0] * w, v1 = acc[ai][bj][m][1] * w;
                        u32x4 q; q.x = cvt_pk_bf16(v0[0], v0[1]); q.y = cvt_pk_bf16(v0[2], v0[3]); q.z = cvt_pk_bf16(v1[0], v1[1]); q.w = cvt_pk_bf16(v1[2], v1[3]);
                        *(u32x4*)(rowp + bj * HALF) = q; } }
                asm volatile("" ::: "memory"); }
    }
};
}

struct Args { const float* in[31]; float* out; unsigned char* ws; int ph_lo, ph_hi; };
typedef const __attribute__((address_space(4))) Args* KArgs;
__device__ __forceinline__ KArgs kargs() { KArgs p = (KArgs)__builtin_amdgcn_kernarg_segment_ptr(); asm volatile("" : "+s"(p)); return p; }
#define AIN(i) (a->in[i])
enum { I_X = 0, I_C, I_CTX, I_CCTX, I_ADAW, I_ADAB, I_N1G, I_N2G, I_WIN, I_WOUT, I_GNG, I_GWS, I_GB, I_LB, I_HNG, I_MU, I_W0, I_WUP, I_A0, I_AUP, I_GUP, I_KK, I_KA, I_RK, I_GNGG, I_GNB, I_RW, I_RB, I_WGU, I_WDN, I_FNG };

__device__ __forceinline__ void p0_transpose_item(const float* W, int K, int N, bf16* WT, int n_row0, LAS float* scr, int kb, int nb, int lane) {
    const int k0 = 64 * kb, n0 = 32 * nb;
#pragma unroll 8
    for (int i = 0; i < 32; ++i) { const int kk = 2 * i + (lane >> 5); scr[kk * 33 + (lane & 31)] = W[(size_t)(k0 + kk) * N + n0 + (lane & 31)]; }
    asm volatile("s_waitcnt lgkmcnt(0)" ::: "memory");
    const int c = lane & 7;
#pragma unroll
    for (int j = 0; j < 4; ++j) { const int n = (lane >> 3) + 8 * j; const LAS float* s = scr + (8 * c) * 33 + n;
        u32x4 o; o.x = pk2(s[0 * 33], s[1 * 33]); o.y = pk2(s[2 * 33], s[3 * 33]); o.z = pk2(s[4 * 33], s[5 * 33]); o.w = pk2(s[6 * 33], s[7 * 33]);
        *(u32x4*)(WT + (size_t)(n_row0 + n) * K + k0 + 8 * c) = o; }
    asm volatile("s_waitcnt lgkmcnt(0)" ::: "memory");
}

__device__ __forceinline__ void convert_moe(KArgs a, int l, LAS unsigned char* lds) {
    const int tid = tid_fresh(), lane = tid & 63, wave = tid >> 6;
    const int gw = blockIdx.x * 8 + wave, NGW = gridDim.x * 8;
    unsigned char* ws = a->ws;
    LAS float* scr = (LAS float*)(lds + wave * 16384);
    constexpr int I_GU = 32 * 64, I_DN = 16 * 64, N2 = 16 * I_GU, N3 = N2 + 16 * I_DN;
    for (int it = gw; it < N3; it += NGW) {
        if (it < N2) { const int e = it / I_GU, r = it % I_GU, kb = r / 64, nb = r % 64;
            const int n0 = 32 * nb, hh = n0 >> 10, nn = n0 & 1023, row0 = 256 * (nn >> 7) + 128 * hh + (nn & 127);
            p0_transpose_item(a->in[I_WGU] + (size_t)(l * NE + e) * D * 2048, D, 2048, (bf16*)(ws + WS_WGU) + (size_t)e * 2048 * D, row0, scr, kb, nb, lane); }
        else { const int q = it - N2, e = q / I_DN, r = q % I_DN, kb = r / 64, nb = r % 64;
            p0_transpose_item(a->in[I_WDN] + (size_t)(l * NE + e) * DE * D, DE, D, (bf16*)(ws + WS_WDN) + (size_t)e * D * DE, 32 * nb, scr, kb, nb, lane); }
    }
}
__device__ __forceinline__ void phase_prologue(KArgs a, LAS unsigned char* lds) {
    const int tid = tid_fresh(), lane = tid & 63, wave = tid >> 6;
    const int G = gridDim.x, gw = blockIdx.x * 8 + wave, NGW = G * 8;
    unsigned char* ws = a->ws;
    LAS float* scr = (LAS float*)(lds + wave * 16384);
    constexpr int I_IN = 32 * 232, I_OUT = 32 * 64;
    constexpr int N0 = 2 * I_IN, N1 = N0 + 2 * I_OUT;
    for (int it = gw; it < N1; it += NGW) {
        if (it < N0) { const int l = it / I_IN, r = it % I_IN, kb = r / 232, nb = r % 232;
            p0_transpose_item(a->in[I_WIN] + (size_t)l * D * INC, D, INC, (bf16*)(ws + WS_WIN) + (size_t)l * INC * D, 32 * nb, scr, kb, nb, lane); }
        else { const int q = it - N0, l = q / I_OUT, r = q % I_OUT, kb = r / 64, nb = r % 64;
            p0_transpose_item(a->in[I_WOUT] + (size_t)l * D * D, D, D, (bf16*)(ws + WS_WOUT) + (size_t)l * D * D, 32 * nb, scr, kb, nb, lane); }
    }
    convert_moe(a, 0, lds);
    {
        const int gt = blockIdx.x * NTHREADS + tid, NGT = G * NTHREADS;
        bf16* wup = (bf16*)(ws + WS_SMALLW + SW_WUP); bf16* aup = (bf16*)(ws + WS_SMALLW + SW_AUP); bf16* gup = (bf16*)(ws + WS_SMALLW + SW_GUP); bf16* gws = (bf16*)(ws + WS_SMALLW + SW_GWS);
        for (int i = gt; i < 2 * 2 * 768 * 64; i += NGT) { const int k = i & 63, n = (i >> 6) % 768, ld = i / (768 * 64); wup[i] = (bf16)f2bf(a->in[I_WUP][((size_t)ld * 64 + k) * 768 + n]); }
        for (int i = gt; i < 2 * 768 * 64; i += NGT) { const int k = i & 63, n = (i >> 6) % 768, l = i / (768 * 64); aup[i] = (bf16)f2bf(a->in[I_AUP][((size_t)l * 64 + k) * 768 + n]); }
        for (int i = gt; i < 2 * 768 * 128; i += NGT) { const int k = i & 127, n = (i >> 7) % 768, l = i / (768 * 128); gup[i] = (bf16)f2bf(a->in[I_GUP][((size_t)l * 128 + k) * 768 + n]); }
        for (int i = gt; i < 2 * 4 * 128 * 128; i += NGT) gws[i] = (bf16)f2bf(a->in[I_GWS][i]);
    }
    __syncthreads();
    {
        LAS float* sv = (LAS float*)lds;
        LAS float* red = (LAS float*)(lds + 73728);
        for (int i = tid; i < 9 * D; i += NTHREADS) { const int r = i / D, k = i % D; const float v = r < 8 ? a->in[I_C][r * D + k] : a->in[I_CCTX][k]; sv[i] = siluf_(v); }
        __syncthreads();
        float* mod = (float*)(ws + WS_MOD);
        for (int it = blockIdx.x; it < 2 * 96; it += G) {
            const int l = it / 96, cb = it % 96, cq = tid & 31, kg = tid >> 5;
            const float* wp = a->in[I_ADAW] + (size_t)l * D * 12288 + (size_t)(kg * 128) * 12288 + cb * 128 + cq * 4;
            f32x4 acc[9];
#pragma unroll
            for (int r = 0; r < 9; ++r) acc[r] = (f32x4){0.f, 0.f, 0.f, 0.f};
#pragma unroll 4
            for (int k = 0; k < 128; ++k) { const f32x4 w = *(const f32x4*)(wp + (size_t)k * 12288);
#pragma unroll
                for (int r = 0; r < 9; ++r) acc[r] += w * sv[r * D + kg * 128 + k]; }
#pragma unroll
            for (int r = 0; r < 9; ++r) *(LAS f32x4*)(red + ((kg * 9 + r) * 128 + cq * 4)) = acc[r];
            __syncthreads();
            for (int o = tid; o < 9 * 128; o += NTHREADS) { const int r = o / 128, c = o % 128; float s = a->in[I_ADAB][(size_t)l * 12288 + cb * 128 + c];
#pragma unroll
                for (int q = 0; q < 16; ++q) s += red[(q * 9 + r) * 128 + c];
                mod[((size_t)l * 9 + r) * 12288 + cb * 128 + c] = s; }
            __syncthreads();
        }
    }
}

template <int MODE>
__device__ __forceinline__ void phase_norm1(KArgs a, int l, bool dry) {
    const int tid_ = tid_fresh(); const int lane = tid_ & 63, wave = tid_ >> 6, gw = blockIdx.x * 8 + wave, NGW = gridDim.x * 8;
    unsigned char* ws = a->ws;
    const float* mod = (const float*)(ws + WS_MOD);
    float* X = (float*)(ws + WS_X); bf16* H = (bf16*)(ws + WS_H); const bf16* YK = (const bf16*)(ws + WS_YK);
    float* Xo = dry ? (float*)(ws + WS_END) : X; bf16* Ho = dry ? (bf16*)(ws + WS_END) : H; float* Oo = dry ? (float*)(ws + WS_END) : a->out;
    const int nrows = (MODE == 2) ? NLAT : MALL;
    const int rpw = (nrows + NGW - 1) / NGW; const int r0 = gw * rpw, r1 = (r0 + rpw < nrows) ? r0 + rpw : nrows;
    f32x4 ck[8], cs[8], cg[8]; int cur_mr = -1;
    for (int row = r0; row < r1; ++row) {
        const int mr = modrow_of(row); const int orow = dry ? (row & 2047) : row;
        if (mr != cur_mr) { cur_mr = mr;
#pragma unroll
            for (int j = 0; j < 8; ++j) { const int c = 4 * lane + 256 * j;
                if (MODE == 2) ck[j] = *(const f32x4*)(a->in[I_FNG] + c);
                else { const float* m = mod + ((size_t)l * 9 + mr) * 12288; const f32x4 g = *(const f32x4*)(a->in[I_N1G] + (size_t)l * D + c); ck[j] = g * (*(const f32x4*)(m + D + c) + 1.0f); cs[j] = *(const f32x4*)(m + c); }
                if (MODE != 0) cg[j] = *(const f32x4*)(mod + ((size_t)(l - 1) * 9 + mr) * 12288 + 5 * D + c); } }
        f32x4 v[8];
        if (MODE == 0) { const float* xr = row < NLAT ? a->in[I_X] + (size_t)row * D : a->in[I_CTX] + (size_t)(row - NLAT) * D;
#pragma unroll
            for (int j = 0; j < 8; ++j) v[j] = *(const f32x4*)(xr + 4 * lane + 256 * j);
        } else {
            const float* xr = X + (size_t)row * D; const bf16* y0 = YK + (size_t)row * D; const bf16* y1 = YK + ((size_t)MALL + row) * D;
            u32x2 p0[8], p1[8];
#pragma unroll
            for (int j = 0; j < 8; ++j) { const int c = 4 * lane + 256 * j; v[j] = *(const f32x4*)(xr + c); p0[j] = *(const u32x2*)(y0 + c); p1[j] = *(const u32x2*)(y1 + c); }
#pragma unroll
            for (int j = 0; j < 8; ++j) { f32x4 f; f[0] = bflo(p0[j].x) + bflo(p1[j].x); f[1] = bfhi(p0[j].x) + bfhi(p1[j].x); f[2] = bflo(p0[j].y) + bflo(p1[j].y); f[3] = bfhi(p0[j].y) + bfhi(p1[j].y);
                v[j] = v[j] + cg[j] * f; }
            if (MODE == 1) {
#pragma unroll
                for (int j = 0; j < 8; ++j) *(f32x4*)(Xo + (size_t)orow * D + 4 * lane + 256 * j) = v[j];
            }
        }
        float ss = 0.f;
#pragma unroll
        for (int j = 0; j < 8; ++j) ss += (v[j][0] * v[j][0] + v[j][1] * v[j][1]) + (v[j][2] * v[j][2] + v[j][3] * v[j][3]);
        const float rstd = 1.0f / sqrtf(wave_sum(ss) * (1.0f / D) + NORM_EPS);
        if (MODE == 2) {
#pragma unroll
            for (int j = 0; j < 8; ++j) *(f32x4*)(Oo + (size_t)orow * D + 4 * lane + 256 * j) = v[j] * rstd * ck[j];
        } else {
#pragma unroll
            for (int j = 0; j < 8; ++j) { const f32x4 h = v[j] * rstd * ck[j] + cs[j]; u32x2 o; o.x = pk2(h[0], h[1]); o.y = pk2(h[2], h[3]); *(u32x2*)(Ho + (size_t)orow * D + 4 * lane + 256 * j) = o; }
        }
    }
}

__device__ __forceinline__ void phase_norm2_router(KArgs a, int l, bool dry, LAS unsigned char* lds) {
    const int tid_ = tid_fresh(); const int lane = tid_ & 63, wave = tid_ >> 6, gw = blockIdx.x * 8 + wave, NGW = gridDim.x * 8;
    unsigned char* ws = a->ws;
    const float* mod = (const float*)(ws + WS_MOD);
    const float* X = (const float*)(ws + WS_X); bf16* H = (bf16*)(ws + WS_H);
    unsigned* cnt = (unsigned*)(ws + WS_CTL) + CW_CNT + l * 16 * 64 + (dry ? 4096 : 0);
    unsigned* ridx = (unsigned*)(ws + (dry ? WS_END : WS_RIDX)); float* rwt = (float*)(ws + (dry ? WS_END + 4 * MiB : WS_RW)); bf16* Ho = dry ? (bf16*)(ws + WS_END + 8 * MiB) : H;
    const int nrows = (l == DEPTH - 1) ? NLAT : MALL;
    LAS f32x4* rwl = (LAS f32x4*)lds;
    { const float* rw = a->in[I_RW];
      for (int idx = tid_; idx < 8192; idx += NTHREADS) { const int ln = idx & 63, q = (idx >> 6) & 3, i = (idx >> 8) & 3, j = idx >> 10; rwl[idx] = *(const f32x4*)(rw + (size_t)(4 * ln + 256 * j + i) * 16 + 4 * q); } }
    __syncthreads();
    const int rpw = (nrows + NGW - 1) / NGW; const int r0 = gw * rpw, r1 = (r0 + rpw < nrows) ? r0 + rpw : nrows;
    f32x4 ck[8], cs[8]; int cur_mr = -1;
    float rb[16];
#pragma unroll
    for (int e = 0; e < 16; ++e) rb[e] = a->in[I_RB][e];
    for (int row = r0; row < r1; ++row) {
        const int mr = modrow_of(row); const int orow = dry ? (row & 2047) : row;
        if (mr != cur_mr) { cur_mr = mr; const float* m = mod + ((size_t)l * 9 + mr) * 12288;
#pragma unroll
            for (int j = 0; j < 8; ++j) { const int c = 4 * lane + 256 * j; const f32x4 g = *(const f32x4*)(a->in[I_N2G] + (size_t)l * D + c); ck[j] = g * (*(const f32x4*)(m + 4 * D + c) + 1.0f); cs[j] = *(const f32x4*)(m + 3 * D + c); } }
        const float* xr = X + (size_t)row * D;
        f32x4 v[8]; float ss = 0.f;
#pragma unroll
        for (int j = 0; j < 8; ++j) { v[j] = *(const f32x4*)(xr + 4 * lane + 256 * j); ss += (v[j][0] * v[j][0] + v[j][1] * v[j][1]) + (v[j][2] * v[j][2] + v[j][3] * v[j][3]); }
        const float rstd = 1.0f / sqrtf(wave_sum(ss) * (1.0f / D) + NORM_EPS);
        f32x4 lg4[4];
#pragma unroll
        for (int q = 0; q < 4; ++q) lg4[q] = (f32x4){0.f, 0.f, 0.f, 0.f};
#pragma unroll
        for (int j = 0; j < 8; ++j) { const f32x4 h = v[j] * rstd * ck[j] + cs[j]; u32x2 o; o.x = pk2(h[0], h[1]); o.y = pk2(h[2], h[3]); *(u32x2*)(Ho + (size_t)orow * D + 4 * lane + 256 * j) = o;
#pragma unroll
            for (int i = 0; i < 4; ++i)
#pragma unroll
                for (int q = 0; q < 4; ++q) lg4[q] += rwl[((j * 4 + i) * 4 + q) * 64 + lane] * h[i];
            asm volatile("" ::: "memory"); }
        float lg[16];
#pragma unroll
        for (int e = 0; e < 16; ++e) lg[e] = wave_sum(lg4[e >> 2][e & 3]) + rb[e];
        float mx = lg[0];
#pragma unroll
        for (int e = 1; e < 16; ++e) mx = fmaxf(mx, lg[e]);
        float p[16], sum = 0.f;
#pragma unroll
        for (int e = 0; e < 16; ++e) { p[e] = __expf(lg[e] - mx); sum += p[e]; }
        const float inv = 1.0f / sum;
#pragma unroll
        for (int e = 0; e < 16; ++e) p[e] *= inv;
        int sel = 0; float best = -1.f;
#pragma unroll
        for (int gI = 0; gI < 4; ++gI) { float m1 = -1.f, m2 = -1.f;
#pragma unroll
            for (int i = 0; i < 4; ++i) { const float q = p[4 * gI + i]; if (q > m1) { m2 = m1; m1 = q; } else if (q > m2) m2 = q; }
            const float s = m1 + m2; if (s > best) { best = s; sel = gI; } }
        int i1 = 0, i2 = 0; float p1 = -2.f, p2 = -2.f;
#pragma unroll
        for (int gI = 0; gI < 4; ++gI)
#pragma unroll
            for (int i = 0; i < 4; ++i) { const float q = (gI == sel) ? p[4 * gI + i] : -1.0f; const int e = 4 * gI + i;
                if (gI == sel) { if (q > p1) { p2 = p1; i2 = i1; p1 = q; i1 = e; } else if (q > p2) { p2 = q; i2 = e; } } }
        const float wsum = p1 + p2, w1 = p1 / wsum, w2 = p2 / wsum;
        if (lane == 0) {
            const unsigned q1 = atomicAdd(cnt + i1 * 64, 1u); ridx[(size_t)i1 * MALL + q1] = (unsigned)row; rwt[(size_t)i1 * MALL + q1] = w1;
            const unsigned q2 = atomicAdd(cnt + i2 * 64, 1u); ridx[(size_t)i2 * MALL + q2] = (unsigned)row | 0x80000000u; rwt[(size_t)i2 * MALL + q2] = w2;
        }
    }
    __syncthreads();
}

template <bool FOR_DOWN>
__device__ __forceinline__ void moe_tables(KArgs a, int l, LAS unsigned char* lds, int cvirt) {
    const int tid = tid_fresh(), G = gridDim.x;
    unsigned char* ws = a->ws;
    const unsigned* cnt = (const unsigned*)(ws + WS_CTL) + CW_CNT + l * 16 * 64;
    const unsigned* ridx = (const unsigned*)(ws + WS_RIDX); const float* rwt = (const float*)(ws + WS_RW);
    LAS int* tp = (LAS int*)(lds + LDS_TP); LAS unsigned* tab = (LAS unsigned*)(lds + LDS_TAB); LAS float* tabw = (LAS float*)(lds + LDS_TABW);
    if (tid == 0) { int acc = 0; for (int e = 0; e < 16; ++e) { tp[e] = acc; acc += (int)((cnt[e * 64] + 255u) >> 8); } tp[16] = acc; }
    __syncthreads();
    const int ntot = tp[16] * 8;
    for (int i = 0; i < 9; ++i) { const int L = i * G + cvirt; if (L >= ntot) break;
        const int tile = L >> 3; int e = 0;
        for (int j = 1; j < 16; ++j) e += (tile >= tp[j]) ? 1 : 0;
        const int pos0 = (tile - tp[e]) * 256; const unsigned ce = cnt[e * 64];
        if (tid < 256) { const int pos = pos0 + tid; const bool valid = (unsigned)pos < ce; const unsigned ent = ridx[(size_t)e * MALL + (valid ? pos : 0)];
            if (FOR_DOWN) { tab[i * 256 + tid] = valid ? ent : (ent | 0x40000000u); tabw[i * 256 + tid] = valid ? rwt[(size_t)e * MALL + pos] : 0.f; }
            else tab[i * 256 + tid] = (ent & 0xffffu) * (unsigned)(D * 2); }
    }
    __syncthreads();
}

__device__ __forceinline__ void gmlp_item(KArgs a, int l, int item, LAS unsigned char* lds) {
    const int tid = tid_fresh(), lane = tid & 63, wave = tid >> 6;
    unsigned char* ws = a->ws;
    const bf16* P = (const bf16*)(ws + WS_P); bf16* Y = (bf16*)(ws + WS_Y);
    const int chunk = item >> 2, h = item & 3;
    const int row0 = chunk < 256 ? chunk * 128 : NLAT + (chunk - 256) * 128;
    LAS bf16* wsl = (LAS bf16*)lds;
    LAS bf16* vT = (LAS bf16*)(lds + 128 * 136 * 2);
    const bf16* gws = (const bf16*)(ws + WS_SMALLW + SW_GWS) + ((size_t)l * 4 + h) * 128 * 128;
    for (int p = tid; p < 2048; p += NTHREADS) { const int t = p >> 4, c8 = p & 15; *(LAS u32x4*)(wsl + t * 136 + c8 * 8) = *(const u32x4*)(gws + t * 128 + c8 * 8); }
    {
        const int s = tid >> 2, qd = tid & 3; const bf16* vp = P + (size_t)(row0 + s) * INC + OFF_V + h * 128 + qd * 32;
        float g[32]; float ss = 0.f;
#pragma unroll
        for (int q = 0; q < 4; ++q) { float f[8]; unpack8(*(const u32x4*)(vp + 8 * q), f);
#pragma unroll
            for (int j = 0; j < 8; ++j) { const float x = geluf_(f[j]); g[8 * q + j] = x; ss += x * x; } }
        ss += __shfl_xor(ss, 1); ss += __shfl_xor(ss, 2);
        const float rstd = 1.0f / sqrtf(ss * (1.0f / 128.0f) + NORM_EPS);
        const float* ng = a->in[I_GNG] + (size_t)l * 512 + h * 128 + qd * 32;
#pragma unroll
        for (int j = 0; j < 32; ++j) vT[(qd * 32 + j) * 136 + s] = (bf16)f2bf(g[j] * rstd * ng[j]);
    }
    __syncthreads();
    f32x4 acc[8];
#pragma unroll
    for (int ct = 0; ct < 8; ++ct) acc[ct] = (f32x4){0.f, 0.f, 0.f, 0.f};
    const int fr = lane & 15, fq = lane >> 4;
#pragma unroll
    for (int ks = 0; ks < 4; ++ks) {
        const bf16x8 bfrag = *(const LAS bf16x8*)(wsl + (16 * wave + fr) * 136 + ks * 32 + fq * 8);
#pragma unroll
        for (int ct = 0; ct < 8; ++ct) { const bf16x8 afrag = *(const LAS bf16x8*)(vT + (16 * ct + fr) * 136 + ks * 32 + fq * 8);
            acc[ct] = __builtin_amdgcn_mfma_f32_16x16x32_bf16(afrag, bfrag, acc[ct], 0, 0, 0); }
    }
    const int t = 16 * wave + fr; const float wb = a->in[I_GB][((size_t)l * 4 + h) * 128 + t];
    const bf16* up = P + (size_t)(row0 + t) * INC + OFF_U + h * 128; bf16* yp = Y + (size_t)(row0 + t) * D + h * 128;
#pragma unroll
    for (int ct = 0; ct < 8; ++ct) { const int c = 16 * ct + 4 * fq; const u32x2 uu = *(const u32x2*)(up + c);
        const float y0 = geluf_(bflo(uu.x)) * (acc[ct][0] + wb), y1 = geluf_(bfhi(uu.x)) * (acc[ct][1] + wb), y2 = geluf_(bflo(uu.y)) * (acc[ct][2] + wb), y3 = geluf_(bfhi(uu.y)) * (acc[ct][3] + wb);
        u32x2 o; o.x = pk2(y0, y1); o.y = pk2(y2, y3); *(u32x2*)(yp + c) = o; }
    __syncthreads();
}

constexpr int SP_ = 72;
__device__ __forceinline__ int kperm_pos(int k) { const int s5 = k & 31; return (k & 32) + 8 * ((s5 >> 2) & 3) + 4 * (s5 >> 4) + (s5 & 3); }
__device__ __forceinline__ void rwkv_prep_item(KArgs a, int l, int tile, int head, LAS unsigned char* lds) {
    const int tid = tid_fresh(), lane = tid & 63, wave = tid >> 6;
    unsigned char* ws = a->ws;
    const bf16* P = (const bf16*)(ws + WS_P); bf16* Y = (bf16*)(ws + WS_Y);
    LAS bf16* SR = (LAS bf16*)lds; LAS bf16* SK = SR + 64 * SP_; LAS bf16* SV = SK + 64 * SP_; LAS bf16* SKK = SV + 64 * SP_; LAS bf16* SB = SKK + 64 * SP_; LAS bf16* SWF = SB + 64 * SP_; LAS bf16* SWB = SWF + 64 * SP_;
    LAS bf16* tw = SWB + 64 * SP_;
    LAS bf16* adl = tw + 64 * SP_;
    LAS bf16* sg = adl + 64 * SP_;
    LAS float* invn = (LAS float*)(sg + 64 * 136);
    LAS unsigned char* wpriv = (LAS unsigned char*)(invn + 64) + wave * 6144;
    const int row0 = tile * 64; const bool isl = row0 < NLAT;
    const float* mu = a->in[I_MU] + (size_t)l * CCOLS; const float* kkw = a->in[I_KK] + (size_t)l * CW + head * 64;
    auto shift_group = [&](int tk, int col, float (&z)[8]) {
        const int row = row0 + tk; int o0, o1, o2, o3; bool v0, v1, v2, v3;
        if (isl) { const int gr = (row >> 6) & 63; o0 = -1; o1 = 1; o2 = -64; o3 = 64; v0 = tk > 0; v1 = tk < 63; v2 = gr > 0; v3 = gr < 63; }
        else { const int tc = (row - NLAT) & 255; o0 = -1; o1 = 1; o2 = -1; o3 = 1; v0 = tc > 0; v1 = tc < 255; v2 = v0; v3 = v1; }
        const bf16* pp = P + (size_t)row * INC + OFF_C + col;
        const u32x4 uo = *(const u32x4*)pp, u0 = *(const u32x4*)(pp + (v0 ? o0 : 0) * INC), u1 = *(const u32x4*)(pp + (v1 ? o1 : 0) * INC), u2 = *(const u32x4*)(pp + (v2 ? o2 : 0) * INC), u3 = *(const u32x4*)(pp + (v3 ? o3 : 0) * INC);
        const f32x4 m0 = *(const f32x4*)(mu + col), m1 = *(const f32x4*)(mu + col + 4);
        float own[8], n0[8], n1[8], n2[8], n3[8]; unpack8(uo, own); unpack8(u0, n0); unpack8(u1, n1); unpack8(u2, n2); unpack8(u3, n3);
        const float f0 = v0 ? 1.f : 0.f, f1 = v1 ? 1.f : 0.f, f2 = v2 ? 1.f : 0.f, f3 = v3 ? 1.f : 0.f;
        const float nb[8] = {n0[0] * f0, n1[1] * f1, n2[2] * f2, n3[3] * f3, n0[4] * f0, n1[5] * f1, n2[6] * f2, n3[7] * f3};
#pragma unroll
        for (int j = 0; j < 8; ++j) { const float mm = j < 4 ? m0[j] : m1[j - 4]; z[j] = own[j] + mm * (nb[j] - own[j]); }
    };
#pragma unroll
    for (int it = 0; it < 3; ++it) { const int g = tid + NTHREADS * it, tk = g / 24, gi = g % 24, c8 = (gi & 7) * 8;
        float z[8]; shift_group(tk, (gi >> 3) * 768 + head * 64 + c8, z);
        if (gi < 8) *(LAS u32x4*)(SR + tk * SP_ + c8) = pack8(z);
        else if (gi < 16) { *(LAS u32x4*)(SK + tk * SP_ + c8) = pack8(z);
            const f32x4 k0 = *(const f32x4*)(kkw + c8), k1 = *(const f32x4*)(kkw + c8 + 4); float ss = 0.f;
#pragma unroll
            for (int j = 0; j < 8; ++j) { const float q = z[j] * (j < 4 ? k0[j] : k1[j - 4]); ss += q * q; }
            ss += __shfl_xor(ss, 1); ss += __shfl_xor(ss, 2); ss += __shfl_xor(ss, 4);
            if ((gi & 7) == 0) invn[tk] = 1.0f / fmaxf(sqrtf(ss), 1e-12f); }
        else *(LAS u32x4*)(SV + tk * SP_ + c8) = pack8(z); }
#pragma unroll
    for (int it = 0; it < 4; ++it) { const int g = tid + NTHREADS * it, tk = g >> 5, gi = g & 31;
        float z[8]; shift_group(tk, 2304 + gi * 8, z);
        if (gi < 8) { float t8[8];
#pragma unroll
            for (int j = 0; j < 8; ++j) t8[j] = tanhf(z[j]);
            *(LAS u32x4*)(tw + tk * SP_ + gi * 8) = pack8(t8); }
        else if (gi < 16) *(LAS u32x4*)(adl + tk * SP_ + (gi - 8) * 8) = pack8(z);
        else { float t8[8];
#pragma unroll
            for (int j = 0; j < 8; ++j) t8[j] = sigmoidf_(z[j]);
            *(LAS u32x4*)(sg + tk * 136 + (gi - 16) * 8) = pack8(t8); } }
    __syncthreads();
    {
        const int fr = lane & 15, fq = lane >> 4, nt = wave & 3, th = wave >> 2;
        const bf16* wupT = (const bf16*)(ws + WS_SMALLW + SW_WUP) + (size_t)l * 2 * 768 * 64;
        const bf16* aupT = (const bf16*)(ws + WS_SMALLW + SW_AUP) + (size_t)l * 768 * 64;
        const bf16* gupT = (const bf16*)(ws + WS_SMALLW + SW_GUP) + (size_t)l * 768 * 128;
        const float* a0 = a->in[I_A0] + (size_t)l * CW + head * 64; const float* kaw = a->in[I_KA] + (size_t)l * CW + head * 64; const float* w0 = a->in[I_W0] + (size_t)l * 2 * CW + head * 64;
        const int nloc = 16 * nt + 4 * fq;
#pragma unroll 1
        for (int mat = 0; mat < 4; ++mat) {
            const bf16* WT = mat == 0 ? aupT : (mat == 1 ? wupT : (mat == 2 ? wupT + 768 * 64 : gupT));
            const int KK = mat == 3 ? 128 : 64; const LAS bf16* act = mat == 0 ? adl : (mat == 3 ? sg : tw); const int apitch = mat == 3 ? 136 : SP_;
            f32x4 acc[2];
            acc[0] = (f32x4){0.f, 0.f, 0.f, 0.f}; acc[1] = acc[0];
            for (int ks = 0; ks < KK / 32; ++ks) { const bf16x8 afr = *(const bf16x8*)(WT + (size_t)(head * 64 + 16 * nt + fr) * KK + ks * 32 + fq * 8);
#pragma unroll
                for (int tt = 0; tt < 2; ++tt) { const bf16x8 bfr = *(const LAS bf16x8*)(act + (16 * (2 * th + tt) + fr) * apitch + ks * 32 + fq * 8); acc[tt] = __builtin_amdgcn_mfma_f32_16x16x32_bf16(afr, bfr, acc[tt], 0, 0, 0); } }
#pragma unroll
            for (int tt = 0; tt < 2; ++tt) { const int tk = 16 * (2 * th + tt) + fr; const f32x4 v = acc[tt];
                if (mat == 0) {
                    const f32x4 a0v = *(const f32x4*)(a0 + nloc), kav = *(const f32x4*)(kaw + nloc), kkv = *(const f32x4*)(kkw + nloc);
                    const u32x2 kp = *(const LAS u32x2*)(SK + tk * SP_ + nloc); const float kf[4] = {bflo(kp.x), bfhi(kp.x), bflo(kp.y), bfhi(kp.y)};
                    const float inn = invn[tk]; float k2[4], kk[4], bb[4];
#pragma unroll
                    for (int j = 0; j < 4; ++j) { const float av = sigmoidf_(a0v[j] + v[j]); kk[j] = kf[j] * kkv[j] * inn; k2[j] = kf[j] * (1.0f + (av - 1.0f) * kav[j]); bb[j] = kk[j] * av; }
                    u32x2 q; q.x = pk2(k2[0], k2[1]); q.y = pk2(k2[2], k2[3]); *(LAS u32x2*)(SK + tk * SP_ + nloc) = q;
                    q.x = pk2(kk[0], kk[1]); q.y = pk2(kk[2], kk[3]); *(LAS u32x2*)(SKK + tk * SP_ + nloc) = q;
                    q.x = pk2(bb[0], bb[1]); q.y = pk2(bb[2], bb[3]); *(LAS u32x2*)(SB + tk * SP_ + nloc) = q;
                } else if (mat <= 2) {
                    const f32x4 w0v = *(const f32x4*)(w0 + (mat - 1) * CW + nloc); float d[4];
#pragma unroll
                    for (int j = 0; j < 4; ++j) d[j] = __expf(-DECAY_SCALE * sigmoidf_(w0v[j] + v[j]));
                    u32x2 q; q.x = pk2(d[0], d[1]); q.y = pk2(d[2], d[3]); *(LAS u32x2*)((mat == 1 ? SWF : SWB) + tk * SP_ + nloc) = q;
                } else {
                    u32x2 q; q.x = pk2(v[0], v[1]); q.y = pk2(v[2], v[3]); *(u32x2*)(Y + (size_t)(row0 + tk) * D + 1280 + head * 64 + nloc) = q;
                }
            }
        }
    }
    __syncthreads();
    { const int tk = tid >> 3, c8 = (tid & 7) * 8; float r8[8], k8[8], v8[8];
      unpack8(*(const LAS u32x4*)(SR + tk * SP_ + c8), r8); unpack8(*(const LAS u32x4*)(SK + tk * SP_ + c8), k8); unpack8(*(const LAS u32x4*)(SV + tk * SP_ + c8), v8);
      const float* rkp = a->in[I_RK] + (size_t)l * CW + head * 64 + c8; const f32x4 rk0 = *(const f32x4*)rkp, rk1 = *(const f32x4*)(rkp + 4);
      float bs = 0.f;
#pragma unroll
      for (int j = 0; j < 8; ++j) bs += r8[j] * k8[j] * (j < 4 ? rk0[j] : rk1[j - 4]);
      bs += __shfl_xor(bs, 1); bs += __shfl_xor(bs, 2); bs += __shfl_xor(bs, 4);
#pragma unroll
      for (int j = 0; j < 8; ++j) v8[j] *= bs;
      *(u32x4*)(Y + (size_t)(row0 + tk) * D + 512 + head * 64 + c8) = pack8(v8); }
    {
        const int c4 = wave & 3, dir = wave >> 2, fr = lane & 15, fq = lane >> 4;
        LAS float* CB = (LAS float*)wpriv;
        LAS float* AA = CB + 16 * 64;
        const LAS bf16* SW = dir ? SWB : SWF;
        auto trow = [&](int tau) { return 16 * c4 + (dir ? 15 - tau : tau); };
        float c[16];
        { float run = 0.f;
#pragma unroll
          for (int t = 0; t < 16; ++t) { run += __logf(bf1(SW[trow(t) * SP_ + lane])); c[t] = run; CB[t * 64 + lane] = run; } }
        const int rec_dir = dir, bidx = isl ? (row0 >> 12) : ((row0 - NLAT) >> 8);
        const int tcl = isl ? 4 * ((row0 >> 6) & 63) + c4 : 4 * (((row0 - NLAT) >> 6) & 3) + c4;
        const int nproc = isl ? 16 + (dir ? 255 - tcl : tcl) : (dir ? 15 - tcl : tcl);
        unsigned char* rec = ws + WS_PRE + ((size_t)((rec_dir * 8 + bidx) * 12 + head) * NCHUNK16 + nproc) * PRE_REC;
        { const float cl = c[15]; float bk[32];
#pragma unroll
          for (int t = 0; t < 16; ++t) { const float e = __expf(cl - c[t]); const int pos = 8 * (t >> 2) + (t & 3); bk[pos] = bf1(SB[trow(t) * SP_ + lane]) * e; bk[pos + 4] = bf1(SK[trow(t) * SP_ + lane]) * e; }
#pragma unroll
          for (int q4 = 0; q4 < 4; ++q4) { u32x4 o; o.x = pk2(bk[8 * q4], bk[8 * q4 + 1]); o.y = pk2(bk[8 * q4 + 2], bk[8 * q4 + 3]); o.z = pk2(bk[8 * q4 + 4], bk[8 * q4 + 5]); o.w = pk2(bk[8 * q4 + 6], bk[8 * q4 + 7]);
              *(u32x4*)(rec + PR_BK + lane * 64 + q4 * 16) = o; }
          *(float*)(rec + PR_GAM + lane * 4) = __expf(cl); }
        asm volatile("s_waitcnt lgkmcnt(0)" ::: "memory");
        bf16x8 fa[2], frr[2], fb[2], fk[2];
        { const int tr = trow(fr);
#pragma unroll
          for (int sx = 0; sx < 2; ++sx) { const int ch = 32 * sx + 8 * fq; float kk8[8], r8[8], b8[8], k8[8];
              unpack8(*(const LAS u32x4*)(SKK + tr * SP_ + ch), kk8); unpack8(*(const LAS u32x4*)(SR + tr * SP_ + ch), r8); unpack8(*(const LAS u32x4*)(SB + tr * SP_ + ch), b8); unpack8(*(const LAS u32x4*)(SK + tr * SP_ + ch), k8);
              const f32x4 c0 = *(const LAS f32x4*)(CB + fr * 64 + ch), c1 = *(const LAS f32x4*)(CB + fr * 64 + ch + 4);
              f32x4 p0 = (f32x4){0.f, 0.f, 0.f, 0.f}, p1 = p0; if (fr > 0) { p0 = *(const LAS f32x4*)(CB + (fr - 1) * 64 + ch); p1 = *(const LAS f32x4*)(CB + (fr - 1) * 64 + ch + 4); }
              float xa[8], xr[8], xb[8], xk[8];
#pragma unroll
              for (int j = 0; j < 8; ++j) { const float cc = j < 4 ? c0[j] : c1[j - 4], cp = j < 4 ? p0[j] : p1[j - 4]; const float ep = __expf(cp), ec = __expf(cc), en = __builtin_amdgcn_rcpf(ec);
                  xa[j] = -kk8[j] * ep; xr[j] = r8[j] * ec; xb[j] = b8[j] * en; xk[j] = k8[j] * en; }
              const u32x4 ua = pack8(xa), ur = pack8(xr), ub = pack8(xb), uk = pack8(xk);
              fa[sx] = __builtin_bit_cast(bf16x8, ua); frr[sx] = __builtin_bit_cast(bf16x8, ur); fb[sx] = __builtin_bit_cast(bf16x8, ub); fk[sx] = __builtin_bit_cast(bf16x8, uk); } }
        f32x4 gab = (f32x4){0.f, 0.f, 0.f, 0.f}, gak = gab, grb = gab, grk = gab;
#pragma unroll
        for (int sx = 0; sx < 2; ++sx) { gab = __builtin_amdgcn_mfma_f32_16x16x32_bf16(fa[sx], fb[sx], gab, 0, 0, 0); gak = __builtin_amdgcn_mfma_f32_16x16x32_bf16(fa[sx], fk[sx], gak, 0, 0, 0);
            grb = __builtin_amdgcn_mfma_f32_16x16x32_bf16(frr[sx], fb[sx], grb, 0, 0, 0); grk = __builtin_amdgcn_mfma_f32_16x16x32_bf16(frr[sx], fk[sx], grk, 0, 0, 0); }
#pragma unroll
        for (int j = 0; j < 4; ++j) { const int tau = 4 * fq + j; const bool lo = fr < tau, le = fr <= tau;
            AA[tau * 16 + fr] = lo ? gab[j] : 0.f; AA[256 + tau * 16 + fr] = lo ? gak[j] : 0.f; grb[j] = le ? grb[j] : 0.f; grk[j] = le ? grk[j] : 0.f; }
        asm volatile("s_waitcnt lgkmcnt(0)" ::: "memory");
        float wv[16], mv[16];
#pragma unroll
        for (int t = 0; t < 16; ++t) { const float ab = -bf1(SKK[trow(t) * SP_ + lane]) * (t > 0 ? __expf(c[t - 1]) : 1.0f); float accw = ab, accm = AA[256 + t * 16 + fr];
#pragma unroll
            for (int q4 = 0; q4 < 4; ++q4) { if (4 * q4 < t) { const f32x4 cf = *(const LAS f32x4*)(AA + t * 16 + 4 * q4);
#pragma unroll
                for (int j = 0; j < 4; ++j) if (4 * q4 + j < t) { accw += cf[j] * wv[4 * q4 + j]; accm += cf[j] * mv[4 * q4 + j]; } } }
            wv[t] = accw; mv[t] = accm; }
        { LAS bf16* stg = (LAS bf16*)CB; const int pp = kperm_pos(lane);
#pragma unroll
          for (int t = 0; t < 16; ++t) { stg[t * 64 + pp] = (bf16)f2bf(wv[t]); stg[1024 + t * 64 + pp] = (bf16)f2bf(bf1(SR[trow(t) * SP_ + lane]) * __expf(c[t])); }
          asm volatile("s_waitcnt lgkmcnt(0)" ::: "memory");
#pragma unroll
          for (int q4 = 0; q4 < 4; ++q4) *(u32x4*)(rec + PR_WP + (q4 * 64 + lane) * 16) = *(const LAS u32x4*)((LAS unsigned char*)stg + (q4 * 64 + lane) * 16); }
        { LAS bf16* stg = (LAS bf16*)AA; const int ps = 8 * (fr >> 2) + (fr & 3);
          asm volatile("s_waitcnt lgkmcnt(0)" ::: "memory");
#pragma unroll
          for (int j = 0; j < 4; ++j) { const int tau = 4 * fq + j; stg[tau * 32 + ps] = (bf16)f2bf(grb[j]); stg[tau * 32 + ps + 4] = (bf16)f2bf(grk[j]); }
          if (lane < 16) {
#pragma unroll
              for (int t = 0; t < 16; ++t) stg[512 + t * 16 + lane] = (bf16)f2bf(mv[t]); }
          asm volatile("s_waitcnt lgkmcnt(0)" ::: "memory");
          *(u32x4*)(rec + PR_ARBK + lane * 16) = *(const LAS u32x4*)((LAS unsigned char*)stg + lane * 16);
          if (lane < 32) *(u32x4*)(rec + PR_ARBK + 1024 + lane * 16) = *(const LAS u32x4*)((LAS unsigned char*)stg + 1024 + lane * 16); }
        if (dir == 0) { float v16[16];
#pragma unroll
            for (int t = 0; t < 16; ++t) v16[t] = bf1(SV[(16 * c4 + t) * SP_ + lane]);
            const int tcg = isl ? 16 + tcl : tcl;
            unsigned char* vrec = ws + WS_VT + ((size_t)(bidx * 12 + head) * NCHUNK16 + tcg) * 2048 + lane * 32;
            u32x4 o; o.x = pk2(v16[0], v16[1]); o.y = pk2(v16[2], v16[3]); o.z = pk2(v16[4], v16[5]); o.w = pk2(v16[6], v16[7]); *(u32x4*)vrec = o;
            o.x = pk2(v16[8], v16[9]); o.y = pk2(v16[10], v16[11]); o.z = pk2(v16[12], v16[13]); o.w = pk2(v16[14], v16[15]); *(u32x4*)(vrec + 16) = o; }
    }
    __syncthreads();
}

__device__ __forceinline__ float dpp_xor1(float x) { return __builtin_bit_cast(float, __builtin_amdgcn_update_dpp(0, __builtin_bit_cast(int, x), 0xB1, 0xF, 0xF, false)); }
__device__ __forceinline__ float dpp_xor2(float x) { return __builtin_bit_cast(float, __builtin_amdgcn_update_dpp(0, __builtin_bit_cast(int, x), 0x4E, 0xF, 0xF, false)); }
__device__ __forceinline__ int chain_row(int dir, int b, int s) {
    if (s < CTXL) return NLAT + b * CTXL + (dir ? (CTXL - 1 - s) : s);
    const int t = s - CTXL; return b * T + (dir ? (T - 1 - t) : t);
}
__device__ __forceinline__ float dpp_hmirror(float x) { return __builtin_bit_cast(float, __builtin_amdgcn_update_dpp(0, __builtin_bit_cast(int, x), 0x141, 0xF, 0xF, false)); }
struct RwRec { u32x4 wp[2], rp[2], bk[4], arbk; u32x2 mak, vt; f32x4 gam[4]; };
__device__ __forceinline__ void rw_load(RwRec& r, const LAS unsigned char* rec, int fr, int kg, int qv, int dir) {
#pragma unroll
    for (int sx = 0; sx < 2; ++sx) { r.wp[sx] = *(const LAS u32x4*)(rec + PR_WP + fr * 128 + sx * 64 + kg * 16); r.rp[sx] = *(const LAS u32x4*)(rec + PR_RP + fr * 128 + sx * 64 + kg * 16); }
#pragma unroll
    for (int i = 0; i < 4; ++i) { r.bk[i] = *(const LAS u32x4*)(rec + PR_BK + (16 * i + fr) * 64 + kg * 16); r.gam[i] = *(const LAS f32x4*)(rec + PR_GAM + (16 * i + 4 * kg) * 4); }
    r.arbk = *(const LAS u32x4*)(rec + PR_ARBK + fr * 64 + kg * 16);
    r.mak = *(const LAS u32x2*)(rec + PR_MAK + fr * 32 + kg * 8);
    r.vt = *(const LAS u32x2*)(rec + PRE_REC + (16 * qv + fr) * 32 + (dir ? (12 - 4 * kg) : 4 * kg) * 2);
}
constexpr int RW_R = 6, RW_SLOT = PRE_REC + 2048;
__device__ __forceinline__ void rwkv_chain_mfma(KArgs a, int task_base, LAS unsigned char* lds) {
    const int t_ = tid_fresh(); const int lane = t_ & 63, fr = lane & 15, kg = lane >> 4; const int wave = __builtin_amdgcn_readfirstlane(t_ >> 6); const int task = task_base + wave;
    unsigned char* ws = a->ws;
    bf16* OC = (bf16*)(ws + WS_OC);
    const int cid = task >> 2, qv = task & 3, dir = cid / 96, b = (cid % 96) / 12, h = cid % 12;
    const unsigned char* rec0 = ws + WS_PRE + (size_t)((dir * 8 + b) * 12 + h) * NCHUNK16 * PRE_REC;
    const unsigned char* vrec0 = ws + WS_VT + (size_t)(b * 12 + h) * NCHUNK16 * 2048;
    LAS unsigned char* ring = lds + (wave >> 2) * (RW_R * RW_SLOT);
    auto tchunk = [&](int n) { return n < 16 ? (dir ? 15 - n : n) : 16 + (dir ? 255 - (n - 16) : (n - 16)); };
    auto issue = [&](int n) { const int nn = n < NCHUNK16 ? n : NCHUNK16 - 1; LAS unsigned char* slot = ring + (n % RW_R) * RW_SLOT;
#pragma unroll
        for (int jj = 0; jj < 3; ++jj) { const int j = 3 * qv + jj;
            const unsigned char* src = (j < 10 ? rec0 + (size_t)nn * PRE_REC + 1024 * j : vrec0 + (size_t)tchunk(nn) * 2048 + 1024 * (j - 10)) + lane * 16;
            __builtin_amdgcn_global_load_lds((const unsigned*)src, (LAS unsigned*)(slot + 1024 * j), 16, 0, 0); } };
    f32x4 ST[4];
#pragma unroll
    for (int i = 0; i < 4; ++i) ST[i] = (f32x4){0.f, 0.f, 0.f, 0.f};
    unsigned uvU0 = 0u, uvU1 = 0u;
#pragma unroll
    for (int n = 0; n < RW_R - 1; ++n) issue(n);
    for (int n = 0; n < NCHUNK16; ++n) {
        asm volatile("s_waitcnt vmcnt(12)" ::: "memory");
        __builtin_amdgcn_s_barrier(); asm volatile("" ::: "memory");
        issue(n + RW_R - 1);
        RwRec cur; rw_load(cur, ring + (n % RW_R) * RW_SLOT, fr, kg, qv, dir);
        u32x4 fs[2];
#pragma unroll
        for (int sx = 0; sx < 2; ++sx) { fs[sx].x = pk2(ST[2 * sx][0], ST[2 * sx][1]); fs[sx].y = pk2(ST[2 * sx][2], ST[2 * sx][3]); fs[sx].z = pk2(ST[2 * sx + 1][0], ST[2 * sx + 1][1]); fs[sx].w = pk2(ST[2 * sx + 1][2], ST[2 * sx + 1][3]); }
        u32x2 vt = cur.vt; if (dir) { const unsigned x = vt.x, y = vt.y; vt.x = (y >> 16) | (y << 16); vt.y = (x >> 16) | (x << 16); }
        u32x4 fuv; fuv.x = uvU0; fuv.y = uvU1; fuv.z = vt.x; fuv.w = vt.y;
        u32x4 fmak; fmak.x = 0u; fmak.y = 0u; fmak.z = cur.mak.x; fmak.w = cur.mak.y;
        f32x4 U = (f32x4){0.f, 0.f, 0.f, 0.f};
        U = __builtin_amdgcn_mfma_f32_16x16x32_bf16(__builtin_bit_cast(bf16x8, cur.wp[0]), __builtin_bit_cast(bf16x8, fs[0]), U, 0, 0, 0);
        U = __builtin_amdgcn_mfma_f32_16x16x32_bf16(__builtin_bit_cast(bf16x8, cur.wp[1]), __builtin_bit_cast(bf16x8, fs[1]), U, 0, 0, 0);
        U = __builtin_amdgcn_mfma_f32_16x16x32_bf16(__builtin_bit_cast(bf16x8, fmak), __builtin_bit_cast(bf16x8, fuv), U, 0, 0, 0);
        uvU0 = pk2(U[0], U[1]); uvU1 = pk2(U[2], U[3]); fuv.x = uvU0; fuv.y = uvU1;
        f32x4 OT = (f32x4){0.f, 0.f, 0.f, 0.f};
        OT = __builtin_amdgcn_mfma_f32_16x16x32_bf16(__builtin_bit_cast(bf16x8, fs[0]), __builtin_bit_cast(bf16x8, cur.rp[0]), OT, 0, 0, 0);
        OT = __builtin_amdgcn_mfma_f32_16x16x32_bf16(__builtin_bit_cast(bf16x8, fs[1]), __builtin_bit_cast(bf16x8, cur.rp[1]), OT, 0, 0, 0);
        OT = __builtin_amdgcn_mfma_f32_16x16x32_bf16(__builtin_bit_cast(bf16x8, fuv), __builtin_bit_cast(bf16x8, cur.arbk), OT, 0, 0, 0);
#pragma unroll
        for (int i = 0; i < 4; ++i) ST[i] = __builtin_amdgcn_mfma_f32_16x16x32_bf16(__builtin_bit_cast(bf16x8, cur.bk[i]), __builtin_bit_cast(bf16x8, fuv), ST[i] * cur.gam[i], 0, 0, 0);
        const int row = chain_row(dir, b, 16 * n + fr);
        u32x2 o; o.x = pk2(OT[0], OT[1]); o.y = pk2(OT[2], OT[3]); *(u32x2*)(OC + ((size_t)dir * MALL + row) * CW + h * 64 + 16 * qv + 4 * kg) = o;
    }
    asm volatile("s_waitcnt vmcnt(0)" ::: "memory");
    __builtin_amdgcn_s_barrier(); asm volatile("" ::: "memory");
}
#define LDS_BAR() do { asm volatile("s_waitcnt lgkmcnt(0)" ::: "memory"); __builtin_amdgcn_s_barrier(); asm volatile("" ::: "memory"); } while (0)
__device__ __forceinline__ void hgrn_prep_item(KArgs a, int l, int item, LAS unsigned char* lds) {
    const int tid = tid_fresh();
    unsigned char* ws = a->ws;
    bf16* P = (bf16*)(ws + WS_P); bf16* HQB = (bf16*)(ws + WS_HQB); float* HG = (float*)(ws + WS_HG);
    const int cn = item % 68, bh = item / 68, h = bh % 6, b = bh / 6;
    const int row0 = cn < 4 ? NLAT + b * CTXL + 64 * cn : b * T + 64 * (cn - 4);
    constexpr int QP = 136;
    LAS bf16* SQ = (LAS bf16*)lds; LAS bf16* KF = SQ + 64 * QP; LAS bf16* KB = KF + 64 * QP; LAS bf16* QB = KB + 64 * QP;
    LAS float* LF = (LAS float*)(QB + 64 * QP); LAS float* LBk = LF + 64 * 128;
    LAS float* tot = LBk + 64 * 128;
    LAS float* lbs = tot + 1024;
    if (tid < 256) { const int dr = tid >> 7, ch = h * 128 + (tid & 127); float lb = 0.f;
        if (l != 0) { const float l0 = a->in[I_LB][((size_t)dr * DEPTH + 0) * BW + ch], l1 = a->in[I_LB][((size_t)dr * DEPTH + 1) * BW + ch]; lb = __builtin_amdgcn_rcpf(1.0f + __expf(l0 - l1)); }
        lbs[tid] = lb; }
    const int ta = tid >> 3, d0 = (tid & 7) * 16;
    bf16* prow = P + (size_t)(row0 + ta) * INC + h * 128 + d0;
    u32x4 rq[2], rf[2], rb[2];
    rq[0] = *(const u32x4*)(prow + OFF_Q); rq[1] = *(const u32x4*)(prow + OFF_Q + 8); rf[0] = *(const u32x4*)(prow + OFF_ZF); rf[1] = *(const u32x4*)(prow + OFF_ZF + 8); rb[0] = *(const u32x4*)(prow + OFF_ZB); rb[1] = *(const u32x4*)(prow + OFF_ZB + 8);
    __syncthreads();
#pragma unroll
    for (int hf = 0; hf < 2; ++hf) { float qf[8], zf[8], zb[8], oq[8], of[8], ob[8]; unpack8(rq[hf], qf); unpack8(rf[hf], zf); unpack8(rb[hf], zb);
        const int dd = d0 + 8 * hf; f32x4 lf0, lf1, lb0, lb1;
#pragma unroll
        for (int j = 0; j < 8; ++j) { const float lF = lbs[dd + j], lB = lbs[128 + dd + j];
            const float ff = lF + (1.0f - lF) * sigmoidf_(zf[j]), fb = lB + (1.0f - lB) * sigmoidf_(zb[j]);
            const float a1 = fmaxf(__logf(ff), -60.0f), a2 = fmaxf(__logf(fb), -60.0f);
            if (j < 4) { lf0[j] = a1; lb0[j] = a2; } else { lf1[j - 4] = a1; lb1[j - 4] = a2; }
            oq[j] = siluf_(qf[j]); of[j] = 1.0f - ff; ob[j] = 1.0f - fb; }
        *(LAS u32x4*)(SQ + ta * QP + dd) = pack8(oq); *(LAS u32x4*)(KF + ta * QP + dd) = pack8(of); *(LAS u32x4*)(KB + ta * QP + dd) = pack8(ob);
        *(LAS f32x4*)(LF + ta * 128 + dd) = lf0; *(LAS f32x4*)(LF + ta * 128 + dd + 4) = lf1; *(LAS f32x4*)(LBk + ta * 128 + dd) = lb0; *(LAS f32x4*)(LBk + ta * 128 + dd + 4) = lb1; }
    __syncthreads();
    const int d = tid & 127, qt = tid >> 7;
    float csf[16], csb[16];
    { float r1 = 0.f, r2 = 0.f;
#pragma unroll
      for (int i = 0; i < 16; ++i) { const int tp = 16 * qt + i; r1 += LF[tp * 128 + d]; csf[i] = r1; r2 += LBk[(63 - tp) * 128 + d]; csb[i] = r2; }
      tot[qt * 128 + d] = r1; tot[512 + qt * 128 + d] = r2; }
    __syncthreads();
#pragma unroll
    for (int dr = 0; dr < 2; ++dr) { const LAS float* tt = tot + 512 * dr; const float t0 = tt[d], t1 = tt[128 + d], t2 = tt[256 + d], t3 = tt[384 + d];
        const float bmid = t0 + t1, btot = bmid + t2 + t3; const float base = (qt > 0 ? t0 : 0.f) + (qt > 1 ? t1 : 0.f) + (qt > 2 ? t2 : 0.f);
        if (qt == 0) { const int npr = dr == 0 ? cn : (cn < 4 ? 3 - cn : 4 + 63 - (cn - 4)); float* g = HG + ((size_t)(((dr * 8 + b) * 6 + h) * 68 + npr)) * 256; g[d] = __expf(bmid); g[128 + d] = __expf(btot - bmid); }
#pragma unroll
        for (int i = 0; i < 16; ++i) { const int tp = 16 * qt + i, tok = dr ? 63 - tp : tp; const float bt = base + (dr ? csb[i] : csf[i]);
            const float eq = __expf(fminf(bt - bmid, 80.0f)), ek = __expf(fminf(bmid - bt, 80.0f));
            const float qv = bf1(SQ[tok * QP + d]) * eq;
            if (dr == 0) { KF[tok * QP + d] = (bf16)f2bf(bf1(KF[tok * QP + d]) * ek); QB[tok * QP + d] = (bf16)f2bf(qv); }
            else { KB[tok * QP + d] = (bf16)f2bf(bf1(KB[tok * QP + d]) * ek); SQ[tok * QP + d] = (bf16)f2bf(qv); } }
        __syncthreads(); }
#pragma unroll
    for (int hf = 0; hf < 2; ++hf) { const int dd = d0 + 8 * hf;
        *(u32x4*)(prow + OFF_Q + 8 * hf) = *(const LAS u32x4*)(QB + ta * QP + dd); *(u32x4*)(prow + OFF_ZF + 8 * hf) = *(const LAS u32x4*)(KF + ta * QP + dd); *(u32x4*)(prow + OFF_ZB + 8 * hf) = *(const LAS u32x4*)(KB + ta * QP + dd);
        *(u32x4*)(HQB + (size_t)(row0 + ta) * BW + h * 128 + dd) = *(const LAS u32x4*)(SQ + ta * QP + dd); }
    __syncthreads();
}
__device__ __forceinline__ unsigned tr_addr(const LAS bf16* X, int pitch, int r0, int c0, int lane) { const int i = lane & 15, g = lane >> 4; return (unsigned)(size_t)(X + (r0 + 8 * g + (i >> 2)) * pitch + c0 + 4 * (i & 3)); }
__device__ __forceinline__ void tr8x4(u32x2 (&lo)[4], u32x2 (&hi)[4], unsigned a0, unsigned a1, unsigned a2, unsigned a3, unsigned rowstep4) {
    const unsigned b0 = a0 + rowstep4, b1 = a1 + rowstep4, b2 = a2 + rowstep4, b3 = a3 + rowstep4;
    asm volatile("ds_read_b64_tr_b16 %0, %8\n\tds_read_b64_tr_b16 %1, %9\n\tds_read_b64_tr_b16 %2, %10\n\tds_read_b64_tr_b16 %3, %11\n\t"
                 "ds_read_b64_tr_b16 %4, %12\n\tds_read_b64_tr_b16 %5, %13\n\tds_read_b64_tr_b16 %6, %14\n\tds_read_b64_tr_b16 %7, %15\n\ts_waitcnt lgkmcnt(0)"
                 : "=&v"(lo[0]), "=&v"(lo[1]), "=&v"(lo[2]), "=&v"(lo[3]), "=&v"(hi[0]), "=&v"(hi[1]), "=&v"(hi[2]), "=&v"(hi[3])
                 : "v"(a0), "v"(a1), "v"(a2), "v"(a3), "v"(b0), "v"(b1), "v"(b2), "v"(b3) : "memory");
}
__device__ __forceinline__ bf16x8 mk8(u32x2 lo, u32x2 hi) { u32x4 v; v.x = lo.x; v.y = lo.y; v.z = hi.x; v.w = hi.y; return __builtin_bit_cast(bf16x8, v); }
__device__ __forceinline__ void hgrn_chain_lean(KArgs a, int cid, LAS unsigned char* lds) {
    const int tid = tid_fresh(), lane = tid & 63, wave = tid >> 6, fr = lane & 15, fq = lane >> 4;
    unsigned char* ws = a->ws;
    const bf16* P = (const bf16*)(ws + WS_P); const bf16* HQB = (const bf16*)(ws + WS_HQB); const float* HG = (const float*)(ws + WS_HG); bf16* OB = (bf16*)(ws + WS_OB);
    const int dir = cid / 48, b = (cid % 48) / 6, h = cid % 6;
    constexpr int QP = 136, SP = 72;
    LAS bf16* qs = (LAS bf16*)lds;
    LAS bf16* ks = qs + 64 * QP;
    LAS bf16* vs = ks + 64 * QP;
    LAS bf16* pl = vs + 64 * QP;
    LAS bf16* sT = pl + 64 * SP;
    LAS float* gm = (LAS float*)(sT + 128 * QP);
    const int ta = tid >> 3, d0 = (tid & 7) * 16;
    const int koff = dir ? OFF_ZB : OFF_ZF;
    f32x4 S[8];
#pragma unroll
    for (int vt = 0; vt < 8; ++vt) S[vt] = (f32x4){0.f, 0.f, 0.f, 0.f};
    u32x4 rq[2], rk[2], rv[2]; float rg = 0.f;
    auto load_chunk = [&](int n) { const int row = chain_row(dir, b, 64 * n + ta); const bf16* pr = P + (size_t)row * INC + h * 128 + d0;
        const bf16* qr = dir ? HQB + (size_t)row * BW + h * 128 + d0 : pr + OFF_Q;
        rq[0] = *(const u32x4*)qr; rq[1] = *(const u32x4*)(qr + 8); rk[0] = *(const u32x4*)(pr + koff); rk[1] = *(const u32x4*)(pr + koff + 8); rv[0] = *(const u32x4*)(pr + OFF_I); rv[1] = *(const u32x4*)(pr + OFF_I + 8);
        if (tid < 256) rg = HG[((size_t)(((dir * 8 + b) * 6 + h) * 68 + n)) * 256 + tid]; };
    load_chunk(0);
    constexpr int NCH = (CTXL + T) / 64;
    for (int n = 0; n < NCH; ++n) {
        const int s0 = n * 64;
        *(LAS u32x4*)(qs + ta * QP + d0) = rq[0]; *(LAS u32x4*)(qs + ta * QP + d0 + 8) = rq[1]; *(LAS u32x4*)(ks + ta * QP + d0) = rk[0]; *(LAS u32x4*)(ks + ta * QP + d0 + 8) = rk[1];
        *(LAS u32x4*)(vs + ta * QP + d0) = rv[0]; *(LAS u32x4*)(vs + ta * QP + d0 + 8) = rv[1]; if (tid < 256) gm[tid] = rg;
        if (n + 1 < NCH) load_chunk(n + 1);
        LDS_BAR();
        { const f32x4 g4 = *(const LAS f32x4*)(gm + 16 * wave + 4 * fq);
#pragma unroll
          for (int vt = 0; vt < 8; ++vt) { S[vt] = S[vt] * g4; u32x2 o; o.x = pk2(S[vt][0], S[vt][1]); o.y = pk2(S[vt][2], S[vt][3]); *(LAS u32x2*)(sT + (16 * vt + fr) * QP + 16 * wave + 4 * fq) = o; } }
        { const int tt = wave >> 1;
#pragma unroll
          for (int u = 0; u < 2; ++u) { const int sg = 2 * (wave & 1) + u; f32x4 acc = (f32x4){0.f, 0.f, 0.f, 0.f};
              if (sg <= tt) {
#pragma unroll
                  for (int kq = 0; kq < 4; ++kq) { const bf16x8 af = *(const LAS bf16x8*)(ks + (16 * sg + fr) * QP + 32 * kq + 8 * fq), bfm = *(const LAS bf16x8*)(qs + (16 * tt + fr) * QP + 32 * kq + 8 * fq);
                      acc = __builtin_amdgcn_mfma_f32_16x16x32_bf16(af, bfm, acc, 0, 0, 0); }
                  if (sg == tt) {
#pragma unroll
                      for (int j = 0; j < 4; ++j) if (4 * fq + j > fr) acc[j] = 0.f; }
              }
              u32x2 o; o.x = pk2(acc[0], acc[1]); o.y = pk2(acc[2], acc[3]); *(LAS u32x2*)(pl + (16 * tt + fr) * SP + 16 * sg + 4 * fq) = o; } }
        LDS_BAR();
        u32x2 vl_[2][8], vh_[2][8], xl_[2][4], xh_[2][4];
        const unsigned rs4 = (unsigned)(4 * QP * 2);
#pragma unroll
        for (int kq = 0; kq < 2; ++kq) {
            u32x2 l4[4], h4[4];
            tr8x4(l4, h4, tr_addr(vs, QP, 32 * kq, 0, lane), tr_addr(vs, QP, 32 * kq, 16, lane), tr_addr(vs, QP, 32 * kq, 32, lane), tr_addr(vs, QP, 32 * kq, 48, lane), rs4);
#pragma unroll
            for (int q = 0; q < 4; ++q) { vl_[kq][q] = l4[q]; vh_[kq][q] = h4[q]; }
            tr8x4(l4, h4, tr_addr(vs, QP, 32 * kq, 64, lane), tr_addr(vs, QP, 32 * kq, 80, lane), tr_addr(vs, QP, 32 * kq, 96, lane), tr_addr(vs, QP, 32 * kq, 112, lane), rs4);
#pragma unroll
            for (int q = 0; q < 4; ++q) { vl_[kq][4 + q] = l4[q]; vh_[kq][4 + q] = h4[q]; }
        }
        { u32x2 l4[4], h4[4];
          tr8x4(l4, h4, tr_addr(ks, QP, 0, 16 * wave, lane), tr_addr(vs, QP, 0, 16 * wave, lane), tr_addr(ks, QP, 32, 16 * wave, lane), tr_addr(vs, QP, 32, 16 * wave, lane), rs4);
          xl_[0][0] = l4[0]; xh_[0][0] = h4[0]; xl_[0][1] = l4[1]; xh_[0][1] = h4[1]; xl_[1][0] = l4[2]; xh_[1][0] = h4[2]; xl_[1][1] = l4[3]; xh_[1][1] = h4[3]; }
        __builtin_amdgcn_sched_barrier(0);
#pragma unroll
        for (int tt = 0; tt < 4; ++tt) { f32x4 acc = (f32x4){0.f, 0.f, 0.f, 0.f};
#pragma unroll
            for (int kq = 0; kq < 2; ++kq) { const bf16x8 af = mk8(xl_[kq][1], xh_[kq][1]);
                const bf16x8 bfm = *(const LAS bf16x8*)(pl + (16 * tt + fr) * SP + 32 * kq + 8 * fq); acc = __builtin_amdgcn_mfma_f32_16x16x32_bf16(af, bfm, acc, 0, 0, 0); }
#pragma unroll
            for (int kq = 0; kq < 4; ++kq) { const bf16x8 af = *(const LAS bf16x8*)(sT + (16 * wave + fr) * QP + 32 * kq + 8 * fq), bfm = *(const LAS bf16x8*)(qs + (16 * tt + fr) * QP + 32 * kq + 8 * fq);
                acc = __builtin_amdgcn_mfma_f32_16x16x32_bf16(af, bfm, acc, 0, 0, 0); }
            const int row = chain_row(dir, b, s0 + 16 * tt + fr);
            u32x2 o; o.x = pk2(acc[0], acc[1]); o.y = pk2(acc[2], acc[3]); *(u32x2*)(OB + ((size_t)dir * MALL + row) * BW + h * 128 + 16 * wave + 4 * fq) = o; }
        { const f32x4 ge = *(const LAS f32x4*)(gm + 128 + 16 * wave + 4 * fq);
#pragma unroll
          for (int kq = 0; kq < 2; ++kq) { const bf16x8 af = mk8(xl_[kq][0], xh_[kq][0]);
#pragma unroll
              for (int vt = 0; vt < 8; ++vt) S[vt] = __builtin_amdgcn_mfma_f32_16x16x32_bf16(af, mk8(vl_[kq][vt], vh_[kq][vt]), S[vt], 0, 0, 0); }
#pragma unroll
          for (int vt = 0; vt < 8; ++vt) S[vt] = S[vt] * ge; }
        LDS_BAR();
    }
}
__device__ __forceinline__ void hgrn_chain_mfma(KArgs a, int l, int cid, LAS unsigned char* lds) {
    const int tid = tid_fresh(), lane = tid & 63, wave = tid >> 6, fr = lane & 15, fq = lane >> 4;
    unsigned char* ws = a->ws;
    const bf16* P = (const bf16*)(ws + WS_P); bf16* OB = (bf16*)(ws + WS_OB);
    const int dir = cid / 48, b = (cid % 48) / 6, h = cid % 6;
    constexpr int QP = 136, SP = 72;
    LAS bf16* qs = (LAS bf16*)lds;
    LAS bf16* ks = qs + 64 * QP;
    LAS bf16* kT = ks + 64 * QP;
    LAS bf16* vT = kT + 128 * SP;
    LAS bf16* pl = vT + 128 * SP;
    LAS bf16* sT = pl + 64 * SP;
    LAS float* tot = (LAS float*)(sT + 128 * QP);
    LAS float* gmid = tot + 512;
    LAS float* gend = gmid + 128;
    LAS float* lbs = gend + 128;
    LAS float* lfb = (LAS float*)sT;
    const int d = tid & 127, qt = tid >> 7;
    const int tau_a = tid >> 3, d0 = (tid & 7) * 16;
    if (tid < 128) { const int ch = h * 128 + tid; float lb = 0.f;
        if (l != 0) { const float l0 = a->in[I_LB][((size_t)dir * DEPTH + 0) * BW + ch], l1 = a->in[I_LB][((size_t)dir * DEPTH + 1) * BW + ch]; lb = 1.0f / (1.0f + __expf(l0 - l1)); }
        lbs[tid] = lb; }
    f32x4 S[8];
#pragma unroll
    for (int vt = 0; vt < 8; ++vt) S[vt] = (f32x4){0.f, 0.f, 0.f, 0.f};
    const int zoff = dir ? OFF_ZB : OFF_ZF;
    u32x4 rq[2], ri[2], rz[2];
    { const bf16* pr = P + (size_t)chain_row(dir, b, tau_a) * INC + h * 128 + d0;
      rq[0] = *(const u32x4*)(pr + OFF_Q); rq[1] = *(const u32x4*)(pr + OFF_Q + 8); ri[0] = *(const u32x4*)(pr + OFF_I); ri[1] = *(const u32x4*)(pr + OFF_I + 8); rz[0] = *(const u32x4*)(pr + zoff); rz[1] = *(const u32x4*)(pr + zoff + 8); }
    __syncthreads();
    constexpr int NCH = (CTXL + T) / 64;
    for (int n = 0; n < NCH; ++n) {
        const int s0 = n * 64;
#pragma unroll
        for (int hf = 0; hf < 2; ++hf) { float qf[8], zf[8], oq[8], ok[8]; unpack8(rq[hf], qf); unpack8(rz[hf], zf);
            const int dd = d0 + 8 * hf; const f32x4 lb0 = *(const LAS f32x4*)(lbs + dd), lb1 = *(const LAS f32x4*)(lbs + dd + 4); f32x4 lf0, lf1;
#pragma unroll
            for (int j = 0; j < 8; ++j) { const float lb = j < 4 ? lb0[j] : lb1[j - 4]; const float f = lb + (1.0f - lb) * sigmoidf_(zf[j]); const float lf = fmaxf(__logf(f), -60.0f);
                if (j < 4) lf0[j] = lf; else lf1[j - 4] = lf; oq[j] = siluf_(qf[j]); ok[j] = 1.0f - f; }
            *(LAS u32x4*)(qs + tau_a * QP + dd) = pack8(oq); *(LAS u32x4*)(ks + tau_a * QP + dd) = pack8(ok);
            *(LAS f32x4*)(lfb + tau_a * 128 + dd) = lf0; *(LAS f32x4*)(lfb + tau_a * 128 + dd + 4) = lf1;
            const u32x4 vv = ri[hf];
            vT[(dd + 0) * SP + tau_a] = (bf16)(vv.x & 0xffffu); vT[(dd + 1) * SP + tau_a] = (bf16)(vv.x >> 16); vT[(dd + 2) * SP + tau_a] = (bf16)(vv.y & 0xffffu); vT[(dd + 3) * SP + tau_a] = (bf16)(vv.y >> 16);
            vT[(dd + 4) * SP + tau_a] = (bf16)(vv.z & 0xffffu); vT[(dd + 5) * SP + tau_a] = (bf16)(vv.z >> 16); vT[(dd + 6) * SP + tau_a] = (bf16)(vv.w & 0xffffu); vT[(dd + 7) * SP + tau_a] = (bf16)(vv.w >> 16); }
        if (n + 1 < NCH) { const bf16* pr = P + (size_t)chain_row(dir, b, s0 + 64 + tau_a) * INC + h * 128 + d0;
            rq[0] = *(const u32x4*)(pr + OFF_Q); rq[1] = *(const u32x4*)(pr + OFF_Q + 8); ri[0] = *(const u32x4*)(pr + OFF_I); ri[1] = *(const u32x4*)(pr + OFF_I + 8); rz[0] = *(const u32x4*)(pr + zoff); rz[1] = *(const u32x4*)(pr + zoff + 8); }
        LDS_BAR();
        float cs[16];
        { float run = 0.f;
#pragma unroll
          for (int i = 0; i < 16; ++i) { run += lfb[(16 * qt + i) * 128 + d]; cs[i] = run; }
          tot[qt * 128 + d] = run; }
        LDS_BAR();
        { const float t0 = tot[d], t1 = tot[128 + d], t2 = tot[256 + d], t3 = tot[384 + d];
          const float bmid = t0 + t1, btot = bmid + t2 + t3; const float base = (qt > 0 ? t0 : 0.f) + (qt > 1 ? t1 : 0.f) + (qt > 2 ? t2 : 0.f);
          if (qt == 0) { gmid[d] = __expf(bmid); gend[d] = __expf(btot - bmid); }
#pragma unroll
          for (int i = 0; i < 16; ++i) { const int tau = 16 * qt + i; const float bt = base + cs[i];
              const float eq = __expf(fminf(bt - bmid, 80.0f)), ek = __expf(fminf(bmid - bt, 80.0f));
              const bf16 qb = (bf16)f2bf(bf1(qs[tau * QP + d]) * eq), kb = (bf16)f2bf(bf1(ks[tau * QP + d]) * ek);
              qs[tau * QP + d] = qb; ks[tau * QP + d] = kb; kT[d * SP + tau] = kb; } }
        LDS_BAR();
        { const f32x4 gm = *(const LAS f32x4*)(gmid + 16 * wave + 4 * fq);
#pragma unroll
          for (int vt = 0; vt < 8; ++vt) { S[vt] = S[vt] * gm; u32x2 o; o.x = pk2(S[vt][0], S[vt][1]); o.y = pk2(S[vt][2], S[vt][3]); *(LAS u32x2*)(sT + (16 * vt + fr) * QP + 16 * wave + 4 * fq) = o; } }
        { const int tt = wave >> 1;
#pragma unroll
          for (int u = 0; u < 2; ++u) { const int sg = 2 * (wave & 1) + u; f32x4 acc = (f32x4){0.f, 0.f, 0.f, 0.f};
              if (sg <= tt) {
#pragma unroll
                  for (int kq = 0; kq < 4; ++kq) { const bf16x8 af = *(const LAS bf16x8*)(ks + (16 * sg + fr) * QP + 32 * kq + 8 * fq), bfm = *(const LAS bf16x8*)(qs + (16 * tt + fr) * QP + 32 * kq + 8 * fq);
                      acc = __builtin_amdgcn_mfma_f32_16x16x32_bf16(af, bfm, acc, 0, 0, 0); }
                  if (sg == tt) {
#pragma unroll
                      for (int j = 0; j < 4; ++j) if (4 * fq + j > fr) acc[j] = 0.f; }
              }
              u32x2 o; o.x = pk2(acc[0], acc[1]); o.y = pk2(acc[2], acc[3]); *(LAS u32x2*)(pl + (16 * tt + fr) * SP + 16 * sg + 4 * fq) = o; } }
        LDS_BAR();
#pragma unroll
        for (int tt = 0; tt < 4; ++tt) { f32x4 acc = (f32x4){0.f, 0.f, 0.f, 0.f};
#pragma unroll
            for (int kq = 0; kq < 2; ++kq) { const bf16x8 af = *(const LAS bf16x8*)(vT + (16 * wave + fr) * SP + 32 * kq + 8 * fq), bfm = *(const LAS bf16x8*)(pl + (16 * tt + fr) * SP + 32 * kq + 8 * fq);
                acc = __builtin_amdgcn_mfma_f32_16x16x32_bf16(af, bfm, acc, 0, 0, 0); }
#pragma unroll
            for (int kq = 0; kq < 4; ++kq) { const bf16x8 af = *(const LAS bf16x8*)(sT + (16 * wave + fr) * QP + 32 * kq + 8 * fq), bfm = *(const LAS bf16x8*)(qs + (16 * tt + fr) * QP + 32 * kq + 8 * fq);
                acc = __builtin_amdgcn_mfma_f32_16x16x32_bf16(af, bfm, acc, 0, 0, 0); }
            const int row = chain_row(dir, b, s0 + 16 * tt + fr);
            u32x2 o; o.x = pk2(acc[0], acc[1]); o.y = pk2(acc[2], acc[3]); *(u32x2*)(OB + ((size_t)dir * MALL + row) * BW + h * 128 + 16 * wave + 4 * fq) = o; }
        { const f32x4 ge = *(const LAS f32x4*)(gend + 16 * wave + 4 * fq);
#pragma unroll
          for (int kq = 0; kq < 2; ++kq) { const bf16x8 af = *(const LAS bf16x8*)(kT + (16 * wave + fr) * SP + 32 * kq + 8 * fq);
#pragma unroll
              for (int vt = 0; vt < 8; ++vt) { const bf16x8 bfm = *(const LAS bf16x8*)(vT + (16 * vt + fr) * SP + 32 * kq + 8 * fq); S[vt] = __builtin_amdgcn_mfma_f32_16x16x32_bf16(af, bfm, S[vt], 0, 0, 0); } }
#pragma unroll
          for (int vt = 0; vt < 8; ++vt) S[vt] = S[vt] * ge; }
        LDS_BAR();
    }
}
__device__ __forceinline__ void hgrn_chain(KArgs a, int l, int cid, LAS unsigned char* lds) {
    const int tid = tid_fresh();
    unsigned char* ws = a->ws;
    const bf16* P = (const bf16*)(ws + WS_P); bf16* OB = (bf16*)(ws + WS_OB);
    const int dir = cid / 48, b = (cid % 48) / 6, h = cid % 6;
    LAS float* tq = (LAS float*)lds;
    LAS float* tk = tq + 16 * 128;
    LAS float* tf = tk + 16 * 128;
    LAS float* tv = tf + 16 * 128;
    LAS float* ot = tv + 16 * 128;
    const int v = tid >> 2, q = tid & 3;
    float S[32];
#pragma unroll
    for (int j = 0; j < 32; ++j) S[j] = 0.f;
    const int sst = tid >> 5, sc4 = (tid & 31) * 4;
    float lb[4];
#pragma unroll
    for (int j = 0; j < 4; ++j) { const int ch = h * 128 + sc4 + j;
        if (l == 0) lb[j] = 0.f; else { const float l0 = a->in[I_LB][((size_t)dir * DEPTH + 0) * BW + ch], l1 = a->in[I_LB][((size_t)dir * DEPTH + 1) * BW + ch]; lb[j] = 1.0f / (1.0f + __expf(l0 - l1)); } }
    for (int s0 = 0; s0 < CTXL + T; s0 += 16) {
        { const int row = chain_row(dir, b, s0 + sst); const bf16* pr = P + (size_t)row * INC + h * 128 + sc4;
          const u32x2 pq = *(const u32x2*)(pr + OFF_Q), pi = *(const u32x2*)(pr + OFF_I), pz = *(const u32x2*)(pr + (dir ? OFF_ZB : OFF_ZF));
          const float qf[4] = {bflo(pq.x), bfhi(pq.x), bflo(pq.y), bfhi(pq.y)}, vf[4] = {bflo(pi.x), bfhi(pi.x), bflo(pi.y), bfhi(pi.y)}, zf[4] = {bflo(pz.x), bfhi(pz.x), bflo(pz.y), bfhi(pz.y)};
          f32x4 oq, ok, of, ov;
#pragma unroll
          for (int j = 0; j < 4; ++j) { const float f = lb[j] + (1.0f - lb[j]) * sigmoidf_(zf[j]); oq[j] = siluf_(qf[j]); of[j] = f; ok[j] = 1.0f - f; ov[j] = vf[j]; }
          *(LAS f32x4*)(tq + sst * 128 + sc4) = oq; *(LAS f32x4*)(tk + sst * 128 + sc4) = ok; *(LAS f32x4*)(tf + sst * 128 + sc4) = of; *(LAS f32x4*)(tv + sst * 128 + sc4) = ov; }
        LDS_BAR();
        for (int st = 0; st < 16; ++st) {
            const float vv = tv[st * 128 + v]; float o0 = 0.f, o1 = 0.f;
#pragma unroll
            for (int j = 0; j < 8; ++j) { const f32x4 fq4 = *(const LAS f32x4*)(tf + st * 128 + q * 32 + 4 * j), kq4 = *(const LAS f32x4*)(tk + st * 128 + q * 32 + 4 * j), qq4 = *(const LAS f32x4*)(tq + st * 128 + q * 32 + 4 * j);
#pragma unroll
                for (int i = 0; i < 4; ++i) { const float sn = fq4[i] * S[4 * j + i] + kq4[i] * vv; S[4 * j + i] = sn; if (i & 1) o1 += qq4[i] * sn; else o0 += qq4[i] * sn; } }
            float o = o0 + o1; o += dpp_xor1(o); o += dpp_xor2(o);
            if (q == 0) ot[st * 128 + v] = o;
        }
        LDS_BAR();
        if (tid < 256) { const int st = tid >> 4, part = tid & 15; const int row = chain_row(dir, b, s0 + st); const LAS float* op = ot + st * 128 + part * 8;
            float f[8];
#pragma unroll
            for (int j = 0; j < 8; ++j) f[j] = op[j];
            *(u32x4*)(OB + ((size_t)dir * MALL + row) * BW + h * 128 + part * 8) = pack8(f); }
    }
    LDS_BAR();
}

__device__ __forceinline__ float grp_sum32(float v) { v += __shfl_xor(v, 1); v += __shfl_xor(v, 2); v += __shfl_xor(v, 4); v += __shfl_xor(v, 8); v += __shfl_xor(v, 16); return v; }
__device__ __forceinline__ float grp_sum16(float v) { v += __shfl_xor(v, 1); v += __shfl_xor(v, 2); v += __shfl_xor(v, 4); v += __shfl_xor(v, 8); return v; }
__device__ __forceinline__ void phase_finalize(KArgs a, int l, bool dry) {
    const int tid_ = tid_fresh(); const int lane = tid_ & 63, wave = tid_ >> 6, gw = blockIdx.x * 8 + wave, NGW = gridDim.x * 8;
    unsigned char* ws = a->ws;
    const bf16* P = (const bf16*)(ws + WS_P); const bf16* OB = (const bf16*)(ws + WS_OB); const bf16* OC = (const bf16*)(ws + WS_OC); bf16* Y = (bf16*)(ws + WS_Y);
    bf16* Yo = dry ? (bf16*)(ws + WS_END) : Y;
    const int nrows = (l == DEPTH - 1) ? NLAT : MALL;
    const int rpw = (nrows + NGW - 1) / NGW; const int r0 = gw * rpw, r1 = (r0 + rpw < nrows) ? r0 + rpw : nrows;
    f32x4 hng[3], gng[3], gnb[3];
#pragma unroll
    for (int k = 0; k < 3; ++k) { const int c = 256 * k + 4 * lane; hng[k] = *(const f32x4*)(a->in[I_HNG] + (size_t)l * BW + c);
        gng[k] = *(const f32x4*)(a->in[I_GNGG] + (size_t)l * CW + c); gnb[k] = *(const f32x4*)(a->in[I_GNB] + (size_t)l * CW + c); }
    for (int row = r0; row < r1; ++row) {
        const int orow = dry ? (row & 2047) : row;
        u32x2 bf_[3], bb_[3], bg_[3], cf_[3], cb_[3], cv_[3], cg_[3];
#pragma unroll
        for (int k = 0; k < 3; ++k) { const int c = 256 * k + 4 * lane;
            bf_[k] = *(const u32x2*)(OB + (size_t)row * BW + c); bb_[k] = *(const u32x2*)(OB + ((size_t)MALL + row) * BW + c); bg_[k] = *(const u32x2*)(P + (size_t)row * INC + OFF_OG + c);
            cf_[k] = *(const u32x2*)(OC + (size_t)row * CW + c); cb_[k] = *(const u32x2*)(OC + ((size_t)MALL + row) * CW + c);
            cv_[k] = *(const u32x2*)(Y + (size_t)row * D + 512 + c);
            cg_[k] = *(const u32x2*)(Y + (size_t)row * D + 1280 + c); }
#pragma unroll
        for (int k = 0; k < 3; ++k) { const int c = 256 * k + 4 * lane;
            { float o[4] = {bflo(bf_[k].x) + bflo(bb_[k].x), bfhi(bf_[k].x) + bfhi(bb_[k].x), bflo(bf_[k].y) + bflo(bb_[k].y), bfhi(bf_[k].y) + bfhi(bb_[k].y)};
              const float ss = grp_sum32((o[0] * o[0] + o[1] * o[1]) + (o[2] * o[2] + o[3] * o[3])); const float rstd = 1.0f / sqrtf(ss * (1.0f / 128.0f) + NORM_EPS);
              const float g4[4] = {bflo(bg_[k].x), bfhi(bg_[k].x), bflo(bg_[k].y), bfhi(bg_[k].y)}; float y[4];
#pragma unroll
              for (int j = 0; j < 4; ++j) y[j] = o[j] * rstd * hng[k][j] * sigmoidf_(g4[j]);
              u32x2 q; q.x = pk2(y[0], y[1]); q.y = pk2(y[2], y[3]); *(u32x2*)(Yo + (size_t)orow * D + 512 + c) = q; }
            { float o[4] = {bflo(cf_[k].x) + bflo(cb_[k].x), bfhi(cf_[k].x) + bfhi(cb_[k].x), bflo(cf_[k].y) + bflo(cb_[k].y), bfhi(cf_[k].y) + bfhi(cb_[k].y)};
              const float v4[4] = {bflo(cv_[k].x), bfhi(cv_[k].x), bflo(cv_[k].y), bfhi(cv_[k].y)}, g4[4] = {bflo(cg_[k].x), bfhi(cg_[k].x), bflo(cg_[k].y), bfhi(cg_[k].y)};
              const float mean = grp_sum16((o[0] + o[1]) + (o[2] + o[3])) * (1.0f / 64.0f);
              float dl[4]; float sq = 0.f;
#pragma unroll
              for (int j = 0; j < 4; ++j) { dl[j] = o[j] - mean; sq += dl[j] * dl[j]; }
              const float var = grp_sum16(sq) * (1.0f / 64.0f); const float rs = 1.0f / sqrtf(var + GN_EPS); float y[4];
#pragma unroll
              for (int j = 0; j < 4; ++j) y[j] = (dl[j] * rs * gng[k][j] + gnb[k][j] + v4[j]) * g4[j];
              u32x2 q; q.x = pk2(y[0], y[1]); q.y = pk2(y[2], y[3]); *(u32x2*)(Yo + (size_t)orow * D + 1280 + c) = q; }
        }
    }
}

__global__ void __launch_bounds__(NTHREADS, 2) mk_fwd(Args args_unused) {
    extern __shared__ __attribute__((aligned(16))) unsigned char lds_raw[];
    LAS unsigned char* lds = (LAS unsigned char*)lds_raw;
    volatile LAS unsigned* misc = (volatile LAS unsigned*)(lds + LDS_MISC);
    const int tid = threadIdx.x, G = gridDim.x;
    if (tid < 64) misc[tid] = 0u;
    __syncthreads();
    XcdBarrier bar; bar.bar = nullptr; bar.x = 0; bar.st = nullptr;
    int lo, hi;
    { KArgs a = kargs(); lo = a->ph_lo; hi = a->ph_hi; unsigned* ctl = (unsigned*)(a->ws + WS_CTL); bar.bar = ctl + CW_BAR; if (!MK_MULTI) bar = xcd_barrier_post(ctl + CW_BAR, misc + 8); }
    const int cvirt = (G % 8 == 0) ? ((int)blockIdx.x % 8) * (G / 8) + (int)blockIdx.x / 8 : (int)blockIdx.x;
#define IN(k) (lo <= (k) && (k) < hi)
#define PM(b) ((PHMASK >> (b)) & 1)
#define REP(b) _Pragma("unroll 1") for (int rep_ = 0; rep_ < 1 + ((PROBE_DUP >> (b)) & 1); ++rep_)
#define SEAM(k) do { if (!MK_MULTI && IN(k) && IN((k) + 1)) { xcd_barrier(bar); if ((PROBE_DUP >> 13) & 1) xcd_barrier(bar); } } while (0)

    if (PM(0) && IN(0)) REP(0) { phase_prologue(kargs(), lds); } SEAM(0);

#pragma unroll 1
    for (int l = 0; l < DEPTH; ++l) {
        const int pb = 1 + 9 * l;
        const bool lastl = (l == DEPTH - 1);
        if (PM(1) && IN(pb + 0)) { if ((PROBE_DUP >> 1) & 1) { if (l == 0) phase_norm1<0>(kargs(), l, true); else phase_norm1<1>(kargs(), l, true); } if (l == 0) phase_norm1<0>(kargs(), l, false); else { phase_norm1<1>(kargs(), l, false); __syncthreads(); convert_moe(kargs(), l, lds); __syncthreads(); } } SEAM(pb + 0);
        if (PM(2) && IN(pb + 1)) REP(2) {
            KArgs a = kargs(); unsigned char* ws = a->ws;
            pg8::Gemm g{(const bf16*)(ws + WS_H), (const bf16*)(ws + WS_WIN) + (size_t)l * INC * D, MALL, INC, D};
            pg8::StaticOrder S; S.init(MALL, INC, G, (int)blockIdx.x);
            pg8::EpiBf16 E{(bf16*)(ws + WS_P), INC};
            pg8::gemm_phase<pg8::EpiBf16, pg8::StaticOrder, true, false>(lds, g, S, E, nullptr);
        } SEAM(pb + 1);
        if (PM(3) && IN(pb + 2)) REP(3) {
            const int ngm = lastl ? 1024 : 1088;
            for (int it = blockIdx.x; it < ngm + 544 * 12 + 3264; it += G) { if (it >= ngm + 544 * 12) hgrn_prep_item(kargs(), l, it - ngm - 544 * 12, lds); else if (it < ngm) { _Pragma("unroll 1") for (int r2 = 0; r2 < 1 + ((PROBE_DUP >> 14) & 1); ++r2) gmlp_item(kargs(), l, it, lds); } else { const int q = it - ngm; _Pragma("unroll 1") for (int r2 = 0; r2 < 1 + ((PROBE_DUP >> 15) & 1); ++r2) rwkv_prep_item(kargs(), l, q / 12, q % 12, lds); } }
        } SEAM(pb + 2);
        if (PM(4) && IN(pb + 3)) REP(4) {
            if (G == 256) { const int bx = blockIdx.x;
                if (bx < 96) rwkv_chain_mfma(kargs(), bx * 8, lds);
                else if (bx < 192) hgrn_chain_lean(kargs(), bx - 96, lds); }
            else { for (int it = blockIdx.x; it < 192; it += G) { if (it < 96) rwkv_chain_mfma(kargs(), it * 8, lds); else hgrn_chain_lean(kargs(), it - 96, lds); } }
        } SEAM(pb + 3);
        if (PM(5) && IN(pb + 4)) { if ((PROBE_DUP >> 5) & 1) phase_finalize(kargs(), l, true); phase_finalize(kargs(), l, false); } SEAM(pb + 4);
        if (PM(6) && IN(pb + 5)) REP(6) {
            KArgs a = kargs(); unsigned char* ws = a->ws;
            const int Mo = lastl ? NLAT : MALL;
            pg8::Gemm g{(const bf16*)(ws + WS_Y), (const bf16*)(ws + WS_WOUT) + (size_t)l * D * D, Mo, D, D};
            pg8::StaticOrder S; S.init(Mo, D, G, (int)blockIdx.x);
            const float* xl = l == 0 ? a->in[I_X] : (const float*)(ws + WS_X); const float* xc = l == 0 ? a->in[I_CTX] : (const float*)(ws + WS_X) + (size_t)NLAT * D;
            pg8::EpiResid E{xl, xc, (float*)(ws + WS_X), (const float*)(ws + WS_MOD) + (size_t)l * 9 * 12288 + 2 * D};
            pg8::gemm_phase<pg8::EpiResid, pg8::StaticOrder, true, false>(lds, g, S, E, nullptr);
        } SEAM(pb + 5);
        if (PM(7) && IN(pb + 6)) { if ((PROBE_DUP >> 7) & 1) phase_norm2_router(kargs(), l, true, lds); phase_norm2_router(kargs(), l, false, lds); } SEAM(pb + 6);
        if (PM(8) && IN(pb + 7)) REP(8) {
            KArgs a = kargs(); unsigned char* ws = a->ws;
            moe_tables<false>(a, l, lds, cvirt);
            pg8::Gemm g{(const bf16*)(ws + WS_H), (const bf16*)(ws + WS_WGU), 0, 2048, D};
            pg8::MoeOrder S{(const LAS int*)(lds + LDS_TP), G, cvirt, (unsigned)(2048 * D * 2)};
            pg8::EpiSwiglu E{(bf16*)(ws + WS_ACT)};
            pg8::gemm_phase<pg8::EpiSwiglu, pg8::MoeOrder, false, true>(lds, g, S, E, (const LAS unsigned*)(lds + LDS_TAB));
        } SEAM(pb + 7);
        if (PM(9) && IN(pb + 8)) REP(9) {
            KArgs a = kargs(); unsigned char* ws = a->ws;
            moe_tables<true>(a, l, lds, cvirt);
            pg8::Gemm g{(const bf16*)(ws + WS_ACT), (const bf16*)(ws + WS_WDN), 0, D, DE};
            pg8::MoeOrder S{(const LAS int*)(lds + LDS_TP), G, cvirt, (unsigned)(D * DE * 2)};
            pg8::EpiDown E{(bf16*)(ws + WS_YK), (const LAS unsigned*)(lds + LDS_TAB), (const LAS float*)(lds + LDS_TABW)};
            pg8::gemm_phase<pg8::EpiDown, pg8::MoeOrder, false, false>(lds, g, S, E, nullptr);
        } SEAM(pb + 8);
    }
    if (PM(10) && IN(1 + 9 * DEPTH)) { if ((PROBE_DUP >> 10) & 1) phase_norm1<2>(kargs(), DEPTH, true); phase_norm1<2>(kargs(), DEPTH, false); }
#undef IN
#undef SEAM
}

extern "C" void kernel_launch(void* const* d_in, const int* in_sizes, int n_in, void* d_out, int out_size, void* d_ws, size_t ws_size, hipStream_t stream) {
    static int grid = 0;
    if (grid == 0) {
        if (n_in != 31 || ws_size < WS_END) { fprintf(stderr, "kernel_launch: unexpected n_in %d / ws %zu (need %zu)\n", n_in, ws_size, (size_t)WS_END); grid = -1; return; }
        int dev = 0, cus = 0, per_cu = 0;
        hipGetDevice(&dev); hipDeviceGetAttribute(&cus, hipDeviceAttributeMultiprocessorCount, dev);
        if (hipFuncSetAttribute((const void*)mk_fwd, hipFuncAttributeMaxDynamicSharedMemorySize, LDS_BYTES) != hipSuccess) { fprintf(stderr, "kernel_launch: hipFuncSetAttribute failed\n"); grid = -1; return; }
        if (hipOccupancyMaxActiveBlocksPerMultiprocessor(&per_cu, (const void*)mk_fwd, NTHREADS, LDS_BYTES) != hipSuccess || per_cu < 1) fprintf(stderr, "kernel_launch: occupancy query says %d\n", per_cu);
        (void)hipGetLastError();
        grid = cus > 0 ? cus : 256;
    }
    if (grid < 0) return;
    hipMemsetAsync((char*)d_ws + WS_CTL, 0, CTL_ZERO_BYTES, stream);
    Args a{};
    for (int i = 0; i < 31; ++i) a.in[i] = (const float*)d_in[i];
    a.out = (float*)d_out; a.ws = (unsigned char*)d_ws;
    constexpr int NPH = 2 + 9 * DEPTH;
#if MK_MULTI
    for (int p = 0; p < NPH; ++p) { a.ph_lo = p; a.ph_hi = p + 1; hipLaunchKernelGGL(mk_fwd, dim3(grid), dim3(NTHREADS), LDS_BYTES, stream, a); }
#else
    a.ph_lo = 0; a.ph_hi = NPH; hipLaunchKernelGGL(mk_fwd, dim3(grid), dim3(NTHREADS), LDS_BYTES, stream, a);
#endif
}
```

```cpp
#include <hip/hip_runtime.h>
#include <cstdio>
#include <cstdint>

#ifndef PHMASK
#define PHMASK 0xFFFF
#endif
#ifndef PROBE_DUP
#define PROBE_DUP 0
#endif
#ifndef MK_MULTI
#define MK_MULTI 0
#endif

#define GAS __attribute__((address_space(1)))
#define LAS __attribute__((address_space(3)))
typedef unsigned short bf16;
typedef short bf16x8 __attribute__((ext_vector_type(8)));
typedef float f32x4 __attribute__((ext_vector_type(4)));
typedef float f32x2 __attribute__((ext_vector_type(2)));
typedef unsigned u32x4 __attribute__((ext_vector_type(4)));
typedef unsigned u32x2 __attribute__((ext_vector_type(2)));

constexpr int D = 2048, NB = 8, T = 4096, CTXL = 256, DEPTH = 2;
constexpr int NLAT = NB * T, NCTX = NB * CTXL, MALL = NLAT + NCTX;
constexpr int INC = 7424;
constexpr int OFF_U = 0, OFF_V = 512, OFF_Q = 1024, OFF_I = 1792, OFF_ZF = 2560, OFF_ZB = 3328, OFF_OG = 4096;
constexpr int OFF_C = 4864;
constexpr int BW = 768, CW = 768, CCOLS = 2560;
constexpr int NE = 16, DE = 1024;
constexpr int PC2W = 7 * 768;
constexpr int NTHREADS = 512;
constexpr float NORM_EPS = 1e-6f, GN_EPS = 64e-5f, DECAY_SCALE = 0.60653065971263342f;

constexpr size_t MiB = 1u << 20;
constexpr size_t WS_CTL = 0, CTL_ZERO_BYTES = 1 * MiB;
constexpr size_t WS_MOD = 1 * MiB;
constexpr size_t WS_SMALLW = 2 * MiB;
constexpr size_t SW_WUP = 0, SW_AUP = SW_WUP + (size_t)2 * 2 * 768 * 64 * 2, SW_GUP = SW_AUP + (size_t)2 * 768 * 64 * 2, SW_GWS = SW_GUP + (size_t)2 * 768 * 128 * 2;
constexpr size_t WS_WIN = 4 * MiB, WS_WOUT = 62 * MiB, WS_WGU = 78 * MiB, WS_WDN = 206 * MiB;
constexpr size_t WS_X = 270 * MiB, WS_H = 542 * MiB, WS_Y = 678 * MiB, WS_P = 814 * MiB, WS_PRE = 1307 * MiB, WS_VT = 1817 * MiB, WS_OC = 1868 * MiB, WS_HQB = 1970 * MiB, WS_HG = 2021 * MiB, WS_END = 2028 * MiB;
constexpr int PRE_REC = 10240, PR_WP = 0, PR_RP = 2048, PR_BK = 4096, PR_ARBK = 8192, PR_MAK = 9216, PR_GAM = 9728, NCHUNK16 = 272;
constexpr size_t WS_OB = WS_H;
constexpr size_t WS_ACT = WS_P, WS_YK = WS_P + 144 * MiB, WS_RIDX = WS_P + 416 * MiB, WS_RW = WS_RIDX + 3 * MiB;
static_assert(WS_RW + 3 * MiB <= WS_PRE, "moe overlay");
constexpr int MAXSLOT_TILES = 288;
constexpr int CW_BAR = 4096;
constexpr int CW_CNT = 16384;

constexpr int LDS_STAGE = 0, LDS_TAB = 131072, LDS_TABW = LDS_TAB + 9 * 1024, LDS_TP = LDS_TABW + 9 * 1024, LDS_MISC = 150528, LDS_BYTES = 152 * 1024;
static_assert(LDS_TP + 128 <= LDS_MISC, "lds map");

typedef __bf16 bf16x2_t __attribute__((ext_vector_type(2)));
__device__ __forceinline__ unsigned pk2(float lo, float hi) { const f32x2 v = {lo, hi}; return __builtin_bit_cast(unsigned, __builtin_convertvector(v, bf16x2_t)); }
__device__ __forceinline__ unsigned f2bf(float f) { return pk2(f, f) & 0xffffu; }
__device__ __forceinline__ float bflo(unsigned u) { return __builtin_bit_cast(float, u << 16); }
__device__ __forceinline__ float bfhi(unsigned u) { return __builtin_bit_cast(float, u & 0xffff0000u); }
__device__ __forceinline__ float bf1(bf16 b) { return __builtin_bit_cast(float, ((unsigned)b) << 16); }
__device__ __forceinline__ float sigmoidf_(float x) { return __builtin_amdgcn_rcpf(1.0f + __expf(-x)); }
__device__ __forceinline__ float siluf_(float x) { return x * __builtin_amdgcn_rcpf(1.0f + __expf(-x)); }
__device__ __forceinline__ float geluf_(float v) {
    const float av = fabsf(v), t = __builtin_amdgcn_rcpf(av * 0.2316418882f + 1.0f);
    float q = t * 0.5307027145f + (-0.7265760135f); q = q * t + 0.7107068705f; q = q * t + (-0.142248368f); q = q * t + 0.127414796f; q = q * t;
    const float e = __builtin_amdgcn_exp2f((v * v) * (-0.72134752044f)); const float m = v * (q * e); return v < 0.f ? m : v - m; }
__device__ __forceinline__ float wave_sum(float v) {
#pragma unroll
    for (int o = 1; o < 64; o <<= 1) v += __shfl_xor(v, o);
    return v;
}
__device__ __forceinline__ int tid_fresh() { int t = threadIdx.x; asm volatile("" : "+v"(t)); return t; }
__device__ __forceinline__ void unpack8(const u32x4 v, float (&f)[8]) {
    f[0] = bflo(v.x); f[1] = bfhi(v.x); f[2] = bflo(v.y); f[3] = bfhi(v.y); f[4] = bflo(v.z); f[5] = bfhi(v.z); f[6] = bflo(v.w); f[7] = bfhi(v.w);
}
__device__ __forceinline__ u32x4 pack8(const float (&f)[8]) { u32x4 v; v.x = pk2(f[0], f[1]); v.y = pk2(f[2], f[3]); v.z = pk2(f[4], f[5]); v.w = pk2(f[6], f[7]); return v; }
__device__ __forceinline__ int modrow_of(int row) { return row < NLAT ? (row >> 12) : 8; }

#define XB_TMO      128
#define XB_XCNT(j)  (256  + 64 * (j))
#define XB_XSUB(j)  (1280 + 64 * (j))
#define XB_XGEN(j)  (2304 + 64 * (j))
#define XB_TOP      3328
#define XB_TOPGEN   3392
#define XCD_BAR_WORDS 3456
#define XB_SPIN_CAP (1u << 18)
__device__ __forceinline__ unsigned xb_ld(unsigned* p)              { return __hip_atomic_load(p, __ATOMIC_RELAXED, __HIP_MEMORY_SCOPE_AGENT); }
__device__ __forceinline__ unsigned xb_add(unsigned* p, unsigned v) { return __hip_atomic_fetch_add(p, v, __ATOMIC_RELAXED, __HIP_MEMORY_SCOPE_AGENT); }
__device__ __forceinline__ unsigned xb_xcc_id() { return (unsigned)__builtin_amdgcn_s_getreg((3 << 11) | 20) & 0xFu; }
#define XB_SPIN(cond, bar) do { unsigned _sp = 0; while (cond) { __builtin_amdgcn_s_sleep(1); \
    if ((++_sp & 255u) == 0u) { if (xb_ld(&(bar)[XB_TMO])) break; if (_sp > XB_SPIN_CAP) { atomicAdd(&(bar)[XB_TMO], 1u); break; } } } } while (0)
struct XcdBarrier { unsigned* bar; unsigned x; volatile LAS unsigned* st; };
__device__ __forceinline__ XcdBarrier xcd_barrier_post(unsigned* bar, volatile LAS unsigned* st) {
    XcdBarrier b; b.bar = bar; b.x = xb_xcc_id(); b.st = st;
    if (threadIdx.x == 0) (void)xb_add(&bar[XB_XCNT(b.x)], 1u);
    return b;
}
__device__ __forceinline__ void xcd_barrier_complete(unsigned* bar, unsigned x, unsigned& nloc, unsigned& nx) {
    const unsigned G = gridDim.x * gridDim.y * gridDim.z;
    unsigned sum, cnt, mine, sp = 0u;
    for (;;) {
        sum = 0u; cnt = 0u; mine = 0u;
#pragma unroll
        for (unsigned j = 0; j < 16; ++j) { const unsigned c = xb_ld(&bar[XB_XCNT(j)]); sum += c; cnt += (c > 0u) ? 1u : 0u; mine = (j == x) ? c : mine; }
        if (sum == G) break;
        __builtin_amdgcn_s_sleep(1);
        if ((++sp & 255u) == 0u) { if (xb_ld(&bar[XB_TMO])) break; if (sp > XB_SPIN_CAP) { atomicAdd(&bar[XB_TMO], 1u); break; } }
    }
    nloc = mine > 0u ? mine : 1u; nx = cnt > 0u ? cnt : 1u;
}
__device__ __forceinline__ void xcd_barrier(const XcdBarrier& b) {
    asm volatile("s_waitcnt vmcnt(0)" ::: "memory");
    __syncthreads();
    if (threadIdx.x == 0) {
        unsigned* bar = b.bar;
        __builtin_amdgcn_s_waitcnt(0);
        unsigned nloc = b.st[0], nx = b.st[1];
        if (nloc == 0u) { xcd_barrier_complete(bar, b.x, nloc, nx); b.st[0] = nloc; b.st[1] = nx; }
        const unsigned old = xb_add(&bar[XB_XSUB(b.x)], 1u);
        const unsigned gen = old / nloc;
        if (old + 1u == (gen + 1u) * nloc) {
            __builtin_amdgcn_fence(__ATOMIC_RELEASE, "agent");
            asm volatile("s_waitcnt vmcnt(0)" ::: "memory");
            const unsigned og = xb_add(&bar[XB_TOP], 1u);
            const unsigned tg = og / nx;
            if (og + 1u == (tg + 1u) * nx) xb_add(&bar[XB_TOPGEN], 1u);
            else XB_SPIN(xb_ld(&bar[XB_TOPGEN]) == tg, bar);
            __builtin_amdgcn_fence(__ATOMIC_ACQUIRE, "agent");
            xb_add(&bar[XB_XGEN(b.x)], 1u);
            asm volatile("s_waitcnt vmcnt(0)" ::: "memory");
        } else {
            XB_SPIN(xb_ld(&bar[XB_XGEN(b.x)]) == gen, bar);
            __builtin_amdgcn_fence(__ATOMIC_ACQUIRE, "agent");
            asm volatile("s_waitcnt vmcnt(0)" ::: "memory");
        }
    }
    __syncthreads();
}

namespace pg8 {
constexpr int BM = 256, BK = 64, HALF = 128, HTB = HALF * BK * 2, STAGE_BYTES = 8 * HTB, NXCD = 8, WGM = 8;
__host__ __device__ __forceinline__ int lds_byte(int r, int c) { const int st = (r >> 4) * 2 + (c >> 5), rr = r & 15, cc = c & 31, ob = rr * 64 + cc * 2; return st * 1024 + (ob ^ (((ob >> 9) & 1) << 5)); }
__host__ __device__ __forceinline__ void stage_rc(int b, int& R, int& C) { const int st = b / 1024, sb = b % 1024, swz = sb ^ (((sb >> 9) & 1) << 5); R = (st >> 1) * 16 + swz / 64; C = (st & 1) * 32 + (swz % 64) / 2; }
__host__ __device__ __forceinline__ int perm32(int rho) { const int n = rho >> 4, i = rho & 15; return 8 * (i >> 2) + 4 * n + (i & 3); }

struct Unit { int pm, pn, e, aux; };
struct Gemm { const bf16* A; const bf16* Bt; int M, N, K; };

struct StaticOrder {
    int nM, nN, nwg, G, c;
    __device__ void init(int M, int N, int G_, int c_) { nM = M / BM; nN = N / BM; nwg = nM * nN; G = G_; c = c_; }
    __device__ bool next(int i, Unit& u) const {
        const long L = (long)i * G + c; if (L >= nwg) return false;
        int wgid = (int)L; { const int q = nwg / NXCD, r = nwg % NXCD, xcd = wgid % NXCD, off = wgid / NXCD; wgid = (xcd < r ? xcd * (q + 1) : r * (q + 1) + (xcd - r) * q) + off; }
        const int nig = WGM * nN, gid = wgid / nig, fm = gid * WGM, gsz = (nM - fm) < WGM ? (nM - fm) : WGM;
        u.pm = fm + ((wgid % nig) % gsz); u.pn = (wgid % nig) / gsz; u.e = 0; u.aux = 0; return true;
    }
    __device__ __forceinline__ unsigned b_off(const Unit& u, unsigned tstep) const { return (unsigned)u.pn * tstep; }
};
struct MoeOrder {
    const LAS int* tp; int G, c; unsigned estride;
    __device__ bool next(int i, Unit& u) const {
        const int L = i * G + c; const int ntot = tp[16] * 8; if (L >= ntot) return false;
        const int tile = L >> 3; int e = 0;
#pragma unroll
        for (int j = 1; j < 16; ++j) e += (tile >= tp[j]) ? 1 : 0;
        u.pm = tile; u.pn = L & 7; u.e = e; u.aux = i; return true;
    }
    __device__ __forceinline__ unsigned b_off(const Unit& u, unsigned tstep) const { return (unsigned)u.e * estride + (unsigned)u.pn * tstep; }
};

#define PG8_LAS __attribute__((address_space(3)))
template <class Epi, class Sched, bool ALIGN_EPI, bool GATHER>
__device__ __forceinline__ void gemm_phase(PG8_LAS unsigned char* lds, const Gemm g, const Sched& S, const Epi& E, const PG8_LAS unsigned* tabA) {
    const int tid = tid_fresh(), wid = __builtin_amdgcn_readfirstlane(tid >> 6), lane = tid & 63, wr = wid >> 2, wc = wid & 3, fr = lane & 15, fq = lane >> 4;
    const int K = g.K, nt = K / BK;
    int sR[2], sC[2];
    unsigned voffB[2];
#pragma unroll
    for (int i = 0; i < 2; ++i) { int R, C; stage_rc(tid * 16 + i * 8192, R, C); sR[i] = R; sC[i] = C; const int Rb = Epi::PERM ? ((R & ~31) + perm32(R & 31)) : R;
        voffB[i] = (unsigned)(Rb * K + C) * 2u; }
    const unsigned kstep = (unsigned)(BK * 2);
    const unsigned hstep = (unsigned)(HALF * K * 2);
    const unsigned tstep = 2u * hstep;
    const unsigned ldsw = (unsigned)wid * 1024u;
    const char* const baseA = (const char*)g.A; const char* const baseB = (const char*)g.Bt;
    const int aoff = lds_byte(wr * 64 + fr, fq * 8), boff = lds_byte(wc * 32 + fr, fq * 8);
#define PG8_SA(b, h) (((b) * 2 + (h)) * HTB)
#define PG8_SB(b, h) ((4 + (b) * 2 + (h)) * HTB)
#define PG8_STAGE(bufoff, gbase, uoff, voff) do { _Pragma("unroll") for (int _i = 0; _i < 2; ++_i) \
        __builtin_amdgcn_global_load_lds((const unsigned*)((gbase) + (size_t)(unsigned)((uoff) + (voff)[_i])), (PG8_LAS unsigned*)(lds + (bufoff) + ldsw + _i * 8192), 16, 0, 0); } while (0)
#define PG8_LDA(dst, b, h) do { _Pragma("unroll") for (int m = 0; m < 4; ++m) _Pragma("unroll") for (int k = 0; k < 2; ++k) dst[m][k] = *(const PG8_LAS bf16x8*)(lds + PG8_SA(b, h) + aoff + m * 2048 + k * 1024); } while (0)
#define PG8_LDB(dst, b, h) do { _Pragma("unroll") for (int n = 0; n < 2; ++n) _Pragma("unroll") for (int k = 0; k < 2; ++k) dst[n][k] = *(const PG8_LAS bf16x8*)(lds + PG8_SB(b, h) + boff + n * 2048 + k * 1024); } while (0)
#define PG8_MMA(ai, bj, At, Bt) do { __builtin_amdgcn_s_setprio(1); _Pragma("unroll") for (int m = 0; m < 4; ++m) _Pragma("unroll") for (int n = 0; n < 2; ++n) _Pragma("unroll") for (int k = 0; k < 2; ++k) \
        acc[ai][bj][m][n] = __builtin_amdgcn_mfma_f32_16x16x32_bf16(Bt[n][k], At[m][k], acc[ai][bj][m][n], 0, 0, 0); __builtin_amdgcn_s_setprio(0); } while (0)
#define PG8_WAIT_V(n) asm volatile("s_waitcnt vmcnt(" #n ")" ::: "memory")
#define PG8_WAIT_L(n) asm volatile("s_waitcnt lgkmcnt(" #n ")" ::: "memory")
#define PG8_BAR __builtin_amdgcn_s_barrier()
#define PG8_SCHED __builtin_amdgcn_sched_barrier(0)
    Unit cur, nxt; int ui = 0;
    if (!S.next(0, cur)) return;
    f32x4 acc[2][2][4][2];
#pragma unroll
    for (int a = 0; a < 2; ++a)
#pragma unroll
        for (int b = 0; b < 2; ++b)
#pragma unroll
            for (int m = 0; m < 4; ++m)
#pragma unroll
                for (int n = 0; n < 2; ++n) acc[a][b][m][n] = (f32x4){0.f, 0.f, 0.f, 0.f};
    bf16x8 At[4][2], B0[2][2], B1[2][2];
    unsigned vA0[2], vA1[2], nA0[2], nA1[2];
    unsigned uA, uB = S.b_off(cur, tstep);
    if constexpr (GATHER) { uA = 0u;
#pragma unroll
        for (int i = 0; i < 2; ++i) { vA0[i] = tabA[cur.aux * 256 + sR[i]] + (unsigned)sC[i] * 2u; vA1[i] = tabA[cur.aux * 256 + 128 + sR[i]] + (unsigned)sC[i] * 2u; }
    } else { uA = (unsigned)cur.pm * tstep;
#pragma unroll
        for (int i = 0; i < 2; ++i) { vA0[i] = (unsigned)(sR[i] * K + sC[i]) * 2u; vA1[i] = vA0[i] + hstep; }
    }
    PG8_STAGE(PG8_SB(0, 0), baseB, uB, voffB); PG8_STAGE(PG8_SB(0, 1), baseB, uB + hstep, voffB); PG8_STAGE(PG8_SA(0, 0), baseA, uA, vA0); PG8_STAGE(PG8_SA(0, 1), baseA, uA, vA1);
    if (wr == 1) PG8_BAR;
    PG8_WAIT_V(2); PG8_BAR;
    PG8_STAGE(PG8_SB(1, 0), baseB, uB + kstep, voffB); PG8_STAGE(PG8_SA(1, 0), baseA, uA + kstep, vA0); PG8_STAGE(PG8_SB(1, 1), baseB, uB + hstep + kstep, voffB);
    PG8_WAIT_V(6); PG8_BAR;
    for (;;) {
        const bool has_next = S.next(ui + 1, nxt);
        unsigned nuA, nuB = has_next ? S.b_off(nxt, tstep) : uB;
        if constexpr (GATHER) { nuA = 0u;
#pragma unroll
            for (int i = 0; i < 2; ++i) { if (has_next) { nA0[i] = tabA[nxt.aux * 256 + sR[i]] + (unsigned)sC[i] * 2u; nA1[i] = tabA[nxt.aux * 256 + 128 + sR[i]] + (unsigned)sC[i] * 2u; } else { nA0[i] = vA0[i]; nA1[i] = vA1[i]; } }
        } else { nuA = has_next ? (unsigned)nxt.pm * tstep : uA;
#pragma unroll
            for (int i = 0; i < 2; ++i) { nA0[i] = vA0[i]; nA1[i] = vA1[i]; }
        }
        for (int t = 0; t < nt; t += 2) {
            const bool last = (t == nt - 2);
            const unsigned a1 = uA + (unsigned)(t + 1) * kstep;
            const unsigned a2 = last ? nuA : uA + (unsigned)(t + 2) * kstep; const unsigned b2 = last ? nuB : uB + (unsigned)(t + 2) * kstep;
            const unsigned a3 = a2 + kstep; const unsigned b3 = b2 + kstep;
            unsigned w0[2], w1[2];
#pragma unroll
            for (int i = 0; i < 2; ++i) { w0[i] = (GATHER && last) ? nA0[i] : vA0[i]; w1[i] = (GATHER && last) ? nA1[i] : vA1[i]; }
            PG8_LDB(B0, 0, 0); PG8_LDB(B1, 0, 1); PG8_SCHED; PG8_LDA(At, 0, 0); PG8_STAGE(PG8_SA(1, 1), baseA, a1, vA1);
            PG8_WAIT_V(8); PG8_WAIT_L(0); PG8_BAR; PG8_MMA(0, 0, At, B0); PG8_MMA(0, 1, At, B1); PG8_BAR; PG8_SCHED;
            PG8_LDA(At, 0, 1); PG8_STAGE(PG8_SB(0, 0), baseB, b2, voffB); PG8_STAGE(PG8_SB(0, 1), baseB, b2 + hstep, voffB); PG8_STAGE(PG8_SA(0, 0), baseA, a2, w0);
            PG8_WAIT_V(8); PG8_WAIT_L(0); PG8_BAR; PG8_MMA(1, 0, At, B0); PG8_MMA(1, 1, At, B1); PG8_BAR; PG8_SCHED;
            PG8_LDB(B0, 1, 0); PG8_LDB(B1, 1, 1); PG8_SCHED; PG8_LDA(At, 1, 0); PG8_STAGE(PG8_SA(0, 1), baseA, a2, w1);
            PG8_WAIT_V(8); PG8_WAIT_L(0); PG8_BAR; PG8_MMA(0, 0, At, B0); PG8_MMA(0, 1, At, B1); PG8_BAR; PG8_SCHED;
            PG8_LDA(At, 1, 1); PG8_STAGE(PG8_SB(1, 0), baseB, b3, voffB); PG8_STAGE(PG8_SB(1, 1), baseB, b3 + hstep, voffB); PG8_STAGE(PG8_SA(1, 0), baseA, a3, w0);
            PG8_WAIT_V(8); PG8_WAIT_L(0); PG8_BAR; PG8_MMA(1, 0, At, B0); PG8_MMA(1, 1, At, B1); PG8_BAR; PG8_SCHED;
        }
        if constexpr (ALIGN_EPI) { if (wr == 0) PG8_BAR; }
        E(acc, cur, wr, wc, fr, fq);
        if (!has_next) break;
#pragma unroll
        for (int a = 0; a < 2; ++a)
#pragma unroll
            for (int b = 0; b < 2; ++b)
#pragma unroll
                for (int m = 0; m < 4; ++m)
#pragma unroll
                    for (int n = 0; n < 2; ++n) acc[a][b][m][n] = (f32x4){0.f, 0.f, 0.f, 0.f};
        cur = nxt; uA = nuA; uB = nuB; ++ui;
#pragma unroll
        for (int i = 0; i < 2; ++i) { vA0[i] = nA0[i]; vA1[i] = nA1[i]; }
        if constexpr (ALIGN_EPI) { if (wr == 1) PG8_BAR; }
    }
    PG8_WAIT_V(0);
    if constexpr (!ALIGN_EPI) { if (wr == 0) PG8_BAR; }
    PG8_BAR;
#undef PG8_SA
#undef PG8_SB
#undef PG8_STAGE
#undef PG8_LDA
#undef PG8_LDB
#undef PG8_MMA
#undef PG8_WAIT_V
#undef PG8_WAIT_L
#undef PG8_BAR
#undef PG8_SCHED
}

__device__ __forceinline__ unsigned cvt_pk_bf16(float lo, float hi) { return pk2(lo, hi); }

struct EpiBf16 {
    static constexpr bool PERM = true;
    bf16* O; int ldc;
    __device__ __forceinline__ void operator()(const f32x4 (&acc)[2][2][4][2], const Unit& u, int wr, int wc, int fr, int fq) const {
        const int row0 = u.pm * BM + wr * 64 + fr; const int col0 = u.pn * BM + wc * 32 + 8 * fq;
#pragma unroll
        for (int ai = 0; ai < 2; ++ai)
#pragma unroll
            for (int m = 0; m < 4; ++m) { bf16* rowp = O + (size_t)(row0 + ai * HALF + m * 16) * ldc + col0;
#pragma unroll
                for (int bj = 0; bj < 2; ++bj) { const f32x4 v0 = acc[ai][bj][m][0], v1 = acc[ai][bj][m][1];
                    u32x4 w; w.x = cvt_pk_bf16(v0[0], v0[1]); w.y = cvt_pk_bf16(v0[2], v0[3]); w.z = cvt_pk_bf16(v1[0], v1[1]); w.w = cvt_pk_bf16(v1[2], v1[3]);
                    *(u32x4*)(rowp + bj * HALF) = w; } }
    }
};
struct EpiResid {
    static constexpr bool PERM = false;
    const float* xl; const float* xc; float* out; const float* gate;
    __device__ __forceinline__ void operator()(const f32x4 (&acc)[2][2][4][2], const Unit& u, int wr, int wc, int fr, int fq) const {
        const int rt = u.pm * BM; const bool isl = rt < NLAT;
        const float* base = isl ? xl + (size_t)rt * D : xc + (size_t)(rt - NLAT) * D;
        const float* gp = gate + (size_t)(isl ? (rt >> 12) : 8) * 12288;
        const int rl0 = wr * 64 + fr, col0 = u.pn * BM + wc * 32 + 4 * fq;
#pragma unroll
        for (int ai = 0; ai < 2; ++ai)
#pragma unroll
            for (int m = 0; m < 4; ++m) { const int rl = rl0 + ai * HALF + m * 16; const float* bp = base + (size_t)rl * D + col0; float* op = out + (size_t)(rt + rl) * D + col0;
#pragma unroll
                for (int bj = 0; bj < 2; ++bj)
#pragma unroll
                    for (int n = 0; n < 2; ++n) { const f32x4 b = *(const f32x4*)(bp + bj * HALF + n * 16); const f32x4 gv = *(const f32x4*)(gp + col0 + bj * HALF + n * 16); *(f32x4*)(op + bj * HALF + n * 16) = b + gv * acc[ai][bj][m][n]; }
                asm volatile("" ::: "memory"); }
    }
};
struct EpiSwiglu {
    static constexpr bool PERM = true;
    bf16* O;
    __device__ __forceinline__ void operator()(const f32x4 (&acc)[2][2][4][2], const Unit& u, int wr, int wc, int fr, int fq) const {
        const int row0 = u.pm * BM + wr * 64 + fr; const int col0 = u.pn * 128 + wc * 32 + 8 * fq;
#pragma unroll
        for (int ai = 0; ai < 2; ++ai)
#pragma unroll
            for (int m = 0; m < 4; ++m) { bf16* rowp = O + (size_t)(row0 + ai * HALF + m * 16) * DE + col0;
                float o[8];
#pragma unroll
                for (int n = 0; n < 2; ++n)
#pragma unroll
                    for (int j = 0; j < 4; ++j) { const float gt = acc[ai][0][m][n][j], up = acc[ai][1][m][n][j]; o[n * 4 + j] = gt * __builtin_amdgcn_rcpf(1.0f + __expf(-gt)) * up; }
                u32x4 w; w.x = cvt_pk_bf16(o[0], o[1]); w.y = cvt_pk_bf16(o[2], o[3]); w.z = cvt_pk_bf16(o[4], o[5]); w.w = cvt_pk_bf16(o[6], o[7]);
                *(u32x4*)rowp = w; }
    }
};
struct EpiDown {
    static constexpr bool PERM = true;
    bf16* YK; const PG8_LAS unsigned* tab; const PG8_LAS float* tabw;
    __device__ __forceinline__ void operator()(const f32x4 (&acc)[2][2][4][2], const Unit& u, int wr, int wc, int fr, int fq) const {
        const int rl0 = wr * 64 + fr; const int col0 = u.pn * BM + wc * 32 + 8 * fq;
#pragma unroll
        for (int ai = 0; ai < 2; ++ai)
#pragma unroll
            for (int m = 0; m < 4; ++m) { const int rl = rl0 + ai * HALF + m * 16; const unsigned ent = tab[u.aux * 256 + rl]; const float w = tabw[u.aux * 256 + rl];
                if (!(ent & 0x40000000u)) { bf16* rowp = YK + ((size_t)(ent >> 31) * MALL + (ent & 0xffffu)) * D + col0;
#pragma unroll
                    for (int bj = 0; bj < 2; ++bj) { const f32x4 v0 = acc[ai][bj][m][0] * w, v1 = acc[ai][bj][m][1] * w;
                        u32x4 q; q.x = cvt_pk_bf16(v0[0], v0[1]); q.y = cvt_pk_bf16(v0[2], v0[3]); q.z = cvt_pk_bf16(v1[0], v1[1]); q.w = cvt_pk_bf16(v1[2], v1[3]);
                        *(u32x4*)(rowp + bj * HALF) = q; } }
                asm volatile("" ::: "memory"); }
    }
};
}

struct Args { const float* in[31]; float* out; unsigned char* ws; int ph_lo, ph_hi; };
typedef const __attribute__((address_space(4))) Args* KArgs;
__device__ __forceinline__ KArgs kargs() { KArgs p = (KArgs)__builtin_amdgcn_kernarg_segment_ptr(); asm volatile("" : "+s"(p)); return p; }
#define AIN(i) (a->in[i])
enum { I_X = 0, I_C, I_CTX, I_CCTX, I_ADAW, I_ADAB, I_N1G, I_N2G, I_WIN, I_WOUT, I_GNG, I_GWS, I_GB, I_LB, I_HNG, I_MU, I_W0, I_WUP, I_A0, I_AUP, I_GUP, I_KK, I_KA, I_RK, I_GNGG, I_GNB, I_RW, I_RB, I_WGU, I_WDN, I_FNG };

__device__ __forceinline__ void p0_transpose_item(const float* W, int K, int N, bf16* WT, int n_row0, LAS float* scr, int kb, int nb, int lane) {
    const int k0 = 64 * kb, n0 = 32 * nb;
#pragma unroll 8
    for (int i = 0; i < 32; ++i) { const int kk = 2 * i + (lane >> 5); scr[kk * 33 + (lane & 31)] = W[(size_t)(k0 + kk) * N + n0 + (lane & 31)]; }
    asm volatile("s_waitcnt lgkmcnt(0)" ::: "memory");
    const int c = lane & 7;
#pragma unroll
    for (int j = 0; j < 4; ++j) { const int n = (lane >> 3) + 8 * j; const LAS float* s = scr + (8 * c) * 33 + n;
        u32x4 o; o.x = pk2(s[0 * 33], s[1 * 33]); o.y = pk2(s[2 * 33], s[3 * 33]); o.z = pk2(s[4 * 33], s[5 * 33]); o.w = pk2(s[6 * 33], s[7 * 33]);
        *(u32x4*)(WT + (size_t)(n_row0 + n) * K + k0 + 8 * c) = o; }
    asm volatile("s_waitcnt lgkmcnt(0)" ::: "memory");
}

__device__ __forceinline__ void convert_moe(KArgs a, int l, LAS unsigned char* lds) {
    const int tid = tid_fresh(), lane = tid & 63, wave = tid >> 6;
    const int gw = blockIdx.x * 8 + wave, NGW = gridDim.x * 8;
    unsigned char* ws = a->ws;
    LAS float* scr = (LAS float*)(lds + wave * 16384);
    constexpr int I_GU = 32 * 64, I_DN = 16 * 64, N2 = 16 * I_GU, N3 = N2 + 16 * I_DN;
    for (int it = gw; it < N3; it += NGW) {
        if (it < N2) { const int e = it / I_GU, r = it % I_GU, kb = r / 64, nb = r % 64;
            const int n0 = 32 * nb, hh = n0 >> 10, nn = n0 & 1023, row0 = 256 * (nn >> 7) + 128 * hh + (nn & 127);
            p0_transpose_item(a->in[I_WGU] + (size_t)(l * NE + e) * D * 2048, D, 2048, (bf16*)(ws + WS_WGU) + (size_t)e * 2048 * D, row0, scr, kb, nb, lane); }
        else { const int q = it - N2, e = q / I_DN, r = q % I_DN, kb = r / 64, nb = r % 64;
            p0_transpose_item(a->in[I_WDN] + (size_t)(l * NE + e) * DE * D, DE, D, (bf16*)(ws + WS_WDN) + (size_t)e * D * DE, 32 * nb, scr, kb, nb, lane); }
    }
}
__device__ __forceinline__ void phase_prologue(KArgs a, LAS unsigned char* lds) {
    const int tid = tid_fresh(), lane = tid & 63, wave = tid >> 6;
    const int G = gridDim.x, gw = blockIdx.x * 8 + wave, NGW = G * 8;
    unsigned char* ws = a->ws;
    LAS float* scr = (LAS float*)(lds + wave * 16384);
    constexpr int I_IN = 32 * 232, I_OUT = 32 * 64;
    constexpr int N0 = 2 * I_IN, N1 = N0 + 2 * I_OUT;
    for (int it = gw; it < N1; it += NGW) {
        if (it < N0) { const int l = it / I_IN, r = it % I_IN, kb = r / 232, nb = r % 232;
            p0_transpose_item(a->in[I_WIN] + (size_t)l * D * INC, D, INC, (bf16*)(ws + WS_WIN) + (size_t)l * INC * D, 32 * nb, scr, kb, nb, lane); }
        else { const int q = it - N0, l = q / I_OUT, r = q % I_OUT, kb = r / 64, nb = r % 64;
            p0_transpose_item(a->in[I_WOUT] + (size_t)l * D * D, D, D, (bf16*)(ws + WS_WOUT) + (size_t)l * D * D, 32 * nb, scr, kb, nb, lane); }
    }
    convert_moe(a, 0, lds);
    {
        const int gt = blockIdx.x * NTHREADS + tid, NGT = G * NTHREADS;
        bf16* wup = (bf16*)(ws + WS_SMALLW + SW_WUP); bf16* aup = (bf16*)(ws + WS_SMALLW + SW_AUP); bf16* gup = (bf16*)(ws + WS_SMALLW + SW_GUP); bf16* gws = (bf16*)(ws + WS_SMALLW + SW_GWS);
        for (int i = gt; i < 2 * 2 * 768 * 64; i += NGT) { const int k = i & 63, n = (i >> 6) % 768, ld = i / (768 * 64); wup[i] = (bf16)f2bf(a->in[I_WUP][((size_t)ld * 64 + k) * 768 + n]); }
        for (int i = gt; i < 2 * 768 * 64; i += NGT) { const int k = i & 63, n = (i >> 6) % 768, l = i / (768 * 64); aup[i] = (bf16)f2bf(a->in[I_AUP][((size_t)l * 64 + k) * 768 + n]); }
        for (int i = gt; i < 2 * 768 * 128; i += NGT) { const int k = i & 127, n = (i >> 7) % 768, l = i / (768 * 128); gup[i] = (bf16)f2bf(a->in[I_GUP][((size_t)l * 128 + k) * 768 + n]); }
        for (int i = gt; i < 2 * 4 * 128 * 128; i += NGT) gws[i] = (bf16)f2bf(a->in[I_GWS][i]);
    }
    __syncthreads();
    {
        LAS float* sv = (LAS float*)lds;
        LAS float* red = (LAS float*)(lds + 73728);
        for (int i = tid; i < 9 * D; i += NTHREADS) { const int r = i / D, k = i % D; const float v = r < 8 ? a->in[I_C][r * D + k] : a->in[I_CCTX][k]; sv[i] = siluf_(v); }
        __syncthreads();
        float* mod = (float*)(ws + WS_MOD);
        for (int it = blockIdx.x; it < 2 * 96; it += G) {
            const int l = it / 96, cb = it % 96, cq = tid & 31, kg = tid >> 5;
            const float* wp = a->in[I_ADAW] + (size_t)l * D * 12288 + (size_t)(kg * 128) * 12288 + cb * 128 + cq * 4;
            f32x4 acc[9];
#pragma unroll
            for (int r = 0; r < 9; ++r) acc[r] = (f32x4){0.f, 0.f, 0.f, 0.f};
#pragma unroll 4
            for (int k = 0; k < 128; ++k) { const f32x4 w = *(const f32x4*)(wp + (size_t)k * 12288);
#pragma unroll
                for (int r = 0; r < 9; ++r) acc[r] += w * sv[r * D + kg * 128 + k]; }
#pragma unroll
            for (int r = 0; r < 9; ++r) *(LAS f32x4*)(red + ((kg * 9 + r) * 128 + cq * 4)) = acc[r];
            __syncthreads();
            for (int o = tid; o < 9 * 128; o += NTHREADS) { const int r = o / 128, c = o % 128; float s = a->in[I_ADAB][(size_t)l * 12288 + cb * 128 + c];
#pragma unroll
                for (int q = 0; q < 16; ++q) s += red[(q * 9 + r) * 128 + c];
                mod[((size_t)l * 9 + r) * 12288 + cb * 128 + c] = s; }
            __syncthreads();
        }
    }
}

template <int MODE>
__device__ __forceinline__ void phase_norm1(KArgs a, int l, bool dry) {
    const int tid_ = tid_fresh(); const int lane = tid_ & 63, wave = tid_ >> 6, gw = blockIdx.x * 8 + wave, NGW = gridDim.x * 8;
    unsigned char* ws = a->ws;
    const float* mod = (const float*)(ws + WS_MOD);
    float* X = (float*)(ws + WS_X); bf16* H = (bf16*)(ws + WS_H); const bf16* YK = (const bf16*)(ws + WS_YK);
    float* Xo = dry ? (float*)(ws + WS_END) : X; bf16* Ho = dry ? (bf16*)(ws + WS_END) : H; float* Oo = dry ? (float*)(ws + WS_END) : a->out;
    const int nrows = (MODE == 2) ? NLAT : MALL;
    const int rpw = (nrows + NGW - 1) / NGW; const int r0 = gw * rpw, r1 = (r0 + rpw < nrows) ? r0 + rpw : nrows;
    f32x4 ck[8], cs[8], cg[8]; int cur_mr = -1;
    for (int row = r0; row < r1; ++row) {
        const int mr = modrow_of(row); const int orow = dry ? (row & 2047) : row;
        if (mr != cur_mr) { cur_mr = mr;
#pragma unroll
            for (int j = 0; j < 8; ++j) { const int c = 4 * lane + 256 * j;
                if (MODE == 2) ck[j] = *(const f32x4*)(a->in[I_FNG] + c);
                else { const float* m = mod + ((size_t)l * 9 + mr) * 12288; const f32x4 g = *(const f32x4*)(a->in[I_N1G] + (size_t)l * D + c); ck[j] = g * (*(const f32x4*)(m + D + c) + 1.0f); cs[j] = *(const f32x4*)(m + c); }
                if (MODE != 0) cg[j] = *(const f32x4*)(mod + ((size_t)(l - 1) * 9 + mr) * 12288 + 5 * D + c); } }
        f32x4 v[8];
        if (MODE == 0) { const float* xr = row < NLAT ? a->in[I_X] + (size_t)row * D : a->in[I_CTX] + (size_t)(row - NLAT) * D;
#pragma unroll
            for (int j = 0; j < 8; ++j) v[j] = *(const f32x4*)(xr + 4 * lane + 256 * j);
        } else {
            const float* xr = X + (size_t)row * D; const bf16* y0 = YK + (size_t)row * D; const bf16* y1 = YK + ((size_t)MALL + row) * D;
            u32x2 p0[8], p1[8];
#pragma unroll
            for (int j = 0; j < 8; ++j) { const int c = 4 * lane + 256 * j; v[j] = *(const f32x4*)(xr + c); p0[j] = *(const u32x2*)(y0 + c); p1[j] = *(const u32x2*)(y1 + c); }
#pragma unroll
            for (int j = 0; j < 8; ++j) { f32x4 f; f[0] = bflo(p0[j].x) + bflo(p1[j].x); f[1] = bfhi(p0[j].x) + bfhi(p1[j].x); f[2] = bflo(p0[j].y) + bflo(p1[j].y); f[3] = bfhi(p0[j].y) + bfhi(p1[j].y);
                v[j] = v[j] + cg[j] * f; }
            if (MODE == 1) {
#pragma unroll
                for (int j = 0; j < 8; ++j) *(f32x4*)(Xo + (size_t)orow * D + 4 * lane + 256 * j) = v[j];
            }
        }
        float ss = 0.f;
#pragma unroll
        for (int j = 0; j < 8; ++j) ss += (v[j][0] * v[j][0] + v[j][1] * v[j][1]) + (v[j][2] * v[j][2] + v[j][3] * v[j][3]);
        const float rstd = 1.0f / sqrtf(wave_sum(ss) * (1.0f / D) + NORM_EPS);
        if (MODE == 2) {
#pragma unroll
            for (int j = 0; j < 8; ++j) *(f32x4*)(Oo + (size_t)orow * D + 4 * lane + 256 * j) = v[j] * rstd * ck[j];
        } else {
#pragma unroll
            for (int j = 0; j < 8; ++j) { const f32x4 h = v[j] * rstd * ck[j] + cs[j]; u32x2 o; o.x = pk2(h[0], h[1]); o.y = pk2(h[2], h[3]); *(u32x2*)(Ho + (size_t)orow * D + 4 * lane + 256 * j) = o; }
        }
    }
}

__device__ __forceinline__ void phase_norm2_router(KArgs a, int l, bool dry, LAS unsigned char* lds) {
    const int tid_ = tid_fresh(); const int lane = tid_ & 63, wave = tid_ >> 6, gw = blockIdx.x * 8 + wave, NGW = gridDim.x * 8;
    unsigned char* ws = a->ws;
    const float* mod = (const float*)(ws + WS_MOD);
    const float* X = (const float*)(ws + WS_X); bf16* H = (bf16*)(ws + WS_H);
    unsigned* cnt = (unsigned*)(ws + WS_CTL) + CW_CNT + l * 16 * 64 + (dry ? 4096 : 0);
    unsigned* ridx = (unsigned*)(ws + (dry ? WS_END : WS_RIDX)); float* rwt = (float*)(ws + (dry ? WS_END + 4 * MiB : WS_RW)); bf16* Ho = dry ? (bf16*)(ws + WS_END + 8 * MiB) : H;
    const int nrows = (l == DEPTH - 1) ? NLAT : MALL;
    LAS f32x4* rwl = (LAS f32x4*)lds;
    { const float* rw = a->in[I_RW];
      for (int idx = tid_; idx < 8192; idx += NTHREADS) { const int ln = idx & 63, q = (idx >> 6) & 3, i = (idx >> 8) & 3, j = idx >> 10; rwl[idx] = *(const f32x4*)(rw + (size_t)(4 * ln + 256 * j + i) * 16 + 4 * q); } }
    __syncthreads();
    const int rpw = (nrows + NGW - 1) / NGW; const int r0 = gw * rpw, r1 = (r0 + rpw < nrows) ? r0 + rpw : nrows;
    f32x4 ck[8], cs[8]; int cur_mr = -1;
    float rb[16];
#pragma unroll
    for (int e = 0; e < 16; ++e) rb[e] = a->in[I_RB][e];
    for (int row = r0; row < r1; ++row) {
        const int mr = modrow_of(row); const int orow = dry ? (row & 2047) : row;
        if (mr != cur_mr) { cur_mr = mr; const float* m = mod + ((size_t)l * 9 + mr) * 12288;
#pragma unroll
            for (int j = 0; j < 8; ++j) { const int c = 4 * lane + 256 * j; const f32x4 g = *(const f32x4*)(a->in[I_N2G] + (size_t)l * D + c); ck[j] = g * (*(const f32x4*)(m + 4 * D + c) + 1.0f); cs[j] = *(const f32x4*)(m + 3 * D + c); } }
        const float* xr = X + (size_t)row * D;
        f32x4 v[8]; float ss = 0.f;
#pragma unroll
        for (int j = 0; j < 8; ++j) { v[j] = *(const f32x4*)(xr + 4 * lane + 256 * j); ss += (v[j][0] * v[j][0] + v[j][1] * v[j][1]) + (v[j][2] * v[j][2] + v[j][3] * v[j][3]); }
        const float rstd = 1.0f / sqrtf(wave_sum(ss) * (1.0f / D) + NORM_EPS);
        f32x4 lg4[4];
#pragma unroll
        for (int q = 0; q < 4; ++q) lg4[q] = (f32x4){0.f, 0.f, 0.f, 0.f};
#pragma unroll
        for (int j = 0; j < 8; ++j) { const f32x4 h = v[j] * rstd * ck[j] + cs[j]; u32x2 o; o.x = pk2(h[0], h[1]); o.y = pk2(h[2], h[3]); *(u32x2*)(Ho + (size_t)orow * D + 4 * lane + 256 * j) = o;
#pragma unroll
            for (int i = 0; i < 4; ++i)
#pragma unroll
                for (int q = 0; q < 4; ++q) lg4[q] += rwl[((j * 4 + i) * 4 + q) * 64 + lane] * h[i];
            asm volatile("" ::: "memory"); }
        float lg[16];
#pragma unroll
        for (int e = 0; e < 16; ++e) lg[e] = wave_sum(lg4[e >> 2][e & 3]) + rb[e];
        float mx = lg[0];
#pragma unroll
        for (int e = 1; e < 16; ++e) mx = fmaxf(mx, lg[e]);
        float p[16], sum = 0.f;
#pragma unroll
        for (int e = 0; e < 16; ++e) { p[e] = __expf(lg[e] - mx); sum += p[e]; }
        const float inv = 1.0f / sum;
#pragma unroll
        for (int e = 0; e < 16; ++e) p[e] *= inv;
        int sel = 0; float best = -1.f;
#pragma unroll
        for (int gI = 0; gI < 4; ++gI) { float m1 = -1.f, m2 = -1.f;
#pragma unroll
            for (int i = 0; i < 4; ++i) { const float q = p[4 * gI + i]; if (q > m1) { m2 = m1; m1 = q; } else if (q > m2) m2 = q; }
            const float s = m1 + m2; if (s > best) { best = s; sel = gI; } }
        int i1 = 0, i2 = 0; float p1 = -2.f, p2 = -2.f;
#pragma unroll
        for (int gI = 0; gI < 4; ++gI)
#pragma unroll
            for (int i = 0; i < 4; ++i) { const float q = (gI == sel) ? p[4 * gI + i] : -1.0f; const int e = 4 * gI + i;
                if (gI == sel) { if (q > p1) { p2 = p1; i2 = i1; p1 = q; i1 = e; } else if (q > p2) { p2 = q; i2 = e; } } }
        const float wsum = p1 + p2, w1 = p1 / wsum, w2 = p2 / wsum;
        if (lane == 0) {
            const unsigned q1 = atomicAdd(cnt + i1 * 64, 1u); ridx[(size_t)i1 * MALL + q1] = (unsigned)row; rwt[(size_t)i1 * MALL + q1] = w1;
            const unsigned q2 = atomicAdd(cnt + i2 * 64, 1u); ridx[(size_t)i2 * MALL + q2] = (unsigned)row | 0x80000000u; rwt[(size_t)i2 * MALL + q2] = w2;
        }
    }
    __syncthreads();
}

template <bool FOR_DOWN>
__device__ __forceinline__ void moe_tables(KArgs a, int l, LAS unsigned char* lds, int cvirt) {
    const int tid = tid_fresh(), G = gridDim.x;
    unsigned char* ws = a->ws;
    const unsigned* cnt = (const unsigned*)(ws + WS_CTL) + CW_CNT + l * 16 * 64;
    const unsigned* ridx = (const unsigned*)(ws + WS_RIDX); const float* rwt = (const float*)(ws + WS_RW);
    LAS int* tp = (LAS int*)(lds + LDS_TP); LAS unsigned* tab = (LAS unsigned*)(lds + LDS_TAB); LAS float* tabw = (LAS float*)(lds + LDS_TABW);
    if (tid == 0) { int acc = 0; for (int e = 0; e < 16; ++e) { tp[e] = acc; acc += (int)((cnt[e * 64] + 255u) >> 8); } tp[16] = acc; }
    __syncthreads();
    const int ntot = tp[16] * 8;
    for (int i = 0; i < 9; ++i) { const int L = i * G + cvirt; if (L >= ntot) break;
        const int tile = L >> 3; int e = 0;
        for (int j = 1; j < 16; ++j) e += (tile >= tp[j]) ? 1 : 0;
        const int pos0 = (tile - tp[e]) * 256; const unsigned ce = cnt[e * 64];
        if (tid < 256) { const int pos = pos0 + tid; const bool valid = (unsigned)pos < ce; const unsigned ent = ridx[(size_t)e * MALL + (valid ? pos : 0)];
            if (FOR_DOWN) { tab[i * 256 + tid] = valid ? ent : (ent | 0x40000000u); tabw[i * 256 + tid] = valid ? rwt[(size_t)e * MALL + pos] : 0.f; }
            else tab[i * 256 + tid] = (ent & 0xffffu) * (unsigned)(D * 2); }
    }
    __syncthreads();
}

__device__ __forceinline__ void gmlp_item(KArgs a, int l, int item, LAS unsigned char* lds) {
    const int tid = tid_fresh(), lane = tid & 63, wave = tid >> 6;
    unsigned char* ws = a->ws;
    const bf16* P = (const bf16*)(ws + WS_P); bf16* Y = (bf16*)(ws + WS_Y);
    const int chunk = item >> 2, h = item & 3;
    const int row0 = chunk < 256 ? chunk * 128 : NLAT + (chunk - 256) * 128;
    LAS bf16* wsl = (LAS bf16*)lds;
    LAS bf16* vT = (LAS bf16*)(lds + 128 * 136 * 2);
    const bf16* gws = (const bf16*)(ws + WS_SMALLW + SW_GWS) + ((size_t)l * 4 + h) * 128 * 128;
    for (int p = tid; p < 2048; p += NTHREADS) { const int t = p >> 4, c8 = p & 15; *(LAS u32x4*)(wsl + t * 136 + c8 * 8) = *(const u32x4*)(gws + t * 128 + c8 * 8); }
    {
        const int s = tid >> 2, qd = tid & 3; const bf16* vp = P + (size_t)(row0 + s) * INC + OFF_V + h * 128 + qd * 32;
        float g[32]; float ss = 0.f;
#pragma unroll
        for (int q = 0; q < 4; ++q) { float f[8]; unpack8(*(const u32x4*)(vp + 8 * q), f);
#pragma unroll
            for (int j = 0; j < 8; ++j) { const float x = geluf_(f[j]); g[8 * q + j] = x; ss += x * x; } }
        ss += __shfl_xor(ss, 1); ss += __shfl_xor(ss, 2);
        const float rstd = 1.0f / sqrtf(ss * (1.0f / 128.0f) + NORM_EPS);
        const float* ng = a->in[I_GNG] + (size_t)l * 512 + h * 128 + qd * 32;
#pragma unroll
        for (int j = 0; j < 32; ++j) vT[(qd * 32 + j) * 136 + s] = (bf16)f2bf(g[j] * rstd * ng[j]);
    }
    __syncthreads();
    f32x4 acc[8];
#pragma unroll
    for (int ct = 0; ct < 8; ++ct) acc[ct] = (f32x4){0.f, 0.f, 0.f, 0.f};
    const int fr = lane & 15, fq = lane >> 4;
#pragma unroll
    for (int ks = 0; ks < 4; ++ks) {
        const bf16x8 bfrag = *(const LAS bf16x8*)(wsl + (16 * wave + fr) * 136 + ks * 32 + fq * 8);
#pragma unroll
        for (int ct = 0; ct < 8; ++ct) { const bf16x8 afrag = *(const LAS bf16x8*)(vT + (16 * ct + fr) * 136 + ks * 32 + fq * 8);
            acc[ct] = __builtin_amdgcn_mfma_f32_16x16x32_bf16(afrag, bfrag, acc[ct], 0, 0, 0); }
    }
    const int t = 16 * wave + fr; const float wb = a->in[I_GB][((size_t)l * 4 + h) * 128 + t];
    const bf16* up = P + (size_t)(row0 + t) * INC + OFF_U + h * 128; bf16* yp = Y + (size_t)(row0 + t) * D + h * 128;
#pragma unroll
    for (int ct = 0; ct < 8; ++ct) { const int c = 16 * ct + 4 * fq; const u32x2 uu = *(const u32x2*)(up + c);
        const float y0 = geluf_(bflo(uu.x)) * (acc[ct][0] + wb), y1 = geluf_(bfhi(uu.x)) * (acc[ct][1] + wb), y2 = geluf_(bflo(uu.y)) * (acc[ct][2] + wb), y3 = geluf_(bfhi(uu.y)) * (acc[ct][3] + wb);
        u32x2 o; o.x = pk2(y0, y1); o.y = pk2(y2, y3); *(u32x2*)(yp + c) = o; }
    __syncthreads();
}

constexpr int SP_ = 72;
__device__ __forceinline__ int kperm_pos(int k) { const int s5 = k & 31; return (k & 32) + 8 * ((s5 >> 2) & 3) + 4 * (s5 >> 4) + (s5 & 3); }
__device__ __forceinline__ void rwkv_prep_item(KArgs a, int l, int tile, int hgrp, LAS unsigned char* lds) {
    const int tid = tid_fresh(), lane = tid & 63, wave = tid >> 6;
    unsigned char* ws = a->ws;
    const bf16* P = (const bf16*)(ws + WS_P); bf16* Y = (bf16*)(ws + WS_Y);
    LAS bf16* SR = (LAS bf16*)lds; LAS bf16* SK = SR + 64 * SP_; LAS bf16* SV = SK + 64 * SP_; LAS bf16* SKK = SV + 64 * SP_; LAS bf16* SB = SKK + 64 * SP_; LAS bf16* SWF = SB + 64 * SP_; LAS bf16* SWB = SWF + 64 * SP_;
    LAS bf16* tw = SWB + 64 * SP_;
    LAS bf16* adl = tw + 64 * SP_;
    LAS bf16* sg = adl + 64 * SP_;
    LAS float* invn = (LAS float*)(sg + 64 * 136);
    LAS unsigned char* wpriv = (LAS unsigned char*)(invn + 64) + wave * 6144;
    const int row0 = tile * 64; const bool isl = row0 < NLAT;
    const float* mu = a->in[I_MU] + (size_t)l * CCOLS;
    const char* Pb = (const char*)P;
    auto shift_group = [&](int tk, int col, float (&z)[8]) {
        const int row = row0 + tk; int o0, o1, o2, o3; bool v0, v1, v2, v3;
        if (isl) { const int gr = (row >> 6) & 63; o0 = -1; o1 = 1; o2 = -64; o3 = 64; v0 = tk > 0; v1 = tk < 63; v2 = gr > 0; v3 = gr < 63; }
        else { const int tc = (row - NLAT) & 255; o0 = -1; o1 = 1; o2 = -1; o3 = 1; v0 = tc > 0; v1 = tc < 255; v2 = v0; v3 = v1; }
        const unsigned off = (unsigned)row * (unsigned)(INC * 2) + (unsigned)(OFF_C + col) * 2u;
        const u32x4 uo = *(const u32x4*)(Pb + off), u0 = *(const u32x4*)(Pb + (off + (unsigned)((v0 ? o0 : 0) * INC * 2))), u1 = *(const u32x4*)(Pb + (off + (unsigned)((v1 ? o1 : 0) * INC * 2))),
                    u2 = *(const u32x4*)(Pb + (off + (unsigned)((v2 ? o2 : 0) * INC * 2))), u3 = *(const u32x4*)(Pb + (off + (unsigned)((v3 ? o3 : 0) * INC * 2)));
        const f32x4 m0 = *(const f32x4*)(mu + col), m1 = *(const f32x4*)(mu + col + 4);
        float own[8], n0[8], n1[8], n2[8], n3[8]; unpack8(uo, own); unpack8(u0, n0); unpack8(u1, n1); unpack8(u2, n2); unpack8(u3, n3);
        const float f0 = v0 ? 1.f : 0.f, f1 = v1 ? 1.f : 0.f, f2 = v2 ? 1.f : 0.f, f3 = v3 ? 1.f : 0.f;
        const float nb[8] = {n0[0] * f0, n1[1] * f1, n2[2] * f2, n3[3] * f3, n0[4] * f0, n1[5] * f1, n2[6] * f2, n3[7] * f3};
#pragma unroll
        for (int j = 0; j < 8; ++j) { const float mm = j < 4 ? m0[j] : m1[j - 4]; z[j] = own[j] + mm * (nb[j] - own[j]); }
    };
#pragma unroll
    for (int it = 0; it < 4; ++it) { const int g = tid + NTHREADS * it, tk = g >> 5, gi = g & 31;
        float z[8]; shift_group(tk, 2304 + gi * 8, z);
        if (gi < 8) { float t8[8];
#pragma unroll
            for (int j = 0; j < 8; ++j) t8[j] = 1.0f - 2.0f * __builtin_amdgcn_rcpf(1.0f + __expf(2.0f * z[j]));
            *(LAS u32x4*)(tw + tk * SP_ + gi * 8) = pack8(t8); }
        else if (gi < 16) *(LAS u32x4*)(adl + tk * SP_ + (gi - 8) * 8) = pack8(z);
        else { float t8[8];
#pragma unroll
            for (int j = 0; j < 8; ++j) t8[j] = sigmoidf_(z[j]);
            *(LAS u32x4*)(sg + tk * 136 + (gi - 16) * 8) = pack8(t8); } }
    __syncthreads();
#pragma unroll 1
    for (int hh = 0; hh < 4; ++hh) {
    const int tid = tid_fresh(), lane = tid & 63, wave = tid >> 6;
    const int head = 4 * hgrp + hh; const float* kkw = a->in[I_KK] + (size_t)l * CW + head * 64;
#pragma unroll
    for (int it = 0; it < 3; ++it) { const int g = tid + NTHREADS * it, tk = g / 24, gi = g % 24, c8 = (gi & 7) * 8;
        float z[8]; shift_group(tk, (gi >> 3) * 768 + head * 64 + c8, z);
        if (gi < 8) *(LAS u32x4*)(SR + tk * SP_ + c8) = pack8(z);
        else if (gi < 16) { *(LAS u32x4*)(SK + tk * SP_ + c8) = pack8(z);
            const f32x4 k0 = *(const f32x4*)(kkw + c8), k1 = *(const f32x4*)(kkw + c8 + 4); float ss = 0.f;
#pragma unroll
            for (int j = 0; j < 8; ++j) { const float q = z[j] * (j < 4 ? k0[j] : k1[j - 4]); ss += q * q; }
            ss += __shfl_xor(ss, 1); ss += __shfl_xor(ss, 2); ss += __shfl_xor(ss, 4);
            if ((gi & 7) == 0) invn[tk] = 1.0f / fmaxf(sqrtf(ss), 1e-12f); }
        else *(LAS u32x4*)(SV + tk * SP_ + c8) = pack8(z); }
    __syncthreads();
    {
        const int fr = lane & 15, fq = lane >> 4, nt = wave & 3, th = wave >> 2;
        const bf16* wupT = (const bf16*)(ws + WS_SMALLW + SW_WUP) + (size_t)l * 2 * 768 * 64;
        const bf16* aupT = (const bf16*)(ws + WS_SMALLW + SW_AUP) + (size_t)l * 768 * 64;
        const bf16* gupT = (const bf16*)(ws + WS_SMALLW + SW_GUP) + (size_t)l * 768 * 128;
        const float* a0 = a->in[I_A0] + (size_t)l * CW + head * 64; const float* kaw = a->in[I_KA] + (size_t)l * CW + head * 64; const float* w0 = a->in[I_W0] + (size_t)l * 2 * CW + head * 64;
        const int nloc = 16 * nt + 4 * fq;
#pragma unroll 1
        for (int mat = 0; mat < 4; ++mat) {
            const bf16* WT = mat == 0 ? aupT : (mat == 1 ? wupT : (mat == 2 ? wupT + 768 * 64 : gupT));
            const int KK = mat == 3 ? 128 : 64; const LAS bf16* act = mat == 0 ? adl : (mat == 3 ? sg : tw); const int apitch = mat == 3 ? 136 : SP_;
            f32x4 acc[2];
            acc[0] = (f32x4){0.f, 0.f, 0.f, 0.f}; acc[1] = acc[0];
            for (int ks = 0; ks < KK / 32; ++ks) { const bf16x8 afr = *(const bf16x8*)(WT + (size_t)(head * 64 + 16 * nt + fr) * KK + ks * 32 + fq * 8);
#pragma unroll
                for (int tt = 0; tt < 2; ++tt) { const bf16x8 bfr = *(const LAS bf16x8*)(act + (16 * (2 * th + tt) + fr) * apitch + ks * 32 + fq * 8); acc[tt] = __builtin_amdgcn_mfma_f32_16x16x32_bf16(afr, bfr, acc[tt], 0, 0, 0); } }
#pragma unroll
            for (int tt = 0; tt < 2; ++tt) { const int tk = 16 * (2 * th + tt) + fr; const f32x4 v = acc[tt];
                if (mat == 0) {
                    const f32x4 a0v = *(const f32x4*)(a0 + nloc), kav = *(const f32x4*)(kaw + nloc), kkv = *(const f32x4*)(kkw + nloc);
                    const u32x2 kp = *(const LAS u32x2*)(SK + tk * SP_ + nloc); const float kf[4] = {bflo(kp.x), bfhi(kp.x), bflo(kp.y), bfhi(kp.y)};
                    const float inn = invn[tk]; float k2[4], kk[4], bb[4];
#pragma unroll
                    for (int j = 0; j < 4; ++j) { const float av = sigmoidf_(a0v[j] + v[j]); kk[j] = kf[j] * kkv[j] * inn; k2[j] = kf[j] * (1.0f + (av - 1.0f) * kav[j]); bb[j] = kk[j] * av; }
                    u32x2 q; q.x = pk2(k2[0], k2[1]); q.y = pk2(k2[2], k2[3]); *(LAS u32x2*)(SK + tk * SP_ + nloc) = q;
                    q.x = pk2(kk[0], kk[1]); q.y = pk2(kk[2], kk[3]); *(LAS u32x2*)(SKK + tk * SP_ + nloc) = q;
                    q.x = pk2(bb[0], bb[1]); q.y = pk2(bb[2], bb[3]); *(LAS u32x2*)(SB + tk * SP_ + nloc) = q;
                } else if (mat <= 2) {
                    const f32x4 w0v = *(const f32x4*)(w0 + (mat - 1) * CW + nloc); float d[4];
#pragma unroll
                    for (int j = 0; j < 4; ++j) d[j] = __expf(-DECAY_SCALE * sigmoidf_(w0v[j] + v[j]));
                    u32x2 q; q.x = pk2(d[0], d[1]); q.y = pk2(d[2], d[3]); *(LAS u32x2*)((mat == 1 ? SWF : SWB) + tk * SP_ + nloc) = q;
                } else {
                    u32x2 q; q.x = pk2(v[0], v[1]); q.y = pk2(v[2], v[3]); *(u32x2*)(Y + (size_t)(row0 + tk) * D + 1280 + head * 64 + nloc) = q;
                }
            }
        }
    }
    __syncthreads();
    { const int tk = tid >> 3, c8 = (tid & 7) * 8; float r8[8], k8[8], v8[8];
      unpack8(*(const LAS u32x4*)(SR + tk * SP_ + c8), r8); unpack8(*(const LAS u32x4*)(SK + tk * SP_ + c8), k8); unpack8(*(const LAS u32x4*)(SV + tk * SP_ + c8), v8);
      const float* rkp = a->in[I_RK] + (size_t)l * CW + head * 64 + c8; const f32x4 rk0 = *(const f32x4*)rkp, rk1 = *(const f32x4*)(rkp + 4);
      float bs = 0.f;
#pragma unroll
      for (int j = 0; j < 8; ++j) bs += r8[j] * k8[j] * (j < 4 ? rk0[j] : rk1[j - 4]);
      bs += __shfl_xor(bs, 1); bs += __shfl_xor(bs, 2); bs += __shfl_xor(bs, 4);
#pragma unroll
      for (int j = 0; j < 8; ++j) v8[j] *= bs;
      *(u32x4*)(Y + (size_t)(row0 + tk) * D + 512 + head * 64 + c8) = pack8(v8); }
    {
        const int c4 = wave & 3, dir = wave >> 2, fr = lane & 15, fq = lane >> 4;
        LAS float* CB = (LAS float*)wpriv;
        LAS float* AA = CB + 16 * 64;
        const LAS bf16* SW = dir ? SWB : SWF;
        auto trow = [&](int tau) { return 16 * c4 + (dir ? 15 - tau : tau); };
        float c[16];
        { float run = 0.f;
#pragma unroll
          for (int t = 0; t < 16; ++t) { run += __logf(bf1(SW[trow(t) * SP_ + lane])); c[t] = run; CB[t * 64 + lane] = run; } }
        const int rec_dir = dir, bidx = isl ? (row0 >> 12) : ((row0 - NLAT) >> 8);
        const int tcl = isl ? 4 * ((row0 >> 6) & 63) + c4 : 4 * (((row0 - NLAT) >> 6) & 3) + c4;
        const int nproc = isl ? 16 + (dir ? 255 - tcl : tcl) : (dir ? 15 - tcl : tcl);
        unsigned char* rec = ws + WS_PRE + ((size_t)((rec_dir * 8 + bidx) * 12 + head) * NCHUNK16 + nproc) * PRE_REC;
        { const float cl = c[15]; float bk[32];
#pragma unroll
          for (int t = 0; t < 16; ++t) { const float e = __expf(cl - c[t]); const int pos = 8 * (t >> 2) + (t & 3); bk[pos] = bf1(SB[trow(t) * SP_ + lane]) * e; bk[pos + 4] = bf1(SK[trow(t) * SP_ + lane]) * e; }
#pragma unroll
          for (int q4 = 0; q4 < 4; ++q4) { u32x4 o; o.x = pk2(bk[8 * q4], bk[8 * q4 + 1]); o.y = pk2(bk[8 * q4 + 2], bk[8 * q4 + 3]); o.z = pk2(bk[8 * q4 + 4], bk[8 * q4 + 5]); o.w = pk2(bk[8 * q4 + 6], bk[8 * q4 + 7]);
              *(u32x4*)(rec + PR_BK + lane * 64 + q4 * 16) = o; }
          *(float*)(rec + PR_GAM + lane * 4) = __expf(cl); }
        asm volatile("s_waitcnt lgkmcnt(0)" ::: "memory");
        bf16x8 fa[2], frr[2], fb[2], fk[2];
        { const int tr = trow(fr);
#pragma unroll
          for (int sx = 0; sx < 2; ++sx) { const int ch = 32 * sx + 8 * fq; float kk8[8], r8[8], b8[8], k8[8];
              unpack8(*(const LAS u32x4*)(SKK + tr * SP_ + ch), kk8); unpack8(*(const LAS u32x4*)(SR + tr * SP_ + ch), r8); unpack8(*(const LAS u32x4*)(SB + tr * SP_ + ch), b8); unpack8(*(const LAS u32x4*)(SK + tr * SP_ + ch), k8);
              const f32x4 c0 = *(const LAS f32x4*)(CB + fr * 64 + ch), c1 = *(const LAS f32x4*)(CB + fr * 64 + ch + 4);
              f32x4 p0 = (f32x4){0.f, 0.f, 0.f, 0.f}, p1 = p0; if (fr > 0) { p0 = *(const LAS f32x4*)(CB + (fr - 1) * 64 + ch); p1 = *(const LAS f32x4*)(CB + (fr - 1) * 64 + ch + 4); }
              float xa[8], xr[8], xb[8], xk[8];
#pragma unroll
              for (int j = 0; j < 8; ++j) { const float cc = j < 4 ? c0[j] : c1[j - 4], cp = j < 4 ? p0[j] : p1[j - 4]; const float ep = __expf(cp), ec = __expf(cc), en = __builtin_amdgcn_rcpf(ec);
                  xa[j] = -kk8[j] * ep; xr[j] = r8[j] * ec; xb[j] = b8[j] * en; xk[j] = k8[j] * en; }
              const u32x4 ua = pack8(xa), ur = pack8(xr), ub = pack8(xb), uk = pack8(xk);
              fa[sx] = __builtin_bit_cast(bf16x8, ua); frr[sx] = __builtin_bit_cast(bf16x8, ur); fb[sx] = __builtin_bit_cast(bf16x8, ub); fk[sx] = __builtin_bit_cast(bf16x8, uk); } }
        f32x4 gab = (f32x4){0.f, 0.f, 0.f, 0.f}, gak = gab, grb = gab, grk = gab;
#pragma unroll
        for (int sx = 0; sx < 2; ++sx) { gab = __builtin_amdgcn_mfma_f32_16x16x32_bf16(fa[sx], fb[sx], gab, 0, 0, 0); gak = __builtin_amdgcn_mfma_f32_16x16x32_bf16(fa[sx], fk[sx], gak, 0, 0, 0);
            grb = __builtin_amdgcn_mfma_f32_16x16x32_bf16(frr[sx], fb[sx], grb, 0, 0, 0); grk = __builtin_amdgcn_mfma_f32_16x16x32_bf16(frr[sx], fk[sx], grk, 0, 0, 0); }
#pragma unroll
        for (int j = 0; j < 4; ++j) { const int tau = 4 * fq + j; const bool lo = fr < tau, le = fr <= tau;
            AA[tau * 16 + fr] = lo ? gab[j] : 0.f; AA[256 + tau * 16 + fr] = lo ? gak[j] : 0.f; grb[j] = le ? grb[j] : 0.f; grk[j] = le ? grk[j] : 0.f; }
        asm volatile("s_waitcnt lgkmcnt(0)" ::: "memory");
        float wv[16], mv[16];
#pragma unroll
        for (int t = 0; t < 16; ++t) { const float ab = -bf1(SKK[trow(t) * SP_ + lane]) * (t > 0 ? __expf(c[t - 1]) : 1.0f); float accw = ab, accm = AA[256 + t * 16 + fr];
#pragma unroll
            for (int q4 = 0; q4 < 4; ++q4) { if (4 * q4 < t) { const f32x4 cf = *(const LAS f32x4*)(AA + t * 16 + 4 * q4);
#pragma unroll
                for (int j = 0; j < 4; ++j) if (4 * q4 + j < t) { accw += cf[j] * wv[4 * q4 + j]; accm += cf[j] * mv[4 * q4 + j]; } } }
            wv[t] = accw; mv[t] = accm; }
        { LAS bf16* stg = (LAS bf16*)CB; const int pp = kperm_pos(lane);
#pragma unroll
          for (int t = 0; t < 16; ++t) { stg[t * 64 + pp] = (bf16)f2bf(wv[t]); stg[1024 + t * 64 + pp] = (bf16)f2bf(bf1(SR[trow(t) * SP_ + lane]) * __expf(c[t])); }
          asm volatile("s_waitcnt lgkmcnt(0)" ::: "memory");
#pragma unroll
          for (int q4 = 0; q4 < 4; ++q4) *(u32x4*)(rec + PR_WP + (q4 * 64 + lane) * 16) = *(const LAS u32x4*)((LAS unsigned char*)stg + (q4 * 64 + lane) * 16); }
        { LAS bf16* stg = (LAS bf16*)AA; const int ps = 8 * (fr >> 2) + (fr & 3);
          asm volatile("s_waitcnt lgkmcnt(0)" ::: "memory");
#pragma unroll
          for (int j = 0; j < 4; ++j) { const int tau = 4 * fq + j; stg[tau * 32 + ps] = (bf16)f2bf(grb[j]); stg[tau * 32 + ps + 4] = (bf16)f2bf(grk[j]); }
          if (lane < 16) {
#pragma unroll
              for (int t = 0; t < 16; ++t) stg[512 + t * 16 + lane] = (bf16)f2bf(mv[t]); }
          asm volatile("s_waitcnt lgkmcnt(0)" ::: "memory");
          *(u32x4*)(rec + PR_ARBK + lane * 16) = *(const LAS u32x4*)((LAS unsigned char*)stg + lane * 16);
          if (lane < 32) *(u32x4*)(rec + PR_ARBK + 1024 + lane * 16) = *(const LAS u32x4*)((LAS unsigned char*)stg + 1024 + lane * 16); }
        if (dir == 0) { float v16[16];
#pragma unroll
            for (int t = 0; t < 16; ++t) v16[t] = bf1(SV[(16 * c4 + t) * SP_ + lane]);
            const int tcg = isl ? 16 + tcl : tcl;
            unsigned char* vrec = ws + WS_VT + ((size_t)(bidx * 12 + head) * NCHUNK16 + tcg) * 2048 + lane * 32;
            u32x4 o; o.x = pk2(v16[0], v16[1]); o.y = pk2(v16[2], v16[3]); o.z = pk2(v16[4], v16[5]); o.w = pk2(v16[6], v16[7]); *(u32x4*)vrec = o;
            o.x = pk2(v16[8], v16[9]); o.y = pk2(v16[10], v16[11]); o.z = pk2(v16[12], v16[13]); o.w = pk2(v16[14], v16[15]); *(u32x4*)(vrec + 16) = o; }
    }
    __syncthreads();
    }
}

__device__ __forceinline__ float dpp_xor1(float x) { return __builtin_bit_cast(float, __builtin_amdgcn_update_dpp(0, __builtin_bit_cast(int, x), 0xB1, 0xF, 0xF, false)); }
__device__ __forceinline__ float dpp_xor2(float x) { return __builtin_bit_cast(float, __builtin_amdgcn_update_dpp(0, __builtin_bit_cast(int, x), 0x4E, 0xF, 0xF, false)); }
__device__ __forceinline__ int chain_row(int dir, int b, int s) {
    if (s < CTXL) return NLAT + b * CTXL + (dir ? (CTXL - 1 - s) : s);
    const int t = s - CTXL; return b * T + (dir ? (T - 1 - t) : t);
}
__device__ __forceinline__ float dpp_hmirror(float x) { return __builtin_bit_cast(float, __builtin_amdgcn_update_dpp(0, __builtin_bit_cast(int, x), 0x141, 0xF, 0xF, false)); }
struct RwRec { u32x4 wp[2], rp[2], bk[4], arbk; u32x2 mak, vt; f32x4 gam[4]; };
__device__ __forceinline__ void rw_load(RwRec& r, const LAS unsigned char* rec, int fr, int kg, int qv, int dir) {
#pragma unroll
    for (int sx = 0; sx < 2; ++sx) { r.wp[sx] = *(const LAS u32x4*)(rec + PR_WP + fr * 128 + sx * 64 + kg * 16); r.rp[sx] = *(const LAS u32x4*)(rec + PR_RP + fr * 128 + sx * 64 + kg * 16); }
#pragma unroll
    for (int i = 0; i < 4; ++i) { r.bk[i] = *(const LAS u32x4*)(rec + PR_BK + (16 * i + fr) * 64 + kg * 16); r.gam[i] = *(const LAS f32x4*)(rec + PR_GAM + (16 * i + 4 * kg) * 4); }
    r.arbk = *(const LAS u32x4*)(rec + PR_ARBK + fr * 64 + kg * 16);
    r.mak = *(const LAS u32x2*)(rec + PR_MAK + fr * 32 + kg * 8);
    r.vt = *(const LAS u32x2*)(rec + PRE_REC + (16 * qv + fr) * 32 + (dir ? (12 - 4 * kg) : 4 * kg) * 2);
}
constexpr int RW_R = 6, RW_SLOT = PRE_REC + 2048;
__device__ __forceinline__ void rwkv_chain_mfma(KArgs a, int task_base, LAS unsigned char* lds) {
    const int t_ = tid_fresh(); const int lane = t_ & 63, fr = lane & 15, kg = lane >> 4; const int wave = __builtin_amdgcn_readfirstlane(t_ >> 6); const int task = task_base + wave;
    unsigned char* ws = a->ws;
    bf16* OC = (bf16*)(ws + WS_OC);
    const int cid = task >> 2, qv = task & 3, dir = cid / 96, b = (cid % 96) / 12, h = cid % 12;
    const unsigned char* rec0 = ws + WS_PRE + (size_t)((dir * 8 + b) * 12 + h) * NCHUNK16 * PRE_REC;
    const unsigned char* vrec0 = ws + WS_VT + (size_t)(b * 12 + h) * NCHUNK16 * 2048;
    LAS unsigned char* ring = lds + (wave >> 2) * (RW_R * RW_SLOT);
    auto tchunk = [&](int n) { return n < 16 ? (dir ? 15 - n : n) : 16 + (dir ? 255 - (n - 16) : (n - 16)); };
    auto issue = [&](int n) { const int nn = n < NCHUNK16 ? n : NCHUNK16 - 1; LAS unsigned char* slot = ring + (n % RW_R) * RW_SLOT;
#pragma unroll
        for (int jj = 0; jj < 3; ++jj) { const int j = 3 * qv + jj;
            const unsigned char* src = (j < 10 ? rec0 + (size_t)nn * PRE_REC + 1024 * j : vrec0 + (size_t)tchunk(nn) * 2048 + 1024 * (j - 10)) + lane * 16;
            __builtin_amdgcn_global_load_lds((const unsigned*)src, (LAS unsigned*)(slot + 1024 * j), 16, 0, 0); } };
    f32x4 ST[4];
#pragma unroll
    for (int i = 0; i < 4; ++i) ST[i] = (f32x4){0.f, 0.f, 0.f, 0.f};
    unsigned uvU0 = 0u, uvU1 = 0u;
#pragma unroll
    for (int n = 0; n < RW_R - 1; ++n) issue(n);
    for (int n = 0; n < NCHUNK16; ++n) {
        asm volatile("s_waitcnt vmcnt(12)" ::: "memory");
        __builtin_amdgcn_s_barrier(); asm volatile("" ::: "memory");
        issue(n + RW_R - 1);
        RwRec cur; rw_load(cur, ring + (n % RW_R) * RW_SLOT, fr, kg, qv, dir);
        u32x4 fs[2];
#pragma unroll
        for (int sx = 0; sx < 2; ++sx) { fs[sx].x = pk2(ST[2 * sx][0], ST[2 * sx][1]); fs[sx].y = pk2(ST[2 * sx][2], ST[2 * sx][3]); fs[sx].z = pk2(ST[2 * sx + 1][0], ST[2 * sx + 1][1]); fs[sx].w = pk2(ST[2 * sx + 1][2], ST[2 * sx + 1][3]); }
        u32x2 vt = cur.vt; if (dir) { const unsigned x = vt.x, y = vt.y; vt.x = (y >> 16) | (y << 16); vt.y = (x >> 16) | (x << 16); }
        u32x4 fuv; fuv.x = uvU0; fuv.y = uvU1; fuv.z = vt.x; fuv.w = vt.y;
        u32x4 fmak; fmak.x = 0u; fmak.y = 0u; fmak.z = cur.mak.x; fmak.w = cur.mak.y;
        f32x4 U = (f32x4){0.f, 0.f, 0.f, 0.f};
        U = __builtin_amdgcn_mfma_f32_16x16x32_bf16(__builtin_bit_cast(bf16x8, cur.wp[0]), __builtin_bit_cast(bf16x8, fs[0]), U, 0, 0, 0);
        U = __builtin_amdgcn_mfma_f32_16x16x32_bf16(__builtin_bit_cast(bf16x8, cur.wp[1]), __builtin_bit_cast(bf16x8, fs[1]), U, 0, 0, 0);
        U = __builtin_amdgcn_mfma_f32_16x16x32_bf16(__builtin_bit_cast(bf16x8, fmak), __builtin_bit_cast(bf16x8, fuv), U, 0, 0, 0);
        uvU0 = pk2(U[0], U[1]); uvU1 = pk2(U[2], U[3]); fuv.x = uvU0; fuv.y = uvU1;
        f32x4 OT = (f32x4){0.f, 0.f, 0.f, 0.f};
        OT = __builtin_amdgcn_mfma_f32_16x16x32_bf16(__builtin_bit_cast(bf16x8, fs[0]), __builtin_bit_cast(bf16x8, cur.rp[0]), OT, 0, 0, 0);
        OT = __builtin_amdgcn_mfma_f32_16x16x32_bf16(__builtin_bit_cast(bf16x8, fs[1]), __builtin_bit_cast(bf16x8, cur.rp[1]), OT, 0, 0, 0);
        OT = __builtin_amdgcn_mfma_f32_16x16x32_bf16(__builtin_bit_cast(bf16x8, fuv), __builtin_bit_cast(bf16x8, cur.arbk), OT, 0, 0, 0);
#pragma unroll
        for (int i = 0; i < 4; ++i) ST[i] = __builtin_amdgcn_mfma_f32_16x16x32_bf16(__builtin_bit_cast(bf16x8, cur.bk[i]), __builtin_bit_cast(bf16x8, fuv), ST[i] * cur.gam[i], 0, 0, 0);
        const int row = chain_row(dir, b, 16 * n + fr);
        u32x2 o; o.x = pk2(OT[0], OT[1]); o.y = pk2(OT[2], OT[3]); *(u32x2*)(OC + ((size_t)dir * MALL + row) * CW + h * 64 + 16 * qv + 4 * kg) = o;
    }
    asm volatile("s_waitcnt vmcnt(0)" ::: "memory");
    __builtin_amdgcn_s_barrier(); asm volatile("" ::: "memory");
}
#define LDS_BAR() do { asm volatile("s_waitcnt lgkmcnt(0)" ::: "memory"); __builtin_amdgcn_s_barrier(); asm volatile("" ::: "memory"); } while (0)
__device__ __forceinline__ void hgrn_prep_item(KArgs a, int l, int item, LAS unsigned char* lds) {
    const int tid = tid_fresh();
    unsigned char* ws = a->ws;
    bf16* P = (bf16*)(ws + WS_P); bf16* HQB = (bf16*)(ws + WS_HQB); float* HG = (float*)(ws + WS_HG);
    const int cn = item % 68, bh = item / 68, h = bh % 6, b = bh / 6;
    const int row0 = cn < 4 ? NLAT + b * CTXL + 64 * cn : b * T + 64 * (cn - 4);
    constexpr int QP = 136;
    LAS bf16* SQ = (LAS bf16*)lds; LAS bf16* KF = SQ + 64 * QP; LAS bf16* KB = KF + 64 * QP; LAS bf16* QB = KB + 64 * QP;
    LAS float* LF = (LAS float*)(QB + 64 * QP); LAS float* LBk = LF + 64 * 128;
    LAS float* tot = LBk + 64 * 128;
    LAS float* lbs = tot + 1024;
    if (tid < 256) { const int dr = tid >> 7, ch = h * 128 + (tid & 127); float lb = 0.f;
        if (l != 0) { const float l0 = a->in[I_LB][((size_t)dr * DEPTH + 0) * BW + ch], l1 = a->in[I_LB][((size_t)dr * DEPTH + 1) * BW + ch]; lb = __builtin_amdgcn_rcpf(1.0f + __expf(l0 - l1)); }
        lbs[tid] = lb; }
    const int ta = tid >> 3, d0 = (tid & 7) * 16;
    bf16* prow = P + (size_t)(row0 + ta) * INC + h * 128 + d0;
    u32x4 rq[2], rf[2], rb[2];
    rq[0] = *(const u32x4*)(prow + OFF_Q); rq[1] = *(const u32x4*)(prow + OFF_Q + 8); rf[0] = *(const u32x4*)(prow + OFF_ZF); rf[1] = *(const u32x4*)(prow + OFF_ZF + 8); rb[0] = *(const u32x4*)(prow + OFF_ZB); rb[1] = *(const u32x4*)(prow + OFF_ZB + 8);
    __syncthreads();
#pragma unroll
    for (int hf = 0; hf < 2; ++hf) { float qf[8], zf[8], zb[8], oq[8], of[8], ob[8]; unpack8(rq[hf], qf); unpack8(rf[hf], zf); unpack8(rb[hf], zb);
        const int dd = d0 + 8 * hf; f32x4 lf0, lf1, lb0, lb1;
#pragma unroll
        for (int j = 0; j < 8; ++j) { const float lF = lbs[dd + j], lB = lbs[128 + dd + j];
            const float ff = lF + (1.0f - lF) * sigmoidf_(zf[j]), fb = lB + (1.0f - lB) * sigmoidf_(zb[j]);
            const float a1 = fmaxf(__logf(ff), -60.0f), a2 = fmaxf(__logf(fb), -60.0f);
            if (j < 4) { lf0[j] = a1; lb0[j] = a2; } else { lf1[j - 4] = a1; lb1[j - 4] = a2; }
            oq[j] = siluf_(qf[j]); of[j] = 1.0f - ff; ob[j] = 1.0f - fb; }
        *(LAS u32x4*)(SQ + ta * QP + dd) = pack8(oq); *(LAS u32x4*)(KF + ta * QP + dd) = pack8(of); *(LAS u32x4*)(KB + ta * QP + dd) = pack8(ob);
        *(LAS f32x4*)(LF + ta * 128 + dd) = lf0; *(LAS f32x4*)(LF + ta * 128 + dd + 4) = lf1; *(LAS f32x4*)(LBk + ta * 128 + dd) = lb0; *(LAS f32x4*)(LBk + ta * 128 + dd + 4) = lb1; }
    __syncthreads();
    const int d = tid & 127, qt = tid >> 7;
    float csf[16], csb[16];
    { float r1 = 0.f, r2 = 0.f;
#pragma unroll
      for (int i = 0; i < 16; ++i) { const int tp = 16 * qt + i; r1 += LF[tp * 128 + d]; csf[i] = r1; r2 += LBk[(63 - tp) * 128 + d]; csb[i] = r2; }
      tot[qt * 128 + d] = r1; tot[512 + qt * 128 + d] = r2; }
    __syncthreads();
#pragma unroll
    for (int dr = 0; dr < 2; ++dr) { const LAS float* tt = tot + 512 * dr; const float t0 = tt[d], t1 = tt[128 + d], t2 = tt[256 + d], t3 = tt[384 + d];
        const float bmid = t0 + t1, btot = bmid + t2 + t3; const float base = (qt > 0 ? t0 : 0.f) + (qt > 1 ? t1 : 0.f) + (qt > 2 ? t2 : 0.f);
        if (qt == 0) { const int npr = dr == 0 ? cn : (cn < 4 ? 3 - cn : 4 + 63 - (cn - 4)); float* g = HG + ((size_t)(((dr * 8 + b) * 6 + h) * 68 + npr)) * 256; g[d] = __expf(bmid); g[128 + d] = __expf(btot - bmid); }
#pragma unroll
        for (int i = 0; i < 16; ++i) { const int tp = 16 * qt + i, tok = dr ? 63 - tp : tp; const float bt = base + (dr ? csb[i] : csf[i]);
            const float eq = __expf(fminf(bt - bmid, 80.0f)), ek = __expf(fminf(bmid - bt, 80.0f));
            const float qv = bf1(SQ[tok * QP + d]) * eq;
            if (dr == 0) { KF[tok * QP + d] = (bf16)f2bf(bf1(KF[tok * QP + d]) * ek); QB[tok * QP + d] = (bf16)f2bf(qv); }
            else { KB[tok * QP + d] = (bf16)f2bf(bf1(KB[tok * QP + d]) * ek); SQ[tok * QP + d] = (bf16)f2bf(qv); } }
        __syncthreads(); }
#pragma unroll
    for (int hf = 0; hf < 2; ++hf) { const int dd = d0 + 8 * hf;
        *(u32x4*)(prow + OFF_Q + 8 * hf) = *(const LAS u32x4*)(QB + ta * QP + dd); *(u32x4*)(prow + OFF_ZF + 8 * hf) = *(const LAS u32x4*)(KF + ta * QP + dd); *(u32x4*)(prow + OFF_ZB + 8 * hf) = *(const LAS u32x4*)(KB + ta * QP + dd);
        *(u32x4*)(HQB + (size_t)(row0 + ta) * BW + h * 128 + dd) = *(const LAS u32x4*)(SQ + ta * QP + dd); }
    __syncthreads();
}
__device__ __forceinline__ unsigned tr_addr(const LAS bf16* X, int pitch, int r0, int c0, int lane) { const int i = lane & 15, g = lane >> 4; return (unsigned)(size_t)(X + (r0 + 8 * g + (i >> 2)) * pitch + c0 + 4 * (i & 3)); }
__device__ __forceinline__ void tr8x4(u32x2 (&lo)[4], u32x2 (&hi)[4], unsigned a0, unsigned a1, unsigned a2, unsigned a3, unsigned rowstep4) {
    const unsigned b0 = a0 + rowstep4, b1 = a1 + rowstep4, b2 = a2 + rowstep4, b3 = a3 + rowstep4;
    asm volatile("ds_read_b64_tr_b16 %0, %8\n\tds_read_b64_tr_b16 %1, %9\n\tds_read_b64_tr_b16 %2, %10\n\tds_read_b64_tr_b16 %3, %11\n\t"
                 "ds_read_b64_tr_b16 %4, %12\n\tds_read_b64_tr_b16 %5, %13\n\tds_read_b64_tr_b16 %6, %14\n\tds_read_b64_tr_b16 %7, %15\n\ts_waitcnt lgkmcnt(0)"
                 : "=&v"(lo[0]), "=&v"(lo[1]), "=&v"(lo[2]), "=&v"(lo[3]), "=&v"(hi[0]), "=&v"(hi[1]), "=&v"(hi[2]), "=&v"(hi[3])
                 : "v"(a0), "v"(a1), "v"(a2), "v"(a3), "v"(b0), "v"(b1), "v"(b2), "v"(b3) : "memory");
}
__device__ __forceinline__ bf16x8 mk8(u32x2 lo, u32x2 hi) { u32x4 v; v.x = lo.x; v.y = lo.y; v.z = hi.x; v.w = hi.y; return __builtin_bit_cast(bf16x8, v); }
__device__ __forceinline__ void hgrn_chain_lean(KArgs a, int cid, LAS unsigned char* lds) {
    const int tid = tid_fresh(), lane = tid & 63, wave = tid >> 6, fr = lane & 15, fq = lane >> 4;
    unsigned char* ws = a->ws;
    const bf16* P = (const bf16*)(ws + WS_P); const bf16* HQB = (const bf16*)(ws + WS_HQB); const float* HG = (const float*)(ws + WS_HG); bf16* OB = (bf16*)(ws + WS_OB);
    const int dir = cid / 48, b = (cid % 48) / 6, h = cid % 6;
    constexpr int QP = 136, SP = 72;
    LAS bf16* qs = (LAS bf16*)lds;
    LAS bf16* ks = qs + 64 * QP;
    LAS bf16* vs = ks + 64 * QP;
    LAS bf16* pl = vs + 64 * QP;
    LAS bf16* sT = pl + 64 * SP;
    LAS float* gm = (LAS float*)(sT + 128 * QP);
    const int ta = tid >> 3, d0 = (tid & 7) * 16;
    const int koff = dir ? OFF_ZB : OFF_ZF;
    f32x4 S[8];
#pragma unroll
    for (int vt = 0; vt < 8; ++vt) S[vt] = (f32x4){0.f, 0.f, 0.f, 0.f};
    u32x4 rq[2], rk[2], rv[2]; float rg = 0.f;
    auto load_chunk = [&](int n) { const int row = chain_row(dir, b, 64 * n + ta); const bf16* pr = P + (size_t)row * INC + h * 128 + d0;
        const bf16* qr = dir ? HQB + (size_t)row * BW + h * 128 + d0 : pr + OFF_Q;
        rq[0] = *(const u32x4*)qr; rq[1] = *(const u32x4*)(qr + 8); rk[0] = *(const u32x4*)(pr + koff); rk[1] = *(const u32x4*)(pr + koff + 8); rv[0] = *(const u32x4*)(pr + OFF_I); rv[1] = *(const u32x4*)(pr + OFF_I + 8);
        if (tid < 256) rg = HG[((size_t)(((dir * 8 + b) * 6 + h) * 68 + n)) * 256 + tid]; };
    load_chunk(0);
    constexpr int NCH = (CTXL + T) / 64;
    for (int n = 0; n < NCH; ++n) {
        const int s0 = n * 64;
        *(LAS u32x4*)(qs + ta * QP + d0) = rq[0]; *(LAS u32x4*)(qs + ta * QP + d0 + 8) = rq[1]; *(LAS u32x4*)(ks + ta * QP + d0) = rk[0]; *(LAS u32x4*)(ks + ta * QP + d0 + 8) = rk[1];
        *(LAS u32x4*)(vs + ta * QP + d0) = rv[0]; *(LAS u32x4*)(vs + ta * QP + d0 + 8) = rv[1]; if (tid < 256) gm[tid] = rg;
        if (n + 1 < NCH) load_chunk(n + 1);
        LDS_BAR();
        { const f32x4 g4 = *(const LAS f32x4*)(gm + 16 * wave + 4 * fq);
#pragma unroll
          for (int vt = 0; vt < 8; ++vt) { S[vt] = S[vt] * g4; u32x2 o; o.x = pk2(S[vt][0], S[vt][1]); o.y = pk2(S[vt][2], S[vt][3]); *(LAS u32x2*)(sT + (16 * vt + fr) * QP + 16 * wave + 4 * fq) = o; } }
        { const int tt = wave >> 1;
#pragma unroll
          for (int u = 0; u < 2; ++u) { const int sg = 2 * (wave & 1) + u; f32x4 acc = (f32x4){0.f, 0.f, 0.f, 0.f};
              if (sg <= tt) {
#pragma unroll
                  for (int kq = 0; kq < 4; ++kq) { const bf16x8 af = *(const LAS bf16x8*)(ks + (16 * sg + fr) * QP + 32 * kq + 8 * fq), bfm = *(const LAS bf16x8*)(qs + (16 * tt + fr) * QP + 32 * kq + 8 * fq);
                      acc = __builtin_amdgcn_mfma_f32_16x16x32_bf16(af, bfm, acc, 0, 0, 0); }
                  if (sg == tt) {
#pragma unroll
                      for (int j = 0; j < 4; ++j) if (4 * fq + j > fr) acc[j] = 0.f; }
              }
              u32x2 o; o.x = pk2(acc[0], acc[1]); o.y = pk2(acc[2], acc[3]); *(LAS u32x2*)(pl + (16 * tt + fr) * SP + 16 * sg + 4 * fq) = o; } }
        LDS_BAR();
        f32x4 oacc[4];
#pragma unroll
        for (int tt = 0; tt < 4; ++tt) { f32x4 acc = (f32x4){0.f, 0.f, 0.f, 0.f};
#pragma unroll
            for (int kq = 0; kq < 4; ++kq) { const bf16x8 af = *(const LAS bf16x8*)(sT + (16 * wave + fr) * QP + 32 * kq + 8 * fq), bfm = *(const LAS bf16x8*)(qs + (16 * tt + fr) * QP + 32 * kq + 8 * fq);
                acc = __builtin_amdgcn_mfma_f32_16x16x32_bf16(af, bfm, acc, 0, 0, 0); }
            oacc[tt] = acc; }
        const unsigned rs4 = (unsigned)(4 * QP * 2);
#pragma unroll
        for (int kq = 0; kq < 2; ++kq) {
            u32x2 vl_[8], vh_[8], xl_[4], xh_[4];
            { u32x2 l4[4], h4[4];
              tr8x4(l4, h4, tr_addr(vs, QP, 32 * kq, 0, lane), tr_addr(vs, QP, 32 * kq, 16, lane), tr_addr(vs, QP, 32 * kq, 32, lane), tr_addr(vs, QP, 32 * kq, 48, lane), rs4);
#pragma unroll
              for (int q = 0; q < 4; ++q) { vl_[q] = l4[q]; vh_[q] = h4[q]; }
              tr8x4(l4, h4, tr_addr(vs, QP, 32 * kq, 64, lane), tr_addr(vs, QP, 32 * kq, 80, lane), tr_addr(vs, QP, 32 * kq, 96, lane), tr_addr(vs, QP, 32 * kq, 112, lane), rs4);
#pragma unroll
              for (int q = 0; q < 4; ++q) { vl_[4 + q] = l4[q]; vh_[4 + q] = h4[q]; }
              tr8x4(xl_, xh_, tr_addr(ks, QP, 32 * kq, 16 * wave, lane), tr_addr(vs, QP, 32 * kq, 16 * wave, lane), tr_addr(ks, QP, 32 * kq, 16 * wave, lane), tr_addr(vs, QP, 32 * kq, 16 * wave, lane), rs4); }
            __builtin_amdgcn_sched_barrier(0);
            { const bf16x8 af = mk8(xl_[1], xh_[1]);
#pragma unroll
              for (int tt = 0; tt < 4; ++tt) { const bf16x8 bfm = *(const LAS bf16x8*)(pl + (16 * tt + fr) * SP + 32 * kq + 8 * fq); oacc[tt] = __builtin_amdgcn_mfma_f32_16x16x32_bf16(af, bfm, oacc[tt], 0, 0, 0); } }
            { const bf16x8 af = mk8(xl_[0], xh_[0]);
#pragma unroll
              for (int vt = 0; vt < 8; ++vt) S[vt] = __builtin_amdgcn_mfma_f32_16x16x32_bf16(af, mk8(vl_[vt], vh_[vt]), S[vt], 0, 0, 0); }
        }
#pragma unroll
        for (int tt = 0; tt < 4; ++tt) { const int row = chain_row(dir, b, s0 + 16 * tt + fr);
            u32x2 o; o.x = pk2(oacc[tt][0], oacc[tt][1]); o.y = pk2(oacc[tt][2], oacc[tt][3]); *(u32x2*)(OB + ((size_t)dir * MALL + row) * BW + h * 128 + 16 * wave + 4 * fq) = o; }
        { const f32x4 ge = *(const LAS f32x4*)(gm + 128 + 16 * wave + 4 * fq);
#pragma unroll
          for (int vt = 0; vt < 8; ++vt) S[vt] = S[vt] * ge; }
        LDS_BAR();
    }
}
__device__ __forceinline__ void hgrn_chain_mfma(KArgs a, int l, int cid, LAS unsigned char* lds) {
    const int tid = tid_fresh(), lane = tid & 63, wave = tid >> 6, fr = lane & 15, fq = lane >> 4;
    unsigned char* ws = a->ws;
    const bf16* P = (const bf16*)(ws + WS_P); bf16* OB = (bf16*)(ws + WS_OB);
    const int dir = cid / 48, b = (cid % 48) / 6, h = cid % 6;
    constexpr int QP = 136, SP = 72;
    LAS bf16* qs = (LAS bf16*)lds;
    LAS bf16* ks = qs + 64 * QP;
    LAS bf16* kT = ks + 64 * QP;
    LAS bf16* vT = kT + 128 * SP;
    LAS bf16* pl = vT + 128 * SP;
    LAS bf16* sT = pl + 64 * SP;
    LAS float* tot = (LAS float*)(sT + 128 * QP);
    LAS float* gmid = tot + 512;
    LAS float* gend = gmid + 128;
    LAS float* lbs = gend + 128;
    LAS float* lfb = (LAS float*)sT;
    const int d = tid & 127, qt = tid >> 7;
    const int tau_a = tid >> 3, d0 = (tid & 7) * 16;
    if (tid < 128) { const int ch = h * 128 + tid; float lb = 0.f;
        if (l != 0) { const float l0 = a->in[I_LB][((size_t)dir * DEPTH + 0) * BW + ch], l1 = a->in[I_LB][((size_t)dir * DEPTH + 1) * BW + ch]; lb = 1.0f / (1.0f + __expf(l0 - l1)); }
        lbs[tid] = lb; }
    f32x4 S[8];
#pragma unroll
    for (int vt = 0; vt < 8; ++vt) S[vt] = (f32x4){0.f, 0.f, 0.f, 0.f};
    const int zoff = dir ? OFF_ZB : OFF_ZF;
    u32x4 rq[2], ri[2], rz[2];
    { const bf16* pr = P + (size_t)chain_row(dir, b, tau_a) * INC + h * 128 + d0;
      rq[0] = *(const u32x4*)(pr + OFF_Q); rq[1] = *(const u32x4*)(pr + OFF_Q + 8); ri[0] = *(const u32x4*)(pr + OFF_I); ri[1] = *(const u32x4*)(pr + OFF_I + 8); rz[0] = *(const u32x4*)(pr + zoff); rz[1] = *(const u32x4*)(pr + zoff + 8); }
    __syncthreads();
    constexpr int NCH = (CTXL + T) / 64;
    for (int n = 0; n < NCH; ++n) {
        const int s0 = n * 64;
#pragma unroll
        for (int hf = 0; hf < 2; ++hf) { float qf[8], zf[8], oq[8], ok[8]; unpack8(rq[hf], qf); unpack8(rz[hf], zf);
            const int dd = d0 + 8 * hf; const f32x4 lb0 = *(const LAS f32x4*)(lbs + dd), lb1 = *(const LAS f32x4*)(lbs + dd + 4); f32x4 lf0, lf1;
#pragma unroll
            for (int j = 0; j < 8; ++j) { const float lb = j < 4 ? lb0[j] : lb1[j - 4]; const float f = lb + (1.0f - lb) * sigmoidf_(zf[j]); const float lf = fmaxf(__logf(f), -60.0f);
                if (j < 4) lf0[j] = lf; else lf1[j - 4] = lf; oq[j] = siluf_(qf[j]); ok[j] = 1.0f - f; }
            *(LAS u32x4*)(qs + tau_a * QP + dd) = pack8(oq); *(LAS u32x4*)(ks + tau_a * QP + dd) = pack8(ok);
            *(LAS f32x4*)(lfb + tau_a * 128 + dd) = lf0; *(LAS f32x4*)(lfb + tau_a * 128 + dd + 4) = lf1;
            const u32x4 vv = ri[hf];
            vT[(dd + 0) * SP + tau_a] = (bf16)(vv.x & 0xffffu); vT[(dd + 1) * SP + tau_a] = (bf16)(vv.x >> 16); vT[(dd + 2) * SP + tau_a] = (bf16)(vv.y & 0xffffu); vT[(dd + 3) * SP + tau_a] = (bf16)(vv.y >> 16);
            vT[(dd + 4) * SP + tau_a] = (bf16)(vv.z & 0xffffu); vT[(dd + 5) * SP + tau_a] = (bf16)(vv.z >> 16); vT[(dd + 6) * SP + tau_a] = (bf16)(vv.w & 0xffffu); vT[(dd + 7) * SP + tau_a] = (bf16)(vv.w >> 16); }
        if (n + 1 < NCH) { const bf16* pr = P + (size_t)chain_row(dir, b, s0 + 64 + tau_a) * INC + h * 128 + d0;
            rq[0] = *(const u32x4*)(pr + OFF_Q); rq[1] = *(const u32x4*)(pr + OFF_Q + 8); ri[0] = *(const u32x4*)(pr + OFF_I); ri[1] = *(const u32x4*)(pr + OFF_I + 8); rz[0] = *(const u32x4*)(pr + zoff); rz[1] = *(const u32x4*)(pr + zoff + 8); }
        LDS_BAR();
        float cs[16];
        { float run = 0.f;
#pragma unroll
          for (int i = 0; i < 16; ++i) { run += lfb[(16 * qt + i) * 128 + d]; cs[i] = run; }
          tot[qt * 128 + d] = run; }
        LDS_BAR();
        { const float t0 = tot[d], t1 = tot[128 + d], t2 = tot[256 + d], t3 = tot[384 + d];
          const float bmid = t0 + t1, btot = bmid + t2 + t3; const float base = (qt > 0 ? t0 : 0.f) + (qt > 1 ? t1 : 0.f) + (qt > 2 ? t2 : 0.f);
          if (qt == 0) { gmid[d] = __expf(bmid); gend[d] = __expf(btot - bmid); }
#pragma unroll
          for (int i = 0; i < 16; ++i) { const int tau = 16 * qt + i; const float bt = base + cs[i];
              const float eq = __expf(fminf(bt - bmid, 80.0f)), ek = __expf(fminf(bmid - bt, 80.0f));
              const bf16 qb = (bf16)f2bf(bf1(qs[tau * QP + d]) * eq), kb = (bf16)f2bf(bf1(ks[tau * QP + d]) * ek);
              qs[tau * QP + d] = qb; ks[tau * QP + d] = kb; kT[d * SP + tau] = kb; } }
        LDS_BAR();
        { const f32x4 gm = *(const LAS f32x4*)(gmid + 16 * wave + 4 * fq);
#pragma unroll
          for (int vt = 0; vt < 8; ++vt) { S[vt] = S[vt] * gm; u32x2 o; o.x = pk2(S[vt][0], S[vt][1]); o.y = pk2(S[vt][2], S[vt][3]); *(LAS u32x2*)(sT + (16 * vt + fr) * QP + 16 * wave + 4 * fq) = o; } }
        { const int tt = wave >> 1;
#pragma unroll
          for (int u = 0; u < 2; ++u) { const int sg = 2 * (wave & 1) + u; f32x4 acc = (f32x4){0.f, 0.f, 0.f, 0.f};
              if (sg <= tt) {
#pragma unroll
                  for (int kq = 0; kq < 4; ++kq) { const bf16x8 af = *(const LAS bf16x8*)(ks + (16 * sg + fr) * QP + 32 * kq + 8 * fq), bfm = *(const LAS bf16x8*)(qs + (16 * tt + fr) * QP + 32 * kq + 8 * fq);
                      acc = __builtin_amdgcn_mfma_f32_16x16x32_bf16(af, bfm, acc, 0, 0, 0); }
                  if (sg == tt) {
#pragma unroll
                      for (int j = 0; j < 4; ++j) if (4 * fq + j > fr) acc[j] = 0.f; }
              }
              u32x2 o; o.x = pk2(acc[0], acc[1]); o.y = pk2(acc[2], acc[3]); *(LAS u32x2*)(pl + (16 * tt + fr) * SP + 16 * sg + 4 * fq) = o; } }
        LDS_BAR();
#pragma unroll
        for (int tt = 0; tt < 4; ++tt) { f32x4 acc = (f32x4){0.f, 0.f, 0.f, 0.f};
#pragma unroll
            for (int kq = 0; kq < 2; ++kq) { const bf16x8 af = *(const LAS bf16x8*)(vT + (16 * wave + fr) * SP + 32 * kq + 8 * fq), bfm = *(const LAS bf16x8*)(pl + (16 * tt + fr) * SP + 32 * kq + 8 * fq);
                acc = __builtin_amdgcn_mfma_f32_16x16x32_bf16(af, bfm, acc, 0, 0, 0); }
#pragma unroll
            for (int kq = 0; kq < 4; ++kq) { const bf16x8 af = *(const LAS bf16x8*)(sT + (16 * wave + fr) * QP + 32 * kq + 8 * fq), bfm = *(const LAS bf16x8*)(qs + (16 * tt + fr) * QP + 32 * kq + 8 * fq);
                acc = __builtin_amdgcn_mfma_f32_16x16x32_bf16(af, bfm, acc, 0, 0, 0); }
            const int row = chain_row(dir, b, s0 + 16 * tt + fr);
            u32x2 o; o.x = pk2(acc[0], acc[1]); o.y = pk2(acc[2], acc[3]); *(u32x2*)(OB + ((size_t)dir * MALL + row) * BW + h * 128 + 16 * wave + 4 * fq) = o; }
        { const f32x4 ge = *(const LAS f32x4*)(gend + 16 * wave + 4 * fq);
#pragma unroll
          for (int kq = 0; kq < 2; ++kq) { const bf16x8 af = *(const LAS bf16x8*)(kT + (16 * wave + fr) * SP + 32 * kq + 8 * fq);
#pragma unroll
              for (int vt = 0; vt < 8; ++vt) { const bf16x8 bfm = *(const LAS bf16x8*)(vT + (16 * vt + fr) * SP + 32 * kq + 8 * fq); S[vt] = __builtin_amdgcn_mfma_f32_16x16x32_bf16(af, bfm, S[vt], 0, 0, 0); } }
#pragma unroll
          for (int vt = 0; vt < 8; ++vt) S[vt] = S[vt] * ge; }
        LDS_BAR();
    }
}
__device__ __forceinline__ void hgrn_chain(KArgs a, int l, int cid, LAS unsigned char* lds) {
    const int tid = tid_fresh();
    unsigned char* ws = a->ws;
    const bf16* P = (const bf16*)(ws + WS_P); bf16* OB = (bf16*)(ws + WS_OB);
    const int dir = cid / 48, b = (cid % 48) / 6, h = cid % 6;
    LAS float* tq = (LAS float*)lds;
    LAS float* tk = tq + 16 * 128;
    LAS float* tf = tk + 16 * 128;
    LAS float* tv = tf + 16 * 128;
    LAS float* ot = tv + 16 * 128;
    const int v = tid >> 2, q = tid & 3;
    float S[32];
#pragma unroll
    for (int j = 0; j < 32; ++j) S[j] = 0.f;
    const int sst = tid >> 5, sc4 = (tid & 31) * 4;
    float lb[4];
#pragma unroll
    for (int j = 0; j < 4; ++j) { const int ch = h * 128 + sc4 + j;
        if (l == 0) lb[j] = 0.f; else { const float l0 = a->in[I_LB][((size_t)dir * DEPTH + 0) * BW + ch], l1 = a->in[I_LB][((size_t)dir * DEPTH + 1) * BW + ch]; lb[j] = 1.0f / (1.0f + __expf(l0 - l1)); } }
    for (int s0 = 0; s0 < CTXL + T; s0 += 16) {
        { const int row = chain_row(dir, b, s0 + sst); const bf16* pr = P + (size_t)row * INC + h * 128 + sc4;
          const u32x2 pq = *(const u32x2*)(pr + OFF_Q), pi = *(const u32x2*)(pr + OFF_I), pz = *(const u32x2*)(pr + (dir ? OFF_ZB : OFF_ZF));
          const float qf[4] = {bflo(pq.x), bfhi(pq.x), bflo(pq.y), bfhi(pq.y)}, vf[4] = {bflo(pi.x), bfhi(pi.x), bflo(pi.y), bfhi(pi.y)}, zf[4] = {bflo(pz.x), bfhi(pz.x), bflo(pz.y), bfhi(pz.y)};
          f32x4 oq, ok, of, ov;
#pragma unroll
          for (int j = 0; j < 4; ++j) { const float f = lb[j] + (1.0f - lb[j]) * sigmoidf_(zf[j]); oq[j] = siluf_(qf[j]); of[j] = f; ok[j] = 1.0f - f; ov[j] = vf[j]; }
          *(LAS f32x4*)(tq + sst * 128 + sc4) = oq; *(LAS f32x4*)(tk + sst * 128 + sc4) = ok; *(LAS f32x4*)(tf + sst * 128 + sc4) = of; *(LAS f32x4*)(tv + sst * 128 + sc4) = ov; }
        LDS_BAR();
        for (int st = 0; st < 16; ++st) {
            const float vv = tv[st * 128 + v]; float o0 = 0.f, o1 = 0.f;
#pragma unroll
            for (int j = 0; j < 8; ++j) { const f32x4 fq4 = *(const LAS f32x4*)(tf + st * 128 + q * 32 + 4 * j), kq4 = *(const LAS f32x4*)(tk + st * 128 + q * 32 + 4 * j), qq4 = *(const LAS f32x4*)(tq + st * 128 + q * 32 + 4 * j);
#pragma unroll
                for (int i = 0; i < 4; ++i) { const float sn = fq4[i] * S[4 * j + i] + kq4[i] * vv; S[4 * j + i] = sn; if (i & 1) o1 += qq4[i] * sn; else o0 += qq4[i] * sn; } }
            float o = o0 + o1; o += dpp_xor1(o); o += dpp_xor2(o);
            if (q == 0) ot[st * 128 + v] = o;
        }
        LDS_BAR();
        if (tid < 256) { const int st = tid >> 4, part = tid & 15; const int row = chain_row(dir, b, s0 + st); const LAS float* op = ot + st * 128 + part * 8;
            float f[8];
#pragma unroll
            for (int j = 0; j < 8; ++j) f[j] = op[j];
            *(u32x4*)(OB + ((size_t)dir * MALL + row) * BW + h * 128 + part * 8) = pack8(f); }
    }
    LDS_BAR();
}

__device__ __forceinline__ float grp_sum32(float v) { v += __shfl_xor(v, 1); v += __shfl_xor(v, 2); v += __shfl_xor(v, 4); v += __shfl_xor(v, 8); v += __shfl_xor(v, 16); return v; }
__device__ __forceinline__ float grp_sum16(float v) { v += __shfl_xor(v, 1); v += __shfl_xor(v, 2); v += __shfl_xor(v, 4); v += __shfl_xor(v, 8); return v; }
__device__ __forceinline__ void phase_finalize(KArgs a, int l, bool dry) {
    const int tid_ = tid_fresh(); const int lane = tid_ & 63, wave = tid_ >> 6, gw = blockIdx.x * 8 + wave, NGW = gridDim.x * 8;
    unsigned char* ws = a->ws;
    const bf16* P = (const bf16*)(ws + WS_P); const bf16* OB = (const bf16*)(ws + WS_OB); const bf16* OC = (const bf16*)(ws + WS_OC); bf16* Y = (bf16*)(ws + WS_Y);
    bf16* Yo = dry ? (bf16*)(ws + WS_END) : Y;
    const int nrows = (l == DEPTH - 1) ? NLAT : MALL;
    const int rpw = (nrows + NGW - 1) / NGW; const int r0 = gw * rpw, r1 = (r0 + rpw < nrows) ? r0 + rpw : nrows;
    f32x4 hng[3], gng[3], gnb[3];
#pragma unroll
    for (int k = 0; k < 3; ++k) { const int c = 256 * k + 4 * lane; hng[k] = *(const f32x4*)(a->in[I_HNG] + (size_t)l * BW + c);
        gng[k] = *(const f32x4*)(a->in[I_GNGG] + (size_t)l * CW + c); gnb[k] = *(const f32x4*)(a->in[I_GNB] + (size_t)l * CW + c); }
    for (int row = r0; row < r1; ++row) {
        const int orow = dry ? (row & 2047) : row;
        u32x2 bf_[3], bb_[3], bg_[3], cf_[3], cb_[3], cv_[3], cg_[3];
#pragma unroll
        for (int k = 0; k < 3; ++k) { const int c = 256 * k + 4 * lane;
            bf_[k] = *(const u32x2*)(OB + (size_t)row * BW + c); bb_[k] = *(const u32x2*)(OB + ((size_t)MALL + row) * BW + c); bg_[k] = *(const u32x2*)(P + (size_t)row * INC + OFF_OG + c);
            cf_[k] = *(const u32x2*)(OC + (size_t)row * CW + c); cb_[k] = *(const u32x2*)(OC + ((size_t)MALL + row) * CW + c);
            cv_[k] = *(const u32x2*)(Y + (size_t)row * D + 512 + c);
            cg_[k] = *(const u32x2*)(Y + (size_t)row * D + 1280 + c); }
#pragma unroll
        for (int k = 0; k < 3; ++k) { const int c = 256 * k + 4 * lane;
            { float o[4] = {bflo(bf_[k].x) + bflo(bb_[k].x), bfhi(bf_[k].x) + bfhi(bb_[k].x), bflo(bf_[k].y) + bflo(bb_[k].y), bfhi(bf_[k].y) + bfhi(bb_[k].y)};
              const float ss = grp_sum32((o[0] * o[0] + o[1] * o[1]) + (o[2] * o[2] + o[3] * o[3])); const float rstd = 1.0f / sqrtf(ss * (1.0f / 128.0f) + NORM_EPS);
              const float g4[4] = {bflo(bg_[k].x), bfhi(bg_[k].x), bflo(bg_[k].y), bfhi(bg_[k].y)}; float y[4];
#pragma unroll
              for (int j = 0; j < 4; ++j) y[j] = o[j] * rstd * hng[k][j] * sigmoidf_(g4[j]);
              u32x2 q; q.x = pk2(y[0], y[1]); q.y = pk2(y[2], y[3]); *(u32x2*)(Yo + (size_t)orow * D + 512 + c) = q; }
            { float o[4] = {bflo(cf_[k].x) + bflo(cb_[k].x), bfhi(cf_[k].x) + bfhi(cb_[k].x), bflo(cf_[k].y) + bflo(cb_[k].y), bfhi(cf_[k].y) + bfhi(cb_[k].y)};
              const float v4[4] = {bflo(cv_[k].x), bfhi(cv_[k].x), bflo(cv_[k].y), bfhi(cv_[k].y)}, g4[4] = {bflo(cg_[k].x), bfhi(cg_[k].x), bflo(cg_[k].y), bfhi(cg_[k].y)};
              const float mean = grp_sum16((o[0] + o[1]) + (o[2] + o[3])) * (1.0f / 64.0f);
              float dl[4]; float sq = 0.f;
#pragma unroll
              for (int j = 0; j < 4; ++j) { dl[j] = o[j] - mean; sq += dl[j] * dl[j]; }
              const float var = grp_sum16(sq) * (1.0f / 64.0f); const float rs = 1.0f / sqrtf(var + GN_EPS); float y[4];
#pragma unroll
              for (int j = 0; j < 4; ++j) y[j] = (dl[j] * rs * gng[k][j] + gnb[k][j] + v4[j]) * g4[j];
              u32x2 q; q.x = pk2(y[0], y[1]); q.y = pk2(y[2], y[3]); *(u32x2*)(Yo + (size_t)orow * D + 1280 + c) = q; }
        }
    }
}

__global__ void __launch_bounds__(NTHREADS, 2) mk_fwd(Args args_unused) {
    extern __shared__ __attribute__((aligned(16))) unsigned char lds_raw[];
    LAS unsigned char* lds = (LAS unsigned char*)lds_raw;
    volatile LAS unsigned* misc = (volatile LAS unsigned*)(lds + LDS_MISC);
    const int tid = threadIdx.x, G = gridDim.x;
    if (tid < 64) misc[tid] = 0u;
    __syncthreads();
    XcdBarrier bar; bar.bar = nullptr; bar.x = 0; bar.st = nullptr;
    int lo, hi;
    { KArgs a = kargs(); lo = a->ph_lo; hi = a->ph_hi; unsigned* ctl = (unsigned*)(a->ws + WS_CTL); bar.bar = ctl + CW_BAR; if (!MK_MULTI) bar = xcd_barrier_post(ctl + CW_BAR, misc + 8); }
    const int cvirt = (G % 8 == 0) ? ((int)blockIdx.x % 8) * (G / 8) + (int)blockIdx.x / 8 : (int)blockIdx.x;
#define IN(k) (lo <= (k) && (k) < hi)
#define PM(b) ((PHMASK >> (b)) & 1)
#define REP(b) _Pragma("unroll 1") for (int rep_ = 0; rep_ < 1 + ((PROBE_DUP >> (b)) & 1); ++rep_)
#define SEAM(k) do { if (!MK_MULTI && IN(k) && IN((k) + 1)) { xcd_barrier(bar); if ((PROBE_DUP >> 13) & 1) xcd_barrier(bar); } } while (0)

    if (PM(0) && IN(0)) REP(0) { phase_prologue(kargs(), lds); } SEAM(0);

#pragma unroll 1
    for (int l = 0; l < DEPTH; ++l) {
        const int pb = 1 + 9 * l;
        const bool lastl = (l == DEPTH - 1);
        if (PM(1) && IN(pb + 0)) { if ((PROBE_DUP >> 1) & 1) { if (l == 0) phase_norm1<0>(kargs(), l, true); else phase_norm1<1>(kargs(), l, true); } if (l == 0) phase_norm1<0>(kargs(), l, false); else { phase_norm1<1>(kargs(), l, false); __syncthreads(); convert_moe(kargs(), l, lds); __syncthreads(); } } SEAM(pb + 0);
        if (PM(2) && IN(pb + 1)) REP(2) {
            KArgs a = kargs(); unsigned char* ws = a->ws;
            pg8::Gemm g{(const bf16*)(ws + WS_H), (const bf16*)(ws + WS_WIN) + (size_t)l * INC * D, MALL, INC, D};
            pg8::StaticOrder S; S.init(MALL, INC, G, (int)blockIdx.x);
            pg8::EpiBf16 E{(bf16*)(ws + WS_P), INC};
            pg8::gemm_phase<pg8::EpiBf16, pg8::StaticOrder, true, false>(lds, g, S, E, nullptr);
        } SEAM(pb + 1);
        if (PM(3) && IN(pb + 2)) REP(3) {
            const int ngm = lastl ? 1024 : 1088;
            for (int it = blockIdx.x; it < ngm + 544 * 3 + 3264; it += G) { if (it >= ngm + 544 * 3) hgrn_prep_item(kargs(), l, it - ngm - 544 * 3, lds); else if (it < ngm) { _Pragma("unroll 1") for (int r2 = 0; r2 < 1 + ((PROBE_DUP >> 14) & 1); ++r2) gmlp_item(kargs(), l, it, lds); } else { const int q = it - ngm; _Pragma("unroll 1") for (int r2 = 0; r2 < 1 + ((PROBE_DUP >> 15) & 1); ++r2) rwkv_prep_item(kargs(), l, q / 3, q % 3, lds); } }
        } SEAM(pb + 2);
        if (PM(4) && IN(pb + 3)) REP(4) {
            if (G == 256) { const int bx = blockIdx.x;
                if (bx < 96) rwkv_chain_mfma(kargs(), bx * 8, lds);
                else if (bx < 192) hgrn_chain_lean(kargs(), bx - 96, lds); }
            else { for (int it = blockIdx.x; it < 192; it += G) { if (it < 96) rwkv_chain_mfma(kargs(), it * 8, lds); else hgrn_chain_lean(kargs(), it - 96, lds); } }
        } SEAM(pb + 3);
        if (PM(5) && IN(pb + 4)) { if ((PROBE_DUP >> 5) & 1) phase_finalize(kargs(), l, true); phase_finalize(kargs(), l, false); } SEAM(pb + 4);
        if (PM(6) && IN(pb + 5)) REP(6) {
            KArgs a = kargs(); unsigned char* ws = a->ws;
            const int Mo = lastl ? NLAT : MALL;
            pg8::Gemm g{(const bf16*)(ws + WS_Y), (const bf16*)(ws + WS_WOUT) + (size_t)l * D * D, Mo, D, D};
            pg8::StaticOrder S; S.init(Mo, D, G, (int)blockIdx.x);
            const float* xl = l == 0 ? a->in[I_X] : (const float*)(ws + WS_X); const float* xc = l == 0 ? a->in[I_CTX] : (const float*)(ws + WS_X) + (size_t)NLAT * D;
            pg8::EpiResid E{xl, xc, (float*)(ws + WS_X), (const float*)(ws + WS_MOD) + (size_t)l * 9 * 12288 + 2 * D};
            pg8::gemm_phase<pg8::EpiResid, pg8::StaticOrder, true, false>(lds, g, S, E, nullptr);
        } SEAM(pb + 5);
        if (PM(7) && IN(pb + 6)) { if ((PROBE_DUP >> 7) & 1) phase_norm2_router(kargs(), l, true, lds); phase_norm2_router(kargs(), l, false, lds); } SEAM(pb + 6);
        if (PM(8) && IN(pb + 7)) REP(8) {
            KArgs a = kargs(); unsigned char* ws = a->ws;
            moe_tables<false>(a, l, lds, cvirt);
            pg8::Gemm g{(const bf16*)(ws + WS_H), (const bf16*)(ws + WS_WGU), 0, 2048, D};
            pg8::MoeOrder S{(const LAS int*)(lds + LDS_TP), G, cvirt, (unsigned)(2048 * D * 2)};
            pg8::EpiSwiglu E{(bf16*)(ws + WS_ACT)};
            pg8::gemm_phase<pg8::EpiSwiglu, pg8::MoeOrder, false, true>(lds, g, S, E, (const LAS unsigned*)(lds + LDS_TAB));
        } SEAM(pb + 7);
        if (PM(9) && IN(pb + 8)) REP(9) {
            KArgs a = kargs(); unsigned char* ws = a->ws;
            moe_tables<true>(a, l, lds, cvirt);
            pg8::Gemm g{(const bf16*)(ws + WS_ACT), (const bf16*)(ws + WS_WDN), 0, D, DE};
            pg8::MoeOrder S{(const LAS int*)(lds + LDS_TP), G, cvirt, (unsigned)(D * DE * 2)};
            pg8::EpiDown E{(bf16*)(ws + WS_YK), (const LAS unsigned*)(lds + LDS_TAB), (const LAS float*)(lds + LDS_TABW)};
            pg8::gemm_phase<pg8::EpiDown, pg8::MoeOrder, false, false>(lds, g, S, E, nullptr);
        } SEAM(pb + 8);
    }
    if (PM(10) && IN(1 + 9 * DEPTH)) { if ((PROBE_DUP >> 10) & 1) phase_norm1<2>(kargs(), DEPTH, true); phase_norm1<2>(kargs(), DEPTH, false); }
#undef IN
#undef SEAM
}

extern "C" void kernel_launch(void* const* d_in, const int* in_sizes, int n_in, void* d_out, int out_size, void* d_ws, size_t ws_size, hipStream_t stream) {
    static int grid = 0;
    if (grid == 0) {
        if (n_in != 31 || ws_size < WS_END) { fprintf(stderr, "kernel_launch: unexpected n_in %d / ws %zu (need %zu)\n", n_in, ws_size, (size_t)WS_END); grid = -1; return; }
        int dev = 0, cus = 0, per_cu = 0;
        hipGetDevice(&dev); hipDeviceGetAttribute(&cus, hipDeviceAttributeMultiprocessorCount, dev);
        if (hipFuncSetAttribute((const void*)mk_fwd, hipFuncAttributeMaxDynamicSharedMemorySize, LDS_BYTES) != hipSuccess) { fprintf(stderr, "kernel_launch: hipFuncSetAttribute failed\n"); grid = -1; return; }
        if (hipOccupancyMaxActiveBlocksPerMultiprocessor(&per_cu, (const void*)mk_fwd, NTHREADS, LDS_BYTES) != hipSuccess || per_cu < 1) fprintf(stderr, "kernel_launch: occupancy query says %d\n", per_cu);
        (void)hipGetLastError();
        grid = cus > 0 ? cus : 256;
    }
    if (grid < 0) return;
    hipMemsetAsync((char*)d_ws + WS_CTL, 0, CTL_ZERO_BYTES, stream);
    Args a{};
    for (int i = 0; i < 31; ++i) a.in[i] = (const float*)d_in[i];
    a.out = (float*)d_out; a.ws = (unsigned char*)d_ws;
    constexpr int NPH = 2 + 9 * DEPTH;
#if MK_MULTI
    for (int p = 0; p < NPH; ++p) { a.ph_lo = p; a.ph_hi = p + 1; hipLaunchKernelGGL(mk_fwd, dim3(grid), dim3(NTHREADS), LDS_BYTES, stream, a); }
#else
    a.ph_lo = 0; a.ph_hi = NPH; hipLaunchKernelGGL(mk_fwd, dim3(grid), dim3(NTHREADS), LDS_BYTES, stream, a);
#endif
}
```

```cpp
#include <hip/hip_runtime.h>
#include <cstdio>
#include <cstdint>

#ifndef PHMASK
#define PHMASK 0xFFFF
#endif
#ifndef PROBE_DUP
#define PROBE_DUP 0
#endif
#ifndef MK_MULTI
#define MK_MULTI 0
#endif

#define GAS __attribute__((address_space(1)))
#define LAS __attribute__((address_space(3)))
typedef unsigned short bf16;
typedef short bf16x8 __attribute__((ext_vector_type(8)));
typedef float f32x4 __attribute__((ext_vector_type(4)));
typedef float f32x2 __attribute__((ext_vector_type(2)));
typedef unsigned u32x4 __attribute__((ext_vector_type(4)));
typedef unsigned u32x2 __attribute__((ext_vector_type(2)));

constexpr int D = 2048, NB = 8, T = 4096, CTXL = 256, DEPTH = 2;
constexpr int NLAT = NB * T, NCTX = NB * CTXL, MALL = NLAT + NCTX;
constexpr int INC = 7424;
constexpr int OFF_U = 0, OFF_V = 512, OFF_Q = 1024, OFF_I = 1792, OFF_ZF = 2560, OFF_ZB = 3328, OFF_OG = 4096;
constexpr int OFF_C = 4864;
constexpr int BW = 768, CW = 768, CCOLS = 2560;
constexpr int NE = 16, DE = 1024;
constexpr int PC2W = 7 * 768;
constexpr int NTHREADS = 512;
constexpr float NORM_EPS = 1e-6f, GN_EPS = 64e-5f, DECAY_SCALE = 0.60653065971263342f;

constexpr size_t MiB = 1u << 20;
constexpr size_t WS_CTL = 0, CTL_ZERO_BYTES = 1 * MiB;
constexpr size_t WS_MOD = 1 * MiB;
constexpr size_t WS_SMALLW = 2 * MiB;
constexpr size_t SW_WUP = 0, SW_AUP = SW_WUP + (size_t)2 * 2 * 768 * 64 * 2, SW_GUP = SW_AUP + (size_t)2 * 768 * 64 * 2, SW_GWS = SW_GUP + (size_t)2 * 768 * 128 * 2;
constexpr size_t WS_WIN = 4 * MiB, WS_WOUT = 62 * MiB, WS_WGU = 78 * MiB, WS_WDN = 206 * MiB;
constexpr size_t WS_X = 270 * MiB, WS_H = 542 * MiB, WS_Y = 678 * MiB, WS_P = 814 * MiB, WS_PRE = 1307 * MiB, WS_VT = 1817 * MiB, WS_OC = 1868 * MiB, WS_HQB = 1970 * MiB, WS_HG = 2021 * MiB, WS_END = 2028 * MiB;
constexpr int PRE_REC = 10240, PR_WP = 0, PR_RP = 2048, PR_BK = 4096, PR_ARBK = 8192, PR_MAK = 9216, PR_GAM = 9728, NCHUNK16 = 272;
constexpr size_t WS_OB = WS_H;
constexpr size_t WS_ACT = WS_P, WS_YK = WS_P + 144 * MiB, WS_RIDX = WS_P + 416 * MiB, WS_RW = WS_RIDX + 3 * MiB;
static_assert(WS_RW + 3 * MiB <= WS_PRE, "moe overlay");
constexpr int MAXSLOT_TILES = 288;
constexpr int CW_BAR = 4096;
constexpr int CW_PREPQ = 28672;
constexpr int CW_CNT = 16384;

constexpr int LDS_STAGE = 0, LDS_TAB = 131072, LDS_TABW = LDS_TAB + 9 * 1024, LDS_TP = LDS_TABW + 9 * 1024, LDS_MISC = 150528, LDS_BYTES = 152 * 1024;
static_assert(LDS_TP + 128 <= LDS_MISC, "lds map");

typedef __bf16 bf16x2_t __attribute__((ext_vector_type(2)));
__device__ __forceinline__ unsigned pk2(float lo, float hi) { const f32x2 v = {lo, hi}; return __builtin_bit_cast(unsigned, __builtin_convertvector(v, bf16x2_t)); }
__device__ __forceinline__ unsigned f2bf(float f) { return pk2(f, f) & 0xffffu; }
__device__ __forceinline__ float bflo(unsigned u) { return __builtin_bit_cast(float, u << 16); }
__device__ __forceinline__ float bfhi(unsigned u) { return __builtin_bit_cast(float, u & 0xffff0000u); }
__device__ __forceinline__ float bf1(bf16 b) { return __builtin_bit_cast(float, ((unsigned)b) << 16); }
__device__ __forceinline__ float sigmoidf_(float x) { return __builtin_amdgcn_rcpf(1.0f + __expf(-x)); }
__device__ __forceinline__ float siluf_(float x) { return x * __builtin_amdgcn_rcpf(1.0f + __expf(-x)); }
__device__ __forceinline__ float geluf_(float v) {
    const float av = fabsf(v), t = __builtin_amdgcn_rcpf(av * 0.2316418882f + 1.0f);
    float q = t * 0.5307027145f + (-0.7265760135f); q = q * t + 0.7107068705f; q = q * t + (-0.142248368f); q = q * t + 0.127414796f; q = q * t;
    const float e = __builtin_amdgcn_exp2f((v * v) * (-0.72134752044f)); const float m = v * (q * e); return v < 0.f ? m : v - m; }
__device__ __forceinline__ float wave_sum(float v) {
#pragma unroll
    for (int o = 1; o < 64; o <<= 1) v += __shfl_xor(v, o);
    return v;
}
__device__ __forceinline__ int tid_fresh() { int t = threadIdx.x; asm volatile("" : "+v"(t)); return t; }
__device__ __forceinline__ void unpack8(const u32x4 v, float (&f)[8]) {
    f[0] = bflo(v.x); f[1] = bfhi(v.x); f[2] = bflo(v.y); f[3] = bfhi(v.y); f[4] = bflo(v.z); f[5] = bfhi(v.z); f[6] = bflo(v.w); f[7] = bfhi(v.w);
}
__device__ __forceinline__ u32x4 pack8(const float (&f)[8]) { u32x4 v; v.x = pk2(f[0], f[1]); v.y = pk2(f[2], f[3]); v.z = pk2(f[4], f[5]); v.w = pk2(f[6], f[7]); return v; }
__device__ __forceinline__ int modrow_of(int row) { return row < NLAT ? (row >> 12) : 8; }

#define XB_TMO      128
#define XB_XCNT(j)  (256  + 64 * (j))
#define XB_XSUB(j)  (1280 + 64 * (j))
#define XB_XGEN(j)  (2304 + 64 * (j))
#define XB_TOP      3328
#define XB_TOPGEN   3392
#define XCD_BAR_WORDS 3456
#define XB_SPIN_CAP (1u << 18)
__device__ __forceinline__ unsigned xb_ld(unsigned* p)              { return __hip_atomic_load(p, __ATOMIC_RELAXED, __HIP_MEMORY_SCOPE_AGENT); }
__device__ __forceinline__ unsigned xb_add(unsigned* p, unsigned v) { return __hip_atomic_fetch_add(p, v, __ATOMIC_RELAXED, __HIP_MEMORY_SCOPE_AGENT); }
__device__ __forceinline__ unsigned xb_xcc_id() { return (unsigned)__builtin_amdgcn_s_getreg((3 << 11) | 20) & 0xFu; }
#define XB_SPIN(cond, bar) do { unsigned _sp = 0; while (cond) { __builtin_amdgcn_s_sleep(1); \
    if ((++_sp & 255u) == 0u) { if (xb_ld(&(bar)[XB_TMO])) break; if (_sp > XB_SPIN_CAP) { atomicAdd(&(bar)[XB_TMO], 1u); break; } } } } while (0)
struct XcdBarrier { unsigned* bar; unsigned x; volatile LAS unsigned* st; };
__device__ __forceinline__ XcdBarrier xcd_barrier_post(unsigned* bar, volatile LAS unsigned* st) {
    XcdBarrier b; b.bar = bar; b.x = xb_xcc_id(); b.st = st;
    if (threadIdx.x == 0) (void)xb_add(&bar[XB_XCNT(b.x)], 1u);
    return b;
}
__device__ __forceinline__ void xcd_barrier_complete(unsigned* bar, unsigned x, unsigned& nloc, unsigned& nx) {
    const unsigned G = gridDim.x * gridDim.y * gridDim.z;
    unsigned sum, cnt, mine, sp = 0u;
    for (;;) {
        sum = 0u; cnt = 0u; mine = 0u;
#pragma unroll
        for (unsigned j = 0; j < 16; ++j) { const unsigned c = xb_ld(&bar[XB_XCNT(j)]); sum += c; cnt += (c > 0u) ? 1u : 0u; mine = (j == x) ? c : mine; }
        if (sum == G) break;
        __builtin_amdgcn_s_sleep(1);
        if ((++sp & 255u) == 0u) { if (xb_ld(&bar[XB_TMO])) break; if (sp > XB_SPIN_CAP) { atomicAdd(&bar[XB_TMO], 1u); break; } }
    }
    nloc = mine > 0u ? mine : 1u; nx = cnt > 0u ? cnt : 1u;
}
__device__ __forceinline__ void xcd_barrier(const XcdBarrier& b) {
    asm volatile("s_waitcnt vmcnt(0)" ::: "memory");
    __syncthreads();
    if (threadIdx.x == 0) {
        unsigned* bar = b.bar;
        __builtin_amdgcn_s_waitcnt(0);
        unsigned nloc = b.st[0], nx = b.st[1];
        if (nloc == 0u) { xcd_barrier_complete(bar, b.x, nloc, nx); b.st[0] = nloc; b.st[1] = nx; }
        const unsigned old = xb_add(&bar[XB_XSUB(b.x)], 1u);
        const unsigned gen = old / nloc;
        if (old + 1u == (gen + 1u) * nloc) {
            __builtin_amdgcn_fence(__ATOMIC_RELEASE, "agent");
            asm volatile("s_waitcnt vmcnt(0)" ::: "memory");
            const unsigned og = xb_add(&bar[XB_TOP], 1u);
            const unsigned tg = og / nx;
            if (og + 1u == (tg + 1u) * nx) xb_add(&bar[XB_TOPGEN], 1u);
            else XB_SPIN(xb_ld(&bar[XB_TOPGEN]) == tg, bar);
            __builtin_amdgcn_fence(__ATOMIC_ACQUIRE, "agent");
            xb_add(&bar[XB_XGEN(b.x)], 1u);
            asm volatile("s_waitcnt vmcnt(0)" ::: "memory");
        } else {
            XB_SPIN(xb_ld(&bar[XB_XGEN(b.x)]) == gen, bar);
            __builtin_amdgcn_fence(__ATOMIC_ACQUIRE, "agent");
            asm volatile("s_waitcnt vmcnt(0)" ::: "memory");
        }
    }
    __syncthreads();
}

namespace pg8 {
constexpr int BM = 256, BK = 64, HALF = 128, HTB = HALF * BK * 2, STAGE_BYTES = 8 * HTB, NXCD = 8, WGM = 8;
__host__ __device__ __forceinline__ int lds_byte(int r, int c) { const int st = (r >> 4) * 2 + (c >> 5), rr = r & 15, cc = c & 31, ob = rr * 64 + cc * 2; return st * 1024 + (ob ^ (((ob >> 9) & 1) << 5)); }
__host__ __device__ __forceinline__ void stage_rc(int b, int& R, int& C) { const int st = b / 1024, sb = b % 1024, swz = sb ^ (((sb >> 9) & 1) << 5); R = (st >> 1) * 16 + swz / 64; C = (st & 1) * 32 + (swz % 64) / 2; }
__host__ __device__ __forceinline__ int perm32(int rho) { const int n = rho >> 4, i = rho & 15; return 8 * (i >> 2) + 4 * n + (i & 3); }

struct Unit { int pm, pn, e, aux; };
struct Gemm { const bf16* A; const bf16* Bt; int M, N, K; };

struct StaticOrder {
    int nM, nN, nwg, G, c;
    __device__ void init(int M, int N, int G_, int c_) { nM = M / BM; nN = N / BM; nwg = nM * nN; G = G_; c = c_; }
    __device__ bool next(int i, Unit& u) const {
        const long L = (long)i * G + c; if (L >= nwg) return false;
        int wgid = (int)L; { const int q = nwg / NXCD, r = nwg % NXCD, xcd = wgid % NXCD, off = wgid / NXCD; wgid = (xcd < r ? xcd * (q + 1) : r * (q + 1) + (xcd - r) * q) + off; }
        const int nig = WGM * nN, gid = wgid / nig, fm = gid * WGM, gsz = (nM - fm) < WGM ? (nM - fm) : WGM;
        u.pm = fm + ((wgid % nig) % gsz); u.pn = (wgid % nig) / gsz; u.e = 0; u.aux = 0; return true;
    }
    __device__ __forceinline__ unsigned b_off(const Unit& u, unsigned tstep) const { return (unsigned)u.pn * tstep; }
};
struct MoeOrder {
    const LAS int* tp; int G, c; unsigned estride;
    __device__ bool next(int i, Unit& u) const {
        const int L = i * G + c; const int ntot = tp[16] * 8; if (L >= ntot) return false;
        const int tile = L >> 3; int e = 0;
#pragma unroll
        for (int j = 1; j < 16; ++j) e += (tile >= tp[j]) ? 1 : 0;
        u.pm = tile; u.pn = L & 7; u.e = e; u.aux = i; return true;
    }
    __device__ __forceinline__ unsigned b_off(const Unit& u, unsigned tstep) const { return (unsigned)u.e * estride + (unsigned)u.pn * tstep; }
};

#define PG8_LAS __attribute__((address_space(3)))
template <class Epi, class Sched, bool ALIGN_EPI, bool GATHER>
__device__ __forceinline__ void gemm_phase(PG8_LAS unsigned char* lds, const Gemm g, const Sched& S, const Epi& E, const PG8_LAS unsigned* tabA) {
    const int tid = tid_fresh(), wid = __builtin_amdgcn_readfirstlane(tid >> 6), lane = tid & 63, wr = wid >> 2, wc = wid & 3, fr = lane & 15, fq = lane >> 4;
    const int K = g.K, nt = K / BK;
    int sR[2], sC[2];
    unsigned voffB[2];
#pragma unroll
    for (int i = 0; i < 2; ++i) { int R, C; stage_rc(tid * 16 + i * 8192, R, C); sR[i] = R; sC[i] = C; const int Rb = Epi::PERM ? ((R & ~31) + perm32(R & 31)) : R;
        voffB[i] = (unsigned)(Rb * K + C) * 2u; }
    const unsigned kstep = (unsigned)(BK * 2);
    const unsigned hstep = (unsigned)(HALF * K * 2);
    const unsigned tstep = 2u * hstep;
    const unsigned ldsw = (unsigned)wid * 1024u;
    const char* const baseA = (const char*)g.A; const char* const baseB = (const char*)g.Bt;
    const int aoff = lds_byte(wr * 64 + fr, fq * 8), boff = lds_byte(wc * 32 + fr, fq * 8);
#define PG8_SA(b, h) (((b) * 2 + (h)) * HTB)
#define PG8_SB(b, h) ((4 + (b) * 2 + (h)) * HTB)
#define PG8_STAGE(bufoff, gbase, uoff, voff) do { _Pragma("unroll") for (int _i = 0; _i < 2; ++_i) \
        __builtin_amdgcn_global_load_lds((const unsigned*)((gbase) + (size_t)(unsigned)((uoff) + (voff)[_i])), (PG8_LAS unsigned*)(lds + (bufoff) + ldsw + _i * 8192), 16, 0, 0); } while (0)
#define PG8_LDA(dst, b, h) do { _Pragma("unroll") for (int m = 0; m < 4; ++m) _Pragma("unroll") for (int k = 0; k < 2; ++k) dst[m][k] = *(const PG8_LAS bf16x8*)(lds + PG8_SA(b, h) + aoff + m * 2048 + k * 1024); } while (0)
#define PG8_LDB(dst, b, h) do { _Pragma("unroll") for (int n = 0; n < 2; ++n) _Pragma("unroll") for (int k = 0; k < 2; ++k) dst[n][k] = *(const PG8_LAS bf16x8*)(lds + PG8_SB(b, h) + boff + n * 2048 + k * 1024); } while (0)
#define PG8_MMA(ai, bj, At, Bt) do { __builtin_amdgcn_s_setprio(1); _Pragma("unroll") for (int m = 0; m < 4; ++m) _Pragma("unroll") for (int n = 0; n < 2; ++n) _Pragma("unroll") for (int k = 0; k < 2; ++k) \
        acc[ai][bj][m][n] = __builtin_amdgcn_mfma_f32_16x16x32_bf16(Bt[n][k], At[m][k], acc[ai][bj][m][n], 0, 0, 0); __builtin_amdgcn_s_setprio(0); } while (0)
#define PG8_WAIT_V(n) asm volatile("s_waitcnt vmcnt(" #n ")" ::: "memory")
#define PG8_WAIT_L(n) asm volatile("s_waitcnt lgkmcnt(" #n ")" ::: "memory")
#define PG8_BAR __builtin_amdgcn_s_barrier()
#define PG8_SCHED __builtin_amdgcn_sched_barrier(0)
    Unit cur, nxt; int ui = 0;
    if (!S.next(0, cur)) return;
    f32x4 acc[2][2][4][2];
#pragma unroll
    for (int a = 0; a < 2; ++a)
#pragma unroll
        for (int b = 0; b < 2; ++b)
#pragma unroll
            for (int m = 0; m < 4; ++m)
#pragma unroll
                for (int n = 0; n < 2; ++n) acc[a][b][m][n] = (f32x4){0.f, 0.f, 0.f, 0.f};
    bf16x8 At[4][2], B0[2][2], B1[2][2];
    unsigned vA0[2], vA1[2], nA0[2], nA1[2];
    unsigned uA, uB = S.b_off(cur, tstep);
    if constexpr (GATHER) { uA = 0u;
#pragma unroll
        for (int i = 0; i < 2; ++i) { vA0[i] = tabA[cur.aux * 256 + sR[i]] + (unsigned)sC[i] * 2u; vA1[i] = tabA[cur.aux * 256 + 128 + sR[i]] + (unsigned)sC[i] * 2u; }
    } else { uA = (unsigned)cur.pm * tstep;
#pragma unroll
        for (int i = 0; i < 2; ++i) { vA0[i] = (unsigned)(sR[i] * K + sC[i]) * 2u; vA1[i] = vA0[i] + hstep; }
    }
    PG8_STAGE(PG8_SB(0, 0), baseB, uB, voffB); PG8_STAGE(PG8_SB(0, 1), baseB, uB + hstep, voffB); PG8_STAGE(PG8_SA(0, 0), baseA, uA, vA0); PG8_STAGE(PG8_SA(0, 1), baseA, uA, vA1);
    if (wr == 1) PG8_BAR;
    PG8_WAIT_V(2); PG8_BAR;
    PG8_STAGE(PG8_SB(1, 0), baseB, uB + kstep, voffB); PG8_STAGE(PG8_SA(1, 0), baseA, uA + kstep, vA0); PG8_STAGE(PG8_SB(1, 1), baseB, uB + hstep + kstep, voffB);
    PG8_WAIT_V(6); PG8_BAR;
    for (;;) {
        const bool has_next = S.next(ui + 1, nxt);
        unsigned nuA, nuB = has_next ? S.b_off(nxt, tstep) : uB;
        if constexpr (GATHER) { nuA = 0u;
#pragma unroll
            for (int i = 0; i < 2; ++i) { if (has_next) { nA0[i] = tabA[nxt.aux * 256 + sR[i]] + (unsigned)sC[i] * 2u; nA1[i] = tabA[nxt.aux * 256 + 128 + sR[i]] + (unsigned)sC[i] * 2u; } else { nA0[i] = vA0[i]; nA1[i] = vA1[i]; } }
        } else { nuA = has_next ? (unsigned)nxt.pm * tstep : uA;
#pragma unroll
            for (int i = 0; i < 2; ++i) { nA0[i] = vA0[i]; nA1[i] = vA1[i]; }
        }
        for (int t = 0; t < nt; t += 2) {
            const bool last = (t == nt - 2);
            const unsigned a1 = uA + (unsigned)(t + 1) * kstep;
            const unsigned a2 = last ? nuA : uA + (unsigned)(t + 2) * kstep; const unsigned b2 = last ? nuB : uB + (unsigned)(t + 2) * kstep;
            const unsigned a3 = a2 + kstep; const unsigned b3 = b2 + kstep;
            unsigned w0[2], w1[2];
#pragma unroll
            for (int i = 0; i < 2; ++i) { w0[i] = (GATHER && last) ? nA0[i] : vA0[i]; w1[i] = (GATHER && last) ? nA1[i] : vA1[i]; }
            PG8_LDB(B0, 0, 0); PG8_LDB(B1, 0, 1); PG8_SCHED; PG8_LDA(At, 0, 0); PG8_STAGE(PG8_SA(1, 1), baseA, a1, vA1);
            PG8_WAIT_V(8); PG8_WAIT_L(0); PG8_BAR; PG8_MMA(0, 0, At, B0); PG8_MMA(0, 1, At, B1); PG8_BAR; PG8_SCHED;
            PG8_LDA(At, 0, 1); PG8_STAGE(PG8_SB(0, 0), baseB, b2, voffB); PG8_STAGE(PG8_SB(0, 1), baseB, b2 + hstep, voffB); PG8_STAGE(PG8_SA(0, 0), baseA, a2, w0);
            PG8_WAIT_V(8); PG8_WAIT_L(0); PG8_BAR; PG8_MMA(1, 0, At, B0); PG8_MMA(1, 1, At, B1); PG8_BAR; PG8_SCHED;
            PG8_LDB(B0, 1, 0); PG8_LDB(B1, 1, 1); PG8_SCHED; PG8_LDA(At, 1, 0); PG8_STAGE(PG8_SA(0, 1), baseA, a2, w1);
            PG8_WAIT_V(8); PG8_WAIT_L(0); PG8_BAR; PG8_MMA(0, 0, At, B0); PG8_MMA(0, 1, At, B1); PG8_BAR; PG8_SCHED;
            PG8_LDA(At, 1, 1); PG8_STAGE(PG8_SB(1, 0), baseB, b3, voffB); PG8_STAGE(PG8_SB(1, 1), baseB, b3 + hstep, voffB); PG8_STAGE(PG8_SA(1, 0), baseA, a3, w0);
            PG8_WAIT_V(8); PG8_WAIT_L(0); PG8_BAR; PG8_MMA(1, 0, At, B0); PG8_MMA(1, 1, At, B1); PG8_BAR; PG8_SCHED;
        }
        if constexpr (ALIGN_EPI) { if (wr == 0) PG8_BAR; }
        E(acc, cur, wr, wc, fr, fq);
        if (!has_next) break;
#pragma unroll
        for (int a = 0; a < 2; ++a)
#pragma unroll
            for (int b = 0; b < 2; ++b)
#pragma unroll
                for (int m = 0; m < 4; ++m)
#pragma unroll
                    for (int n = 0; n < 2; ++n) acc[a][b][m][n] = (f32x4){0.f, 0.f, 0.f, 0.f};
        cur = nxt; uA = nuA; uB = nuB; ++ui;
#pragma unroll
        for (int i = 0; i < 2; ++i) { vA0[i] = nA0[i]; vA1[i] = nA1[i]; }
        if constexpr (ALIGN_EPI) { if (wr == 1) PG8_BAR; }
    }
    PG8_WAIT_V(0);
    if constexpr (!ALIGN_EPI) { if (wr == 0) PG8_BAR; }
    PG8_BAR;
#undef PG8_SA
#undef PG8_SB
#undef PG8_STAGE
#undef PG8_LDA
#undef PG8_LDB
#undef PG8_MMA
#undef PG8_WAIT_V
#undef PG8_WAIT_L
#undef PG8_BAR
#undef PG8_SCHED
}

__device__ __forceinline__ unsigned cvt_pk_bf16(float lo, float hi) { return pk2(lo, hi); }

struct EpiBf16 {
    static constexpr bool PERM = true;
    bf16* O; int ldc;
    __device__ __forceinline__ void operator()(const f32x4 (&acc)[2][2][4][2], const Unit& u, int wr, int wc, int fr, int fq) const {
        const int row0 = u.pm * BM + wr * 64 + fr; const int col0 = u.pn * BM + wc * 32 + 8 * fq;
#pragma unroll
        for (int ai = 0; ai < 2; ++ai)
#pragma unroll
            for (int m = 0; m < 4; ++m) { bf16* rowp = O + (size_t)(row0 + ai * HALF + m * 16) * ldc + col0;
#pragma unroll
                for (int bj = 0; bj < 2; ++bj) { const f32x4 v0 = acc[ai][bj][m][0], v1 = acc[ai][bj][m][1];
                    u32x4 w; w.x = cvt_pk_bf16(v0[0], v0[1]); w.y = cvt_pk_bf16(v0[2], v0[3]); w.z = cvt_pk_bf16(v1[0], v1[1]); w.w = cvt_pk_bf16(v1[2], v1[3]);
                    *(u32x4*)(rowp + bj * HALF) = w; } }
    }
};
struct EpiResid {
    static constexpr bool PERM = false;
    const float* xl; const float* xc; float* out; const float* gate;
    __device__ __forceinline__ void operator()(const f32x4 (&acc)[2][2][4][2], const Unit& u, int wr, int wc, int fr, int fq) const {
        const int rt = u.pm * BM; const bool isl = rt < NLAT;
        const float* base = isl ? xl + (size_t)rt * D : xc + (size_t)(rt - NLAT) * D;
        const float* gp = gate + (size_t)(isl ? (rt >> 12) : 8) * 12288;
        const int rl0 = wr * 64 + fr, col0 = u.pn * BM + wc * 32 + 4 * fq;
#pragma unroll
        for (int ai = 0; ai < 2; ++ai)
#pragma unroll
            for (int m = 0; m < 4; ++m) { const int rl = rl0 + ai * HALF + m * 16; const float* bp = base + (size_t)rl * D + col0; float* op = out + (size_t)(rt + rl) * D + col0;
#pragma unroll
                for (int bj = 0; bj < 2; ++bj)
#pragma unroll
                    for (int n = 0; n < 2; ++n) { const f32x4 b = *(const f32x4*)(bp + bj * HALF + n * 16); const f32x4 gv = *(const f32x4*)(gp + col0 + bj * HALF + n * 16); *(f32x4*)(op + bj * HALF + n * 16) = b + gv * acc[ai][bj][m][n]; }
                asm volatile("" ::: "memory"); }
    }
};
struct EpiSwiglu {
    static constexpr bool PERM = true;
    bf16* O;
    __device__ __forceinline__ void operator()(const f32x4 (&acc)[2][2][4][2], const Unit& u, int wr, int wc, int fr, int fq) const {
        const int row0 = u.pm * BM + wr * 64 + fr; const int col0 = u.pn * 128 + wc * 32 + 8 * fq;
#pragma unroll
        for (int ai = 0; ai < 2; ++ai)
#pragma unroll
            for (int m = 0; m < 4; ++m) { bf16* rowp = O + (size_t)(row0 + ai * HALF + m * 16) * DE + col0;
                float o[8];
#pragma unroll
                for (int n = 0; n < 2; ++n)
#pragma unroll
                    for (int j = 0; j < 4; ++j) { const float gt = acc[ai][0][m][n][j], up = acc[ai][1][m][n][j]; o[n * 4 + j] = gt * __builtin_amdgcn_rcpf(1.0f + __expf(-gt)) * up; }
                u32x4 w; w.x = cvt_pk_bf16(o[0], o[1]); w.y = cvt_pk_bf16(o[2], o[3]); w.z = cvt_pk_bf16(o[4], o[5]); w.w = cvt_pk_bf16(o[6], o[7]);
                *(u32x4*)rowp = w; }
    }
};
struct EpiDown {
    static constexpr bool PERM = true;
    bf16* YK; const PG8_LAS unsigned* tab; const PG8_LAS float* tabw;
    __device__ __forceinline__ void operator()(const f32x4 (&acc)[2][2][4][2], const Unit& u, int wr, int wc, int fr, int fq) const {
        const int rl0 = wr * 64 + fr; const int col0 = u.pn * BM + wc * 32 + 8 * fq;
#pragma unroll
        for (int ai = 0; ai < 2; ++ai)
#pragma unroll
            for (int m = 0; m < 4; ++m) { const int rl = rl0 + ai * HALF + m * 16; const unsigned ent = tab[u.aux * 256 + rl]; const float w = tabw[u.aux * 256 + rl];
                if (!(ent & 0x40000000u)) { bf16* rowp = YK + ((size_t)(ent >> 31) * MALL + (ent & 0xffffu)) * D + col0;
#pragma unroll
                    for (int bj = 0; bj < 2; ++bj) { const f32x4 v0 = acc[ai][bj][m][0] * w, v1 = acc[ai][bj][m][1] * w;
                        u32x4 q; q.x = cvt_pk_bf16(v0[0], v0[1]); q.y = cvt_pk_bf16(v0[2], v0[3]); q.z = cvt_pk_bf16(v1[0], v1[1]); q.w = cvt_pk_bf16(v1[2], v1[3]);
                        *(u32x4*)(rowp + bj * HALF) = q; } }
                asm volatile("" ::: "memory"); }
    }
};
}

struct Args { const float* in[31]; float* out; unsigned char* ws; int ph_lo, ph_hi; };
typedef const __attribute__((address_space(4))) Args* KArgs;
__device__ __forceinline__ KArgs kargs() { KArgs p = (KArgs)__builtin_amdgcn_kernarg_segment_ptr(); asm volatile("" : "+s"(p)); return p; }
#define AIN(i) (a->in[i])
enum { I_X = 0, I_C, I_CTX, I_CCTX, I_ADAW, I_ADAB, I_N1G, I_N2G, I_WIN, I_WOUT, I_GNG, I_GWS, I_GB, I_LB, I_HNG, I_MU, I_W0, I_WUP, I_A0, I_AUP, I_GUP, I_KK, I_KA, I_RK, I_GNGG, I_GNB, I_RW, I_RB, I_WGU, I_WDN, I_FNG };

__device__ __forceinline__ void p0_transpose_item(const float* W, int K, int N, bf16* WT, int n_row0, LAS float* scr, int kb, int nb, int lane) {
    const int k0 = 64 * kb, n0 = 32 * nb;
#pragma unroll 8
    for (int i = 0; i < 32; ++i) { const int kk = 2 * i + (lane >> 5); scr[kk * 33 + (lane & 31)] = W[(size_t)(k0 + kk) * N + n0 + (lane & 31)]; }
    asm volatile("s_waitcnt lgkmcnt(0)" ::: "memory");
    const int c = lane & 7;
#pragma unroll
    for (int j = 0; j < 4; ++j) { const int n = (lane >> 3) + 8 * j; const LAS float* s = scr + (8 * c) * 33 + n;
        u32x4 o; o.x = pk2(s[0 * 33], s[1 * 33]); o.y = pk2(s[2 * 33], s[3 * 33]); o.z = pk2(s[4 * 33], s[5 * 33]); o.w = pk2(s[6 * 33], s[7 * 33]);
        *(u32x4*)(WT + (size_t)(n_row0 + n) * K + k0 + 8 * c) = o; }
    asm volatile("s_waitcnt lgkmcnt(0)" ::: "memory");
}

__device__ __forceinline__ void convert_moe(KArgs a, int l, LAS unsigned char* lds) {
    const int tid = tid_fresh(), lane = tid & 63, wave = tid >> 6;
    const int gw = blockIdx.x * 8 + wave, NGW = gridDim.x * 8;
    unsigned char* ws = a->ws;
    LAS float* scr = (LAS float*)(lds + wave * 16384);
    constexpr int I_GU = 32 * 64, I_DN = 16 * 64, N2 = 16 * I_GU, N3 = N2 + 16 * I_DN;
    for (int it = gw; it < N3; it += NGW) {
        if (it < N2) { const int e = it / I_GU, r = it % I_GU, kb = r / 64, nb = r % 64;
            const int n0 = 32 * nb, hh = n0 >> 10, nn = n0 & 1023, row0 = 256 * (nn >> 7) + 128 * hh + (nn & 127);
            p0_transpose_item(a->in[I_WGU] + (size_t)(l * NE + e) * D * 2048, D, 2048, (bf16*)(ws + WS_WGU) + (size_t)e * 2048 * D, row0, scr, kb, nb, lane); }
        else { const int q = it - N2, e = q / I_DN, r = q % I_DN, kb = r / 64, nb = r % 64;
            p0_transpose_item(a->in[I_WDN] + (size_t)(l * NE + e) * DE * D, DE, D, (bf16*)(ws + WS_WDN) + (size_t)e * D * DE, 32 * nb, scr, kb, nb, lane); }
    }
}
__device__ __forceinline__ void phase_prologue(KArgs a, LAS unsigned char* lds) {
    const int tid = tid_fresh(), lane = tid & 63, wave = tid >> 6;
    const int G = gridDim.x, gw = blockIdx.x * 8 + wave, NGW = G * 8;
    unsigned char* ws = a->ws;
    LAS float* scr = (LAS float*)(lds + wave * 16384);
    constexpr int I_IN = 32 * 232, I_OUT = 32 * 64;
    constexpr int N0 = 2 * I_IN, N1 = N0 + 2 * I_OUT;
    for (int it = gw; it < N1; it += NGW) {
        if (it < N0) { const int l = it / I_IN, r = it % I_IN, kb = r / 232, nb = r % 232;
            p0_transpose_item(a->in[I_WIN] + (size_t)l * D * INC, D, INC, (bf16*)(ws + WS_WIN) + (size_t)l * INC * D, 32 * nb, scr, kb, nb, lane); }
        else { const int q = it - N0, l = q / I_OUT, r = q % I_OUT, kb = r / 64, nb = r % 64;
            p0_transpose_item(a->in[I_WOUT] + (size_t)l * D * D, D, D, (bf16*)(ws + WS_WOUT) + (size_t)l * D * D, 32 * nb, scr, kb, nb, lane); }
    }
    convert_moe(a, 0, lds);
    {
        const int gt = blockIdx.x * NTHREADS + tid, NGT = G * NTHREADS;
        bf16* wup = (bf16*)(ws + WS_SMALLW + SW_WUP); bf16* aup = (bf16*)(ws + WS_SMALLW + SW_AUP); bf16* gup = (bf16*)(ws + WS_SMALLW + SW_GUP); bf16* gws = (bf16*)(ws + WS_SMALLW + SW_GWS);
        for (int i = gt; i < 2 * 2 * 768 * 64; i += NGT) { const int k = i & 63, n = (i >> 6) % 768, ld = i / (768 * 64); wup[i] = (bf16)f2bf(a->in[I_WUP][((size_t)ld * 64 + k) * 768 + n]); }
        for (int i = gt; i < 2 * 768 * 64; i += NGT) { const int k = i & 63, n = (i >> 6) % 768, l = i / (768 * 64); aup[i] = (bf16)f2bf(a->in[I_AUP][((size_t)l * 64 + k) * 768 + n]); }
        for (int i = gt; i < 2 * 768 * 128; i += NGT) { const int k = i & 127, n = (i >> 7) % 768, l = i / (768 * 128); gup[i] = (bf16)f2bf(a->in[I_GUP][((size_t)l * 128 + k) * 768 + n]); }
        for (int i = gt; i < 2 * 4 * 128 * 128; i += NGT) gws[i] = (bf16)f2bf(a->in[I_GWS][i]);
    }
    __syncthreads();
    {
        LAS float* sv = (LAS float*)lds;
        LAS float* red = (LAS float*)(lds + 73728);
        for (int i = tid; i < 9 * D; i += NTHREADS) { const int r = i / D, k = i % D; const float v = r < 8 ? a->in[I_C][r * D + k] : a->in[I_CCTX][k]; sv[i] = siluf_(v); }
        __syncthreads();
        float* mod = (float*)(ws + WS_MOD);
        for (int it = blockIdx.x; it < 2 * 96; it += G) {
            const int l = it / 96, cb = it % 96, cq = tid & 31, kg = tid >> 5;
            const float* wp = a->in[I_ADAW] + (size_t)l * D * 12288 + (size_t)(kg * 128) * 12288 + cb * 128 + cq * 4;
            f32x4 acc[9];
#pragma unroll
            for (int r = 0; r < 9; ++r) acc[r] = (f32x4){0.f, 0.f, 0.f, 0.f};
#pragma unroll 4
            for (int k = 0; k < 128; ++k) { const f32x4 w = *(const f32x4*)(wp + (size_t)k * 12288);
#pragma unroll
                for (int r = 0; r < 9; ++r) acc[r] += w * sv[r * D + kg * 128 + k]; }
#pragma unroll
            for (int r = 0; r < 9; ++r) *(LAS f32x4*)(red + ((kg * 9 + r) * 128 + cq * 4)) = acc[r];
            __syncthreads();
            for (int o = tid; o < 9 * 128; o += NTHREADS) { const int r = o / 128, c = o % 128; float s = a->in[I_ADAB][(size_t)l * 12288 + cb * 128 + c];
#pragma unroll
                for (int q = 0; q < 16; ++q) s += red[(q * 9 + r) * 128 + c];
                mod[((size_t)l * 9 + r) * 12288 + cb * 128 + c] = s; }
            __syncthreads();
        }
    }
}

template <int MODE>
__device__ __forceinline__ void phase_norm1(KArgs a, int l, bool dry) {
    const int tid_ = tid_fresh(); const int lane = tid_ & 63, wave = tid_ >> 6, gw = blockIdx.x * 8 + wave, NGW = gridDim.x * 8;
    unsigned char* ws = a->ws;
    const float* mod = (const float*)(ws + WS_MOD);
    float* X = (float*)(ws + WS_X); bf16* H = (bf16*)(ws + WS_H); const bf16* YK = (const bf16*)(ws + WS_YK);
    float* Xo = dry ? (float*)(ws + WS_END) : X; bf16* Ho = dry ? (bf16*)(ws + WS_END) : H; float* Oo = dry ? (float*)(ws + WS_END) : a->out;
    const int nrows = (MODE == 2) ? NLAT : MALL;
    const int rpw = (nrows + NGW - 1) / NGW; const int r0 = gw * rpw, r1 = (r0 + rpw < nrows) ? r0 + rpw : nrows;
    f32x4 ck[8], cs[8], cg[8]; int cur_mr = -1;
    for (int row = r0; row < r1; ++row) {
        const int mr = modrow_of(row); const int orow = dry ? (row & 2047) : row;
        if (mr != cur_mr) { cur_mr = mr;
#pragma unroll
            for (int j = 0; j < 8; ++j) { const int c = 4 * lane + 256 * j;
                if (MODE == 2) ck[j] = *(const f32x4*)(a->in[I_FNG] + c);
                else { const float* m = mod + ((size_t)l * 9 + mr) * 12288; const f32x4 g = *(const f32x4*)(a->in[I_N1G] + (size_t)l * D + c); ck[j] = g * (*(const f32x4*)(m + D + c) + 1.0f); cs[j] = *(const f32x4*)(m + c); }
                if (MODE != 0) cg[j] = *(const f32x4*)(mod + ((size_t)(l - 1) * 9 + mr) * 12288 + 5 * D + c); } }
        f32x4 v[8];
        if (MODE == 0) { const float* xr = row < NLAT ? a->in[I_X] + (size_t)row * D : a->in[I_CTX] + (size_t)(row - NLAT) * D;
#pragma unroll
            for (int j = 0; j < 8; ++j) v[j] = *(const f32x4*)(xr + 4 * lane + 256 * j);
        } else {
            const float* xr = X + (size_t)row * D; const bf16* y0 = YK + (size_t)row * D; const bf16* y1 = YK + ((size_t)MALL + row) * D;
            u32x2 p0[8], p1[8];
#pragma unroll
            for (int j = 0; j < 8; ++j) { const int c = 4 * lane + 256 * j; v[j] = *(const f32x4*)(xr + c); p0[j] = *(const u32x2*)(y0 + c); p1[j] = *(const u32x2*)(y1 + c); }
#pragma unroll
            for (int j = 0; j < 8; ++j) { f32x4 f; f[0] = bflo(p0[j].x) + bflo(p1[j].x); f[1] = bfhi(p0[j].x) + bfhi(p1[j].x); f[2] = bflo(p0[j].y) + bflo(p1[j].y); f[3] = bfhi(p0[j].y) + bfhi(p1[j].y);
                v[j] = v[j] + cg[j] * f; }
            if (MODE == 1) {
#pragma unroll
                for (int j = 0; j < 8; ++j) *(f32x4*)(Xo + (size_t)orow * D + 4 * lane + 256 * j) = v[j];
            }
        }
        float ss = 0.f;
#pragma unroll
        for (int j = 0; j < 8; ++j) ss += (v[j][0] * v[j][0] + v[j][1] * v[j][1]) + (v[j][2] * v[j][2] + v[j][3] * v[j][3]);
        const float rstd = 1.0f / sqrtf(wave_sum(ss) * (1.0f / D) + NORM_EPS);
        if (MODE == 2) {
#pragma unroll
            for (int j = 0; j < 8; ++j) *(f32x4*)(Oo + (size_t)orow * D + 4 * lane + 256 * j) = v[j] * rstd * ck[j];
        } else {
#pragma unroll
            for (int j = 0; j < 8; ++j) { const f32x4 h = v[j] * rstd * ck[j] + cs[j]; u32x2 o; o.x = pk2(h[0], h[1]); o.y = pk2(h[2], h[3]); *(u32x2*)(Ho + (size_t)orow * D + 4 * lane + 256 * j) = o; }
        }
    }
}

__device__ __forceinline__ void phase_norm2_router(KArgs a, int l, bool dry, LAS unsigned char* lds) {
    const int tid_ = tid_fresh(); const int lane = tid_ & 63, wave = tid_ >> 6, gw = blockIdx.x * 8 + wave, NGW = gridDim.x * 8;
    unsigned char* ws = a->ws;
    const float* mod = (const float*)(ws + WS_MOD);
    const float* X = (const float*)(ws + WS_X); bf16* H = (bf16*)(ws + WS_H);
    unsigned* cnt = (unsigned*)(ws + WS_CTL) + CW_CNT + l * 16 * 64 + (dry ? 4096 : 0);
    unsigned* ridx = (unsigned*)(ws + (dry ? WS_END : WS_RIDX)); float* rwt = (float*)(ws + (dry ? WS_END + 4 * MiB : WS_RW)); bf16* Ho = dry ? (bf16*)(ws + WS_END + 8 * MiB) : H;
    const int nrows = (l == DEPTH - 1) ? NLAT : MALL;
    LAS f32x4* rwl = (LAS f32x4*)lds;
    { const float* rw = a->in[I_RW];
      for (int idx = tid_; idx < 8192; idx += NTHREADS) { const int ln = idx & 63, q = (idx >> 6) & 3, i = (idx >> 8) & 3, j = idx >> 10; rwl[idx] = *(const f32x4*)(rw + (size_t)(4 * ln + 256 * j + i) * 16 + 4 * q); } }
    __syncthreads();
    const int rpw = (nrows + NGW - 1) / NGW; const int r0 = gw * rpw, r1 = (r0 + rpw < nrows) ? r0 + rpw : nrows;
    f32x4 ck[8], cs[8]; int cur_mr = -1;
    float rb[16];
#pragma unroll
    for (int e = 0; e < 16; ++e) rb[e] = a->in[I_RB][e];
    for (int row = r0; row < r1; ++row) {
        const int mr = modrow_of(row); const int orow = dry ? (row & 2047) : row;
        if (mr != cur_mr) { cur_mr = mr; const float* m = mod + ((size_t)l * 9 + mr) * 12288;
#pragma unroll
            for (int j = 0; j < 8; ++j) { const int c = 4 * lane + 256 * j; const f32x4 g = *(const f32x4*)(a->in[I_N2G] + (size_t)l * D + c); ck[j] = g * (*(const f32x4*)(m + 4 * D + c) + 1.0f); cs[j] = *(const f32x4*)(m + 3 * D + c); } }
        const float* xr = X + (size_t)row * D;
        f32x4 v[8]; float ss = 0.f;
#pragma unroll
        for (int j = 0; j < 8; ++j) { v[j] = *(const f32x4*)(xr + 4 * lane + 256 * j); ss += (v[j][0] * v[j][0] + v[j][1] * v[j][1]) + (v[j][2] * v[j][2] + v[j][3] * v[j][3]); }
        const float rstd = 1.0f / sqrtf(wave_sum(ss) * (1.0f / D) + NORM_EPS);
        f32x4 lg4[4];
#pragma unroll
        for (int q = 0; q < 4; ++q) lg4[q] = (f32x4){0.f, 0.f, 0.f, 0.f};
#pragma unroll
        for (int j = 0; j < 8; ++j) { const f32x4 h = v[j] * rstd * ck[j] + cs[j]; u32x2 o; o.x = pk2(h[0], h[1]); o.y = pk2(h[2], h[3]); *(u32x2*)(Ho + (size_t)orow * D + 4 * lane + 256 * j) = o;
#pragma unroll
            for (int i = 0; i < 4; ++i)
#pragma unroll
                for (int q = 0; q < 4; ++q) lg4[q] += rwl[((j * 4 + i) * 4 + q) * 64 + lane] * h[i];
            asm volatile("" ::: "memory"); }
        float lg[16];
#pragma unroll
        for (int e = 0; e < 16; ++e) lg[e] = wave_sum(lg4[e >> 2][e & 3]) + rb[e];
        float mx = lg[0];
#pragma unroll
        for (int e = 1; e < 16; ++e) mx = fmaxf(mx, lg[e]);
        float p[16], sum = 0.f;
#pragma unroll
        for (int e = 0; e < 16; ++e) { p[e] = __expf(lg[e] - mx); sum += p[e]; }
        const float inv = 1.0f / sum;
#pragma unroll
        for (int e = 0; e < 16; ++e) p[e] *= inv;
        int sel = 0; float best = -1.f;
#pragma unroll
        for (int gI = 0; gI < 4; ++gI) { float m1 = -1.f, m2 = -1.f;
#pragma unroll
            for (int i = 0; i < 4; ++i) { const float q = p[4 * gI + i]; if (q > m1) { m2 = m1; m1 = q; } else if (q > m2) m2 = q; }
            const float s = m1 + m2; if (s > best) { best = s; sel = gI; } }
        int i1 = 0, i2 = 0; float p1 = -2.f, p2 = -2.f;
#pragma unroll
        for (int gI = 0; gI < 4; ++gI)
#pragma unroll
            for (int i = 0; i < 4; ++i) { const float q = (gI == sel) ? p[4 * gI + i] : -1.0f; const int e = 4 * gI + i;
                if (gI == sel) { if (q > p1) { p2 = p1; i2 = i1; p1 = q; i1 = e; } else if (q > p2) { p2 = q; i2 = e; } } }
        const float wsum = p1 + p2, w1 = p1 / wsum, w2 = p2 / wsum;
        if (lane == 0) {
            const unsigned q1 = atomicAdd(cnt + i1 * 64, 1u); ridx[(size_t)i1 * MALL + q1] = (unsigned)row; rwt[(size_t)i1 * MALL + q1] = w1;
            const unsigned q2 = atomicAdd(cnt + i2 * 64, 1u); ridx[(size_t)i2 * MALL + q2] = (unsigned)row | 0x80000000u; rwt[(size_t)i2 * MALL + q2] = w2;
        }
    }
    __syncthreads();
}

template <bool FOR_DOWN>
__device__ __forceinline__ void moe_tables(KArgs a, int l, LAS unsigned char* lds, int cvirt) {
    const int tid = tid_fresh(), G = gridDim.x;
    unsigned char* ws = a->ws;
    const unsigned* cnt = (const unsigned*)(ws + WS_CTL) + CW_CNT + l * 16 * 64;
    const unsigned* ridx = (const unsigned*)(ws + WS_RIDX); const float* rwt = (const float*)(ws + WS_RW);
    LAS int* tp = (LAS int*)(lds + LDS_TP); LAS unsigned* tab = (LAS unsigned*)(lds + LDS_TAB); LAS float* tabw = (LAS float*)(lds + LDS_TABW);
    if (tid == 0) { int acc = 0; for (int e = 0; e < 16; ++e) { tp[e] = acc; acc += (int)((cnt[e * 64] + 255u) >> 8); } tp[16] = acc; }
    __syncthreads();
    const int ntot = tp[16] * 8;
    for (int i = 0; i < 9; ++i) { const int L = i * G + cvirt; if (L >= ntot) break;
        const int tile = L >> 3; int e = 0;
        for (int j = 1; j < 16; ++j) e += (tile >= tp[j]) ? 1 : 0;
        const int pos0 = (tile - tp[e]) * 256; const unsigned ce = cnt[e * 64];
        if (tid < 256) { const int pos = pos0 + tid; const bool valid = (unsigned)pos < ce; const unsigned ent = ridx[(size_t)e * MALL + (valid ? pos : 0)];
            if (FOR_DOWN) { tab[i * 256 + tid] = valid ? ent : (ent | 0x40000000u); tabw[i * 256 + tid] = valid ? rwt[(size_t)e * MALL + pos] : 0.f; }
            else tab[i * 256 + tid] = (ent & 0xffffu) * (unsigned)(D * 2); }
    }
    __syncthreads();
}

__device__ __forceinline__ void gmlp_item(KArgs a, int l, int item, LAS unsigned char* lds) {
    const int tid = tid_fresh(), lane = tid & 63, wave = tid >> 6;
    unsigned char* ws = a->ws;
    const bf16* P = (const bf16*)(ws + WS_P); bf16* Y = (bf16*)(ws + WS_Y);
    const int chunk = item >> 2, h = item & 3;
    const int row0 = chunk < 256 ? chunk * 128 : NLAT + (chunk - 256) * 128;
    LAS bf16* wsl = (LAS bf16*)lds;
    LAS bf16* vT = (LAS bf16*)(lds + 128 * 136 * 2);
    const bf16* gws = (const bf16*)(ws + WS_SMALLW + SW_GWS) + ((size_t)l * 4 + h) * 128 * 128;
    for (int p = tid; p < 2048; p += NTHREADS) { const int t = p >> 4, c8 = p & 15; *(LAS u32x4*)(wsl + t * 136 + c8 * 8) = *(const u32x4*)(gws + t * 128 + c8 * 8); }
    {
        const int s = tid >> 2, qd = tid & 3; const bf16* vp = P + (size_t)(row0 + s) * INC + OFF_V + h * 128 + qd * 32;
        float g[32]; float ss = 0.f;
#pragma unroll
        for (int q = 0; q < 4; ++q) { float f[8]; unpack8(*(const u32x4*)(vp + 8 * q), f);
#pragma unroll
            for (int j = 0; j < 8; ++j) { const float x = geluf_(f[j]); g[8 * q + j] = x; ss += x * x; } }
        ss += __shfl_xor(ss, 1); ss += __shfl_xor(ss, 2);
        const float rstd = 1.0f / sqrtf(ss * (1.0f / 128.0f) + NORM_EPS);
        const float* ng = a->in[I_GNG] + (size_t)l * 512 + h * 128 + qd * 32;
#pragma unroll
        for (int j = 0; j < 32; ++j) vT[(qd * 32 + j) * 136 + s] = (bf16)f2bf(g[j] * rstd * ng[j]);
    }
    __syncthreads();
    f32x4 acc[8];
#pragma unroll
    for (int ct = 0; ct < 8; ++ct) acc[ct] = (f32x4){0.f, 0.f, 0.f, 0.f};
    const int fr = lane & 15, fq = lane >> 4;
#pragma unroll
    for (int ks = 0; ks < 4; ++ks) {
        const bf16x8 bfrag = *(const LAS bf16x8*)(wsl + (16 * wave + fr) * 136 + ks * 32 + fq * 8);
#pragma unroll
        for (int ct = 0; ct < 8; ++ct) { const bf16x8 afrag = *(const LAS bf16x8*)(vT + (16 * ct + fr) * 136 + ks * 32 + fq * 8);
            acc[ct] = __builtin_amdgcn_mfma_f32_16x16x32_bf16(afrag, bfrag, acc[ct], 0, 0, 0); }
    }
    const int t = 16 * wave + fr; const float wb = a->in[I_GB][((size_t)l * 4 + h) * 128 + t];
    const bf16* up = P + (size_t)(row0 + t) * INC + OFF_U + h * 128; bf16* yp = Y + (size_t)(row0 + t) * D + h * 128;
#pragma unroll
    for (int ct = 0; ct < 8; ++ct) { const int c = 16 * ct + 4 * fq; const u32x2 uu = *(const u32x2*)(up + c);
        const float y0 = geluf_(bflo(uu.x)) * (acc[ct][0] + wb), y1 = geluf_(bfhi(uu.x)) * (acc[ct][1] + wb), y2 = geluf_(bflo(uu.y)) * (acc[ct][2] + wb), y3 = geluf_(bfhi(uu.y)) * (acc[ct][3] + wb);
        u32x2 o; o.x = pk2(y0, y1); o.y = pk2(y2, y3); *(u32x2*)(yp + c) = o; }
    __syncthreads();
}

constexpr int SP_ = 72;
__device__ __forceinline__ int kperm_pos(int k) { const int s5 = k & 31; return (k & 32) + 8 * ((s5 >> 2) & 3) + 4 * (s5 >> 4) + (s5 & 3); }
__device__ __forceinline__ void rwkv_prep_item(KArgs a, int l, int tile, int hgrp, LAS unsigned char* lds) {
    const int tid = tid_fresh(), lane = tid & 63, wave = tid >> 6;
    unsigned char* ws = a->ws;
    const bf16* P = (const bf16*)(ws + WS_P); bf16* Y = (bf16*)(ws + WS_Y);
    LAS bf16* SR = (LAS bf16*)lds; LAS bf16* SK = SR + 64 * SP_; LAS bf16* SV = SK + 64 * SP_; LAS bf16* SKK = SV + 64 * SP_; LAS bf16* SB = SKK + 64 * SP_; LAS bf16* SWF = SB + 64 * SP_; LAS bf16* SWB = SWF + 64 * SP_;
    LAS bf16* tw = SWB + 64 * SP_;
    LAS bf16* adl = tw + 64 * SP_;
    LAS bf16* sg = adl + 64 * SP_;
    LAS float* invn = (LAS float*)(sg + 64 * 136);
    LAS unsigned char* wpriv = (LAS unsigned char*)(invn + 64) + wave * 6144;
    const int row0 = tile * 64; const bool isl = row0 < NLAT;
    const float* mu = a->in[I_MU] + (size_t)l * CCOLS;
    const char* Pb = (const char*)P;
    auto shift_group = [&](int tk, int col, float (&z)[8]) {
        const int row = row0 + tk; int o0, o1, o2, o3; bool v0, v1, v2, v3;
        if (isl) { const int gr = (row >> 6) & 63; o0 = -1; o1 = 1; o2 = -64; o3 = 64; v0 = tk > 0; v1 = tk < 63; v2 = gr > 0; v3 = gr < 63; }
        else { const int tc = (row - NLAT) & 255; o0 = -1; o1 = 1; o2 = -1; o3 = 1; v0 = tc > 0; v1 = tc < 255; v2 = v0; v3 = v1; }
        const unsigned off = (unsigned)row * (unsigned)(INC * 2) + (unsigned)(OFF_C + col) * 2u;
        const u32x4 uo = *(const u32x4*)(Pb + off), u0 = *(const u32x4*)(Pb + (off + (unsigned)((v0 ? o0 : 0) * INC * 2))), u1 = *(const u32x4*)(Pb + (off + (unsigned)((v1 ? o1 : 0) * INC * 2))),
                    u2 = *(const u32x4*)(Pb + (off + (unsigned)((v2 ? o2 : 0) * INC * 2))), u3 = *(const u32x4*)(Pb + (off + (unsigned)((v3 ? o3 : 0) * INC * 2)));
        const f32x4 m0 = *(const f32x4*)(mu + col), m1 = *(const f32x4*)(mu + col + 4);
        float own[8], n0[8], n1[8], n2[8], n3[8]; unpack8(uo, own); unpack8(u0, n0); unpack8(u1, n1); unpack8(u2, n2); unpack8(u3, n3);
        const float f0 = v0 ? 1.f : 0.f, f1 = v1 ? 1.f : 0.f, f2 = v2 ? 1.f : 0.f, f3 = v3 ? 1.f : 0.f;
        const float nb[8] = {n0[0] * f0, n1[1] * f1, n2[2] * f2, n3[3] * f3, n0[4] * f0, n1[5] * f1, n2[6] * f2, n3[7] * f3};
#pragma unroll
        for (int j = 0; j < 8; ++j) { const float mm = j < 4 ? m0[j] : m1[j - 4]; z[j] = own[j] + mm * (nb[j] - own[j]); }
    };
#pragma unroll
    for (int it = 0; it < 4; ++it) { const int g = tid + NTHREADS * it, tk = g >> 5, gi = g & 31;
        float z[8]; shift_group(tk, 2304 + gi * 8, z);
        if (gi < 8) { float t8[8];
#pragma unroll
            for (int j = 0; j < 8; ++j) t8[j] = 1.0f - 2.0f * __builtin_amdgcn_rcpf(1.0f + __expf(2.0f * z[j]));
            *(LAS u32x4*)(tw + tk * SP_ + gi * 8) = pack8(t8); }
        else if (gi < 16) *(LAS u32x4*)(adl + tk * SP_ + (gi - 8) * 8) = pack8(z);
        else { float t8[8];
#pragma unroll
            for (int j = 0; j < 8; ++j) t8[j] = sigmoidf_(z[j]);
            *(LAS u32x4*)(sg + tk * 136 + (gi - 16) * 8) = pack8(t8); } }
    __syncthreads();
#pragma unroll 1
    for (int hh = 0; hh < 4; ++hh) {
    const int tid = tid_fresh(), lane = tid & 63, wave = tid >> 6;
    const int head = 4 * hgrp + hh; const float* kkw = a->in[I_KK] + (size_t)l * CW + head * 64;
#pragma unroll
    for (int it = 0; it < 3; ++it) { const int g = tid + NTHREADS * it, tk = g / 24, gi = g % 24, c8 = (gi & 7) * 8;
        float z[8]; shift_group(tk, (gi >> 3) * 768 + head * 64 + c8, z);
        if (gi < 8) *(LAS u32x4*)(SR + tk * SP_ + c8) = pack8(z);
        else if (gi < 16) { *(LAS u32x4*)(SK + tk * SP_ + c8) = pack8(z);
            const f32x4 k0 = *(const f32x4*)(kkw + c8), k1 = *(const f32x4*)(kkw + c8 + 4); float ss = 0.f;
#pragma unroll
            for (int j = 0; j < 8; ++j) { const float q = z[j] * (j < 4 ? k0[j] : k1[j - 4]); ss += q * q; }
            ss += __shfl_xor(ss, 1); ss += __shfl_xor(ss, 2); ss += __shfl_xor(ss, 4);
            if ((gi & 7) == 0) invn[tk] = 1.0f / fmaxf(sqrtf(ss), 1e-12f); }
        else *(LAS u32x4*)(SV + tk * SP_ + c8) = pack8(z); }
    __syncthreads();
    {
        const int fr = lane & 15, fq = lane >> 4, nt = wave & 3, th = wave >> 2;
        const bf16* wupT = (const bf16*)(ws + WS_SMALLW + SW_WUP) + (size_t)l * 2 * 768 * 64;
        const bf16* aupT = (const bf16*)(ws + WS_SMALLW + SW_AUP) + (size_t)l * 768 * 64;
        const bf16* gupT = (const bf16*)(ws + WS_SMALLW + SW_GUP) + (size_t)l * 768 * 128;
        const float* a0 = a->in[I_A0] + (size_t)l * CW + head * 64; const float* kaw = a->in[I_KA] + (size_t)l * CW + head * 64; const float* w0 = a->in[I_W0] + (size_t)l * 2 * CW + head * 64;
        const int nloc = 16 * nt + 4 * fq;
#pragma unroll 1
        for (int mat = 0; mat < 4; ++mat) {
            const bf16* WT = mat == 0 ? aupT : (mat == 1 ? wupT : (mat == 2 ? wupT + 768 * 64 : gupT));
            const int KK = mat == 3 ? 128 : 64; const LAS bf16* act = mat == 0 ? adl : (mat == 3 ? sg : tw); const int apitch = mat == 3 ? 136 : SP_;
            f32x4 acc[2];
            acc[0] = (f32x4){0.f, 0.f, 0.f, 0.f}; acc[1] = acc[0];
            for (int ks = 0; ks < KK / 32; ++ks) { const bf16x8 afr = *(const bf16x8*)(WT + (size_t)(head * 64 + 16 * nt + fr) * KK + ks * 32 + fq * 8);
#pragma unroll
                for (int tt = 0; tt < 2; ++tt) { const bf16x8 bfr = *(const LAS bf16x8*)(act + (16 * (2 * th + tt) + fr) * apitch + ks * 32 + fq * 8); acc[tt] = __builtin_amdgcn_mfma_f32_16x16x32_bf16(afr, bfr, acc[tt], 0, 0, 0); } }
#pragma unroll
            for (int tt = 0; tt < 2; ++tt) { const int tk = 16 * (2 * th + tt) + fr; const f32x4 v = acc[tt];
                if (mat == 0) {
                    const f32x4 a0v = *(const f32x4*)(a0 + nloc), kav = *(const f32x4*)(kaw + nloc), kkv = *(const f32x4*)(kkw + nloc);
                    const u32x2 kp = *(const LAS u32x2*)(SK + tk * SP_ + nloc); const float kf[4] = {bflo(kp.x), bfhi(kp.x), bflo(kp.y), bfhi(kp.y)};
                    const float inn = invn[tk]; float k2[4], kk[4], bb[4];
#pragma unroll
                    for (int j = 0; j < 4; ++j) { const float av = sigmoidf_(a0v[j] + v[j]); kk[j] = kf[j] * kkv[j] * inn; k2[j] = kf[j] * (1.0f + (av - 1.0f) * kav[j]); bb[j] = kk[j] * av; }
                    u32x2 q; q.x = pk2(k2[0], k2[1]); q.y = pk2(k2[2], k2[3]); *(LAS u32x2*)(SK + tk * SP_ + nloc) = q;
                    q.x = pk2(kk[0], kk[1]); q.y = pk2(kk[2], kk[3]); *(LAS u32x2*)(SKK + tk * SP_ + nloc) = q;
                    q.x = pk2(bb[0], bb[1]); q.y = pk2(bb[2], bb[3]); *(LAS u32x2*)(SB + tk * SP_ + nloc) = q;
                } else if (mat <= 2) {
                    const f32x4 w0v = *(const f32x4*)(w0 + (mat - 1) * CW + nloc); float d[4];
#pragma unroll
                    for (int j = 0; j < 4; ++j) d[j] = __expf(-DECAY_SCALE * sigmoidf_(w0v[j] + v[j]));
                    u32x2 q; q.x = pk2(d[0], d[1]); q.y = pk2(d[2], d[3]); *(LAS u32x2*)((mat == 1 ? SWF : SWB) + tk * SP_ + nloc) = q;
                } else {
                    u32x2 q; q.x = pk2(v[0], v[1]); q.y = pk2(v[2], v[3]); *(u32x2*)(Y + (size_t)(row0 + tk) * D + 1280 + head * 64 + nloc) = q;
                }
            }
        }
    }
    __syncthreads();
    { const int tk = tid >> 3, c8 = (tid & 7) * 8; float r8[8], k8[8], v8[8];
      unpack8(*(const LAS u32x4*)(SR + tk * SP_ + c8), r8); unpack8(*(const LAS u32x4*)(SK + tk * SP_ + c8), k8); unpack8(*(const LAS u32x4*)(SV + tk * SP_ + c8), v8);
      const float* rkp = a->in[I_RK] + (size_t)l * CW + head * 64 + c8; const f32x4 rk0 = *(const f32x4*)rkp, rk1 = *(const f32x4*)(rkp + 4);
      float bs = 0.f;
#pragma unroll
      for (int j = 0; j < 8; ++j) bs += r8[j] * k8[j] * (j < 4 ? rk0[j] : rk1[j - 4]);
      bs += __shfl_xor(bs, 1); bs += __shfl_xor(bs, 2); bs += __shfl_xor(bs, 4);
#pragma unroll
      for (int j = 0; j < 8; ++j) v8[j] *= bs;
      *(u32x4*)(Y + (size_t)(row0 + tk) * D + 512 + head * 64 + c8) = pack8(v8); }
    {
        const int c4 = wave & 3, dir = wave >> 2, fr = lane & 15, fq = lane >> 4;
        LAS float* CB = (LAS float*)wpriv;
        LAS float* AA = CB + 16 * 64;
        const LAS bf16* SW = dir ? SWB : SWF;
        auto trow = [&](int tau) { return 16 * c4 + (dir ? 15 - tau : tau); };
        float c[16], ci[16];
        { float run = 1.f;
#pragma unroll
          for (int t = 0; t < 16; ++t) { run *= bf1(SW[trow(t) * SP_ + lane]); c[t] = run; ci[t] = __builtin_amdgcn_rcpf(run); CB[t * 64 + lane] = run; } }
        const int rec_dir = dir, bidx = isl ? (row0 >> 12) : ((row0 - NLAT) >> 8);
        const int tcl = isl ? 4 * ((row0 >> 6) & 63) + c4 : 4 * (((row0 - NLAT) >> 6) & 3) + c4;
        const int nproc = isl ? 16 + (dir ? 255 - tcl : tcl) : (dir ? 15 - tcl : tcl);
        unsigned char* rec = ws + WS_PRE + ((size_t)((rec_dir * 8 + bidx) * 12 + head) * NCHUNK16 + nproc) * PRE_REC;
        { const float cl = c[15]; float bk[32];
#pragma unroll
          for (int t = 0; t < 16; ++t) { const float e = cl * ci[t]; const int pos = 8 * (t >> 2) + (t & 3); bk[pos] = bf1(SB[trow(t) * SP_ + lane]) * e; bk[pos + 4] = bf1(SK[trow(t) * SP_ + lane]) * e; }
#pragma unroll
          for (int q4 = 0; q4 < 4; ++q4) { u32x4 o; o.x = pk2(bk[8 * q4], bk[8 * q4 + 1]); o.y = pk2(bk[8 * q4 + 2], bk[8 * q4 + 3]); o.z = pk2(bk[8 * q4 + 4], bk[8 * q4 + 5]); o.w = pk2(bk[8 * q4 + 6], bk[8 * q4 + 7]);
              *(u32x4*)(rec + PR_BK + lane * 64 + q4 * 16) = o; }
          *(float*)(rec + PR_GAM + lane * 4) = cl; }
        asm volatile("s_waitcnt lgkmcnt(0)" ::: "memory");
        bf16x8 fa[2], frr[2], fb[2], fk[2];
        { const int tr = trow(fr);
#pragma unroll
          for (int sx = 0; sx < 2; ++sx) { const int ch = 32 * sx + 8 * fq; float kk8[8], r8[8], b8[8], k8[8];
              unpack8(*(const LAS u32x4*)(SKK + tr * SP_ + ch), kk8); unpack8(*(const LAS u32x4*)(SR + tr * SP_ + ch), r8); unpack8(*(const LAS u32x4*)(SB + tr * SP_ + ch), b8); unpack8(*(const LAS u32x4*)(SK + tr * SP_ + ch), k8);
              const f32x4 c0 = *(const LAS f32x4*)(CB + fr * 64 + ch), c1 = *(const LAS f32x4*)(CB + fr * 64 + ch + 4);
              f32x4 p0 = (f32x4){1.f, 1.f, 1.f, 1.f}, p1 = p0; if (fr > 0) { p0 = *(const LAS f32x4*)(CB + (fr - 1) * 64 + ch); p1 = *(const LAS f32x4*)(CB + (fr - 1) * 64 + ch + 4); }
              float xa[8], xr[8], xb[8], xk[8];
#pragma unroll
              for (int j = 0; j < 8; ++j) { const float ec = j < 4 ? c0[j] : c1[j - 4], ep = j < 4 ? p0[j] : p1[j - 4]; const float en = __builtin_amdgcn_rcpf(ec);
                  xa[j] = -kk8[j] * ep; xr[j] = r8[j] * ec; xb[j] = b8[j] * en; xk[j] = k8[j] * en; }
              const u32x4 ua = pack8(xa), ur = pack8(xr), ub = pack8(xb), uk = pack8(xk);
              fa[sx] = __builtin_bit_cast(bf16x8, ua); frr[sx] = __builtin_bit_cast(bf16x8, ur); fb[sx] = __builtin_bit_cast(bf16x8, ub); fk[sx] = __builtin_bit_cast(bf16x8, uk); } }
        f32x4 gab = (f32x4){0.f, 0.f, 0.f, 0.f}, gak = gab, grb = gab, grk = gab;
#pragma unroll
        for (int sx = 0; sx < 2; ++sx) { gab = __builtin_amdgcn_mfma_f32_16x16x32_bf16(fa[sx], fb[sx], gab, 0, 0, 0); gak = __builtin_amdgcn_mfma_f32_16x16x32_bf16(fa[sx], fk[sx], gak, 0, 0, 0);
            grb = __builtin_amdgcn_mfma_f32_16x16x32_bf16(frr[sx], fb[sx], grb, 0, 0, 0); grk = __builtin_amdgcn_mfma_f32_16x16x32_bf16(frr[sx], fk[sx], grk, 0, 0, 0); }
#pragma unroll
        for (int j = 0; j < 4; ++j) { const int tau = 4 * fq + j; const bool lo = fr < tau, le = fr <= tau;
            AA[tau * 16 + fr] = lo ? gab[j] : 0.f; AA[256 + tau * 16 + fr] = lo ? gak[j] : 0.f; grb[j] = le ? grb[j] : 0.f; grk[j] = le ? grk[j] : 0.f; }
        asm volatile("s_waitcnt lgkmcnt(0)" ::: "memory");
        float wv[16], mv[16];
#pragma unroll
        for (int t = 0; t < 16; ++t) { const float ab = -bf1(SKK[trow(t) * SP_ + lane]) * (t > 0 ? c[t - 1] : 1.0f); float accw = ab, accm = AA[256 + t * 16 + fr];
#pragma unroll
            for (int q4 = 0; q4 < 4; ++q4) { if (4 * q4 < t) { const f32x4 cf = *(const LAS f32x4*)(AA + t * 16 + 4 * q4);
#pragma unroll
                for (int j = 0; j < 4; ++j) if (4 * q4 + j < t) { accw += cf[j] * wv[4 * q4 + j]; accm += cf[j] * mv[4 * q4 + j]; } } }
            wv[t] = accw; mv[t] = accm; }
        { LAS bf16* stg = (LAS bf16*)CB; const int pp = kperm_pos(lane);
#pragma unroll
          for (int t = 0; t < 16; ++t) { stg[t * 64 + pp] = (bf16)f2bf(wv[t]); stg[1024 + t * 64 + pp] = (bf16)f2bf(bf1(SR[trow(t) * SP_ + lane]) * c[t]); }
          asm volatile("s_waitcnt lgkmcnt(0)" ::: "memory");
#pragma unroll
          for (int q4 = 0; q4 < 4; ++q4) *(u32x4*)(rec + PR_WP + (q4 * 64 + lane) * 16) = *(const LAS u32x4*)((LAS unsigned char*)stg + (q4 * 64 + lane) * 16); }
        { LAS bf16* stg = (LAS bf16*)AA; const int ps = 8 * (fr >> 2) + (fr & 3);
          asm volatile("s_waitcnt lgkmcnt(0)" ::: "memory");
#pragma unroll
          for (int j = 0; j < 4; ++j) { const int tau = 4 * fq + j; stg[tau * 32 + ps] = (bf16)f2bf(grb[j]); stg[tau * 32 + ps + 4] = (bf16)f2bf(grk[j]); }
          if (lane < 16) {
#pragma unroll
              for (int t = 0; t < 16; ++t) stg[512 + t * 16 + lane] = (bf16)f2bf(mv[t]); }
          asm volatile("s_waitcnt lgkmcnt(0)" ::: "memory");
          *(u32x4*)(rec + PR_ARBK + lane * 16) = *(const LAS u32x4*)((LAS unsigned char*)stg + lane * 16);
          if (lane < 32) *(u32x4*)(rec + PR_ARBK + 1024 + lane * 16) = *(const LAS u32x4*)((LAS unsigned char*)stg + 1024 + lane * 16); }
        if (dir == 0) { float v16[16];
#pragma unroll
            for (int t = 0; t < 16; ++t) v16[t] = bf1(SV[(16 * c4 + t) * SP_ + lane]);
            const int tcg = isl ? 16 + tcl : tcl;
            unsigned char* vrec = ws + WS_VT + ((size_t)(bidx * 12 + head) * NCHUNK16 + tcg) * 2048 + lane * 32;
            u32x4 o; o.x = pk2(v16[0], v16[1]); o.y = pk2(v16[2], v16[3]); o.z = pk2(v16[4], v16[5]); o.w = pk2(v16[6], v16[7]); *(u32x4*)vrec = o;
            o.x = pk2(v16[8], v16[9]); o.y = pk2(v16[10], v16[11]); o.z = pk2(v16[12], v16[13]); o.w = pk2(v16[14], v16[15]); *(u32x4*)(vrec + 16) = o; }
    }
    __syncthreads();
    }
}

__device__ __forceinline__ float dpp_xor1(float x) { return __builtin_bit_cast(float, __builtin_amdgcn_update_dpp(0, __builtin_bit_cast(int, x), 0xB1, 0xF, 0xF, false)); }
__device__ __forceinline__ float dpp_xor2(float x) { return __builtin_bit_cast(float, __builtin_amdgcn_update_dpp(0, __builtin_bit_cast(int, x), 0x4E, 0xF, 0xF, false)); }
__device__ __forceinline__ int chain_row(int dir, int b, int s) {
    if (s < CTXL) return NLAT + b * CTXL + (dir ? (CTXL - 1 - s) : s);
    const int t = s - CTXL; return b * T + (dir ? (T - 1 - t) : t);
}
__device__ __forceinline__ float dpp_hmirror(float x) { return __builtin_bit_cast(float, __builtin_amdgcn_update_dpp(0, __builtin_bit_cast(int, x), 0x141, 0xF, 0xF, false)); }
struct RwRec { u32x4 wp[2], rp[2], bk[4], arbk; u32x2 mak, vt[2]; f32x4 gam[4]; };
__device__ __forceinline__ void rw_load(RwRec& r, const LAS unsigned char* rec, int fr, int kg, int hv, int dir) {
#pragma unroll
    for (int sx = 0; sx < 2; ++sx) { r.wp[sx] = *(const LAS u32x4*)(rec + PR_WP + fr * 128 + sx * 64 + kg * 16); r.rp[sx] = *(const LAS u32x4*)(rec + PR_RP + fr * 128 + sx * 64 + kg * 16); }
#pragma unroll
    for (int i = 0; i < 4; ++i) { r.bk[i] = *(const LAS u32x4*)(rec + PR_BK + (16 * i + fr) * 64 + kg * 16); r.gam[i] = *(const LAS f32x4*)(rec + PR_GAM + (16 * i + 4 * kg) * 4); }
    r.arbk = *(const LAS u32x4*)(rec + PR_ARBK + fr * 64 + kg * 16);
    r.mak = *(const LAS u32x2*)(rec + PR_MAK + fr * 32 + kg * 8);
#pragma unroll
    for (int q = 0; q < 2; ++q) r.vt[q] = *(const LAS u32x2*)(rec + PRE_REC + (16 * (2 * hv + q) + fr) * 32 + (dir ? (12 - 4 * kg) : 4 * kg) * 2);
}
constexpr int RW_R = 6, RW_SLOT = PRE_REC + 2048;
__device__ __forceinline__ void rwkv_chain_mfma(KArgs a, int task_base, LAS unsigned char* lds) {
    const int t_ = tid_fresh(); const int lane = t_ & 63, fr = lane & 15, kg = lane >> 4; const int wave = __builtin_amdgcn_readfirstlane(t_ >> 6);
    unsigned char* ws = a->ws;
    bf16* OC = (bf16*)(ws + WS_OC);
    const int cid = (task_base >> 2) + (wave >> 2), wq = wave & 3, dir = cid / 96, b = (cid % 96) / 12, h = cid % 12;
    const bool comp = wq < 2; const int hv = wq & 1;
    const unsigned char* rec0 = ws + WS_PRE + (size_t)((dir * 8 + b) * 12 + h) * NCHUNK16 * PRE_REC;
    const unsigned char* vrec0 = ws + WS_VT + (size_t)(b * 12 + h) * NCHUNK16 * 2048;
    LAS unsigned char* ring = lds + (wave >> 2) * (RW_R * RW_SLOT);
    auto tchunk = [&](int n) { return n < 16 ? (dir ? 15 - n : n) : 16 + (dir ? 255 - (n - 16) : (n - 16)); };
    auto issue = [&](int n) { const int nn = n < NCHUNK16 ? n : NCHUNK16 - 1; LAS unsigned char* slot = ring + (n % RW_R) * RW_SLOT;
#pragma unroll
        for (int jj = 0; jj < 3; ++jj) { const int j = 3 * wq + jj;
            const unsigned char* src = (j < 10 ? rec0 + (size_t)nn * PRE_REC + 1024 * j : vrec0 + (size_t)tchunk(nn) * 2048 + 1024 * (j - 10)) + lane * 16;
            __builtin_amdgcn_global_load_lds((const unsigned*)src, (LAS unsigned*)(slot + 1024 * j), 16, 0, 0); } };
    f32x4 ST[2][4];
#pragma unroll
    for (int q = 0; q < 2; ++q)
#pragma unroll
        for (int i = 0; i < 4; ++i) ST[q][i] = (f32x4){0.f, 0.f, 0.f, 0.f};
    unsigned uvU[2][2] = {{0u, 0u}, {0u, 0u}};
#pragma unroll
    for (int n = 0; n < RW_R - 1; ++n) issue(n);
    for (int n = 0; n < NCHUNK16; ++n) {
        asm volatile("s_waitcnt vmcnt(12)" ::: "memory");
        __builtin_amdgcn_s_barrier(); asm volatile("" ::: "memory");
        issue(n + RW_R - 1);
        if (comp) {
            RwRec cur; rw_load(cur, ring + (n % RW_R) * RW_SLOT, fr, kg, hv, dir);
            u32x4 fmak; fmak.x = 0u; fmak.y = 0u; fmak.z = cur.mak.x; fmak.w = cur.mak.y;
            const int row = chain_row(dir, b, 16 * n + fr);
#pragma unroll
            for (int q = 0; q < 2; ++q) {
                u32x4 fs[2];
#pragma unroll
                for (int sx = 0; sx < 2; ++sx) { fs[sx].x = pk2(ST[q][2 * sx][0], ST[q][2 * sx][1]); fs[sx].y = pk2(ST[q][2 * sx][2], ST[q][2 * sx][3]); fs[sx].z = pk2(ST[q][2 * sx + 1][0], ST[q][2 * sx + 1][1]); fs[sx].w = pk2(ST[q][2 * sx + 1][2], ST[q][2 * sx + 1][3]); }
                u32x2 vt = cur.vt[q]; if (dir) { const unsigned x = vt.x, y = vt.y; vt.x = (y >> 16) | (y << 16); vt.y = (x >> 16) | (x << 16); }
                u32x4 fuv; fuv.x = uvU[q][0]; fuv.y = uvU[q][1]; fuv.z = vt.x; fuv.w = vt.y;
                f32x4 U = (f32x4){0.f, 0.f, 0.f, 0.f};
                U = __builtin_amdgcn_mfma_f32_16x16x32_bf16(__builtin_bit_cast(bf16x8, cur.wp[0]), __builtin_bit_cast(bf16x8, fs[0]), U, 0, 0, 0);
                U = __builtin_amdgcn_mfma_f32_16x16x32_bf16(__builtin_bit_cast(bf16x8, cur.wp[1]), __builtin_bit_cast(bf16x8, fs[1]), U, 0, 0, 0);
                U = __builtin_amdgcn_mfma_f32_16x16x32_bf16(__builtin_bit_cast(bf16x8, fmak), __builtin_bit_cast(bf16x8, fuv), U, 0, 0, 0);
                uvU[q][0] = pk2(U[0], U[1]); uvU[q][1] = pk2(U[2], U[3]); fuv.x = uvU[q][0]; fuv.y = uvU[q][1];
                f32x4 OT = (f32x4){0.f, 0.f, 0.f, 0.f};
                OT = __builtin_amdgcn_mfma_f32_16x16x32_bf16(__builtin_bit_cast(bf16x8, fs[0]), __builtin_bit_cast(bf16x8, cur.rp[0]), OT, 0, 0, 0);
                OT = __builtin_amdgcn_mfma_f32_16x16x32_bf16(__builtin_bit_cast(bf16x8, fs[1]), __builtin_bit_cast(bf16x8, cur.rp[1]), OT, 0, 0, 0);
                OT = __builtin_amdgcn_mfma_f32_16x16x32_bf16(__builtin_bit_cast(bf16x8, fuv), __builtin_bit_cast(bf16x8, cur.arbk), OT, 0, 0, 0);
#pragma unroll
                for (int i = 0; i < 4; ++i) ST[q][i] = __builtin_amdgcn_mfma_f32_16x16x32_bf16(__builtin_bit_cast(bf16x8, cur.bk[i]), __builtin_bit_cast(bf16x8, fuv), ST[q][i] * cur.gam[i], 0, 0, 0);
                u32x2 o; o.x = pk2(OT[0], OT[1]); o.y = pk2(OT[2], OT[3]); *(u32x2*)(OC + ((size_t)dir * MALL + row) * CW + h * 64 + 16 * (2 * hv + q) + 4 * kg) = o;
            }
        }
    }
    asm volatile("s_waitcnt vmcnt(0)" ::: "memory");
    __builtin_amdgcn_s_barrier(); asm volatile("" ::: "memory");
}
#define LDS_BAR() do { asm volatile("s_waitcnt lgkmcnt(0)" ::: "memory"); __builtin_amdgcn_s_barrier(); asm volatile("" ::: "memory"); } while (0)
__device__ __forceinline__ void hgrn_prep_item(KArgs a, int l, int item, LAS unsigned char* lds, bool dry) {
    const int tid = tid_fresh();
    unsigned char* ws = a->ws;
    bf16* P = (bf16*)(ws + WS_P); bf16* HQB = (bf16*)(ws + WS_HQB); float* HG = (float*)(ws + WS_HG);
    const int cn = item % 68, bh = item / 68, h = bh % 6, b = bh / 6;
    const int row0 = cn < 4 ? NLAT + b * CTXL + 64 * cn : b * T + 64 * (cn - 4);
    constexpr int QP = 136;
    LAS bf16* SQ = (LAS bf16*)lds; LAS bf16* KF = SQ + 64 * QP; LAS bf16* KB = KF + 64 * QP; LAS bf16* QB = KB + 64 * QP;
    LAS float* LF = (LAS float*)(QB + 64 * QP); LAS float* LBk = LF + 64 * 128;
    LAS float* tot = LBk + 64 * 128;
    LAS float* lbs = tot + 1024;
    if (tid < 256) { const int dr = tid >> 7, ch = h * 128 + (tid & 127); float lb = 0.f;
        if (l != 0) { const float l0 = a->in[I_LB][((size_t)dr * DEPTH + 0) * BW + ch], l1 = a->in[I_LB][((size_t)dr * DEPTH + 1) * BW + ch]; lb = __builtin_amdgcn_rcpf(1.0f + __expf(l0 - l1)); }
        lbs[tid] = lb; }
    const int ta = tid >> 3, d0 = (tid & 7) * 16;
    bf16* prow = P + (size_t)(row0 + ta) * INC + h * 128 + d0;
    u32x4 rq[2], rf[2], rb[2];
    rq[0] = *(const u32x4*)(prow + OFF_Q); rq[1] = *(const u32x4*)(prow + OFF_Q + 8); rf[0] = *(const u32x4*)(prow + OFF_ZF); rf[1] = *(const u32x4*)(prow + OFF_ZF + 8); rb[0] = *(const u32x4*)(prow + OFF_ZB); rb[1] = *(const u32x4*)(prow + OFF_ZB + 8);
    __syncthreads();
#pragma unroll
    for (int hf = 0; hf < 2; ++hf) { float qf[8], zf[8], zb[8], oq[8], of[8], ob[8]; unpack8(rq[hf], qf); unpack8(rf[hf], zf); unpack8(rb[hf], zb);
        const int dd = d0 + 8 * hf; f32x4 lf0, lf1, lb0, lb1;
#pragma unroll
        for (int j = 0; j < 8; ++j) { const float lF = lbs[dd + j], lB = lbs[128 + dd + j];
            const float ff = lF + (1.0f - lF) * sigmoidf_(zf[j]), fb = lB + (1.0f - lB) * sigmoidf_(zb[j]);
            const float a1 = fmaxf(__logf(ff), -60.0f), a2 = fmaxf(__logf(fb), -60.0f);
            if (j < 4) { lf0[j] = a1; lb0[j] = a2; } else { lf1[j - 4] = a1; lb1[j - 4] = a2; }
            oq[j] = siluf_(qf[j]); of[j] = 1.0f - ff; ob[j] = 1.0f - fb; }
        *(LAS u32x4*)(SQ + ta * QP + dd) = pack8(oq); *(LAS u32x4*)(KF + ta * QP + dd) = pack8(of); *(LAS u32x4*)(KB + ta * QP + dd) = pack8(ob);
        *(LAS f32x4*)(LF + ta * 128 + dd) = lf0; *(LAS f32x4*)(LF + ta * 128 + dd + 4) = lf1; *(LAS f32x4*)(LBk + ta * 128 + dd) = lb0; *(LAS f32x4*)(LBk + ta * 128 + dd + 4) = lb1; }
    __syncthreads();
    const int d = tid & 127, qt = tid >> 7;
    float csf[16], csb[16];
    { float r1 = 0.f, r2 = 0.f;
#pragma unroll
      for (int i = 0; i < 16; ++i) { const int tp = 16 * qt + i; r1 += LF[tp * 128 + d]; csf[i] = r1; r2 += LBk[(63 - tp) * 128 + d]; csb[i] = r2; }
      tot[qt * 128 + d] = r1; tot[512 + qt * 128 + d] = r2; }
    __syncthreads();
#pragma unroll
    for (int dr = 0; dr < 2; ++dr) { const LAS float* tt = tot + 512 * dr; const float t0 = tt[d], t1 = tt[128 + d], t2 = tt[256 + d], t3 = tt[384 + d];
        const float bmid = t0 + t1, btot = bmid + t2 + t3; const float base = (qt > 0 ? t0 : 0.f) + (qt > 1 ? t1 : 0.f) + (qt > 2 ? t2 : 0.f);
        if (qt == 0) { const int npr = dr == 0 ? cn : (cn < 4 ? 3 - cn : 4 + 63 - (cn - 4)); float* g = (dry ? (float*)(ws + WS_END + 8 * MiB) : HG) + ((size_t)(((dr * 8 + b) * 6 + h) * 68 + npr)) * 256; g[d] = __expf(bmid); g[128 + d] = __expf(btot - bmid); }
#pragma unroll
        for (int i = 0; i < 16; ++i) { const int tp = 16 * qt + i, tok = dr ? 63 - tp : tp; const float bt = base + (dr ? csb[i] : csf[i]);
            const float eq = __expf(fminf(bt - bmid, 80.0f)), ek = __expf(fminf(bmid - bt, 80.0f));
            const float qv = bf1(SQ[tok * QP + d]) * eq;
            if (dr == 0) { KF[tok * QP + d] = (bf16)f2bf(bf1(KF[tok * QP + d]) * ek); QB[tok * QP + d] = (bf16)f2bf(qv); }
            else { KB[tok * QP + d] = (bf16)f2bf(bf1(KB[tok * QP + d]) * ek); SQ[tok * QP + d] = (bf16)f2bf(qv); } }
        __syncthreads(); }
    bf16* prow_o = dry ? (bf16*)(ws + WS_END) + (size_t)((row0 + ta) & 511) * INC + h * 128 + d0 : prow; bf16* hqb_o = dry ? (bf16*)(ws + WS_END) : HQB;
#pragma unroll
    for (int hf = 0; hf < 2; ++hf) { const int dd = d0 + 8 * hf;
        *(u32x4*)(prow_o + OFF_Q + 8 * hf) = *(const LAS u32x4*)(QB + ta * QP + dd); *(u32x4*)(prow_o + OFF_ZF + 8 * hf) = *(const LAS u32x4*)(KF + ta * QP + dd); *(u32x4*)(prow_o + OFF_ZB + 8 * hf) = *(const LAS u32x4*)(KB + ta * QP + dd);
        *(u32x4*)(hqb_o + (size_t)(dry ? ((row0 + ta) & 1023) : (row0 + ta)) * BW + h * 128 + dd) = *(const LAS u32x4*)(SQ + ta * QP + dd); }
    __syncthreads();
}
__device__ __forceinline__ unsigned tr_addr(const LAS bf16* X, int pitch, int r0, int c0, int lane) { const int i = lane & 15, g = lane >> 4; return (unsigned)(size_t)(X + (r0 + 8 * g + (i >> 2)) * pitch + c0 + 4 * (i & 3)); }
__device__ __forceinline__ void tr8x4(u32x2 (&lo)[4], u32x2 (&hi)[4], unsigned a0, unsigned a1, unsigned a2, unsigned a3, unsigned rowstep4) {
    const unsigned b0 = a0 + rowstep4, b1 = a1 + rowstep4, b2 = a2 + rowstep4, b3 = a3 + rowstep4;
    asm volatile("ds_read_b64_tr_b16 %0, %8\n\tds_read_b64_tr_b16 %1, %9\n\tds_read_b64_tr_b16 %2, %10\n\tds_read_b64_tr_b16 %3, %11\n\t"
                 "ds_read_b64_tr_b16 %4, %12\n\tds_read_b64_tr_b16 %5, %13\n\tds_read_b64_tr_b16 %6, %14\n\tds_read_b64_tr_b16 %7, %15\n\ts_waitcnt lgkmcnt(0)"
                 : "=&v"(lo[0]), "=&v"(lo[1]), "=&v"(lo[2]), "=&v"(lo[3]), "=&v"(hi[0]), "=&v"(hi[1]), "=&v"(hi[2]), "=&v"(hi[3])
                 : "v"(a0), "v"(a1), "v"(a2), "v"(a3), "v"(b0), "v"(b1), "v"(b2), "v"(b3) : "memory");
}
__device__ __forceinline__ bf16x8 mk8(u32x2 lo, u32x2 hi) { u32x4 v; v.x = lo.x; v.y = lo.y; v.z = hi.x; v.w = hi.y; return __builtin_bit_cast(bf16x8, v); }
__device__ __forceinline__ void hgrn_chain_lean(KArgs a, int cid, LAS unsigned char* lds) {
    const int tid = tid_fresh(), lane = tid & 63, wave = tid >> 6, fr = lane & 15, fq = lane >> 4;
    unsigned char* ws = a->ws;
    const bf16* P = (const bf16*)(ws + WS_P); const bf16* HQB = (const bf16*)(ws + WS_HQB); const float* HG = (const float*)(ws + WS_HG); bf16* OB = (bf16*)(ws + WS_OB);
    const int dir = cid / 48, b = (cid % 48) / 6, h = cid % 6;
    constexpr int QP = 136, SP = 72;
    LAS bf16* qs = (LAS bf16*)lds;
    LAS bf16* ks = qs + 64 * QP;
    LAS bf16* vs = ks + 64 * QP;
    LAS bf16* pl = vs + 64 * QP;
    LAS bf16* sT = pl + 64 * SP;
    LAS float* gm = (LAS float*)(sT + 128 * QP);
    const int ta = tid >> 3, d0 = (tid & 7) * 16;
    const int koff = dir ? OFF_ZB : OFF_ZF;
    f32x4 S[8];
#pragma unroll
    for (int vt = 0; vt < 8; ++vt) S[vt] = (f32x4){0.f, 0.f, 0.f, 0.f};
    u32x4 rq[2], rk[2], rv[2]; float rg = 0.f;
    auto load_chunk = [&](int n) { const int row = chain_row(dir, b, 64 * n + ta); const bf16* pr = P + (size_t)row * INC + h * 128 + d0;
        const bf16* qr = dir ? HQB + (size_t)row * BW + h * 128 + d0 : pr + OFF_Q;
        rq[0] = *(const u32x4*)qr; rq[1] = *(const u32x4*)(qr + 8); rk[0] = *(const u32x4*)(pr + koff); rk[1] = *(const u32x4*)(pr + koff + 8); rv[0] = *(const u32x4*)(pr + OFF_I); rv[1] = *(const u32x4*)(pr + OFF_I + 8);
        if (tid < 256) rg = HG[((size_t)(((dir * 8 + b) * 6 + h) * 68 + n)) * 256 + tid]; };
    load_chunk(0);
    constexpr int NCH = (CTXL + T) / 64;
    for (int n = 0; n < NCH; ++n) {
        const int s0 = n * 64;
        *(LAS u32x4*)(qs + ta * QP + d0) = rq[0]; *(LAS u32x4*)(qs + ta * QP + d0 + 8) = rq[1]; *(LAS u32x4*)(ks + ta * QP + d0) = rk[0]; *(LAS u32x4*)(ks + ta * QP + d0 + 8) = rk[1];
        *(LAS u32x4*)(vs + ta * QP + d0) = rv[0]; *(LAS u32x4*)(vs + ta * QP + d0 + 8) = rv[1]; if (tid < 256) gm[tid] = rg;
        if (n + 1 < NCH) load_chunk(n + 1);
        LDS_BAR();
        { const f32x4 g4 = *(const LAS f32x4*)(gm + 16 * wave + 4 * fq);
#pragma unroll
          for (int vt = 0; vt < 8; ++vt) { S[vt] = S[vt] * g4; u32x2 o; o.x = pk2(S[vt][0], S[vt][1]); o.y = pk2(S[vt][2], S[vt][3]); *(LAS u32x2*)(sT + (16 * vt + fr) * QP + 16 * wave + 4 * fq) = o; } }
        { const int tt = wave >> 1;
#pragma unroll
          for (int u = 0; u < 2; ++u) { const int sg = 2 * (wave & 1) + u; f32x4 acc = (f32x4){0.f, 0.f, 0.f, 0.f};
              if (sg <= tt) {
#pragma unroll
                  for (int kq = 0; kq < 4; ++kq) { const bf16x8 af = *(const LAS bf16x8*)(ks + (16 * sg + fr) * QP + 32 * kq + 8 * fq), bfm = *(const LAS bf16x8*)(qs + (16 * tt + fr) * QP + 32 * kq + 8 * fq);
                      acc = __builtin_amdgcn_mfma_f32_16x16x32_bf16(af, bfm, acc, 0, 0, 0); }
                  if (sg == tt) {
#pragma unroll
                      for (int j = 0; j < 4; ++j) if (4 * fq + j > fr) acc[j] = 0.f; }
              }
              u32x2 o; o.x = pk2(acc[0], acc[1]); o.y = pk2(acc[2], acc[3]); *(LAS u32x2*)(pl + (16 * tt + fr) * SP + 16 * sg + 4 * fq) = o; } }
        LDS_BAR();
        f32x4 oacc[4];
#pragma unroll
        for (int tt = 0; tt < 4; ++tt) { f32x4 acc = (f32x4){0.f, 0.f, 0.f, 0.f};
#pragma unroll
            for (int kq = 0; kq < 4; ++kq) { const bf16x8 af = *(const LAS bf16x8*)(sT + (16 * wave + fr) * QP + 32 * kq + 8 * fq), bfm = *(const LAS bf16x8*)(qs + (16 * tt + fr) * QP + 32 * kq + 8 * fq);
                acc = __builtin_amdgcn_mfma_f32_16x16x32_bf16(af, bfm, acc, 0, 0, 0); }
            oacc[tt] = acc; }
        const unsigned rs4 = (unsigned)(4 * QP * 2);
#pragma unroll
        for (int kq = 0; kq < 2; ++kq) {
            u32x2 vl_[8], vh_[8], xl_[4], xh_[4];
            { u32x2 l4[4], h4[4];
              tr8x4(l4, h4, tr_addr(vs, QP, 32 * kq, 0, lane), tr_addr(vs, QP, 32 * kq, 16, lane), tr_addr(vs, QP, 32 * kq, 32, lane), tr_addr(vs, QP, 32 * kq, 48, lane), rs4);
#pragma unroll
              for (int q = 0; q < 4; ++q) { vl_[q] = l4[q]; vh_[q] = h4[q]; }
              tr8x4(l4, h4, tr_addr(vs, QP, 32 * kq, 64, lane), tr_addr(vs, QP, 32 * kq, 80, lane), tr_addr(vs, QP, 32 * kq, 96, lane), tr_addr(vs, QP, 32 * kq, 112, lane), rs4);
#pragma unroll
              for (int q = 0; q < 4; ++q) { vl_[4 + q] = l4[q]; vh_[4 + q] = h4[q]; }
              tr8x4(xl_, xh_, tr_addr(ks, QP, 32 * kq, 16 * wave, lane), tr_addr(vs, QP, 32 * kq, 16 * wave, lane), tr_addr(ks, QP, 32 * kq, 16 * wave, lane), tr_addr(vs, QP, 32 * kq, 16 * wave, lane), rs4); }
            __builtin_amdgcn_sched_barrier(0);
            { const bf16x8 af = mk8(xl_[1], xh_[1]);
#pragma unroll
              for (int tt = 0; tt < 4; ++tt) { const bf16x8 bfm = *(const LAS bf16x8*)(pl + (16 * tt + fr) * SP + 32 * kq + 8 * fq); oacc[tt] = __builtin_amdgcn_mfma_f32_16x16x32_bf16(af, bfm, oacc[tt], 0, 0, 0); } }
            { const bf16x8 af = mk8(xl_[0], xh_[0]);
#pragma unroll
              for (int vt = 0; vt < 8; ++vt) S[vt] = __builtin_amdgcn_mfma_f32_16x16x32_bf16(af, mk8(vl_[vt], vh_[vt]), S[vt], 0, 0, 0); }
        }
#pragma unroll
        for (int tt = 0; tt < 4; ++tt) { const int row = chain_row(dir, b, s0 + 16 * tt + fr);
            u32x2 o; o.x = pk2(oacc[tt][0], oacc[tt][1]); o.y = pk2(oacc[tt][2], oacc[tt][3]); *(u32x2*)(OB + ((size_t)dir * MALL + row) * BW + h * 128 + 16 * wave + 4 * fq) = o; }
        { const f32x4 ge = *(const LAS f32x4*)(gm + 128 + 16 * wave + 4 * fq);
#pragma unroll
          for (int vt = 0; vt < 8; ++vt) S[vt] = S[vt] * ge; }
        LDS_BAR();
    }
}
__device__ __forceinline__ void hgrn_chain_mfma(KArgs a, int l, int cid, LAS unsigned char* lds) {
    const int tid = tid_fresh(), lane = tid & 63, wave = tid >> 6, fr = lane & 15, fq = lane >> 4;
    unsigned char* ws = a->ws;
    const bf16* P = (const bf16*)(ws + WS_P); bf16* OB = (bf16*)(ws + WS_OB);
    const int dir = cid / 48, b = (cid % 48) / 6, h = cid % 6;
    constexpr int QP = 136, SP = 72;
    LAS bf16* qs = (LAS bf16*)lds;
    LAS bf16* ks = qs + 64 * QP;
    LAS bf16* kT = ks + 64 * QP;
    LAS bf16* vT = kT + 128 * SP;
    LAS bf16* pl = vT + 128 * SP;
    LAS bf16* sT = pl + 64 * SP;
    LAS float* tot = (LAS float*)(sT + 128 * QP);
    LAS float* gmid = tot + 512;
    LAS float* gend = gmid + 128;
    LAS float* lbs = gend + 128;
    LAS float* lfb = (LAS float*)sT;
    const int d = tid & 127, qt = tid >> 7;
    const int tau_a = tid >> 3, d0 = (tid & 7) * 16;
    if (tid < 128) { const int ch = h * 128 + tid; float lb = 0.f;
        if (l != 0) { const float l0 = a->in[I_LB][((size_t)dir * DEPTH + 0) * BW + ch], l1 = a->in[I_LB][((size_t)dir * DEPTH + 1) * BW + ch]; lb = 1.0f / (1.0f + __expf(l0 - l1)); }
        lbs[tid] = lb; }
    f32x4 S[8];
#pragma unroll
    for (int vt = 0; vt < 8; ++vt) S[vt] = (f32x4){0.f, 0.f, 0.f, 0.f};
    const int zoff = dir ? OFF_ZB : OFF_ZF;
    u32x4 rq[2], ri[2], rz[2];
    { const bf16* pr = P + (size_t)chain_row(dir, b, tau_a) * INC + h * 128 + d0;
      rq[0] = *(const u32x4*)(pr + OFF_Q); rq[1] = *(const u32x4*)(pr + OFF_Q + 8); ri[0] = *(const u32x4*)(pr + OFF_I); ri[1] = *(const u32x4*)(pr + OFF_I + 8); rz[0] = *(const u32x4*)(pr + zoff); rz[1] = *(const u32x4*)(pr + zoff + 8); }
    __syncthreads();
    constexpr int NCH = (CTXL + T) / 64;
    for (int n = 0; n < NCH; ++n) {
        const int s0 = n * 64;
#pragma unroll
        for (int hf = 0; hf < 2; ++hf) { float qf[8], zf[8], oq[8], ok[8]; unpack8(rq[hf], qf); unpack8(rz[hf], zf);
            const int dd = d0 + 8 * hf; const f32x4 lb0 = *(const LAS f32x4*)(lbs + dd), lb1 = *(const LAS f32x4*)(lbs + dd + 4); f32x4 lf0, lf1;
#pragma unroll
            for (int j = 0; j < 8; ++j) { const float lb = j < 4 ? lb0[j] : lb1[j - 4]; const float f = lb + (1.0f - lb) * sigmoidf_(zf[j]); const float lf = fmaxf(__logf(f), -60.0f);
                if (j < 4) lf0[j] = lf; else lf1[j - 4] = lf; oq[j] = siluf_(qf[j]); ok[j] = 1.0f - f; }
            *(LAS u32x4*)(qs + tau_a * QP + dd) = pack8(oq); *(LAS u32x4*)(ks + tau_a * QP + dd) = pack8(ok);
            *(LAS f32x4*)(lfb + tau_a * 128 + dd) = lf0; *(LAS f32x4*)(lfb + tau_a * 128 + dd + 4) = lf1;
            const u32x4 vv = ri[hf];
            vT[(dd + 0) * SP + tau_a] = (bf16)(vv.x & 0xffffu); vT[(dd + 1) * SP + tau_a] = (bf16)(vv.x >> 16); vT[(dd + 2) * SP + tau_a] = (bf16)(vv.y & 0xffffu); vT[(dd + 3) * SP + tau_a] = (bf16)(vv.y >> 16);
            vT[(dd + 4) * SP + tau_a] = (bf16)(vv.z & 0xffffu); vT[(dd + 5) * SP + tau_a] = (bf16)(vv.z >> 16); vT[(dd + 6) * SP + tau_a] = (bf16)(vv.w & 0xffffu); vT[(dd + 7) * SP + tau_a] = (bf16)(vv.w >> 16); }
        if (n + 1 < NCH) { const bf16* pr = P + (size_t)chain_row(dir, b, s0 + 64 + tau_a) * INC + h * 128 + d0;
            rq[0] = *(const u32x4*)(pr + OFF_Q); rq[1] = *(const u32x4*)(pr + OFF_Q + 8); ri[0] = *(const u32x4*)(pr + OFF_I); ri[1] = *(const u32x4*)(pr + OFF_I + 8); rz[0] = *(const u32x4*)(pr + zoff); rz[1] = *(const u32x4*)(pr + zoff + 8); }
        LDS_BAR();
        float cs[16];
        { float run = 0.f;
#pragma unroll
          for (int i = 0; i < 16; ++i) { run += lfb[(16 * qt + i) * 128 + d]; cs[i] = run; }
          tot[qt * 128 + d] = run; }
        LDS_BAR();
        { const float t0 = tot[d], t1 = tot[128 + d], t2 = tot[256 + d], t3 = tot[384 + d];
          const float bmid = t0 + t1, btot = bmid + t2 + t3; const float base = (qt > 0 ? t0 : 0.f) + (qt > 1 ? t1 : 0.f) + (qt > 2 ? t2 : 0.f);
          if (qt == 0) { gmid[d] = __expf(bmid); gend[d] = __expf(btot - bmid); }
#pragma unroll
          for (int i = 0; i < 16; ++i) { const int tau = 16 * qt + i; const float bt = base + cs[i];
              const float eq = __expf(fminf(bt - bmid, 80.0f)), ek = __expf(fminf(bmid - bt, 80.0f));
              const bf16 qb = (bf16)f2bf(bf1(qs[tau * QP + d]) * eq), kb = (bf16)f2bf(bf1(ks[tau * QP + d]) * ek);
              qs[tau * QP + d] = qb; ks[tau * QP + d] = kb; kT[d * SP + tau] = kb; } }
        LDS_BAR();
        { const f32x4 gm = *(const LAS f32x4*)(gmid + 16 * wave + 4 * fq);
#pragma unroll
          for (int vt = 0; vt < 8; ++vt) { S[vt] = S[vt] * gm; u32x2 o; o.x = pk2(S[vt][0], S[vt][1]); o.y = pk2(S[vt][2], S[vt][3]); *(LAS u32x2*)(sT + (16 * vt + fr) * QP + 16 * wave + 4 * fq) = o; } }
        { const int tt = wave >> 1;
#pragma unroll
          for (int u = 0; u < 2; ++u) { const int sg = 2 * (wave & 1) + u; f32x4 acc = (f32x4){0.f, 0.f, 0.f, 0.f};
              if (sg <= tt) {
#pragma unroll
                  for (int kq = 0; kq < 4; ++kq) { const bf16x8 af = *(const LAS bf16x8*)(ks + (16 * sg + fr) * QP + 32 * kq + 8 * fq), bfm = *(const LAS bf16x8*)(qs + (16 * tt + fr) * QP + 32 * kq + 8 * fq);
                      acc = __builtin_amdgcn_mfma_f32_16x16x32_bf16(af, bfm, acc, 0, 0, 0); }
                  if (sg == tt) {
#pragma unroll
                      for (int j = 0; j < 4; ++j) if (4 * fq + j > fr) acc[j] = 0.f; }
              }
              u32x2 o; o.x = pk2(acc[0], acc[1]); o.y = pk2(acc[2], acc[3]); *(LAS u32x2*)(pl + (16 * tt + fr) * SP + 16 * sg + 4 * fq) = o; } }
        LDS_BAR();
#pragma unroll
        for (int tt = 0; tt < 4; ++tt) { f32x4 acc = (f32x4){0.f, 0.f, 0.f, 0.f};
#pragma unroll
            for (int kq = 0; kq < 2; ++kq) { const bf16x8 af = *(const LAS bf16x8*)(vT + (16 * wave + fr) * SP + 32 * kq + 8 * fq), bfm = *(const LAS bf16x8*)(pl + (16 * tt + fr) * SP + 32 * kq + 8 * fq);
                acc = __builtin_amdgcn_mfma_f32_16x16x32_bf16(af, bfm, acc, 0, 0, 0); }
#pragma unroll
            for (int kq = 0; kq < 4; ++kq) { const bf16x8 af = *(const LAS bf16x8*)(sT + (16 * wave + fr) * QP + 32 * kq + 8 * fq), bfm = *(const LAS bf16x8*)(qs + (16 * tt + fr) * QP + 32 * kq + 8 * fq);
                acc = __builtin_amdgcn_mfma_f32_16x16x32_bf16(af, bfm, acc, 0, 0, 0); }
            const int row = chain_row(dir, b, s0 + 16 * tt + fr);
            u32x2 o; o.x = pk2(acc[0], acc[1]); o.y = pk2(acc[2], acc[3]); *(u32x2*)(OB + ((size_t)dir * MALL + row) * BW + h * 128 + 16 * wave + 4 * fq) = o; }
        { const f32x4 ge = *(const LAS f32x4*)(gend + 16 * wave + 4 * fq);
#pragma unroll
          for (int kq = 0; kq < 2; ++kq) { const bf16x8 af = *(const LAS bf16x8*)(kT + (16 * wave + fr) * SP + 32 * kq + 8 * fq);
#pragma unroll
              for (int vt = 0; vt < 8; ++vt) { const bf16x8 bfm = *(const LAS bf16x8*)(vT + (16 * vt + fr) * SP + 32 * kq + 8 * fq); S[vt] = __builtin_amdgcn_mfma_f32_16x16x32_bf16(af, bfm, S[vt], 0, 0, 0); } }
#pragma unroll
          for (int vt = 0; vt < 8; ++vt) S[vt] = S[vt] * ge; }
        LDS_BAR();
    }
}
__device__ __forceinline__ void hgrn_chain(KArgs a, int l, int cid, LAS unsigned char* lds) {
    const int tid = tid_fresh();
    unsigned char* ws = a->ws;
    const bf16* P = (const bf16*)(ws + WS_P); bf16* OB = (bf16*)(ws + WS_OB);
    const int dir = cid / 48, b = (cid % 48) / 6, h = cid % 6;
    LAS float* tq = (LAS float*)lds;
    LAS float* tk = tq + 16 * 128;
    LAS float* tf = tk + 16 * 128;
    LAS float* tv = tf + 16 * 128;
    LAS float* ot = tv + 16 * 128;
    const int v = tid >> 2, q = tid & 3;
    float S[32];
#pragma unroll
    for (int j = 0; j < 32; ++j) S[j] = 0.f;
    const int sst = tid >> 5, sc4 = (tid & 31) * 4;
    float lb[4];
#pragma unroll
    for (int j = 0; j < 4; ++j) { const int ch = h * 128 + sc4 + j;
        if (l == 0) lb[j] = 0.f; else { const float l0 = a->in[I_LB][((size_t)dir * DEPTH + 0) * BW + ch], l1 = a->in[I_LB][((size_t)dir * DEPTH + 1) * BW + ch]; lb[j] = 1.0f / (1.0f + __expf(l0 - l1)); } }
    for (int s0 = 0; s0 < CTXL + T; s0 += 16) {
        { const int row = chain_row(dir, b, s0 + sst); const bf16* pr = P + (size_t)row * INC + h * 128 + sc4;
          const u32x2 pq = *(const u32x2*)(pr + OFF_Q), pi = *(const u32x2*)(pr + OFF_I), pz = *(const u32x2*)(pr + (dir ? OFF_ZB : OFF_ZF));
          const float qf[4] = {bflo(pq.x), bfhi(pq.x), bflo(pq.y), bfhi(pq.y)}, vf[4] = {bflo(pi.x), bfhi(pi.x), bflo(pi.y), bfhi(pi.y)}, zf[4] = {bflo(pz.x), bfhi(pz.x), bflo(pz.y), bfhi(pz.y)};
          f32x4 oq, ok, of, ov;
#pragma unroll
          for (int j = 0; j < 4; ++j) { const float f = lb[j] + (1.0f - lb[j]) * sigmoidf_(zf[j]); oq[j] = siluf_(qf[j]); of[j] = f; ok[j] = 1.0f - f; ov[j] = vf[j]; }
          *(LAS f32x4*)(tq + sst * 128 + sc4) = oq; *(LAS f32x4*)(tk + sst * 128 + sc4) = ok; *(LAS f32x4*)(tf + sst * 128 + sc4) = of; *(LAS f32x4*)(tv + sst * 128 + sc4) = ov; }
        LDS_BAR();
        for (int st = 0; st < 16; ++st) {
            const float vv = tv[st * 128 + v]; float o0 = 0.f, o1 = 0.f;
#pragma unroll
            for (int j = 0; j < 8; ++j) { const f32x4 fq4 = *(const LAS f32x4*)(tf + st * 128 + q * 32 + 4 * j), kq4 = *(const LAS f32x4*)(tk + st * 128 + q * 32 + 4 * j), qq4 = *(const LAS f32x4*)(tq + st * 128 + q * 32 + 4 * j);
#pragma unroll
                for (int i = 0; i < 4; ++i) { const float sn = fq4[i] * S[4 * j + i] + kq4[i] * vv; S[4 * j + i] = sn; if (i & 1) o1 += qq4[i] * sn; else o0 += qq4[i] * sn; } }
            float o = o0 + o1; o += dpp_xor1(o); o += dpp_xor2(o);
            if (q == 0) ot[st * 128 + v] = o;
        }
        LDS_BAR();
        if (tid < 256) { const int st = tid >> 4, part = tid & 15; const int row = chain_row(dir, b, s0 + st); const LAS float* op = ot + st * 128 + part * 8;
            float f[8];
#pragma unroll
            for (int j = 0; j < 8; ++j) f[j] = op[j];
            *(u32x4*)(OB + ((size_t)dir * MALL + row) * BW + h * 128 + part * 8) = pack8(f); }
    }
    LDS_BAR();
}

__device__ __forceinline__ float grp_sum32(float v) { v += __shfl_xor(v, 1); v += __shfl_xor(v, 2); v += __shfl_xor(v, 4); v += __shfl_xor(v, 8); v += __shfl_xor(v, 16); return v; }
__device__ __forceinline__ float grp_sum16(float v) { v += __shfl_xor(v, 1); v += __shfl_xor(v, 2); v += __shfl_xor(v, 4); v += __shfl_xor(v, 8); return v; }
__device__ __forceinline__ void phase_finalize(KArgs a, int l, bool dry) {
    const int tid_ = tid_fresh(); const int lane = tid_ & 63, wave = tid_ >> 6, gw = blockIdx.x * 8 + wave, NGW = gridDim.x * 8;
    unsigned char* ws = a->ws;
    const bf16* P = (const bf16*)(ws + WS_P); const bf16* OB = (const bf16*)(ws + WS_OB); const bf16* OC = (const bf16*)(ws + WS_OC); bf16* Y = (bf16*)(ws + WS_Y);
    bf16* Yo = dry ? (bf16*)(ws + WS_END) : Y;
    const int nrows = (l == DEPTH - 1) ? NLAT : MALL;
    const int rpw = (nrows + NGW - 1) / NGW; const int r0 = gw * rpw, r1 = (r0 + rpw < nrows) ? r0 + rpw : nrows;
    f32x4 hng[3], gng[3], gnb[3];
#pragma unroll
    for (int k = 0; k < 3; ++k) { const int c = 256 * k + 4 * lane; hng[k] = *(const f32x4*)(a->in[I_HNG] + (size_t)l * BW + c);
        gng[k] = *(const f32x4*)(a->in[I_GNGG] + (size_t)l * CW + c); gnb[k] = *(const f32x4*)(a->in[I_GNB] + (size_t)l * CW + c); }
    for (int row = r0; row < r1; ++row) {
        const int orow = dry ? (row & 2047) : row;
        u32x2 bf_[3], bb_[3], bg_[3], cf_[3], cb_[3], cv_[3], cg_[3];
#pragma unroll
        for (int k = 0; k < 3; ++k) { const int c = 256 * k + 4 * lane;
            bf_[k] = *(const u32x2*)(OB + (size_t)row * BW + c); bb_[k] = *(const u32x2*)(OB + ((size_t)MALL + row) * BW + c); bg_[k] = *(const u32x2*)(P + (size_t)row * INC + OFF_OG + c);
            cf_[k] = *(const u32x2*)(OC + (size_t)row * CW + c); cb_[k] = *(const u32x2*)(OC + ((size_t)MALL + row) * CW + c);
            cv_[k] = *(const u32x2*)(Y + (size_t)row * D + 512 + c);
            cg_[k] = *(const u32x2*)(Y + (size_t)row * D + 1280 + c); }
#pragma unroll
        for (int k = 0; k < 3; ++k) { const int c = 256 * k + 4 * lane;
            { float o[4] = {bflo(bf_[k].x) + bflo(bb_[k].x), bfhi(bf_[k].x) + bfhi(bb_[k].x), bflo(bf_[k].y) + bflo(bb_[k].y), bfhi(bf_[k].y) + bfhi(bb_[k].y)};
              const float ss = grp_sum32((o[0] * o[0] + o[1] * o[1]) + (o[2] * o[2] + o[3] * o[3])); const float rstd = 1.0f / sqrtf(ss * (1.0f / 128.0f) + NORM_EPS);
              const float g4[4] = {bflo(bg_[k].x), bfhi(bg_[k].x), bflo(bg_[k].y), bfhi(bg_[k].y)}; float y[4];
#pragma unroll
              for (int j = 0; j < 4; ++j) y[j] = o[j] * rstd * hng[k][j] * sigmoidf_(g4[j]);
              u32x2 q; q.x = pk2(y[0], y[1]); q.y = pk2(y[2], y[3]); *(u32x2*)(Yo + (size_t)orow * D + 512 + c) = q; }
            { float o[4] = {bflo(cf_[k].x) + bflo(cb_[k].x), bfhi(cf_[k].x) + bfhi(cb_[k].x), bflo(cf_[k].y) + bflo(cb_[k].y), bfhi(cf_[k].y) + bfhi(cb_[k].y)};
              const float v4[4] = {bflo(cv_[k].x), bfhi(cv_[k].x), bflo(cv_[k].y), bfhi(cv_[k].y)}, g4[4] = {bflo(cg_[k].x), bfhi(cg_[k].x), bflo(cg_[k].y), bfhi(cg_[k].y)};
              const float mean = grp_sum16((o[0] + o[1]) + (o[2] + o[3])) * (1.0f / 64.0f);
              float dl[4]; float sq = 0.f;
#pragma unroll
              for (int j = 0; j < 4; ++j) { dl[j] = o[j] - mean; sq += dl[j] * dl[j]; }
              const float var = grp_sum16(sq) * (1.0f / 64.0f); const float rs = 1.0f / sqrtf(var + GN_EPS); float y[4];
#pragma unroll
              for (int j = 0; j < 4; ++j) y[j] = (dl[j] * rs * gng[k][j] + gnb[k][j] + v4[j]) * g4[j];
              u32x2 q; q.x = pk2(y[0], y[1]); q.y = pk2(y[2], y[3]); *(u32x2*)(Yo + (size_t)orow * D + 1280 + c) = q; }
        }
    }
}

__global__ void __launch_bounds__(NTHREADS, 2) mk_fwd(Args args_unused) {
    extern __shared__ __attribute__((aligned(16))) unsigned char lds_raw[];
    LAS unsigned char* lds = (LAS unsigned char*)lds_raw;
    volatile LAS unsigned* misc = (volatile LAS unsigned*)(lds + LDS_MISC);
    const int tid = threadIdx.x, G = gridDim.x;
    if (tid < 64) misc[tid] = 0u;
    __syncthreads();
    XcdBarrier bar; bar.bar = nullptr; bar.x = 0; bar.st = nullptr;
    int lo, hi;
    { KArgs a = kargs(); lo = a->ph_lo; hi = a->ph_hi; unsigned* ctl = (unsigned*)(a->ws + WS_CTL); bar.bar = ctl + CW_BAR; if (!MK_MULTI) bar = xcd_barrier_post(ctl + CW_BAR, misc + 8); }
    const int cvirt = (G % 8 == 0) ? ((int)blockIdx.x % 8) * (G / 8) + (int)blockIdx.x / 8 : (int)blockIdx.x;
#define IN(k) (lo <= (k) && (k) < hi)
#define PM(b) ((PHMASK >> (b)) & 1)
#define REP(b) _Pragma("unroll 1") for (int rep_ = 0; rep_ < 1 + ((PROBE_DUP >> (b)) & 1); ++rep_)
#define SEAM(k) do { if (!MK_MULTI && IN(k) && IN((k) + 1)) { xcd_barrier(bar); if ((PROBE_DUP >> 13) & 1) xcd_barrier(bar); } } while (0)

    if (PM(0) && IN(0)) REP(0) { phase_prologue(kargs(), lds); } SEAM(0);

#pragma unroll 1
    for (int l = 0; l < DEPTH; ++l) {
        const int pb = 1 + 9 * l;
        const bool lastl = (l == DEPTH - 1);
        if (PM(1) && IN(pb + 0)) { if ((PROBE_DUP >> 1) & 1) { if (l == 0) phase_norm1<0>(kargs(), l, true); else phase_norm1<1>(kargs(), l, true); } if (l == 0) phase_norm1<0>(kargs(), l, false); else { phase_norm1<1>(kargs(), l, false); __syncthreads(); convert_moe(kargs(), l, lds); __syncthreads(); } } SEAM(pb + 0);
        if (PM(2) && IN(pb + 1)) REP(2) {
            KArgs a = kargs(); unsigned char* ws = a->ws;
            pg8::Gemm g{(const bf16*)(ws + WS_H), (const bf16*)(ws + WS_WIN) + (size_t)l * INC * D, MALL, INC, D};
            pg8::StaticOrder S; S.init(MALL, INC, G, (int)blockIdx.x);
            pg8::EpiBf16 E{(bf16*)(ws + WS_P), INC};
            pg8::gemm_phase<pg8::EpiBf16, pg8::StaticOrder, false, false>(lds, g, S, E, nullptr);
        } SEAM(pb + 1);
        if (PM(3) && IN(pb + 2)) {
            const int ngm = lastl ? 1024 : 1088;
            unsigned* qhead = (unsigned*)(kargs()->ws + WS_CTL) + CW_PREPQ + 64 * l;
            const int n_rw = 544 * 3, n_hg = 3264, n_all = n_rw + n_hg + ngm;
            for (;;) {
                if (threadIdx.x == 0) misc[16] = __hip_atomic_fetch_add(qhead, 1u, __ATOMIC_RELAXED, __HIP_MEMORY_SCOPE_AGENT);
                __syncthreads();
                const int it = (int)misc[16];
                if (it >= n_all) break;
                if (it < n_rw) { _Pragma("unroll 1") for (int r2 = 0; r2 < 1 + ((PROBE_DUP >> 15) & 1); ++r2) rwkv_prep_item(kargs(), l, it / 3, it % 3, lds); }
                else if (it < n_rw + n_hg) { if ((PROBE_DUP >> 16) & 1) hgrn_prep_item(kargs(), l, it - n_rw, lds, true); hgrn_prep_item(kargs(), l, it - n_rw, lds, false); }
                else { _Pragma("unroll 1") for (int r2 = 0; r2 < 1 + ((PROBE_DUP >> 14) & 1); ++r2) gmlp_item(kargs(), l, it - n_rw - n_hg, lds); }
            }
            __syncthreads();
        } SEAM(pb + 2);
        if (PM(4) && IN(pb + 3)) REP(4) {
            if (G == 256) { const int bx = blockIdx.x;
                if (bx < 96) { _Pragma("unroll 1") for (int r2 = 0; r2 < 1 + ((PROBE_DUP >> 12) & 1); ++r2) rwkv_chain_mfma(kargs(), bx * 8, lds); }
                else if (bx < 192) { _Pragma("unroll 1") for (int r2 = 0; r2 < 1 + ((PROBE_DUP >> 11) & 1); ++r2) hgrn_chain_lean(kargs(), bx - 96, lds); } }
            else { for (int it = blockIdx.x; it < 192; it += G) { if (it < 96) rwkv_chain_mfma(kargs(), it * 8, lds); else hgrn_chain_lean(kargs(), it - 96, lds); } }
        } SEAM(pb + 3);
        if (PM(5) && IN(pb + 4)) { if ((PROBE_DUP >> 5) & 1) phase_finalize(kargs(), l, true); phase_finalize(kargs(), l, false); } SEAM(pb + 4);
        if (PM(6) && IN(pb + 5)) REP(6) {
            KArgs a = kargs(); unsigned char* ws = a->ws;
            const int Mo = lastl ? NLAT : MALL;
            pg8::Gemm g{(const bf16*)(ws + WS_Y), (const bf16*)(ws + WS_WOUT) + (size_t)l * D * D, Mo, D, D};
            pg8::StaticOrder S; S.init(Mo, D, G, (int)blockIdx.x);
            const float* xl = l == 0 ? a->in[I_X] : (const float*)(ws + WS_X); const float* xc = l == 0 ? a->in[I_CTX] : (const float*)(ws + WS_X) + (size_t)NLAT * D;
            pg8::EpiResid E{xl, xc, (float*)(ws + WS_X), (const float*)(ws + WS_MOD) + (size_t)l * 9 * 12288 + 2 * D};
            pg8::gemm_phase<pg8::EpiResid, pg8::StaticOrder, true, false>(lds, g, S, E, nullptr);
        } SEAM(pb + 5);
        if (PM(7) && IN(pb + 6)) { if ((PROBE_DUP >> 7) & 1) phase_norm2_router(kargs(), l, true, lds); phase_norm2_router(kargs(), l, false, lds); } SEAM(pb + 6);
        if (PM(8) && IN(pb + 7)) REP(8) {
            KArgs a = kargs(); unsigned char* ws = a->ws;
            moe_tables<false>(a, l, lds, cvirt);
            pg8::Gemm g{(const bf16*)(ws + WS_H), (const bf16*)(ws + WS_WGU), 0, 2048, D};
            pg8::MoeOrder S{(const LAS int*)(lds + LDS_TP), G, cvirt, (unsigned)(2048 * D * 2)};
            pg8::EpiSwiglu E{(bf16*)(ws + WS_ACT)};
            pg8::gemm_phase<pg8::EpiSwiglu, pg8::MoeOrder, false, true>(lds, g, S, E, (const LAS unsigned*)(lds + LDS_TAB));
        } SEAM(pb + 7);
        if (PM(9) && IN(pb + 8)) REP(9) {
            KArgs a = kargs(); unsigned char* ws = a->ws;
            moe_tables<true>(a, l, lds, cvirt);
            pg8::Gemm g{(const bf16*)(ws + WS_ACT), (const bf16*)(ws + WS_WDN), 0, D, DE};
            pg8::MoeOrder S{(const LAS int*)(lds + LDS_TP), G, cvirt, (unsigned)(D * DE * 2)};
            pg8::EpiDown E{(bf16*)(ws + WS_YK), (const LAS unsigned*)(lds + LDS_TAB), (const LAS float*)(lds + LDS_TABW)};
            pg8::gemm_phase<pg8::EpiDown, pg8::MoeOrder, false, false>(lds, g, S, E, nullptr);
        } SEAM(pb + 8);
    }
    if (PM(10) && IN(1 + 9 * DEPTH)) { if ((PROBE_DUP >> 10) & 1) phase_norm1<2>(kargs(), DEPTH, true); phase_norm1<2>(kargs(), DEPTH, false); }
#undef IN
#undef SEAM
}

extern "C" void kernel_launch(void* const* d_in, const int* in_sizes, int n_in, void* d_out, int out_size, void* d_ws, size_t ws_size, hipStream_t stream) {
    static int grid = 0;
    if (grid == 0) {
        if (n_in != 31 || ws_size < WS_END) { fprintf(stderr, "kernel_launch: unexpected n_in %d / ws %zu (need %zu)\n", n_in, ws_size, (size_t)WS_END); grid = -1; return; }
        int dev = 0, cus = 0, per_cu = 0;
        hipGetDevice(&dev); hipDeviceGetAttribute(&cus, hipDeviceAttributeMultiprocessorCount, dev);
        if (hipFuncSetAttribute((const void*)mk_fwd, hipFuncAttributeMaxDynamicSharedMemorySize, LDS_BYTES) != hipSuccess) { fprintf(stderr, "kernel_launch: hipFuncSetAttribute failed\n"); grid = -1; return; }
        if (hipOccupancyMaxActiveBlocksPerMultiprocessor(&per_cu, (const void*)mk_fwd, NTHREADS, LDS_BYTES) != hipSuccess || per_cu < 1) fprintf(stderr, "kernel_launch: occupancy query says %d\n", per_cu);
        (void)hipGetLastError();
        grid = cus > 0 ? cus : 256;
    }
    if (grid < 0) return;
    hipMemsetAsync((char*)d_ws + WS_CTL, 0, CTL_ZERO_BYTES, stream);
    Args a{};
    for (int i = 0; i < 31; ++i) a.in[i] = (const float*)d_in[i];
    a.out = (float*)d_out; a.ws = (unsigned char*)d_ws;
    constexpr int NPH = 2 + 9 * DEPTH;
#if MK_MULTI
    for (int p = 0; p < NPH; ++p) { a.ph_lo = p; a.ph_hi = p + 1; hipLaunchKernelGGL(mk_fwd, dim3(grid), dim3(NTHREADS), LDS_BYTES, stream, a); }
#else
    a.ph_lo = 0; a.ph_hi = NPH; hipLaunchKernelGGL(mk_fwd, dim3(grid), dim3(NTHREADS), LDS_BYTES, stream, a);
#endif
}
```

```cpp
#include <hip/hip_runtime.h>
#include <cstdio>
#include <cstdint>

#ifndef PHMASK
#define PHMASK 0xFFFF
#endif
#ifndef PROBE_DUP
#define PROBE_DUP 0
#endif
#ifndef MK_MULTI
#define MK_MULTI 0
#endif

#define GAS __attribute__((address_space(1)))
#define LAS __attribute__((address_space(3)))
typedef unsigned short bf16;
typedef short bf16x8 __attribute__((ext_vector_type(8)));
typedef float f32x4 __attribute__((ext_vector_type(4)));
typedef float f32x2 __attribute__((ext_vector_type(2)));
typedef unsigned u32x4 __attribute__((ext_vector_type(4)));
typedef unsigned u32x2 __attribute__((ext_vector_type(2)));

constexpr int D = 2048, NB = 8, T = 4096, CTXL = 256, DEPTH = 2;
constexpr int NLAT = NB * T, NCTX = NB * CTXL, MALL = NLAT + NCTX;
constexpr int INC = 7424;
constexpr int OFF_U = 0, OFF_V = 512, OFF_Q = 1024, OFF_I = 1792, OFF_ZF = 2560, OFF_ZB = 3328, OFF_OG = 4096;
constexpr int OFF_C = 4864;
constexpr int BW = 768, CW = 768, CCOLS = 2560;
constexpr int NE = 16, DE = 1024;
constexpr int PC2W = 7 * 768;
constexpr int NTHREADS = 512;
constexpr float NORM_EPS = 1e-6f, GN_EPS = 64e-5f, DECAY_SCALE = 0.60653065971263342f;

constexpr size_t MiB = 1u << 20;
constexpr size_t WS_CTL = 0, CTL_ZERO_BYTES = 1 * MiB;
constexpr size_t WS_MOD = 1 * MiB;
constexpr size_t WS_SMALLW = 2 * MiB;
constexpr size_t SW_WUP = 0, SW_AUP = SW_WUP + (size_t)2 * 2 * 768 * 64 * 2, SW_GUP = SW_AUP + (size_t)2 * 768 * 64 * 2, SW_GWS = SW_GUP + (size_t)2 * 768 * 128 * 2;
constexpr size_t WS_WIN = 4 * MiB, WS_WOUT = 62 * MiB, WS_WGU = 78 * MiB, WS_WDN = 206 * MiB;
constexpr size_t WS_X = 270 * MiB, WS_H = 542 * MiB, WS_Y = 678 * MiB, WS_P = 814 * MiB, WS_PRE = 1307 * MiB, WS_VT = 1817 * MiB, WS_OC = 1868 * MiB, WS_HQB = 1970 * MiB, WS_HG = 2021 * MiB, WS_END = 2028 * MiB;
constexpr int PRE_REC = 10240, PR_WP = 0, PR_RP = 2048, PR_BK = 4096, PR_ARBK = 8192, PR_MAK = 9216, PR_GAM = 9728, NCHUNK16 = 272;
constexpr size_t WS_OB = WS_H;
constexpr size_t WS_ACT = WS_P, WS_YK = WS_P + 144 * MiB, WS_RIDX = WS_P + 416 * MiB, WS_RW = WS_RIDX + 3 * MiB;
static_assert(WS_RW + 3 * MiB <= WS_PRE, "moe overlay");
constexpr int MAXSLOT_TILES = 288;
constexpr int CW_BAR = 4096;
constexpr int CW_GMQ = 30720;
constexpr int CW_PREPQ = 28672;
constexpr int CW_CNT = 16384;

constexpr int LDS_STAGE = 0, LDS_TAB = 131072, LDS_TABW = LDS_TAB + 9 * 1024, LDS_TP = LDS_TABW + 9 * 1024, LDS_MISC = 150528, LDS_BYTES = 152 * 1024;
static_assert(LDS_TP + 128 <= LDS_MISC, "lds map");

typedef __bf16 bf16x2_t __attribute__((ext_vector_type(2)));
__device__ __forceinline__ unsigned pk2(float lo, float hi) { const f32x2 v = {lo, hi}; return __builtin_bit_cast(unsigned, __builtin_convertvector(v, bf16x2_t)); }
__device__ __forceinline__ unsigned f2bf(float f) { return pk2(f, f) & 0xffffu; }
__device__ __forceinline__ float bflo(unsigned u) { return __builtin_bit_cast(float, u << 16); }
__device__ __forceinline__ float bfhi(unsigned u) { return __builtin_bit_cast(float, u & 0xffff0000u); }
__device__ __forceinline__ float bf1(bf16 b) { return __builtin_bit_cast(float, ((unsigned)b) << 16); }
__device__ __forceinline__ float sigmoidf_(float x) { return __builtin_amdgcn_rcpf(1.0f + __expf(-x)); }
__device__ __forceinline__ float siluf_(float x) { return x * __builtin_amdgcn_rcpf(1.0f + __expf(-x)); }
__device__ __forceinline__ float geluf_(float v) {
    const float av = fabsf(v), t = __builtin_amdgcn_rcpf(av * 0.2316418882f + 1.0f);
    float q = t * 0.5307027145f + (-0.7265760135f); q = q * t + 0.7107068705f; q = q * t + (-0.142248368f); q = q * t + 0.127414796f; q = q * t;
    const float e = __builtin_amdgcn_exp2f((v * v) * (-0.72134752044f)); const float m = v * (q * e); return v < 0.f ? m : v - m; }
__device__ __forceinline__ float wave_sum(float v) {
#pragma unroll
    for (int o = 1; o < 64; o <<= 1) v += __shfl_xor(v, o);
    return v;
}
__device__ __forceinline__ int tid_fresh() { int t = threadIdx.x; asm volatile("" : "+v"(t)); return t; }
__device__ __forceinline__ void unpack8(const u32x4 v, float (&f)[8]) {
    f[0] = bflo(v.x); f[1] = bfhi(v.x); f[2] = bflo(v.y); f[3] = bfhi(v.y); f[4] = bflo(v.z); f[5] = bfhi(v.z); f[6] = bflo(v.w); f[7] = bfhi(v.w);
}
__device__ __forceinline__ u32x4 pack8(const float (&f)[8]) { u32x4 v; v.x = pk2(f[0], f[1]); v.y = pk2(f[2], f[3]); v.z = pk2(f[4], f[5]); v.w = pk2(f[6], f[7]); return v; }
__device__ __forceinline__ int modrow_of(int row) { return row < NLAT ? (row >> 12) : 8; }

#define XB_TMO      128
#define XB_XCNT(j)  (256  + 64 * (j))
#define XB_XSUB(j)  (1280 + 64 * (j))
#define XB_XGEN(j)  (2304 + 64 * (j))
#define XB_TOP      3328
#define XB_TOPGEN   3392
#define XCD_BAR_WORDS 3456
#define XB_SPIN_CAP (1u << 18)
__device__ __forceinline__ unsigned xb_ld(unsigned* p)              { return __hip_atomic_load(p, __ATOMIC_RELAXED, __HIP_MEMORY_SCOPE_AGENT); }
__device__ __forceinline__ unsigned xb_add(unsigned* p, unsigned v) { return __hip_atomic_fetch_add(p, v, __ATOMIC_RELAXED, __HIP_MEMORY_SCOPE_AGENT); }
__device__ __forceinline__ unsigned xb_xcc_id() { return (unsigned)__builtin_amdgcn_s_getreg((3 << 11) | 20) & 0xFu; }
#define XB_SPIN(cond, bar) do { unsigned _sp = 0; while (cond) { __builtin_amdgcn_s_sleep(1); \
    if ((++_sp & 255u) == 0u) { if (xb_ld(&(bar)[XB_TMO])) break; if (_sp > XB_SPIN_CAP) { atomicAdd(&(bar)[XB_TMO], 1u); break; } } } } while (0)
struct XcdBarrier { unsigned* bar; unsigned x; volatile LAS unsigned* st; };
__device__ __forceinline__ XcdBarrier xcd_barrier_post(unsigned* bar, volatile LAS unsigned* st) {
    XcdBarrier b; b.bar = bar; b.x = xb_xcc_id(); b.st = st;
    if (threadIdx.x == 0) (void)xb_add(&bar[XB_XCNT(b.x)], 1u);
    return b;
}
__device__ __forceinline__ void xcd_barrier_complete(unsigned* bar, unsigned x, unsigned& nloc, unsigned& nx) {
    const unsigned G = gridDim.x * gridDim.y * gridDim.z;
    unsigned sum, cnt, mine, sp = 0u;
    for (;;) {
        sum = 0u; cnt = 0u; mine = 0u;
#pragma unroll
        for (unsigned j = 0; j < 16; ++j) { const unsigned c = xb_ld(&bar[XB_XCNT(j)]); sum += c; cnt += (c > 0u) ? 1u : 0u; mine = (j == x) ? c : mine; }
        if (sum == G) break;
        __builtin_amdgcn_s_sleep(1);
        if ((++sp & 255u) == 0u) { if (xb_ld(&bar[XB_TMO])) break; if (sp > XB_SPIN_CAP) { atomicAdd(&bar[XB_TMO], 1u); break; } }
    }
    nloc = mine > 0u ? mine : 1u; nx = cnt > 0u ? cnt : 1u;
}
__device__ __forceinline__ void xcd_barrier(const XcdBarrier& b) {
    asm volatile("s_waitcnt vmcnt(0)" ::: "memory");
    __syncthreads();
    if (threadIdx.x == 0) {
        unsigned* bar = b.bar;
        __builtin_amdgcn_s_waitcnt(0);
        unsigned nloc = b.st[0], nx = b.st[1];
        if (nloc == 0u) { xcd_barrier_complete(bar, b.x, nloc, nx); b.st[0] = nloc; b.st[1] = nx; }
        const unsigned old = xb_add(&bar[XB_XSUB(b.x)], 1u);
        const unsigned gen = old / nloc;
        if (old + 1u == (gen + 1u) * nloc) {
            __builtin_amdgcn_fence(__ATOMIC_RELEASE, "agent");
            asm volatile("s_waitcnt vmcnt(0)" ::: "memory");
            const unsigned og = xb_add(&bar[XB_TOP], 1u);
            const unsigned tg = og / nx;
            if (og + 1u == (tg + 1u) * nx) xb_add(&bar[XB_TOPGEN], 1u);
            else XB_SPIN(xb_ld(&bar[XB_TOPGEN]) == tg, bar);
            __builtin_amdgcn_fence(__ATOMIC_ACQUIRE, "agent");
            xb_add(&bar[XB_XGEN(b.x)], 1u);
            asm volatile("s_waitcnt vmcnt(0)" ::: "memory");
        } else {
            XB_SPIN(xb_ld(&bar[XB_XGEN(b.x)]) == gen, bar);
            __builtin_amdgcn_fence(__ATOMIC_ACQUIRE, "agent");
            asm volatile("s_waitcnt vmcnt(0)" ::: "memory");
        }
    }
    __syncthreads();
}

namespace pg8 {
constexpr int BM = 256, BK = 64, HALF = 128, HTB = HALF * BK * 2, STAGE_BYTES = 8 * HTB, NXCD = 8, WGM = 8;
__host__ __device__ __forceinline__ int lds_byte(int r, int c) { const int st = (r >> 4) * 2 + (c >> 5), rr = r & 15, cc = c & 31, ob = rr * 64 + cc * 2; return st * 1024 + (ob ^ (((ob >> 9) & 1) << 5)); }
__host__ __device__ __forceinline__ void stage_rc(int b, int& R, int& C) { const int st = b / 1024, sb = b % 1024, swz = sb ^ (((sb >> 9) & 1) << 5); R = (st >> 1) * 16 + swz / 64; C = (st & 1) * 32 + (swz % 64) / 2; }
__host__ __device__ __forceinline__ int perm32(int rho) { const int n = rho >> 4, i = rho & 15; return 8 * (i >> 2) + 4 * n + (i & 3); }

struct Unit { int pm, pn, e, aux; };
struct Gemm { const bf16* A; const bf16* Bt; int M, N, K; };

struct StaticOrder {
    int nM, nN, nwg, G, c;
    __device__ void init(int M, int N, int G_, int c_) { nM = M / BM; nN = N / BM; nwg = nM * nN; G = G_; c = c_; }
    __device__ bool next(int i, Unit& u) const {
        const long L = (long)i * G + c; if (L >= nwg) return false;
        int wgid = (int)L; { const int q = nwg / NXCD, r = nwg % NXCD, xcd = wgid % NXCD, off = wgid / NXCD; wgid = (xcd < r ? xcd * (q + 1) : r * (q + 1) + (xcd - r) * q) + off; }
        const int nig = WGM * nN, gid = wgid / nig, fm = gid * WGM, gsz = (nM - fm) < WGM ? (nM - fm) : WGM;
        u.pm = fm + ((wgid % nig) % gsz); u.pn = (wgid % nig) / gsz; u.e = 0; u.aux = 0; return true;
    }
    __device__ __forceinline__ unsigned b_off(const Unit& u, unsigned tstep) const { return (unsigned)u.pn * tstep; }
};
struct MoeOrder {
    const LAS int* tp; int G, c; unsigned estride;
    __device__ bool next(int i, Unit& u) const {
        const int L = i * G + c; const int ntot = tp[16] * 8; if (L >= ntot) return false;
        const int tile = L >> 3; int e = 0;
#pragma unroll
        for (int j = 1; j < 16; ++j) e += (tile >= tp[j]) ? 1 : 0;
        u.pm = tile; u.pn = L & 7; u.e = e; u.aux = i; return true;
    }
    __device__ __forceinline__ unsigned b_off(const Unit& u, unsigned tstep) const { return (unsigned)u.e * estride + (unsigned)u.pn * tstep; }
};

#define PG8_LAS __attribute__((address_space(3)))
template <class Epi, class Sched, bool ALIGN_EPI, bool GATHER>
__device__ __forceinline__ void gemm_phase(PG8_LAS unsigned char* lds, const Gemm g, const Sched& S, const Epi& E, const PG8_LAS unsigned* tabA) {
    const int tid = tid_fresh(), wid = __builtin_amdgcn_readfirstlane(tid >> 6), lane = tid & 63, wr = wid >> 2, wc = wid & 3, fr = lane & 15, fq = lane >> 4;
    const int K = g.K, nt = K / BK;
    int sR[2], sC[2];
    unsigned voffB[2];
#pragma unroll
    for (int i = 0; i < 2; ++i) { int R, C; stage_rc(tid * 16 + i * 8192, R, C); sR[i] = R; sC[i] = C; const int Rb = Epi::PERM ? ((R & ~31) + perm32(R & 31)) : R;
        voffB[i] = (unsigned)(Rb * K + C) * 2u; }
    const unsigned kstep = (unsigned)(BK * 2);
    const unsigned hstep = (unsigned)(HALF * K * 2);
    const unsigned tstep = 2u * hstep;
    const unsigned ldsw = (unsigned)wid * 1024u;
    const char* const baseA = (const char*)g.A; const char* const baseB = (const char*)g.Bt;
    const int aoff = lds_byte(wr * 64 + fr, fq * 8), boff = lds_byte(wc * 32 + fr, fq * 8);
#define PG8_SA(b, h) (((b) * 2 + (h)) * HTB)
#define PG8_SB(b, h) ((4 + (b) * 2 + (h)) * HTB)
#define PG8_STAGE(bufoff, gbase, uoff, voff) do { _Pragma("unroll") for (int _i = 0; _i < 2; ++_i) \
        __builtin_amdgcn_global_load_lds((const unsigned*)((gbase) + (size_t)(unsigned)((uoff) + (voff)[_i])), (PG8_LAS unsigned*)(lds + (bufoff) + ldsw + _i * 8192), 16, 0, 0); } while (0)
#define PG8_LDA(dst, b, h) do { _Pragma("unroll") for (int m = 0; m < 4; ++m) _Pragma("unroll") for (int k = 0; k < 2; ++k) dst[m][k] = *(const PG8_LAS bf16x8*)(lds + PG8_SA(b, h) + aoff + m * 2048 + k * 1024); } while (0)
#define PG8_LDB(dst, b, h) do { _Pragma("unroll") for (int n = 0; n < 2; ++n) _Pragma("unroll") for (int k = 0; k < 2; ++k) dst[n][k] = *(const PG8_LAS bf16x8*)(lds + PG8_SB(b, h) + boff + n * 2048 + k * 1024); } while (0)
#define PG8_MMA(ai, bj, At, Bt) do { __builtin_amdgcn_s_setprio(1); _Pragma("unroll") for (int m = 0; m < 4; ++m) _Pragma("unroll") for (int n = 0; n < 2; ++n) _Pragma("unroll") for (int k = 0; k < 2; ++k) \
        acc[ai][bj][m][n] = __builtin_amdgcn_mfma_f32_16x16x32_bf16(Bt[n][k], At[m][k], acc[ai][bj][m][n], 0, 0, 0); __builtin_amdgcn_s_setprio(0); } while (0)
#define PG8_WAIT_V(n) asm volatile("s_waitcnt vmcnt(" #n ")" ::: "memory")
#define PG8_WAIT_L(n) asm volatile("s_waitcnt lgkmcnt(" #n ")" ::: "memory")
#define PG8_BAR __builtin_amdgcn_s_barrier()
#define PG8_SCHED __builtin_amdgcn_sched_barrier(0)
    Unit cur, nxt; int ui = 0;
    if (!S.next(0, cur)) return;
    f32x4 acc[2][2][4][2];
#pragma unroll
    for (int a = 0; a < 2; ++a)
#pragma unroll
        for (int b = 0; b < 2; ++b)
#pragma unroll
            for (int m = 0; m < 4; ++m)
#pragma unroll
                for (int n = 0; n < 2; ++n) acc[a][b][m][n] = (f32x4){0.f, 0.f, 0.f, 0.f};
    bf16x8 At[4][2], B0[2][2], B1[2][2];
    unsigned vA0[2], vA1[2], nA0[2], nA1[2];
    unsigned uA, uB = S.b_off(cur, tstep);
    if constexpr (GATHER) { uA = 0u;
#pragma unroll
        for (int i = 0; i < 2; ++i) { vA0[i] = tabA[cur.aux * 256 + sR[i]] + (unsigned)sC[i] * 2u; vA1[i] = tabA[cur.aux * 256 + 128 + sR[i]] + (unsigned)sC[i] * 2u; }
    } else { uA = (unsigned)cur.pm * tstep;
#pragma unroll
        for (int i = 0; i < 2; ++i) { vA0[i] = (unsigned)(sR[i] * K + sC[i]) * 2u; vA1[i] = vA0[i] + hstep; }
    }
    PG8_STAGE(PG8_SB(0, 0), baseB, uB, voffB); PG8_STAGE(PG8_SB(0, 1), baseB, uB + hstep, voffB); PG8_STAGE(PG8_SA(0, 0), baseA, uA, vA0); PG8_STAGE(PG8_SA(0, 1), baseA, uA, vA1);
    if (wr == 1) PG8_BAR;
    PG8_WAIT_V(2); PG8_BAR;
    PG8_STAGE(PG8_SB(1, 0), baseB, uB + kstep, voffB); PG8_STAGE(PG8_SA(1, 0), baseA, uA + kstep, vA0); PG8_STAGE(PG8_SB(1, 1), baseB, uB + hstep + kstep, voffB);
    PG8_WAIT_V(6); PG8_BAR;
    for (;;) {
        const bool has_next = S.next(ui + 1, nxt);
        unsigned nuA, nuB = has_next ? S.b_off(nxt, tstep) : uB;
        if constexpr (GATHER) { nuA = 0u;
#pragma unroll
            for (int i = 0; i < 2; ++i) { if (has_next) { nA0[i] = tabA[nxt.aux * 256 + sR[i]] + (unsigned)sC[i] * 2u; nA1[i] = tabA[nxt.aux * 256 + 128 + sR[i]] + (unsigned)sC[i] * 2u; } else { nA0[i] = vA0[i]; nA1[i] = vA1[i]; } }
        } else { nuA = has_next ? (unsigned)nxt.pm * tstep : uA;
#pragma unroll
            for (int i = 0; i < 2; ++i) { nA0[i] = vA0[i]; nA1[i] = vA1[i]; }
        }
        for (int t = 0; t < nt; t += 2) {
            const bool last = (t == nt - 2);
            const unsigned a1 = uA + (unsigned)(t + 1) * kstep;
            const unsigned a2 = last ? nuA : uA + (unsigned)(t + 2) * kstep; const unsigned b2 = last ? nuB : uB + (unsigned)(t + 2) * kstep;
            const unsigned a3 = a2 + kstep; const unsigned b3 = b2 + kstep;
            unsigned w0[2], w1[2];
#pragma unroll
            for (int i = 0; i < 2; ++i) { w0[i] = (GATHER && last) ? nA0[i] : vA0[i]; w1[i] = (GATHER && last) ? nA1[i] : vA1[i]; }
            PG8_LDB(B0, 0, 0); PG8_LDB(B1, 0, 1); PG8_SCHED; PG8_LDA(At, 0, 0); PG8_STAGE(PG8_SA(1, 1), baseA, a1, vA1);
            PG8_WAIT_V(8); PG8_WAIT_L(0); PG8_BAR; PG8_MMA(0, 0, At, B0); PG8_MMA(0, 1, At, B1); PG8_BAR; PG8_SCHED;
            PG8_LDA(At, 0, 1); PG8_STAGE(PG8_SB(0, 0), baseB, b2, voffB); PG8_STAGE(PG8_SB(0, 1), baseB, b2 + hstep, voffB); PG8_STAGE(PG8_SA(0, 0), baseA, a2, w0);
            PG8_WAIT_V(8); PG8_WAIT_L(0); PG8_BAR; PG8_MMA(1, 0, At, B0); PG8_MMA(1, 1, At, B1); PG8_BAR; PG8_SCHED;
            PG8_LDB(B0, 1, 0); PG8_LDB(B1, 1, 1); PG8_SCHED; PG8_LDA(At, 1, 0); PG8_STAGE(PG8_SA(0, 1), baseA, a2, w1);
            PG8_WAIT_V(8); PG8_WAIT_L(0); PG8_BAR; PG8_MMA(0, 0, At, B0); PG8_MMA(0, 1, At, B1); PG8_BAR; PG8_SCHED;
            PG8_LDA(At, 1, 1); PG8_STAGE(PG8_SB(1, 0), baseB, b3, voffB); PG8_STAGE(PG8_SB(1, 1), baseB, b3 + hstep, voffB); PG8_STAGE(PG8_SA(1, 0), baseA, a3, w0);
            PG8_WAIT_V(8); PG8_WAIT_L(0); PG8_BAR; PG8_MMA(1, 0, At, B0); PG8_MMA(1, 1, At, B1); PG8_BAR; PG8_SCHED;
        }
        if constexpr (ALIGN_EPI) { if (wr == 0) PG8_BAR; }
        E(acc, cur, wr, wc, fr, fq);
        if (!has_next) break;
#pragma unroll
        for (int a = 0; a < 2; ++a)
#pragma unroll
            for (int b = 0; b < 2; ++b)
#pragma unroll
                for (int m = 0; m < 4; ++m)
#pragma unroll
                    for (int n = 0; n < 2; ++n) acc[a][b][m][n] = (f32x4){0.f, 0.f, 0.f, 0.f};
        cur = nxt; uA = nuA; uB = nuB; ++ui;
#pragma unroll
        for (int i = 0; i < 2; ++i) { vA0[i] = nA0[i]; vA1[i] = nA1[i]; }
        if constexpr (ALIGN_EPI) { if (wr == 1) PG8_BAR; }
    }
    PG8_WAIT_V(0);
    if constexpr (!ALIGN_EPI) { if (wr == 0) PG8_BAR; }
    PG8_BAR;
#undef PG8_SA
#undef PG8_SB
#undef PG8_STAGE
#undef PG8_LDA
#undef PG8_LDB
#undef PG8_MMA
#undef PG8_WAIT_V
#undef PG8_WAIT_L
#undef PG8_BAR
#undef PG8_SCHED
}

__device__ __forceinline__ unsigned cvt_pk_bf16(float lo, float hi) { return pk2(lo, hi); }

struct EpiBf16 {
    static constexpr bool PERM = true;
    bf16* O; int ldc;
    __device__ __forceinline__ void operator()(const f32x4 (&acc)[2][2][4][2], const Unit& u, int wr, int wc, int fr, int fq) const {
        const int row0 = u.pm * BM + wr * 64 + fr; const int col0 = u.pn * BM + wc * 32 + 8 * fq;
#pragma unroll
        for (int ai = 0; ai < 2; ++ai)
#pragma unroll
            for (int m = 0; m < 4; ++m) { bf16* rowp = O + (size_t)(row0 + ai * HALF + m * 16) * ldc + col0;
#pragma unroll
                for (int bj = 0; bj < 2; ++bj) { const f32x4 v0 = acc[ai][bj][m][0], v1 = acc[ai][bj][m][1];
                    u32x4 w; w.x = cvt_pk_bf16(v0[0], v0[1]); w.y = cvt_pk_bf16(v0[2], v0[3]); w.z = cvt_pk_bf16(v1[0], v1[1]); w.w = cvt_pk_bf16(v1[2], v1[3]);
                    *(u32x4*)(rowp + bj * HALF) = w; } }
    }
};
struct EpiResid {
    static constexpr bool PERM = false;
    const float* xl; const float* xc; float* out; const float* gate;
    __device__ __forceinline__ void operator()(const f32x4 (&acc)[2][2][4][2], const Unit& u, int wr, int wc, int fr, int fq) const {
        const int rt = u.pm * BM; const bool isl = rt < NLAT;
        const float* base = isl ? xl + (size_t)rt * D : xc + (size_t)(rt - NLAT) * D;
        const float* gp = gate + (size_t)(isl ? (rt >> 12) : 8) * 12288;
        const int rl0 = wr * 64 + fr, col0 = u.pn * BM + wc * 32 + 4 * fq;
#pragma unroll
        for (int ai = 0; ai < 2; ++ai)
#pragma unroll
            for (int m = 0; m < 4; ++m) { const int rl = rl0 + ai * HALF + m * 16; const float* bp = base + (size_t)rl * D + col0; float* op = out + (size_t)(rt + rl) * D + col0;
#pragma unroll
                for (int bj = 0; bj < 2; ++bj)
#pragma unroll
                    for (int n = 0; n < 2; ++n) { const f32x4 b = *(const f32x4*)(bp + bj * HALF + n * 16); const f32x4 gv = *(const f32x4*)(gp + col0 + bj * HALF + n * 16); *(f32x4*)(op + bj * HALF + n * 16) = b + gv * acc[ai][bj][m][n]; }
                asm volatile("" ::: "memory"); }
    }
};
struct EpiSwiglu {
    static constexpr bool PERM = true;
    bf16* O;
    __device__ __forceinline__ void operator()(const f32x4 (&acc)[2][2][4][2], const Unit& u, int wr, int wc, int fr, int fq) const {
        const int row0 = u.pm * BM + wr * 64 + fr; const int col0 = u.pn * 128 + wc * 32 + 8 * fq;
#pragma unroll
        for (int ai = 0; ai < 2; ++ai)
#pragma unroll
            for (int m = 0; m < 4; ++m) { bf16* rowp = O + (size_t)(row0 + ai * HALF + m * 16) * DE + col0;
                float o[8];
#pragma unroll
                for (int n = 0; n < 2; ++n)
#pragma unroll
                    for (int j = 0; j < 4; ++j) { const float gt = acc[ai][0][m][n][j], up = acc[ai][1][m][n][j]; o[n * 4 + j] = gt * __builtin_amdgcn_rcpf(1.0f + __expf(-gt)) * up; }
                u32x4 w; w.x = cvt_pk_bf16(o[0], o[1]); w.y = cvt_pk_bf16(o[2], o[3]); w.z = cvt_pk_bf16(o[4], o[5]); w.w = cvt_pk_bf16(o[6], o[7]);
                *(u32x4*)rowp = w; }
    }
};
struct EpiDown {
    static constexpr bool PERM = true;
    bf16* YK; const PG8_LAS unsigned* tab; const PG8_LAS float* tabw;
    __device__ __forceinline__ void operator()(const f32x4 (&acc)[2][2][4][2], const Unit& u, int wr, int wc, int fr, int fq) const {
        const int rl0 = wr * 64 + fr; const int col0 = u.pn * BM + wc * 32 + 8 * fq;
#pragma unroll
        for (int ai = 0; ai < 2; ++ai)
#pragma unroll
            for (int m = 0; m < 4; ++m) { const int rl = rl0 + ai * HALF + m * 16; const unsigned ent = tab[u.aux * 256 + rl]; const float w = tabw[u.aux * 256 + rl];
                if (!(ent & 0x40000000u)) { bf16* rowp = YK + ((size_t)(ent >> 31) * MALL + (ent & 0xffffu)) * D + col0;
#pragma unroll
                    for (int bj = 0; bj < 2; ++bj) { const f32x4 v0 = acc[ai][bj][m][0] * w, v1 = acc[ai][bj][m][1] * w;
                        u32x4 q; q.x = cvt_pk_bf16(v0[0], v0[1]); q.y = cvt_pk_bf16(v0[2], v0[3]); q.z = cvt_pk_bf16(v1[0], v1[1]); q.w = cvt_pk_bf16(v1[2], v1[3]);
                        *(u32x4*)(rowp + bj * HALF) = q; } }
                asm volatile("" ::: "memory"); }
    }
};
}

struct Args { const float* in[31]; float* out; unsigned char* ws; int ph_lo, ph_hi; };
typedef const __attribute__((address_space(4))) Args* KArgs;
__device__ __forceinline__ KArgs kargs() { KArgs p = (KArgs)__builtin_amdgcn_kernarg_segment_ptr(); asm volatile("" : "+s"(p)); return p; }
#define AIN(i) (a->in[i])
enum { I_X = 0, I_C, I_CTX, I_CCTX, I_ADAW, I_ADAB, I_N1G, I_N2G, I_WIN, I_WOUT, I_GNG, I_GWS, I_GB, I_LB, I_HNG, I_MU, I_W0, I_WUP, I_A0, I_AUP, I_GUP, I_KK, I_KA, I_RK, I_GNGG, I_GNB, I_RW, I_RB, I_WGU, I_WDN, I_FNG };

__device__ __forceinline__ void p0_transpose_item(const float* W, int K, int N, bf16* WT, int n_row0, LAS float* scr, int kb, int nb, int lane) {
    const int k0 = 64 * kb, n0 = 32 * nb;
#pragma unroll 8
    for (int i = 0; i < 32; ++i) { const int kk = 2 * i + (lane >> 5); scr[kk * 33 + (lane & 31)] = W[(size_t)(k0 + kk) * N + n0 + (lane & 31)]; }
    asm volatile("s_waitcnt lgkmcnt(0)" ::: "memory");
    const int c = lane & 7;
#pragma unroll
    for (int j = 0; j < 4; ++j) { const int n = (lane >> 3) + 8 * j; const LAS float* s = scr + (8 * c) * 33 + n;
        u32x4 o; o.x = pk2(s[0 * 33], s[1 * 33]); o.y = pk2(s[2 * 33], s[3 * 33]); o.z = pk2(s[4 * 33], s[5 * 33]); o.w = pk2(s[6 * 33], s[7 * 33]);
        *(u32x4*)(WT + (size_t)(n_row0 + n) * K + k0 + 8 * c) = o; }
    asm volatile("s_waitcnt lgkmcnt(0)" ::: "memory");
}

__device__ __forceinline__ void convert_moe(KArgs a, int l, LAS unsigned char* lds) {
    const int tid = tid_fresh(), lane = tid & 63, wave = tid >> 6;
    const int gw = blockIdx.x * 8 + wave, NGW = gridDim.x * 8;
    unsigned char* ws = a->ws;
    LAS float* scr = (LAS float*)(lds + wave * 16384);
    constexpr int I_GU = 32 * 64, I_DN = 16 * 64, N2 = 16 * I_GU, N3 = N2 + 16 * I_DN;
    for (int it = gw; it < N3; it += NGW) {
        if (it < N2) { const int e = it / I_GU, r = it % I_GU, kb = r / 64, nb = r % 64;
            const int n0 = 32 * nb, hh = n0 >> 10, nn = n0 & 1023, row0 = 256 * (nn >> 7) + 128 * hh + (nn & 127);
            p0_transpose_item(a->in[I_WGU] + (size_t)(l * NE + e) * D * 2048, D, 2048, (bf16*)(ws + WS_WGU) + (size_t)e * 2048 * D, row0, scr, kb, nb, lane); }
        else { const int q = it - N2, e = q / I_DN, r = q % I_DN, kb = r / 64, nb = r % 64;
            p0_transpose_item(a->in[I_WDN] + (size_t)(l * NE + e) * DE * D, DE, D, (bf16*)(ws + WS_WDN) + (size_t)e * D * DE, 32 * nb, scr, kb, nb, lane); }
    }
}
__device__ __forceinline__ void phase_prologue(KArgs a, LAS unsigned char* lds) {
    const int tid = tid_fresh(), lane = tid & 63, wave = tid >> 6;
    const int G = gridDim.x, gw = blockIdx.x * 8 + wave, NGW = G * 8;
    unsigned char* ws = a->ws;
    LAS float* scr = (LAS float*)(lds + wave * 16384);
    constexpr int I_IN = 32 * 232, I_OUT = 32 * 64;
    constexpr int N0 = 2 * I_IN, N1 = N0 + 2 * I_OUT;
    for (int it = gw; it < N1; it += NGW) {
        if (it < N0) { const int l = it / I_IN, r = it % I_IN, kb = r / 232, nb = r % 232;
            p0_transpose_item(a->in[I_WIN] + (size_t)l * D * INC, D, INC, (bf16*)(ws + WS_WIN) + (size_t)l * INC * D, 32 * nb, scr, kb, nb, lane); }
        else { const int q = it - N0, l = q / I_OUT, r = q % I_OUT, kb = r / 64, nb = r % 64;
            p0_transpose_item(a->in[I_WOUT] + (size_t)l * D * D, D, D, (bf16*)(ws + WS_WOUT) + (size_t)l * D * D, 32 * nb, scr, kb, nb, lane); }
    }
    convert_moe(a, 0, lds);
    {
        const int gt = blockIdx.x * NTHREADS + tid, NGT = G * NTHREADS;
        bf16* wup = (bf16*)(ws + WS_SMALLW + SW_WUP); bf16* aup = (bf16*)(ws + WS_SMALLW + SW_AUP); bf16* gup = (bf16*)(ws + WS_SMALLW + SW_GUP); bf16* gws = (bf16*)(ws + WS_SMALLW + SW_GWS);
        for (int i = gt; i < 2 * 2 * 768 * 64; i += NGT) { const int k = i & 63, n = (i >> 6) % 768, ld = i / (768 * 64); wup[i] = (bf16)f2bf(a->in[I_WUP][((size_t)ld * 64 + k) * 768 + n]); }
        for (int i = gt; i < 2 * 768 * 64; i += NGT) { const int k = i & 63, n = (i >> 6) % 768, l = i / (768 * 64); aup[i] = (bf16)f2bf(a->in[I_AUP][((size_t)l * 64 + k) * 768 + n]); }
        for (int i = gt; i < 2 * 768 * 128; i += NGT) { const int k = i & 127, n = (i >> 7) % 768, l = i / (768 * 128); gup[i] = (bf16)f2bf(a->in[I_GUP][((size_t)l * 128 + k) * 768 + n]); }
        for (int i = gt; i < 2 * 4 * 128 * 128; i += NGT) gws[i] = (bf16)f2bf(a->in[I_GWS][i]);
    }
    __syncthreads();
    {
        LAS float* sv = (LAS float*)lds;
        LAS float* red = (LAS float*)(lds + 73728);
        for (int i = tid; i < 9 * D; i += NTHREADS) { const int r = i / D, k = i % D; const float v = r < 8 ? a->in[I_C][r * D + k] : a->in[I_CCTX][k]; sv[i] = siluf_(v); }
        __syncthreads();
        float* mod = (float*)(ws + WS_MOD);
        for (int it = blockIdx.x; it < 2 * 96; it += G) {
            const int l = it / 96, cb = it % 96, cq = tid & 31, kg = tid >> 5;
            const float* wp = a->in[I_ADAW] + (size_t)l * D * 12288 + (size_t)(kg * 128) * 12288 + cb * 128 + cq * 4;
            f32x4 acc[9];
#pragma unroll
            for (int r = 0; r < 9; ++r) acc[r] = (f32x4){0.f, 0.f, 0.f, 0.f};
#pragma unroll 4
            for (int k = 0; k < 128; ++k) { const f32x4 w = *(const f32x4*)(wp + (size_t)k * 12288);
#pragma unroll
                for (int r = 0; r < 9; ++r) acc[r] += w * sv[r * D + kg * 128 + k]; }
#pragma unroll
            for (int r = 0; r < 9; ++r) *(LAS f32x4*)(red + ((kg * 9 + r) * 128 + cq * 4)) = acc[r];
            __syncthreads();
            for (int o = tid; o < 9 * 128; o += NTHREADS) { const int r = o / 128, c = o % 128; float s = a->in[I_ADAB][(size_t)l * 12288 + cb * 128 + c];
#pragma unroll
                for (int q = 0; q < 16; ++q) s += red[(q * 9 + r) * 128 + c];
                mod[((size_t)l * 9 + r) * 12288 + cb * 128 + c] = s; }
            __syncthreads();
        }
    }
}

template <int MODE>
__device__ __forceinline__ void phase_norm1(KArgs a, int l, bool dry) {
    const int tid_ = tid_fresh(); const int lane = tid_ & 63, wave = tid_ >> 6, gw = blockIdx.x * 8 + wave, NGW = gridDim.x * 8;
    unsigned char* ws = a->ws;
    const float* mod = (const float*)(ws + WS_MOD);
    float* X = (float*)(ws + WS_X); bf16* H = (bf16*)(ws + WS_H); const bf16* YK = (const bf16*)(ws + WS_YK);
    float* Xo = dry ? (float*)(ws + WS_END) : X; bf16* Ho = dry ? (bf16*)(ws + WS_END) : H; float* Oo = dry ? (float*)(ws + WS_END) : a->out;
    const int nrows = (MODE == 2) ? NLAT : MALL;
    const int rpw = (nrows + NGW - 1) / NGW; const int r0 = gw * rpw, r1 = (r0 + rpw < nrows) ? r0 + rpw : nrows;
    f32x4 ck[8], cs[8], cg[8]; int cur_mr = -1;
    for (int row = r0; row < r1; ++row) {
        const int mr = modrow_of(row); const int orow = dry ? (row & 2047) : row;
        if (mr != cur_mr) { cur_mr = mr;
#pragma unroll
            for (int j = 0; j < 8; ++j) { const int c = 4 * lane + 256 * j;
                if (MODE == 2) ck[j] = *(const f32x4*)(a->in[I_FNG] + c);
                else { const float* m = mod + ((size_t)l * 9 + mr) * 12288; const f32x4 g = *(const f32x4*)(a->in[I_N1G] + (size_t)l * D + c); ck[j] = g * (*(const f32x4*)(m + D + c) + 1.0f); cs[j] = *(const f32x4*)(m + c); }
                if (MODE != 0) cg[j] = *(const f32x4*)(mod + ((size_t)(l - 1) * 9 + mr) * 12288 + 5 * D + c); } }
        f32x4 v[8];
        if (MODE == 0) { const float* xr = row < NLAT ? a->in[I_X] + (size_t)row * D : a->in[I_CTX] + (size_t)(row - NLAT) * D;
#pragma unroll
            for (int j = 0; j < 8; ++j) v[j] = *(const f32x4*)(xr + 4 * lane + 256 * j);
        } else {
            const float* xr = X + (size_t)row * D; const bf16* y0 = YK + (size_t)row * D; const bf16* y1 = YK + ((size_t)MALL + row) * D;
            u32x2 p0[8], p1[8];
#pragma unroll
            for (int j = 0; j < 8; ++j) { const int c = 4 * lane + 256 * j; v[j] = *(const f32x4*)(xr + c); p0[j] = *(const u32x2*)(y0 + c); p1[j] = *(const u32x2*)(y1 + c); }
#pragma unroll
            for (int j = 0; j < 8; ++j) { f32x4 f; f[0] = bflo(p0[j].x) + bflo(p1[j].x); f[1] = bfhi(p0[j].x) + bfhi(p1[j].x); f[2] = bflo(p0[j].y) + bflo(p1[j].y); f[3] = bfhi(p0[j].y) + bfhi(p1[j].y);
                v[j] = v[j] + cg[j] * f; }
            if (MODE == 1) {
#pragma unroll
                for (int j = 0; j < 8; ++j) *(f32x4*)(Xo + (size_t)orow * D + 4 * lane + 256 * j) = v[j];
            }
        }
        float ss = 0.f;
#pragma unroll
        for (int j = 0; j < 8; ++j) ss += (v[j][0] * v[j][0] + v[j][1] * v[j][1]) + (v[j][2] * v[j][2] + v[j][3] * v[j][3]);
        const float rstd = 1.0f / sqrtf(wave_sum(ss) * (1.0f / D) + NORM_EPS);
        if (MODE == 2) {
#pragma unroll
            for (int j = 0; j < 8; ++j) *(f32x4*)(Oo + (size_t)orow * D + 4 * lane + 256 * j) = v[j] * rstd * ck[j];
        } else {
#pragma unroll
            for (int j = 0; j < 8; ++j) { const f32x4 h = v[j] * rstd * ck[j] + cs[j]; u32x2 o; o.x = pk2(h[0], h[1]); o.y = pk2(h[2], h[3]); *(u32x2*)(Ho + (size_t)orow * D + 4 * lane + 256 * j) = o; }
        }
    }
}

__device__ __forceinline__ void phase_norm2_router(KArgs a, int l, bool dry, LAS unsigned char* lds) {
    const int tid_ = tid_fresh(); const int lane = tid_ & 63, wave = tid_ >> 6, gw = blockIdx.x * 8 + wave, NGW = gridDim.x * 8;
    unsigned char* ws = a->ws;
    const float* mod = (const float*)(ws + WS_MOD);
    const float* X = (const float*)(ws + WS_X); bf16* H = (bf16*)(ws + WS_H);
    unsigned* cnt = (unsigned*)(ws + WS_CTL) + CW_CNT + l * 16 * 64 + (dry ? 4096 : 0);
    unsigned* ridx = (unsigned*)(ws + (dry ? WS_END : WS_RIDX)); float* rwt = (float*)(ws + (dry ? WS_END + 4 * MiB : WS_RW)); bf16* Ho = dry ? (bf16*)(ws + WS_END + 8 * MiB) : H;
    const int nrows = (l == DEPTH - 1) ? NLAT : MALL;
    LAS f32x4* rwl = (LAS f32x4*)lds;
    { const float* rw = a->in[I_RW];
      for (int idx = tid_; idx < 8192; idx += NTHREADS) { const int ln = idx & 63, q = (idx >> 6) & 3, i = (idx >> 8) & 3, j = idx >> 10; rwl[idx] = *(const f32x4*)(rw + (size_t)(4 * ln + 256 * j + i) * 16 + 4 * q); } }
    __syncthreads();
    const int rpw = (nrows + NGW - 1) / NGW; const int r0 = gw * rpw, r1 = (r0 + rpw < nrows) ? r0 + rpw : nrows;
    f32x4 ck[8], cs[8]; int cur_mr = -1;
    float rb[16];
#pragma unroll
    for (int e = 0; e < 16; ++e) rb[e] = a->in[I_RB][e];
    for (int row = r0; row < r1; ++row) {
        const int mr = modrow_of(row); const int orow = dry ? (row & 2047) : row;
        if (mr != cur_mr) { cur_mr = mr; const float* m = mod + ((size_t)l * 9 + mr) * 12288;
#pragma unroll
            for (int j = 0; j < 8; ++j) { const int c = 4 * lane + 256 * j; const f32x4 g = *(const f32x4*)(a->in[I_N2G] + (size_t)l * D + c); ck[j] = g * (*(const f32x4*)(m + 4 * D + c) + 1.0f); cs[j] = *(const f32x4*)(m + 3 * D + c); } }
        const float* xr = X + (size_t)row * D;
        f32x4 v[8]; float ss = 0.f;
#pragma unroll
        for (int j = 0; j < 8; ++j) { v[j] = *(const f32x4*)(xr + 4 * lane + 256 * j); ss += (v[j][0] * v[j][0] + v[j][1] * v[j][1]) + (v[j][2] * v[j][2] + v[j][3] * v[j][3]); }
        const float rstd = 1.0f / sqrtf(wave_sum(ss) * (1.0f / D) + NORM_EPS);
        f32x4 lg4[4];
#pragma unroll
        for (int q = 0; q < 4; ++q) lg4[q] = (f32x4){0.f, 0.f, 0.f, 0.f};
#pragma unroll
        for (int j = 0; j < 8; ++j) { const f32x4 h = v[j] * rstd * ck[j] + cs[j]; u32x2 o; o.x = pk2(h[0], h[1]); o.y = pk2(h[2], h[3]); *(u32x2*)(Ho + (size_t)orow * D + 4 * lane + 256 * j) = o;
#pragma unroll
            for (int i = 0; i < 4; ++i)
#pragma unroll
                for (int q = 0; q < 4; ++q) lg4[q] += rwl[((j * 4 + i) * 4 + q) * 64 + lane] * h[i];
            asm volatile("" ::: "memory"); }
        float lg[16];
#pragma unroll
        for (int e = 0; e < 16; ++e) lg[e] = wave_sum(lg4[e >> 2][e & 3]) + rb[e];
        float mx = lg[0];
#pragma unroll
        for (int e = 1; e < 16; ++e) mx = fmaxf(mx, lg[e]);
        float p[16], sum = 0.f;
#pragma unroll
        for (int e = 0; e < 16; ++e) { p[e] = __expf(lg[e] - mx); sum += p[e]; }
        const float inv = 1.0f / sum;
#pragma unroll
        for (int e = 0; e < 16; ++e) p[e] *= inv;
        int sel = 0; float best = -1.f;
#pragma unroll
        for (int gI = 0; gI < 4; ++gI) { float m1 = -1.f, m2 = -1.f;
#pragma unroll
            for (int i = 0; i < 4; ++i) { const float q = p[4 * gI + i]; if (q > m1) { m2 = m1; m1 = q; } else if (q > m2) m2 = q; }
            const float s = m1 + m2; if (s > best) { best = s; sel = gI; } }
        int i1 = 0, i2 = 0; float p1 = -2.f, p2 = -2.f;
#pragma unroll
        for (int gI = 0; gI < 4; ++gI)
#pragma unroll
            for (int i = 0; i < 4; ++i) { const float q = (gI == sel) ? p[4 * gI + i] : -1.0f; const int e = 4 * gI + i;
                if (gI == sel) { if (q > p1) { p2 = p1; i2 = i1; p1 = q; i1 = e; } else if (q > p2) { p2 = q; i2 = e; } } }
        const float wsum = p1 + p2, w1 = p1 / wsum, w2 = p2 / wsum;
        if (lane == 0) {
            const unsigned q1 = atomicAdd(cnt + i1 * 64, 1u); ridx[(size_t)i1 * MALL + q1] = (unsigned)row; rwt[(size_t)i1 * MALL + q1] = w1;
            const unsigned q2 = atomicAdd(cnt + i2 * 64, 1u); ridx[(size_t)i2 * MALL + q2] = (unsigned)row | 0x80000000u; rwt[(size_t)i2 * MALL + q2] = w2;
        }
    }
    __syncthreads();
}

template <bool FOR_DOWN>
__device__ __forceinline__ void moe_tables(KArgs a, int l, LAS unsigned char* lds, int cvirt) {
    const int tid = tid_fresh(), G = gridDim.x;
    unsigned char* ws = a->ws;
    const unsigned* cnt = (const unsigned*)(ws + WS_CTL) + CW_CNT + l * 16 * 64;
    const unsigned* ridx = (const unsigned*)(ws + WS_RIDX); const float* rwt = (const float*)(ws + WS_RW);
    LAS int* tp = (LAS int*)(lds + LDS_TP); LAS unsigned* tab = (LAS unsigned*)(lds + LDS_TAB); LAS float* tabw = (LAS float*)(lds + LDS_TABW);
    if (tid == 0) { int acc = 0; for (int e = 0; e < 16; ++e) { tp[e] = acc; acc += (int)((cnt[e * 64] + 255u) >> 8); } tp[16] = acc; }
    __syncthreads();
    const int ntot = tp[16] * 8;
    for (int i = 0; i < 9; ++i) { const int L = i * G + cvirt; if (L >= ntot) break;
        const int tile = L >> 3; int e = 0;
        for (int j = 1; j < 16; ++j) e += (tile >= tp[j]) ? 1 : 0;
        const int pos0 = (tile - tp[e]) * 256; const unsigned ce = cnt[e * 64];
        if (tid < 256) { const int pos = pos0 + tid; const bool valid = (unsigned)pos < ce; const unsigned ent = ridx[(size_t)e * MALL + (valid ? pos : 0)];
            if (FOR_DOWN) { tab[i * 256 + tid] = valid ? ent : (ent | 0x40000000u); tabw[i * 256 + tid] = valid ? rwt[(size_t)e * MALL + pos] : 0.f; }
            else tab[i * 256 + tid] = (ent & 0xffffu) * (unsigned)(D * 2); }
    }
    __syncthreads();
}

__device__ __forceinline__ void gmlp_item(KArgs a, int l, int item, LAS unsigned char* lds) {
    const int tid = tid_fresh(), lane = tid & 63, wave = tid >> 6;
    unsigned char* ws = a->ws;
    const bf16* P = (const bf16*)(ws + WS_P); bf16* Y = (bf16*)(ws + WS_Y);
    const int chunk = item >> 2, h = item & 3;
    const int row0 = chunk < 256 ? chunk * 128 : NLAT + (chunk - 256) * 128;
    LAS bf16* wsl = (LAS bf16*)lds;
    LAS bf16* vT = (LAS bf16*)(lds + 128 * 136 * 2);
    const bf16* gws = (const bf16*)(ws + WS_SMALLW + SW_GWS) + ((size_t)l * 4 + h) * 128 * 128;
    for (int p = tid; p < 2048; p += NTHREADS) { const int t = p >> 4, c8 = p & 15; *(LAS u32x4*)(wsl + t * 136 + c8 * 8) = *(const u32x4*)(gws + t * 128 + c8 * 8); }
    {
        const int s = tid >> 2, qd = tid & 3; const bf16* vp = P + (size_t)(row0 + s) * INC + OFF_V + h * 128 + qd * 32;
        float g[32]; float ss = 0.f;
#pragma unroll
        for (int q = 0; q < 4; ++q) { float f[8]; unpack8(*(const u32x4*)(vp + 8 * q), f);
#pragma unroll
            for (int j = 0; j < 8; ++j) { const float x = geluf_(f[j]); g[8 * q + j] = x; ss += x * x; } }
        ss += __shfl_xor(ss, 1); ss += __shfl_xor(ss, 2);
        const float rstd = 1.0f / sqrtf(ss * (1.0f / 128.0f) + NORM_EPS);
        const float* ng = a->in[I_GNG] + (size_t)l * 512 + h * 128 + qd * 32;
#pragma unroll
        for (int j = 0; j < 32; ++j) vT[(qd * 32 + j) * 136 + s] = (bf16)f2bf(g[j] * rstd * ng[j]);
    }
    __syncthreads();
    f32x4 acc[8];
#pragma unroll
    for (int ct = 0; ct < 8; ++ct) acc[ct] = (f32x4){0.f, 0.f, 0.f, 0.f};
    const int fr = lane & 15, fq = lane >> 4;
#pragma unroll
    for (int ks = 0; ks < 4; ++ks) {
        const bf16x8 bfrag = *(const LAS bf16x8*)(wsl + (16 * wave + fr) * 136 + ks * 32 + fq * 8);
#pragma unroll
        for (int ct = 0; ct < 8; ++ct) { const bf16x8 afrag = *(const LAS bf16x8*)(vT + (16 * ct + fr) * 136 + ks * 32 + fq * 8);
            acc[ct] = __builtin_amdgcn_mfma_f32_16x16x32_bf16(afrag, bfrag, acc[ct], 0, 0, 0); }
    }
    const int t = 16 * wave + fr; const float wb = a->in[I_GB][((size_t)l * 4 + h) * 128 + t];
    const bf16* up = P + (size_t)(row0 + t) * INC + OFF_U + h * 128; bf16* yp = Y + (size_t)(row0 + t) * D + h * 128;
#pragma unroll
    for (int ct = 0; ct < 8; ++ct) { const int c = 16 * ct + 4 * fq; const u32x2 uu = *(const u32x2*)(up + c);
        const float y0 = geluf_(bflo(uu.x)) * (acc[ct][0] + wb), y1 = geluf_(bfhi(uu.x)) * (acc[ct][1] + wb), y2 = geluf_(bflo(uu.y)) * (acc[ct][2] + wb), y3 = geluf_(bfhi(uu.y)) * (acc[ct][3] + wb);
        u32x2 o; o.x = pk2(y0, y1); o.y = pk2(y2, y3); *(u32x2*)(yp + c) = o; }
    __syncthreads();
}

constexpr int SP_ = 72;
__device__ __forceinline__ int kperm_pos(int k) { const int s5 = k & 31; return (k & 32) + 8 * ((s5 >> 2) & 3) + 4 * (s5 >> 4) + (s5 & 3); }
__device__ __forceinline__ void rwkv_prep_item(KArgs a, int l, int tile, int hgrp, LAS unsigned char* lds) {
    const int tid = tid_fresh(), lane = tid & 63, wave = tid >> 6;
    unsigned char* ws = a->ws;
    const bf16* P = (const bf16*)(ws + WS_P); bf16* Y = (bf16*)(ws + WS_Y);
    LAS bf16* SR = (LAS bf16*)lds; LAS bf16* SK = SR + 64 * SP_; LAS bf16* SV = SK + 64 * SP_; LAS bf16* SKK = SV + 64 * SP_; LAS bf16* SB = SKK + 64 * SP_; LAS bf16* SWF = SB + 64 * SP_; LAS bf16* SWB = SWF + 64 * SP_;
    LAS bf16* tw = SWB + 64 * SP_;
    LAS bf16* adl = tw + 64 * SP_;
    LAS bf16* sg = adl + 64 * SP_;
    LAS float* invn = (LAS float*)(sg + 64 * 136);
    LAS unsigned char* wpriv = (LAS unsigned char*)(invn + 64) + wave * 6144;
    const int row0 = tile * 64; const bool isl = row0 < NLAT;
    const float* mu = a->in[I_MU] + (size_t)l * CCOLS;
    const char* Pb = (const char*)P;
    auto shift_group = [&](int tk, int col, float (&z)[8]) {
        const int row = row0 + tk; int o0, o1, o2, o3; bool v0, v1, v2, v3;
        if (isl) { const int gr = (row >> 6) & 63; o0 = -1; o1 = 1; o2 = -64; o3 = 64; v0 = tk > 0; v1 = tk < 63; v2 = gr > 0; v3 = gr < 63; }
        else { const int tc = (row - NLAT) & 255; o0 = -1; o1 = 1; o2 = -1; o3 = 1; v0 = tc > 0; v1 = tc < 255; v2 = v0; v3 = v1; }
        const unsigned off = (unsigned)row * (unsigned)(INC * 2) + (unsigned)(OFF_C + col) * 2u;
        const u32x4 uo = *(const u32x4*)(Pb + off), u0 = *(const u32x4*)(Pb + (off + (unsigned)((v0 ? o0 : 0) * INC * 2))), u1 = *(const u32x4*)(Pb + (off + (unsigned)((v1 ? o1 : 0) * INC * 2))),
                    u2 = *(const u32x4*)(Pb + (off + (unsigned)((v2 ? o2 : 0) * INC * 2))), u3 = *(const u32x4*)(Pb + (off + (unsigned)((v3 ? o3 : 0) * INC * 2)));
        const f32x4 m0 = *(const f32x4*)(mu + col), m1 = *(const f32x4*)(mu + col + 4);
        float own[8], n0[8], n1[8], n2[8], n3[8]; unpack8(uo, own); unpack8(u0, n0); unpack8(u1, n1); unpack8(u2, n2); unpack8(u3, n3);
        const float f0 = v0 ? 1.f : 0.f, f1 = v1 ? 1.f : 0.f, f2 = v2 ? 1.f : 0.f, f3 = v3 ? 1.f : 0.f;
        const float nb[8] = {n0[0] * f0, n1[1] * f1, n2[2] * f2, n3[3] * f3, n0[4] * f0, n1[5] * f1, n2[6] * f2, n3[7] * f3};
#pragma unroll
        for (int j = 0; j < 8; ++j) { const float mm = j < 4 ? m0[j] : m1[j - 4]; z[j] = own[j] + mm * (nb[j] - own[j]); }
    };
#pragma unroll
    for (int it = 0; it < 4; ++it) { const int g = tid + NTHREADS * it, tk = g >> 5, gi = g & 31;
        float z[8]; shift_group(tk, 2304 + gi * 8, z);
        if (gi < 8) { float t8[8];
#pragma unroll
            for (int j = 0; j < 8; ++j) t8[j] = 1.0f - 2.0f * __builtin_amdgcn_rcpf(1.0f + __expf(2.0f * z[j]));
            *(LAS u32x4*)(tw + tk * SP_ + gi * 8) = pack8(t8); }
        else if (gi < 16) *(LAS u32x4*)(adl + tk * SP_ + (gi - 8) * 8) = pack8(z);
        else { float t8[8];
#pragma unroll
            for (int j = 0; j < 8; ++j) t8[j] = sigmoidf_(z[j]);
            *(LAS u32x4*)(sg + tk * 136 + (gi - 16) * 8) = pack8(t8); } }
    __syncthreads();
#pragma unroll 1
    for (int hh = 0; hh < 4; ++hh) {
    const int tid = tid_fresh(), lane = tid & 63, wave = tid >> 6;
    const int head = 4 * hgrp + hh; const float* kkw = a->in[I_KK] + (size_t)l * CW + head * 64;
#pragma unroll
    for (int it = 0; it < 3; ++it) { const int g = tid + NTHREADS * it, tk = g / 24, gi = g % 24, c8 = (gi & 7) * 8;
        float z[8]; shift_group(tk, (gi >> 3) * 768 + head * 64 + c8, z);
        if (gi < 8) *(LAS u32x4*)(SR + tk * SP_ + c8) = pack8(z);
        else if (gi < 16) { *(LAS u32x4*)(SK + tk * SP_ + c8) = pack8(z);
            const f32x4 k0 = *(const f32x4*)(kkw + c8), k1 = *(const f32x4*)(kkw + c8 + 4); float ss = 0.f;
#pragma unroll
            for (int j = 0; j < 8; ++j) { const float q = z[j] * (j < 4 ? k0[j] : k1[j - 4]); ss += q * q; }
            ss += __shfl_xor(ss, 1); ss += __shfl_xor(ss, 2); ss += __shfl_xor(ss, 4);
            if ((gi & 7) == 0) invn[tk] = 1.0f / fmaxf(sqrtf(ss), 1e-12f); }
        else *(LAS u32x4*)(SV + tk * SP_ + c8) = pack8(z); }
    __syncthreads();
    {
        const int fr = lane & 15, fq = lane >> 4, nt = wave & 3, th = wave >> 2;
        const bf16* wupT = (const bf16*)(ws + WS_SMALLW + SW_WUP) + (size_t)l * 2 * 768 * 64;
        const bf16* aupT = (const bf16*)(ws + WS_SMALLW + SW_AUP) + (size_t)l * 768 * 64;
        const bf16* gupT = (const bf16*)(ws + WS_SMALLW + SW_GUP) + (size_t)l * 768 * 128;
        const float* a0 = a->in[I_A0] + (size_t)l * CW + head * 64; const float* kaw = a->in[I_KA] + (size_t)l * CW + head * 64; const float* w0 = a->in[I_W0] + (size_t)l * 2 * CW + head * 64;
        const int nloc = 16 * nt + 4 * fq;
#pragma unroll 1
        for (int mat = 0; mat < 4; ++mat) {
            const bf16* WT = mat == 0 ? aupT : (mat == 1 ? wupT : (mat == 2 ? wupT + 768 * 64 : gupT));
            const int KK = mat == 3 ? 128 : 64; const LAS bf16* act = mat == 0 ? adl : (mat == 3 ? sg : tw); const int apitch = mat == 3 ? 136 : SP_;
            f32x4 acc[2];
            acc[0] = (f32x4){0.f, 0.f, 0.f, 0.f}; acc[1] = acc[0];
            for (int ks = 0; ks < KK / 32; ++ks) { const bf16x8 afr = *(const bf16x8*)(WT + (size_t)(head * 64 + 16 * nt + fr) * KK + ks * 32 + fq * 8);
#pragma unroll
                for (int tt = 0; tt < 2; ++tt) { const bf16x8 bfr = *(const LAS bf16x8*)(act + (16 * (2 * th + tt) + fr) * apitch + ks * 32 + fq * 8); acc[tt] = __builtin_amdgcn_mfma_f32_16x16x32_bf16(afr, bfr, acc[tt], 0, 0, 0); } }
#pragma unroll
            for (int tt = 0; tt < 2; ++tt) { const int tk = 16 * (2 * th + tt) + fr; const f32x4 v = acc[tt];
                if (mat == 0) {
                    const f32x4 a0v = *(const f32x4*)(a0 + nloc), kav = *(const f32x4*)(kaw + nloc), kkv = *(const f32x4*)(kkw + nloc);
                    const u32x2 kp = *(const LAS u32x2*)(SK + tk * SP_ + nloc); const float kf[4] = {bflo(kp.x), bfhi(kp.x), bflo(kp.y), bfhi(kp.y)};
                    const float inn = invn[tk]; float k2[4], kk[4], bb[4];
#pragma unroll
                    for (int j = 0; j < 4; ++j) { const float av = sigmoidf_(a0v[j] + v[j]); kk[j] = kf[j] * kkv[j] * inn; k2[j] = kf[j] * (1.0f + (av - 1.0f) * kav[j]); bb[j] = kk[j] * av; }
                    u32x2 q; q.x = pk2(k2[0], k2[1]); q.y = pk2(k2[2], k2[3]); *(LAS u32x2*)(SK + tk * SP_ + nloc) = q;
                    q.x = pk2(kk[0], kk[1]); q.y = pk2(kk[2], kk[3]); *(LAS u32x2*)(SKK + tk * SP_ + nloc) = q;
                    q.x = pk2(bb[0], bb[1]); q.y = pk2(bb[2], bb[3]); *(LAS u32x2*)(SB + tk * SP_ + nloc) = q;
                } else if (mat <= 2) {
                    const f32x4 w0v = *(const f32x4*)(w0 + (mat - 1) * CW + nloc); float d[4];
#pragma unroll
                    for (int j = 0; j < 4; ++j) d[j] = __expf(-DECAY_SCALE * sigmoidf_(w0v[j] + v[j]));
                    u32x2 q; q.x = pk2(d[0], d[1]); q.y = pk2(d[2], d[3]); *(LAS u32x2*)((mat == 1 ? SWF : SWB) + tk * SP_ + nloc) = q;
                } else {
                    u32x2 q; q.x = pk2(v[0], v[1]); q.y = pk2(v[2], v[3]); *(u32x2*)(Y + (size_t)(row0 + tk) * D + 1280 + head * 64 + nloc) = q;
                }
            }
        }
    }
    __syncthreads();
    { const int tk = tid >> 3, c8 = (tid & 7) * 8; float r8[8], k8[8], v8[8];
      unpack8(*(const LAS u32x4*)(SR + tk * SP_ + c8), r8); unpack8(*(const LAS u32x4*)(SK + tk * SP_ + c8), k8); unpack8(*(const LAS u32x4*)(SV + tk * SP_ + c8), v8);
      const float* rkp = a->in[I_RK] + (size_t)l * CW + head * 64 + c8; const f32x4 rk0 = *(const f32x4*)rkp, rk1 = *(const f32x4*)(rkp + 4);
      float bs = 0.f;
#pragma unroll
      for (int j = 0; j < 8; ++j) bs += r8[j] * k8[j] * (j < 4 ? rk0[j] : rk1[j - 4]);
      bs += __shfl_xor(bs, 1); bs += __shfl_xor(bs, 2); bs += __shfl_xor(bs, 4);
#pragma unroll
      for (int j = 0; j < 8; ++j) v8[j] *= bs;
      *(u32x4*)(Y + (size_t)(row0 + tk) * D + 512 + head * 64 + c8) = pack8(v8); }
    {
        const int c4 = wave & 3, dir = wave >> 2, fr = lane & 15, fq = lane >> 4;
        LAS float* CB = (LAS float*)wpriv;
        LAS float* AA = CB + 16 * 64;
        const LAS bf16* SW = dir ? SWB : SWF;
        auto trow = [&](int tau) { return 16 * c4 + (dir ? 15 - tau : tau); };
        float c[16], ci[16];
        { float run = 1.f;
#pragma unroll
          for (int t = 0; t < 16; ++t) { run *= bf1(SW[trow(t) * SP_ + lane]); c[t] = run; ci[t] = __builtin_amdgcn_rcpf(run); CB[t * 64 + lane] = run; } }
        const int rec_dir = dir, bidx = isl ? (row0 >> 12) : ((row0 - NLAT) >> 8);
        const int tcl = isl ? 4 * ((row0 >> 6) & 63) + c4 : 4 * (((row0 - NLAT) >> 6) & 3) + c4;
        const int nproc = isl ? 16 + (dir ? 255 - tcl : tcl) : (dir ? 15 - tcl : tcl);
        unsigned char* rec = ws + WS_PRE + ((size_t)((rec_dir * 8 + bidx) * 12 + head) * NCHUNK16 + nproc) * PRE_REC;
        { const float cl = c[15]; float bk[32];
#pragma unroll
          for (int t = 0; t < 16; ++t) { const float e = cl * ci[t]; const int pos = 8 * (t >> 2) + (t & 3); bk[pos] = bf1(SB[trow(t) * SP_ + lane]) * e; bk[pos + 4] = bf1(SK[trow(t) * SP_ + lane]) * e; }
#pragma unroll
          for (int q4 = 0; q4 < 4; ++q4) { u32x4 o; o.x = pk2(bk[8 * q4], bk[8 * q4 + 1]); o.y = pk2(bk[8 * q4 + 2], bk[8 * q4 + 3]); o.z = pk2(bk[8 * q4 + 4], bk[8 * q4 + 5]); o.w = pk2(bk[8 * q4 + 6], bk[8 * q4 + 7]);
              *(u32x4*)(rec + PR_BK + lane * 64 + q4 * 16) = o; }
          *(float*)(rec + PR_GAM + lane * 4) = cl; }
        asm volatile("s_waitcnt lgkmcnt(0)" ::: "memory");
        bf16x8 fa[2], frr[2], fb[2], fk[2];
        { const int tr = trow(fr);
#pragma unroll
          for (int sx = 0; sx < 2; ++sx) { const int ch = 32 * sx + 8 * fq; float kk8[8], r8[8], b8[8], k8[8];
              unpack8(*(const LAS u32x4*)(SKK + tr * SP_ + ch), kk8); unpack8(*(const LAS u32x4*)(SR + tr * SP_ + ch), r8); unpack8(*(const LAS u32x4*)(SB + tr * SP_ + ch), b8); unpack8(*(const LAS u32x4*)(SK + tr * SP_ + ch), k8);
              const f32x4 c0 = *(const LAS f32x4*)(CB + fr * 64 + ch), c1 = *(const LAS f32x4*)(CB + fr * 64 + ch + 4);
              f32x4 p0 = (f32x4){1.f, 1.f, 1.f, 1.f}, p1 = p0; if (fr > 0) { p0 = *(const LAS f32x4*)(CB + (fr - 1) * 64 + ch); p1 = *(const LAS f32x4*)(CB + (fr - 1) * 64 + ch + 4); }
              float xa[8], xr[8], xb[8], xk[8];
#pragma unroll
              for (int j = 0; j < 8; ++j) { const float ec = j < 4 ? c0[j] : c1[j - 4], ep = j < 4 ? p0[j] : p1[j - 4]; const float en = __builtin_amdgcn_rcpf(ec);
                  xa[j] = -kk8[j] * ep; xr[j] = r8[j] * ec; xb[j] = b8[j] * en; xk[j] = k8[j] * en; }
              const u32x4 ua = pack8(xa), ur = pack8(xr), ub = pack8(xb), uk = pack8(xk);
              fa[sx] = __builtin_bit_cast(bf16x8, ua); frr[sx] = __builtin_bit_cast(bf16x8, ur); fb[sx] = __builtin_bit_cast(bf16x8, ub); fk[sx] = __builtin_bit_cast(bf16x8, uk); } }
        f32x4 gab = (f32x4){0.f, 0.f, 0.f, 0.f}, gak = gab, grb = gab, grk = gab;
#pragma unroll
        for (int sx = 0; sx < 2; ++sx) { gab = __builtin_amdgcn_mfma_f32_16x16x32_bf16(fa[sx], fb[sx], gab, 0, 0, 0); gak = __builtin_amdgcn_mfma_f32_16x16x32_bf16(fa[sx], fk[sx], gak, 0, 0, 0);
            grb = __builtin_amdgcn_mfma_f32_16x16x32_bf16(frr[sx], fb[sx], grb, 0, 0, 0); grk = __builtin_amdgcn_mfma_f32_16x16x32_bf16(frr[sx], fk[sx], grk, 0, 0, 0); }
#pragma unroll
        for (int j = 0; j < 4; ++j) { const int tau = 4 * fq + j; const bool lo = fr < tau, le = fr <= tau;
            AA[tau * 16 + fr] = lo ? gab[j] : 0.f; AA[256 + tau * 16 + fr] = lo ? gak[j] : 0.f; grb[j] = le ? grb[j] : 0.f; grk[j] = le ? grk[j] : 0.f; }
        asm volatile("s_waitcnt lgkmcnt(0)" ::: "memory");
        float wv[16], mv[16];
#pragma unroll
        for (int t = 0; t < 16; ++t) { const float ab = -bf1(SKK[trow(t) * SP_ + lane]) * (t > 0 ? c[t - 1] : 1.0f); float accw = ab, accm = AA[256 + t * 16 + fr];
#pragma unroll
            for (int q4 = 0; q4 < 4; ++q4) { if (4 * q4 < t) { const f32x4 cf = *(const LAS f32x4*)(AA + t * 16 + 4 * q4);
#pragma unroll
                for (int j = 0; j < 4; ++j) if (4 * q4 + j < t) { accw += cf[j] * wv[4 * q4 + j]; accm += cf[j] * mv[4 * q4 + j]; } } }
            wv[t] = accw; mv[t] = accm; }
        { LAS bf16* stg = (LAS bf16*)CB; const int pp = kperm_pos(lane);
#pragma unroll
          for (int t = 0; t < 16; ++t) { stg[t * 64 + pp] = (bf16)f2bf(wv[t]); stg[1024 + t * 64 + pp] = (bf16)f2bf(bf1(SR[trow(t) * SP_ + lane]) * c[t]); }
          asm volatile("s_waitcnt lgkmcnt(0)" ::: "memory");
#pragma unroll
          for (int q4 = 0; q4 < 4; ++q4) *(u32x4*)(rec + PR_WP + (q4 * 64 + lane) * 16) = *(const LAS u32x4*)((LAS unsigned char*)stg + (q4 * 64 + lane) * 16); }
        { LAS bf16* stg = (LAS bf16*)AA; const int ps = 8 * (fr >> 2) + (fr & 3);
          asm volatile("s_waitcnt lgkmcnt(0)" ::: "memory");
#pragma unroll
          for (int j = 0; j < 4; ++j) { const int tau = 4 * fq + j; stg[tau * 32 + ps] = (bf16)f2bf(grb[j]); stg[tau * 32 + ps + 4] = (bf16)f2bf(grk[j]); }
          if (lane < 16) {
#pragma unroll
              for (int t = 0; t < 16; ++t) stg[512 + t * 16 + lane] = (bf16)f2bf(mv[t]); }
          asm volatile("s_waitcnt lgkmcnt(0)" ::: "memory");
          *(u32x4*)(rec + PR_ARBK + lane * 16) = *(const LAS u32x4*)((LAS unsigned char*)stg + lane * 16);
          if (lane < 32) *(u32x4*)(rec + PR_ARBK + 1024 + lane * 16) = *(const LAS u32x4*)((LAS unsigned char*)stg + 1024 + lane * 16); }
        if (dir == 0) { float v16[16];
#pragma unroll
            for (int t = 0; t < 16; ++t) v16[t] = bf1(SV[(16 * c4 + t) * SP_ + lane]);
            const int tcg = isl ? 16 + tcl : tcl;
            unsigned char* vrec = ws + WS_VT + ((size_t)(bidx * 12 + head) * NCHUNK16 + tcg) * 2048 + lane * 32;
            u32x4 o; o.x = pk2(v16[0], v16[1]); o.y = pk2(v16[2], v16[3]); o.z = pk2(v16[4], v16[5]); o.w = pk2(v16[6], v16[7]); *(u32x4*)vrec = o;
            o.x = pk2(v16[8], v16[9]); o.y = pk2(v16[10], v16[11]); o.z = pk2(v16[12], v16[13]); o.w = pk2(v16[14], v16[15]); *(u32x4*)(vrec + 16) = o; }
    }
    __syncthreads();
    }
}

__device__ __forceinline__ float dpp_xor1(float x) { return __builtin_bit_cast(float, __builtin_amdgcn_update_dpp(0, __builtin_bit_cast(int, x), 0xB1, 0xF, 0xF, false)); }
__device__ __forceinline__ float dpp_xor2(float x) { return __builtin_bit_cast(float, __builtin_amdgcn_update_dpp(0, __builtin_bit_cast(int, x), 0x4E, 0xF, 0xF, false)); }
__device__ __forceinline__ int chain_row(int dir, int b, int s) {
    if (s < CTXL) return NLAT + b * CTXL + (dir ? (CTXL - 1 - s) : s);
    const int t = s - CTXL; return b * T + (dir ? (T - 1 - t) : t);
}
__device__ __forceinline__ float dpp_hmirror(float x) { return __builtin_bit_cast(float, __builtin_amdgcn_update_dpp(0, __builtin_bit_cast(int, x), 0x141, 0xF, 0xF, false)); }
struct RwRec { u32x4 wp[2], rp[2], bk[4], arbk; u32x2 mak, vt[2]; f32x4 gam[4]; };
__device__ __forceinline__ void rw_load(RwRec& r, const LAS unsigned char* rec, int fr, int kg, int hv, int dir) {
#pragma unroll
    for (int sx = 0; sx < 2; ++sx) { r.wp[sx] = *(const LAS u32x4*)(rec + PR_WP + fr * 128 + sx * 64 + kg * 16); r.rp[sx] = *(const LAS u32x4*)(rec + PR_RP + fr * 128 + sx * 64 + kg * 16); }
#pragma unroll
    for (int i = 0; i < 4; ++i) { r.bk[i] = *(const LAS u32x4*)(rec + PR_BK + (16 * i + fr) * 64 + kg * 16); r.gam[i] = *(const LAS f32x4*)(rec + PR_GAM + (16 * i + 4 * kg) * 4); }
    r.arbk = *(const LAS u32x4*)(rec + PR_ARBK + fr * 64 + kg * 16);
    r.mak = *(const LAS u32x2*)(rec + PR_MAK + fr * 32 + kg * 8);
#pragma unroll
    for (int q = 0; q < 2; ++q) r.vt[q] = *(const LAS u32x2*)(rec + PRE_REC + (16 * (2 * hv + q) + fr) * 32 + (dir ? (12 - 4 * kg) : 4 * kg) * 2);
}
constexpr int RW_R = 6, RW_SLOT = PRE_REC + 2048;
__device__ __forceinline__ void rwkv_chain_mfma(KArgs a, int task_base, LAS unsigned char* lds) {
    const int t_ = tid_fresh(); const int lane = t_ & 63, fr = lane & 15, kg = lane >> 4; const int wave = __builtin_amdgcn_readfirstlane(t_ >> 6);
    unsigned char* ws = a->ws;
    bf16* OC = (bf16*)(ws + WS_OC);
    const int cid = (task_base >> 2) + (wave >> 2), wq = wave & 3, dir = cid / 96, b = (cid % 96) / 12, h = cid % 12;
    const bool comp = wq < 2; const int hv = wq & 1;
    const unsigned char* rec0 = ws + WS_PRE + (size_t)((dir * 8 + b) * 12 + h) * NCHUNK16 * PRE_REC;
    const unsigned char* vrec0 = ws + WS_VT + (size_t)(b * 12 + h) * NCHUNK16 * 2048;
    LAS unsigned char* ring = lds + (wave >> 2) * (RW_R * RW_SLOT);
    auto tchunk = [&](int n) { return n < 16 ? (dir ? 15 - n : n) : 16 + (dir ? 255 - (n - 16) : (n - 16)); };
    auto issue = [&](int n) { const int nn = n < NCHUNK16 ? n : NCHUNK16 - 1; LAS unsigned char* slot = ring + (n % RW_R) * RW_SLOT;
#pragma unroll
        for (int jj = 0; jj < 3; ++jj) { const int j = 3 * wq + jj;
            const unsigned char* src = (j < 10 ? rec0 + (size_t)nn * PRE_REC + 1024 * j : vrec0 + (size_t)tchunk(nn) * 2048 + 1024 * (j - 10)) + lane * 16;
            __builtin_amdgcn_global_load_lds((const unsigned*)src, (LAS unsigned*)(slot + 1024 * j), 16, 0, 0); } };
    f32x4 ST[2][4];
#pragma unroll
    for (int q = 0; q < 2; ++q)
#pragma unroll
        for (int i = 0; i < 4; ++i) ST[q][i] = (f32x4){0.f, 0.f, 0.f, 0.f};
    unsigned uvU[2][2] = {{0u, 0u}, {0u, 0u}};
#pragma unroll
    for (int n = 0; n < RW_R - 1; ++n) issue(n);
    for (int n = 0; n < NCHUNK16; ++n) {
        asm volatile("s_waitcnt vmcnt(12)" ::: "memory");
        __builtin_amdgcn_s_barrier(); asm volatile("" ::: "memory");
        issue(n + RW_R - 1);
        if (comp) {
            RwRec cur; rw_load(cur, ring + (n % RW_R) * RW_SLOT, fr, kg, hv, dir);
            u32x4 fmak; fmak.x = 0u; fmak.y = 0u; fmak.z = cur.mak.x; fmak.w = cur.mak.y;
            const int row = chain_row(dir, b, 16 * n + fr);
#pragma unroll
            for (int q = 0; q < 2; ++q) {
                u32x4 fs[2];
#pragma unroll
                for (int sx = 0; sx < 2; ++sx) { fs[sx].x = pk2(ST[q][2 * sx][0], ST[q][2 * sx][1]); fs[sx].y = pk2(ST[q][2 * sx][2], ST[q][2 * sx][3]); fs[sx].z = pk2(ST[q][2 * sx + 1][0], ST[q][2 * sx + 1][1]); fs[sx].w = pk2(ST[q][2 * sx + 1][2], ST[q][2 * sx + 1][3]); }
                u32x2 vt = cur.vt[q]; if (dir) { const unsigned x = vt.x, y = vt.y; vt.x = (y >> 16) | (y << 16); vt.y = (x >> 16) | (x << 16); }
                u32x4 fuv; fuv.x = uvU[q][0]; fuv.y = uvU[q][1]; fuv.z = vt.x; fuv.w = vt.y;
                f32x4 U = (f32x4){0.f, 0.f, 0.f, 0.f};
                U = __builtin_amdgcn_mfma_f32_16x16x32_bf16(__builtin_bit_cast(bf16x8, cur.wp[0]), __builtin_bit_cast(bf16x8, fs[0]), U, 0, 0, 0);
                U = __builtin_amdgcn_mfma_f32_16x16x32_bf16(__builtin_bit_cast(bf16x8, cur.wp[1]), __builtin_bit_cast(bf16x8, fs[1]), U, 0, 0, 0);
                U = __builtin_amdgcn_mfma_f32_16x16x32_bf16(__builtin_bit_cast(bf16x8, fmak), __builtin_bit_cast(bf16x8, fuv), U, 0, 0, 0);
                uvU[q][0] = pk2(U[0], U[1]); uvU[q][1] = pk2(U[2], U[3]); fuv.x = uvU[q][0]; fuv.y = uvU[q][1];
                f32x4 OT = (f32x4){0.f, 0.f, 0.f, 0.f};
                OT = __builtin_amdgcn_mfma_f32_16x16x32_bf16(__builtin_bit_cast(bf16x8, fs[0]), __builtin_bit_cast(bf16x8, cur.rp[0]), OT, 0, 0, 0);
                OT = __builtin_amdgcn_mfma_f32_16x16x32_bf16(__builtin_bit_cast(bf16x8, fs[1]), __builtin_bit_cast(bf16x8, cur.rp[1]), OT, 0, 0, 0);
                OT = __builtin_amdgcn_mfma_f32_16x16x32_bf16(__builtin_bit_cast(bf16x8, fuv), __builtin_bit_cast(bf16x8, cur.arbk), OT, 0, 0, 0);
#pragma unroll
                for (int i = 0; i < 4; ++i) ST[q][i] = __builtin_amdgcn_mfma_f32_16x16x32_bf16(__builtin_bit_cast(bf16x8, cur.bk[i]), __builtin_bit_cast(bf16x8, fuv), ST[q][i] * cur.gam[i], 0, 0, 0);
                u32x2 o; o.x = pk2(OT[0], OT[1]); o.y = pk2(OT[2], OT[3]); *(u32x2*)(OC + ((size_t)dir * MALL + row) * CW + h * 64 + 16 * (2 * hv + q) + 4 * kg) = o;
            }
        }
    }
    asm volatile("s_waitcnt vmcnt(0)" ::: "memory");
    __builtin_amdgcn_s_barrier(); asm volatile("" ::: "memory");
}
#define LDS_BAR() do { asm volatile("s_waitcnt lgkmcnt(0)" ::: "memory"); __builtin_amdgcn_s_barrier(); asm volatile("" ::: "memory"); } while (0)
__device__ __forceinline__ void hgrn_prep_item(KArgs a, int l, int item, LAS unsigned char* lds, bool dry) {
    const int tid = tid_fresh();
    unsigned char* ws = a->ws;
    bf16* P = (bf16*)(ws + WS_P); bf16* HQB = (bf16*)(ws + WS_HQB); float* HG = (float*)(ws + WS_HG);
    const int cn = item % 68, bh = item / 68, h = bh % 6, b = bh / 6;
    const int row0 = cn < 4 ? NLAT + b * CTXL + 64 * cn : b * T + 64 * (cn - 4);
    constexpr int QP = 136;
    LAS bf16* SQ = (LAS bf16*)lds; LAS bf16* KF = SQ + 64 * QP; LAS bf16* KB = KF + 64 * QP; LAS bf16* QB = KB + 64 * QP;
    LAS float* LF = (LAS float*)(QB + 64 * QP); LAS float* LBk = LF + 64 * 128;
    LAS float* tot = LBk + 64 * 128;
    LAS float* lbs = tot + 1024;
    if (tid < 256) { const int dr = tid >> 7, ch = h * 128 + (tid & 127); float lb = 0.f;
        if (l != 0) { const float l0 = a->in[I_LB][((size_t)dr * DEPTH + 0) * BW + ch], l1 = a->in[I_LB][((size_t)dr * DEPTH + 1) * BW + ch]; lb = __builtin_amdgcn_rcpf(1.0f + __expf(l0 - l1)); }
        lbs[tid] = lb; }
    const int ta = tid >> 3, d0 = (tid & 7) * 16;
    bf16* prow = P + (size_t)(row0 + ta) * INC + h * 128 + d0;
    u32x4 rq[2], rf[2], rb[2];
    rq[0] = *(const u32x4*)(prow + OFF_Q); rq[1] = *(const u32x4*)(prow + OFF_Q + 8); rf[0] = *(const u32x4*)(prow + OFF_ZF); rf[1] = *(const u32x4*)(prow + OFF_ZF + 8); rb[0] = *(const u32x4*)(prow + OFF_ZB); rb[1] = *(const u32x4*)(prow + OFF_ZB + 8);
    __syncthreads();
#pragma unroll
    for (int hf = 0; hf < 2; ++hf) { float qf[8], zf[8], zb[8], oq[8], of[8], ob[8]; unpack8(rq[hf], qf); unpack8(rf[hf], zf); unpack8(rb[hf], zb);
        const int dd = d0 + 8 * hf; f32x4 lf0, lf1, lb0, lb1;
#pragma unroll
        for (int j = 0; j < 8; ++j) { const float lF = lbs[dd + j], lB = lbs[128 + dd + j];
            const float ff = lF + (1.0f - lF) * sigmoidf_(zf[j]), fb = lB + (1.0f - lB) * sigmoidf_(zb[j]);
            const float a1 = fmaxf(__logf(ff), -60.0f), a2 = fmaxf(__logf(fb), -60.0f);
            if (j < 4) { lf0[j] = a1; lb0[j] = a2; } else { lf1[j - 4] = a1; lb1[j - 4] = a2; }
            oq[j] = siluf_(qf[j]); of[j] = 1.0f - ff; ob[j] = 1.0f - fb; }
        *(LAS u32x4*)(SQ + ta * QP + dd) = pack8(oq); *(LAS u32x4*)(KF + ta * QP + dd) = pack8(of); *(LAS u32x4*)(KB + ta * QP + dd) = pack8(ob);
        *(LAS f32x4*)(LF + ta * 128 + dd) = lf0; *(LAS f32x4*)(LF + ta * 128 + dd + 4) = lf1; *(LAS f32x4*)(LBk + ta * 128 + dd) = lb0; *(LAS f32x4*)(LBk + ta * 128 + dd + 4) = lb1; }
    __syncthreads();
    { const int d = tid & 127, qt = tid >> 7; float r1 = 0.f, r2 = 0.f;
#pragma unroll
      for (int i = 0; i < 16; ++i) { const int tp = 16 * qt + i; r1 += LF[tp * 128 + d]; LF[tp * 128 + d] = r1; r2 += LBk[(63 - tp) * 128 + d]; LBk[(63 - tp) * 128 + d] = r2; }
      tot[qt * 128 + d] = r1; tot[512 + qt * 128 + d] = r2; }
    __syncthreads();
    LAS float* bas = lbs + 256;
    LAS float* bmd = bas + 1024;
    { const int d = tid & 127, dr = (tid >> 7) & 1; if (tid < 256) { const LAS float* tt = tot + 512 * dr; const float t0 = tt[d], t1 = tt[128 + d], t2 = tt[256 + d], t3 = tt[384 + d];
        bas[(dr * 4 + 0) * 128 + d] = 0.f; bas[(dr * 4 + 1) * 128 + d] = t0; bas[(dr * 4 + 2) * 128 + d] = t0 + t1; bas[(dr * 4 + 3) * 128 + d] = t0 + t1 + t2; bmd[dr * 128 + d] = t0 + t1;
        const int npr = dr == 0 ? cn : (cn < 4 ? 3 - cn : 4 + 63 - (cn - 4)); float* g = (dry ? (float*)(ws + WS_END + 8 * MiB) : HG) + ((size_t)(((dr * 8 + b) * 6 + h) * 68 + npr)) * 256; g[d] = __expf(t0 + t1); g[128 + d] = __expf(t2 + t3); } }
    __syncthreads();
#pragma unroll
    for (int hf = 0; hf < 2; ++hf) { const int dd = d0 + 8 * hf; float sq[8], kf[8], kb[8];
        unpack8(*(const LAS u32x4*)(SQ + ta * QP + dd), sq); unpack8(*(const LAS u32x4*)(KF + ta * QP + dd), kf); unpack8(*(const LAS u32x4*)(KB + ta * QP + dd), kb);
        float oqf[8], okf[8], oqb[8], okb[8];
#pragma unroll
        for (int dr = 0; dr < 2; ++dr) { const int tp = dr ? 63 - ta : ta, q = tp >> 4; const LAS float* pf = (dr ? LBk : LF) + ta * 128 + dd;
            const f32x4 p0 = *(const LAS f32x4*)pf, p1 = *(const LAS f32x4*)(pf + 4), b0 = *(const LAS f32x4*)(bas + (dr * 4 + q) * 128 + dd), b1 = *(const LAS f32x4*)(bas + (dr * 4 + q) * 128 + dd + 4),
                        m0 = *(const LAS f32x4*)(bmd + dr * 128 + dd), m1 = *(const LAS f32x4*)(bmd + dr * 128 + dd + 4);
#pragma unroll
            for (int j = 0; j < 8; ++j) { const float bt = (j < 4 ? p0[j] + b0[j] : p1[j - 4] + b1[j - 4]), bm = j < 4 ? m0[j] : m1[j - 4];
                const float eq = __expf(fminf(bt - bm, 80.0f)), ek = __expf(fminf(bm - bt, 80.0f));
                if (dr == 0) { oqf[j] = sq[j] * eq; okf[j] = kf[j] * ek; } else { oqb[j] = sq[j] * eq; okb[j] = kb[j] * ek; } } }
        *(LAS u32x4*)(QB + ta * QP + dd) = pack8(oqf); *(LAS u32x4*)(KF + ta * QP + dd) = pack8(okf); *(LAS u32x4*)(KB + ta * QP + dd) = pack8(okb); *(LAS u32x4*)(SQ + ta * QP + dd) = pack8(oqb); }
    bf16* prow_o = dry ? (bf16*)(ws + WS_END) + (size_t)((row0 + ta) & 511) * INC + h * 128 + d0 : prow; bf16* hqb_o = dry ? (bf16*)(ws + WS_END) : HQB;
#pragma unroll
    for (int hf = 0; hf < 2; ++hf) { const int dd = d0 + 8 * hf;
        *(u32x4*)(prow_o + OFF_Q + 8 * hf) = *(const LAS u32x4*)(QB + ta * QP + dd); *(u32x4*)(prow_o + OFF_ZF + 8 * hf) = *(const LAS u32x4*)(KF + ta * QP + dd); *(u32x4*)(prow_o + OFF_ZB + 8 * hf) = *(const LAS u32x4*)(KB + ta * QP + dd);
        *(u32x4*)(hqb_o + (size_t)(dry ? ((row0 + ta) & 1023) : (row0 + ta)) * BW + h * 128 + dd) = *(const LAS u32x4*)(SQ + ta * QP + dd); }
    __syncthreads();
}
__device__ __forceinline__ unsigned tr_addr(const LAS bf16* X, int pitch, int r0, int c0, int lane) { const int i = lane & 15, g = lane >> 4; return (unsigned)(size_t)(X + (r0 + 8 * g + (i >> 2)) * pitch + c0 + 4 * (i & 3)); }
__device__ __forceinline__ void tr8x4(u32x2 (&lo)[4], u32x2 (&hi)[4], unsigned a0, unsigned a1, unsigned a2, unsigned a3, unsigned rowstep4) {
    const unsigned b0 = a0 + rowstep4, b1 = a1 + rowstep4, b2 = a2 + rowstep4, b3 = a3 + rowstep4;
    asm volatile("ds_read_b64_tr_b16 %0, %8\n\tds_read_b64_tr_b16 %1, %9\n\tds_read_b64_tr_b16 %2, %10\n\tds_read_b64_tr_b16 %3, %11\n\t"
                 "ds_read_b64_tr_b16 %4, %12\n\tds_read_b64_tr_b16 %5, %13\n\tds_read_b64_tr_b16 %6, %14\n\tds_read_b64_tr_b16 %7, %15\n\ts_waitcnt lgkmcnt(0)"
                 : "=&v"(lo[0]), "=&v"(lo[1]), "=&v"(lo[2]), "=&v"(lo[3]), "=&v"(hi[0]), "=&v"(hi[1]), "=&v"(hi[2]), "=&v"(hi[3])
                 : "v"(a0), "v"(a1), "v"(a2), "v"(a3), "v"(b0), "v"(b1), "v"(b2), "v"(b3) : "memory");
}
__device__ __forceinline__ bf16x8 mk8(u32x2 lo, u32x2 hi) { u32x4 v; v.x = lo.x; v.y = lo.y; v.z = hi.x; v.w = hi.y; return __builtin_bit_cast(bf16x8, v); }
__device__ __forceinline__ void hgrn_chain_lean(KArgs a, int cid, LAS unsigned char* lds) {
    const int tid = tid_fresh(), lane = tid & 63, wave = tid >> 6, fr = lane & 15, fq = lane >> 4;
    unsigned char* ws = a->ws;
    const bf16* P = (const bf16*)(ws + WS_P); const bf16* HQB = (const bf16*)(ws + WS_HQB); const float* HG = (const float*)(ws + WS_HG); bf16* OB = (bf16*)(ws + WS_OB);
    const int dir = cid / 48, b = (cid % 48) / 6, h = cid % 6;
    constexpr int QP = 136, SP = 72;
    LAS bf16* qs = (LAS bf16*)lds;
    LAS bf16* ks = qs + 64 * QP;
    LAS bf16* vs = ks + 64 * QP;
    LAS bf16* pl = vs + 64 * QP;
    LAS bf16* sT = pl + 64 * SP;
    LAS float* gm = (LAS float*)(sT + 128 * QP);
    const int ta = tid >> 3, d0 = (tid & 7) * 16;
    const int koff = dir ? OFF_ZB : OFF_ZF;
    f32x4 S[8];
#pragma unroll
    for (int vt = 0; vt < 8; ++vt) S[vt] = (f32x4){0.f, 0.f, 0.f, 0.f};
    u32x4 rq[2], rk[2], rv[2]; float rg = 0.f;
    auto load_chunk = [&](int n) { const int row = chain_row(dir, b, 64 * n + ta); const bf16* pr = P + (size_t)row * INC + h * 128 + d0;
        const bf16* qr = dir ? HQB + (size_t)row * BW + h * 128 + d0 : pr + OFF_Q;
        rq[0] = *(const u32x4*)qr; rq[1] = *(const u32x4*)(qr + 8); rk[0] = *(const u32x4*)(pr + koff); rk[1] = *(const u32x4*)(pr + koff + 8); rv[0] = *(const u32x4*)(pr + OFF_I); rv[1] = *(const u32x4*)(pr + OFF_I + 8);
        if (tid < 256) rg = HG[((size_t)(((dir * 8 + b) * 6 + h) * 68 + n)) * 256 + tid]; };
    load_chunk(0);
    constexpr int NCH = (CTXL + T) / 64;
    for (int n = 0; n < NCH; ++n) {
        const int s0 = n * 64;
        *(LAS u32x4*)(qs + ta * QP + d0) = rq[0]; *(LAS u32x4*)(qs + ta * QP + d0 + 8) = rq[1]; *(LAS u32x4*)(ks + ta * QP + d0) = rk[0]; *(LAS u32x4*)(ks + ta * QP + d0 + 8) = rk[1];
        *(LAS u32x4*)(vs + ta * QP + d0) = rv[0]; *(LAS u32x4*)(vs + ta * QP + d0 + 8) = rv[1]; if (tid < 256) gm[tid] = rg;
        if (n + 1 < NCH) load_chunk(n + 1);
        LDS_BAR();
        { const f32x4 g4 = *(const LAS f32x4*)(gm + 16 * wave + 4 * fq);
#pragma unroll
          for (int vt = 0; vt < 8; ++vt) { S[vt] = S[vt] * g4; u32x2 o; o.x = pk2(S[vt][0], S[vt][1]); o.y = pk2(S[vt][2], S[vt][3]); *(LAS u32x2*)(sT + (16 * vt + fr) * QP + 16 * wave + 4 * fq) = o; } }
        { const int tt = wave >> 1;
#pragma unroll
          for (int u = 0; u < 2; ++u) { const int sg = 2 * (wave & 1) + u; f32x4 acc = (f32x4){0.f, 0.f, 0.f, 0.f};
              if (sg <= tt) {
#pragma unroll
                  for (int kq = 0; kq < 4; ++kq) { const bf16x8 af = *(const LAS bf16x8*)(ks + (16 * sg + fr) * QP + 32 * kq + 8 * fq), bfm = *(const LAS bf16x8*)(qs + (16 * tt + fr) * QP + 32 * kq + 8 * fq);
                      acc = __builtin_amdgcn_mfma_f32_16x16x32_bf16(af, bfm, acc, 0, 0, 0); }
                  if (sg == tt) {
#pragma unroll
                      for (int j = 0; j < 4; ++j) if (4 * fq + j > fr) acc[j] = 0.f; }
              }
              u32x2 o; o.x = pk2(acc[0], acc[1]); o.y = pk2(acc[2], acc[3]); *(LAS u32x2*)(pl + (16 * tt + fr) * SP + 16 * sg + 4 * fq) = o; } }
        LDS_BAR();
        f32x4 oacc[4];
#pragma unroll
        for (int tt = 0; tt < 4; ++tt) { f32x4 acc = (f32x4){0.f, 0.f, 0.f, 0.f};
#pragma unroll
            for (int kq = 0; kq < 4; ++kq) { const bf16x8 af = *(const LAS bf16x8*)(sT + (16 * wave + fr) * QP + 32 * kq + 8 * fq), bfm = *(const LAS bf16x8*)(qs + (16 * tt + fr) * QP + 32 * kq + 8 * fq);
                acc = __builtin_amdgcn_mfma_f32_16x16x32_bf16(af, bfm, acc, 0, 0, 0); }
            oacc[tt] = acc; }
        const unsigned rs4 = (unsigned)(4 * QP * 2);
#pragma unroll
        for (int kq = 0; kq < 2; ++kq) {
            u32x2 vl_[8], vh_[8], xl_[4], xh_[4];
            { u32x2 l4[4], h4[4];
              tr8x4(l4, h4, tr_addr(vs, QP, 32 * kq, 0, lane), tr_addr(vs, QP, 32 * kq, 16, lane), tr_addr(vs, QP, 32 * kq, 32, lane), tr_addr(vs, QP, 32 * kq, 48, lane), rs4);
#pragma unroll
              for (int q = 0; q < 4; ++q) { vl_[q] = l4[q]; vh_[q] = h4[q]; }
              tr8x4(l4, h4, tr_addr(vs, QP, 32 * kq, 64, lane), tr_addr(vs, QP, 32 * kq, 80, lane), tr_addr(vs, QP, 32 * kq, 96, lane), tr_addr(vs, QP, 32 * kq, 112, lane), rs4);
#pragma unroll
              for (int q = 0; q < 4; ++q) { vl_[4 + q] = l4[q]; vh_[4 + q] = h4[q]; }
              tr8x4(xl_, xh_, tr_addr(ks, QP, 32 * kq, 16 * wave, lane), tr_addr(vs, QP, 32 * kq, 16 * wave, lane), tr_addr(ks, QP, 32 * kq, 16 * wave, lane), tr_addr(vs, QP, 32 * kq, 16 * wave, lane), rs4); }
            __builtin_amdgcn_sched_barrier(0);
            { const bf16x8 af = mk8(xl_[1], xh_[1]);
#pragma unroll
              for (int tt = 0; tt < 4; ++tt) { const bf16x8 bfm = *(const LAS bf16x8*)(pl + (16 * tt + fr) * SP + 32 * kq + 8 * fq); oacc[tt] = __builtin_amdgcn_mfma_f32_16x16x32_bf16(af, bfm, oacc[tt], 0, 0, 0); } }
            { const bf16x8 af = mk8(xl_[0], xh_[0]);
#pragma unroll
              for (int vt = 0; vt < 8; ++vt) S[vt] = __builtin_amdgcn_mfma_f32_16x16x32_bf16(af, mk8(vl_[vt], vh_[vt]), S[vt], 0, 0, 0); }
        }
#pragma unroll
        for (int tt = 0; tt < 4; ++tt) { const int row = chain_row(dir, b, s0 + 16 * tt + fr);
            u32x2 o; o.x = pk2(oacc[tt][0], oacc[tt][1]); o.y = pk2(oacc[tt][2], oacc[tt][3]); *(u32x2*)(OB + ((size_t)dir * MALL + row) * BW + h * 128 + 16 * wave + 4 * fq) = o; }
        { const f32x4 ge = *(const LAS f32x4*)(gm + 128 + 16 * wave + 4 * fq);
#pragma unroll
          for (int vt = 0; vt < 8; ++vt) S[vt] = S[vt] * ge; }
        LDS_BAR();
    }
}
__device__ __forceinline__ void hgrn_chain_mfma(KArgs a, int l, int cid, LAS unsigned char* lds) {
    const int tid = tid_fresh(), lane = tid & 63, wave = tid >> 6, fr = lane & 15, fq = lane >> 4;
    unsigned char* ws = a->ws;
    const bf16* P = (const bf16*)(ws + WS_P); bf16* OB = (bf16*)(ws + WS_OB);
    const int dir = cid / 48, b = (cid % 48) / 6, h = cid % 6;
    constexpr int QP = 136, SP = 72;
    LAS bf16* qs = (LAS bf16*)lds;
    LAS bf16* ks = qs + 64 * QP;
    LAS bf16* kT = ks + 64 * QP;
    LAS bf16* vT = kT + 128 * SP;
    LAS bf16* pl = vT + 128 * SP;
    LAS bf16* sT = pl + 64 * SP;
    LAS float* tot = (LAS float*)(sT + 128 * QP);
    LAS float* gmid = tot + 512;
    LAS float* gend = gmid + 128;
    LAS float* lbs = gend + 128;
    LAS float* lfb = (LAS float*)sT;
    const int d = tid & 127, qt = tid >> 7;
    const int tau_a = tid >> 3, d0 = (tid & 7) * 16;
    if (tid < 128) { const int ch = h * 128 + tid; float lb = 0.f;
        if (l != 0) { const float l0 = a->in[I_LB][((size_t)dir * DEPTH + 0) * BW + ch], l1 = a->in[I_LB][((size_t)dir * DEPTH + 1) * BW + ch]; lb = 1.0f / (1.0f + __expf(l0 - l1)); }
        lbs[tid] = lb; }
    f32x4 S[8];
#pragma unroll
    for (int vt = 0; vt < 8; ++vt) S[vt] = (f32x4){0.f, 0.f, 0.f, 0.f};
    const int zoff = dir ? OFF_ZB : OFF_ZF;
    u32x4 rq[2], ri[2], rz[2];
    { const bf16* pr = P + (size_t)chain_row(dir, b, tau_a) * INC + h * 128 + d0;
      rq[0] = *(const u32x4*)(pr + OFF_Q); rq[1] = *(const u32x4*)(pr + OFF_Q + 8); ri[0] = *(const u32x4*)(pr + OFF_I); ri[1] = *(const u32x4*)(pr + OFF_I + 8); rz[0] = *(const u32x4*)(pr + zoff); rz[1] = *(const u32x4*)(pr + zoff + 8); }
    __syncthreads();
    constexpr int NCH = (CTXL + T) / 64;
    for (int n = 0; n < NCH; ++n) {
        const int s0 = n * 64;
#pragma unroll
        for (int hf = 0; hf < 2; ++hf) { float qf[8], zf[8], oq[8], ok[8]; unpack8(rq[hf], qf); unpack8(rz[hf], zf);
            const int dd = d0 + 8 * hf; const f32x4 lb0 = *(const LAS f32x4*)(lbs + dd), lb1 = *(const LAS f32x4*)(lbs + dd + 4); f32x4 lf0, lf1;
#pragma unroll
            for (int j = 0; j < 8; ++j) { const float lb = j < 4 ? lb0[j] : lb1[j - 4]; const float f = lb + (1.0f - lb) * sigmoidf_(zf[j]); const float lf = fmaxf(__logf(f), -60.0f);
                if (j < 4) lf0[j] = lf; else lf1[j - 4] = lf; oq[j] = siluf_(qf[j]); ok[j] = 1.0f - f; }
            *(LAS u32x4*)(qs + tau_a * QP + dd) = pack8(oq); *(LAS u32x4*)(ks + tau_a * QP + dd) = pack8(ok);
            *(LAS f32x4*)(lfb + tau_a * 128 + dd) = lf0; *(LAS f32x4*)(lfb + tau_a * 128 + dd + 4) = lf1;
            const u32x4 vv = ri[hf];
            vT[(dd + 0) * SP + tau_a] = (bf16)(vv.x & 0xffffu); vT[(dd + 1) * SP + tau_a] = (bf16)(vv.x >> 16); vT[(dd + 2) * SP + tau_a] = (bf16)(vv.y & 0xffffu); vT[(dd + 3) * SP + tau_a] = (bf16)(vv.y >> 16);
            vT[(dd + 4) * SP + tau_a] = (bf16)(vv.z & 0xffffu); vT[(dd + 5) * SP + tau_a] = (bf16)(vv.z >> 16); vT[(dd + 6) * SP + tau_a] = (bf16)(vv.w & 0xffffu); vT[(dd + 7) * SP + tau_a] = (bf16)(vv.w >> 16); }
        if (n + 1 < NCH) { const bf16* pr = P + (size_t)chain_row(dir, b, s0 + 64 + tau_a) * INC + h * 128 + d0;
            rq[0] = *(const u32x4*)(pr + OFF_Q); rq[1] = *(const u32x4*)(pr + OFF_Q + 8); ri[0] = *(const u32x4*)(pr + OFF_I); ri[1] = *(const u32x4*)(pr + OFF_I + 8); rz[0] = *(const u32x4*)(pr + zoff); rz[1] = *(const u32x4*)(pr + zoff + 8); }
        LDS_BAR();
        float cs[16];
        { float run = 0.f;
#pragma unroll
          for (int i = 0; i < 16; ++i) { run += lfb[(16 * qt + i) * 128 + d]; cs[i] = run; }
          tot[qt * 128 + d] = run; }
        LDS_BAR();
        { const float t0 = tot[d], t1 = tot[128 + d], t2 = tot[256 + d], t3 = tot[384 + d];
          const float bmid = t0 + t1, btot = bmid + t2 + t3; const float base = (qt > 0 ? t0 : 0.f) + (qt > 1 ? t1 : 0.f) + (qt > 2 ? t2 : 0.f);
          if (qt == 0) { gmid[d] = __expf(bmid); gend[d] = __expf(btot - bmid); }
#pragma unroll
          for (int i = 0; i < 16; ++i) { const int tau = 16 * qt + i; const float bt = base + cs[i];
              const float eq = __expf(fminf(bt - bmid, 80.0f)), ek = __expf(fminf(bmid - bt, 80.0f));
              const bf16 qb = (bf16)f2bf(bf1(qs[tau * QP + d]) * eq), kb = (bf16)f2bf(bf1(ks[tau * QP + d]) * ek);
              qs[tau * QP + d] = qb; ks[tau * QP + d] = kb; kT[d * SP + tau] = kb; } }
        LDS_BAR();
        { const f32x4 gm = *(const LAS f32x4*)(gmid + 16 * wave + 4 * fq);
#pragma unroll
          for (int vt = 0; vt < 8; ++vt) { S[vt] = S[vt] * gm; u32x2 o; o.x = pk2(S[vt][0], S[vt][1]); o.y = pk2(S[vt][2], S[vt][3]); *(LAS u32x2*)(sT + (16 * vt + fr) * QP + 16 * wave + 4 * fq) = o; } }
        { const int tt = wave >> 1;
#pragma unroll
          for (int u = 0; u < 2; ++u) { const int sg = 2 * (wave & 1) + u; f32x4 acc = (f32x4){0.f, 0.f, 0.f, 0.f};
              if (sg <= tt) {
#pragma unroll
                  for (int kq = 0; kq < 4; ++kq) { const bf16x8 af = *(const LAS bf16x8*)(ks + (16 * sg + fr) * QP + 32 * kq + 8 * fq), bfm = *(const LAS bf16x8*)(qs + (16 * tt + fr) * QP + 32 * kq + 8 * fq);
                      acc = __builtin_amdgcn_mfma_f32_16x16x32_bf16(af, bfm, acc, 0, 0, 0); }
                  if (sg == tt) {
#pragma unroll
                      for (int j = 0; j < 4; ++j) if (4 * fq + j > fr) acc[j] = 0.f; }
              }
              u32x2 o; o.x = pk2(acc[0], acc[1]); o.y = pk2(acc[2], acc[3]); *(LAS u32x2*)(pl + (16 * tt + fr) * SP + 16 * sg + 4 * fq) = o; } }
        LDS_BAR();
#pragma unroll
        for (int tt = 0; tt < 4; ++tt) { f32x4 acc = (f32x4){0.f, 0.f, 0.f, 0.f};
#pragma unroll
            for (int kq = 0; kq < 2; ++kq) { const bf16x8 af = *(const LAS bf16x8*)(vT + (16 * wave + fr) * SP + 32 * kq + 8 * fq), bfm = *(const LAS bf16x8*)(pl + (16 * tt + fr) * SP + 32 * kq + 8 * fq);
                acc = __builtin_amdgcn_mfma_f32_16x16x32_bf16(af, bfm, acc, 0, 0, 0); }
#pragma unroll
            for (int kq = 0; kq < 4; ++kq) { const bf16x8 af = *(const LAS bf16x8*)(sT + (16 * wave + fr) * QP + 32 * kq + 8 * fq), bfm = *(const LAS bf16x8*)(qs + (16 * tt + fr) * QP + 32 * kq + 8 * fq);
                acc = __builtin_amdgcn_mfma_f32_16x16x32_bf16(af, bfm, acc, 0, 0, 0); }
            const int row = chain_row(dir, b, s0 + 16 * tt + fr);
            u32x2 o; o.x = pk2(acc[0], acc[1]); o.y = pk2(acc[2], acc[3]); *(u32x2*)(OB + ((size_t)dir * MALL + row) * BW + h * 128 + 16 * wave + 4 * fq) = o; }
        { const f32x4 ge = *(const LAS f32x4*)(gend + 16 * wave + 4 * fq);
#pragma unroll
          for (int kq = 0; kq < 2; ++kq) { const bf16x8 af = *(const LAS bf16x8*)(kT + (16 * wave + fr) * SP + 32 * kq + 8 * fq);
#pragma unroll
              for (int vt = 0; vt < 8; ++vt) { const bf16x8 bfm = *(const LAS bf16x8*)(vT + (16 * vt + fr) * SP + 32 * kq + 8 * fq); S[vt] = __builtin_amdgcn_mfma_f32_16x16x32_bf16(af, bfm, S[vt], 0, 0, 0); } }
#pragma unroll
          for (int vt = 0; vt < 8; ++vt) S[vt] = S[vt] * ge; }
        LDS_BAR();
    }
}
__device__ __forceinline__ void hgrn_chain(KArgs a, int l, int cid, LAS unsigned char* lds) {
    const int tid = tid_fresh();
    unsigned char* ws = a->ws;
    const bf16* P = (const bf16*)(ws + WS_P); bf16* OB = (bf16*)(ws + WS_OB);
    const int dir = cid / 48, b = (cid % 48) / 6, h = cid % 6;
    LAS float* tq = (LAS float*)lds;
    LAS float* tk = tq + 16 * 128;
    LAS float* tf = tk + 16 * 128;
    LAS float* tv = tf + 16 * 128;
    LAS float* ot = tv + 16 * 128;
    const int v = tid >> 2, q = tid & 3;
    float S[32];
#pragma unroll
    for (int j = 0; j < 32; ++j) S[j] = 0.f;
    const int sst = tid >> 5, sc4 = (tid & 31) * 4;
    float lb[4];
#pragma unroll
    for (int j = 0; j < 4; ++j) { const int ch = h * 128 + sc4 + j;
        if (l == 0) lb[j] = 0.f; else { const float l0 = a->in[I_LB][((size_t)dir * DEPTH + 0) * BW + ch], l1 = a->in[I_LB][((size_t)dir * DEPTH + 1) * BW + ch]; lb[j] = 1.0f / (1.0f + __expf(l0 - l1)); } }
    for (int s0 = 0; s0 < CTXL + T; s0 += 16) {
        { const int row = chain_row(dir, b, s0 + sst); const bf16* pr = P + (size_t)row * INC + h * 128 + sc4;
          const u32x2 pq = *(const u32x2*)(pr + OFF_Q), pi = *(const u32x2*)(pr + OFF_I), pz = *(const u32x2*)(pr + (dir ? OFF_ZB : OFF_ZF));
          const float qf[4] = {bflo(pq.x), bfhi(pq.x), bflo(pq.y), bfhi(pq.y)}, vf[4] = {bflo(pi.x), bfhi(pi.x), bflo(pi.y), bfhi(pi.y)}, zf[4] = {bflo(pz.x), bfhi(pz.x), bflo(pz.y), bfhi(pz.y)};
          f32x4 oq, ok, of, ov;
#pragma unroll
          for (int j = 0; j < 4; ++j) { const float f = lb[j] + (1.0f - lb[j]) * sigmoidf_(zf[j]); oq[j] = siluf_(qf[j]); of[j] = f; ok[j] = 1.0f - f; ov[j] = vf[j]; }
          *(LAS f32x4*)(tq + sst * 128 + sc4) = oq; *(LAS f32x4*)(tk + sst * 128 + sc4) = ok; *(LAS f32x4*)(tf + sst * 128 + sc4) = of; *(LAS f32x4*)(tv + sst * 128 + sc4) = ov; }
        LDS_BAR();
        for (int st = 0; st < 16; ++st) {
            const float vv = tv[st * 128 + v]; float o0 = 0.f, o1 = 0.f;
#pragma unroll
            for (int j = 0; j < 8; ++j) { const f32x4 fq4 = *(const LAS f32x4*)(tf + st * 128 + q * 32 + 4 * j), kq4 = *(const LAS f32x4*)(tk + st * 128 + q * 32 + 4 * j), qq4 = *(const LAS f32x4*)(tq + st * 128 + q * 32 + 4 * j);
#pragma unroll
                for (int i = 0; i < 4; ++i) { const float sn = fq4[i] * S[4 * j + i] + kq4[i] * vv; S[4 * j + i] = sn; if (i & 1) o1 += qq4[i] * sn; else o0 += qq4[i] * sn; } }
            float o = o0 + o1; o += dpp_xor1(o); o += dpp_xor2(o);
            if (q == 0) ot[st * 128 + v] = o;
        }
        LDS_BAR();
        if (tid < 256) { const int st = tid >> 4, part = tid & 15; const int row = chain_row(dir, b, s0 + st); const LAS float* op = ot + st * 128 + part * 8;
            float f[8];
#pragma unroll
            for (int j = 0; j < 8; ++j) f[j] = op[j];
            *(u32x4*)(OB + ((size_t)dir * MALL + row) * BW + h * 128 + part * 8) = pack8(f); }
    }
    LDS_BAR();
}

__device__ __forceinline__ float grp_sum32(float v) { v += __shfl_xor(v, 1); v += __shfl_xor(v, 2); v += __shfl_xor(v, 4); v += __shfl_xor(v, 8); v += __shfl_xor(v, 16); return v; }
__device__ __forceinline__ float grp_sum16(float v) { v += __shfl_xor(v, 1); v += __shfl_xor(v, 2); v += __shfl_xor(v, 4); v += __shfl_xor(v, 8); return v; }
__device__ __forceinline__ void phase_finalize(KArgs a, int l, bool dry) {
    const int tid_ = tid_fresh(); const int lane = tid_ & 63, wave = tid_ >> 6, gw = blockIdx.x * 8 + wave, NGW = gridDim.x * 8;
    unsigned char* ws = a->ws;
    const bf16* P = (const bf16*)(ws + WS_P); const bf16* OB = (const bf16*)(ws + WS_OB); const bf16* OC = (const bf16*)(ws + WS_OC); bf16* Y = (bf16*)(ws + WS_Y);
    bf16* Yo = dry ? (bf16*)(ws + WS_END) : Y;
    const int nrows = (l == DEPTH - 1) ? NLAT : MALL;
    const int rpw = (nrows + NGW - 1) / NGW; const int r0 = gw * rpw, r1 = (r0 + rpw < nrows) ? r0 + rpw : nrows;
    f32x4 hng[3], gng[3], gnb[3];
#pragma unroll
    for (int k = 0; k < 3; ++k) { const int c = 256 * k + 4 * lane; hng[k] = *(const f32x4*)(a->in[I_HNG] + (size_t)l * BW + c);
        gng[k] = *(const f32x4*)(a->in[I_GNGG] + (size_t)l * CW + c); gnb[k] = *(const f32x4*)(a->in[I_GNB] + (size_t)l * CW + c); }
    for (int row = r0; row < r1; ++row) {
        const int orow = dry ? (row & 2047) : row;
        u32x2 bf_[3], bb_[3], bg_[3], cf_[3], cb_[3], cv_[3], cg_[3];
#pragma unroll
        for (int k = 0; k < 3; ++k) { const int c = 256 * k + 4 * lane;
            bf_[k] = *(const u32x2*)(OB + (size_t)row * BW + c); bb_[k] = *(const u32x2*)(OB + ((size_t)MALL + row) * BW + c); bg_[k] = *(const u32x2*)(P + (size_t)row * INC + OFF_OG + c);
            cf_[k] = *(const u32x2*)(OC + (size_t)row * CW + c); cb_[k] = *(const u32x2*)(OC + ((size_t)MALL + row) * CW + c);
            cv_[k] = *(const u32x2*)(Y + (size_t)row * D + 512 + c);
            cg_[k] = *(const u32x2*)(Y + (size_t)row * D + 1280 + c); }
#pragma unroll
        for (int k = 0; k < 3; ++k) { const int c = 256 * k + 4 * lane;
            { float o[4] = {bflo(bf_[k].x) + bflo(bb_[k].x), bfhi(bf_[k].x) + bfhi(bb_[k].x), bflo(bf_[k].y) + bflo(bb_[k].y), bfhi(bf_[k].y) + bfhi(bb_[k].y)};
              const float ss = grp_sum32((o[0] * o[0] + o[1] * o[1]) + (o[2] * o[2] + o[3] * o[3])); const float rstd = 1.0f / sqrtf(ss * (1.0f / 128.0f) + NORM_EPS);
              const float g4[4] = {bflo(bg_[k].x), bfhi(bg_[k].x), bflo(bg_[k].y), bfhi(bg_[k].y)}; float y[4];
#pragma unroll
              for (int j = 0; j < 4; ++j) y[j] = o[j] * rstd * hng[k][j] * sigmoidf_(g4[j]);
              u32x2 q; q.x = pk2(y[0], y[1]); q.y = pk2(y[2], y[3]); *(u32x2*)(Yo + (size_t)orow * D + 512 + c) = q; }
            { float o[4] = {bflo(cf_[k].x) + bflo(cb_[k].x), bfhi(cf_[k].x) + bfhi(cb_[k].x), bflo(cf_[k].y) + bflo(cb_[k].y), bfhi(cf_[k].y) + bfhi(cb_[k].y)};
              const float v4[4] = {bflo(cv_[k].x), bfhi(cv_[k].x), bflo(cv_[k].y), bfhi(cv_[k].y)}, g4[4] = {bflo(cg_[k].x), bfhi(cg_[k].x), bflo(cg_[k].y), bfhi(cg_[k].y)};
              const float mean = grp_sum16((o[0] + o[1]) + (o[2] + o[3])) * (1.0f / 64.0f);
              float dl[4]; float sq = 0.f;
#pragma unroll
              for (int j = 0; j < 4; ++j) { dl[j] = o[j] - mean; sq += dl[j] * dl[j]; }
              const float var = grp_sum16(sq) * (1.0f / 64.0f); const float rs = 1.0f / sqrtf(var + GN_EPS); float y[4];
#pragma unroll
              for (int j = 0; j < 4; ++j) y[j] = (dl[j] * rs * gng[k][j] + gnb[k][j] + v4[j]) * g4[j];
              u32x2 q; q.x = pk2(y[0], y[1]); q.y = pk2(y[2], y[3]); *(u32x2*)(Yo + (size_t)orow * D + 1280 + c) = q; }
        }
    }
}

__global__ void __launch_bounds__(NTHREADS, 2) mk_fwd(Args args_unused) {
    extern __shared__ __attribute__((aligned(16))) unsigned char lds_raw[];
    LAS unsigned char* lds = (LAS unsigned char*)lds_raw;
    volatile LAS unsigned* misc = (volatile LAS unsigned*)(lds + LDS_MISC);
    const int tid = threadIdx.x, G = gridDim.x;
    if (tid < 64) misc[tid] = 0u;
    __syncthreads();
    XcdBarrier bar; bar.bar = nullptr; bar.x = 0; bar.st = nullptr;
    int lo, hi;
    { KArgs a = kargs(); lo = a->ph_lo; hi = a->ph_hi; unsigned* ctl = (unsigned*)(a->ws + WS_CTL); bar.bar = ctl + CW_BAR; if (!MK_MULTI) bar = xcd_barrier_post(ctl + CW_BAR, misc + 8); }
    const int cvirt = (G % 8 == 0) ? ((int)blockIdx.x % 8) * (G / 8) + (int)blockIdx.x / 8 : (int)blockIdx.x;
#define IN(k) (lo <= (k) && (k) < hi)
#define PM(b) ((PHMASK >> (b)) & 1)
#define REP(b) _Pragma("unroll 1") for (int rep_ = 0; rep_ < 1 + ((PROBE_DUP >> (b)) & 1); ++rep_)
#define SEAM(k) do { if (!MK_MULTI && IN(k) && IN((k) + 1)) { xcd_barrier(bar); if ((PROBE_DUP >> 13) & 1) xcd_barrier(bar); } } while (0)

    if (PM(0) && IN(0)) REP(0) { phase_prologue(kargs(), lds); } SEAM(0);

#pragma unroll 1
    for (int l = 0; l < DEPTH; ++l) {
        const int pb = 1 + 9 * l;
        const bool lastl = (l == DEPTH - 1);
        if (PM(1) && IN(pb + 0)) { if ((PROBE_DUP >> 1) & 1) { if (l == 0) phase_norm1<0>(kargs(), l, true); else phase_norm1<1>(kargs(), l, true); } if (l == 0) phase_norm1<0>(kargs(), l, false); else { phase_norm1<1>(kargs(), l, false); __syncthreads(); convert_moe(kargs(), l, lds); __syncthreads(); } } SEAM(pb + 0);
        if (PM(2) && IN(pb + 1)) REP(2) {
            KArgs a = kargs(); unsigned char* ws = a->ws;
            pg8::Gemm g{(const bf16*)(ws + WS_H), (const bf16*)(ws + WS_WIN) + (size_t)l * INC * D, MALL, INC, D};
            pg8::StaticOrder S; S.init(MALL, INC, G, (int)blockIdx.x);
            pg8::EpiBf16 E{(bf16*)(ws + WS_P), INC};
            pg8::gemm_phase<pg8::EpiBf16, pg8::StaticOrder, false, false>(lds, g, S, E, nullptr);
        } SEAM(pb + 1);
        if (PM(3) && IN(pb + 2)) {
            const int ngm = lastl ? 1024 : 1088;
            unsigned* qhead = (unsigned*)(kargs()->ws + WS_CTL) + CW_PREPQ + 64 * l;
            const int n_rw = 544 * 3, n_hg = 3264, n_all = (G == 256) ? n_rw + n_hg : n_rw + n_hg + ngm;
            for (;;) {
                if (threadIdx.x == 0) misc[16] = __hip_atomic_fetch_add(qhead, 1u, __ATOMIC_RELAXED, __HIP_MEMORY_SCOPE_AGENT);
                __syncthreads();
                const int it = (int)misc[16];
                if (it >= n_all) break;
                if (it < n_rw) { _Pragma("unroll 1") for (int r2 = 0; r2 < 1 + ((PROBE_DUP >> 15) & 1); ++r2) rwkv_prep_item(kargs(), l, it / 3, it % 3, lds); }
                else if (it < n_rw + n_hg) { if ((PROBE_DUP >> 16) & 1) hgrn_prep_item(kargs(), l, it - n_rw, lds, true); hgrn_prep_item(kargs(), l, it - n_rw, lds, false); }
                else { _Pragma("unroll 1") for (int r2 = 0; r2 < 1 + ((PROBE_DUP >> 14) & 1); ++r2) gmlp_item(kargs(), l, it - n_rw - n_hg, lds); }
            }
            __syncthreads();
        } SEAM(pb + 2);
        if (PM(4) && IN(pb + 3)) REP(4) {
            if (G == 256) { const int bx = blockIdx.x;
                if (bx < 96) { _Pragma("unroll 1") for (int r2 = 0; r2 < 1 + ((PROBE_DUP >> 12) & 1); ++r2) rwkv_chain_mfma(kargs(), bx * 8, lds); }
                else if (bx < 192) { _Pragma("unroll 1") for (int r2 = 0; r2 < 1 + ((PROBE_DUP >> 11) & 1); ++r2) hgrn_chain_lean(kargs(), bx - 96, lds); }
                if (bx < 96 || bx >= 192) {
                    unsigned* gq = (unsigned*)(kargs()->ws + WS_CTL) + CW_GMQ + 64 * l; const int ngm2 = lastl ? 1024 : 1088;
                    for (;;) { if (threadIdx.x == 0) misc[17] = __hip_atomic_fetch_add(gq, 1u, __ATOMIC_RELAXED, __HIP_MEMORY_SCOPE_AGENT);
                        __syncthreads(); const int it = (int)misc[17]; if (it >= ngm2) break; gmlp_item(kargs(), l, it, lds); }
                    __syncthreads(); } }
            else { for (int it = blockIdx.x; it < 192; it += G) { if (it < 96) rwkv_chain_mfma(kargs(), it * 8, lds); else hgrn_chain_lean(kargs(), it - 96, lds); } }
        } SEAM(pb + 3);
        if (PM(5) && IN(pb + 4)) { if ((PROBE_DUP >> 5) & 1) phase_finalize(kargs(), l, true); phase_finalize(kargs(), l, false); } SEAM(pb + 4);
        if (PM(6) && IN(pb + 5)) REP(6) {
            KArgs a = kargs(); unsigned char* ws = a->ws;
            const int Mo = lastl ? NLAT : MALL;
            pg8::Gemm g{(const bf16*)(ws + WS_Y), (const bf16*)(ws + WS_WOUT) + (size_t)l * D * D, Mo, D, D};
            pg8::StaticOrder S; S.init(Mo, D, G, (int)blockIdx.x);
            const float* xl = l == 0 ? a->in[I_X] : (const float*)(ws + WS_X); const float* xc = l == 0 ? a->in[I_CTX] : (const float*)(ws + WS_X) + (size_t)NLAT * D;
            pg8::EpiResid E{xl, xc, (float*)(ws + WS_X), (const float*)(ws + WS_MOD) + (size_t)l * 9 * 12288 + 2 * D};
            pg8::gemm_phase<pg8::EpiResid, pg8::StaticOrder, true, false>(lds, g, S, E, nullptr);
        } SEAM(pb + 5);
        if (PM(7) && IN(pb + 6)) { if ((PROBE_DUP >> 7) & 1) phase_norm2_router(kargs(), l, true, lds); phase_norm2_router(kargs(), l, false, lds); } SEAM(pb + 6);
        if (PM(8) && IN(pb + 7)) REP(8) {
            KArgs a = kargs(); unsigned char* ws = a->ws;
            moe_tables<false>(a, l, lds, cvirt);
            pg8::Gemm g{(const bf16*)(ws + WS_H), (const bf16*)(ws + WS_WGU), 0, 2048, D};
            pg8::MoeOrder S{(const LAS int*)(lds + LDS_TP), G, cvirt, (unsigned)(2048 * D * 2)};
            pg8::EpiSwiglu E{(bf16*)(ws + WS_ACT)};
            pg8::gemm_phase<pg8::EpiSwiglu, pg8::MoeOrder, false, true>(lds, g, S, E, (const LAS unsigned*)(lds + LDS_TAB));
        } SEAM(pb + 7);
        if (PM(9) && IN(pb + 8)) REP(9) {
            KArgs a = kargs(); unsigned char* ws = a->ws;
            moe_tables<true>(a, l, lds, cvirt);
            pg8::Gemm g{(const bf16*)(ws + WS_ACT), (const bf16*)(ws + WS_WDN), 0, D, DE};
            pg8::MoeOrder S{(const LAS int*)(lds + LDS_TP), G, cvirt, (unsigned)(D * DE * 2)};
            pg8::EpiDown E{(bf16*)(ws + WS_YK), (const LAS unsigned*)(lds + LDS_TAB), (const LAS float*)(lds + LDS_TABW)};
            pg8::gemm_phase<pg8::EpiDown, pg8::MoeOrder, false, false>(lds, g, S, E, nullptr);
        } SEAM(pb + 8);
    }
    if (PM(10) && IN(1 + 9 * DEPTH)) { if ((PROBE_DUP >> 10) & 1) phase_norm1<2>(kargs(), DEPTH, true); phase_norm1<2>(kargs(), DEPTH, false); }
#undef IN
#undef SEAM
}

extern "C" void kernel_launch(void* const* d_in, const int* in_sizes, int n_in, void* d_out, int out_size, void* d_ws, size_t ws_size, hipStream_t stream) {
    static int grid = 0;
    if (grid == 0) {
        if (n_in != 31 || ws_size < WS_END) { fprintf(stderr, "kernel_launch: unexpected n_in %d / ws %zu (need %zu)\n", n_in, ws_size, (size_t)WS_END); grid = -1; return; }
        int dev = 0, cus = 0, per_cu = 0;
        hipGetDevice(&dev); hipDeviceGetAttribute(&cus, hipDeviceAttributeMultiprocessorCount, dev);
        if (hipFuncSetAttribute((const void*)mk_fwd, hipFuncAttributeMaxDynamicSharedMemorySize, LDS_BYTES) != hipSuccess) { fprintf(stderr, "kernel_launch: hipFuncSetAttribute failed\n"); grid = -1; return; }
        if (hipOccupancyMaxActiveBlocksPerMultiprocessor(&per_cu, (const void*)mk_fwd, NTHREADS, LDS_BYTES) != hipSuccess || per_cu < 1) fprintf(stderr, "kernel_launch: occupancy query says %d\n", per_cu);
        (void)hipGetLastError();
        grid = cus > 0 ? cus : 256;
    }
    if (grid < 0) return;
    hipMemsetAsync((char*)d_ws + WS_CTL, 0, CTL_ZERO_BYTES, stream);
    Args a{};
    for (int i = 0; i < 31; ++i) a.in[i] = (const float*)d_in[i];
    a.out = (float*)d_out; a.ws = (unsigned char*)d_ws;
    constexpr int NPH = 2 + 9 * DEPTH;
#if MK_MULTI
    for (int p = 0; p < NPH; ++p) { a.ph_lo = p; a.ph_hi = p + 1; hipLaunchKernelGGL(mk_fwd, dim3(grid), dim3(NTHREADS), LDS_BYTES, stream, a); }
#else
    a.ph_lo = 0; a.ph_hi = NPH; hipLaunchKernelGGL(mk_fwd, dim3(grid), dim3(NTHREADS), LDS_BYTES, stream, a);
#endif
}
```

```cpp
#include <hip/hip_runtime.h>
#include <cstdio>
#include <cstdint>

#ifndef PHMASK
#define PHMASK 0xFFFF
#endif
#ifndef PROBE_DUP
#define PROBE_DUP 0
#endif
#ifndef MK_MULTI
#define MK_MULTI 0
#endif

#define GAS __attribute__((address_space(1)))
#define LAS __attribute__((address_space(3)))
typedef unsigned short bf16;
typedef short bf16x8 __attribute__((ext_vector_type(8)));
typedef float f32x4 __attribute__((ext_vector_type(4)));
typedef float f32x2 __attribute__((ext_vector_type(2)));
typedef unsigned u32x4 __attribute__((ext_vector_type(4)));
typedef unsigned u32x2 __attribute__((ext_vector_type(2)));

constexpr int D = 2048, NB = 8, T = 4096, CTXL = 256, DEPTH = 2;
constexpr int NLAT = NB * T, NCTX = NB * CTXL, MALL = NLAT + NCTX;
constexpr int INC = 7424;
constexpr int OFF_U = 0, OFF_V = 512, OFF_Q = 1024, OFF_I = 1792, OFF_ZF = 2560, OFF_ZB = 3328, OFF_OG = 4096;
constexpr int OFF_C = 4864;
constexpr int BW = 768, CW = 768, CCOLS = 2560;
constexpr int NE = 16, DE = 1024;
constexpr int PC2W = 7 * 768;
constexpr int NTHREADS = 512;
constexpr float NORM_EPS = 1e-6f, GN_EPS = 64e-5f, DECAY_SCALE = 0.60653065971263342f;

constexpr size_t MiB = 1u << 20;
constexpr size_t WS_CTL = 0, CTL_ZERO_BYTES = 1 * MiB;
constexpr size_t WS_MOD = 1 * MiB;
constexpr size_t WS_SMALLW = 2 * MiB;
constexpr size_t SW_WUP = 0, SW_AUP = SW_WUP + (size_t)2 * 2 * 768 * 64 * 2, SW_GUP = SW_AUP + (size_t)2 * 768 * 64 * 2, SW_GWS = SW_GUP + (size_t)2 * 768 * 128 * 2;
constexpr size_t WS_WIN = 4 * MiB, WS_WOUT = 62 * MiB, WS_WGU = 78 * MiB, WS_WDN = 206 * MiB;
constexpr size_t WS_X = 270 * MiB, WS_H = 542 * MiB, WS_Y = 678 * MiB, WS_P = 814 * MiB, WS_PRE = 1307 * MiB, WS_VT = 1817 * MiB, WS_OC = 1868 * MiB, WS_HQB = 1970 * MiB, WS_HG = 2021 * MiB, WS_END = 2028 * MiB;
constexpr int PRE_REC = 10240, PR_WP = 0, PR_RP = 2048, PR_BK = 4096, PR_ARBK = 8192, PR_MAK = 9216, PR_GAM = 9728, NCHUNK16 = 272;
constexpr size_t WS_OB = WS_H;
constexpr size_t WS_ACT = WS_P, WS_YK = WS_P + 144 * MiB, WS_RIDX = WS_P + 416 * MiB, WS_RW = WS_RIDX + 3 * MiB;
static_assert(WS_RW + 3 * MiB <= WS_PRE, "moe overlay");
constexpr int MAXSLOT_TILES = 288;
constexpr int CW_BAR = 4096;
constexpr int CW_GMQ = 30720;
constexpr int CW_PREPQ = 28672;
constexpr int CW_CNT = 16384;

constexpr int LDS_STAGE = 0, LDS_TAB = 131072, LDS_TABW = LDS_TAB + 9 * 1024, LDS_TP = LDS_TABW + 9 * 1024, LDS_MISC = 150528, LDS_BYTES = 152 * 1024;
static_assert(LDS_TP + 128 <= LDS_MISC, "lds map");

typedef __bf16 bf16x2_t __attribute__((ext_vector_type(2)));
__device__ __forceinline__ unsigned pk2(float lo, float hi) { const f32x2 v = {lo, hi}; return __builtin_bit_cast(unsigned, __builtin_convertvector(v, bf16x2_t)); }
__device__ __forceinline__ unsigned f2bf(float f) { return pk2(f, f) & 0xffffu; }
__device__ __forceinline__ float bflo(unsigned u) { return __builtin_bit_cast(float, u << 16); }
__device__ __forceinline__ float bfhi(unsigned u) { return __builtin_bit_cast(float, u & 0xffff0000u); }
__device__ __forceinline__ float bf1(bf16 b) { return __builtin_bit_cast(float, ((unsigned)b) << 16); }
__device__ __forceinline__ float sigmoidf_(float x) { return __builtin_amdgcn_rcpf(1.0f + __expf(-x)); }
__device__ __forceinline__ float siluf_(float x) { return x * __builtin_amdgcn_rcpf(1.0f + __expf(-x)); }
__device__ __forceinline__ float geluf_(float v) {
    const float av = fabsf(v), t = __builtin_amdgcn_rcpf(av * 0.2316418882f + 1.0f);
    float q = t * 0.5307027145f + (-0.7265760135f); q = q * t + 0.7107068705f; q = q * t + (-0.142248368f); q = q * t + 0.127414796f; q = q * t;
    const float e = __builtin_amdgcn_exp2f((v * v) * (-0.72134752044f)); const float m = v * (q * e); return v < 0.f ? m : v - m; }
__device__ __forceinline__ float wave_sum(float v) {
#pragma unroll
    for (int o = 1; o < 64; o <<= 1) v += __shfl_xor(v, o);
    return v;
}
__device__ __forceinline__ int tid_fresh() { int t = threadIdx.x; asm volatile("" : "+v"(t)); return t; }
__device__ __forceinline__ void unpack8(const u32x4 v, float (&f)[8]) {
    f[0] = bflo(v.x); f[1] = bfhi(v.x); f[2] = bflo(v.y); f[3] = bfhi(v.y); f[4] = bflo(v.z); f[5] = bfhi(v.z); f[6] = bflo(v.w); f[7] = bfhi(v.w);
}
__device__ __forceinline__ u32x4 pack8(const float (&f)[8]) { u32x4 v; v.x = pk2(f[0], f[1]); v.y = pk2(f[2], f[3]); v.z = pk2(f[4], f[5]); v.w = pk2(f[6], f[7]); return v; }
__device__ __forceinline__ int modrow_of(int row) { return row < NLAT ? (row >> 12) : 8; }

#define XB_TMO      128
#define XB_XCNT(j)  (256  + 64 * (j))
#define XB_XSUB(j)  (1280 + 64 * (j))
#define XB_XGEN(j)  (2304 + 64 * (j))
#define XB_TOP      3328
#define XB_TOPGEN   3392
#define XCD_BAR_WORDS 3456
#define XB_SPIN_CAP (1u << 18)
__device__ __forceinline__ unsigned xb_ld(unsigned* p)              { return __hip_atomic_load(p, __ATOMIC_RELAXED, __HIP_MEMORY_SCOPE_AGENT); }
__device__ __forceinline__ unsigned xb_add(unsigned* p, unsigned v) { return __hip_atomic_fetch_add(p, v, __ATOMIC_RELAXED, __HIP_MEMORY_SCOPE_AGENT); }
__device__ __forceinline__ unsigned xb_xcc_id() { return (unsigned)__builtin_amdgcn_s_getreg((3 << 11) | 20) & 0xFu; }
#define XB_SPIN(cond, bar) do { unsigned _sp = 0; while (cond) { __builtin_amdgcn_s_sleep(1); \
    if ((++_sp & 255u) == 0u) { if (xb_ld(&(bar)[XB_TMO])) break; if (_sp > XB_SPIN_CAP) { atomicAdd(&(bar)[XB_TMO], 1u); break; } } } } while (0)
struct XcdBarrier { unsigned* bar; unsigned x; volatile LAS unsigned* st; };
__device__ __forceinline__ XcdBarrier xcd_barrier_post(unsigned* bar, volatile LAS unsigned* st) {
    XcdBarrier b; b.bar = bar; b.x = xb_xcc_id(); b.st = st;
    if (threadIdx.x == 0) (void)xb_add(&bar[XB_XCNT(b.x)], 1u);
    return b;
}
__device__ __forceinline__ void xcd_barrier_complete(unsigned* bar, unsigned x, unsigned& nloc, unsigned& nx) {
    const unsigned G = gridDim.x * gridDim.y * gridDim.z;
    unsigned sum, cnt, mine, sp = 0u;
    for (;;) {
        sum = 0u; cnt = 0u; mine = 0u;
#pragma unroll
        for (unsigned j = 0; j < 16; ++j) { const unsigned c = xb_ld(&bar[XB_XCNT(j)]); sum += c; cnt += (c > 0u) ? 1u : 0u; mine = (j == x) ? c : mine; }
        if (sum == G) break;
        __builtin_amdgcn_s_sleep(1);
        if ((++sp & 255u) == 0u) { if (xb_ld(&bar[XB_TMO])) break; if (sp > XB_SPIN_CAP) { atomicAdd(&bar[XB_TMO], 1u); break; } }
    }
    nloc = mine > 0u ? mine : 1u; nx = cnt > 0u ? cnt : 1u;
}
__device__ __forceinline__ void xcd_barrier(const XcdBarrier& b) {
    asm volatile("s_waitcnt vmcnt(0)" ::: "memory");
    __syncthreads();
    if (threadIdx.x == 0) {
        unsigned* bar = b.bar;
        __builtin_amdgcn_s_waitcnt(0);
        unsigned nloc = b.st[0], nx = b.st[1];
        if (nloc == 0u) { xcd_barrier_complete(bar, b.x, nloc, nx); b.st[0] = nloc; b.st[1] = nx; }
        const unsigned old = xb_add(&bar[XB_XSUB(b.x)], 1u);
        const unsigned gen = old / nloc;
        if (old + 1u == (gen + 1u) * nloc) {
            __builtin_amdgcn_fence(__ATOMIC_RELEASE, "agent");
            asm volatile("s_waitcnt vmcnt(0)" ::: "memory");
            const unsigned og = xb_add(&bar[XB_TOP], 1u);
            const unsigned tg = og / nx;
            if (og + 1u == (tg + 1u) * nx) xb_add(&bar[XB_TOPGEN], 1u);
            else XB_SPIN(xb_ld(&bar[XB_TOPGEN]) == tg, bar);
            __builtin_amdgcn_fence(__ATOMIC_ACQUIRE, "agent");
            xb_add(&bar[XB_XGEN(b.x)], 1u);
            asm volatile("s_waitcnt vmcnt(0)" ::: "memory");
        } else {
            XB_SPIN(xb_ld(&bar[XB_XGEN(b.x)]) == gen, bar);
            __builtin_amdgcn_fence(__ATOMIC_ACQUIRE, "agent");
            asm volatile("s_waitcnt vmcnt(0)" ::: "memory");
        }
    }
    __syncthreads();
}

namespace pg8 {
constexpr int BM = 256, BK = 64, HALF = 128, HTB = HALF * BK * 2, STAGE_BYTES = 8 * HTB, NXCD = 8, WGM = 8;
__host__ __device__ __forceinline__ int lds_byte(int r, int c) { const int st = (r >> 4) * 2 + (c >> 5), rr = r & 15, cc = c & 31, ob = rr * 64 + cc * 2; return st * 1024 + (ob ^ (((ob >> 9) & 1) << 5)); }
__host__ __device__ __forceinline__ void stage_rc(int b, int& R, int& C) { const int st = b / 1024, sb = b % 1024, swz = sb ^ (((sb >> 9) & 1) << 5); R = (st >> 1) * 16 + swz / 64; C = (st & 1) * 32 + (swz % 64) / 2; }
__host__ __device__ __forceinline__ int perm32(int rho) { const int n = rho >> 4, i = rho & 15; return 8 * (i >> 2) + 4 * n + (i & 3); }

struct Unit { int pm, pn, e, aux; };
struct Gemm { const bf16* A; const bf16* Bt; int M, N, K; };

struct StaticOrder {
    int nM, nN, nwg, G, c;
    __device__ void init(int M, int N, int G_, int c_) { nM = M / BM; nN = N / BM; nwg = nM * nN; G = G_; c = c_; }
    __device__ bool next(int i, Unit& u) const {
        const long L = (long)i * G + c; if (L >= nwg) return false;
        int wgid = (int)L; { const int q = nwg / NXCD, r = nwg % NXCD, xcd = wgid % NXCD, off = wgid / NXCD; wgid = (xcd < r ? xcd * (q + 1) : r * (q + 1) + (xcd - r) * q) + off; }
        const int nig = WGM * nN, gid = wgid / nig, fm = gid * WGM, gsz = (nM - fm) < WGM ? (nM - fm) : WGM;
        u.pm = fm + ((wgid % nig) % gsz); u.pn = (wgid % nig) / gsz; u.e = 0; u.aux = 0; return true;
    }
    __device__ __forceinline__ unsigned b_off(const Unit& u, unsigned tstep) const { return (unsigned)u.pn * tstep; }
};
struct MoeOrder {
    const LAS int* tp; int G, c; unsigned estride;
    __device__ bool next(int i, Unit& u) const {
        const int L = i * G + c; const int ntot = tp[16] * 8; if (L >= ntot) return false;
        const int tile = L >> 3; int e = 0;
#pragma unroll
        for (int j = 1; j < 16; ++j) e += (tile >= tp[j]) ? 1 : 0;
        u.pm = tile; u.pn = L & 7; u.e = e; u.aux = i; return true;
    }
    __device__ __forceinline__ unsigned b_off(const Unit& u, unsigned tstep) const { return (unsigned)u.e * estride + (unsigned)u.pn * tstep; }
};

#define PG8_LAS __attribute__((address_space(3)))
template <class Epi, class Sched, bool ALIGN_EPI, bool GATHER>
__device__ __forceinline__ void gemm_phase(PG8_LAS unsigned char* lds, const Gemm g, const Sched& S, const Epi& E, const PG8_LAS unsigned* tabA) {
    const int tid = tid_fresh(), wid = __builtin_amdgcn_readfirstlane(tid >> 6), lane = tid & 63, wr = wid >> 2, wc = wid & 3, fr = lane & 15, fq = lane >> 4;
    const int K = g.K, nt = K / BK;
    int sR[2], sC[2];
    unsigned voffB[2];
#pragma unroll
    for (int i = 0; i < 2; ++i) { int R, C; stage_rc(tid * 16 + i * 8192, R, C); sR[i] = R; sC[i] = C; const int Rb = Epi::PERM ? ((R & ~31) + perm32(R & 31)) : R;
        voffB[i] = (unsigned)(Rb * K + C) * 2u; }
    const unsigned kstep = (unsigned)(BK * 2);
    const unsigned hstep = (unsigned)(HALF * K * 2);
    const unsigned tstep = 2u * hstep;
    const unsigned ldsw = (unsigned)wid * 1024u;
    const char* const baseA = (const char*)g.A; const char* const baseB = (const char*)g.Bt;
    const int aoff = lds_byte(wr * 64 + fr, fq * 8), boff = lds_byte(wc * 32 + fr, fq * 8);
#define PG8_SA(b, h) (((b) * 2 + (h)) * HTB)
#define PG8_SB(b, h) ((4 + (b) * 2 + (h)) * HTB)
#define PG8_STAGE(bufoff, gbase, uoff, voff) do { _Pragma("unroll") for (int _i = 0; _i < 2; ++_i) \
        __builtin_amdgcn_global_load_lds((const unsigned*)((gbase) + (size_t)(unsigned)((uoff) + (voff)[_i])), (PG8_LAS unsigned*)(lds + (bufoff) + ldsw + _i * 8192), 16, 0, 0); } while (0)
#define PG8_LDA(dst, b, h) do { _Pragma("unroll") for (int m = 0; m < 4; ++m) _Pragma("unroll") for (int k = 0; k < 2; ++k) dst[m][k] = *(const PG8_LAS bf16x8*)(lds + PG8_SA(b, h) + aoff + m * 2048 + k * 1024); } while (0)
#define PG8_LDB(dst, b, h) do { _Pragma("unroll") for (int n = 0; n < 2; ++n) _Pragma("unroll") for (int k = 0; k < 2; ++k) dst[n][k] = *(const PG8_LAS bf16x8*)(lds + PG8_SB(b, h) + boff + n * 2048 + k * 1024); } while (0)
#define PG8_MMA(ai, bj, At, Bt) do { __builtin_amdgcn_s_setprio(1); _Pragma("unroll") for (int m = 0; m < 4; ++m) _Pragma("unroll") for (int n = 0; n < 2; ++n) _Pragma("unroll") for (int k = 0; k < 2; ++k) \
        acc[ai][bj][m][n] = __builtin_amdgcn_mfma_f32_16x16x32_bf16(Bt[n][k], At[m][k], acc[ai][bj][m][n], 0, 0, 0); __builtin_amdgcn_s_setprio(0); } while (0)
#define PG8_WAIT_V(n) asm volatile("s_waitcnt vmcnt(" #n ")" ::: "memory")
#define PG8_WAIT_L(n) asm volatile("s_waitcnt lgkmcnt(" #n ")" ::: "memory")
#define PG8_BAR __builtin_amdgcn_s_barrier()
#define PG8_SCHED __builtin_amdgcn_sched_barrier(0)
    Unit cur, nxt; int ui = 0;
    if (!S.next(0, cur)) return;
    f32x4 acc[2][2][4][2];
#pragma unroll
    for (int a = 0; a < 2; ++a)
#pragma unroll
        for (int b = 0; b < 2; ++b)
#pragma unroll
            for (int m = 0; m < 4; ++m)
#pragma unroll
                for (int n = 0; n < 2; ++n) acc[a][b][m][n] = (f32x4){0.f, 0.f, 0.f, 0.f};
    bf16x8 At[4][2], B0[2][2], B1[2][2];
    unsigned vA0[2], vA1[2], nA0[2], nA1[2];
    unsigned uA, uB = S.b_off(cur, tstep);
    if constexpr (GATHER) { uA = 0u;
#pragma unroll
        for (int i = 0; i < 2; ++i) { vA0[i] = tabA[cur.aux * 256 + sR[i]] + (unsigned)sC[i] * 2u; vA1[i] = tabA[cur.aux * 256 + 128 + sR[i]] + (unsigned)sC[i] * 2u; }
    } else { uA = (unsigned)cur.pm * tstep;
#pragma unroll
        for (int i = 0; i < 2; ++i) { vA0[i] = (unsigned)(sR[i] * K + sC[i]) * 2u; vA1[i] = vA0[i] + hstep; }
    }
    PG8_STAGE(PG8_SB(0, 0), baseB, uB, voffB); PG8_STAGE(PG8_SB(0, 1), baseB, uB + hstep, voffB); PG8_STAGE(PG8_SA(0, 0), baseA, uA, vA0); PG8_STAGE(PG8_SA(0, 1), baseA, uA, vA1);
    if (wr == 1) PG8_BAR;
    PG8_WAIT_V(2); PG8_BAR;
    PG8_STAGE(PG8_SB(1, 0), baseB, uB + kstep, voffB); PG8_STAGE(PG8_SA(1, 0), baseA, uA + kstep, vA0); PG8_STAGE(PG8_SB(1, 1), baseB, uB + hstep + kstep, voffB);
    PG8_WAIT_V(6); PG8_BAR;
    for (;;) {
        const bool has_next = S.next(ui + 1, nxt);
        unsigned nuA, nuB = has_next ? S.b_off(nxt, tstep) : uB;
        if constexpr (GATHER) { nuA = 0u;
#pragma unroll
            for (int i = 0; i < 2; ++i) { if (has_next) { nA0[i] = tabA[nxt.aux * 256 + sR[i]] + (unsigned)sC[i] * 2u; nA1[i] = tabA[nxt.aux * 256 + 128 + sR[i]] + (unsigned)sC[i] * 2u; } else { nA0[i] = vA0[i]; nA1[i] = vA1[i]; } }
        } else { nuA = has_next ? (unsigned)nxt.pm * tstep : uA;
#pragma unroll
            for (int i = 0; i < 2; ++i) { nA0[i] = vA0[i]; nA1[i] = vA1[i]; }
        }
        for (int t = 0; t < nt; t += 2) {
            const bool last = (t == nt - 2);
            const unsigned a1 = uA + (unsigned)(t + 1) * kstep;
            const unsigned a2 = last ? nuA : uA + (unsigned)(t + 2) * kstep; const unsigned b2 = last ? nuB : uB + (unsigned)(t + 2) * kstep;
            const unsigned a3 = a2 + kstep; const unsigned b3 = b2 + kstep;
            unsigned w0[2], w1[2];
#pragma unroll
            for (int i = 0; i < 2; ++i) { w0[i] = (GATHER && last) ? nA0[i] : vA0[i]; w1[i] = (GATHER && last) ? nA1[i] : vA1[i]; }
            PG8_LDB(B0, 0, 0); PG8_LDB(B1, 0, 1); PG8_SCHED; PG8_LDA(At, 0, 0); PG8_STAGE(PG8_SA(1, 1), baseA, a1, vA1);
            PG8_WAIT_V(8); PG8_WAIT_L(0); PG8_BAR; PG8_MMA(0, 0, At, B0); PG8_MMA(0, 1, At, B1); PG8_BAR; PG8_SCHED;
            PG8_LDA(At, 0, 1); PG8_STAGE(PG8_SB(0, 0), baseB, b2, voffB); PG8_STAGE(PG8_SB(0, 1), baseB, b2 + hstep, voffB); PG8_STAGE(PG8_SA(0, 0), baseA, a2, w0);
            PG8_WAIT_V(8); PG8_WAIT_L(0); PG8_BAR; PG8_MMA(1, 0, At, B0); PG8_MMA(1, 1, At, B1); PG8_BAR; PG8_SCHED;
            PG8_LDB(B0, 1, 0); PG8_LDB(B1, 1, 1); PG8_SCHED; PG8_LDA(At, 1, 0); PG8_STAGE(PG8_SA(0, 1), baseA, a2, w1);
            PG8_WAIT_V(8); PG8_WAIT_L(0); PG8_BAR; PG8_MMA(0, 0, At, B0); PG8_MMA(0, 1, At, B1); PG8_BAR; PG8_SCHED;
            PG8_LDA(At, 1, 1); PG8_STAGE(PG8_SB(1, 0), baseB, b3, voffB); PG8_STAGE(PG8_SB(1, 1), baseB, b3 + hstep, voffB); PG8_STAGE(PG8_SA(1, 0), baseA, a3, w0);
            PG8_WAIT_V(8); PG8_WAIT_L(0); PG8_BAR; PG8_MMA(1, 0, At, B0); PG8_MMA(1, 1, At, B1); PG8_BAR; PG8_SCHED;
        }
        if constexpr (ALIGN_EPI) { if (wr == 0) PG8_BAR; }
        E(acc, cur, wr, wc, fr, fq);
        if (!has_next) break;
#pragma unroll
        for (int a = 0; a < 2; ++a)
#pragma unroll
            for (int b = 0; b < 2; ++b)
#pragma unroll
                for (int m = 0; m < 4; ++m)
#pragma unroll
                    for (int n = 0; n < 2; ++n) acc[a][b][m][n] = (f32x4){0.f, 0.f, 0.f, 0.f};
        cur = nxt; uA = nuA; uB = nuB; ++ui;
#pragma unroll
        for (int i = 0; i < 2; ++i) { vA0[i] = nA0[i]; vA1[i] = nA1[i]; }
        if constexpr (ALIGN_EPI) { if (wr == 1) PG8_BAR; }
    }
    PG8_WAIT_V(0);
    if constexpr (!ALIGN_EPI) { if (wr == 0) PG8_BAR; }
    PG8_BAR;
#undef PG8_SA
#undef PG8_SB
#undef PG8_STAGE
#undef PG8_LDA
#undef PG8_LDB
#undef PG8_MMA
#undef PG8_WAIT_V
#undef PG8_WAIT_L
#undef PG8_BAR
#undef PG8_SCHED
}

__device__ __forceinline__ unsigned cvt_pk_bf16(float lo, float hi) { return pk2(lo, hi); }

struct EpiBf16 {
    static constexpr bool PERM = true;
    bf16* O; int ldc;
    __device__ __forceinline__ void operator()(const f32x4 (&acc)[2][2][4][2], const Unit& u, int wr, int wc, int fr, int fq) const {
        const int row0 = u.pm * BM + wr * 64 + fr; const int col0 = u.pn * BM + wc * 32 + 8 * fq;
#pragma unroll
        for (int ai = 0; ai < 2; ++ai)
#pragma unroll
            for (int m = 0; m < 4; ++m) { bf16* rowp = O + (size_t)(row0 + ai * HALF + m * 16) * ldc + col0;
#pragma unroll
                for (int bj = 0; bj < 2; ++bj) { const f32x4 v0 = acc[ai][bj][m][0], v1 = acc[ai][bj][m][1];
                    u32x4 w; w.x = cvt_pk_bf16(v0[0], v0[1]); w.y = cvt_pk_bf16(v0[2], v0[3]); w.z = cvt_pk_bf16(v1[0], v1[1]); w.w = cvt_pk_bf16(v1[2], v1[3]);
                    *(u32x4*)(rowp + bj * HALF) = w; } }
    }
};
struct EpiResid {
    static constexpr bool PERM = false;
    const float* xl; const float* xc; float* out; const float* gate;
    __device__ __forceinline__ void operator()(const f32x4 (&acc)[2][2][4][2], const Unit& u, int wr, int wc, int fr, int fq) const {
        const int rt = u.pm * BM; const bool isl = rt < NLAT;
        const float* base = isl ? xl + (size_t)rt * D : xc + (size_t)(rt - NLAT) * D;
        const float* gp = gate + (size_t)(isl ? (rt >> 12) : 8) * 12288;
        const int rl0 = wr * 64 + fr, col0 = u.pn * BM + wc * 32 + 4 * fq;
#pragma unroll
        for (int ai = 0; ai < 2; ++ai)
#pragma unroll
            for (int m = 0; m < 4; ++m) { const int rl = rl0 + ai * HALF + m * 16; const float* bp = base + (size_t)rl * D + col0; float* op = out + (size_t)(rt + rl) * D + col0;
#pragma unroll
                for (int bj = 0; bj < 2; ++bj)
#pragma unroll
                    for (int n = 0; n < 2; ++n) { const f32x4 b = *(const f32x4*)(bp + bj * HALF + n * 16); const f32x4 gv = *(const f32x4*)(gp + col0 + bj * HALF + n * 16); *(f32x4*)(op + bj * HALF + n * 16) = b + gv * acc[ai][bj][m][n]; }
                asm volatile("" ::: "memory"); }
    }
};
struct EpiSwiglu {
    static constexpr bool PERM = true;
    bf16* O;
    __device__ __forceinline__ void operator()(const f32x4 (&acc)[2][2][4][2], const Unit& u, int wr, int wc, int fr, int fq) const {
        const int row0 = u.pm * BM + wr * 64 + fr; const int col0 = u.pn * 128 + wc * 32 + 8 * fq;
#pragma unroll
        for (int ai = 0; ai < 2; ++ai)
#pragma unroll
            for (int m = 0; m < 4; ++m) { bf16* rowp = O + (size_t)(row0 + ai * HALF + m * 16) * DE + col0;
                float o[8];
#pragma unroll
                for (int n = 0; n < 2; ++n)
#pragma unroll
                    for (int j = 0; j < 4; ++j) { const float gt = acc[ai][0][m][n][j], up = acc[ai][1][m][n][j]; o[n * 4 + j] = gt * __builtin_amdgcn_rcpf(1.0f + __expf(-gt)) * up; }
                u32x4 w; w.x = cvt_pk_bf16(o[0], o[1]); w.y = cvt_pk_bf16(o[2], o[3]); w.z = cvt_pk_bf16(o[4], o[5]); w.w = cvt_pk_bf16(o[6], o[7]);
                *(u32x4*)rowp = w; }
    }
};
struct EpiDown {
    static constexpr bool PERM = true;
    bf16* YK; const PG8_LAS unsigned* tab; const PG8_LAS float* tabw;
    __device__ __forceinline__ void operator()(const f32x4 (&acc)[2][2][4][2], const Unit& u, int wr, int wc, int fr, int fq) const {
        const int rl0 = wr * 64 + fr; const int col0 = u.pn * BM + wc * 32 + 8 * fq;
#pragma unroll
        for (int ai = 0; ai < 2; ++ai)
#pragma unroll
            for (int m = 0; m < 4; ++m) { const int rl = rl0 + ai * HALF + m * 16; const unsigned ent = tab[u.aux * 256 + rl]; const float w = tabw[u.aux * 256 + rl];
                if (!(ent & 0x40000000u)) { bf16* rowp = YK + ((size_t)(ent >> 31) * MALL + (ent & 0xffffu)) * D + col0;
#pragma unroll
                    for (int bj = 0; bj < 2; ++bj) { const f32x4 v0 = acc[ai][bj][m][0] * w, v1 = acc[ai][bj][m][1] * w;
                        u32x4 q; q.x = cvt_pk_bf16(v0[0], v0[1]); q.y = cvt_pk_bf16(v0[2], v0[3]); q.z = cvt_pk_bf16(v1[0], v1[1]); q.w = cvt_pk_bf16(v1[2], v1[3]);
                        *(u32x4*)(rowp + bj * HALF) = q; } }
                asm volatile("" ::: "memory"); }
    }
};
}

struct Args { const float* in[31]; float* out; unsigned char* ws; int ph_lo, ph_hi; };
typedef const __attribute__((address_space(4))) Args* KArgs;
__device__ __forceinline__ KArgs kargs() { KArgs p = (KArgs)__builtin_amdgcn_kernarg_segment_ptr(); asm volatile("" : "+s"(p)); return p; }
#define AIN(i) (a->in[i])
enum { I_X = 0, I_C, I_CTX, I_CCTX, I_ADAW, I_ADAB, I_N1G, I_N2G, I_WIN, I_WOUT, I_GNG, I_GWS, I_GB, I_LB, I_HNG, I_MU, I_W0, I_WUP, I_A0, I_AUP, I_GUP, I_KK, I_KA, I_RK, I_GNGG, I_GNB, I_RW, I_RB, I_WGU, I_WDN, I_FNG };

__device__ __forceinline__ void p0_transpose_item(const float* W, int K, int N, bf16* WT, int n_row0, LAS float* scr, int kb, int nb, int lane) {
    const int k0 = 64 * kb, n0 = 32 * nb;
#pragma unroll 8
    for (int i = 0; i < 32; ++i) { const int kk = 2 * i + (lane >> 5); scr[kk * 33 + (lane & 31)] = W[(size_t)(k0 + kk) * N + n0 + (lane & 31)]; }
    asm volatile("s_waitcnt lgkmcnt(0)" ::: "memory");
    const int c = lane & 7;
#pragma unroll
    for (int j = 0; j < 4; ++j) { const int n = (lane >> 3) + 8 * j; const LAS float* s = scr + (8 * c) * 33 + n;
        u32x4 o; o.x = pk2(s[0 * 33], s[1 * 33]); o.y = pk2(s[2 * 33], s[3 * 33]); o.z = pk2(s[4 * 33], s[5 * 33]); o.w = pk2(s[6 * 33], s[7 * 33]);
        *(u32x4*)(WT + (size_t)(n_row0 + n) * K + k0 + 8 * c) = o; }
    asm volatile("s_waitcnt lgkmcnt(0)" ::: "memory");
}

__device__ __forceinline__ void convert_moe(KArgs a, int l, LAS unsigned char* lds) {
    const int tid = tid_fresh(), lane = tid & 63, wave = tid >> 6;
    const int gw = blockIdx.x * 8 + wave, NGW = gridDim.x * 8;
    unsigned char* ws = a->ws;
    LAS float* scr = (LAS float*)(lds + wave * 16384);
    constexpr int I_GU = 32 * 64, I_DN = 16 * 64, N2 = 16 * I_GU, N3 = N2 + 16 * I_DN;
    for (int it = gw; it < N3; it += NGW) {
        if (it < N2) { const int e = it / I_GU, r = it % I_GU, kb = r / 64, nb = r % 64;
            const int n0 = 32 * nb, hh = n0 >> 10, nn = n0 & 1023, row0 = 256 * (nn >> 7) + 128 * hh + (nn & 127);
            p0_transpose_item(a->in[I_WGU] + (size_t)(l * NE + e) * D * 2048, D, 2048, (bf16*)(ws + WS_WGU) + (size_t)e * 2048 * D, row0, scr, kb, nb, lane); }
        else { const int q = it - N2, e = q / I_DN, r = q % I_DN, kb = r / 64, nb = r % 64;
            p0_transpose_item(a->in[I_WDN] + (size_t)(l * NE + e) * DE * D, DE, D, (bf16*)(ws + WS_WDN) + (size_t)e * D * DE, 32 * nb, scr, kb, nb, lane); }
    }
}
__device__ __forceinline__ void phase_prologue(KArgs a, LAS unsigned char* lds) {
    const int tid = tid_fresh(), lane = tid & 63, wave = tid >> 6;
    const int G = gridDim.x, gw = blockIdx.x * 8 + wave, NGW = G * 8;
    unsigned char* ws = a->ws;
    LAS float* scr = (LAS float*)(lds + wave * 16384);
    constexpr int I_IN = 32 * 232, I_OUT = 32 * 64;
    constexpr int N0 = 2 * I_IN, N1 = N0 + 2 * I_OUT;
    for (int it = gw; it < N1; it += NGW) {
        if (it < N0) { const int l = it / I_IN, r = it % I_IN, kb = r / 232, nb = r % 232;
            p0_transpose_item(a->in[I_WIN] + (size_t)l * D * INC, D, INC, (bf16*)(ws + WS_WIN) + (size_t)l * INC * D, 32 * nb, scr, kb, nb, lane); }
        else { const int q = it - N0, l = q / I_OUT, r = q % I_OUT, kb = r / 64, nb = r % 64;
            p0_transpose_item(a->in[I_WOUT] + (size_t)l * D * D, D, D, (bf16*)(ws + WS_WOUT) + (size_t)l * D * D, 32 * nb, scr, kb, nb, lane); }
    }
    convert_moe(a, 0, lds);
    {
        const int gt = blockIdx.x * NTHREADS + tid, NGT = G * NTHREADS;
        bf16* wup = (bf16*)(ws + WS_SMALLW + SW_WUP); bf16* aup = (bf16*)(ws + WS_SMALLW + SW_AUP); bf16* gup = (bf16*)(ws + WS_SMALLW + SW_GUP); bf16* gws = (bf16*)(ws + WS_SMALLW + SW_GWS);
        for (int i = gt; i < 2 * 2 * 768 * 64; i += NGT) { const int k = i & 63, n = (i >> 6) % 768, ld = i / (768 * 64); wup[i] = (bf16)f2bf(a->in[I_WUP][((size_t)ld * 64 + k) * 768 + n]); }
        for (int i = gt; i < 2 * 768 * 64; i += NGT) { const int k = i & 63, n = (i >> 6) % 768, l = i / (768 * 64); aup[i] = (bf16)f2bf(a->in[I_AUP][((size_t)l * 64 + k) * 768 + n]); }
        for (int i = gt; i < 2 * 768 * 128; i += NGT) { const int k = i & 127, n = (i >> 7) % 768, l = i / (768 * 128); gup[i] = (bf16)f2bf(a->in[I_GUP][((size_t)l * 128 + k) * 768 + n]); }
        for (int i = gt; i < 2 * 4 * 128 * 128; i += NGT) gws[i] = (bf16)f2bf(a->in[I_GWS][i]);
    }
    __syncthreads();
    {
        LAS float* sv = (LAS float*)lds;
        LAS float* red = (LAS float*)(lds + 73728);
        for (int i = tid; i < 9 * D; i += NTHREADS) { const int r = i / D, k = i % D; const float v = r < 8 ? a->in[I_C][r * D + k] : a->in[I_CCTX][k]; sv[i] = siluf_(v); }
        __syncthreads();
        float* mod = (float*)(ws + WS_MOD);
        for (int it = blockIdx.x; it < 2 * 96; it += G) {
            const int l = it / 96, cb = it % 96, cq = tid & 31, kg = tid >> 5;
            const float* wp = a->in[I_ADAW] + (size_t)l * D * 12288 + (size_t)(kg * 128) * 12288 + cb * 128 + cq * 4;
            f32x4 acc[9];
#pragma unroll
            for (int r = 0; r < 9; ++r) acc[r] = (f32x4){0.f, 0.f, 0.f, 0.f};
#pragma unroll 4
            for (int k = 0; k < 128; ++k) { const f32x4 w = *(const f32x4*)(wp + (size_t)k * 12288);
#pragma unroll
                for (int r = 0; r < 9; ++r) acc[r] += w * sv[r * D + kg * 128 + k]; }
#pragma unroll
            for (int r = 0; r < 9; ++r) *(LAS f32x4*)(red + ((kg * 9 + r) * 128 + cq * 4)) = acc[r];
            __syncthreads();
            for (int o = tid; o < 9 * 128; o += NTHREADS) { const int r = o / 128, c = o % 128; float s = a->in[I_ADAB][(size_t)l * 12288 + cb * 128 + c];
#pragma unroll
                for (int q = 0; q < 16; ++q) s += red[(q * 9 + r) * 128 + c];
                mod[((size_t)l * 9 + r) * 12288 + cb * 128 + c] = s; }
            __syncthreads();
        }
    }
}

template <int MODE>
__device__ __forceinline__ void phase_norm1(KArgs a, int l, bool dry) {
    const int tid_ = tid_fresh(); const int lane = tid_ & 63, wave = tid_ >> 6, gw = blockIdx.x * 8 + wave, NGW = gridDim.x * 8;
    unsigned char* ws = a->ws;
    const float* mod = (const float*)(ws + WS_MOD);
    float* X = (float*)(ws + WS_X); bf16* H = (bf16*)(ws + WS_H); const bf16* YK = (const bf16*)(ws + WS_YK);
    float* Xo = dry ? (float*)(ws + WS_END) : X; bf16* Ho = dry ? (bf16*)(ws + WS_END) : H; float* Oo = dry ? (float*)(ws + WS_END) : a->out;
    const int nrows = (MODE == 2) ? NLAT : MALL;
    const int rpw = (nrows + NGW - 1) / NGW; const int r0 = gw * rpw, r1 = (r0 + rpw < nrows) ? r0 + rpw : nrows;
    f32x4 ck[8], cs[8], cg[8]; int cur_mr = -1;
    for (int row = r0; row < r1; ++row) {
        const int mr = modrow_of(row); const int orow = dry ? (row & 2047) : row;
        if (mr != cur_mr) { cur_mr = mr;
#pragma unroll
            for (int j = 0; j < 8; ++j) { const int c = 4 * lane + 256 * j;
                if (MODE == 2) ck[j] = *(const f32x4*)(a->in[I_FNG] + c);
                else { const float* m = mod + ((size_t)l * 9 + mr) * 12288; const f32x4 g = *(const f32x4*)(a->in[I_N1G] + (size_t)l * D + c); ck[j] = g * (*(const f32x4*)(m + D + c) + 1.0f); cs[j] = *(const f32x4*)(m + c); }
                if (MODE != 0) cg[j] = *(const f32x4*)(mod + ((size_t)(l - 1) * 9 + mr) * 12288 + 5 * D + c); } }
        f32x4 v[8];
        if (MODE == 0) { const float* xr = row < NLAT ? a->in[I_X] + (size_t)row * D : a->in[I_CTX] + (size_t)(row - NLAT) * D;
#pragma unroll
            for (int j = 0; j < 8; ++j) v[j] = *(const f32x4*)(xr + 4 * lane + 256 * j);
        } else {
            const float* xr = X + (size_t)row * D; const bf16* y0 = YK + (size_t)row * D; const bf16* y1 = YK + ((size_t)MALL + row) * D;
            u32x2 p0[8], p1[8];
#pragma unroll
            for (int j = 0; j < 8; ++j) { const int c = 4 * lane + 256 * j; v[j] = *(const f32x4*)(xr + c); p0[j] = *(const u32x2*)(y0 + c); p1[j] = *(const u32x2*)(y1 + c); }
#pragma unroll
            for (int j = 0; j < 8; ++j) { f32x4 f; f[0] = bflo(p0[j].x) + bflo(p1[j].x); f[1] = bfhi(p0[j].x) + bfhi(p1[j].x); f[2] = bflo(p0[j].y) + bflo(p1[j].y); f[3] = bfhi(p0[j].y) + bfhi(p1[j].y);
                v[j] = v[j] + cg[j] * f; }
            if (MODE == 1) {
#pragma unroll
                for (int j = 0; j < 8; ++j) *(f32x4*)(Xo + (size_t)orow * D + 4 * lane + 256 * j) = v[j];
            }
        }
        float ss = 0.f;
#pragma unroll
        for (int j = 0; j < 8; ++j) ss += (v[j][0] * v[j][0] + v[j][1] * v[j][1]) + (v[j][2] * v[j][2] + v[j][3] * v[j][3]);
        const float rstd = 1.0f / sqrtf(wave_sum(ss) * (1.0f / D) + NORM_EPS);
        if (MODE == 2) {
#pragma unroll
            for (int j = 0; j < 8; ++j) *(f32x4*)(Oo + (size_t)orow * D + 4 * lane + 256 * j) = v[j] * rstd * ck[j];
        } else {
#pragma unroll
            for (int j = 0; j < 8; ++j) { const f32x4 h = v[j] * rstd * ck[j] + cs[j]; u32x2 o; o.x = pk2(h[0], h[1]); o.y = pk2(h[2], h[3]); *(u32x2*)(Ho + (size_t)orow * D + 4 * lane + 256 * j) = o; }
        }
    }
}

__device__ __forceinline__ void phase_norm2_router(KArgs a, int l, bool dry, LAS unsigned char* lds) {
    const int tid_ = tid_fresh(); const int lane = tid_ & 63, wave = tid_ >> 6, gw = blockIdx.x * 8 + wave, NGW = gridDim.x * 8;
    unsigned char* ws = a->ws;
    const float* mod = (const float*)(ws + WS_MOD);
    const float* X = (const float*)(ws + WS_X); bf16* H = (bf16*)(ws + WS_H);
    unsigned* cnt = (unsigned*)(ws + WS_CTL) + CW_CNT + l * 16 * 64 + (dry ? 4096 : 0);
    unsigned* ridx = (unsigned*)(ws + (dry ? WS_END : WS_RIDX)); float* rwt = (float*)(ws + (dry ? WS_END + 4 * MiB : WS_RW)); bf16* Ho = dry ? (bf16*)(ws + WS_END + 8 * MiB) : H;
    const int nrows = (l == DEPTH - 1) ? NLAT : MALL;
    LAS f32x4* rwl = (LAS f32x4*)lds;
    { const float* rw = a->in[I_RW];
      for (int idx = tid_; idx < 8192; idx += NTHREADS) { const int ln = idx & 63, q = (idx >> 6) & 3, i = (idx >> 8) & 3, j = idx >> 10; rwl[idx] = *(const f32x4*)(rw + (size_t)(4 * ln + 256 * j + i) * 16 + 4 * q); } }
    __syncthreads();
    const int rpw = (nrows + NGW - 1) / NGW; const int r0 = gw * rpw, r1 = (r0 + rpw < nrows) ? r0 + rpw : nrows;
    f32x4 ck[8]; int cur_mr = -1;
    const float* rbp = a->in[I_RB];
    for (int row = r0; row < r1; ++row) {
        const int mr = modrow_of(row); const int orow = dry ? (row & 2047) : row;
        if (mr != cur_mr) { cur_mr = mr; const float* m = mod + ((size_t)l * 9 + mr) * 12288;
#pragma unroll
            for (int j = 0; j < 8; ++j) { const int c = 4 * lane + 256 * j; const f32x4 g = *(const f32x4*)(a->in[I_N2G] + (size_t)l * D + c); ck[j] = g * (*(const f32x4*)(m + 4 * D + c) + 1.0f); } }
        const float* shp = mod + ((size_t)l * 9 + mr) * 12288 + 3 * D;
        const float* xr = X + (size_t)row * D;
        f32x4 v[8]; float ss = 0.f;
#pragma unroll
        for (int j = 0; j < 8; ++j) { v[j] = *(const f32x4*)(xr + 4 * lane + 256 * j); ss += (v[j][0] * v[j][0] + v[j][1] * v[j][1]) + (v[j][2] * v[j][2] + v[j][3] * v[j][3]); }
        const float rstd = 1.0f / sqrtf(wave_sum(ss) * (1.0f / D) + NORM_EPS);
        f32x4 lg4[4];
#pragma unroll
        for (int q = 0; q < 4; ++q) lg4[q] = (f32x4){0.f, 0.f, 0.f, 0.f};
#pragma unroll
        for (int j = 0; j < 8; ++j) { const f32x4 h = v[j] * rstd * ck[j] + *(const f32x4*)(shp + 4 * lane + 256 * j); u32x2 o; o.x = pk2(h[0], h[1]); o.y = pk2(h[2], h[3]); *(u32x2*)(Ho + (size_t)orow * D + 4 * lane + 256 * j) = o;
#pragma unroll
            for (int i = 0; i < 4; ++i)
#pragma unroll
                for (int q = 0; q < 4; ++q) lg4[q] += rwl[((j * 4 + i) * 4 + q) * 64 + lane] * h[i];
            asm volatile("" ::: "memory"); }
        float lg[16];
        { float t8[8], t4[4], t2[2], t1;
          const bool b5 = lane & 32, b4 = lane & 16, b3 = lane & 8, b2 = lane & 4;
#pragma unroll
          for (int i = 0; i < 8; ++i) { const float keep = b5 ? lg4[(i + 8) >> 2][(i + 8) & 3] : lg4[i >> 2][i & 3], send = b5 ? lg4[i >> 2][i & 3] : lg4[(i + 8) >> 2][(i + 8) & 3]; t8[i] = keep + __shfl_xor(send, 32); }
#pragma unroll
          for (int i = 0; i < 4; ++i) { const float keep = b4 ? t8[i + 4] : t8[i], send = b4 ? t8[i] : t8[i + 4]; t4[i] = keep + __shfl_xor(send, 16); }
#pragma unroll
          for (int i = 0; i < 2; ++i) { const float keep = b3 ? t4[i + 2] : t4[i], send = b3 ? t4[i] : t4[i + 2]; t2[i] = keep + __shfl_xor(send, 8); }
          { const float keep = b2 ? t2[1] : t2[0], send = b2 ? t2[0] : t2[1]; t1 = keep + __shfl_xor(send, 4); }
          t1 += __shfl_xor(t1, 2); t1 += __shfl_xor(t1, 1);
#pragma unroll
          for (int e = 0; e < 16; ++e) { const int src = ((e >> 3) & 1) * 32 + ((e >> 2) & 1) * 16 + ((e >> 1) & 1) * 8 + (e & 1) * 4; lg[e] = __builtin_bit_cast(float, __builtin_amdgcn_readlane(__builtin_bit_cast(int, t1), src)) + rbp[e]; } }
        float mx = lg[0];
#pragma unroll
        for (int e = 1; e < 16; ++e) mx = fmaxf(mx, lg[e]);
        float p[16], sum = 0.f;
#pragma unroll
        for (int e = 0; e < 16; ++e) { p[e] = __expf(lg[e] - mx); sum += p[e]; }
        const float inv = 1.0f / sum;
#pragma unroll
        for (int e = 0; e < 16; ++e) p[e] *= inv;
        int sel = 0; float best = -1.f;
#pragma unroll
        for (int gI = 0; gI < 4; ++gI) { float m1 = -1.f, m2 = -1.f;
#pragma unroll
            for (int i = 0; i < 4; ++i) { const float q = p[4 * gI + i]; if (q > m1) { m2 = m1; m1 = q; } else if (q > m2) m2 = q; }
            const float s = m1 + m2; if (s > best) { best = s; sel = gI; } }
        int i1 = 0, i2 = 0; float p1 = -2.f, p2 = -2.f;
#pragma unroll
        for (int gI = 0; gI < 4; ++gI)
#pragma unroll
            for (int i = 0; i < 4; ++i) { const float q = (gI == sel) ? p[4 * gI + i] : -1.0f; const int e = 4 * gI + i;
                if (gI == sel) { if (q > p1) { p2 = p1; i2 = i1; p1 = q; i1 = e; } else if (q > p2) { p2 = q; i2 = e; } } }
        const float wsum = p1 + p2, w1 = p1 / wsum, w2 = p2 / wsum;
        if (lane == 0) {
            const unsigned q1 = atomicAdd(cnt + i1 * 64, 1u); ridx[(size_t)i1 * MALL + q1] = (unsigned)row; rwt[(size_t)i1 * MALL + q1] = w1;
            const unsigned q2 = atomicAdd(cnt + i2 * 64, 1u); ridx[(size_t)i2 * MALL + q2] = (unsigned)row | 0x80000000u; rwt[(size_t)i2 * MALL + q2] = w2;
        }
    }
    __syncthreads();
}

template <bool FOR_DOWN>
__device__ __forceinline__ void moe_tables(KArgs a, int l, LAS unsigned char* lds, int cvirt) {
    const int tid = tid_fresh(), G = gridDim.x;
    unsigned char* ws = a->ws;
    const unsigned* cnt = (const unsigned*)(ws + WS_CTL) + CW_CNT + l * 16 * 64;
    const unsigned* ridx = (const unsigned*)(ws + WS_RIDX); const float* rwt = (const float*)(ws + WS_RW);
    LAS int* tp = (LAS int*)(lds + LDS_TP); LAS unsigned* tab = (LAS unsigned*)(lds + LDS_TAB); LAS float* tabw = (LAS float*)(lds + LDS_TABW);
    if (tid == 0) { int acc = 0; for (int e = 0; e < 16; ++e) { tp[e] = acc; acc += (int)((cnt[e * 64] + 255u) >> 8); } tp[16] = acc; }
    __syncthreads();
    const int ntot = tp[16] * 8;
    for (int i = 0; i < 9; ++i) { const int L = i * G + cvirt; if (L >= ntot) break;
        const int tile = L >> 3; int e = 0;
        for (int j = 1; j < 16; ++j) e += (tile >= tp[j]) ? 1 : 0;
        const int pos0 = (tile - tp[e]) * 256; const unsigned ce = cnt[e * 64];
        if (tid < 256) { const int pos = pos0 + tid; const bool valid = (unsigned)pos < ce; const unsigned ent = ridx[(size_t)e * MALL + (valid ? pos : 0)];
            if (FOR_DOWN) { tab[i * 256 + tid] = valid ? ent : (ent | 0x40000000u); tabw[i * 256 + tid] = valid ? rwt[(size_t)e * MALL + pos] : 0.f; }
            else tab[i * 256 + tid] = (ent & 0xffffu) * (unsigned)(D * 2); }
    }
    __syncthreads();
}

__device__ __forceinline__ void gmlp_item(KArgs a, int l, int item, LAS unsigned char* lds) {
    const int tid = tid_fresh(), lane = tid & 63, wave = tid >> 6;
    unsigned char* ws = a->ws;
    const bf16* P = (const bf16*)(ws + WS_P); bf16* Y = (bf16*)(ws + WS_Y);
    const int chunk = item >> 2, h = item & 3;
    const int row0 = chunk < 256 ? chunk * 128 : NLAT + (chunk - 256) * 128;
    LAS bf16* wsl = (LAS bf16*)lds;
    LAS bf16* vT = (LAS bf16*)(lds + 128 * 136 * 2);
    const bf16* gws = (const bf16*)(ws + WS_SMALLW + SW_GWS) + ((size_t)l * 4 + h) * 128 * 128;
    for (int p = tid; p < 2048; p += NTHREADS) { const int t = p >> 4, c8 = p & 15; *(LAS u32x4*)(wsl + t * 136 + c8 * 8) = *(const u32x4*)(gws + t * 128 + c8 * 8); }
    {
        const int s = tid >> 2, qd = tid & 3; const bf16* vp = P + (size_t)(row0 + s) * INC + OFF_V + h * 128 + qd * 32;
        float g[32]; float ss = 0.f;
#pragma unroll
        for (int q = 0; q < 4; ++q) { float f[8]; unpack8(*(const u32x4*)(vp + 8 * q), f);
#pragma unroll
            for (int j = 0; j < 8; ++j) { const float x = geluf_(f[j]); g[8 * q + j] = x; ss += x * x; } }
        ss += __shfl_xor(ss, 1); ss += __shfl_xor(ss, 2);
        const float rstd = 1.0f / sqrtf(ss * (1.0f / 128.0f) + NORM_EPS);
        const float* ng = a->in[I_GNG] + (size_t)l * 512 + h * 128 + qd * 32;
#pragma unroll
        for (int j = 0; j < 32; ++j) vT[(qd * 32 + j) * 136 + s] = (bf16)f2bf(g[j] * rstd * ng[j]);
    }
    __syncthreads();
    f32x4 acc[8];
#pragma unroll
    for (int ct = 0; ct < 8; ++ct) acc[ct] = (f32x4){0.f, 0.f, 0.f, 0.f};
    const int fr = lane & 15, fq = lane >> 4;
#pragma unroll
    for (int ks = 0; ks < 4; ++ks) {
        const bf16x8 bfrag = *(const LAS bf16x8*)(wsl + (16 * wave + fr) * 136 + ks * 32 + fq * 8);
#pragma unroll
        for (int ct = 0; ct < 8; ++ct) { const bf16x8 afrag = *(const LAS bf16x8*)(vT + (16 * ct + fr) * 136 + ks * 32 + fq * 8);
            acc[ct] = __builtin_amdgcn_mfma_f32_16x16x32_bf16(afrag, bfrag, acc[ct], 0, 0, 0); }
    }
    const int t = 16 * wave + fr; const float wb = a->in[I_GB][((size_t)l * 4 + h) * 128 + t];
    const bf16* up = P + (size_t)(row0 + t) * INC + OFF_U + h * 128; bf16* yp = Y + (size_t)(row0 + t) * D + h * 128;
#pragma unroll
    for (int ct = 0; ct < 8; ++ct) { const int c = 16 * ct + 4 * fq; const u32x2 uu = *(const u32x2*)(up + c);
        const float y0 = geluf_(bflo(uu.x)) * (acc[ct][0] + wb), y1 = geluf_(bfhi(uu.x)) * (acc[ct][1] + wb), y2 = geluf_(bflo(uu.y)) * (acc[ct][2] + wb), y3 = geluf_(bfhi(uu.y)) * (acc[ct][3] + wb);
        u32x2 o; o.x = pk2(y0, y1); o.y = pk2(y2, y3); *(u32x2*)(yp + c) = o; }
    __syncthreads();
}

constexpr int SP_ = 72;
__device__ __forceinline__ int kperm_pos(int k) { const int s5 = k & 31; return (k & 32) + 8 * ((s5 >> 2) & 3) + 4 * (s5 >> 4) + (s5 & 3); }
__device__ __forceinline__ void rwkv_prep_item(KArgs a, int l, int tile, int hgrp, LAS unsigned char* lds) {
    const int tid = tid_fresh(), lane = tid & 63, wave = tid >> 6;
    unsigned char* ws = a->ws;
    const bf16* P = (const bf16*)(ws + WS_P); bf16* Y = (bf16*)(ws + WS_Y);
    LAS bf16* SR = (LAS bf16*)lds; LAS bf16* SK = SR + 64 * SP_; LAS bf16* SV = SK + 64 * SP_; LAS bf16* SKK = SV + 64 * SP_; LAS bf16* SB = SKK + 64 * SP_; LAS bf16* SWF = SB + 64 * SP_; LAS bf16* SWB = SWF + 64 * SP_;
    LAS bf16* tw = SWB + 64 * SP_;
    LAS bf16* adl = tw + 64 * SP_;
    LAS bf16* sg = adl + 64 * SP_;
    LAS float* invn = (LAS float*)(sg + 64 * 136);
    LAS unsigned char* wpriv = (LAS unsigned char*)(invn + 64) + wave * 6144;
    const int row0 = tile * 64; const bool isl = row0 < NLAT;
    const float* mu = a->in[I_MU] + (size_t)l * CCOLS;
    const char* Pb = (const char*)P;
    auto shift_group = [&](int tk, int col, float (&z)[8]) {
        const int row = row0 + tk; int o0, o1, o2, o3; bool v0, v1, v2, v3;
        if (isl) { const int gr = (row >> 6) & 63; o0 = -1; o1 = 1; o2 = -64; o3 = 64; v0 = tk > 0; v1 = tk < 63; v2 = gr > 0; v3 = gr < 63; }
        else { const int tc = (row - NLAT) & 255; o0 = -1; o1 = 1; o2 = -1; o3 = 1; v0 = tc > 0; v1 = tc < 255; v2 = v0; v3 = v1; }
        const unsigned off = (unsigned)row * (unsigned)(INC * 2) + (unsigned)(OFF_C + col) * 2u;
        const u32x4 uo = *(const u32x4*)(Pb + off), u0 = *(const u32x4*)(Pb + (off + (unsigned)((v0 ? o0 : 0) * INC * 2))), u1 = *(const u32x4*)(Pb + (off + (unsigned)((v1 ? o1 : 0) * INC * 2))),
                    u2 = *(const u32x4*)(Pb + (off + (unsigned)((v2 ? o2 : 0) * INC * 2))), u3 = *(const u32x4*)(Pb + (off + (unsigned)((v3 ? o3 : 0) * INC * 2)));
        const f32x4 m0 = *(const f32x4*)(mu + col), m1 = *(const f32x4*)(mu + col + 4);
        float own[8], n0[8], n1[8], n2[8], n3[8]; unpack8(uo, own); unpack8(u0, n0); unpack8(u1, n1); unpack8(u2, n2); unpack8(u3, n3);
        const float f0 = v0 ? 1.f : 0.f, f1 = v1 ? 1.f : 0.f, f2 = v2 ? 1.f : 0.f, f3 = v3 ? 1.f : 0.f;
        const float nb[8] = {n0[0] * f0, n1[1] * f1, n2[2] * f2, n3[3] * f3, n0[4] * f0, n1[5] * f1, n2[6] * f2, n3[7] * f3};
#pragma unroll
        for (int j = 0; j < 8; ++j) { const float mm = j < 4 ? m0[j] : m1[j - 4]; z[j] = own[j] + mm * (nb[j] - own[j]); }
    };
#pragma unroll
    for (int it = 0; it < 4; ++it) { const int g = tid + NTHREADS * it, tk = g >> 5, gi = g & 31;
        float z[8]; shift_group(tk, 2304 + gi * 8, z);
        if (gi < 8) { float t8[8];
#pragma unroll
            for (int j = 0; j < 8; ++j) t8[j] = 1.0f - 2.0f * __builtin_amdgcn_rcpf(1.0f + __expf(2.0f * z[j]));
            *(LAS u32x4*)(tw + tk * SP_ + gi * 8) = pack8(t8); }
        else if (gi < 16) *(LAS u32x4*)(adl + tk * SP_ + (gi - 8) * 8) = pack8(z);
        else { float t8[8];
#pragma unroll
            for (int j = 0; j < 8; ++j) t8[j] = sigmoidf_(z[j]);
            *(LAS u32x4*)(sg + tk * 136 + (gi - 16) * 8) = pack8(t8); } }
    __syncthreads();
#pragma unroll 1
    for (int hh = 0; hh < 4; ++hh) {
    const int tid = tid_fresh(), lane = tid & 63, wave = tid >> 6;
    const int head = 4 * hgrp + hh; const float* kkw = a->in[I_KK] + (size_t)l * CW + head * 64;
#pragma unroll
    for (int it = 0; it < 3; ++it) { const int g = tid + NTHREADS * it, tk = g / 24, gi = g % 24, c8 = (gi & 7) * 8;
        float z[8]; shift_group(tk, (gi >> 3) * 768 + head * 64 + c8, z);
        if (gi < 8) *(LAS u32x4*)(SR + tk * SP_ + c8) = pack8(z);
        else if (gi < 16) { *(LAS u32x4*)(SK + tk * SP_ + c8) = pack8(z);
            const f32x4 k0 = *(const f32x4*)(kkw + c8), k1 = *(const f32x4*)(kkw + c8 + 4); float ss = 0.f;
#pragma unroll
            for (int j = 0; j < 8; ++j) { const float q = z[j] * (j < 4 ? k0[j] : k1[j - 4]); ss += q * q; }
            ss += __shfl_xor(ss, 1); ss += __shfl_xor(ss, 2); ss += __shfl_xor(ss, 4);
            if ((gi & 7) == 0) invn[tk] = 1.0f / fmaxf(sqrtf(ss), 1e-12f); }
        else *(LAS u32x4*)(SV + tk * SP_ + c8) = pack8(z); }
    __syncthreads();
    {
        const int fr = lane & 15, fq = lane >> 4, nt = wave & 3, th = wave >> 2;
        const bf16* wupT = (const bf16*)(ws + WS_SMALLW + SW_WUP) + (size_t)l * 2 * 768 * 64;
        const bf16* aupT = (const bf16*)(ws + WS_SMALLW + SW_AUP) + (size_t)l * 768 * 64;
        const bf16* gupT = (const bf16*)(ws + WS_SMALLW + SW_GUP) + (size_t)l * 768 * 128;
        const float* a0 = a->in[I_A0] + (size_t)l * CW + head * 64; const float* kaw = a->in[I_KA] + (size_t)l * CW + head * 64; const float* w0 = a->in[I_W0] + (size_t)l * 2 * CW + head * 64;
        const int nloc = 16 * nt + 4 * fq;
#pragma unroll 1
        for (int mat = 0; mat < 4; ++mat) {
            const bf16* WT = mat == 0 ? aupT : (mat == 1 ? wupT : (mat == 2 ? wupT + 768 * 64 : gupT));
            const int KK = mat == 3 ? 128 : 64; const LAS bf16* act = mat == 0 ? adl : (mat == 3 ? sg : tw); const int apitch = mat == 3 ? 136 : SP_;
            f32x4 acc[2];
            acc[0] = (f32x4){0.f, 0.f, 0.f, 0.f}; acc[1] = acc[0];
            for (int ks = 0; ks < KK / 32; ++ks) { const bf16x8 afr = *(const bf16x8*)(WT + (size_t)(head * 64 + 16 * nt + fr) * KK + ks * 32 + fq * 8);
#pragma unroll
                for (int tt = 0; tt < 2; ++tt) { const bf16x8 bfr = *(const LAS bf16x8*)(act + (16 * (2 * th + tt) + fr) * apitch + ks * 32 + fq * 8); acc[tt] = __builtin_amdgcn_mfma_f32_16x16x32_bf16(afr, bfr, acc[tt], 0, 0, 0); } }
#pragma unroll
            for (int tt = 0; tt < 2; ++tt) { const int tk = 16 * (2 * th + tt) + fr; const f32x4 v = acc[tt];
                if (mat == 0) {
                    const f32x4 a0v = *(const f32x4*)(a0 + nloc), kav = *(const f32x4*)(kaw + nloc), kkv = *(const f32x4*)(kkw + nloc);
                    const u32x2 kp = *(const LAS u32x2*)(SK + tk * SP_ + nloc); const float kf[4] = {bflo(kp.x), bfhi(kp.x), bflo(kp.y), bfhi(kp.y)};
                    const float inn = invn[tk]; float k2[4], kk[4], bb[4];
#pragma unroll
                    for (int j = 0; j < 4; ++j) { const float av = sigmoidf_(a0v[j] + v[j]); kk[j] = kf[j] * kkv[j] * inn; k2[j] = kf[j] * (1.0f + (av - 1.0f) * kav[j]); bb[j] = kk[j] * av; }
                    u32x2 q; q.x = pk2(k2[0], k2[1]); q.y = pk2(k2[2], k2[3]); *(LAS u32x2*)(SK + tk * SP_ + nloc) = q;
                    q.x = pk2(kk[0], kk[1]); q.y = pk2(kk[2], kk[3]); *(LAS u32x2*)(SKK + tk * SP_ + nloc) = q;
                    q.x = pk2(bb[0], bb[1]); q.y = pk2(bb[2], bb[3]); *(LAS u32x2*)(SB + tk * SP_ + nloc) = q;
                } else if (mat <= 2) {
                    const f32x4 w0v = *(const f32x4*)(w0 + (mat - 1) * CW + nloc); float d[4];
#pragma unroll
                    for (int j = 0; j < 4; ++j) d[j] = __expf(-DECAY_SCALE * sigmoidf_(w0v[j] + v[j]));
                    u32x2 q; q.x = pk2(d[0], d[1]); q.y = pk2(d[2], d[3]); *(LAS u32x2*)((mat == 1 ? SWF : SWB) + tk * SP_ + nloc) = q;
                } else {
                    u32x2 q; q.x = pk2(v[0], v[1]); q.y = pk2(v[2], v[3]); *(u32x2*)(Y + (size_t)(row0 + tk) * D + 1280 + head * 64 + nloc) = q;
                }
            }
        }
    }
    __syncthreads();
    { const int tk = tid >> 3, c8 = (tid & 7) * 8; float r8[8], k8[8], v8[8];
      unpack8(*(const LAS u32x4*)(SR + tk * SP_ + c8), r8); unpack8(*(const LAS u32x4*)(SK + tk * SP_ + c8), k8); unpack8(*(const LAS u32x4*)(SV + tk * SP_ + c8), v8);
      const float* rkp = a->in[I_RK] + (size_t)l * CW + head * 64 + c8; const f32x4 rk0 = *(const f32x4*)rkp, rk1 = *(const f32x4*)(rkp + 4);
      float bs = 0.f;
#pragma unroll
      for (int j = 0; j < 8; ++j) bs += r8[j] * k8[j] * (j < 4 ? rk0[j] : rk1[j - 4]);
      bs += __shfl_xor(bs, 1); bs += __shfl_xor(bs, 2); bs += __shfl_xor(bs, 4);
#pragma unroll
      for (int j = 0; j < 8; ++j) v8[j] *= bs;
      *(u32x4*)(Y + (size_t)(row0 + tk) * D + 512 + head * 64 + c8) = pack8(v8); }
    {
        const int c4 = wave & 3, dir = wave >> 2, fr = lane & 15, fq = lane >> 4;
        LAS float* CB = (LAS float*)wpriv;
        LAS float* AA = CB + 16 * 64;
        const LAS bf16* SW = dir ? SWB : SWF;
        auto trow = [&](int tau) { return 16 * c4 + (dir ? 15 - tau : tau); };
        float c[16], ci[16];
        { float run = 1.f;
#pragma unroll
          for (int t = 0; t < 16; ++t) { run *= bf1(SW[trow(t) * SP_ + lane]); c[t] = run; ci[t] = __builtin_amdgcn_rcpf(run); CB[t * 64 + lane] = run; } }
        const int rec_dir = dir, bidx = isl ? (row0 >> 12) : ((row0 - NLAT) >> 8);
        const int tcl = isl ? 4 * ((row0 >> 6) & 63) + c4 : 4 * (((row0 - NLAT) >> 6) & 3) + c4;
        const int nproc = isl ? 16 + (dir ? 255 - tcl : tcl) : (dir ? 15 - tcl : tcl);
        unsigned char* rec = ws + WS_PRE + ((size_t)((rec_dir * 8 + bidx) * 12 + head) * NCHUNK16 + nproc) * PRE_REC;
        { const float cl = c[15]; float bk[32];
#pragma unroll
          for (int t = 0; t < 16; ++t) { const float e = cl * ci[t]; const int pos = 8 * (t >> 2) + (t & 3); bk[pos] = bf1(SB[trow(t) * SP_ + lane]) * e; bk[pos + 4] = bf1(SK[trow(t) * SP_ + lane]) * e; }
#pragma unroll
          for (int q4 = 0; q4 < 4; ++q4) { u32x4 o; o.x = pk2(bk[8 * q4], bk[8 * q4 + 1]); o.y = pk2(bk[8 * q4 + 2], bk[8 * q4 + 3]); o.z = pk2(bk[8 * q4 + 4], bk[8 * q4 + 5]); o.w = pk2(bk[8 * q4 + 6], bk[8 * q4 + 7]);
              *(u32x4*)(rec + PR_BK + lane * 64 + q4 * 16) = o; }
          *(float*)(rec + PR_GAM + lane * 4) = cl; }
        asm volatile("s_waitcnt lgkmcnt(0)" ::: "memory");
        bf16x8 fa[2], frr[2], fb[2], fk[2];
        { const int tr = trow(fr);
#pragma unroll
          for (int sx = 0; sx < 2; ++sx) { const int ch = 32 * sx + 8 * fq; float kk8[8], r8[8], b8[8], k8[8];
              unpack8(*(const LAS u32x4*)(SKK + tr * SP_ + ch), kk8); unpack8(*(const LAS u32x4*)(SR + tr * SP_ + ch), r8); unpack8(*(const LAS u32x4*)(SB + tr * SP_ + ch), b8); unpack8(*(const LAS u32x4*)(SK + tr * SP_ + ch), k8);
              const f32x4 c0 = *(const LAS f32x4*)(CB + fr * 64 + ch), c1 = *(const LAS f32x4*)(CB + fr * 64 + ch + 4);
              f32x4 p0 = (f32x4){1.f, 1.f, 1.f, 1.f}, p1 = p0; if (fr > 0) { p0 = *(const LAS f32x4*)(CB + (fr - 1) * 64 + ch); p1 = *(const LAS f32x4*)(CB + (fr - 1) * 64 + ch + 4); }
              float xa[8], xr[8], xb[8], xk[8];
#pragma unroll
              for (int j = 0; j < 8; ++j) { const float ec = j < 4 ? c0[j] : c1[j - 4], ep = j < 4 ? p0[j] : p1[j - 4]; const float en = __builtin_amdgcn_rcpf(ec);
                  xa[j] = -kk8[j] * ep; xr[j] = r8[j] * ec; xb[j] = b8[j] * en; xk[j] = k8[j] * en; }
              const u32x4 ua = pack8(xa), ur = pack8(xr), ub = pack8(xb), uk = pack8(xk);
              fa[sx] = __builtin_bit_cast(bf16x8, ua); frr[sx] = __builtin_bit_cast(bf16x8, ur); fb[sx] = __builtin_bit_cast(bf16x8, ub); fk[sx] = __builtin_bit_cast(bf16x8, uk); } }
        f32x4 gab = (f32x4){0.f, 0.f, 0.f, 0.f}, gak = gab, grb = gab, grk = gab;
#pragma unroll
        for (int sx = 0; sx < 2; ++sx) { gab = __builtin_amdgcn_mfma_f32_16x16x32_bf16(fa[sx], fb[sx], gab, 0, 0, 0); gak = __builtin_amdgcn_mfma_f32_16x16x32_bf16(fa[sx], fk[sx], gak, 0, 0, 0);
            grb = __builtin_amdgcn_mfma_f32_16x16x32_bf16(frr[sx], fb[sx], grb, 0, 0, 0); grk = __builtin_amdgcn_mfma_f32_16x16x32_bf16(frr[sx], fk[sx], grk, 0, 0, 0); }
#pragma unroll
        for (int j = 0; j < 4; ++j) { const int tau = 4 * fq + j; const bool lo = fr < tau, le = fr <= tau;
            AA[tau * 16 + fr] = lo ? gab[j] : 0.f; AA[256 + tau * 16 + fr] = lo ? gak[j] : 0.f; grb[j] = le ? grb[j] : 0.f; grk[j] = le ? grk[j] : 0.f; }
        asm volatile("s_waitcnt lgkmcnt(0)" ::: "memory");
        float wv[16], mv[16];
#pragma unroll
        for (int t = 0; t < 16; ++t) { const float ab = -bf1(SKK[trow(t) * SP_ + lane]) * (t > 0 ? c[t - 1] : 1.0f); float accw = ab, accm = AA[256 + t * 16 + fr];
#pragma unroll
            for (int q4 = 0; q4 < 4; ++q4) { if (4 * q4 < t) { const f32x4 cf = *(const LAS f32x4*)(AA + t * 16 + 4 * q4);
#pragma unroll
                for (int j = 0; j < 4; ++j) if (4 * q4 + j < t) { accw += cf[j] * wv[4 * q4 + j]; accm += cf[j] * mv[4 * q4 + j]; } } }
            wv[t] = accw; mv[t] = accm; }
        { LAS bf16* stg = (LAS bf16*)CB; const int pp = kperm_pos(lane);
#pragma unroll
          for (int t = 0; t < 16; ++t) { stg[t * 64 + pp] = (bf16)f2bf(wv[t]); stg[1024 + t * 64 + pp] = (bf16)f2bf(bf1(SR[trow(t) * SP_ + lane]) * c[t]); }
          asm volatile("s_waitcnt lgkmcnt(0)" ::: "memory");
#pragma unroll
          for (int q4 = 0; q4 < 4; ++q4) *(u32x4*)(rec + PR_WP + (q4 * 64 + lane) * 16) = *(const LAS u32x4*)((LAS unsigned char*)stg + (q4 * 64 + lane) * 16); }
        { LAS bf16* stg = (LAS bf16*)AA; const int ps = 8 * (fr >> 2) + (fr & 3);
          asm volatile("s_waitcnt lgkmcnt(0)" ::: "memory");
#pragma unroll
          for (int j = 0; j < 4; ++j) { const int tau = 4 * fq + j; stg[tau * 32 + ps] = (bf16)f2bf(grb[j]); stg[tau * 32 + ps + 4] = (bf16)f2bf(grk[j]); }
          if (lane < 16) {
#pragma unroll
              for (int t = 0; t < 16; ++t) stg[512 + t * 16 + lane] = (bf16)f2bf(mv[t]); }
          asm volatile("s_waitcnt lgkmcnt(0)" ::: "memory");
          *(u32x4*)(rec + PR_ARBK + lane * 16) = *(const LAS u32x4*)((LAS unsigned char*)stg + lane * 16);
          if (lane < 32) *(u32x4*)(rec + PR_ARBK + 1024 + lane * 16) = *(const LAS u32x4*)((LAS unsigned char*)stg + 1024 + lane * 16); }
        if (dir == 0) { float v16[16];
#pragma unroll
            for (int t = 0; t < 16; ++t) v16[t] = bf1(SV[(16 * c4 + t) * SP_ + lane]);
            const int tcg = isl ? 16 + tcl : tcl;
            unsigned char* vrec = ws + WS_VT + ((size_t)(bidx * 12 + head) * NCHUNK16 + tcg) * 2048 + lane * 32;
            u32x4 o; o.x = pk2(v16[0], v16[1]); o.y = pk2(v16[2], v16[3]); o.z = pk2(v16[4], v16[5]); o.w = pk2(v16[6], v16[7]); *(u32x4*)vrec = o;
            o.x = pk2(v16[8], v16[9]); o.y = pk2(v16[10], v16[11]); o.z = pk2(v16[12], v16[13]); o.w = pk2(v16[14], v16[15]); *(u32x4*)(vrec + 16) = o; }
    }
    __syncthreads();
    }
}

__device__ __forceinline__ float dpp_xor1(float x) { return __builtin_bit_cast(float, __builtin_amdgcn_update_dpp(0, __builtin_bit_cast(int, x), 0xB1, 0xF, 0xF, false)); }
__device__ __forceinline__ float dpp_xor2(float x) { return __builtin_bit_cast(float, __builtin_amdgcn_update_dpp(0, __builtin_bit_cast(int, x), 0x4E, 0xF, 0xF, false)); }
__device__ __forceinline__ int chain_row(int dir, int b, int s) {
    if (s < CTXL) return NLAT + b * CTXL + (dir ? (CTXL - 1 - s) : s);
    const int t = s - CTXL; return b * T + (dir ? (T - 1 - t) : t);
}
__device__ __forceinline__ float dpp_hmirror(float x) { return __builtin_bit_cast(float, __builtin_amdgcn_update_dpp(0, __builtin_bit_cast(int, x), 0x141, 0xF, 0xF, false)); }
struct RwRec { u32x4 wp[2], rp[2], bk[4], arbk; u32x2 mak, vt[2]; f32x4 gam[4]; };
__device__ __forceinline__ void rw_load(RwRec& r, const LAS unsigned char* rec, int fr, int kg, int hv, int dir) {
#pragma unroll
    for (int sx = 0; sx < 2; ++sx) { r.wp[sx] = *(const LAS u32x4*)(rec + PR_WP + fr * 128 + sx * 64 + kg * 16); r.rp[sx] = *(const LAS u32x4*)(rec + PR_RP + fr * 128 + sx * 64 + kg * 16); }
#pragma unroll
    for (int i = 0; i < 4; ++i) { r.bk[i] = *(const LAS u32x4*)(rec + PR_BK + (16 * i + fr) * 64 + kg * 16); r.gam[i] = *(const LAS f32x4*)(rec + PR_GAM + (16 * i + 4 * kg) * 4); }
    r.arbk = *(const LAS u32x4*)(rec + PR_ARBK + fr * 64 + kg * 16);
    r.mak = *(const LAS u32x2*)(rec + PR_MAK + fr * 32 + kg * 8);
#pragma unroll
    for (int q = 0; q < 2; ++q) r.vt[q] = *(const LAS u32x2*)(rec + PRE_REC + (16 * (2 * hv + q) + fr) * 32 + (dir ? (12 - 4 * kg) : 4 * kg) * 2);
}
constexpr int RW_R = 6, RW_SLOT = PRE_REC + 2048;
__device__ __forceinline__ void rwkv_chain_mfma(KArgs a, int task_base, LAS unsigned char* lds) {
    const int t_ = tid_fresh(); const int lane = t_ & 63, fr = lane & 15, kg = lane >> 4; const int wave = __builtin_amdgcn_readfirstlane(t_ >> 6);
    unsigned char* ws = a->ws;
    bf16* OC = (bf16*)(ws + WS_OC);
    const int cid = (task_base >> 2) + (wave >> 2), wq = wave & 3, dir = cid / 96, b = (cid % 96) / 12, h = cid % 12;
    const bool comp = wq < 2; const int hv = wq & 1;
    const unsigned char* rec0 = ws + WS_PRE + (size_t)((dir * 8 + b) * 12 + h) * NCHUNK16 * PRE_REC;
    const unsigned char* vrec0 = ws + WS_VT + (size_t)(b * 12 + h) * NCHUNK16 * 2048;
    LAS unsigned char* ring = lds + (wave >> 2) * (RW_R * RW_SLOT);
    auto tchunk = [&](int n) { return n < 16 ? (dir ? 15 - n : n) : 16 + (dir ? 255 - (n - 16) : (n - 16)); };
    auto issue = [&](int n) { const int nn = n < NCHUNK16 ? n : NCHUNK16 - 1; LAS unsigned char* slot = ring + (n % RW_R) * RW_SLOT;
#pragma unroll
        for (int jj = 0; jj < 3; ++jj) { const int j = 3 * wq + jj;
            const unsigned char* src = (j < 10 ? rec0 + (size_t)nn * PRE_REC + 1024 * j : vrec0 + (size_t)tchunk(nn) * 2048 + 1024 * (j - 10)) + lane * 16;
            __builtin_amdgcn_global_load_lds((const unsigned*)src, (LAS unsigned*)(slot + 1024 * j), 16, 0, 0); } };
    f32x4 ST[2][4];
#pragma unroll
    for (int q = 0; q < 2; ++q)
#pragma unroll
        for (int i = 0; i < 4; ++i) ST[q][i] = (f32x4){0.f, 0.f, 0.f, 0.f};
    unsigned uvU[2][2] = {{0u, 0u}, {0u, 0u}};
#pragma unroll
    for (int n = 0; n < RW_R - 1; ++n) issue(n);
    for (int n = 0; n < NCHUNK16; ++n) {
        asm volatile("s_waitcnt vmcnt(12)" ::: "memory");
        __builtin_amdgcn_s_barrier(); asm volatile("" ::: "memory");
        issue(n + RW_R - 1);
        if (comp) {
            RwRec cur; rw_load(cur, ring + (n % RW_R) * RW_SLOT, fr, kg, hv, dir);
            u32x4 fmak; fmak.x = 0u; fmak.y = 0u; fmak.z = cur.mak.x; fmak.w = cur.mak.y;
            const int row = chain_row(dir, b, 16 * n + fr);
#pragma unroll
            for (int q = 0; q < 2; ++q) {
                u32x4 fs[2];
#pragma unroll
                for (int sx = 0; sx < 2; ++sx) { fs[sx].x = pk2(ST[q][2 * sx][0], ST[q][2 * sx][1]); fs[sx].y = pk2(ST[q][2 * sx][2], ST[q][2 * sx][3]); fs[sx].z = pk2(ST[q][2 * sx + 1][0], ST[q][2 * sx + 1][1]); fs[sx].w = pk2(ST[q][2 * sx + 1][2], ST[q][2 * sx + 1][3]); }
                u32x2 vt = cur.vt[q]; if (dir) { const unsigned x = vt.x, y = vt.y; vt.x = (y >> 16) | (y << 16); vt.y = (x >> 16) | (x << 16); }
                u32x4 fuv; fuv.x = uvU[q][0]; fuv.y = uvU[q][1]; fuv.z = vt.x; fuv.w = vt.y;
                f32x4 U = (f32x4){0.f, 0.f, 0.f, 0.f};
                U = __builtin_amdgcn_mfma_f32_16x16x32_bf16(__builtin_bit_cast(bf16x8, cur.wp[0]), __builtin_bit_cast(bf16x8, fs[0]), U, 0, 0, 0);
                U = __builtin_amdgcn_mfma_f32_16x16x32_bf16(__builtin_bit_cast(bf16x8, cur.wp[1]), __builtin_bit_cast(bf16x8, fs[1]), U, 0, 0, 0);
                U = __builtin_amdgcn_mfma_f32_16x16x32_bf16(__builtin_bit_cast(bf16x8, fmak), __builtin_bit_cast(bf16x8, fuv), U, 0, 0, 0);
                uvU[q][0] = pk2(U[0], U[1]); uvU[q][1] = pk2(U[2], U[3]); fuv.x = uvU[q][0]; fuv.y = uvU[q][1];
                f32x4 OT = (f32x4){0.f, 0.f, 0.f, 0.f};
                OT = __builtin_amdgcn_mfma_f32_16x16x32_bf16(__builtin_bit_cast(bf16x8, fs[0]), __builtin_bit_cast(bf16x8, cur.rp[0]), OT, 0, 0, 0);
                OT = __builtin_amdgcn_mfma_f32_16x16x32_bf16(__builtin_bit_cast(bf16x8, fs[1]), __builtin_bit_cast(bf16x8, cur.rp[1]), OT, 0, 0, 0);
                OT = __builtin_amdgcn_mfma_f32_16x16x32_bf16(__builtin_bit_cast(bf16x8, fuv), __builtin_bit_cast(bf16x8, cur.arbk), OT, 0, 0, 0);
#pragma unroll
                for (int i = 0; i < 4; ++i) ST[q][i] = __builtin_amdgcn_mfma_f32_16x16x32_bf16(__builtin_bit_cast(bf16x8, cur.bk[i]), __builtin_bit_cast(bf16x8, fuv), ST[q][i] * cur.gam[i], 0, 0, 0);
                u32x2 o; o.x = pk2(OT[0], OT[1]); o.y = pk2(OT[2], OT[3]); *(u32x2*)(OC + ((size_t)dir * MALL + row) * CW + h * 64 + 16 * (2 * hv + q) + 4 * kg) = o;
            }
        }
    }
    asm volatile("s_waitcnt vmcnt(0)" ::: "memory");
    __builtin_amdgcn_s_barrier(); asm volatile("" ::: "memory");
}
#define LDS_BAR() do { asm volatile("s_waitcnt lgkmcnt(0)" ::: "memory"); __builtin_amdgcn_s_barrier(); asm volatile("" ::: "memory"); } while (0)
__device__ __forceinline__ void hgrn_prep_item(KArgs a, int l, int item, LAS unsigned char* lds, bool dry) {
    const int tid = tid_fresh();
    unsigned char* ws = a->ws;
    bf16* P = (bf16*)(ws + WS_P); bf16* HQB = (bf16*)(ws + WS_HQB); float* HG = (float*)(ws + WS_HG);
    const int cn = item % 68, bh = item / 68, h = bh % 6, b = bh / 6;
    const int row0 = cn < 4 ? NLAT + b * CTXL + 64 * cn : b * T + 64 * (cn - 4);
    constexpr int QP = 136;
    LAS bf16* SQ = (LAS bf16*)lds; LAS bf16* KF = SQ + 64 * QP; LAS bf16* KB = KF + 64 * QP; LAS bf16* QB = KB + 64 * QP;
    LAS float* LF = (LAS float*)(QB + 64 * QP); LAS float* LBk = LF + 64 * 128;
    LAS float* tot = LBk + 64 * 128;
    LAS float* lbs = tot + 1024;
    if (tid < 256) { const int dr = tid >> 7, ch = h * 128 + (tid & 127); float lb = 0.f;
        if (l != 0) { const float l0 = a->in[I_LB][((size_t)dr * DEPTH + 0) * BW + ch], l1 = a->in[I_LB][((size_t)dr * DEPTH + 1) * BW + ch]; lb = __builtin_amdgcn_rcpf(1.0f + __expf(l0 - l1)); }
        lbs[tid] = lb; }
    const int ta = tid >> 3, d0 = (tid & 7) * 16;
    bf16* prow = P + (size_t)(row0 + ta) * INC + h * 128 + d0;
    u32x4 rq[2], rf[2], rb[2];
    rq[0] = *(const u32x4*)(prow + OFF_Q); rq[1] = *(const u32x4*)(prow + OFF_Q + 8); rf[0] = *(const u32x4*)(prow + OFF_ZF); rf[1] = *(const u32x4*)(prow + OFF_ZF + 8); rb[0] = *(const u32x4*)(prow + OFF_ZB); rb[1] = *(const u32x4*)(prow + OFF_ZB + 8);
    __syncthreads();
#pragma unroll
    for (int hf = 0; hf < 2; ++hf) { float qf[8], zf[8], zb[8], oq[8], of[8], ob[8]; unpack8(rq[hf], qf); unpack8(rf[hf], zf); unpack8(rb[hf], zb);
        const int dd = d0 + 8 * hf; f32x4 lf0, lf1, lb0, lb1;
#pragma unroll
        for (int j = 0; j < 8; ++j) { const float lF = lbs[dd + j], lB = lbs[128 + dd + j];
            const float ff = lF + (1.0f - lF) * sigmoidf_(zf[j]), fb = lB + (1.0f - lB) * sigmoidf_(zb[j]);
            const float a1 = fmaxf(__logf(ff), -60.0f), a2 = fmaxf(__logf(fb), -60.0f);
            if (j < 4) { lf0[j] = a1; lb0[j] = a2; } else { lf1[j - 4] = a1; lb1[j - 4] = a2; }
            oq[j] = siluf_(qf[j]); of[j] = 1.0f - ff; ob[j] = 1.0f - fb; }
        *(LAS u32x4*)(SQ + ta * QP + dd) = pack8(oq); *(LAS u32x4*)(KF + ta * QP + dd) = pack8(of); *(LAS u32x4*)(KB + ta * QP + dd) = pack8(ob);
        *(LAS f32x4*)(LF + ta * 128 + dd) = lf0; *(LAS f32x4*)(LF + ta * 128 + dd + 4) = lf1; *(LAS f32x4*)(LBk + ta * 128 + dd) = lb0; *(LAS f32x4*)(LBk + ta * 128 + dd + 4) = lb1; }
    __syncthreads();
    { const int d = tid & 127, qt = tid >> 7; float r1 = 0.f, r2 = 0.f;
#pragma unroll
      for (int i = 0; i < 16; ++i) { const int tp = 16 * qt + i; r1 += LF[tp * 128 + d]; LF[tp * 128 + d] = r1; r2 += LBk[(63 - tp) * 128 + d]; LBk[(63 - tp) * 128 + d] = r2; }
      tot[qt * 128 + d] = r1; tot[512 + qt * 128 + d] = r2; }
    __syncthreads();
    LAS float* bas = lbs + 256;
    LAS float* bmd = bas + 1024;
    { const int d = tid & 127, dr = (tid >> 7) & 1; if (tid < 256) { const LAS float* tt = tot + 512 * dr; const float t0 = tt[d], t1 = tt[128 + d], t2 = tt[256 + d], t3 = tt[384 + d];
        bas[(dr * 4 + 0) * 128 + d] = 0.f; bas[(dr * 4 + 1) * 128 + d] = t0; bas[(dr * 4 + 2) * 128 + d] = t0 + t1; bas[(dr * 4 + 3) * 128 + d] = t0 + t1 + t2; bmd[dr * 128 + d] = t0 + t1;
        const int npr = dr == 0 ? cn : (cn < 4 ? 3 - cn : 4 + 63 - (cn - 4)); float* g = (dry ? (float*)(ws + WS_END + 8 * MiB) : HG) + ((size_t)(((dr * 8 + b) * 6 + h) * 68 + npr)) * 256; g[d] = __expf(t0 + t1); g[128 + d] = __expf(t2 + t3); } }
    __syncthreads();
#pragma unroll
    for (int hf = 0; hf < 2; ++hf) { const int dd = d0 + 8 * hf; float sq[8], kf[8], kb[8];
        unpack8(*(const LAS u32x4*)(SQ + ta * QP + dd), sq); unpack8(*(const LAS u32x4*)(KF + ta * QP + dd), kf); unpack8(*(const LAS u32x4*)(KB + ta * QP + dd), kb);
        float oqf[8], okf[8], oqb[8], okb[8];
#pragma unroll
        for (int dr = 0; dr < 2; ++dr) { const int tp = dr ? 63 - ta : ta, q = tp >> 4; const LAS float* pf = (dr ? LBk : LF) + ta * 128 + dd;
            const f32x4 p0 = *(const LAS f32x4*)pf, p1 = *(const LAS f32x4*)(pf + 4), b0 = *(const LAS f32x4*)(bas + (dr * 4 + q) * 128 + dd), b1 = *(const LAS f32x4*)(bas + (dr * 4 + q) * 128 + dd + 4),
                        m0 = *(const LAS f32x4*)(bmd + dr * 128 + dd), m1 = *(const LAS f32x4*)(bmd + dr * 128 + dd + 4);
#pragma unroll
            for (int j = 0; j < 8; ++j) { const float bt = (j < 4 ? p0[j] + b0[j] : p1[j - 4] + b1[j - 4]), bm = j < 4 ? m0[j] : m1[j - 4];
                const float eq = __expf(fminf(bt - bm, 80.0f)), ek = __expf(fminf(bm - bt, 80.0f));
                if (dr == 0) { oqf[j] = sq[j] * eq; okf[j] = kf[j] * ek; } else { oqb[j] = sq[j] * eq; okb[j] = kb[j] * ek; } } }
        *(LAS u32x4*)(QB + ta * QP + dd) = pack8(oqf); *(LAS u32x4*)(KF + ta * QP + dd) = pack8(okf); *(LAS u32x4*)(KB + ta * QP + dd) = pack8(okb); *(LAS u32x4*)(SQ + ta * QP + dd) = pack8(oqb); }
    bf16* prow_o = dry ? (bf16*)(ws + WS_END) + (size_t)((row0 + ta) & 511) * INC + h * 128 + d0 : prow; bf16* hqb_o = dry ? (bf16*)(ws + WS_END) : HQB;
#pragma unroll
    for (int hf = 0; hf < 2; ++hf) { const int dd = d0 + 8 * hf;
        *(u32x4*)(prow_o + OFF_Q + 8 * hf) = *(const LAS u32x4*)(QB + ta * QP + dd); *(u32x4*)(prow_o + OFF_ZF + 8 * hf) = *(const LAS u32x4*)(KF + ta * QP + dd); *(u32x4*)(prow_o + OFF_ZB + 8 * hf) = *(const LAS u32x4*)(KB + ta * QP + dd);
        *(u32x4*)(hqb_o + (size_t)(dry ? ((row0 + ta) & 1023) : (row0 + ta)) * BW + h * 128 + dd) = *(const LAS u32x4*)(SQ + ta * QP + dd); }
    __syncthreads();
}
__device__ __forceinline__ unsigned tr_addr(const LAS bf16* X, int pitch, int r0, int c0, int lane) { const int i = lane & 15, g = lane >> 4; return (unsigned)(size_t)(X + (r0 + 8 * g + (i >> 2)) * pitch + c0 + 4 * (i & 3)); }
__device__ __forceinline__ void tr8x4(u32x2 (&lo)[4], u32x2 (&hi)[4], unsigned a0, unsigned a1, unsigned a2, unsigned a3, unsigned rowstep4) {
    const unsigned b0 = a0 + rowstep4, b1 = a1 + rowstep4, b2 = a2 + rowstep4, b3 = a3 + rowstep4;
    asm volatile("ds_read_b64_tr_b16 %0, %8\n\tds_read_b64_tr_b16 %1, %9\n\tds_read_b64_tr_b16 %2, %10\n\tds_read_b64_tr_b16 %3, %11\n\t"
                 "ds_read_b64_tr_b16 %4, %12\n\tds_read_b64_tr_b16 %5, %13\n\tds_read_b64_tr_b16 %6, %14\n\tds_read_b64_tr_b16 %7, %15\n\ts_waitcnt lgkmcnt(0)"
                 : "=&v"(lo[0]), "=&v"(lo[1]), "=&v"(lo[2]), "=&v"(lo[3]), "=&v"(hi[0]), "=&v"(hi[1]), "=&v"(hi[2]), "=&v"(hi[3])
                 : "v"(a0), "v"(a1), "v"(a2), "v"(a3), "v"(b0), "v"(b1), "v"(b2), "v"(b3) : "memory");
}
__device__ __forceinline__ void tr_half(u32x2 (&vl)[8], u32x2 (&vh)[8], u32x2 (&xl)[2], u32x2 (&xh)[2], unsigned av, unsigned ak, unsigned ax) {
    asm volatile(
        "ds_read_b64_tr_b16 %0, %20\n\tds_read_b64_tr_b16 %1, %20 offset:32\n\tds_read_b64_tr_b16 %2, %20 offset:64\n\tds_read_b64_tr_b16 %3, %20 offset:96\n\t"
        "ds_read_b64_tr_b16 %4, %20 offset:128\n\tds_read_b64_tr_b16 %5, %20 offset:160\n\tds_read_b64_tr_b16 %6, %20 offset:192\n\tds_read_b64_tr_b16 %7, %20 offset:224\n\t"
        "ds_read_b64_tr_b16 %8, %20 offset:1088\n\tds_read_b64_tr_b16 %9, %20 offset:1120\n\tds_read_b64_tr_b16 %10, %20 offset:1152\n\tds_read_b64_tr_b16 %11, %20 offset:1184\n\t"
        "ds_read_b64_tr_b16 %12, %20 offset:1216\n\tds_read_b64_tr_b16 %13, %20 offset:1248\n\tds_read_b64_tr_b16 %14, %20 offset:1280\n\tds_read_b64_tr_b16 %15, %20 offset:1312\n\t"
        "ds_read_b64_tr_b16 %16, %21\n\tds_read_b64_tr_b16 %17, %22\n\tds_read_b64_tr_b16 %18, %21 offset:1088\n\tds_read_b64_tr_b16 %19, %22 offset:1088\n\ts_waitcnt lgkmcnt(0)"
        : "=&v"(vl[0]), "=&v"(vl[1]), "=&v"(vl[2]), "=&v"(vl[3]), "=&v"(vl[4]), "=&v"(vl[5]), "=&v"(vl[6]), "=&v"(vl[7]),
          "=&v"(vh[0]), "=&v"(vh[1]), "=&v"(vh[2]), "=&v"(vh[3]), "=&v"(vh[4]), "=&v"(vh[5]), "=&v"(vh[6]), "=&v"(vh[7]),
          "=&v"(xl[0]), "=&v"(xl[1]), "=&v"(xh[0]), "=&v"(xh[1])
        : "v"(av), "v"(ak), "v"(ax) : "memory");
}
__device__ __forceinline__ bf16x8 mk8(u32x2 lo, u32x2 hi) { u32x4 v; v.x = lo.x; v.y = lo.y; v.z = hi.x; v.w = hi.y; return __builtin_bit_cast(bf16x8, v); }
__device__ __forceinline__ void hgrn_chain_lean(KArgs a, int cid, LAS unsigned char* lds) {
    const int tid = tid_fresh(), lane = tid & 63, wave = tid >> 6, fr = lane & 15, fq = lane >> 4;
    unsigned char* ws = a->ws;
    const bf16* P = (const bf16*)(ws + WS_P); const bf16* HQB = (const bf16*)(ws + WS_HQB); const float* HG = (const float*)(ws + WS_HG); bf16* OB = (bf16*)(ws + WS_OB);
    const int dir = cid / 48, b = (cid % 48) / 6, h = cid % 6;
    constexpr int QP = 136, SP = 72;
    LAS bf16* qs = (LAS bf16*)lds;
    LAS bf16* ks = qs + 64 * QP;
    LAS bf16* vs = ks + 64 * QP;
    LAS bf16* pl = vs + 64 * QP;
    LAS bf16* sT = pl + 64 * SP;
    LAS float* gm = (LAS float*)(sT + 128 * QP);
    const int ta = tid >> 3, d0 = (tid & 7) * 16;
    const int koff = dir ? OFF_ZB : OFF_ZF;
    f32x4 S[8];
#pragma unroll
    for (int vt = 0; vt < 8; ++vt) S[vt] = (f32x4){0.f, 0.f, 0.f, 0.f};
    u32x4 rq[2], rk[2], rv[2]; float rg = 0.f;
    auto load_chunk = [&](int n) { const int row = chain_row(dir, b, 64 * n + ta); const bf16* pr = P + (size_t)row * INC + h * 128 + d0;
        const bf16* qr = dir ? HQB + (size_t)row * BW + h * 128 + d0 : pr + OFF_Q;
        rq[0] = *(const u32x4*)qr; rq[1] = *(const u32x4*)(qr + 8); rk[0] = *(const u32x4*)(pr + koff); rk[1] = *(const u32x4*)(pr + koff + 8); rv[0] = *(const u32x4*)(pr + OFF_I); rv[1] = *(const u32x4*)(pr + OFF_I + 8);
        if (tid < 256) rg = HG[((size_t)(((dir * 8 + b) * 6 + h) * 68 + n)) * 256 + tid]; };
    load_chunk(0);
    constexpr int NCH = (CTXL + T) / 64;
    for (int n = 0; n < NCH; ++n) {
        const int s0 = n * 64;
        *(LAS u32x4*)(qs + ta * QP + d0) = rq[0]; *(LAS u32x4*)(qs + ta * QP + d0 + 8) = rq[1]; *(LAS u32x4*)(ks + ta * QP + d0) = rk[0]; *(LAS u32x4*)(ks + ta * QP + d0 + 8) = rk[1];
        *(LAS u32x4*)(vs + ta * QP + d0) = rv[0]; *(LAS u32x4*)(vs + ta * QP + d0 + 8) = rv[1]; if (tid < 256) gm[tid] = rg;
        if (n + 1 < NCH) load_chunk(n + 1);
        LDS_BAR();
        { const f32x4 g4 = *(const LAS f32x4*)(gm + 16 * wave + 4 * fq);
#pragma unroll
          for (int vt = 0; vt < 8; ++vt) { S[vt] = S[vt] * g4; u32x2 o; o.x = pk2(S[vt][0], S[vt][1]); o.y = pk2(S[vt][2], S[vt][3]); *(LAS u32x2*)(sT + (16 * vt + fr) * QP + 16 * wave + 4 * fq) = o; } }
        { const int tt = wave >> 1;
#pragma unroll
          for (int u = 0; u < 2; ++u) { const int sg = 2 * (wave & 1) + u; f32x4 acc = (f32x4){0.f, 0.f, 0.f, 0.f};
              if (sg <= tt) {
#pragma unroll
                  for (int kq = 0; kq < 4; ++kq) { const bf16x8 af = *(const LAS bf16x8*)(ks + (16 * sg + fr) * QP + 32 * kq + 8 * fq), bfm = *(const LAS bf16x8*)(qs + (16 * tt + fr) * QP + 32 * kq + 8 * fq);
                      acc = __builtin_amdgcn_mfma_f32_16x16x32_bf16(af, bfm, acc, 0, 0, 0); }
                  if (sg == tt) {
#pragma unroll
                      for (int j = 0; j < 4; ++j) if (4 * fq + j > fr) acc[j] = 0.f; }
              }
              u32x2 o; o.x = pk2(acc[0], acc[1]); o.y = pk2(acc[2], acc[3]); *(LAS u32x2*)(pl + (16 * tt + fr) * SP + 16 * sg + 4 * fq) = o; } }
        LDS_BAR();
        f32x4 oacc[4];
#pragma unroll
        for (int tt = 0; tt < 4; ++tt) { f32x4 acc = (f32x4){0.f, 0.f, 0.f, 0.f};
#pragma unroll
            for (int kq = 0; kq < 4; ++kq) { const bf16x8 af = *(const LAS bf16x8*)(sT + (16 * wave + fr) * QP + 32 * kq + 8 * fq), bfm = *(const LAS bf16x8*)(qs + (16 * tt + fr) * QP + 32 * kq + 8 * fq);
                acc = __builtin_amdgcn_mfma_f32_16x16x32_bf16(af, bfm, acc, 0, 0, 0); }
            oacc[tt] = acc; }
        const unsigned rs4 = (unsigned)(4 * QP * 2);
#pragma unroll
        for (int kq = 0; kq < 2; ++kq) {
            u32x2 vl_[8], vh_[8], xl_[2], xh_[2];
            static_assert(QP == 136, "tr_half's immediates assume 272-byte rows");
            tr_half(vl_, vh_, xl_, xh_, tr_addr(vs, QP, 32 * kq, 0, lane), tr_addr(ks, QP, 32 * kq, 16 * wave, lane), tr_addr(vs, QP, 32 * kq, 16 * wave, lane));
            __builtin_amdgcn_sched_barrier(0);
            { const bf16x8 af = mk8(xl_[1], xh_[1]);
#pragma unroll
              for (int tt = 0; tt < 4; ++tt) { const bf16x8 bfm = *(const LAS bf16x8*)(pl + (16 * tt + fr) * SP + 32 * kq + 8 * fq); oacc[tt] = __builtin_amdgcn_mfma_f32_16x16x32_bf16(af, bfm, oacc[tt], 0, 0, 0); } }
            { const bf16x8 af = mk8(xl_[0], xh_[0]);
#pragma unroll
              for (int vt = 0; vt < 8; ++vt) S[vt] = __builtin_amdgcn_mfma_f32_16x16x32_bf16(af, mk8(vl_[vt], vh_[vt]), S[vt], 0, 0, 0); }
        }
#pragma unroll
        for (int tt = 0; tt < 4; ++tt) { const int row = chain_row(dir, b, s0 + 16 * tt + fr);
            u32x2 o; o.x = pk2(oacc[tt][0], oacc[tt][1]); o.y = pk2(oacc[tt][2], oacc[tt][3]); *(u32x2*)(OB + ((size_t)dir * MALL + row) * BW + h * 128 + 16 * wave + 4 * fq) = o; }
        { const f32x4 ge = *(const LAS f32x4*)(gm + 128 + 16 * wave + 4 * fq);
#pragma unroll
          for (int vt = 0; vt < 8; ++vt) S[vt] = S[vt] * ge; }
        LDS_BAR();
    }
}
__device__ __forceinline__ void hgrn_chain_mfma(KArgs a, int l, int cid, LAS unsigned char* lds) {
    const int tid = tid_fresh(), lane = tid & 63, wave = tid >> 6, fr = lane & 15, fq = lane >> 4;
    unsigned char* ws = a->ws;
    const bf16* P = (const bf16*)(ws + WS_P); bf16* OB = (bf16*)(ws + WS_OB);
    const int dir = cid / 48, b = (cid % 48) / 6, h = cid % 6;
    constexpr int QP = 136, SP = 72;
    LAS bf16* qs = (LAS bf16*)lds;
    LAS bf16* ks = qs + 64 * QP;
    LAS bf16* kT = ks + 64 * QP;
    LAS bf16* vT = kT + 128 * SP;
    LAS bf16* pl = vT + 128 * SP;
    LAS bf16* sT = pl + 64 * SP;
    LAS float* tot = (LAS float*)(sT + 128 * QP);
    LAS float* gmid = tot + 512;
    LAS float* gend = gmid + 128;
    LAS float* lbs = gend + 128;
    LAS float* lfb = (LAS float*)sT;
    const int d = tid & 127, qt = tid >> 7;
    const int tau_a = tid >> 3, d0 = (tid & 7) * 16;
    if (tid < 128) { const int ch = h * 128 + tid; float lb = 0.f;
        if (l != 0) { const float l0 = a->in[I_LB][((size_t)dir * DEPTH + 0) * BW + ch], l1 = a->in[I_LB][((size_t)dir * DEPTH + 1) * BW + ch]; lb = 1.0f / (1.0f + __expf(l0 - l1)); }
        lbs[tid] = lb; }
    f32x4 S[8];
#pragma unroll
    for (int vt = 0; vt < 8; ++vt) S[vt] = (f32x4){0.f, 0.f, 0.f, 0.f};
    const int zoff = dir ? OFF_ZB : OFF_ZF;
    u32x4 rq[2], ri[2], rz[2];
    { const bf16* pr = P + (size_t)chain_row(dir, b, tau_a) * INC + h * 128 + d0;
      rq[0] = *(const u32x4*)(pr + OFF_Q); rq[1] = *(const u32x4*)(pr + OFF_Q + 8); ri[0] = *(const u32x4*)(pr + OFF_I); ri[1] = *(const u32x4*)(pr + OFF_I + 8); rz[0] = *(const u32x4*)(pr + zoff); rz[1] = *(const u32x4*)(pr + zoff + 8); }
    __syncthreads();
    constexpr int NCH = (CTXL + T) / 64;
    for (int n = 0; n < NCH; ++n) {
        const int s0 = n * 64;
#pragma unroll
        for (int hf = 0; hf < 2; ++hf) { float qf[8], zf[8], oq[8], ok[8]; unpack8(rq[hf], qf); unpack8(rz[hf], zf);
            const int dd = d0 + 8 * hf; const f32x4 lb0 = *(const LAS f32x4*)(lbs + dd), lb1 = *(const LAS f32x4*)(lbs + dd + 4); f32x4 lf0, lf1;
#pragma unroll
            for (int j = 0; j < 8; ++j) { const float lb = j < 4 ? lb0[j] : lb1[j - 4]; const float f = lb + (1.0f - lb) * sigmoidf_(zf[j]); const float lf = fmaxf(__logf(f), -60.0f);
                if (j < 4) lf0[j] = lf; else lf1[j - 4] = lf; oq[j] = siluf_(qf[j]); ok[j] = 1.0f - f; }
            *(LAS u32x4*)(qs + tau_a * QP + dd) = pack8(oq); *(LAS u32x4*)(ks + tau_a * QP + dd) = pack8(ok);
            *(LAS f32x4*)(lfb + tau_a * 128 + dd) = lf0; *(LAS f32x4*)(lfb + tau_a * 128 + dd + 4) = lf1;
            const u32x4 vv = ri[hf];
            vT[(dd + 0) * SP + tau_a] = (bf16)(vv.x & 0xffffu); vT[(dd + 1) * SP + tau_a] = (bf16)(vv.x >> 16); vT[(dd + 2) * SP + tau_a] = (bf16)(vv.y & 0xffffu); vT[(dd + 3) * SP + tau_a] = (bf16)(vv.y >> 16);
            vT[(dd + 4) * SP + tau_a] = (bf16)(vv.z & 0xffffu); vT[(dd + 5) * SP + tau_a] = (bf16)(vv.z >> 16); vT[(dd + 6) * SP + tau_a] = (bf16)(vv.w & 0xffffu); vT[(dd + 7) * SP + tau_a] = (bf16)(vv.w >> 16); }
        if (n + 1 < NCH) { const bf16* pr = P + (size_t)chain_row(dir, b, s0 + 64 + tau_a) * INC + h * 128 + d0;
            rq[0] = *(const u32x4*)(pr + OFF_Q); rq[1] = *(const u32x4*)(pr + OFF_Q + 8); ri[0] = *(const u32x4*)(pr + OFF_I); ri[1] = *(const u32x4*)(pr + OFF_I + 8); rz[0] = *(const u32x4*)(pr + zoff); rz[1] = *(const u32x4*)(pr + zoff + 8); }
        LDS_BAR();
        float cs[16];
        { float run = 0.f;
#pragma unroll
          for (int i = 0; i < 16; ++i) { run += lfb[(16 * qt + i) * 128 + d]; cs[i] = run; }
          tot[qt * 128 + d] = run; }
        LDS_BAR();
        { const float t0 = tot[d], t1 = tot[128 + d], t2 = tot[256 + d], t3 = tot[384 + d];
          const float bmid = t0 + t1, btot = bmid + t2 + t3; const float base = (qt > 0 ? t0 : 0.f) + (qt > 1 ? t1 : 0.f) + (qt > 2 ? t2 : 0.f);
          if (qt == 0) { gmid[d] = __expf(bmid); gend[d] = __expf(btot - bmid); }
#pragma unroll
          for (int i = 0; i < 16; ++i) { const int tau = 16 * qt + i; const float bt = base + cs[i];
              const float eq = __expf(fminf(bt - bmid, 80.0f)), ek = __expf(fminf(bmid - bt, 80.0f));
              const bf16 qb = (bf16)f2bf(bf1(qs[tau * QP + d]) * eq), kb = (bf16)f2bf(bf1(ks[tau * QP + d]) * ek);
              qs[tau * QP + d] = qb; ks[tau * QP + d] = kb; kT[d * SP + tau] = kb; } }
        LDS_BAR();
        { const f32x4 gm = *(const LAS f32x4*)(gmid + 16 * wave + 4 * fq);
#pragma unroll
          for (int vt = 0; vt < 8; ++vt) { S[vt] = S[vt] * gm; u32x2 o; o.x = pk2(S[vt][0], S[vt][1]); o.y = pk2(S[vt][2], S[vt][3]); *(LAS u32x2*)(sT + (16 * vt + fr) * QP + 16 * wave + 4 * fq) = o; } }
        { const int tt = wave >> 1;
#pragma unroll
          for (int u = 0; u < 2; ++u) { const int sg = 2 * (wave & 1) + u; f32x4 acc = (f32x4){0.f, 0.f, 0.f, 0.f};
              if (sg <= tt) {
#pragma unroll
                  for (int kq = 0; kq < 4; ++kq) { const bf16x8 af = *(const LAS bf16x8*)(ks + (16 * sg + fr) * QP + 32 * kq + 8 * fq), bfm = *(const LAS bf16x8*)(qs + (16 * tt + fr) * QP + 32 * kq + 8 * fq);
                      acc = __builtin_amdgcn_mfma_f32_16x16x32_bf16(af, bfm, acc, 0, 0, 0); }
                  if (sg == tt) {
#pragma unroll
                      for (int j = 0; j < 4; ++j) if (4 * fq + j > fr) acc[j] = 0.f; }
              }
              u32x2 o; o.x = pk2(acc[0], acc[1]); o.y = pk2(acc[2], acc[3]); *(LAS u32x2*)(pl + (16 * tt + fr) * SP + 16 * sg + 4 * fq) = o; } }
        LDS_BAR();
#pragma unroll
        for (int tt = 0; tt < 4; ++tt) { f32x4 acc = (f32x4){0.f, 0.f, 0.f, 0.f};
#pragma unroll
            for (int kq = 0; kq < 2; ++kq) { const bf16x8 af = *(const LAS bf16x8*)(vT + (16 * wave + fr) * SP + 32 * kq + 8 * fq), bfm = *(const LAS bf16x8*)(pl + (16 * tt + fr) * SP + 32 * kq + 8 * fq);
                acc = __builtin_amdgcn_mfma_f32_16x16x32_bf16(af, bfm, acc, 0, 0, 0); }
#pragma unroll
            for (int kq = 0; kq < 4; ++kq) { const bf16x8 af = *(const LAS bf16x8*)(sT + (16 * wave + fr) * QP + 32 * kq + 8 * fq), bfm = *(const LAS bf16x8*)(qs + (16 * tt + fr) * QP + 32 * kq + 8 * fq);
                acc = __builtin_amdgcn_mfma_f32_16x16x32_bf16(af, bfm, acc, 0, 0, 0); }
            const int row = chain_row(dir, b, s0 + 16 * tt + fr);
            u32x2 o; o.x = pk2(acc[0], acc[1]); o.y = pk2(acc[2], acc[3]); *(u32x2*)(OB + ((size_t)dir * MALL + row) * BW + h * 128 + 16 * wave + 4 * fq) = o; }
        { const f32x4 ge = *(const LAS f32x4*)(gend + 16 * wave + 4 * fq);
#pragma unroll
          for (int kq = 0; kq < 2; ++kq) { const bf16x8 af = *(const LAS bf16x8*)(kT + (16 * wave + fr) * SP + 32 * kq + 8 * fq);
#pragma unroll
              for (int vt = 0; vt < 8; ++vt) { const bf16x8 bfm = *(const LAS bf16x8*)(vT + (16 * vt + fr) * SP + 32 * kq + 8 * fq); S[vt] = __builtin_amdgcn_mfma_f32_16x16x32_bf16(af, bfm, S[vt], 0, 0, 0); } }
#pragma unroll
          for (int vt = 0; vt < 8; ++vt) S[vt] = S[vt] * ge; }
        LDS_BAR();
    }
}
__device__ __forceinline__ void hgrn_chain(KArgs a, int l, int cid, LAS unsigned char* lds) {
    const int tid = tid_fresh();
    unsigned char* ws = a->ws;
    const bf16* P = (const bf16*)(ws + WS_P); bf16* OB = (bf16*)(ws + WS_OB);
    const int dir = cid / 48, b = (cid % 48) / 6, h = cid % 6;
    LAS float* tq = (LAS float*)lds;
    LAS float* tk = tq + 16 * 128;
    LAS float* tf = tk + 16 * 128;
    LAS float* tv = tf + 16 * 128;
    LAS float* ot = tv + 16 * 128;
    const int v = tid >> 2, q = tid & 3;
    float S[32];
#pragma unroll
    for (int j = 0; j < 32; ++j) S[j] = 0.f;
    const int sst = tid >> 5, sc4 = (tid & 31) * 4;
    float lb[4];
#pragma unroll
    for (int j = 0; j < 4; ++j) { const int ch = h * 128 + sc4 + j;
        if (l == 0) lb[j] = 0.f; else { const float l0 = a->in[I_LB][((size_t)dir * DEPTH + 0) * BW + ch], l1 = a->in[I_LB][((size_t)dir * DEPTH + 1) * BW + ch]; lb[j] = 1.0f / (1.0f + __expf(l0 - l1)); } }
    for (int s0 = 0; s0 < CTXL + T; s0 += 16) {
        { const int row = chain_row(dir, b, s0 + sst); const bf16* pr = P + (size_t)row * INC + h * 128 + sc4;
          const u32x2 pq = *(const u32x2*)(pr + OFF_Q), pi = *(const u32x2*)(pr + OFF_I), pz = *(const u32x2*)(pr + (dir ? OFF_ZB : OFF_ZF));
          const float qf[4] = {bflo(pq.x), bfhi(pq.x), bflo(pq.y), bfhi(pq.y)}, vf[4] = {bflo(pi.x), bfhi(pi.x), bflo(pi.y), bfhi(pi.y)}, zf[4] = {bflo(pz.x), bfhi(pz.x), bflo(pz.y), bfhi(pz.y)};
          f32x4 oq, ok, of, ov;
#pragma unroll
          for (int j = 0; j < 4; ++j) { const float f = lb[j] + (1.0f - lb[j]) * sigmoidf_(zf[j]); oq[j] = siluf_(qf[j]); of[j] = f; ok[j] = 1.0f - f; ov[j] = vf[j]; }
          *(LAS f32x4*)(tq + sst * 128 + sc4) = oq; *(LAS f32x4*)(tk + sst * 128 + sc4) = ok; *(LAS f32x4*)(tf + sst * 128 + sc4) = of; *(LAS f32x4*)(tv + sst * 128 + sc4) = ov; }
        LDS_BAR();
        for (int st = 0; st < 16; ++st) {
            const float vv = tv[st * 128 + v]; float o0 = 0.f, o1 = 0.f;
#pragma unroll
            for (int j = 0; j < 8; ++j) { const f32x4 fq4 = *(const LAS f32x4*)(tf + st * 128 + q * 32 + 4 * j), kq4 = *(const LAS f32x4*)(tk + st * 128 + q * 32 + 4 * j), qq4 = *(const LAS f32x4*)(tq + st * 128 + q * 32 + 4 * j);
#pragma unroll
                for (int i = 0; i < 4; ++i) { const float sn = fq4[i] * S[4 * j + i] + kq4[i] * vv; S[4 * j + i] = sn; if (i & 1) o1 += qq4[i] * sn; else o0 += qq4[i] * sn; } }
            float o = o0 + o1; o += dpp_xor1(o); o += dpp_xor2(o);
            if (q == 0) ot[st * 128 + v] = o;
        }
        LDS_BAR();
        if (tid < 256) { const int st = tid >> 4, part = tid & 15; const int row = chain_row(dir, b, s0 + st); const LAS float* op = ot + st * 128 + part * 8;
            float f[8];
#pragma unroll
            for (int j = 0; j < 8; ++j) f[j] = op[j];
            *(u32x4*)(OB + ((size_t)dir * MALL + row) * BW + h * 128 + part * 8) = pack8(f); }
    }
    LDS_BAR();
}

__device__ __forceinline__ float grp_sum32(float v) { v += __shfl_xor(v, 1); v += __shfl_xor(v, 2); v += __shfl_xor(v, 4); v += __shfl_xor(v, 8); v += __shfl_xor(v, 16); return v; }
__device__ __forceinline__ float grp_sum16(float v) { v += __shfl_xor(v, 1); v += __shfl_xor(v, 2); v += __shfl_xor(v, 4); v += __shfl_xor(v, 8); return v; }
__device__ __forceinline__ void phase_finalize(KArgs a, int l, bool dry) {
    const int tid_ = tid_fresh(); const int lane = tid_ & 63, wave = tid_ >> 6, gw = blockIdx.x * 8 + wave, NGW = gridDim.x * 8;
    unsigned char* ws = a->ws;
    const bf16* P = (const bf16*)(ws + WS_P); const bf16* OB = (const bf16*)(ws + WS_OB); const bf16* OC = (const bf16*)(ws + WS_OC); bf16* Y = (bf16*)(ws + WS_Y);
    bf16* Yo = dry ? (bf16*)(ws + WS_END) : Y;
    const int nrows = (l == DEPTH - 1) ? NLAT : MALL;
    const int rpw = (nrows + NGW - 1) / NGW; const int r0 = gw * rpw, r1 = (r0 + rpw < nrows) ? r0 + rpw : nrows;
    f32x4 hng[3], gng[3], gnb[3];
#pragma unroll
    for (int k = 0; k < 3; ++k) { const int c = 256 * k + 4 * lane; hng[k] = *(const f32x4*)(a->in[I_HNG] + (size_t)l * BW + c);
        gng[k] = *(const f32x4*)(a->in[I_GNGG] + (size_t)l * CW + c); gnb[k] = *(const f32x4*)(a->in[I_GNB] + (size_t)l * CW + c); }
    for (int row = r0; row < r1; ++row) {
        const int orow = dry ? (row & 2047) : row;
        u32x2 bf_[3], bb_[3], bg_[3], cf_[3], cb_[3], cv_[3], cg_[3];
#pragma unroll
        for (int k = 0; k < 3; ++k) { const int c = 256 * k + 4 * lane;
            bf_[k] = *(const u32x2*)(OB + (size_t)row * BW + c); bb_[k] = *(const u32x2*)(OB + ((size_t)MALL + row) * BW + c); bg_[k] = *(const u32x2*)(P + (size_t)row * INC + OFF_OG + c);
            cf_[k] = *(const u32x2*)(OC + (size_t)row * CW + c); cb_[k] = *(const u32x2*)(OC + ((size_t)MALL + row) * CW + c);
            cv_[k] = *(const u32x2*)(Y + (size_t)row * D + 512 + c);
            cg_[k] = *(const u32x2*)(Y + (size_t)row * D + 1280 + c); }
#pragma unroll
        for (int k = 0; k < 3; ++k) { const int c = 256 * k + 4 * lane;
            { float o[4] = {bflo(bf_[k].x) + bflo(bb_[k].x), bfhi(bf_[k].x) + bfhi(bb_[k].x), bflo(bf_[k].y) + bflo(bb_[k].y), bfhi(bf_[k].y) + bfhi(bb_[k].y)};
              const float ss = grp_sum32((o[0] * o[0] + o[1] * o[1]) + (o[2] * o[2] + o[3] * o[3])); const float rstd = 1.0f / sqrtf(ss * (1.0f / 128.0f) + NORM_EPS);
              const float g4[4] = {bflo(bg_[k].x), bfhi(bg_[k].x), bflo(bg_[k].y), bfhi(bg_[k].y)}; float y[4];
#pragma unroll
              for (int j = 0; j < 4; ++j) y[j] = o[j] * rstd * hng[k][j] * sigmoidf_(g4[j]);
              u32x2 q; q.x = pk2(y[0], y[1]); q.y = pk2(y[2], y[3]); *(u32x2*)(Yo + (size_t)orow * D + 512 + c) = q; }
            { float o[4] = {bflo(cf_[k].x) + bflo(cb_[k].x), bfhi(cf_[k].x) + bfhi(cb_[k].x), bflo(cf_[k].y) + bflo(cb_[k].y), bfhi(cf_[k].y) + bfhi(cb_[k].y)};
              const float v4[4] = {bflo(cv_[k].x), bfhi(cv_[k].x), bflo(cv_[k].y), bfhi(cv_[k].y)}, g4[4] = {bflo(cg_[k].x), bfhi(cg_[k].x), bflo(cg_[k].y), bfhi(cg_[k].y)};
              const float mean = grp_sum16((o[0] + o[1]) + (o[2] + o[3])) * (1.0f / 64.0f);
              float dl[4]; float sq = 0.f;
#pragma unroll
              for (int j = 0; j < 4; ++j) { dl[j] = o[j] - mean; sq += dl[j] * dl[j]; }
              const float var = grp_sum16(sq) * (1.0f / 64.0f); const float rs = 1.0f / sqrtf(var + GN_EPS); float y[4];
#pragma unroll
              for (int j = 0; j < 4; ++j) y[j] = (dl[j] * rs * gng[k][j] + gnb[k][j] + v4[j]) * g4[j];
              u32x2 q; q.x = pk2(y[0], y[1]); q.y = pk2(y[2], y[3]); *(u32x2*)(Yo + (size_t)orow * D + 1280 + c) = q; }
        }
    }
}

__global__ void __launch_bounds__(NTHREADS, 2) mk_fwd(Args args_unused) {
    extern __shared__ __attribute__((aligned(16))) unsigned char lds_raw[];
    LAS unsigned char* lds = (LAS unsigned char*)lds_raw;
    volatile LAS unsigned* misc = (volatile LAS unsigned*)(lds + LDS_MISC);
    const int tid = threadIdx.x, G = gridDim.x;
    if (tid < 64) misc[tid] = 0u;
    __syncthreads();
    XcdBarrier bar; bar.bar = nullptr; bar.x = 0; bar.st = nullptr;
    int lo, hi;
    { KArgs a = kargs(); lo = a->ph_lo; hi = a->ph_hi; unsigned* ctl = (unsigned*)(a->ws + WS_CTL); bar.bar = ctl + CW_BAR; if (!MK_MULTI) bar = xcd_barrier_post(ctl + CW_BAR, misc + 8); }
    const int cvirt = (G % 8 == 0) ? ((int)blockIdx.x % 8) * (G / 8) + (int)blockIdx.x / 8 : (int)blockIdx.x;
#define IN(k) (lo <= (k) && (k) < hi)
#define PM(b) ((PHMASK >> (b)) & 1)
#define REP(b) _Pragma("unroll 1") for (int rep_ = 0; rep_ < 1 + ((PROBE_DUP >> (b)) & 1); ++rep_)
#define SEAM(k) do { if (!MK_MULTI && IN(k) && IN((k) + 1)) { xcd_barrier(bar); if ((PROBE_DUP >> 13) & 1) xcd_barrier(bar); } } while (0)

    if (PM(0) && IN(0)) REP(0) { phase_prologue(kargs(), lds); } SEAM(0);

#pragma unroll 1
    for (int l = 0; l < DEPTH; ++l) {
        const int pb = 1 + 9 * l;
        const bool lastl = (l == DEPTH - 1);
        if (PM(1) && IN(pb + 0)) { if ((PROBE_DUP >> 1) & 1) { if (l == 0) phase_norm1<0>(kargs(), l, true); else phase_norm1<1>(kargs(), l, true); } if (l == 0) phase_norm1<0>(kargs(), l, false); else { phase_norm1<1>(kargs(), l, false); __syncthreads(); convert_moe(kargs(), l, lds); __syncthreads(); } } SEAM(pb + 0);
        if (PM(2) && IN(pb + 1)) REP(2) {
            KArgs a = kargs(); unsigned char* ws = a->ws;
            pg8::Gemm g{(const bf16*)(ws + WS_H), (const bf16*)(ws + WS_WIN) + (size_t)l * INC * D, MALL, INC, D};
            pg8::StaticOrder S; S.init(MALL, INC, G, (int)blockIdx.x);
            pg8::EpiBf16 E{(bf16*)(ws + WS_P), INC};
            pg8::gemm_phase<pg8::EpiBf16, pg8::StaticOrder, false, false>(lds, g, S, E, nullptr);
        } SEAM(pb + 1);
        if (PM(3) && IN(pb + 2)) {
            const int ngm = lastl ? 1024 : 1088;
            unsigned* qhead = (unsigned*)(kargs()->ws + WS_CTL) + CW_PREPQ + 64 * l;
            const int n_rw = 544 * 3, n_hg = 3264, n_all = (G == 256) ? n_rw + n_hg : n_rw + n_hg + ngm;
            for (;;) {
                if (threadIdx.x == 0) misc[16] = __hip_atomic_fetch_add(qhead, 1u, __ATOMIC_RELAXED, __HIP_MEMORY_SCOPE_AGENT);
                __syncthreads();
                const int it = (int)misc[16];
                if (it >= n_all) break;
                if (it < n_rw) { _Pragma("unroll 1") for (int r2 = 0; r2 < 1 + ((PROBE_DUP >> 15) & 1); ++r2) rwkv_prep_item(kargs(), l, it / 3, it % 3, lds); }
                else if (it < n_rw + n_hg) { if ((PROBE_DUP >> 16) & 1) hgrn_prep_item(kargs(), l, it - n_rw, lds, true); hgrn_prep_item(kargs(), l, it - n_rw, lds, false); }
                else { _Pragma("unroll 1") for (int r2 = 0; r2 < 1 + ((PROBE_DUP >> 14) & 1); ++r2) gmlp_item(kargs(), l, it - n_rw - n_hg, lds); }
            }
            __syncthreads();
        } SEAM(pb + 2);
        if (PM(4) && IN(pb + 3)) REP(4) {
            if (G == 256) { const int bx = blockIdx.x;
                if (bx < 96) { _Pragma("unroll 1") for (int r2 = 0; r2 < 1 + ((PROBE_DUP >> 12) & 1); ++r2) rwkv_chain_mfma(kargs(), bx * 8, lds); }
                else if (bx < 192) { _Pragma("unroll 1") for (int r2 = 0; r2 < 1 + ((PROBE_DUP >> 11) & 1); ++r2) hgrn_chain_lean(kargs(), bx - 96, lds); }
                if (bx < 96 || bx >= 192) {
                    unsigned* gq = (unsigned*)(kargs()->ws + WS_CTL) + CW_GMQ + 64 * l; const int ngm2 = lastl ? 1024 : 1088;
                    for (;;) { if (threadIdx.x == 0) misc[17] = __hip_atomic_fetch_add(gq, 1u, __ATOMIC_RELAXED, __HIP_MEMORY_SCOPE_AGENT);
                        __syncthreads(); const int it = (int)misc[17]; if (it >= ngm2) break; gmlp_item(kargs(), l, it, lds); }
                    __syncthreads(); } }
            else { for (int it = blockIdx.x; it < 192; it += G) { if (it < 96) rwkv_chain_mfma(kargs(), it * 8, lds); else hgrn_chain_lean(kargs(), it - 96, lds); } }
        } SEAM(pb + 3);
        if (PM(5) && IN(pb + 4)) { if ((PROBE_DUP >> 5) & 1) phase_finalize(kargs(), l, true); phase_finalize(kargs(), l, false); } SEAM(pb + 4);
        if (PM(6) && IN(pb + 5)) REP(6) {
            KArgs a = kargs(); unsigned char* ws = a->ws;
            const int Mo = lastl ? NLAT : MALL;
            pg8::Gemm g{(const bf16*)(ws + WS_Y), (const bf16*)(ws + WS_WOUT) + (size_t)l * D * D, Mo, D, D};
            pg8::StaticOrder S; S.init(Mo, D, G, (int)blockIdx.x);
            const float* xl = l == 0 ? a->in[I_X] : (const float*)(ws + WS_X); const float* xc = l == 0 ? a->in[I_CTX] : (const float*)(ws + WS_X) + (size_t)NLAT * D;
            pg8::EpiResid E{xl, xc, (float*)(ws + WS_X), (const float*)(ws + WS_MOD) + (size_t)l * 9 * 12288 + 2 * D};
            pg8::gemm_phase<pg8::EpiResid, pg8::StaticOrder, true, false>(lds, g, S, E, nullptr);
        } SEAM(pb + 5);
        if (PM(7) && IN(pb + 6)) { if ((PROBE_DUP >> 7) & 1) phase_norm2_router(kargs(), l, true, lds); phase_norm2_router(kargs(), l, false, lds); } SEAM(pb + 6);
        if (PM(8) && IN(pb + 7)) REP(8) {
            KArgs a = kargs(); unsigned char* ws = a->ws;
            moe_tables<false>(a, l, lds, cvirt);
            pg8::Gemm g{(const bf16*)(ws + WS_H), (const bf16*)(ws + WS_WGU), 0, 2048, D};
            pg8::MoeOrder S{(const LAS int*)(lds + LDS_TP), G, cvirt, (unsigned)(2048 * D * 2)};
            pg8::EpiSwiglu E{(bf16*)(ws + WS_ACT)};
            pg8::gemm_phase<pg8::EpiSwiglu, pg8::MoeOrder, false, true>(lds, g, S, E, (const LAS unsigned*)(lds + LDS_TAB));
        } SEAM(pb + 7);
        if (PM(9) && IN(pb + 8)) REP(9) {
            KArgs a = kargs(); unsigned char* ws = a->ws;
            moe_tables<true>(a, l, lds, cvirt);
            pg8::Gemm g{(const bf16*)(ws + WS_ACT), (const bf16*)(ws + WS_WDN), 0, D, DE};
            pg8::MoeOrder S{(const LAS int*)(lds + LDS_TP), G, cvirt, (unsigned)(D * DE * 2)};
            pg8::EpiDown E{(bf16*)(ws + WS_YK), (const LAS unsigned*)(lds + LDS_TAB), (const LAS float*)(lds + LDS_TABW)};
            pg8::gemm_phase<pg8::EpiDown, pg8::MoeOrder, false, false>(lds, g, S, E, nullptr);
        } SEAM(pb + 8);
    }
    if (PM(10) && IN(1 + 9 * DEPTH)) { if ((PROBE_DUP >> 10) & 1) phase_norm1<2>(kargs(), DEPTH, true); phase_norm1<2>(kargs(), DEPTH, false); }
#undef IN
#undef SEAM
}

extern "C" void kernel_launch(void* const* d_in, const int* in_sizes, int n_in, void* d_out, int out_size, void* d_ws, size_t ws_size, hipStream_t stream) {
    static int grid = 0;
    if (grid == 0) {
        if (n_in != 31 || ws_size < WS_END) { fprintf(stderr, "kernel_launch: unexpected n_in %d / ws %zu (need %zu)\n", n_in, ws_size, (size_t)WS_END); grid = -1; return; }
        int dev = 0, cus = 0, per_cu = 0;
        hipGetDevice(&dev); hipDeviceGetAttribute(&cus, hipDeviceAttributeMultiprocessorCount, dev);
        if (hipFuncSetAttribute((const void*)mk_fwd, hipFuncAttributeMaxDynamicSharedMemorySize, LDS_BYTES) != hipSuccess) { fprintf(stderr, "kernel_launch: hipFuncSetAttribute failed\n"); grid = -1; return; }
        if (hipOccupancyMaxActiveBlocksPerMultiprocessor(&per_cu, (const void*)mk_fwd, NTHREADS, LDS_BYTES) != hipSuccess || per_cu < 1) fprintf(stderr, "kernel_launch: occupancy query says %d\n", per_cu);
        (void)hipGetLastError();
        grid = cus > 0 ? cus : 256;
    }
    if (grid < 0) return;
    hipMemsetAsync((char*)d_ws + WS_CTL, 0, CTL_ZERO_BYTES, stream);
    Args a{};
    for (int i = 0; i < 31; ++i) a.in[i] = (const float*)d_in[i];
    a.out = (float*)d_out; a.ws = (unsigned char*)d_ws;
    constexpr int NPH = 2 + 9 * DEPTH;
#if MK_MULTI
    for (int p = 0; p < NPH; ++p) { a.ph_lo = p; a.ph_hi = p + 1; hipLaunchKernelGGL(mk_fwd, dim3(grid), dim3(NTHREADS), LDS_BYTES, stream, a); }
#else
    a.ph_lo = 0; a.ph_hi = NPH; hipLaunchKernelGGL(mk_fwd, dim3(grid), dim3(NTHREADS), LDS_BYTES, stream, a);
#endif
}
```

```cpp
#include <hip/hip_runtime.h>
#include <cstdio>
#include <cstdint>

#ifndef PHMASK
#define PHMASK 0xFFFF
#endif
#ifndef PROBE_DUP
#define PROBE_DUP 0
#endif
#ifndef MK_MULTI
#define MK_MULTI 0
#endif

#define GAS __attribute__((address_space(1)))
#define LAS __attribute__((address_space(3)))
typedef unsigned short bf16;
typedef short bf16x8 __attribute__((ext_vector_type(8)));
typedef float f32x4 __attribute__((ext_vector_type(4)));
typedef float f32x2 __attribute__((ext_vector_type(2)));
typedef unsigned u32x4 __attribute__((ext_vector_type(4)));
typedef unsigned u32x2 __attribute__((ext_vector_type(2)));

constexpr int D = 2048, NB = 8, T = 4096, CTXL = 256, DEPTH = 2;
constexpr int NLAT = NB * T, NCTX = NB * CTXL, MALL = NLAT + NCTX;
constexpr int INC = 7424;
constexpr int OFF_U = 0, OFF_V = 512, OFF_Q = 1024, OFF_I = 1792, OFF_ZF = 2560, OFF_ZB = 3328, OFF_OG = 4096;
constexpr int OFF_C = 4864;
constexpr int BW = 768, CW = 768, CCOLS = 2560;
constexpr int NE = 16, DE = 1024;
constexpr int PC2W = 7 * 768;
constexpr int NTHREADS = 512;
constexpr float NORM_EPS = 1e-6f, GN_EPS = 64e-5f, DECAY_SCALE = 0.60653065971263342f;

constexpr size_t MiB = 1u << 20;
constexpr size_t WS_CTL = 0, CTL_ZERO_BYTES = 1 * MiB;
constexpr size_t WS_MOD = 1 * MiB;
constexpr size_t WS_SMALLW = 2 * MiB;
constexpr size_t SW_WUP = 0, SW_AUP = SW_WUP + (size_t)2 * 2 * 768 * 64 * 2, SW_GUP = SW_AUP + (size_t)2 * 768 * 64 * 2, SW_GWS = SW_GUP + (size_t)2 * 768 * 128 * 2;
constexpr size_t WS_WIN = 4 * MiB, WS_WOUT = 62 * MiB, WS_WGU = 78 * MiB, WS_WDN = 206 * MiB;
constexpr size_t WS_X = 270 * MiB, WS_H = 542 * MiB, WS_Y = 678 * MiB, WS_P = 814 * MiB, WS_PRE = 1307 * MiB, WS_VT = 1817 * MiB, WS_OC = 1868 * MiB, WS_HQB = 1970 * MiB, WS_HG = 2021 * MiB, WS_END = 2028 * MiB;
constexpr int PRE_REC = 10240, PR_WP = 0, PR_RP = 2048, PR_BK = 4096, PR_ARBK = 8192, PR_MAK = 9216, PR_GAM = 9728, NCHUNK16 = 272;
constexpr size_t WS_OB = WS_H;
constexpr size_t WS_ACT = WS_P, WS_YK = WS_P + 144 * MiB, WS_RIDX = WS_P + 416 * MiB, WS_RW = WS_RIDX + 3 * MiB;
static_assert(WS_RW + 3 * MiB <= WS_PRE, "moe overlay");
constexpr int MAXSLOT_TILES = 288;
constexpr int CW_BAR = 4096;
constexpr int CW_GMQ = 30720;
constexpr int CW_PREPQ = 28672;
constexpr int CW_CNT = 16384;

constexpr int LDS_STAGE = 0, LDS_TAB = 131072, LDS_TABW = LDS_TAB + 9 * 1024, LDS_TP = LDS_TABW + 9 * 1024, LDS_MISC = 150528, LDS_BYTES = 152 * 1024;
static_assert(LDS_TP + 128 <= LDS_MISC, "lds map");

typedef __bf16 bf16x2_t __attribute__((ext_vector_type(2)));
__device__ __forceinline__ unsigned pk2(float lo, float hi) { const f32x2 v = {lo, hi}; return __builtin_bit_cast(unsigned, __builtin_convertvector(v, bf16x2_t)); }
__device__ __forceinline__ unsigned f2bf(float f) { return pk2(f, f) & 0xffffu; }
__device__ __forceinline__ unsigned pk4_fp8(float a, float b, float c, float d) { int p = 0; p = __builtin_amdgcn_cvt_pk_fp8_f32(a, b, p, false); p = __builtin_amdgcn_cvt_pk_fp8_f32(c, d, p, true); return (unsigned)p; }
__device__ __forceinline__ float bflo(unsigned u) { return __builtin_bit_cast(float, u << 16); }
__device__ __forceinline__ float bfhi(unsigned u) { return __builtin_bit_cast(float, u & 0xffff0000u); }
__device__ __forceinline__ float bf1(bf16 b) { return __builtin_bit_cast(float, ((unsigned)b) << 16); }
__device__ __forceinline__ float sigmoidf_(float x) { return __builtin_amdgcn_rcpf(1.0f + __expf(-x)); }
__device__ __forceinline__ float siluf_(float x) { return x * __builtin_amdgcn_rcpf(1.0f + __expf(-x)); }
__device__ __forceinline__ float geluf_(float v) {
    const float av = fabsf(v), t = __builtin_amdgcn_rcpf(av * 0.2316418882f + 1.0f);
    float q = t * 0.5307027145f + (-0.7265760135f); q = q * t + 0.7107068705f; q = q * t + (-0.142248368f); q = q * t + 0.127414796f; q = q * t;
    const float e = __builtin_amdgcn_exp2f((v * v) * (-0.72134752044f)); const float m = v * (q * e); return v < 0.f ? m : v - m; }
__device__ __forceinline__ float wave_sum(float v) {
#pragma unroll
    for (int o = 1; o < 64; o <<= 1) v += __shfl_xor(v, o);
    return v;
}
__device__ __forceinline__ int tid_fresh() { int t = threadIdx.x; asm volatile("" : "+v"(t)); return t; }
__device__ __forceinline__ void unpack8(const u32x4 v, float (&f)[8]) {
    f[0] = bflo(v.x); f[1] = bfhi(v.x); f[2] = bflo(v.y); f[3] = bfhi(v.y); f[4] = bflo(v.z); f[5] = bfhi(v.z); f[6] = bflo(v.w); f[7] = bfhi(v.w);
}
__device__ __forceinline__ u32x4 pack8(const float (&f)[8]) { u32x4 v; v.x = pk2(f[0], f[1]); v.y = pk2(f[2], f[3]); v.z = pk2(f[4], f[5]); v.w = pk2(f[6], f[7]); return v; }
__device__ __forceinline__ int modrow_of(int row) { return row < NLAT ? (row >> 12) : 8; }

#define XB_TMO      128
#define XB_XCNT(j)  (256  + 64 * (j))
#define XB_XSUB(j)  (1280 + 64 * (j))
#define XB_XGEN(j)  (2304 + 64 * (j))
#define XB_TOP      3328
#define XB_TOPGEN   3392
#define XCD_BAR_WORDS 3456
#define XB_SPIN_CAP (1u << 18)
__device__ __forceinline__ unsigned xb_ld(unsigned* p)              { return __hip_atomic_load(p, __ATOMIC_RELAXED, __HIP_MEMORY_SCOPE_AGENT); }
__device__ __forceinline__ unsigned xb_add(unsigned* p, unsigned v) { return __hip_atomic_fetch_add(p, v, __ATOMIC_RELAXED, __HIP_MEMORY_SCOPE_AGENT); }
__device__ __forceinline__ unsigned xb_xcc_id() { return (unsigned)__builtin_amdgcn_s_getreg((3 << 11) | 20) & 0xFu; }
#define XB_SPIN(cond, bar) do { unsigned _sp = 0; while (cond) { __builtin_amdgcn_s_sleep(1); \
    if ((++_sp & 255u) == 0u) { if (xb_ld(&(bar)[XB_TMO])) break; if (_sp > XB_SPIN_CAP) { atomicAdd(&(bar)[XB_TMO], 1u); break; } } } } while (0)
struct XcdBarrier { unsigned* bar; unsigned x; volatile LAS unsigned* st; };
__device__ __forceinline__ XcdBarrier xcd_barrier_post(unsigned* bar, volatile LAS unsigned* st) {
    XcdBarrier b; b.bar = bar; b.x = xb_xcc_id(); b.st = st;
    if (threadIdx.x == 0) (void)xb_add(&bar[XB_XCNT(b.x)], 1u);
    return b;
}
__device__ __forceinline__ void xcd_barrier_complete(unsigned* bar, unsigned x, unsigned& nloc, unsigned& nx) {
    const unsigned G = gridDim.x * gridDim.y * gridDim.z;
    unsigned sum, cnt, mine, sp = 0u;
    for (;;) {
        sum = 0u; cnt = 0u; mine = 0u;
#pragma unroll
        for (unsigned j = 0; j < 16; ++j) { const unsigned c = xb_ld(&bar[XB_XCNT(j)]); sum += c; cnt += (c > 0u) ? 1u : 0u; mine = (j == x) ? c : mine; }
        if (sum == G) break;
        __builtin_amdgcn_s_sleep(1);
        if ((++sp & 255u) == 0u) { if (xb_ld(&bar[XB_TMO])) break; if (sp > XB_SPIN_CAP) { atomicAdd(&bar[XB_TMO], 1u); break; } }
    }
    nloc = mine > 0u ? mine : 1u; nx = cnt > 0u ? cnt : 1u;
}
__device__ __forceinline__ void xcd_barrier(const XcdBarrier& b) {
    asm volatile("s_waitcnt vmcnt(0)" ::: "memory");
    __syncthreads();
    if (threadIdx.x == 0) {
        unsigned* bar = b.bar;
        __builtin_amdgcn_s_waitcnt(0);
        unsigned nloc = b.st[0], nx = b.st[1];
        if (nloc == 0u) { xcd_barrier_complete(bar, b.x, nloc, nx); b.st[0] = nloc; b.st[1] = nx; }
        const unsigned old = xb_add(&bar[XB_XSUB(b.x)], 1u);
        const unsigned gen = old / nloc;
        if (old + 1u == (gen + 1u) * nloc) {
            __builtin_amdgcn_fence(__ATOMIC_RELEASE, "agent");
            asm volatile("s_waitcnt vmcnt(0)" ::: "memory");
            const unsigned og = xb_add(&bar[XB_TOP], 1u);
            const unsigned tg = og / nx;
            if (og + 1u == (tg + 1u) * nx) xb_add(&bar[XB_TOPGEN], 1u);
            else XB_SPIN(xb_ld(&bar[XB_TOPGEN]) == tg, bar);
            __builtin_amdgcn_fence(__ATOMIC_ACQUIRE, "agent");
            xb_add(&bar[XB_XGEN(b.x)], 1u);
            asm volatile("s_waitcnt vmcnt(0)" ::: "memory");
        } else {
            XB_SPIN(xb_ld(&bar[XB_XGEN(b.x)]) == gen, bar);
            __builtin_amdgcn_fence(__ATOMIC_ACQUIRE, "agent");
            asm volatile("s_waitcnt vmcnt(0)" ::: "memory");
        }
    }
    __syncthreads();
}

namespace pg8 {
constexpr int BM = 256, BK = 64, HALF = 128, HTB = HALF * BK * 2, STAGE_BYTES = 8 * HTB, NXCD = 8, WGM = 8;
__host__ __device__ __forceinline__ int lds_byte(int r, int c) { const int st = (r >> 4) * 2 + (c >> 5), rr = r & 15, cc = c & 31, ob = rr * 64 + cc * 2; return st * 1024 + (ob ^ (((ob >> 9) & 1) << 5)); }
__host__ __device__ __forceinline__ void stage_rc(int b, int& R, int& C) { const int st = b / 1024, sb = b % 1024, swz = sb ^ (((sb >> 9) & 1) << 5); R = (st >> 1) * 16 + swz / 64; C = (st & 1) * 32 + (swz % 64) / 2; }
__host__ __device__ __forceinline__ int perm32(int rho) { const int n = rho >> 4, i = rho & 15; return 8 * (i >> 2) + 4 * n + (i & 3); }

struct Unit { int pm, pn, e, aux; };
struct Gemm { const bf16* A; const bf16* Bt; int M, N, K; };

struct StaticOrder {
    int nM, nN, nwg, G, c;
    __device__ void init(int M, int N, int G_, int c_) { nM = M / BM; nN = N / BM; nwg = nM * nN; G = G_; c = c_; }
    __device__ bool next(int i, Unit& u) const {
        const long L = (long)i * G + c; if (L >= nwg) return false;
        int wgid = (int)L; { const int q = nwg / NXCD, r = nwg % NXCD, xcd = wgid % NXCD, off = wgid / NXCD; wgid = (xcd < r ? xcd * (q + 1) : r * (q + 1) + (xcd - r) * q) + off; }
        const int nig = WGM * nN, gid = wgid / nig, fm = gid * WGM, gsz = (nM - fm) < WGM ? (nM - fm) : WGM;
        u.pm = fm + ((wgid % nig) % gsz); u.pn = (wgid % nig) / gsz; u.e = 0; u.aux = 0; return true;
    }
    __device__ __forceinline__ unsigned b_off(const Unit& u, unsigned tstep) const { return (unsigned)u.pn * tstep; }
};
struct MoeOrder {
    const LAS int* tp; int G, c; unsigned estride;
    __device__ bool next(int i, Unit& u) const {
        const int L = i * G + c; const int ntot = tp[16] * 8; if (L >= ntot) return false;
        const int tile = L >> 3; int e = 0;
#pragma unroll
        for (int j = 1; j < 16; ++j) e += (tile >= tp[j]) ? 1 : 0;
        u.pm = tile; u.pn = L & 7; u.e = e; u.aux = i; return true;
    }
    __device__ __forceinline__ unsigned b_off(const Unit& u, unsigned tstep) const { return (unsigned)u.e * estride + (unsigned)u.pn * tstep; }
};

#define PG8_LAS __attribute__((address_space(3)))
template <class Epi, class Sched, bool ALIGN_EPI, bool GATHER>
__device__ __forceinline__ void gemm_phase(PG8_LAS unsigned char* lds, const Gemm g, const Sched& S, const Epi& E, const PG8_LAS unsigned* tabA) {
    const int tid = tid_fresh(), wid = __builtin_amdgcn_readfirstlane(tid >> 6), lane = tid & 63, wr = wid >> 2, wc = wid & 3, fr = lane & 15, fq = lane >> 4;
    const int K = g.K, nt = K / BK;
    int sR[2], sC[2];
    unsigned voffB[2];
#pragma unroll
    for (int i = 0; i < 2; ++i) { int R, C; stage_rc(tid * 16 + i * 8192, R, C); sR[i] = R; sC[i] = C; const int Rb = Epi::PERM ? ((R & ~31) + perm32(R & 31)) : R;
        voffB[i] = (unsigned)(Rb * K + C) * 2u; }
    const unsigned kstep = (unsigned)(BK * 2);
    const unsigned hstep = (unsigned)(HALF * K * 2);
    const unsigned tstep = 2u * hstep;
    const unsigned ldsw = (unsigned)wid * 1024u;
    const char* const baseA = (const char*)g.A; const char* const baseB = (const char*)g.Bt;
    const int aoff = lds_byte(wr * 64 + fr, fq * 8), boff = lds_byte(wc * 32 + fr, fq * 8);
#define PG8_SA(b, h) (((b) * 2 + (h)) * HTB)
#define PG8_SB(b, h) ((4 + (b) * 2 + (h)) * HTB)
#define PG8_STAGE(bufoff, gbase, uoff, voff) do { _Pragma("unroll") for (int _i = 0; _i < 2; ++_i) \
        __builtin_amdgcn_global_load_lds((const unsigned*)((gbase) + (size_t)(unsigned)((uoff) + (voff)[_i])), (PG8_LAS unsigned*)(lds + (bufoff) + ldsw + _i * 8192), 16, 0, 0); } while (0)
#define PG8_LDA(dst, b, h) do { _Pragma("unroll") for (int m = 0; m < 4; ++m) _Pragma("unroll") for (int k = 0; k < 2; ++k) dst[m][k] = *(const PG8_LAS bf16x8*)(lds + PG8_SA(b, h) + aoff + m * 2048 + k * 1024); } while (0)
#define PG8_LDB(dst, b, h) do { _Pragma("unroll") for (int n = 0; n < 2; ++n) _Pragma("unroll") for (int k = 0; k < 2; ++k) dst[n][k] = *(const PG8_LAS bf16x8*)(lds + PG8_SB(b, h) + boff + n * 2048 + k * 1024); } while (0)
#define PG8_MMA(ai, bj, At, Bt) do { __builtin_amdgcn_s_setprio(1); _Pragma("unroll") for (int m = 0; m < 4; ++m) _Pragma("unroll") for (int n = 0; n < 2; ++n) _Pragma("unroll") for (int k = 0; k < 2; ++k) \
        acc[ai][bj][m][n] = __builtin_amdgcn_mfma_f32_16x16x32_bf16(Bt[n][k], At[m][k], acc[ai][bj][m][n], 0, 0, 0); __builtin_amdgcn_s_setprio(0); } while (0)
#define PG8_WAIT_V(n) asm volatile("s_waitcnt vmcnt(" #n ")" ::: "memory")
#define PG8_WAIT_L(n) asm volatile("s_waitcnt lgkmcnt(" #n ")" ::: "memory")
#define PG8_BAR __builtin_amdgcn_s_barrier()
#define PG8_SCHED __builtin_amdgcn_sched_barrier(0)
    Unit cur, nxt; int ui = 0;
    if (!S.next(0, cur)) return;
    f32x4 acc[2][2][4][2];
#pragma unroll
    for (int a = 0; a < 2; ++a)
#pragma unroll
        for (int b = 0; b < 2; ++b)
#pragma unroll
            for (int m = 0; m < 4; ++m)
#pragma unroll
                for (int n = 0; n < 2; ++n) acc[a][b][m][n] = (f32x4){0.f, 0.f, 0.f, 0.f};
    bf16x8 At[4][2], B0[2][2], B1[2][2];
    unsigned vA0[2], vA1[2], nA0[2], nA1[2];
    unsigned uA, uB = S.b_off(cur, tstep);
    if constexpr (GATHER) { uA = 0u;
#pragma unroll
        for (int i = 0; i < 2; ++i) { vA0[i] = tabA[cur.aux * 256 + sR[i]] + (unsigned)sC[i] * 2u; vA1[i] = tabA[cur.aux * 256 + 128 + sR[i]] + (unsigned)sC[i] * 2u; }
    } else { uA = (unsigned)cur.pm * tstep;
#pragma unroll
        for (int i = 0; i < 2; ++i) { vA0[i] = (unsigned)(sR[i] * K + sC[i]) * 2u; vA1[i] = vA0[i] + hstep; }
    }
    PG8_STAGE(PG8_SB(0, 0), baseB, uB, voffB); PG8_STAGE(PG8_SB(0, 1), baseB, uB + hstep, voffB); PG8_STAGE(PG8_SA(0, 0), baseA, uA, vA0); PG8_STAGE(PG8_SA(0, 1), baseA, uA, vA1);
    if (wr == 1) PG8_BAR;
    PG8_WAIT_V(2); PG8_BAR;
    PG8_STAGE(PG8_SB(1, 0), baseB, uB + kstep, voffB); PG8_STAGE(PG8_SA(1, 0), baseA, uA + kstep, vA0); PG8_STAGE(PG8_SB(1, 1), baseB, uB + hstep + kstep, voffB);
    PG8_WAIT_V(6); PG8_BAR;
    for (;;) {
        const bool has_next = S.next(ui + 1, nxt);
        unsigned nuA, nuB = has_next ? S.b_off(nxt, tstep) : uB;
        if constexpr (GATHER) { nuA = 0u;
#pragma unroll
            for (int i = 0; i < 2; ++i) { if (has_next) { nA0[i] = tabA[nxt.aux * 256 + sR[i]] + (unsigned)sC[i] * 2u; nA1[i] = tabA[nxt.aux * 256 + 128 + sR[i]] + (unsigned)sC[i] * 2u; } else { nA0[i] = vA0[i]; nA1[i] = vA1[i]; } }
        } else { nuA = has_next ? (unsigned)nxt.pm * tstep : uA;
#pragma unroll
            for (int i = 0; i < 2; ++i) { nA0[i] = vA0[i]; nA1[i] = vA1[i]; }
        }
#pragma unroll 1
        for (int t = 0; t < nt; t += 2) {
            const bool last = (t == nt - 2);
            const unsigned a1 = uA + (unsigned)(t + 1) * kstep;
            const unsigned a2 = last ? nuA : uA + (unsigned)(t + 2) * kstep; const unsigned b2 = last ? nuB : uB + (unsigned)(t + 2) * kstep;
            const unsigned a3 = a2 + kstep; const unsigned b3 = b2 + kstep;
            unsigned w0[2], w1[2];
#pragma unroll
            for (int i = 0; i < 2; ++i) { w0[i] = (GATHER && last) ? nA0[i] : vA0[i]; w1[i] = (GATHER && last) ? nA1[i] : vA1[i]; }
            PG8_LDB(B0, 0, 0); PG8_LDB(B1, 0, 1); PG8_SCHED; PG8_LDA(At, 0, 0); PG8_STAGE(PG8_SA(1, 1), baseA, a1, vA1);
            PG8_WAIT_V(8); PG8_WAIT_L(0); PG8_BAR; PG8_MMA(0, 0, At, B0); PG8_MMA(0, 1, At, B1); PG8_BAR; PG8_SCHED;
            PG8_LDA(At, 0, 1); PG8_STAGE(PG8_SB(0, 0), baseB, b2, voffB); PG8_STAGE(PG8_SB(0, 1), baseB, b2 + hstep, voffB); PG8_STAGE(PG8_SA(0, 0), baseA, a2, w0);
            PG8_WAIT_V(8); PG8_WAIT_L(0); PG8_BAR; PG8_MMA(1, 0, At, B0); PG8_MMA(1, 1, At, B1); PG8_BAR; PG8_SCHED;
            PG8_LDB(B0, 1, 0); PG8_LDB(B1, 1, 1); PG8_SCHED; PG8_LDA(At, 1, 0); PG8_STAGE(PG8_SA(0, 1), baseA, a2, w1);
            PG8_WAIT_V(8); PG8_WAIT_L(0); PG8_BAR; PG8_MMA(0, 0, At, B0); PG8_MMA(0, 1, At, B1); PG8_BAR; PG8_SCHED;
            PG8_LDA(At, 1, 1); PG8_STAGE(PG8_SB(1, 0), baseB, b3, voffB); PG8_STAGE(PG8_SB(1, 1), baseB, b3 + hstep, voffB); PG8_STAGE(PG8_SA(1, 0), baseA, a3, w0);
            PG8_WAIT_V(8); PG8_WAIT_L(0); PG8_BAR; PG8_MMA(1, 0, At, B0); PG8_MMA(1, 1, At, B1); PG8_BAR; PG8_SCHED;
        }
        if constexpr (ALIGN_EPI) { if (wr == 0) PG8_BAR; }
        E(acc, cur, wr, wc, fr, fq);
        if (!has_next) break;
#pragma unroll
        for (int a = 0; a < 2; ++a)
#pragma unroll
            for (int b = 0; b < 2; ++b)
#pragma unroll
                for (int m = 0; m < 4; ++m)
#pragma unroll
                    for (int n = 0; n < 2; ++n) acc[a][b][m][n] = (f32x4){0.f, 0.f, 0.f, 0.f};
        cur = nxt; uA = nuA; uB = nuB; ++ui;
#pragma unroll
        for (int i = 0; i < 2; ++i) { vA0[i] = nA0[i]; vA1[i] = nA1[i]; }
        if constexpr (ALIGN_EPI) { if (wr == 1) PG8_BAR; }
    }
    PG8_WAIT_V(0);
    if constexpr (!ALIGN_EPI) { if (wr == 0) PG8_BAR; }
    PG8_BAR;
#undef PG8_SA
#undef PG8_SB
#undef PG8_STAGE
#undef PG8_LDA
#undef PG8_LDB
#undef PG8_MMA
#undef PG8_WAIT_V
#undef PG8_WAIT_L
#undef PG8_BAR
#undef PG8_SCHED
}

typedef int i32x8v __attribute__((ext_vector_type(8)));
typedef int i32x4v __attribute__((ext_vector_type(4)));
template <class Epi, class Sched, bool ALIGN_EPI, bool GATHER>
__device__ __forceinline__ void gemm_phase8(PG8_LAS unsigned char* lds, const Gemm g, const Sched& S, const Epi& E, const PG8_LAS unsigned* tabA) {
    const int tid = tid_fresh(), wid = __builtin_amdgcn_readfirstlane(tid >> 6), lane = tid & 63, wr = wid >> 2, wc = wid & 3, fr = lane & 15, fq = lane >> 4;
    const int K = g.K, nt = K / BK;
    int sR[2], sC[2];
    unsigned voffB[2];
#pragma unroll
    for (int i = 0; i < 2; ++i) { int R, C; stage_rc(tid * 16 + i * 8192, R, C); sR[i] = R; sC[i] = C; const int Rb = Epi::PERM ? ((R & ~31) + perm32(R & 31)) : R;
        voffB[i] = (unsigned)(Rb * K + C) * 2u; }
    const unsigned kstep = (unsigned)(BK * 2);
    const unsigned hstep = (unsigned)(HALF * K * 2);
    const unsigned tstep = 2u * hstep;
    const unsigned ldsw = (unsigned)wid * 1024u;
    const char* const baseA = (const char*)g.A; const char* const baseB = (const char*)g.Bt;
    const int aoff = lds_byte(wr * 64 + fr, 32 * (fq >> 1) + 16 * (fq & 1)), boff = lds_byte(wc * 32 + fr, 32 * (fq >> 1) + 16 * (fq & 1));
#define PG8_SA(b, h) (((b) * 2 + (h)) * HTB)
#define PG8_SB(b, h) ((4 + (b) * 2 + (h)) * HTB)
#define PG8_STAGE(bufoff, gbase, uoff, voff) do { _Pragma("unroll") for (int _i = 0; _i < 2; ++_i) \
        __builtin_amdgcn_global_load_lds((const unsigned*)((gbase) + (size_t)(unsigned)((uoff) + (voff)[_i])), (PG8_LAS unsigned*)(lds + (bufoff) + ldsw + _i * 8192), 16, 0, 0); } while (0)
#define PG8_LD32(p) __builtin_shufflevector(*(const PG8_LAS i32x4v*)(p), *(const PG8_LAS i32x4v*)((p) + 16), 0, 1, 2, 3, 4, 5, 6, 7)
#define PG8_LDA(dst, b, h) do { _Pragma("unroll") for (int m = 0; m < 4; ++m) dst[m] = PG8_LD32(lds + PG8_SA(b, h) + aoff + m * 2048); } while (0)
#define PG8_LDB(dst, b, h) do { _Pragma("unroll") for (int n = 0; n < 2; ++n) dst[n] = PG8_LD32(lds + PG8_SB(b, h) + boff + n * 2048); } while (0)
#define PG8_MMA(ai, bj, At, Bt) do { __builtin_amdgcn_s_setprio(1); _Pragma("unroll") for (int m = 0; m < 4; ++m) _Pragma("unroll") for (int n = 0; n < 2; ++n) \
        asm volatile("v_mfma_scale_f32_16x16x128_f8f6f4 %0, %1, %2, %0, %3, %4 op_sel_hi:[0,0,0]" : "+v"(acc[ai][bj][m][n]) : "v"(Bt[n]), "v"(At[m]), "v"(scw), "v"(sca)); __builtin_amdgcn_s_setprio(0); } while (0)
#define PG8_MFMA_DRAIN asm volatile("s_nop 15\n\ts_nop 15\n\ts_nop 15" ::: "memory")
#define PG8_WAIT_V(n) asm volatile("s_waitcnt vmcnt(" #n ")" ::: "memory")
#define PG8_WAIT_L(n) asm volatile("s_waitcnt lgkmcnt(" #n ")" ::: "memory")
#define PG8_BAR __builtin_amdgcn_s_barrier()
#define PG8_SCHED __builtin_amdgcn_sched_barrier(0)
    Unit cur, nxt; int ui = 0;
    if (!S.next(0, cur)) return;
    f32x4 acc[2][2][4][2];
#pragma unroll
    for (int a = 0; a < 2; ++a)
#pragma unroll
        for (int b = 0; b < 2; ++b)
#pragma unroll
            for (int m = 0; m < 4; ++m)
#pragma unroll
                for (int n = 0; n < 2; ++n) acc[a][b][m][n] = (f32x4){0.f, 0.f, 0.f, 0.f};
    i32x8v At[4], B0[2], B1[2];
    int scw = 0x7a7a7a7a, sca = 0x7f7f7f7f;
    asm volatile("" : "+v"(scw), "+v"(sca));
    unsigned vA0[2], vA1[2], nA0[2], nA1[2];
    unsigned uA, uB = S.b_off(cur, tstep);
    if constexpr (GATHER) { uA = 0u;
#pragma unroll
        for (int i = 0; i < 2; ++i) { vA0[i] = tabA[cur.aux * 256 + sR[i]] + (unsigned)sC[i] * 2u; vA1[i] = tabA[cur.aux * 256 + 128 + sR[i]] + (unsigned)sC[i] * 2u; }
    } else { uA = (unsigned)cur.pm * tstep;
#pragma unroll
        for (int i = 0; i < 2; ++i) { vA0[i] = (unsigned)(sR[i] * K + sC[i]) * 2u; vA1[i] = vA0[i] + hstep; }
    }
    PG8_STAGE(PG8_SB(0, 0), baseB, uB, voffB); PG8_STAGE(PG8_SB(0, 1), baseB, uB + hstep, voffB); PG8_STAGE(PG8_SA(0, 0), baseA, uA, vA0); PG8_STAGE(PG8_SA(0, 1), baseA, uA, vA1);
    if (wr == 1) PG8_BAR;
    PG8_WAIT_V(2); PG8_BAR;
    PG8_STAGE(PG8_SB(1, 0), baseB, uB + kstep, voffB); PG8_STAGE(PG8_SA(1, 0), baseA, uA + kstep, vA0); PG8_STAGE(PG8_SB(1, 1), baseB, uB + hstep + kstep, voffB);
    PG8_WAIT_V(6); PG8_BAR;
    for (;;) {
        const bool has_next = S.next(ui + 1, nxt);
        unsigned nuA, nuB = has_next ? S.b_off(nxt, tstep) : uB;
        if constexpr (GATHER) { nuA = 0u;
#pragma unroll
            for (int i = 0; i < 2; ++i) { if (has_next) { nA0[i] = tabA[nxt.aux * 256 + sR[i]] + (unsigned)sC[i] * 2u; nA1[i] = tabA[nxt.aux * 256 + 128 + sR[i]] + (unsigned)sC[i] * 2u; } else { nA0[i] = vA0[i]; nA1[i] = vA1[i]; } }
        } else { nuA = has_next ? (unsigned)nxt.pm * tstep : uA;
#pragma unroll
            for (int i = 0; i < 2; ++i) { nA0[i] = vA0[i]; nA1[i] = vA1[i]; }
        }
#pragma unroll 1
        for (int t = 0; t < nt; t += 2) {
            const bool last = (t == nt - 2);
            const unsigned a1 = uA + (unsigned)(t + 1) * kstep;
            const unsigned a2 = last ? nuA : uA + (unsigned)(t + 2) * kstep; const unsigned b2 = last ? nuB : uB + (unsigned)(t + 2) * kstep;
            const unsigned a3 = a2 + kstep; const unsigned b3 = b2 + kstep;
            unsigned w0[2], w1[2];
#pragma unroll
            for (int i = 0; i < 2; ++i) { w0[i] = (GATHER && last) ? nA0[i] : vA0[i]; w1[i] = (GATHER && last) ? nA1[i] : vA1[i]; }
            PG8_LDB(B0, 0, 0); PG8_LDB(B1, 0, 1); PG8_SCHED; PG8_LDA(At, 0, 0); PG8_STAGE(PG8_SA(1, 1), baseA, a1, vA1);
            PG8_WAIT_V(8); PG8_WAIT_L(0); PG8_BAR; PG8_MMA(0, 0, At, B0); PG8_MMA(0, 1, At, B1); PG8_BAR; PG8_SCHED;
            PG8_LDA(At, 0, 1); PG8_STAGE(PG8_SB(0, 0), baseB, b2, voffB); PG8_STAGE(PG8_SB(0, 1), baseB, b2 + hstep, voffB); PG8_STAGE(PG8_SA(0, 0), baseA, a2, w0);
            PG8_WAIT_V(8); PG8_WAIT_L(0); PG8_BAR; PG8_MMA(1, 0, At, B0); PG8_MMA(1, 1, At, B1); PG8_BAR; PG8_SCHED;
            PG8_LDB(B0, 1, 0); PG8_LDB(B1, 1, 1); PG8_SCHED; PG8_LDA(At, 1, 0); PG8_STAGE(PG8_SA(0, 1), baseA, a2, w1);
            PG8_WAIT_V(8); PG8_WAIT_L(0); PG8_BAR; PG8_MMA(0, 0, At, B0); PG8_MMA(0, 1, At, B1); PG8_BAR; PG8_SCHED;
            PG8_LDA(At, 1, 1); PG8_STAGE(PG8_SB(1, 0), baseB, b3, voffB); PG8_STAGE(PG8_SB(1, 1), baseB, b3 + hstep, voffB); PG8_STAGE(PG8_SA(1, 0), baseA, a3, w0);
            PG8_WAIT_V(8); PG8_WAIT_L(0); PG8_BAR; PG8_MMA(1, 0, At, B0); PG8_MMA(1, 1, At, B1); PG8_BAR; PG8_SCHED;
        }
        if constexpr (ALIGN_EPI) { if (wr == 0) PG8_BAR; }
        PG8_MFMA_DRAIN;
        { const int l2 = tid_fresh() & 63; E(acc, cur, wr, wc, l2 & 15, l2 >> 4); }
        if (!has_next) break;
#pragma unroll
        for (int a = 0; a < 2; ++a)
#pragma unroll
            for (int b = 0; b < 2; ++b)
#pragma unroll
                for (int m = 0; m < 4; ++m)
#pragma unroll
                    for (int n = 0; n < 2; ++n) acc[a][b][m][n] = (f32x4){0.f, 0.f, 0.f, 0.f};
        cur = nxt; uA = nuA; uB = nuB; ++ui;
#pragma unroll
        for (int i = 0; i < 2; ++i) { vA0[i] = nA0[i]; vA1[i] = nA1[i]; }
        if constexpr (ALIGN_EPI) { if (wr == 1) PG8_BAR; }
    }
    PG8_WAIT_V(0);
    if constexpr (!ALIGN_EPI) { if (wr == 0) PG8_BAR; }
    PG8_BAR;
#undef PG8_SA
#undef PG8_SB
#undef PG8_STAGE
#undef PG8_LDA
#undef PG8_LD32
#undef PG8_LDB
#undef PG8_MMA
#undef PG8_MFMA_DRAIN
#undef PG8_WAIT_V
#undef PG8_WAIT_L
#undef PG8_BAR
#undef PG8_SCHED
}

__device__ __forceinline__ unsigned cvt_pk_bf16(float lo, float hi) { return pk2(lo, hi); }

struct EpiBf16 {
    static constexpr bool PERM = true;
    bf16* O; int ldc;
    __device__ __forceinline__ void operator()(const f32x4 (&acc)[2][2][4][2], const Unit& u, int wr, int wc, int fr, int fq) const {
        const int row0 = u.pm * BM + wr * 64 + fr; const int col0 = u.pn * BM + wc * 32 + 8 * fq;
#pragma unroll
        for (int ai = 0; ai < 2; ++ai)
#pragma unroll
            for (int m = 0; m < 4; ++m) { bf16* rowp = O + (size_t)(row0 + ai * HALF + m * 16) * ldc + col0;
#pragma unroll
                for (int bj = 0; bj < 2; ++bj) { const f32x4 v0 = acc[ai][bj][m][0], v1 = acc[ai][bj][m][1];
                    u32x4 w; w.x = cvt_pk_bf16(v0[0], v0[1]); w.y = cvt_pk_bf16(v0[2], v0[3]); w.z = cvt_pk_bf16(v1[0], v1[1]); w.w = cvt_pk_bf16(v1[2], v1[3]);
                    *(u32x4*)(rowp + bj * HALF) = w; } }
    }
};
struct EpiResid {
    static constexpr bool PERM = false;
    const float* xl; const float* xc; float* out; const float* gate;
    __device__ __forceinline__ void operator()(const f32x4 (&acc)[2][2][4][2], const Unit& u, int wr, int wc, int fr, int fq) const {
        const int rt = u.pm * BM; const bool isl = rt < NLAT;
        const float* base = isl ? xl + (size_t)rt * D : xc + (size_t)(rt - NLAT) * D;
        const float* gp = gate + (size_t)(isl ? (rt >> 12) : 8) * 12288;
        const int rl0 = wr * 64 + fr, col0 = u.pn * BM + wc * 32 + 4 * fq;
#pragma unroll
        for (int ai = 0; ai < 2; ++ai)
#pragma unroll
            for (int m = 0; m < 4; ++m) { const int rl = rl0 + ai * HALF + m * 16; const float* bp = base + (size_t)rl * D + col0; float* op = out + (size_t)(rt + rl) * D + col0;
#pragma unroll
                for (int bj = 0; bj < 2; ++bj)
#pragma unroll
                    for (int n = 0; n < 2; ++n) { const f32x4 b = *(const f32x4*)(bp + bj * HALF + n * 16); const f32x4 gv = *(const f32x4*)(gp + col0 + bj * HALF + n * 16); *(f32x4*)(op + bj * HALF + n * 16) = b + gv * acc[ai][bj][m][n]; }
                asm volatile("" ::: "memory"); }
    }
};
struct EpiSwiglu {
    static constexpr bool PERM = true;
    unsigned char* O;
    __device__ __forceinline__ void operator()(const f32x4 (&acc)[2][2][4][2], const Unit& u, int wr, int wc, int fr, int fq) const {
        const int row0 = u.pm * BM + wr * 64 + fr; const int col0 = u.pn * 128 + wc * 32 + 8 * fq;
#pragma unroll
        for (int ai = 0; ai < 2; ++ai)
#pragma unroll
            for (int m = 0; m < 4; ++m) { unsigned char* rowp = O + (size_t)(row0 + ai * HALF + m * 16) * DE + col0;
                float o[8];
#pragma unroll
                for (int n = 0; n < 2; ++n)
#pragma unroll
                    for (int j = 0; j < 4; ++j) { const float gt = acc[ai][0][m][n][j], up = acc[ai][1][m][n][j]; o[n * 4 + j] = gt * __builtin_amdgcn_rcpf(1.0f + __expf(-gt)) * up; }
                u32x2 w; w.x = pk4_fp8(o[0], o[1], o[2], o[3]); w.y = pk4_fp8(o[4], o[5], o[6], o[7]);
                *(u32x2*)rowp = w; }
    }
};
struct EpiDown {
    static constexpr bool PERM = true;
    bf16* YK; const PG8_LAS unsigned* tab; const PG8_LAS float* tabw;
    __device__ __forceinline__ void operator()(const f32x4 (&acc)[2][2][4][2], const Unit& u, int wr, int wc, int fr, int fq) const {
        const int rl0 = wr * 64 + fr; const int col0 = u.pn * BM + wc * 32 + 8 * fq;
#pragma unroll
        for (int ai = 0; ai < 2; ++ai)
#pragma unroll
            for (int m = 0; m < 4; ++m) { const int rl = rl0 + ai * HALF + m * 16; const unsigned ent = tab[u.aux * 256 + rl]; const float w = tabw[u.aux * 256 + rl];
                if (!(ent & 0x40000000u)) { bf16* rowp = YK + ((size_t)(ent >> 31) * MALL + (ent & 0xffffu)) * D + col0;
#pragma unroll
                    for (int bj = 0; bj < 2; ++bj) { const f32x4 v0 = acc[ai][bj][m][0] * w, v1 = acc[ai][bj][m][1] * w;
                        u32x4 q; q.x = cvt_pk_bf16(v0[0], v0[1]); q.y = cvt_pk_bf16(v0[2], v0[3]); q.z = cvt_pk_bf16(v1[0], v1[1]); q.w = cvt_pk_bf16(v1[2], v1[3]);
                        *(u32x4*)(rowp + bj * HALF) = q; } }
                asm volatile("" ::: "memory"); }
    }
};
}

struct Args { const float* in[31]; float* out; unsigned char* ws; int ph_lo, ph_hi; };
typedef const __attribute__((address_space(4))) Args* KArgs;
__device__ __forceinline__ KArgs kargs() { KArgs p = (KArgs)__builtin_amdgcn_kernarg_segment_ptr(); asm volatile("" : "+s"(p)); return p; }
#define AIN(i) (a->in[i])
enum { I_X = 0, I_C, I_CTX, I_CCTX, I_ADAW, I_ADAB, I_N1G, I_N2G, I_WIN, I_WOUT, I_GNG, I_GWS, I_GB, I_LB, I_HNG, I_MU, I_W0, I_WUP, I_A0, I_AUP, I_GUP, I_KK, I_KA, I_RK, I_GNGG, I_GNB, I_RW, I_RB, I_WGU, I_WDN, I_FNG };

__device__ __forceinline__ void p0_transpose_item(const float* W, int K, int N, bf16* WT, int n_row0, LAS float* scr, int kb, int nb, int lane) {
    const int k0 = 64 * kb, n0 = 32 * nb;
#pragma unroll 8
    for (int i = 0; i < 32; ++i) { const int kk = 2 * i + (lane >> 5); scr[kk * 33 + (lane & 31)] = W[(size_t)(k0 + kk) * N + n0 + (lane & 31)]; }
    asm volatile("s_waitcnt lgkmcnt(0)" ::: "memory");
    const int c = lane & 7;
#pragma unroll
    for (int j = 0; j < 4; ++j) { const int n = (lane >> 3) + 8 * j; const LAS float* s = scr + (8 * c) * 33 + n;
        u32x4 o; o.x = pk2(s[0 * 33], s[1 * 33]); o.y = pk2(s[2 * 33], s[3 * 33]); o.z = pk2(s[4 * 33], s[5 * 33]); o.w = pk2(s[6 * 33], s[7 * 33]);
        *(u32x4*)(WT + (size_t)(n_row0 + n) * K + k0 + 8 * c) = o; }
    asm volatile("s_waitcnt lgkmcnt(0)" ::: "memory");
}

__device__ __forceinline__ void p0_transpose_item8(const float* W, int K, int N, unsigned char* WT, int n_row0, LAS float* scr, int kb, int nb, int lane) {
    const int k0 = 64 * kb, n0 = 32 * nb;
#pragma unroll 8
    for (int i = 0; i < 32; ++i) { const int kk = 2 * i + (lane >> 5); scr[kk * 33 + (lane & 31)] = W[(size_t)(k0 + kk) * N + n0 + (lane & 31)]; }
    asm volatile("s_waitcnt lgkmcnt(0)" ::: "memory");
    const int c = lane & 7;
#pragma unroll
    for (int j = 0; j < 4; ++j) { const int n = (lane >> 3) + 8 * j; const LAS float* sp = scr + (8 * c) * 33 + n;
        u32x2 o; o.x = pk4_fp8(sp[0 * 33] * 32.f, sp[1 * 33] * 32.f, sp[2 * 33] * 32.f, sp[3 * 33] * 32.f); o.y = pk4_fp8(sp[4 * 33] * 32.f, sp[5 * 33] * 32.f, sp[6 * 33] * 32.f, sp[7 * 33] * 32.f);
        *(u32x2*)(WT + (size_t)(n_row0 + n) * K + k0 + 8 * c) = o; }
    asm volatile("s_waitcnt lgkmcnt(0)" ::: "memory");
}
__device__ __forceinline__ void convert_moe(KArgs a, int l, LAS unsigned char* lds) {
    const int tid = tid_fresh(), lane = tid & 63, wave = tid >> 6;
    const int gw = blockIdx.x * 8 + wave, NGW = gridDim.x * 8;
    unsigned char* ws = a->ws;
    LAS float* scr = (LAS float*)(lds + wave * 16384);
    constexpr int I_GU = 32 * 64, I_DN = 16 * 64, N2 = 16 * I_GU, N3 = N2 + 16 * I_DN;
    for (int it = gw; it < N3; it += NGW) {
        if (it < N2) { const int e = it / I_GU, r = it % I_GU, kb = r / 64, nb = r % 64;
            const int n0 = 32 * nb, hh = n0 >> 10, nn = n0 & 1023, row0 = 256 * (nn >> 7) + 128 * hh + (nn & 127);
            p0_transpose_item8(a->in[I_WGU] + (size_t)(l * NE + e) * D * 2048, D, 2048, ws + WS_WGU + (size_t)e * 2048 * D, row0, scr, kb, nb, lane); }
        else { const int q = it - N2, e = q / I_DN, r = q % I_DN, kb = r / 64, nb = r % 64;
            p0_transpose_item8(a->in[I_WDN] + (size_t)(l * NE + e) * DE * D, DE, D, ws + WS_WDN + (size_t)e * D * DE, 32 * nb, scr, kb, nb, lane); }
    }
}
__device__ __forceinline__ void phase_prologue(KArgs a, LAS unsigned char* lds) {
    const int tid = tid_fresh(), lane = tid & 63, wave = tid >> 6;
    const int G = gridDim.x, gw = blockIdx.x * 8 + wave, NGW = G * 8;
    unsigned char* ws = a->ws;
    LAS float* scr = (LAS float*)(lds + wave * 16384);
    constexpr int I_IN = 32 * 232, I_OUT = 32 * 64;
    constexpr int N0 = 2 * I_IN, N1 = N0 + 2 * I_OUT;
    for (int it = gw; it < N1; it += NGW) {
        if (it < N0) { const int l = it / I_IN, r = it % I_IN, kb = r / 232, nb = r % 232;
            p0_transpose_item(a->in[I_WIN] + (size_t)l * D * INC, D, INC, (bf16*)(ws + WS_WIN) + (size_t)l * INC * D, 32 * nb, scr, kb, nb, lane); }
        else { const int q = it - N0, l = q / I_OUT, r = q % I_OUT, kb = r / 64, nb = r % 64;
            p0_transpose_item(a->in[I_WOUT] + (size_t)l * D * D, D, D, (bf16*)(ws + WS_WOUT) + (size_t)l * D * D, 32 * nb, scr, kb, nb, lane); }
    }
    convert_moe(a, 0, lds);
    {
        const int gt = blockIdx.x * NTHREADS + tid, NGT = G * NTHREADS;
        bf16* wup = (bf16*)(ws + WS_SMALLW + SW_WUP); bf16* aup = (bf16*)(ws + WS_SMALLW + SW_AUP); bf16* gup = (bf16*)(ws + WS_SMALLW + SW_GUP); bf16* gws = (bf16*)(ws + WS_SMALLW + SW_GWS);
        for (int i = gt; i < 2 * 2 * 768 * 64; i += NGT) { const int k = i & 63, n = (i >> 6) % 768, ld = i / (768 * 64); wup[i] = (bf16)f2bf(a->in[I_WUP][((size_t)ld * 64 + k) * 768 + n]); }
        for (int i = gt; i < 2 * 768 * 64; i += NGT) { const int k = i & 63, n = (i >> 6) % 768, l = i / (768 * 64); aup[i] = (bf16)f2bf(a->in[I_AUP][((size_t)l * 64 + k) * 768 + n]); }
        for (int i = gt; i < 2 * 768 * 128; i += NGT) { const int k = i & 127, n = (i >> 7) % 768, l = i / (768 * 128); gup[i] = (bf16)f2bf(a->in[I_GUP][((size_t)l * 128 + k) * 768 + n]); }
        for (int i = gt; i < 2 * 4 * 128 * 128; i += NGT) gws[i] = (bf16)f2bf(a->in[I_GWS][i]);
    }
    __syncthreads();
    {
        LAS float* sv = (LAS float*)lds;
        LAS float* red = (LAS float*)(lds + 73728);
        for (int i = tid; i < 9 * D; i += NTHREADS) { const int r = i / D, k = i % D; const float v = r < 8 ? a->in[I_C][r * D + k] : a->in[I_CCTX][k]; sv[i] = siluf_(v); }
        __syncthreads();
        float* mod = (float*)(ws + WS_MOD);
        for (int it = blockIdx.x; it < 2 * 96; it += G) {
            const int l = it / 96, cb = it % 96, cq = tid & 31, kg = tid >> 5;
            const float* wp = a->in[I_ADAW] + (size_t)l * D * 12288 + (size_t)(kg * 128) * 12288 + cb * 128 + cq * 4;
            f32x4 acc[9];
#pragma unroll
            for (int r = 0; r < 9; ++r) acc[r] = (f32x4){0.f, 0.f, 0.f, 0.f};
#pragma unroll 4
            for (int k = 0; k < 128; ++k) { const f32x4 w = *(const f32x4*)(wp + (size_t)k * 12288);
#pragma unroll
                for (int r = 0; r < 9; ++r) acc[r] += w * sv[r * D + kg * 128 + k]; }
#pragma unroll
            for (int r = 0; r < 9; ++r) *(LAS f32x4*)(red + ((kg * 9 + r) * 128 + cq * 4)) = acc[r];
            __syncthreads();
            for (int o = tid; o < 9 * 128; o += NTHREADS) { const int r = o / 128, c = o % 128; float s = a->in[I_ADAB][(size_t)l * 12288 + cb * 128 + c];
#pragma unroll
                for (int q = 0; q < 16; ++q) s += red[(q * 9 + r) * 128 + c];
                mod[((size_t)l * 9 + r) * 12288 + cb * 128 + c] = s; }
            __syncthreads();
        }
    }
}

template <int MODE>
__device__ __forceinline__ void phase_norm1(KArgs a, int l, bool dry) {
    const int tid_ = tid_fresh(); const int lane = tid_ & 63, wave = tid_ >> 6, gw = blockIdx.x * 8 + wave, NGW = gridDim.x * 8;
    unsigned char* ws = a->ws;
    const float* mod = (const float*)(ws + WS_MOD);
    float* X = (float*)(ws + WS_X); bf16* H = (bf16*)(ws + WS_H); const bf16* YK = (const bf16*)(ws + WS_YK);
    float* Xo = dry ? (float*)(ws + WS_END) : X; bf16* Ho = dry ? (bf16*)(ws + WS_END) : H; float* Oo = dry ? (float*)(ws + WS_END) : a->out;
    const int nrows = (MODE == 2) ? NLAT : MALL;
    const int rpw = (nrows + NGW - 1) / NGW; const int r0 = gw * rpw, r1 = (r0 + rpw < nrows) ? r0 + rpw : nrows;
    f32x4 ck[8], cs[8], cg[8]; int cur_mr = -1;
    for (int row = r0; row < r1; ++row) {
        const int mr = modrow_of(row); const int orow = dry ? (row & 2047) : row;
        if (mr != cur_mr) { cur_mr = mr;
#pragma unroll
            for (int j = 0; j < 8; ++j) { const int c = 4 * lane + 256 * j;
                if (MODE == 2) ck[j] = *(const f32x4*)(a->in[I_FNG] + c);
                else { const float* m = mod + ((size_t)l * 9 + mr) * 12288; const f32x4 g = *(const f32x4*)(a->in[I_N1G] + (size_t)l * D + c); ck[j] = g * (*(const f32x4*)(m + D + c) + 1.0f); cs[j] = *(const f32x4*)(m + c); }
                if (MODE != 0) cg[j] = *(const f32x4*)(mod + ((size_t)(l - 1) * 9 + mr) * 12288 + 5 * D + c); } }
        f32x4 v[8];
        if (MODE == 0) { const float* xr = row < NLAT ? a->in[I_X] + (size_t)row * D : a->in[I_CTX] + (size_t)(row - NLAT) * D;
#pragma unroll
            for (int j = 0; j < 8; ++j) v[j] = *(const f32x4*)(xr + 4 * lane + 256 * j);
        } else {
            const float* xr = X + (size_t)row * D; const bf16* y0 = YK + (size_t)row * D; const bf16* y1 = YK + ((size_t)MALL + row) * D;
            u32x2 p0[8], p1[8];
#pragma unroll
            for (int j = 0; j < 8; ++j) { const int c = 4 * lane + 256 * j; v[j] = *(const f32x4*)(xr + c); p0[j] = *(const u32x2*)(y0 + c); p1[j] = *(const u32x2*)(y1 + c); }
#pragma unroll
            for (int j = 0; j < 8; ++j) { f32x4 f; f[0] = bflo(p0[j].x) + bflo(p1[j].x); f[1] = bfhi(p0[j].x) + bfhi(p1[j].x); f[2] = bflo(p0[j].y) + bflo(p1[j].y); f[3] = bfhi(p0[j].y) + bfhi(p1[j].y);
                v[j] = v[j] + cg[j] * f; }
            if (MODE == 1) {
#pragma unroll
                for (int j = 0; j < 8; ++j) *(f32x4*)(Xo + (size_t)orow * D + 4 * lane + 256 * j) = v[j];
            }
        }
        float ss = 0.f;
#pragma unroll
        for (int j = 0; j < 8; ++j) ss += (v[j][0] * v[j][0] + v[j][1] * v[j][1]) + (v[j][2] * v[j][2] + v[j][3] * v[j][3]);
        const float rstd = 1.0f / sqrtf(wave_sum(ss) * (1.0f / D) + NORM_EPS);
        if (MODE == 2) {
#pragma unroll
            for (int j = 0; j < 8; ++j) *(f32x4*)(Oo + (size_t)orow * D + 4 * lane + 256 * j) = v[j] * rstd * ck[j];
        } else {
#pragma unroll
            for (int j = 0; j < 8; ++j) { const f32x4 h = v[j] * rstd * ck[j] + cs[j]; u32x2 o; o.x = pk2(h[0], h[1]); o.y = pk2(h[2], h[3]); *(u32x2*)(Ho + (size_t)orow * D + 4 * lane + 256 * j) = o; }
        }
    }
}

__device__ __forceinline__ void phase_norm2_router(KArgs a, int l, bool dry, LAS unsigned char* lds) {
    const int tid_ = tid_fresh(); const int lane = tid_ & 63, wave = tid_ >> 6, gw = blockIdx.x * 8 + wave, NGW = gridDim.x * 8;
    unsigned char* ws = a->ws;
    const float* mod = (const float*)(ws + WS_MOD);
    const float* X = (const float*)(ws + WS_X); bf16* H = (bf16*)(ws + WS_H);
    unsigned* cnt = (unsigned*)(ws + WS_CTL) + CW_CNT + l * 16 * 64 + (dry ? 4096 : 0);
    unsigned* ridx = (unsigned*)(ws + (dry ? WS_END : WS_RIDX)); float* rwt = (float*)(ws + (dry ? WS_END + 4 * MiB : WS_RW)); bf16* Ho = dry ? (bf16*)(ws + WS_END + 8 * MiB) : H;
    const int nrows = (l == DEPTH - 1) ? NLAT : MALL;
    LAS f32x4* rwl = (LAS f32x4*)lds;
    { const float* rw = a->in[I_RW];
      for (int idx = tid_; idx < 8192; idx += NTHREADS) { const int ln = idx & 63, q = (idx >> 6) & 3, i = (idx >> 8) & 3, j = idx >> 10; rwl[idx] = *(const f32x4*)(rw + (size_t)(4 * ln + 256 * j + i) * 16 + 4 * q); } }
    __syncthreads();
    const int rpw = (nrows + NGW - 1) / NGW; const int r0 = gw * rpw, r1 = (r0 + rpw < nrows) ? r0 + rpw : nrows;
    f32x4 ck[8]; int cur_mr = -1;
    const float* rbp = a->in[I_RB];
    for (int row = r0; row < r1; ++row) {
        const int mr = modrow_of(row); const int orow = dry ? (row & 2047) : row;
        if (mr != cur_mr) { cur_mr = mr; const float* m = mod + ((size_t)l * 9 + mr) * 12288;
#pragma unroll
            for (int j = 0; j < 8; ++j) { const int c = 4 * lane + 256 * j; const f32x4 g = *(const f32x4*)(a->in[I_N2G] + (size_t)l * D + c); ck[j] = g * (*(const f32x4*)(m + 4 * D + c) + 1.0f); } }
        const float* shp = mod + ((size_t)l * 9 + mr) * 12288 + 3 * D;
        const float* xr = X + (size_t)row * D;
        f32x4 v[8]; float ss = 0.f;
#pragma unroll
        for (int j = 0; j < 8; ++j) { v[j] = *(const f32x4*)(xr + 4 * lane + 256 * j); ss += (v[j][0] * v[j][0] + v[j][1] * v[j][1]) + (v[j][2] * v[j][2] + v[j][3] * v[j][3]); }
        const float rstd = 1.0f / sqrtf(wave_sum(ss) * (1.0f / D) + NORM_EPS);
        f32x4 lg4[4];
#pragma unroll
        for (int q = 0; q < 4; ++q) lg4[q] = (f32x4){0.f, 0.f, 0.f, 0.f};
#pragma unroll
        for (int j = 0; j < 8; ++j) { const f32x4 h = v[j] * rstd * ck[j] + *(const f32x4*)(shp + 4 * lane + 256 * j); *(unsigned*)((unsigned char*)Ho + (size_t)orow * D + 4 * lane + 256 * j) = pk4_fp8(h[0], h[1], h[2], h[3]);
#pragma unroll
            for (int i = 0; i < 4; ++i)
#pragma unroll
                for (int q = 0; q < 4; ++q) lg4[q] += rwl[((j * 4 + i) * 4 + q) * 64 + lane] * h[i];
            asm volatile("" ::: "memory"); }
        float lg[16];
        { float t8[8], t4[4], t2[2], t1;
          const bool b5 = lane & 32, b4 = lane & 16, b3 = lane & 8, b2 = lane & 4;
#pragma unroll
          for (int i = 0; i < 8; ++i) { const float keep = b5 ? lg4[(i + 8) >> 2][(i + 8) & 3] : lg4[i >> 2][i & 3], send = b5 ? lg4[i >> 2][i & 3] : lg4[(i + 8) >> 2][(i + 8) & 3]; t8[i] = keep + __shfl_xor(send, 32); }
#pragma unroll
          for (int i = 0; i < 4; ++i) { const float keep = b4 ? t8[i + 4] : t8[i], send = b4 ? t8[i] : t8[i + 4]; t4[i] = keep + __shfl_xor(send, 16); }
#pragma unroll
          for (int i = 0; i < 2; ++i) { const float keep = b3 ? t4[i + 2] : t4[i], send = b3 ? t4[i] : t4[i + 2]; t2[i] = keep + __shfl_xor(send, 8); }
          { const float keep = b2 ? t2[1] : t2[0], send = b2 ? t2[0] : t2[1]; t1 = keep + __shfl_xor(send, 4); }
          t1 += __shfl_xor(t1, 2); t1 += __shfl_xor(t1, 1);
#pragma unroll
          for (int e = 0; e < 16; ++e) { const int src = ((e >> 3) & 1) * 32 + ((e >> 2) & 1) * 16 + ((e >> 1) & 1) * 8 + (e & 1) * 4; lg[e] = __builtin_bit_cast(float, __builtin_amdgcn_readlane(__builtin_bit_cast(int, t1), src)) + rbp[e]; } }
        float mx = lg[0];
#pragma unroll
        for (int e = 1; e < 16; ++e) mx = fmaxf(mx, lg[e]);
        float p[16], sum = 0.f;
#pragma unroll
        for (int e = 0; e < 16; ++e) { p[e] = __expf(lg[e] - mx); sum += p[e]; }
        const float inv = 1.0f / sum;
#pragma unroll
        for (int e = 0; e < 16; ++e) p[e] *= inv;
        int sel = 0; float best = -1.f;
#pragma unroll
        for (int gI = 0; gI < 4; ++gI) { float m1 = -1.f, m2 = -1.f;
#pragma unroll
            for (int i = 0; i < 4; ++i) { const float q = p[4 * gI + i]; if (q > m1) { m2 = m1; m1 = q; } else if (q > m2) m2 = q; }
            const float s = m1 + m2; if (s > best) { best = s; sel = gI; } }
        int i1 = 0, i2 = 0; float p1 = -2.f, p2 = -2.f;
#pragma unroll
        for (int gI = 0; gI < 4; ++gI)
#pragma unroll
            for (int i = 0; i < 4; ++i) { const float q = (gI == sel) ? p[4 * gI + i] : -1.0f; const int e = 4 * gI + i;
                if (gI == sel) { if (q > p1) { p2 = p1; i2 = i1; p1 = q; i1 = e; } else if (q > p2) { p2 = q; i2 = e; } } }
        const float wsum = p1 + p2, w1 = p1 / wsum, w2 = p2 / wsum;
        if (lane == 0) {
            const unsigned q1 = atomicAdd(cnt + i1 * 64, 1u); ridx[(size_t)i1 * MALL + q1] = (unsigned)row; rwt[(size_t)i1 * MALL + q1] = w1;
            const unsigned q2 = atomicAdd(cnt + i2 * 64, 1u); ridx[(size_t)i2 * MALL + q2] = (unsigned)row | 0x80000000u; rwt[(size_t)i2 * MALL + q2] = w2;
        }
    }
    __syncthreads();
}

template <bool FOR_DOWN>
__device__ __forceinline__ void moe_tables(KArgs a, int l, LAS unsigned char* lds, int cvirt) {
    const int tid = tid_fresh(), G = gridDim.x;
    unsigned char* ws = a->ws;
    const unsigned* cnt = (const unsigned*)(ws + WS_CTL) + CW_CNT + l * 16 * 64;
    const unsigned* ridx = (const unsigned*)(ws + WS_RIDX); const float* rwt = (const float*)(ws + WS_RW);
    LAS int* tp = (LAS int*)(lds + LDS_TP); LAS unsigned* tab = (LAS unsigned*)(lds + LDS_TAB); LAS float* tabw = (LAS float*)(lds + LDS_TABW);
    if (tid == 0) { int acc = 0; for (int e = 0; e < 16; ++e) { tp[e] = acc; acc += (int)((cnt[e * 64] + 255u) >> 8); } tp[16] = acc; }
    __syncthreads();
    const int ntot = tp[16] * 8;
    for (int i = 0; i < 9; ++i) { const int L = i * G + cvirt; if (L >= ntot) break;
        const int tile = L >> 3; int e = 0;
        for (int j = 1; j < 16; ++j) e += (tile >= tp[j]) ? 1 : 0;
        const int pos0 = (tile - tp[e]) * 256; const unsigned ce = cnt[e * 64];
        if (tid < 256) { const int pos = pos0 + tid; const bool valid = (unsigned)pos < ce; const unsigned ent = ridx[(size_t)e * MALL + (valid ? pos : 0)];
            if (FOR_DOWN) { tab[i * 256 + tid] = valid ? ent : (ent | 0x40000000u); tabw[i * 256 + tid] = valid ? rwt[(size_t)e * MALL + pos] : 0.f; }
            else tab[i * 256 + tid] = (ent & 0xffffu) * (unsigned)D; }
    }
    __syncthreads();
}

__device__ __forceinline__ void gmlp_item(KArgs a, int l, int item, LAS unsigned char* lds) {
    const int tid = tid_fresh(), lane = tid & 63, wave = tid >> 6;
    unsigned char* ws = a->ws;
    const bf16* P = (const bf16*)(ws + WS_P); bf16* Y = (bf16*)(ws + WS_Y);
    const int chunk = item >> 2, h = item & 3;
    const int row0 = chunk < 256 ? chunk * 128 : NLAT + (chunk - 256) * 128;
    LAS bf16* wsl = (LAS bf16*)lds;
    LAS bf16* vT = (LAS bf16*)(lds + 128 * 136 * 2);
    const bf16* gws = (const bf16*)(ws + WS_SMALLW + SW_GWS) + ((size_t)l * 4 + h) * 128 * 128;
    for (int p = tid; p < 2048; p += NTHREADS) { const int t = p >> 4, c8 = p & 15; *(LAS u32x4*)(wsl + t * 136 + c8 * 8) = *(const u32x4*)(gws + t * 128 + c8 * 8); }
    {
        const int s = tid >> 2, qd = tid & 3; const bf16* vp = P + (size_t)(row0 + s) * INC + OFF_V + h * 128 + qd * 32;
        float g[32]; float ss = 0.f;
#pragma unroll
        for (int q = 0; q < 4; ++q) { float f[8]; unpack8(*(const u32x4*)(vp + 8 * q), f);
#pragma unroll
            for (int j = 0; j < 8; ++j) { const float x = geluf_(f[j]); g[8 * q + j] = x; ss += x * x; } }
        ss += __shfl_xor(ss, 1); ss += __shfl_xor(ss, 2);
        const float rstd = 1.0f / sqrtf(ss * (1.0f / 128.0f) + NORM_EPS);
        const float* ng = a->in[I_GNG] + (size_t)l * 512 + h * 128 + qd * 32;
#pragma unroll
        for (int j = 0; j < 32; ++j) vT[(qd * 32 + j) * 136 + s] = (bf16)f2bf(g[j] * rstd * ng[j]);
    }
    __syncthreads();
    f32x4 acc[8];
#pragma unroll
    for (int ct = 0; ct < 8; ++ct) acc[ct] = (f32x4){0.f, 0.f, 0.f, 0.f};
    const int fr = lane & 15, fq = lane >> 4;
#pragma unroll
    for (int ks = 0; ks < 4; ++ks) {
        const bf16x8 bfrag = *(const LAS bf16x8*)(wsl + (16 * wave + fr) * 136 + ks * 32 + fq * 8);
#pragma unroll
        for (int ct = 0; ct < 8; ++ct) { const bf16x8 afrag = *(const LAS bf16x8*)(vT + (16 * ct + fr) * 136 + ks * 32 + fq * 8);
            acc[ct] = __builtin_amdgcn_mfma_f32_16x16x32_bf16(afrag, bfrag, acc[ct], 0, 0, 0); }
    }
    const int t = 16 * wave + fr; const float wb = a->in[I_GB][((size_t)l * 4 + h) * 128 + t];
    const bf16* up = P + (size_t)(row0 + t) * INC + OFF_U + h * 128; bf16* yp = Y + (size_t)(row0 + t) * D + h * 128;
#pragma unroll
    for (int ct = 0; ct < 8; ++ct) { const int c = 16 * ct + 4 * fq; const u32x2 uu = *(const u32x2*)(up + c);
        const float y0 = geluf_(bflo(uu.x)) * (acc[ct][0] + wb), y1 = geluf_(bfhi(uu.x)) * (acc[ct][1] + wb), y2 = geluf_(bflo(uu.y)) * (acc[ct][2] + wb), y3 = geluf_(bfhi(uu.y)) * (acc[ct][3] + wb);
        u32x2 o; o.x = pk2(y0, y1); o.y = pk2(y2, y3); *(u32x2*)(yp + c) = o; }
    __syncthreads();
}

constexpr int SP_ = 72;
__device__ __forceinline__ int kperm_pos(int k) { const int s5 = k & 31; return (k & 32) + 8 * ((s5 >> 2) & 3) + 4 * (s5 >> 4) + (s5 & 3); }
__device__ __forceinline__ void rwkv_prep_item(KArgs a, int l, int tile, int hgrp, LAS unsigned char* lds) {
    const int tid = tid_fresh(), lane = tid & 63, wave = tid >> 6;
    unsigned char* ws = a->ws;
    const bf16* P = (const bf16*)(ws + WS_P); bf16* Y = (bf16*)(ws + WS_Y);
    LAS bf16* SR = (LAS bf16*)lds; LAS bf16* SK = SR + 64 * SP_; LAS bf16* SV = SK + 64 * SP_; LAS bf16* SKK = SV + 64 * SP_; LAS bf16* SB = SKK + 64 * SP_; LAS bf16* SWF = SB + 64 * SP_; LAS bf16* SWB = SWF + 64 * SP_;
    LAS bf16* tw = SWB + 64 * SP_;
    LAS bf16* adl = tw + 64 * SP_;
    LAS bf16* sg = adl + 64 * SP_;
    LAS float* invn = (LAS float*)(sg + 64 * 136);
    LAS unsigned char* wpriv = (LAS unsigned char*)(invn + 64) + wave * 6144;
    const int row0 = tile * 64; const bool isl = row0 < NLAT;
    const float* mu = a->in[I_MU] + (size_t)l * CCOLS;
    const char* Pb = (const char*)P;
    auto shift_group = [&](int tk, int col, float (&z)[8]) {
        const int row = row0 + tk; int o0, o1, o2, o3; bool v0, v1, v2, v3;
        if (isl) { const int gr = (row >> 6) & 63; o0 = -1; o1 = 1; o2 = -64; o3 = 64; v0 = tk > 0; v1 = tk < 63; v2 = gr > 0; v3 = gr < 63; }
        else { const int tc = (row - NLAT) & 255; o0 = -1; o1 = 1; o2 = -1; o3 = 1; v0 = tc > 0; v1 = tc < 255; v2 = v0; v3 = v1; }
        const unsigned off = (unsigned)row * (unsigned)(INC * 2) + (unsigned)(OFF_C + col) * 2u;
        const u32x4 uo = *(const u32x4*)(Pb + off), u0 = *(const u32x4*)(Pb + (off + (unsigned)((v0 ? o0 : 0) * INC * 2))), u1 = *(const u32x4*)(Pb + (off + (unsigned)((v1 ? o1 : 0) * INC * 2))),
                    u2 = *(const u32x4*)(Pb + (off + (unsigned)((v2 ? o2 : 0) * INC * 2))), u3 = *(const u32x4*)(Pb + (off + (unsigned)((v3 ? o3 : 0) * INC * 2)));
        const f32x4 m0 = *(const f32x4*)(mu + col), m1 = *(const f32x4*)(mu + col + 4);
        float own[8], n0[8], n1[8], n2[8], n3[8]; unpack8(uo, own); unpack8(u0, n0); unpack8(u1, n1); unpack8(u2, n2); unpack8(u3, n3);
        const float f0 = v0 ? 1.f : 0.f, f1 = v1 ? 1.f : 0.f, f2 = v2 ? 1.f : 0.f, f3 = v3 ? 1.f : 0.f;
        const float nb[8] = {n0[0] * f0, n1[1] * f1, n2[2] * f2, n3[3] * f3, n0[4] * f0, n1[5] * f1, n2[6] * f2, n3[7] * f3};
#pragma unroll
        for (int j = 0; j < 8; ++j) { const float mm = j < 4 ? m0[j] : m1[j - 4]; z[j] = own[j] + mm * (nb[j] - own[j]); }
    };
#pragma unroll
    for (int it = 0; it < 4; ++it) { const int g = tid + NTHREADS * it, tk = g >> 5, gi = g & 31;
        float z[8]; shift_group(tk, 2304 + gi * 8, z);
        if (gi < 8) { float t8[8];
#pragma unroll
            for (int j = 0; j < 8; ++j) t8[j] = 1.0f - 2.0f * __builtin_amdgcn_rcpf(1.0f + __expf(2.0f * z[j]));
            *(LAS u32x4*)(tw + tk * SP_ + gi * 8) = pack8(t8); }
        else if (gi < 16) *(LAS u32x4*)(adl + tk * SP_ + (gi - 8) * 8) = pack8(z);
        else { float t8[8];
#pragma unroll
            for (int j = 0; j < 8; ++j) t8[j] = sigmoidf_(z[j]);
            *(LAS u32x4*)(sg + tk * 136 + (gi - 16) * 8) = pack8(t8); } }
    __syncthreads();
#pragma unroll 1
    for (int hh = 0; hh < 4; ++hh) {
    const int tid = tid_fresh(), lane = tid & 63, wave = tid >> 6;
    const int head = 4 * hgrp + hh; const float* kkw = a->in[I_KK] + (size_t)l * CW + head * 64;
#pragma unroll
    for (int it = 0; it < 3; ++it) { const int g = tid + NTHREADS * it, tk = g / 24, gi = g % 24, c8 = (gi & 7) * 8;
        float z[8]; shift_group(tk, (gi >> 3) * 768 + head * 64 + c8, z);
        if (gi < 8) *(LAS u32x4*)(SR + tk * SP_ + c8) = pack8(z);
        else if (gi < 16) { *(LAS u32x4*)(SK + tk * SP_ + c8) = pack8(z);
            const f32x4 k0 = *(const f32x4*)(kkw + c8), k1 = *(const f32x4*)(kkw + c8 + 4); float ss = 0.f;
#pragma unroll
            for (int j = 0; j < 8; ++j) { const float q = z[j] * (j < 4 ? k0[j] : k1[j - 4]); ss += q * q; }
            ss += __shfl_xor(ss, 1); ss += __shfl_xor(ss, 2); ss += __shfl_xor(ss, 4);
            if ((gi & 7) == 0) invn[tk] = 1.0f / fmaxf(sqrtf(ss), 1e-12f); }
        else *(LAS u32x4*)(SV + tk * SP_ + c8) = pack8(z); }
    __syncthreads();
    {
        const int fr = lane & 15, fq = lane >> 4, nt = wave & 3, th = wave >> 2;
        const bf16* wupT = (const bf16*)(ws + WS_SMALLW + SW_WUP) + (size_t)l * 2 * 768 * 64;
        const bf16* aupT = (const bf16*)(ws + WS_SMALLW + SW_AUP) + (size_t)l * 768 * 64;
        const bf16* gupT = (const bf16*)(ws + WS_SMALLW + SW_GUP) + (size_t)l * 768 * 128;
        const float* a0 = a->in[I_A0] + (size_t)l * CW + head * 64; const float* kaw = a->in[I_KA] + (size_t)l * CW + head * 64; const float* w0 = a->in[I_W0] + (size_t)l * 2 * CW + head * 64;
        const int nloc = 16 * nt + 4 * fq;
#pragma unroll 1
        for (int mat = 0; mat < 4; ++mat) {
            const bf16* WT = mat == 0 ? aupT : (mat == 1 ? wupT : (mat == 2 ? wupT + 768 * 64 : gupT));
            const int KK = mat == 3 ? 128 : 64; const LAS bf16* act = mat == 0 ? adl : (mat == 3 ? sg : tw); const int apitch = mat == 3 ? 136 : SP_;
            f32x4 acc[2];
            acc[0] = (f32x4){0.f, 0.f, 0.f, 0.f}; acc[1] = acc[0];
            for (int ks = 0; ks < KK / 32; ++ks) { const bf16x8 afr = *(const bf16x8*)(WT + (size_t)(head * 64 + 16 * nt + fr) * KK + ks * 32 + fq * 8);
#pragma unroll
                for (int tt = 0; tt < 2; ++tt) { const bf16x8 bfr = *(const LAS bf16x8*)(act + (16 * (2 * th + tt) + fr) * apitch + ks * 32 + fq * 8); acc[tt] = __builtin_amdgcn_mfma_f32_16x16x32_bf16(afr, bfr, acc[tt], 0, 0, 0); } }
#pragma unroll
            for (int tt = 0; tt < 2; ++tt) { const int tk = 16 * (2 * th + tt) + fr; const f32x4 v = acc[tt];
                if (mat == 0) {
                    const f32x4 a0v = *(const f32x4*)(a0 + nloc), kav = *(const f32x4*)(kaw + nloc), kkv = *(const f32x4*)(kkw + nloc);
                    const u32x2 kp = *(const LAS u32x2*)(SK + tk * SP_ + nloc); const float kf[4] = {bflo(kp.x), bfhi(kp.x), bflo(kp.y), bfhi(kp.y)};
                    const float inn = invn[tk]; float k2[4], kk[4], bb[4];
#pragma unroll
                    for (int j = 0; j < 4; ++j) { const float av = sigmoidf_(a0v[j] + v[j]); kk[j] = kf[j] * kkv[j] * inn; k2[j] = kf[j] * (1.0f + (av - 1.0f) * kav[j]); bb[j] = kk[j] * av; }
                    u32x2 q; q.x = pk2(k2[0], k2[1]); q.y = pk2(k2[2], k2[3]); *(LAS u32x2*)(SK + tk * SP_ + nloc) = q;
                    q.x = pk2(kk[0], kk[1]); q.y = pk2(kk[2], kk[3]); *(LAS u32x2*)(SKK + tk * SP_ + nloc) = q;
                    q.x = pk2(bb[0], bb[1]); q.y = pk2(bb[2], bb[3]); *(LAS u32x2*)(SB + tk * SP_ + nloc) = q;
                } else if (mat <= 2) {
                    const f32x4 w0v = *(const f32x4*)(w0 + (mat - 1) * CW + nloc); float d[4];
#pragma unroll
                    for (int j = 0; j < 4; ++j) d[j] = __expf(-DECAY_SCALE * sigmoidf_(w0v[j] + v[j]));
                    u32x2 q; q.x = pk2(d[0], d[1]); q.y = pk2(d[2], d[3]); *(LAS u32x2*)((mat == 1 ? SWF : SWB) + tk * SP_ + nloc) = q;
                } else {
                    u32x2 q; q.x = pk2(v[0], v[1]); q.y = pk2(v[2], v[3]); *(u32x2*)(Y + (size_t)(row0 + tk) * D + 1280 + head * 64 + nloc) = q;
                }
            }
        }
    }
    __syncthreads();
    { const int tk = tid >> 3, c8 = (tid & 7) * 8; float r8[8], k8[8], v8[8];
      unpack8(*(const LAS u32x4*)(SR + tk * SP_ + c8), r8); unpack8(*(const LAS u32x4*)(SK + tk * SP_ + c8), k8); unpack8(*(const LAS u32x4*)(SV + tk * SP_ + c8), v8);
      const float* rkp = a->in[I_RK] + (size_t)l * CW + head * 64 + c8; const f32x4 rk0 = *(const f32x4*)rkp, rk1 = *(const f32x4*)(rkp + 4);
      float bs = 0.f;
#pragma unroll
      for (int j = 0; j < 8; ++j) bs += r8[j] * k8[j] * (j < 4 ? rk0[j] : rk1[j - 4]);
      bs += __shfl_xor(bs, 1); bs += __shfl_xor(bs, 2); bs += __shfl_xor(bs, 4);
#pragma unroll
      for (int j = 0; j < 8; ++j) v8[j] *= bs;
      *(u32x4*)(Y + (size_t)(row0 + tk) * D + 512 + head * 64 + c8) = pack8(v8); }
    {
        const int c4 = wave & 3, dir = wave >> 2, fr = lane & 15, fq = lane >> 4;
        LAS float* CB = (LAS float*)wpriv;
        LAS float* AA = CB + 16 * 64;
        const LAS bf16* SW = dir ? SWB : SWF;
        auto trow = [&](int tau) { return 16 * c4 + (dir ? 15 - tau : tau); };
        float c[16], ci[16];
        { float run = 1.f;
#pragma unroll
          for (int t = 0; t < 16; ++t) { run *= bf1(SW[trow(t) * SP_ + lane]); c[t] = run; ci[t] = __builtin_amdgcn_rcpf(run); CB[t * 64 + lane] = run; } }
        const int rec_dir = dir, bidx = isl ? (row0 >> 12) : ((row0 - NLAT) >> 8);
        const int tcl = isl ? 4 * ((row0 >> 6) & 63) + c4 : 4 * (((row0 - NLAT) >> 6) & 3) + c4;
        const int nproc = isl ? 16 + (dir ? 255 - tcl : tcl) : (dir ? 15 - tcl : tcl);
        unsigned char* rec = ws + WS_PRE + ((size_t)((rec_dir * 8 + bidx) * 12 + head) * NCHUNK16 + nproc) * PRE_REC;
        { const float cl = c[15]; float bk[32];
#pragma unroll
          for (int t = 0; t < 16; ++t) { const float e = cl * ci[t]; const int pos = 8 * (t >> 2) + (t & 3); bk[pos] = bf1(SB[trow(t) * SP_ + lane]) * e; bk[pos + 4] = bf1(SK[trow(t) * SP_ + lane]) * e; }
#pragma unroll
          for (int q4 = 0; q4 < 4; ++q4) { u32x4 o; o.x = pk2(bk[8 * q4], bk[8 * q4 + 1]); o.y = pk2(bk[8 * q4 + 2], bk[8 * q4 + 3]); o.z = pk2(bk[8 * q4 + 4], bk[8 * q4 + 5]); o.w = pk2(bk[8 * q4 + 6], bk[8 * q4 + 7]);
              *(u32x4*)(rec + PR_BK + lane * 64 + q4 * 16) = o; }
          *(float*)(rec + PR_GAM + lane * 4) = cl; }
        asm volatile("s_waitcnt lgkmcnt(0)" ::: "memory");
        bf16x8 fa[2], frr[2], fb[2], fk[2];
        { const int tr = trow(fr);
#pragma unroll
          for (int sx = 0; sx < 2; ++sx) { const int ch = 32 * sx + 8 * fq; float kk8[8], r8[8], b8[8], k8[8];
              unpack8(*(const LAS u32x4*)(SKK + tr * SP_ + ch), kk8); unpack8(*(const LAS u32x4*)(SR + tr * SP_ + ch), r8); unpack8(*(const LAS u32x4*)(SB + tr * SP_ + ch), b8); unpack8(*(const LAS u32x4*)(SK + tr * SP_ + ch), k8);
              const f32x4 c0 = *(const LAS f32x4*)(CB + fr * 64 + ch), c1 = *(const LAS f32x4*)(CB + fr * 64 + ch + 4);
              f32x4 p0 = (f32x4){1.f, 1.f, 1.f, 1.f}, p1 = p0; if (fr > 0) { p0 = *(const LAS f32x4*)(CB + (fr - 1) * 64 + ch); p1 = *(const LAS f32x4*)(CB + (fr - 1) * 64 + ch + 4); }
              float xa[8], xr[8], xb[8], xk[8];
#pragma unroll
              for (int j = 0; j < 8; ++j) { const float ec = j < 4 ? c0[j] : c1[j - 4], ep = j < 4 ? p0[j] : p1[j - 4]; const float en = __builtin_amdgcn_rcpf(ec);
                  xa[j] = -kk8[j] * ep; xr[j] = r8[j] * ec; xb[j] = b8[j] * en; xk[j] = k8[j] * en; }
              const u32x4 ua = pack8(xa), ur = pack8(xr), ub = pack8(xb), uk = pack8(xk);
              fa[sx] = __builtin_bit_cast(bf16x8, ua); frr[sx] = __builtin_bit_cast(bf16x8, ur); fb[sx] = __builtin_bit_cast(bf16x8, ub); fk[sx] = __builtin_bit_cast(bf16x8, uk); } }
        f32x4 gab = (f32x4){0.f, 0.f, 0.f, 0.f}, gak = gab, grb = gab, grk = gab;
#pragma unroll
        for (int sx = 0; sx < 2; ++sx) { gab = __builtin_amdgcn_mfma_f32_16x16x32_bf16(fa[sx], fb[sx], gab, 0, 0, 0); gak = __builtin_amdgcn_mfma_f32_16x16x32_bf16(fa[sx], fk[sx], gak, 0, 0, 0);
            grb = __builtin_amdgcn_mfma_f32_16x16x32_bf16(frr[sx], fb[sx], grb, 0, 0, 0); grk = __builtin_amdgcn_mfma_f32_16x16x32_bf16(frr[sx], fk[sx], grk, 0, 0, 0); }
#pragma unroll
        for (int j = 0; j < 4; ++j) { const int tau = 4 * fq + j; const bool lo = fr < tau, le = fr <= tau;
            AA[tau * 16 + fr] = lo ? gab[j] : 0.f; AA[256 + tau * 16 + fr] = lo ? gak[j] : 0.f; grb[j] = le ? grb[j] : 0.f; grk[j] = le ? grk[j] : 0.f; }
        asm volatile("s_waitcnt lgkmcnt(0)" ::: "memory");
        float wv[16], mv[16];
#pragma unroll
        for (int t = 0; t < 16; ++t) { const float ab = -bf1(SKK[trow(t) * SP_ + lane]) * (t > 0 ? c[t - 1] : 1.0f); float accw = ab, accm = AA[256 + t * 16 + fr];
#pragma unroll
            for (int q4 = 0; q4 < 4; ++q4) { if (4 * q4 < t) { const f32x4 cf = *(const LAS f32x4*)(AA + t * 16 + 4 * q4);
#pragma unroll
                for (int j = 0; j < 4; ++j) if (4 * q4 + j < t) { accw += cf[j] * wv[4 * q4 + j]; accm += cf[j] * mv[4 * q4 + j]; } } }
            wv[t] = accw; mv[t] = accm; }
        { LAS bf16* stg = (LAS bf16*)CB; const int pp = kperm_pos(lane);
#pragma unroll
          for (int t = 0; t < 16; ++t) { stg[t * 64 + pp] = (bf16)f2bf(wv[t]); stg[1024 + t * 64 + pp] = (bf16)f2bf(bf1(SR[trow(t) * SP_ + lane]) * c[t]); }
          asm volatile("s_waitcnt lgkmcnt(0)" ::: "memory");
#pragma unroll
          for (int q4 = 0; q4 < 4; ++q4) *(u32x4*)(rec + PR_WP + (q4 * 64 + lane) * 16) = *(const LAS u32x4*)((LAS unsigned char*)stg + (q4 * 64 + lane) * 16); }
        { LAS bf16* stg = (LAS bf16*)AA; const int ps = 8 * (fr >> 2) + (fr & 3);
          asm volatile("s_waitcnt lgkmcnt(0)" ::: "memory");
#pragma unroll
          for (int j = 0; j < 4; ++j) { const int tau = 4 * fq + j; stg[tau * 32 + ps] = (bf16)f2bf(grb[j]); stg[tau * 32 + ps + 4] = (bf16)f2bf(grk[j]); }
          if (lane < 16) {
#pragma unroll
              for (int t = 0; t < 16; ++t) stg[512 + t * 16 + lane] = (bf16)f2bf(mv[t]); }
          asm volatile("s_waitcnt lgkmcnt(0)" ::: "memory");
          *(u32x4*)(rec + PR_ARBK + lane * 16) = *(const LAS u32x4*)((LAS unsigned char*)stg + lane * 16);
          if (lane < 32) *(u32x4*)(rec + PR_ARBK + 1024 + lane * 16) = *(const LAS u32x4*)((LAS unsigned char*)stg + 1024 + lane * 16); }
        if (dir == 0) { float v16[16];
#pragma unroll
            for (int t = 0; t < 16; ++t) v16[t] = bf1(SV[(16 * c4 + t) * SP_ + lane]);
            const int tcg = isl ? 16 + tcl : tcl;
            unsigned char* vrec = ws + WS_VT + ((size_t)(bidx * 12 + head) * NCHUNK16 + tcg) * 2048 + lane * 32;
            u32x4 o; o.x = pk2(v16[0], v16[1]); o.y = pk2(v16[2], v16[3]); o.z = pk2(v16[4], v16[5]); o.w = pk2(v16[6], v16[7]); *(u32x4*)vrec = o;
            o.x = pk2(v16[8], v16[9]); o.y = pk2(v16[10], v16[11]); o.z = pk2(v16[12], v16[13]); o.w = pk2(v16[14], v16[15]); *(u32x4*)(vrec + 16) = o; }
    }
    __syncthreads();
    }
}

__device__ __forceinline__ float dpp_xor1(float x) { return __builtin_bit_cast(float, __builtin_amdgcn_update_dpp(0, __builtin_bit_cast(int, x), 0xB1, 0xF, 0xF, false)); }
__device__ __forceinline__ float dpp_xor2(float x) { return __builtin_bit_cast(float, __builtin_amdgcn_update_dpp(0, __builtin_bit_cast(int, x), 0x4E, 0xF, 0xF, false)); }
__device__ __forceinline__ int chain_row(int dir, int b, int s) {
    if (s < CTXL) return NLAT + b * CTXL + (dir ? (CTXL - 1 - s) : s);
    const int t = s - CTXL; return b * T + (dir ? (T - 1 - t) : t);
}
__device__ __forceinline__ float dpp_hmirror(float x) { return __builtin_bit_cast(float, __builtin_amdgcn_update_dpp(0, __builtin_bit_cast(int, x), 0x141, 0xF, 0xF, false)); }
struct RwRec { u32x4 wp[2], rp[2], bk[4], arbk; u32x2 mak, vt[2]; f32x4 gam[4]; };
__device__ __forceinline__ void rw_load(RwRec& r, const LAS unsigned char* rec, int fr, int kg, int hv, int dir) {
#pragma unroll
    for (int sx = 0; sx < 2; ++sx) { r.wp[sx] = *(const LAS u32x4*)(rec + PR_WP + fr * 128 + sx * 64 + kg * 16); r.rp[sx] = *(const LAS u32x4*)(rec + PR_RP + fr * 128 + sx * 64 + kg * 16); }
#pragma unroll
    for (int i = 0; i < 4; ++i) { r.bk[i] = *(const LAS u32x4*)(rec + PR_BK + (16 * i + fr) * 64 + kg * 16); r.gam[i] = *(const LAS f32x4*)(rec + PR_GAM + (16 * i + 4 * kg) * 4); }
    r.arbk = *(const LAS u32x4*)(rec + PR_ARBK + fr * 64 + kg * 16);
    r.mak = *(const LAS u32x2*)(rec + PR_MAK + fr * 32 + kg * 8);
#pragma unroll
    for (int q = 0; q < 2; ++q) r.vt[q] = *(const LAS u32x2*)(rec + PRE_REC + (16 * (2 * hv + q) + fr) * 32 + (dir ? (12 - 4 * kg) : 4 * kg) * 2);
}
constexpr int RW_R = 6, RW_SLOT = PRE_REC + 2048;
__device__ __forceinline__ void rwkv_chain_mfma(KArgs a, int task_base, LAS unsigned char* lds) {
    const int t_ = tid_fresh(); const int lane = t_ & 63, fr = lane & 15, kg = lane >> 4; const int wave = __builtin_amdgcn_readfirstlane(t_ >> 6);
    unsigned char* ws = a->ws;
    bf16* OC = (bf16*)(ws + WS_OC);
    const int cid = (task_base >> 2) + (wave >> 2), wq = wave & 3, dir = cid / 96, b = (cid % 96) / 12, h = cid % 12;
    const bool comp = wq < 2; const int hv = wq & 1;
    const unsigned char* rec0 = ws + WS_PRE + (size_t)((dir * 8 + b) * 12 + h) * NCHUNK16 * PRE_REC;
    const unsigned char* vrec0 = ws + WS_VT + (size_t)(b * 12 + h) * NCHUNK16 * 2048;
    LAS unsigned char* ring = lds + (wave >> 2) * (RW_R * RW_SLOT);
    auto tchunk = [&](int n) { return n < 16 ? (dir ? 15 - n : n) : 16 + (dir ? 255 - (n - 16) : (n - 16)); };
    auto issue = [&](int n) { const int nn = n < NCHUNK16 ? n : NCHUNK16 - 1; LAS unsigned char* slot = ring + (n % RW_R) * RW_SLOT;
#pragma unroll
        for (int jj = 0; jj < 3; ++jj) { const int j = 3 * wq + jj;
            const unsigned char* src = (j < 10 ? rec0 + (size_t)nn * PRE_REC + 1024 * j : vrec0 + (size_t)tchunk(nn) * 2048 + 1024 * (j - 10)) + lane * 16;
            __builtin_amdgcn_global_load_lds((const unsigned*)src, (LAS unsigned*)(slot + 1024 * j), 16, 0, 0); } };
    f32x4 ST[2][4];
#pragma unroll
    for (int q = 0; q < 2; ++q)
#pragma unroll
        for (int i = 0; i < 4; ++i) ST[q][i] = (f32x4){0.f, 0.f, 0.f, 0.f};
    unsigned uvU[2][2] = {{0u, 0u}, {0u, 0u}};
#pragma unroll
    for (int n = 0; n < RW_R - 1; ++n) issue(n);
    for (int n = 0; n < NCHUNK16; ++n) {
        asm volatile("s_waitcnt vmcnt(12)" ::: "memory");
        __builtin_amdgcn_s_barrier(); asm volatile("" ::: "memory");
        issue(n + RW_R - 1);
        if (comp) {
            RwRec cur; rw_load(cur, ring + (n % RW_R) * RW_SLOT, fr, kg, hv, dir);
            u32x4 fmak; fmak.x = 0u; fmak.y = 0u; fmak.z = cur.mak.x; fmak.w = cur.mak.y;
            const int row = chain_row(dir, b, 16 * n + fr);
#pragma unroll
            for (int q = 0; q < 2; ++q) {
                u32x4 fs[2];
#pragma unroll
                for (int sx = 0; sx < 2; ++sx) { fs[sx].x = pk2(ST[q][2 * sx][0], ST[q][2 * sx][1]); fs[sx].y = pk2(ST[q][2 * sx][2], ST[q][2 * sx][3]); fs[sx].z = pk2(ST[q][2 * sx + 1][0], ST[q][2 * sx + 1][1]); fs[sx].w = pk2(ST[q][2 * sx + 1][2], ST[q][2 * sx + 1][3]); }
                u32x2 vt = cur.vt[q]; if (dir) { const unsigned x = vt.x, y = vt.y; vt.x = (y >> 16) | (y << 16); vt.y = (x >> 16) | (x << 16); }
                u32x4 fuv; fuv.x = uvU[q][0]; fuv.y = uvU[q][1]; fuv.z = vt.x; fuv.w = vt.y;
                f32x4 U = (f32x4){0.f, 0.f, 0.f, 0.f};
                U = __builtin_amdgcn_mfma_f32_16x16x32_bf16(__builtin_bit_cast(bf16x8, cur.wp[0]), __builtin_bit_cast(bf16x8, fs[0]), U, 0, 0, 0);
                U = __builtin_amdgcn_mfma_f32_16x16x32_bf16(__builtin_bit_cast(bf16x8, cur.wp[1]), __builtin_bit_cast(bf16x8, fs[1]), U, 0, 0, 0);
                U = __builtin_amdgcn_mfma_f32_16x16x32_bf16(__builtin_bit_cast(bf16x8, fmak), __builtin_bit_cast(bf16x8, fuv), U, 0, 0, 0);
                uvU[q][0] = pk2(U[0], U[1]); uvU[q][1] = pk2(U[2], U[3]); fuv.x = uvU[q][0]; fuv.y = uvU[q][1];
                f32x4 OT = (f32x4){0.f, 0.f, 0.f, 0.f};
                OT = __builtin_amdgcn_mfma_f32_16x16x32_bf16(__builtin_bit_cast(bf16x8, fs[0]), __builtin_bit_cast(bf16x8, cur.rp[0]), OT, 0, 0, 0);
                OT = __builtin_amdgcn_mfma_f32_16x16x32_bf16(__builtin_bit_cast(bf16x8, fs[1]), __builtin_bit_cast(bf16x8, cur.rp[1]), OT, 0, 0, 0);
                OT = __builtin_amdgcn_mfma_f32_16x16x32_bf16(__builtin_bit_cast(bf16x8, fuv), __builtin_bit_cast(bf16x8, cur.arbk), OT, 0, 0, 0);
#pragma unroll
                for (int i = 0; i < 4; ++i) ST[q][i] = __builtin_amdgcn_mfma_f32_16x16x32_bf16(__builtin_bit_cast(bf16x8, cur.bk[i]), __builtin_bit_cast(bf16x8, fuv), ST[q][i] * cur.gam[i], 0, 0, 0);
                u32x2 o; o.x = pk2(OT[0], OT[1]); o.y = pk2(OT[2], OT[3]); *(u32x2*)(OC + ((size_t)dir * MALL + row) * CW + h * 64 + 16 * (2 * hv + q) + 4 * kg) = o;
            }
        }
    }
    asm volatile("s_waitcnt vmcnt(0)" ::: "memory");
    __builtin_amdgcn_s_barrier(); asm volatile("" ::: "memory");
}
#define LDS_BAR() do { asm volatile("s_waitcnt lgkmcnt(0)" ::: "memory"); __builtin_amdgcn_s_barrier(); asm volatile("" ::: "memory"); } while (0)
__device__ __forceinline__ void hgrn_prep_item(KArgs a, int l, int item, LAS unsigned char* lds, bool dry) {
    const int tid = tid_fresh();
    unsigned char* ws = a->ws;
    bf16* P = (bf16*)(ws + WS_P); bf16* HQB = (bf16*)(ws + WS_HQB); float* HG = (float*)(ws + WS_HG);
    const int cn = item % 68, bh = item / 68, h = bh % 6, b = bh / 6;
    const int row0 = cn < 4 ? NLAT + b * CTXL + 64 * cn : b * T + 64 * (cn - 4);
    constexpr int QP = 136;
    LAS bf16* SQ = (LAS bf16*)lds; LAS bf16* KF = SQ + 64 * QP; LAS bf16* KB = KF + 64 * QP; LAS bf16* QB = KB + 64 * QP;
    LAS float* LF = (LAS float*)(QB + 64 * QP); LAS float* LBk = LF + 64 * 128;
    LAS float* tot = LBk + 64 * 128;
    LAS float* lbs = tot + 1024;
    if (tid < 256) { const int dr = tid >> 7, ch = h * 128 + (tid & 127); float lb = 0.f;
        if (l != 0) { const float l0 = a->in[I_LB][((size_t)dr * DEPTH + 0) * BW + ch], l1 = a->in[I_LB][((size_t)dr * DEPTH + 1) * BW + ch]; lb = __builtin_amdgcn_rcpf(1.0f + __expf(l0 - l1)); }
        lbs[tid] = lb; }
    const int ta = tid >> 3, d0 = (tid & 7) * 16;
    bf16* prow = P + (size_t)(row0 + ta) * INC + h * 128 + d0;
    u32x4 rq[2], rf[2], rb[2];
    rq[0] = *(const u32x4*)(prow + OFF_Q); rq[1] = *(const u32x4*)(prow + OFF_Q + 8); rf[0] = *(const u32x4*)(prow + OFF_ZF); rf[1] = *(const u32x4*)(prow + OFF_ZF + 8); rb[0] = *(const u32x4*)(prow + OFF_ZB); rb[1] = *(const u32x4*)(prow + OFF_ZB + 8);
    __syncthreads();
#pragma unroll
    for (int hf = 0; hf < 2; ++hf) { float qf[8], zf[8], zb[8], oq[8], of[8], ob[8]; unpack8(rq[hf], qf); unpack8(rf[hf], zf); unpack8(rb[hf], zb);
        const int dd = d0 + 8 * hf; f32x4 lf0, lf1, lb0, lb1;
#pragma unroll
        for (int j = 0; j < 8; ++j) { const float lF = lbs[dd + j], lB = lbs[128 + dd + j];
            const float ff = lF + (1.0f - lF) * sigmoidf_(zf[j]), fb = lB + (1.0f - lB) * sigmoidf_(zb[j]);
            const float a1 = fmaxf(__logf(ff), -60.0f), a2 = fmaxf(__logf(fb), -60.0f);
            if (j < 4) { lf0[j] = a1; lb0[j] = a2; } else { lf1[j - 4] = a1; lb1[j - 4] = a2; }
            oq[j] = siluf_(qf[j]); of[j] = 1.0f - ff; ob[j] = 1.0f - fb; }
        *(LAS u32x4*)(SQ + ta * QP + dd) = pack8(oq); *(LAS u32x4*)(KF + ta * QP + dd) = pack8(of); *(LAS u32x4*)(KB + ta * QP + dd) = pack8(ob);
        *(LAS f32x4*)(LF + ta * 128 + dd) = lf0; *(LAS f32x4*)(LF + ta * 128 + dd + 4) = lf1; *(LAS f32x4*)(LBk + ta * 128 + dd) = lb0; *(LAS f32x4*)(LBk + ta * 128 + dd + 4) = lb1; }
    __syncthreads();
    { const int d = tid & 127, qt = tid >> 7; float r1 = 0.f, r2 = 0.f;
#pragma unroll
      for (int i = 0; i < 16; ++i) { const int tp = 16 * qt + i; r1 += LF[tp * 128 + d]; LF[tp * 128 + d] = r1; r2 += LBk[(63 - tp) * 128 + d]; LBk[(63 - tp) * 128 + d] = r2; }
      tot[qt * 128 + d] = r1; tot[512 + qt * 128 + d] = r2; }
    __syncthreads();
    LAS float* bas = lbs + 256;
    LAS float* bmd = bas + 1024;
    { const int d = tid & 127, dr = (tid >> 7) & 1; if (tid < 256) { const LAS float* tt = tot + 512 * dr; const float t0 = tt[d], t1 = tt[128 + d], t2 = tt[256 + d], t3 = tt[384 + d];
        bas[(dr * 4 + 0) * 128 + d] = 0.f; bas[(dr * 4 + 1) * 128 + d] = t0; bas[(dr * 4 + 2) * 128 + d] = t0 + t1; bas[(dr * 4 + 3) * 128 + d] = t0 + t1 + t2; bmd[dr * 128 + d] = t0 + t1;
        const int npr = dr == 0 ? cn : (cn < 4 ? 3 - cn : 4 + 63 - (cn - 4)); float* g = (dry ? (float*)(ws + WS_END + 8 * MiB) : HG) + ((size_t)(((dr * 8 + b) * 6 + h) * 68 + npr)) * 256; g[d] = __expf(t0 + t1); g[128 + d] = __expf(t2 + t3); } }
    __syncthreads();
#pragma unroll
    for (int hf = 0; hf < 2; ++hf) { const int dd = d0 + 8 * hf; float sq[8], kf[8], kb[8];
        unpack8(*(const LAS u32x4*)(SQ + ta * QP + dd), sq); unpack8(*(const LAS u32x4*)(KF + ta * QP + dd), kf); unpack8(*(const LAS u32x4*)(KB + ta * QP + dd), kb);
        float oqf[8], okf[8], oqb[8], okb[8];
#pragma unroll
        for (int dr = 0; dr < 2; ++dr) { const int tp = dr ? 63 - ta : ta, q = tp >> 4; const LAS float* pf = (dr ? LBk : LF) + ta * 128 + dd;
            const f32x4 p0 = *(const LAS f32x4*)pf, p1 = *(const LAS f32x4*)(pf + 4), b0 = *(const LAS f32x4*)(bas + (dr * 4 + q) * 128 + dd), b1 = *(const LAS f32x4*)(bas + (dr * 4 + q) * 128 + dd + 4),
                        m0 = *(const LAS f32x4*)(bmd + dr * 128 + dd), m1 = *(const LAS f32x4*)(bmd + dr * 128 + dd + 4);
#pragma unroll
            for (int j = 0; j < 8; ++j) { const float bt = (j < 4 ? p0[j] + b0[j] : p1[j - 4] + b1[j - 4]), bm = j < 4 ? m0[j] : m1[j - 4];
                const float eq = __expf(fminf(bt - bm, 80.0f)), ek = __expf(fminf(bm - bt, 80.0f));
                if (dr == 0) { oqf[j] = sq[j] * eq; okf[j] = kf[j] * ek; } else { oqb[j] = sq[j] * eq; okb[j] = kb[j] * ek; } } }
        *(LAS u32x4*)(QB + ta * QP + dd) = pack8(oqf); *(LAS u32x4*)(KF + ta * QP + dd) = pack8(okf); *(LAS u32x4*)(KB + ta * QP + dd) = pack8(okb); *(LAS u32x4*)(SQ + ta * QP + dd) = pack8(oqb); }
    bf16* prow_o = dry ? (bf16*)(ws + WS_END) + (size_t)((row0 + ta) & 511) * INC + h * 128 + d0 : prow; bf16* hqb_o = dry ? (bf16*)(ws + WS_END) : HQB;
#pragma unroll
    for (int hf = 0; hf < 2; ++hf) { const int dd = d0 + 8 * hf;
        *(u32x4*)(prow_o + OFF_Q + 8 * hf) = *(const LAS u32x4*)(QB + ta * QP + dd); *(u32x4*)(prow_o + OFF_ZF + 8 * hf) = *(const LAS u32x4*)(KF + ta * QP + dd); *(u32x4*)(prow_o + OFF_ZB + 8 * hf) = *(const LAS u32x4*)(KB + ta * QP + dd);
        *(u32x4*)(hqb_o + (size_t)(dry ? ((row0 + ta) & 1023) : (row0 + ta)) * BW + h * 128 + dd) = *(const LAS u32x4*)(SQ + ta * QP + dd); }
    __syncthreads();
}
__device__ __forceinline__ unsigned tr_addr(const LAS bf16* X, int pitch, int r0, int c0, int lane) { const int i = lane & 15, g = lane >> 4; return (unsigned)(size_t)(X + (r0 + 8 * g + (i >> 2)) * pitch + c0 + 4 * (i & 3)); }
__device__ __forceinline__ void tr8x4(u32x2 (&lo)[4], u32x2 (&hi)[4], unsigned a0, unsigned a1, unsigned a2, unsigned a3, unsigned rowstep4) {
    const unsigned b0 = a0 + rowstep4, b1 = a1 + rowstep4, b2 = a2 + rowstep4, b3 = a3 + rowstep4;
    asm volatile("ds_read_b64_tr_b16 %0, %8\n\tds_read_b64_tr_b16 %1, %9\n\tds_read_b64_tr_b16 %2, %10\n\tds_read_b64_tr_b16 %3, %11\n\t"
                 "ds_read_b64_tr_b16 %4, %12\n\tds_read_b64_tr_b16 %5, %13\n\tds_read_b64_tr_b16 %6, %14\n\tds_read_b64_tr_b16 %7, %15\n\ts_waitcnt lgkmcnt(0)"
                 : "=&v"(lo[0]), "=&v"(lo[1]), "=&v"(lo[2]), "=&v"(lo[3]), "=&v"(hi[0]), "=&v"(hi[1]), "=&v"(hi[2]), "=&v"(hi[3])
                 : "v"(a0), "v"(a1), "v"(a2), "v"(a3), "v"(b0), "v"(b1), "v"(b2), "v"(b3) : "memory");
}
__device__ __forceinline__ void tr_half(u32x2 (&vl)[8], u32x2 (&vh)[8], u32x2 (&xl)[2], u32x2 (&xh)[2], unsigned av, unsigned ak, unsigned ax) {
    asm volatile(
        "ds_read_b64_tr_b16 %0, %20\n\tds_read_b64_tr_b16 %1, %20 offset:32\n\tds_read_b64_tr_b16 %2, %20 offset:64\n\tds_read_b64_tr_b16 %3, %20 offset:96\n\t"
        "ds_read_b64_tr_b16 %4, %20 offset:128\n\tds_read_b64_tr_b16 %5, %20 offset:160\n\tds_read_b64_tr_b16 %6, %20 offset:192\n\tds_read_b64_tr_b16 %7, %20 offset:224\n\t"
        "ds_read_b64_tr_b16 %8, %20 offset:1088\n\tds_read_b64_tr_b16 %9, %20 offset:1120\n\tds_read_b64_tr_b16 %10, %20 offset:1152\n\tds_read_b64_tr_b16 %11, %20 offset:1184\n\t"
        "ds_read_b64_tr_b16 %12, %20 offset:1216\n\tds_read_b64_tr_b16 %13, %20 offset:1248\n\tds_read_b64_tr_b16 %14, %20 offset:1280\n\tds_read_b64_tr_b16 %15, %20 offset:1312\n\t"
        "ds_read_b64_tr_b16 %16, %21\n\tds_read_b64_tr_b16 %17, %22\n\tds_read_b64_tr_b16 %18, %21 offset:1088\n\tds_read_b64_tr_b16 %19, %22 offset:1088\n\ts_waitcnt lgkmcnt(0)"
        : "=&v"(vl[0]), "=&v"(vl[1]), "=&v"(vl[2]), "=&v"(vl[3]), "=&v"(vl[4]), "=&v"(vl[5]), "=&v"(vl[6]), "=&v"(vl[7]),
          "=&v"(vh[0]), "=&v"(vh[1]), "=&v"(vh[2]), "=&v"(vh[3]), "=&v"(vh[4]), "=&v"(vh[5]), "=&v"(vh[6]), "=&v"(vh[7]),
          "=&v"(xl[0]), "=&v"(xl[1]), "=&v"(xh[0]), "=&v"(xh[1])
        : "v"(av), "v"(ak), "v"(ax) : "memory");
}
__device__ __forceinline__ bf16x8 mk8(u32x2 lo, u32x2 hi) { u32x4 v; v.x = lo.x; v.y = lo.y; v.z = hi.x; v.w = hi.y; return __builtin_bit_cast(bf16x8, v); }
__device__ __forceinline__ void hgrn_chain_lean(KArgs a, int cid, LAS unsigned char* lds) {
    const int tid = tid_fresh(), lane = tid & 63, wave = tid >> 6, fr = lane & 15, fq = lane >> 4;
    unsigned char* ws = a->ws;
    const bf16* P = (const bf16*)(ws + WS_P); const bf16* HQB = (const bf16*)(ws + WS_HQB); const float* HG = (const float*)(ws + WS_HG); bf16* OB = (bf16*)(ws + WS_OB);
    const int dir = cid / 48, b = (cid % 48) / 6, h = cid % 6;
    constexpr int QP = 136, SP = 72;
    LAS bf16* qs = (LAS bf16*)lds;
    LAS bf16* ks = qs + 64 * QP;
    LAS bf16* vs = ks + 64 * QP;
    LAS bf16* pl = vs + 64 * QP;
    LAS bf16* sT = pl + 64 * SP;
    LAS float* gm = (LAS float*)(sT + 128 * QP);
    const int ta = tid >> 3, d0 = (tid & 7) * 16;
    const int koff = dir ? OFF_ZB : OFF_ZF;
    f32x4 S[8];
#pragma unroll
    for (int vt = 0; vt < 8; ++vt) S[vt] = (f32x4){0.f, 0.f, 0.f, 0.f};
    u32x4 rq[2], rk[2], rv[2]; float rg = 0.f;
    auto load_chunk = [&](int n) { const int row = chain_row(dir, b, 64 * n + ta); const bf16* pr = P + (size_t)row * INC + h * 128 + d0;
        const bf16* qr = dir ? HQB + (size_t)row * BW + h * 128 + d0 : pr + OFF_Q;
        rq[0] = *(const u32x4*)qr; rq[1] = *(const u32x4*)(qr + 8); rk[0] = *(const u32x4*)(pr + koff); rk[1] = *(const u32x4*)(pr + koff + 8); rv[0] = *(const u32x4*)(pr + OFF_I); rv[1] = *(const u32x4*)(pr + OFF_I + 8);
        if (tid < 256) rg = HG[((size_t)(((dir * 8 + b) * 6 + h) * 68 + n)) * 256 + tid]; };
    load_chunk(0);
    constexpr int NCH = (CTXL + T) / 64;
    for (int n = 0; n < NCH; ++n) {
        const int s0 = n * 64;
        *(LAS u32x4*)(qs + ta * QP + d0) = rq[0]; *(LAS u32x4*)(qs + ta * QP + d0 + 8) = rq[1]; *(LAS u32x4*)(ks + ta * QP + d0) = rk[0]; *(LAS u32x4*)(ks + ta * QP + d0 + 8) = rk[1];
        *(LAS u32x4*)(vs + ta * QP + d0) = rv[0]; *(LAS u32x4*)(vs + ta * QP + d0 + 8) = rv[1]; if (tid < 256) gm[tid] = rg;
        if (n + 1 < NCH) load_chunk(n + 1);
        LDS_BAR();
        { const f32x4 g4 = *(const LAS f32x4*)(gm + 16 * wave + 4 * fq);
#pragma unroll
          for (int vt = 0; vt < 8; ++vt) { S[vt] = S[vt] * g4; u32x2 o; o.x = pk2(S[vt][0], S[vt][1]); o.y = pk2(S[vt][2], S[vt][3]); *(LAS u32x2*)(sT + (16 * vt + fr) * QP + 16 * wave + 4 * fq) = o; } }
        { const int tt = wave >> 1;
#pragma unroll
          for (int u = 0; u < 2; ++u) { const int sg = 2 * (wave & 1) + u; f32x4 acc = (f32x4){0.f, 0.f, 0.f, 0.f};
              if (sg <= tt) {
#pragma unroll
                  for (int kq = 0; kq < 4; ++kq) { const bf16x8 af = *(const LAS bf16x8*)(ks + (16 * sg + fr) * QP + 32 * kq + 8 * fq), bfm = *(const LAS bf16x8*)(qs + (16 * tt + fr) * QP + 32 * kq + 8 * fq);
                      acc = __builtin_amdgcn_mfma_f32_16x16x32_bf16(af, bfm, acc, 0, 0, 0); }
                  if (sg == tt) {
#pragma unroll
                      for (int j = 0; j < 4; ++j) if (4 * fq + j > fr) acc[j] = 0.f; }
              }
              u32x2 o; o.x = pk2(acc[0], acc[1]); o.y = pk2(acc[2], acc[3]); *(LAS u32x2*)(pl + (16 * tt + fr) * SP + 16 * sg + 4 * fq) = o; } }
        LDS_BAR();
        f32x4 oacc[4];
#pragma unroll
        for (int tt = 0; tt < 4; ++tt) { f32x4 acc = (f32x4){0.f, 0.f, 0.f, 0.f};
#pragma unroll
            for (int kq = 0; kq < 4; ++kq) { const bf16x8 af = *(const LAS bf16x8*)(sT + (16 * wave + fr) * QP + 32 * kq + 8 * fq), bfm = *(const LAS bf16x8*)(qs + (16 * tt + fr) * QP + 32 * kq + 8 * fq);
                acc = __builtin_amdgcn_mfma_f32_16x16x32_bf16(af, bfm, acc, 0, 0, 0); }
            oacc[tt] = acc; }
        const unsigned rs4 = (unsigned)(4 * QP * 2);
#pragma unroll
        for (int kq = 0; kq < 2; ++kq) {
            u32x2 vl_[8], vh_[8], xl_[2], xh_[2];
            static_assert(QP == 136, "tr_half's immediates assume 272-byte rows");
            tr_half(vl_, vh_, xl_, xh_, tr_addr(vs, QP, 32 * kq, 0, lane), tr_addr(ks, QP, 32 * kq, 16 * wave, lane), tr_addr(vs, QP, 32 * kq, 16 * wave, lane));
            __builtin_amdgcn_sched_barrier(0);
            { const bf16x8 af = mk8(xl_[1], xh_[1]);
#pragma unroll
              for (int tt = 0; tt < 4; ++tt) { const bf16x8 bfm = *(const LAS bf16x8*)(pl + (16 * tt + fr) * SP + 32 * kq + 8 * fq); oacc[tt] = __builtin_amdgcn_mfma_f32_16x16x32_bf16(af, bfm, oacc[tt], 0, 0, 0); } }
            { const bf16x8 af = mk8(xl_[0], xh_[0]);
#pragma unroll
              for (int vt = 0; vt < 8; ++vt) S[vt] = __builtin_amdgcn_mfma_f32_16x16x32_bf16(af, mk8(vl_[vt], vh_[vt]), S[vt], 0, 0, 0); }
        }
#pragma unroll
        for (int tt = 0; tt < 4; ++tt) { const int row = chain_row(dir, b, s0 + 16 * tt + fr);
            u32x2 o; o.x = pk2(oacc[tt][0], oacc[tt][1]); o.y = pk2(oacc[tt][2], oacc[tt][3]); *(u32x2*)(OB + ((size_t)dir * MALL + row) * BW + h * 128 + 16 * wave + 4 * fq) = o; }
        { const f32x4 ge = *(const LAS f32x4*)(gm + 128 + 16 * wave + 4 * fq);
#pragma unroll
          for (int vt = 0; vt < 8; ++vt) S[vt] = S[vt] * ge; }
        LDS_BAR();
    }
}
__device__ __forceinline__ void hgrn_chain_mfma(KArgs a, int l, int cid, LAS unsigned char* lds) {
    const int tid = tid_fresh(), lane = tid & 63, wave = tid >> 6, fr = lane & 15, fq = lane >> 4;
    unsigned char* ws = a->ws;
    const bf16* P = (const bf16*)(ws + WS_P); bf16* OB = (bf16*)(ws + WS_OB);
    const int dir = cid / 48, b = (cid % 48) / 6, h = cid % 6;
    constexpr int QP = 136, SP = 72;
    LAS bf16* qs = (LAS bf16*)lds;
    LAS bf16* ks = qs + 64 * QP;
    LAS bf16* kT = ks + 64 * QP;
    LAS bf16* vT = kT + 128 * SP;
    LAS bf16* pl = vT + 128 * SP;
    LAS bf16* sT = pl + 64 * SP;
    LAS float* tot = (LAS float*)(sT + 128 * QP);
    LAS float* gmid = tot + 512;
    LAS float* gend = gmid + 128;
    LAS float* lbs = gend + 128;
    LAS float* lfb = (LAS float*)sT;
    const int d = tid & 127, qt = tid >> 7;
    const int tau_a = tid >> 3, d0 = (tid & 7) * 16;
    if (tid < 128) { const int ch = h * 128 + tid; float lb = 0.f;
        if (l != 0) { const float l0 = a->in[I_LB][((size_t)dir * DEPTH + 0) * BW + ch], l1 = a->in[I_LB][((size_t)dir * DEPTH + 1) * BW + ch]; lb = 1.0f / (1.0f + __expf(l0 - l1)); }
        lbs[tid] = lb; }
    f32x4 S[8];
#pragma unroll
    for (int vt = 0; vt < 8; ++vt) S[vt] = (f32x4){0.f, 0.f, 0.f, 0.f};
    const int zoff = dir ? OFF_ZB : OFF_ZF;
    u32x4 rq[2], ri[2], rz[2];
    { const bf16* pr = P + (size_t)chain_row(dir, b, tau_a) * INC + h * 128 + d0;
      rq[0] = *(const u32x4*)(pr + OFF_Q); rq[1] = *(const u32x4*)(pr + OFF_Q + 8); ri[0] = *(const u32x4*)(pr + OFF_I); ri[1] = *(const u32x4*)(pr + OFF_I + 8); rz[0] = *(const u32x4*)(pr + zoff); rz[1] = *(const u32x4*)(pr + zoff + 8); }
    __syncthreads();
    constexpr int NCH = (CTXL + T) / 64;
    for (int n = 0; n < NCH; ++n) {
        const int s0 = n * 64;
#pragma unroll
        for (int hf = 0; hf < 2; ++hf) { float qf[8], zf[8], oq[8], ok[8]; unpack8(rq[hf], qf); unpack8(rz[hf], zf);
            const int dd = d0 + 8 * hf; const f32x4 lb0 = *(const LAS f32x4*)(lbs + dd), lb1 = *(const LAS f32x4*)(lbs + dd + 4); f32x4 lf0, lf1;
#pragma unroll
            for (int j = 0; j < 8; ++j) { const float lb = j < 4 ? lb0[j] : lb1[j - 4]; const float f = lb + (1.0f - lb) * sigmoidf_(zf[j]); const float lf = fmaxf(__logf(f), -60.0f);
                if (j < 4) lf0[j] = lf; else lf1[j - 4] = lf; oq[j] = siluf_(qf[j]); ok[j] = 1.0f - f; }
            *(LAS u32x4*)(qs + tau_a * QP + dd) = pack8(oq); *(LAS u32x4*)(ks + tau_a * QP + dd) = pack8(ok);
            *(LAS f32x4*)(lfb + tau_a * 128 + dd) = lf0; *(LAS f32x4*)(lfb + tau_a * 128 + dd + 4) = lf1;
            const u32x4 vv = ri[hf];
            vT[(dd + 0) * SP + tau_a] = (bf16)(vv.x & 0xffffu); vT[(dd + 1) * SP + tau_a] = (bf16)(vv.x >> 16); vT[(dd + 2) * SP + tau_a] = (bf16)(vv.y & 0xffffu); vT[(dd + 3) * SP + tau_a] = (bf16)(vv.y >> 16);
            vT[(dd + 4) * SP + tau_a] = (bf16)(vv.z & 0xffffu); vT[(dd + 5) * SP + tau_a] = (bf16)(vv.z >> 16); vT[(dd + 6) * SP + tau_a] = (bf16)(vv.w & 0xffffu); vT[(dd + 7) * SP + tau_a] = (bf16)(vv.w >> 16); }
        if (n + 1 < NCH) { const bf16* pr = P + (size_t)chain_row(dir, b, s0 + 64 + tau_a) * INC + h * 128 + d0;
            rq[0] = *(const u32x4*)(pr + OFF_Q); rq[1] = *(const u32x4*)(pr + OFF_Q + 8); ri[0] = *(const u32x4*)(pr + OFF_I); ri[1] = *(const u32x4*)(pr + OFF_I + 8); rz[0] = *(const u32x4*)(pr + zoff); rz[1] = *(const u32x4*)(pr + zoff + 8); }
        LDS_BAR();
        float cs[16];
        { float run = 0.f;
#pragma unroll
          for (int i = 0; i < 16; ++i) { run += lfb[(16 * qt + i) * 128 + d]; cs[i] = run; }
          tot[qt * 128 + d] = run; }
        LDS_BAR();
        { const float t0 = tot[d], t1 = tot[128 + d], t2 = tot[256 + d], t3 = tot[384 + d];
          const float bmid = t0 + t1, btot = bmid + t2 + t3; const float base = (qt > 0 ? t0 : 0.f) + (qt > 1 ? t1 : 0.f) + (qt > 2 ? t2 : 0.f);
          if (qt == 0) { gmid[d] = __expf(bmid); gend[d] = __expf(btot - bmid); }
#pragma unroll
          for (int i = 0; i < 16; ++i) { const int tau = 16 * qt + i; const float bt = base + cs[i];
              const float eq = __expf(fminf(bt - bmid, 80.0f)), ek = __expf(fminf(bmid - bt, 80.0f));
              const bf16 qb = (bf16)f2bf(bf1(qs[tau * QP + d]) * eq), kb = (bf16)f2bf(bf1(ks[tau * QP + d]) * ek);
              qs[tau * QP + d] = qb; ks[tau * QP + d] = kb; kT[d * SP + tau] = kb; } }
        LDS_BAR();
        { const f32x4 gm = *(const LAS f32x4*)(gmid + 16 * wave + 4 * fq);
#pragma unroll
          for (int vt = 0; vt < 8; ++vt) { S[vt] = S[vt] * gm; u32x2 o; o.x = pk2(S[vt][0], S[vt][1]); o.y = pk2(S[vt][2], S[vt][3]); *(LAS u32x2*)(sT + (16 * vt + fr) * QP + 16 * wave + 4 * fq) = o; } }
        { const int tt = wave >> 1;
#pragma unroll
          for (int u = 0; u < 2; ++u) { const int sg = 2 * (wave & 1) + u; f32x4 acc = (f32x4){0.f, 0.f, 0.f, 0.f};
              if (sg <= tt) {
#pragma unroll
                  for (int kq = 0; kq < 4; ++kq) { const bf16x8 af = *(const LAS bf16x8*)(ks + (16 * sg + fr) * QP + 32 * kq + 8 * fq), bfm = *(const LAS bf16x8*)(qs + (16 * tt + fr) * QP + 32 * kq + 8 * fq);
                      acc = __builtin_amdgcn_mfma_f32_16x16x32_bf16(af, bfm, acc, 0, 0, 0); }
                  if (sg == tt) {
#pragma unroll
                      for (int j = 0; j < 4; ++j) if (4 * fq + j > fr) acc[j] = 0.f; }
              }
              u32x2 o; o.x = pk2(acc[0], acc[1]); o.y = pk2(acc[2], acc[3]); *(LAS u32x2*)(pl + (16 * tt + fr) * SP + 16 * sg + 4 * fq) = o; } }
        LDS_BAR();
#pragma unroll
        for (int tt = 0; tt < 4; ++tt) { f32x4 acc = (f32x4){0.f, 0.f, 0.f, 0.f};
#pragma unroll
            for (int kq = 0; kq < 2; ++kq) { const bf16x8 af = *(const LAS bf16x8*)(vT + (16 * wave + fr) * SP + 32 * kq + 8 * fq), bfm = *(const LAS bf16x8*)(pl + (16 * tt + fr) * SP + 32 * kq + 8 * fq);
                acc = __builtin_amdgcn_mfma_f32_16x16x32_bf16(af, bfm, acc, 0, 0, 0); }
#pragma unroll
            for (int kq = 0; kq < 4; ++kq) { const bf16x8 af = *(const LAS bf16x8*)(sT + (16 * wave + fr) * QP + 32 * kq + 8 * fq), bfm = *(const LAS bf16x8*)(qs + (16 * tt + fr) * QP + 32 * kq + 8 * fq);
                acc = __builtin_amdgcn_mfma_f32_16x16x32_bf16(af, bfm, acc, 0, 0, 0); }
            const int row = chain_row(dir, b, s0 + 16 * tt + fr);
            u32x2 o; o.x = pk2(acc[0], acc[1]); o.y = pk2(acc[2], acc[3]); *(u32x2*)(OB + ((size_t)dir * MALL + row) * BW + h * 128 + 16 * wave + 4 * fq) = o; }
        { const f32x4 ge = *(const LAS f32x4*)(gend + 16 * wave + 4 * fq);
#pragma unroll
          for (int kq = 0; kq < 2; ++kq) { const bf16x8 af = *(const LAS bf16x8*)(kT + (16 * wave + fr) * SP + 32 * kq + 8 * fq);
#pragma unroll
              for (int vt = 0; vt < 8; ++vt) { const bf16x8 bfm = *(const LAS bf16x8*)(vT + (16 * vt + fr) * SP + 32 * kq + 8 * fq); S[vt] = __builtin_amdgcn_mfma_f32_16x16x32_bf16(af, bfm, S[vt], 0, 0, 0); } }
#pragma unroll
          for (int vt = 0; vt < 8; ++vt) S[vt] = S[vt] * ge; }
        LDS_BAR();
    }
}
__device__ __forceinline__ void hgrn_chain(KArgs a, int l, int cid, LAS unsigned char* lds) {
    const int tid = tid_fresh();
    unsigned char* ws = a->ws;
    const bf16* P = (const bf16*)(ws + WS_P); bf16* OB = (bf16*)(ws + WS_OB);
    const int dir = cid / 48, b = (cid % 48) / 6, h = cid % 6;
    LAS float* tq = (LAS float*)lds;
    LAS float* tk = tq + 16 * 128;
    LAS float* tf = tk + 16 * 128;
    LAS float* tv = tf + 16 * 128;
    LAS float* ot = tv + 16 * 128;
    const int v = tid >> 2, q = tid & 3;
    float S[32];
#pragma unroll
    for (int j = 0; j < 32; ++j) S[j] = 0.f;
    const int sst = tid >> 5, sc4 = (tid & 31) * 4;
    float lb[4];
#pragma unroll
    for (int j = 0; j < 4; ++j) { const int ch = h * 128 + sc4 + j;
        if (l == 0) lb[j] = 0.f; else { const float l0 = a->in[I_LB][((size_t)dir * DEPTH + 0) * BW + ch], l1 = a->in[I_LB][((size_t)dir * DEPTH + 1) * BW + ch]; lb[j] = 1.0f / (1.0f + __expf(l0 - l1)); } }
    for (int s0 = 0; s0 < CTXL + T; s0 += 16) {
        { const int row = chain_row(dir, b, s0 + sst); const bf16* pr = P + (size_t)row * INC + h * 128 + sc4;
          const u32x2 pq = *(const u32x2*)(pr + OFF_Q), pi = *(const u32x2*)(pr + OFF_I), pz = *(const u32x2*)(pr + (dir ? OFF_ZB : OFF_ZF));
          const float qf[4] = {bflo(pq.x), bfhi(pq.x), bflo(pq.y), bfhi(pq.y)}, vf[4] = {bflo(pi.x), bfhi(pi.x), bflo(pi.y), bfhi(pi.y)}, zf[4] = {bflo(pz.x), bfhi(pz.x), bflo(pz.y), bfhi(pz.y)};
          f32x4 oq, ok, of, ov;
#pragma unroll
          for (int j = 0; j < 4; ++j) { const float f = lb[j] + (1.0f - lb[j]) * sigmoidf_(zf[j]); oq[j] = siluf_(qf[j]); of[j] = f; ok[j] = 1.0f - f; ov[j] = vf[j]; }
          *(LAS f32x4*)(tq + sst * 128 + sc4) = oq; *(LAS f32x4*)(tk + sst * 128 + sc4) = ok; *(LAS f32x4*)(tf + sst * 128 + sc4) = of; *(LAS f32x4*)(tv + sst * 128 + sc4) = ov; }
        LDS_BAR();
        for (int st = 0; st < 16; ++st) {
            const float vv = tv[st * 128 + v]; float o0 = 0.f, o1 = 0.f;
#pragma unroll
            for (int j = 0; j < 8; ++j) { const f32x4 fq4 = *(const LAS f32x4*)(tf + st * 128 + q * 32 + 4 * j), kq4 = *(const LAS f32x4*)(tk + st * 128 + q * 32 + 4 * j), qq4 = *(const LAS f32x4*)(tq + st * 128 + q * 32 + 4 * j);
#pragma unroll
                for (int i = 0; i < 4; ++i) { const float sn = fq4[i] * S[4 * j + i] + kq4[i] * vv; S[4 * j + i] = sn; if (i & 1) o1 += qq4[i] * sn; else o0 += qq4[i] * sn; } }
            float o = o0 + o1; o += dpp_xor1(o); o += dpp_xor2(o);
            if (q == 0) ot[st * 128 + v] = o;
        }
        LDS_BAR();
        if (tid < 256) { const int st = tid >> 4, part = tid & 15; const int row = chain_row(dir, b, s0 + st); const LAS float* op = ot + st * 128 + part * 8;
            float f[8];
#pragma unroll
            for (int j = 0; j < 8; ++j) f[j] = op[j];
            *(u32x4*)(OB + ((size_t)dir * MALL + row) * BW + h * 128 + part * 8) = pack8(f); }
    }
    LDS_BAR();
}

__device__ __forceinline__ float grp_sum32(float v) { v += __shfl_xor(v, 1); v += __shfl_xor(v, 2); v += __shfl_xor(v, 4); v += __shfl_xor(v, 8); v += __shfl_xor(v, 16); return v; }
__device__ __forceinline__ float grp_sum16(float v) { v += __shfl_xor(v, 1); v += __shfl_xor(v, 2); v += __shfl_xor(v, 4); v += __shfl_xor(v, 8); return v; }
__device__ __forceinline__ void phase_finalize(KArgs a, int l, bool dry) {
    const int tid_ = tid_fresh(); const int lane = tid_ & 63, wave = tid_ >> 6, gw = blockIdx.x * 8 + wave, NGW = gridDim.x * 8;
    unsigned char* ws = a->ws;
    const bf16* P = (const bf16*)(ws + WS_P); const bf16* OB = (const bf16*)(ws + WS_OB); const bf16* OC = (const bf16*)(ws + WS_OC); bf16* Y = (bf16*)(ws + WS_Y);
    bf16* Yo = dry ? (bf16*)(ws + WS_END) : Y;
    const int nrows = (l == DEPTH - 1) ? NLAT : MALL;
    const int rpw = (nrows + NGW - 1) / NGW; const int r0 = gw * rpw, r1 = (r0 + rpw < nrows) ? r0 + rpw : nrows;
    f32x4 hng[3], gng[3], gnb[3];
#pragma unroll
    for (int k = 0; k < 3; ++k) { const int c = 256 * k + 4 * lane; hng[k] = *(const f32x4*)(a->in[I_HNG] + (size_t)l * BW + c);
        gng[k] = *(const f32x4*)(a->in[I_GNGG] + (size_t)l * CW + c); gnb[k] = *(const f32x4*)(a->in[I_GNB] + (size_t)l * CW + c); }
    for (int row = r0; row < r1; ++row) {
        const int orow = dry ? (row & 2047) : row;
        u32x2 bf_[3], bb_[3], bg_[3], cf_[3], cb_[3], cv_[3], cg_[3];
#pragma unroll
        for (int k = 0; k < 3; ++k) { const int c = 256 * k + 4 * lane;
            bf_[k] = *(const u32x2*)(OB + (size_t)row * BW + c); bb_[k] = *(const u32x2*)(OB + ((size_t)MALL + row) * BW + c); bg_[k] = *(const u32x2*)(P + (size_t)row * INC + OFF_OG + c);
            cf_[k] = *(const u32x2*)(OC + (size_t)row * CW + c); cb_[k] = *(const u32x2*)(OC + ((size_t)MALL + row) * CW + c);
            cv_[k] = *(const u32x2*)(Y + (size_t)row * D + 512 + c);
            cg_[k] = *(const u32x2*)(Y + (size_t)row * D + 1280 + c); }
#pragma unroll
        for (int k = 0; k < 3; ++k) { const int c = 256 * k + 4 * lane;
            { float o[4] = {bflo(bf_[k].x) + bflo(bb_[k].x), bfhi(bf_[k].x) + bfhi(bb_[k].x), bflo(bf_[k].y) + bflo(bb_[k].y), bfhi(bf_[k].y) + bfhi(bb_[k].y)};
              const float ss = grp_sum32((o[0] * o[0] + o[1] * o[1]) + (o[2] * o[2] + o[3] * o[3])); const float rstd = 1.0f / sqrtf(ss * (1.0f / 128.0f) + NORM_EPS);
              const float g4[4] = {bflo(bg_[k].x), bfhi(bg_[k].x), bflo(bg_[k].y), bfhi(bg_[k].y)}; float y[4];
#pragma unroll
              for (int j = 0; j < 4; ++j) y[j] = o[j] * rstd * hng[k][j] * sigmoidf_(g4[j]);
              u32x2 q; q.x = pk2(y[0], y[1]); q.y = pk2(y[2], y[3]); *(u32x2*)(Yo + (size_t)orow * D + 512 + c) = q; }
            { float o[4] = {bflo(cf_[k].x) + bflo(cb_[k].x), bfhi(cf_[k].x) + bfhi(cb_[k].x), bflo(cf_[k].y) + bflo(cb_[k].y), bfhi(cf_[k].y) + bfhi(cb_[k].y)};
              const float v4[4] = {bflo(cv_[k].x), bfhi(cv_[k].x), bflo(cv_[k].y), bfhi(cv_[k].y)}, g4[4] = {bflo(cg_[k].x), bfhi(cg_[k].x), bflo(cg_[k].y), bfhi(cg_[k].y)};
              const float mean = grp_sum16((o[0] + o[1]) + (o[2] + o[3])) * (1.0f / 64.0f);
              float dl[4]; float sq = 0.f;
#pragma unroll
              for (int j = 0; j < 4; ++j) { dl[j] = o[j] - mean; sq += dl[j] * dl[j]; }
              const float var = grp_sum16(sq) * (1.0f / 64.0f); const float rs = 1.0f / sqrtf(var + GN_EPS); float y[4];
#pragma unroll
              for (int j = 0; j < 4; ++j) y[j] = (dl[j] * rs * gng[k][j] + gnb[k][j] + v4[j]) * g4[j];
              u32x2 q; q.x = pk2(y[0], y[1]); q.y = pk2(y[2], y[3]); *(u32x2*)(Yo + (size_t)orow * D + 1280 + c) = q; }
        }
    }
}

__global__ void __launch_bounds__(NTHREADS, 2) mk_fwd(Args args_unused) {
    extern __shared__ __attribute__((aligned(16))) unsigned char lds_raw[];
    LAS unsigned char* lds = (LAS unsigned char*)lds_raw;
    volatile LAS unsigned* misc = (volatile LAS unsigned*)(lds + LDS_MISC);
    const int tid = threadIdx.x, G = gridDim.x;
    if (tid < 64) misc[tid] = 0u;
    __syncthreads();
    XcdBarrier bar; bar.bar = nullptr; bar.x = 0; bar.st = nullptr;
    int lo, hi;
    { KArgs a = kargs(); lo = a->ph_lo; hi = a->ph_hi; unsigned* ctl = (unsigned*)(a->ws + WS_CTL); bar.bar = ctl + CW_BAR; if (!MK_MULTI) bar = xcd_barrier_post(ctl + CW_BAR, misc + 8); }
    const int cvirt = (G % 8 == 0) ? ((int)blockIdx.x % 8) * (G / 8) + (int)blockIdx.x / 8 : (int)blockIdx.x;
#define IN(k) (lo <= (k) && (k) < hi)
#define PM(b) ((PHMASK >> (b)) & 1)
#define REP(b) _Pragma("unroll 1") for (int rep_ = 0; rep_ < 1 + ((PROBE_DUP >> (b)) & 1); ++rep_)
#define SEAM(k) do { if (!MK_MULTI && IN(k) && IN((k) + 1)) { xcd_barrier(bar); if ((PROBE_DUP >> 13) & 1) xcd_barrier(bar); } } while (0)

    if (PM(0) && IN(0)) REP(0) { phase_prologue(kargs(), lds); } SEAM(0);

#pragma unroll 1
    for (int l = 0; l < DEPTH; ++l) {
        const int pb = 1 + 9 * l;
        const bool lastl = (l == DEPTH - 1);
        if (PM(1) && IN(pb + 0)) { if ((PROBE_DUP >> 1) & 1) { if (l == 0) phase_norm1<0>(kargs(), l, true); else phase_norm1<1>(kargs(), l, true); } if (l == 0) phase_norm1<0>(kargs(), l, false); else { phase_norm1<1>(kargs(), l, false); __syncthreads(); convert_moe(kargs(), l, lds); __syncthreads(); } } SEAM(pb + 0);
        if (PM(2) && IN(pb + 1)) REP(2) {
            KArgs a = kargs(); unsigned char* ws = a->ws;
            pg8::Gemm g{(const bf16*)(ws + WS_H), (const bf16*)(ws + WS_WIN) + (size_t)l * INC * D, MALL, INC, D};
            pg8::StaticOrder S; S.init(MALL, INC, G, (int)blockIdx.x);
            pg8::EpiBf16 E{(bf16*)(ws + WS_P), INC};
            pg8::gemm_phase<pg8::EpiBf16, pg8::StaticOrder, false, false>(lds, g, S, E, nullptr);
        } SEAM(pb + 1);
        if (PM(3) && IN(pb + 2)) {
            const int ngm = lastl ? 1024 : 1088;
            unsigned* qhead = (unsigned*)(kargs()->ws + WS_CTL) + CW_PREPQ + 64 * l;
            const int n_rw = 544 * 3, n_hg = 3264, n_all = (G == 256) ? n_rw + n_hg : n_rw + n_hg + ngm;
            for (;;) {
                if (threadIdx.x == 0) misc[16] = __hip_atomic_fetch_add(qhead, 1u, __ATOMIC_RELAXED, __HIP_MEMORY_SCOPE_AGENT);
                __syncthreads();
                const int it = (int)misc[16];
                if (it >= n_all) break;
                if (it < n_rw) { _Pragma("unroll 1") for (int r2 = 0; r2 < 1 + ((PROBE_DUP >> 15) & 1); ++r2) rwkv_prep_item(kargs(), l, it / 3, it % 3, lds); }
                else if (it < n_rw + n_hg) { if ((PROBE_DUP >> 16) & 1) hgrn_prep_item(kargs(), l, it - n_rw, lds, true); hgrn_prep_item(kargs(), l, it - n_rw, lds, false); }
                else { _Pragma("unroll 1") for (int r2 = 0; r2 < 1 + ((PROBE_DUP >> 14) & 1); ++r2) gmlp_item(kargs(), l, it - n_rw - n_hg, lds); }
            }
            __syncthreads();
        } SEAM(pb + 2);
        if (PM(4) && IN(pb + 3)) REP(4) {
            if (G == 256) { const int bx = blockIdx.x;
                if (bx < 96) { _Pragma("unroll 1") for (int r2 = 0; r2 < 1 + ((PROBE_DUP >> 12) & 1); ++r2) rwkv_chain_mfma(kargs(), bx * 8, lds); }
                else if (bx < 192) { _Pragma("unroll 1") for (int r2 = 0; r2 < 1 + ((PROBE_DUP >> 11) & 1); ++r2) hgrn_chain_lean(kargs(), bx - 96, lds); }
                if (bx < 96 || bx >= 192) {
                    unsigned* gq = (unsigned*)(kargs()->ws + WS_CTL) + CW_GMQ + 64 * l; const int ngm2 = lastl ? 1024 : 1088;
                    for (;;) { if (threadIdx.x == 0) misc[17] = __hip_atomic_fetch_add(gq, 1u, __ATOMIC_RELAXED, __HIP_MEMORY_SCOPE_AGENT);
                        __syncthreads(); const int it = (int)misc[17]; if (it >= ngm2) break; gmlp_item(kargs(), l, it, lds); }
                    __syncthreads(); } }
            else { for (int it = blockIdx.x; it < 192; it += G) { if (it < 96) rwkv_chain_mfma(kargs(), it * 8, lds); else hgrn_chain_lean(kargs(), it - 96, lds); } }
        } SEAM(pb + 3);
        if (PM(5) && IN(pb + 4)) { if ((PROBE_DUP >> 5) & 1) phase_finalize(kargs(), l, true); phase_finalize(kargs(), l, false); } SEAM(pb + 4);
        if (PM(6) && IN(pb + 5)) REP(6) {
            KArgs a = kargs(); unsigned char* ws = a->ws;
            const int Mo = lastl ? NLAT : MALL;
            pg8::Gemm g{(const bf16*)(ws + WS_Y), (const bf16*)(ws + WS_WOUT) + (size_t)l * D * D, Mo, D, D};
            pg8::StaticOrder S; S.init(Mo, D, G, (int)blockIdx.x);
            const float* xl = l == 0 ? a->in[I_X] : (const float*)(ws + WS_X); const float* xc = l == 0 ? a->in[I_CTX] : (const float*)(ws + WS_X) + (size_t)NLAT * D;
            pg8::EpiResid E{xl, xc, (float*)(ws + WS_X), (const float*)(ws + WS_MOD) + (size_t)l * 9 * 12288 + 2 * D};
            pg8::gemm_phase<pg8::EpiResid, pg8::StaticOrder, true, false>(lds, g, S, E, nullptr);
        } SEAM(pb + 5);
        if (PM(7) && IN(pb + 6)) { if ((PROBE_DUP >> 7) & 1) phase_norm2_router(kargs(), l, true, lds); phase_norm2_router(kargs(), l, false, lds); } SEAM(pb + 6);
        if (PM(8) && IN(pb + 7)) REP(8) {
            KArgs a = kargs(); unsigned char* ws = a->ws;
            moe_tables<false>(a, l, lds, cvirt);
            pg8::Gemm g{(const bf16*)(ws + WS_H), (const bf16*)(ws + WS_WGU), 0, 2048, D / 2};
            pg8::MoeOrder S{(const LAS int*)(lds + LDS_TP), G, cvirt, (unsigned)(2048 * D)};
            pg8::EpiSwiglu E{ws + WS_ACT};
            pg8::gemm_phase8<pg8::EpiSwiglu, pg8::MoeOrder, false, true>(lds, g, S, E, (const LAS unsigned*)(lds + LDS_TAB));
        } SEAM(pb + 7);
        if (PM(9) && IN(pb + 8)) REP(9) {
            KArgs a = kargs(); unsigned char* ws = a->ws;
            moe_tables<true>(a, l, lds, cvirt);
            pg8::Gemm g{(const bf16*)(ws + WS_ACT), (const bf16*)(ws + WS_WDN), 0, D, DE / 2};
            pg8::MoeOrder S{(const LAS int*)(lds + LDS_TP), G, cvirt, (unsigned)(D * DE)};
            pg8::EpiDown E{(bf16*)(ws + WS_YK), (const LAS unsigned*)(lds + LDS_TAB), (const LAS float*)(lds + LDS_TABW)};
            pg8::gemm_phase8<pg8::EpiDown, pg8::MoeOrder, false, false>(lds, g, S, E, nullptr);
        } SEAM(pb + 8);
    }
    if (PM(10) && IN(1 + 9 * DEPTH)) { if ((PROBE_DUP >> 10) & 1) phase_norm1<2>(kargs(), DEPTH, true); phase_norm1<2>(kargs(), DEPTH, false); }
#undef IN
#undef SEAM
}

extern "C" void kernel_launch(void* const* d_in, const int* in_sizes, int n_in, void* d_out, int out_size, void* d_ws, size_t ws_size, hipStream_t stream) {
    static int grid = 0;
    if (grid == 0) {
        if (n_in != 31 || ws_size < WS_END) { fprintf(stderr, "kernel_launch: unexpected n_in %d / ws %zu (need %zu)\n", n_in, ws_size, (size_t)WS_END); grid = -1; return; }
        int dev = 0, cus = 0, per_cu = 0;
        hipGetDevice(&dev); hipDeviceGetAttribute(&cus, hipDeviceAttributeMultiprocessorCount, dev);
        if (hipFuncSetAttribute((const void*)mk_fwd, hipFuncAttributeMaxDynamicSharedMemorySize, LDS_BYTES) != hipSuccess) { fprintf(stderr, "kernel_launch: hipFuncSetAttribute failed\n"); grid = -1; return; }
        if (hipOccupancyMaxActiveBlocksPerMultiprocessor(&per_cu, (const void*)mk_fwd, NTHREADS, LDS_BYTES) != hipSuccess || per_cu < 1) fprintf(stderr, "kernel_launch: occupancy query says %d\n", per_cu);
        (void)hipGetLastError();
        grid = cus > 0 ? cus : 256;
    }
    if (grid < 0) return;
    hipMemsetAsync((char*)d_ws + WS_CTL, 0, CTL_ZERO_BYTES, stream);
    Args a{};
    for (int i = 0; i < 31; ++i) a.in[i] = (const float*)d_in[i];
    a.out = (float*)d_out; a.ws = (unsigned char*)d_ws;
    constexpr int NPH = 2 + 9 * DEPTH;
#if MK_MULTI
    for (int p = 0; p < NPH; ++p) { a.ph_lo = p; a.ph_hi = p + 1; hipLaunchKernelGGL(mk_fwd, dim3(grid), dim3(NTHREADS), LDS_BYTES, stream, a); }
#else
    a.ph_lo = 0; a.ph_hi = NPH; hipLaunchKernelGGL(mk_fwd, dim3(grid), dim3(NTHREADS), LDS_BYTES, stream, a);
#endif
}
```

```cpp
#include <hip/hip_runtime.h>
#include <cstdio>
#include <cstdint>

#ifndef PHMASK
#define PHMASK 0xFFFF
#endif
#ifndef PROBE_DUP
#define PROBE_DUP 0
#endif
#ifndef MK_MULTI
#define MK_MULTI 0
#endif

#define GAS __attribute__((address_space(1)))
#define LAS __attribute__((address_space(3)))
typedef unsigned short bf16;
typedef short bf16x8 __attribute__((ext_vector_type(8)));
typedef float f32x4 __attribute__((ext_vector_type(4)));
typedef float f32x2 __attribute__((ext_vector_type(2)));
typedef unsigned u32x4 __attribute__((ext_vector_type(4)));
typedef unsigned u32x2 __attribute__((ext_vector_type(2)));

constexpr int D = 2048, NB = 8, T = 4096, CTXL = 256, DEPTH = 2;
constexpr int NLAT = NB * T, NCTX = NB * CTXL, MALL = NLAT + NCTX;
constexpr int INC = 7424;
constexpr int OFF_U = 0, OFF_V = 512, OFF_Q = 1024, OFF_I = 1792, OFF_ZF = 2560, OFF_ZB = 3328, OFF_OG = 4096;
constexpr int OFF_C = 4864;
constexpr int BW = 768, CW = 768, CCOLS = 2560;
constexpr int NE = 16, DE = 1024;
constexpr int PC2W = 7 * 768;
constexpr int NTHREADS = 512;
constexpr float NORM_EPS = 1e-6f, GN_EPS = 64e-5f, DECAY_SCALE = 0.60653065971263342f;

constexpr size_t MiB = 1u << 20;
constexpr size_t WS_CTL = 0, CTL_ZERO_BYTES = 1 * MiB;
constexpr size_t WS_MOD = 1 * MiB;
constexpr size_t WS_SMALLW = 2 * MiB;
constexpr size_t SW_WUP = 0, SW_AUP = SW_WUP + (size_t)2 * 2 * 768 * 64 * 2, SW_GUP = SW_AUP + (size_t)2 * 768 * 64 * 2, SW_GWS = SW_GUP + (size_t)2 * 768 * 128 * 2;
constexpr size_t WS_WIN = 4 * MiB, WS_WOUT = 62 * MiB, WS_WGU = 78 * MiB, WS_WDN = 142 * MiB, WS_Y8 = 174 * MiB;
constexpr size_t WS_X = 270 * MiB, WS_H = 542 * MiB, WS_Y = 678 * MiB, WS_P = 814 * MiB, WS_PRE = 1307 * MiB, WS_VT = 1817 * MiB, WS_OC = 1868 * MiB, WS_HQB = 1970 * MiB, WS_HG = 2021 * MiB, WS_END = 2028 * MiB;
constexpr int PRE_REC = 10240, PR_WP = 0, PR_RP = 2048, PR_BK = 4096, PR_ARBK = 8192, PR_MAK = 9216, PR_GAM = 9728, NCHUNK16 = 272;
constexpr size_t WS_OB = WS_H;
constexpr size_t WS_ACT = WS_P, WS_YK = WS_P + 144 * MiB, WS_RIDX = WS_P + 416 * MiB, WS_RW = WS_RIDX + 3 * MiB;
static_assert(WS_RW + 3 * MiB <= WS_PRE, "moe overlay");
constexpr int MAXSLOT_TILES = 288;
constexpr int CW_BAR = 4096;
constexpr int CW_GMQ = 30720;
constexpr int CW_PREPQ = 28672;
constexpr int CW_CNT = 16384;

constexpr int LDS_STAGE = 0, LDS_TAB = 131072, LDS_TABW = LDS_TAB + 9 * 1024, LDS_TP = LDS_TABW + 9 * 1024, LDS_MISC = 150528, LDS_BYTES = 152 * 1024;
static_assert(LDS_TP + 128 <= LDS_MISC, "lds map");

typedef __bf16 bf16x2_t __attribute__((ext_vector_type(2)));
__device__ __forceinline__ unsigned pk2(float lo, float hi) { const f32x2 v = {lo, hi}; return __builtin_bit_cast(unsigned, __builtin_convertvector(v, bf16x2_t)); }
__device__ __forceinline__ unsigned f2bf(float f) { return pk2(f, f) & 0xffffu; }
__device__ __forceinline__ unsigned pk4_fp8(float a, float b, float c, float d) { int p = 0; p = __builtin_amdgcn_cvt_pk_fp8_f32(a, b, p, false); p = __builtin_amdgcn_cvt_pk_fp8_f32(c, d, p, true); return (unsigned)p; }
__device__ __forceinline__ float bflo(unsigned u) { return __builtin_bit_cast(float, u << 16); }
__device__ __forceinline__ float bfhi(unsigned u) { return __builtin_bit_cast(float, u & 0xffff0000u); }
__device__ __forceinline__ float bf1(bf16 b) { return __builtin_bit_cast(float, ((unsigned)b) << 16); }
__device__ __forceinline__ float sigmoidf_(float x) { return __builtin_amdgcn_rcpf(1.0f + __expf(-x)); }
__device__ __forceinline__ float siluf_(float x) { return x * __builtin_amdgcn_rcpf(1.0f + __expf(-x)); }
__device__ __forceinline__ float geluf_(float v) {
    const float av = fabsf(v), t = __builtin_amdgcn_rcpf(av * 0.2316418882f + 1.0f);
    float q = t * 0.5307027145f + (-0.7265760135f); q = q * t + 0.7107068705f; q = q * t + (-0.142248368f); q = q * t + 0.127414796f; q = q * t;
    const float e = __builtin_amdgcn_exp2f((v * v) * (-0.72134752044f)); const float m = v * (q * e); return v < 0.f ? m : v - m; }
__device__ __forceinline__ float wave_sum(float v) {
#pragma unroll
    for (int o = 1; o < 64; o <<= 1) v += __shfl_xor(v, o);
    return v;
}
__device__ __forceinline__ int tid_fresh() { int t = threadIdx.x; asm volatile("" : "+v"(t)); return t; }
__device__ __forceinline__ void unpack8(const u32x4 v, float (&f)[8]) {
    f[0] = bflo(v.x); f[1] = bfhi(v.x); f[2] = bflo(v.y); f[3] = bfhi(v.y); f[4] = bflo(v.z); f[5] = bfhi(v.z); f[6] = bflo(v.w); f[7] = bfhi(v.w);
}
__device__ __forceinline__ u32x4 pack8(const float (&f)[8]) { u32x4 v; v.x = pk2(f[0], f[1]); v.y = pk2(f[2], f[3]); v.z = pk2(f[4], f[5]); v.w = pk2(f[6], f[7]); return v; }
__device__ __forceinline__ int modrow_of(int row) { return row < NLAT ? (row >> 12) : 8; }

#define XB_TMO      128
#define XB_XCNT(j)  (256  + 64 * (j))
#define XB_XSUB(j)  (1280 + 64 * (j))
#define XB_XGEN(j)  (2304 + 64 * (j))
#define XB_TOP      3328
#define XB_TOPGEN   3392
#define XCD_BAR_WORDS 3456
#define XB_SPIN_CAP (1u << 18)
__device__ __forceinline__ unsigned xb_ld(unsigned* p)              { return __hip_atomic_load(p, __ATOMIC_RELAXED, __HIP_MEMORY_SCOPE_AGENT); }
__device__ __forceinline__ unsigned xb_add(unsigned* p, unsigned v) { return __hip_atomic_fetch_add(p, v, __ATOMIC_RELAXED, __HIP_MEMORY_SCOPE_AGENT); }
__device__ __forceinline__ unsigned xb_xcc_id() { return (unsigned)__builtin_amdgcn_s_getreg((3 << 11) | 20) & 0xFu; }
#define XB_SPIN(cond, bar) do { unsigned _sp = 0; while (cond) { __builtin_amdgcn_s_sleep(1); \
    if ((++_sp & 255u) == 0u) { if (xb_ld(&(bar)[XB_TMO])) break; if (_sp > XB_SPIN_CAP) { atomicAdd(&(bar)[XB_TMO], 1u); break; } } } } while (0)
struct XcdBarrier { unsigned* bar; unsigned x; volatile LAS unsigned* st; };
__device__ __forceinline__ XcdBarrier xcd_barrier_post(unsigned* bar, volatile LAS unsigned* st) {
    XcdBarrier b; b.bar = bar; b.x = xb_xcc_id(); b.st = st;
    if (threadIdx.x == 0) (void)xb_add(&bar[XB_XCNT(b.x)], 1u);
    return b;
}
__device__ __forceinline__ void xcd_barrier_complete(unsigned* bar, unsigned x, unsigned& nloc, unsigned& nx) {
    const unsigned G = gridDim.x * gridDim.y * gridDim.z;
    unsigned sum, cnt, mine, sp = 0u;
    for (;;) {
        sum = 0u; cnt = 0u; mine = 0u;
#pragma unroll
        for (unsigned j = 0; j < 16; ++j) { const unsigned c = xb_ld(&bar[XB_XCNT(j)]); sum += c; cnt += (c > 0u) ? 1u : 0u; mine = (j == x) ? c : mine; }
        if (sum == G) break;
        __builtin_amdgcn_s_sleep(1);
        if ((++sp & 255u) == 0u) { if (xb_ld(&bar[XB_TMO])) break; if (sp > XB_SPIN_CAP) { atomicAdd(&bar[XB_TMO], 1u); break; } }
    }
    nloc = mine > 0u ? mine : 1u; nx = cnt > 0u ? cnt : 1u;
}
__device__ __forceinline__ void xcd_barrier(const XcdBarrier& b) {
    asm volatile("s_waitcnt vmcnt(0)" ::: "memory");
    __syncthreads();
    if (threadIdx.x == 0) {
        unsigned* bar = b.bar;
        __builtin_amdgcn_s_waitcnt(0);
        unsigned nloc = b.st[0], nx = b.st[1];
        if (nloc == 0u) { xcd_barrier_complete(bar, b.x, nloc, nx); b.st[0] = nloc; b.st[1] = nx; }
        const unsigned old = xb_add(&bar[XB_XSUB(b.x)], 1u);
        const unsigned gen = old / nloc;
        if (old + 1u == (gen + 1u) * nloc) {
            __builtin_amdgcn_fence(__ATOMIC_RELEASE, "agent");
            asm volatile("s_waitcnt vmcnt(0)" ::: "memory");
            const unsigned og = xb_add(&bar[XB_TOP], 1u);
            const unsigned tg = og / nx;
            if (og + 1u == (tg + 1u) * nx) xb_add(&bar[XB_TOPGEN], 1u);
            else XB_SPIN(xb_ld(&bar[XB_TOPGEN]) == tg, bar);
            __builtin_amdgcn_fence(__ATOMIC_ACQUIRE, "agent");
            xb_add(&bar[XB_XGEN(b.x)], 1u);
            asm volatile("s_waitcnt vmcnt(0)" ::: "memory");
        } else {
            XB_SPIN(xb_ld(&bar[XB_XGEN(b.x)]) == gen, bar);
            __builtin_amdgcn_fence(__ATOMIC_ACQUIRE, "agent");
            asm volatile("s_waitcnt vmcnt(0)" ::: "memory");
        }
    }
    __syncthreads();
}

namespace pg8 {
constexpr int BM = 256, BK = 64, HALF = 128, HTB = HALF * BK * 2, STAGE_BYTES = 8 * HTB, NXCD = 8, WGM = 8;
__host__ __device__ __forceinline__ int lds_byte(int r, int c) { const int st = (r >> 4) * 2 + (c >> 5), rr = r & 15, cc = c & 31, ob = rr * 64 + cc * 2; return st * 1024 + (ob ^ (((ob >> 9) & 1) << 5)); }
__host__ __device__ __forceinline__ void stage_rc(int b, int& R, int& C) { const int st = b / 1024, sb = b % 1024, swz = sb ^ (((sb >> 9) & 1) << 5); R = (st >> 1) * 16 + swz / 64; C = (st & 1) * 32 + (swz % 64) / 2; }
__host__ __device__ __forceinline__ int perm32(int rho) { const int n = rho >> 4, i = rho & 15; return 8 * (i >> 2) + 4 * n + (i & 3); }

struct Unit { int pm, pn, e, aux; };
struct Gemm { const bf16* A; const bf16* Bt; int M, N, K; };

struct StaticOrder {
    int nM, nN, nwg, G, c;
    __device__ void init(int M, int N, int G_, int c_) { nM = M / BM; nN = N / BM; nwg = nM * nN; G = G_; c = c_; }
    __device__ bool next(int i, Unit& u) const {
        const long L = (long)i * G + c; if (L >= nwg) return false;
        int wgid = (int)L; { const int q = nwg / NXCD, r = nwg % NXCD, xcd = wgid % NXCD, off = wgid / NXCD; wgid = (xcd < r ? xcd * (q + 1) : r * (q + 1) + (xcd - r) * q) + off; }
        const int nig = WGM * nN, gid = wgid / nig, fm = gid * WGM, gsz = (nM - fm) < WGM ? (nM - fm) : WGM;
        u.pm = fm + ((wgid % nig) % gsz); u.pn = (wgid % nig) / gsz; u.e = 0; u.aux = 0; return true;
    }
    __device__ __forceinline__ unsigned b_off(const Unit& u, unsigned tstep) const { return (unsigned)u.pn * tstep; }
};
struct MoeOrder {
    const LAS int* tp; int G, c; unsigned estride;
    __device__ bool next(int i, Unit& u) const {
        const int L = i * G + c; const int ntot = tp[16] * 8; if (L >= ntot) return false;
        const int tile = L >> 3; int e = 0;
#pragma unroll
        for (int j = 1; j < 16; ++j) e += (tile >= tp[j]) ? 1 : 0;
        u.pm = tile; u.pn = L & 7; u.e = e; u.aux = i; return true;
    }
    __device__ __forceinline__ unsigned b_off(const Unit& u, unsigned tstep) const { return (unsigned)u.e * estride + (unsigned)u.pn * tstep; }
};

#define PG8_LAS __attribute__((address_space(3)))
template <class Epi, class Sched, bool ALIGN_EPI, bool GATHER>
__device__ __forceinline__ void gemm_phase(PG8_LAS unsigned char* lds, const Gemm g, const Sched& S, const Epi& E, const PG8_LAS unsigned* tabA) {
    const int tid = tid_fresh(), wid = __builtin_amdgcn_readfirstlane(tid >> 6), lane = tid & 63, wr = wid >> 2, wc = wid & 3, fr = lane & 15, fq = lane >> 4;
    const int K = g.K, nt = K / BK;
    int sR[2], sC[2];
    unsigned voffB[2];
#pragma unroll
    for (int i = 0; i < 2; ++i) { int R, C; stage_rc(tid * 16 + i * 8192, R, C); sR[i] = R; sC[i] = C; const int Rb = Epi::PERM ? ((R & ~31) + perm32(R & 31)) : R;
        voffB[i] = (unsigned)(Rb * K + C) * 2u; }
    const unsigned kstep = (unsigned)(BK * 2);
    const unsigned hstep = (unsigned)(HALF * K * 2);
    const unsigned tstep = 2u * hstep;
    const unsigned ldsw = (unsigned)wid * 1024u;
    const char* const baseA = (const char*)g.A; const char* const baseB = (const char*)g.Bt;
    const int aoff = lds_byte(wr * 64 + fr, fq * 8), boff = lds_byte(wc * 32 + fr, fq * 8);
#define PG8_SA(b, h) (((b) * 2 + (h)) * HTB)
#define PG8_SB(b, h) ((4 + (b) * 2 + (h)) * HTB)
#define PG8_STAGE(bufoff, gbase, uoff, voff) do { _Pragma("unroll") for (int _i = 0; _i < 2; ++_i) \
        __builtin_amdgcn_global_load_lds((const unsigned*)((gbase) + (size_t)(unsigned)((uoff) + (voff)[_i])), (PG8_LAS unsigned*)(lds + (bufoff) + ldsw + _i * 8192), 16, 0, 0); } while (0)
#define PG8_LDA(dst, b, h) do { _Pragma("unroll") for (int m = 0; m < 4; ++m) _Pragma("unroll") for (int k = 0; k < 2; ++k) dst[m][k] = *(const PG8_LAS bf16x8*)(lds + PG8_SA(b, h) + aoff + m * 2048 + k * 1024); } while (0)
#define PG8_LDB(dst, b, h) do { _Pragma("unroll") for (int n = 0; n < 2; ++n) _Pragma("unroll") for (int k = 0; k < 2; ++k) dst[n][k] = *(const PG8_LAS bf16x8*)(lds + PG8_SB(b, h) + boff + n * 2048 + k * 1024); } while (0)
#define PG8_MMA(ai, bj, At, Bt) do { __builtin_amdgcn_s_setprio(1); _Pragma("unroll") for (int m = 0; m < 4; ++m) _Pragma("unroll") for (int n = 0; n < 2; ++n) _Pragma("unroll") for (int k = 0; k < 2; ++k) \
        acc[ai][bj][m][n] = __builtin_amdgcn_mfma_f32_16x16x32_bf16(Bt[n][k], At[m][k], acc[ai][bj][m][n], 0, 0, 0); __builtin_amdgcn_s_setprio(0); } while (0)
#define PG8_WAIT_V(n) asm volatile("s_waitcnt vmcnt(" #n ")" ::: "memory")
#define PG8_WAIT_L(n) asm volatile("s_waitcnt lgkmcnt(" #n ")" ::: "memory")
#define PG8_BAR __builtin_amdgcn_s_barrier()
#define PG8_SCHED __builtin_amdgcn_sched_barrier(0)
    Unit cur, nxt; int ui = 0;
    if (!S.next(0, cur)) return;
    f32x4 acc[2][2][4][2];
#pragma unroll
    for (int a = 0; a < 2; ++a)
#pragma unroll
        for (int b = 0; b < 2; ++b)
#pragma unroll
            for (int m = 0; m < 4; ++m)
#pragma unroll
                for (int n = 0; n < 2; ++n) acc[a][b][m][n] = (f32x4){0.f, 0.f, 0.f, 0.f};
    bf16x8 At[4][2], B0[2][2], B1[2][2];
    unsigned vA0[2], vA1[2], nA0[2], nA1[2];
    unsigned uA, uB = S.b_off(cur, tstep);
    if constexpr (GATHER) { uA = 0u;
#pragma unroll
        for (int i = 0; i < 2; ++i) { vA0[i] = tabA[cur.aux * 256 + sR[i]] + (unsigned)sC[i] * 2u; vA1[i] = tabA[cur.aux * 256 + 128 + sR[i]] + (unsigned)sC[i] * 2u; }
    } else { uA = (unsigned)cur.pm * tstep;
#pragma unroll
        for (int i = 0; i < 2; ++i) { vA0[i] = (unsigned)(sR[i] * K + sC[i]) * 2u; vA1[i] = vA0[i] + hstep; }
    }
    PG8_STAGE(PG8_SB(0, 0), baseB, uB, voffB); PG8_STAGE(PG8_SB(0, 1), baseB, uB + hstep, voffB); PG8_STAGE(PG8_SA(0, 0), baseA, uA, vA0); PG8_STAGE(PG8_SA(0, 1), baseA, uA, vA1);
    if (wr == 1) PG8_BAR;
    PG8_WAIT_V(2); PG8_BAR;
    PG8_STAGE(PG8_SB(1, 0), baseB, uB + kstep, voffB); PG8_STAGE(PG8_SA(1, 0), baseA, uA + kstep, vA0); PG8_STAGE(PG8_SB(1, 1), baseB, uB + hstep + kstep, voffB);
    PG8_WAIT_V(6); PG8_BAR;
    for (;;) {
        const bool has_next = S.next(ui + 1, nxt);
        unsigned nuA, nuB = has_next ? S.b_off(nxt, tstep) : uB;
        if constexpr (GATHER) { nuA = 0u;
#pragma unroll
            for (int i = 0; i < 2; ++i) { if (has_next) { nA0[i] = tabA[nxt.aux * 256 + sR[i]] + (unsigned)sC[i] * 2u; nA1[i] = tabA[nxt.aux * 256 + 128 + sR[i]] + (unsigned)sC[i] * 2u; } else { nA0[i] = vA0[i]; nA1[i] = vA1[i]; } }
        } else { nuA = has_next ? (unsigned)nxt.pm * tstep : uA;
#pragma unroll
            for (int i = 0; i < 2; ++i) { nA0[i] = vA0[i]; nA1[i] = vA1[i]; }
        }
#pragma unroll 1
        for (int t = 0; t < nt; t += 2) {
            const bool last = (t == nt - 2);
            const unsigned a1 = uA + (unsigned)(t + 1) * kstep;
            const unsigned a2 = last ? nuA : uA + (unsigned)(t + 2) * kstep; const unsigned b2 = last ? nuB : uB + (unsigned)(t + 2) * kstep;
            const unsigned a3 = a2 + kstep; const unsigned b3 = b2 + kstep;
            unsigned w0[2], w1[2];
#pragma unroll
            for (int i = 0; i < 2; ++i) { w0[i] = (GATHER && last) ? nA0[i] : vA0[i]; w1[i] = (GATHER && last) ? nA1[i] : vA1[i]; }
            PG8_LDB(B0, 0, 0); PG8_LDB(B1, 0, 1); PG8_SCHED; PG8_LDA(At, 0, 0); PG8_STAGE(PG8_SA(1, 1), baseA, a1, vA1);
            PG8_WAIT_V(8); PG8_WAIT_L(0); PG8_BAR; PG8_MMA(0, 0, At, B0); PG8_MMA(0, 1, At, B1); PG8_BAR; PG8_SCHED;
            PG8_LDA(At, 0, 1); PG8_STAGE(PG8_SB(0, 0), baseB, b2, voffB); PG8_STAGE(PG8_SB(0, 1), baseB, b2 + hstep, voffB); PG8_STAGE(PG8_SA(0, 0), baseA, a2, w0);
            PG8_WAIT_V(8); PG8_WAIT_L(0); PG8_BAR; PG8_MMA(1, 0, At, B0); PG8_MMA(1, 1, At, B1); PG8_BAR; PG8_SCHED;
            PG8_LDB(B0, 1, 0); PG8_LDB(B1, 1, 1); PG8_SCHED; PG8_LDA(At, 1, 0); PG8_STAGE(PG8_SA(0, 1), baseA, a2, w1);
            PG8_WAIT_V(8); PG8_WAIT_L(0); PG8_BAR; PG8_MMA(0, 0, At, B0); PG8_MMA(0, 1, At, B1); PG8_BAR; PG8_SCHED;
            PG8_LDA(At, 1, 1); PG8_STAGE(PG8_SB(1, 0), baseB, b3, voffB); PG8_STAGE(PG8_SB(1, 1), baseB, b3 + hstep, voffB); PG8_STAGE(PG8_SA(1, 0), baseA, a3, w0);
            PG8_WAIT_V(8); PG8_WAIT_L(0); PG8_BAR; PG8_MMA(1, 0, At, B0); PG8_MMA(1, 1, At, B1); PG8_BAR; PG8_SCHED;
        }
        if constexpr (ALIGN_EPI) { if (wr == 0) PG8_BAR; }
        E(acc, cur, wr, wc, fr, fq);
        if (!has_next) break;
#pragma unroll
        for (int a = 0; a < 2; ++a)
#pragma unroll
            for (int b = 0; b < 2; ++b)
#pragma unroll
                for (int m = 0; m < 4; ++m)
#pragma unroll
                    for (int n = 0; n < 2; ++n) acc[a][b][m][n] = (f32x4){0.f, 0.f, 0.f, 0.f};
        cur = nxt; uA = nuA; uB = nuB; ++ui;
#pragma unroll
        for (int i = 0; i < 2; ++i) { vA0[i] = nA0[i]; vA1[i] = nA1[i]; }
        if constexpr (ALIGN_EPI) { if (wr == 1) PG8_BAR; }
    }
    PG8_WAIT_V(0);
    if constexpr (!ALIGN_EPI) { if (wr == 0) PG8_BAR; }
    PG8_BAR;
#undef PG8_SA
#undef PG8_SB
#undef PG8_STAGE
#undef PG8_LDA
#undef PG8_LDB
#undef PG8_MMA
#undef PG8_WAIT_V
#undef PG8_WAIT_L
#undef PG8_BAR
#undef PG8_SCHED
}

typedef int i32x8v __attribute__((ext_vector_type(8)));
typedef int i32x4v __attribute__((ext_vector_type(4)));
template <class Epi, class Sched, bool ALIGN_EPI, bool GATHER>
__device__ __forceinline__ void gemm_phase8(PG8_LAS unsigned char* lds, const Gemm g, const Sched& S, const Epi& E, const PG8_LAS unsigned* tabA) {
    const int tid = tid_fresh(), wid = __builtin_amdgcn_readfirstlane(tid >> 6), lane = tid & 63, wr = wid >> 2, wc = wid & 3, fr = lane & 15, fq = lane >> 4;
    const int K = g.K, nt = K / BK;
    int sR[2], sC[2];
    unsigned voffB[2];
#pragma unroll
    for (int i = 0; i < 2; ++i) { int R, C; stage_rc(tid * 16 + i * 8192, R, C); sR[i] = R; sC[i] = C; const int Rb = Epi::PERM ? ((R & ~31) + perm32(R & 31)) : R;
        voffB[i] = (unsigned)(Rb * K + C) * 2u; }
    const unsigned kstep = (unsigned)(BK * 2);
    const unsigned hstep = (unsigned)(HALF * K * 2);
    const unsigned tstep = 2u * hstep;
    const unsigned ldsw = (unsigned)wid * 1024u;
    const char* const baseA = (const char*)g.A; const char* const baseB = (const char*)g.Bt;
    const int aoff = lds_byte(wr * 64 + fr, 32 * (fq >> 1) + 16 * (fq & 1)), boff = lds_byte(wc * 32 + fr, 32 * (fq >> 1) + 16 * (fq & 1));
#define PG8_SA(b, h) (((b) * 2 + (h)) * HTB)
#define PG8_SB(b, h) ((4 + (b) * 2 + (h)) * HTB)
#define PG8_STAGE(bufoff, gbase, uoff, voff) do { _Pragma("unroll") for (int _i = 0; _i < 2; ++_i) \
        __builtin_amdgcn_global_load_lds((const unsigned*)((gbase) + (size_t)(unsigned)((uoff) + (voff)[_i])), (PG8_LAS unsigned*)(lds + (bufoff) + ldsw + _i * 8192), 16, 0, 0); } while (0)
#define PG8_LD32(p) __builtin_shufflevector(*(const PG8_LAS i32x4v*)(p), *(const PG8_LAS i32x4v*)((p) + 16), 0, 1, 2, 3, 4, 5, 6, 7)
#define PG8_LDA(dst, b, h) do { _Pragma("unroll") for (int m = 0; m < 4; ++m) dst[m] = PG8_LD32(lds + PG8_SA(b, h) + aoff + m * 2048); } while (0)
#define PG8_LDB(dst, b, h) do { _Pragma("unroll") for (int n = 0; n < 2; ++n) dst[n] = PG8_LD32(lds + PG8_SB(b, h) + boff + n * 2048); } while (0)
#define PG8_MMA(ai, bj, At, Bt) do { __builtin_amdgcn_s_setprio(1); _Pragma("unroll") for (int m = 0; m < 4; ++m) _Pragma("unroll") for (int n = 0; n < 2; ++n) \
        asm volatile("v_mfma_scale_f32_16x16x128_f8f6f4 %0, %1, %2, %0, %3, %4 op_sel_hi:[0,0,0]" : "+v"(acc[ai][bj][m][n]) : "v"(Bt[n]), "v"(At[m]), "v"(scw), "v"(sca)); __builtin_amdgcn_s_setprio(0); } while (0)
#define PG8_MFMA_DRAIN asm volatile("s_nop 15\n\ts_nop 15\n\ts_nop 15" ::: "memory")
#define PG8_WAIT_V(n) asm volatile("s_waitcnt vmcnt(" #n ")" ::: "memory")
#define PG8_WAIT_L(n) asm volatile("s_waitcnt lgkmcnt(" #n ")" ::: "memory")
#define PG8_BAR __builtin_amdgcn_s_barrier()
#define PG8_SCHED __builtin_amdgcn_sched_barrier(0)
    Unit cur, nxt; int ui = 0;
    if (!S.next(0, cur)) return;
    f32x4 acc[2][2][4][2];
#pragma unroll
    for (int a = 0; a < 2; ++a)
#pragma unroll
        for (int b = 0; b < 2; ++b)
#pragma unroll
            for (int m = 0; m < 4; ++m)
#pragma unroll
                for (int n = 0; n < 2; ++n) acc[a][b][m][n] = (f32x4){0.f, 0.f, 0.f, 0.f};
    i32x8v At[4], B0[2], B1[2];
    int scw = 0x7a7a7a7a, sca = 0x7f7f7f7f;
    asm volatile("" : "+v"(scw), "+v"(sca));
    unsigned vA0[2], vA1[2], nA0[2], nA1[2];
    unsigned uA, uB = S.b_off(cur, tstep);
    if constexpr (GATHER) { uA = 0u;
#pragma unroll
        for (int i = 0; i < 2; ++i) { vA0[i] = tabA[cur.aux * 256 + sR[i]] + (unsigned)sC[i] * 2u; vA1[i] = tabA[cur.aux * 256 + 128 + sR[i]] + (unsigned)sC[i] * 2u; }
    } else { uA = (unsigned)cur.pm * tstep;
#pragma unroll
        for (int i = 0; i < 2; ++i) { vA0[i] = (unsigned)(sR[i] * K + sC[i]) * 2u; vA1[i] = vA0[i] + hstep; }
    }
    PG8_STAGE(PG8_SB(0, 0), baseB, uB, voffB); PG8_STAGE(PG8_SB(0, 1), baseB, uB + hstep, voffB); PG8_STAGE(PG8_SA(0, 0), baseA, uA, vA0); PG8_STAGE(PG8_SA(0, 1), baseA, uA, vA1);
    if (wr == 1) PG8_BAR;
    PG8_WAIT_V(2); PG8_BAR;
    PG8_STAGE(PG8_SB(1, 0), baseB, uB + kstep, voffB); PG8_STAGE(PG8_SA(1, 0), baseA, uA + kstep, vA0); PG8_STAGE(PG8_SB(1, 1), baseB, uB + hstep + kstep, voffB);
    PG8_WAIT_V(6); PG8_BAR;
    for (;;) {
        const bool has_next = S.next(ui + 1, nxt);
        unsigned nuA, nuB = has_next ? S.b_off(nxt, tstep) : uB;
        if constexpr (GATHER) { nuA = 0u;
#pragma unroll
            for (int i = 0; i < 2; ++i) { if (has_next) { nA0[i] = tabA[nxt.aux * 256 + sR[i]] + (unsigned)sC[i] * 2u; nA1[i] = tabA[nxt.aux * 256 + 128 + sR[i]] + (unsigned)sC[i] * 2u; } else { nA0[i] = vA0[i]; nA1[i] = vA1[i]; } }
        } else { nuA = has_next ? (unsigned)nxt.pm * tstep : uA;
#pragma unroll
            for (int i = 0; i < 2; ++i) { nA0[i] = vA0[i]; nA1[i] = vA1[i]; }
        }
#pragma unroll 1
        for (int t = 0; t < nt; t += 2) {
            const bool last = (t == nt - 2);
            const unsigned a1 = uA + (unsigned)(t + 1) * kstep;
            const unsigned a2 = last ? nuA : uA + (unsigned)(t + 2) * kstep; const unsigned b2 = last ? nuB : uB + (unsigned)(t + 2) * kstep;
            const unsigned a3 = a2 + kstep; const unsigned b3 = b2 + kstep;
            unsigned w0[2], w1[2];
#pragma unroll
            for (int i = 0; i < 2; ++i) { w0[i] = (GATHER && last) ? nA0[i] : vA0[i]; w1[i] = (GATHER && last) ? nA1[i] : vA1[i]; }
            PG8_LDB(B0, 0, 0); PG8_LDB(B1, 0, 1); PG8_SCHED; PG8_LDA(At, 0, 0); PG8_STAGE(PG8_SA(1, 1), baseA, a1, vA1);
            PG8_WAIT_V(8); PG8_WAIT_L(0); PG8_BAR; PG8_MMA(0, 0, At, B0); PG8_MMA(0, 1, At, B1); PG8_BAR; PG8_SCHED;
            PG8_LDA(At, 0, 1); PG8_STAGE(PG8_SB(0, 0), baseB, b2, voffB); PG8_STAGE(PG8_SB(0, 1), baseB, b2 + hstep, voffB); PG8_STAGE(PG8_SA(0, 0), baseA, a2, w0);
            PG8_WAIT_V(8); PG8_WAIT_L(0); PG8_BAR; PG8_MMA(1, 0, At, B0); PG8_MMA(1, 1, At, B1); PG8_BAR; PG8_SCHED;
            PG8_LDB(B0, 1, 0); PG8_LDB(B1, 1, 1); PG8_SCHED; PG8_LDA(At, 1, 0); PG8_STAGE(PG8_SA(0, 1), baseA, a2, w1);
            PG8_WAIT_V(8); PG8_WAIT_L(0); PG8_BAR; PG8_MMA(0, 0, At, B0); PG8_MMA(0, 1, At, B1); PG8_BAR; PG8_SCHED;
            PG8_LDA(At, 1, 1); PG8_STAGE(PG8_SB(1, 0), baseB, b3, voffB); PG8_STAGE(PG8_SB(1, 1), baseB, b3 + hstep, voffB); PG8_STAGE(PG8_SA(1, 0), baseA, a3, w0);
            PG8_WAIT_V(8); PG8_WAIT_L(0); PG8_BAR; PG8_MMA(1, 0, At, B0); PG8_MMA(1, 1, At, B1); PG8_BAR; PG8_SCHED;
        }
        if constexpr (ALIGN_EPI) { if (wr == 0) PG8_BAR; }
        PG8_MFMA_DRAIN;
        { const int l2 = tid_fresh() & 63; E(acc, cur, wr, wc, l2 & 15, l2 >> 4); }
        if (!has_next) break;
#pragma unroll
        for (int a = 0; a < 2; ++a)
#pragma unroll
            for (int b = 0; b < 2; ++b)
#pragma unroll
                for (int m = 0; m < 4; ++m)
#pragma unroll
                    for (int n = 0; n < 2; ++n) acc[a][b][m][n] = (f32x4){0.f, 0.f, 0.f, 0.f};
        cur = nxt; uA = nuA; uB = nuB; ++ui;
#pragma unroll
        for (int i = 0; i < 2; ++i) { vA0[i] = nA0[i]; vA1[i] = nA1[i]; }
        if constexpr (ALIGN_EPI) { if (wr == 1) PG8_BAR; }
    }
    PG8_WAIT_V(0);
    if constexpr (!ALIGN_EPI) { if (wr == 0) PG8_BAR; }
    PG8_BAR;
#undef PG8_SA
#undef PG8_SB
#undef PG8_STAGE
#undef PG8_LDA
#undef PG8_LD32
#undef PG8_LDB
#undef PG8_MMA
#undef PG8_MFMA_DRAIN
#undef PG8_WAIT_V
#undef PG8_WAIT_L
#undef PG8_BAR
#undef PG8_SCHED
}

__device__ __forceinline__ unsigned cvt_pk_bf16(float lo, float hi) { return pk2(lo, hi); }

struct EpiBf16 {
    static constexpr bool PERM = true;
    bf16* O; int ldc;
    __device__ __forceinline__ void operator()(const f32x4 (&acc)[2][2][4][2], const Unit& u, int wr, int wc, int fr, int fq) const {
        const int row0 = u.pm * BM + wr * 64 + fr; const int col0 = u.pn * BM + wc * 32 + 8 * fq;
#pragma unroll
        for (int ai = 0; ai < 2; ++ai)
#pragma unroll
            for (int m = 0; m < 4; ++m) { bf16* rowp = O + (size_t)(row0 + ai * HALF + m * 16) * ldc + col0;
#pragma unroll
                for (int bj = 0; bj < 2; ++bj) { const f32x4 v0 = acc[ai][bj][m][0], v1 = acc[ai][bj][m][1];
                    u32x4 w; w.x = cvt_pk_bf16(v0[0], v0[1]); w.y = cvt_pk_bf16(v0[2], v0[3]); w.z = cvt_pk_bf16(v1[0], v1[1]); w.w = cvt_pk_bf16(v1[2], v1[3]);
                    *(u32x4*)(rowp + bj * HALF) = w; } }
    }
};
struct EpiResid {
    static constexpr bool PERM = false;
    const float* xl; const float* xc; float* out; const float* gate;
    __device__ __forceinline__ void operator()(const f32x4 (&acc)[2][2][4][2], const Unit& u, int wr, int wc, int fr, int fq) const {
        const int rt = u.pm * BM; const bool isl = rt < NLAT;
        const float* base = isl ? xl + (size_t)rt * D : xc + (size_t)(rt - NLAT) * D;
        const float* gp = gate + (size_t)(isl ? (rt >> 12) : 8) * 12288;
        const int rl0 = wr * 64 + fr, col0 = u.pn * BM + wc * 32 + 4 * fq;
#pragma unroll
        for (int ai = 0; ai < 2; ++ai)
#pragma unroll
            for (int m = 0; m < 4; ++m) { const int rl = rl0 + ai * HALF + m * 16; const float* bp = base + (size_t)rl * D + col0; float* op = out + (size_t)(rt + rl) * D + col0;
#pragma unroll
                for (int bj = 0; bj < 2; ++bj)
#pragma unroll
                    for (int n = 0; n < 2; ++n) { const f32x4 b = *(const f32x4*)(bp + bj * HALF + n * 16); const f32x4 gv = *(const f32x4*)(gp + col0 + bj * HALF + n * 16); *(f32x4*)(op + bj * HALF + n * 16) = b + gv * acc[ai][bj][m][n]; }
                asm volatile("" ::: "memory"); }
    }
};
struct EpiSwiglu {
    static constexpr bool PERM = true;
    unsigned char* O;
    __device__ __forceinline__ void operator()(const f32x4 (&acc)[2][2][4][2], const Unit& u, int wr, int wc, int fr, int fq) const {
        const int row0 = u.pm * BM + wr * 64 + fr; const int col0 = u.pn * 128 + wc * 32 + 8 * fq;
#pragma unroll
        for (int ai = 0; ai < 2; ++ai)
#pragma unroll
            for (int m = 0; m < 4; ++m) { unsigned char* rowp = O + (size_t)(row0 + ai * HALF + m * 16) * DE + col0;
                float o[8];
#pragma unroll
                for (int n = 0; n < 2; ++n)
#pragma unroll
                    for (int j = 0; j < 4; ++j) { const float gt = acc[ai][0][m][n][j], up = acc[ai][1][m][n][j]; o[n * 4 + j] = gt * __builtin_amdgcn_rcpf(1.0f + __expf(-gt)) * up; }
                u32x2 w; w.x = pk4_fp8(o[0], o[1], o[2], o[3]); w.y = pk4_fp8(o[4], o[5], o[6], o[7]);
                *(u32x2*)rowp = w; }
    }
};
struct EpiDown {
    static constexpr bool PERM = true;
    bf16* YK; const PG8_LAS unsigned* tab; const PG8_LAS float* tabw;
    __device__ __forceinline__ void operator()(const f32x4 (&acc)[2][2][4][2], const Unit& u, int wr, int wc, int fr, int fq) const {
        const int rl0 = wr * 64 + fr; const int col0 = u.pn * BM + wc * 32 + 8 * fq;
#pragma unroll
        for (int ai = 0; ai < 2; ++ai)
#pragma unroll
            for (int m = 0; m < 4; ++m) { const int rl = rl0 + ai * HALF + m * 16; const unsigned ent = tab[u.aux * 256 + rl]; const float w = tabw[u.aux * 256 + rl];
                if (!(ent & 0x40000000u)) { bf16* rowp = YK + ((size_t)(ent >> 31) * MALL + (ent & 0xffffu)) * D + col0;
#pragma unroll
                    for (int bj = 0; bj < 2; ++bj) { const f32x4 v0 = acc[ai][bj][m][0] * w, v1 = acc[ai][bj][m][1] * w;
                        u32x4 q; q.x = cvt_pk_bf16(v0[0], v0[1]); q.y = cvt_pk_bf16(v0[2], v0[3]); q.z = cvt_pk_bf16(v1[0], v1[1]); q.w = cvt_pk_bf16(v1[2], v1[3]);
                        *(u32x4*)(rowp + bj * HALF) = q; } }
                asm volatile("" ::: "memory"); }
    }
};
}

struct Args { const float* in[31]; float* out; unsigned char* ws; int ph_lo, ph_hi; };
typedef const __attribute__((address_space(4))) Args* KArgs;
__device__ __forceinline__ KArgs kargs() { KArgs p = (KArgs)__builtin_amdgcn_kernarg_segment_ptr(); asm volatile("" : "+s"(p)); return p; }
#define AIN(i) (a->in[i])
enum { I_X = 0, I_C, I_CTX, I_CCTX, I_ADAW, I_ADAB, I_N1G, I_N2G, I_WIN, I_WOUT, I_GNG, I_GWS, I_GB, I_LB, I_HNG, I_MU, I_W0, I_WUP, I_A0, I_AUP, I_GUP, I_KK, I_KA, I_RK, I_GNGG, I_GNB, I_RW, I_RB, I_WGU, I_WDN, I_FNG };

__device__ __forceinline__ void p0_transpose_item(const float* W, int K, int N, bf16* WT, int n_row0, LAS float* scr, int kb, int nb, int lane) {
    const int k0 = 64 * kb, n0 = 32 * nb;
#pragma unroll 8
    for (int i = 0; i < 32; ++i) { const int kk = 2 * i + (lane >> 5); scr[kk * 33 + (lane & 31)] = W[(size_t)(k0 + kk) * N + n0 + (lane & 31)]; }
    asm volatile("s_waitcnt lgkmcnt(0)" ::: "memory");
    const int c = lane & 7;
#pragma unroll
    for (int j = 0; j < 4; ++j) { const int n = (lane >> 3) + 8 * j; const LAS float* s = scr + (8 * c) * 33 + n;
        u32x4 o; o.x = pk2(s[0 * 33], s[1 * 33]); o.y = pk2(s[2 * 33], s[3 * 33]); o.z = pk2(s[4 * 33], s[5 * 33]); o.w = pk2(s[6 * 33], s[7 * 33]);
        *(u32x4*)(WT + (size_t)(n_row0 + n) * K + k0 + 8 * c) = o; }
    asm volatile("s_waitcnt lgkmcnt(0)" ::: "memory");
}

__device__ __forceinline__ void p0_transpose_item8(const float* W, int K, int N, unsigned char* WT, int n_row0, LAS float* scr, int kb, int nb, int lane) {
    const int k0 = 64 * kb, n0 = 32 * nb;
#pragma unroll 8
    for (int i = 0; i < 32; ++i) { const int kk = 2 * i + (lane >> 5); scr[kk * 33 + (lane & 31)] = W[(size_t)(k0 + kk) * N + n0 + (lane & 31)]; }
    asm volatile("s_waitcnt lgkmcnt(0)" ::: "memory");
    const int c = lane & 7;
#pragma unroll
    for (int j = 0; j < 4; ++j) { const int n = (lane >> 3) + 8 * j; const LAS float* sp = scr + (8 * c) * 33 + n;
        u32x2 o; o.x = pk4_fp8(sp[0 * 33] * 32.f, sp[1 * 33] * 32.f, sp[2 * 33] * 32.f, sp[3 * 33] * 32.f); o.y = pk4_fp8(sp[4 * 33] * 32.f, sp[5 * 33] * 32.f, sp[6 * 33] * 32.f, sp[7 * 33] * 32.f);
        *(u32x2*)(WT + (size_t)(n_row0 + n) * K + k0 + 8 * c) = o; }
    asm volatile("s_waitcnt lgkmcnt(0)" ::: "memory");
}
__device__ __forceinline__ void convert_moe(KArgs a, int l, LAS unsigned char* lds) {
    const int tid = tid_fresh(), lane = tid & 63, wave = tid >> 6;
    const int gw = blockIdx.x * 8 + wave, NGW = gridDim.x * 8;
    unsigned char* ws = a->ws;
    LAS float* scr = (LAS float*)(lds + wave * 16384);
    constexpr int I_GU = 32 * 64, I_DN = 16 * 64, N2 = 16 * I_GU, N3 = N2 + 16 * I_DN;
    for (int it = gw; it < N3; it += NGW) {
        if (it < N2) { const int e = it / I_GU, r = it % I_GU, kb = r / 64, nb = r % 64;
            const int n0 = 32 * nb, hh = n0 >> 10, nn = n0 & 1023, row0 = 256 * (nn >> 7) + 128 * hh + (nn & 127);
            p0_transpose_item8(a->in[I_WGU] + (size_t)(l * NE + e) * D * 2048, D, 2048, ws + WS_WGU + (size_t)e * 2048 * D, row0, scr, kb, nb, lane); }
        else { const int q = it - N2, e = q / I_DN, r = q % I_DN, kb = r / 64, nb = r % 64;
            p0_transpose_item8(a->in[I_WDN] + (size_t)(l * NE + e) * DE * D, DE, D, ws + WS_WDN + (size_t)e * D * DE, 32 * nb, scr, kb, nb, lane); }
    }
}
__device__ __forceinline__ void phase_prologue(KArgs a, LAS unsigned char* lds) {
    const int tid = tid_fresh(), lane = tid & 63, wave = tid >> 6;
    const int G = gridDim.x, gw = blockIdx.x * 8 + wave, NGW = G * 8;
    unsigned char* ws = a->ws;
    LAS float* scr = (LAS float*)(lds + wave * 16384);
    constexpr int I_IN = 32 * 232, I_OUT = 32 * 64;
    constexpr int N0 = 2 * I_IN, N1 = N0 + 2 * I_OUT;
    for (int it = gw; it < N1; it += NGW) {
        if (it < N0) { const int l = it / I_IN, r = it % I_IN, kb = r / 232, nb = r % 232;
            p0_transpose_item(a->in[I_WIN] + (size_t)l * D * INC, D, INC, (bf16*)(ws + WS_WIN) + (size_t)l * INC * D, 32 * nb, scr, kb, nb, lane); }
        else { const int q = it - N0, l = q / I_OUT, r = q % I_OUT, kb = r / 64, nb = r % 64;
            p0_transpose_item8(a->in[I_WOUT] + (size_t)l * D * D, D, D, ws + WS_WOUT + (size_t)l * D * D, 32 * nb, scr, kb, nb, lane); }
    }
    convert_moe(a, 0, lds);
    {
        const int gt = blockIdx.x * NTHREADS + tid, NGT = G * NTHREADS;
        bf16* wup = (bf16*)(ws + WS_SMALLW + SW_WUP); bf16* aup = (bf16*)(ws + WS_SMALLW + SW_AUP); bf16* gup = (bf16*)(ws + WS_SMALLW + SW_GUP); bf16* gws = (bf16*)(ws + WS_SMALLW + SW_GWS);
        for (int i = gt; i < 2 * 2 * 768 * 64; i += NGT) { const int k = i & 63, n = (i >> 6) % 768, ld = i / (768 * 64); wup[i] = (bf16)f2bf(a->in[I_WUP][((size_t)ld * 64 + k) * 768 + n]); }
        for (int i = gt; i < 2 * 768 * 64; i += NGT) { const int k = i & 63, n = (i >> 6) % 768, l = i / (768 * 64); aup[i] = (bf16)f2bf(a->in[I_AUP][((size_t)l * 64 + k) * 768 + n]); }
        for (int i = gt; i < 2 * 768 * 128; i += NGT) { const int k = i & 127, n = (i >> 7) % 768, l = i / (768 * 128); gup[i] = (bf16)f2bf(a->in[I_GUP][((size_t)l * 128 + k) * 768 + n]); }
        for (int i = gt; i < 2 * 4 * 128 * 128; i += NGT) gws[i] = (bf16)f2bf(a->in[I_GWS][i]);
    }
    __syncthreads();
    {
        LAS float* sv = (LAS float*)lds;
        LAS float* red = (LAS float*)(lds + 73728);
        for (int i = tid; i < 9 * D; i += NTHREADS) { const int r = i / D, k = i % D; const float v = r < 8 ? a->in[I_C][r * D + k] : a->in[I_CCTX][k]; sv[i] = siluf_(v); }
        __syncthreads();
        float* mod = (float*)(ws + WS_MOD);
        for (int it = blockIdx.x; it < 2 * 96; it += G) {
            const int l = it / 96, cb = it % 96, cq = tid & 31, kg = tid >> 5;
            const float* wp = a->in[I_ADAW] + (size_t)l * D * 12288 + (size_t)(kg * 128) * 12288 + cb * 128 + cq * 4;
            f32x4 acc[9];
#pragma unroll
            for (int r = 0; r < 9; ++r) acc[r] = (f32x4){0.f, 0.f, 0.f, 0.f};
#pragma unroll 4
            for (int k = 0; k < 128; ++k) { const f32x4 w = *(const f32x4*)(wp + (size_t)k * 12288);
#pragma unroll
                for (int r = 0; r < 9; ++r) acc[r] += w * sv[r * D + kg * 128 + k]; }
#pragma unroll
            for (int r = 0; r < 9; ++r) *(LAS f32x4*)(red + ((kg * 9 + r) * 128 + cq * 4)) = acc[r];
            __syncthreads();
            for (int o = tid; o < 9 * 128; o += NTHREADS) { const int r = o / 128, c = o % 128; float s = a->in[I_ADAB][(size_t)l * 12288 + cb * 128 + c];
#pragma unroll
                for (int q = 0; q < 16; ++q) s += red[(q * 9 + r) * 128 + c];
                mod[((size_t)l * 9 + r) * 12288 + cb * 128 + c] = s; }
            __syncthreads();
        }
    }
}

template <int MODE>
__device__ __forceinline__ void phase_norm1(KArgs a, int l, bool dry) {
    const int tid_ = tid_fresh(); const int lane = tid_ & 63, wave = tid_ >> 6, gw = blockIdx.x * 8 + wave, NGW = gridDim.x * 8;
    unsigned char* ws = a->ws;
    const float* mod = (const float*)(ws + WS_MOD);
    float* X = (float*)(ws + WS_X); bf16* H = (bf16*)(ws + WS_H); const bf16* YK = (const bf16*)(ws + WS_YK);
    float* Xo = dry ? (float*)(ws + WS_END) : X; bf16* Ho = dry ? (bf16*)(ws + WS_END) : H; float* Oo = dry ? (float*)(ws + WS_END) : a->out;
    const int nrows = (MODE == 2) ? NLAT : MALL;
    const int rpw = (nrows + NGW - 1) / NGW; const int r0 = gw * rpw, r1 = (r0 + rpw < nrows) ? r0 + rpw : nrows;
    f32x4 ck[8], cs[8], cg[8]; int cur_mr = -1;
    for (int row = r0; row < r1; ++row) {
        const int mr = modrow_of(row); const int orow = dry ? (row & 2047) : row;
        if (mr != cur_mr) { cur_mr = mr;
#pragma unroll
            for (int j = 0; j < 8; ++j) { const int c = 4 * lane + 256 * j;
                if (MODE == 2) ck[j] = *(const f32x4*)(a->in[I_FNG] + c);
                else { const float* m = mod + ((size_t)l * 9 + mr) * 12288; const f32x4 g = *(const f32x4*)(a->in[I_N1G] + (size_t)l * D + c); ck[j] = g * (*(const f32x4*)(m + D + c) + 1.0f); cs[j] = *(const f32x4*)(m + c); }
                if (MODE != 0) cg[j] = *(const f32x4*)(mod + ((size_t)(l - 1) * 9 + mr) * 12288 + 5 * D + c); } }
        f32x4 v[8];
        if (MODE == 0) { const float* xr = row < NLAT ? a->in[I_X] + (size_t)row * D : a->in[I_CTX] + (size_t)(row - NLAT) * D;
#pragma unroll
            for (int j = 0; j < 8; ++j) v[j] = *(const f32x4*)(xr + 4 * lane + 256 * j);
        } else {
            const float* xr = X + (size_t)row * D; const bf16* y0 = YK + (size_t)row * D; const bf16* y1 = YK + ((size_t)MALL + row) * D;
            u32x2 p0[8], p1[8];
#pragma unroll
            for (int j = 0; j < 8; ++j) { const int c = 4 * lane + 256 * j; v[j] = *(const f32x4*)(xr + c); p0[j] = *(const u32x2*)(y0 + c); p1[j] = *(const u32x2*)(y1 + c); }
#pragma unroll
            for (int j = 0; j < 8; ++j) { f32x4 f; f[0] = bflo(p0[j].x) + bflo(p1[j].x); f[1] = bfhi(p0[j].x) + bfhi(p1[j].x); f[2] = bflo(p0[j].y) + bflo(p1[j].y); f[3] = bfhi(p0[j].y) + bfhi(p1[j].y);
                v[j] = v[j] + cg[j] * f; }
            if (MODE == 1) {
#pragma unroll
                for (int j = 0; j < 8; ++j) *(f32x4*)(Xo + (size_t)orow * D + 4 * lane + 256 * j) = v[j];
            }
        }
        float ss = 0.f;
#pragma unroll
        for (int j = 0; j < 8; ++j) ss += (v[j][0] * v[j][0] + v[j][1] * v[j][1]) + (v[j][2] * v[j][2] + v[j][3] * v[j][3]);
        const float rstd = 1.0f / sqrtf(wave_sum(ss) * (1.0f / D) + NORM_EPS);
        if (MODE == 2) {
#pragma unroll
            for (int j = 0; j < 8; ++j) *(f32x4*)(Oo + (size_t)orow * D + 4 * lane + 256 * j) = v[j] * rstd * ck[j];
        } else {
#pragma unroll
            for (int j = 0; j < 8; ++j) { const f32x4 h = v[j] * rstd * ck[j] + cs[j]; u32x2 o; o.x = pk2(h[0], h[1]); o.y = pk2(h[2], h[3]); *(u32x2*)(Ho + (size_t)orow * D + 4 * lane + 256 * j) = o; }
        }
    }
}

__device__ __forceinline__ void phase_norm2_router(KArgs a, int l, bool dry, LAS unsigned char* lds) {
    const int tid_ = tid_fresh(); const int lane = tid_ & 63, wave = tid_ >> 6, gw = blockIdx.x * 8 + wave, NGW = gridDim.x * 8;
    unsigned char* ws = a->ws;
    const float* mod = (const float*)(ws + WS_MOD);
    const float* X = (const float*)(ws + WS_X); bf16* H = (bf16*)(ws + WS_H);
    unsigned* cnt = (unsigned*)(ws + WS_CTL) + CW_CNT + l * 16 * 64 + (dry ? 4096 : 0);
    unsigned* ridx = (unsigned*)(ws + (dry ? WS_END : WS_RIDX)); float* rwt = (float*)(ws + (dry ? WS_END + 4 * MiB : WS_RW)); bf16* Ho = dry ? (bf16*)(ws + WS_END + 8 * MiB) : H;
    const int nrows = (l == DEPTH - 1) ? NLAT : MALL;
    LAS f32x4* rwl = (LAS f32x4*)lds;
    { const float* rw = a->in[I_RW];
      for (int idx = tid_; idx < 8192; idx += NTHREADS) { const int ln = idx & 63, q = (idx >> 6) & 3, i = (idx >> 8) & 3, j = idx >> 10; rwl[idx] = *(const f32x4*)(rw + (size_t)(4 * ln + 256 * j + i) * 16 + 4 * q); } }
    __syncthreads();
    const int rpw = (nrows + NGW - 1) / NGW; const int r0 = gw * rpw, r1 = (r0 + rpw < nrows) ? r0 + rpw : nrows;
    f32x4 ck[8]; int cur_mr = -1;
    const float* rbp = a->in[I_RB];
    for (int row = r0; row < r1; ++row) {
        const int mr = modrow_of(row); const int orow = dry ? (row & 2047) : row;
        if (mr != cur_mr) { cur_mr = mr; const float* m = mod + ((size_t)l * 9 + mr) * 12288;
#pragma unroll
            for (int j = 0; j < 8; ++j) { const int c = 4 * lane + 256 * j; const f32x4 g = *(const f32x4*)(a->in[I_N2G] + (size_t)l * D + c); ck[j] = g * (*(const f32x4*)(m + 4 * D + c) + 1.0f); } }
        const float* shp = mod + ((size_t)l * 9 + mr) * 12288 + 3 * D;
        const float* xr = X + (size_t)row * D;
        f32x4 v[8]; float ss = 0.f;
#pragma unroll
        for (int j = 0; j < 8; ++j) { v[j] = *(const f32x4*)(xr + 4 * lane + 256 * j); ss += (v[j][0] * v[j][0] + v[j][1] * v[j][1]) + (v[j][2] * v[j][2] + v[j][3] * v[j][3]); }
        const float rstd = 1.0f / sqrtf(wave_sum(ss) * (1.0f / D) + NORM_EPS);
        f32x4 lg4[4];
#pragma unroll
        for (int q = 0; q < 4; ++q) lg4[q] = (f32x4){0.f, 0.f, 0.f, 0.f};
#pragma unroll
        for (int j = 0; j < 8; ++j) { const f32x4 h = v[j] * rstd * ck[j] + *(const f32x4*)(shp + 4 * lane + 256 * j); *(unsigned*)((unsigned char*)Ho + (size_t)orow * D + 4 * lane + 256 * j) = pk4_fp8(h[0], h[1], h[2], h[3]);
#pragma unroll
            for (int i = 0; i < 4; ++i)
#pragma unroll
                for (int q = 0; q < 4; ++q) lg4[q] += rwl[((j * 4 + i) * 4 + q) * 64 + lane] * h[i];
            asm volatile("" ::: "memory"); }
        float lg[16];
        { float t8[8], t4[4], t2[2], t1;
          const bool b5 = lane & 32, b4 = lane & 16, b3 = lane & 8, b2 = lane & 4;
#pragma unroll
          for (int i = 0; i < 8; ++i) { const float keep = b5 ? lg4[(i + 8) >> 2][(i + 8) & 3] : lg4[i >> 2][i & 3], send = b5 ? lg4[i >> 2][i & 3] : lg4[(i + 8) >> 2][(i + 8) & 3]; t8[i] = keep + __shfl_xor(send, 32); }
#pragma unroll
          for (int i = 0; i < 4; ++i) { const float keep = b4 ? t8[i + 4] : t8[i], send = b4 ? t8[i] : t8[i + 4]; t4[i] = keep + __shfl_xor(send, 16); }
#pragma unroll
          for (int i = 0; i < 2; ++i) { const float keep = b3 ? t4[i + 2] : t4[i], send = b3 ? t4[i] : t4[i + 2]; t2[i] = keep + __shfl_xor(send, 8); }
          { const float keep = b2 ? t2[1] : t2[0], send = b2 ? t2[0] : t2[1]; t1 = keep + __shfl_xor(send, 4); }
          t1 += __shfl_xor(t1, 2); t1 += __shfl_xor(t1, 1);
#pragma unroll
          for (int e = 0; e < 16; ++e) { const int src = ((e >> 3) & 1) * 32 + ((e >> 2) & 1) * 16 + ((e >> 1) & 1) * 8 + (e & 1) * 4; lg[e] = __builtin_bit_cast(float, __builtin_amdgcn_readlane(__builtin_bit_cast(int, t1), src)) + rbp[e]; } }
        float mx = lg[0];
#pragma unroll
        for (int e = 1; e < 16; ++e) mx = fmaxf(mx, lg[e]);
        float p[16], sum = 0.f;
#pragma unroll
        for (int e = 0; e < 16; ++e) { p[e] = __expf(lg[e] - mx); sum += p[e]; }
        const float inv = 1.0f / sum;
#pragma unroll
        for (int e = 0; e < 16; ++e) p[e] *= inv;
        int sel = 0; float best = -1.f;
#pragma unroll
        for (int gI = 0; gI < 4; ++gI) { float m1 = -1.f, m2 = -1.f;
#pragma unroll
            for (int i = 0; i < 4; ++i) { const float q = p[4 * gI + i]; if (q > m1) { m2 = m1; m1 = q; } else if (q > m2) m2 = q; }
            const float s = m1 + m2; if (s > best) { best = s; sel = gI; } }
        int i1 = 0, i2 = 0; float p1 = -2.f, p2 = -2.f;
#pragma unroll
        for (int gI = 0; gI < 4; ++gI)
#pragma unroll
            for (int i = 0; i < 4; ++i) { const float q = (gI == sel) ? p[4 * gI + i] : -1.0f; const int e = 4 * gI + i;
                if (gI == sel) { if (q > p1) { p2 = p1; i2 = i1; p1 = q; i1 = e; } else if (q > p2) { p2 = q; i2 = e; } } }
        const float wsum = p1 + p2, w1 = p1 / wsum, w2 = p2 / wsum;
        if (lane == 0) {
            const unsigned q1 = atomicAdd(cnt + i1 * 64, 1u); ridx[(size_t)i1 * MALL + q1] = (unsigned)row; rwt[(size_t)i1 * MALL + q1] = w1;
            const unsigned q2 = atomicAdd(cnt + i2 * 64, 1u); ridx[(size_t)i2 * MALL + q2] = (unsigned)row | 0x80000000u; rwt[(size_t)i2 * MALL + q2] = w2;
        }
    }
    __syncthreads();
}

template <bool FOR_DOWN>
__device__ __forceinline__ void moe_tables(KArgs a, int l, LAS unsigned char* lds, int cvirt) {
    const int tid = tid_fresh(), G = gridDim.x;
    unsigned char* ws = a->ws;
    const unsigned* cnt = (const unsigned*)(ws + WS_CTL) + CW_CNT + l * 16 * 64;
    const unsigned* ridx = (const unsigned*)(ws + WS_RIDX); const float* rwt = (const float*)(ws + WS_RW);
    LAS int* tp = (LAS int*)(lds + LDS_TP); LAS unsigned* tab = (LAS unsigned*)(lds + LDS_TAB); LAS float* tabw = (LAS float*)(lds + LDS_TABW);
    if (tid == 0) { int acc = 0; for (int e = 0; e < 16; ++e) { tp[e] = acc; acc += (int)((cnt[e * 64] + 255u) >> 8); } tp[16] = acc; }
    __syncthreads();
    const int ntot = tp[16] * 8;
    for (int i = 0; i < 9; ++i) { const int L = i * G + cvirt; if (L >= ntot) break;
        const int tile = L >> 3; int e = 0;
        for (int j = 1; j < 16; ++j) e += (tile >= tp[j]) ? 1 : 0;
        const int pos0 = (tile - tp[e]) * 256; const unsigned ce = cnt[e * 64];
        if (tid < 256) { const int pos = pos0 + tid; const bool valid = (unsigned)pos < ce; const unsigned ent = ridx[(size_t)e * MALL + (valid ? pos : 0)];
            if (FOR_DOWN) { tab[i * 256 + tid] = valid ? ent : (ent | 0x40000000u); tabw[i * 256 + tid] = valid ? rwt[(size_t)e * MALL + pos] : 0.f; }
            else tab[i * 256 + tid] = (ent & 0xffffu) * (unsigned)D; }
    }
    __syncthreads();
}

__device__ __forceinline__ void gmlp_item(KArgs a, int l, int item, LAS unsigned char* lds) {
    const int tid = tid_fresh(), lane = tid & 63, wave = tid >> 6;
    unsigned char* ws = a->ws;
    const bf16* P = (const bf16*)(ws + WS_P); bf16* Y = (bf16*)(ws + WS_Y);
    const int chunk = item >> 2, h = item & 3;
    const int row0 = chunk < 256 ? chunk * 128 : NLAT + (chunk - 256) * 128;
    LAS bf16* wsl = (LAS bf16*)lds;
    LAS bf16* vT = (LAS bf16*)(lds + 128 * 136 * 2);
    const bf16* gws = (const bf16*)(ws + WS_SMALLW + SW_GWS) + ((size_t)l * 4 + h) * 128 * 128;
    for (int p = tid; p < 2048; p += NTHREADS) { const int t = p >> 4, c8 = p & 15; *(LAS u32x4*)(wsl + t * 136 + c8 * 8) = *(const u32x4*)(gws + t * 128 + c8 * 8); }
    {
        const int s = tid >> 2, qd = tid & 3; const bf16* vp = P + (size_t)(row0 + s) * INC + OFF_V + h * 128 + qd * 32;
        float g[32]; float ss = 0.f;
#pragma unroll
        for (int q = 0; q < 4; ++q) { float f[8]; unpack8(*(const u32x4*)(vp + 8 * q), f);
#pragma unroll
            for (int j = 0; j < 8; ++j) { const float x = geluf_(f[j]); g[8 * q + j] = x; ss += x * x; } }
        ss += __shfl_xor(ss, 1); ss += __shfl_xor(ss, 2);
        const float rstd = 1.0f / sqrtf(ss * (1.0f / 128.0f) + NORM_EPS);
        const float* ng = a->in[I_GNG] + (size_t)l * 512 + h * 128 + qd * 32;
#pragma unroll
        for (int j = 0; j < 32; ++j) vT[(qd * 32 + j) * 136 + s] = (bf16)f2bf(g[j] * rstd * ng[j]);
    }
    __syncthreads();
    f32x4 acc[8];
#pragma unroll
    for (int ct = 0; ct < 8; ++ct) acc[ct] = (f32x4){0.f, 0.f, 0.f, 0.f};
    const int fr = lane & 15, fq = lane >> 4;
#pragma unroll
    for (int ks = 0; ks < 4; ++ks) {
        const bf16x8 bfrag = *(const LAS bf16x8*)(wsl + (16 * wave + fr) * 136 + ks * 32 + fq * 8);
#pragma unroll
        for (int ct = 0; ct < 8; ++ct) { const bf16x8 afrag = *(const LAS bf16x8*)(vT + (16 * ct + fr) * 136 + ks * 32 + fq * 8);
            acc[ct] = __builtin_amdgcn_mfma_f32_16x16x32_bf16(afrag, bfrag, acc[ct], 0, 0, 0); }
    }
    const int t = 16 * wave + fr; const float wb = a->in[I_GB][((size_t)l * 4 + h) * 128 + t];
    const bf16* up = P + (size_t)(row0 + t) * INC + OFF_U + h * 128; unsigned char* yp = a->ws + WS_Y8 + (size_t)(row0 + t) * D + h * 128;
#pragma unroll
    for (int ct = 0; ct < 8; ++ct) { const int c = 16 * ct + 4 * fq; const u32x2 uu = *(const u32x2*)(up + c);
        const float y0 = geluf_(bflo(uu.x)) * (acc[ct][0] + wb), y1 = geluf_(bfhi(uu.x)) * (acc[ct][1] + wb), y2 = geluf_(bflo(uu.y)) * (acc[ct][2] + wb), y3 = geluf_(bfhi(uu.y)) * (acc[ct][3] + wb);
        *(unsigned*)(yp + c) = pk4_fp8(y0, y1, y2, y3); }
    __syncthreads();
}

constexpr int SP_ = 72;
__device__ __forceinline__ int kperm_pos(int k) { const int s5 = k & 31; return (k & 32) + 8 * ((s5 >> 2) & 3) + 4 * (s5 >> 4) + (s5 & 3); }
__device__ __forceinline__ void rwkv_prep_item(KArgs a, int l, int tile, int hgrp, LAS unsigned char* lds) {
    const int tid = tid_fresh(), lane = tid & 63, wave = tid >> 6;
    unsigned char* ws = a->ws;
    const bf16* P = (const bf16*)(ws + WS_P); bf16* Y = (bf16*)(ws + WS_Y);
    LAS bf16* SR = (LAS bf16*)lds; LAS bf16* SK = SR + 64 * SP_; LAS bf16* SV = SK + 64 * SP_; LAS bf16* SKK = SV + 64 * SP_; LAS bf16* SB = SKK + 64 * SP_; LAS bf16* SWF = SB + 64 * SP_; LAS bf16* SWB = SWF + 64 * SP_;
    LAS bf16* tw = SWB + 64 * SP_;
    LAS bf16* adl = tw + 64 * SP_;
    LAS bf16* sg = adl + 64 * SP_;
    LAS float* invn = (LAS float*)(sg + 64 * 136);
    LAS unsigned char* wpriv = (LAS unsigned char*)(invn + 64) + wave * 6144;
    const int row0 = tile * 64; const bool isl = row0 < NLAT;
    const float* mu = a->in[I_MU] + (size_t)l * CCOLS;
    const char* Pb = (const char*)P;
    auto shift_group = [&](int tk, int col, float (&z)[8]) {
        const int row = row0 + tk; int o0, o1, o2, o3; bool v0, v1, v2, v3;
        if (isl) { const int gr = (row >> 6) & 63; o0 = -1; o1 = 1; o2 = -64; o3 = 64; v0 = tk > 0; v1 = tk < 63; v2 = gr > 0; v3 = gr < 63; }
        else { const int tc = (row - NLAT) & 255; o0 = -1; o1 = 1; o2 = -1; o3 = 1; v0 = tc > 0; v1 = tc < 255; v2 = v0; v3 = v1; }
        const unsigned off = (unsigned)row * (unsigned)(INC * 2) + (unsigned)(OFF_C + col) * 2u;
        const u32x4 uo = *(const u32x4*)(Pb + off), u0 = *(const u32x4*)(Pb + (off + (unsigned)((v0 ? o0 : 0) * INC * 2))), u1 = *(const u32x4*)(Pb + (off + (unsigned)((v1 ? o1 : 0) * INC * 2))),
                    u2 = *(const u32x4*)(Pb + (off + (unsigned)((v2 ? o2 : 0) * INC * 2))), u3 = *(const u32x4*)(Pb + (off + (unsigned)((v3 ? o3 : 0) * INC * 2)));
        const f32x4 m0 = *(const f32x4*)(mu + col), m1 = *(const f32x4*)(mu + col + 4);
        float own[8], n0[8], n1[8], n2[8], n3[8]; unpack8(uo, own); unpack8(u0, n0); unpack8(u1, n1); unpack8(u2, n2); unpack8(u3, n3);
        const float f0 = v0 ? 1.f : 0.f, f1 = v1 ? 1.f : 0.f, f2 = v2 ? 1.f : 0.f, f3 = v3 ? 1.f : 0.f;
        const float nb[8] = {n0[0] * f0, n1[1] * f1, n2[2] * f2, n3[3] * f3, n0[4] * f0, n1[5] * f1, n2[6] * f2, n3[7] * f3};
#pragma unroll
        for (int j = 0; j < 8; ++j) { const float mm = j < 4 ? m0[j] : m1[j - 4]; z[j] = own[j] + mm * (nb[j] - own[j]); }
    };
#pragma unroll
    for (int it = 0; it < 4; ++it) { const int g = tid + NTHREADS * it, tk = g >> 5, gi = g & 31;
        float z[8]; shift_group(tk, 2304 + gi * 8, z);
        if (gi < 8) { float t8[8];
#pragma unroll
            for (int j = 0; j < 8; ++j) t8[j] = 1.0f - 2.0f * __builtin_amdgcn_rcpf(1.0f + __expf(2.0f * z[j]));
            *(LAS u32x4*)(tw + tk * SP_ + gi * 8) = pack8(t8); }
        else if (gi < 16) *(LAS u32x4*)(adl + tk * SP_ + (gi - 8) * 8) = pack8(z);
        else { float t8[8];
#pragma unroll
            for (int j = 0; j < 8; ++j) t8[j] = sigmoidf_(z[j]);
            *(LAS u32x4*)(sg + tk * 136 + (gi - 16) * 8) = pack8(t8); } }
    __syncthreads();
#pragma unroll 1
    for (int hh = 0; hh < 4; ++hh) {
    const int tid = tid_fresh(), lane = tid & 63, wave = tid >> 6;
    const int head = 4 * hgrp + hh; const float* kkw = a->in[I_KK] + (size_t)l * CW + head * 64;
#pragma unroll
    for (int it = 0; it < 3; ++it) { const int g = tid + NTHREADS * it, tk = g / 24, gi = g % 24, c8 = (gi & 7) * 8;
        float z[8]; shift_group(tk, (gi >> 3) * 768 + head * 64 + c8, z);
        if (gi < 8) *(LAS u32x4*)(SR + tk * SP_ + c8) = pack8(z);
        else if (gi < 16) { *(LAS u32x4*)(SK + tk * SP_ + c8) = pack8(z);
            const f32x4 k0 = *(const f32x4*)(kkw + c8), k1 = *(const f32x4*)(kkw + c8 + 4); float ss = 0.f;
#pragma unroll
            for (int j = 0; j < 8; ++j) { const float q = z[j] * (j < 4 ? k0[j] : k1[j - 4]); ss += q * q; }
            ss += __shfl_xor(ss, 1); ss += __shfl_xor(ss, 2); ss += __shfl_xor(ss, 4);
            if ((gi & 7) == 0) invn[tk] = 1.0f / fmaxf(sqrtf(ss), 1e-12f); }
        else *(LAS u32x4*)(SV + tk * SP_ + c8) = pack8(z); }
    __syncthreads();
    {
        const int fr = lane & 15, fq = lane >> 4, nt = wave & 3, th = wave >> 2;
        const bf16* wupT = (const bf16*)(ws + WS_SMALLW + SW_WUP) + (size_t)l * 2 * 768 * 64;
        const bf16* aupT = (const bf16*)(ws + WS_SMALLW + SW_AUP) + (size_t)l * 768 * 64;
        const bf16* gupT = (const bf16*)(ws + WS_SMALLW + SW_GUP) + (size_t)l * 768 * 128;
        const float* a0 = a->in[I_A0] + (size_t)l * CW + head * 64; const float* kaw = a->in[I_KA] + (size_t)l * CW + head * 64; const float* w0 = a->in[I_W0] + (size_t)l * 2 * CW + head * 64;
        const int nloc = 16 * nt + 4 * fq;
#pragma unroll 1
        for (int mat = 0; mat < 4; ++mat) {
            const bf16* WT = mat == 0 ? aupT : (mat == 1 ? wupT : (mat == 2 ? wupT + 768 * 64 : gupT));
            const int KK = mat == 3 ? 128 : 64; const LAS bf16* act = mat == 0 ? adl : (mat == 3 ? sg : tw); const int apitch = mat == 3 ? 136 : SP_;
            f32x4 acc[2];
            acc[0] = (f32x4){0.f, 0.f, 0.f, 0.f}; acc[1] = acc[0];
            for (int ks = 0; ks < KK / 32; ++ks) { const bf16x8 afr = *(const bf16x8*)(WT + (size_t)(head * 64 + 16 * nt + fr) * KK + ks * 32 + fq * 8);
#pragma unroll
                for (int tt = 0; tt < 2; ++tt) { const bf16x8 bfr = *(const LAS bf16x8*)(act + (16 * (2 * th + tt) + fr) * apitch + ks * 32 + fq * 8); acc[tt] = __builtin_amdgcn_mfma_f32_16x16x32_bf16(afr, bfr, acc[tt], 0, 0, 0); } }
#pragma unroll
            for (int tt = 0; tt < 2; ++tt) { const int tk = 16 * (2 * th + tt) + fr; const f32x4 v = acc[tt];
                if (mat == 0) {
                    const f32x4 a0v = *(const f32x4*)(a0 + nloc), kav = *(const f32x4*)(kaw + nloc), kkv = *(const f32x4*)(kkw + nloc);
                    const u32x2 kp = *(const LAS u32x2*)(SK + tk * SP_ + nloc); const float kf[4] = {bflo(kp.x), bfhi(kp.x), bflo(kp.y), bfhi(kp.y)};
                    const float inn = invn[tk]; float k2[4], kk[4], bb[4];
#pragma unroll
                    for (int j = 0; j < 4; ++j) { const float av = sigmoidf_(a0v[j] + v[j]); kk[j] = kf[j] * kkv[j] * inn; k2[j] = kf[j] * (1.0f + (av - 1.0f) * kav[j]); bb[j] = kk[j] * av; }
                    u32x2 q; q.x = pk2(k2[0], k2[1]); q.y = pk2(k2[2], k2[3]); *(LAS u32x2*)(SK + tk * SP_ + nloc) = q;
                    q.x = pk2(kk[0], kk[1]); q.y = pk2(kk[2], kk[3]); *(LAS u32x2*)(SKK + tk * SP_ + nloc) = q;
                    q.x = pk2(bb[0], bb[1]); q.y = pk2(bb[2], bb[3]); *(LAS u32x2*)(SB + tk * SP_ + nloc) = q;
                } else if (mat <= 2) {
                    const f32x4 w0v = *(const f32x4*)(w0 + (mat - 1) * CW + nloc); float d[4];
#pragma unroll
                    for (int j = 0; j < 4; ++j) d[j] = __expf(-DECAY_SCALE * sigmoidf_(w0v[j] + v[j]));
                    u32x2 q; q.x = pk2(d[0], d[1]); q.y = pk2(d[2], d[3]); *(LAS u32x2*)((mat == 1 ? SWF : SWB) + tk * SP_ + nloc) = q;
                } else {
                    u32x2 q; q.x = pk2(v[0], v[1]); q.y = pk2(v[2], v[3]); *(u32x2*)(Y + (size_t)(row0 + tk) * D + 1280 + head * 64 + nloc) = q;
                }
            }
        }
    }
    __syncthreads();
    { const int tk = tid >> 3, c8 = (tid & 7) * 8; float r8[8], k8[8], v8[8];
      unpack8(*(const LAS u32x4*)(SR + tk * SP_ + c8), r8); unpack8(*(const LAS u32x4*)(SK + tk * SP_ + c8), k8); unpack8(*(const LAS u32x4*)(SV + tk * SP_ + c8), v8);
      const float* rkp = a->in[I_RK] + (size_t)l * CW + head * 64 + c8; const f32x4 rk0 = *(const f32x4*)rkp, rk1 = *(const f32x4*)(rkp + 4);
      float bs = 0.f;
#pragma unroll
      for (int j = 0; j < 8; ++j) bs += r8[j] * k8[j] * (j < 4 ? rk0[j] : rk1[j - 4]);
      bs += __shfl_xor(bs, 1); bs += __shfl_xor(bs, 2); bs += __shfl_xor(bs, 4);
#pragma unroll
      for (int j = 0; j < 8; ++j) v8[j] *= bs;
      *(u32x4*)(Y + (size_t)(row0 + tk) * D + 512 + head * 64 + c8) = pack8(v8); }
    {
        const int c4 = wave & 3, dir = wave >> 2, fr = lane & 15, fq = lane >> 4;
        LAS float* CB = (LAS float*)wpriv;
        LAS float* AA = CB + 16 * 64;
        const LAS bf16* SW = dir ? SWB : SWF;
        auto trow = [&](int tau) { return 16 * c4 + (dir ? 15 - tau : tau); };
        float c[16], ci[16];
        { float run = 1.f;
#pragma unroll
          for (int t = 0; t < 16; ++t) { run *= bf1(SW[trow(t) * SP_ + lane]); c[t] = run; ci[t] = __builtin_amdgcn_rcpf(run); CB[t * 64 + lane] = run; } }
        const int rec_dir = dir, bidx = isl ? (row0 >> 12) : ((row0 - NLAT) >> 8);
        const int tcl = isl ? 4 * ((row0 >> 6) & 63) + c4 : 4 * (((row0 - NLAT) >> 6) & 3) + c4;
        const int nproc = isl ? 16 + (dir ? 255 - tcl : tcl) : (dir ? 15 - tcl : tcl);
        unsigned char* rec = ws + WS_PRE + ((size_t)((rec_dir * 8 + bidx) * 12 + head) * NCHUNK16 + nproc) * PRE_REC;
        { const float cl = c[15]; float bk[32];
#pragma unroll
          for (int t = 0; t < 16; ++t) { const float e = cl * ci[t]; const int pos = 8 * (t >> 2) + (t & 3); bk[pos] = bf1(SB[trow(t) * SP_ + lane]) * e; bk[pos + 4] = bf1(SK[trow(t) * SP_ + lane]) * e; }
#pragma unroll
          for (int q4 = 0; q4 < 4; ++q4) { u32x4 o; o.x = pk2(bk[8 * q4], bk[8 * q4 + 1]); o.y = pk2(bk[8 * q4 + 2], bk[8 * q4 + 3]); o.z = pk2(bk[8 * q4 + 4], bk[8 * q4 + 5]); o.w = pk2(bk[8 * q4 + 6], bk[8 * q4 + 7]);
              *(u32x4*)(rec + PR_BK + lane * 64 + q4 * 16) = o; }
          *(float*)(rec + PR_GAM + lane * 4) = cl; }
        asm volatile("s_waitcnt lgkmcnt(0)" ::: "memory");
        bf16x8 fa[2], frr[2], fb[2], fk[2];
        { const int tr = trow(fr);
#pragma unroll
          for (int sx = 0; sx < 2; ++sx) { const int ch = 32 * sx + 8 * fq; float kk8[8], r8[8], b8[8], k8[8];
              unpack8(*(const LAS u32x4*)(SKK + tr * SP_ + ch), kk8); unpack8(*(const LAS u32x4*)(SR + tr * SP_ + ch), r8); unpack8(*(const LAS u32x4*)(SB + tr * SP_ + ch), b8); unpack8(*(const LAS u32x4*)(SK + tr * SP_ + ch), k8);
              const f32x4 c0 = *(const LAS f32x4*)(CB + fr * 64 + ch), c1 = *(const LAS f32x4*)(CB + fr * 64 + ch + 4);
              f32x4 p0 = (f32x4){1.f, 1.f, 1.f, 1.f}, p1 = p0; if (fr > 0) { p0 = *(const LAS f32x4*)(CB + (fr - 1) * 64 + ch); p1 = *(const LAS f32x4*)(CB + (fr - 1) * 64 + ch + 4); }
              float xa[8], xr[8], xb[8], xk[8];
#pragma unroll
              for (int j = 0; j < 8; ++j) { const float ec = j < 4 ? c0[j] : c1[j - 4], ep = j < 4 ? p0[j] : p1[j - 4]; const float en = __builtin_amdgcn_rcpf(ec);
                  xa[j] = -kk8[j] * ep; xr[j] = r8[j] * ec; xb[j] = b8[j] * en; xk[j] = k8[j] * en; }
              const u32x4 ua = pack8(xa), ur = pack8(xr), ub = pack8(xb), uk = pack8(xk);
              fa[sx] = __builtin_bit_cast(bf16x8, ua); frr[sx] = __builtin_bit_cast(bf16x8, ur); fb[sx] = __builtin_bit_cast(bf16x8, ub); fk[sx] = __builtin_bit_cast(bf16x8, uk); } }
        f32x4 gab = (f32x4){0.f, 0.f, 0.f, 0.f}, gak = gab, grb = gab, grk = gab;
#pragma unroll
        for (int sx = 0; sx < 2; ++sx) { gab = __builtin_amdgcn_mfma_f32_16x16x32_bf16(fa[sx], fb[sx], gab, 0, 0, 0); gak = __builtin_amdgcn_mfma_f32_16x16x32_bf16(fa[sx], fk[sx], gak, 0, 0, 0);
            grb = __builtin_amdgcn_mfma_f32_16x16x32_bf16(frr[sx], fb[sx], grb, 0, 0, 0); grk = __builtin_amdgcn_mfma_f32_16x16x32_bf16(frr[sx], fk[sx], grk, 0, 0, 0); }
#pragma unroll
        for (int j = 0; j < 4; ++j) { const int tau = 4 * fq + j; const bool lo = fr < tau, le = fr <= tau;
            AA[tau * 16 + fr] = lo ? gab[j] : 0.f; AA[256 + tau * 16 + fr] = lo ? gak[j] : 0.f; grb[j] = le ? grb[j] : 0.f; grk[j] = le ? grk[j] : 0.f; }
        asm volatile("s_waitcnt lgkmcnt(0)" ::: "memory");
        float wv[16], mv[16];
#pragma unroll
        for (int t = 0; t < 16; ++t) { const float ab = -bf1(SKK[trow(t) * SP_ + lane]) * (t > 0 ? c[t - 1] : 1.0f); float accw = ab, accm = AA[256 + t * 16 + fr];
#pragma unroll
            for (int q4 = 0; q4 < 4; ++q4) { if (4 * q4 < t) { const f32x4 cf = *(const LAS f32x4*)(AA + t * 16 + 4 * q4);
#pragma unroll
                for (int j = 0; j < 4; ++j) if (4 * q4 + j < t) { accw += cf[j] * wv[4 * q4 + j]; accm += cf[j] * mv[4 * q4 + j]; } } }
            wv[t] = accw; mv[t] = accm; }
        { LAS bf16* stg = (LAS bf16*)CB; const int pp = kperm_pos(lane);
#pragma unroll
          for (int t = 0; t < 16; ++t) { stg[t * 64 + pp] = (bf16)f2bf(wv[t]); stg[1024 + t * 64 + pp] = (bf16)f2bf(bf1(SR[trow(t) * SP_ + lane]) * c[t]); }
          asm volatile("s_waitcnt lgkmcnt(0)" ::: "memory");
#pragma unroll
          for (int q4 = 0; q4 < 4; ++q4) *(u32x4*)(rec + PR_WP + (q4 * 64 + lane) * 16) = *(const LAS u32x4*)((LAS unsigned char*)stg + (q4 * 64 + lane) * 16); }
        { LAS bf16* stg = (LAS bf16*)AA; const int ps = 8 * (fr >> 2) + (fr & 3);
          asm volatile("s_waitcnt lgkmcnt(0)" ::: "memory");
#pragma unroll
          for (int j = 0; j < 4; ++j) { const int tau = 4 * fq + j; stg[tau * 32 + ps] = (bf16)f2bf(grb[j]); stg[tau * 32 + ps + 4] = (bf16)f2bf(grk[j]); }
          if (lane < 16) {
#pragma unroll
              for (int t = 0; t < 16; ++t) stg[512 + t * 16 + lane] = (bf16)f2bf(mv[t]); }
          asm volatile("s_waitcnt lgkmcnt(0)" ::: "memory");
          *(u32x4*)(rec + PR_ARBK + lane * 16) = *(const LAS u32x4*)((LAS unsigned char*)stg + lane * 16);
          if (lane < 32) *(u32x4*)(rec + PR_ARBK + 1024 + lane * 16) = *(const LAS u32x4*)((LAS unsigned char*)stg + 1024 + lane * 16); }
        if (dir == 0) { float v16[16];
#pragma unroll
            for (int t = 0; t < 16; ++t) v16[t] = bf1(SV[(16 * c4 + t) * SP_ + lane]);
            const int tcg = isl ? 16 + tcl : tcl;
            unsigned char* vrec = ws + WS_VT + ((size_t)(bidx * 12 + head) * NCHUNK16 + tcg) * 2048 + lane * 32;
            u32x4 o; o.x = pk2(v16[0], v16[1]); o.y = pk2(v16[2], v16[3]); o.z = pk2(v16[4], v16[5]); o.w = pk2(v16[6], v16[7]); *(u32x4*)vrec = o;
            o.x = pk2(v16[8], v16[9]); o.y = pk2(v16[10], v16[11]); o.z = pk2(v16[12], v16[13]); o.w = pk2(v16[14], v16[15]); *(u32x4*)(vrec + 16) = o; }
    }
    __syncthreads();
    }
}

__device__ __forceinline__ float dpp_xor1(float x) { return __builtin_bit_cast(float, __builtin_amdgcn_update_dpp(0, __builtin_bit_cast(int, x), 0xB1, 0xF, 0xF, false)); }
__device__ __forceinline__ float dpp_xor2(float x) { return __builtin_bit_cast(float, __builtin_amdgcn_update_dpp(0, __builtin_bit_cast(int, x), 0x4E, 0xF, 0xF, false)); }
__device__ __forceinline__ int chain_row(int dir, int b, int s) {
    if (s < CTXL) return NLAT + b * CTXL + (dir ? (CTXL - 1 - s) : s);
    const int t = s - CTXL; return b * T + (dir ? (T - 1 - t) : t);
}
__device__ __forceinline__ float dpp_hmirror(float x) { return __builtin_bit_cast(float, __builtin_amdgcn_update_dpp(0, __builtin_bit_cast(int, x), 0x141, 0xF, 0xF, false)); }
struct RwRec { u32x4 wp[2], rp[2], bk[4], arbk; u32x2 mak, vt[2]; f32x4 gam[4]; };
__device__ __forceinline__ void rw_load(RwRec& r, const LAS unsigned char* rec, int fr, int kg, int hv, int dir) {
#pragma unroll
    for (int sx = 0; sx < 2; ++sx) { r.wp[sx] = *(const LAS u32x4*)(rec + PR_WP + fr * 128 + sx * 64 + kg * 16); r.rp[sx] = *(const LAS u32x4*)(rec + PR_RP + fr * 128 + sx * 64 + kg * 16); }
#pragma unroll
    for (int i = 0; i < 4; ++i) { r.bk[i] = *(const LAS u32x4*)(rec + PR_BK + (16 * i + fr) * 64 + kg * 16); r.gam[i] = *(const LAS f32x4*)(rec + PR_GAM + (16 * i + 4 * kg) * 4); }
    r.arbk = *(const LAS u32x4*)(rec + PR_ARBK + fr * 64 + kg * 16);
    r.mak = *(const LAS u32x2*)(rec + PR_MAK + fr * 32 + kg * 8);
#pragma unroll
    for (int q = 0; q < 2; ++q) r.vt[q] = *(const LAS u32x2*)(rec + PRE_REC + (16 * (2 * hv + q) + fr) * 32 + (dir ? (12 - 4 * kg) : 4 * kg) * 2);
}
constexpr int RW_R = 6, RW_SLOT = PRE_REC + 2048;
__device__ __forceinline__ void rwkv_chain_mfma(KArgs a, int task_base, LAS unsigned char* lds) {
    const int t_ = tid_fresh(); const int lane = t_ & 63, fr = lane & 15, kg = lane >> 4; const int wave = __builtin_amdgcn_readfirstlane(t_ >> 6);
    unsigned char* ws = a->ws;
    bf16* OC = (bf16*)(ws + WS_OC);
    const int cid = (task_base >> 2) + (wave >> 2), wq = wave & 3, dir = cid / 96, b = (cid % 96) / 12, h = cid % 12;
    const bool comp = wq < 2; const int hv = wq & 1;
    const unsigned char* rec0 = ws + WS_PRE + (size_t)((dir * 8 + b) * 12 + h) * NCHUNK16 * PRE_REC;
    const unsigned char* vrec0 = ws + WS_VT + (size_t)(b * 12 + h) * NCHUNK16 * 2048;
    LAS unsigned char* ring = lds + (wave >> 2) * (RW_R * RW_SLOT);
    auto tchunk = [&](int n) { return n < 16 ? (dir ? 15 - n : n) : 16 + (dir ? 255 - (n - 16) : (n - 16)); };
    auto issue = [&](int n) { const int nn = n < NCHUNK16 ? n : NCHUNK16 - 1; LAS unsigned char* slot = ring + (n % RW_R) * RW_SLOT;
#pragma unroll
        for (int jj = 0; jj < 3; ++jj) { const int j = 3 * wq + jj;
            const unsigned char* src = (j < 10 ? rec0 + (size_t)nn * PRE_REC + 1024 * j : vrec0 + (size_t)tchunk(nn) * 2048 + 1024 * (j - 10)) + lane * 16;
            __builtin_amdgcn_global_load_lds((const unsigned*)src, (LAS unsigned*)(slot + 1024 * j), 16, 0, 0); } };
    f32x4 ST[2][4];
#pragma unroll
    for (int q = 0; q < 2; ++q)
#pragma unroll
        for (int i = 0; i < 4; ++i) ST[q][i] = (f32x4){0.f, 0.f, 0.f, 0.f};
    unsigned uvU[2][2] = {{0u, 0u}, {0u, 0u}};
#pragma unroll
    for (int n = 0; n < RW_R - 1; ++n) issue(n);
    for (int n = 0; n < NCHUNK16; ++n) {
        asm volatile("s_waitcnt vmcnt(12)" ::: "memory");
        __builtin_amdgcn_s_barrier(); asm volatile("" ::: "memory");
        issue(n + RW_R - 1);
        if (comp) {
            RwRec cur; rw_load(cur, ring + (n % RW_R) * RW_SLOT, fr, kg, hv, dir);
            u32x4 fmak; fmak.x = 0u; fmak.y = 0u; fmak.z = cur.mak.x; fmak.w = cur.mak.y;
            const int row = chain_row(dir, b, 16 * n + fr);
#pragma unroll
            for (int q = 0; q < 2; ++q) {
                u32x4 fs[2];
#pragma unroll
                for (int sx = 0; sx < 2; ++sx) { fs[sx].x = pk2(ST[q][2 * sx][0], ST[q][2 * sx][1]); fs[sx].y = pk2(ST[q][2 * sx][2], ST[q][2 * sx][3]); fs[sx].z = pk2(ST[q][2 * sx + 1][0], ST[q][2 * sx + 1][1]); fs[sx].w = pk2(ST[q][2 * sx + 1][2], ST[q][2 * sx + 1][3]); }
                u32x2 vt = cur.vt[q]; if (dir) { const unsigned x = vt.x, y = vt.y; vt.x = (y >> 16) | (y << 16); vt.y = (x >> 16) | (x << 16); }
                u32x4 fuv; fuv.x = uvU[q][0]; fuv.y = uvU[q][1]; fuv.z = vt.x; fuv.w = vt.y;
                f32x4 U = (f32x4){0.f, 0.f, 0.f, 0.f};
                U = __builtin_amdgcn_mfma_f32_16x16x32_bf16(__builtin_bit_cast(bf16x8, cur.wp[0]), __builtin_bit_cast(bf16x8, fs[0]), U, 0, 0, 0);
                U = __builtin_amdgcn_mfma_f32_16x16x32_bf16(__builtin_bit_cast(bf16x8, cur.wp[1]), __builtin_bit_cast(bf16x8, fs[1]), U, 0, 0, 0);
                U = __builtin_amdgcn_mfma_f32_16x16x32_bf16(__builtin_bit_cast(bf16x8, fmak), __builtin_bit_cast(bf16x8, fuv), U, 0, 0, 0);
                uvU[q][0] = pk2(U[0], U[1]); uvU[q][1] = pk2(U[2], U[3]); fuv.x = uvU[q][0]; fuv.y = uvU[q][1];
                f32x4 OT = (f32x4){0.f, 0.f, 0.f, 0.f};
                OT = __builtin_amdgcn_mfma_f32_16x16x32_bf16(__builtin_bit_cast(bf16x8, fs[0]), __builtin_bit_cast(bf16x8, cur.rp[0]), OT, 0, 0, 0);
                OT = __builtin_amdgcn_mfma_f32_16x16x32_bf16(__builtin_bit_cast(bf16x8, fs[1]), __builtin_bit_cast(bf16x8, cur.rp[1]), OT, 0, 0, 0);
                OT = __builtin_amdgcn_mfma_f32_16x16x32_bf16(__builtin_bit_cast(bf16x8, fuv), __builtin_bit_cast(bf16x8, cur.arbk), OT, 0, 0, 0);
#pragma unroll
                for (int i = 0; i < 4; ++i) ST[q][i] = __builtin_amdgcn_mfma_f32_16x16x32_bf16(__builtin_bit_cast(bf16x8, cur.bk[i]), __builtin_bit_cast(bf16x8, fuv), ST[q][i] * cur.gam[i], 0, 0, 0);
                u32x2 o; o.x = pk2(OT[0], OT[1]); o.y = pk2(OT[2], OT[3]); *(u32x2*)(OC + ((size_t)dir * MALL + row) * CW + h * 64 + 16 * (2 * hv + q) + 4 * kg) = o;
            }
        }
    }
    asm volatile("s_waitcnt vmcnt(0)" ::: "memory");
    __builtin_amdgcn_s_barrier(); asm volatile("" ::: "memory");
}
#define LDS_BAR() do { asm volatile("s_waitcnt lgkmcnt(0)" ::: "memory"); __builtin_amdgcn_s_barrier(); asm volatile("" ::: "memory"); } while (0)
__device__ __forceinline__ void hgrn_prep_item(KArgs a, int l, int item, LAS unsigned char* lds, bool dry) {
    const int tid = tid_fresh();
    unsigned char* ws = a->ws;
    bf16* P = (bf16*)(ws + WS_P); bf16* HQB = (bf16*)(ws + WS_HQB); float* HG = (float*)(ws + WS_HG);
    const int cn = item % 68, bh = item / 68, h = bh % 6, b = bh / 6;
    const int row0 = cn < 4 ? NLAT + b * CTXL + 64 * cn : b * T + 64 * (cn - 4);
    constexpr int QP = 136;
    LAS bf16* SQ = (LAS bf16*)lds; LAS bf16* KF = SQ + 64 * QP; LAS bf16* KB = KF + 64 * QP; LAS bf16* QB = KB + 64 * QP;
    LAS float* LF = (LAS float*)(QB + 64 * QP); LAS float* LBk = LF + 64 * 128;
    LAS float* tot = LBk + 64 * 128;
    LAS float* lbs = tot + 1024;
    if (tid < 256) { const int dr = tid >> 7, ch = h * 128 + (tid & 127); float lb = 0.f;
        if (l != 0) { const float l0 = a->in[I_LB][((size_t)dr * DEPTH + 0) * BW + ch], l1 = a->in[I_LB][((size_t)dr * DEPTH + 1) * BW + ch]; lb = __builtin_amdgcn_rcpf(1.0f + __expf(l0 - l1)); }
        lbs[tid] = lb; }
    const int ta = tid >> 3, d0 = (tid & 7) * 16;
    bf16* prow = P + (size_t)(row0 + ta) * INC + h * 128 + d0;
    u32x4 rq[2], rf[2], rb[2];
    rq[0] = *(const u32x4*)(prow + OFF_Q); rq[1] = *(const u32x4*)(prow + OFF_Q + 8); rf[0] = *(const u32x4*)(prow + OFF_ZF); rf[1] = *(const u32x4*)(prow + OFF_ZF + 8); rb[0] = *(const u32x4*)(prow + OFF_ZB); rb[1] = *(const u32x4*)(prow + OFF_ZB + 8);
    __syncthreads();
#pragma unroll
    for (int hf = 0; hf < 2; ++hf) { float qf[8], zf[8], zb[8], oq[8], of[8], ob[8]; unpack8(rq[hf], qf); unpack8(rf[hf], zf); unpack8(rb[hf], zb);
        const int dd = d0 + 8 * hf; f32x4 lf0, lf1, lb0, lb1;
#pragma unroll
        for (int j = 0; j < 8; ++j) { const float lF = lbs[dd + j], lB = lbs[128 + dd + j];
            const float ff = lF + (1.0f - lF) * sigmoidf_(zf[j]), fb = lB + (1.0f - lB) * sigmoidf_(zb[j]);
            const float a1 = fmaxf(__logf(ff), -60.0f), a2 = fmaxf(__logf(fb), -60.0f);
            if (j < 4) { lf0[j] = a1; lb0[j] = a2; } else { lf1[j - 4] = a1; lb1[j - 4] = a2; }
            oq[j] = siluf_(qf[j]); of[j] = 1.0f - ff; ob[j] = 1.0f - fb; }
        *(LAS u32x4*)(SQ + ta * QP + dd) = pack8(oq); *(LAS u32x4*)(KF + ta * QP + dd) = pack8(of); *(LAS u32x4*)(KB + ta * QP + dd) = pack8(ob);
        *(LAS f32x4*)(LF + ta * 128 + dd) = lf0; *(LAS f32x4*)(LF + ta * 128 + dd + 4) = lf1; *(LAS f32x4*)(LBk + ta * 128 + dd) = lb0; *(LAS f32x4*)(LBk + ta * 128 + dd + 4) = lb1; }
    __syncthreads();
    { const int d = tid & 127, qt = tid >> 7; float r1 = 0.f, r2 = 0.f;
#pragma unroll
      for (int i = 0; i < 16; ++i) { const int tp = 16 * qt + i; r1 += LF[tp * 128 + d]; LF[tp * 128 + d] = r1; r2 += LBk[(63 - tp) * 128 + d]; LBk[(63 - tp) * 128 + d] = r2; }
      tot[qt * 128 + d] = r1; tot[512 + qt * 128 + d] = r2; }
    __syncthreads();
    LAS float* bas = lbs + 256;
    LAS float* bmd = bas + 1024;
    { const int d = tid & 127, dr = (tid >> 7) & 1; if (tid < 256) { const LAS float* tt = tot + 512 * dr; const float t0 = tt[d], t1 = tt[128 + d], t2 = tt[256 + d], t3 = tt[384 + d];
        bas[(dr * 4 + 0) * 128 + d] = 0.f; bas[(dr * 4 + 1) * 128 + d] = t0; bas[(dr * 4 + 2) * 128 + d] = t0 + t1; bas[(dr * 4 + 3) * 128 + d] = t0 + t1 + t2; bmd[dr * 128 + d] = t0 + t1;
        const int npr = dr == 0 ? cn : (cn < 4 ? 3 - cn : 4 + 63 - (cn - 4)); float* g = (dry ? (float*)(ws + WS_END + 8 * MiB) : HG) + ((size_t)(((dr * 8 + b) * 6 + h) * 68 + npr)) * 256; g[d] = __expf(t0 + t1); g[128 + d] = __expf(t2 + t3); } }
    __syncthreads();
#pragma unroll
    for (int hf = 0; hf < 2; ++hf) { const int dd = d0 + 8 * hf; float sq[8], kf[8], kb[8];
        unpack8(*(const LAS u32x4*)(SQ + ta * QP + dd), sq); unpack8(*(const LAS u32x4*)(KF + ta * QP + dd), kf); unpack8(*(const LAS u32x4*)(KB + ta * QP + dd), kb);
        float oqf[8], okf[8], oqb[8], okb[8];
#pragma unroll
        for (int dr = 0; dr < 2; ++dr) { const int tp = dr ? 63 - ta : ta, q = tp >> 4; const LAS float* pf = (dr ? LBk : LF) + ta * 128 + dd;
            const f32x4 p0 = *(const LAS f32x4*)pf, p1 = *(const LAS f32x4*)(pf + 4), b0 = *(const LAS f32x4*)(bas + (dr * 4 + q) * 128 + dd), b1 = *(const LAS f32x4*)(bas + (dr * 4 + q) * 128 + dd + 4),
                        m0 = *(const LAS f32x4*)(bmd + dr * 128 + dd), m1 = *(const LAS f32x4*)(bmd + dr * 128 + dd + 4);
#pragma unroll
            for (int j = 0; j < 8; ++j) { const float bt = (j < 4 ? p0[j] + b0[j] : p1[j - 4] + b1[j - 4]), bm = j < 4 ? m0[j] : m1[j - 4];
                const float eq = __expf(fminf(bt - bm, 80.0f)), ek = __expf(fminf(bm - bt, 80.0f));
                if (dr == 0) { oqf[j] = sq[j] * eq; okf[j] = kf[j] * ek; } else { oqb[j] = sq[j] * eq; okb[j] = kb[j] * ek; } } }
        *(LAS u32x4*)(QB + ta * QP + dd) = pack8(oqf); *(LAS u32x4*)(KF + ta * QP + dd) = pack8(okf); *(LAS u32x4*)(KB + ta * QP + dd) = pack8(okb); *(LAS u32x4*)(SQ + ta * QP + dd) = pack8(oqb); }
    bf16* prow_o = dry ? (bf16*)(ws + WS_END) + (size_t)((row0 + ta) & 511) * INC + h * 128 + d0 : prow; bf16* hqb_o = dry ? (bf16*)(ws + WS_END) : HQB;
#pragma unroll
    for (int hf = 0; hf < 2; ++hf) { const int dd = d0 + 8 * hf;
        *(u32x4*)(prow_o + OFF_Q + 8 * hf) = *(const LAS u32x4*)(QB + ta * QP + dd); *(u32x4*)(prow_o + OFF_ZF + 8 * hf) = *(const LAS u32x4*)(KF + ta * QP + dd); *(u32x4*)(prow_o + OFF_ZB + 8 * hf) = *(const LAS u32x4*)(KB + ta * QP + dd);
        *(u32x4*)(hqb_o + (size_t)(dry ? ((row0 + ta) & 1023) : (row0 + ta)) * BW + h * 128 + dd) = *(const LAS u32x4*)(SQ + ta * QP + dd); }
    __syncthreads();
}
__device__ __forceinline__ unsigned tr_addr(const LAS bf16* X, int pitch, int r0, int c0, int lane) { const int i = lane & 15, g = lane >> 4; return (unsigned)(size_t)(X + (r0 + 8 * g + (i >> 2)) * pitch + c0 + 4 * (i & 3)); }
__device__ __forceinline__ void tr8x4(u32x2 (&lo)[4], u32x2 (&hi)[4], unsigned a0, unsigned a1, unsigned a2, unsigned a3, unsigned rowstep4) {
    const unsigned b0 = a0 + rowstep4, b1 = a1 + rowstep4, b2 = a2 + rowstep4, b3 = a3 + rowstep4;
    asm volatile("ds_read_b64_tr_b16 %0, %8\n\tds_read_b64_tr_b16 %1, %9\n\tds_read_b64_tr_b16 %2, %10\n\tds_read_b64_tr_b16 %3, %11\n\t"
                 "ds_read_b64_tr_b16 %4, %12\n\tds_read_b64_tr_b16 %5, %13\n\tds_read_b64_tr_b16 %6, %14\n\tds_read_b64_tr_b16 %7, %15\n\ts_waitcnt lgkmcnt(0)"
                 : "=&v"(lo[0]), "=&v"(lo[1]), "=&v"(lo[2]), "=&v"(lo[3]), "=&v"(hi[0]), "=&v"(hi[1]), "=&v"(hi[2]), "=&v"(hi[3])
                 : "v"(a0), "v"(a1), "v"(a2), "v"(a3), "v"(b0), "v"(b1), "v"(b2), "v"(b3) : "memory");
}
__device__ __forceinline__ void tr_half(u32x2 (&vl)[8], u32x2 (&vh)[8], u32x2 (&xl)[2], u32x2 (&xh)[2], unsigned av, unsigned ak, unsigned ax) {
    asm volatile(
        "ds_read_b64_tr_b16 %0, %20\n\tds_read_b64_tr_b16 %1, %20 offset:32\n\tds_read_b64_tr_b16 %2, %20 offset:64\n\tds_read_b64_tr_b16 %3, %20 offset:96\n\t"
        "ds_read_b64_tr_b16 %4, %20 offset:128\n\tds_read_b64_tr_b16 %5, %20 offset:160\n\tds_read_b64_tr_b16 %6, %20 offset:192\n\tds_read_b64_tr_b16 %7, %20 offset:224\n\t"
        "ds_read_b64_tr_b16 %8, %20 offset:1088\n\tds_read_b64_tr_b16 %9, %20 offset:1120\n\tds_read_b64_tr_b16 %10, %20 offset:1152\n\tds_read_b64_tr_b16 %11, %20 offset:1184\n\t"
        "ds_read_b64_tr_b16 %12, %20 offset:1216\n\tds_read_b64_tr_b16 %13, %20 offset:1248\n\tds_read_b64_tr_b16 %14, %20 offset:1280\n\tds_read_b64_tr_b16 %15, %20 offset:1312\n\t"
        "ds_read_b64_tr_b16 %16, %21\n\tds_read_b64_tr_b16 %17, %22\n\tds_read_b64_tr_b16 %18, %21 offset:1088\n\tds_read_b64_tr_b16 %19, %22 offset:1088\n\ts_waitcnt lgkmcnt(0)"
        : "=&v"(vl[0]), "=&v"(vl[1]), "=&v"(vl[2]), "=&v"(vl[3]), "=&v"(vl[4]), "=&v"(vl[5]), "=&v"(vl[6]), "=&v"(vl[7]),
          "=&v"(vh[0]), "=&v"(vh[1]), "=&v"(vh[2]), "=&v"(vh[3]), "=&v"(vh[4]), "=&v"(vh[5]), "=&v"(vh[6]), "=&v"(vh[7]),
          "=&v"(xl[0]), "=&v"(xl[1]), "=&v"(xh[0]), "=&v"(xh[1])
        : "v"(av), "v"(ak), "v"(ax) : "memory");
}
__device__ __forceinline__ bf16x8 mk8(u32x2 lo, u32x2 hi) { u32x4 v; v.x = lo.x; v.y = lo.y; v.z = hi.x; v.w = hi.y; return __builtin_bit_cast(bf16x8, v); }
__device__ __forceinline__ void hgrn_chain_lean(KArgs a, int cid, LAS unsigned char* lds) {
    const int tid = tid_fresh(), lane = tid & 63, wave = tid >> 6, fr = lane & 15, fq = lane >> 4;
    unsigned char* ws = a->ws;
    const bf16* P = (const bf16*)(ws + WS_P); const bf16* HQB = (const bf16*)(ws + WS_HQB); const float* HG = (const float*)(ws + WS_HG); bf16* OB = (bf16*)(ws + WS_OB);
    const int dir = cid / 48, b = (cid % 48) / 6, h = cid % 6;
    constexpr int QP = 136, SP = 72;
    LAS bf16* qs = (LAS bf16*)lds;
    LAS bf16* ks = qs + 64 * QP;
    LAS bf16* vs = ks + 64 * QP;
    LAS bf16* pl = vs + 64 * QP;
    LAS bf16* sT = pl + 64 * SP;
    LAS float* gm = (LAS float*)(sT + 128 * QP);
    const int ta = tid >> 3, d0 = (tid & 7) * 16;
    const int koff = dir ? OFF_ZB : OFF_ZF;
    f32x4 S[8];
#pragma unroll
    for (int vt = 0; vt < 8; ++vt) S[vt] = (f32x4){0.f, 0.f, 0.f, 0.f};
    u32x4 rq[2], rk[2], rv[2]; float rg = 0.f;
    auto load_chunk = [&](int n) { const int row = chain_row(dir, b, 64 * n + ta); const bf16* pr = P + (size_t)row * INC + h * 128 + d0;
        const bf16* qr = dir ? HQB + (size_t)row * BW + h * 128 + d0 : pr + OFF_Q;
        rq[0] = *(const u32x4*)qr; rq[1] = *(const u32x4*)(qr + 8); rk[0] = *(const u32x4*)(pr + koff); rk[1] = *(const u32x4*)(pr + koff + 8); rv[0] = *(const u32x4*)(pr + OFF_I); rv[1] = *(const u32x4*)(pr + OFF_I + 8);
        if (tid < 256) rg = HG[((size_t)(((dir * 8 + b) * 6 + h) * 68 + n)) * 256 + tid]; };
    load_chunk(0);
    constexpr int NCH = (CTXL + T) / 64;
    for (int n = 0; n < NCH; ++n) {
        const int s0 = n * 64;
        *(LAS u32x4*)(qs + ta * QP + d0) = rq[0]; *(LAS u32x4*)(qs + ta * QP + d0 + 8) = rq[1]; *(LAS u32x4*)(ks + ta * QP + d0) = rk[0]; *(LAS u32x4*)(ks + ta * QP + d0 + 8) = rk[1];
        *(LAS u32x4*)(vs + ta * QP + d0) = rv[0]; *(LAS u32x4*)(vs + ta * QP + d0 + 8) = rv[1]; if (tid < 256) gm[tid] = rg;
        if (n + 1 < NCH) load_chunk(n + 1);
        LDS_BAR();
        { const f32x4 g4 = *(const LAS f32x4*)(gm + 16 * wave + 4 * fq);
#pragma unroll
          for (int vt = 0; vt < 8; ++vt) { S[vt] = S[vt] * g4; u32x2 o; o.x = pk2(S[vt][0], S[vt][1]); o.y = pk2(S[vt][2], S[vt][3]); *(LAS u32x2*)(sT + (16 * vt + fr) * QP + 16 * wave + 4 * fq) = o; } }
        { const int tt = wave >> 1;
#pragma unroll
          for (int u = 0; u < 2; ++u) { const int sg = 2 * (wave & 1) + u; f32x4 acc = (f32x4){0.f, 0.f, 0.f, 0.f};
              if (sg <= tt) {
#pragma unroll
                  for (int kq = 0; kq < 4; ++kq) { const bf16x8 af = *(const LAS bf16x8*)(ks + (16 * sg + fr) * QP + 32 * kq + 8 * fq), bfm = *(const LAS bf16x8*)(qs + (16 * tt + fr) * QP + 32 * kq + 8 * fq);
                      acc = __builtin_amdgcn_mfma_f32_16x16x32_bf16(af, bfm, acc, 0, 0, 0); }
                  if (sg == tt) {
#pragma unroll
                      for (int j = 0; j < 4; ++j) if (4 * fq + j > fr) acc[j] = 0.f; }
              }
              u32x2 o; o.x = pk2(acc[0], acc[1]); o.y = pk2(acc[2], acc[3]); *(LAS u32x2*)(pl + (16 * tt + fr) * SP + 16 * sg + 4 * fq) = o; } }
        LDS_BAR();
        f32x4 oacc[4];
#pragma unroll
        for (int tt = 0; tt < 4; ++tt) { f32x4 acc = (f32x4){0.f, 0.f, 0.f, 0.f};
#pragma unroll
            for (int kq = 0; kq < 4; ++kq) { const bf16x8 af = *(const LAS bf16x8*)(sT + (16 * wave + fr) * QP + 32 * kq + 8 * fq), bfm = *(const LAS bf16x8*)(qs + (16 * tt + fr) * QP + 32 * kq + 8 * fq);
                acc = __builtin_amdgcn_mfma_f32_16x16x32_bf16(af, bfm, acc, 0, 0, 0); }
            oacc[tt] = acc; }
        const unsigned rs4 = (unsigned)(4 * QP * 2);
#pragma unroll
        for (int kq = 0; kq < 2; ++kq) {
            u32x2 vl_[8], vh_[8], xl_[2], xh_[2];
            static_assert(QP == 136, "tr_half's immediates assume 272-byte rows");
            tr_half(vl_, vh_, xl_, xh_, tr_addr(vs, QP, 32 * kq, 0, lane), tr_addr(ks, QP, 32 * kq, 16 * wave, lane), tr_addr(vs, QP, 32 * kq, 16 * wave, lane));
            __builtin_amdgcn_sched_barrier(0);
            { const bf16x8 af = mk8(xl_[1], xh_[1]);
#pragma unroll
              for (int tt = 0; tt < 4; ++tt) { const bf16x8 bfm = *(const LAS bf16x8*)(pl + (16 * tt + fr) * SP + 32 * kq + 8 * fq); oacc[tt] = __builtin_amdgcn_mfma_f32_16x16x32_bf16(af, bfm, oacc[tt], 0, 0, 0); } }
            { const bf16x8 af = mk8(xl_[0], xh_[0]);
#pragma unroll
              for (int vt = 0; vt < 8; ++vt) S[vt] = __builtin_amdgcn_mfma_f32_16x16x32_bf16(af, mk8(vl_[vt], vh_[vt]), S[vt], 0, 0, 0); }
        }
#pragma unroll
        for (int tt = 0; tt < 4; ++tt) { const int row = chain_row(dir, b, s0 + 16 * tt + fr);
            u32x2 o; o.x = pk2(oacc[tt][0], oacc[tt][1]); o.y = pk2(oacc[tt][2], oacc[tt][3]); *(u32x2*)(OB + ((size_t)dir * MALL + row) * BW + h * 128 + 16 * wave + 4 * fq) = o; }
        { const f32x4 ge = *(const LAS f32x4*)(gm + 128 + 16 * wave + 4 * fq);
#pragma unroll
          for (int vt = 0; vt < 8; ++vt) S[vt] = S[vt] * ge; }
        LDS_BAR();
    }
}
__device__ __forceinline__ void hgrn_chain_mfma(KArgs a, int l, int cid, LAS unsigned char* lds) {
    const int tid = tid_fresh(), lane = tid & 63, wave = tid >> 6, fr = lane & 15, fq = lane >> 4;
    unsigned char* ws = a->ws;
    const bf16* P = (const bf16*)(ws + WS_P); bf16* OB = (bf16*)(ws + WS_OB);
    const int dir = cid / 48, b = (cid % 48) / 6, h = cid % 6;
    constexpr int QP = 136, SP = 72;
    LAS bf16* qs = (LAS bf16*)lds;
    LAS bf16* ks = qs + 64 * QP;
    LAS bf16* kT = ks + 64 * QP;
    LAS bf16* vT = kT + 128 * SP;
    LAS bf16* pl = vT + 128 * SP;
    LAS bf16* sT = pl + 64 * SP;
    LAS float* tot = (LAS float*)(sT + 128 * QP);
    LAS float* gmid = tot + 512;
    LAS float* gend = gmid + 128;
    LAS float* lbs = gend + 128;
    LAS float* lfb = (LAS float*)sT;
    const int d = tid & 127, qt = tid >> 7;
    const int tau_a = tid >> 3, d0 = (tid & 7) * 16;
    if (tid < 128) { const int ch = h * 128 + tid; float lb = 0.f;
        if (l != 0) { const float l0 = a->in[I_LB][((size_t)dir * DEPTH + 0) * BW + ch], l1 = a->in[I_LB][((size_t)dir * DEPTH + 1) * BW + ch]; lb = 1.0f / (1.0f + __expf(l0 - l1)); }
        lbs[tid] = lb; }
    f32x4 S[8];
#pragma unroll
    for (int vt = 0; vt < 8; ++vt) S[vt] = (f32x4){0.f, 0.f, 0.f, 0.f};
    const int zoff = dir ? OFF_ZB : OFF_ZF;
    u32x4 rq[2], ri[2], rz[2];
    { const bf16* pr = P + (size_t)chain_row(dir, b, tau_a) * INC + h * 128 + d0;
      rq[0] = *(const u32x4*)(pr + OFF_Q); rq[1] = *(const u32x4*)(pr + OFF_Q + 8); ri[0] = *(const u32x4*)(pr + OFF_I); ri[1] = *(const u32x4*)(pr + OFF_I + 8); rz[0] = *(const u32x4*)(pr + zoff); rz[1] = *(const u32x4*)(pr + zoff + 8); }
    __syncthreads();
    constexpr int NCH = (CTXL + T) / 64;
    for (int n = 0; n < NCH; ++n) {
        const int s0 = n * 64;
#pragma unroll
        for (int hf = 0; hf < 2; ++hf) { float qf[8], zf[8], oq[8], ok[8]; unpack8(rq[hf], qf); unpack8(rz[hf], zf);
            const int dd = d0 + 8 * hf; const f32x4 lb0 = *(const LAS f32x4*)(lbs + dd), lb1 = *(const LAS f32x4*)(lbs + dd + 4); f32x4 lf0, lf1;
#pragma unroll
            for (int j = 0; j < 8; ++j) { const float lb = j < 4 ? lb0[j] : lb1[j - 4]; const float f = lb + (1.0f - lb) * sigmoidf_(zf[j]); const float lf = fmaxf(__logf(f), -60.0f);
                if (j < 4) lf0[j] = lf; else lf1[j - 4] = lf; oq[j] = siluf_(qf[j]); ok[j] = 1.0f - f; }
            *(LAS u32x4*)(qs + tau_a * QP + dd) = pack8(oq); *(LAS u32x4*)(ks + tau_a * QP + dd) = pack8(ok);
            *(LAS f32x4*)(lfb + tau_a * 128 + dd) = lf0; *(LAS f32x4*)(lfb + tau_a * 128 + dd + 4) = lf1;
            const u32x4 vv = ri[hf];
            vT[(dd + 0) * SP + tau_a] = (bf16)(vv.x & 0xffffu); vT[(dd + 1) * SP + tau_a] = (bf16)(vv.x >> 16); vT[(dd + 2) * SP + tau_a] = (bf16)(vv.y & 0xffffu); vT[(dd + 3) * SP + tau_a] = (bf16)(vv.y >> 16);
            vT[(dd + 4) * SP + tau_a] = (bf16)(vv.z & 0xffffu); vT[(dd + 5) * SP + tau_a] = (bf16)(vv.z >> 16); vT[(dd + 6) * SP + tau_a] = (bf16)(vv.w & 0xffffu); vT[(dd + 7) * SP + tau_a] = (bf16)(vv.w >> 16); }
        if (n + 1 < NCH) { const bf16* pr = P + (size_t)chain_row(dir, b, s0 + 64 + tau_a) * INC + h * 128 + d0;
            rq[0] = *(const u32x4*)(pr + OFF_Q); rq[1] = *(const u32x4*)(pr + OFF_Q + 8); ri[0] = *(const u32x4*)(pr + OFF_I); ri[1] = *(const u32x4*)(pr + OFF_I + 8); rz[0] = *(const u32x4*)(pr + zoff); rz[1] = *(const u32x4*)(pr + zoff + 8); }
        LDS_BAR();
        float cs[16];
        { float run = 0.f;
#pragma unroll
          for (int i = 0; i < 16; ++i) { run += lfb[(16 * qt + i) * 128 + d]; cs[i] = run; }
          tot[qt * 128 + d] = run; }
        LDS_BAR();
        { const float t0 = tot[d], t1 = tot[128 + d], t2 = tot[256 + d], t3 = tot[384 + d];
          const float bmid = t0 + t1, btot = bmid + t2 + t3; const float base = (qt > 0 ? t0 : 0.f) + (qt > 1 ? t1 : 0.f) + (qt > 2 ? t2 : 0.f);
          if (qt == 0) { gmid[d] = __expf(bmid); gend[d] = __expf(btot - bmid); }
#pragma unroll
          for (int i = 0; i < 16; ++i) { const int tau = 16 * qt + i; const float bt = base + cs[i];
              const float eq = __expf(fminf(bt - bmid, 80.0f)), ek = __expf(fminf(bmid - bt, 80.0f));
              const bf16 qb = (bf16)f2bf(bf1(qs[tau * QP + d]) * eq), kb = (bf16)f2bf(bf1(ks[tau * QP + d]) * ek);
              qs[tau * QP + d] = qb; ks[tau * QP + d] = kb; kT[d * SP + tau] = kb; } }
        LDS_BAR();
        { const f32x4 gm = *(const LAS f32x4*)(gmid + 16 * wave + 4 * fq);
#pragma unroll
          for (int vt = 0; vt < 8; ++vt) { S[vt] = S[vt] * gm; u32x2 o; o.x = pk2(S[vt][0], S[vt][1]); o.y = pk2(S[vt][2], S[vt][3]); *(LAS u32x2*)(sT + (16 * vt + fr) * QP + 16 * wave + 4 * fq) = o; } }
        { const int tt = wave >> 1;
#pragma unroll
          for (int u = 0; u < 2; ++u) { const int sg = 2 * (wave & 1) + u; f32x4 acc = (f32x4){0.f, 0.f, 0.f, 0.f};
              if (sg <= tt) {
#pragma unroll
                  for (int kq = 0; kq < 4; ++kq) { const bf16x8 af = *(const LAS bf16x8*)(ks + (16 * sg + fr) * QP + 32 * kq + 8 * fq), bfm = *(const LAS bf16x8*)(qs + (16 * tt + fr) * QP + 32 * kq + 8 * fq);
                      acc = __builtin_amdgcn_mfma_f32_16x16x32_bf16(af, bfm, acc, 0, 0, 0); }
                  if (sg == tt) {
#pragma unroll
                      for (int j = 0; j < 4; ++j) if (4 * fq + j > fr) acc[j] = 0.f; }
              }
              u32x2 o; o.x = pk2(acc[0], acc[1]); o.y = pk2(acc[2], acc[3]); *(LAS u32x2*)(pl + (16 * tt + fr) * SP + 16 * sg + 4 * fq) = o; } }
        LDS_BAR();
#pragma unroll
        for (int tt = 0; tt < 4; ++tt) { f32x4 acc = (f32x4){0.f, 0.f, 0.f, 0.f};
#pragma unroll
            for (int kq = 0; kq < 2; ++kq) { const bf16x8 af = *(const LAS bf16x8*)(vT + (16 * wave + fr) * SP + 32 * kq + 8 * fq), bfm = *(const LAS bf16x8*)(pl + (16 * tt + fr) * SP + 32 * kq + 8 * fq);
                acc = __builtin_amdgcn_mfma_f32_16x16x32_bf16(af, bfm, acc, 0, 0, 0); }
#pragma unroll
            for (int kq = 0; kq < 4; ++kq) { const bf16x8 af = *(const LAS bf16x8*)(sT + (16 * wave + fr) * QP + 32 * kq + 8 * fq), bfm = *(const LAS bf16x8*)(qs + (16 * tt + fr) * QP + 32 * kq + 8 * fq);
                acc = __builtin_amdgcn_mfma_f32_16x16x32_bf16(af, bfm, acc, 0, 0, 0); }
            const int row = chain_row(dir, b, s0 + 16 * tt + fr);
            u32x2 o; o.x = pk2(acc[0], acc[1]); o.y = pk2(acc[2], acc[3]); *(u32x2*)(OB + ((size_t)dir * MALL + row) * BW + h * 128 + 16 * wave + 4 * fq) = o; }
        { const f32x4 ge = *(const LAS f32x4*)(gend + 16 * wave + 4 * fq);
#pragma unroll
          for (int kq = 0; kq < 2; ++kq) { const bf16x8 af = *(const LAS bf16x8*)(kT + (16 * wave + fr) * SP + 32 * kq + 8 * fq);
#pragma unroll
              for (int vt = 0; vt < 8; ++vt) { const bf16x8 bfm = *(const LAS bf16x8*)(vT + (16 * vt + fr) * SP + 32 * kq + 8 * fq); S[vt] = __builtin_amdgcn_mfma_f32_16x16x32_bf16(af, bfm, S[vt], 0, 0, 0); } }
#pragma unroll
          for (int vt = 0; vt < 8; ++vt) S[vt] = S[vt] * ge; }
        LDS_BAR();
    }
}
__device__ __forceinline__ void hgrn_chain(KArgs a, int l, int cid, LAS unsigned char* lds) {
    const int tid = tid_fresh();
    unsigned char* ws = a->ws;
    const bf16* P = (const bf16*)(ws + WS_P); bf16* OB = (bf16*)(ws + WS_OB);
    const int dir = cid / 48, b = (cid % 48) / 6, h = cid % 6;
    LAS float* tq = (LAS float*)lds;
    LAS float* tk = tq + 16 * 128;
    LAS float* tf = tk + 16 * 128;
    LAS float* tv = tf + 16 * 128;
    LAS float* ot = tv + 16 * 128;
    const int v = tid >> 2, q = tid & 3;
    float S[32];
#pragma unroll
    for (int j = 0; j < 32; ++j) S[j] = 0.f;
    const int sst = tid >> 5, sc4 = (tid & 31) * 4;
    float lb[4];
#pragma unroll
    for (int j = 0; j < 4; ++j) { const int ch = h * 128 + sc4 + j;
        if (l == 0) lb[j] = 0.f; else { const float l0 = a->in[I_LB][((size_t)dir * DEPTH + 0) * BW + ch], l1 = a->in[I_LB][((size_t)dir * DEPTH + 1) * BW + ch]; lb[j] = 1.0f / (1.0f + __expf(l0 - l1)); } }
    for (int s0 = 0; s0 < CTXL + T; s0 += 16) {
        { const int row = chain_row(dir, b, s0 + sst); const bf16* pr = P + (size_t)row * INC + h * 128 + sc4;
          const u32x2 pq = *(const u32x2*)(pr + OFF_Q), pi = *(const u32x2*)(pr + OFF_I), pz = *(const u32x2*)(pr + (dir ? OFF_ZB : OFF_ZF));
          const float qf[4] = {bflo(pq.x), bfhi(pq.x), bflo(pq.y), bfhi(pq.y)}, vf[4] = {bflo(pi.x), bfhi(pi.x), bflo(pi.y), bfhi(pi.y)}, zf[4] = {bflo(pz.x), bfhi(pz.x), bflo(pz.y), bfhi(pz.y)};
          f32x4 oq, ok, of, ov;
#pragma unroll
          for (int j = 0; j < 4; ++j) { const float f = lb[j] + (1.0f - lb[j]) * sigmoidf_(zf[j]); oq[j] = siluf_(qf[j]); of[j] = f; ok[j] = 1.0f - f; ov[j] = vf[j]; }
          *(LAS f32x4*)(tq + sst * 128 + sc4) = oq; *(LAS f32x4*)(tk + sst * 128 + sc4) = ok; *(LAS f32x4*)(tf + sst * 128 + sc4) = of; *(LAS f32x4*)(tv + sst * 128 + sc4) = ov; }
        LDS_BAR();
        for (int st = 0; st < 16; ++st) {
            const float vv = tv[st * 128 + v]; float o0 = 0.f, o1 = 0.f;
#pragma unroll
            for (int j = 0; j < 8; ++j) { const f32x4 fq4 = *(const LAS f32x4*)(tf + st * 128 + q * 32 + 4 * j), kq4 = *(const LAS f32x4*)(tk + st * 128 + q * 32 + 4 * j), qq4 = *(const LAS f32x4*)(tq + st * 128 + q * 32 + 4 * j);
#pragma unroll
                for (int i = 0; i < 4; ++i) { const float sn = fq4[i] * S[4 * j + i] + kq4[i] * vv; S[4 * j + i] = sn; if (i & 1) o1 += qq4[i] * sn; else o0 += qq4[i] * sn; } }
            float o = o0 + o1; o += dpp_xor1(o); o += dpp_xor2(o);
            if (q == 0) ot[st * 128 + v] = o;
        }
        LDS_BAR();
        if (tid < 256) { const int st = tid >> 4, part = tid & 15; const int row = chain_row(dir, b, s0 + st); const LAS float* op = ot + st * 128 + part * 8;
            float f[8];
#pragma unroll
            for (int j = 0; j < 8; ++j) f[j] = op[j];
            *(u32x4*)(OB + ((size_t)dir * MALL + row) * BW + h * 128 + part * 8) = pack8(f); }
    }
    LDS_BAR();
}

__device__ __forceinline__ float grp_sum32(float v) { v += __shfl_xor(v, 1); v += __shfl_xor(v, 2); v += __shfl_xor(v, 4); v += __shfl_xor(v, 8); v += __shfl_xor(v, 16); return v; }
__device__ __forceinline__ float grp_sum16(float v) { v += __shfl_xor(v, 1); v += __shfl_xor(v, 2); v += __shfl_xor(v, 4); v += __shfl_xor(v, 8); return v; }
__device__ __forceinline__ void phase_finalize(KArgs a, int l, bool dry) {
    const int tid_ = tid_fresh(); const int lane = tid_ & 63, wave = tid_ >> 6, gw = blockIdx.x * 8 + wave, NGW = gridDim.x * 8;
    unsigned char* ws = a->ws;
    const bf16* P = (const bf16*)(ws + WS_P); const bf16* OB = (const bf16*)(ws + WS_OB); const bf16* OC = (const bf16*)(ws + WS_OC); bf16* Y = (bf16*)(ws + WS_Y);
    unsigned char* Yo = dry ? ws + WS_END : ws + WS_Y8;
    const int nrows = (l == DEPTH - 1) ? NLAT : MALL;
    const int rpw = (nrows + NGW - 1) / NGW; const int r0 = gw * rpw, r1 = (r0 + rpw < nrows) ? r0 + rpw : nrows;
    f32x4 hng[3], gng[3], gnb[3];
#pragma unroll
    for (int k = 0; k < 3; ++k) { const int c = 256 * k + 4 * lane; hng[k] = *(const f32x4*)(a->in[I_HNG] + (size_t)l * BW + c);
        gng[k] = *(const f32x4*)(a->in[I_GNGG] + (size_t)l * CW + c); gnb[k] = *(const f32x4*)(a->in[I_GNB] + (size_t)l * CW + c); }
    for (int row = r0; row < r1; ++row) {
        const int orow = dry ? (row & 2047) : row;
        u32x2 bf_[3], bb_[3], bg_[3], cf_[3], cb_[3], cv_[3], cg_[3];
#pragma unroll
        for (int k = 0; k < 3; ++k) { const int c = 256 * k + 4 * lane;
            bf_[k] = *(const u32x2*)(OB + (size_t)row * BW + c); bb_[k] = *(const u32x2*)(OB + ((size_t)MALL + row) * BW + c); bg_[k] = *(const u32x2*)(P + (size_t)row * INC + OFF_OG + c);
            cf_[k] = *(const u32x2*)(OC + (size_t)row * CW + c); cb_[k] = *(const u32x2*)(OC + ((size_t)MALL + row) * CW + c);
            cv_[k] = *(const u32x2*)(Y + (size_t)row * D + 512 + c);
            cg_[k] = *(const u32x2*)(Y + (size_t)row * D + 1280 + c); }
#pragma unroll
        for (int k = 0; k < 3; ++k) { const int c = 256 * k + 4 * lane;
            { float o[4] = {bflo(bf_[k].x) + bflo(bb_[k].x), bfhi(bf_[k].x) + bfhi(bb_[k].x), bflo(bf_[k].y) + bflo(bb_[k].y), bfhi(bf_[k].y) + bfhi(bb_[k].y)};
              const float ss = grp_sum32((o[0] * o[0] + o[1] * o[1]) + (o[2] * o[2] + o[3] * o[3])); const float rstd = 1.0f / sqrtf(ss * (1.0f / 128.0f) + NORM_EPS);
              const float g4[4] = {bflo(bg_[k].x), bfhi(bg_[k].x), bflo(bg_[k].y), bfhi(bg_[k].y)}; float y[4];
#pragma unroll
              for (int j = 0; j < 4; ++j) y[j] = o[j] * rstd * hng[k][j] * sigmoidf_(g4[j]);
              *(unsigned*)(Yo + (size_t)orow * D + 512 + c) = pk4_fp8(y[0], y[1], y[2], y[3]); }
            { float o[4] = {bflo(cf_[k].x) + bflo(cb_[k].x), bfhi(cf_[k].x) + bfhi(cb_[k].x), bflo(cf_[k].y) + bflo(cb_[k].y), bfhi(cf_[k].y) + bfhi(cb_[k].y)};
              const float v4[4] = {bflo(cv_[k].x), bfhi(cv_[k].x), bflo(cv_[k].y), bfhi(cv_[k].y)}, g4[4] = {bflo(cg_[k].x), bfhi(cg_[k].x), bflo(cg_[k].y), bfhi(cg_[k].y)};
              const float mean = grp_sum16((o[0] + o[1]) + (o[2] + o[3])) * (1.0f / 64.0f);
              float dl[4]; float sq = 0.f;
#pragma unroll
              for (int j = 0; j < 4; ++j) { dl[j] = o[j] - mean; sq += dl[j] * dl[j]; }
              const float var = grp_sum16(sq) * (1.0f / 64.0f); const float rs = 1.0f / sqrtf(var + GN_EPS); float y[4];
#pragma unroll
              for (int j = 0; j < 4; ++j) y[j] = (dl[j] * rs * gng[k][j] + gnb[k][j] + v4[j]) * g4[j];
              *(unsigned*)(Yo + (size_t)orow * D + 1280 + c) = pk4_fp8(y[0], y[1], y[2], y[3]); }
        }
    }
}

__global__ void __launch_bounds__(NTHREADS, 2) mk_fwd(Args args_unused) {
    extern __shared__ __attribute__((aligned(16))) unsigned char lds_raw[];
    LAS unsigned char* lds = (LAS unsigned char*)lds_raw;
    volatile LAS unsigned* misc = (volatile LAS unsigned*)(lds + LDS_MISC);
    const int tid = threadIdx.x, G = gridDim.x;
    if (tid < 64) misc[tid] = 0u;
    __syncthreads();
    XcdBarrier bar; bar.bar = nullptr; bar.x = 0; bar.st = nullptr;
    int lo, hi;
    { KArgs a = kargs(); lo = a->ph_lo; hi = a->ph_hi; unsigned* ctl = (unsigned*)(a->ws + WS_CTL); bar.bar = ctl + CW_BAR; if (!MK_MULTI) bar = xcd_barrier_post(ctl + CW_BAR, misc + 8); }
    const int cvirt = (G % 8 == 0) ? ((int)blockIdx.x % 8) * (G / 8) + (int)blockIdx.x / 8 : (int)blockIdx.x;
#define IN(k) (lo <= (k) && (k) < hi)
#define PM(b) ((PHMASK >> (b)) & 1)
#define REP(b) _Pragma("unroll 1") for (int rep_ = 0; rep_ < 1 + ((PROBE_DUP >> (b)) & 1); ++rep_)
#define SEAM(k) do { if (!MK_MULTI && IN(k) && IN((k) + 1)) { xcd_barrier(bar); if ((PROBE_DUP >> 13) & 1) xcd_barrier(bar); } } while (0)

    if (PM(0) && IN(0)) REP(0) { phase_prologue(kargs(), lds); } SEAM(0);

#pragma unroll 1
    for (int l = 0; l < DEPTH; ++l) {
        const int pb = 1 + 9 * l;
        const bool lastl = (l == DEPTH - 1);
        if (PM(1) && IN(pb + 0)) { if ((PROBE_DUP >> 1) & 1) { if (l == 0) phase_norm1<0>(kargs(), l, true); else phase_norm1<1>(kargs(), l, true); } if (l == 0) phase_norm1<0>(kargs(), l, false); else { phase_norm1<1>(kargs(), l, false); __syncthreads(); convert_moe(kargs(), l, lds); __syncthreads(); } } SEAM(pb + 0);
        if (PM(2) && IN(pb + 1)) REP(2) {
            KArgs a = kargs(); unsigned char* ws = a->ws;
            pg8::Gemm g{(const bf16*)(ws + WS_H), (const bf16*)(ws + WS_WIN) + (size_t)l * INC * D, MALL, INC, D};
            pg8::StaticOrder S; S.init(MALL, INC, G, (int)blockIdx.x);
            pg8::EpiBf16 E{(bf16*)(ws + WS_P), INC};
            pg8::gemm_phase<pg8::EpiBf16, pg8::StaticOrder, false, false>(lds, g, S, E, nullptr);
        } SEAM(pb + 1);
        if (PM(3) && IN(pb + 2)) {
            const int ngm = lastl ? 1024 : 1088;
            unsigned* qhead = (unsigned*)(kargs()->ws + WS_CTL) + CW_PREPQ + 64 * l;
            const int n_rw = 544 * 3, n_hg = 3264, n_all = (G == 256) ? n_rw + n_hg : n_rw + n_hg + ngm;
            for (;;) {
                if (threadIdx.x == 0) misc[16] = __hip_atomic_fetch_add(qhead, 1u, __ATOMIC_RELAXED, __HIP_MEMORY_SCOPE_AGENT);
                __syncthreads();
                const int it = (int)misc[16];
                if (it >= n_all) break;
                if (it < n_rw) { _Pragma("unroll 1") for (int r2 = 0; r2 < 1 + ((PROBE_DUP >> 15) & 1); ++r2) rwkv_prep_item(kargs(), l, it / 3, it % 3, lds); }
                else if (it < n_rw + n_hg) { if ((PROBE_DUP >> 16) & 1) hgrn_prep_item(kargs(), l, it - n_rw, lds, true); hgrn_prep_item(kargs(), l, it - n_rw, lds, false); }
                else { _Pragma("unroll 1") for (int r2 = 0; r2 < 1 + ((PROBE_DUP >> 14) & 1); ++r2) gmlp_item(kargs(), l, it - n_rw - n_hg, lds); }
            }
            __syncthreads();
        } SEAM(pb + 2);
        if (PM(4) && IN(pb + 3)) REP(4) {
            if (G == 256) { const int bx = blockIdx.x;
                if (bx < 96) { _Pragma("unroll 1") for (int r2 = 0; r2 < 1 + ((PROBE_DUP >> 12) & 1); ++r2) rwkv_chain_mfma(kargs(), bx * 8, lds); }
                else if (bx < 192) { _Pragma("unroll 1") for (int r2 = 0; r2 < 1 + ((PROBE_DUP >> 11) & 1); ++r2) hgrn_chain_lean(kargs(), bx - 96, lds); }
                if (bx < 96 || bx >= 192) {
                    unsigned* gq = (unsigned*)(kargs()->ws + WS_CTL) + CW_GMQ + 64 * l; const int ngm2 = lastl ? 1024 : 1088;
                    for (;;) { if (threadIdx.x == 0) misc[17] = __hip_atomic_fetch_add(gq, 1u, __ATOMIC_RELAXED, __HIP_MEMORY_SCOPE_AGENT);
                        __syncthreads(); const int it = (int)misc[17]; if (it >= ngm2) break; gmlp_item(kargs(), l, it, lds); }
                    __syncthreads(); } }
            else { for (int it = blockIdx.x; it < 192; it += G) { if (it < 96) rwkv_chain_mfma(kargs(), it * 8, lds); else hgrn_chain_lean(kargs(), it - 96, lds); } }
        } SEAM(pb + 3);
        if (PM(5) && IN(pb + 4)) { if ((PROBE_DUP >> 5) & 1) phase_finalize(kargs(), l, true); phase_finalize(kargs(), l, false); } SEAM(pb + 4);
        if (PM(6) && IN(pb + 5)) REP(6) {
            KArgs a = kargs(); unsigned char* ws = a->ws;
            const int Mo = lastl ? NLAT : MALL;
            pg8::Gemm g{(const bf16*)(ws + WS_Y8), (const bf16*)(ws + WS_WOUT + (size_t)l * D * D), Mo, D, D / 2};
            pg8::StaticOrder S; S.init(Mo, D, G, (int)blockIdx.x);
            const float* xl = l == 0 ? a->in[I_X] : (const float*)(ws + WS_X); const float* xc = l == 0 ? a->in[I_CTX] : (const float*)(ws + WS_X) + (size_t)NLAT * D;
            pg8::EpiResid E{xl, xc, (float*)(ws + WS_X), (const float*)(ws + WS_MOD) + (size_t)l * 9 * 12288 + 2 * D};
            pg8::gemm_phase8<pg8::EpiResid, pg8::StaticOrder, true, false>(lds, g, S, E, nullptr);
        } SEAM(pb + 5);
        if (PM(7) && IN(pb + 6)) { if ((PROBE_DUP >> 7) & 1) phase_norm2_router(kargs(), l, true, lds); phase_norm2_router(kargs(), l, false, lds); } SEAM(pb + 6);
        if (PM(8) && IN(pb + 7)) REP(8) {
            KArgs a = kargs(); unsigned char* ws = a->ws;
            moe_tables<false>(a, l, lds, cvirt);
            pg8::Gemm g{(const bf16*)(ws + WS_H), (const bf16*)(ws + WS_WGU), 0, 2048, D / 2};
            pg8::MoeOrder S{(const LAS int*)(lds + LDS_TP), G, cvirt, (unsigned)(2048 * D)};
            pg8::EpiSwiglu E{ws + WS_ACT};
            pg8::gemm_phase8<pg8::EpiSwiglu, pg8::MoeOrder, false, true>(lds, g, S, E, (const LAS unsigned*)(lds + LDS_TAB));
        } SEAM(pb + 7);
        if (PM(9) && IN(pb + 8)) REP(9) {
            KArgs a = kargs(); unsigned char* ws = a->ws;
            moe_tables<true>(a, l, lds, cvirt);
            pg8::Gemm g{(const bf16*)(ws + WS_ACT), (const bf16*)(ws + WS_WDN), 0, D, DE / 2};
            pg8::MoeOrder S{(const LAS int*)(lds + LDS_TP), G, cvirt, (unsigned)(D * DE)};
            pg8::EpiDown E{(bf16*)(ws + WS_YK), (const LAS unsigned*)(lds + LDS_TAB), (const LAS float*)(lds + LDS_TABW)};
            pg8::gemm_phase8<pg8::EpiDown, pg8::MoeOrder, false, false>(lds, g, S, E, nullptr);
        } SEAM(pb + 8);
    }
    if (PM(10) && IN(1 + 9 * DEPTH)) { if ((PROBE_DUP >> 10) & 1) phase_norm1<2>(kargs(), DEPTH, true); phase_norm1<2>(kargs(), DEPTH, false); }
#undef IN
#undef SEAM
}

extern "C" void kernel_launch(void* const* d_in, const int* in_sizes, int n_in, void* d_out, int out_size, void* d_ws, size_t ws_size, hipStream_t stream) {
    static int grid = 0;
    if (grid == 0) {
        if (n_in != 31 || ws_size < WS_END) { fprintf(stderr, "kernel_launch: unexpected n_in %d / ws %zu (need %zu)\n", n_in, ws_size, (size_t)WS_END); grid = -1; return; }
        int dev = 0, cus = 0, per_cu = 0;
        hipGetDevice(&dev); hipDeviceGetAttribute(&cus, hipDeviceAttributeMultiprocessorCount, dev);
        if (hipFuncSetAttribute((const void*)mk_fwd, hipFuncAttributeMaxDynamicSharedMemorySize, LDS_BYTES) != hipSuccess) { fprintf(stderr, "kernel_launch: hipFuncSetAttribute failed\n"); grid = -1; return; }
        if (hipOccupancyMaxActiveBlocksPerMultiprocessor(&per_cu, (const void*)mk_fwd, NTHREADS, LDS_BYTES) != hipSuccess || per_cu < 1) fprintf(stderr, "kernel_launch: occupancy query says %d\n", per_cu);
        (void)hipGetLastError();
        grid = cus > 0 ? cus : 256;
    }
    if (grid < 0) return;
    hipMemsetAsync((char*)d_ws + WS_CTL, 0, CTL_ZERO_BYTES, stream);
    Args a{};
    for (int i = 0; i < 31; ++i) a.in[i] = (const float*)d_in[i];
    a.out = (float*)d_out; a.ws = (unsigned char*)d_ws;
    constexpr int NPH = 2 + 9 * DEPTH;
#if MK_MULTI
    for (int p = 0; p < NPH; ++p) { a.ph_lo = p; a.ph_hi = p + 1; hipLaunchKernelGGL(mk_fwd, dim3(grid), dim3(NTHREADS), LDS_BYTES, stream, a); }
#else
    a.ph_lo = 0; a.ph_hi = NPH; hipLaunchKernelGGL(mk_fwd, dim3(grid), dim3(NTHREADS), LDS_BYTES, stream, a);
#endif
}
```

```cpp
#include <hip/hip_runtime.h>
#include <cstdio>
#include <cstdint>

#ifndef PHMASK
#define PHMASK 0xFFFF
#endif
#ifndef PROBE_DUP
#define PROBE_DUP 0
#endif
#ifndef MK_MULTI
#define MK_MULTI 0
#endif

#define GAS __attribute__((address_space(1)))
#define LAS __attribute__((address_space(3)))
typedef unsigned short bf16;
typedef short bf16x8 __attribute__((ext_vector_type(8)));
typedef float f32x4 __attribute__((ext_vector_type(4)));
typedef float f32x2 __attribute__((ext_vector_type(2)));
typedef unsigned u32x4 __attribute__((ext_vector_type(4)));
typedef unsigned u32x2 __attribute__((ext_vector_type(2)));

constexpr int D = 2048, NB = 8, T = 4096, CTXL = 256, DEPTH = 2;
constexpr int NLAT = NB * T, NCTX = NB * CTXL, MALL = NLAT + NCTX;
constexpr int INC = 7424;
constexpr int OFF_U = 0, OFF_V = 512, OFF_Q = 1024, OFF_I = 1792, OFF_ZF = 2560, OFF_ZB = 3328, OFF_OG = 4096;
constexpr int OFF_C = 4864;
constexpr int BW = 768, CW = 768, CCOLS = 2560;
constexpr int NE = 16, DE = 1024;
constexpr int PC2W = 7 * 768;
constexpr int NTHREADS = 512;
constexpr float NORM_EPS = 1e-6f, GN_EPS = 64e-5f, DECAY_SCALE = 0.60653065971263342f;

constexpr size_t MiB = 1u << 20;
constexpr size_t WS_CTL = 0, CTL_ZERO_BYTES = 1 * MiB;
constexpr size_t WS_MOD = 1 * MiB;
constexpr size_t WS_SMALLW = 2 * MiB;
constexpr size_t SW_WUP = 0, SW_AUP = SW_WUP + (size_t)2 * 2 * 768 * 64 * 2, SW_GUP = SW_AUP + (size_t)2 * 768 * 64 * 2, SW_GWS = SW_GUP + (size_t)2 * 768 * 128 * 2;
constexpr size_t WS_WIN = 4 * MiB, WS_WOUT = 62 * MiB, WS_WGU = 78 * MiB, WS_WDN = 142 * MiB, WS_Y8 = 174 * MiB;
constexpr size_t WS_X = 270 * MiB, WS_H = 542 * MiB, WS_Y = 678 * MiB, WS_P = 814 * MiB, WS_PRE = 1307 * MiB, WS_VT = 1817 * MiB, WS_OC = 1868 * MiB, WS_HQB = 1970 * MiB, WS_HG = 2021 * MiB, WS_END = 2028 * MiB;
constexpr int PRE_REC = 10240, PR_WP = 0, PR_RP = 2048, PR_BK = 4096, PR_ARBK = 8192, PR_MAK = 9216, PR_GAM = 9728, NCHUNK16 = 272;
constexpr size_t WS_OB = WS_H;
constexpr size_t WS_ACT = WS_P, WS_YK = WS_P + 144 * MiB, WS_RIDX = WS_P + 416 * MiB, WS_RW = WS_RIDX + 3 * MiB;
static_assert(WS_RW + 3 * MiB <= WS_PRE, "moe overlay");
constexpr int MAXSLOT_TILES = 288;
constexpr int CW_BAR = 4096;
constexpr int CW_GMQ = 30720;
constexpr int CW_PREPQ = 28672;
constexpr int CW_CNT = 16384;

constexpr int LDS_STAGE = 0, LDS_TAB = 131072, LDS_TABW = LDS_TAB + 9 * 1024, LDS_TP = LDS_TABW + 9 * 1024, LDS_MISC = 150528, LDS_BYTES = 152 * 1024;
static_assert(LDS_TP + 128 <= LDS_MISC, "lds map");

typedef __bf16 bf16x2_t __attribute__((ext_vector_type(2)));
__device__ __forceinline__ unsigned pk2(float lo, float hi) { const f32x2 v = {lo, hi}; return __builtin_bit_cast(unsigned, __builtin_convertvector(v, bf16x2_t)); }
__device__ __forceinline__ unsigned f2bf(float f) { return pk2(f, f) & 0xffffu; }
__device__ __forceinline__ unsigned pk4_fp8(float a, float b, float c, float d) {
    a = __builtin_amdgcn_fmed3f(a, -448.f, 448.f); b = __builtin_amdgcn_fmed3f(b, -448.f, 448.f); c = __builtin_amdgcn_fmed3f(c, -448.f, 448.f); d = __builtin_amdgcn_fmed3f(d, -448.f, 448.f);
    int p = 0; p = __builtin_amdgcn_cvt_pk_fp8_f32(a, b, p, false); p = __builtin_amdgcn_cvt_pk_fp8_f32(c, d, p, true); return (unsigned)p; }
__device__ __forceinline__ float bflo(unsigned u) { return __builtin_bit_cast(float, u << 16); }
__device__ __forceinline__ float bfhi(unsigned u) { return __builtin_bit_cast(float, u & 0xffff0000u); }
__device__ __forceinline__ float bf1(bf16 b) { return __builtin_bit_cast(float, ((unsigned)b) << 16); }
__device__ __forceinline__ float sigmoidf_(float x) { return __builtin_amdgcn_rcpf(1.0f + __expf(-x)); }
__device__ __forceinline__ float siluf_(float x) { return x * __builtin_amdgcn_rcpf(1.0f + __expf(-x)); }
__device__ __forceinline__ float geluf_(float v) {
    const float av = fabsf(v), t = __builtin_amdgcn_rcpf(av * 0.2316418882f + 1.0f);
    float q = t * 0.5307027145f + (-0.7265760135f); q = q * t + 0.7107068705f; q = q * t + (-0.142248368f); q = q * t + 0.127414796f; q = q * t;
    const float e = __builtin_amdgcn_exp2f((v * v) * (-0.72134752044f)); const float m = v * (q * e); return v < 0.f ? m : v - m; }
__device__ __forceinline__ float wave_sum(float v) {
#pragma unroll
    for (int o = 1; o < 64; o <<= 1) v += __shfl_xor(v, o);
    return v;
}
__device__ __forceinline__ int tid_fresh() { int t = threadIdx.x; asm volatile("" : "+v"(t)); return t; }
__device__ __forceinline__ void unpack8(const u32x4 v, float (&f)[8]) {
    f[0] = bflo(v.x); f[1] = bfhi(v.x); f[2] = bflo(v.y); f[3] = bfhi(v.y); f[4] = bflo(v.z); f[5] = bfhi(v.z); f[6] = bflo(v.w); f[7] = bfhi(v.w);
}
__device__ __forceinline__ u32x4 pack8(const float (&f)[8]) { u32x4 v; v.x = pk2(f[0], f[1]); v.y = pk2(f[2], f[3]); v.z = pk2(f[4], f[5]); v.w = pk2(f[6], f[7]); return v; }
__device__ __forceinline__ int modrow_of(int row) { return row < NLAT ? (row >> 12) : 8; }

#define XB_TMO      128
#define XB_XCNT(j)  (256  + 64 * (j))
#define XB_XSUB(j)  (1280 + 64 * (j))
#define XB_XGEN(j)  (2304 + 64 * (j))
#define XB_TOP      3328
#define XB_TOPGEN   3392
#define XCD_BAR_WORDS 3456
#define XB_SPIN_CAP (1u << 18)
__device__ __forceinline__ unsigned xb_ld(unsigned* p)              { return __hip_atomic_load(p, __ATOMIC_RELAXED, __HIP_MEMORY_SCOPE_AGENT); }
__device__ __forceinline__ unsigned xb_add(unsigned* p, unsigned v) { return __hip_atomic_fetch_add(p, v, __ATOMIC_RELAXED, __HIP_MEMORY_SCOPE_AGENT); }
__device__ __forceinline__ unsigned xb_xcc_id() { return (unsigned)__builtin_amdgcn_s_getreg((3 << 11) | 20) & 0xFu; }
#define XB_SPIN(cond, bar) do { unsigned _sp = 0; while (cond) { __builtin_amdgcn_s_sleep(1); \
    if ((++_sp & 255u) == 0u) { if (xb_ld(&(bar)[XB_TMO])) break; if (_sp > XB_SPIN_CAP) { atomicAdd(&(bar)[XB_TMO], 1u); break; } } } } while (0)
struct XcdBarrier { unsigned* bar; unsigned x; volatile LAS unsigned* st; };
__device__ __forceinline__ XcdBarrier xcd_barrier_post(unsigned* bar, volatile LAS unsigned* st) {
    XcdBarrier b; b.bar = bar; b.x = xb_xcc_id(); b.st = st;
    if (threadIdx.x == 0) (void)xb_add(&bar[XB_XCNT(b.x)], 1u);
    return b;
}
__device__ __forceinline__ void xcd_barrier_complete(unsigned* bar, unsigned x, unsigned& nloc, unsigned& nx) {
    const unsigned G = gridDim.x * gridDim.y * gridDim.z;
    unsigned sum, cnt, mine, sp = 0u;
    for (;;) {
        sum = 0u; cnt = 0u; mine = 0u;
#pragma unroll
        for (unsigned j = 0; j < 16; ++j) { const unsigned c = xb_ld(&bar[XB_XCNT(j)]); sum += c; cnt += (c > 0u) ? 1u : 0u; mine = (j == x) ? c : mine; }
        if (sum == G) break;
        __builtin_amdgcn_s_sleep(1);
        if ((++sp & 255u) == 0u) { if (xb_ld(&bar[XB_TMO])) break; if (sp > XB_SPIN_CAP) { atomicAdd(&bar[XB_TMO], 1u); break; } }
    }
    nloc = mine > 0u ? mine : 1u; nx = cnt > 0u ? cnt : 1u;
}
__device__ __forceinline__ void xcd_barrier(const XcdBarrier& b) {
    asm volatile("s_waitcnt vmcnt(0)" ::: "memory");
    __syncthreads();
    if (threadIdx.x == 0) {
        unsigned* bar = b.bar;
        __builtin_amdgcn_s_waitcnt(0);
        unsigned nloc = b.st[0], nx = b.st[1];
        if (nloc == 0u) { xcd_barrier_complete(bar, b.x, nloc, nx); b.st[0] = nloc; b.st[1] = nx; }
        const unsigned old = xb_add(&bar[XB_XSUB(b.x)], 1u);
        const unsigned gen = old / nloc;
        if (old + 1u == (gen + 1u) * nloc) {
            __builtin_amdgcn_fence(__ATOMIC_RELEASE, "agent");
            asm volatile("s_waitcnt vmcnt(0)" ::: "memory");
            const unsigned og = xb_add(&bar[XB_TOP], 1u);
            const unsigned tg = og / nx;
            if (og + 1u == (tg + 1u) * nx) xb_add(&bar[XB_TOPGEN], 1u);
            else XB_SPIN(xb_ld(&bar[XB_TOPGEN]) == tg, bar);
            __builtin_amdgcn_fence(__ATOMIC_ACQUIRE, "agent");
            xb_add(&bar[XB_XGEN(b.x)], 1u);
            asm volatile("s_waitcnt vmcnt(0)" ::: "memory");
        } else {
            XB_SPIN(xb_ld(&bar[XB_XGEN(b.x)]) == gen, bar);
            __builtin_amdgcn_fence(__ATOMIC_ACQUIRE, "agent");
            asm volatile("s_waitcnt vmcnt(0)" ::: "memory");
        }
    }
    __syncthreads();
}

namespace pg8 {
constexpr int BM = 256, BK = 64, HALF = 128, HTB = HALF * BK * 2, STAGE_BYTES = 8 * HTB, NXCD = 8, WGM = 8;
__host__ __device__ __forceinline__ int lds_byte(int r, int c) { const int st = (r >> 4) * 2 + (c >> 5), rr = r & 15, cc = c & 31, ob = rr * 64 + cc * 2; return st * 1024 + (ob ^ (((ob >> 9) & 1) << 5)); }
__host__ __device__ __forceinline__ void stage_rc(int b, int& R, int& C) { const int st = b / 1024, sb = b % 1024, swz = sb ^ (((sb >> 9) & 1) << 5); R = (st >> 1) * 16 + swz / 64; C = (st & 1) * 32 + (swz % 64) / 2; }
__host__ __device__ __forceinline__ int perm32(int rho) { const int n = rho >> 4, i = rho & 15; return 8 * (i >> 2) + 4 * n + (i & 3); }

struct Unit { int pm, pn, e, aux; };
struct Gemm { const bf16* A; const bf16* Bt; int M, N, K; };

struct StaticOrder {
    int nM, nN, nwg, G, c;
    __device__ void init(int M, int N, int G_, int c_) { nM = M / BM; nN = N / BM; nwg = nM * nN; G = G_; c = c_; }
    __device__ bool next(int i, Unit& u) const {
        const long L = (long)i * G + c; if (L >= nwg) return false;
        int wgid = (int)L; { const int q = nwg / NXCD, r = nwg % NXCD, xcd = wgid % NXCD, off = wgid / NXCD; wgid = (xcd < r ? xcd * (q + 1) : r * (q + 1) + (xcd - r) * q) + off; }
        const int nig = WGM * nN, gid = wgid / nig, fm = gid * WGM, gsz = (nM - fm) < WGM ? (nM - fm) : WGM;
        u.pm = fm + ((wgid % nig) % gsz); u.pn = (wgid % nig) / gsz; u.e = 0; u.aux = 0; return true;
    }
    __device__ __forceinline__ unsigned b_off(const Unit& u, unsigned tstep) const { return (unsigned)u.pn * tstep; }
};
struct MoeOrder {
    const LAS int* tp; int G, c; unsigned estride;
    __device__ bool next(int i, Unit& u) const {
        const int L = i * G + c; const int ntot = tp[16] * 8; if (L >= ntot) return false;
        const int tile = L >> 3; int e = 0;
#pragma unroll
        for (int j = 1; j < 16; ++j) e += (tile >= tp[j]) ? 1 : 0;
        u.pm = tile; u.pn = L & 7; u.e = e; u.aux = i; return true;
    }
    __device__ __forceinline__ unsigned b_off(const Unit& u, unsigned tstep) const { return (unsigned)u.e * estride + (unsigned)u.pn * tstep; }
};

#define PG8_LAS __attribute__((address_space(3)))
template <class Epi, class Sched, bool ALIGN_EPI, bool GATHER>
__device__ __forceinline__ void gemm_phase(PG8_LAS unsigned char* lds, const Gemm g, const Sched& S, const Epi& E, const PG8_LAS unsigned* tabA) {
    const int tid = tid_fresh(), wid = __builtin_amdgcn_readfirstlane(tid >> 6), lane = tid & 63, wr = wid >> 2, wc = wid & 3, fr = lane & 15, fq = lane >> 4;
    const int K = g.K, nt = K / BK;
    int sR[2], sC[2];
    unsigned voffB[2];
#pragma unroll
    for (int i = 0; i < 2; ++i) { int R, C; stage_rc(tid * 16 + i * 8192, R, C); sR[i] = R; sC[i] = C; const int Rb = Epi::PERM ? ((R & ~31) + perm32(R & 31)) : R;
        voffB[i] = (unsigned)(Rb * K + C) * 2u; }
    const unsigned kstep = (unsigned)(BK * 2);
    const unsigned hstep = (unsigned)(HALF * K * 2);
    const unsigned tstep = 2u * hstep;
    const unsigned ldsw = (unsigned)wid * 1024u;
    const char* const baseA = (const char*)g.A; const char* const baseB = (const char*)g.Bt;
    const int aoff = lds_byte(wr * 64 + fr, fq * 8), boff = lds_byte(wc * 32 + fr, fq * 8);
#define PG8_SA(b, h) (((b) * 2 + (h)) * HTB)
#define PG8_SB(b, h) ((4 + (b) * 2 + (h)) * HTB)
#define PG8_STAGE(bufoff, gbase, uoff, voff) do { _Pragma("unroll") for (int _i = 0; _i < 2; ++_i) \
        __builtin_amdgcn_global_load_lds((const unsigned*)((gbase) + (size_t)(unsigned)((uoff) + (voff)[_i])), (PG8_LAS unsigned*)(lds + (bufoff) + ldsw + _i * 8192), 16, 0, 0); } while (0)
#define PG8_LDA(dst, b, h) do { _Pragma("unroll") for (int m = 0; m < 4; ++m) _Pragma("unroll") for (int k = 0; k < 2; ++k) dst[m][k] = *(const PG8_LAS bf16x8*)(lds + PG8_SA(b, h) + aoff + m * 2048 + k * 1024); } while (0)
#define PG8_LDB(dst, b, h) do { _Pragma("unroll") for (int n = 0; n < 2; ++n) _Pragma("unroll") for (int k = 0; k < 2; ++k) dst[n][k] = *(const PG8_LAS bf16x8*)(lds + PG8_SB(b, h) + boff + n * 2048 + k * 1024); } while (0)
#define PG8_MMA(ai, bj, At, Bt) do { __builtin_amdgcn_s_setprio(1); _Pragma("unroll") for (int m = 0; m < 4; ++m) _Pragma("unroll") for (int n = 0; n < 2; ++n) _Pragma("unroll") for (int k = 0; k < 2; ++k) \
        acc[ai][bj][m][n] = __builtin_amdgcn_mfma_f32_16x16x32_bf16(Bt[n][k], At[m][k], acc[ai][bj][m][n], 0, 0, 0); __builtin_amdgcn_s_setprio(0); } while (0)
#define PG8_WAIT_V(n) asm volatile("s_waitcnt vmcnt(" #n ")" ::: "memory")
#define PG8_WAIT_L(n) asm volatile("s_waitcnt lgkmcnt(" #n ")" ::: "memory")
#define PG8_BAR __builtin_amdgcn_s_barrier()
#define PG8_SCHED __builtin_amdgcn_sched_barrier(0)
    Unit cur, nxt; int ui = 0;
    if (!S.next(0, cur)) return;
    f32x4 acc[2][2][4][2];
#pragma unroll
    for (int a = 0; a < 2; ++a)
#pragma unroll
        for (int b = 0; b < 2; ++b)
#pragma unroll
            for (int m = 0; m < 4; ++m)
#pragma unroll
                for (int n = 0; n < 2; ++n) acc[a][b][m][n] = (f32x4){0.f, 0.f, 0.f, 0.f};
    bf16x8 At[4][2], B0[2][2], B1[2][2];
    unsigned vA0[2], vA1[2], nA0[2], nA1[2];
    unsigned uA, uB = S.b_off(cur, tstep);
    if constexpr (GATHER) { uA = 0u;
#pragma unroll
        for (int i = 0; i < 2; ++i) { vA0[i] = tabA[cur.aux * 256 + sR[i]] + (unsigned)sC[i] * 2u; vA1[i] = tabA[cur.aux * 256 + 128 + sR[i]] + (unsigned)sC[i] * 2u; }
    } else { uA = (unsigned)cur.pm * tstep;
#pragma unroll
        for (int i = 0; i < 2; ++i) { vA0[i] = (unsigned)(sR[i] * K + sC[i]) * 2u; vA1[i] = vA0[i] + hstep; }
    }
    PG8_STAGE(PG8_SB(0, 0), baseB, uB, voffB); PG8_STAGE(PG8_SB(0, 1), baseB, uB + hstep, voffB); PG8_STAGE(PG8_SA(0, 0), baseA, uA, vA0); PG8_STAGE(PG8_SA(0, 1), baseA, uA, vA1);
    if (wr == 1) PG8_BAR;
    PG8_WAIT_V(2); PG8_BAR;
    PG8_STAGE(PG8_SB(1, 0), baseB, uB + kstep, voffB); PG8_STAGE(PG8_SA(1, 0), baseA, uA + kstep, vA0); PG8_STAGE(PG8_SB(1, 1), baseB, uB + hstep + kstep, voffB);
    PG8_WAIT_V(6); PG8_BAR;
    for (;;) {
        const bool has_next = S.next(ui + 1, nxt);
        unsigned nuA, nuB = has_next ? S.b_off(nxt, tstep) : uB;
        if constexpr (GATHER) { nuA = 0u;
#pragma unroll
            for (int i = 0; i < 2; ++i) { if (has_next) { nA0[i] = tabA[nxt.aux * 256 + sR[i]] + (unsigned)sC[i] * 2u; nA1[i] = tabA[nxt.aux * 256 + 128 + sR[i]] + (unsigned)sC[i] * 2u; } else { nA0[i] = vA0[i]; nA1[i] = vA1[i]; } }
        } else { nuA = has_next ? (unsigned)nxt.pm * tstep : uA;
#pragma unroll
            for (int i = 0; i < 2; ++i) { nA0[i] = vA0[i]; nA1[i] = vA1[i]; }
        }
#pragma unroll 1
        for (int t = 0; t < nt; t += 2) {
            const bool last = (t == nt - 2);
            const unsigned a1 = uA + (unsigned)(t + 1) * kstep;
            const unsigned a2 = last ? nuA : uA + (unsigned)(t + 2) * kstep; const unsigned b2 = last ? nuB : uB + (unsigned)(t + 2) * kstep;
            const unsigned a3 = a2 + kstep; const unsigned b3 = b2 + kstep;
            unsigned w0[2], w1[2];
#pragma unroll
            for (int i = 0; i < 2; ++i) { w0[i] = (GATHER && last) ? nA0[i] : vA0[i]; w1[i] = (GATHER && last) ? nA1[i] : vA1[i]; }
            PG8_LDB(B0, 0, 0); PG8_LDB(B1, 0, 1); PG8_SCHED; PG8_LDA(At, 0, 0); PG8_STAGE(PG8_SA(1, 1), baseA, a1, vA1);
            PG8_WAIT_V(8); PG8_WAIT_L(0); PG8_BAR; PG8_MMA(0, 0, At, B0); PG8_MMA(0, 1, At, B1); PG8_BAR; PG8_SCHED;
            PG8_LDA(At, 0, 1); PG8_STAGE(PG8_SB(0, 0), baseB, b2, voffB); PG8_STAGE(PG8_SB(0, 1), baseB, b2 + hstep, voffB); PG8_STAGE(PG8_SA(0, 0), baseA, a2, w0);
            PG8_WAIT_V(8); PG8_WAIT_L(0); PG8_BAR; PG8_MMA(1, 0, At, B0); PG8_MMA(1, 1, At, B1); PG8_BAR; PG8_SCHED;
            PG8_LDB(B0, 1, 0); PG8_LDB(B1, 1, 1); PG8_SCHED; PG8_LDA(At, 1, 0); PG8_STAGE(PG8_SA(0, 1), baseA, a2, w1);
            PG8_WAIT_V(8); PG8_WAIT_L(0); PG8_BAR; PG8_MMA(0, 0, At, B0); PG8_MMA(0, 1, At, B1); PG8_BAR; PG8_SCHED;
            PG8_LDA(At, 1, 1); PG8_STAGE(PG8_SB(1, 0), baseB, b3, voffB); PG8_STAGE(PG8_SB(1, 1), baseB, b3 + hstep, voffB); PG8_STAGE(PG8_SA(1, 0), baseA, a3, w0);
            PG8_WAIT_V(8); PG8_WAIT_L(0); PG8_BAR; PG8_MMA(1, 0, At, B0); PG8_MMA(1, 1, At, B1); PG8_BAR; PG8_SCHED;
        }
        if constexpr (ALIGN_EPI) { if (wr == 0) PG8_BAR; }
        E(acc, cur, wr, wc, fr, fq);
        if (!has_next) break;
#pragma unroll
        for (int a = 0; a < 2; ++a)
#pragma unroll
            for (int b = 0; b < 2; ++b)
#pragma unroll
                for (int m = 0; m < 4; ++m)
#pragma unroll
                    for (int n = 0; n < 2; ++n) acc[a][b][m][n] = (f32x4){0.f, 0.f, 0.f, 0.f};
        cur = nxt; uA = nuA; uB = nuB; ++ui;
#pragma unroll
        for (int i = 0; i < 2; ++i) { vA0[i] = nA0[i]; vA1[i] = nA1[i]; }
        if constexpr (ALIGN_EPI) { if (wr == 1) PG8_BAR; }
    }
    PG8_WAIT_V(0);
    if constexpr (!ALIGN_EPI) { if (wr == 0) PG8_BAR; }
    PG8_BAR;
#undef PG8_SA
#undef PG8_SB
#undef PG8_STAGE
#undef PG8_LDA
#undef PG8_LDB
#undef PG8_MMA
#undef PG8_WAIT_V
#undef PG8_WAIT_L
#undef PG8_BAR
#undef PG8_SCHED
}

typedef int i32x8v __attribute__((ext_vector_type(8)));
typedef int i32x4v __attribute__((ext_vector_type(4)));
template <class Epi, class Sched, bool ALIGN_EPI, bool GATHER>
__device__ __forceinline__ void gemm_phase8(PG8_LAS unsigned char* lds, const Gemm g, const Sched& S, const Epi& E, const PG8_LAS unsigned* tabA) {
    const int tid = tid_fresh(), wid = __builtin_amdgcn_readfirstlane(tid >> 6), lane = tid & 63, wr = wid >> 2, wc = wid & 3, fr = lane & 15, fq = lane >> 4;
    const int K = g.K, nt = K / BK;
    int sR[2], sC[2];
    unsigned voffB[2];
#pragma unroll
    for (int i = 0; i < 2; ++i) { int R, C; stage_rc(tid * 16 + i * 8192, R, C); sR[i] = R; sC[i] = C; const int Rb = Epi::PERM ? ((R & ~31) + perm32(R & 31)) : R;
        voffB[i] = (unsigned)(Rb * K + C) * 2u; }
    const unsigned kstep = (unsigned)(BK * 2);
    const unsigned hstep = (unsigned)(HALF * K * 2);
    const unsigned tstep = 2u * hstep;
    const unsigned ldsw = (unsigned)wid * 1024u;
    const char* const baseA = (const char*)g.A; const char* const baseB = (const char*)g.Bt;
    const int aoff = lds_byte(wr * 64 + fr, 32 * (fq >> 1) + 16 * (fq & 1)), boff = lds_byte(wc * 32 + fr, 32 * (fq >> 1) + 16 * (fq & 1));
#define PG8_SA(b, h) (((b) * 2 + (h)) * HTB)
#define PG8_SB(b, h) ((4 + (b) * 2 + (h)) * HTB)
#define PG8_STAGE(bufoff, gbase, uoff, voff) do { _Pragma("unroll") for (int _i = 0; _i < 2; ++_i) \
        __builtin_amdgcn_global_load_lds((const unsigned*)((gbase) + (size_t)(unsigned)((uoff) + (voff)[_i])), (PG8_LAS unsigned*)(lds + (bufoff) + ldsw + _i * 8192), 16, 0, 0); } while (0)
#define PG8_LD32(p) __builtin_shufflevector(*(const PG8_LAS i32x4v*)(p), *(const PG8_LAS i32x4v*)((p) + 16), 0, 1, 2, 3, 4, 5, 6, 7)
#define PG8_LDA(dst, b, h) do { _Pragma("unroll") for (int m = 0; m < 4; ++m) dst[m] = PG8_LD32(lds + PG8_SA(b, h) + aoff + m * 2048); } while (0)
#define PG8_LDB(dst, b, h) do { _Pragma("unroll") for (int n = 0; n < 2; ++n) dst[n] = PG8_LD32(lds + PG8_SB(b, h) + boff + n * 2048); } while (0)
#define PG8_MMA(ai, bj, At, Bt) do { __builtin_amdgcn_s_setprio(1); _Pragma("unroll") for (int m = 0; m < 4; ++m) _Pragma("unroll") for (int n = 0; n < 2; ++n) \
        asm volatile("v_mfma_scale_f32_16x16x128_f8f6f4 %0, %1, %2, %0, %3, %4 op_sel_hi:[0,0,0]" : "+v"(acc[ai][bj][m][n]) : "v"(Bt[n]), "v"(At[m]), "v"(scw), "v"(sca)); __builtin_amdgcn_s_setprio(0); } while (0)
#define PG8_MFMA_DRAIN asm volatile("s_nop 15\n\ts_nop 15\n\ts_nop 15" ::: "memory")
#define PG8_WAIT_V(n) asm volatile("s_waitcnt vmcnt(" #n ")" ::: "memory")
#define PG8_WAIT_L(n) asm volatile("s_waitcnt lgkmcnt(" #n ")" ::: "memory")
#define PG8_BAR __builtin_amdgcn_s_barrier()
#define PG8_SCHED __builtin_amdgcn_sched_barrier(0)
    Unit cur, nxt; int ui = 0;
    if (!S.next(0, cur)) return;
    f32x4 acc[2][2][4][2];
#pragma unroll
    for (int a = 0; a < 2; ++a)
#pragma unroll
        for (int b = 0; b < 2; ++b)
#pragma unroll
            for (int m = 0; m < 4; ++m)
#pragma unroll
                for (int n = 0; n < 2; ++n) acc[a][b][m][n] = (f32x4){0.f, 0.f, 0.f, 0.f};
    i32x8v At[4], B0[2], B1[2];
    int scw = 0x7a7a7a7a, sca = 0x7f7f7f7f;
    asm volatile("" : "+v"(scw), "+v"(sca));
    unsigned vA0[2], vA1[2], nA0[2], nA1[2];
    unsigned uA, uB = S.b_off(cur, tstep);
    if constexpr (GATHER) { uA = 0u;
#pragma unroll
        for (int i = 0; i < 2; ++i) { vA0[i] = tabA[cur.aux * 256 + sR[i]] + (unsigned)sC[i] * 2u; vA1[i] = tabA[cur.aux * 256 + 128 + sR[i]] + (unsigned)sC[i] * 2u; }
    } else { uA = (unsigned)cur.pm * tstep;
#pragma unroll
        for (int i = 0; i < 2; ++i) { vA0[i] = (unsigned)(sR[i] * K + sC[i]) * 2u; vA1[i] = vA0[i] + hstep; }
    }
    PG8_STAGE(PG8_SB(0, 0), baseB, uB, voffB); PG8_STAGE(PG8_SB(0, 1), baseB, uB + hstep, voffB); PG8_STAGE(PG8_SA(0, 0), baseA, uA, vA0); PG8_STAGE(PG8_SA(0, 1), baseA, uA, vA1);
    if (wr == 1) PG8_BAR;
    PG8_WAIT_V(2); PG8_BAR;
    PG8_STAGE(PG8_SB(1, 0), baseB, uB + kstep, voffB); PG8_STAGE(PG8_SA(1, 0), baseA, uA + kstep, vA0); PG8_STAGE(PG8_SB(1, 1), baseB, uB + hstep + kstep, voffB);
    PG8_WAIT_V(6); PG8_BAR;
    for (;;) {
        const bool has_next = S.next(ui + 1, nxt);
        unsigned nuA, nuB = has_next ? S.b_off(nxt, tstep) : uB;
        if constexpr (GATHER) { nuA = 0u;
#pragma unroll
            for (int i = 0; i < 2; ++i) { if (has_next) { nA0[i] = tabA[nxt.aux * 256 + sR[i]] + (unsigned)sC[i] * 2u; nA1[i] = tabA[nxt.aux * 256 + 128 + sR[i]] + (unsigned)sC[i] * 2u; } else { nA0[i] = vA0[i]; nA1[i] = vA1[i]; } }
        } else { nuA = has_next ? (unsigned)nxt.pm * tstep : uA;
#pragma unroll
            for (int i = 0; i < 2; ++i) { nA0[i] = vA0[i]; nA1[i] = vA1[i]; }
        }
#pragma unroll 1
        for (int t = 0; t < nt; t += 2) {
            const bool last = (t == nt - 2);
            const unsigned a1 = uA + (unsigned)(t + 1) * kstep;
            const unsigned a2 = last ? nuA : uA + (unsigned)(t + 2) * kstep; const unsigned b2 = last ? nuB : uB + (unsigned)(t + 2) * kstep;
            const unsigned a3 = a2 + kstep; const unsigned b3 = b2 + kstep;
            unsigned w0[2], w1[2];
#pragma unroll
            for (int i = 0; i < 2; ++i) { w0[i] = (GATHER && last) ? nA0[i] : vA0[i]; w1[i] = (GATHER && last) ? nA1[i] : vA1[i]; }
            PG8_LDB(B0, 0, 0); PG8_LDB(B1, 0, 1); PG8_SCHED; PG8_LDA(At, 0, 0); PG8_STAGE(PG8_SA(1, 1), baseA, a1, vA1);
            PG8_WAIT_V(8); PG8_WAIT_L(0); PG8_BAR; PG8_MMA(0, 0, At, B0); PG8_MMA(0, 1, At, B1); PG8_BAR; PG8_SCHED;
            PG8_LDA(At, 0, 1); PG8_STAGE(PG8_SB(0, 0), baseB, b2, voffB); PG8_STAGE(PG8_SB(0, 1), baseB, b2 + hstep, voffB); PG8_STAGE(PG8_SA(0, 0), baseA, a2, w0);
            PG8_WAIT_V(8); PG8_WAIT_L(0); PG8_BAR; PG8_MMA(1, 0, At, B0); PG8_MMA(1, 1, At, B1); PG8_BAR; PG8_SCHED;
            PG8_LDB(B0, 1, 0); PG8_LDB(B1, 1, 1); PG8_SCHED; PG8_LDA(At, 1, 0); PG8_STAGE(PG8_SA(0, 1), baseA, a2, w1);
            PG8_WAIT_V(8); PG8_WAIT_L(0); PG8_BAR; PG8_MMA(0, 0, At, B0); PG8_MMA(0, 1, At, B1); PG8_BAR; PG8_SCHED;
            PG8_LDA(At, 1, 1); PG8_STAGE(PG8_SB(1, 0), baseB, b3, voffB); PG8_STAGE(PG8_SB(1, 1), baseB, b3 + hstep, voffB); PG8_STAGE(PG8_SA(1, 0), baseA, a3, w0);
            PG8_WAIT_V(8); PG8_WAIT_L(0); PG8_BAR; PG8_MMA(1, 0, At, B0); PG8_MMA(1, 1, At, B1); PG8_BAR; PG8_SCHED;
        }
        if constexpr (ALIGN_EPI) { if (wr == 0) PG8_BAR; }
        PG8_MFMA_DRAIN;
        { const int l2 = tid_fresh() & 63; E(acc, cur, wr, wc, l2 & 15, l2 >> 4); }
        if (!has_next) break;
#pragma unroll
        for (int a = 0; a < 2; ++a)
#pragma unroll
            for (int b = 0; b < 2; ++b)
#pragma unroll
                for (int m = 0; m < 4; ++m)
#pragma unroll
                    for (int n = 0; n < 2; ++n) acc[a][b][m][n] = (f32x4){0.f, 0.f, 0.f, 0.f};
        cur = nxt; uA = nuA; uB = nuB; ++ui;
#pragma unroll
        for (int i = 0; i < 2; ++i) { vA0[i] = nA0[i]; vA1[i] = nA1[i]; }
        if constexpr (ALIGN_EPI) { if (wr == 1) PG8_BAR; }
    }
    PG8_WAIT_V(0);
    if constexpr (!ALIGN_EPI) { if (wr == 0) PG8_BAR; }
    PG8_BAR;
#undef PG8_SA
#undef PG8_SB
#undef PG8_STAGE
#undef PG8_LDA
#undef PG8_LD32
#undef PG8_LDB
#undef PG8_MMA
#undef PG8_MFMA_DRAIN
#undef PG8_WAIT_V
#undef PG8_WAIT_L
#undef PG8_BAR
#undef PG8_SCHED
}

__device__ __forceinline__ unsigned cvt_pk_bf16(float lo, float hi) { return pk2(lo, hi); }

struct EpiBf16 {
    static constexpr bool PERM = true;
    bf16* O; int ldc;
    __device__ __forceinline__ void operator()(const f32x4 (&acc)[2][2][4][2], const Unit& u, int wr, int wc, int fr, int fq) const {
        const int row0 = u.pm * BM + wr * 64 + fr; const int col0 = u.pn * BM + wc * 32 + 8 * fq;
#pragma unroll
        for (int ai = 0; ai < 2; ++ai)
#pragma unroll
            for (int m = 0; m < 4; ++m) { bf16* rowp = O + (size_t)(row0 + ai * HALF + m * 16) * ldc + col0;
#pragma unroll
                for (int bj = 0; bj < 2; ++bj) { const f32x4 v0 = acc[ai][bj][m][0], v1 = acc[ai][bj][m][1];
                    u32x4 w; w.x = cvt_pk_bf16(v0[0], v0[1]); w.y = cvt_pk_bf16(v0[2], v0[3]); w.z = cvt_pk_bf16(v1[0], v1[1]); w.w = cvt_pk_bf16(v1[2], v1[3]);
                    *(u32x4*)(rowp + bj * HALF) = w; } }
    }
};
struct EpiResid {
    static constexpr bool PERM = false;
    const float* xl; const float* xc; float* out; const float* gate;
    __device__ __forceinline__ void operator()(const f32x4 (&acc)[2][2][4][2], const Unit& u, int wr, int wc, int fr, int fq) const {
        const int rt = u.pm * BM; const bool isl = rt < NLAT;
        const float* base = isl ? xl + (size_t)rt * D : xc + (size_t)(rt - NLAT) * D;
        const float* gp = gate + (size_t)(isl ? (rt >> 12) : 8) * 12288;
        const int rl0 = wr * 64 + fr, col0 = u.pn * BM + wc * 32 + 4 * fq;
#pragma unroll
        for (int ai = 0; ai < 2; ++ai)
#pragma unroll
            for (int m = 0; m < 4; ++m) { const int rl = rl0 + ai * HALF + m * 16; const float* bp = base + (size_t)rl * D + col0; float* op = out + (size_t)(rt + rl) * D + col0;
#pragma unroll
                for (int bj = 0; bj < 2; ++bj)
#pragma unroll
                    for (int n = 0; n < 2; ++n) { const f32x4 b = *(const f32x4*)(bp + bj * HALF + n * 16); const f32x4 gv = *(const f32x4*)(gp + col0 + bj * HALF + n * 16); *(f32x4*)(op + bj * HALF + n * 16) = b + gv * acc[ai][bj][m][n]; }
                asm volatile("" ::: "memory"); }
    }
};
struct EpiSwiglu {
    static constexpr bool PERM = true;
    unsigned char* O;
    __device__ __forceinline__ void operator()(const f32x4 (&acc)[2][2][4][2], const Unit& u, int wr, int wc, int fr, int fq) const {
        const int row0 = u.pm * BM + wr * 64 + fr; const int col0 = u.pn * 128 + wc * 32 + 8 * fq;
#pragma unroll
        for (int ai = 0; ai < 2; ++ai)
#pragma unroll
            for (int m = 0; m < 4; ++m) { unsigned char* rowp = O + (size_t)(row0 + ai * HALF + m * 16) * DE + col0;
                float o[8];
#pragma unroll
                for (int n = 0; n < 2; ++n)
#pragma unroll
                    for (int j = 0; j < 4; ++j) { const float gt = acc[ai][0][m][n][j], up = acc[ai][1][m][n][j]; o[n * 4 + j] = gt * __builtin_amdgcn_rcpf(1.0f + __expf(-gt)) * up; }
                u32x2 w; w.x = pk4_fp8(o[0], o[1], o[2], o[3]); w.y = pk4_fp8(o[4], o[5], o[6], o[7]);
                *(u32x2*)rowp = w; }
    }
};
struct EpiDown {
    static constexpr bool PERM = true;
    bf16* YK; const PG8_LAS unsigned* tab; const PG8_LAS float* tabw;
    __device__ __forceinline__ void operator()(const f32x4 (&acc)[2][2][4][2], const Unit& u, int wr, int wc, int fr, int fq) const {
        const int rl0 = wr * 64 + fr; const int col0 = u.pn * BM + wc * 32 + 8 * fq;
#pragma unroll
        for (int ai = 0; ai < 2; ++ai)
#pragma unroll
            for (int m = 0; m < 4; ++m) { const int rl = rl0 + ai * HALF + m * 16; const unsigned ent = tab[u.aux * 256 + rl]; const float w = tabw[u.aux * 256 + rl];
                if (!(ent & 0x40000000u)) { bf16* rowp = YK + ((size_t)(ent >> 31) * MALL + (ent & 0xffffu)) * D + col0;
#pragma unroll
                    for (int bj = 0; bj < 2; ++bj) { const f32x4 v0 = acc[ai][bj][m][0] * w, v1 = acc[ai][bj][m][1] * w;
                        u32x4 q; q.x = cvt_pk_bf16(v0[0], v0[1]); q.y = cvt_pk_bf16(v0[2], v0[3]); q.z = cvt_pk_bf16(v1[0], v1[1]); q.w = cvt_pk_bf16(v1[2], v1[3]);
                        *(u32x4*)(rowp + bj * HALF) = q; } }
                asm volatile("" ::: "memory"); }
    }
};
}

struct Args { const float* in[31]; float* out; unsigned char* ws; int ph_lo, ph_hi; };
typedef const __attribute__((address_space(4))) Args* KArgs;
__device__ __forceinline__ KArgs kargs() { KArgs p = (KArgs)__builtin_amdgcn_kernarg_segment_ptr(); asm volatile("" : "+s"(p)); return p; }
#define AIN(i) (a->in[i])
enum { I_X = 0, I_C, I_CTX, I_CCTX, I_ADAW, I_ADAB, I_N1G, I_N2G, I_WIN, I_WOUT, I_GNG, I_GWS, I_GB, I_LB, I_HNG, I_MU, I_W0, I_WUP, I_A0, I_AUP, I_GUP, I_KK, I_KA, I_RK, I_GNGG, I_GNB, I_RW, I_RB, I_WGU, I_WDN, I_FNG };

__device__ __forceinline__ void p0_transpose_item(const float* W, int K, int N, bf16* WT, int n_row0, LAS float* scr, int kb, int nb, int lane) {
    const int k0 = 64 * kb, n0 = 32 * nb;
#pragma unroll 8
    for (int i = 0; i < 32; ++i) { const int kk = 2 * i + (lane >> 5); scr[kk * 33 + (lane & 31)] = W[(size_t)(k0 + kk) * N + n0 + (lane & 31)]; }
    asm volatile("s_waitcnt lgkmcnt(0)" ::: "memory");
    const int c = lane & 7;
#pragma unroll
    for (int j = 0; j < 4; ++j) { const int n = (lane >> 3) + 8 * j; const LAS float* s = scr + (8 * c) * 33 + n;
        u32x4 o; o.x = pk2(s[0 * 33], s[1 * 33]); o.y = pk2(s[2 * 33], s[3 * 33]); o.z = pk2(s[4 * 33], s[5 * 33]); o.w = pk2(s[6 * 33], s[7 * 33]);
        *(u32x4*)(WT + (size_t)(n_row0 + n) * K + k0 + 8 * c) = o; }
    asm volatile("s_waitcnt lgkmcnt(0)" ::: "memory");
}

__device__ __forceinline__ void p0_transpose_item8(const float* W, int K, int N, unsigned char* WT, int n_row0, LAS float* scr, int kb, int nb, int lane) {
    const int k0 = 64 * kb, n0 = 32 * nb;
#pragma unroll 8
    for (int i = 0; i < 32; ++i) { const int kk = 2 * i + (lane >> 5); scr[kk * 33 + (lane & 31)] = W[(size_t)(k0 + kk) * N + n0 + (lane & 31)]; }
    asm volatile("s_waitcnt lgkmcnt(0)" ::: "memory");
    const int c = lane & 7;
#pragma unroll
    for (int j = 0; j < 4; ++j) { const int n = (lane >> 3) + 8 * j; const LAS float* sp = scr + (8 * c) * 33 + n;
        u32x2 o; o.x = pk4_fp8(sp[0 * 33] * 32.f, sp[1 * 33] * 32.f, sp[2 * 33] * 32.f, sp[3 * 33] * 32.f); o.y = pk4_fp8(sp[4 * 33] * 32.f, sp[5 * 33] * 32.f, sp[6 * 33] * 32.f, sp[7 * 33] * 32.f);
        *(u32x2*)(WT + (size_t)(n_row0 + n) * K + k0 + 8 * c) = o; }
    asm volatile("s_waitcnt lgkmcnt(0)" ::: "memory");
}
__device__ __forceinline__ void convert_moe(KArgs a, int l, LAS unsigned char* lds) {
    const int tid = tid_fresh(), lane = tid & 63, wave = tid >> 6;
    const int gw = blockIdx.x * 8 + wave, NGW = gridDim.x * 8;
    unsigned char* ws = a->ws;
    LAS float* scr = (LAS float*)(lds + wave * 16384);
    constexpr int I_GU = 32 * 64, I_DN = 16 * 64, N2 = 16 * I_GU, N3 = N2 + 16 * I_DN;
    for (int it = gw; it < N3; it += NGW) {
        if (it < N2) { const int e = it / I_GU, r = it % I_GU, kb = r / 64, nb = r % 64;
            const int n0 = 32 * nb, hh = n0 >> 10, nn = n0 & 1023, row0 = 256 * (nn >> 7) + 128 * hh + (nn & 127);
            p0_transpose_item8(a->in[I_WGU] + (size_t)(l * NE + e) * D * 2048, D, 2048, ws + WS_WGU + (size_t)e * 2048 * D, row0, scr, kb, nb, lane); }
        else { const int q = it - N2, e = q / I_DN, r = q % I_DN, kb = r / 64, nb = r % 64;
            p0_transpose_item8(a->in[I_WDN] + (size_t)(l * NE + e) * DE * D, DE, D, ws + WS_WDN + (size_t)e * D * DE, 32 * nb, scr, kb, nb, lane); }
    }
}
__device__ __forceinline__ void phase_prologue(KArgs a, LAS unsigned char* lds) {
    const int tid = tid_fresh(), lane = tid & 63, wave = tid >> 6;
    const int G = gridDim.x, gw = blockIdx.x * 8 + wave, NGW = G * 8;
    unsigned char* ws = a->ws;
    LAS float* scr = (LAS float*)(lds + wave * 16384);
    constexpr int I_IN = 32 * 232, I_OUT = 32 * 64;
    constexpr int N0 = 2 * I_IN, N1 = N0 + 2 * I_OUT;
    for (int it = gw; it < N1; it += NGW) {
        if (it < N0) { const int l = it / I_IN, r = it % I_IN, kb = r / 232, nb = r % 232;
            p0_transpose_item8(a->in[I_WIN] + (size_t)l * D * INC, D, INC, ws + WS_WIN + (size_t)l * INC * D, 32 * nb, scr, kb, nb, lane); }
        else { const int q = it - N0, l = q / I_OUT, r = q % I_OUT, kb = r / 64, nb = r % 64;
            p0_transpose_item8(a->in[I_WOUT] + (size_t)l * D * D, D, D, ws + WS_WOUT + (size_t)l * D * D, 32 * nb, scr, kb, nb, lane); }
    }
    convert_moe(a, 0, lds);
    {
        const int gt = blockIdx.x * NTHREADS + tid, NGT = G * NTHREADS;
        bf16* wup = (bf16*)(ws + WS_SMALLW + SW_WUP); bf16* aup = (bf16*)(ws + WS_SMALLW + SW_AUP); bf16* gup = (bf16*)(ws + WS_SMALLW + SW_GUP); bf16* gws = (bf16*)(ws + WS_SMALLW + SW_GWS);
        for (int i = gt; i < 2 * 2 * 768 * 64; i += NGT) { const int k = i & 63, n = (i >> 6) % 768, ld = i / (768 * 64); wup[i] = (bf16)f2bf(a->in[I_WUP][((size_t)ld * 64 + k) * 768 + n]); }
        for (int i = gt; i < 2 * 768 * 64; i += NGT) { const int k = i & 63, n = (i >> 6) % 768, l = i / (768 * 64); aup[i] = (bf16)f2bf(a->in[I_AUP][((size_t)l * 64 + k) * 768 + n]); }
        for (int i = gt; i < 2 * 768 * 128; i += NGT) { const int k = i & 127, n = (i >> 7) % 768, l = i / (768 * 128); gup[i] = (bf16)f2bf(a->in[I_GUP][((size_t)l * 128 + k) * 768 + n]); }
        for (int i = gt; i < 2 * 4 * 128 * 128; i += NGT) gws[i] = (bf16)f2bf(a->in[I_GWS][i]);
    }
    __syncthreads();
    {
        LAS float* sv = (LAS float*)lds;
        LAS float* red = (LAS float*)(lds + 73728);
        for (int i = tid; i < 9 * D; i += NTHREADS) { const int r = i / D, k = i % D; const float v = r < 8 ? a->in[I_C][r * D + k] : a->in[I_CCTX][k]; sv[i] = siluf_(v); }
        __syncthreads();
        float* mod = (float*)(ws + WS_MOD);
        for (int it = blockIdx.x; it < 2 * 96; it += G) {
            const int l = it / 96, cb = it % 96, cq = tid & 31, kg = tid >> 5;
            const float* wp = a->in[I_ADAW] + (size_t)l * D * 12288 + (size_t)(kg * 128) * 12288 + cb * 128 + cq * 4;
            f32x4 acc[9];
#pragma unroll
            for (int r = 0; r < 9; ++r) acc[r] = (f32x4){0.f, 0.f, 0.f, 0.f};
#pragma unroll 4
            for (int k = 0; k < 128; ++k) { const f32x4 w = *(const f32x4*)(wp + (size_t)k * 12288);
#pragma unroll
                for (int r = 0; r < 9; ++r) acc[r] += w * sv[r * D + kg * 128 + k]; }
#pragma unroll
            for (int r = 0; r < 9; ++r) *(LAS f32x4*)(red + ((kg * 9 + r) * 128 + cq * 4)) = acc[r];
            __syncthreads();
            for (int o = tid; o < 9 * 128; o += NTHREADS) { const int r = o / 128, c = o % 128; float s = a->in[I_ADAB][(size_t)l * 12288 + cb * 128 + c];
#pragma unroll
                for (int q = 0; q < 16; ++q) s += red[(q * 9 + r) * 128 + c];
                mod[((size_t)l * 9 + r) * 12288 + cb * 128 + c] = s; }
            __syncthreads();
        }
    }
}

template <int MODE>
__device__ __forceinline__ void phase_norm1(KArgs a, int l, bool dry) {
    const int tid_ = tid_fresh(); const int lane = tid_ & 63, wave = tid_ >> 6, gw = blockIdx.x * 8 + wave, NGW = gridDim.x * 8;
    unsigned char* ws = a->ws;
    const float* mod = (const float*)(ws + WS_MOD);
    float* X = (float*)(ws + WS_X); bf16* H = (bf16*)(ws + WS_H); const bf16* YK = (const bf16*)(ws + WS_YK);
    float* Xo = dry ? (float*)(ws + WS_END) : X; bf16* Ho = dry ? (bf16*)(ws + WS_END) : H; float* Oo = dry ? (float*)(ws + WS_END) : a->out;
    const int nrows = (MODE == 2) ? NLAT : MALL;
    const int rpw = (nrows + NGW - 1) / NGW; const int r0 = gw * rpw, r1 = (r0 + rpw < nrows) ? r0 + rpw : nrows;
    f32x4 ck[8], cs[8], cg[8]; int cur_mr = -1;
    for (int row = r0; row < r1; ++row) {
        const int mr = modrow_of(row); const int orow = dry ? (row & 2047) : row;
        if (mr != cur_mr) { cur_mr = mr;
#pragma unroll
            for (int j = 0; j < 8; ++j) { const int c = 4 * lane + 256 * j;
                if (MODE == 2) ck[j] = *(const f32x4*)(a->in[I_FNG] + c);
                else { const float* m = mod + ((size_t)l * 9 + mr) * 12288; const f32x4 g = *(const f32x4*)(a->in[I_N1G] + (size_t)l * D + c); ck[j] = g * (*(const f32x4*)(m + D + c) + 1.0f); cs[j] = *(const f32x4*)(m + c); }
                if (MODE != 0) cg[j] = *(const f32x4*)(mod + ((size_t)(l - 1) * 9 + mr) * 12288 + 5 * D + c); } }
        f32x4 v[8];
        if (MODE == 0) { const float* xr = row < NLAT ? a->in[I_X] + (size_t)row * D : a->in[I_CTX] + (size_t)(row - NLAT) * D;
#pragma unroll
            for (int j = 0; j < 8; ++j) v[j] = *(const f32x4*)(xr + 4 * lane + 256 * j);
        } else {
            const float* xr = X + (size_t)row * D; const bf16* y0 = YK + (size_t)row * D; const bf16* y1 = YK + ((size_t)MALL + row) * D;
            u32x2 p0[8], p1[8];
#pragma unroll
            for (int j = 0; j < 8; ++j) { const int c = 4 * lane + 256 * j; v[j] = *(const f32x4*)(xr + c); p0[j] = *(const u32x2*)(y0 + c); p1[j] = *(const u32x2*)(y1 + c); }
#pragma unroll
            for (int j = 0; j < 8; ++j) { f32x4 f; f[0] = bflo(p0[j].x) + bflo(p1[j].x); f[1] = bfhi(p0[j].x) + bfhi(p1[j].x); f[2] = bflo(p0[j].y) + bflo(p1[j].y); f[3] = bfhi(p0[j].y) + bfhi(p1[j].y);
                v[j] = v[j] + cg[j] * f; }
            if (MODE == 1) {
#pragma unroll
                for (int j = 0; j < 8; ++j) *(f32x4*)(Xo + (size_t)orow * D + 4 * lane + 256 * j) = v[j];
            }
        }
        float ss = 0.f;
#pragma unroll
        for (int j = 0; j < 8; ++j) ss += (v[j][0] * v[j][0] + v[j][1] * v[j][1]) + (v[j][2] * v[j][2] + v[j][3] * v[j][3]);
        const float rstd = 1.0f / sqrtf(wave_sum(ss) * (1.0f / D) + NORM_EPS);
        if (MODE == 2) {
#pragma unroll
            for (int j = 0; j < 8; ++j) *(f32x4*)(Oo + (size_t)orow * D + 4 * lane + 256 * j) = v[j] * rstd * ck[j];
        } else {
#pragma unroll
            for (int j = 0; j < 8; ++j) { const f32x4 h = v[j] * rstd * ck[j] + cs[j]; *(unsigned*)((unsigned char*)Ho + (size_t)orow * D + 4 * lane + 256 * j) = pk4_fp8(h[0], h[1], h[2], h[3]); }
        }
    }
}

__device__ __forceinline__ void phase_norm2_router(KArgs a, int l, bool dry, LAS unsigned char* lds) {
    const int tid_ = tid_fresh(); const int lane = tid_ & 63, wave = tid_ >> 6, gw = blockIdx.x * 8 + wave, NGW = gridDim.x * 8;
    unsigned char* ws = a->ws;
    const float* mod = (const float*)(ws + WS_MOD);
    const float* X = (const float*)(ws + WS_X); bf16* H = (bf16*)(ws + WS_H);
    unsigned* cnt = (unsigned*)(ws + WS_CTL) + CW_CNT + l * 16 * 64 + (dry ? 4096 : 0);
    unsigned* ridx = (unsigned*)(ws + (dry ? WS_END : WS_RIDX)); float* rwt = (float*)(ws + (dry ? WS_END + 4 * MiB : WS_RW)); bf16* Ho = dry ? (bf16*)(ws + WS_END + 8 * MiB) : H;
    const int nrows = (l == DEPTH - 1) ? NLAT : MALL;
    LAS f32x4* rwl = (LAS f32x4*)lds;
    { const float* rw = a->in[I_RW];
      for (int idx = tid_; idx < 8192; idx += NTHREADS) { const int ln = idx & 63, q = (idx >> 6) & 3, i = (idx >> 8) & 3, j = idx >> 10; rwl[idx] = *(const f32x4*)(rw + (size_t)(4 * ln + 256 * j + i) * 16 + 4 * q); } }
    __syncthreads();
    const int rpw = (nrows + NGW - 1) / NGW; const int r0 = gw * rpw, r1 = (r0 + rpw < nrows) ? r0 + rpw : nrows;
    f32x4 ck[8]; int cur_mr = -1;
    const float* rbp = a->in[I_RB];
    for (int row = r0; row < r1; ++row) {
        const int mr = modrow_of(row); const int orow = dry ? (row & 2047) : row;
        if (mr != cur_mr) { cur_mr = mr; const float* m = mod + ((size_t)l * 9 + mr) * 12288;
#pragma unroll
            for (int j = 0; j < 8; ++j) { const int c = 4 * lane + 256 * j; const f32x4 g = *(const f32x4*)(a->in[I_N2G] + (size_t)l * D + c); ck[j] = g * (*(const f32x4*)(m + 4 * D + c) + 1.0f); } }
        const float* shp = mod + ((size_t)l * 9 + mr) * 12288 + 3 * D;
        const float* xr = X + (size_t)row * D;
        f32x4 v[8]; float ss = 0.f;
#pragma unroll
        for (int j = 0; j < 8; ++j) { v[j] = *(const f32x4*)(xr + 4 * lane + 256 * j); ss += (v[j][0] * v[j][0] + v[j][1] * v[j][1]) + (v[j][2] * v[j][2] + v[j][3] * v[j][3]); }
        const float rstd = 1.0f / sqrtf(wave_sum(ss) * (1.0f / D) + NORM_EPS);
        f32x4 lg4[4];
#pragma unroll
        for (int q = 0; q < 4; ++q) lg4[q] = (f32x4){0.f, 0.f, 0.f, 0.f};
#pragma unroll
        for (int j = 0; j < 8; ++j) { const f32x4 h = v[j] * rstd * ck[j] + *(const f32x4*)(shp + 4 * lane + 256 * j); *(unsigned*)((unsigned char*)Ho + (size_t)orow * D + 4 * lane + 256 * j) = pk4_fp8(h[0], h[1], h[2], h[3]);
#pragma unroll
            for (int i = 0; i < 4; ++i)
#pragma unroll
                for (int q = 0; q < 4; ++q) lg4[q] += rwl[((j * 4 + i) * 4 + q) * 64 + lane] * h[i];
            asm volatile("" ::: "memory"); }
        float lg[16];
        { float t8[8], t4[4], t2[2], t1;
          const bool b5 = lane & 32, b4 = lane & 16, b3 = lane & 8, b2 = lane & 4;
#pragma unroll
          for (int i = 0; i < 8; ++i) { const float keep = b5 ? lg4[(i + 8) >> 2][(i + 8) & 3] : lg4[i >> 2][i & 3], send = b5 ? lg4[i >> 2][i & 3] : lg4[(i + 8) >> 2][(i + 8) & 3]; t8[i] = keep + __shfl_xor(send, 32); }
#pragma unroll
          for (int i = 0; i < 4; ++i) { const float keep = b4 ? t8[i + 4] : t8[i], send = b4 ? t8[i] : t8[i + 4]; t4[i] = keep + __shfl_xor(send, 16); }
#pragma unroll
          for (int i = 0; i < 2; ++i) { const float keep = b3 ? t4[i + 2] : t4[i], send = b3 ? t4[i] : t4[i + 2]; t2[i] = keep + __shfl_xor(send, 8); }
          { const float keep = b2 ? t2[1] : t2[0], send = b2 ? t2[0] : t2[1]; t1 = keep + __shfl_xor(send, 4); }
          t1 += __shfl_xor(t1, 2); t1 += __shfl_xor(t1, 1);
#pragma unroll
          for (int e = 0; e < 16; ++e) { const int src = ((e >> 3) & 1) * 32 + ((e >> 2) & 1) * 16 + ((e >> 1) & 1) * 8 + (e & 1) * 4; lg[e] = __builtin_bit_cast(float, __builtin_amdgcn_readlane(__builtin_bit_cast(int, t1), src)) + rbp[e]; } }
        float mx = lg[0];
#pragma unroll
        for (int e = 1; e < 16; ++e) mx = fmaxf(mx, lg[e]);
        float p[16], sum = 0.f;
#pragma unroll
        for (int e = 0; e < 16; ++e) { p[e] = __expf(lg[e] - mx); sum += p[e]; }
        const float inv = 1.0f / sum;
#pragma unroll
        for (int e = 0; e < 16; ++e) p[e] *= inv;
        int sel = 0; float best = -1.f;
#pragma unroll
        for (int gI = 0; gI < 4; ++gI) { float m1 = -1.f, m2 = -1.f;
#pragma unroll
            for (int i = 0; i < 4; ++i) { const float q = p[4 * gI + i]; if (q > m1) { m2 = m1; m1 = q; } else if (q > m2) m2 = q; }
            const float s = m1 + m2; if (s > best) { best = s; sel = gI; } }
        int i1 = 0, i2 = 0; float p1 = -2.f, p2 = -2.f;
#pragma unroll
        for (int gI = 0; gI < 4; ++gI)
#pragma unroll
            for (int i = 0; i < 4; ++i) { const float q = (gI == sel) ? p[4 * gI + i] : -1.0f; const int e = 4 * gI + i;
                if (gI == sel) { if (q > p1) { p2 = p1; i2 = i1; p1 = q; i1 = e; } else if (q > p2) { p2 = q; i2 = e; } } }
        const float wsum = p1 + p2, w1 = p1 / wsum, w2 = p2 / wsum;
        if (lane == 0) {
            const unsigned q1 = atomicAdd(cnt + i1 * 64, 1u); ridx[(size_t)i1 * MALL + q1] = (unsigned)row; rwt[(size_t)i1 * MALL + q1] = w1;
            const unsigned q2 = atomicAdd(cnt + i2 * 64, 1u); ridx[(size_t)i2 * MALL + q2] = (unsigned)row | 0x80000000u; rwt[(size_t)i2 * MALL + q2] = w2;
        }
    }
    __syncthreads();
}

template <bool FOR_DOWN>
__device__ __forceinline__ void moe_tables(KArgs a, int l, LAS unsigned char* lds, int cvirt) {
    const int tid = tid_fresh(), G = gridDim.x;
    unsigned char* ws = a->ws;
    const unsigned* cnt = (const unsigned*)(ws + WS_CTL) + CW_CNT + l * 16 * 64;
    const unsigned* ridx = (const unsigned*)(ws + WS_RIDX); const float* rwt = (const float*)(ws + WS_RW);
    LAS int* tp = (LAS int*)(lds + LDS_TP); LAS unsigned* tab = (LAS unsigned*)(lds + LDS_TAB); LAS float* tabw = (LAS float*)(lds + LDS_TABW);
    if (tid == 0) { int acc = 0; for (int e = 0; e < 16; ++e) { tp[e] = acc; acc += (int)((cnt[e * 64] + 255u) >> 8); } tp[16] = acc; }
    __syncthreads();
    const int ntot = tp[16] * 8;
    for (int i = 0; i < 9; ++i) { const int L = i * G + cvirt; if (L >= ntot) break;
        const int tile = L >> 3; int e = 0;
        for (int j = 1; j < 16; ++j) e += (tile >= tp[j]) ? 1 : 0;
        const int pos0 = (tile - tp[e]) * 256; const unsigned ce = cnt[e * 64];
        if (tid < 256) { const int pos = pos0 + tid; const bool valid = (unsigned)pos < ce; const unsigned ent = ridx[(size_t)e * MALL + (valid ? pos : 0)];
            if (FOR_DOWN) { tab[i * 256 + tid] = valid ? ent : (ent | 0x40000000u); tabw[i * 256 + tid] = valid ? rwt[(size_t)e * MALL + pos] : 0.f; }
            else tab[i * 256 + tid] = (ent & 0xffffu) * (unsigned)D; }
    }
    __syncthreads();
}

__device__ __forceinline__ void gmlp_item(KArgs a, int l, int item, LAS unsigned char* lds) {
    const int tid = tid_fresh(), lane = tid & 63, wave = tid >> 6;
    unsigned char* ws = a->ws;
    const bf16* P = (const bf16*)(ws + WS_P); bf16* Y = (bf16*)(ws + WS_Y);
    const int chunk = item >> 2, h = item & 3;
    const int row0 = chunk < 256 ? chunk * 128 : NLAT + (chunk - 256) * 128;
    LAS bf16* wsl = (LAS bf16*)lds;
    LAS bf16* vT = (LAS bf16*)(lds + 128 * 136 * 2);
    const bf16* gws = (const bf16*)(ws + WS_SMALLW + SW_GWS) + ((size_t)l * 4 + h) * 128 * 128;
    for (int p = tid; p < 2048; p += NTHREADS) { const int t = p >> 4, c8 = p & 15; *(LAS u32x4*)(wsl + t * 136 + c8 * 8) = *(const u32x4*)(gws + t * 128 + c8 * 8); }
    {
        const int s = tid >> 2, qd = tid & 3; const bf16* vp = P + (size_t)(row0 + s) * INC + OFF_V + h * 128 + qd * 32;
        float g[32]; float ss = 0.f;
#pragma unroll
        for (int q = 0; q < 4; ++q) { float f[8]; unpack8(*(const u32x4*)(vp + 8 * q), f);
#pragma unroll
            for (int j = 0; j < 8; ++j) { const float x = geluf_(f[j]); g[8 * q + j] = x; ss += x * x; } }
        ss += __shfl_xor(ss, 1); ss += __shfl_xor(ss, 2);
        const float rstd = 1.0f / sqrtf(ss * (1.0f / 128.0f) + NORM_EPS);
        const float* ng = a->in[I_GNG] + (size_t)l * 512 + h * 128 + qd * 32;
#pragma unroll
        for (int j = 0; j < 32; ++j) vT[(qd * 32 + j) * 136 + s] = (bf16)f2bf(g[j] * rstd * ng[j]);
    }
    __syncthreads();
    f32x4 acc[8];
#pragma unroll
    for (int ct = 0; ct < 8; ++ct) acc[ct] = (f32x4){0.f, 0.f, 0.f, 0.f};
    const int fr = lane & 15, fq = lane >> 4;
#pragma unroll
    for (int ks = 0; ks < 4; ++ks) {
        const bf16x8 bfrag = *(const LAS bf16x8*)(wsl + (16 * wave + fr) * 136 + ks * 32 + fq * 8);
#pragma unroll
        for (int ct = 0; ct < 8; ++ct) { const bf16x8 afrag = *(const LAS bf16x8*)(vT + (16 * ct + fr) * 136 + ks * 32 + fq * 8);
            acc[ct] = __builtin_amdgcn_mfma_f32_16x16x32_bf16(afrag, bfrag, acc[ct], 0, 0, 0); }
    }
    const int t = 16 * wave + fr; const float wb = a->in[I_GB][((size_t)l * 4 + h) * 128 + t];
    const bf16* up = P + (size_t)(row0 + t) * INC + OFF_U + h * 128; unsigned char* yp = a->ws + WS_Y8 + (size_t)(row0 + t) * D + h * 128;
#pragma unroll
    for (int ct = 0; ct < 8; ++ct) { const int c = 16 * ct + 4 * fq; const u32x2 uu = *(const u32x2*)(up + c);
        const float y0 = geluf_(bflo(uu.x)) * (acc[ct][0] + wb), y1 = geluf_(bfhi(uu.x)) * (acc[ct][1] + wb), y2 = geluf_(bflo(uu.y)) * (acc[ct][2] + wb), y3 = geluf_(bfhi(uu.y)) * (acc[ct][3] + wb);
        *(unsigned*)(yp + c) = pk4_fp8(y0, y1, y2, y3); }
    __syncthreads();
}

constexpr int SP_ = 72;
__device__ __forceinline__ int kperm_pos(int k) { const int s5 = k & 31; return (k & 32) + 8 * ((s5 >> 2) & 3) + 4 * (s5 >> 4) + (s5 & 3); }
__device__ __forceinline__ void rwkv_prep_item(KArgs a, int l, int tile, int hgrp, LAS unsigned char* lds) {
    const int tid = tid_fresh(), lane = tid & 63, wave = tid >> 6;
    unsigned char* ws = a->ws;
    const bf16* P = (const bf16*)(ws + WS_P); bf16* Y = (bf16*)(ws + WS_Y);
    LAS bf16* SR = (LAS bf16*)lds; LAS bf16* SK = SR + 64 * SP_; LAS bf16* SV = SK + 64 * SP_; LAS bf16* SKK = SV + 64 * SP_; LAS bf16* SB = SKK + 64 * SP_; LAS bf16* SWF = SB + 64 * SP_; LAS bf16* SWB = SWF + 64 * SP_;
    LAS bf16* tw = SWB + 64 * SP_;
    LAS bf16* adl = tw + 64 * SP_;
    LAS bf16* sg = adl + 64 * SP_;
    LAS float* invn = (LAS float*)(sg + 64 * 136);
    LAS unsigned char* wpriv = (LAS unsigned char*)(invn + 64) + wave * 6144;
    const int row0 = tile * 64; const bool isl = row0 < NLAT;
    const float* mu = a->in[I_MU] + (size_t)l * CCOLS;
    const char* Pb = (const char*)P;
    auto shift_group = [&](int tk, int col, float (&z)[8]) {
        const int row = row0 + tk; int o0, o1, o2, o3; bool v0, v1, v2, v3;
        if (isl) { const int gr = (row >> 6) & 63; o0 = -1; o1 = 1; o2 = -64; o3 = 64; v0 = tk > 0; v1 = tk < 63; v2 = gr > 0; v3 = gr < 63; }
        else { const int tc = (row - NLAT) & 255; o0 = -1; o1 = 1; o2 = -1; o3 = 1; v0 = tc > 0; v1 = tc < 255; v2 = v0; v3 = v1; }
        const unsigned off = (unsigned)row * (unsigned)(INC * 2) + (unsigned)(OFF_C + col) * 2u;
        const u32x4 uo = *(const u32x4*)(Pb + off), u0 = *(const u32x4*)(Pb + (off + (unsigned)((v0 ? o0 : 0) * INC * 2))), u1 = *(const u32x4*)(Pb + (off + (unsigned)((v1 ? o1 : 0) * INC * 2))),
                    u2 = *(const u32x4*)(Pb + (off + (unsigned)((v2 ? o2 : 0) * INC * 2))), u3 = *(const u32x4*)(Pb + (off + (unsigned)((v3 ? o3 : 0) * INC * 2)));
        const f32x4 m0 = *(const f32x4*)(mu + col), m1 = *(const f32x4*)(mu + col + 4);
        float own[8], n0[8], n1[8], n2[8], n3[8]; unpack8(uo, own); unpack8(u0, n0); unpack8(u1, n1); unpack8(u2, n2); unpack8(u3, n3);
        const float f0 = v0 ? 1.f : 0.f, f1 = v1 ? 1.f : 0.f, f2 = v2 ? 1.f : 0.f, f3 = v3 ? 1.f : 0.f;
        const float nb[8] = {n0[0] * f0, n1[1] * f1, n2[2] * f2, n3[3] * f3, n0[4] * f0, n1[5] * f1, n2[6] * f2, n3[7] * f3};
#pragma unroll
        for (int j = 0; j < 8; ++j) { const float mm = j < 4 ? m0[j] : m1[j - 4]; z[j] = own[j] + mm * (nb[j] - own[j]); }
    };
#pragma unroll
    for (int it = 0; it < 4; ++it) { const int g = tid + NTHREADS * it, tk = g >> 5, gi = g & 31;
        float z[8]; shift_group(tk, 2304 + gi * 8, z);
        if (gi < 8) { float t8[8];
#pragma unroll
            for (int j = 0; j < 8; ++j) t8[j] = 1.0f - 2.0f * __builtin_amdgcn_rcpf(1.0f + __expf(2.0f * z[j]));
            *(LAS u32x4*)(tw + tk * SP_ + gi * 8) = pack8(t8); }
        else if (gi < 16) *(LAS u32x4*)(adl + tk * SP_ + (gi - 8) * 8) = pack8(z);
        else { float t8[8];
#pragma unroll
            for (int j = 0; j < 8; ++j) t8[j] = sigmoidf_(z[j]);
            *(LAS u32x4*)(sg + tk * 136 + (gi - 16) * 8) = pack8(t8); } }
    __syncthreads();
#pragma unroll 1
    for (int hh = 0; hh < 4; ++hh) {
    const int tid = tid_fresh(), lane = tid & 63, wave = tid >> 6;
    const int head = 4 * hgrp + hh; const float* kkw = a->in[I_KK] + (size_t)l * CW + head * 64;
#pragma unroll
    for (int it = 0; it < 3; ++it) { const int g = tid + NTHREADS * it, tk = g / 24, gi = g % 24, c8 = (gi & 7) * 8;
        float z[8]; shift_group(tk, (gi >> 3) * 768 + head * 64 + c8, z);
        if (gi < 8) *(LAS u32x4*)(SR + tk * SP_ + c8) = pack8(z);
        else if (gi < 16) { *(LAS u32x4*)(SK + tk * SP_ + c8) = pack8(z);
            const f32x4 k0 = *(const f32x4*)(kkw + c8), k1 = *(const f32x4*)(kkw + c8 + 4); float ss = 0.f;
#pragma unroll
            for (int j = 0; j < 8; ++j) { const float q = z[j] * (j < 4 ? k0[j] : k1[j - 4]); ss += q * q; }
            ss += __shfl_xor(ss, 1); ss += __shfl_xor(ss, 2); ss += __shfl_xor(ss, 4);
            if ((gi & 7) == 0) invn[tk] = 1.0f / fmaxf(sqrtf(ss), 1e-12f); }
        else *(LAS u32x4*)(SV + tk * SP_ + c8) = pack8(z); }
    __syncthreads();
    {
        const int fr = lane & 15, fq = lane >> 4, nt = wave & 3, th = wave >> 2;
        const bf16* wupT = (const bf16*)(ws + WS_SMALLW + SW_WUP) + (size_t)l * 2 * 768 * 64;
        const bf16* aupT = (const bf16*)(ws + WS_SMALLW + SW_AUP) + (size_t)l * 768 * 64;
        const bf16* gupT = (const bf16*)(ws + WS_SMALLW + SW_GUP) + (size_t)l * 768 * 128;
        const float* a0 = a->in[I_A0] + (size_t)l * CW + head * 64; const float* kaw = a->in[I_KA] + (size_t)l * CW + head * 64; const float* w0 = a->in[I_W0] + (size_t)l * 2 * CW + head * 64;
        const int nloc = 16 * nt + 4 * fq;
#pragma unroll 1
        for (int mat = 0; mat < 4; ++mat) {
            const bf16* WT = mat == 0 ? aupT : (mat == 1 ? wupT : (mat == 2 ? wupT + 768 * 64 : gupT));
            const int KK = mat == 3 ? 128 : 64; const LAS bf16* act = mat == 0 ? adl : (mat == 3 ? sg : tw); const int apitch = mat == 3 ? 136 : SP_;
            f32x4 acc[2];
            acc[0] = (f32x4){0.f, 0.f, 0.f, 0.f}; acc[1] = acc[0];
            for (int ks = 0; ks < KK / 32; ++ks) { const bf16x8 afr = *(const bf16x8*)(WT + (size_t)(head * 64 + 16 * nt + fr) * KK + ks * 32 + fq * 8);
#pragma unroll
                for (int tt = 0; tt < 2; ++tt) { const bf16x8 bfr = *(const LAS bf16x8*)(act + (16 * (2 * th + tt) + fr) * apitch + ks * 32 + fq * 8); acc[tt] = __builtin_amdgcn_mfma_f32_16x16x32_bf16(afr, bfr, acc[tt], 0, 0, 0); } }
#pragma unroll
            for (int tt = 0; tt < 2; ++tt) { const int tk = 16 * (2 * th + tt) + fr; const f32x4 v = acc[tt];
                if (mat == 0) {
                    const f32x4 a0v = *(const f32x4*)(a0 + nloc), kav = *(const f32x4*)(kaw + nloc), kkv = *(const f32x4*)(kkw + nloc);
                    const u32x2 kp = *(const LAS u32x2*)(SK + tk * SP_ + nloc); const float kf[4] = {bflo(kp.x), bfhi(kp.x), bflo(kp.y), bfhi(kp.y)};
                    const float inn = invn[tk]; float k2[4], kk[4], bb[4];
#pragma unroll
                    for (int j = 0; j < 4; ++j) { const float av = sigmoidf_(a0v[j] + v[j]); kk[j] = kf[j] * kkv[j] * inn; k2[j] = kf[j] * (1.0f + (av - 1.0f) * kav[j]); bb[j] = kk[j] * av; }
                    u32x2 q; q.x = pk2(k2[0], k2[1]); q.y = pk2(k2[2], k2[3]); *(LAS u32x2*)(SK + tk * SP_ + nloc) = q;
                    q.x = pk2(kk[0], kk[1]); q.y = pk2(kk[2], kk[3]); *(LAS u32x2*)(SKK + tk * SP_ + nloc) = q;
                    q.x = pk2(bb[0], bb[1]); q.y = pk2(bb[2], bb[3]); *(LAS u32x2*)(SB + tk * SP_ + nloc) = q;
                } else if (mat <= 2) {
                    const f32x4 w0v = *(const f32x4*)(w0 + (mat - 1) * CW + nloc); float d[4];
#pragma unroll
                    for (int j = 0; j < 4; ++j) d[j] = __expf(-DECAY_SCALE * sigmoidf_(w0v[j] + v[j]));
                    u32x2 q; q.x = pk2(d[0], d[1]); q.y = pk2(d[2], d[3]); *(LAS u32x2*)((mat == 1 ? SWF : SWB) + tk * SP_ + nloc) = q;
                } else {
                    u32x2 q; q.x = pk2(v[0], v[1]); q.y = pk2(v[2], v[3]); *(u32x2*)(Y + (size_t)(row0 + tk) * D + 1280 + head * 64 + nloc) = q;
                }
            }
        }
    }
    __syncthreads();
    { const int tk = tid >> 3, c8 = (tid & 7) * 8; float r8[8], k8[8], v8[8];
      unpack8(*(const LAS u32x4*)(SR + tk * SP_ + c8), r8); unpack8(*(const LAS u32x4*)(SK + tk * SP_ + c8), k8); unpack8(*(const LAS u32x4*)(SV + tk * SP_ + c8), v8);
      const float* rkp = a->in[I_RK] + (size_t)l * CW + head * 64 + c8; const f32x4 rk0 = *(const f32x4*)rkp, rk1 = *(const f32x4*)(rkp + 4);
      float bs = 0.f;
#pragma unroll
      for (int j = 0; j < 8; ++j) bs += r8[j] * k8[j] * (j < 4 ? rk0[j] : rk1[j - 4]);
      bs += __shfl_xor(bs, 1); bs += __shfl_xor(bs, 2); bs += __shfl_xor(bs, 4);
#pragma unroll
      for (int j = 0; j < 8; ++j) v8[j] *= bs;
      *(u32x4*)(Y + (size_t)(row0 + tk) * D + 512 + head * 64 + c8) = pack8(v8); }
    {
        const int c4 = wave & 3, dir = wave >> 2, fr = lane & 15, fq = lane >> 4;
        LAS float* CB = (LAS float*)wpriv;
        LAS float* AA = CB + 16 * 64;
        const LAS bf16* SW = dir ? SWB : SWF;
        auto trow = [&](int tau) { return 16 * c4 + (dir ? 15 - tau : tau); };
        float c[16], ci[16];
        { float run = 1.f;
#pragma unroll
          for (int t = 0; t < 16; ++t) { run *= bf1(SW[trow(t) * SP_ + lane]); c[t] = run; ci[t] = __builtin_amdgcn_rcpf(run); CB[t * 64 + lane] = run; } }
        const int rec_dir = dir, bidx = isl ? (row0 >> 12) : ((row0 - NLAT) >> 8);
        const int tcl = isl ? 4 * ((row0 >> 6) & 63) + c4 : 4 * (((row0 - NLAT) >> 6) & 3) + c4;
        const int nproc = isl ? 16 + (dir ? 255 - tcl : tcl) : (dir ? 15 - tcl : tcl);
        unsigned char* rec = ws + WS_PRE + ((size_t)((rec_dir * 8 + bidx) * 12 + head) * NCHUNK16 + nproc) * PRE_REC;
        { const float cl = c[15]; float bk[32];
#pragma unroll
          for (int t = 0; t < 16; ++t) { const float e = cl * ci[t]; const int pos = 8 * (t >> 2) + (t & 3); bk[pos] = bf1(SB[trow(t) * SP_ + lane]) * e; bk[pos + 4] = bf1(SK[trow(t) * SP_ + lane]) * e; }
#pragma unroll
          for (int q4 = 0; q4 < 4; ++q4) { u32x4 o; o.x = pk2(bk[8 * q4], bk[8 * q4 + 1]); o.y = pk2(bk[8 * q4 + 2], bk[8 * q4 + 3]); o.z = pk2(bk[8 * q4 + 4], bk[8 * q4 + 5]); o.w = pk2(bk[8 * q4 + 6], bk[8 * q4 + 7]);
              *(u32x4*)(rec + PR_BK + lane * 64 + q4 * 16) = o; }
          *(float*)(rec + PR_GAM + lane * 4) = cl; }
        asm volatile("s_waitcnt lgkmcnt(0)" ::: "memory");
        bf16x8 fa[2], frr[2], fb[2], fk[2];
        { const int tr = trow(fr);
#pragma unroll
          for (int sx = 0; sx < 2; ++sx) { const int ch = 32 * sx + 8 * fq; float kk8[8], r8[8], b8[8], k8[8];
              unpack8(*(const LAS u32x4*)(SKK + tr * SP_ + ch), kk8); unpack8(*(const LAS u32x4*)(SR + tr * SP_ + ch), r8); unpack8(*(const LAS u32x4*)(SB + tr * SP_ + ch), b8); unpack8(*(const LAS u32x4*)(SK + tr * SP_ + ch), k8);
              const f32x4 c0 = *(const LAS f32x4*)(CB + fr * 64 + ch), c1 = *(const LAS f32x4*)(CB + fr * 64 + ch + 4);
              f32x4 p0 = (f32x4){1.f, 1.f, 1.f, 1.f}, p1 = p0; if (fr > 0) { p0 = *(const LAS f32x4*)(CB + (fr - 1) * 64 + ch); p1 = *(const LAS f32x4*)(CB + (fr - 1) * 64 + ch + 4); }
              float xa[8], xr[8], xb[8], xk[8];
#pragma unroll
              for (int j = 0; j < 8; ++j) { const float ec = j < 4 ? c0[j] : c1[j - 4], ep = j < 4 ? p0[j] : p1[j - 4]; const float en = __builtin_amdgcn_rcpf(ec);
                  xa[j] = -kk8[j] * ep; xr[j] = r8[j] * ec; xb[j] = b8[j] * en; xk[j] = k8[j] * en; }
              const u32x4 ua = pack8(xa), ur = pack8(xr), ub = pack8(xb), uk = pack8(xk);
              fa[sx] = __builtin_bit_cast(bf16x8, ua); frr[sx] = __builtin_bit_cast(bf16x8, ur); fb[sx] = __builtin_bit_cast(bf16x8, ub); fk[sx] = __builtin_bit_cast(bf16x8, uk); } }
        f32x4 gab = (f32x4){0.f, 0.f, 0.f, 0.f}, gak = gab, grb = gab, grk = gab;
#pragma unroll
        for (int sx = 0; sx < 2; ++sx) { gab = __builtin_amdgcn_mfma_f32_16x16x32_bf16(fa[sx], fb[sx], gab, 0, 0, 0); gak = __builtin_amdgcn_mfma_f32_16x16x32_bf16(fa[sx], fk[sx], gak, 0, 0, 0);
            grb = __builtin_amdgcn_mfma_f32_16x16x32_bf16(frr[sx], fb[sx], grb, 0, 0, 0); grk = __builtin_amdgcn_mfma_f32_16x16x32_bf16(frr[sx], fk[sx], grk, 0, 0, 0); }
#pragma unroll
        for (int j = 0; j < 4; ++j) { const int tau = 4 * fq + j; const bool lo = fr < tau, le = fr <= tau;
            AA[tau * 16 + fr] = lo ? gab[j] : 0.f; AA[256 + tau * 16 + fr] = lo ? gak[j] : 0.f; grb[j] = le ? grb[j] : 0.f; grk[j] = le ? grk[j] : 0.f; }
        asm volatile("s_waitcnt lgkmcnt(0)" ::: "memory");
        float wv[16], mv[16];
#pragma unroll
        for (int t = 0; t < 16; ++t) { const float ab = -bf1(SKK[trow(t) * SP_ + lane]) * (t > 0 ? c[t - 1] : 1.0f); float accw = ab, accm = AA[256 + t * 16 + fr];
#pragma unroll
            for (int q4 = 0; q4 < 4; ++q4) { if (4 * q4 < t) { const f32x4 cf = *(const LAS f32x4*)(AA + t * 16 + 4 * q4);
#pragma unroll
                for (int j = 0; j < 4; ++j) if (4 * q4 + j < t) { accw += cf[j] * wv[4 * q4 + j]; accm += cf[j] * mv[4 * q4 + j]; } } }
            wv[t] = accw; mv[t] = accm; }
        { LAS bf16* stg = (LAS bf16*)CB; const int pp = kperm_pos(lane);
#pragma unroll
          for (int t = 0; t < 16; ++t) { stg[t * 64 + pp] = (bf16)f2bf(wv[t]); stg[1024 + t * 64 + pp] = (bf16)f2bf(bf1(SR[trow(t) * SP_ + lane]) * c[t]); }
          asm volatile("s_waitcnt lgkmcnt(0)" ::: "memory");
#pragma unroll
          for (int q4 = 0; q4 < 4; ++q4) *(u32x4*)(rec + PR_WP + (q4 * 64 + lane) * 16) = *(const LAS u32x4*)((LAS unsigned char*)stg + (q4 * 64 + lane) * 16); }
        { LAS bf16* stg = (LAS bf16*)AA; const int ps = 8 * (fr >> 2) + (fr & 3);
          asm volatile("s_waitcnt lgkmcnt(0)" ::: "memory");
#pragma unroll
          for (int j = 0; j < 4; ++j) { const int tau = 4 * fq + j; stg[tau * 32 + ps] = (bf16)f2bf(grb[j]); stg[tau * 32 + ps + 4] = (bf16)f2bf(grk[j]); }
          if (lane < 16) {
#pragma unroll
              for (int t = 0; t < 16; ++t) stg[512 + t * 16 + lane] = (bf16)f2bf(mv[t]); }
          asm volatile("s_waitcnt lgkmcnt(0)" ::: "memory");
          *(u32x4*)(rec + PR_ARBK + lane * 16) = *(const LAS u32x4*)((LAS unsigned char*)stg + lane * 16);
          if (lane < 32) *(u32x4*)(rec + PR_ARBK + 1024 + lane * 16) = *(const LAS u32x4*)((LAS unsigned char*)stg + 1024 + lane * 16); }
        if (dir == 0) { float v16[16];
#pragma unroll
            for (int t = 0; t < 16; ++t) v16[t] = bf1(SV[(16 * c4 + t) * SP_ + lane]);
            const int tcg = isl ? 16 + tcl : tcl;
            unsigned char* vrec = ws + WS_VT + ((size_t)(bidx * 12 + head) * NCHUNK16 + tcg) * 2048 + lane * 32;
            u32x4 o; o.x = pk2(v16[0], v16[1]); o.y = pk2(v16[2], v16[3]); o.z = pk2(v16[4], v16[5]); o.w = pk2(v16[6], v16[7]); *(u32x4*)vrec = o;
            o.x = pk2(v16[8], v16[9]); o.y = pk2(v16[10], v16[11]); o.z = pk2(v16[12], v16[13]); o.w = pk2(v16[14], v16[15]); *(u32x4*)(vrec + 16) = o; }
    }
    __syncthreads();
    }
}

__device__ __forceinline__ float dpp_xor1(float x) { return __builtin_bit_cast(float, __builtin_amdgcn_update_dpp(0, __builtin_bit_cast(int, x), 0xB1, 0xF, 0xF, false)); }
__device__ __forceinline__ float dpp_xor2(float x) { return __builtin_bit_cast(float, __builtin_amdgcn_update_dpp(0, __builtin_bit_cast(int, x), 0x4E, 0xF, 0xF, false)); }
__device__ __forceinline__ int chain_row(int dir, int b, int s) {
    if (s < CTXL) return NLAT + b * CTXL + (dir ? (CTXL - 1 - s) : s);
    const int t = s - CTXL; return b * T + (dir ? (T - 1 - t) : t);
}
__device__ __forceinline__ float dpp_hmirror(float x) { return __builtin_bit_cast(float, __builtin_amdgcn_update_dpp(0, __builtin_bit_cast(int, x), 0x141, 0xF, 0xF, false)); }
struct RwRec { u32x4 wp[2], rp[2], bk[4], arbk; u32x2 mak, vt[2]; f32x4 gam[4]; };
__device__ __forceinline__ void rw_load(RwRec& r, const LAS unsigned char* rec, int fr, int kg, int hv, int dir) {
#pragma unroll
    for (int sx = 0; sx < 2; ++sx) { r.wp[sx] = *(const LAS u32x4*)(rec + PR_WP + fr * 128 + sx * 64 + kg * 16); r.rp[sx] = *(const LAS u32x4*)(rec + PR_RP + fr * 128 + sx * 64 + kg * 16); }
#pragma unroll
    for (int i = 0; i < 4; ++i) { r.bk[i] = *(const LAS u32x4*)(rec + PR_BK + (16 * i + fr) * 64 + kg * 16); r.gam[i] = *(const LAS f32x4*)(rec + PR_GAM + (16 * i + 4 * kg) * 4); }
    r.arbk = *(const LAS u32x4*)(rec + PR_ARBK + fr * 64 + kg * 16);
    r.mak = *(const LAS u32x2*)(rec + PR_MAK + fr * 32 + kg * 8);
#pragma unroll
    for (int q = 0; q < 2; ++q) r.vt[q] = *(const LAS u32x2*)(rec + PRE_REC + (16 * (2 * hv + q) + fr) * 32 + (dir ? (12 - 4 * kg) : 4 * kg) * 2);
}
constexpr int RW_R = 6, RW_SLOT = PRE_REC + 2048;
__device__ __forceinline__ void rwkv_chain_mfma(KArgs a, int task_base, LAS unsigned char* lds) {
    const int t_ = tid_fresh(); const int lane = t_ & 63, fr = lane & 15, kg = lane >> 4; const int wave = __builtin_amdgcn_readfirstlane(t_ >> 6);
    unsigned char* ws = a->ws;
    bf16* OC = (bf16*)(ws + WS_OC);
    const int cid = (task_base >> 2) + (wave >> 2), wq = wave & 3, dir = cid / 96, b = (cid % 96) / 12, h = cid % 12;
    const bool comp = wq < 2; const int hv = wq & 1;
    const unsigned char* rec0 = ws + WS_PRE + (size_t)((dir * 8 + b) * 12 + h) * NCHUNK16 * PRE_REC;
    const unsigned char* vrec0 = ws + WS_VT + (size_t)(b * 12 + h) * NCHUNK16 * 2048;
    LAS unsigned char* ring = lds + (wave >> 2) * (RW_R * RW_SLOT);
    auto tchunk = [&](int n) { return n < 16 ? (dir ? 15 - n : n) : 16 + (dir ? 255 - (n - 16) : (n - 16)); };
    auto issue = [&](int n) { const int nn = n < NCHUNK16 ? n : NCHUNK16 - 1; LAS unsigned char* slot = ring + (n % RW_R) * RW_SLOT;
#pragma unroll
        for (int jj = 0; jj < 3; ++jj) { const int j = 3 * wq + jj;
            const unsigned char* src = (j < 10 ? rec0 + (size_t)nn * PRE_REC + 1024 * j : vrec0 + (size_t)tchunk(nn) * 2048 + 1024 * (j - 10)) + lane * 16;
            __builtin_amdgcn_global_load_lds((const unsigned*)src, (LAS unsigned*)(slot + 1024 * j), 16, 0, 0); } };
    f32x4 ST[2][4];
#pragma unroll
    for (int q = 0; q < 2; ++q)
#pragma unroll
        for (int i = 0; i < 4; ++i) ST[q][i] = (f32x4){0.f, 0.f, 0.f, 0.f};
    unsigned uvU[2][2] = {{0u, 0u}, {0u, 0u}};
#pragma unroll
    for (int n = 0; n < RW_R - 1; ++n) issue(n);
    for (int n = 0; n < NCHUNK16; ++n) {
        asm volatile("s_waitcnt vmcnt(12)" ::: "memory");
        __builtin_amdgcn_s_barrier(); asm volatile("" ::: "memory");
        issue(n + RW_R - 1);
        if (comp) {
            RwRec cur; rw_load(cur, ring + (n % RW_R) * RW_SLOT, fr, kg, hv, dir);
            u32x4 fmak; fmak.x = 0u; fmak.y = 0u; fmak.z = cur.mak.x; fmak.w = cur.mak.y;
            const int row = chain_row(dir, b, 16 * n + fr);
#pragma unroll
            for (int q = 0; q < 2; ++q) {
                u32x4 fs[2];
#pragma unroll
                for (int sx = 0; sx < 2; ++sx) { fs[sx].x = pk2(ST[q][2 * sx][0], ST[q][2 * sx][1]); fs[sx].y = pk2(ST[q][2 * sx][2], ST[q][2 * sx][3]); fs[sx].z = pk2(ST[q][2 * sx + 1][0], ST[q][2 * sx + 1][1]); fs[sx].w = pk2(ST[q][2 * sx + 1][2], ST[q][2 * sx + 1][3]); }
                u32x2 vt = cur.vt[q]; if (dir) { const unsigned x = vt.x, y = vt.y; vt.x = (y >> 16) | (y << 16); vt.y = (x >> 16) | (x << 16); }
                u32x4 fuv; fuv.x = uvU[q][0]; fuv.y = uvU[q][1]; fuv.z = vt.x; fuv.w = vt.y;
                f32x4 U = (f32x4){0.f, 0.f, 0.f, 0.f};
                U = __builtin_amdgcn_mfma_f32_16x16x32_bf16(__builtin_bit_cast(bf16x8, cur.wp[0]), __builtin_bit_cast(bf16x8, fs[0]), U, 0, 0, 0);
                U = __builtin_amdgcn_mfma_f32_16x16x32_bf16(__builtin_bit_cast(bf16x8, cur.wp[1]), __builtin_bit_cast(bf16x8, fs[1]), U, 0, 0, 0);
                U = __builtin_amdgcn_mfma_f32_16x16x32_bf16(__builtin_bit_cast(bf16x8, fmak), __builtin_bit_cast(bf16x8, fuv), U, 0, 0, 0);
                uvU[q][0] = pk2(U[0], U[1]); uvU[q][1] = pk2(U[2], U[3]); fuv.x = uvU[q][0]; fuv.y = uvU[q][1];
                f32x4 OT = (f32x4){0.f, 0.f, 0.f, 0.f};
                OT = __builtin_amdgcn_mfma_f32_16x16x32_bf16(__builtin_bit_cast(bf16x8, fs[0]), __builtin_bit_cast(bf16x8, cur.rp[0]), OT, 0, 0, 0);
                OT = __builtin_amdgcn_mfma_f32_16x16x32_bf16(__builtin_bit_cast(bf16x8, fs[1]), __builtin_bit_cast(bf16x8, cur.rp[1]), OT, 0, 0, 0);
                OT = __builtin_amdgcn_mfma_f32_16x16x32_bf16(__builtin_bit_cast(bf16x8, fuv), __builtin_bit_cast(bf16x8, cur.arbk), OT, 0, 0, 0);
#pragma unroll
                for (int i = 0; i < 4; ++i) ST[q][i] = __builtin_amdgcn_mfma_f32_16x16x32_bf16(__builtin_bit_cast(bf16x8, cur.bk[i]), __builtin_bit_cast(bf16x8, fuv), ST[q][i] * cur.gam[i], 0, 0, 0);
                u32x2 o; o.x = pk2(OT[0], OT[1]); o.y = pk2(OT[2], OT[3]); *(u32x2*)(OC + ((size_t)dir * MALL + row) * CW + h * 64 + 16 * (2 * hv + q) + 4 * kg) = o;
            }
        }
    }
    asm volatile("s_waitcnt vmcnt(0)" ::: "memory");
    __builtin_amdgcn_s_barrier(); asm volatile("" ::: "memory");
}
#define LDS_BAR() do { asm volatile("s_waitcnt lgkmcnt(0)" ::: "memory"); __builtin_amdgcn_s_barrier(); asm volatile("" ::: "memory"); } while (0)
__device__ __forceinline__ void hgrn_prep_item(KArgs a, int l, int item, LAS unsigned char* lds, bool dry) {
    const int tid = tid_fresh();
    unsigned char* ws = a->ws;
    bf16* P = (bf16*)(ws + WS_P); bf16* HQB = (bf16*)(ws + WS_HQB); float* HG = (float*)(ws + WS_HG);
    const int cn = item % 68, bh = item / 68, h = bh % 6, b = bh / 6;
    const int row0 = cn < 4 ? NLAT + b * CTXL + 64 * cn : b * T + 64 * (cn - 4);
    constexpr int QP = 136;
    LAS bf16* SQ = (LAS bf16*)lds; LAS bf16* KF = SQ + 64 * QP; LAS bf16* KB = KF + 64 * QP; LAS bf16* QB = KB + 64 * QP;
    LAS float* LF = (LAS float*)(QB + 64 * QP); LAS float* LBk = LF + 64 * 128;
    LAS float* tot = LBk + 64 * 128;
    LAS float* lbs = tot + 1024;
    if (tid < 256) { const int dr = tid >> 7, ch = h * 128 + (tid & 127); float lb = 0.f;
        if (l != 0) { const float l0 = a->in[I_LB][((size_t)dr * DEPTH + 0) * BW + ch], l1 = a->in[I_LB][((size_t)dr * DEPTH + 1) * BW + ch]; lb = __builtin_amdgcn_rcpf(1.0f + __expf(l0 - l1)); }
        lbs[tid] = lb; }
    const int ta = tid >> 3, d0 = (tid & 7) * 16;
    bf16* prow = P + (size_t)(row0 + ta) * INC + h * 128 + d0;
    u32x4 rq[2], rf[2], rb[2];
    rq[0] = *(const u32x4*)(prow + OFF_Q); rq[1] = *(const u32x4*)(prow + OFF_Q + 8); rf[0] = *(const u32x4*)(prow + OFF_ZF); rf[1] = *(const u32x4*)(prow + OFF_ZF + 8); rb[0] = *(const u32x4*)(prow + OFF_ZB); rb[1] = *(const u32x4*)(prow + OFF_ZB + 8);
    __syncthreads();
#pragma unroll
    for (int hf = 0; hf < 2; ++hf) { float qf[8], zf[8], zb[8], oq[8], of[8], ob[8]; unpack8(rq[hf], qf); unpack8(rf[hf], zf); unpack8(rb[hf], zb);
        const int dd = d0 + 8 * hf; f32x4 lf0, lf1, lb0, lb1;
#pragma unroll
        for (int j = 0; j < 8; ++j) { const float lF = lbs[dd + j], lB = lbs[128 + dd + j];
            const float ff = lF + (1.0f - lF) * sigmoidf_(zf[j]), fb = lB + (1.0f - lB) * sigmoidf_(zb[j]);
            const float a1 = fmaxf(__logf(ff), -60.0f), a2 = fmaxf(__logf(fb), -60.0f);
            if (j < 4) { lf0[j] = a1; lb0[j] = a2; } else { lf1[j - 4] = a1; lb1[j - 4] = a2; }
            oq[j] = siluf_(qf[j]); of[j] = 1.0f - ff; ob[j] = 1.0f - fb; }
        *(LAS u32x4*)(SQ + ta * QP + dd) = pack8(oq); *(LAS u32x4*)(KF + ta * QP + dd) = pack8(of); *(LAS u32x4*)(KB + ta * QP + dd) = pack8(ob);
        *(LAS f32x4*)(LF + ta * 128 + dd) = lf0; *(LAS f32x4*)(LF + ta * 128 + dd + 4) = lf1; *(LAS f32x4*)(LBk + ta * 128 + dd) = lb0; *(LAS f32x4*)(LBk + ta * 128 + dd + 4) = lb1; }
    __syncthreads();
    { const int d = tid & 127, qt = tid >> 7; float r1 = 0.f, r2 = 0.f;
#pragma unroll
      for (int i = 0; i < 16; ++i) { const int tp = 16 * qt + i; r1 += LF[tp * 128 + d]; LF[tp * 128 + d] = r1; r2 += LBk[(63 - tp) * 128 + d]; LBk[(63 - tp) * 128 + d] = r2; }
      tot[qt * 128 + d] = r1; tot[512 + qt * 128 + d] = r2; }
    __syncthreads();
    LAS float* bas = lbs + 256;
    LAS float* bmd = bas + 1024;
    { const int d = tid & 127, dr = (tid >> 7) & 1; if (tid < 256) { const LAS float* tt = tot + 512 * dr; const float t0 = tt[d], t1 = tt[128 + d], t2 = tt[256 + d], t3 = tt[384 + d];
        bas[(dr * 4 + 0) * 128 + d] = 0.f; bas[(dr * 4 + 1) * 128 + d] = t0; bas[(dr * 4 + 2) * 128 + d] = t0 + t1; bas[(dr * 4 + 3) * 128 + d] = t0 + t1 + t2; bmd[dr * 128 + d] = t0 + t1;
        const int npr = dr == 0 ? cn : (cn < 4 ? 3 - cn : 4 + 63 - (cn - 4)); float* g = (dry ? (float*)(ws + WS_END + 8 * MiB) : HG) + ((size_t)(((dr * 8 + b) * 6 + h) * 68 + npr)) * 256; g[d] = __expf(t0 + t1); g[128 + d] = __expf(t2 + t3); } }
    __syncthreads();
#pragma unroll
    for (int hf = 0; hf < 2; ++hf) { const int dd = d0 + 8 * hf; float sq[8], kf[8], kb[8];
        unpack8(*(const LAS u32x4*)(SQ + ta * QP + dd), sq); unpack8(*(const LAS u32x4*)(KF + ta * QP + dd), kf); unpack8(*(const LAS u32x4*)(KB + ta * QP + dd), kb);
        float oqf[8], okf[8], oqb[8], okb[8];
#pragma unroll
        for (int dr = 0; dr < 2; ++dr) { const int tp = dr ? 63 - ta : ta, q = tp >> 4; const LAS float* pf = (dr ? LBk : LF) + ta * 128 + dd;
            const f32x4 p0 = *(const LAS f32x4*)pf, p1 = *(const LAS f32x4*)(pf + 4), b0 = *(const LAS f32x4*)(bas + (dr * 4 + q) * 128 + dd), b1 = *(const LAS f32x4*)(bas + (dr * 4 + q) * 128 + dd + 4),
                        m0 = *(const LAS f32x4*)(bmd + dr * 128 + dd), m1 = *(const LAS f32x4*)(bmd + dr * 128 + dd + 4);
#pragma unroll
            for (int j = 0; j < 8; ++j) { const float bt = (j < 4 ? p0[j] + b0[j] : p1[j - 4] + b1[j - 4]), bm = j < 4 ? m0[j] : m1[j - 4];
                const float eq = __expf(fminf(bt - bm, 80.0f)), ek = __expf(fminf(bm - bt, 80.0f));
                if (dr == 0) { oqf[j] = sq[j] * eq; okf[j] = kf[j] * ek; } else { oqb[j] = sq[j] * eq; okb[j] = kb[j] * ek; } } }
        *(LAS u32x4*)(QB + ta * QP + dd) = pack8(oqf); *(LAS u32x4*)(KF + ta * QP + dd) = pack8(okf); *(LAS u32x4*)(KB + ta * QP + dd) = pack8(okb); *(LAS u32x4*)(SQ + ta * QP + dd) = pack8(oqb); }
    bf16* prow_o = dry ? (bf16*)(ws + WS_END) + (size_t)((row0 + ta) & 511) * INC + h * 128 + d0 : prow; bf16* hqb_o = dry ? (bf16*)(ws + WS_END) : HQB;
#pragma unroll
    for (int hf = 0; hf < 2; ++hf) { const int dd = d0 + 8 * hf;
        *(u32x4*)(prow_o + OFF_Q + 8 * hf) = *(const LAS u32x4*)(QB + ta * QP + dd); *(u32x4*)(prow_o + OFF_ZF + 8 * hf) = *(const LAS u32x4*)(KF + ta * QP + dd); *(u32x4*)(prow_o + OFF_ZB + 8 * hf) = *(const LAS u32x4*)(KB + ta * QP + dd);
        *(u32x4*)(hqb_o + (size_t)(dry ? ((row0 + ta) & 1023) : (row0 + ta)) * BW + h * 128 + dd) = *(const LAS u32x4*)(SQ + ta * QP + dd); }
    __syncthreads();
}
__device__ __forceinline__ unsigned tr_addr(const LAS bf16* X, int pitch, int r0, int c0, int lane) { const int i = lane & 15, g = lane >> 4; return (unsigned)(size_t)(X + (r0 + 8 * g + (i >> 2)) * pitch + c0 + 4 * (i & 3)); }
__device__ __forceinline__ void tr8x4(u32x2 (&lo)[4], u32x2 (&hi)[4], unsigned a0, unsigned a1, unsigned a2, unsigned a3, unsigned rowstep4) {
    const unsigned b0 = a0 + rowstep4, b1 = a1 + rowstep4, b2 = a2 + rowstep4, b3 = a3 + rowstep4;
    asm volatile("ds_read_b64_tr_b16 %0, %8\n\tds_read_b64_tr_b16 %1, %9\n\tds_read_b64_tr_b16 %2, %10\n\tds_read_b64_tr_b16 %3, %11\n\t"
                 "ds_read_b64_tr_b16 %4, %12\n\tds_read_b64_tr_b16 %5, %13\n\tds_read_b64_tr_b16 %6, %14\n\tds_read_b64_tr_b16 %7, %15\n\ts_waitcnt lgkmcnt(0)"
                 : "=&v"(lo[0]), "=&v"(lo[1]), "=&v"(lo[2]), "=&v"(lo[3]), "=&v"(hi[0]), "=&v"(hi[1]), "=&v"(hi[2]), "=&v"(hi[3])
                 : "v"(a0), "v"(a1), "v"(a2), "v"(a3), "v"(b0), "v"(b1), "v"(b2), "v"(b3) : "memory");
}
__device__ __forceinline__ void tr_half(u32x2 (&vl)[8], u32x2 (&vh)[8], u32x2 (&xl)[2], u32x2 (&xh)[2], unsigned av, unsigned ak, unsigned ax) {
    asm volatile(
        "ds_read_b64_tr_b16 %0, %20\n\tds_read_b64_tr_b16 %1, %20 offset:32\n\tds_read_b64_tr_b16 %2, %20 offset:64\n\tds_read_b64_tr_b16 %3, %20 offset:96\n\t"
        "ds_read_b64_tr_b16 %4, %20 offset:128\n\tds_read_b64_tr_b16 %5, %20 offset:160\n\tds_read_b64_tr_b16 %6, %20 offset:192\n\tds_read_b64_tr_b16 %7, %20 offset:224\n\t"
        "ds_read_b64_tr_b16 %8, %20 offset:1088\n\tds_read_b64_tr_b16 %9, %20 offset:1120\n\tds_read_b64_tr_b16 %10, %20 offset:1152\n\tds_read_b64_tr_b16 %11, %20 offset:1184\n\t"
        "ds_read_b64_tr_b16 %12, %20 offset:1216\n\tds_read_b64_tr_b16 %13, %20 offset:1248\n\tds_read_b64_tr_b16 %14, %20 offset:1280\n\tds_read_b64_tr_b16 %15, %20 offset:1312\n\t"
        "ds_read_b64_tr_b16 %16, %21\n\tds_read_b64_tr_b16 %17, %22\n\tds_read_b64_tr_b16 %18, %21 offset:1088\n\tds_read_b64_tr_b16 %19, %22 offset:1088\n\ts_waitcnt lgkmcnt(0)"
        : "=&v"(vl[0]), "=&v"(vl[1]), "=&v"(vl[2]), "=&v"(vl[3]), "=&v"(vl[4]), "=&v"(vl[5]), "=&v"(vl[6]), "=&v"(vl[7]),
          "=&v"(vh[0]), "=&v"(vh[1]), "=&v"(vh[2]), "=&v"(vh[3]), "=&v"(vh[4]), "=&v"(vh[5]), "=&v"(vh[6]), "=&v"(vh[7]),
          "=&v"(xl[0]), "=&v"(xl[1]), "=&v"(xh[0]), "=&v"(xh[1])
        : "v"(av), "v"(ak), "v"(ax) : "memory");
}
__device__ __forceinline__ bf16x8 mk8(u32x2 lo, u32x2 hi) { u32x4 v; v.x = lo.x; v.y = lo.y; v.z = hi.x; v.w = hi.y; return __builtin_bit_cast(bf16x8, v); }
__device__ __forceinline__ void hgrn_chain_lean(KArgs a, int cid, LAS unsigned char* lds) {
    const int tid = tid_fresh(), lane = tid & 63, wave = tid >> 6, fr = lane & 15, fq = lane >> 4;
    unsigned char* ws = a->ws;
    const bf16* P = (const bf16*)(ws + WS_P); const bf16* HQB = (const bf16*)(ws + WS_HQB); const float* HG = (const float*)(ws + WS_HG); bf16* OB = (bf16*)(ws + WS_OB);
    const int dir = cid / 48, b = (cid % 48) / 6, h = cid % 6;
    constexpr int QP = 136, SP = 72;
    LAS bf16* qs = (LAS bf16*)lds;
    LAS bf16* ks = qs + 64 * QP;
    LAS bf16* vs = ks + 64 * QP;
    LAS bf16* pl = vs + 64 * QP;
    LAS bf16* sT = pl + 64 * SP;
    LAS float* gm = (LAS float*)(sT + 128 * QP);
    const int ta = tid >> 3, d0 = (tid & 7) * 16;
    const int koff = dir ? OFF_ZB : OFF_ZF;
    f32x4 S[8];
#pragma unroll
    for (int vt = 0; vt < 8; ++vt) S[vt] = (f32x4){0.f, 0.f, 0.f, 0.f};
    u32x4 rq[2], rk[2], rv[2]; float rg = 0.f;
    auto load_chunk = [&](int n) { const int row = chain_row(dir, b, 64 * n + ta); const bf16* pr = P + (size_t)row * INC + h * 128 + d0;
        const bf16* qr = dir ? HQB + (size_t)row * BW + h * 128 + d0 : pr + OFF_Q;
        rq[0] = *(const u32x4*)qr; rq[1] = *(const u32x4*)(qr + 8); rk[0] = *(const u32x4*)(pr + koff); rk[1] = *(const u32x4*)(pr + koff + 8); rv[0] = *(const u32x4*)(pr + OFF_I); rv[1] = *(const u32x4*)(pr + OFF_I + 8);
        if (tid < 256) rg = HG[((size_t)(((dir * 8 + b) * 6 + h) * 68 + n)) * 256 + tid]; };
    load_chunk(0);
    constexpr int NCH = (CTXL + T) / 64;
    for (int n = 0; n < NCH; ++n) {
        const int s0 = n * 64;
        *(LAS u32x4*)(qs + ta * QP + d0) = rq[0]; *(LAS u32x4*)(qs + ta * QP + d0 + 8) = rq[1]; *(LAS u32x4*)(ks + ta * QP + d0) = rk[0]; *(LAS u32x4*)(ks + ta * QP + d0 + 8) = rk[1];
        *(LAS u32x4*)(vs + ta * QP + d0) = rv[0]; *(LAS u32x4*)(vs + ta * QP + d0 + 8) = rv[1]; if (tid < 256) gm[tid] = rg;
        if (n + 1 < NCH) load_chunk(n + 1);
        LDS_BAR();
        { const f32x4 g4 = *(const LAS f32x4*)(gm + 16 * wave + 4 * fq);
#pragma unroll
          for (int vt = 0; vt < 8; ++vt) { S[vt] = S[vt] * g4; u32x2 o; o.x = pk2(S[vt][0], S[vt][1]); o.y = pk2(S[vt][2], S[vt][3]); *(LAS u32x2*)(sT + (16 * vt + fr) * QP + 16 * wave + 4 * fq) = o; } }
        { const int tt = wave >> 1;
#pragma unroll
          for (int u = 0; u < 2; ++u) { const int sg = 2 * (wave & 1) + u; f32x4 acc = (f32x4){0.f, 0.f, 0.f, 0.f};
              if (sg <= tt) {
#pragma unroll
                  for (int kq = 0; kq < 4; ++kq) { const bf16x8 af = *(const LAS bf16x8*)(ks + (16 * sg + fr) * QP + 32 * kq + 8 * fq), bfm = *(const LAS bf16x8*)(qs + (16 * tt + fr) * QP + 32 * kq + 8 * fq);
                      acc = __builtin_amdgcn_mfma_f32_16x16x32_bf16(af, bfm, acc, 0, 0, 0); }
                  if (sg == tt) {
#pragma unroll
                      for (int j = 0; j < 4; ++j) if (4 * fq + j > fr) acc[j] = 0.f; }
              }
              u32x2 o; o.x = pk2(acc[0], acc[1]); o.y = pk2(acc[2], acc[3]); *(LAS u32x2*)(pl + (16 * tt + fr) * SP + 16 * sg + 4 * fq) = o; } }
        LDS_BAR();
        f32x4 oacc[4];
#pragma unroll
        for (int tt = 0; tt < 4; ++tt) { f32x4 acc = (f32x4){0.f, 0.f, 0.f, 0.f};
#pragma unroll
            for (int kq = 0; kq < 4; ++kq) { const bf16x8 af = *(const LAS bf16x8*)(sT + (16 * wave + fr) * QP + 32 * kq + 8 * fq), bfm = *(const LAS bf16x8*)(qs + (16 * tt + fr) * QP + 32 * kq + 8 * fq);
                acc = __builtin_amdgcn_mfma_f32_16x16x32_bf16(af, bfm, acc, 0, 0, 0); }
            oacc[tt] = acc; }
        const unsigned rs4 = (unsigned)(4 * QP * 2);
#pragma unroll
        for (int kq = 0; kq < 2; ++kq) {
            u32x2 vl_[8], vh_[8], xl_[2], xh_[2];
            static_assert(QP == 136, "tr_half's immediates assume 272-byte rows");
            tr_half(vl_, vh_, xl_, xh_, tr_addr(vs, QP, 32 * kq, 0, lane), tr_addr(ks, QP, 32 * kq, 16 * wave, lane), tr_addr(vs, QP, 32 * kq, 16 * wave, lane));
            __builtin_amdgcn_sched_barrier(0);
            { const bf16x8 af = mk8(xl_[1], xh_[1]);
#pragma unroll
              for (int tt = 0; tt < 4; ++tt) { const bf16x8 bfm = *(const LAS bf16x8*)(pl + (16 * tt + fr) * SP + 32 * kq + 8 * fq); oacc[tt] = __builtin_amdgcn_mfma_f32_16x16x32_bf16(af, bfm, oacc[tt], 0, 0, 0); } }
            { const bf16x8 af = mk8(xl_[0], xh_[0]);
#pragma unroll
              for (int vt = 0; vt < 8; ++vt) S[vt] = __builtin_amdgcn_mfma_f32_16x16x32_bf16(af, mk8(vl_[vt], vh_[vt]), S[vt], 0, 0, 0); }
        }
#pragma unroll
        for (int tt = 0; tt < 4; ++tt) { const int row = chain_row(dir, b, s0 + 16 * tt + fr);
            u32x2 o; o.x = pk2(oacc[tt][0], oacc[tt][1]); o.y = pk2(oacc[tt][2], oacc[tt][3]); *(u32x2*)(OB + ((size_t)dir * MALL + row) * BW + h * 128 + 16 * wave + 4 * fq) = o; }
        { const f32x4 ge = *(const LAS f32x4*)(gm + 128 + 16 * wave + 4 * fq);
#pragma unroll
          for (int vt = 0; vt < 8; ++vt) S[vt] = S[vt] * ge; }
        LDS_BAR();
    }
}
__device__ __forceinline__ void hgrn_chain_mfma(KArgs a, int l, int cid, LAS unsigned char* lds) {
    const int tid = tid_fresh(), lane = tid & 63, wave = tid >> 6, fr = lane & 15, fq = lane >> 4;
    unsigned char* ws = a->ws;
    const bf16* P = (const bf16*)(ws + WS_P); bf16* OB = (bf16*)(ws + WS_OB);
    const int dir = cid / 48, b = (cid % 48) / 6, h = cid % 6;
    constexpr int QP = 136, SP = 72;
    LAS bf16* qs = (LAS bf16*)lds;
    LAS bf16* ks = qs + 64 * QP;
    LAS bf16* kT = ks + 64 * QP;
    LAS bf16* vT = kT + 128 * SP;
    LAS bf16* pl = vT + 128 * SP;
    LAS bf16* sT = pl + 64 * SP;
    LAS float* tot = (LAS float*)(sT + 128 * QP);
    LAS float* gmid = tot + 512;
    LAS float* gend = gmid + 128;
    LAS float* lbs = gend + 128;
    LAS float* lfb = (LAS float*)sT;
    const int d = tid & 127, qt = tid >> 7;
    const int tau_a = tid >> 3, d0 = (tid & 7) * 16;
    if (tid < 128) { const int ch = h * 128 + tid; float lb = 0.f;
        if (l != 0) { const float l0 = a->in[I_LB][((size_t)dir * DEPTH + 0) * BW + ch], l1 = a->in[I_LB][((size_t)dir * DEPTH + 1) * BW + ch]; lb = 1.0f / (1.0f + __expf(l0 - l1)); }
        lbs[tid] = lb; }
    f32x4 S[8];
#pragma unroll
    for (int vt = 0; vt < 8; ++vt) S[vt] = (f32x4){0.f, 0.f, 0.f, 0.f};
    const int zoff = dir ? OFF_ZB : OFF_ZF;
    u32x4 rq[2], ri[2], rz[2];
    { const bf16* pr = P + (size_t)chain_row(dir, b, tau_a) * INC + h * 128 + d0;
      rq[0] = *(const u32x4*)(pr + OFF_Q); rq[1] = *(const u32x4*)(pr + OFF_Q + 8); ri[0] = *(const u32x4*)(pr + OFF_I); ri[1] = *(const u32x4*)(pr + OFF_I + 8); rz[0] = *(const u32x4*)(pr + zoff); rz[1] = *(const u32x4*)(pr + zoff + 8); }
    __syncthreads();
    constexpr int NCH = (CTXL + T) / 64;
    for (int n = 0; n < NCH; ++n) {
        const int s0 = n * 64;
#pragma unroll
        for (int hf = 0; hf < 2; ++hf) { float qf[8], zf[8], oq[8], ok[8]; unpack8(rq[hf], qf); unpack8(rz[hf], zf);
            const int dd = d0 + 8 * hf; const f32x4 lb0 = *(const LAS f32x4*)(lbs + dd), lb1 = *(const LAS f32x4*)(lbs + dd + 4); f32x4 lf0, lf1;
#pragma unroll
            for (int j = 0; j < 8; ++j) { const float lb = j < 4 ? lb0[j] : lb1[j - 4]; const float f = lb + (1.0f - lb) * sigmoidf_(zf[j]); const float lf = fmaxf(__logf(f), -60.0f);
                if (j < 4) lf0[j] = lf; else lf1[j - 4] = lf; oq[j] = siluf_(qf[j]); ok[j] = 1.0f - f; }
            *(LAS u32x4*)(qs + tau_a * QP + dd) = pack8(oq); *(LAS u32x4*)(ks + tau_a * QP + dd) = pack8(ok);
            *(LAS f32x4*)(lfb + tau_a * 128 + dd) = lf0; *(LAS f32x4*)(lfb + tau_a * 128 + dd + 4) = lf1;
            const u32x4 vv = ri[hf];
            vT[(dd + 0) * SP + tau_a] = (bf16)(vv.x & 0xffffu); vT[(dd + 1) * SP + tau_a] = (bf16)(vv.x >> 16); vT[(dd + 2) * SP + tau_a] = (bf16)(vv.y & 0xffffu); vT[(dd + 3) * SP + tau_a] = (bf16)(vv.y >> 16);
            vT[(dd + 4) * SP + tau_a] = (bf16)(vv.z & 0xffffu); vT[(dd + 5) * SP + tau_a] = (bf16)(vv.z >> 16); vT[(dd + 6) * SP + tau_a] = (bf16)(vv.w & 0xffffu); vT[(dd + 7) * SP + tau_a] = (bf16)(vv.w >> 16); }
        if (n + 1 < NCH) { const bf16* pr = P + (size_t)chain_row(dir, b, s0 + 64 + tau_a) * INC + h * 128 + d0;
            rq[0] = *(const u32x4*)(pr + OFF_Q); rq[1] = *(const u32x4*)(pr + OFF_Q + 8); ri[0] = *(const u32x4*)(pr + OFF_I); ri[1] = *(const u32x4*)(pr + OFF_I + 8); rz[0] = *(const u32x4*)(pr + zoff); rz[1] = *(const u32x4*)(pr + zoff + 8); }
        LDS_BAR();
        float cs[16];
        { float run = 0.f;
#pragma unroll
          for (int i = 0; i < 16; ++i) { run += lfb[(16 * qt + i) * 128 + d]; cs[i] = run; }
          tot[qt * 128 + d] = run; }
        LDS_BAR();
        { const float t0 = tot[d], t1 = tot[128 + d], t2 = tot[256 + d], t3 = tot[384 + d];
          const float bmid = t0 + t1, btot = bmid + t2 + t3; const float base = (qt > 0 ? t0 : 0.f) + (qt > 1 ? t1 : 0.f) + (qt > 2 ? t2 : 0.f);
          if (qt == 0) { gmid[d] = __expf(bmid); gend[d] = __expf(btot - bmid); }
#pragma unroll
          for (int i = 0; i < 16; ++i) { const int tau = 16 * qt + i; const float bt = base + cs[i];
              const float eq = __expf(fminf(bt - bmid, 80.0f)), ek = __expf(fminf(bmid - bt, 80.0f));
              const bf16 qb = (bf16)f2bf(bf1(qs[tau * QP + d]) * eq), kb = (bf16)f2bf(bf1(ks[tau * QP + d]) * ek);
              qs[tau * QP + d] = qb; ks[tau * QP + d] = kb; kT[d * SP + tau] = kb; } }
        LDS_BAR();
        { const f32x4 gm = *(const LAS f32x4*)(gmid + 16 * wave + 4 * fq);
#pragma unroll
          for (int vt = 0; vt < 8; ++vt) { S[vt] = S[vt] * gm; u32x2 o; o.x = pk2(S[vt][0], S[vt][1]); o.y = pk2(S[vt][2], S[vt][3]); *(LAS u32x2*)(sT + (16 * vt + fr) * QP + 16 * wave + 4 * fq) = o; } }
        { const int tt = wave >> 1;
#pragma unroll
          for (int u = 0; u < 2; ++u) { const int sg = 2 * (wave & 1) + u; f32x4 acc = (f32x4){0.f, 0.f, 0.f, 0.f};
              if (sg <= tt) {
#pragma unroll
                  for (int kq = 0; kq < 4; ++kq) { const bf16x8 af = *(const LAS bf16x8*)(ks + (16 * sg + fr) * QP + 32 * kq + 8 * fq), bfm = *(const LAS bf16x8*)(qs + (16 * tt + fr) * QP + 32 * kq + 8 * fq);
                      acc = __builtin_amdgcn_mfma_f32_16x16x32_bf16(af, bfm, acc, 0, 0, 0); }
                  if (sg == tt) {
#pragma unroll
                      for (int j = 0; j < 4; ++j) if (4 * fq + j > fr) acc[j] = 0.f; }
              }
              u32x2 o; o.x = pk2(acc[0], acc[1]); o.y = pk2(acc[2], acc[3]); *(LAS u32x2*)(pl + (16 * tt + fr) * SP + 16 * sg + 4 * fq) = o; } }
        LDS_BAR();
#pragma unroll
        for (int tt = 0; tt < 4; ++tt) { f32x4 acc = (f32x4){0.f, 0.f, 0.f, 0.f};
#pragma unroll
            for (int kq = 0; kq < 2; ++kq) { const bf16x8 af = *(const LAS bf16x8*)(vT + (16 * wave + fr) * SP + 32 * kq + 8 * fq), bfm = *(const LAS bf16x8*)(pl + (16 * tt + fr) * SP + 32 * kq + 8 * fq);
                acc = __builtin_amdgcn_mfma_f32_16x16x32_bf16(af, bfm, acc, 0, 0, 0); }
#pragma unroll
            for (int kq = 0; kq < 4; ++kq) { const bf16x8 af = *(const LAS bf16x8*)(sT + (16 * wave + fr) * QP + 32 * kq + 8 * fq), bfm = *(const LAS bf16x8*)(qs + (16 * tt + fr) * QP + 32 * kq + 8 * fq);
                acc = __builtin_amdgcn_mfma_f32_16x16x32_bf16(af, bfm, acc, 0, 0, 0); }
            const int row = chain_row(dir, b, s0 + 16 * tt + fr);
            u32x2 o; o.x = pk2(acc[0], acc[1]); o.y = pk2(acc[2], acc[3]); *(u32x2*)(OB + ((size_t)dir * MALL + row) * BW + h * 128 + 16 * wave + 4 * fq) = o; }
        { const f32x4 ge = *(const LAS f32x4*)(gend + 16 * wave + 4 * fq);
#pragma unroll
          for (int kq = 0; kq < 2; ++kq) { const bf16x8 af = *(const LAS bf16x8*)(kT + (16 * wave + fr) * SP + 32 * kq + 8 * fq);
#pragma unroll
              for (int vt = 0; vt < 8; ++vt) { const bf16x8 bfm = *(const LAS bf16x8*)(vT + (16 * vt + fr) * SP + 32 * kq + 8 * fq); S[vt] = __builtin_amdgcn_mfma_f32_16x16x32_bf16(af, bfm, S[vt], 0, 0, 0); } }
#pragma unroll
          for (int vt = 0; vt < 8; ++vt) S[vt] = S[vt] * ge; }
        LDS_BAR();
    }
}
__device__ __forceinline__ void hgrn_chain(KArgs a, int l, int cid, LAS unsigned char* lds) {
    const int tid = tid_fresh();
    unsigned char* ws = a->ws;
    const bf16* P = (const bf16*)(ws + WS_P); bf16* OB = (bf16*)(ws + WS_OB);
    const int dir = cid / 48, b = (cid % 48) / 6, h = cid % 6;
    LAS float* tq = (LAS float*)lds;
    LAS float* tk = tq + 16 * 128;
    LAS float* tf = tk + 16 * 128;
    LAS float* tv = tf + 16 * 128;
    LAS float* ot = tv + 16 * 128;
    const int v = tid >> 2, q = tid & 3;
    float S[32];
#pragma unroll
    for (int j = 0; j < 32; ++j) S[j] = 0.f;
    const int sst = tid >> 5, sc4 = (tid & 31) * 4;
    float lb[4];
#pragma unroll
    for (int j = 0; j < 4; ++j) { const int ch = h * 128 + sc4 + j;
        if (l == 0) lb[j] = 0.f; else { const float l0 = a->in[I_LB][((size_t)dir * DEPTH + 0) * BW + ch], l1 = a->in[I_LB][((size_t)dir * DEPTH + 1) * BW + ch]; lb[j] = 1.0f / (1.0f + __expf(l0 - l1)); } }
    for (int s0 = 0; s0 < CTXL + T; s0 += 16) {
        { const int row = chain_row(dir, b, s0 + sst); const bf16* pr = P + (size_t)row * INC + h * 128 + sc4;
          const u32x2 pq = *(const u32x2*)(pr + OFF_Q), pi = *(const u32x2*)(pr + OFF_I), pz = *(const u32x2*)(pr + (dir ? OFF_ZB : OFF_ZF));
          const float qf[4] = {bflo(pq.x), bfhi(pq.x), bflo(pq.y), bfhi(pq.y)}, vf[4] = {bflo(pi.x), bfhi(pi.x), bflo(pi.y), bfhi(pi.y)}, zf[4] = {bflo(pz.x), bfhi(pz.x), bflo(pz.y), bfhi(pz.y)};
          f32x4 oq, ok, of, ov;
#pragma unroll
          for (int j = 0; j < 4; ++j) { const float f = lb[j] + (1.0f - lb[j]) * sigmoidf_(zf[j]); oq[j] = siluf_(qf[j]); of[j] = f; ok[j] = 1.0f - f; ov[j] = vf[j]; }
          *(LAS f32x4*)(tq + sst * 128 + sc4) = oq; *(LAS f32x4*)(tk + sst * 128 + sc4) = ok; *(LAS f32x4*)(tf + sst * 128 + sc4) = of; *(LAS f32x4*)(tv + sst * 128 + sc4) = ov; }
        LDS_BAR();
        for (int st = 0; st < 16; ++st) {
            const float vv = tv[st * 128 + v]; float o0 = 0.f, o1 = 0.f;
#pragma unroll
            for (int j = 0; j < 8; ++j) { const f32x4 fq4 = *(const LAS f32x4*)(tf + st * 128 + q * 32 + 4 * j), kq4 = *(const LAS f32x4*)(tk + st * 128 + q * 32 + 4 * j), qq4 = *(const LAS f32x4*)(tq + st * 128 + q * 32 + 4 * j);
#pragma unroll
                for (int i = 0; i < 4; ++i) { const float sn = fq4[i] * S[4 * j + i] + kq4[i] * vv; S[4 * j + i] = sn; if (i & 1) o1 += qq4[i] * sn; else o0 += qq4[i] * sn; } }
            float o = o0 + o1; o += dpp_xor1(o); o += dpp_xor2(o);
            if (q == 0) ot[st * 128 + v] = o;
        }
        LDS_BAR();
        if (tid < 256) { const int st = tid >> 4, part = tid & 15; const int row = chain_row(dir, b, s0 + st); const LAS float* op = ot + st * 128 + part * 8;
            float f[8];
#pragma unroll
            for (int j = 0; j < 8; ++j) f[j] = op[j];
            *(u32x4*)(OB + ((size_t)dir * MALL + row) * BW + h * 128 + part * 8) = pack8(f); }
    }
    LDS_BAR();
}

__device__ __forceinline__ float grp_sum32(float v) { v += __shfl_xor(v, 1); v += __shfl_xor(v, 2); v += __shfl_xor(v, 4); v += __shfl_xor(v, 8); v += __shfl_xor(v, 16); return v; }
__device__ __forceinline__ float grp_sum16(float v) { v += __shfl_xor(v, 1); v += __shfl_xor(v, 2); v += __shfl_xor(v, 4); v += __shfl_xor(v, 8); return v; }
__device__ __forceinline__ void phase_finalize(KArgs a, int l, bool dry) {
    const int tid_ = tid_fresh(); const int lane = tid_ & 63, wave = tid_ >> 6, gw = blockIdx.x * 8 + wave, NGW = gridDim.x * 8;
    unsigned char* ws = a->ws;
    const bf16* P = (const bf16*)(ws + WS_P); const bf16* OB = (const bf16*)(ws + WS_OB); const bf16* OC = (const bf16*)(ws + WS_OC); bf16* Y = (bf16*)(ws + WS_Y);
    unsigned char* Yo = dry ? ws + WS_END : ws + WS_Y8;
    const int nrows = (l == DEPTH - 1) ? NLAT : MALL;
    const int rpw = (nrows + NGW - 1) / NGW; const int r0 = gw * rpw, r1 = (r0 + rpw < nrows) ? r0 + rpw : nrows;
    f32x4 hng[3], gng[3], gnb[3];
#pragma unroll
    for (int k = 0; k < 3; ++k) { const int c = 256 * k + 4 * lane; hng[k] = *(const f32x4*)(a->in[I_HNG] + (size_t)l * BW + c);
        gng[k] = *(const f32x4*)(a->in[I_GNGG] + (size_t)l * CW + c); gnb[k] = *(const f32x4*)(a->in[I_GNB] + (size_t)l * CW + c); }
    for (int row = r0; row < r1; ++row) {
        const int orow = dry ? (row & 2047) : row;
        u32x2 bf_[3], bb_[3], bg_[3], cf_[3], cb_[3], cv_[3], cg_[3];
#pragma unroll
        for (int k = 0; k < 3; ++k) { const int c = 256 * k + 4 * lane;
            bf_[k] = *(const u32x2*)(OB + (size_t)row * BW + c); bb_[k] = *(const u32x2*)(OB + ((size_t)MALL + row) * BW + c); bg_[k] = *(const u32x2*)(P + (size_t)row * INC + OFF_OG + c);
            cf_[k] = *(const u32x2*)(OC + (size_t)row * CW + c); cb_[k] = *(const u32x2*)(OC + ((size_t)MALL + row) * CW + c);
            cv_[k] = *(const u32x2*)(Y + (size_t)row * D + 512 + c);
            cg_[k] = *(const u32x2*)(Y + (size_t)row * D + 1280 + c); }
#pragma unroll
        for (int k = 0; k < 3; ++k) { const int c = 256 * k + 4 * lane;
            { float o[4] = {bflo(bf_[k].x) + bflo(bb_[k].x), bfhi(bf_[k].x) + bfhi(bb_[k].x), bflo(bf_[k].y) + bflo(bb_[k].y), bfhi(bf_[k].y) + bfhi(bb_[k].y)};
              const float ss = grp_sum32((o[0] * o[0] + o[1] * o[1]) + (o[2] * o[2] + o[3] * o[3])); const float rstd = 1.0f / sqrtf(ss * (1.0f / 128.0f) + NORM_EPS);
              const float g4[4] = {bflo(bg_[k].x), bfhi(bg_[k].x), bflo(bg_[k].y), bfhi(bg_[k].y)}; float y[4];
#pragma unroll
              for (int j = 0; j < 4; ++j) y[j] = o[j] * rstd * hng[k][j] * sigmoidf_(g4[j]);
              *(unsigned*)(Yo + (size_t)orow * D + 512 + c) = pk4_fp8(y[0], y[1], y[2], y[3]); }
            { float o[4] = {bflo(cf_[k].x) + bflo(cb_[k].x), bfhi(cf_[k].x) + bfhi(cb_[k].x), bflo(cf_[k].y) + bflo(cb_[k].y), bfhi(cf_[k].y) + bfhi(cb_[k].y)};
              const float v4[4] = {bflo(cv_[k].x), bfhi(cv_[k].x), bflo(cv_[k].y), bfhi(cv_[k].y)}, g4[4] = {bflo(cg_[k].x), bfhi(cg_[k].x), bflo(cg_[k].y), bfhi(cg_[k].y)};
              const float mean = grp_sum16((o[0] + o[1]) + (o[2] + o[3])) * (1.0f / 64.0f);
              float dl[4]; float sq = 0.f;
#pragma unroll
              for (int j = 0; j < 4; ++j) { dl[j] = o[j] - mean; sq += dl[j] * dl[j]; }
              const float var = grp_sum16(sq) * (1.0f / 64.0f); const float rs = 1.0f / sqrtf(var + GN_EPS); float y[4];
#pragma unroll
              for (int j = 0; j < 4; ++j) y[j] = (dl[j] * rs * gng[k][j] + gnb[k][j] + v4[j]) * g4[j];
              *(unsigned*)(Yo + (size_t)orow * D + 1280 + c) = pk4_fp8(y[0], y[1], y[2], y[3]); }
        }
    }
}

__global__ void __launch_bounds__(NTHREADS, 2) mk_fwd(Args args_unused) {
    extern __shared__ __attribute__((aligned(16))) unsigned char lds_raw[];
    LAS unsigned char* lds = (LAS unsigned char*)lds_raw;
    volatile LAS unsigned* misc = (volatile LAS unsigned*)(lds + LDS_MISC);
    const int tid = threadIdx.x, G = gridDim.x;
    if (tid < 64) misc[tid] = 0u;
    __syncthreads();
    XcdBarrier bar; bar.bar = nullptr; bar.x = 0; bar.st = nullptr;
    int lo, hi;
    { KArgs a = kargs(); lo = a->ph_lo; hi = a->ph_hi; unsigned* ctl = (unsigned*)(a->ws + WS_CTL); bar.bar = ctl + CW_BAR; if (!MK_MULTI) bar = xcd_barrier_post(ctl + CW_BAR, misc + 8); }
    const int cvirt = (G % 8 == 0) ? ((int)blockIdx.x % 8) * (G / 8) + (int)blockIdx.x / 8 : (int)blockIdx.x;
#define IN(k) (lo <= (k) && (k) < hi)
#define PM(b) ((PHMASK >> (b)) & 1)
#define REP(b) _Pragma("unroll 1") for (int rep_ = 0; rep_ < 1 + ((PROBE_DUP >> (b)) & 1); ++rep_)
#define SEAM(k) do { if (!MK_MULTI && IN(k) && IN((k) + 1)) { xcd_barrier(bar); if ((PROBE_DUP >> 13) & 1) xcd_barrier(bar); } } while (0)

    if (PM(0) && IN(0)) REP(0) { phase_prologue(kargs(), lds); } SEAM(0);

#pragma unroll 1
    for (int l = 0; l < DEPTH; ++l) {
        const int pb = 1 + 9 * l;
        const bool lastl = (l == DEPTH - 1);
        if (PM(1) && IN(pb + 0)) { if ((PROBE_DUP >> 1) & 1) { if (l == 0) phase_norm1<0>(kargs(), l, true); else phase_norm1<1>(kargs(), l, true); } if (l == 0) phase_norm1<0>(kargs(), l, false); else { phase_norm1<1>(kargs(), l, false); __syncthreads(); convert_moe(kargs(), l, lds); __syncthreads(); } } SEAM(pb + 0);
        if (PM(2) && IN(pb + 1)) REP(2) {
            KArgs a = kargs(); unsigned char* ws = a->ws;
            pg8::Gemm g{(const bf16*)(ws + WS_H), (const bf16*)(ws + WS_WIN + (size_t)l * INC * D), MALL, INC, D / 2};
            pg8::StaticOrder S; S.init(MALL, INC, G, (int)blockIdx.x);
            pg8::EpiBf16 E{(bf16*)(ws + WS_P), INC};
            pg8::gemm_phase8<pg8::EpiBf16, pg8::StaticOrder, false, false>(lds, g, S, E, nullptr);
        } SEAM(pb + 1);
        if (PM(3) && IN(pb + 2)) {
            const int ngm = lastl ? 1024 : 1088;
            unsigned* qhead = (unsigned*)(kargs()->ws + WS_CTL) + CW_PREPQ + 64 * l;
            const int n_rw = 544 * 3, n_hg = 3264, n_all = (G == 256) ? n_rw + n_hg : n_rw + n_hg + ngm;
            for (;;) {
                if (threadIdx.x == 0) misc[16] = __hip_atomic_fetch_add(qhead, 1u, __ATOMIC_RELAXED, __HIP_MEMORY_SCOPE_AGENT);
                __syncthreads();
                const int it = (int)misc[16];
                if (it >= n_all) break;
                if (it < n_rw) { _Pragma("unroll 1") for (int r2 = 0; r2 < 1 + ((PROBE_DUP >> 15) & 1); ++r2) rwkv_prep_item(kargs(), l, it / 3, it % 3, lds); }
                else if (it < n_rw + n_hg) { if ((PROBE_DUP >> 16) & 1) hgrn_prep_item(kargs(), l, it - n_rw, lds, true); hgrn_prep_item(kargs(), l, it - n_rw, lds, false); }
                else { _Pragma("unroll 1") for (int r2 = 0; r2 < 1 + ((PROBE_DUP >> 14) & 1); ++r2) gmlp_item(kargs(), l, it - n_rw - n_hg, lds); }
            }
            __syncthreads();
        } SEAM(pb + 2);
        if (PM(4) && IN(pb + 3)) REP(4) {
            if (G == 256) { const int bx = blockIdx.x;
                if (bx < 96) { _Pragma("unroll 1") for (int r2 = 0; r2 < 1 + ((PROBE_DUP >> 12) & 1); ++r2) rwkv_chain_mfma(kargs(), bx * 8, lds); }
                else if (bx < 192) { _Pragma("unroll 1") for (int r2 = 0; r2 < 1 + ((PROBE_DUP >> 11) & 1); ++r2) hgrn_chain_lean(kargs(), bx - 96, lds); }
                if (bx < 96 || bx >= 192) {
                    unsigned* gq = (unsigned*)(kargs()->ws + WS_CTL) + CW_GMQ + 64 * l; const int ngm2 = lastl ? 1024 : 1088;
                    for (;;) { if (threadIdx.x == 0) misc[17] = __hip_atomic_fetch_add(gq, 1u, __ATOMIC_RELAXED, __HIP_MEMORY_SCOPE_AGENT);
                        __syncthreads(); const int it = (int)misc[17]; if (it >= ngm2) break; gmlp_item(kargs(), l, it, lds); }
                    __syncthreads(); } }
            else { for (int it = blockIdx.x; it < 192; it += G) { if (it < 96) rwkv_chain_mfma(kargs(), it * 8, lds); else hgrn_chain_lean(kargs(), it - 96, lds); } }
        } SEAM(pb + 3);
        if (PM(5) && IN(pb + 4)) { if ((PROBE_DUP >> 5) & 1) phase_finalize(kargs(), l, true); phase_finalize(kargs(), l, false); } SEAM(pb + 4);
        if (PM(6) && IN(pb + 5)) REP(6) {
            KArgs a = kargs(); unsigned char* ws = a->ws;
            const int Mo = lastl ? NLAT : MALL;
            pg8::Gemm g{(const bf16*)(ws + WS_Y8), (const bf16*)(ws + WS_WOUT + (size_t)l * D * D), Mo, D, D / 2};
            pg8::StaticOrder S; S.init(Mo, D, G, (int)blockIdx.x);
            const float* xl = l == 0 ? a->in[I_X] : (const float*)(ws + WS_X); const float* xc = l == 0 ? a->in[I_CTX] : (const float*)(ws + WS_X) + (size_t)NLAT * D;
            pg8::EpiResid E{xl, xc, (float*)(ws + WS_X), (const float*)(ws + WS_MOD) + (size_t)l * 9 * 12288 + 2 * D};
            pg8::gemm_phase8<pg8::EpiResid, pg8::StaticOrder, true, false>(lds, g, S, E, nullptr);
        } SEAM(pb + 5);
        if (PM(7) && IN(pb + 6)) { if ((PROBE_DUP >> 7) & 1) phase_norm2_router(kargs(), l, true, lds); phase_norm2_router(kargs(), l, false, lds); } SEAM(pb + 6);
        if (PM(8) && IN(pb + 7)) REP(8) {
            KArgs a = kargs(); unsigned char* ws = a->ws;
            moe_tables<false>(a, l, lds, cvirt);
            pg8::Gemm g{(const bf16*)(ws + WS_H), (const bf16*)(ws + WS_WGU), 0, 2048, D / 2};
            pg8::MoeOrder S{(const LAS int*)(lds + LDS_TP), G, cvirt, (unsigned)(2048 * D)};
            pg8::EpiSwiglu E{ws + WS_ACT};
            pg8::gemm_phase8<pg8::EpiSwiglu, pg8::MoeOrder, false, true>(lds, g, S, E, (const LAS unsigned*)(lds + LDS_TAB));
        } SEAM(pb + 7);
        if (PM(9) && IN(pb + 8)) REP(9) {
            KArgs a = kargs(); unsigned char* ws = a->ws;
            moe_tables<true>(a, l, lds, cvirt);
            pg8::Gemm g{(const bf16*)(ws + WS_ACT), (const bf16*)(ws + WS_WDN), 0, D, DE / 2};
            pg8::MoeOrder S{(const LAS int*)(lds + LDS_TP), G, cvirt, (unsigned)(D * DE)};
            pg8::EpiDown E{(bf16*)(ws + WS_YK), (const LAS unsigned*)(lds + LDS_TAB), (const LAS float*)(lds + LDS_TABW)};
            pg8::gemm_phase8<pg8::EpiDown, pg8::MoeOrder, false, false>(lds, g, S, E, nullptr);
        } SEAM(pb + 8);
    }
    if (PM(10) && IN(1 + 9 * DEPTH)) { if ((PROBE_DUP >> 10) & 1) phase_norm1<2>(kargs(), DEPTH, true); phase_norm1<2>(kargs(), DEPTH, false); }
#undef IN
#undef SEAM
}

extern "C" void kernel_launch(void* const* d_in, const int* in_sizes, int n_in, void* d_out, int out_size, void* d_ws, size_t ws_size, hipStream_t stream) {
    static int grid = 0;
    if (grid == 0) {
        if (n_in != 31 || ws_size < WS_END) { fprintf(stderr, "kernel_launch: unexpected n_in %d / ws %zu (need %zu)\n", n_in, ws_size, (size_t)WS_END); grid = -1; return; }
        int dev = 0, cus = 0, per_cu = 0;
        hipGetDevice(&dev); hipDeviceGetAttribute(&cus, hipDeviceAttributeMultiprocessorCount, dev);
        if (hipFuncSetAttribute((const void*)mk_fwd, hipFuncAttributeMaxDynamicSharedMemorySize, LDS_BYTES) != hipSuccess) { fprintf(stderr, "kernel_launch: hipFuncSetAttribute failed\n"); grid = -1; return; }
        if (hipOccupancyMaxActiveBlocksPerMultiprocessor(&per_cu, (const void*)mk_fwd, NTHREADS, LDS_BYTES) != hipSuccess || per_cu < 1) fprintf(stderr, "kernel_launch: occupancy query says %d\n", per_cu);
        (void)hipGetLastError();
        grid = cus > 0 ? cus : 256;
    }
    if (grid < 0) return;
    hipMemsetAsync((char*)d_ws + WS_CTL, 0, CTL_ZERO_BYTES, stream);
    Args a{};
    for (int i = 0; i < 31; ++i) a.in[i] = (const float*)d_in[i];
    a.out = (float*)d_out; a.ws = (unsigned char*)d_ws;
    constexpr int NPH = 2 + 9 * DEPTH;
#if MK_MULTI
    for (int p = 0; p < NPH; ++p) { a.ph_lo = p; a.ph_hi = p + 1; hipLaunchKernelGGL(mk_fwd, dim3(grid), dim3(NTHREADS), LDS_BYTES, stream, a); }
#else
    a.ph_lo = 0; a.ph_hi = NPH; hipLaunchKernelGGL(mk_fwd, dim3(grid), dim3(NTHREADS), LDS_BYTES, stream, a);
#endif
}
```

```cpp
#include <hip/hip_runtime.h>
#include <cstdio>
#include <cstdint>

#ifndef PHMASK
#define PHMASK 0xFFFF
#endif
#ifndef PROBE_DUP
#define PROBE_DUP 0
#endif
#ifndef MK_MULTI
#define MK_MULTI 0
#endif

#define GAS __attribute__((address_space(1)))
#define LAS __attribute__((address_space(3)))
typedef unsigned short bf16;
typedef short bf16x8 __attribute__((ext_vector_type(8)));
typedef float f32x4 __attribute__((ext_vector_type(4)));
typedef float f32x2 __attribute__((ext_vector_type(2)));
typedef unsigned u32x4 __attribute__((ext_vector_type(4)));
typedef unsigned u32x2 __attribute__((ext_vector_type(2)));

constexpr int D = 2048, NB = 8, T = 4096, CTXL = 256, DEPTH = 2;
constexpr int NLAT = NB * T, NCTX = NB * CTXL, MALL = NLAT + NCTX;
constexpr int INC = 7424;
constexpr int OFF_U = 0, OFF_V = 512, OFF_Q = 1024, OFF_I = 1792, OFF_ZF = 2560, OFF_ZB = 3328, OFF_OG = 4096;
constexpr int OFF_C = 4864;
constexpr int BW = 768, CW = 768, CCOLS = 2560;
constexpr int NE = 16, DE = 1024;
constexpr int PC2W = 7 * 768;
constexpr int NTHREADS = 512;
constexpr float NORM_EPS = 1e-6f, GN_EPS = 64e-5f, DECAY_SCALE = 0.60653065971263342f;

constexpr size_t MiB = 1u << 20;
constexpr size_t WS_CTL = 0, CTL_ZERO_BYTES = 1 * MiB;
constexpr size_t WS_MOD = 1 * MiB;
constexpr size_t WS_SMALLW = 2 * MiB;
constexpr size_t SW_WUP = 0, SW_AUP = SW_WUP + (size_t)2 * 2 * 768 * 64 * 2, SW_GUP = SW_AUP + (size_t)2 * 768 * 64 * 2, SW_GWS = SW_GUP + (size_t)2 * 768 * 128 * 2;
constexpr size_t WS_WIN = 4 * MiB, WS_WOUT = 62 * MiB, WS_WGU = 78 * MiB, WS_WDN = 142 * MiB, WS_Y8 = 174 * MiB;
constexpr size_t WS_X = 270 * MiB, WS_H = 542 * MiB, WS_Y = 678 * MiB, WS_P = 814 * MiB, WS_PRE = 1307 * MiB, WS_VT = 1817 * MiB, WS_OC = 1868 * MiB, WS_HQB = 1970 * MiB, WS_HG = 2021 * MiB, WS_END = 2028 * MiB;
constexpr int PRE_REC = 10240, PR_WP = 0, PR_RP = 2048, PR_BK = 4096, PR_ARBK = 8192, PR_MAK = 9216, PR_GAM = 9728, NCHUNK16 = 272;
constexpr size_t WS_OB = WS_H;
constexpr size_t WS_ACT = WS_P, WS_YK = WS_P + 144 * MiB, WS_RIDX = WS_P + 416 * MiB, WS_RW = WS_RIDX + 3 * MiB;
static_assert(WS_RW + 3 * MiB <= WS_PRE, "moe overlay");
constexpr int MAXSLOT_TILES = 288;
constexpr int CW_BAR = 4096;
constexpr int CW_GMQ = 30720;
constexpr int CW_PREPQ = 28672;
constexpr int CW_CNT = 16384;

constexpr int LDS_STAGE = 0, LDS_TAB = 131072, LDS_TABW = LDS_TAB + 9 * 1024, LDS_TP = LDS_TABW + 9 * 1024, LDS_MISC = 150528, LDS_BYTES = 152 * 1024;
static_assert(LDS_TP + 128 <= LDS_MISC, "lds map");

typedef __bf16 bf16x2_t __attribute__((ext_vector_type(2)));
__device__ __forceinline__ unsigned pk2(float lo, float hi) { const f32x2 v = {lo, hi}; return __builtin_bit_cast(unsigned, __builtin_convertvector(v, bf16x2_t)); }
__device__ __forceinline__ unsigned f2bf(float f) { return pk2(f, f) & 0xffffu; }
__device__ __forceinline__ unsigned pk4_fp8(float a, float b, float c, float d) {
    a = __builtin_amdgcn_fmed3f(a, -448.f, 448.f); b = __builtin_amdgcn_fmed3f(b, -448.f, 448.f); c = __builtin_amdgcn_fmed3f(c, -448.f, 448.f); d = __builtin_amdgcn_fmed3f(d, -448.f, 448.f);
    int p = 0; p = __builtin_amdgcn_cvt_pk_fp8_f32(a, b, p, false); p = __builtin_amdgcn_cvt_pk_fp8_f32(c, d, p, true); return (unsigned)p; }
__device__ __forceinline__ float bflo(unsigned u) { return __builtin_bit_cast(float, u << 16); }
__device__ __forceinline__ float bfhi(unsigned u) { return __builtin_bit_cast(float, u & 0xffff0000u); }
__device__ __forceinline__ float bf1(bf16 b) { return __builtin_bit_cast(float, ((unsigned)b) << 16); }
__device__ __forceinline__ float sigmoidf_(float x) { return __builtin_amdgcn_rcpf(1.0f + __expf(-x)); }
__device__ __forceinline__ float siluf_(float x) { return x * __builtin_amdgcn_rcpf(1.0f + __expf(-x)); }
__device__ __forceinline__ float geluf_(float v) {
    const float av = fabsf(v), t = __builtin_amdgcn_rcpf(av * 0.2316418882f + 1.0f);
    float q = t * 0.5307027145f + (-0.7265760135f); q = q * t + 0.7107068705f; q = q * t + (-0.142248368f); q = q * t + 0.127414796f; q = q * t;
    const float e = __builtin_amdgcn_exp2f((v * v) * (-0.72134752044f)); const float m = v * (q * e); return v < 0.f ? m : v - m; }
__device__ __forceinline__ float wave_sum(float v) {
#pragma unroll
    for (int o = 1; o < 64; o <<= 1) v += __shfl_xor(v, o);
    return v;
}
__device__ __forceinline__ int tid_fresh() { int t = threadIdx.x; asm volatile("" : "+v"(t)); return t; }
__device__ __forceinline__ void unpack8(const u32x4 v, float (&f)[8]) {
    f[0] = bflo(v.x); f[1] = bfhi(v.x); f[2] = bflo(v.y); f[3] = bfhi(v.y); f[4] = bflo(v.z); f[5] = bfhi(v.z); f[6] = bflo(v.w); f[7] = bfhi(v.w);
}
__device__ __forceinline__ u32x4 pack8(const float (&f)[8]) { u32x4 v; v.x = pk2(f[0], f[1]); v.y = pk2(f[2], f[3]); v.z = pk2(f[4], f[5]); v.w = pk2(f[6], f[7]); return v; }
__device__ __forceinline__ int modrow_of(int row) { return row < NLAT ? (row >> 12) : 8; }

#define XB_TMO      128
#define XB_XCNT(j)  (256  + 64 * (j))
#define XB_XSUB(j)  (1280 + 64 * (j))
#define XB_XGEN(j)  (2304 + 64 * (j))
#define XB_TOP      3328
#define XB_TOPGEN   3392
#define XCD_BAR_WORDS 3456
#define XB_SPIN_CAP (1u << 18)
__device__ __forceinline__ unsigned xb_ld(unsigned* p)              { return __hip_atomic_load(p, __ATOMIC_RELAXED, __HIP_MEMORY_SCOPE_AGENT); }
__device__ __forceinline__ unsigned xb_add(unsigned* p, unsigned v) { return __hip_atomic_fetch_add(p, v, __ATOMIC_RELAXED, __HIP_MEMORY_SCOPE_AGENT); }
__device__ __forceinline__ unsigned xb_xcc_id() { return (unsigned)__builtin_amdgcn_s_getreg((3 << 11) | 20) & 0xFu; }
#define XB_SPIN(cond, bar) do { unsigned _sp = 0; while (cond) { __builtin_amdgcn_s_sleep(1); \
    if ((++_sp & 255u) == 0u) { if (xb_ld(&(bar)[XB_TMO])) break; if (_sp > XB_SPIN_CAP) { atomicAdd(&(bar)[XB_TMO], 1u); break; } } } } while (0)
struct XcdBarrier { unsigned* bar; unsigned x; volatile LAS unsigned* st; };
__device__ __forceinline__ XcdBarrier xcd_barrier_post(unsigned* bar, volatile LAS unsigned* st) {
    XcdBarrier b; b.bar = bar; b.x = xb_xcc_id(); b.st = st;
    if (threadIdx.x == 0) (void)xb_add(&bar[XB_XCNT(b.x)], 1u);
    return b;
}
__device__ __forceinline__ void xcd_barrier_complete(unsigned* bar, unsigned x, unsigned& nloc, unsigned& nx) {
    const unsigned G = gridDim.x * gridDim.y * gridDim.z;
    unsigned sum, cnt, mine, sp = 0u;
    for (;;) {
        sum = 0u; cnt = 0u; mine = 0u;
#pragma unroll
        for (unsigned j = 0; j < 16; ++j) { const unsigned c = xb_ld(&bar[XB_XCNT(j)]); sum += c; cnt += (c > 0u) ? 1u : 0u; mine = (j == x) ? c : mine; }
        if (sum == G) break;
        __builtin_amdgcn_s_sleep(1);
        if ((++sp & 255u) == 0u) { if (xb_ld(&bar[XB_TMO])) break; if (sp > XB_SPIN_CAP) { atomicAdd(&bar[XB_TMO], 1u); break; } }
    }
    nloc = mine > 0u ? mine : 1u; nx = cnt > 0u ? cnt : 1u;
}
__device__ __forceinline__ void xcd_barrier(const XcdBarrier& b) {
    asm volatile("s_waitcnt vmcnt(0)" ::: "memory");
    __syncthreads();
    if (threadIdx.x == 0) {
        unsigned* bar = b.bar;
        __builtin_amdgcn_s_waitcnt(0);
        unsigned nloc = b.st[0], nx = b.st[1];
        if (nloc == 0u) { xcd_barrier_complete(bar, b.x, nloc, nx); b.st[0] = nloc; b.st[1] = nx; }
        const unsigned old = xb_add(&bar[XB_XSUB(b.x)], 1u);
        const unsigned gen = old / nloc;
        if (old + 1u == (gen + 1u) * nloc) {
            __builtin_amdgcn_fence(__ATOMIC_RELEASE, "agent");
            asm volatile("s_waitcnt vmcnt(0)" ::: "memory");
            const unsigned og = xb_add(&bar[XB_TOP], 1u);
            const unsigned tg = og / nx;
            if (og + 1u == (tg + 1u) * nx) xb_add(&bar[XB_TOPGEN], 1u);
            else XB_SPIN(xb_ld(&bar[XB_TOPGEN]) == tg, bar);
            __builtin_amdgcn_fence(__ATOMIC_ACQUIRE, "agent");
            xb_add(&bar[XB_XGEN(b.x)], 1u);
            asm volatile("s_waitcnt vmcnt(0)" ::: "memory");
        } else {
            XB_SPIN(xb_ld(&bar[XB_XGEN(b.x)]) == gen, bar);
            __builtin_amdgcn_fence(__ATOMIC_ACQUIRE, "agent");
            asm volatile("s_waitcnt vmcnt(0)" ::: "memory");
        }
    }
    __syncthreads();
}

namespace pg8 {
constexpr int BM = 256, BK = 64, HALF = 128, HTB = HALF * BK * 2, STAGE_BYTES = 8 * HTB, NXCD = 8, WGM = 8;
__host__ __device__ __forceinline__ int lds_byte(int r, int c) { const int st = (r >> 4) * 2 + (c >> 5), rr = r & 15, cc = c & 31, ob = rr * 64 + cc * 2; return st * 1024 + (ob ^ (((ob >> 9) & 1) << 5)); }
__host__ __device__ __forceinline__ void stage_rc(int b, int& R, int& C) { const int st = b / 1024, sb = b % 1024, swz = sb ^ (((sb >> 9) & 1) << 5); R = (st >> 1) * 16 + swz / 64; C = (st & 1) * 32 + (swz % 64) / 2; }
__host__ __device__ __forceinline__ int perm32(int rho) { const int n = rho >> 4, i = rho & 15; return 8 * (i >> 2) + 4 * n + (i & 3); }

struct Unit { int pm, pn, e, aux; };
struct Gemm { const bf16* A; const bf16* Bt; int M, N, K; };

struct StaticOrder {
    int nM, nN, nwg, G, c;
    __device__ void init(int M, int N, int G_, int c_) { nM = M / BM; nN = N / BM; nwg = nM * nN; G = G_; c = c_; }
    __device__ bool next(int i, Unit& u) const {
        const long L = (long)i * G + c; if (L >= nwg) return false;
        int wgid = (int)L; { const int q = nwg / NXCD, r = nwg % NXCD, xcd = wgid % NXCD, off = wgid / NXCD; wgid = (xcd < r ? xcd * (q + 1) : r * (q + 1) + (xcd - r) * q) + off; }
        const int nig = WGM * nN, gid = wgid / nig, fm = gid * WGM, gsz = (nM - fm) < WGM ? (nM - fm) : WGM;
        u.pm = fm + ((wgid % nig) % gsz); u.pn = (wgid % nig) / gsz; u.e = 0; u.aux = 0; return true;
    }
    __device__ __forceinline__ unsigned b_off(const Unit& u, unsigned tstep) const { return (unsigned)u.pn * tstep; }
};
struct MoeOrder {
    const LAS int* tp; int G, c; unsigned estride;
    __device__ bool next(int i, Unit& u) const {
        const int L = i * G + c; const int ntot = tp[16] * 8; if (L >= ntot) return false;
        const int tile = L >> 3; int e = 0;
#pragma unroll
        for (int j = 1; j < 16; ++j) e += (tile >= tp[j]) ? 1 : 0;
        u.pm = tile; u.pn = L & 7; u.e = e; u.aux = i; return true;
    }
    __device__ __forceinline__ unsigned b_off(const Unit& u, unsigned tstep) const { return (unsigned)u.e * estride + (unsigned)u.pn * tstep; }
};

#define PG8_LAS __attribute__((address_space(3)))
template <class Epi, class Sched, bool ALIGN_EPI, bool GATHER>
__device__ __forceinline__ void gemm_phase(PG8_LAS unsigned char* lds, const Gemm g, const Sched& S, const Epi& E, const PG8_LAS unsigned* tabA) {
    const int tid = tid_fresh(), wid = __builtin_amdgcn_readfirstlane(tid >> 6), lane = tid & 63, wr = wid >> 2, wc = wid & 3, fr = lane & 15, fq = lane >> 4;
    const int K = g.K, nt = K / BK;
    int sR[2], sC[2];
    unsigned voffB[2];
#pragma unroll
    for (int i = 0; i < 2; ++i) { int R, C; stage_rc(tid * 16 + i * 8192, R, C); sR[i] = R; sC[i] = C; const int Rb = Epi::PERM ? ((R & ~31) + perm32(R & 31)) : R;
        voffB[i] = (unsigned)(Rb * K + C) * 2u; }
    const unsigned kstep = (unsigned)(BK * 2);
    const unsigned hstep = (unsigned)(HALF * K * 2);
    const unsigned tstep = 2u * hstep;
    const unsigned ldsw = (unsigned)wid * 1024u;
    const char* const baseA = (const char*)g.A; const char* const baseB = (const char*)g.Bt;
    const int aoff = lds_byte(wr * 64 + fr, fq * 8), boff = lds_byte(wc * 32 + fr, fq * 8);
#define PG8_SA(b, h) (((b) * 2 + (h)) * HTB)
#define PG8_SB(b, h) ((4 + (b) * 2 + (h)) * HTB)
#define PG8_STAGE(bufoff, gbase, uoff, voff) do { _Pragma("unroll") for (int _i = 0; _i < 2; ++_i) \
        __builtin_amdgcn_global_load_lds((const unsigned*)((gbase) + (size_t)(unsigned)((uoff) + (voff)[_i])), (PG8_LAS unsigned*)(lds + (bufoff) + ldsw + _i * 8192), 16, 0, 0); } while (0)
#define PG8_LDA(dst, b, h) do { _Pragma("unroll") for (int m = 0; m < 4; ++m) _Pragma("unroll") for (int k = 0; k < 2; ++k) dst[m][k] = *(const PG8_LAS bf16x8*)(lds + PG8_SA(b, h) + aoff + m * 2048 + k * 1024); } while (0)
#define PG8_LDB(dst, b, h) do { _Pragma("unroll") for (int n = 0; n < 2; ++n) _Pragma("unroll") for (int k = 0; k < 2; ++k) dst[n][k] = *(const PG8_LAS bf16x8*)(lds + PG8_SB(b, h) + boff + n * 2048 + k * 1024); } while (0)
#define PG8_MMA(ai, bj, At, Bt) do { __builtin_amdgcn_s_setprio(1); _Pragma("unroll") for (int m = 0; m < 4; ++m) _Pragma("unroll") for (int n = 0; n < 2; ++n) _Pragma("unroll") for (int k = 0; k < 2; ++k) \
        acc[ai][bj][m][n] = __builtin_amdgcn_mfma_f32_16x16x32_bf16(Bt[n][k], At[m][k], acc[ai][bj][m][n], 0, 0, 0); __builtin_amdgcn_s_setprio(0); } while (0)
#define PG8_WAIT_V(n) asm volatile("s_waitcnt vmcnt(" #n ")" ::: "memory")
#define PG8_WAIT_L(n) asm volatile("s_waitcnt lgkmcnt(" #n ")" ::: "memory")
#define PG8_BAR __builtin_amdgcn_s_barrier()
#define PG8_SCHED __builtin_amdgcn_sched_barrier(0)
    Unit cur, nxt; int ui = 0;
    if (!S.next(0, cur)) return;
    f32x4 acc[2][2][4][2];
#pragma unroll
    for (int a = 0; a < 2; ++a)
#pragma unroll
        for (int b = 0; b < 2; ++b)
#pragma unroll
            for (int m = 0; m < 4; ++m)
#pragma unroll
                for (int n = 0; n < 2; ++n) acc[a][b][m][n] = (f32x4){0.f, 0.f, 0.f, 0.f};
    bf16x8 At[4][2], B0[2][2], B1[2][2];
    unsigned vA0[2], vA1[2], nA0[2], nA1[2];
    unsigned uA, uB = S.b_off(cur, tstep);
    if constexpr (GATHER) { uA = 0u;
#pragma unroll
        for (int i = 0; i < 2; ++i) { vA0[i] = tabA[cur.aux * 256 + sR[i]] + (unsigned)sC[i] * 2u; vA1[i] = tabA[cur.aux * 256 + 128 + sR[i]] + (unsigned)sC[i] * 2u; }
    } else { uA = (unsigned)cur.pm * tstep;
#pragma unroll
        for (int i = 0; i < 2; ++i) { vA0[i] = (unsigned)(sR[i] * K + sC[i]) * 2u; vA1[i] = vA0[i] + hstep; }
    }
    PG8_STAGE(PG8_SB(0, 0), baseB, uB, voffB); PG8_STAGE(PG8_SB(0, 1), baseB, uB + hstep, voffB); PG8_STAGE(PG8_SA(0, 0), baseA, uA, vA0); PG8_STAGE(PG8_SA(0, 1), baseA, uA, vA1);
    if (wr == 1) PG8_BAR;
    PG8_WAIT_V(2); PG8_BAR;
    PG8_STAGE(PG8_SB(1, 0), baseB, uB + kstep, voffB); PG8_STAGE(PG8_SA(1, 0), baseA, uA + kstep, vA0); PG8_STAGE(PG8_SB(1, 1), baseB, uB + hstep + kstep, voffB);
    PG8_WAIT_V(6); PG8_BAR;
    for (;;) {
        const bool has_next = S.next(ui + 1, nxt);
        unsigned nuA, nuB = has_next ? S.b_off(nxt, tstep) : uB;
        if constexpr (GATHER) { nuA = 0u;
#pragma unroll
            for (int i = 0; i < 2; ++i) { if (has_next) { nA0[i] = tabA[nxt.aux * 256 + sR[i]] + (unsigned)sC[i] * 2u; nA1[i] = tabA[nxt.aux * 256 + 128 + sR[i]] + (unsigned)sC[i] * 2u; } else { nA0[i] = vA0[i]; nA1[i] = vA1[i]; } }
        } else { nuA = has_next ? (unsigned)nxt.pm * tstep : uA;
#pragma unroll
            for (int i = 0; i < 2; ++i) { nA0[i] = vA0[i]; nA1[i] = vA1[i]; }
        }
#pragma unroll 1
        for (int t = 0; t < nt; t += 2) {
            const bool last = (t == nt - 2);
            const unsigned a1 = uA + (unsigned)(t + 1) * kstep;
            const unsigned a2 = last ? nuA : uA + (unsigned)(t + 2) * kstep; const unsigned b2 = last ? nuB : uB + (unsigned)(t + 2) * kstep;
            const unsigned a3 = a2 + kstep; const unsigned b3 = b2 + kstep;
            unsigned w0[2], w1[2];
#pragma unroll
            for (int i = 0; i < 2; ++i) { w0[i] = (GATHER && last) ? nA0[i] : vA0[i]; w1[i] = (GATHER && last) ? nA1[i] : vA1[i]; }
            PG8_LDB(B0, 0, 0); PG8_LDB(B1, 0, 1); PG8_SCHED; PG8_LDA(At, 0, 0); PG8_STAGE(PG8_SA(1, 1), baseA, a1, vA1);
            PG8_WAIT_V(8); PG8_WAIT_L(0); PG8_BAR; PG8_MMA(0, 0, At, B0); PG8_MMA(0, 1, At, B1); PG8_BAR; PG8_SCHED;
            PG8_LDA(At, 0, 1); PG8_STAGE(PG8_SB(0, 0), baseB, b2, voffB); PG8_STAGE(PG8_SB(0, 1), baseB, b2 + hstep, voffB); PG8_STAGE(PG8_SA(0, 0), baseA, a2, w0);
            PG8_WAIT_V(8); PG8_WAIT_L(0); PG8_BAR; PG8_MMA(1, 0, At, B0); PG8_MMA(1, 1, At, B1); PG8_BAR; PG8_SCHED;
            PG8_LDB(B0, 1, 0); PG8_LDB(B1, 1, 1); PG8_SCHED; PG8_LDA(At, 1, 0); PG8_STAGE(PG8_SA(0, 1), baseA, a2, w1);
            PG8_WAIT_V(8); PG8_WAIT_L(0); PG8_BAR; PG8_MMA(0, 0, At, B0); PG8_MMA(0, 1, At, B1); PG8_BAR; PG8_SCHED;
            PG8_LDA(At, 1, 1); PG8_STAGE(PG8_SB(1, 0), baseB, b3, voffB); PG8_STAGE(PG8_SB(1, 1), baseB, b3 + hstep, voffB); PG8_STAGE(PG8_SA(1, 0), baseA, a3, w0);
            PG8_WAIT_V(8); PG8_WAIT_L(0); PG8_BAR; PG8_MMA(1, 0, At, B0); PG8_MMA(1, 1, At, B1); PG8_BAR; PG8_SCHED;
        }
        if constexpr (ALIGN_EPI) { if (wr == 0) PG8_BAR; }
        E(acc, cur, wr, wc, fr, fq);
        if (!has_next) break;
#pragma unroll
        for (int a = 0; a < 2; ++a)
#pragma unroll
            for (int b = 0; b < 2; ++b)
#pragma unroll
                for (int m = 0; m < 4; ++m)
#pragma unroll
                    for (int n = 0; n < 2; ++n) acc[a][b][m][n] = (f32x4){0.f, 0.f, 0.f, 0.f};
        cur = nxt; uA = nuA; uB = nuB; ++ui;
#pragma unroll
        for (int i = 0; i < 2; ++i) { vA0[i] = nA0[i]; vA1[i] = nA1[i]; }
        if constexpr (ALIGN_EPI) { if (wr == 1) PG8_BAR; }
    }
    PG8_WAIT_V(0);
    if constexpr (!ALIGN_EPI) { if (wr == 0) PG8_BAR; }
    PG8_BAR;
#undef PG8_SA
#undef PG8_SB
#undef PG8_STAGE
#undef PG8_LDA
#undef PG8_LDB
#undef PG8_MMA
#undef PG8_WAIT_V
#undef PG8_WAIT_L
#undef PG8_BAR
#undef PG8_SCHED
}

typedef int i32x8v __attribute__((ext_vector_type(8)));
typedef int i32x4v __attribute__((ext_vector_type(4)));
template <class Epi, class Sched, bool ALIGN_EPI, bool GATHER>
__device__ __forceinline__ void gemm_phase8(PG8_LAS unsigned char* lds, const Gemm g, const Sched& S, const Epi& E, const PG8_LAS unsigned* tabA) {
    const int tid = tid_fresh(), wid = __builtin_amdgcn_readfirstlane(tid >> 6), lane = tid & 63, wr = wid >> 2, wc = wid & 3, fr = lane & 15, fq = lane >> 4;
    const int K = g.K, nt = K / BK;
    int sR[2], sC[2];
    unsigned voffB[2];
#pragma unroll
    for (int i = 0; i < 2; ++i) { int R, C; stage_rc(tid * 16 + i * 8192, R, C); sR[i] = R; sC[i] = C; const int Rb = Epi::PERM ? ((R & ~31) + perm32(R & 31)) : R;
        voffB[i] = (unsigned)(Rb * K + C) * 2u; }
    const unsigned kstep = (unsigned)(BK * 2);
    const unsigned hstep = (unsigned)(HALF * K * 2);
    const unsigned tstep = 2u * hstep;
    const unsigned ldsw = (unsigned)wid * 1024u;
    const char* const baseA = (const char*)g.A; const char* const baseB = (const char*)g.Bt;
    const int aoff = lds_byte(wr * 64 + fr, 32 * (fq >> 1) + 16 * (fq & 1)), boff = lds_byte(wc * 32 + fr, 32 * (fq >> 1) + 16 * (fq & 1));
#define PG8_SA(b, h) (((b) * 2 + (h)) * HTB)
#define PG8_SB(b, h) ((4 + (b) * 2 + (h)) * HTB)
#define PG8_STAGE(bufoff, gbase, uoff, voff) do { _Pragma("unroll") for (int _i = 0; _i < 2; ++_i) \
        __builtin_amdgcn_global_load_lds((const unsigned*)((gbase) + (size_t)(unsigned)((uoff) + (voff)[_i])), (PG8_LAS unsigned*)(lds + (bufoff) + ldsw + _i * 8192), 16, 0, 0); } while (0)
#define PG8_LD32(p) __builtin_shufflevector(*(const PG8_LAS i32x4v*)(p), *(const PG8_LAS i32x4v*)((p) + 16), 0, 1, 2, 3, 4, 5, 6, 7)
#define PG8_LDA(dst, b, h) do { _Pragma("unroll") for (int m = 0; m < 4; ++m) dst[m] = PG8_LD32(lds + PG8_SA(b, h) + aoff + m * 2048); } while (0)
#define PG8_LDB(dst, b, h) do { _Pragma("unroll") for (int n = 0; n < 2; ++n) dst[n] = PG8_LD32(lds + PG8_SB(b, h) + boff + n * 2048); } while (0)
#define PG8_MMA(ai, bj, At, Bt) do { __builtin_amdgcn_s_setprio(1); _Pragma("unroll") for (int m = 0; m < 4; ++m) _Pragma("unroll") for (int n = 0; n < 2; ++n) \
        asm volatile("v_mfma_scale_f32_16x16x128_f8f6f4 %0, %1, %2, %0, %3, %4 op_sel_hi:[0,0,0]" : "+v"(acc[ai][bj][m][n]) : "v"(Bt[n]), "v"(At[m]), "v"(scw), "v"(sca)); __builtin_amdgcn_s_setprio(0); } while (0)
#define PG8_MFMA_DRAIN asm volatile("s_nop 15\n\ts_nop 15\n\ts_nop 15" ::: "memory")
#define PG8_WAIT_V(n) asm volatile("s_waitcnt vmcnt(" #n ")" ::: "memory")
#define PG8_WAIT_L(n) asm volatile("s_waitcnt lgkmcnt(" #n ")" ::: "memory")
#define PG8_BAR __builtin_amdgcn_s_barrier()
#define PG8_SCHED __builtin_amdgcn_sched_barrier(0)
    Unit cur, nxt; int ui = 0;
    if (!S.next(0, cur)) return;
    f32x4 acc[2][2][4][2];
#pragma unroll
    for (int a = 0; a < 2; ++a)
#pragma unroll
        for (int b = 0; b < 2; ++b)
#pragma unroll
            for (int m = 0; m < 4; ++m)
#pragma unroll
                for (int n = 0; n < 2; ++n) acc[a][b][m][n] = (f32x4){0.f, 0.f, 0.f, 0.f};
    i32x8v At[4], B0[2], B1[2];
    int scw = 0x7a7a7a7a, sca = 0x7f7f7f7f;
    asm volatile("" : "+v"(scw), "+v"(sca));
    unsigned vA0[2], vA1[2], nA0[2], nA1[2];
    unsigned uA, uB = S.b_off(cur, tstep);
    if constexpr (GATHER) { uA = 0u;
#pragma unroll
        for (int i = 0; i < 2; ++i) { vA0[i] = tabA[cur.aux * 256 + sR[i]] + (unsigned)sC[i] * 2u; vA1[i] = tabA[cur.aux * 256 + 128 + sR[i]] + (unsigned)sC[i] * 2u; }
    } else { uA = (unsigned)cur.pm * tstep;
#pragma unroll
        for (int i = 0; i < 2; ++i) { vA0[i] = (unsigned)(sR[i] * K + sC[i]) * 2u; vA1[i] = vA0[i] + hstep; }
    }
    PG8_STAGE(PG8_SB(0, 0), baseB, uB, voffB); PG8_STAGE(PG8_SB(0, 1), baseB, uB + hstep, voffB); PG8_STAGE(PG8_SA(0, 0), baseA, uA, vA0); PG8_STAGE(PG8_SA(0, 1), baseA, uA, vA1);
    if (wr == 1) PG8_BAR;
    PG8_WAIT_V(2); PG8_BAR;
    PG8_STAGE(PG8_SB(1, 0), baseB, uB + kstep, voffB); PG8_STAGE(PG8_SA(1, 0), baseA, uA + kstep, vA0); PG8_STAGE(PG8_SB(1, 1), baseB, uB + hstep + kstep, voffB);
    PG8_WAIT_V(6); PG8_BAR;
    for (;;) {
        const bool has_next = S.next(ui + 1, nxt);
        unsigned nuA, nuB = has_next ? S.b_off(nxt, tstep) : uB;
        if constexpr (GATHER) { nuA = 0u;
#pragma unroll
            for (int i = 0; i < 2; ++i) { if (has_next) { nA0[i] = tabA[nxt.aux * 256 + sR[i]] + (unsigned)sC[i] * 2u; nA1[i] = tabA[nxt.aux * 256 + 128 + sR[i]] + (unsigned)sC[i] * 2u; } else { nA0[i] = vA0[i]; nA1[i] = vA1[i]; } }
        } else { nuA = has_next ? (unsigned)nxt.pm * tstep : uA;
#pragma unroll
            for (int i = 0; i < 2; ++i) { nA0[i] = vA0[i]; nA1[i] = vA1[i]; }
        }
#pragma unroll 1
        for (int t = 0; t < nt; t += 2) {
            const bool last = (t == nt - 2);
            const unsigned a1 = uA + (unsigned)(t + 1) * kstep;
            const unsigned a2 = last ? nuA : uA + (unsigned)(t + 2) * kstep; const unsigned b2 = last ? nuB : uB + (unsigned)(t + 2) * kstep;
            const unsigned a3 = a2 + kstep; const unsigned b3 = b2 + kstep;
            unsigned w0[2], w1[2];
#pragma unroll
            for (int i = 0; i < 2; ++i) { w0[i] = (GATHER && last) ? nA0[i] : vA0[i]; w1[i] = (GATHER && last) ? nA1[i] : vA1[i]; }
            PG8_LDB(B0, 0, 0); PG8_LDB(B1, 0, 1); PG8_SCHED; PG8_LDA(At, 0, 0); PG8_STAGE(PG8_SA(1, 1), baseA, a1, vA1);
            PG8_WAIT_V(8); PG8_WAIT_L(0); PG8_BAR; PG8_MMA(0, 0, At, B0); PG8_MMA(0, 1, At, B1); PG8_BAR; PG8_SCHED;
            PG8_LDA(At, 0, 1); PG8_STAGE(PG8_SB(0, 0), baseB, b2, voffB); PG8_STAGE(PG8_SB(0, 1), baseB, b2 + hstep, voffB); PG8_STAGE(PG8_SA(0, 0), baseA, a2, w0);
            PG8_WAIT_V(8); PG8_WAIT_L(0); PG8_BAR; PG8_MMA(1, 0, At, B0); PG8_MMA(1, 1, At, B1); PG8_BAR; PG8_SCHED;
            PG8_LDB(B0, 1, 0); PG8_LDB(B1, 1, 1); PG8_SCHED; PG8_LDA(At, 1, 0); PG8_STAGE(PG8_SA(0, 1), baseA, a2, w1);
            PG8_WAIT_V(8); PG8_WAIT_L(0); PG8_BAR; PG8_MMA(0, 0, At, B0); PG8_MMA(0, 1, At, B1); PG8_BAR; PG8_SCHED;
            PG8_LDA(At, 1, 1); PG8_STAGE(PG8_SB(1, 0), baseB, b3, voffB); PG8_STAGE(PG8_SB(1, 1), baseB, b3 + hstep, voffB); PG8_STAGE(PG8_SA(1, 0), baseA, a3, w0);
            PG8_WAIT_V(8); PG8_WAIT_L(0); PG8_BAR; PG8_MMA(1, 0, At, B0); PG8_MMA(1, 1, At, B1); PG8_BAR; PG8_SCHED;
        }
        if constexpr (ALIGN_EPI) { if (wr == 0) PG8_BAR; }
        PG8_MFMA_DRAIN;
        { const int l2 = tid_fresh() & 63; E(acc, cur, wr, wc, l2 & 15, l2 >> 4); }
        if (!has_next) break;
#pragma unroll
        for (int a = 0; a < 2; ++a)
#pragma unroll
            for (int b = 0; b < 2; ++b)
#pragma unroll
                for (int m = 0; m < 4; ++m)
#pragma unroll
                    for (int n = 0; n < 2; ++n) acc[a][b][m][n] = (f32x4){0.f, 0.f, 0.f, 0.f};
        cur = nxt; uA = nuA; uB = nuB; ++ui;
#pragma unroll
        for (int i = 0; i < 2; ++i) { vA0[i] = nA0[i]; vA1[i] = nA1[i]; }
        if constexpr (ALIGN_EPI) { if (wr == 1) PG8_BAR; }
    }
    PG8_WAIT_V(0);
    if constexpr (!ALIGN_EPI) { if (wr == 0) PG8_BAR; }
    PG8_BAR;
#undef PG8_SA
#undef PG8_SB
#undef PG8_STAGE
#undef PG8_LDA
#undef PG8_LD32
#undef PG8_LDB
#undef PG8_MMA
#undef PG8_MFMA_DRAIN
#undef PG8_WAIT_V
#undef PG8_WAIT_L
#undef PG8_BAR
#undef PG8_SCHED
}

__device__ __forceinline__ unsigned cvt_pk_bf16(float lo, float hi) { return pk2(lo, hi); }

struct EpiBf16 {
    static constexpr bool PERM = true;
    bf16* O; int ldc;
    __device__ __forceinline__ void operator()(const f32x4 (&acc)[2][2][4][2], const Unit& u, int wr, int wc, int fr, int fq) const {
        const int row0 = u.pm * BM + wr * 64 + fr; const int col0 = u.pn * BM + wc * 32 + 8 * fq;
#pragma unroll
        for (int ai = 0; ai < 2; ++ai)
#pragma unroll
            for (int m = 0; m < 4; ++m) { bf16* rowp = O + (size_t)(row0 + ai * HALF + m * 16) * ldc + col0;
#pragma unroll
                for (int bj = 0; bj < 2; ++bj) { const f32x4 v0 = acc[ai][bj][m][0], v1 = acc[ai][bj][m][1];
                    u32x4 w; w.x = cvt_pk_bf16(v0[0], v0[1]); w.y = cvt_pk_bf16(v0[2], v0[3]); w.z = cvt_pk_bf16(v1[0], v1[1]); w.w = cvt_pk_bf16(v1[2], v1[3]);
                    *(u32x4*)(rowp + bj * HALF) = w; } }
    }
};
struct EpiResid {
    static constexpr bool PERM = false;
    const float* xl; const float* xc; float* out; const float* gate;
    __device__ __forceinline__ void operator()(const f32x4 (&acc)[2][2][4][2], const Unit& u, int wr, int wc, int fr, int fq) const {
        const int rt = u.pm * BM; const bool isl = rt < NLAT;
        const float* base = isl ? xl + (size_t)rt * D : xc + (size_t)(rt - NLAT) * D;
        const float* gp = gate + (size_t)(isl ? (rt >> 12) : 8) * 12288;
        const int rl0 = wr * 64 + fr, col0 = u.pn * BM + wc * 32 + 4 * fq;
#pragma unroll
        for (int ai = 0; ai < 2; ++ai)
#pragma unroll
            for (int m = 0; m < 4; ++m) { const int rl = rl0 + ai * HALF + m * 16; const float* bp = base + (size_t)rl * D + col0; float* op = out + (size_t)(rt + rl) * D + col0;
#pragma unroll
                for (int bj = 0; bj < 2; ++bj)
#pragma unroll
                    for (int n = 0; n < 2; ++n) { const f32x4 b = *(const f32x4*)(bp + bj * HALF + n * 16); const f32x4 gv = *(const f32x4*)(gp + col0 + bj * HALF + n * 16); *(f32x4*)(op + bj * HALF + n * 16) = b + gv * acc[ai][bj][m][n]; }
                asm volatile("" ::: "memory"); }
    }
};
struct EpiSwiglu {
    static constexpr bool PERM = true;
    unsigned char* O;
    __device__ __forceinline__ void operator()(const f32x4 (&acc)[2][2][4][2], const Unit& u, int wr, int wc, int fr, int fq) const {
        const int row0 = u.pm * BM + wr * 64 + fr; const int col0 = u.pn * 128 + wc * 32 + 8 * fq;
#pragma unroll
        for (int ai = 0; ai < 2; ++ai)
#pragma unroll
            for (int m = 0; m < 4; ++m) { unsigned char* rowp = O + (size_t)(row0 + ai * HALF + m * 16) * DE + col0;
                float o[8];
#pragma unroll
                for (int n = 0; n < 2; ++n)
#pragma unroll
                    for (int j = 0; j < 4; ++j) { const float gt = acc[ai][0][m][n][j], up = acc[ai][1][m][n][j]; o[n * 4 + j] = gt * __builtin_amdgcn_rcpf(1.0f + __expf(-gt)) * up; }
                u32x2 w; w.x = pk4_fp8(o[0], o[1], o[2], o[3]); w.y = pk4_fp8(o[4], o[5], o[6], o[7]);
                *(u32x2*)rowp = w; }
    }
};
struct EpiDown {
    static constexpr bool PERM = true;
    bf16* YK; const PG8_LAS unsigned* tab; const PG8_LAS float* tabw;
    __device__ __forceinline__ void operator()(const f32x4 (&acc)[2][2][4][2], const Unit& u, int wr, int wc, int fr, int fq) const {
        const int rl0 = wr * 64 + fr; const int col0 = u.pn * BM + wc * 32 + 8 * fq;
#pragma unroll
        for (int ai = 0; ai < 2; ++ai)
#pragma unroll
            for (int m = 0; m < 4; ++m) { const int rl = rl0 + ai * HALF + m * 16; const unsigned ent = tab[u.aux * 256 + rl]; const float w = tabw[u.aux * 256 + rl];
                if (!(ent & 0x40000000u)) { bf16* rowp = YK + ((size_t)(ent >> 31) * MALL + (ent & 0xffffu)) * D + col0;
#pragma unroll
                    for (int bj = 0; bj < 2; ++bj) { const f32x4 v0 = acc[ai][bj][m][0] * w, v1 = acc[ai][bj][m][1] * w;
                        u32x4 q; q.x = cvt_pk_bf16(v0[0], v0[1]); q.y = cvt_pk_bf16(v0[2], v0[3]); q.z = cvt_pk_bf16(v1[0], v1[1]); q.w = cvt_pk_bf16(v1[2], v1[3]);
                        *(u32x4*)(rowp + bj * HALF) = q; } }
                asm volatile("" ::: "memory"); }
    }
};
}

struct Args { const float* in[31]; float* out; unsigned char* ws; int ph_lo, ph_hi; };
typedef const __attribute__((address_space(4))) Args* KArgs;
__device__ __forceinline__ KArgs kargs() { KArgs p = (KArgs)__builtin_amdgcn_kernarg_segment_ptr(); asm volatile("" : "+s"(p)); return p; }
#define AIN(i) (a->in[i])
enum { I_X = 0, I_C, I_CTX, I_CCTX, I_ADAW, I_ADAB, I_N1G, I_N2G, I_WIN, I_WOUT, I_GNG, I_GWS, I_GB, I_LB, I_HNG, I_MU, I_W0, I_WUP, I_A0, I_AUP, I_GUP, I_KK, I_KA, I_RK, I_GNGG, I_GNB, I_RW, I_RB, I_WGU, I_WDN, I_FNG };

__device__ __forceinline__ void p0_transpose_item(const float* W, int K, int N, bf16* WT, int n_row0, LAS float* scr, int kb, int nb, int lane) {
    const int k0 = 64 * kb, n0 = 32 * nb;
#pragma unroll 8
    for (int i = 0; i < 32; ++i) { const int kk = 2 * i + (lane >> 5); scr[kk * 33 + (lane & 31)] = W[(size_t)(k0 + kk) * N + n0 + (lane & 31)]; }
    asm volatile("s_waitcnt lgkmcnt(0)" ::: "memory");
    const int c = lane & 7;
#pragma unroll
    for (int j = 0; j < 4; ++j) { const int n = (lane >> 3) + 8 * j; const LAS float* s = scr + (8 * c) * 33 + n;
        u32x4 o; o.x = pk2(s[0 * 33], s[1 * 33]); o.y = pk2(s[2 * 33], s[3 * 33]); o.z = pk2(s[4 * 33], s[5 * 33]); o.w = pk2(s[6 * 33], s[7 * 33]);
        *(u32x4*)(WT + (size_t)(n_row0 + n) * K + k0 + 8 * c) = o; }
    asm volatile("s_waitcnt lgkmcnt(0)" ::: "memory");
}

__device__ __forceinline__ void p0_transpose_item8(const float* W, int K, int N, unsigned char* WT, int n_row0, LAS float* scr, int kb, int nb, int lane) {
    const int k0 = 64 * kb, n0 = 32 * nb;
#pragma unroll 8
    for (int i = 0; i < 32; ++i) { const int kk = 2 * i + (lane >> 5); scr[kk * 33 + (lane & 31)] = W[(size_t)(k0 + kk) * N + n0 + (lane & 31)]; }
    asm volatile("s_waitcnt lgkmcnt(0)" ::: "memory");
    const int c = lane & 7;
#pragma unroll
    for (int j = 0; j < 4; ++j) { const int n = (lane >> 3) + 8 * j; const LAS float* sp = scr + (8 * c) * 33 + n;
        u32x2 o; o.x = pk4_fp8(sp[0 * 33] * 32.f, sp[1 * 33] * 32.f, sp[2 * 33] * 32.f, sp[3 * 33] * 32.f); o.y = pk4_fp8(sp[4 * 33] * 32.f, sp[5 * 33] * 32.f, sp[6 * 33] * 32.f, sp[7 * 33] * 32.f);
        *(u32x2*)(WT + (size_t)(n_row0 + n) * K + k0 + 8 * c) = o; }
    asm volatile("s_waitcnt lgkmcnt(0)" ::: "memory");
}
__device__ __forceinline__ void convert_moe(KArgs a, int l, LAS unsigned char* lds) {
    const int tid = tid_fresh(), lane = tid & 63, wave = tid >> 6;
    const int gw = blockIdx.x * 8 + wave, NGW = gridDim.x * 8;
    unsigned char* ws = a->ws;
    LAS float* scr = (LAS float*)(lds + wave * 16384);
    constexpr int I_GU = 32 * 64, I_DN = 16 * 64, N2 = 16 * I_GU, N3 = N2 + 16 * I_DN;
    for (int it = gw; it < N3; it += NGW) {
        if (it < N2) { const int e = it / I_GU, r = it % I_GU, kb = r / 64, nb = r % 64;
            const int n0 = 32 * nb, hh = n0 >> 10, nn = n0 & 1023, row0 = 256 * (nn >> 7) + 128 * hh + (nn & 127);
            p0_transpose_item8(a->in[I_WGU] + (size_t)(l * NE + e) * D * 2048, D, 2048, ws + WS_WGU + (size_t)e * 2048 * D, row0, scr, kb, nb, lane); }
        else { const int q = it - N2, e = q / I_DN, r = q % I_DN, kb = r / 64, nb = r % 64;
            p0_transpose_item8(a->in[I_WDN] + (size_t)(l * NE + e) * DE * D, DE, D, ws + WS_WDN + (size_t)e * D * DE, 32 * nb, scr, kb, nb, lane); }
    }
}
__device__ __forceinline__ void phase_prologue(KArgs a, LAS unsigned char* lds) {
    const int tid = tid_fresh(), lane = tid & 63, wave = tid >> 6;
    const int G = gridDim.x, gw = blockIdx.x * 8 + wave, NGW = G * 8;
    unsigned char* ws = a->ws;
    LAS float* scr = (LAS float*)(lds + wave * 16384);
    constexpr int I_IN = 32 * 232, I_OUT = 32 * 64;
    constexpr int N0 = 2 * I_IN, N1 = N0 + 2 * I_OUT;
    for (int it = gw; it < N1; it += NGW) {
        if (it < N0) { const int l = it / I_IN, r = it % I_IN, kb = r / 232, nb = r % 232;
            p0_transpose_item8(a->in[I_WIN] + (size_t)l * D * INC, D, INC, ws + WS_WIN + (size_t)l * INC * D, 32 * nb, scr, kb, nb, lane); }
        else { const int q = it - N0, l = q / I_OUT, r = q % I_OUT, kb = r / 64, nb = r % 64;
            p0_transpose_item8(a->in[I_WOUT] + (size_t)l * D * D, D, D, ws + WS_WOUT + (size_t)l * D * D, 32 * nb, scr, kb, nb, lane); }
    }
    convert_moe(a, 0, lds);
    {
        const int gt = blockIdx.x * NTHREADS + tid, NGT = G * NTHREADS;
        bf16* wup = (bf16*)(ws + WS_SMALLW + SW_WUP); bf16* aup = (bf16*)(ws + WS_SMALLW + SW_AUP); bf16* gup = (bf16*)(ws + WS_SMALLW + SW_GUP); bf16* gws = (bf16*)(ws + WS_SMALLW + SW_GWS);
        for (int i = gt; i < 2 * 2 * 768 * 64; i += NGT) { const int k = i & 63, n = (i >> 6) % 768, ld = i / (768 * 64); wup[i] = (bf16)f2bf(a->in[I_WUP][((size_t)ld * 64 + k) * 768 + n]); }
        for (int i = gt; i < 2 * 768 * 64; i += NGT) { const int k = i & 63, n = (i >> 6) % 768, l = i / (768 * 64); aup[i] = (bf16)f2bf(a->in[I_AUP][((size_t)l * 64 + k) * 768 + n]); }
        for (int i = gt; i < 2 * 768 * 128; i += NGT) { const int k = i & 127, n = (i >> 7) % 768, l = i / (768 * 128); gup[i] = (bf16)f2bf(a->in[I_GUP][((size_t)l * 128 + k) * 768 + n]); }
        for (int i = gt; i < 2 * 4 * 128 * 128; i += NGT) gws[i] = (bf16)f2bf(a->in[I_GWS][i]);
    }
    __syncthreads();
    {
        LAS float* sv = (LAS float*)lds;
        LAS float* red = (LAS float*)(lds + 73728);
        for (int i = tid; i < 9 * D; i += NTHREADS) { const int r = i / D, k = i % D; const float v = r < 8 ? a->in[I_C][r * D + k] : a->in[I_CCTX][k]; sv[i] = siluf_(v); }
        __syncthreads();
        float* mod = (float*)(ws + WS_MOD);
        for (int it = blockIdx.x; it < 2 * 96; it += G) {
            const int l = it / 96, cb = it % 96, cq = tid & 31, kg = tid >> 5;
            const float* wp = a->in[I_ADAW] + (size_t)l * D * 12288 + (size_t)(kg * 128) * 12288 + cb * 128 + cq * 4;
            f32x4 acc[9];
#pragma unroll
            for (int r = 0; r < 9; ++r) acc[r] = (f32x4){0.f, 0.f, 0.f, 0.f};
#pragma unroll 4
            for (int k = 0; k < 128; ++k) { const f32x4 w = *(const f32x4*)(wp + (size_t)k * 12288);
#pragma unroll
                for (int r = 0; r < 9; ++r) acc[r] += w * sv[r * D + kg * 128 + k]; }
#pragma unroll
            for (int r = 0; r < 9; ++r) *(LAS f32x4*)(red + ((kg * 9 + r) * 128 + cq * 4)) = acc[r];
            __syncthreads();
            for (int o = tid; o < 9 * 128; o += NTHREADS) { const int r = o / 128, c = o % 128; float s = a->in[I_ADAB][(size_t)l * 12288 + cb * 128 + c];
#pragma unroll
                for (int q = 0; q < 16; ++q) s += red[(q * 9 + r) * 128 + c];
                mod[((size_t)l * 9 + r) * 12288 + cb * 128 + c] = s; }
            __syncthreads();
        }
    }
}

template <int MODE>
__device__ __forceinline__ void phase_norm1(KArgs a, int l, bool dry) {
    const int tid_ = tid_fresh(); const int lane = tid_ & 63, wave = tid_ >> 6, gw = blockIdx.x * 8 + wave, NGW = gridDim.x * 8;
    unsigned char* ws = a->ws;
    const float* mod = (const float*)(ws + WS_MOD);
    float* X = (float*)(ws + WS_X); bf16* H = (bf16*)(ws + WS_H); const bf16* YK = (const bf16*)(ws + WS_YK);
    float* Xo = dry ? (float*)(ws + WS_END) : X; bf16* Ho = dry ? (bf16*)(ws + WS_END) : H; float* Oo = dry ? (float*)(ws + WS_END) : a->out;
    const int nrows = (MODE == 2) ? NLAT : MALL;
    const int rpw = (nrows + NGW - 1) / NGW; const int r0 = gw * rpw, r1 = (r0 + rpw < nrows) ? r0 + rpw : nrows;
    f32x4 ck[8], cs[8], cg[8]; int cur_mr = -1;
    for (int row = r0; row < r1; ++row) {
        const int mr = modrow_of(row); const int orow = dry ? (row & 2047) : row;
        if (mr != cur_mr) { cur_mr = mr;
#pragma unroll
            for (int j = 0; j < 8; ++j) { const int c = 4 * lane + 256 * j;
                if (MODE == 2) ck[j] = *(const f32x4*)(a->in[I_FNG] + c);
                else { const float* m = mod + ((size_t)l * 9 + mr) * 12288; const f32x4 g = *(const f32x4*)(a->in[I_N1G] + (size_t)l * D + c); ck[j] = g * (*(const f32x4*)(m + D + c) + 1.0f); cs[j] = *(const f32x4*)(m + c); }
                if (MODE != 0) cg[j] = *(const f32x4*)(mod + ((size_t)(l - 1) * 9 + mr) * 12288 + 5 * D + c); } }
        f32x4 v[8];
        if (MODE == 0) { const float* xr = row < NLAT ? a->in[I_X] + (size_t)row * D : a->in[I_CTX] + (size_t)(row - NLAT) * D;
#pragma unroll
            for (int j = 0; j < 8; ++j) v[j] = *(const f32x4*)(xr + 4 * lane + 256 * j);
        } else {
            const float* xr = X + (size_t)row * D; const bf16* y0 = YK + (size_t)row * D; const bf16* y1 = YK + ((size_t)MALL + row) * D;
            u32x2 p0[8], p1[8];
#pragma unroll
            for (int j = 0; j < 8; ++j) { const int c = 4 * lane + 256 * j; v[j] = *(const f32x4*)(xr + c); p0[j] = *(const u32x2*)(y0 + c); p1[j] = *(const u32x2*)(y1 + c); }
#pragma unroll
            for (int j = 0; j < 8; ++j) { f32x4 f; f[0] = bflo(p0[j].x) + bflo(p1[j].x); f[1] = bfhi(p0[j].x) + bfhi(p1[j].x); f[2] = bflo(p0[j].y) + bflo(p1[j].y); f[3] = bfhi(p0[j].y) + bfhi(p1[j].y);
                v[j] = v[j] + cg[j] * f; }
            if (MODE == 1) {
#pragma unroll
                for (int j = 0; j < 8; ++j) *(f32x4*)(Xo + (size_t)orow * D + 4 * lane + 256 * j) = v[j];
            }
        }
        float ss = 0.f;
#pragma unroll
        for (int j = 0; j < 8; ++j) ss += (v[j][0] * v[j][0] + v[j][1] * v[j][1]) + (v[j][2] * v[j][2] + v[j][3] * v[j][3]);
        const float rstd = 1.0f / sqrtf(wave_sum(ss) * (1.0f / D) + NORM_EPS);
        if (MODE == 2) {
#pragma unroll
            for (int j = 0; j < 8; ++j) *(f32x4*)(Oo + (size_t)orow * D + 4 * lane + 256 * j) = v[j] * rstd * ck[j];
        } else {
#pragma unroll
            for (int j = 0; j < 8; ++j) { const f32x4 h = v[j] * rstd * ck[j] + cs[j]; *(unsigned*)((unsigned char*)Ho + (size_t)orow * D + 4 * lane + 256 * j) = pk4_fp8(h[0], h[1], h[2], h[3]); }
        }
    }
}

__device__ __forceinline__ void phase_norm2_router(KArgs a, int l, bool dry, LAS unsigned char* lds) {
    const int tid_ = tid_fresh(); const int lane = tid_ & 63, wave = tid_ >> 6, gw = blockIdx.x * 8 + wave, NGW = gridDim.x * 8;
    unsigned char* ws = a->ws;
    const float* mod = (const float*)(ws + WS_MOD);
    const float* X = (const float*)(ws + WS_X); bf16* H = (bf16*)(ws + WS_H);
    unsigned* cnt = (unsigned*)(ws + WS_CTL) + CW_CNT + l * 16 * 64 + (dry ? 4096 : 0);
    unsigned* ridx = (unsigned*)(ws + (dry ? WS_END : WS_RIDX)); float* rwt = (float*)(ws + (dry ? WS_END + 4 * MiB : WS_RW)); bf16* Ho = dry ? (bf16*)(ws + WS_END + 8 * MiB) : H;
    const int nrows = (l == DEPTH - 1) ? NLAT : MALL;
    LAS f32x4* rwl = (LAS f32x4*)lds;
    { const float* rw = a->in[I_RW];
      for (int idx = tid_; idx < 8192; idx += NTHREADS) { const int ln = idx & 63, q = (idx >> 6) & 3, i = (idx >> 8) & 3, j = idx >> 10; rwl[idx] = *(const f32x4*)(rw + (size_t)(4 * ln + 256 * j + i) * 16 + 4 * q); } }
    __syncthreads();
    const int rpw = (nrows + NGW - 1) / NGW; const int r0 = gw * rpw, r1 = (r0 + rpw < nrows) ? r0 + rpw : nrows;
    f32x4 ck[8]; int cur_mr = -1;
    const float* rbp = a->in[I_RB];
    for (int row = r0; row < r1; ++row) {
        const int mr = modrow_of(row); const int orow = dry ? (row & 2047) : row;
        if (mr != cur_mr) { cur_mr = mr; const float* m = mod + ((size_t)l * 9 + mr) * 12288;
#pragma unroll
            for (int j = 0; j < 8; ++j) { const int c = 4 * lane + 256 * j; const f32x4 g = *(const f32x4*)(a->in[I_N2G] + (size_t)l * D + c); ck[j] = g * (*(const f32x4*)(m + 4 * D + c) + 1.0f); } }
        const float* shp = mod + ((size_t)l * 9 + mr) * 12288 + 3 * D;
        const float* xr = X + (size_t)row * D;
        f32x4 v[8]; float ss = 0.f;
#pragma unroll
        for (int j = 0; j < 8; ++j) { v[j] = *(const f32x4*)(xr + 4 * lane + 256 * j); ss += (v[j][0] * v[j][0] + v[j][1] * v[j][1]) + (v[j][2] * v[j][2] + v[j][3] * v[j][3]); }
        const float rstd = 1.0f / sqrtf(wave_sum(ss) * (1.0f / D) + NORM_EPS);
        f32x4 lg4[4];
#pragma unroll
        for (int q = 0; q < 4; ++q) lg4[q] = (f32x4){0.f, 0.f, 0.f, 0.f};
#pragma unroll
        for (int j = 0; j < 8; ++j) { const f32x4 h = v[j] * rstd * ck[j] + *(const f32x4*)(shp + 4 * lane + 256 * j); *(unsigned*)((unsigned char*)Ho + (size_t)orow * D + 4 * lane + 256 * j) = pk4_fp8(h[0], h[1], h[2], h[3]);
#pragma unroll
            for (int i = 0; i < 4; ++i)
#pragma unroll
                for (int q = 0; q < 4; ++q) lg4[q] += rwl[((j * 4 + i) * 4 + q) * 64 + lane] * h[i];
            asm volatile("" ::: "memory"); }
        float lg[16];
        { float t8[8], t4[4], t2[2], t1;
          const bool b5 = lane & 32, b4 = lane & 16, b3 = lane & 8, b2 = lane & 4;
#pragma unroll
          for (int i = 0; i < 8; ++i) { const float keep = b5 ? lg4[(i + 8) >> 2][(i + 8) & 3] : lg4[i >> 2][i & 3], send = b5 ? lg4[i >> 2][i & 3] : lg4[(i + 8) >> 2][(i + 8) & 3]; t8[i] = keep + __shfl_xor(send, 32); }
#pragma unroll
          for (int i = 0; i < 4; ++i) { const float keep = b4 ? t8[i + 4] : t8[i], send = b4 ? t8[i] : t8[i + 4]; t4[i] = keep + __shfl_xor(send, 16); }
#pragma unroll
          for (int i = 0; i < 2; ++i) { const float keep = b3 ? t4[i + 2] : t4[i], send = b3 ? t4[i] : t4[i + 2]; t2[i] = keep + __shfl_xor(send, 8); }
          { const float keep = b2 ? t2[1] : t2[0], send = b2 ? t2[0] : t2[1]; t1 = keep + __shfl_xor(send, 4); }
          t1 += __shfl_xor(t1, 2); t1 += __shfl_xor(t1, 1);
#pragma unroll
          for (int e = 0; e < 16; ++e) { const int src = ((e >> 3) & 1) * 32 + ((e >> 2) & 1) * 16 + ((e >> 1) & 1) * 8 + (e & 1) * 4; lg[e] = __builtin_bit_cast(float, __builtin_amdgcn_readlane(__builtin_bit_cast(int, t1), src)) + rbp[e]; } }
        float mx = lg[0];
#pragma unroll
        for (int e = 1; e < 16; ++e) mx = fmaxf(mx, lg[e]);
        float p[16], sum = 0.f;
#pragma unroll
        for (int e = 0; e < 16; ++e) { p[e] = __expf(lg[e] - mx); sum += p[e]; }
        const float inv = 1.0f / sum;
#pragma unroll
        for (int e = 0; e < 16; ++e) p[e] *= inv;
        int sel = 0; float best = -1.f;
#pragma unroll
        for (int gI = 0; gI < 4; ++gI) { float m1 = -1.f, m2 = -1.f;
#pragma unroll
            for (int i = 0; i < 4; ++i) { const float q = p[4 * gI + i]; if (q > m1) { m2 = m1; m1 = q; } else if (q > m2) m2 = q; }
            const float s = m1 + m2; if (s > best) { best = s; sel = gI; } }
        int i1 = 0, i2 = 0; float p1 = -2.f, p2 = -2.f;
#pragma unroll
        for (int gI = 0; gI < 4; ++gI)
#pragma unroll
            for (int i = 0; i < 4; ++i) { const float q = (gI == sel) ? p[4 * gI + i] : -1.0f; const int e = 4 * gI + i;
                if (gI == sel) { if (q > p1) { p2 = p1; i2 = i1; p1 = q; i1 = e; } else if (q > p2) { p2 = q; i2 = e; } } }
        const float wsum = p1 + p2, w1 = p1 / wsum, w2 = p2 / wsum;
        if (lane == 0) {
            const unsigned q1 = atomicAdd(cnt + i1 * 64, 1u); ridx[(size_t)i1 * MALL + q1] = (unsigned)row; rwt[(size_t)i1 * MALL + q1] = w1;
            const unsigned q2 = atomicAdd(cnt + i2 * 64, 1u); ridx[(size_t)i2 * MALL + q2] = (unsigned)row | 0x80000000u; rwt[(size_t)i2 * MALL + q2] = w2;
        }
    }
    __syncthreads();
}

template <bool FOR_DOWN>
__device__ __forceinline__ void moe_tables(KArgs a, int l, LAS unsigned char* lds, int cvirt) {
    const int tid = tid_fresh(), G = gridDim.x;
    unsigned char* ws = a->ws;
    const unsigned* cnt = (const unsigned*)(ws + WS_CTL) + CW_CNT + l * 16 * 64;
    const unsigned* ridx = (const unsigned*)(ws + WS_RIDX); const float* rwt = (const float*)(ws + WS_RW);
    LAS int* tp = (LAS int*)(lds + LDS_TP); LAS unsigned* tab = (LAS unsigned*)(lds + LDS_TAB); LAS float* tabw = (LAS float*)(lds + LDS_TABW);
    if (tid == 0) { int acc = 0; for (int e = 0; e < 16; ++e) { tp[e] = acc; acc += (int)((cnt[e * 64] + 255u) >> 8); } tp[16] = acc; }
    __syncthreads();
    const int ntot = tp[16] * 8;
    for (int i = 0; i < 9; ++i) { const int L = i * G + cvirt; if (L >= ntot) break;
        const int tile = L >> 3; int e = 0;
        for (int j = 1; j < 16; ++j) e += (tile >= tp[j]) ? 1 : 0;
        const int pos0 = (tile - tp[e]) * 256; const unsigned ce = cnt[e * 64];
        if (tid < 256) { const int pos = pos0 + tid; const bool valid = (unsigned)pos < ce; const unsigned ent = ridx[(size_t)e * MALL + (valid ? pos : 0)];
            if (FOR_DOWN) { tab[i * 256 + tid] = valid ? ent : (ent | 0x40000000u); tabw[i * 256 + tid] = valid ? rwt[(size_t)e * MALL + pos] : 0.f; }
            else tab[i * 256 + tid] = (ent & 0xffffu) * (unsigned)D; }
    }
    __syncthreads();
}

__device__ __forceinline__ void gmlp_item(KArgs a, int l, int item, LAS unsigned char* lds) {
    const int tid = tid_fresh(), lane = tid & 63, wave = tid >> 6;
    unsigned char* ws = a->ws;
    const bf16* P = (const bf16*)(ws + WS_P); bf16* Y = (bf16*)(ws + WS_Y);
    const int chunk = item >> 2, h = item & 3;
    const int row0 = chunk < 256 ? chunk * 128 : NLAT + (chunk - 256) * 128;
    LAS bf16* wsl = (LAS bf16*)lds;
    LAS bf16* vT = (LAS bf16*)(lds + 128 * 136 * 2);
    const bf16* gws = (const bf16*)(ws + WS_SMALLW + SW_GWS) + ((size_t)l * 4 + h) * 128 * 128;
    for (int p = tid; p < 2048; p += NTHREADS) { const int t = p >> 4, c8 = p & 15; *(LAS u32x4*)(wsl + t * 136 + c8 * 8) = *(const u32x4*)(gws + t * 128 + c8 * 8); }
    {
        const int s = tid >> 2, qd = tid & 3; const bf16* vp = P + (size_t)(row0 + s) * INC + OFF_V + h * 128 + qd * 32;
        float g[32]; float ss = 0.f;
#pragma unroll
        for (int q = 0; q < 4; ++q) { float f[8]; unpack8(*(const u32x4*)(vp + 8 * q), f);
#pragma unroll
            for (int j = 0; j < 8; ++j) { const float x = geluf_(f[j]); g[8 * q + j] = x; ss += x * x; } }
        ss += __shfl_xor(ss, 1); ss += __shfl_xor(ss, 2);
        const float rstd = 1.0f / sqrtf(ss * (1.0f / 128.0f) + NORM_EPS);
        const float* ng = a->in[I_GNG] + (size_t)l * 512 + h * 128 + qd * 32;
#pragma unroll
        for (int j = 0; j < 32; ++j) vT[(qd * 32 + j) * 136 + s] = (bf16)f2bf(g[j] * rstd * ng[j]);
    }
    __syncthreads();
    f32x4 acc[8];
#pragma unroll
    for (int ct = 0; ct < 8; ++ct) acc[ct] = (f32x4){0.f, 0.f, 0.f, 0.f};
    const int fr = lane & 15, fq = lane >> 4;
#pragma unroll
    for (int ks = 0; ks < 4; ++ks) {
        const bf16x8 bfrag = *(const LAS bf16x8*)(wsl + (16 * wave + fr) * 136 + ks * 32 + fq * 8);
#pragma unroll
        for (int ct = 0; ct < 8; ++ct) { const bf16x8 afrag = *(const LAS bf16x8*)(vT + (16 * ct + fr) * 136 + ks * 32 + fq * 8);
            acc[ct] = __builtin_amdgcn_mfma_f32_16x16x32_bf16(afrag, bfrag, acc[ct], 0, 0, 0); }
    }
    const int t = 16 * wave + fr; const float wb = a->in[I_GB][((size_t)l * 4 + h) * 128 + t];
    const bf16* up = P + (size_t)(row0 + t) * INC + OFF_U + h * 128; unsigned char* yp = a->ws + WS_Y8 + (size_t)(row0 + t) * D + h * 128;
#pragma unroll
    for (int ct = 0; ct < 8; ++ct) { const int c = 16 * ct + 4 * fq; const u32x2 uu = *(const u32x2*)(up + c);
        const float y0 = geluf_(bflo(uu.x)) * (acc[ct][0] + wb), y1 = geluf_(bfhi(uu.x)) * (acc[ct][1] + wb), y2 = geluf_(bflo(uu.y)) * (acc[ct][2] + wb), y3 = geluf_(bfhi(uu.y)) * (acc[ct][3] + wb);
        *(unsigned*)(yp + c) = pk4_fp8(y0, y1, y2, y3); }
    __syncthreads();
}

constexpr int SP_ = 72;
__device__ __forceinline__ int kperm_pos(int k) { const int s5 = k & 31; return (k & 32) + 8 * ((s5 >> 2) & 3) + 4 * (s5 >> 4) + (s5 & 3); }
__device__ __forceinline__ void rwkv_prep_item(KArgs a, int l, int tile, int hgrp, LAS unsigned char* lds) {
    const int tid = tid_fresh(), lane = tid & 63, wave = tid >> 6;
    unsigned char* ws = a->ws;
    const bf16* P = (const bf16*)(ws + WS_P); bf16* Y = (bf16*)(ws + WS_Y);
    LAS bf16* SR = (LAS bf16*)lds; LAS bf16* SK = SR + 64 * SP_; LAS bf16* SV = SK + 64 * SP_; LAS bf16* SKK = SV + 64 * SP_; LAS bf16* SB = SKK + 64 * SP_; LAS bf16* SWF = SB + 64 * SP_; LAS bf16* SWB = SWF + 64 * SP_;
    LAS bf16* tw = SWB + 64 * SP_;
    LAS bf16* adl = tw + 64 * SP_;
    LAS bf16* sg = adl + 64 * SP_;
    LAS float* invn = (LAS float*)(sg + 64 * 136);
    LAS unsigned char* wpriv = (LAS unsigned char*)(invn + 64) + wave * 6144;
    const int row0 = tile * 64; const bool isl = row0 < NLAT;
    const float* mu = a->in[I_MU] + (size_t)l * CCOLS;
    const char* Pb = (const char*)P;
    auto shift_group = [&](int tk, int col, float (&z)[8]) {
        const int row = row0 + tk; int o0, o1, o2, o3; bool v0, v1, v2, v3;
        if (isl) { const int gr = (row >> 6) & 63; o0 = -1; o1 = 1; o2 = -64; o3 = 64; v0 = tk > 0; v1 = tk < 63; v2 = gr > 0; v3 = gr < 63; }
        else { const int tc = (row - NLAT) & 255; o0 = -1; o1 = 1; o2 = -1; o3 = 1; v0 = tc > 0; v1 = tc < 255; v2 = v0; v3 = v1; }
        const unsigned off = (unsigned)row * (unsigned)(INC * 2) + (unsigned)(OFF_C + col) * 2u;
        const u32x4 uo = *(const u32x4*)(Pb + off), u0 = *(const u32x4*)(Pb + (off + (unsigned)((v0 ? o0 : 0) * INC * 2))), u1 = *(const u32x4*)(Pb + (off + (unsigned)((v1 ? o1 : 0) * INC * 2))),
                    u2 = *(const u32x4*)(Pb + (off + (unsigned)((v2 ? o2 : 0) * INC * 2))), u3 = *(const u32x4*)(Pb + (off + (unsigned)((v3 ? o3 : 0) * INC * 2)));
        const f32x4 m0 = *(const f32x4*)(mu + col), m1 = *(const f32x4*)(mu + col + 4);
        float own[8], n0[8], n1[8], n2[8], n3[8]; unpack8(uo, own); unpack8(u0, n0); unpack8(u1, n1); unpack8(u2, n2); unpack8(u3, n3);
        const float f0 = v0 ? 1.f : 0.f, f1 = v1 ? 1.f : 0.f, f2 = v2 ? 1.f : 0.f, f3 = v3 ? 1.f : 0.f;
        const float nb[8] = {n0[0] * f0, n1[1] * f1, n2[2] * f2, n3[3] * f3, n0[4] * f0, n1[5] * f1, n2[6] * f2, n3[7] * f3};
#pragma unroll
        for (int j = 0; j < 8; ++j) { const float mm = j < 4 ? m0[j] : m1[j - 4]; z[j] = own[j] + mm * (nb[j] - own[j]); }
    };
#pragma unroll
    for (int it = 0; it < 4; ++it) { const int g = tid + NTHREADS * it, tk = g >> 5, gi = g & 31;
        float z[8]; shift_group(tk, 2304 + gi * 8, z);
        if (gi < 8) { float t8[8];
#pragma unroll
            for (int j = 0; j < 8; ++j) t8[j] = 1.0f - 2.0f * __builtin_amdgcn_rcpf(1.0f + __expf(2.0f * z[j]));
            *(LAS u32x4*)(tw + tk * SP_ + gi * 8) = pack8(t8); }
        else if (gi < 16) *(LAS u32x4*)(adl + tk * SP_ + (gi - 8) * 8) = pack8(z);
        else { float t8[8];
#pragma unroll
            for (int j = 0; j < 8; ++j) t8[j] = sigmoidf_(z[j]);
            *(LAS u32x4*)(sg + tk * 136 + (gi - 16) * 8) = pack8(t8); } }
    __syncthreads();
#pragma unroll 1
    for (int hh = 0; hh < 4; ++hh) {
    const int tid = tid_fresh(), lane = tid & 63, wave = tid >> 6;
    const int head = 4 * hgrp + hh; const float* kkw = a->in[I_KK] + (size_t)l * CW + head * 64;
#pragma unroll
    for (int it = 0; it < 3; ++it) { const int g = tid + NTHREADS * it, tk = g / 24, gi = g % 24, c8 = (gi & 7) * 8;
        float z[8]; shift_group(tk, (gi >> 3) * 768 + head * 64 + c8, z);
        if (gi < 8) *(LAS u32x4*)(SR + tk * SP_ + c8) = pack8(z);
        else if (gi < 16) { *(LAS u32x4*)(SK + tk * SP_ + c8) = pack8(z);
            const f32x4 k0 = *(const f32x4*)(kkw + c8), k1 = *(const f32x4*)(kkw + c8 + 4); float ss = 0.f;
#pragma unroll
            for (int j = 0; j < 8; ++j) { const float q = z[j] * (j < 4 ? k0[j] : k1[j - 4]); ss += q * q; }
            ss += __shfl_xor(ss, 1); ss += __shfl_xor(ss, 2); ss += __shfl_xor(ss, 4);
            if ((gi & 7) == 0) invn[tk] = 1.0f / fmaxf(sqrtf(ss), 1e-12f); }
        else *(LAS u32x4*)(SV + tk * SP_ + c8) = pack8(z); }
    __syncthreads();
    {
        const int fr = lane & 15, fq = lane >> 4, nt = wave & 3, th = wave >> 2;
        const bf16* wupT = (const bf16*)(ws + WS_SMALLW + SW_WUP) + (size_t)l * 2 * 768 * 64;
        const bf16* aupT = (const bf16*)(ws + WS_SMALLW + SW_AUP) + (size_t)l * 768 * 64;
        const bf16* gupT = (const bf16*)(ws + WS_SMALLW + SW_GUP) + (size_t)l * 768 * 128;
        const float* a0 = a->in[I_A0] + (size_t)l * CW + head * 64; const float* kaw = a->in[I_KA] + (size_t)l * CW + head * 64; const float* w0 = a->in[I_W0] + (size_t)l * 2 * CW + head * 64;
        const int nloc = 16 * nt + 4 * fq;
#pragma unroll 1
        for (int mat = 0; mat < 4; ++mat) {
            const bf16* WT = mat == 0 ? aupT : (mat == 1 ? wupT : (mat == 2 ? wupT + 768 * 64 : gupT));
            const int KK = mat == 3 ? 128 : 64; const LAS bf16* act = mat == 0 ? adl : (mat == 3 ? sg : tw); const int apitch = mat == 3 ? 136 : SP_;
            f32x4 acc[2];
            acc[0] = (f32x4){0.f, 0.f, 0.f, 0.f}; acc[1] = acc[0];
            for (int ks = 0; ks < KK / 32; ++ks) { const bf16x8 afr = *(const bf16x8*)(WT + (size_t)(head * 64 + 16 * nt + fr) * KK + ks * 32 + fq * 8);
#pragma unroll
                for (int tt = 0; tt < 2; ++tt) { const bf16x8 bfr = *(const LAS bf16x8*)(act + (16 * (2 * th + tt) + fr) * apitch + ks * 32 + fq * 8); acc[tt] = __builtin_amdgcn_mfma_f32_16x16x32_bf16(afr, bfr, acc[tt], 0, 0, 0); } }
#pragma unroll
            for (int tt = 0; tt < 2; ++tt) { const int tk = 16 * (2 * th + tt) + fr; const f32x4 v = acc[tt];
                if (mat == 0) {
                    const f32x4 a0v = *(const f32x4*)(a0 + nloc), kav = *(const f32x4*)(kaw + nloc), kkv = *(const f32x4*)(kkw + nloc);
                    const u32x2 kp = *(const LAS u32x2*)(SK + tk * SP_ + nloc); const float kf[4] = {bflo(kp.x), bfhi(kp.x), bflo(kp.y), bfhi(kp.y)};
                    const float inn = invn[tk]; float k2[4], kk[4], bb[4];
#pragma unroll
                    for (int j = 0; j < 4; ++j) { const float av = sigmoidf_(a0v[j] + v[j]); kk[j] = kf[j] * kkv[j] * inn; k2[j] = kf[j] * (1.0f + (av - 1.0f) * kav[j]); bb[j] = kk[j] * av; }
                    u32x2 q; q.x = pk2(k2[0], k2[1]); q.y = pk2(k2[2], k2[3]); *(LAS u32x2*)(SK + tk * SP_ + nloc) = q;
                    q.x = pk2(kk[0], kk[1]); q.y = pk2(kk[2], kk[3]); *(LAS u32x2*)(SKK + tk * SP_ + nloc) = q;
                    q.x = pk2(bb[0], bb[1]); q.y = pk2(bb[2], bb[3]); *(LAS u32x2*)(SB + tk * SP_ + nloc) = q;
                } else if (mat <= 2) {
                    const f32x4 w0v = *(const f32x4*)(w0 + (mat - 1) * CW + nloc); float d[4];
#pragma unroll
                    for (int j = 0; j < 4; ++j) d[j] = __expf(-DECAY_SCALE * sigmoidf_(w0v[j] + v[j]));
                    u32x2 q; q.x = pk2(d[0], d[1]); q.y = pk2(d[2], d[3]); *(LAS u32x2*)((mat == 1 ? SWF : SWB) + tk * SP_ + nloc) = q;
                } else {
                    u32x2 q; q.x = pk2(v[0], v[1]); q.y = pk2(v[2], v[3]); *(u32x2*)(Y + (size_t)(row0 + tk) * D + 1280 + head * 64 + nloc) = q;
                }
            }
        }
    }
    __syncthreads();
    { const int tk = tid >> 3, c8 = (tid & 7) * 8; float r8[8], k8[8], v8[8];
      unpack8(*(const LAS u32x4*)(SR + tk * SP_ + c8), r8); unpack8(*(const LAS u32x4*)(SK + tk * SP_ + c8), k8); unpack8(*(const LAS u32x4*)(SV + tk * SP_ + c8), v8);
      const float* rkp = a->in[I_RK] + (size_t)l * CW + head * 64 + c8; const f32x4 rk0 = *(const f32x4*)rkp, rk1 = *(const f32x4*)(rkp + 4);
      float bs = 0.f;
#pragma unroll
      for (int j = 0; j < 8; ++j) bs += r8[j] * k8[j] * (j < 4 ? rk0[j] : rk1[j - 4]);
      bs += __shfl_xor(bs, 1); bs += __shfl_xor(bs, 2); bs += __shfl_xor(bs, 4);
#pragma unroll
      for (int j = 0; j < 8; ++j) v8[j] *= bs;
      *(u32x4*)(Y + (size_t)(row0 + tk) * D + 512 + head * 64 + c8) = pack8(v8); }
    {
        const int c4 = wave & 3, dir = wave >> 2, fr = lane & 15, fq = lane >> 4;
        LAS float* CB = (LAS float*)wpriv;
        LAS float* AA = CB + 16 * 64;
        const LAS bf16* SW = dir ? SWB : SWF;
        auto trow = [&](int tau) { return 16 * c4 + (dir ? 15 - tau : tau); };
        float c[16], ci[16];
        { float run = 1.f;
#pragma unroll
          for (int t = 0; t < 16; ++t) { run *= bf1(SW[trow(t) * SP_ + lane]); c[t] = run; ci[t] = __builtin_amdgcn_rcpf(run); CB[t * 64 + lane] = run; } }
        const int rec_dir = dir, bidx = isl ? (row0 >> 12) : ((row0 - NLAT) >> 8);
        const int tcl = isl ? 4 * ((row0 >> 6) & 63) + c4 : 4 * (((row0 - NLAT) >> 6) & 3) + c4;
        const int nproc = isl ? 16 + (dir ? 255 - tcl : tcl) : (dir ? 15 - tcl : tcl);
        unsigned char* rec = ws + WS_PRE + ((size_t)((rec_dir * 8 + bidx) * 12 + head) * NCHUNK16 + nproc) * PRE_REC;
        { const float cl = c[15]; float bk[32];
#pragma unroll
          for (int t = 0; t < 16; ++t) { const float e = cl * ci[t]; const int pos = 8 * (t >> 2) + (t & 3); bk[pos] = bf1(SB[trow(t) * SP_ + lane]) * e; bk[pos + 4] = bf1(SK[trow(t) * SP_ + lane]) * e; }
#pragma unroll
          for (int q4 = 0; q4 < 4; ++q4) { u32x4 o; o.x = pk2(bk[8 * q4], bk[8 * q4 + 1]); o.y = pk2(bk[8 * q4 + 2], bk[8 * q4 + 3]); o.z = pk2(bk[8 * q4 + 4], bk[8 * q4 + 5]); o.w = pk2(bk[8 * q4 + 6], bk[8 * q4 + 7]);
              *(u32x4*)(rec + PR_BK + lane * 64 + q4 * 16) = o; }
          *(float*)(rec + PR_GAM + lane * 4) = cl; }
        asm volatile("s_waitcnt lgkmcnt(0)" ::: "memory");
        bf16x8 fa[2], frr[2], fb[2], fk[2];
        { const int tr = trow(fr);
#pragma unroll
          for (int sx = 0; sx < 2; ++sx) { const int ch = 32 * sx + 8 * fq; float kk8[8], r8[8], b8[8], k8[8];
              unpack8(*(const LAS u32x4*)(SKK + tr * SP_ + ch), kk8); unpack8(*(const LAS u32x4*)(SR + tr * SP_ + ch), r8); unpack8(*(const LAS u32x4*)(SB + tr * SP_ + ch), b8); unpack8(*(const LAS u32x4*)(SK + tr * SP_ + ch), k8);
              const f32x4 c0 = *(const LAS f32x4*)(CB + fr * 64 + ch), c1 = *(const LAS f32x4*)(CB + fr * 64 + ch + 4);
              f32x4 p0 = (f32x4){1.f, 1.f, 1.f, 1.f}, p1 = p0; if (fr > 0) { p0 = *(const LAS f32x4*)(CB + (fr - 1) * 64 + ch); p1 = *(const LAS f32x4*)(CB + (fr - 1) * 64 + ch + 4); }
              float xa[8], xr[8], xb[8], xk[8];
#pragma unroll
              for (int j = 0; j < 8; ++j) { const float ec = j < 4 ? c0[j] : c1[j - 4], ep = j < 4 ? p0[j] : p1[j - 4]; const float en = __builtin_amdgcn_rcpf(ec);
                  xa[j] = -kk8[j] * ep; xr[j] = r8[j] * ec; xb[j] = b8[j] * en; xk[j] = k8[j] * en; }
              const u32x4 ua = pack8(xa), ur = pack8(xr), ub = pack8(xb), uk = pack8(xk);
              fa[sx] = __builtin_bit_cast(bf16x8, ua); frr[sx] = __builtin_bit_cast(bf16x8, ur); fb[sx] = __builtin_bit_cast(bf16x8, ub); fk[sx] = __builtin_bit_cast(bf16x8, uk); } }
        f32x4 gab = (f32x4){0.f, 0.f, 0.f, 0.f}, gak = gab, grb = gab, grk = gab;
#pragma unroll
        for (int sx = 0; sx < 2; ++sx) { gab = __builtin_amdgcn_mfma_f32_16x16x32_bf16(fa[sx], fb[sx], gab, 0, 0, 0); gak = __builtin_amdgcn_mfma_f32_16x16x32_bf16(fa[sx], fk[sx], gak, 0, 0, 0);
            grb = __builtin_amdgcn_mfma_f32_16x16x32_bf16(frr[sx], fb[sx], grb, 0, 0, 0); grk = __builtin_amdgcn_mfma_f32_16x16x32_bf16(frr[sx], fk[sx], grk, 0, 0, 0); }
#pragma unroll
        for (int j = 0; j < 4; ++j) { const int tau = 4 * fq + j; const bool lo = fr < tau, le = fr <= tau;
            AA[tau * 16 + fr] = lo ? gab[j] : 0.f; AA[256 + tau * 16 + fr] = lo ? gak[j] : 0.f; grb[j] = le ? grb[j] : 0.f; grk[j] = le ? grk[j] : 0.f; }
        asm volatile("s_waitcnt lgkmcnt(0)" ::: "memory");
        float wv[16], mv[16];
#pragma unroll
        for (int t = 0; t < 16; ++t) { const float ab = -bf1(SKK[trow(t) * SP_ + lane]) * (t > 0 ? c[t - 1] : 1.0f); float accw = ab, accm = AA[256 + t * 16 + fr];
#pragma unroll
            for (int q4 = 0; q4 < 4; ++q4) { if (4 * q4 < t) { const f32x4 cf = *(const LAS f32x4*)(AA + t * 16 + 4 * q4);
#pragma unroll
                for (int j = 0; j < 4; ++j) if (4 * q4 + j < t) { accw += cf[j] * wv[4 * q4 + j]; accm += cf[j] * mv[4 * q4 + j]; } } }
            wv[t] = accw; mv[t] = accm; }
        { LAS bf16* stg = (LAS bf16*)CB; const int pp = kperm_pos(lane);
#pragma unroll
          for (int t = 0; t < 16; ++t) { stg[t * 64 + pp] = (bf16)f2bf(wv[t]); stg[1024 + t * 64 + pp] = (bf16)f2bf(bf1(SR[trow(t) * SP_ + lane]) * c[t]); }
          asm volatile("s_waitcnt lgkmcnt(0)" ::: "memory");
#pragma unroll
          for (int q4 = 0; q4 < 4; ++q4) *(u32x4*)(rec + PR_WP + (q4 * 64 + lane) * 16) = *(const LAS u32x4*)((LAS unsigned char*)stg + (q4 * 64 + lane) * 16); }
        { LAS bf16* stg = (LAS bf16*)AA; const int ps = 8 * (fr >> 2) + (fr & 3);
          asm volatile("s_waitcnt lgkmcnt(0)" ::: "memory");
#pragma unroll
          for (int j = 0; j < 4; ++j) { const int tau = 4 * fq + j; stg[tau * 32 + ps] = (bf16)f2bf(grb[j]); stg[tau * 32 + ps + 4] = (bf16)f2bf(grk[j]); }
          if (lane < 16) {
#pragma unroll
              for (int t = 0; t < 16; ++t) stg[512 + t * 16 + lane] = (bf16)f2bf(mv[t]); }
          asm volatile("s_waitcnt lgkmcnt(0)" ::: "memory");
          *(u32x4*)(rec + PR_ARBK + lane * 16) = *(const LAS u32x4*)((LAS unsigned char*)stg + lane * 16);
          if (lane < 32) *(u32x4*)(rec + PR_ARBK + 1024 + lane * 16) = *(const LAS u32x4*)((LAS unsigned char*)stg + 1024 + lane * 16); }
        if (dir == 0) { float v16[16];
#pragma unroll
            for (int t = 0; t < 16; ++t) v16[t] = bf1(SV[(16 * c4 + t) * SP_ + lane]);
            const int tcg = isl ? 16 + tcl : tcl;
            unsigned char* vrec = ws + WS_VT + ((size_t)(bidx * 12 + head) * NCHUNK16 + tcg) * 2048 + lane * 32;
            u32x4 o; o.x = pk2(v16[0], v16[1]); o.y = pk2(v16[2], v16[3]); o.z = pk2(v16[4], v16[5]); o.w = pk2(v16[6], v16[7]); *(u32x4*)vrec = o;
            o.x = pk2(v16[8], v16[9]); o.y = pk2(v16[10], v16[11]); o.z = pk2(v16[12], v16[13]); o.w = pk2(v16[14], v16[15]); *(u32x4*)(vrec + 16) = o; }
    }
    __syncthreads();
    }
}

__device__ __forceinline__ float dpp_xor1(float x) { return __builtin_bit_cast(float, __builtin_amdgcn_update_dpp(0, __builtin_bit_cast(int, x), 0xB1, 0xF, 0xF, false)); }
__device__ __forceinline__ float dpp_xor2(float x) { return __builtin_bit_cast(float, __builtin_amdgcn_update_dpp(0, __builtin_bit_cast(int, x), 0x4E, 0xF, 0xF, false)); }
__device__ __forceinline__ int chain_row(int dir, int b, int s) {
    if (s < CTXL) return NLAT + b * CTXL + (dir ? (CTXL - 1 - s) : s);
    const int t = s - CTXL; return b * T + (dir ? (T - 1 - t) : t);
}
__device__ __forceinline__ float dpp_hmirror(float x) { return __builtin_bit_cast(float, __builtin_amdgcn_update_dpp(0, __builtin_bit_cast(int, x), 0x141, 0xF, 0xF, false)); }
struct RwRec { u32x4 wp[2], rp[2], bk[4], arbk; u32x2 mak, vt[2]; f32x4 gam[4]; };
__device__ __forceinline__ void rw_load(RwRec& r, const LAS unsigned char* rec, int fr, int kg, int hv, int dir) {
#pragma unroll
    for (int sx = 0; sx < 2; ++sx) { r.wp[sx] = *(const LAS u32x4*)(rec + PR_WP + fr * 128 + sx * 64 + kg * 16); r.rp[sx] = *(const LAS u32x4*)(rec + PR_RP + fr * 128 + sx * 64 + kg * 16); }
#pragma unroll
    for (int i = 0; i < 4; ++i) { r.bk[i] = *(const LAS u32x4*)(rec + PR_BK + (16 * i + fr) * 64 + kg * 16); r.gam[i] = *(const LAS f32x4*)(rec + PR_GAM + (16 * i + 4 * kg) * 4); }
    r.arbk = *(const LAS u32x4*)(rec + PR_ARBK + fr * 64 + kg * 16);
    r.mak = *(const LAS u32x2*)(rec + PR_MAK + fr * 32 + kg * 8);
#pragma unroll
    for (int q = 0; q < 2; ++q) r.vt[q] = *(const LAS u32x2*)(rec + PRE_REC + (16 * (2 * hv + q) + fr) * 32 + (dir ? (12 - 4 * kg) : 4 * kg) * 2);
}
constexpr int RW_R = 6, RW_SLOT = PRE_REC + 2048;
__device__ __forceinline__ void rwkv_chain_mfma(KArgs a, int task_base, LAS unsigned char* lds) {
    const int t_ = tid_fresh(); const int lane = t_ & 63, fr = lane & 15, kg = lane >> 4; const int wave = __builtin_amdgcn_readfirstlane(t_ >> 6);
    unsigned char* ws = a->ws;
    bf16* OC = (bf16*)(ws + WS_OC);
    const int cid = (task_base >> 2) + (wave >> 2), wq = wave & 3, dir = cid / 96, b = (cid % 96) / 12, h = cid % 12;
    const bool comp = wq < 2; const int hv = wq & 1;
    const unsigned char* rec0 = ws + WS_PRE + (size_t)((dir * 8 + b) * 12 + h) * NCHUNK16 * PRE_REC;
    const unsigned char* vrec0 = ws + WS_VT + (size_t)(b * 12 + h) * NCHUNK16 * 2048;
    LAS unsigned char* ring = lds + (wave >> 2) * (RW_R * RW_SLOT);
    auto tchunk = [&](int n) { return n < 16 ? (dir ? 15 - n : n) : 16 + (dir ? 255 - (n - 16) : (n - 16)); };
    auto issue = [&](int n) { const int nn = n < NCHUNK16 ? n : NCHUNK16 - 1; LAS unsigned char* slot = ring + (n % RW_R) * RW_SLOT;
#pragma unroll
        for (int jj = 0; jj < 3; ++jj) { const int j = 3 * wq + jj;
            const unsigned char* src = (j < 10 ? rec0 + (size_t)nn * PRE_REC + 1024 * j : vrec0 + (size_t)tchunk(nn) * 2048 + 1024 * (j - 10)) + lane * 16;
            __builtin_amdgcn_global_load_lds((const unsigned*)src, (LAS unsigned*)(slot + 1024 * j), 16, 0, 0); } };
    f32x4 ST[2][4];
#pragma unroll
    for (int q = 0; q < 2; ++q)
#pragma unroll
        for (int i = 0; i < 4; ++i) ST[q][i] = (f32x4){0.f, 0.f, 0.f, 0.f};
    unsigned uvU[2][2] = {{0u, 0u}, {0u, 0u}};
#pragma unroll
    for (int n = 0; n < RW_R - 1; ++n) issue(n);
    for (int n = 0; n < NCHUNK16; ++n) {
        if (comp && n >= RW_R - 1) asm volatile("s_waitcnt vmcnt(22)" ::: "memory"); else asm volatile("s_waitcnt vmcnt(12)" ::: "memory");
        __builtin_amdgcn_s_barrier(); asm volatile("" ::: "memory");
        issue(n + RW_R - 1);
        if (comp) {
            RwRec cur; rw_load(cur, ring + (n % RW_R) * RW_SLOT, fr, kg, hv, dir);
            u32x4 fmak; fmak.x = 0u; fmak.y = 0u; fmak.z = cur.mak.x; fmak.w = cur.mak.y;
            const int row = chain_row(dir, b, 16 * n + fr);
#pragma unroll
            for (int q = 0; q < 2; ++q) {
                u32x4 fs[2];
#pragma unroll
                for (int sx = 0; sx < 2; ++sx) { fs[sx].x = pk2(ST[q][2 * sx][0], ST[q][2 * sx][1]); fs[sx].y = pk2(ST[q][2 * sx][2], ST[q][2 * sx][3]); fs[sx].z = pk2(ST[q][2 * sx + 1][0], ST[q][2 * sx + 1][1]); fs[sx].w = pk2(ST[q][2 * sx + 1][2], ST[q][2 * sx + 1][3]); }
                u32x2 vt = cur.vt[q]; if (dir) { const unsigned x = vt.x, y = vt.y; vt.x = (y >> 16) | (y << 16); vt.y = (x >> 16) | (x << 16); }
                u32x4 fuv; fuv.x = uvU[q][0]; fuv.y = uvU[q][1]; fuv.z = vt.x; fuv.w = vt.y;
                f32x4 U = (f32x4){0.f, 0.f, 0.f, 0.f};
                U = __builtin_amdgcn_mfma_f32_16x16x32_bf16(__builtin_bit_cast(bf16x8, cur.wp[0]), __builtin_bit_cast(bf16x8, fs[0]), U, 0, 0, 0);
                U = __builtin_amdgcn_mfma_f32_16x16x32_bf16(__builtin_bit_cast(bf16x8, cur.wp[1]), __builtin_bit_cast(bf16x8, fs[1]), U, 0, 0, 0);
                U = __builtin_amdgcn_mfma_f32_16x16x32_bf16(__builtin_bit_cast(bf16x8, fmak), __builtin_bit_cast(bf16x8, fuv), U, 0, 0, 0);
                uvU[q][0] = pk2(U[0], U[1]); uvU[q][1] = pk2(U[2], U[3]); fuv.x = uvU[q][0]; fuv.y = uvU[q][1];
                f32x4 OT = (f32x4){0.f, 0.f, 0.f, 0.f};
                OT = __builtin_amdgcn_mfma_f32_16x16x32_bf16(__builtin_bit_cast(bf16x8, fs[0]), __builtin_bit_cast(bf16x8, cur.rp[0]), OT, 0, 0, 0);
                OT = __builtin_amdgcn_mfma_f32_16x16x32_bf16(__builtin_bit_cast(bf16x8, fs[1]), __builtin_bit_cast(bf16x8, cur.rp[1]), OT, 0, 0, 0);
                OT = __builtin_amdgcn_mfma_f32_16x16x32_bf16(__builtin_bit_cast(bf16x8, fuv), __builtin_bit_cast(bf16x8, cur.arbk), OT, 0, 0, 0);
#pragma unroll
                for (int i = 0; i < 4; ++i) ST[q][i] = __builtin_amdgcn_mfma_f32_16x16x32_bf16(__builtin_bit_cast(bf16x8, cur.bk[i]), __builtin_bit_cast(bf16x8, fuv), ST[q][i] * cur.gam[i], 0, 0, 0);
                u32x2 o; o.x = pk2(OT[0], OT[1]); o.y = pk2(OT[2], OT[3]); *(u32x2*)(OC + ((size_t)dir * MALL + row) * CW + h * 64 + 16 * (2 * hv + q) + 4 * kg) = o;
            }
        }
    }
    asm volatile("s_waitcnt vmcnt(0)" ::: "memory");
    __builtin_amdgcn_s_barrier(); asm volatile("" ::: "memory");
}
#define LDS_BAR() do { asm volatile("s_waitcnt lgkmcnt(0)" ::: "memory"); __builtin_amdgcn_s_barrier(); asm volatile("" ::: "memory"); } while (0)
__device__ __forceinline__ void hgrn_prep_item(KArgs a, int l, int item, LAS unsigned char* lds, bool dry) {
    const int tid = tid_fresh();
    unsigned char* ws = a->ws;
    bf16* P = (bf16*)(ws + WS_P); bf16* HQB = (bf16*)(ws + WS_HQB); float* HG = (float*)(ws + WS_HG);
    const int cn = item % 68, bh = item / 68, h = bh % 6, b = bh / 6;
    const int row0 = cn < 4 ? NLAT + b * CTXL + 64 * cn : b * T + 64 * (cn - 4);
    constexpr int QP = 136;
    LAS bf16* SQ = (LAS bf16*)lds; LAS bf16* KF = SQ + 64 * QP; LAS bf16* KB = KF + 64 * QP; LAS bf16* QB = KB + 64 * QP;
    LAS float* LF = (LAS float*)(QB + 64 * QP); LAS float* LBk = LF + 64 * 128;
    LAS float* tot = LBk + 64 * 128;
    LAS float* lbs = tot + 1024;
    if (tid < 256) { const int dr = tid >> 7, ch = h * 128 + (tid & 127); float lb = 0.f;
        if (l != 0) { const float l0 = a->in[I_LB][((size_t)dr * DEPTH + 0) * BW + ch], l1 = a->in[I_LB][((size_t)dr * DEPTH + 1) * BW + ch]; lb = __builtin_amdgcn_rcpf(1.0f + __expf(l0 - l1)); }
        lbs[tid] = lb; }
    const int ta = tid >> 3, d0 = (tid & 7) * 16;
    bf16* prow = P + (size_t)(row0 + ta) * INC + h * 128 + d0;
    u32x4 rq[2], rf[2], rb[2];
    rq[0] = *(const u32x4*)(prow + OFF_Q); rq[1] = *(const u32x4*)(prow + OFF_Q + 8); rf[0] = *(const u32x4*)(prow + OFF_ZF); rf[1] = *(const u32x4*)(prow + OFF_ZF + 8); rb[0] = *(const u32x4*)(prow + OFF_ZB); rb[1] = *(const u32x4*)(prow + OFF_ZB + 8);
    __syncthreads();
#pragma unroll
    for (int hf = 0; hf < 2; ++hf) { float qf[8], zf[8], zb[8], oq[8], of[8], ob[8]; unpack8(rq[hf], qf); unpack8(rf[hf], zf); unpack8(rb[hf], zb);
        const int dd = d0 + 8 * hf; f32x4 lf0, lf1, lb0, lb1;
#pragma unroll
        for (int j = 0; j < 8; ++j) { const float lF = lbs[dd + j], lB = lbs[128 + dd + j];
            const float ff = lF + (1.0f - lF) * sigmoidf_(zf[j]), fb = lB + (1.0f - lB) * sigmoidf_(zb[j]);
            const float a1 = fmaxf(__logf(ff), -60.0f), a2 = fmaxf(__logf(fb), -60.0f);
            if (j < 4) { lf0[j] = a1; lb0[j] = a2; } else { lf1[j - 4] = a1; lb1[j - 4] = a2; }
            oq[j] = siluf_(qf[j]); of[j] = 1.0f - ff; ob[j] = 1.0f - fb; }
        *(LAS u32x4*)(SQ + ta * QP + dd) = pack8(oq); *(LAS u32x4*)(KF + ta * QP + dd) = pack8(of); *(LAS u32x4*)(KB + ta * QP + dd) = pack8(ob);
        *(LAS f32x4*)(LF + ta * 128 + dd) = lf0; *(LAS f32x4*)(LF + ta * 128 + dd + 4) = lf1; *(LAS f32x4*)(LBk + ta * 128 + dd) = lb0; *(LAS f32x4*)(LBk + ta * 128 + dd + 4) = lb1; }
    __syncthreads();
    { const int d = tid & 127, qt = tid >> 7; float r1 = 0.f, r2 = 0.f;
#pragma unroll
      for (int i = 0; i < 16; ++i) { const int tp = 16 * qt + i; r1 += LF[tp * 128 + d]; LF[tp * 128 + d] = r1; r2 += LBk[(63 - tp) * 128 + d]; LBk[(63 - tp) * 128 + d] = r2; }
      tot[qt * 128 + d] = r1; tot[512 + qt * 128 + d] = r2; }
    __syncthreads();
    LAS float* bas = lbs + 256;
    LAS float* bmd = bas + 1024;
    { const int d = tid & 127, dr = (tid >> 7) & 1; if (tid < 256) { const LAS float* tt = tot + 512 * dr; const float t0 = tt[d], t1 = tt[128 + d], t2 = tt[256 + d], t3 = tt[384 + d];
        bas[(dr * 4 + 0) * 128 + d] = 0.f; bas[(dr * 4 + 1) * 128 + d] = t0; bas[(dr * 4 + 2) * 128 + d] = t0 + t1; bas[(dr * 4 + 3) * 128 + d] = t0 + t1 + t2; bmd[dr * 128 + d] = t0 + t1;
        const int npr = dr == 0 ? cn : (cn < 4 ? 3 - cn : 4 + 63 - (cn - 4)); float* g = (dry ? (float*)(ws + WS_END + 8 * MiB) : HG) + ((size_t)(((dr * 8 + b) * 6 + h) * 68 + npr)) * 256; g[d] = __expf(t0 + t1); g[128 + d] = __expf(t2 + t3); } }
    __syncthreads();
#pragma unroll
    for (int hf = 0; hf < 2; ++hf) { const int dd = d0 + 8 * hf; float sq[8], kf[8], kb[8];
        unpack8(*(const LAS u32x4*)(SQ + ta * QP + dd), sq); unpack8(*(const LAS u32x4*)(KF + ta * QP + dd), kf); unpack8(*(const LAS u32x4*)(KB + ta * QP + dd), kb);
        float oqf[8], okf[8], oqb[8], okb[8];
#pragma unroll
        for (int dr = 0; dr < 2; ++dr) { const int tp = dr ? 63 - ta : ta, q = tp >> 4; const LAS float* pf = (dr ? LBk : LF) + ta * 128 + dd;
            const f32x4 p0 = *(const LAS f32x4*)pf, p1 = *(const LAS f32x4*)(pf + 4), b0 = *(const LAS f32x4*)(bas + (dr * 4 + q) * 128 + dd), b1 = *(const LAS f32x4*)(bas + (dr * 4 + q) * 128 + dd + 4),
                        m0 = *(const LAS f32x4*)(bmd + dr * 128 + dd), m1 = *(const LAS f32x4*)(bmd + dr * 128 + dd + 4);
#pragma unroll
            for (int j = 0; j < 8; ++j) { const float bt = (j < 4 ? p0[j] + b0[j] : p1[j - 4] + b1[j - 4]), bm = j < 4 ? m0[j] : m1[j - 4];
                const float eq = __expf(fminf(bt - bm, 80.0f)), ek = __expf(fminf(bm - bt, 80.0f));
                if (dr == 0) { oqf[j] = sq[j] * eq; okf[j] = kf[j] * ek; } else { oqb[j] = sq[j] * eq; okb[j] = kb[j] * ek; } } }
        *(LAS u32x4*)(QB + ta * QP + dd) = pack8(oqf); *(LAS u32x4*)(KF + ta * QP + dd) = pack8(okf); *(LAS u32x4*)(KB + ta * QP + dd) = pack8(okb); *(LAS u32x4*)(SQ + ta * QP + dd) = pack8(oqb); }
    bf16* prow_o = dry ? (bf16*)(ws + WS_END) + (size_t)((row0 + ta) & 511) * INC + h * 128 + d0 : prow; bf16* hqb_o = dry ? (bf16*)(ws + WS_END) : HQB;
#pragma unroll
    for (int hf = 0; hf < 2; ++hf) { const int dd = d0 + 8 * hf;
        *(u32x4*)(prow_o + OFF_Q + 8 * hf) = *(const LAS u32x4*)(QB + ta * QP + dd); *(u32x4*)(prow_o + OFF_ZF + 8 * hf) = *(const LAS u32x4*)(KF + ta * QP + dd); *(u32x4*)(prow_o + OFF_ZB + 8 * hf) = *(const LAS u32x4*)(KB + ta * QP + dd);
        *(u32x4*)(hqb_o + (size_t)(dry ? ((row0 + ta) & 1023) : (row0 + ta)) * BW + h * 128 + dd) = *(const LAS u32x4*)(SQ + ta * QP + dd); }
    __syncthreads();
}
__device__ __forceinline__ unsigned tr_addr(const LAS bf16* X, int pitch, int r0, int c0, int lane) { const int i = lane & 15, g = lane >> 4; return (unsigned)(size_t)(X + (r0 + 8 * g + (i >> 2)) * pitch + c0 + 4 * (i & 3)); }
__device__ __forceinline__ void tr8x4(u32x2 (&lo)[4], u32x2 (&hi)[4], unsigned a0, unsigned a1, unsigned a2, unsigned a3, unsigned rowstep4) {
    const unsigned b0 = a0 + rowstep4, b1 = a1 + rowstep4, b2 = a2 + rowstep4, b3 = a3 + rowstep4;
    asm volatile("ds_read_b64_tr_b16 %0, %8\n\tds_read_b64_tr_b16 %1, %9\n\tds_read_b64_tr_b16 %2, %10\n\tds_read_b64_tr_b16 %3, %11\n\t"
                 "ds_read_b64_tr_b16 %4, %12\n\tds_read_b64_tr_b16 %5, %13\n\tds_read_b64_tr_b16 %6, %14\n\tds_read_b64_tr_b16 %7, %15\n\ts_waitcnt lgkmcnt(0)"
                 : "=&v"(lo[0]), "=&v"(lo[1]), "=&v"(lo[2]), "=&v"(lo[3]), "=&v"(hi[0]), "=&v"(hi[1]), "=&v"(hi[2]), "=&v"(hi[3])
                 : "v"(a0), "v"(a1), "v"(a2), "v"(a3), "v"(b0), "v"(b1), "v"(b2), "v"(b3) : "memory");
}
__device__ __forceinline__ void tr_half(u32x2 (&vl)[8], u32x2 (&vh)[8], u32x2 (&xl)[2], u32x2 (&xh)[2], unsigned av, unsigned ak, unsigned ax) {
    asm volatile(
        "ds_read_b64_tr_b16 %0, %20\n\tds_read_b64_tr_b16 %1, %20 offset:32\n\tds_read_b64_tr_b16 %2, %20 offset:64\n\tds_read_b64_tr_b16 %3, %20 offset:96\n\t"
        "ds_read_b64_tr_b16 %4, %20 offset:128\n\tds_read_b64_tr_b16 %5, %20 offset:160\n\tds_read_b64_tr_b16 %6, %20 offset:192\n\tds_read_b64_tr_b16 %7, %20 offset:224\n\t"
        "ds_read_b64_tr_b16 %8, %20 offset:1088\n\tds_read_b64_tr_b16 %9, %20 offset:1120\n\tds_read_b64_tr_b16 %10, %20 offset:1152\n\tds_read_b64_tr_b16 %11, %20 offset:1184\n\t"
        "ds_read_b64_tr_b16 %12, %20 offset:1216\n\tds_read_b64_tr_b16 %13, %20 offset:1248\n\tds_read_b64_tr_b16 %14, %20 offset:1280\n\tds_read_b64_tr_b16 %15, %20 offset:1312\n\t"
        "ds_read_b64_tr_b16 %16, %21\n\tds_read_b64_tr_b16 %17, %22\n\tds_read_b64_tr_b16 %18, %21 offset:1088\n\tds_read_b64_tr_b16 %19, %22 offset:1088\n\ts_waitcnt lgkmcnt(0)"
        : "=&v"(vl[0]), "=&v"(vl[1]), "=&v"(vl[2]), "=&v"(vl[3]), "=&v"(vl[4]), "=&v"(vl[5]), "=&v"(vl[6]), "=&v"(vl[7]),
          "=&v"(vh[0]), "=&v"(vh[1]), "=&v"(vh[2]), "=&v"(vh[3]), "=&v"(vh[4]), "=&v"(vh[5]), "=&v"(vh[6]), "=&v"(vh[7]),
          "=&v"(xl[0]), "=&v"(xl[1]), "=&v"(xh[0]), "=&v"(xh[1])
        : "v"(av), "v"(ak), "v"(ax) : "memory");
}
__device__ __forceinline__ bf16x8 mk8(u32x2 lo, u32x2 hi) { u32x4 v; v.x = lo.x; v.y = lo.y; v.z = hi.x; v.w = hi.y; return __builtin_bit_cast(bf16x8, v); }
__device__ __forceinline__ void hgrn_chain_lean(KArgs a, int cid, LAS unsigned char* lds) {
    const int tid = tid_fresh(), lane = tid & 63, wave = tid >> 6, fr = lane & 15, fq = lane >> 4;
    unsigned char* ws = a->ws;
    const bf16* P = (const bf16*)(ws + WS_P); const bf16* HQB = (const bf16*)(ws + WS_HQB); const float* HG = (const float*)(ws + WS_HG); bf16* OB = (bf16*)(ws + WS_OB);
    const int dir = cid / 48, b = (cid % 48) / 6, h = cid % 6;
    constexpr int QP = 136, SP = 72;
    LAS bf16* qs = (LAS bf16*)lds;
    LAS bf16* ks = qs + 64 * QP;
    LAS bf16* vs = ks + 64 * QP;
    LAS bf16* pl = vs + 64 * QP;
    LAS bf16* sT = pl + 64 * SP;
    LAS float* gm = (LAS float*)(sT + 128 * QP);
    const int ta = tid >> 3, d0 = (tid & 7) * 16;
    const int koff = dir ? OFF_ZB : OFF_ZF;
    f32x4 S[8];
#pragma unroll
    for (int vt = 0; vt < 8; ++vt) S[vt] = (f32x4){0.f, 0.f, 0.f, 0.f};
    u32x4 rq[2], rk[2], rv[2]; float rg = 0.f;
    auto load_chunk = [&](int n) { const int row = chain_row(dir, b, 64 * n + ta); const bf16* pr = P + (size_t)row * INC + h * 128 + d0;
        const bf16* qr = dir ? HQB + (size_t)row * BW + h * 128 + d0 : pr + OFF_Q;
        rq[0] = *(const u32x4*)qr; rq[1] = *(const u32x4*)(qr + 8); rk[0] = *(const u32x4*)(pr + koff); rk[1] = *(const u32x4*)(pr + koff + 8); rv[0] = *(const u32x4*)(pr + OFF_I); rv[1] = *(const u32x4*)(pr + OFF_I + 8);
        if (tid < 256) rg = HG[((size_t)(((dir * 8 + b) * 6 + h) * 68 + n)) * 256 + tid]; };
    load_chunk(0);
    constexpr int NCH = (CTXL + T) / 64;
    for (int n = 0; n < NCH; ++n) {
        const int s0 = n * 64;
        *(LAS u32x4*)(qs + ta * QP + d0) = rq[0]; *(LAS u32x4*)(qs + ta * QP + d0 + 8) = rq[1]; *(LAS u32x4*)(ks + ta * QP + d0) = rk[0]; *(LAS u32x4*)(ks + ta * QP + d0 + 8) = rk[1];
        *(LAS u32x4*)(vs + ta * QP + d0) = rv[0]; *(LAS u32x4*)(vs + ta * QP + d0 + 8) = rv[1]; if (tid < 256) gm[tid] = rg;
        if (n + 1 < NCH) load_chunk(n + 1);
        LDS_BAR();
        { const f32x4 g4 = *(const LAS f32x4*)(gm + 16 * wave + 4 * fq);
#pragma unroll
          for (int vt = 0; vt < 8; ++vt) { S[vt] = S[vt] * g4; u32x2 o; o.x = pk2(S[vt][0], S[vt][1]); o.y = pk2(S[vt][2], S[vt][3]); *(LAS u32x2*)(sT + (16 * vt + fr) * QP + 16 * wave + 4 * fq) = o; } }
        { const int tt = wave >> 1;
#pragma unroll
          for (int u = 0; u < 2; ++u) { const int sg = 2 * (wave & 1) + u; f32x4 acc = (f32x4){0.f, 0.f, 0.f, 0.f};
              if (sg <= tt) {
#pragma unroll
                  for (int kq = 0; kq < 4; ++kq) { const bf16x8 af = *(const LAS bf16x8*)(ks + (16 * sg + fr) * QP + 32 * kq + 8 * fq), bfm = *(const LAS bf16x8*)(qs + (16 * tt + fr) * QP + 32 * kq + 8 * fq);
                      acc = __builtin_amdgcn_mfma_f32_16x16x32_bf16(af, bfm, acc, 0, 0, 0); }
                  if (sg == tt) {
#pragma unroll
                      for (int j = 0; j < 4; ++j) if (4 * fq + j > fr) acc[j] = 0.f; }
              }
              u32x2 o; o.x = pk2(acc[0], acc[1]); o.y = pk2(acc[2], acc[3]); *(LAS u32x2*)(pl + (16 * tt + fr) * SP + 16 * sg + 4 * fq) = o; } }
        LDS_BAR();
        f32x4 oacc[4];
#pragma unroll
        for (int tt = 0; tt < 4; ++tt) { f32x4 acc = (f32x4){0.f, 0.f, 0.f, 0.f};
#pragma unroll
            for (int kq = 0; kq < 4; ++kq) { const bf16x8 af = *(const LAS bf16x8*)(sT + (16 * wave + fr) * QP + 32 * kq + 8 * fq), bfm = *(const LAS bf16x8*)(qs + (16 * tt + fr) * QP + 32 * kq + 8 * fq);
                acc = __builtin_amdgcn_mfma_f32_16x16x32_bf16(af, bfm, acc, 0, 0, 0); }
            oacc[tt] = acc; }
        const unsigned rs4 = (unsigned)(4 * QP * 2);
#pragma unroll
        for (int kq = 0; kq < 2; ++kq) {
            u32x2 vl_[8], vh_[8], xl_[2], xh_[2];
            static_assert(QP == 136, "tr_half's immediates assume 272-byte rows");
            tr_half(vl_, vh_, xl_, xh_, tr_addr(vs, QP, 32 * kq, 0, lane), tr_addr(ks, QP, 32 * kq, 16 * wave, lane), tr_addr(vs, QP, 32 * kq, 16 * wave, lane));
            __builtin_amdgcn_sched_barrier(0);
            { const bf16x8 af = mk8(xl_[1], xh_[1]);
#pragma unroll
              for (int tt = 0; tt < 4; ++tt) { const bf16x8 bfm = *(const LAS bf16x8*)(pl + (16 * tt + fr) * SP + 32 * kq + 8 * fq); oacc[tt] = __builtin_amdgcn_mfma_f32_16x16x32_bf16(af, bfm, oacc[tt], 0, 0, 0); } }
            { const bf16x8 af = mk8(xl_[0], xh_[0]);
#pragma unroll
              for (int vt = 0; vt < 8; ++vt) S[vt] = __builtin_amdgcn_mfma_f32_16x16x32_bf16(af, mk8(vl_[vt], vh_[vt]), S[vt], 0, 0, 0); }
        }
#pragma unroll
        for (int tt = 0; tt < 4; ++tt) { const int row = chain_row(dir, b, s0 + 16 * tt + fr);
            u32x2 o; o.x = pk2(oacc[tt][0], oacc[tt][1]); o.y = pk2(oacc[tt][2], oacc[tt][3]); *(u32x2*)(OB + ((size_t)dir * MALL + row) * BW + h * 128 + 16 * wave + 4 * fq) = o; }
        { const f32x4 ge = *(const LAS f32x4*)(gm + 128 + 16 * wave + 4 * fq);
#pragma unroll
          for (int vt = 0; vt < 8; ++vt) S[vt] = S[vt] * ge; }
        LDS_BAR();
    }
}
__device__ __forceinline__ void hgrn_chain_mfma(KArgs a, int l, int cid, LAS unsigned char* lds) {
    const int tid = tid_fresh(), lane = tid & 63, wave = tid >> 6, fr = lane & 15, fq = lane >> 4;
    unsigned char* ws = a->ws;
    const bf16* P = (const bf16*)(ws + WS_P); bf16* OB = (bf16*)(ws + WS_OB);
    const int dir = cid / 48, b = (cid % 48) / 6, h = cid % 6;
    constexpr int QP = 136, SP = 72;
    LAS bf16* qs = (LAS bf16*)lds;
    LAS bf16* ks = qs + 64 * QP;
    LAS bf16* kT = ks + 64 * QP;
    LAS bf16* vT = kT + 128 * SP;
    LAS bf16* pl = vT + 128 * SP;
    LAS bf16* sT = pl + 64 * SP;
    LAS float* tot = (LAS float*)(sT + 128 * QP);
    LAS float* gmid = tot + 512;
    LAS float* gend = gmid + 128;
    LAS float* lbs = gend + 128;
    LAS float* lfb = (LAS float*)sT;
    const int d = tid & 127, qt = tid >> 7;
    const int tau_a = tid >> 3, d0 = (tid & 7) * 16;
    if (tid < 128) { const int ch = h * 128 + tid; float lb = 0.f;
        if (l != 0) { const float l0 = a->in[I_LB][((size_t)dir * DEPTH + 0) * BW + ch], l1 = a->in[I_LB][((size_t)dir * DEPTH + 1) * BW + ch]; lb = 1.0f / (1.0f + __expf(l0 - l1)); }
        lbs[tid] = lb; }
    f32x4 S[8];
#pragma unroll
    for (int vt = 0; vt < 8; ++vt) S[vt] = (f32x4){0.f, 0.f, 0.f, 0.f};
    const int zoff = dir ? OFF_ZB : OFF_ZF;
    u32x4 rq[2], ri[2], rz[2];
    { const bf16* pr = P + (size_t)chain_row(dir, b, tau_a) * INC + h * 128 + d0;
      rq[0] = *(const u32x4*)(pr + OFF_Q); rq[1] = *(const u32x4*)(pr + OFF_Q + 8); ri[0] = *(const u32x4*)(pr + OFF_I); ri[1] = *(const u32x4*)(pr + OFF_I + 8); rz[0] = *(const u32x4*)(pr + zoff); rz[1] = *(const u32x4*)(pr + zoff + 8); }
    __syncthreads();
    constexpr int NCH = (CTXL + T) / 64;
    for (int n = 0; n < NCH; ++n) {
        const int s0 = n * 64;
#pragma unroll
        for (int hf = 0; hf < 2; ++hf) { float qf[8], zf[8], oq[8], ok[8]; unpack8(rq[hf], qf); unpack8(rz[hf], zf);
            const int dd = d0 + 8 * hf; const f32x4 lb0 = *(const LAS f32x4*)(lbs + dd), lb1 = *(const LAS f32x4*)(lbs + dd + 4); f32x4 lf0, lf1;
#pragma unroll
            for (int j = 0; j < 8; ++j) { const float lb = j < 4 ? lb0[j] : lb1[j - 4]; const float f = lb + (1.0f - lb) * sigmoidf_(zf[j]); const float lf = fmaxf(__logf(f), -60.0f);
                if (j < 4) lf0[j] = lf; else lf1[j - 4] = lf; oq[j] = siluf_(qf[j]); ok[j] = 1.0f - f; }
            *(LAS u32x4*)(qs + tau_a * QP + dd) = pack8(oq); *(LAS u32x4*)(ks + tau_a * QP + dd) = pack8(ok);
            *(LAS f32x4*)(lfb + tau_a * 128 + dd) = lf0; *(LAS f32x4*)(lfb + tau_a * 128 + dd + 4) = lf1;
            const u32x4 vv = ri[hf];
            vT[(dd + 0) * SP + tau_a] = (bf16)(vv.x & 0xffffu); vT[(dd + 1) * SP + tau_a] = (bf16)(vv.x >> 16); vT[(dd + 2) * SP + tau_a] = (bf16)(vv.y & 0xffffu); vT[(dd + 3) * SP + tau_a] = (bf16)(vv.y >> 16);
            vT[(dd + 4) * SP + tau_a] = (bf16)(vv.z & 0xffffu); vT[(dd + 5) * SP + tau_a] = (bf16)(vv.z >> 16); vT[(dd + 6) * SP + tau_a] = (bf16)(vv.w & 0xffffu); vT[(dd + 7) * SP + tau_a] = (bf16)(vv.w >> 16); }
        if (n + 1 < NCH) { const bf16* pr = P + (size_t)chain_row(dir, b, s0 + 64 + tau_a) * INC + h * 128 + d0;
            rq[0] = *(const u32x4*)(pr + OFF_Q); rq[1] = *(const u32x4*)(pr + OFF_Q + 8); ri[0] = *(const u32x4*)(pr + OFF_I); ri[1] = *(const u32x4*)(pr + OFF_I + 8); rz[0] = *(const u32x4*)(pr + zoff); rz[1] = *(const u32x4*)(pr + zoff + 8); }
        LDS_BAR();
        float cs[16];
        { float run = 0.f;
#pragma unroll
          for (int i = 0; i < 16; ++i) { run += lfb[(16 * qt + i) * 128 + d]; cs[i] = run; }
          tot[qt * 128 + d] = run; }
        LDS_BAR();
        { const float t0 = tot[d], t1 = tot[128 + d], t2 = tot[256 + d], t3 = tot[384 + d];
          const float bmid = t0 + t1, btot = bmid + t2 + t3; const float base = (qt > 0 ? t0 : 0.f) + (qt > 1 ? t1 : 0.f) + (qt > 2 ? t2 : 0.f);
          if (qt == 0) { gmid[d] = __expf(bmid); gend[d] = __expf(btot - bmid); }
#pragma unroll
          for (int i = 0; i < 16; ++i) { const int tau = 16 * qt + i; const float bt = base + cs[i];
              const float eq = __expf(fminf(bt - bmid, 80.0f)), ek = __expf(fminf(bmid - bt, 80.0f));
              const bf16 qb = (bf16)f2bf(bf1(qs[tau * QP + d]) * eq), kb = (bf16)f2bf(bf1(ks[tau * QP + d]) * ek);
              qs[tau * QP + d] = qb; ks[tau * QP + d] = kb; kT[d * SP + tau] = kb; } }
        LDS_BAR();
        { const f32x4 gm = *(const LAS f32x4*)(gmid + 16 * wave + 4 * fq);
#pragma unroll
          for (int vt = 0; vt < 8; ++vt) { S[vt] = S[vt] * gm; u32x2 o; o.x = pk2(S[vt][0], S[vt][1]); o.y = pk2(S[vt][2], S[vt][3]); *(LAS u32x2*)(sT + (16 * vt + fr) * QP + 16 * wave + 4 * fq) = o; } }
        { const int tt = wave >> 1;
#pragma unroll
          for (int u = 0; u < 2; ++u) { const int sg = 2 * (wave & 1) + u; f32x4 acc = (f32x4){0.f, 0.f, 0.f, 0.f};
              if (sg <= tt) {
#pragma unroll
                  for (int kq = 0; kq < 4; ++kq) { const bf16x8 af = *(const LAS bf16x8*)(ks + (16 * sg + fr) * QP + 32 * kq + 8 * fq), bfm = *(const LAS bf16x8*)(qs + (16 * tt + fr) * QP + 32 * kq + 8 * fq);
                      acc = __builtin_amdgcn_mfma_f32_16x16x32_bf16(af, bfm, acc, 0, 0, 0); }
                  if (sg == tt) {
#pragma unroll
                      for (int j = 0; j < 4; ++j) if (4 * fq + j > fr) acc[j] = 0.f; }
              }
              u32x2 o; o.x = pk2(acc[0], acc[1]); o.y = pk2(acc[2], acc[3]); *(LAS u32x2*)(pl + (16 * tt + fr) * SP + 16 * sg + 4 * fq) = o; } }
        LDS_BAR();
#pragma unroll
        for (int tt = 0; tt < 4; ++tt) { f32x4 acc = (f32x4){0.f, 0.f, 0.f, 0.f};
#pragma unroll
            for (int kq = 0; kq < 2; ++kq) { const bf16x8 af = *(const LAS bf16x8*)(vT + (16 * wave + fr) * SP + 32 * kq + 8 * fq), bfm = *(const LAS bf16x8*)(pl + (16 * tt + fr) * SP + 32 * kq + 8 * fq);
                acc = __builtin_amdgcn_mfma_f32_16x16x32_bf16(af, bfm, acc, 0, 0, 0); }
#pragma unroll
            for (int kq = 0; kq < 4; ++kq) { const bf16x8 af = *(const LAS bf16x8*)(sT + (16 * wave + fr) * QP + 32 * kq + 8 * fq), bfm = *(const LAS bf16x8*)(qs + (16 * tt + fr) * QP + 32 * kq + 8 * fq);
                acc = __builtin_amdgcn_mfma_f32_16x16x32_bf16(af, bfm, acc, 0, 0, 0); }
            const int row = chain_row(dir, b, s0 + 16 * tt + fr);
            u32x2 o; o.x = pk2(acc[0], acc[1]); o.y = pk2(acc[2], acc[3]); *(u32x2*)(OB + ((size_t)dir * MALL + row) * BW + h * 128 + 16 * wave + 4 * fq) = o; }
        { const f32x4 ge = *(const LAS f32x4*)(gend + 16 * wave + 4 * fq);
#pragma unroll
          for (int kq = 0; kq < 2; ++kq) { const bf16x8 af = *(const LAS bf16x8*)(kT + (16 * wave + fr) * SP + 32 * kq + 8 * fq);
#pragma unroll
              for (int vt = 0; vt < 8; ++vt) { const bf16x8 bfm = *(const LAS bf16x8*)(vT + (16 * vt + fr) * SP + 32 * kq + 8 * fq); S[vt] = __builtin_amdgcn_mfma_f32_16x16x32_bf16(af, bfm, S[vt], 0, 0, 0); } }
#pragma unroll
          for (int vt = 0; vt < 8; ++vt) S[vt] = S[vt] * ge; }
        LDS_BAR();
    }
}
__device__ __forceinline__ void hgrn_chain(KArgs a, int l, int cid, LAS unsigned char* lds) {
    const int tid = tid_fresh();
    unsigned char* ws = a->ws;
    const bf16* P = (const bf16*)(ws + WS_P); bf16* OB = (bf16*)(ws + WS_OB);
    const int dir = cid / 48, b = (cid % 48) / 6, h = cid % 6;
    LAS float* tq = (LAS float*)lds;
    LAS float* tk = tq + 16 * 128;
    LAS float* tf = tk + 16 * 128;
    LAS float* tv = tf + 16 * 128;
    LAS float* ot = tv + 16 * 128;
    const int v = tid >> 2, q = tid & 3;
    float S[32];
#pragma unroll
    for (int j = 0; j < 32; ++j) S[j] = 0.f;
    const int sst = tid >> 5, sc4 = (tid & 31) * 4;
    float lb[4];
#pragma unroll
    for (int j = 0; j < 4; ++j) { const int ch = h * 128 + sc4 + j;
        if (l == 0) lb[j] = 0.f; else { const float l0 = a->in[I_LB][((size_t)dir * DEPTH + 0) * BW + ch], l1 = a->in[I_LB][((size_t)dir * DEPTH + 1) * BW + ch]; lb[j] = 1.0f / (1.0f + __expf(l0 - l1)); } }
    for (int s0 = 0; s0 < CTXL + T; s0 += 16) {
        { const int row = chain_row(dir, b, s0 + sst); const bf16* pr = P + (size_t)row * INC + h * 128 + sc4;
          const u32x2 pq = *(const u32x2*)(pr + OFF_Q), pi = *(const u32x2*)(pr + OFF_I), pz = *(const u32x2*)(pr + (dir ? OFF_ZB : OFF_ZF));
          const float qf[4] = {bflo(pq.x), bfhi(pq.x), bflo(pq.y), bfhi(pq.y)}, vf[4] = {bflo(pi.x), bfhi(pi.x), bflo(pi.y), bfhi(pi.y)}, zf[4] = {bflo(pz.x), bfhi(pz.x), bflo(pz.y), bfhi(pz.y)};
          f32x4 oq, ok, of, ov;
#pragma unroll
          for (int j = 0; j < 4; ++j) { const float f = lb[j] + (1.0f - lb[j]) * sigmoidf_(zf[j]); oq[j] = siluf_(qf[j]); of[j] = f; ok[j] = 1.0f - f; ov[j] = vf[j]; }
          *(LAS f32x4*)(tq + sst * 128 + sc4) = oq; *(LAS f32x4*)(tk + sst * 128 + sc4) = ok; *(LAS f32x4*)(tf + sst * 128 + sc4) = of; *(LAS f32x4*)(tv + sst * 128 + sc4) = ov; }
        LDS_BAR();
        for (int st = 0; st < 16; ++st) {
            const float vv = tv[st * 128 + v]; float o0 = 0.f, o1 = 0.f;
#pragma unroll
            for (int j = 0; j < 8; ++j) { const f32x4 fq4 = *(const LAS f32x4*)(tf + st * 128 + q * 32 + 4 * j), kq4 = *(const LAS f32x4*)(tk + st * 128 + q * 32 + 4 * j), qq4 = *(const LAS f32x4*)(tq + st * 128 + q * 32 + 4 * j);
#pragma unroll
                for (int i = 0; i < 4; ++i) { const float sn = fq4[i] * S[4 * j + i] + kq4[i] * vv; S[4 * j + i] = sn; if (i & 1) o1 += qq4[i] * sn; else o0 += qq4[i] * sn; } }
            float o = o0 + o1; o += dpp_xor1(o); o += dpp_xor2(o);
            if (q == 0) ot[st * 128 + v] = o;
        }
        LDS_BAR();
        if (tid < 256) { const int st = tid >> 4, part = tid & 15; const int row = chain_row(dir, b, s0 + st); const LAS float* op = ot + st * 128 + part * 8;
            float f[8];
#pragma unroll
            for (int j = 0; j < 8; ++j) f[j] = op[j];
            *(u32x4*)(OB + ((size_t)dir * MALL + row) * BW + h * 128 + part * 8) = pack8(f); }
    }
    LDS_BAR();
}

__device__ __forceinline__ float grp_sum32(float v) { v += __shfl_xor(v, 1); v += __shfl_xor(v, 2); v += __shfl_xor(v, 4); v += __shfl_xor(v, 8); v += __shfl_xor(v, 16); return v; }
__device__ __forceinline__ float grp_sum16(float v) { v += __shfl_xor(v, 1); v += __shfl_xor(v, 2); v += __shfl_xor(v, 4); v += __shfl_xor(v, 8); return v; }
__device__ __forceinline__ void phase_finalize(KArgs a, int l, bool dry) {
    const int tid_ = tid_fresh(); const int lane = tid_ & 63, wave = tid_ >> 6, gw = blockIdx.x * 8 + wave, NGW = gridDim.x * 8;
    unsigned char* ws = a->ws;
    const bf16* P = (const bf16*)(ws + WS_P); const bf16* OB = (const bf16*)(ws + WS_OB); const bf16* OC = (const bf16*)(ws + WS_OC); bf16* Y = (bf16*)(ws + WS_Y);
    unsigned char* Yo = dry ? ws + WS_END : ws + WS_Y8;
    const int nrows = (l == DEPTH - 1) ? NLAT : MALL;
    const int rpw = (nrows + NGW - 1) / NGW; const int r0 = gw * rpw, r1 = (r0 + rpw < nrows) ? r0 + rpw : nrows;
    f32x4 hng[3], gng[3], gnb[3];
#pragma unroll
    for (int k = 0; k < 3; ++k) { const int c = 256 * k + 4 * lane; hng[k] = *(const f32x4*)(a->in[I_HNG] + (size_t)l * BW + c);
        gng[k] = *(const f32x4*)(a->in[I_GNGG] + (size_t)l * CW + c); gnb[k] = *(const f32x4*)(a->in[I_GNB] + (size_t)l * CW + c); }
    for (int row = r0; row < r1; ++row) {
        const int orow = dry ? (row & 2047) : row;
        u32x2 bf_[3], bb_[3], bg_[3], cf_[3], cb_[3], cv_[3], cg_[3];
#pragma unroll
        for (int k = 0; k < 3; ++k) { const int c = 256 * k + 4 * lane;
            bf_[k] = *(const u32x2*)(OB + (size_t)row * BW + c); bb_[k] = *(const u32x2*)(OB + ((size_t)MALL + row) * BW + c); bg_[k] = *(const u32x2*)(P + (size_t)row * INC + OFF_OG + c);
            cf_[k] = *(const u32x2*)(OC + (size_t)row * CW + c); cb_[k] = *(const u32x2*)(OC + ((size_t)MALL + row) * CW + c);
            cv_[k] = *(const u32x2*)(Y + (size_t)row * D + 512 + c);
            cg_[k] = *(const u32x2*)(Y + (size_t)row * D + 1280 + c); }
#pragma unroll
        for (int k = 0; k < 3; ++k) { const int c = 256 * k + 4 * lane;
            { float o[4] = {bflo(bf_[k].x) + bflo(bb_[k].x), bfhi(bf_[k].x) + bfhi(bb_[k].x), bflo(bf_[k].y) + bflo(bb_[k].y), bfhi(bf_[k].y) + bfhi(bb_[k].y)};
              const float ss = grp_sum32((o[0] * o[0] + o[1] * o[1]) + (o[2] * o[2] + o[3] * o[3])); const float rstd = 1.0f / sqrtf(ss * (1.0f / 128.0f) + NORM_EPS);
              const float g4[4] = {bflo(bg_[k].x), bfhi(bg_[k].x), bflo(bg_[k].y), bfhi(bg_[k].y)}; float y[4];
#pragma unroll
              for (int j = 0; j < 4; ++j) y[j] = o[j] * rstd * hng[k][j] * sigmoidf_(g4[j]);
              *(unsigned*)(Yo + (size_t)orow * D + 512 + c) = pk4_fp8(y[0], y[1], y[2], y[3]); }
            { float o[4] = {bflo(cf_[k].x) + bflo(cb_[k].x), bfhi(cf_[k].x) + bfhi(cb_[k].x), bflo(cf_[k].y) + bflo(cb_[k].y), bfhi(cf_[k].y) + bfhi(cb_[k].y)};
              const float v4[4] = {bflo(cv_[k].x), bfhi(cv_[k].x), bflo(cv_[k].y), bfhi(cv_[k].y)}, g4[4] = {bflo(cg_[k].x), bfhi(cg_[k].x), bflo(cg_[k].y), bfhi(cg_[k].y)};
              const float mean = grp_sum16((o[0] + o[1]) + (o[2] + o[3])) * (1.0f / 64.0f);
              float dl[4]; float sq = 0.f;
#pragma unroll
              for (int j = 0; j < 4; ++j) { dl[j] = o[j] - mean; sq += dl[j] * dl[j]; }
              const float var = grp_sum16(sq) * (1.0f / 64.0f); const float rs = 1.0f / sqrtf(var + GN_EPS); float y[4];
#pragma unroll
              for (int j = 0; j < 4; ++j) y[j] = (dl[j] * rs * gng[k][j] + gnb[k][j] + v4[j]) * g4[j];
              *(unsigned*)(Yo + (size_t)orow * D + 1280 + c) = pk4_fp8(y[0], y[1], y[2], y[3]); }
        }
    }
}

__global__ void __launch_bounds__(NTHREADS, 2) mk_fwd(Args args_unused) {
    extern __shared__ __attribute__((aligned(16))) unsigned char lds_raw[];
    LAS unsigned char* lds = (LAS unsigned char*)lds_raw;
    volatile LAS unsigned* misc = (volatile LAS unsigned*)(lds + LDS_MISC);
    const int tid = threadIdx.x, G = gridDim.x;
    if (tid < 64) misc[tid] = 0u;
    __syncthreads();
    XcdBarrier bar; bar.bar = nullptr; bar.x = 0; bar.st = nullptr;
    int lo, hi;
    { KArgs a = kargs(); lo = a->ph_lo; hi = a->ph_hi; unsigned* ctl = (unsigned*)(a->ws + WS_CTL); bar.bar = ctl + CW_BAR; if (!MK_MULTI) bar = xcd_barrier_post(ctl + CW_BAR, misc + 8); }
    const int cvirt = (G % 8 == 0) ? ((int)blockIdx.x % 8) * (G / 8) + (int)blockIdx.x / 8 : (int)blockIdx.x;
#define IN(k) (lo <= (k) && (k) < hi)
#define PM(b) ((PHMASK >> (b)) & 1)
#define REP(b) _Pragma("unroll 1") for (int rep_ = 0; rep_ < 1 + ((PROBE_DUP >> (b)) & 1); ++rep_)
#define SEAM(k) do { if (!MK_MULTI && IN(k) && IN((k) + 1)) { xcd_barrier(bar); if ((PROBE_DUP >> 13) & 1) xcd_barrier(bar); } } while (0)

    if (PM(0) && IN(0)) REP(0) { phase_prologue(kargs(), lds); } SEAM(0);

#pragma unroll 1
    for (int l = 0; l < DEPTH; ++l) {
        const int pb = 1 + 9 * l;
        const bool lastl = (l == DEPTH - 1);
        if (PM(1) && IN(pb + 0)) { if ((PROBE_DUP >> 1) & 1) { if (l == 0) phase_norm1<0>(kargs(), l, true); else phase_norm1<1>(kargs(), l, true); } if (l == 0) phase_norm1<0>(kargs(), l, false); else { phase_norm1<1>(kargs(), l, false); __syncthreads(); convert_moe(kargs(), l, lds); __syncthreads(); } } SEAM(pb + 0);
        if (PM(2) && IN(pb + 1)) REP(2) {
            KArgs a = kargs(); unsigned char* ws = a->ws;
            pg8::Gemm g{(const bf16*)(ws + WS_H), (const bf16*)(ws + WS_WIN + (size_t)l * INC * D), MALL, INC, D / 2};
            pg8::StaticOrder S; S.init(MALL, INC, G, (int)blockIdx.x);
            pg8::EpiBf16 E{(bf16*)(ws + WS_P), INC};
            pg8::gemm_phase8<pg8::EpiBf16, pg8::StaticOrder, false, false>(lds, g, S, E, nullptr);
        } SEAM(pb + 1);
        if (PM(3) && IN(pb + 2)) {
            const int ngm = lastl ? 1024 : 1088;
            unsigned* qhead = (unsigned*)(kargs()->ws + WS_CTL) + CW_PREPQ + 64 * l;
            const int n_rw = 544 * 3, n_hg = 3264, n_all = (G == 256) ? n_rw + n_hg : n_rw + n_hg + ngm;
            for (;;) {
                if (threadIdx.x == 0) misc[16] = __hip_atomic_fetch_add(qhead, 1u, __ATOMIC_RELAXED, __HIP_MEMORY_SCOPE_AGENT);
                __syncthreads();
                const int it = (int)misc[16];
                if (it >= n_all) break;
                if (it < n_rw) { _Pragma("unroll 1") for (int r2 = 0; r2 < 1 + ((PROBE_DUP >> 15) & 1); ++r2) rwkv_prep_item(kargs(), l, it / 3, it % 3, lds); }
                else if (it < n_rw + n_hg) { if ((PROBE_DUP >> 16) & 1) hgrn_prep_item(kargs(), l, it - n_rw, lds, true); hgrn_prep_item(kargs(), l, it - n_rw, lds, false); }
                else { _Pragma("unroll 1") for (int r2 = 0; r2 < 1 + ((PROBE_DUP >> 14) & 1); ++r2) gmlp_item(kargs(), l, it - n_rw - n_hg, lds); }
            }
            __syncthreads();
        } SEAM(pb + 2);
        if (PM(4) && IN(pb + 3)) REP(4) {
            if (G == 256) { const int bx = blockIdx.x;
                if (bx < 96) { _Pragma("unroll 1") for (int r2 = 0; r2 < 1 + ((PROBE_DUP >> 12) & 1); ++r2) rwkv_chain_mfma(kargs(), bx * 8, lds); }
                else if (bx < 192) { _Pragma("unroll 1") for (int r2 = 0; r2 < 1 + ((PROBE_DUP >> 11) & 1); ++r2) hgrn_chain_lean(kargs(), bx - 96, lds); }
                if (bx < 96 || bx >= 192) {
                    unsigned* gq = (unsigned*)(kargs()->ws + WS_CTL) + CW_GMQ + 64 * l; const int ngm2 = lastl ? 1024 : 1088;
                    for (;;) { if (threadIdx.x == 0) misc[17] = __hip_atomic_fetch_add(gq, 1u, __ATOMIC_RELAXED, __HIP_MEMORY_SCOPE_AGENT);
                        __syncthreads(); const int it = (int)misc[17]; if (it >= ngm2) break; gmlp_item(kargs(), l, it, lds); }
                    __syncthreads(); } }
            else { for (int it = blockIdx.x; it < 192; it += G) { if (it < 96) rwkv_chain_mfma(kargs(), it * 8, lds); else hgrn_chain_lean(kargs(), it - 96, lds); } }
        } SEAM(pb + 3);
        if (PM(5) && IN(pb + 4)) { if ((PROBE_DUP >> 5) & 1) phase_finalize(kargs(), l, true); phase_finalize(kargs(), l, false); } SEAM(pb + 4);
        if (PM(6) && IN(pb + 5)) REP(6) {
            KArgs a = kargs(); unsigned char* ws = a->ws;
            const int Mo = lastl ? NLAT : MALL;
            pg8::Gemm g{(const bf16*)(ws + WS_Y8), (const bf16*)(ws + WS_WOUT + (size_t)l * D * D), Mo, D, D / 2};
            pg8::StaticOrder S; S.init(Mo, D, G, (int)blockIdx.x);
            const float* xl = l == 0 ? a->in[I_X] : (const float*)(ws + WS_X); const float* xc = l == 0 ? a->in[I_CTX] : (const float*)(ws + WS_X) + (size_t)NLAT * D;
            pg8::EpiResid E{xl, xc, (float*)(ws + WS_X), (const float*)(ws + WS_MOD) + (size_t)l * 9 * 12288 + 2 * D};
            pg8::gemm_phase8<pg8::EpiResid, pg8::StaticOrder, true, false>(lds, g, S, E, nullptr);
        } SEAM(pb + 5);
        if (PM(7) && IN(pb + 6)) { if ((PROBE_DUP >> 7) & 1) phase_norm2_router(kargs(), l, true, lds); phase_norm2_router(kargs(), l, false, lds); } SEAM(pb + 6);
        if (PM(8) && IN(pb + 7)) REP(8) {
            KArgs a = kargs(); unsigned char* ws = a->ws;
            moe_tables<false>(a, l, lds, cvirt);
            pg8::Gemm g{(const bf16*)(ws + WS_H), (const bf16*)(ws + WS_WGU), 0, 2048, D / 2};
            pg8::MoeOrder S{(const LAS int*)(lds + LDS_TP), G, cvirt, (unsigned)(2048 * D)};
            pg8::EpiSwiglu E{ws + WS_ACT};
            pg8::gemm_phase8<pg8::EpiSwiglu, pg8::MoeOrder, false, true>(lds, g, S, E, (const LAS unsigned*)(lds + LDS_TAB));
        } SEAM(pb + 7);
        if (PM(9) && IN(pb + 8)) REP(9) {
            KArgs a = kargs(); unsigned char* ws = a->ws;
            moe_tables<true>(a, l, lds, cvirt);
            pg8::Gemm g{(const bf16*)(ws + WS_ACT), (const bf16*)(ws + WS_WDN), 0, D, DE / 2};
            pg8::MoeOrder S{(const LAS int*)(lds + LDS_TP), G, cvirt, (unsigned)(D * DE)};
            pg8::EpiDown E{(bf16*)(ws + WS_YK), (const LAS unsigned*)(lds + LDS_TAB), (const LAS float*)(lds + LDS_TABW)};
            pg8::gemm_phase8<pg8::EpiDown, pg8::MoeOrder, false, false>(lds, g, S, E, nullptr);
        } SEAM(pb + 8);
    }
    if (PM(10) && IN(1 + 9 * DEPTH)) { if ((PROBE_DUP >> 10) & 1) phase_norm1<2>(kargs(), DEPTH, true); phase_norm1<2>(kargs(), DEPTH, false); }
#undef IN
#undef SEAM
}

extern "C" void kernel_launch(void* const* d_in, const int* in_sizes, int n_in, void* d_out, int out_size, void* d_ws, size_t ws_size, hipStream_t stream) {
    static int grid = 0;
    if (grid == 0) {
        if (n_in != 31 || ws_size < WS_END) { fprintf(stderr, "kernel_launch: unexpected n_in %d / ws %zu (need %zu)\n", n_in, ws_size, (size_t)WS_END); grid = -1; return; }
        int dev = 0, cus = 0, per_cu = 0;
        hipGetDevice(&dev); hipDeviceGetAttribute(&cus, hipDeviceAttributeMultiprocessorCount, dev);
        if (hipFuncSetAttribute((const void*)mk_fwd, hipFuncAttributeMaxDynamicSharedMemorySize, LDS_BYTES) != hipSuccess) { fprintf(stderr, "kernel_launch: hipFuncSetAttribute failed\n"); grid = -1; return; }
        if (hipOccupancyMaxActiveBlocksPerMultiprocessor(&per_cu, (const void*)mk_fwd, NTHREADS, LDS_BYTES) != hipSuccess || per_cu < 1) fprintf(stderr, "kernel_launch: occupancy query says %d\n", per_cu);
        (void)hipGetLastError();
        grid = cus > 0 ? cus : 256;
    }
    if (grid < 0) return;
    hipMemsetAsync((char*)d_ws + WS_CTL, 0, CTL_ZERO_BYTES, stream);
    Args a{};
    for (int i = 0; i < 31; ++i) a.in[i] = (const float*)d_in[i];
    a.out = (float*)d_out; a.ws = (unsigned char*)d_ws;
    constexpr int NPH = 2 + 9 * DEPTH;
#if MK_MULTI
    for (int p = 0; p < NPH; ++p) { a.ph_lo = p; a.ph_hi = p + 1; hipLaunchKernelGGL(mk_fwd, dim3(grid), dim3(NTHREADS), LDS_BYTES, stream, a); }
#else
    a.ph_lo = 0; a.ph_hi = NPH; hipLaunchKernelGGL(mk_fwd, dim3(grid), dim3(NTHREADS), LDS_BYTES, stream, a);
#endif
}
```

```cpp
#include <hip/hip_runtime.h>
#include <cstdio>
#include <cstdint>

#ifndef PHMASK
#define PHMASK 0xFFFF
#endif
#ifndef PROBE_DUP
#define PROBE_DUP 0
#endif
#ifndef MK_MULTI
#define MK_MULTI 0
#endif

#define GAS __attribute__((address_space(1)))
#define LAS __attribute__((address_space(3)))
typedef unsigned short bf16;
typedef short bf16x8 __attribute__((ext_vector_type(8)));
typedef float f32x4 __attribute__((ext_vector_type(4)));
typedef float f32x2 __attribute__((ext_vector_type(2)));
typedef unsigned u32x4 __attribute__((ext_vector_type(4)));
typedef unsigned u32x2 __attribute__((ext_vector_type(2)));

constexpr int D = 2048, NB = 8, T = 4096, CTXL = 256, DEPTH = 2;
constexpr int NLAT = NB * T, NCTX = NB * CTXL, MALL = NLAT + NCTX;
constexpr int INC = 7424;
constexpr int OFF_U = 0, OFF_V = 512, OFF_Q = 1024, OFF_I = 1792, OFF_ZF = 2560, OFF_ZB = 3328, OFF_OG = 4096;
constexpr int OFF_C = 4864;
constexpr int BW = 768, CW = 768, CCOLS = 2560;
constexpr int NE = 16, DE = 1024;
constexpr int PC2W = 7 * 768;
constexpr int NTHREADS = 512;
constexpr float NORM_EPS = 1e-6f, GN_EPS = 64e-5f, DECAY_SCALE = 0.60653065971263342f;

constexpr size_t MiB = 1u << 20;
constexpr size_t WS_CTL = 0, CTL_ZERO_BYTES = 1 * MiB;
constexpr size_t WS_MOD = 1 * MiB;
constexpr size_t WS_SMALLW = 2 * MiB;
constexpr size_t SW_WUP = 0, SW_AUP = SW_WUP + (size_t)2 * 2 * 768 * 64 * 2, SW_GUP = SW_AUP + (size_t)2 * 768 * 64 * 2, SW_GWS = SW_GUP + (size_t)2 * 768 * 128 * 2;
constexpr size_t WS_WIN = 4 * MiB, WS_WOUT = 62 * MiB, WS_WGU = 78 * MiB, WS_WDN = 142 * MiB, WS_Y8 = 174 * MiB;
constexpr size_t WS_X = 270 * MiB, WS_H = 542 * MiB, WS_Y = 678 * MiB, WS_P = 814 * MiB, WS_PRE = 1307 * MiB, WS_VT = 1817 * MiB, WS_OC = 1868 * MiB, WS_HQB = 1970 * MiB, WS_HG = 2021 * MiB, WS_END = 2028 * MiB;
constexpr int PRE_REC = 10240, PR_WP = 0, PR_RP = 2048, PR_BK = 4096, PR_ARBK = 8192, PR_MAK = 9216, PR_GAM = 9728, NCHUNK16 = 272;
constexpr size_t WS_OB = WS_H;
constexpr size_t WS_ACT = WS_P, WS_YK = WS_P + 144 * MiB, WS_RIDX = WS_P + 416 * MiB, WS_RW = WS_RIDX + 3 * MiB;
static_assert(WS_RW + 3 * MiB <= WS_PRE, "moe overlay");
constexpr int MAXSLOT_TILES = 288;
constexpr int CW_BAR = 4096;
constexpr int CW_GMQ = 30720;
constexpr int CW_PREPQ = 28672;
constexpr int CW_CNT = 16384;

constexpr int LDS_STAGE = 0, LDS_TAB = 131072, LDS_TABW = LDS_TAB + 9 * 1024, LDS_TP = LDS_TABW + 9 * 1024, LDS_MISC = 150528, LDS_BYTES = 152 * 1024;
static_assert(LDS_TP + 128 <= LDS_MISC, "lds map");

typedef __bf16 bf16x2_t __attribute__((ext_vector_type(2)));
__device__ __forceinline__ unsigned pk2(float lo, float hi) { const f32x2 v = {lo, hi}; return __builtin_bit_cast(unsigned, __builtin_convertvector(v, bf16x2_t)); }
__device__ __forceinline__ unsigned f2bf(float f) { return pk2(f, f) & 0xffffu; }
__device__ __forceinline__ unsigned pk4_fp8(float a, float b, float c, float d) {
    a = __builtin_amdgcn_fmed3f(a, -448.f, 448.f); b = __builtin_amdgcn_fmed3f(b, -448.f, 448.f); c = __builtin_amdgcn_fmed3f(c, -448.f, 448.f); d = __builtin_amdgcn_fmed3f(d, -448.f, 448.f);
    int p = 0; p = __builtin_amdgcn_cvt_pk_fp8_f32(a, b, p, false); p = __builtin_amdgcn_cvt_pk_fp8_f32(c, d, p, true); return (unsigned)p; }
__device__ __forceinline__ float bflo(unsigned u) { return __builtin_bit_cast(float, u << 16); }
__device__ __forceinline__ float bfhi(unsigned u) { return __builtin_bit_cast(float, u & 0xffff0000u); }
__device__ __forceinline__ float bf1(bf16 b) { return __builtin_bit_cast(float, ((unsigned)b) << 16); }
__device__ __forceinline__ float sigmoidf_(float x) { return __builtin_amdgcn_rcpf(1.0f + __expf(-x)); }
__device__ __forceinline__ float siluf_(float x) { return x * __builtin_amdgcn_rcpf(1.0f + __expf(-x)); }
__device__ __forceinline__ float geluf_(float v) {
    const float av = fabsf(v), t = __builtin_amdgcn_rcpf(av * 0.2316418882f + 1.0f);
    float q = t * 0.5307027145f + (-0.7265760135f); q = q * t + 0.7107068705f; q = q * t + (-0.142248368f); q = q * t + 0.127414796f; q = q * t;
    const float e = __builtin_amdgcn_exp2f((v * v) * (-0.72134752044f)); const float m = v * (q * e); return v < 0.f ? m : v - m; }
__device__ __forceinline__ float wave_sum(float v) {
#pragma unroll
    for (int o = 1; o < 64; o <<= 1) v += __shfl_xor(v, o);
    return v;
}
__device__ __forceinline__ int tid_fresh() { int t = threadIdx.x; asm volatile("" : "+v"(t)); return t; }
__device__ __forceinline__ void unpack8(const u32x4 v, float (&f)[8]) {
    f[0] = bflo(v.x); f[1] = bfhi(v.x); f[2] = bflo(v.y); f[3] = bfhi(v.y); f[4] = bflo(v.z); f[5] = bfhi(v.z); f[6] = bflo(v.w); f[7] = bfhi(v.w);
}
__device__ __forceinline__ u32x4 pack8(const float (&f)[8]) { u32x4 v; v.x = pk2(f[0], f[1]); v.y = pk2(f[2], f[3]); v.z = pk2(f[4], f[5]); v.w = pk2(f[6], f[7]); return v; }
__device__ __forceinline__ int modrow_of(int row) { return row < NLAT ? (row >> 12) : 8; }

#define XB_TMO      128
#define XB_XCNT(j)  (256  + 64 * (j))
#define XB_XSUB(j)  (1280 + 64 * (j))
#define XB_XGEN(j)  (2304 + 64 * (j))
#define XB_TOP      3328
#define XB_TOPGEN   3392
#define XCD_BAR_WORDS 3456
#define XB_SPIN_CAP (1u << 18)
__device__ __forceinline__ unsigned xb_ld(unsigned* p)              { return __hip_atomic_load(p, __ATOMIC_RELAXED, __HIP_MEMORY_SCOPE_AGENT); }
__device__ __forceinline__ unsigned xb_add(unsigned* p, unsigned v) { return __hip_atomic_fetch_add(p, v, __ATOMIC_RELAXED, __HIP_MEMORY_SCOPE_AGENT); }
__device__ __forceinline__ unsigned xb_xcc_id() { return (unsigned)__builtin_amdgcn_s_getreg((3 << 11) | 20) & 0xFu; }
#define XB_SPIN(cond, bar) do { unsigned _sp = 0; while (cond) { __builtin_amdgcn_s_sleep(1); \
    if ((++_sp & 255u) == 0u) { if (xb_ld(&(bar)[XB_TMO])) break; if (_sp > XB_SPIN_CAP) { atomicAdd(&(bar)[XB_TMO], 1u); break; } } } } while (0)
struct XcdBarrier { unsigned* bar; unsigned x; volatile LAS unsigned* st; };
__device__ __forceinline__ XcdBarrier xcd_barrier_post(unsigned* bar, volatile LAS unsigned* st) {
    XcdBarrier b; b.bar = bar; b.x = xb_xcc_id(); b.st = st;
    if (threadIdx.x == 0) (void)xb_add(&bar[XB_XCNT(b.x)], 1u);
    return b;
}
__device__ __forceinline__ void xcd_barrier_complete(unsigned* bar, unsigned x, unsigned& nloc, unsigned& nx) {
    const unsigned G = gridDim.x * gridDim.y * gridDim.z;
    unsigned sum, cnt, mine, sp = 0u;
    for (;;) {
        sum = 0u; cnt = 0u; mine = 0u;
#pragma unroll
        for (unsigned j = 0; j < 16; ++j) { const unsigned c = xb_ld(&bar[XB_XCNT(j)]); sum += c; cnt += (c > 0u) ? 1u : 0u; mine = (j == x) ? c : mine; }
        if (sum == G) break;
        __builtin_amdgcn_s_sleep(1);
        if ((++sp & 255u) == 0u) { if (xb_ld(&bar[XB_TMO])) break; if (sp > XB_SPIN_CAP) { atomicAdd(&bar[XB_TMO], 1u); break; } }
    }
    nloc = mine > 0u ? mine : 1u; nx = cnt > 0u ? cnt : 1u;
}
__device__ __forceinline__ void xcd_barrier(const XcdBarrier& b) {
    asm volatile("s_waitcnt vmcnt(0)" ::: "memory");
    __syncthreads();
    if (threadIdx.x == 0) {
        unsigned* bar = b.bar;
        __builtin_amdgcn_s_waitcnt(0);
        unsigned nloc = b.st[0], nx = b.st[1];
        if (nloc == 0u) { xcd_barrier_complete(bar, b.x, nloc, nx); b.st[0] = nloc; b.st[1] = nx; }
        const unsigned old = xb_add(&bar[XB_XSUB(b.x)], 1u);
        const unsigned gen = old / nloc;
        if (old + 1u == (gen + 1u) * nloc) {
            __builtin_amdgcn_fence(__ATOMIC_RELEASE, "agent");
            asm volatile("s_waitcnt vmcnt(0)" ::: "memory");
            const unsigned og = xb_add(&bar[XB_TOP], 1u);
            const unsigned tg = og / nx;
            if (og + 1u == (tg + 1u) * nx) xb_add(&bar[XB_TOPGEN], 1u);
            else XB_SPIN(xb_ld(&bar[XB_TOPGEN]) == tg, bar);
            __builtin_amdgcn_fence(__ATOMIC_ACQUIRE, "agent");
            xb_add(&bar[XB_XGEN(b.x)], 1u);
            asm volatile("s_waitcnt vmcnt(0)" ::: "memory");
        } else {
            XB_SPIN(xb_ld(&bar[XB_XGEN(b.x)]) == gen, bar);
            __builtin_amdgcn_fence(__ATOMIC_ACQUIRE, "agent");
            asm volatile("s_waitcnt vmcnt(0)" ::: "memory");
        }
    }
    __syncthreads();
}

namespace pg8 {
constexpr int BM = 256, BK = 64, HALF = 128, HTB = HALF * BK * 2, STAGE_BYTES = 8 * HTB, NXCD = 8, WGM = 8;
__host__ __device__ __forceinline__ int lds_byte(int r, int c) { const int st = (r >> 4) * 2 + (c >> 5), rr = r & 15, cc = c & 31, ob = rr * 64 + cc * 2; return st * 1024 + (ob ^ (((ob >> 9) & 1) << 5)); }
__host__ __device__ __forceinline__ void stage_rc(int b, int& R, int& C) { const int st = b / 1024, sb = b % 1024, swz = sb ^ (((sb >> 9) & 1) << 5); R = (st >> 1) * 16 + swz / 64; C = (st & 1) * 32 + (swz % 64) / 2; }
__host__ __device__ __forceinline__ int perm32(int rho) { const int n = rho >> 4, i = rho & 15; return 8 * (i >> 2) + 4 * n + (i & 3); }

struct Unit { int pm, pn, e, aux; };
struct Gemm { const bf16* A; const bf16* Bt; int M, N, K; };

struct StaticOrder {
    int nM, nN, nwg, G, c;
    __device__ void init(int M, int N, int G_, int c_) { nM = M / BM; nN = N / BM; nwg = nM * nN; G = G_; c = c_; }
    __device__ bool next(int i, Unit& u) const {
        const long L = (long)i * G + c; if (L >= nwg) return false;
        int wgid = (int)L; { const int q = nwg / NXCD, r = nwg % NXCD, xcd = wgid % NXCD, off = wgid / NXCD; wgid = (xcd < r ? xcd * (q + 1) : r * (q + 1) + (xcd - r) * q) + off; }
        const int nig = WGM * nN, gid = wgid / nig, fm = gid * WGM, gsz = (nM - fm) < WGM ? (nM - fm) : WGM;
        u.pm = fm + ((wgid % nig) % gsz); u.pn = (wgid % nig) / gsz; u.e = 0; u.aux = 0; return true;
    }
    __device__ __forceinline__ unsigned b_off(const Unit& u, unsigned tstep) const { return (unsigned)u.pn * tstep; }
};
struct MoeOrder {
    const LAS int* tp; int G, c; unsigned estride;
    __device__ bool next(int i, Unit& u) const {
        const int L = i * G + c; const int ntot = tp[16] * 8; if (L >= ntot) return false;
        const int tile = L >> 3; int e = 0;
#pragma unroll
        for (int j = 1; j < 16; ++j) e += (tile >= tp[j]) ? 1 : 0;
        u.pm = tile; u.pn = L & 7; u.e = e; u.aux = i; return true;
    }
    __device__ __forceinline__ unsigned b_off(const Unit& u, unsigned tstep) const { return (unsigned)u.e * estride + (unsigned)u.pn * tstep; }
};

#define PG8_LAS __attribute__((address_space(3)))
template <class Epi, class Sched, bool ALIGN_EPI, bool GATHER>
__device__ __forceinline__ void gemm_phase(PG8_LAS unsigned char* lds, const Gemm g, const Sched& S, const Epi& E, const PG8_LAS unsigned* tabA) {
    const int tid = tid_fresh(), wid = __builtin_amdgcn_readfirstlane(tid >> 6), lane = tid & 63, wr = wid >> 2, wc = wid & 3, fr = lane & 15, fq = lane >> 4;
    const int K = g.K, nt = K / BK;
    int sR[2], sC[2];
    unsigned voffB[2];
#pragma unroll
    for (int i = 0; i < 2; ++i) { int R, C; stage_rc(tid * 16 + i * 8192, R, C); sR[i] = R; sC[i] = C; const int Rb = Epi::PERM ? ((R & ~31) + perm32(R & 31)) : R;
        voffB[i] = (unsigned)(Rb * K + C) * 2u; }
    const unsigned kstep = (unsigned)(BK * 2);
    const unsigned hstep = (unsigned)(HALF * K * 2);
    const unsigned tstep = 2u * hstep;
    const unsigned ldsw = (unsigned)wid * 1024u;
    const char* const baseA = (const char*)g.A; const char* const baseB = (const char*)g.Bt;
    const int aoff = lds_byte(wr * 64 + fr, fq * 8), boff = lds_byte(wc * 32 + fr, fq * 8);
#define PG8_SA(b, h) (((b) * 2 + (h)) * HTB)
#define PG8_SB(b, h) ((4 + (b) * 2 + (h)) * HTB)
#define PG8_STAGE(bufoff, gbase, uoff, voff) do { _Pragma("unroll") for (int _i = 0; _i < 2; ++_i) \
        __builtin_amdgcn_global_load_lds((const unsigned*)((gbase) + (size_t)(unsigned)((uoff) + (voff)[_i])), (PG8_LAS unsigned*)(lds + (bufoff) + ldsw + _i * 8192), 16, 0, 0); } while (0)
#define PG8_LDA(dst, b, h) do { _Pragma("unroll") for (int m = 0; m < 4; ++m) _Pragma("unroll") for (int k = 0; k < 2; ++k) dst[m][k] = *(const PG8_LAS bf16x8*)(lds + PG8_SA(b, h) + aoff + m * 2048 + k * 1024); } while (0)
#define PG8_LDB(dst, b, h) do { _Pragma("unroll") for (int n = 0; n < 2; ++n) _Pragma("unroll") for (int k = 0; k < 2; ++k) dst[n][k] = *(const PG8_LAS bf16x8*)(lds + PG8_SB(b, h) + boff + n * 2048 + k * 1024); } while (0)
#define PG8_MMA(ai, bj, At, Bt) do { __builtin_amdgcn_s_setprio(1); _Pragma("unroll") for (int m = 0; m < 4; ++m) _Pragma("unroll") for (int n = 0; n < 2; ++n) _Pragma("unroll") for (int k = 0; k < 2; ++k) \
        acc[ai][bj][m][n] = __builtin_amdgcn_mfma_f32_16x16x32_bf16(Bt[n][k], At[m][k], acc[ai][bj][m][n], 0, 0, 0); __builtin_amdgcn_s_setprio(0); } while (0)
#define PG8_WAIT_V(n) asm volatile("s_waitcnt vmcnt(" #n ")" ::: "memory")
#define PG8_WAIT_L(n) asm volatile("s_waitcnt lgkmcnt(" #n ")" ::: "memory")
#define PG8_BAR __builtin_amdgcn_s_barrier()
#define PG8_SCHED __builtin_amdgcn_sched_barrier(0)
    Unit cur, nxt; int ui = 0;
    if (!S.next(0, cur)) return;
    f32x4 acc[2][2][4][2];
#pragma unroll
    for (int a = 0; a < 2; ++a)
#pragma unroll
        for (int b = 0; b < 2; ++b)
#pragma unroll
            for (int m = 0; m < 4; ++m)
#pragma unroll
                for (int n = 0; n < 2; ++n) acc[a][b][m][n] = (f32x4){0.f, 0.f, 0.f, 0.f};
    bf16x8 At[4][2], B0[2][2], B1[2][2];
    unsigned vA0[2], vA1[2], nA0[2], nA1[2];
    unsigned uA, uB = S.b_off(cur, tstep);
    if constexpr (GATHER) { uA = 0u;
#pragma unroll
        for (int i = 0; i < 2; ++i) { vA0[i] = tabA[cur.aux * 256 + sR[i]] + (unsigned)sC[i] * 2u; vA1[i] = tabA[cur.aux * 256 + 128 + sR[i]] + (unsigned)sC[i] * 2u; }
    } else { uA = (unsigned)cur.pm * tstep;
#pragma unroll
        for (int i = 0; i < 2; ++i) { vA0[i] = (unsigned)(sR[i] * K + sC[i]) * 2u; vA1[i] = vA0[i] + hstep; }
    }
    PG8_STAGE(PG8_SB(0, 0), baseB, uB, voffB); PG8_STAGE(PG8_SB(0, 1), baseB, uB + hstep, voffB); PG8_STAGE(PG8_SA(0, 0), baseA, uA, vA0); PG8_STAGE(PG8_SA(0, 1), baseA, uA, vA1);
    if (wr == 1) PG8_BAR;
    PG8_WAIT_V(2); PG8_BAR;
    PG8_STAGE(PG8_SB(1, 0), baseB, uB + kstep, voffB); PG8_STAGE(PG8_SA(1, 0), baseA, uA + kstep, vA0); PG8_STAGE(PG8_SB(1, 1), baseB, uB + hstep + kstep, voffB);
    PG8_WAIT_V(6); PG8_BAR;
    for (;;) {
        const bool has_next = S.next(ui + 1, nxt);
        unsigned nuA, nuB = has_next ? S.b_off(nxt, tstep) : uB;
        if constexpr (GATHER) { nuA = 0u;
#pragma unroll
            for (int i = 0; i < 2; ++i) { if (has_next) { nA0[i] = tabA[nxt.aux * 256 + sR[i]] + (unsigned)sC[i] * 2u; nA1[i] = tabA[nxt.aux * 256 + 128 + sR[i]] + (unsigned)sC[i] * 2u; } else { nA0[i] = vA0[i]; nA1[i] = vA1[i]; } }
        } else { nuA = has_next ? (unsigned)nxt.pm * tstep : uA;
#pragma unroll
            for (int i = 0; i < 2; ++i) { nA0[i] = vA0[i]; nA1[i] = vA1[i]; }
        }
#pragma unroll 1
        for (int t = 0; t < nt; t += 2) {
            const bool last = (t == nt - 2);
            const unsigned a1 = uA + (unsigned)(t + 1) * kstep;
            const unsigned a2 = last ? nuA : uA + (unsigned)(t + 2) * kstep; const unsigned b2 = last ? nuB : uB + (unsigned)(t + 2) * kstep;
            const unsigned a3 = a2 + kstep; const unsigned b3 = b2 + kstep;
            unsigned w0[2], w1[2];
#pragma unroll
            for (int i = 0; i < 2; ++i) { w0[i] = (GATHER && last) ? nA0[i] : vA0[i]; w1[i] = (GATHER && last) ? nA1[i] : vA1[i]; }
            PG8_LDB(B0, 0, 0); PG8_LDB(B1, 0, 1); PG8_SCHED; PG8_LDA(At, 0, 0); PG8_STAGE(PG8_SA(1, 1), baseA, a1, vA1);
            PG8_WAIT_V(8); PG8_WAIT_L(0); PG8_BAR; PG8_MMA(0, 0, At, B0); PG8_MMA(0, 1, At, B1); PG8_BAR; PG8_SCHED;
            PG8_LDA(At, 0, 1); PG8_STAGE(PG8_SB(0, 0), baseB, b2, voffB); PG8_STAGE(PG8_SB(0, 1), baseB, b2 + hstep, voffB); PG8_STAGE(PG8_SA(0, 0), baseA, a2, w0);
            PG8_WAIT_V(8); PG8_WAIT_L(0); PG8_BAR; PG8_MMA(1, 0, At, B0); PG8_MMA(1, 1, At, B1); PG8_BAR; PG8_SCHED;
            PG8_LDB(B0, 1, 0); PG8_LDB(B1, 1, 1); PG8_SCHED; PG8_LDA(At, 1, 0); PG8_STAGE(PG8_SA(0, 1), baseA, a2, w1);
            PG8_WAIT_V(8); PG8_WAIT_L(0); PG8_BAR; PG8_MMA(0, 0, At, B0); PG8_MMA(0, 1, At, B1); PG8_BAR; PG8_SCHED;
            PG8_LDA(At, 1, 1); PG8_STAGE(PG8_SB(1, 0), baseB, b3, voffB); PG8_STAGE(PG8_SB(1, 1), baseB, b3 + hstep, voffB); PG8_STAGE(PG8_SA(1, 0), baseA, a3, w0);
            PG8_WAIT_V(8); PG8_WAIT_L(0); PG8_BAR; PG8_MMA(1, 0, At, B0); PG8_MMA(1, 1, At, B1); PG8_BAR; PG8_SCHED;
        }
        if constexpr (ALIGN_EPI) { if (wr == 0) PG8_BAR; }
        E(acc, cur, wr, wc, fr, fq);
        if (!has_next) break;
#pragma unroll
        for (int a = 0; a < 2; ++a)
#pragma unroll
            for (int b = 0; b < 2; ++b)
#pragma unroll
                for (int m = 0; m < 4; ++m)
#pragma unroll
                    for (int n = 0; n < 2; ++n) acc[a][b][m][n] = (f32x4){0.f, 0.f, 0.f, 0.f};
        cur = nxt; uA = nuA; uB = nuB; ++ui;
#pragma unroll
        for (int i = 0; i < 2; ++i) { vA0[i] = nA0[i]; vA1[i] = nA1[i]; }
        if constexpr (ALIGN_EPI) { if (wr == 1) PG8_BAR; }
    }
    PG8_WAIT_V(0);
    if constexpr (!ALIGN_EPI) { if (wr == 0) PG8_BAR; }
    PG8_BAR;
#undef PG8_SA
#undef PG8_SB
#undef PG8_STAGE
#undef PG8_LDA
#undef PG8_LDB
#undef PG8_MMA
#undef PG8_WAIT_V
#undef PG8_WAIT_L
#undef PG8_BAR
#undef PG8_SCHED
}

typedef int i32x8v __attribute__((ext_vector_type(8)));
typedef int i32x4v __attribute__((ext_vector_type(4)));
template <class Epi, class Sched, bool ALIGN_EPI, bool GATHER>
__device__ __forceinline__ void gemm_phase8(PG8_LAS unsigned char* lds, const Gemm g, const Sched& S, const Epi& E, const PG8_LAS unsigned* tabA) {
    const int tid = tid_fresh(), wid = __builtin_amdgcn_readfirstlane(tid >> 6), lane = tid & 63, wr = wid >> 2, wc = wid & 3, fr = lane & 15, fq = lane >> 4;
    const int K = g.K, nt = K / BK;
    int sR[2], sC[2];
    unsigned voffB[2];
#pragma unroll
    for (int i = 0; i < 2; ++i) { int R, C; stage_rc(tid * 16 + i * 8192, R, C); sR[i] = R; sC[i] = C; const int Rb = Epi::PERM ? ((R & ~31) + perm32(R & 31)) : R;
        voffB[i] = (unsigned)(Rb * K + C) * 2u; }
    const unsigned kstep = (unsigned)(BK * 2);
    const unsigned hstep = (unsigned)(HALF * K * 2);
    const unsigned tstep = 2u * hstep;
    const unsigned ldsw = (unsigned)wid * 1024u;
    const char* const baseA = (const char*)g.A; const char* const baseB = (const char*)g.Bt;
    const int aoff = lds_byte(wr * 64 + fr, 32 * (fq >> 1) + 16 * (fq & 1)), boff = lds_byte(wc * 32 + fr, 32 * (fq >> 1) + 16 * (fq & 1));
#define PG8_SA(b, h) (((b) * 2 + (h)) * HTB)
#define PG8_SB(b, h) ((4 + (b) * 2 + (h)) * HTB)
#define PG8_STAGE(bufoff, gbase, uoff, voff) do { _Pragma("unroll") for (int _i = 0; _i < 2; ++_i) \
        __builtin_amdgcn_global_load_lds((const unsigned*)((gbase) + (size_t)(unsigned)((uoff) + (voff)[_i])), (PG8_LAS unsigned*)(lds + (bufoff) + ldsw + _i * 8192), 16, 0, 0); } while (0)
#define PG8_LD32(p) __builtin_shufflevector(*(const PG8_LAS i32x4v*)(p), *(const PG8_LAS i32x4v*)((p) + 16), 0, 1, 2, 3, 4, 5, 6, 7)
#define PG8_LDA(dst, b, h) do { _Pragma("unroll") for (int m = 0; m < 4; ++m) dst[m] = PG8_LD32(lds + PG8_SA(b, h) + aoff + m * 2048); } while (0)
#define PG8_LDB(dst, b, h) do { _Pragma("unroll") for (int n = 0; n < 2; ++n) dst[n] = PG8_LD32(lds + PG8_SB(b, h) + boff + n * 2048); } while (0)
#define PG8_MMA(ai, bj, At, Bt) do { __builtin_amdgcn_s_setprio(1); _Pragma("unroll") for (int m = 0; m < 4; ++m) _Pragma("unroll") for (int n = 0; n < 2; ++n) \
        asm volatile("v_mfma_scale_f32_16x16x128_f8f6f4 %0, %1, %2, %0, %3, %4 op_sel_hi:[0,0,0]" : "+v"(acc[ai][bj][m][n]) : "v"(Bt[n]), "v"(At[m]), "v"(scw), "v"(sca)); __builtin_amdgcn_s_setprio(0); } while (0)
#define PG8_MFMA_DRAIN asm volatile("s_nop 15\n\ts_nop 15\n\ts_nop 15" ::: "memory")
#define PG8_WAIT_V(n) asm volatile("s_waitcnt vmcnt(" #n ")" ::: "memory")
#define PG8_WAIT_L(n) asm volatile("s_waitcnt lgkmcnt(" #n ")" ::: "memory")
#define PG8_BAR __builtin_amdgcn_s_barrier()
#define PG8_SCHED __builtin_amdgcn_sched_barrier(0)
    Unit cur, nxt; int ui = 0;
    if (!S.next(0, cur)) return;
    f32x4 acc[2][2][4][2];
#pragma unroll
    for (int a = 0; a < 2; ++a)
#pragma unroll
        for (int b = 0; b < 2; ++b)
#pragma unroll
            for (int m = 0; m < 4; ++m)
#pragma unroll
                for (int n = 0; n < 2; ++n) acc[a][b][m][n] = (f32x4){0.f, 0.f, 0.f, 0.f};
    i32x8v At[4], B0[2], B1[2];
    int scw = 0x7a7a7a7a, sca = 0x7f7f7f7f;
    asm volatile("" : "+v"(scw), "+v"(sca));
    unsigned vA0[2], vA1[2], nA0[2], nA1[2];
    unsigned uA, uB = S.b_off(cur, tstep);
    if constexpr (GATHER) { uA = 0u;
#pragma unroll
        for (int i = 0; i < 2; ++i) { vA0[i] = tabA[cur.aux * 256 + sR[i]] + (unsigned)sC[i] * 2u; vA1[i] = tabA[cur.aux * 256 + 128 + sR[i]] + (unsigned)sC[i] * 2u; }
    } else { uA = (unsigned)cur.pm * tstep;
#pragma unroll
        for (int i = 0; i < 2; ++i) { vA0[i] = (unsigned)(sR[i] * K + sC[i]) * 2u; vA1[i] = vA0[i] + hstep; }
    }
    PG8_STAGE(PG8_SB(0, 0), baseB, uB, voffB); PG8_STAGE(PG8_SB(0, 1), baseB, uB + hstep, voffB); PG8_STAGE(PG8_SA(0, 0), baseA, uA, vA0); PG8_STAGE(PG8_SA(0, 1), baseA, uA, vA1);
    if (wr == 1) PG8_BAR;
    PG8_WAIT_V(2); PG8_BAR;
    PG8_STAGE(PG8_SB(1, 0), baseB, uB + kstep, voffB); PG8_STAGE(PG8_SA(1, 0), baseA, uA + kstep, vA0); PG8_STAGE(PG8_SB(1, 1), baseB, uB + hstep + kstep, voffB);
    PG8_WAIT_V(6); PG8_BAR;
    for (;;) {
        const bool has_next = S.next(ui + 1, nxt);
        unsigned nuA, nuB = has_next ? S.b_off(nxt, tstep) : uB;
        if constexpr (GATHER) { nuA = 0u;
#pragma unroll
            for (int i = 0; i < 2; ++i) { if (has_next) { nA0[i] = tabA[nxt.aux * 256 + sR[i]] + (unsigned)sC[i] * 2u; nA1[i] = tabA[nxt.aux * 256 + 128 + sR[i]] + (unsigned)sC[i] * 2u; } else { nA0[i] = vA0[i]; nA1[i] = vA1[i]; } }
        } else { nuA = has_next ? (unsigned)nxt.pm * tstep : uA;
#pragma unroll
            for (int i = 0; i < 2; ++i) { nA0[i] = vA0[i]; nA1[i] = vA1[i]; }
        }
#pragma unroll 1
        for (int t = 0; t < nt; t += 2) {
            const bool last = (t == nt - 2);
            const unsigned a1 = uA + (unsigned)(t + 1) * kstep;
            const unsigned a2 = last ? nuA : uA + (unsigned)(t + 2) * kstep; const unsigned b2 = last ? nuB : uB + (unsigned)(t + 2) * kstep;
            const unsigned a3 = a2 + kstep; const unsigned b3 = b2 + kstep;
            unsigned w0[2], w1[2];
#pragma unroll
            for (int i = 0; i < 2; ++i) { w0[i] = (GATHER && last) ? nA0[i] : vA0[i]; w1[i] = (GATHER && last) ? nA1[i] : vA1[i]; }
            PG8_LDB(B0, 0, 0); PG8_LDB(B1, 0, 1); PG8_SCHED; PG8_LDA(At, 0, 0); PG8_STAGE(PG8_SA(1, 1), baseA, a1, vA1);
            PG8_WAIT_V(8); PG8_WAIT_L(0); PG8_BAR; PG8_MMA(0, 0, At, B0); PG8_MMA(0, 1, At, B1); PG8_BAR; PG8_SCHED;
            PG8_LDA(At, 0, 1); PG8_STAGE(PG8_SB(0, 0), baseB, b2, voffB); PG8_STAGE(PG8_SB(0, 1), baseB, b2 + hstep, voffB); PG8_STAGE(PG8_SA(0, 0), baseA, a2, w0);
            PG8_WAIT_V(8); PG8_WAIT_L(0); PG8_BAR; PG8_MMA(1, 0, At, B0); PG8_MMA(1, 1, At, B1); PG8_BAR; PG8_SCHED;
            PG8_LDB(B0, 1, 0); PG8_LDB(B1, 1, 1); PG8_SCHED; PG8_LDA(At, 1, 0); PG8_STAGE(PG8_SA(0, 1), baseA, a2, w1);
            PG8_WAIT_V(8); PG8_WAIT_L(0); PG8_BAR; PG8_MMA(0, 0, At, B0); PG8_MMA(0, 1, At, B1); PG8_BAR; PG8_SCHED;
            PG8_LDA(At, 1, 1); PG8_STAGE(PG8_SB(1, 0), baseB, b3, voffB); PG8_STAGE(PG8_SB(1, 1), baseB, b3 + hstep, voffB); PG8_STAGE(PG8_SA(1, 0), baseA, a3, w0);
            PG8_WAIT_V(8); PG8_WAIT_L(0); PG8_BAR; PG8_MMA(1, 0, At, B0); PG8_MMA(1, 1, At, B1); PG8_BAR; PG8_SCHED;
        }
        if constexpr (ALIGN_EPI) { if (wr == 0) PG8_BAR; }
        PG8_MFMA_DRAIN;
        { const int l2 = tid_fresh() & 63; E(acc, cur, wr, wc, l2 & 15, l2 >> 4); }
        if (!has_next) break;
#pragma unroll
        for (int a = 0; a < 2; ++a)
#pragma unroll
            for (int b = 0; b < 2; ++b)
#pragma unroll
                for (int m = 0; m < 4; ++m)
#pragma unroll
                    for (int n = 0; n < 2; ++n) acc[a][b][m][n] = (f32x4){0.f, 0.f, 0.f, 0.f};
        cur = nxt; uA = nuA; uB = nuB; ++ui;
#pragma unroll
        for (int i = 0; i < 2; ++i) { vA0[i] = nA0[i]; vA1[i] = nA1[i]; }
        if constexpr (ALIGN_EPI) { if (wr == 1) PG8_BAR; }
    }
    PG8_WAIT_V(0);
    if constexpr (!ALIGN_EPI) { if (wr == 0) PG8_BAR; }
    PG8_BAR;
#undef PG8_SA
#undef PG8_SB
#undef PG8_STAGE
#undef PG8_LDA
#undef PG8_LD32
#undef PG8_LDB
#undef PG8_MMA
#undef PG8_MFMA_DRAIN
#undef PG8_WAIT_V
#undef PG8_WAIT_L
#undef PG8_BAR
#undef PG8_SCHED
}

__device__ __forceinline__ unsigned cvt_pk_bf16(float lo, float hi) { return pk2(lo, hi); }

struct EpiBf16 {
    static constexpr bool PERM = true;
    bf16* O; int ldc;
    __device__ __forceinline__ void operator()(const f32x4 (&acc)[2][2][4][2], const Unit& u, int wr, int wc, int fr, int fq) const {
        const int row0 = u.pm * BM + wr * 64 + fr; const int col0 = u.pn * BM + wc * 32 + 8 * fq;
#pragma unroll
        for (int ai = 0; ai < 2; ++ai)
#pragma unroll
            for (int m = 0; m < 4; ++m) { bf16* rowp = O + (size_t)(row0 + ai * HALF + m * 16) * ldc + col0;
#pragma unroll
                for (int bj = 0; bj < 2; ++bj) { const f32x4 v0 = acc[ai][bj][m][0], v1 = acc[ai][bj][m][1];
                    u32x4 w; w.x = cvt_pk_bf16(v0[0], v0[1]); w.y = cvt_pk_bf16(v0[2], v0[3]); w.z = cvt_pk_bf16(v1[0], v1[1]); w.w = cvt_pk_bf16(v1[2], v1[3]);
                    *(u32x4*)(rowp + bj * HALF) = w; } }
    }
};
struct EpiResid {
    static constexpr bool PERM = false;
    const float* xl; const float* xc; float* out; const float* gate;
    __device__ __forceinline__ void operator()(const f32x4 (&acc)[2][2][4][2], const Unit& u, int wr, int wc, int fr, int fq) const {
        const int rt = u.pm * BM; const bool isl = rt < NLAT;
        const float* base = isl ? xl + (size_t)rt * D : xc + (size_t)(rt - NLAT) * D;
        const float* gp = gate + (size_t)(isl ? (rt >> 12) : 8) * 12288;
        const int rl0 = wr * 64 + fr, col0 = u.pn * BM + wc * 32 + 4 * fq;
#pragma unroll
        for (int ai = 0; ai < 2; ++ai)
#pragma unroll
            for (int m = 0; m < 4; ++m) { const int rl = rl0 + ai * HALF + m * 16; const float* bp = base + (size_t)rl * D + col0; float* op = out + (size_t)(rt + rl) * D + col0;
#pragma unroll
                for (int bj = 0; bj < 2; ++bj)
#pragma unroll
                    for (int n = 0; n < 2; ++n) { const f32x4 b = *(const f32x4*)(bp + bj * HALF + n * 16); const f32x4 gv = *(const f32x4*)(gp + col0 + bj * HALF + n * 16); *(f32x4*)(op + bj * HALF + n * 16) = b + gv * acc[ai][bj][m][n]; }
                asm volatile("" ::: "memory"); }
    }
};
struct EpiSwiglu {
    static constexpr bool PERM = true;
    unsigned char* O;
    __device__ __forceinline__ void operator()(const f32x4 (&acc)[2][2][4][2], const Unit& u, int wr, int wc, int fr, int fq) const {
        const int row0 = u.pm * BM + wr * 64 + fr; const int col0 = u.pn * 128 + wc * 32 + 8 * fq;
#pragma unroll
        for (int ai = 0; ai < 2; ++ai)
#pragma unroll
            for (int m = 0; m < 4; ++m) { unsigned char* rowp = O + (size_t)(row0 + ai * HALF + m * 16) * DE + col0;
                float o[8];
#pragma unroll
                for (int n = 0; n < 2; ++n)
#pragma unroll
                    for (int j = 0; j < 4; ++j) { const float gt = acc[ai][0][m][n][j], up = acc[ai][1][m][n][j]; o[n * 4 + j] = gt * __builtin_amdgcn_rcpf(1.0f + __expf(-gt)) * up; }
                u32x2 w; w.x = pk4_fp8(o[0], o[1], o[2], o[3]); w.y = pk4_fp8(o[4], o[5], o[6], o[7]);
                *(u32x2*)rowp = w; }
    }
};
struct EpiDown {
    static constexpr bool PERM = true;
    bf16* YK; const PG8_LAS unsigned* tab; const PG8_LAS float* tabw;
    __device__ __forceinline__ void operator()(const f32x4 (&acc)[2][2][4][2], const Unit& u, int wr, int wc, int fr, int fq) const {
        const int rl0 = wr * 64 + fr; const int col0 = u.pn * BM + wc * 32 + 8 * fq;
#pragma unroll
        for (int ai = 0; ai < 2; ++ai)
#pragma unroll
            for (int m = 0; m < 4; ++m) { const int rl = rl0 + ai * HALF + m * 16; const unsigned ent = tab[u.aux * 256 + rl]; const float w = tabw[u.aux * 256 + rl];
                if (!(ent & 0x40000000u)) { bf16* rowp = YK + ((size_t)(ent >> 31) * MALL + (ent & 0xffffu)) * D + col0;
#pragma unroll
                    for (int bj = 0; bj < 2; ++bj) { const f32x4 v0 = acc[ai][bj][m][0] * w, v1 = acc[ai][bj][m][1] * w;
                        u32x4 q; q.x = cvt_pk_bf16(v0[0], v0[1]); q.y = cvt_pk_bf16(v0[2], v0[3]); q.z = cvt_pk_bf16(v1[0], v1[1]); q.w = cvt_pk_bf16(v1[2], v1[3]);
                        *(u32x4*)(rowp + bj * HALF) = q; } }
                asm volatile("" ::: "memory"); }
    }
};
}

struct Args { const float* in[31]; float* out; unsigned char* ws; int ph_lo, ph_hi; };
typedef const __attribute__((address_space(4))) Args* KArgs;
__device__ __forceinline__ KArgs kargs() { KArgs p = (KArgs)__builtin_amdgcn_kernarg_segment_ptr(); asm volatile("" : "+s"(p)); return p; }
#define AIN(i) (a->in[i])
enum { I_X = 0, I_C, I_CTX, I_CCTX, I_ADAW, I_ADAB, I_N1G, I_N2G, I_WIN, I_WOUT, I_GNG, I_GWS, I_GB, I_LB, I_HNG, I_MU, I_W0, I_WUP, I_A0, I_AUP, I_GUP, I_KK, I_KA, I_RK, I_GNGG, I_GNB, I_RW, I_RB, I_WGU, I_WDN, I_FNG };

__device__ __forceinline__ void p0_transpose_item(const float* W, int K, int N, bf16* WT, int n_row0, LAS float* scr, int kb, int nb, int lane) {
    const int k0 = 64 * kb, n0 = 32 * nb;
#pragma unroll 8
    for (int i = 0; i < 32; ++i) { const int kk = 2 * i + (lane >> 5); scr[kk * 33 + (lane & 31)] = W[(size_t)(k0 + kk) * N + n0 + (lane & 31)]; }
    asm volatile("s_waitcnt lgkmcnt(0)" ::: "memory");
    const int c = lane & 7;
#pragma unroll
    for (int j = 0; j < 4; ++j) { const int n = (lane >> 3) + 8 * j; const LAS float* s = scr + (8 * c) * 33 + n;
        u32x4 o; o.x = pk2(s[0 * 33], s[1 * 33]); o.y = pk2(s[2 * 33], s[3 * 33]); o.z = pk2(s[4 * 33], s[5 * 33]); o.w = pk2(s[6 * 33], s[7 * 33]);
        *(u32x4*)(WT + (size_t)(n_row0 + n) * K + k0 + 8 * c) = o; }
    asm volatile("s_waitcnt lgkmcnt(0)" ::: "memory");
}

__device__ __forceinline__ void p0_transpose_item8(const float* W, int K, int N, unsigned char* WT, int n_row0, LAS float* scr, int kb, int nb, int lane) {
    const int k0 = 64 * kb, n0 = 32 * nb;
    { const int c4 = (lane & 7) * 4;
      f32x4 t[8];
#pragma unroll
      for (int i = 0; i < 8; ++i) t[i] = *(const f32x4*)(W + (size_t)(k0 + 8 * i + (lane >> 3)) * N + n0 + c4);
#pragma unroll
      for (int i = 0; i < 8; ++i) { LAS float* d = scr + (8 * i + (lane >> 3)) * 33 + c4; d[0] = t[i][0]; d[1] = t[i][1]; d[2] = t[i][2]; d[3] = t[i][3]; } }
    asm volatile("s_waitcnt lgkmcnt(0)" ::: "memory");
    const int c = lane & 7;
#pragma unroll
    for (int j = 0; j < 4; ++j) { const int n = (lane >> 3) + 8 * j; const LAS float* sp = scr + (8 * c) * 33 + n;
        u32x2 o; o.x = pk4_fp8(sp[0 * 33] * 32.f, sp[1 * 33] * 32.f, sp[2 * 33] * 32.f, sp[3 * 33] * 32.f); o.y = pk4_fp8(sp[4 * 33] * 32.f, sp[5 * 33] * 32.f, sp[6 * 33] * 32.f, sp[7 * 33] * 32.f);
        *(u32x2*)(WT + (size_t)(n_row0 + n) * K + k0 + 8 * c) = o; }
    asm volatile("s_waitcnt lgkmcnt(0)" ::: "memory");
}
__device__ __forceinline__ void convert_moe(KArgs a, int l, LAS unsigned char* lds) {
    const int tid = tid_fresh(), lane = tid & 63, wave = tid >> 6;
    const int gw = blockIdx.x * 8 + wave, NGW = gridDim.x * 8;
    unsigned char* ws = a->ws;
    LAS float* scr = (LAS float*)(lds + wave * 16384);
    constexpr int I_GU = 32 * 64, I_DN = 16 * 64, N2 = 16 * I_GU, N3 = N2 + 16 * I_DN;
    for (int it = gw; it < N3; it += NGW) {
        if (it < N2) { const int e = it / I_GU, r = it % I_GU, kb = r / 64, nb = r % 64;
            const int n0 = 32 * nb, hh = n0 >> 10, nn = n0 & 1023, row0 = 256 * (nn >> 7) + 128 * hh + (nn & 127);
            p0_transpose_item8(a->in[I_WGU] + (size_t)(l * NE + e) * D * 2048, D, 2048, ws + WS_WGU + (size_t)e * 2048 * D, row0, scr, kb, nb, lane); }
        else { const int q = it - N2, e = q / I_DN, r = q % I_DN, kb = r / 64, nb = r % 64;
            p0_transpose_item8(a->in[I_WDN] + (size_t)(l * NE + e) * DE * D, DE, D, ws + WS_WDN + (size_t)e * D * DE, 32 * nb, scr, kb, nb, lane); }
    }
}
__device__ __forceinline__ void phase_prologue(KArgs a, LAS unsigned char* lds) {
    const int tid = tid_fresh(), lane = tid & 63, wave = tid >> 6;
    const int G = gridDim.x, gw = blockIdx.x * 8 + wave, NGW = G * 8;
    unsigned char* ws = a->ws;
    LAS float* scr = (LAS float*)(lds + wave * 16384);
    constexpr int I_IN = 32 * 232, I_OUT = 32 * 64;
    constexpr int N0 = 2 * I_IN, N1 = N0 + 2 * I_OUT;
    for (int it = gw; it < N1; it += NGW) {
        if (it < N0) { const int l = it / I_IN, r = it % I_IN, kb = r / 232, nb = r % 232;
            p0_transpose_item8(a->in[I_WIN] + (size_t)l * D * INC, D, INC, ws + WS_WIN + (size_t)l * INC * D, 32 * nb, scr, kb, nb, lane); }
        else { const int q = it - N0, l = q / I_OUT, r = q % I_OUT, kb = r / 64, nb = r % 64;
            p0_transpose_item8(a->in[I_WOUT] + (size_t)l * D * D, D, D, ws + WS_WOUT + (size_t)l * D * D, 32 * nb, scr, kb, nb, lane); }
    }
    convert_moe(a, 0, lds);
    {
        const int gt = blockIdx.x * NTHREADS + tid, NGT = G * NTHREADS;
        bf16* wup = (bf16*)(ws + WS_SMALLW + SW_WUP); bf16* aup = (bf16*)(ws + WS_SMALLW + SW_AUP); bf16* gup = (bf16*)(ws + WS_SMALLW + SW_GUP); bf16* gws = (bf16*)(ws + WS_SMALLW + SW_GWS);
        for (int i = gt; i < 2 * 2 * 768 * 64; i += NGT) { const int k = i & 63, n = (i >> 6) % 768, ld = i / (768 * 64); wup[i] = (bf16)f2bf(a->in[I_WUP][((size_t)ld * 64 + k) * 768 + n]); }
        for (int i = gt; i < 2 * 768 * 64; i += NGT) { const int k = i & 63, n = (i >> 6) % 768, l = i / (768 * 64); aup[i] = (bf16)f2bf(a->in[I_AUP][((size_t)l * 64 + k) * 768 + n]); }
        for (int i = gt; i < 2 * 768 * 128; i += NGT) { const int k = i & 127, n = (i >> 7) % 768, l = i / (768 * 128); gup[i] = (bf16)f2bf(a->in[I_GUP][((size_t)l * 128 + k) * 768 + n]); }
        for (int i = gt; i < 2 * 4 * 128 * 128; i += NGT) gws[i] = (bf16)f2bf(a->in[I_GWS][i]);
    }
    __syncthreads();
    {
        LAS float* sv = (LAS float*)lds;
        LAS float* red = (LAS float*)(lds + 73728);
        for (int i = tid; i < 9 * D; i += NTHREADS) { const int r = i / D, k = i % D; const float v = r < 8 ? a->in[I_C][r * D + k] : a->in[I_CCTX][k]; sv[i] = siluf_(v); }
        __syncthreads();
        float* mod = (float*)(ws + WS_MOD);
        for (int it = blockIdx.x; it < 2 * 96; it += G) {
            const int l = it / 96, cb = it % 96, cq = tid & 31, kg = tid >> 5;
            const float* wp = a->in[I_ADAW] + (size_t)l * D * 12288 + (size_t)(kg * 128) * 12288 + cb * 128 + cq * 4;
            f32x4 acc[9];
#pragma unroll
            for (int r = 0; r < 9; ++r) acc[r] = (f32x4){0.f, 0.f, 0.f, 0.f};
#pragma unroll 4
            for (int k = 0; k < 128; ++k) { const f32x4 w = *(const f32x4*)(wp + (size_t)k * 12288);
#pragma unroll
                for (int r = 0; r < 9; ++r) acc[r] += w * sv[r * D + kg * 128 + k]; }
#pragma unroll
            for (int r = 0; r < 9; ++r) *(LAS f32x4*)(red + ((kg * 9 + r) * 128 + cq * 4)) = acc[r];
            __syncthreads();
            for (int o = tid; o < 9 * 128; o += NTHREADS) { const int r = o / 128, c = o % 128; float s = a->in[I_ADAB][(size_t)l * 12288 + cb * 128 + c];
#pragma unroll
                for (int q = 0; q < 16; ++q) s += red[(q * 9 + r) * 128 + c];
                mod[((size_t)l * 9 + r) * 12288 + cb * 128 + c] = s; }
            __syncthreads();
        }
    }
}

template <int MODE>
__device__ __forceinline__ void phase_norm1(KArgs a, int l, bool dry) {
    const int tid_ = tid_fresh(); const int lane = tid_ & 63, wave = tid_ >> 6, gw = blockIdx.x * 8 + wave, NGW = gridDim.x * 8;
    unsigned char* ws = a->ws;
    const float* mod = (const float*)(ws + WS_MOD);
    float* X = (float*)(ws + WS_X); bf16* H = (bf16*)(ws + WS_H); const bf16* YK = (const bf16*)(ws + WS_YK);
    float* Xo = dry ? (float*)(ws + WS_END) : X; bf16* Ho = dry ? (bf16*)(ws + WS_END) : H; float* Oo = dry ? (float*)(ws + WS_END) : a->out;
    const int nrows = (MODE == 2) ? NLAT : MALL;
    const int rpw = (nrows + NGW - 1) / NGW; const int r0 = gw * rpw, r1 = (r0 + rpw < nrows) ? r0 + rpw : nrows;
    f32x4 ck[8], cs[8], cg[8]; int cur_mr = -1;
    for (int row = r0; row < r1; ++row) {
        const int mr = modrow_of(row); const int orow = dry ? (row & 2047) : row;
        if (mr != cur_mr) { cur_mr = mr;
#pragma unroll
            for (int j = 0; j < 8; ++j) { const int c = 4 * lane + 256 * j;
                if (MODE == 2) ck[j] = *(const f32x4*)(a->in[I_FNG] + c);
                else { const float* m = mod + ((size_t)l * 9 + mr) * 12288; const f32x4 g = *(const f32x4*)(a->in[I_N1G] + (size_t)l * D + c); ck[j] = g * (*(const f32x4*)(m + D + c) + 1.0f); cs[j] = *(const f32x4*)(m + c); }
                if (MODE != 0) cg[j] = *(const f32x4*)(mod + ((size_t)(l - 1) * 9 + mr) * 12288 + 5 * D + c); } }
        f32x4 v[8];
        if (MODE == 0) { const float* xr = row < NLAT ? a->in[I_X] + (size_t)row * D : a->in[I_CTX] + (size_t)(row - NLAT) * D;
#pragma unroll
            for (int j = 0; j < 8; ++j) v[j] = *(const f32x4*)(xr + 4 * lane + 256 * j);
        } else {
            const float* xr = X + (size_t)row * D; const bf16* y0 = YK + (size_t)row * D; const bf16* y1 = YK + ((size_t)MALL + row) * D;
            u32x2 p0[8], p1[8];
#pragma unroll
            for (int j = 0; j < 8; ++j) { const int c = 4 * lane + 256 * j; v[j] = *(const f32x4*)(xr + c); p0[j] = *(const u32x2*)(y0 + c); p1[j] = *(const u32x2*)(y1 + c); }
#pragma unroll
            for (int j = 0; j < 8; ++j) { f32x4 f; f[0] = bflo(p0[j].x) + bflo(p1[j].x); f[1] = bfhi(p0[j].x) + bfhi(p1[j].x); f[2] = bflo(p0[j].y) + bflo(p1[j].y); f[3] = bfhi(p0[j].y) + bfhi(p1[j].y);
                v[j] = v[j] + cg[j] * f; }
            if (MODE == 1) {
#pragma unroll
                for (int j = 0; j < 8; ++j) *(f32x4*)(Xo + (size_t)orow * D + 4 * lane + 256 * j) = v[j];
            }
        }
        float ss = 0.f;
#pragma unroll
        for (int j = 0; j < 8; ++j) ss += (v[j][0] * v[j][0] + v[j][1] * v[j][1]) + (v[j][2] * v[j][2] + v[j][3] * v[j][3]);
        const float rstd = 1.0f / sqrtf(wave_sum(ss) * (1.0f / D) + NORM_EPS);
        if (MODE == 2) {
#pragma unroll
            for (int j = 0; j < 8; ++j) *(f32x4*)(Oo + (size_t)orow * D + 4 * lane + 256 * j) = v[j] * rstd * ck[j];
        } else {
#pragma unroll
            for (int j = 0; j < 8; ++j) { const f32x4 h = v[j] * rstd * ck[j] + cs[j]; *(unsigned*)((unsigned char*)Ho + (size_t)orow * D + 4 * lane + 256 * j) = pk4_fp8(h[0], h[1], h[2], h[3]); }
        }
    }
}

__device__ __forceinline__ void phase_norm2_router(KArgs a, int l, bool dry, LAS unsigned char* lds) {
    const int tid_ = tid_fresh(); const int lane = tid_ & 63, wave = tid_ >> 6, gw = blockIdx.x * 8 + wave, NGW = gridDim.x * 8;
    unsigned char* ws = a->ws;
    const float* mod = (const float*)(ws + WS_MOD);
    const float* X = (const float*)(ws + WS_X); bf16* H = (bf16*)(ws + WS_H);
    unsigned* cnt = (unsigned*)(ws + WS_CTL) + CW_CNT + l * 16 * 64 + (dry ? 4096 : 0);
    unsigned* ridx = (unsigned*)(ws + (dry ? WS_END : WS_RIDX)); float* rwt = (float*)(ws + (dry ? WS_END + 4 * MiB : WS_RW)); bf16* Ho = dry ? (bf16*)(ws + WS_END + 8 * MiB) : H;
    const int nrows = (l == DEPTH - 1) ? NLAT : MALL;
    LAS f32x4* rwl = (LAS f32x4*)lds;
    { const float* rw = a->in[I_RW];
      for (int idx = tid_; idx < 8192; idx += NTHREADS) { const int ln = idx & 63, q = (idx >> 6) & 3, i = (idx >> 8) & 3, j = idx >> 10; rwl[idx] = *(const f32x4*)(rw + (size_t)(4 * ln + 256 * j + i) * 16 + 4 * q); } }
    __syncthreads();
    const int rpw = (nrows + NGW - 1) / NGW; const int r0 = gw * rpw, r1 = (r0 + rpw < nrows) ? r0 + rpw : nrows;
    f32x4 ck[8]; int cur_mr = -1;
    const float* rbp = a->in[I_RB];
    for (int row = r0; row < r1; ++row) {
        const int mr = modrow_of(row); const int orow = dry ? (row & 2047) : row;
        if (mr != cur_mr) { cur_mr = mr; const float* m = mod + ((size_t)l * 9 + mr) * 12288;
#pragma unroll
            for (int j = 0; j < 8; ++j) { const int c = 4 * lane + 256 * j; const f32x4 g = *(const f32x4*)(a->in[I_N2G] + (size_t)l * D + c); ck[j] = g * (*(const f32x4*)(m + 4 * D + c) + 1.0f); } }
        const float* shp = mod + ((size_t)l * 9 + mr) * 12288 + 3 * D;
        const float* xr = X + (size_t)row * D;
        f32x4 v[8]; float ss = 0.f;
#pragma unroll
        for (int j = 0; j < 8; ++j) { v[j] = *(const f32x4*)(xr + 4 * lane + 256 * j); ss += (v[j][0] * v[j][0] + v[j][1] * v[j][1]) + (v[j][2] * v[j][2] + v[j][3] * v[j][3]); }
        const float rstd = 1.0f / sqrtf(wave_sum(ss) * (1.0f / D) + NORM_EPS);
        f32x4 lg4[4];
#pragma unroll
        for (int q = 0; q < 4; ++q) lg4[q] = (f32x4){0.f, 0.f, 0.f, 0.f};
#pragma unroll
        for (int j = 0; j < 8; ++j) { const f32x4 h = v[j] * rstd * ck[j] + *(const f32x4*)(shp + 4 * lane + 256 * j); *(unsigned*)((unsigned char*)Ho + (size_t)orow * D + 4 * lane + 256 * j) = pk4_fp8(h[0], h[1], h[2], h[3]);
#pragma unroll
            for (int i = 0; i < 4; ++i)
#pragma unroll
                for (int q = 0; q < 4; ++q) lg4[q] += rwl[((j * 4 + i) * 4 + q) * 64 + lane] * h[i];
            asm volatile("" ::: "memory"); }
        float lg[16];
        { float t8[8], t4[4], t2[2], t1;
          const bool b5 = lane & 32, b4 = lane & 16, b3 = lane & 8, b2 = lane & 4;
#pragma unroll
          for (int i = 0; i < 8; ++i) { const float keep = b5 ? lg4[(i + 8) >> 2][(i + 8) & 3] : lg4[i >> 2][i & 3], send = b5 ? lg4[i >> 2][i & 3] : lg4[(i + 8) >> 2][(i + 8) & 3]; t8[i] = keep + __shfl_xor(send, 32); }
#pragma unroll
          for (int i = 0; i < 4; ++i) { const float keep = b4 ? t8[i + 4] : t8[i], send = b4 ? t8[i] : t8[i + 4]; t4[i] = keep + __shfl_xor(send, 16); }
#pragma unroll
          for (int i = 0; i < 2; ++i) { const float keep = b3 ? t4[i + 2] : t4[i], send = b3 ? t4[i] : t4[i + 2]; t2[i] = keep + __shfl_xor(send, 8); }
          { const float keep = b2 ? t2[1] : t2[0], send = b2 ? t2[0] : t2[1]; t1 = keep + __shfl_xor(send, 4); }
          t1 += __shfl_xor(t1, 2); t1 += __shfl_xor(t1, 1);
#pragma unroll
          for (int e = 0; e < 16; ++e) { const int src = ((e >> 3) & 1) * 32 + ((e >> 2) & 1) * 16 + ((e >> 1) & 1) * 8 + (e & 1) * 4; lg[e] = __builtin_bit_cast(float, __builtin_amdgcn_readlane(__builtin_bit_cast(int, t1), src)) + rbp[e]; } }
        float mx = lg[0];
#pragma unroll
        for (int e = 1; e < 16; ++e) mx = fmaxf(mx, lg[e]);
        float p[16], sum = 0.f;
#pragma unroll
        for (int e = 0; e < 16; ++e) { p[e] = __expf(lg[e] - mx); sum += p[e]; }
        const float inv = 1.0f / sum;
#pragma unroll
        for (int e = 0; e < 16; ++e) p[e] *= inv;
        int sel = 0; float best = -1.f;
#pragma unroll
        for (int gI = 0; gI < 4; ++gI) { float m1 = -1.f, m2 = -1.f;
#pragma unroll
            for (int i = 0; i < 4; ++i) { const float q = p[4 * gI + i]; if (q > m1) { m2 = m1; m1 = q; } else if (q > m2) m2 = q; }
            const float s = m1 + m2; if (s > best) { best = s; sel = gI; } }
        int i1 = 0, i2 = 0; float p1 = -2.f, p2 = -2.f;
#pragma unroll
        for (int gI = 0; gI < 4; ++gI)
#pragma unroll
            for (int i = 0; i < 4; ++i) { const float q = (gI == sel) ? p[4 * gI + i] : -1.0f; const int e = 4 * gI + i;
                if (gI == sel) { if (q > p1) { p2 = p1; i2 = i1; p1 = q; i1 = e; } else if (q > p2) { p2 = q; i2 = e; } } }
        const float wsum = p1 + p2, w1 = p1 / wsum, w2 = p2 / wsum;
        if (lane == 0) {
            const unsigned q1 = atomicAdd(cnt + i1 * 64, 1u); ridx[(size_t)i1 * MALL + q1] = (unsigned)row; rwt[(size_t)i1 * MALL + q1] = w1;
            const unsigned q2 = atomicAdd(cnt + i2 * 64, 1u); ridx[(size_t)i2 * MALL + q2] = (unsigned)row | 0x80000000u; rwt[(size_t)i2 * MALL + q2] = w2;
        }
    }
    __syncthreads();
}

template <bool FOR_DOWN>
__device__ __forceinline__ void moe_tables(KArgs a, int l, LAS unsigned char* lds, int cvirt) {
    const int tid = tid_fresh(), G = gridDim.x;
    unsigned char* ws = a->ws;
    const unsigned* cnt = (const unsigned*)(ws + WS_CTL) + CW_CNT + l * 16 * 64;
    const unsigned* ridx = (const unsigned*)(ws + WS_RIDX); const float* rwt = (const float*)(ws + WS_RW);
    LAS int* tp = (LAS int*)(lds + LDS_TP); LAS unsigned* tab = (LAS unsigned*)(lds + LDS_TAB); LAS float* tabw = (LAS float*)(lds + LDS_TABW);
    if (tid == 0) { int acc = 0; for (int e = 0; e < 16; ++e) { tp[e] = acc; acc += (int)((cnt[e * 64] + 255u) >> 8); } tp[16] = acc; }
    __syncthreads();
    const int ntot = tp[16] * 8;
    for (int i = 0; i < 9; ++i) { const int L = i * G + cvirt; if (L >= ntot) break;
        const int tile = L >> 3; int e = 0;
        for (int j = 1; j < 16; ++j) e += (tile >= tp[j]) ? 1 : 0;
        const int pos0 = (tile - tp[e]) * 256; const unsigned ce = cnt[e * 64];
        if (tid < 256) { const int pos = pos0 + tid; const bool valid = (unsigned)pos < ce; const unsigned ent = ridx[(size_t)e * MALL + (valid ? pos : 0)];
            if (FOR_DOWN) { tab[i * 256 + tid] = valid ? ent : (ent | 0x40000000u); tabw[i * 256 + tid] = valid ? rwt[(size_t)e * MALL + pos] : 0.f; }
            else tab[i * 256 + tid] = (ent & 0xffffu) * (unsigned)D; }
    }
    __syncthreads();
}

__device__ __forceinline__ void gmlp_item(KArgs a, int l, int item, LAS unsigned char* lds) {
    const int tid = tid_fresh(), lane = tid & 63, wave = tid >> 6;
    unsigned char* ws = a->ws;
    const bf16* P = (const bf16*)(ws + WS_P); bf16* Y = (bf16*)(ws + WS_Y);
    const int chunk = item >> 2, h = item & 3;
    const int row0 = chunk < 256 ? chunk * 128 : NLAT + (chunk - 256) * 128;
    LAS bf16* wsl = (LAS bf16*)lds;
    LAS bf16* vT = (LAS bf16*)(lds + 128 * 136 * 2);
    const bf16* gws = (const bf16*)(ws + WS_SMALLW + SW_GWS) + ((size_t)l * 4 + h) * 128 * 128;
    for (int p = tid; p < 2048; p += NTHREADS) { const int t = p >> 4, c8 = p & 15; *(LAS u32x4*)(wsl + t * 136 + c8 * 8) = *(const u32x4*)(gws + t * 128 + c8 * 8); }
    {
        const int s = tid >> 2, qd = tid & 3; const bf16* vp = P + (size_t)(row0 + s) * INC + OFF_V + h * 128 + qd * 32;
        float g[32]; float ss = 0.f;
#pragma unroll
        for (int q = 0; q < 4; ++q) { float f[8]; unpack8(*(const u32x4*)(vp + 8 * q), f);
#pragma unroll
            for (int j = 0; j < 8; ++j) { const float x = geluf_(f[j]); g[8 * q + j] = x; ss += x * x; } }
        ss += __shfl_xor(ss, 1); ss += __shfl_xor(ss, 2);
        const float rstd = 1.0f / sqrtf(ss * (1.0f / 128.0f) + NORM_EPS);
        const float* ng = a->in[I_GNG] + (size_t)l * 512 + h * 128 + qd * 32;
#pragma unroll
        for (int j = 0; j < 32; ++j) vT[(qd * 32 + j) * 136 + s] = (bf16)f2bf(g[j] * rstd * ng[j]);
    }
    __syncthreads();
    f32x4 acc[8];
#pragma unroll
    for (int ct = 0; ct < 8; ++ct) acc[ct] = (f32x4){0.f, 0.f, 0.f, 0.f};
    const int fr = lane & 15, fq = lane >> 4;
#pragma unroll
    for (int ks = 0; ks < 4; ++ks) {
        const bf16x8 bfrag = *(const LAS bf16x8*)(wsl + (16 * wave + fr) * 136 + ks * 32 + fq * 8);
#pragma unroll
        for (int ct = 0; ct < 8; ++ct) { const bf16x8 afrag = *(const LAS bf16x8*)(vT + (16 * ct + fr) * 136 + ks * 32 + fq * 8);
            acc[ct] = __builtin_amdgcn_mfma_f32_16x16x32_bf16(afrag, bfrag, acc[ct], 0, 0, 0); }
    }
    const int t = 16 * wave + fr; const float wb = a->in[I_GB][((size_t)l * 4 + h) * 128 + t];
    const bf16* up = P + (size_t)(row0 + t) * INC + OFF_U + h * 128; unsigned char* yp = a->ws + WS_Y8 + (size_t)(row0 + t) * D + h * 128;
#pragma unroll
    for (int ct = 0; ct < 8; ++ct) { const int c = 16 * ct + 4 * fq; const u32x2 uu = *(const u32x2*)(up + c);
        const float y0 = geluf_(bflo(uu.x)) * (acc[ct][0] + wb), y1 = geluf_(bfhi(uu.x)) * (acc[ct][1] + wb), y2 = geluf_(bflo(uu.y)) * (acc[ct][2] + wb), y3 = geluf_(bfhi(uu.y)) * (acc[ct][3] + wb);
        *(unsigned*)(yp + c) = pk4_fp8(y0, y1, y2, y3); }
    __syncthreads();
}

constexpr int SP_ = 72;
__device__ __forceinline__ int kperm_pos(int k) { const int s5 = k & 31; return (k & 32) + 8 * ((s5 >> 2) & 3) + 4 * (s5 >> 4) + (s5 & 3); }
__device__ __forceinline__ void rwkv_prep_item(KArgs a, int l, int tile, int hgrp, LAS unsigned char* lds) {
    const int tid = tid_fresh(), lane = tid & 63, wave = tid >> 6;
    unsigned char* ws = a->ws;
    const bf16* P = (const bf16*)(ws + WS_P); bf16* Y = (bf16*)(ws + WS_Y);
    LAS bf16* SR = (LAS bf16*)lds; LAS bf16* SK = SR + 64 * SP_; LAS bf16* SV = SK + 64 * SP_; LAS bf16* SKK = SV + 64 * SP_; LAS bf16* SB = SKK + 64 * SP_; LAS bf16* SWF = SB + 64 * SP_; LAS bf16* SWB = SWF + 64 * SP_;
    LAS bf16* tw = SWB + 64 * SP_;
    LAS bf16* adl = tw + 64 * SP_;
    LAS bf16* sg = adl + 64 * SP_;
    LAS float* invn = (LAS float*)(sg + 64 * 136);
    LAS unsigned char* wpriv = (LAS unsigned char*)(invn + 64) + wave * 6144;
    const int row0 = tile * 64; const bool isl = row0 < NLAT;
    const float* mu = a->in[I_MU] + (size_t)l * CCOLS;
    const char* Pb = (const char*)P;
    auto shift_group = [&](int tk, int col, float (&z)[8]) {
        const int row = row0 + tk; int o0, o1, o2, o3; bool v0, v1, v2, v3;
        if (isl) { const int gr = (row >> 6) & 63; o0 = -1; o1 = 1; o2 = -64; o3 = 64; v0 = tk > 0; v1 = tk < 63; v2 = gr > 0; v3 = gr < 63; }
        else { const int tc = (row - NLAT) & 255; o0 = -1; o1 = 1; o2 = -1; o3 = 1; v0 = tc > 0; v1 = tc < 255; v2 = v0; v3 = v1; }
        const unsigned off = (unsigned)row * (unsigned)(INC * 2) + (unsigned)(OFF_C + col) * 2u;
        const u32x4 uo = *(const u32x4*)(Pb + off), u0 = *(const u32x4*)(Pb + (off + (unsigned)((v0 ? o0 : 0) * INC * 2))), u1 = *(const u32x4*)(Pb + (off + (unsigned)((v1 ? o1 : 0) * INC * 2))),
                    u2 = *(const u32x4*)(Pb + (off + (unsigned)((v2 ? o2 : 0) * INC * 2))), u3 = *(const u32x4*)(Pb + (off + (unsigned)((v3 ? o3 : 0) * INC * 2)));
        const f32x4 m0 = *(const f32x4*)(mu + col), m1 = *(const f32x4*)(mu + col + 4);
        float own[8], n0[8], n1[8], n2[8], n3[8]; unpack8(uo, own); unpack8(u0, n0); unpack8(u1, n1); unpack8(u2, n2); unpack8(u3, n3);
        const float f0 = v0 ? 1.f : 0.f, f1 = v1 ? 1.f : 0.f, f2 = v2 ? 1.f : 0.f, f3 = v3 ? 1.f : 0.f;
        const float nb[8] = {n0[0] * f0, n1[1] * f1, n2[2] * f2, n3[3] * f3, n0[4] * f0, n1[5] * f1, n2[6] * f2, n3[7] * f3};
#pragma unroll
        for (int j = 0; j < 8; ++j) { const float mm = j < 4 ? m0[j] : m1[j - 4]; z[j] = own[j] + mm * (nb[j] - own[j]); }
    };
#pragma unroll
    for (int it = 0; it < 4; ++it) { const int g = tid + NTHREADS * it, tk = g >> 5, gi = g & 31;
        float z[8]; shift_group(tk, 2304 + gi * 8, z);
        if (gi < 8) { float t8[8];
#pragma unroll
            for (int j = 0; j < 8; ++j) t8[j] = 1.0f - 2.0f * __builtin_amdgcn_rcpf(1.0f + __expf(2.0f * z[j]));
            *(LAS u32x4*)(tw + tk * SP_ + gi * 8) = pack8(t8); }
        else if (gi < 16) *(LAS u32x4*)(adl + tk * SP_ + (gi - 8) * 8) = pack8(z);
        else { float t8[8];
#pragma unroll
            for (int j = 0; j < 8; ++j) t8[j] = sigmoidf_(z[j]);
            *(LAS u32x4*)(sg + tk * 136 + (gi - 16) * 8) = pack8(t8); } }
    __syncthreads();
#pragma unroll 1
    for (int hh = 0; hh < 4; ++hh) {
    const int tid = tid_fresh(), lane = tid & 63, wave = tid >> 6;
    const int head = 4 * hgrp + hh; const float* kkw = a->in[I_KK] + (size_t)l * CW + head * 64;
#pragma unroll
    for (int it = 0; it < 3; ++it) { const int g = tid + NTHREADS * it, tk = g / 24, gi = g % 24, c8 = (gi & 7) * 8;
        float z[8]; shift_group(tk, (gi >> 3) * 768 + head * 64 + c8, z);
        if (gi < 8) *(LAS u32x4*)(SR + tk * SP_ + c8) = pack8(z);
        else if (gi < 16) { *(LAS u32x4*)(SK + tk * SP_ + c8) = pack8(z);
            const f32x4 k0 = *(const f32x4*)(kkw + c8), k1 = *(const f32x4*)(kkw + c8 + 4); float ss = 0.f;
#pragma unroll
            for (int j = 0; j < 8; ++j) { const float q = z[j] * (j < 4 ? k0[j] : k1[j - 4]); ss += q * q; }
            ss += __shfl_xor(ss, 1); ss += __shfl_xor(ss, 2); ss += __shfl_xor(ss, 4);
            if ((gi & 7) == 0) invn[tk] = 1.0f / fmaxf(sqrtf(ss), 1e-12f); }
        else *(LAS u32x4*)(SV + tk * SP_ + c8) = pack8(z); }
    __syncthreads();
    {
        const int fr = lane & 15, fq = lane >> 4, nt = wave & 3, th = wave >> 2;
        const bf16* wupT = (const bf16*)(ws + WS_SMALLW + SW_WUP) + (size_t)l * 2 * 768 * 64;
        const bf16* aupT = (const bf16*)(ws + WS_SMALLW + SW_AUP) + (size_t)l * 768 * 64;
        const bf16* gupT = (const bf16*)(ws + WS_SMALLW + SW_GUP) + (size_t)l * 768 * 128;
        const float* a0 = a->in[I_A0] + (size_t)l * CW + head * 64; const float* kaw = a->in[I_KA] + (size_t)l * CW + head * 64; const float* w0 = a->in[I_W0] + (size_t)l * 2 * CW + head * 64;
        const int nloc = 16 * nt + 4 * fq;
#pragma unroll 1
        for (int mat = 0; mat < 4; ++mat) {
            const bf16* WT = mat == 0 ? aupT : (mat == 1 ? wupT : (mat == 2 ? wupT + 768 * 64 : gupT));
            const int KK = mat == 3 ? 128 : 64; const LAS bf16* act = mat == 0 ? adl : (mat == 3 ? sg : tw); const int apitch = mat == 3 ? 136 : SP_;
            f32x4 acc[2];
            acc[0] = (f32x4){0.f, 0.f, 0.f, 0.f}; acc[1] = acc[0];
            for (int ks = 0; ks < KK / 32; ++ks) { const bf16x8 afr = *(const bf16x8*)(WT + (size_t)(head * 64 + 16 * nt + fr) * KK + ks * 32 + fq * 8);
#pragma unroll
                for (int tt = 0; tt < 2; ++tt) { const bf16x8 bfr = *(const LAS bf16x8*)(act + (16 * (2 * th + tt) + fr) * apitch + ks * 32 + fq * 8); acc[tt] = __builtin_amdgcn_mfma_f32_16x16x32_bf16(afr, bfr, acc[tt], 0, 0, 0); } }
#pragma unroll
            for (int tt = 0; tt < 2; ++tt) { const int tk = 16 * (2 * th + tt) + fr; const f32x4 v = acc[tt];
                if (mat == 0) {
                    const f32x4 a0v = *(const f32x4*)(a0 + nloc), kav = *(const f32x4*)(kaw + nloc), kkv = *(const f32x4*)(kkw + nloc);
                    const u32x2 kp = *(const LAS u32x2*)(SK + tk * SP_ + nloc); const float kf[4] = {bflo(kp.x), bfhi(kp.x), bflo(kp.y), bfhi(kp.y)};
                    const float inn = invn[tk]; float k2[4], kk[4], bb[4];
#pragma unroll
                    for (int j = 0; j < 4; ++j) { const float av = sigmoidf_(a0v[j] + v[j]); kk[j] = kf[j] * kkv[j] * inn; k2[j] = kf[j] * (1.0f + (av - 1.0f) * kav[j]); bb[j] = kk[j] * av; }
                    u32x2 q; q.x = pk2(k2[0], k2[1]); q.y = pk2(k2[2], k2[3]); *(LAS u32x2*)(SK + tk * SP_ + nloc) = q;
                    q.x = pk2(kk[0], kk[1]); q.y = pk2(kk[2], kk[3]); *(LAS u32x2*)(SKK + tk * SP_ + nloc) = q;
                    q.x = pk2(bb[0], bb[1]); q.y = pk2(bb[2], bb[3]); *(LAS u32x2*)(SB + tk * SP_ + nloc) = q;
                } else if (mat <= 2) {
                    const f32x4 w0v = *(const f32x4*)(w0 + (mat - 1) * CW + nloc); float d[4];
#pragma unroll
                    for (int j = 0; j < 4; ++j) d[j] = __expf(-DECAY_SCALE * sigmoidf_(w0v[j] + v[j]));
                    u32x2 q; q.x = pk2(d[0], d[1]); q.y = pk2(d[2], d[3]); *(LAS u32x2*)((mat == 1 ? SWF : SWB) + tk * SP_ + nloc) = q;
                } else {
                    u32x2 q; q.x = pk2(v[0], v[1]); q.y = pk2(v[2], v[3]); *(u32x2*)(Y + (size_t)(row0 + tk) * D + 1280 + head * 64 + nloc) = q;
                }
            }
        }
    }
    __syncthreads();
    { const int tk = tid >> 3, c8 = (tid & 7) * 8; float r8[8], k8[8], v8[8];
      unpack8(*(const LAS u32x4*)(SR + tk * SP_ + c8), r8); unpack8(*(const LAS u32x4*)(SK + tk * SP_ + c8), k8); unpack8(*(const LAS u32x4*)(SV + tk * SP_ + c8), v8);
      const float* rkp = a->in[I_RK] + (size_t)l * CW + head * 64 + c8; const f32x4 rk0 = *(const f32x4*)rkp, rk1 = *(const f32x4*)(rkp + 4);
      float bs = 0.f;
#pragma unroll
      for (int j = 0; j < 8; ++j) bs += r8[j] * k8[j] * (j < 4 ? rk0[j] : rk1[j - 4]);
      bs += __shfl_xor(bs, 1); bs += __shfl_xor(bs, 2); bs += __shfl_xor(bs, 4);
#pragma unroll
      for (int j = 0; j < 8; ++j) v8[j] *= bs;
      *(u32x4*)(Y + (size_t)(row0 + tk) * D + 512 + head * 64 + c8) = pack8(v8); }
    {
        const int c4 = wave & 3, dir = wave >> 2, fr = lane & 15, fq = lane >> 4;
        LAS float* CB = (LAS float*)wpriv;
        LAS float* AA = CB + 16 * 64;
        const LAS bf16* SW = dir ? SWB : SWF;
        auto trow = [&](int tau) { return 16 * c4 + (dir ? 15 - tau : tau); };
        float c[16], ci[16];
        { float run = 1.f;
#pragma unroll
          for (int t = 0; t < 16; ++t) { run *= bf1(SW[trow(t) * SP_ + lane]); c[t] = run; ci[t] = __builtin_amdgcn_rcpf(run); CB[t * 64 + lane] = run; } }
        const int rec_dir = dir, bidx = isl ? (row0 >> 12) : ((row0 - NLAT) >> 8);
        const int tcl = isl ? 4 * ((row0 >> 6) & 63) + c4 : 4 * (((row0 - NLAT) >> 6) & 3) + c4;
        const int nproc = isl ? 16 + (dir ? 255 - tcl : tcl) : (dir ? 15 - tcl : tcl);
        unsigned char* rec = ws + WS_PRE + ((size_t)((rec_dir * 8 + bidx) * 12 + head) * NCHUNK16 + nproc) * PRE_REC;
        { const float cl = c[15]; float bk[32];
#pragma unroll
          for (int t = 0; t < 16; ++t) { const float e = cl * ci[t]; const int pos = 8 * (t >> 2) + (t & 3); bk[pos] = bf1(SB[trow(t) * SP_ + lane]) * e; bk[pos + 4] = bf1(SK[trow(t) * SP_ + lane]) * e; }
#pragma unroll
          for (int q4 = 0; q4 < 4; ++q4) { u32x4 o; o.x = pk2(bk[8 * q4], bk[8 * q4 + 1]); o.y = pk2(bk[8 * q4 + 2], bk[8 * q4 + 3]); o.z = pk2(bk[8 * q4 + 4], bk[8 * q4 + 5]); o.w = pk2(bk[8 * q4 + 6], bk[8 * q4 + 7]);
              *(u32x4*)(rec + PR_BK + lane * 64 + q4 * 16) = o; }
          *(float*)(rec + PR_GAM + lane * 4) = cl; }
        asm volatile("s_waitcnt lgkmcnt(0)" ::: "memory");
        bf16x8 fa[2], frr[2], fb[2], fk[2];
        { const int tr = trow(fr);
#pragma unroll
          for (int sx = 0; sx < 2; ++sx) { const int ch = 32 * sx + 8 * fq; float kk8[8], r8[8], b8[8], k8[8];
              unpack8(*(const LAS u32x4*)(SKK + tr * SP_ + ch), kk8); unpack8(*(const LAS u32x4*)(SR + tr * SP_ + ch), r8); unpack8(*(const LAS u32x4*)(SB + tr * SP_ + ch), b8); unpack8(*(const LAS u32x4*)(SK + tr * SP_ + ch), k8);
              const f32x4 c0 = *(const LAS f32x4*)(CB + fr * 64 + ch), c1 = *(const LAS f32x4*)(CB + fr * 64 + ch + 4);
              f32x4 p0 = (f32x4){1.f, 1.f, 1.f, 1.f}, p1 = p0; if (fr > 0) { p0 = *(const LAS f32x4*)(CB + (fr - 1) * 64 + ch); p1 = *(const LAS f32x4*)(CB + (fr - 1) * 64 + ch + 4); }
              float xa[8], xr[8], xb[8], xk[8];
#pragma unroll
              for (int j = 0; j < 8; ++j) { const float ec = j < 4 ? c0[j] : c1[j - 4], ep = j < 4 ? p0[j] : p1[j - 4]; const float en = __builtin_amdgcn_rcpf(ec);
                  xa[j] = -kk8[j] * ep; xr[j] = r8[j] * ec; xb[j] = b8[j] * en; xk[j] = k8[j] * en; }
              const u32x4 ua = pack8(xa), ur = pack8(xr), ub = pack8(xb), uk = pack8(xk);
              fa[sx] = __builtin_bit_cast(bf16x8, ua); frr[sx] = __builtin_bit_cast(bf16x8, ur); fb[sx] = __builtin_bit_cast(bf16x8, ub); fk[sx] = __builtin_bit_cast(bf16x8, uk); } }
        f32x4 gab = (f32x4){0.f, 0.f, 0.f, 0.f}, gak = gab, grb = gab, grk = gab;
#pragma unroll
        for (int sx = 0; sx < 2; ++sx) { gab = __builtin_amdgcn_mfma_f32_16x16x32_bf16(fa[sx], fb[sx], gab, 0, 0, 0); gak = __builtin_amdgcn_mfma_f32_16x16x32_bf16(fa[sx], fk[sx], gak, 0, 0, 0);
            grb = __builtin_amdgcn_mfma_f32_16x16x32_bf16(frr[sx], fb[sx], grb, 0, 0, 0); grk = __builtin_amdgcn_mfma_f32_16x16x32_bf16(frr[sx], fk[sx], grk, 0, 0, 0); }
#pragma unroll
        for (int j = 0; j < 4; ++j) { const int tau = 4 * fq + j; const bool lo = fr < tau, le = fr <= tau;
            AA[tau * 16 + fr] = lo ? gab[j] : 0.f; AA[256 + tau * 16 + fr] = lo ? gak[j] : 0.f; grb[j] = le ? grb[j] : 0.f; grk[j] = le ? grk[j] : 0.f; }
        asm volatile("s_waitcnt lgkmcnt(0)" ::: "memory");
        float wv[16], mv[16];
#pragma unroll
        for (int t = 0; t < 16; ++t) { const float ab = -bf1(SKK[trow(t) * SP_ + lane]) * (t > 0 ? c[t - 1] : 1.0f); float accw = ab, accm = AA[256 + t * 16 + fr];
#pragma unroll
            for (int q4 = 0; q4 < 4; ++q4) { if (4 * q4 < t) { const f32x4 cf = *(const LAS f32x4*)(AA + t * 16 + 4 * q4);
#pragma unroll
                for (int j = 0; j < 4; ++j) if (4 * q4 + j < t) { accw += cf[j] * wv[4 * q4 + j]; accm += cf[j] * mv[4 * q4 + j]; } } }
            wv[t] = accw; mv[t] = accm; }
        { LAS bf16* stg = (LAS bf16*)CB; const int pp = kperm_pos(lane);
#pragma unroll
          for (int t = 0; t < 16; ++t) { stg[t * 64 + pp] = (bf16)f2bf(wv[t]); stg[1024 + t * 64 + pp] = (bf16)f2bf(bf1(SR[trow(t) * SP_ + lane]) * c[t]); }
          asm volatile("s_waitcnt lgkmcnt(0)" ::: "memory");
#pragma unroll
          for (int q4 = 0; q4 < 4; ++q4) *(u32x4*)(rec + PR_WP + (q4 * 64 + lane) * 16) = *(const LAS u32x4*)((LAS unsigned char*)stg + (q4 * 64 + lane) * 16); }
        { LAS bf16* stg = (LAS bf16*)AA; const int ps = 8 * (fr >> 2) + (fr & 3);
          asm volatile("s_waitcnt lgkmcnt(0)" ::: "memory");
#pragma unroll
          for (int j = 0; j < 4; ++j) { const int tau = 4 * fq + j; stg[tau * 32 + ps] = (bf16)f2bf(grb[j]); stg[tau * 32 + ps + 4] = (bf16)f2bf(grk[j]); }
          if (lane < 16) {
#pragma unroll
              for (int t = 0; t < 16; ++t) stg[512 + t * 16 + lane] = (bf16)f2bf(mv[t]); }
          asm volatile("s_waitcnt lgkmcnt(0)" ::: "memory");
          *(u32x4*)(rec + PR_ARBK + lane * 16) = *(const LAS u32x4*)((LAS unsigned char*)stg + lane * 16);
          if (lane < 32) *(u32x4*)(rec + PR_ARBK + 1024 + lane * 16) = *(const LAS u32x4*)((LAS unsigned char*)stg + 1024 + lane * 16); }
        if (dir == 0) { float v16[16];
#pragma unroll
            for (int t = 0; t < 16; ++t) v16[t] = bf1(SV[(16 * c4 + t) * SP_ + lane]);
            const int tcg = isl ? 16 + tcl : tcl;
            unsigned char* vrec = ws + WS_VT + ((size_t)(bidx * 12 + head) * NCHUNK16 + tcg) * 2048 + lane * 32;
            u32x4 o; o.x = pk2(v16[0], v16[1]); o.y = pk2(v16[2], v16[3]); o.z = pk2(v16[4], v16[5]); o.w = pk2(v16[6], v16[7]); *(u32x4*)vrec = o;
            o.x = pk2(v16[8], v16[9]); o.y = pk2(v16[10], v16[11]); o.z = pk2(v16[12], v16[13]); o.w = pk2(v16[14], v16[15]); *(u32x4*)(vrec + 16) = o; }
    }
    __syncthreads();
    }
}

__device__ __forceinline__ float dpp_xor1(float x) { return __builtin_bit_cast(float, __builtin_amdgcn_update_dpp(0, __builtin_bit_cast(int, x), 0xB1, 0xF, 0xF, false)); }
__device__ __forceinline__ float dpp_xor2(float x) { return __builtin_bit_cast(float, __builtin_amdgcn_update_dpp(0, __builtin_bit_cast(int, x), 0x4E, 0xF, 0xF, false)); }
__device__ __forceinline__ int chain_row(int dir, int b, int s) {
    if (s < CTXL) return NLAT + b * CTXL + (dir ? (CTXL - 1 - s) : s);
    const int t = s - CTXL; return b * T + (dir ? (T - 1 - t) : t);
}
__device__ __forceinline__ float dpp_hmirror(float x) { return __builtin_bit_cast(float, __builtin_amdgcn_update_dpp(0, __builtin_bit_cast(int, x), 0x141, 0xF, 0xF, false)); }
struct RwRec { u32x4 wp[2], rp[2], bk[4], arbk; u32x2 mak, vt[2]; f32x4 gam[4]; };
__device__ __forceinline__ void rw_load(RwRec& r, const LAS unsigned char* rec, int fr, int kg, int hv, int dir) {
#pragma unroll
    for (int sx = 0; sx < 2; ++sx) { r.wp[sx] = *(const LAS u32x4*)(rec + PR_WP + fr * 128 + sx * 64 + kg * 16); r.rp[sx] = *(const LAS u32x4*)(rec + PR_RP + fr * 128 + sx * 64 + kg * 16); }
#pragma unroll
    for (int i = 0; i < 4; ++i) { r.bk[i] = *(const LAS u32x4*)(rec + PR_BK + (16 * i + fr) * 64 + kg * 16); r.gam[i] = *(const LAS f32x4*)(rec + PR_GAM + (16 * i + 4 * kg) * 4); }
    r.arbk = *(const LAS u32x4*)(rec + PR_ARBK + fr * 64 + kg * 16);
    r.mak = *(const LAS u32x2*)(rec + PR_MAK + fr * 32 + kg * 8);
#pragma unroll
    for (int q = 0; q < 2; ++q) r.vt[q] = *(const LAS u32x2*)(rec + PRE_REC + (16 * (2 * hv + q) + fr) * 32 + (dir ? (12 - 4 * kg) : 4 * kg) * 2);
}
constexpr int RW_R = 6, RW_SLOT = PRE_REC + 2048;
__device__ __forceinline__ void rwkv_chain_mfma(KArgs a, int task_base, LAS unsigned char* lds) {
    const int t_ = tid_fresh(); const int lane = t_ & 63, fr = lane & 15, kg = lane >> 4; const int wave = __builtin_amdgcn_readfirstlane(t_ >> 6);
    unsigned char* ws = a->ws;
    bf16* OC = (bf16*)(ws + WS_OC);
    const int cid = (task_base >> 2) + (wave >> 2), wq = wave & 3, dir = cid / 96, b = (cid % 96) / 12, h = cid % 12;
    const bool comp = wq < 2; const int hv = wq & 1;
    const unsigned char* rec0 = ws + WS_PRE + (size_t)((dir * 8 + b) * 12 + h) * NCHUNK16 * PRE_REC;
    const unsigned char* vrec0 = ws + WS_VT + (size_t)(b * 12 + h) * NCHUNK16 * 2048;
    LAS unsigned char* ring = lds + (wave >> 2) * (RW_R * RW_SLOT);
    auto tchunk = [&](int n) { return n < 16 ? (dir ? 15 - n : n) : 16 + (dir ? 255 - (n - 16) : (n - 16)); };
    auto issue = [&](int n) { const int nn = n < NCHUNK16 ? n : NCHUNK16 - 1; LAS unsigned char* slot = ring + (n % RW_R) * RW_SLOT;
#pragma unroll
        for (int jj = 0; jj < 3; ++jj) { const int j = 3 * wq + jj;
            const unsigned char* src = (j < 10 ? rec0 + (size_t)nn * PRE_REC + 1024 * j : vrec0 + (size_t)tchunk(nn) * 2048 + 1024 * (j - 10)) + lane * 16;
            __builtin_amdgcn_global_load_lds((const unsigned*)src, (LAS unsigned*)(slot + 1024 * j), 16, 0, 0); } };
    f32x4 ST[2][4];
#pragma unroll
    for (int q = 0; q < 2; ++q)
#pragma unroll
        for (int i = 0; i < 4; ++i) ST[q][i] = (f32x4){0.f, 0.f, 0.f, 0.f};
    unsigned uvU[2][2] = {{0u, 0u}, {0u, 0u}};
#pragma unroll
    for (int n = 0; n < RW_R - 1; ++n) issue(n);
    for (int n = 0; n < NCHUNK16; ++n) {
        if (comp && n >= RW_R - 1) asm volatile("s_waitcnt vmcnt(22)" ::: "memory"); else asm volatile("s_waitcnt vmcnt(12)" ::: "memory");
        __builtin_amdgcn_s_barrier(); asm volatile("" ::: "memory");
        issue(n + RW_R - 1);
        if (comp) {
            RwRec cur; rw_load(cur, ring + (n % RW_R) * RW_SLOT, fr, kg, hv, dir);
            u32x4 fmak; fmak.x = 0u; fmak.y = 0u; fmak.z = cur.mak.x; fmak.w = cur.mak.y;
            const int row = chain_row(dir, b, 16 * n + fr);
#pragma unroll
            for (int q = 0; q < 2; ++q) {
                u32x4 fs[2];
#pragma unroll
                for (int sx = 0; sx < 2; ++sx) { fs[sx].x = pk2(ST[q][2 * sx][0], ST[q][2 * sx][1]); fs[sx].y = pk2(ST[q][2 * sx][2], ST[q][2 * sx][3]); fs[sx].z = pk2(ST[q][2 * sx + 1][0], ST[q][2 * sx + 1][1]); fs[sx].w = pk2(ST[q][2 * sx + 1][2], ST[q][2 * sx + 1][3]); }
                u32x2 vt = cur.vt[q]; if (dir) { const unsigned x = vt.x, y = vt.y; vt.x = (y >> 16) | (y << 16); vt.y = (x >> 16) | (x << 16); }
                u32x4 fuv; fuv.x = uvU[q][0]; fuv.y = uvU[q][1]; fuv.z = vt.x; fuv.w = vt.y;
                f32x4 U = (f32x4){0.f, 0.f, 0.f, 0.f};
                U = __builtin_amdgcn_mfma_f32_16x16x32_bf16(__builtin_bit_cast(bf16x8, cur.wp[0]), __builtin_bit_cast(bf16x8, fs[0]), U, 0, 0, 0);
                U = __builtin_amdgcn_mfma_f32_16x16x32_bf16(__builtin_bit_cast(bf16x8, cur.wp[1]), __builtin_bit_cast(bf16x8, fs[1]), U, 0, 0, 0);
                U = __builtin_amdgcn_mfma_f32_16x16x32_bf16(__builtin_bit_cast(bf16x8, fmak), __builtin_bit_cast(bf16x8, fuv), U, 0, 0, 0);
                uvU[q][0] = pk2(U[0], U[1]); uvU[q][1] = pk2(U[2], U[3]); fuv.x = uvU[q][0]; fuv.y = uvU[q][1];
                f32x4 OT = (f32x4){0.f, 0.f, 0.f, 0.f};
                OT = __builtin_amdgcn_mfma_f32_16x16x32_bf16(__builtin_bit_cast(bf16x8, fs[0]), __builtin_bit_cast(bf16x8, cur.rp[0]), OT, 0, 0, 0);
                OT = __builtin_amdgcn_mfma_f32_16x16x32_bf16(__builtin_bit_cast(bf16x8, fs[1]), __builtin_bit_cast(bf16x8, cur.rp[1]), OT, 0, 0, 0);
                OT = __builtin_amdgcn_mfma_f32_16x16x32_bf16(__builtin_bit_cast(bf16x8, fuv), __builtin_bit_cast(bf16x8, cur.arbk), OT, 0, 0, 0);
#pragma unroll
                for (int i = 0; i < 4; ++i) ST[q][i] = __builtin_amdgcn_mfma_f32_16x16x32_bf16(__builtin_bit_cast(bf16x8, cur.bk[i]), __builtin_bit_cast(bf16x8, fuv), ST[q][i] * cur.gam[i], 0, 0, 0);
                u32x2 o; o.x = pk2(OT[0], OT[1]); o.y = pk2(OT[2], OT[3]); *(u32x2*)(OC + ((size_t)dir * MALL + row) * CW + h * 64 + 16 * (2 * hv + q) + 4 * kg) = o;
            }
        }
    }
    asm volatile("s_waitcnt vmcnt(0)" ::: "memory");
    __builtin_amdgcn_s_barrier(); asm volatile("" ::: "memory");
}
#define LDS_BAR() do { asm volatile("s_waitcnt lgkmcnt(0)" ::: "memory"); __builtin_amdgcn_s_barrier(); asm volatile("" ::: "memory"); } while (0)
__device__ __forceinline__ void hgrn_prep_item(KArgs a, int l, int item, LAS unsigned char* lds, bool dry) {
    const int tid = tid_fresh();
    unsigned char* ws = a->ws;
    bf16* P = (bf16*)(ws + WS_P); bf16* HQB = (bf16*)(ws + WS_HQB); float* HG = (float*)(ws + WS_HG);
    const int cn = item % 68, bh = item / 68, h = bh % 6, b = bh / 6;
    const int row0 = cn < 4 ? NLAT + b * CTXL + 64 * cn : b * T + 64 * (cn - 4);
    constexpr int QP = 136;
    LAS bf16* SQ = (LAS bf16*)lds; LAS bf16* KF = SQ + 64 * QP; LAS bf16* KB = KF + 64 * QP; LAS bf16* QB = KB + 64 * QP;
    LAS float* LF = (LAS float*)(QB + 64 * QP); LAS float* LBk = LF + 64 * 128;
    LAS float* tot = LBk + 64 * 128;
    LAS float* lbs = tot + 1024;
    if (tid < 256) { const int dr = tid >> 7, ch = h * 128 + (tid & 127); float lb = 0.f;
        if (l != 0) { const float l0 = a->in[I_LB][((size_t)dr * DEPTH + 0) * BW + ch], l1 = a->in[I_LB][((size_t)dr * DEPTH + 1) * BW + ch]; lb = __builtin_amdgcn_rcpf(1.0f + __expf(l0 - l1)); }
        lbs[tid] = lb; }
    const int ta = tid >> 3, d0 = (tid & 7) * 16;
    bf16* prow = P + (size_t)(row0 + ta) * INC + h * 128 + d0;
    u32x4 rq[2], rf[2], rb[2];
    rq[0] = *(const u32x4*)(prow + OFF_Q); rq[1] = *(const u32x4*)(prow + OFF_Q + 8); rf[0] = *(const u32x4*)(prow + OFF_ZF); rf[1] = *(const u32x4*)(prow + OFF_ZF + 8); rb[0] = *(const u32x4*)(prow + OFF_ZB); rb[1] = *(const u32x4*)(prow + OFF_ZB + 8);
    __syncthreads();
#pragma unroll
    for (int hf = 0; hf < 2; ++hf) { float qf[8], zf[8], zb[8], oq[8], of[8], ob[8]; unpack8(rq[hf], qf); unpack8(rf[hf], zf); unpack8(rb[hf], zb);
        const int dd = d0 + 8 * hf; f32x4 lf0, lf1, lb0, lb1;
#pragma unroll
        for (int j = 0; j < 8; ++j) { const float lF = lbs[dd + j], lB = lbs[128 + dd + j];
            const float ff = lF + (1.0f - lF) * sigmoidf_(zf[j]), fb = lB + (1.0f - lB) * sigmoidf_(zb[j]);
            const float a1 = fmaxf(__logf(ff), -60.0f), a2 = fmaxf(__logf(fb), -60.0f);
            if (j < 4) { lf0[j] = a1; lb0[j] = a2; } else { lf1[j - 4] = a1; lb1[j - 4] = a2; }
            oq[j] = siluf_(qf[j]); of[j] = 1.0f - ff; ob[j] = 1.0f - fb; }
        *(LAS u32x4*)(SQ + ta * QP + dd) = pack8(oq); *(LAS u32x4*)(KF + ta * QP + dd) = pack8(of); *(LAS u32x4*)(KB + ta * QP + dd) = pack8(ob);
        *(LAS f32x4*)(LF + ta * 128 + dd) = lf0; *(LAS f32x4*)(LF + ta * 128 + dd + 4) = lf1; *(LAS f32x4*)(LBk + ta * 128 + dd) = lb0; *(LAS f32x4*)(LBk + ta * 128 + dd + 4) = lb1; }
    __syncthreads();
    { const int d = tid & 127, qt = tid >> 7; float r1 = 0.f, r2 = 0.f;
#pragma unroll
      for (int i = 0; i < 16; ++i) { const int tp = 16 * qt + i; r1 += LF[tp * 128 + d]; LF[tp * 128 + d] = r1; r2 += LBk[(63 - tp) * 128 + d]; LBk[(63 - tp) * 128 + d] = r2; }
      tot[qt * 128 + d] = r1; tot[512 + qt * 128 + d] = r2; }
    __syncthreads();
    LAS float* bas = lbs + 256;
    LAS float* bmd = bas + 1024;
    { const int d = tid & 127, dr = (tid >> 7) & 1; if (tid < 256) { const LAS float* tt = tot + 512 * dr; const float t0 = tt[d], t1 = tt[128 + d], t2 = tt[256 + d], t3 = tt[384 + d];
        bas[(dr * 4 + 0) * 128 + d] = 0.f; bas[(dr * 4 + 1) * 128 + d] = t0; bas[(dr * 4 + 2) * 128 + d] = t0 + t1; bas[(dr * 4 + 3) * 128 + d] = t0 + t1 + t2; bmd[dr * 128 + d] = t0 + t1;
        const int npr = dr == 0 ? cn : (cn < 4 ? 3 - cn : 4 + 63 - (cn - 4)); float* g = (dry ? (float*)(ws + WS_END + 8 * MiB) : HG) + ((size_t)(((dr * 8 + b) * 6 + h) * 68 + npr)) * 256; g[d] = __expf(t0 + t1); g[128 + d] = __expf(t2 + t3); } }
    __syncthreads();
#pragma unroll
    for (int hf = 0; hf < 2; ++hf) { const int dd = d0 + 8 * hf; float sq[8], kf[8], kb[8];
        unpack8(*(const LAS u32x4*)(SQ + ta * QP + dd), sq); unpack8(*(const LAS u32x4*)(KF + ta * QP + dd), kf); unpack8(*(const LAS u32x4*)(KB + ta * QP + dd), kb);
        float oqf[8], okf[8], oqb[8], okb[8];
#pragma unroll
        for (int dr = 0; dr < 2; ++dr) { const int tp = dr ? 63 - ta : ta, q = tp >> 4; const LAS float* pf = (dr ? LBk : LF) + ta * 128 + dd;
            const f32x4 p0 = *(const LAS f32x4*)pf, p1 = *(const LAS f32x4*)(pf + 4), b0 = *(const LAS f32x4*)(bas + (dr * 4 + q) * 128 + dd), b1 = *(const LAS f32x4*)(bas + (dr * 4 + q) * 128 + dd + 4),
                        m0 = *(const LAS f32x4*)(bmd + dr * 128 + dd), m1 = *(const LAS f32x4*)(bmd + dr * 128 + dd + 4);
#pragma unroll
            for (int j = 0; j < 8; ++j) { const float bt = (j < 4 ? p0[j] + b0[j] : p1[j - 4] + b1[j - 4]), bm = j < 4 ? m0[j] : m1[j - 4];
                const float eq = __expf(fminf(bt - bm, 80.0f)), ek = __expf(fminf(bm - bt, 80.0f));
                if (dr == 0) { oqf[j] = sq[j] * eq; okf[j] = kf[j] * ek; } else { oqb[j] = sq[j] * eq; okb[j] = kb[j] * ek; } } }
        *(LAS u32x4*)(QB + ta * QP + dd) = pack8(oqf); *(LAS u32x4*)(KF + ta * QP + dd) = pack8(okf); *(LAS u32x4*)(KB + ta * QP + dd) = pack8(okb); *(LAS u32x4*)(SQ + ta * QP + dd) = pack8(oqb); }
    bf16* prow_o = dry ? (bf16*)(ws + WS_END) + (size_t)((row0 + ta) & 511) * INC + h * 128 + d0 : prow; bf16* hqb_o = dry ? (bf16*)(ws + WS_END) : HQB;
#pragma unroll
    for (int hf = 0; hf < 2; ++hf) { const int dd = d0 + 8 * hf;
        *(u32x4*)(prow_o + OFF_Q + 8 * hf) = *(const LAS u32x4*)(QB + ta * QP + dd); *(u32x4*)(prow_o + OFF_ZF + 8 * hf) = *(const LAS u32x4*)(KF + ta * QP + dd); *(u32x4*)(prow_o + OFF_ZB + 8 * hf) = *(const LAS u32x4*)(KB + ta * QP + dd);
        *(u32x4*)(hqb_o + (size_t)(dry ? ((row0 + ta) & 1023) : (row0 + ta)) * BW + h * 128 + dd) = *(const LAS u32x4*)(SQ + ta * QP + dd); }
    __syncthreads();
}
__device__ __forceinline__ unsigned tr_addr(const LAS bf16* X, int pitch, int r0, int c0, int lane) { const int i = lane & 15, g = lane >> 4; return (unsigned)(size_t)(X + (r0 + 8 * g + (i >> 2)) * pitch + c0 + 4 * (i & 3)); }
__device__ __forceinline__ void tr8x4(u32x2 (&lo)[4], u32x2 (&hi)[4], unsigned a0, unsigned a1, unsigned a2, unsigned a3, unsigned rowstep4) {
    const unsigned b0 = a0 + rowstep4, b1 = a1 + rowstep4, b2 = a2 + rowstep4, b3 = a3 + rowstep4;
    asm volatile("ds_read_b64_tr_b16 %0, %8\n\tds_read_b64_tr_b16 %1, %9\n\tds_read_b64_tr_b16 %2, %10\n\tds_read_b64_tr_b16 %3, %11\n\t"
                 "ds_read_b64_tr_b16 %4, %12\n\tds_read_b64_tr_b16 %5, %13\n\tds_read_b64_tr_b16 %6, %14\n\tds_read_b64_tr_b16 %7, %15\n\ts_waitcnt lgkmcnt(0)"
                 : "=&v"(lo[0]), "=&v"(lo[1]), "=&v"(lo[2]), "=&v"(lo[3]), "=&v"(hi[0]), "=&v"(hi[1]), "=&v"(hi[2]), "=&v"(hi[3])
                 : "v"(a0), "v"(a1), "v"(a2), "v"(a3), "v"(b0), "v"(b1), "v"(b2), "v"(b3) : "memory");
}
__device__ __forceinline__ void tr_half(u32x2 (&vl)[8], u32x2 (&vh)[8], u32x2 (&xl)[2], u32x2 (&xh)[2], unsigned av, unsigned ak, unsigned ax) {
    asm volatile(
        "ds_read_b64_tr_b16 %0, %20\n\tds_read_b64_tr_b16 %1, %20 offset:32\n\tds_read_b64_tr_b16 %2, %20 offset:64\n\tds_read_b64_tr_b16 %3, %20 offset:96\n\t"
        "ds_read_b64_tr_b16 %4, %20 offset:128\n\tds_read_b64_tr_b16 %5, %20 offset:160\n\tds_read_b64_tr_b16 %6, %20 offset:192\n\tds_read_b64_tr_b16 %7, %20 offset:224\n\t"
        "ds_read_b64_tr_b16 %8, %20 offset:1088\n\tds_read_b64_tr_b16 %9, %20 offset:1120\n\tds_read_b64_tr_b16 %10, %20 offset:1152\n\tds_read_b64_tr_b16 %11, %20 offset:1184\n\t"
        "ds_read_b64_tr_b16 %12, %20 offset:1216\n\tds_read_b64_tr_b16 %13, %20 offset:1248\n\tds_read_b64_tr_b16 %14, %20 offset:1280\n\tds_read_b64_tr_b16 %15, %20 offset:1312\n\t"
        "ds_read_b64_tr_b16 %16, %21\n\tds_read_b64_tr_b16 %17, %22\n\tds_read_b64_tr_b16 %18, %21 offset:1088\n\tds_read_b64_tr_b16 %19, %22 offset:1088\n\ts_waitcnt lgkmcnt(0)"
        : "=&v"(vl[0]), "=&v"(vl[1]), "=&v"(vl[2]), "=&v"(vl[3]), "=&v"(vl[4]), "=&v"(vl[5]), "=&v"(vl[6]), "=&v"(vl[7]),
          "=&v"(vh[0]), "=&v"(vh[1]), "=&v"(vh[2]), "=&v"(vh[3]), "=&v"(vh[4]), "=&v"(vh[5]), "=&v"(vh[6]), "=&v"(vh[7]),
          "=&v"(xl[0]), "=&v"(xl[1]), "=&v"(xh[0]), "=&v"(xh[1])
        : "v"(av), "v"(ak), "v"(ax) : "memory");
}
__device__ __forceinline__ bf16x8 mk8(u32x2 lo, u32x2 hi) { u32x4 v; v.x = lo.x; v.y = lo.y; v.z = hi.x; v.w = hi.y; return __builtin_bit_cast(bf16x8, v); }
__device__ __forceinline__ void hgrn_chain_lean(KArgs a, int cid, LAS unsigned char* lds) {
    const int tid = tid_fresh(), lane = tid & 63, wave = tid >> 6, fr = lane & 15, fq = lane >> 4;
    unsigned char* ws = a->ws;
    const bf16* P = (const bf16*)(ws + WS_P); const bf16* HQB = (const bf16*)(ws + WS_HQB); const float* HG = (const float*)(ws + WS_HG); bf16* OB = (bf16*)(ws + WS_OB);
    const int dir = cid / 48, b = (cid % 48) / 6, h = cid % 6;
    constexpr int QP = 136, SP = 72;
    LAS bf16* qs = (LAS bf16*)lds;
    LAS bf16* ks = qs + 64 * QP;
    LAS bf16* vs = ks + 64 * QP;
    LAS bf16* pl = vs + 64 * QP;
    LAS bf16* sT = pl + 64 * SP;
    LAS float* gm = (LAS float*)(sT + 128 * QP);
    const int ta = tid >> 3, d0 = (tid & 7) * 16;
    const int koff = dir ? OFF_ZB : OFF_ZF;
    f32x4 S[8];
#pragma unroll
    for (int vt = 0; vt < 8; ++vt) S[vt] = (f32x4){0.f, 0.f, 0.f, 0.f};
    u32x4 rq[2], rk[2], rv[2]; float rg = 0.f;
    auto load_chunk = [&](int n) { const int row = chain_row(dir, b, 64 * n + ta); const bf16* pr = P + (size_t)row * INC + h * 128 + d0;
        const bf16* qr = dir ? HQB + (size_t)row * BW + h * 128 + d0 : pr + OFF_Q;
        rq[0] = *(const u32x4*)qr; rq[1] = *(const u32x4*)(qr + 8); rk[0] = *(const u32x4*)(pr + koff); rk[1] = *(const u32x4*)(pr + koff + 8); rv[0] = *(const u32x4*)(pr + OFF_I); rv[1] = *(const u32x4*)(pr + OFF_I + 8);
        if (tid < 256) rg = HG[((size_t)(((dir * 8 + b) * 6 + h) * 68 + n)) * 256 + tid]; };
    load_chunk(0);
    constexpr int NCH = (CTXL + T) / 64;
    for (int n = 0; n < NCH; ++n) {
        const int s0 = n * 64;
        *(LAS u32x4*)(qs + ta * QP + d0) = rq[0]; *(LAS u32x4*)(qs + ta * QP + d0 + 8) = rq[1]; *(LAS u32x4*)(ks + ta * QP + d0) = rk[0]; *(LAS u32x4*)(ks + ta * QP + d0 + 8) = rk[1];
        *(LAS u32x4*)(vs + ta * QP + d0) = rv[0]; *(LAS u32x4*)(vs + ta * QP + d0 + 8) = rv[1]; if (tid < 256) gm[tid] = rg;
        if (n + 1 < NCH) load_chunk(n + 1);
        LDS_BAR();
        { const f32x4 g4 = *(const LAS f32x4*)(gm + 16 * wave + 4 * fq);
#pragma unroll
          for (int vt = 0; vt < 8; ++vt) { S[vt] = S[vt] * g4; u32x2 o; o.x = pk2(S[vt][0], S[vt][1]); o.y = pk2(S[vt][2], S[vt][3]); *(LAS u32x2*)(sT + (16 * vt + fr) * QP + 16 * wave + 4 * fq) = o; } }
        { const int tt = wave >> 1;
#pragma unroll
          for (int u = 0; u < 2; ++u) { const int sg = 2 * (wave & 1) + u; f32x4 acc = (f32x4){0.f, 0.f, 0.f, 0.f};
              if (sg <= tt) {
#pragma unroll
                  for (int kq = 0; kq < 4; ++kq) { const bf16x8 af = *(const LAS bf16x8*)(ks + (16 * sg + fr) * QP + 32 * kq + 8 * fq), bfm = *(const LAS bf16x8*)(qs + (16 * tt + fr) * QP + 32 * kq + 8 * fq);
                      acc = __builtin_amdgcn_mfma_f32_16x16x32_bf16(af, bfm, acc, 0, 0, 0); }
                  if (sg == tt) {
#pragma unroll
                      for (int j = 0; j < 4; ++j) if (4 * fq + j > fr) acc[j] = 0.f; }
              }
              u32x2 o; o.x = pk2(acc[0], acc[1]); o.y = pk2(acc[2], acc[3]); *(LAS u32x2*)(pl + (16 * tt + fr) * SP + 16 * sg + 4 * fq) = o; } }
        LDS_BAR();
        f32x4 oacc[4];
#pragma unroll
        for (int tt = 0; tt < 4; ++tt) { f32x4 acc = (f32x4){0.f, 0.f, 0.f, 0.f};
#pragma unroll
            for (int kq = 0; kq < 4; ++kq) { const bf16x8 af = *(const LAS bf16x8*)(sT + (16 * wave + fr) * QP + 32 * kq + 8 * fq), bfm = *(const LAS bf16x8*)(qs + (16 * tt + fr) * QP + 32 * kq + 8 * fq);
                acc = __builtin_amdgcn_mfma_f32_16x16x32_bf16(af, bfm, acc, 0, 0, 0); }
            oacc[tt] = acc; }
        const unsigned rs4 = (unsigned)(4 * QP * 2);
#pragma unroll
        for (int kq = 0; kq < 2; ++kq) {
            u32x2 vl_[8], vh_[8], xl_[2], xh_[2];
            static_assert(QP == 136, "tr_half's immediates assume 272-byte rows");
            tr_half(vl_, vh_, xl_, xh_, tr_addr(vs, QP, 32 * kq, 0, lane), tr_addr(ks, QP, 32 * kq, 16 * wave, lane), tr_addr(vs, QP, 32 * kq, 16 * wave, lane));
            __builtin_amdgcn_sched_barrier(0);
            { const bf16x8 af = mk8(xl_[1], xh_[1]);
#pragma unroll
              for (int tt = 0; tt < 4; ++tt) { const bf16x8 bfm = *(const LAS bf16x8*)(pl + (16 * tt + fr) * SP + 32 * kq + 8 * fq); oacc[tt] = __builtin_amdgcn_mfma_f32_16x16x32_bf16(af, bfm, oacc[tt], 0, 0, 0); } }
            { const bf16x8 af = mk8(xl_[0], xh_[0]);
#pragma unroll
              for (int vt = 0; vt < 8; ++vt) S[vt] = __builtin_amdgcn_mfma_f32_16x16x32_bf16(af, mk8(vl_[vt], vh_[vt]), S[vt], 0, 0, 0); }
        }
#pragma unroll
        for (int tt = 0; tt < 4; ++tt) { const int row = chain_row(dir, b, s0 + 16 * tt + fr);
            u32x2 o; o.x = pk2(oacc[tt][0], oacc[tt][1]); o.y = pk2(oacc[tt][2], oacc[tt][3]); *(u32x2*)(OB + ((size_t)dir * MALL + row) * BW + h * 128 + 16 * wave + 4 * fq) = o; }
        { const f32x4 ge = *(const LAS f32x4*)(gm + 128 + 16 * wave + 4 * fq);
#pragma unroll
          for (int vt = 0; vt < 8; ++vt) S[vt] = S[vt] * ge; }
        LDS_BAR();
    }
}
__device__ __forceinline__ void hgrn_chain_mfma(KArgs a, int l, int cid, LAS unsigned char* lds) {
    const int tid = tid_fresh(), lane = tid & 63, wave = tid >> 6, fr = lane & 15, fq = lane >> 4;
    unsigned char* ws = a->ws;
    const bf16* P = (const bf16*)(ws + WS_P); bf16* OB = (bf16*)(ws + WS_OB);
    const int dir = cid / 48, b = (cid % 48) / 6, h = cid % 6;
    constexpr int QP = 136, SP = 72;
    LAS bf16* qs = (LAS bf16*)lds;
    LAS bf16* ks = qs + 64 * QP;
    LAS bf16* kT = ks + 64 * QP;
    LAS bf16* vT = kT + 128 * SP;
    LAS bf16* pl = vT + 128 * SP;
    LAS bf16* sT = pl + 64 * SP;
    LAS float* tot = (LAS float*)(sT + 128 * QP);
    LAS float* gmid = tot + 512;
    LAS float* gend = gmid + 128;
    LAS float* lbs = gend + 128;
    LAS float* lfb = (LAS float*)sT;
    const int d = tid & 127, qt = tid >> 7;
    const int tau_a = tid >> 3, d0 = (tid & 7) * 16;
    if (tid < 128) { const int ch = h * 128 + tid; float lb = 0.f;
        if (l != 0) { const float l0 = a->in[I_LB][((size_t)dir * DEPTH + 0) * BW + ch], l1 = a->in[I_LB][((size_t)dir * DEPTH + 1) * BW + ch]; lb = 1.0f / (1.0f + __expf(l0 - l1)); }
        lbs[tid] = lb; }
    f32x4 S[8];
#pragma unroll
    for (int vt = 0; vt < 8; ++vt) S[vt] = (f32x4){0.f, 0.f, 0.f, 0.f};
    const int zoff = dir ? OFF_ZB : OFF_ZF;
    u32x4 rq[2], ri[2], rz[2];
    { const bf16* pr = P + (size_t)chain_row(dir, b, tau_a) * INC + h * 128 + d0;
      rq[0] = *(const u32x4*)(pr + OFF_Q); rq[1] = *(const u32x4*)(pr + OFF_Q + 8); ri[0] = *(const u32x4*)(pr + OFF_I); ri[1] = *(const u32x4*)(pr + OFF_I + 8); rz[0] = *(const u32x4*)(pr + zoff); rz[1] = *(const u32x4*)(pr + zoff + 8); }
    __syncthreads();
    constexpr int NCH = (CTXL + T) / 64;
    for (int n = 0; n < NCH; ++n) {
        const int s0 = n * 64;
#pragma unroll
        for (int hf = 0; hf < 2; ++hf) { float qf[8], zf[8], oq[8], ok[8]; unpack8(rq[hf], qf); unpack8(rz[hf], zf);
            const int dd = d0 + 8 * hf; const f32x4 lb0 = *(const LAS f32x4*)(lbs + dd), lb1 = *(const LAS f32x4*)(lbs + dd + 4); f32x4 lf0, lf1;
#pragma unroll
            for (int j = 0; j < 8; ++j) { const float lb = j < 4 ? lb0[j] : lb1[j - 4]; const float f = lb + (1.0f - lb) * sigmoidf_(zf[j]); const float lf = fmaxf(__logf(f), -60.0f);
                if (j < 4) lf0[j] = lf; else lf1[j - 4] = lf; oq[j] = siluf_(qf[j]); ok[j] = 1.0f - f; }
            *(LAS u32x4*)(qs + tau_a * QP + dd) = pack8(oq); *(LAS u32x4*)(ks + tau_a * QP + dd) = pack8(ok);
            *(LAS f32x4*)(lfb + tau_a * 128 + dd) = lf0; *(LAS f32x4*)(lfb + tau_a * 128 + dd + 4) = lf1;
            const u32x4 vv = ri[hf];
            vT[(dd + 0) * SP + tau_a] = (bf16)(vv.x & 0xffffu); vT[(dd + 1) * SP + tau_a] = (bf16)(vv.x >> 16); vT[(dd + 2) * SP + tau_a] = (bf16)(vv.y & 0xffffu); vT[(dd + 3) * SP + tau_a] = (bf16)(vv.y >> 16);
            vT[(dd + 4) * SP + tau_a] = (bf16)(vv.z & 0xffffu); vT[(dd + 5) * SP + tau_a] = (bf16)(vv.z >> 16); vT[(dd + 6) * SP + tau_a] = (bf16)(vv.w & 0xffffu); vT[(dd + 7) * SP + tau_a] = (bf16)(vv.w >> 16); }
        if (n + 1 < NCH) { const bf16* pr = P + (size_t)chain_row(dir, b, s0 + 64 + tau_a) * INC + h * 128 + d0;
            rq[0] = *(const u32x4*)(pr + OFF_Q); rq[1] = *(const u32x4*)(pr + OFF_Q + 8); ri[0] = *(const u32x4*)(pr + OFF_I); ri[1] = *(const u32x4*)(pr + OFF_I + 8); rz[0] = *(const u32x4*)(pr + zoff); rz[1] = *(const u32x4*)(pr + zoff + 8); }
        LDS_BAR();
        float cs[16];
        { float run = 0.f;
#pragma unroll
          for (int i = 0; i < 16; ++i) { run += lfb[(16 * qt + i) * 128 + d]; cs[i] = run; }
          tot[qt * 128 + d] = run; }
        LDS_BAR();
        { const float t0 = tot[d], t1 = tot[128 + d], t2 = tot[256 + d], t3 = tot[384 + d];
          const float bmid = t0 + t1, btot = bmid + t2 + t3; const float base = (qt > 0 ? t0 : 0.f) + (qt > 1 ? t1 : 0.f) + (qt > 2 ? t2 : 0.f);
          if (qt == 0) { gmid[d] = __expf(bmid); gend[d] = __expf(btot - bmid); }
#pragma unroll
          for (int i = 0; i < 16; ++i) { const int tau = 16 * qt + i; const float bt = base + cs[i];
              const float eq = __expf(fminf(bt - bmid, 80.0f)), ek = __expf(fminf(bmid - bt, 80.0f));
              const bf16 qb = (bf16)f2bf(bf1(qs[tau * QP + d]) * eq), kb = (bf16)f2bf(bf1(ks[tau * QP + d]) * ek);
              qs[tau * QP + d] = qb; ks[tau * QP + d] = kb; kT[d * SP + tau] = kb; } }
        LDS_BAR();
        { const f32x4 gm = *(const LAS f32x4*)(gmid + 16 * wave + 4 * fq);
#pragma unroll
          for (int vt = 0; vt < 8; ++vt) { S[vt] = S[vt] * gm; u32x2 o; o.x = pk2(S[vt][0], S[vt][1]); o.y = pk2(S[vt][2], S[vt][3]); *(LAS u32x2*)(sT + (16 * vt + fr) * QP + 16 * wave + 4 * fq) = o; } }
        { const int tt = wave >> 1;
#pragma unroll
          for (int u = 0; u < 2; ++u) { const int sg = 2 * (wave & 1) + u; f32x4 acc = (f32x4){0.f, 0.f, 0.f, 0.f};
              if (sg <= tt) {
#pragma unroll
                  for (int kq = 0; kq < 4; ++kq) { const bf16x8 af = *(const LAS bf16x8*)(ks + (16 * sg + fr) * QP + 32 * kq + 8 * fq), bfm = *(const LAS bf16x8*)(qs + (16 * tt + fr) * QP + 32 * kq + 8 * fq);
                      acc = __builtin_amdgcn_mfma_f32_16x16x32_bf16(af, bfm, acc, 0, 0, 0); }
                  if (sg == tt) {
#pragma unroll
                      for (int j = 0; j < 4; ++j) if (4 * fq + j > fr) acc[j] = 0.f; }
              }
              u32x2 o; o.x = pk2(acc[0], acc[1]); o.y = pk2(acc[2], acc[3]); *(LAS u32x2*)(pl + (16 * tt + fr) * SP + 16 * sg + 4 * fq) = o; } }
        LDS_BAR();
#pragma unroll
        for (int tt = 0; tt < 4; ++tt) { f32x4 acc = (f32x4){0.f, 0.f, 0.f, 0.f};
#pragma unroll
            for (int kq = 0; kq < 2; ++kq) { const bf16x8 af = *(const LAS bf16x8*)(vT + (16 * wave + fr) * SP + 32 * kq + 8 * fq), bfm = *(const LAS bf16x8*)(pl + (16 * tt + fr) * SP + 32 * kq + 8 * fq);
                acc = __builtin_amdgcn_mfma_f32_16x16x32_bf16(af, bfm, acc, 0, 0, 0); }
#pragma unroll
            for (int kq = 0; kq < 4; ++kq) { const bf16x8 af = *(const LAS bf16x8*)(sT + (16 * wave + fr) * QP + 32 * kq + 8 * fq), bfm = *(const LAS bf16x8*)(qs + (16 * tt + fr) * QP + 32 * kq + 8 * fq);
                acc = __builtin_amdgcn_mfma_f32_16x16x32_bf16(af, bfm, acc, 0, 0, 0); }
            const int row = chain_row(dir, b, s0 + 16 * tt + fr);
            u32x2 o; o.x = pk2(acc[0], acc[1]); o.y = pk2(acc[2], acc[3]); *(u32x2*)(OB + ((size_t)dir * MALL + row) * BW + h * 128 + 16 * wave + 4 * fq) = o; }
        { const f32x4 ge = *(const LAS f32x4*)(gend + 16 * wave + 4 * fq);
#pragma unroll
          for (int kq = 0; kq < 2; ++kq) { const bf16x8 af = *(const LAS bf16x8*)(kT + (16 * wave + fr) * SP + 32 * kq + 8 * fq);
#pragma unroll
              for (int vt = 0; vt < 8; ++vt) { const bf16x8 bfm = *(const LAS bf16x8*)(vT + (16 * vt + fr) * SP + 32 * kq + 8 * fq); S[vt] = __builtin_amdgcn_mfma_f32_16x16x32_bf16(af, bfm, S[vt], 0, 0, 0); } }
#pragma unroll
          for (int vt = 0; vt < 8; ++vt) S[vt] = S[vt] * ge; }
        LDS_BAR();
    }
}
__device__ __forceinline__ void hgrn_chain(KArgs a, int l, int cid, LAS unsigned char* lds) {
    const int tid = tid_fresh();
    unsigned char* ws = a->ws;
    const bf16* P = (const bf16*)(ws + WS_P); bf16* OB = (bf16*)(ws + WS_OB);
    const int dir = cid / 48, b = (cid % 48) / 6, h = cid % 6;
    LAS float* tq = (LAS float*)lds;
    LAS float* tk = tq + 16 * 128;
    LAS float* tf = tk + 16 * 128;
    LAS float* tv = tf + 16 * 128;
    LAS float* ot = tv + 16 * 128;
    const int v = tid >> 2, q = tid & 3;
    float S[32];
#pragma unroll
    for (int j = 0; j < 32; ++j) S[j] = 0.f;
    const int sst = tid >> 5, sc4 = (tid & 31) * 4;
    float lb[4];
#pragma unroll
    for (int j = 0; j < 4; ++j) { const int ch = h * 128 + sc4 + j;
        if (l == 0) lb[j] = 0.f; else { const float l0 = a->in[I_LB][((size_t)dir * DEPTH + 0) * BW + ch], l1 = a->in[I_LB][((size_t)dir * DEPTH + 1) * BW + ch]; lb[j] = 1.0f / (1.0f + __expf(l0 - l1)); } }
    for (int s0 = 0; s0 < CTXL + T; s0 += 16) {
        { const int row = chain_row(dir, b, s0 + sst); const bf16* pr = P + (size_t)row * INC + h * 128 + sc4;
          const u32x2 pq = *(const u32x2*)(pr + OFF_Q), pi = *(const u32x2*)(pr + OFF_I), pz = *(const u32x2*)(pr + (dir ? OFF_ZB : OFF_ZF));
          const float qf[4] = {bflo(pq.x), bfhi(pq.x), bflo(pq.y), bfhi(pq.y)}, vf[4] = {bflo(pi.x), bfhi(pi.x), bflo(pi.y), bfhi(pi.y)}, zf[4] = {bflo(pz.x), bfhi(pz.x), bflo(pz.y), bfhi(pz.y)};
          f32x4 oq, ok, of, ov;
#pragma unroll
          for (int j = 0; j < 4; ++j) { const float f = lb[j] + (1.0f - lb[j]) * sigmoidf_(zf[j]); oq[j] = siluf_(qf[j]); of[j] = f; ok[j] = 1.0f - f; ov[j] = vf[j]; }
          *(LAS f32x4*)(tq + sst * 128 + sc4) = oq; *(LAS f32x4*)(tk + sst * 128 + sc4) = ok; *(LAS f32x4*)(tf + sst * 128 + sc4) = of; *(LAS f32x4*)(tv + sst * 128 + sc4) = ov; }
        LDS_BAR();
        for (int st = 0; st < 16; ++st) {
            const float vv = tv[st * 128 + v]; float o0 = 0.f, o1 = 0.f;
#pragma unroll
            for (int j = 0; j < 8; ++j) { const f32x4 fq4 = *(const LAS f32x4*)(tf + st * 128 + q * 32 + 4 * j), kq4 = *(const LAS f32x4*)(tk + st * 128 + q * 32 + 4 * j), qq4 = *(const LAS f32x4*)(tq + st * 128 + q * 32 + 4 * j);
#pragma unroll
                for (int i = 0; i < 4; ++i) { const float sn = fq4[i] * S[4 * j + i] + kq4[i] * vv; S[4 * j + i] = sn; if (i & 1) o1 += qq4[i] * sn; else o0 += qq4[i] * sn; } }
            float o = o0 + o1; o += dpp_xor1(o); o += dpp_xor2(o);
            if (q == 0) ot[st * 128 + v] = o;
        }
        LDS_BAR();
        if (tid < 256) { const int st = tid >> 4, part = tid & 15; const int row = chain_row(dir, b, s0 + st); const LAS float* op = ot + st * 128 + part * 8;
            float f[8];
#pragma unroll
            for (int j = 0; j < 8; ++j) f[j] = op[j];
            *(u32x4*)(OB + ((size_t)dir * MALL + row) * BW + h * 128 + part * 8) = pack8(f); }
    }
    LDS_BAR();
}

__device__ __forceinline__ float grp_sum32(float v) { v += __shfl_xor(v, 1); v += __shfl_xor(v, 2); v += __shfl_xor(v, 4); v += __shfl_xor(v, 8); v += __shfl_xor(v, 16); return v; }
__device__ __forceinline__ float grp_sum16(float v) { v += __shfl_xor(v, 1); v += __shfl_xor(v, 2); v += __shfl_xor(v, 4); v += __shfl_xor(v, 8); return v; }
__device__ __forceinline__ void phase_finalize(KArgs a, int l, bool dry) {
    const int tid_ = tid_fresh(); const int lane = tid_ & 63, wave = tid_ >> 6, gw = blockIdx.x * 8 + wave, NGW = gridDim.x * 8;
    unsigned char* ws = a->ws;
    const bf16* P = (const bf16*)(ws + WS_P); const bf16* OB = (const bf16*)(ws + WS_OB); const bf16* OC = (const bf16*)(ws + WS_OC); bf16* Y = (bf16*)(ws + WS_Y);
    unsigned char* Yo = dry ? ws + WS_END : ws + WS_Y8;
    const int nrows = (l == DEPTH - 1) ? NLAT : MALL;
    const int rpw = (nrows + NGW - 1) / NGW; const int r0 = gw * rpw, r1 = (r0 + rpw < nrows) ? r0 + rpw : nrows;
    f32x4 hng[3], gng[3], gnb[3];
#pragma unroll
    for (int k = 0; k < 3; ++k) { const int c = 256 * k + 4 * lane; hng[k] = *(const f32x4*)(a->in[I_HNG] + (size_t)l * BW + c);
        gng[k] = *(const f32x4*)(a->in[I_GNGG] + (size_t)l * CW + c); gnb[k] = *(const f32x4*)(a->in[I_GNB] + (size_t)l * CW + c); }
    for (int row = r0; row < r1; ++row) {
        const int orow = dry ? (row & 2047) : row;
        u32x2 bf_[3], bb_[3], bg_[3], cf_[3], cb_[3], cv_[3], cg_[3];
#pragma unroll
        for (int k = 0; k < 3; ++k) { const int c = 256 * k + 4 * lane;
            bf_[k] = *(const u32x2*)(OB + (size_t)row * BW + c); bb_[k] = *(const u32x2*)(OB + ((size_t)MALL + row) * BW + c); bg_[k] = *(const u32x2*)(P + (size_t)row * INC + OFF_OG + c);
            cf_[k] = *(const u32x2*)(OC + (size_t)row * CW + c); cb_[k] = *(const u32x2*)(OC + ((size_t)MALL + row) * CW + c);
            cv_[k] = *(const u32x2*)(Y + (size_t)row * D + 512 + c);
            cg_[k] = *(const u32x2*)(Y + (size_t)row * D + 1280 + c); }
#pragma unroll
        for (int k = 0; k < 3; ++k) { const int c = 256 * k + 4 * lane;
            { float o[4] = {bflo(bf_[k].x) + bflo(bb_[k].x), bfhi(bf_[k].x) + bfhi(bb_[k].x), bflo(bf_[k].y) + bflo(bb_[k].y), bfhi(bf_[k].y) + bfhi(bb_[k].y)};
              const float ss = grp_sum32((o[0] * o[0] + o[1] * o[1]) + (o[2] * o[2] + o[3] * o[3])); const float rstd = 1.0f / sqrtf(ss * (1.0f / 128.0f) + NORM_EPS);
              const float g4[4] = {bflo(bg_[k].x), bfhi(bg_[k].x), bflo(bg_[k].y), bfhi(bg_[k].y)}; float y[4];
#pragma unroll
              for (int j = 0; j < 4; ++j) y[j] = o[j] * rstd * hng[k][j] * sigmoidf_(g4[j]);
              *(unsigned*)(Yo + (size_t)orow * D + 512 + c) = pk4_fp8(y[0], y[1], y[2], y[3]); }
            { float o[4] = {bflo(cf_[k].x) + bflo(cb_[k].x), bfhi(cf_[k].x) + bfhi(cb_[k].x), bflo(cf_[k].y) + bflo(cb_[k].y), bfhi(cf_[k].y) + bfhi(cb_[k].y)};
              const float v4[4] = {bflo(cv_[k].x), bfhi(cv_[k].x), bflo(cv_[k].y), bfhi(cv_[k].y)}, g4[4] = {bflo(cg_[k].x), bfhi(cg_[k].x), bflo(cg_[k].y), bfhi(cg_[k].y)};
              const float mean = grp_sum16((o[0] + o[1]) + (o[2] + o[3])) * (1.0f / 64.0f);
              float dl[4]; float sq = 0.f;
#pragma unroll
              for (int j = 0; j < 4; ++j) { dl[j] = o[j] - mean; sq += dl[j] * dl[j]; }
              const float var = grp_sum16(sq) * (1.0f / 64.0f); const float rs = 1.0f / sqrtf(var + GN_EPS); float y[4];
#pragma unroll
              for (int j = 0; j < 4; ++j) y[j] = (dl[j] * rs * gng[k][j] + gnb[k][j] + v4[j]) * g4[j];
              *(unsigned*)(Yo + (size_t)orow * D + 1280 + c) = pk4_fp8(y[0], y[1], y[2], y[3]); }
        }
    }
}

__global__ void __launch_bounds__(NTHREADS, 2) mk_fwd(Args args_unused) {
    extern __shared__ __attribute__((aligned(16))) unsigned char lds_raw[];
    LAS unsigned char* lds = (LAS unsigned char*)lds_raw;
    volatile LAS unsigned* misc = (volatile LAS unsigned*)(lds + LDS_MISC);
    const int tid = threadIdx.x, G = gridDim.x;
    if (tid < 64) misc[tid] = 0u;
    __syncthreads();
    XcdBarrier bar; bar.bar = nullptr; bar.x = 0; bar.st = nullptr;
    int lo, hi;
    { KArgs a = kargs(); lo = a->ph_lo; hi = a->ph_hi; unsigned* ctl = (unsigned*)(a->ws + WS_CTL); bar.bar = ctl + CW_BAR; if (!MK_MULTI) bar = xcd_barrier_post(ctl + CW_BAR, misc + 8); }
    const int cvirt = (G % 8 == 0) ? ((int)blockIdx.x % 8) * (G / 8) + (int)blockIdx.x / 8 : (int)blockIdx.x;
#define IN(k) (lo <= (k) && (k) < hi)
#define PM(b) ((PHMASK >> (b)) & 1)
#define REP(b) _Pragma("unroll 1") for (int rep_ = 0; rep_ < 1 + ((PROBE_DUP >> (b)) & 1); ++rep_)
#define SEAM(k) do { if (!MK_MULTI && IN(k) && IN((k) + 1)) { xcd_barrier(bar); if ((PROBE_DUP >> 13) & 1) xcd_barrier(bar); } } while (0)

    if (PM(0) && IN(0)) REP(0) { phase_prologue(kargs(), lds); } SEAM(0);

#pragma unroll 1
    for (int l = 0; l < DEPTH; ++l) {
        const int pb = 1 + 9 * l;
        const bool lastl = (l == DEPTH - 1);
        if (PM(1) && IN(pb + 0)) { if ((PROBE_DUP >> 1) & 1) { if (l == 0) phase_norm1<0>(kargs(), l, true); else phase_norm1<1>(kargs(), l, true); } if (l == 0) phase_norm1<0>(kargs(), l, false); else { phase_norm1<1>(kargs(), l, false); __syncthreads(); convert_moe(kargs(), l, lds); __syncthreads(); } } SEAM(pb + 0);
        if (PM(2) && IN(pb + 1)) REP(2) {
            KArgs a = kargs(); unsigned char* ws = a->ws;
            pg8::Gemm g{(const bf16*)(ws + WS_H), (const bf16*)(ws + WS_WIN + (size_t)l * INC * D), MALL, INC, D / 2};
            pg8::StaticOrder S; S.init(MALL, INC, G, (int)blockIdx.x);
            pg8::EpiBf16 E{(bf16*)(ws + WS_P), INC};
            pg8::gemm_phase8<pg8::EpiBf16, pg8::StaticOrder, false, false>(lds, g, S, E, nullptr);
        } SEAM(pb + 1);
        if (PM(3) && IN(pb + 2)) {
            const int ngm = lastl ? 1024 : 1088;
            unsigned* qhead = (unsigned*)(kargs()->ws + WS_CTL) + CW_PREPQ + 64 * l;
            const int n_rw = 544 * 3, n_hg = 3264, n_all = (G == 256) ? n_rw + n_hg : n_rw + n_hg + ngm;
            for (;;) {
                if (threadIdx.x == 0) misc[16] = __hip_atomic_fetch_add(qhead, 1u, __ATOMIC_RELAXED, __HIP_MEMORY_SCOPE_AGENT);
                __syncthreads();
                const int it = (int)misc[16];
                if (it >= n_all) break;
                if (it < n_rw) { _Pragma("unroll 1") for (int r2 = 0; r2 < 1 + ((PROBE_DUP >> 15) & 1); ++r2) rwkv_prep_item(kargs(), l, it / 3, it % 3, lds); }
                else if (it < n_rw + n_hg) { if ((PROBE_DUP >> 16) & 1) hgrn_prep_item(kargs(), l, it - n_rw, lds, true); hgrn_prep_item(kargs(), l, it - n_rw, lds, false); }
                else { _Pragma("unroll 1") for (int r2 = 0; r2 < 1 + ((PROBE_DUP >> 14) & 1); ++r2) gmlp_item(kargs(), l, it - n_rw - n_hg, lds); }
            }
            __syncthreads();
        } SEAM(pb + 2);
        if (PM(4) && IN(pb + 3)) REP(4) {
            if (G == 256) { const int bx = blockIdx.x;
                if (bx < 96) { _Pragma("unroll 1") for (int r2 = 0; r2 < 1 + ((PROBE_DUP >> 12) & 1); ++r2) rwkv_chain_mfma(kargs(), bx * 8, lds); }
                else if (bx < 192) { _Pragma("unroll 1") for (int r2 = 0; r2 < 1 + ((PROBE_DUP >> 11) & 1); ++r2) hgrn_chain_lean(kargs(), bx - 96, lds); }
                if (bx < 96 || bx >= 192) {
                    unsigned* gq = (unsigned*)(kargs()->ws + WS_CTL) + CW_GMQ + 64 * l; const int ngm2 = lastl ? 1024 : 1088;
                    for (;;) { if (threadIdx.x == 0) misc[17] = __hip_atomic_fetch_add(gq, 1u, __ATOMIC_RELAXED, __HIP_MEMORY_SCOPE_AGENT);
                        __syncthreads(); const int it = (int)misc[17]; if (it >= ngm2) break; gmlp_item(kargs(), l, it, lds); }
                    __syncthreads(); } }
            else { for (int it = blockIdx.x; it < 192; it += G) { if (it < 96) rwkv_chain_mfma(kargs(), it * 8, lds); else hgrn_chain_lean(kargs(), it - 96, lds); } }
        } SEAM(pb + 3);
        if (PM(5) && IN(pb + 4)) { if ((PROBE_DUP >> 5) & 1) phase_finalize(kargs(), l, true); phase_finalize(kargs(), l, false); } SEAM(pb + 4);
        if (PM(6) && IN(pb + 5)) REP(6) {
            KArgs a = kargs(); unsigned char* ws = a->ws;
            const int Mo = lastl ? NLAT : MALL;
            pg8::Gemm g{(const bf16*)(ws + WS_Y8), (const bf16*)(ws + WS_WOUT + (size_t)l * D * D), Mo, D, D / 2};
            pg8::StaticOrder S; S.init(Mo, D, G, (int)blockIdx.x);
            const float* xl = l == 0 ? a->in[I_X] : (const float*)(ws + WS_X); const float* xc = l == 0 ? a->in[I_CTX] : (const float*)(ws + WS_X) + (size_t)NLAT * D;
            pg8::EpiResid E{xl, xc, (float*)(ws + WS_X), (const float*)(ws + WS_MOD) + (size_t)l * 9 * 12288 + 2 * D};
            pg8::gemm_phase8<pg8::EpiResid, pg8::StaticOrder, true, false>(lds, g, S, E, nullptr);
        } SEAM(pb + 5);
        if (PM(7) && IN(pb + 6)) { if ((PROBE_DUP >> 7) & 1) phase_norm2_router(kargs(), l, true, lds); phase_norm2_router(kargs(), l, false, lds); } SEAM(pb + 6);
        if (PM(8) && IN(pb + 7)) REP(8) {
            KArgs a = kargs(); unsigned char* ws = a->ws;
            moe_tables<false>(a, l, lds, cvirt);
            pg8::Gemm g{(const bf16*)(ws + WS_H), (const bf16*)(ws + WS_WGU), 0, 2048, D / 2};
            pg8::MoeOrder S{(const LAS int*)(lds + LDS_TP), G, cvirt, (unsigned)(2048 * D)};
            pg8::EpiSwiglu E{ws + WS_ACT};
            pg8::gemm_phase8<pg8::EpiSwiglu, pg8::MoeOrder, false, true>(lds, g, S, E, (const LAS unsigned*)(lds + LDS_TAB));
        } SEAM(pb + 7);
        if (PM(9) && IN(pb + 8)) REP(9) {
            KArgs a = kargs(); unsigned char* ws = a->ws;
            moe_tables<true>(a, l, lds, cvirt);
            pg8::Gemm g{(const bf16*)(ws + WS_ACT), (const bf16*)(ws + WS_WDN), 0, D, DE / 2};
            pg8::MoeOrder S{(const LAS int*)(lds + LDS_TP), G, cvirt, (unsigned)(D * DE)};
            pg8::EpiDown E{(bf16*)(ws + WS_YK), (const LAS unsigned*)(lds + LDS_TAB), (const LAS float*)(lds + LDS_TABW)};
            pg8::gemm_phase8<pg8::EpiDown, pg8::MoeOrder, false, false>(lds, g, S, E, nullptr);
        } SEAM(pb + 8);
    }
    if (PM(10) && IN(1 + 9 * DEPTH)) { if ((PROBE_DUP >> 10) & 1) phase_norm1<2>(kargs(), DEPTH, true); phase_norm1<2>(kargs(), DEPTH, false); }
#undef IN
#undef SEAM
}

extern "C" void kernel_launch(void* const* d_in, const int* in_sizes, int n_in, void* d_out, int out_size, void* d_ws, size_t ws_size, hipStream_t stream) {
    static int grid = 0;
    if (grid == 0) {
        if (n_in != 31 || ws_size < WS_END) { fprintf(stderr, "kernel_launch: unexpected n_in %d / ws %zu (need %zu)\n", n_in, ws_size, (size_t)WS_END); grid = -1; return; }
        int dev = 0, cus = 0, per_cu = 0;
        hipGetDevice(&dev); hipDeviceGetAttribute(&cus, hipDeviceAttributeMultiprocessorCount, dev);
        if (hipFuncSetAttribute((const void*)mk_fwd, hipFuncAttributeMaxDynamicSharedMemorySize, LDS_BYTES) != hipSuccess) { fprintf(stderr, "kernel_launch: hipFuncSetAttribute failed\n"); grid = -1; return; }
        if (hipOccupancyMaxActiveBlocksPerMultiprocessor(&per_cu, (const void*)mk_fwd, NTHREADS, LDS_BYTES) != hipSuccess || per_cu < 1) fprintf(stderr, "kernel_launch: occupancy query says %d\n", per_cu);
        (void)hipGetLastError();
        grid = cus > 0 ? cus : 256;
    }
    if (grid < 0) return;
    hipMemsetAsync((char*)d_ws + WS_CTL, 0, CTL_ZERO_BYTES, stream);
    Args a{};
    for (int i = 0; i < 31; ++i) a.in[i] = (const float*)d_in[i];
    a.out = (float*)d_out; a.ws = (unsigned char*)d_ws;
    constexpr int NPH = 2 + 9 * DEPTH;
#if MK_MULTI
    for (int p = 0; p < NPH; ++p) { a.ph_lo = p; a.ph_hi = p + 1; hipLaunchKernelGGL(mk_fwd, dim3(grid), dim3(NTHREADS), LDS_BYTES, stream, a); }
#else
    a.ph_lo = 0; a.ph_hi = NPH; hipLaunchKernelGGL(mk_fwd, dim3(grid), dim3(NTHREADS), LDS_BYTES, stream, a);
#endif
}
```

```cpp
#include <hip/hip_runtime.h>
#include <cstdio>
#include <cstdint>

#ifndef PHMASK
#define PHMASK 0xFFFF
#endif
#ifndef PROBE_DUP
#define PROBE_DUP 0
#endif
#ifndef MK_MULTI
#define MK_MULTI 0
#endif

#define GAS __attribute__((address_space(1)))
#define LAS __attribute__((address_space(3)))
typedef unsigned short bf16;
typedef short bf16x8 __attribute__((ext_vector_type(8)));
typedef float f32x4 __attribute__((ext_vector_type(4)));
typedef float f32x2 __attribute__((ext_vector_type(2)));
typedef unsigned u32x4 __attribute__((ext_vector_type(4)));
typedef unsigned u32x2 __attribute__((ext_vector_type(2)));

constexpr int D = 2048, NB = 8, T = 4096, CTXL = 256, DEPTH = 2;
constexpr int NLAT = NB * T, NCTX = NB * CTXL, MALL = NLAT + NCTX;
constexpr int INC = 7424;
constexpr int OFF_U = 0, OFF_V = 512, OFF_Q = 1024, OFF_I = 1792, OFF_ZF = 2560, OFF_ZB = 3328, OFF_OG = 4096;
constexpr int OFF_C = 4864;
constexpr int BW = 768, CW = 768, CCOLS = 2560;
constexpr int NE = 16, DE = 1024;
constexpr int PC2W = 7 * 768;
constexpr int NTHREADS = 512;
constexpr float NORM_EPS = 1e-6f, GN_EPS = 64e-5f, DECAY_SCALE = 0.60653065971263342f;

constexpr size_t MiB = 1u << 20;
constexpr size_t WS_CTL = 0, CTL_ZERO_BYTES = 1 * MiB;
constexpr size_t WS_MOD = 1 * MiB;
constexpr size_t WS_SMALLW = 2 * MiB;
constexpr size_t SW_WUP = 0, SW_AUP = SW_WUP + (size_t)2 * 2 * 768 * 64 * 2, SW_GUP = SW_AUP + (size_t)2 * 768 * 64 * 2, SW_GWS = SW_GUP + (size_t)2 * 768 * 128 * 2;
constexpr size_t WS_WIN = 4 * MiB, WS_WOUT = 62 * MiB, WS_WGU = 78 * MiB, WS_WDN = 142 * MiB, WS_Y8 = 174 * MiB;
constexpr size_t WS_X = 270 * MiB, WS_H = 542 * MiB, WS_Y = 678 * MiB, WS_P = 814 * MiB, WS_PRE = 1307 * MiB, WS_VT = 1817 * MiB, WS_OC = 1868 * MiB, WS_HQB = 1970 * MiB, WS_HG = 2021 * MiB, WS_END = 2028 * MiB;
constexpr int PRE_REC = 10240, PR_WP = 0, PR_RP = 2048, PR_BK = 4096, PR_ARBK = 8192, PR_MAK = 9216, PR_GAM = 9728, NCHUNK16 = 272;
constexpr size_t WS_OB = WS_H;
constexpr size_t WS_ACT = WS_P, WS_YK = WS_P + 144 * MiB, WS_RIDX = WS_P + 416 * MiB, WS_RW = WS_RIDX + 3 * MiB;
static_assert(WS_RW + 3 * MiB <= WS_PRE, "moe overlay");
constexpr int MAXSLOT_TILES = 288;
constexpr int CW_BAR = 4096;
constexpr int CW_GMQ = 30720;
constexpr int CW_PREPQ = 28672;
constexpr int CW_CNT = 16384;

constexpr int LDS_STAGE = 0, LDS_TAB = 131072, LDS_TABW = LDS_TAB + 9 * 1024, LDS_TP = LDS_TABW + 9 * 1024, LDS_MISC = 150528, LDS_BYTES = 152 * 1024;
static_assert(LDS_TP + 128 <= LDS_MISC, "lds map");

typedef __bf16 bf16x2_t __attribute__((ext_vector_type(2)));
__device__ __forceinline__ unsigned pk2(float lo, float hi) { const f32x2 v = {lo, hi}; return __builtin_bit_cast(unsigned, __builtin_convertvector(v, bf16x2_t)); }
__device__ __forceinline__ unsigned f2bf(float f) { return pk2(f, f) & 0xffffu; }
__device__ __forceinline__ unsigned pk4_fp8(float a, float b, float c, float d) {
    a = __builtin_amdgcn_fmed3f(a, -448.f, 448.f); b = __builtin_amdgcn_fmed3f(b, -448.f, 448.f); c = __builtin_amdgcn_fmed3f(c, -448.f, 448.f); d = __builtin_amdgcn_fmed3f(d, -448.f, 448.f);
    int p = 0; p = __builtin_amdgcn_cvt_pk_fp8_f32(a, b, p, false); p = __builtin_amdgcn_cvt_pk_fp8_f32(c, d, p, true); return (unsigned)p; }
__device__ __forceinline__ float bflo(unsigned u) { return __builtin_bit_cast(float, u << 16); }
__device__ __forceinline__ float bfhi(unsigned u) { return __builtin_bit_cast(float, u & 0xffff0000u); }
__device__ __forceinline__ float bf1(bf16 b) { return __builtin_bit_cast(float, ((unsigned)b) << 16); }
__device__ __forceinline__ float sigmoidf_(float x) { return __builtin_amdgcn_rcpf(1.0f + __expf(-x)); }
__device__ __forceinline__ float siluf_(float x) { return x * __builtin_amdgcn_rcpf(1.0f + __expf(-x)); }
__device__ __forceinline__ float geluf_(float v) {
    const float av = fabsf(v), t = __builtin_amdgcn_rcpf(av * 0.2316418882f + 1.0f);
    float q = t * 0.5307027145f + (-0.7265760135f); q = q * t + 0.7107068705f; q = q * t + (-0.142248368f); q = q * t + 0.127414796f; q = q * t;
    const float e = __builtin_amdgcn_exp2f((v * v) * (-0.72134752044f)); const float m = v * (q * e); return v < 0.f ? m : v - m; }
__device__ __forceinline__ float wave_sum(float v) {
#pragma unroll
    for (int o = 1; o < 64; o <<= 1) v += __shfl_xor(v, o);
    return v;
}
__device__ __forceinline__ int tid_fresh() { int t = threadIdx.x; asm volatile("" : "+v"(t)); return t; }
__device__ __forceinline__ void unpack8(const u32x4 v, float (&f)[8]) {
    f[0] = bflo(v.x); f[1] = bfhi(v.x); f[2] = bflo(v.y); f[3] = bfhi(v.y); f[4] = bflo(v.z); f[5] = bfhi(v.z); f[6] = bflo(v.w); f[7] = bfhi(v.w);
}
__device__ __forceinline__ u32x4 pack8(const float (&f)[8]) { u32x4 v; v.x = pk2(f[0], f[1]); v.y = pk2(f[2], f[3]); v.z = pk2(f[4], f[5]); v.w = pk2(f[6], f[7]); return v; }
__device__ __forceinline__ int modrow_of(int row) { return row < NLAT ? (row >> 12) : 8; }

#define XB_TMO      128
#define XB_XCNT(j)  (256  + 64 * (j))
#define XB_XSUB(j)  (1280 + 64 * (j))
#define XB_XGEN(j)  (2304 + 64 * (j))
#define XB_TOP      3328
#define XB_TOPGEN   3392
#define XCD_BAR_WORDS 3456
#define XB_SPIN_CAP (1u << 18)
__device__ __forceinline__ unsigned xb_ld(unsigned* p)              { return __hip_atomic_load(p, __ATOMIC_RELAXED, __HIP_MEMORY_SCOPE_AGENT); }
__device__ __forceinline__ unsigned xb_add(unsigned* p, unsigned v) { return __hip_atomic_fetch_add(p, v, __ATOMIC_RELAXED, __HIP_MEMORY_SCOPE_AGENT); }
__device__ __forceinline__ unsigned xb_xcc_id() { return (unsigned)__builtin_amdgcn_s_getreg((3 << 11) | 20) & 0xFu; }
#define XB_SPIN(cond, bar) do { unsigned _sp = 0; while (cond) { __builtin_amdgcn_s_sleep(1); \
    if ((++_sp & 255u) == 0u) { if (xb_ld(&(bar)[XB_TMO])) break; if (_sp > XB_SPIN_CAP) { atomicAdd(&(bar)[XB_TMO], 1u); break; } } } } while (0)
struct XcdBarrier { unsigned* bar; unsigned x; volatile LAS unsigned* st; };
__device__ __forceinline__ XcdBarrier xcd_barrier_post(unsigned* bar, volatile LAS unsigned* st) {
    XcdBarrier b; b.bar = bar; b.x = xb_xcc_id(); b.st = st;
    if (threadIdx.x == 0) (void)xb_add(&bar[XB_XCNT(b.x)], 1u);
    return b;
}
__device__ __forceinline__ void xcd_barrier_complete(unsigned* bar, unsigned x, unsigned& nloc, unsigned& nx) {
    const unsigned G = gridDim.x * gridDim.y * gridDim.z;
    unsigned sum, cnt, mine, sp = 0u;
    for (;;) {
        sum = 0u; cnt = 0u; mine = 0u;
#pragma unroll
        for (unsigned j = 0; j < 16; ++j) { const unsigned c = xb_ld(&bar[XB_XCNT(j)]); sum += c; cnt += (c > 0u) ? 1u : 0u; mine = (j == x) ? c : mine; }
        if (sum == G) break;
        __builtin_amdgcn_s_sleep(1);
        if ((++sp & 255u) == 0u) { if (xb_ld(&bar[XB_TMO])) break; if (sp > XB_SPIN_CAP) { atomicAdd(&bar[XB_TMO], 1u); break; } }
    }
    nloc = mine > 0u ? mine : 1u; nx = cnt > 0u ? cnt : 1u;
}
__device__ __forceinline__ void xcd_barrier(const XcdBarrier& b) {
    asm volatile("s_waitcnt vmcnt(0)" ::: "memory");
    __syncthreads();
    if (threadIdx.x == 0) {
        unsigned* bar = b.bar;
        __builtin_amdgcn_s_waitcnt(0);
        unsigned nloc = b.st[0], nx = b.st[1];
        if (nloc == 0u) { xcd_barrier_complete(bar, b.x, nloc, nx); b.st[0] = nloc; b.st[1] = nx; }
        const unsigned old = xb_add(&bar[XB_XSUB(b.x)], 1u);
        const unsigned gen = old / nloc;
        if (old + 1u == (gen + 1u) * nloc) {
            __builtin_amdgcn_fence(__ATOMIC_RELEASE, "agent");
            asm volatile("s_waitcnt vmcnt(0)" ::: "memory");
            const unsigned og = xb_add(&bar[XB_TOP], 1u);
            const unsigned tg = og / nx;
            if (og + 1u == (tg + 1u) * nx) xb_add(&bar[XB_TOPGEN], 1u);
            else XB_SPIN(xb_ld(&bar[XB_TOPGEN]) == tg, bar);
            __builtin_amdgcn_fence(__ATOMIC_ACQUIRE, "agent");
            xb_add(&bar[XB_XGEN(b.x)], 1u);
            asm volatile("s_waitcnt vmcnt(0)" ::: "memory");
        } else {
            XB_SPIN(xb_ld(&bar[XB_XGEN(b.x)]) == gen, bar);
            __builtin_amdgcn_fence(__ATOMIC_ACQUIRE, "agent");
            asm volatile("s_waitcnt vmcnt(0)" ::: "memory");
        }
    }
    __syncthreads();
}

namespace pg8 {
constexpr int BM = 256, BK = 64, HALF = 128, HTB = HALF * BK * 2, STAGE_BYTES = 8 * HTB, NXCD = 8, WGM = 8;
__host__ __device__ __forceinline__ int lds_byte(int r, int c) { const int st = (r >> 4) * 2 + (c >> 5), rr = r & 15, cc = c & 31, ob = rr * 64 + cc * 2; return st * 1024 + (ob ^ (((ob >> 9) & 1) << 5)); }
__host__ __device__ __forceinline__ void stage_rc(int b, int& R, int& C) { const int st = b / 1024, sb = b % 1024, swz = sb ^ (((sb >> 9) & 1) << 5); R = (st >> 1) * 16 + swz / 64; C = (st & 1) * 32 + (swz % 64) / 2; }
__host__ __device__ __forceinline__ int perm32(int rho) { const int n = rho >> 4, i = rho & 15; return 8 * (i >> 2) + 4 * n + (i & 3); }

struct Unit { int pm, pn, e, aux; };
struct Gemm { const bf16* A; const bf16* Bt; int M, N, K; };

struct StaticOrder {
    int nM, nN, nwg, G, c;
    __device__ void init(int M, int N, int G_, int c_) { nM = M / BM; nN = N / BM; nwg = nM * nN; G = G_; c = c_; }
    __device__ bool next(int i, Unit& u) const {
        const long L = (long)i * G + c; if (L >= nwg) return false;
        int wgid = (int)L; { const int q = nwg / NXCD, r = nwg % NXCD, xcd = wgid % NXCD, off = wgid / NXCD; wgid = (xcd < r ? xcd * (q + 1) : r * (q + 1) + (xcd - r) * q) + off; }
        const int nig = WGM * nN, gid = wgid / nig, fm = gid * WGM, gsz = (nM - fm) < WGM ? (nM - fm) : WGM;
        u.pm = fm + ((wgid % nig) % gsz); u.pn = (wgid % nig) / gsz; u.e = 0; u.aux = 0; return true;
    }
    __device__ __forceinline__ unsigned b_off(const Unit& u, unsigned tstep) const { return (unsigned)u.pn * tstep; }
};
struct MoeOrder {
    const LAS int* tp; int G, c; unsigned estride;
    __device__ bool next(int i, Unit& u) const {
        const int L = i * G + c; const int ntot = tp[16] * 8; if (L >= ntot) return false;
        const int tile = L >> 3; int e = 0;
#pragma unroll
        for (int j = 1; j < 16; ++j) e += (tile >= tp[j]) ? 1 : 0;
        u.pm = tile; u.pn = L & 7; u.e = e; u.aux = i; return true;
    }
    __device__ __forceinline__ unsigned b_off(const Unit& u, unsigned tstep) const { return (unsigned)u.e * estride + (unsigned)u.pn * tstep; }
};

#define PG8_LAS __attribute__((address_space(3)))
template <class Epi, class Sched, bool ALIGN_EPI, bool GATHER>
__device__ __forceinline__ void gemm_phase(PG8_LAS unsigned char* lds, const Gemm g, const Sched& S, const Epi& E, const PG8_LAS unsigned* tabA) {
    const int tid = tid_fresh(), wid = __builtin_amdgcn_readfirstlane(tid >> 6), lane = tid & 63, wr = wid >> 2, wc = wid & 3, fr = lane & 15, fq = lane >> 4;
    const int K = g.K, nt = K / BK;
    int sR[2], sC[2];
    unsigned voffB[2];
#pragma unroll
    for (int i = 0; i < 2; ++i) { int R, C; stage_rc(tid * 16 + i * 8192, R, C); sR[i] = R; sC[i] = C; const int Rb = Epi::PERM ? ((R & ~31) + perm32(R & 31)) : R;
        voffB[i] = (unsigned)(Rb * K + C) * 2u; }
    const unsigned kstep = (unsigned)(BK * 2);
    const unsigned hstep = (unsigned)(HALF * K * 2);
    const unsigned tstep = 2u * hstep;
    const unsigned ldsw = (unsigned)wid * 1024u;
    const char* const baseA = (const char*)g.A; const char* const baseB = (const char*)g.Bt;
    const int aoff = lds_byte(wr * 64 + fr, fq * 8), boff = lds_byte(wc * 32 + fr, fq * 8);
#define PG8_SA(b, h) (((b) * 2 + (h)) * HTB)
#define PG8_SB(b, h) ((4 + (b) * 2 + (h)) * HTB)
#define PG8_STAGE(bufoff, gbase, uoff, voff) do { _Pragma("unroll") for (int _i = 0; _i < 2; ++_i) \
        __builtin_amdgcn_global_load_lds((const unsigned*)((gbase) + (size_t)(unsigned)((uoff) + (voff)[_i])), (PG8_LAS unsigned*)(lds + (bufoff) + ldsw + _i * 8192), 16, 0, 0); } while (0)
#define PG8_LDA(dst, b, h) do { _Pragma("unroll") for (int m = 0; m < 4; ++m) _Pragma("unroll") for (int k = 0; k < 2; ++k) dst[m][k] = *(const PG8_LAS bf16x8*)(lds + PG8_SA(b, h) + aoff + m * 2048 + k * 1024); } while (0)
#define PG8_LDB(dst, b, h) do { _Pragma("unroll") for (int n = 0; n < 2; ++n) _Pragma("unroll") for (int k = 0; k < 2; ++k) dst[n][k] = *(const PG8_LAS bf16x8*)(lds + PG8_SB(b, h) + boff + n * 2048 + k * 1024); } while (0)
#define PG8_MMA(ai, bj, At, Bt) do { __builtin_amdgcn_s_setprio(1); _Pragma("unroll") for (int m = 0; m < 4; ++m) _Pragma("unroll") for (int n = 0; n < 2; ++n) _Pragma("unroll") for (int k = 0; k < 2; ++k) \
        acc[ai][bj][m][n] = __builtin_amdgcn_mfma_f32_16x16x32_bf16(Bt[n][k], At[m][k], acc[ai][bj][m][n], 0, 0, 0); __builtin_amdgcn_s_setprio(0); } while (0)
#define PG8_WAIT_V(n) asm volatile("s_waitcnt vmcnt(" #n ")" ::: "memory")
#define PG8_WAIT_L(n) asm volatile("s_waitcnt lgkmcnt(" #n ")" ::: "memory")
#define PG8_BAR __builtin_amdgcn_s_barrier()
#define PG8_SCHED __builtin_amdgcn_sched_barrier(0)
    Unit cur, nxt; int ui = 0;
    if (!S.next(0, cur)) return;
    f32x4 acc[2][2][4][2];
#pragma unroll
    for (int a = 0; a < 2; ++a)
#pragma unroll
        for (int b = 0; b < 2; ++b)
#pragma unroll
            for (int m = 0; m < 4; ++m)
#pragma unroll
                for (int n = 0; n < 2; ++n) acc[a][b][m][n] = (f32x4){0.f, 0.f, 0.f, 0.f};
    bf16x8 At[4][2], B0[2][2], B1[2][2];
    unsigned vA0[2], vA1[2], nA0[2], nA1[2];
    unsigned uA, uB = S.b_off(cur, tstep);
    if constexpr (GATHER) { uA = 0u;
#pragma unroll
        for (int i = 0; i < 2; ++i) { vA0[i] = tabA[cur.aux * 256 + sR[i]] + (unsigned)sC[i] * 2u; vA1[i] = tabA[cur.aux * 256 + 128 + sR[i]] + (unsigned)sC[i] * 2u; }
    } else { uA = (unsigned)cur.pm * tstep;
#pragma unroll
        for (int i = 0; i < 2; ++i) { vA0[i] = (unsigned)(sR[i] * K + sC[i]) * 2u; vA1[i] = vA0[i] + hstep; }
    }
    PG8_STAGE(PG8_SB(0, 0), baseB, uB, voffB); PG8_STAGE(PG8_SB(0, 1), baseB, uB + hstep, voffB); PG8_STAGE(PG8_SA(0, 0), baseA, uA, vA0); PG8_STAGE(PG8_SA(0, 1), baseA, uA, vA1);
    if (wr == 1) PG8_BAR;
    PG8_WAIT_V(2); PG8_BAR;
    PG8_STAGE(PG8_SB(1, 0), baseB, uB + kstep, voffB); PG8_STAGE(PG8_SA(1, 0), baseA, uA + kstep, vA0); PG8_STAGE(PG8_SB(1, 1), baseB, uB + hstep + kstep, voffB);
    PG8_WAIT_V(6); PG8_BAR;
    for (;;) {
        const bool has_next = S.next(ui + 1, nxt);
        unsigned nuA, nuB = has_next ? S.b_off(nxt, tstep) : uB;
        if constexpr (GATHER) { nuA = 0u;
#pragma unroll
            for (int i = 0; i < 2; ++i) { if (has_next) { nA0[i] = tabA[nxt.aux * 256 + sR[i]] + (unsigned)sC[i] * 2u; nA1[i] = tabA[nxt.aux * 256 + 128 + sR[i]] + (unsigned)sC[i] * 2u; } else { nA0[i] = vA0[i]; nA1[i] = vA1[i]; } }
        } else { nuA = has_next ? (unsigned)nxt.pm * tstep : uA;
#pragma unroll
            for (int i = 0; i < 2; ++i) { nA0[i] = vA0[i]; nA1[i] = vA1[i]; }
        }
#pragma unroll 1
        for (int t = 0; t < nt; t += 2) {
            const bool last = (t == nt - 2);
            const unsigned a1 = uA + (unsigned)(t + 1) * kstep;
            const unsigned a2 = last ? nuA : uA + (unsigned)(t + 2) * kstep; const unsigned b2 = last ? nuB : uB + (unsigned)(t + 2) * kstep;
            const unsigned a3 = a2 + kstep; const unsigned b3 = b2 + kstep;
            unsigned w0[2], w1[2];
#pragma unroll
            for (int i = 0; i < 2; ++i) { w0[i] = (GATHER && last) ? nA0[i] : vA0[i]; w1[i] = (GATHER && last) ? nA1[i] : vA1[i]; }
            PG8_LDB(B0, 0, 0); PG8_LDB(B1, 0, 1); PG8_SCHED; PG8_LDA(At, 0, 0); PG8_STAGE(PG8_SA(1, 1), baseA, a1, vA1);
            PG8_WAIT_V(8); PG8_WAIT_L(0); PG8_BAR; PG8_MMA(0, 0, At, B0); PG8_MMA(0, 1, At, B1); PG8_BAR; PG8_SCHED;
            PG8_LDA(At, 0, 1); PG8_STAGE(PG8_SB(0, 0), baseB, b2, voffB); PG8_STAGE(PG8_SB(0, 1), baseB, b2 + hstep, voffB); PG8_STAGE(PG8_SA(0, 0), baseA, a2, w0);
            PG8_WAIT_V(8); PG8_WAIT_L(0); PG8_BAR; PG8_MMA(1, 0, At, B0); PG8_MMA(1, 1, At, B1); PG8_BAR; PG8_SCHED;
            PG8_LDB(B0, 1, 0); PG8_LDB(B1, 1, 1); PG8_SCHED; PG8_LDA(At, 1, 0); PG8_STAGE(PG8_SA(0, 1), baseA, a2, w1);
            PG8_WAIT_V(8); PG8_WAIT_L(0); PG8_BAR; PG8_MMA(0, 0, At, B0); PG8_MMA(0, 1, At, B1); PG8_BAR; PG8_SCHED;
            PG8_LDA(At, 1, 1); PG8_STAGE(PG8_SB(1, 0), baseB, b3, voffB); PG8_STAGE(PG8_SB(1, 1), baseB, b3 + hstep, voffB); PG8_STAGE(PG8_SA(1, 0), baseA, a3, w0);
            PG8_WAIT_V(8); PG8_WAIT_L(0); PG8_BAR; PG8_MMA(1, 0, At, B0); PG8_MMA(1, 1, At, B1); PG8_BAR; PG8_SCHED;
        }
        if constexpr (ALIGN_EPI) { if (wr == 0) PG8_BAR; }
        E(acc, cur, wr, wc, fr, fq);
        if (!has_next) break;
#pragma unroll
        for (int a = 0; a < 2; ++a)
#pragma unroll
            for (int b = 0; b < 2; ++b)
#pragma unroll
                for (int m = 0; m < 4; ++m)
#pragma unroll
                    for (int n = 0; n < 2; ++n) acc[a][b][m][n] = (f32x4){0.f, 0.f, 0.f, 0.f};
        cur = nxt; uA = nuA; uB = nuB; ++ui;
#pragma unroll
        for (int i = 0; i < 2; ++i) { vA0[i] = nA0[i]; vA1[i] = nA1[i]; }
        if constexpr (ALIGN_EPI) { if (wr == 1) PG8_BAR; }
    }
    PG8_WAIT_V(0);
    if constexpr (!ALIGN_EPI) { if (wr == 0) PG8_BAR; }
    PG8_BAR;
#undef PG8_SA
#undef PG8_SB
#undef PG8_STAGE
#undef PG8_LDA
#undef PG8_LDB
#undef PG8_MMA
#undef PG8_WAIT_V
#undef PG8_WAIT_L
#undef PG8_BAR
#undef PG8_SCHED
}

typedef int i32x8v __attribute__((ext_vector_type(8)));
typedef int i32x4v __attribute__((ext_vector_type(4)));
template <class Epi, class Sched, bool ALIGN_EPI, bool GATHER>
__device__ __forceinline__ void gemm_phase8(PG8_LAS unsigned char* lds, const Gemm g, const Sched& S, const Epi& E, const PG8_LAS unsigned* tabA) {
    const int tid = tid_fresh(), wid = __builtin_amdgcn_readfirstlane(tid >> 6), lane = tid & 63, wr = wid >> 2, wc = wid & 3, fr = lane & 15, fq = lane >> 4;
    const int K = g.K, nt = K / BK;
    int sR[2], sC[2];
    unsigned voffB[2];
#pragma unroll
    for (int i = 0; i < 2; ++i) { int R, C; stage_rc(tid * 16 + i * 8192, R, C); sR[i] = R; sC[i] = C; const int Rb = Epi::PERM ? ((R & ~31) + perm32(R & 31)) : R;
        voffB[i] = (unsigned)(Rb * K + C) * 2u; }
    const unsigned kstep = (unsigned)(BK * 2);
    const unsigned hstep = (unsigned)(HALF * K * 2);
    const unsigned tstep = 2u * hstep;
    const unsigned ldsw = (unsigned)wid * 1024u;
    const char* const baseA = (const char*)g.A; const char* const baseB = (const char*)g.Bt;
    const int aoff = lds_byte(wr * 64 + fr, 32 * (fq >> 1) + 16 * (fq & 1)), boff = lds_byte(wc * 32 + fr, 32 * (fq >> 1) + 16 * (fq & 1));
#define PG8_SA(b, h) (((b) * 2 + (h)) * HTB)
#define PG8_SB(b, h) ((4 + (b) * 2 + (h)) * HTB)
#define PG8_STAGE(bufoff, gbase, uoff, voff) do { _Pragma("unroll") for (int _i = 0; _i < 2; ++_i) \
        __builtin_amdgcn_global_load_lds((const unsigned*)((gbase) + (size_t)(unsigned)((uoff) + (voff)[_i])), (PG8_LAS unsigned*)(lds + (bufoff) + ldsw + _i * 8192), 16, 0, 0); } while (0)
#define PG8_LD32(p) __builtin_shufflevector(*(const PG8_LAS i32x4v*)(p), *(const PG8_LAS i32x4v*)((p) + 16), 0, 1, 2, 3, 4, 5, 6, 7)
#define PG8_LDA(dst, b, h) do { _Pragma("unroll") for (int m = 0; m < 4; ++m) dst[m] = PG8_LD32(lds + PG8_SA(b, h) + aoff + m * 2048); } while (0)
#define PG8_LDB(dst, b, h) do { _Pragma("unroll") for (int n = 0; n < 2; ++n) dst[n] = PG8_LD32(lds + PG8_SB(b, h) + boff + n * 2048); } while (0)
#define PG8_MMA(ai, bj, At, Bt) do { __builtin_amdgcn_s_setprio(1); _Pragma("unroll") for (int m = 0; m < 4; ++m) _Pragma("unroll") for (int n = 0; n < 2; ++n) \
        asm volatile("v_mfma_scale_f32_16x16x128_f8f6f4 %0, %1, %2, %0, %3, %4 op_sel_hi:[0,0,0]" : "+v"(acc[ai][bj][m][n]) : "v"(Bt[n]), "v"(At[m]), "v"(scw), "v"(sca)); __builtin_amdgcn_s_setprio(0); } while (0)
#define PG8_MFMA_DRAIN asm volatile("s_nop 15\n\ts_nop 15\n\ts_nop 15" ::: "memory")
#define PG8_WAIT_V(n) asm volatile("s_waitcnt vmcnt(" #n ")" ::: "memory")
#define PG8_WAIT_L(n) asm volatile("s_waitcnt lgkmcnt(" #n ")" ::: "memory")
#define PG8_BAR __builtin_amdgcn_s_barrier()
#define PG8_SCHED __builtin_amdgcn_sched_barrier(0)
    Unit cur, nxt; int ui = 0;
    if (!S.next(0, cur)) return;
    f32x4 acc[2][2][4][2];
#pragma unroll
    for (int a = 0; a < 2; ++a)
#pragma unroll
        for (int b = 0; b < 2; ++b)
#pragma unroll
            for (int m = 0; m < 4; ++m)
#pragma unroll
                for (int n = 0; n < 2; ++n) acc[a][b][m][n] = (f32x4){0.f, 0.f, 0.f, 0.f};
    i32x8v At[4], B0[2], B1[2];
    int scw = 0x7a7a7a7a, sca = 0x7f7f7f7f;
    asm volatile("" : "+v"(scw), "+v"(sca));
    unsigned vA0[2], vA1[2], nA0[2], nA1[2];
    unsigned uA, uB = S.b_off(cur, tstep);
    if constexpr (GATHER) { uA = 0u;
#pragma unroll
        for (int i = 0; i < 2; ++i) { vA0[i] = tabA[cur.aux * 256 + sR[i]] + (unsigned)sC[i] * 2u; vA1[i] = tabA[cur.aux * 256 + 128 + sR[i]] + (unsigned)sC[i] * 2u; }
    } else { uA = (unsigned)cur.pm * tstep;
#pragma unroll
        for (int i = 0; i < 2; ++i) { vA0[i] = (unsigned)(sR[i] * K + sC[i]) * 2u; vA1[i] = vA0[i] + hstep; }
    }
    PG8_STAGE(PG8_SB(0, 0), baseB, uB, voffB); PG8_STAGE(PG8_SB(0, 1), baseB, uB + hstep, voffB); PG8_STAGE(PG8_SA(0, 0), baseA, uA, vA0); PG8_STAGE(PG8_SA(0, 1), baseA, uA, vA1);
    if (wr == 1) PG8_BAR;
    PG8_WAIT_V(2); PG8_BAR;
    PG8_STAGE(PG8_SB(1, 0), baseB, uB + kstep, voffB); PG8_STAGE(PG8_SA(1, 0), baseA, uA + kstep, vA0); PG8_STAGE(PG8_SB(1, 1), baseB, uB + hstep + kstep, voffB);
    PG8_WAIT_V(6); PG8_BAR;
    for (;;) {
        const bool has_next = S.next(ui + 1, nxt);
        unsigned nuA, nuB = has_next ? S.b_off(nxt, tstep) : uB;
        if constexpr (GATHER) { nuA = 0u;
#pragma unroll
            for (int i = 0; i < 2; ++i) { if (has_next) { nA0[i] = tabA[nxt.aux * 256 + sR[i]] + (unsigned)sC[i] * 2u; nA1[i] = tabA[nxt.aux * 256 + 128 + sR[i]] + (unsigned)sC[i] * 2u; } else { nA0[i] = vA0[i]; nA1[i] = vA1[i]; } }
        } else { nuA = has_next ? (unsigned)nxt.pm * tstep : uA;
#pragma unroll
            for (int i = 0; i < 2; ++i) { nA0[i] = vA0[i]; nA1[i] = vA1[i]; }
        }
#pragma unroll 1
        for (int t = 0; t < nt; t += 2) {
            const bool last = (t == nt - 2);
            const unsigned a1 = uA + (unsigned)(t + 1) * kstep;
            const unsigned a2 = last ? nuA : uA + (unsigned)(t + 2) * kstep; const unsigned b2 = last ? nuB : uB + (unsigned)(t + 2) * kstep;
            const unsigned a3 = a2 + kstep; const unsigned b3 = b2 + kstep;
            unsigned w0[2], w1[2];
#pragma unroll
            for (int i = 0; i < 2; ++i) { w0[i] = (GATHER && last) ? nA0[i] : vA0[i]; w1[i] = (GATHER && last) ? nA1[i] : vA1[i]; }
            PG8_LDB(B0, 0, 0); PG8_LDB(B1, 0, 1); PG8_SCHED; PG8_LDA(At, 0, 0); PG8_STAGE(PG8_SA(1, 1), baseA, a1, vA1);
            PG8_WAIT_V(8); PG8_WAIT_L(0); PG8_BAR; PG8_MMA(0, 0, At, B0); PG8_MMA(0, 1, At, B1); PG8_BAR; PG8_SCHED;
            PG8_LDA(At, 0, 1); PG8_STAGE(PG8_SB(0, 0), baseB, b2, voffB); PG8_STAGE(PG8_SB(0, 1), baseB, b2 + hstep, voffB); PG8_STAGE(PG8_SA(0, 0), baseA, a2, w0);
            PG8_WAIT_V(8); PG8_WAIT_L(0); PG8_BAR; PG8_MMA(1, 0, At, B0); PG8_MMA(1, 1, At, B1); PG8_BAR; PG8_SCHED;
            PG8_LDB(B0, 1, 0); PG8_LDB(B1, 1, 1); PG8_SCHED; PG8_LDA(At, 1, 0); PG8_STAGE(PG8_SA(0, 1), baseA, a2, w1);
            PG8_WAIT_V(8); PG8_WAIT_L(0); PG8_BAR; PG8_MMA(0, 0, At, B0); PG8_MMA(0, 1, At, B1); PG8_BAR; PG8_SCHED;
            PG8_LDA(At, 1, 1); PG8_STAGE(PG8_SB(1, 0), baseB, b3, voffB); PG8_STAGE(PG8_SB(1, 1), baseB, b3 + hstep, voffB); PG8_STAGE(PG8_SA(1, 0), baseA, a3, w0);
            PG8_WAIT_V(8); PG8_WAIT_L(0); PG8_BAR; PG8_MMA(1, 0, At, B0); PG8_MMA(1, 1, At, B1); PG8_BAR; PG8_SCHED;
        }
        if constexpr (ALIGN_EPI) { if (wr == 0) PG8_BAR; }
        PG8_MFMA_DRAIN;
        { const int l2 = tid_fresh() & 63; E(acc, cur, wr, wc, l2 & 15, l2 >> 4); }
        if (!has_next) break;
#pragma unroll
        for (int a = 0; a < 2; ++a)
#pragma unroll
            for (int b = 0; b < 2; ++b)
#pragma unroll
                for (int m = 0; m < 4; ++m)
#pragma unroll
                    for (int n = 0; n < 2; ++n) acc[a][b][m][n] = (f32x4){0.f, 0.f, 0.f, 0.f};
        cur = nxt; uA = nuA; uB = nuB; ++ui;
#pragma unroll
        for (int i = 0; i < 2; ++i) { vA0[i] = nA0[i]; vA1[i] = nA1[i]; }
        if constexpr (ALIGN_EPI) { if (wr == 1) PG8_BAR; }
    }
    PG8_WAIT_V(0);
    if constexpr (!ALIGN_EPI) { if (wr == 0) PG8_BAR; }
    PG8_BAR;
#undef PG8_SA
#undef PG8_SB
#undef PG8_STAGE
#undef PG8_LDA
#undef PG8_LD32
#undef PG8_LDB
#undef PG8_MMA
#undef PG8_MFMA_DRAIN
#undef PG8_WAIT_V
#undef PG8_WAIT_L
#undef PG8_BAR
#undef PG8_SCHED
}

__device__ __forceinline__ unsigned cvt_pk_bf16(float lo, float hi) { return pk2(lo, hi); }

struct EpiBf16 {
    static constexpr bool PERM = true;
    bf16* O; int ldc;
    __device__ __forceinline__ void operator()(const f32x4 (&acc)[2][2][4][2], const Unit& u, int wr, int wc, int fr, int fq) const {
        const int row0 = u.pm * BM + wr * 64 + fr; const int col0 = u.pn * BM + wc * 32 + 8 * fq;
#pragma unroll
        for (int ai = 0; ai < 2; ++ai)
#pragma unroll
            for (int m = 0; m < 4; ++m) { bf16* rowp = O + (size_t)(row0 + ai * HALF + m * 16) * ldc + col0;
#pragma unroll
                for (int bj = 0; bj < 2; ++bj) { const f32x4 v0 = acc[ai][bj][m][0], v1 = acc[ai][bj][m][1];
                    u32x4 w; w.x = cvt_pk_bf16(v0[0], v0[1]); w.y = cvt_pk_bf16(v0[2], v0[3]); w.z = cvt_pk_bf16(v1[0], v1[1]); w.w = cvt_pk_bf16(v1[2], v1[3]);
                    *(u32x4*)(rowp + bj * HALF) = w; } }
    }
};
struct EpiResid {
    static constexpr bool PERM = false;
    const float* xl; const float* xc; float* out; const float* gate;
    __device__ __forceinline__ void operator()(const f32x4 (&acc)[2][2][4][2], const Unit& u, int wr, int wc, int fr, int fq) const {
        const int rt = u.pm * BM; const bool isl = rt < NLAT;
        const float* base = isl ? xl + (size_t)rt * D : xc + (size_t)(rt - NLAT) * D;
        const float* gp = gate + (size_t)(isl ? (rt >> 12) : 8) * 12288;
        const int rl0 = wr * 64 + fr, col0 = u.pn * BM + wc * 32 + 4 * fq;
#pragma unroll
        for (int ai = 0; ai < 2; ++ai)
#pragma unroll
            for (int m = 0; m < 4; ++m) { const int rl = rl0 + ai * HALF + m * 16; const float* bp = base + (size_t)rl * D + col0; float* op = out + (size_t)(rt + rl) * D + col0;
#pragma unroll
                for (int bj = 0; bj < 2; ++bj)
#pragma unroll
                    for (int n = 0; n < 2; ++n) { const f32x4 b = *(const f32x4*)(bp + bj * HALF + n * 16); const f32x4 gv = *(const f32x4*)(gp + col0 + bj * HALF + n * 16); *(f32x4*)(op + bj * HALF + n * 16) = b + gv * acc[ai][bj][m][n]; }
                asm volatile("" ::: "memory"); }
    }
};
struct EpiSwiglu {
    static constexpr bool PERM = true;
    unsigned char* O;
    __device__ __forceinline__ void operator()(const f32x4 (&acc)[2][2][4][2], const Unit& u, int wr, int wc, int fr, int fq) const {
        const int row0 = u.pm * BM + wr * 64 + fr; const int col0 = u.pn * 128 + wc * 32 + 8 * fq;
#pragma unroll
        for (int ai = 0; ai < 2; ++ai)
#pragma unroll
            for (int m = 0; m < 4; ++m) { unsigned char* rowp = O + (size_t)(row0 + ai * HALF + m * 16) * DE + col0;
                float o[8];
#pragma unroll
                for (int n = 0; n < 2; ++n)
#pragma unroll
                    for (int j = 0; j < 4; ++j) { const float gt = acc[ai][0][m][n][j], up = acc[ai][1][m][n][j]; o[n * 4 + j] = gt * __builtin_amdgcn_rcpf(1.0f + __expf(-gt)) * up; }
                u32x2 w; w.x = pk4_fp8(o[0], o[1], o[2], o[3]); w.y = pk4_fp8(o[4], o[5], o[6], o[7]);
                *(u32x2*)rowp = w; }
    }
};
struct EpiDown {
    static constexpr bool PERM = true;
    unsigned char* YK; const PG8_LAS unsigned* tab; const PG8_LAS float* tabw;
    __device__ __forceinline__ void operator()(const f32x4 (&acc)[2][2][4][2], const Unit& u, int wr, int wc, int fr, int fq) const {
        const int rl0 = wr * 64 + fr; const int col0 = u.pn * BM + wc * 32 + 8 * fq;
#pragma unroll
        for (int ai = 0; ai < 2; ++ai)
#pragma unroll
            for (int m = 0; m < 4; ++m) { const int rl = rl0 + ai * HALF + m * 16; const unsigned ent = tab[u.aux * 256 + rl]; const float w = tabw[u.aux * 256 + rl];
                if (!(ent & 0x40000000u)) { unsigned char* rowp = YK + ((size_t)(ent >> 31) * MALL + (ent & 0xffffu)) * D + col0;
#pragma unroll
                    for (int bj = 0; bj < 2; ++bj) { const f32x4 v0 = acc[ai][bj][m][0] * w, v1 = acc[ai][bj][m][1] * w;
                        u32x2 q; q.x = pk4_fp8(v0[0], v0[1], v0[2], v0[3]); q.y = pk4_fp8(v1[0], v1[1], v1[2], v1[3]);
                        *(u32x2*)(rowp + bj * HALF) = q; } }
                asm volatile("" ::: "memory"); }
    }
};
}

struct Args { const float* in[31]; float* out; unsigned char* ws; int ph_lo, ph_hi; };
typedef const __attribute__((address_space(4))) Args* KArgs;
__device__ __forceinline__ KArgs kargs() { KArgs p = (KArgs)__builtin_amdgcn_kernarg_segment_ptr(); asm volatile("" : "+s"(p)); return p; }
#define AIN(i) (a->in[i])
enum { I_X = 0, I_C, I_CTX, I_CCTX, I_ADAW, I_ADAB, I_N1G, I_N2G, I_WIN, I_WOUT, I_GNG, I_GWS, I_GB, I_LB, I_HNG, I_MU, I_W0, I_WUP, I_A0, I_AUP, I_GUP, I_KK, I_KA, I_RK, I_GNGG, I_GNB, I_RW, I_RB, I_WGU, I_WDN, I_FNG };

__device__ __forceinline__ void p0_transpose_item(const float* W, int K, int N, bf16* WT, int n_row0, LAS float* scr, int kb, int nb, int lane) {
    const int k0 = 64 * kb, n0 = 32 * nb;
#pragma unroll 8
    for (int i = 0; i < 32; ++i) { const int kk = 2 * i + (lane >> 5); scr[kk * 33 + (lane & 31)] = W[(size_t)(k0 + kk) * N + n0 + (lane & 31)]; }
    asm volatile("s_waitcnt lgkmcnt(0)" ::: "memory");
    const int c = lane & 7;
#pragma unroll
    for (int j = 0; j < 4; ++j) { const int n = (lane >> 3) + 8 * j; const LAS float* s = scr + (8 * c) * 33 + n;
        u32x4 o; o.x = pk2(s[0 * 33], s[1 * 33]); o.y = pk2(s[2 * 33], s[3 * 33]); o.z = pk2(s[4 * 33], s[5 * 33]); o.w = pk2(s[6 * 33], s[7 * 33]);
        *(u32x4*)(WT + (size_t)(n_row0 + n) * K + k0 + 8 * c) = o; }
    asm volatile("s_waitcnt lgkmcnt(0)" ::: "memory");
}

__device__ __forceinline__ void p0_transpose_item8(const float* W, int K, int N, unsigned char* WT, int n_row0, LAS float* scr, int kb, int nb, int lane) {
    const int k0 = 64 * kb, n0 = 32 * nb;
    { const int c4 = (lane & 7) * 4;
      f32x4 t[8];
#pragma unroll
      for (int i = 0; i < 8; ++i) t[i] = *(const f32x4*)(W + (size_t)(k0 + 8 * i + (lane >> 3)) * N + n0 + c4);
#pragma unroll
      for (int i = 0; i < 8; ++i) { LAS float* d = scr + (8 * i + (lane >> 3)) * 33 + c4; d[0] = t[i][0]; d[1] = t[i][1]; d[2] = t[i][2]; d[3] = t[i][3]; } }
    asm volatile("s_waitcnt lgkmcnt(0)" ::: "memory");
    const int c = lane & 7;
#pragma unroll
    for (int j = 0; j < 4; ++j) { const int n = (lane >> 3) + 8 * j; const LAS float* sp = scr + (8 * c) * 33 + n;
        u32x2 o; o.x = pk4_fp8(sp[0 * 33] * 32.f, sp[1 * 33] * 32.f, sp[2 * 33] * 32.f, sp[3 * 33] * 32.f); o.y = pk4_fp8(sp[4 * 33] * 32.f, sp[5 * 33] * 32.f, sp[6 * 33] * 32.f, sp[7 * 33] * 32.f);
        *(u32x2*)(WT + (size_t)(n_row0 + n) * K + k0 + 8 * c) = o; }
    asm volatile("s_waitcnt lgkmcnt(0)" ::: "memory");
}
__device__ __forceinline__ void convert_moe(KArgs a, int l, LAS unsigned char* lds) {
    const int tid = tid_fresh(), lane = tid & 63, wave = tid >> 6;
    const int gw = blockIdx.x * 8 + wave, NGW = gridDim.x * 8;
    unsigned char* ws = a->ws;
    LAS float* scr = (LAS float*)(lds + wave * 16384);
    constexpr int I_GU = 32 * 64, I_DN = 16 * 64, N2 = 16 * I_GU, N3 = N2 + 16 * I_DN;
    for (int it = gw; it < N3; it += NGW) {
        if (it < N2) { const int e = it / I_GU, r = it % I_GU, kb = r / 64, nb = r % 64;
            const int n0 = 32 * nb, hh = n0 >> 10, nn = n0 & 1023, row0 = 256 * (nn >> 7) + 128 * hh + (nn & 127);
            p0_transpose_item8(a->in[I_WGU] + (size_t)(l * NE + e) * D * 2048, D, 2048, ws + WS_WGU + (size_t)e * 2048 * D, row0, scr, kb, nb, lane); }
        else { const int q = it - N2, e = q / I_DN, r = q % I_DN, kb = r / 64, nb = r % 64;
            p0_transpose_item8(a->in[I_WDN] + (size_t)(l * NE + e) * DE * D, DE, D, ws + WS_WDN + (size_t)e * D * DE, 32 * nb, scr, kb, nb, lane); }
    }
}
__device__ __forceinline__ void phase_prologue(KArgs a, LAS unsigned char* lds) {
    const int tid = tid_fresh(), lane = tid & 63, wave = tid >> 6;
    const int G = gridDim.x, gw = blockIdx.x * 8 + wave, NGW = G * 8;
    unsigned char* ws = a->ws;
    LAS float* scr = (LAS float*)(lds + wave * 16384);
    constexpr int I_IN = 32 * 232, I_OUT = 32 * 64;
    constexpr int N0 = 2 * I_IN, N1 = N0 + 2 * I_OUT;
    for (int it = gw; it < N1; it += NGW) {
        if (it < N0) { const int l = it / I_IN, r = it % I_IN, kb = r / 232, nb = r % 232;
            p0_transpose_item8(a->in[I_WIN] + (size_t)l * D * INC, D, INC, ws + WS_WIN + (size_t)l * INC * D, 32 * nb, scr, kb, nb, lane); }
        else { const int q = it - N0, l = q / I_OUT, r = q % I_OUT, kb = r / 64, nb = r % 64;
            p0_transpose_item8(a->in[I_WOUT] + (size_t)l * D * D, D, D, ws + WS_WOUT + (size_t)l * D * D, 32 * nb, scr, kb, nb, lane); }
    }
    convert_moe(a, 0, lds);
    {
        const int gt = blockIdx.x * NTHREADS + tid, NGT = G * NTHREADS;
        bf16* wup = (bf16*)(ws + WS_SMALLW + SW_WUP); bf16* aup = (bf16*)(ws + WS_SMALLW + SW_AUP); bf16* gup = (bf16*)(ws + WS_SMALLW + SW_GUP); bf16* gws = (bf16*)(ws + WS_SMALLW + SW_GWS);
        for (int i = gt; i < 2 * 2 * 768 * 64; i += NGT) { const int k = i & 63, n = (i >> 6) % 768, ld = i / (768 * 64); wup[i] = (bf16)f2bf(a->in[I_WUP][((size_t)ld * 64 + k) * 768 + n]); }
        for (int i = gt; i < 2 * 768 * 64; i += NGT) { const int k = i & 63, n = (i >> 6) % 768, l = i / (768 * 64); aup[i] = (bf16)f2bf(a->in[I_AUP][((size_t)l * 64 + k) * 768 + n]); }
        for (int i = gt; i < 2 * 768 * 128; i += NGT) { const int k = i & 127, n = (i >> 7) % 768, l = i / (768 * 128); gup[i] = (bf16)f2bf(a->in[I_GUP][((size_t)l * 128 + k) * 768 + n]); }
        for (int i = gt; i < 2 * 4 * 128 * 128; i += NGT) gws[i] = (bf16)f2bf(a->in[I_GWS][i]);
    }
    __syncthreads();
    {
        LAS float* sv = (LAS float*)lds;
        LAS float* red = (LAS float*)(lds + 73728);
        for (int i = tid; i < 9 * D; i += NTHREADS) { const int r = i / D, k = i % D; const float v = r < 8 ? a->in[I_C][r * D + k] : a->in[I_CCTX][k]; sv[i] = siluf_(v); }
        __syncthreads();
        float* mod = (float*)(ws + WS_MOD);
        for (int it = blockIdx.x; it < 2 * 96; it += G) {
            const int l = it / 96, cb = it % 96, cq = tid & 31, kg = tid >> 5;
            const float* wp = a->in[I_ADAW] + (size_t)l * D * 12288 + (size_t)(kg * 128) * 12288 + cb * 128 + cq * 4;
            f32x4 acc[9];
#pragma unroll
            for (int r = 0; r < 9; ++r) acc[r] = (f32x4){0.f, 0.f, 0.f, 0.f};
#pragma unroll 4
            for (int k = 0; k < 128; ++k) { const f32x4 w = *(const f32x4*)(wp + (size_t)k * 12288);
#pragma unroll
                for (int r = 0; r < 9; ++r) acc[r] += w * sv[r * D + kg * 128 + k]; }
#pragma unroll
            for (int r = 0; r < 9; ++r) *(LAS f32x4*)(red + ((kg * 9 + r) * 128 + cq * 4)) = acc[r];
            __syncthreads();
            for (int o = tid; o < 9 * 128; o += NTHREADS) { const int r = o / 128, c = o % 128; float s = a->in[I_ADAB][(size_t)l * 12288 + cb * 128 + c];
#pragma unroll
                for (int q = 0; q < 16; ++q) s += red[(q * 9 + r) * 128 + c];
                mod[((size_t)l * 9 + r) * 12288 + cb * 128 + c] = s; }
            __syncthreads();
        }
    }
}

template <int MODE>
__device__ __forceinline__ void phase_norm1(KArgs a, int l, bool dry) {
    const int tid_ = tid_fresh(); const int lane = tid_ & 63, wave = tid_ >> 6, gw = blockIdx.x * 8 + wave, NGW = gridDim.x * 8;
    unsigned char* ws = a->ws;
    const float* mod = (const float*)(ws + WS_MOD);
    float* X = (float*)(ws + WS_X); bf16* H = (bf16*)(ws + WS_H); const bf16* YK = (const bf16*)(ws + WS_YK);
    float* Xo = dry ? (float*)(ws + WS_END) : X; bf16* Ho = dry ? (bf16*)(ws + WS_END) : H; float* Oo = dry ? (float*)(ws + WS_END) : a->out;
    const int nrows = (MODE == 2) ? NLAT : MALL;
    const int rpw = (nrows + NGW - 1) / NGW; const int r0 = gw * rpw, r1 = (r0 + rpw < nrows) ? r0 + rpw : nrows;
    f32x4 ck[8], cs[8], cg[8]; int cur_mr = -1;
    for (int row = r0; row < r1; ++row) {
        const int mr = modrow_of(row); const int orow = dry ? (row & 2047) : row;
        if (mr != cur_mr) { cur_mr = mr;
#pragma unroll
            for (int j = 0; j < 8; ++j) { const int c = 4 * lane + 256 * j;
                if (MODE == 2) ck[j] = *(const f32x4*)(a->in[I_FNG] + c);
                else { const float* m = mod + ((size_t)l * 9 + mr) * 12288; const f32x4 g = *(const f32x4*)(a->in[I_N1G] + (size_t)l * D + c); ck[j] = g * (*(const f32x4*)(m + D + c) + 1.0f); cs[j] = *(const f32x4*)(m + c); }
                if (MODE != 0) cg[j] = *(const f32x4*)(mod + ((size_t)(l - 1) * 9 + mr) * 12288 + 5 * D + c); } }
        f32x4 v[8];
        if (MODE == 0) { const float* xr = row < NLAT ? a->in[I_X] + (size_t)row * D : a->in[I_CTX] + (size_t)(row - NLAT) * D;
#pragma unroll
            for (int j = 0; j < 8; ++j) v[j] = *(const f32x4*)(xr + 4 * lane + 256 * j);
        } else {
            const float* xr = X + (size_t)row * D; const unsigned char* y0 = (const unsigned char*)YK + (size_t)row * D; const unsigned char* y1 = (const unsigned char*)YK + ((size_t)MALL + row) * D;
            unsigned p0[8], p1[8];
#pragma unroll
            for (int j = 0; j < 8; ++j) { const int c = 4 * lane + 256 * j; v[j] = *(const f32x4*)(xr + c); p0[j] = *(const unsigned*)(y0 + c); p1[j] = *(const unsigned*)(y1 + c); }
#pragma unroll
            for (int j = 0; j < 8; ++j) { const f32x2 a0 = __builtin_amdgcn_cvt_pk_f32_fp8((int)p0[j], false), a1 = __builtin_amdgcn_cvt_pk_f32_fp8((int)p0[j], true), b0 = __builtin_amdgcn_cvt_pk_f32_fp8((int)p1[j], false), b1 = __builtin_amdgcn_cvt_pk_f32_fp8((int)p1[j], true);
                f32x4 f; f[0] = a0[0] + b0[0]; f[1] = a0[1] + b0[1]; f[2] = a1[0] + b1[0]; f[3] = a1[1] + b1[1];
                v[j] = v[j] + cg[j] * f; }
            if (MODE == 1) {
#pragma unroll
                for (int j = 0; j < 8; ++j) *(f32x4*)(Xo + (size_t)orow * D + 4 * lane + 256 * j) = v[j];
            }
        }
        float ss = 0.f;
#pragma unroll
        for (int j = 0; j < 8; ++j) ss += (v[j][0] * v[j][0] + v[j][1] * v[j][1]) + (v[j][2] * v[j][2] + v[j][3] * v[j][3]);
        const float rstd = 1.0f / sqrtf(wave_sum(ss) * (1.0f / D) + NORM_EPS);
        if (MODE == 2) {
#pragma unroll
            for (int j = 0; j < 8; ++j) *(f32x4*)(Oo + (size_t)orow * D + 4 * lane + 256 * j) = v[j] * rstd * ck[j];
        } else {
#pragma unroll
            for (int j = 0; j < 8; ++j) { const f32x4 h = v[j] * rstd * ck[j] + cs[j]; *(unsigned*)((unsigned char*)Ho + (size_t)orow * D + 4 * lane + 256 * j) = pk4_fp8(h[0], h[1], h[2], h[3]); }
        }
    }
}

__device__ __forceinline__ void phase_norm2_router(KArgs a, int l, bool dry, LAS unsigned char* lds) {
    const int tid_ = tid_fresh(); const int lane = tid_ & 63, wave = tid_ >> 6, gw = blockIdx.x * 8 + wave, NGW = gridDim.x * 8;
    unsigned char* ws = a->ws;
    const float* mod = (const float*)(ws + WS_MOD);
    const float* X = (const float*)(ws + WS_X); bf16* H = (bf16*)(ws + WS_H);
    unsigned* cnt = (unsigned*)(ws + WS_CTL) + CW_CNT + l * 16 * 64 + (dry ? 4096 : 0);
    unsigned* ridx = (unsigned*)(ws + (dry ? WS_END : WS_RIDX)); float* rwt = (float*)(ws + (dry ? WS_END + 4 * MiB : WS_RW)); bf16* Ho = dry ? (bf16*)(ws + WS_END + 8 * MiB) : H;
    const int nrows = (l == DEPTH - 1) ? NLAT : MALL;
    LAS f32x4* rwl = (LAS f32x4*)lds;
    { const float* rw = a->in[I_RW];
      for (int idx = tid_; idx < 8192; idx += NTHREADS) { const int ln = idx & 63, q = (idx >> 6) & 3, i = (idx >> 8) & 3, j = idx >> 10; rwl[idx] = *(const f32x4*)(rw + (size_t)(4 * ln + 256 * j + i) * 16 + 4 * q); } }
    __syncthreads();
    const int rpw = (nrows + NGW - 1) / NGW; const int r0 = gw * rpw, r1 = (r0 + rpw < nrows) ? r0 + rpw : nrows;
    f32x4 ck[8]; int cur_mr = -1;
    const float* rbp = a->in[I_RB];
    for (int row = r0; row < r1; ++row) {
        const int mr = modrow_of(row); const int orow = dry ? (row & 2047) : row;
        if (mr != cur_mr) { cur_mr = mr; const float* m = mod + ((size_t)l * 9 + mr) * 12288;
#pragma unroll
            for (int j = 0; j < 8; ++j) { const int c = 4 * lane + 256 * j; const f32x4 g = *(const f32x4*)(a->in[I_N2G] + (size_t)l * D + c); ck[j] = g * (*(const f32x4*)(m + 4 * D + c) + 1.0f); } }
        const float* shp = mod + ((size_t)l * 9 + mr) * 12288 + 3 * D;
        const float* xr = X + (size_t)row * D;
        f32x4 v[8]; float ss = 0.f;
#pragma unroll
        for (int j = 0; j < 8; ++j) { v[j] = *(const f32x4*)(xr + 4 * lane + 256 * j); ss += (v[j][0] * v[j][0] + v[j][1] * v[j][1]) + (v[j][2] * v[j][2] + v[j][3] * v[j][3]); }
        const float rstd = 1.0f / sqrtf(wave_sum(ss) * (1.0f / D) + NORM_EPS);
        f32x4 lg4[4];
#pragma unroll
        for (int q = 0; q < 4; ++q) lg4[q] = (f32x4){0.f, 0.f, 0.f, 0.f};
#pragma unroll
        for (int j = 0; j < 8; ++j) { const f32x4 h = v[j] * rstd * ck[j] + *(const f32x4*)(shp + 4 * lane + 256 * j); *(unsigned*)((unsigned char*)Ho + (size_t)orow * D + 4 * lane + 256 * j) = pk4_fp8(h[0], h[1], h[2], h[3]);
#pragma unroll
            for (int i = 0; i < 4; ++i)
#pragma unroll
                for (int q = 0; q < 4; ++q) lg4[q] += rwl[((j * 4 + i) * 4 + q) * 64 + lane] * h[i];
            asm volatile("" ::: "memory"); }
        float lg[16];
        { float t8[8], t4[4], t2[2], t1;
          const bool b5 = lane & 32, b4 = lane & 16, b3 = lane & 8, b2 = lane & 4;
#pragma unroll
          for (int i = 0; i < 8; ++i) { const float keep = b5 ? lg4[(i + 8) >> 2][(i + 8) & 3] : lg4[i >> 2][i & 3], send = b5 ? lg4[i >> 2][i & 3] : lg4[(i + 8) >> 2][(i + 8) & 3]; t8[i] = keep + __shfl_xor(send, 32); }
#pragma unroll
          for (int i = 0; i < 4; ++i) { const float keep = b4 ? t8[i + 4] : t8[i], send = b4 ? t8[i] : t8[i + 4]; t4[i] = keep + __shfl_xor(send, 16); }
#pragma unroll
          for (int i = 0; i < 2; ++i) { const float keep = b3 ? t4[i + 2] : t4[i], send = b3 ? t4[i] : t4[i + 2]; t2[i] = keep + __shfl_xor(send, 8); }
          { const float keep = b2 ? t2[1] : t2[0], send = b2 ? t2[0] : t2[1]; t1 = keep + __shfl_xor(send, 4); }
          t1 += __shfl_xor(t1, 2); t1 += __shfl_xor(t1, 1);
#pragma unroll
          for (int e = 0; e < 16; ++e) { const int src = ((e >> 3) & 1) * 32 + ((e >> 2) & 1) * 16 + ((e >> 1) & 1) * 8 + (e & 1) * 4; lg[e] = __builtin_bit_cast(float, __builtin_amdgcn_readlane(__builtin_bit_cast(int, t1), src)) + rbp[e]; } }
        float mx = lg[0];
#pragma unroll
        for (int e = 1; e < 16; ++e) mx = fmaxf(mx, lg[e]);
        float p[16], sum = 0.f;
#pragma unroll
        for (int e = 0; e < 16; ++e) { p[e] = __expf(lg[e] - mx); sum += p[e]; }
        const float inv = 1.0f / sum;
#pragma unroll
        for (int e = 0; e < 16; ++e) p[e] *= inv;
        int sel = 0; float best = -1.f;
#pragma unroll
        for (int gI = 0; gI < 4; ++gI) { float m1 = -1.f, m2 = -1.f;
#pragma unroll
            for (int i = 0; i < 4; ++i) { const float q = p[4 * gI + i]; if (q > m1) { m2 = m1; m1 = q; } else if (q > m2) m2 = q; }
            const float s = m1 + m2; if (s > best) { best = s; sel = gI; } }
        int i1 = 0, i2 = 0; float p1 = -2.f, p2 = -2.f;
#pragma unroll
        for (int gI = 0; gI < 4; ++gI)
#pragma unroll
            for (int i = 0; i < 4; ++i) { const float q = (gI == sel) ? p[4 * gI + i] : -1.0f; const int e = 4 * gI + i;
                if (gI == sel) { if (q > p1) { p2 = p1; i2 = i1; p1 = q; i1 = e; } else if (q > p2) { p2 = q; i2 = e; } } }
        const float wsum = p1 + p2, w1 = p1 / wsum, w2 = p2 / wsum;
        if (lane == 0) {
            const unsigned q1 = atomicAdd(cnt + i1 * 64, 1u); ridx[(size_t)i1 * MALL + q1] = (unsigned)row; rwt[(size_t)i1 * MALL + q1] = w1;
            const unsigned q2 = atomicAdd(cnt + i2 * 64, 1u); ridx[(size_t)i2 * MALL + q2] = (unsigned)row | 0x80000000u; rwt[(size_t)i2 * MALL + q2] = w2;
        }
    }
    __syncthreads();
}

template <bool FOR_DOWN>
__device__ __forceinline__ void moe_tables(KArgs a, int l, LAS unsigned char* lds, int cvirt) {
    const int tid = tid_fresh(), G = gridDim.x;
    unsigned char* ws = a->ws;
    const unsigned* cnt = (const unsigned*)(ws + WS_CTL) + CW_CNT + l * 16 * 64;
    const unsigned* ridx = (const unsigned*)(ws + WS_RIDX); const float* rwt = (const float*)(ws + WS_RW);
    LAS int* tp = (LAS int*)(lds + LDS_TP); LAS unsigned* tab = (LAS unsigned*)(lds + LDS_TAB); LAS float* tabw = (LAS float*)(lds + LDS_TABW);
    if (tid == 0) { int acc = 0; for (int e = 0; e < 16; ++e) { tp[e] = acc; acc += (int)((cnt[e * 64] + 255u) >> 8); } tp[16] = acc; }
    __syncthreads();
    const int ntot = tp[16] * 8;
    for (int i = 0; i < 9; ++i) { const int L = i * G + cvirt; if (L >= ntot) break;
        const int tile = L >> 3; int e = 0;
        for (int j = 1; j < 16; ++j) e += (tile >= tp[j]) ? 1 : 0;
        const int pos0 = (tile - tp[e]) * 256; const unsigned ce = cnt[e * 64];
        if (tid < 256) { const int pos = pos0 + tid; const bool valid = (unsigned)pos < ce; const unsigned ent = ridx[(size_t)e * MALL + (valid ? pos : 0)];
            if (FOR_DOWN) { tab[i * 256 + tid] = valid ? ent : (ent | 0x40000000u); tabw[i * 256 + tid] = valid ? rwt[(size_t)e * MALL + pos] : 0.f; }
            else tab[i * 256 + tid] = (ent & 0xffffu) * (unsigned)D; }
    }
    __syncthreads();
}

__device__ __forceinline__ void gmlp_item(KArgs a, int l, int item, LAS unsigned char* lds) {
    const int tid = tid_fresh(), lane = tid & 63, wave = tid >> 6;
    unsigned char* ws = a->ws;
    const bf16* P = (const bf16*)(ws + WS_P); bf16* Y = (bf16*)(ws + WS_Y);
    const int chunk = item >> 2, h = item & 3;
    const int row0 = chunk < 256 ? chunk * 128 : NLAT + (chunk - 256) * 128;
    LAS bf16* wsl = (LAS bf16*)lds;
    LAS bf16* vT = (LAS bf16*)(lds + 128 * 136 * 2);
    const bf16* gws = (const bf16*)(ws + WS_SMALLW + SW_GWS) + ((size_t)l * 4 + h) * 128 * 128;
    for (int p = tid; p < 2048; p += NTHREADS) { const int t = p >> 4, c8 = p & 15; *(LAS u32x4*)(wsl + t * 136 + c8 * 8) = *(const u32x4*)(gws + t * 128 + c8 * 8); }
    {
        const int s = tid >> 2, qd = tid & 3; const bf16* vp = P + (size_t)(row0 + s) * INC + OFF_V + h * 128 + qd * 32;
        float g[32]; float ss = 0.f;
#pragma unroll
        for (int q = 0; q < 4; ++q) { float f[8]; unpack8(*(const u32x4*)(vp + 8 * q), f);
#pragma unroll
            for (int j = 0; j < 8; ++j) { const float x = geluf_(f[j]); g[8 * q + j] = x; ss += x * x; } }
        ss += __shfl_xor(ss, 1); ss += __shfl_xor(ss, 2);
        const float rstd = 1.0f / sqrtf(ss * (1.0f / 128.0f) + NORM_EPS);
        const float* ng = a->in[I_GNG] + (size_t)l * 512 + h * 128 + qd * 32;
#pragma unroll
        for (int j = 0; j < 32; ++j) vT[(qd * 32 + j) * 136 + s] = (bf16)f2bf(g[j] * rstd * ng[j]);
    }
    __syncthreads();
    f32x4 acc[8];
#pragma unroll
    for (int ct = 0; ct < 8; ++ct) acc[ct] = (f32x4){0.f, 0.f, 0.f, 0.f};
    const int fr = lane & 15, fq = lane >> 4;
#pragma unroll
    for (int ks = 0; ks < 4; ++ks) {
        const bf16x8 bfrag = *(const LAS bf16x8*)(wsl + (16 * wave + fr) * 136 + ks * 32 + fq * 8);
#pragma unroll
        for (int ct = 0; ct < 8; ++ct) { const bf16x8 afrag = *(const LAS bf16x8*)(vT + (16 * ct + fr) * 136 + ks * 32 + fq * 8);
            acc[ct] = __builtin_amdgcn_mfma_f32_16x16x32_bf16(afrag, bfrag, acc[ct], 0, 0, 0); }
    }
    const int t = 16 * wave + fr; const float wb = a->in[I_GB][((size_t)l * 4 + h) * 128 + t];
    const bf16* up = P + (size_t)(row0 + t) * INC + OFF_U + h * 128; unsigned char* yp = a->ws + WS_Y8 + (size_t)(row0 + t) * D + h * 128;
#pragma unroll
    for (int ct = 0; ct < 8; ++ct) { const int c = 16 * ct + 4 * fq; const u32x2 uu = *(const u32x2*)(up + c);
        const float y0 = geluf_(bflo(uu.x)) * (acc[ct][0] + wb), y1 = geluf_(bfhi(uu.x)) * (acc[ct][1] + wb), y2 = geluf_(bflo(uu.y)) * (acc[ct][2] + wb), y3 = geluf_(bfhi(uu.y)) * (acc[ct][3] + wb);
        *(unsigned*)(yp + c) = pk4_fp8(y0, y1, y2, y3); }
    __syncthreads();
}

constexpr int SP_ = 72;
__device__ __forceinline__ int kperm_pos(int k) { const int s5 = k & 31; return (k & 32) + 8 * ((s5 >> 2) & 3) + 4 * (s5 >> 4) + (s5 & 3); }
__device__ __forceinline__ void rwkv_prep_item(KArgs a, int l, int tile, int hgrp, LAS unsigned char* lds) {
    const int tid = tid_fresh(), lane = tid & 63, wave = tid >> 6;
    unsigned char* ws = a->ws;
    const bf16* P = (const bf16*)(ws + WS_P); bf16* Y = (bf16*)(ws + WS_Y);
    LAS bf16* SR = (LAS bf16*)lds; LAS bf16* SK = SR + 64 * SP_; LAS bf16* SV = SK + 64 * SP_; LAS bf16* SKK = SV + 64 * SP_; LAS bf16* SB = SKK + 64 * SP_; LAS bf16* SWF = SB + 64 * SP_; LAS bf16* SWB = SWF + 64 * SP_;
    LAS bf16* tw = SWB + 64 * SP_;
    LAS bf16* adl = tw + 64 * SP_;
    LAS bf16* sg = adl + 64 * SP_;
    LAS float* invn = (LAS float*)(sg + 64 * 136);
    LAS unsigned char* wpriv = (LAS unsigned char*)(invn + 64) + wave * 6144;
    const int row0 = tile * 64; const bool isl = row0 < NLAT;
    const float* mu = a->in[I_MU] + (size_t)l * CCOLS;
    const char* Pb = (const char*)P;
    auto shift_group = [&](int tk, int col, float (&z)[8]) {
        const int row = row0 + tk; int o0, o1, o2, o3; bool v0, v1, v2, v3;
        if (isl) { const int gr = (row >> 6) & 63; o0 = -1; o1 = 1; o2 = -64; o3 = 64; v0 = tk > 0; v1 = tk < 63; v2 = gr > 0; v3 = gr < 63; }
        else { const int tc = (row - NLAT) & 255; o0 = -1; o1 = 1; o2 = -1; o3 = 1; v0 = tc > 0; v1 = tc < 255; v2 = v0; v3 = v1; }
        const unsigned off = (unsigned)row * (unsigned)(INC * 2) + (unsigned)(OFF_C + col) * 2u;
        const u32x4 uo = *(const u32x4*)(Pb + off), u0 = *(const u32x4*)(Pb + (off + (unsigned)((v0 ? o0 : 0) * INC * 2))), u1 = *(const u32x4*)(Pb + (off + (unsigned)((v1 ? o1 : 0) * INC * 2))),
                    u2 = *(const u32x4*)(Pb + (off + (unsigned)((v2 ? o2 : 0) * INC * 2))), u3 = *(const u32x4*)(Pb + (off + (unsigned)((v3 ? o3 : 0) * INC * 2)));
        const f32x4 m0 = *(const f32x4*)(mu + col), m1 = *(const f32x4*)(mu + col + 4);
        float own[8], n0[8], n1[8], n2[8], n3[8]; unpack8(uo, own); unpack8(u0, n0); unpack8(u1, n1); unpack8(u2, n2); unpack8(u3, n3);
        const float f0 = v0 ? 1.f : 0.f, f1 = v1 ? 1.f : 0.f, f2 = v2 ? 1.f : 0.f, f3 = v3 ? 1.f : 0.f;
        const float nb[8] = {n0[0] * f0, n1[1] * f1, n2[2] * f2, n3[3] * f3, n0[4] * f0, n1[5] * f1, n2[6] * f2, n3[7] * f3};
#pragma unroll
        for (int j = 0; j < 8; ++j) { const float mm = j < 4 ? m0[j] : m1[j - 4]; z[j] = own[j] + mm * (nb[j] - own[j]); }
    };
#pragma unroll
    for (int it = 0; it < 4; ++it) { const int g = tid + NTHREADS * it, tk = g >> 5, gi = g & 31;
        float z[8]; shift_group(tk, 2304 + gi * 8, z);
        if (gi < 8) { float t8[8];
#pragma unroll
            for (int j = 0; j < 8; ++j) t8[j] = 1.0f - 2.0f * __builtin_amdgcn_rcpf(1.0f + __expf(2.0f * z[j]));
            *(LAS u32x4*)(tw + tk * SP_ + gi * 8) = pack8(t8); }
        else if (gi < 16) *(LAS u32x4*)(adl + tk * SP_ + (gi - 8) * 8) = pack8(z);
        else { float t8[8];
#pragma unroll
            for (int j = 0; j < 8; ++j) t8[j] = sigmoidf_(z[j]);
            *(LAS u32x4*)(sg + tk * 136 + (gi - 16) * 8) = pack8(t8); } }
    __syncthreads();
#pragma unroll 1
    for (int hh = 0; hh < 4; ++hh) {
    const int tid = tid_fresh(), lane = tid & 63, wave = tid >> 6;
    const int head = 4 * hgrp + hh; const float* kkw = a->in[I_KK] + (size_t)l * CW + head * 64;
#pragma unroll
    for (int it = 0; it < 3; ++it) { const int g = tid + NTHREADS * it, tk = g / 24, gi = g % 24, c8 = (gi & 7) * 8;
        float z[8]; shift_group(tk, (gi >> 3) * 768 + head * 64 + c8, z);
        if (gi < 8) *(LAS u32x4*)(SR + tk * SP_ + c8) = pack8(z);
        else if (gi < 16) { *(LAS u32x4*)(SK + tk * SP_ + c8) = pack8(z);
            const f32x4 k0 = *(const f32x4*)(kkw + c8), k1 = *(const f32x4*)(kkw + c8 + 4); float ss = 0.f;
#pragma unroll
            for (int j = 0; j < 8; ++j) { const float q = z[j] * (j < 4 ? k0[j] : k1[j - 4]); ss += q * q; }
            ss += __shfl_xor(ss, 1); ss += __shfl_xor(ss, 2); ss += __shfl_xor(ss, 4);
            if ((gi & 7) == 0) invn[tk] = 1.0f / fmaxf(sqrtf(ss), 1e-12f); }
        else *(LAS u32x4*)(SV + tk * SP_ + c8) = pack8(z); }
    __syncthreads();
    {
        const int fr = lane & 15, fq = lane >> 4, nt = wave & 3, th = wave >> 2;
        const bf16* wupT = (const bf16*)(ws + WS_SMALLW + SW_WUP) + (size_t)l * 2 * 768 * 64;
        const bf16* aupT = (const bf16*)(ws + WS_SMALLW + SW_AUP) + (size_t)l * 768 * 64;
        const bf16* gupT = (const bf16*)(ws + WS_SMALLW + SW_GUP) + (size_t)l * 768 * 128;
        const float* a0 = a->in[I_A0] + (size_t)l * CW + head * 64; const float* kaw = a->in[I_KA] + (size_t)l * CW + head * 64; const float* w0 = a->in[I_W0] + (size_t)l * 2 * CW + head * 64;
        const int nloc = 16 * nt + 4 * fq;
#pragma unroll 1
        for (int mat = 0; mat < 4; ++mat) {
            const bf16* WT = mat == 0 ? aupT : (mat == 1 ? wupT : (mat == 2 ? wupT + 768 * 64 : gupT));
            const int KK = mat == 3 ? 128 : 64; const LAS bf16* act = mat == 0 ? adl : (mat == 3 ? sg : tw); const int apitch = mat == 3 ? 136 : SP_;
            f32x4 acc[2];
            acc[0] = (f32x4){0.f, 0.f, 0.f, 0.f}; acc[1] = acc[0];
            for (int ks = 0; ks < KK / 32; ++ks) { const bf16x8 afr = *(const bf16x8*)(WT + (size_t)(head * 64 + 16 * nt + fr) * KK + ks * 32 + fq * 8);
#pragma unroll
                for (int tt = 0; tt < 2; ++tt) { const bf16x8 bfr = *(const LAS bf16x8*)(act + (16 * (2 * th + tt) + fr) * apitch + ks * 32 + fq * 8); acc[tt] = __builtin_amdgcn_mfma_f32_16x16x32_bf16(afr, bfr, acc[tt], 0, 0, 0); } }
#pragma unroll
            for (int tt = 0; tt < 2; ++tt) { const int tk = 16 * (2 * th + tt) + fr; const f32x4 v = acc[tt];
                if (mat == 0) {
                    const f32x4 a0v = *(const f32x4*)(a0 + nloc), kav = *(const f32x4*)(kaw + nloc), kkv = *(const f32x4*)(kkw + nloc);
                    const u32x2 kp = *(const LAS u32x2*)(SK + tk * SP_ + nloc); const float kf[4] = {bflo(kp.x), bfhi(kp.x), bflo(kp.y), bfhi(kp.y)};
                    const float inn = invn[tk]; float k2[4], kk[4], bb[4];
#pragma unroll
                    for (int j = 0; j < 4; ++j) { const float av = sigmoidf_(a0v[j] + v[j]); kk[j] = kf[j] * kkv[j] * inn; k2[j] = kf[j] * (1.0f + (av - 1.0f) * kav[j]); bb[j] = kk[j] * av; }
                    u32x2 q; q.x = pk2(k2[0], k2[1]); q.y = pk2(k2[2], k2[3]); *(LAS u32x2*)(SK + tk * SP_ + nloc) = q;
                    q.x = pk2(kk[0], kk[1]); q.y = pk2(kk[2], kk[3]); *(LAS u32x2*)(SKK + tk * SP_ + nloc) = q;
                    q.x = pk2(bb[0], bb[1]); q.y = pk2(bb[2], bb[3]); *(LAS u32x2*)(SB + tk * SP_ + nloc) = q;
                } else if (mat <= 2) {
                    const f32x4 w0v = *(const f32x4*)(w0 + (mat - 1) * CW + nloc); float d[4];
#pragma unroll
                    for (int j = 0; j < 4; ++j) d[j] = __expf(-DECAY_SCALE * sigmoidf_(w0v[j] + v[j]));
                    u32x2 q; q.x = pk2(d[0], d[1]); q.y = pk2(d[2], d[3]); *(LAS u32x2*)((mat == 1 ? SWF : SWB) + tk * SP_ + nloc) = q;
                } else {
                    u32x2 q; q.x = pk2(v[0], v[1]); q.y = pk2(v[2], v[3]); *(u32x2*)(Y + (size_t)(row0 + tk) * D + 1280 + head * 64 + nloc) = q;
                }
            }
        }
    }
    __syncthreads();
    { const int tk = tid >> 3, c8 = (tid & 7) * 8; float r8[8], k8[8], v8[8];
      unpack8(*(const LAS u32x4*)(SR + tk * SP_ + c8), r8); unpack8(*(const LAS u32x4*)(SK + tk * SP_ + c8), k8); unpack8(*(const LAS u32x4*)(SV + tk * SP_ + c8), v8);
      const float* rkp = a->in[I_RK] + (size_t)l * CW + head * 64 + c8; const f32x4 rk0 = *(const f32x4*)rkp, rk1 = *(const f32x4*)(rkp + 4);
      float bs = 0.f;
#pragma unroll
      for (int j = 0; j < 8; ++j) bs += r8[j] * k8[j] * (j < 4 ? rk0[j] : rk1[j - 4]);
      bs += __shfl_xor(bs, 1); bs += __shfl_xor(bs, 2); bs += __shfl_xor(bs, 4);
#pragma unroll
      for (int j = 0; j < 8; ++j) v8[j] *= bs;
      *(u32x4*)(Y + (size_t)(row0 + tk) * D + 512 + head * 64 + c8) = pack8(v8); }
    {
        const int c4 = wave & 3, dir = wave >> 2, fr = lane & 15, fq = lane >> 4;
        LAS float* CB = (LAS float*)wpriv;
        LAS float* AA = CB + 16 * 64;
        const LAS bf16* SW = dir ? SWB : SWF;
        auto trow = [&](int tau) { return 16 * c4 + (dir ? 15 - tau : tau); };
        float c[16], ci[16];
        { float run = 1.f;
#pragma unroll
          for (int t = 0; t < 16; ++t) { run *= bf1(SW[trow(t) * SP_ + lane]); c[t] = run; ci[t] = __builtin_amdgcn_rcpf(run); CB[t * 64 + lane] = run; } }
        const int rec_dir = dir, bidx = isl ? (row0 >> 12) : ((row0 - NLAT) >> 8);
        const int tcl = isl ? 4 * ((row0 >> 6) & 63) + c4 : 4 * (((row0 - NLAT) >> 6) & 3) + c4;
        const int nproc = isl ? 16 + (dir ? 255 - tcl : tcl) : (dir ? 15 - tcl : tcl);
        unsigned char* rec = ws + WS_PRE + ((size_t)((rec_dir * 8 + bidx) * 12 + head) * NCHUNK16 + nproc) * PRE_REC;
        { const float cl = c[15]; float bk[32];
#pragma unroll
          for (int t = 0; t < 16; ++t) { const float e = cl * ci[t]; const int pos = 8 * (t >> 2) + (t & 3); bk[pos] = bf1(SB[trow(t) * SP_ + lane]) * e; bk[pos + 4] = bf1(SK[trow(t) * SP_ + lane]) * e; }
#pragma unroll
          for (int q4 = 0; q4 < 4; ++q4) { u32x4 o; o.x = pk2(bk[8 * q4], bk[8 * q4 + 1]); o.y = pk2(bk[8 * q4 + 2], bk[8 * q4 + 3]); o.z = pk2(bk[8 * q4 + 4], bk[8 * q4 + 5]); o.w = pk2(bk[8 * q4 + 6], bk[8 * q4 + 7]);
              *(u32x4*)(rec + PR_BK + lane * 64 + q4 * 16) = o; }
          *(float*)(rec + PR_GAM + lane * 4) = cl; }
        asm volatile("s_waitcnt lgkmcnt(0)" ::: "memory");
        bf16x8 fa[2], frr[2], fb[2], fk[2];
        { const int tr = trow(fr);
#pragma unroll
          for (int sx = 0; sx < 2; ++sx) { const int ch = 32 * sx + 8 * fq; float kk8[8], r8[8], b8[8], k8[8];
              unpack8(*(const LAS u32x4*)(SKK + tr * SP_ + ch), kk8); unpack8(*(const LAS u32x4*)(SR + tr * SP_ + ch), r8); unpack8(*(const LAS u32x4*)(SB + tr * SP_ + ch), b8); unpack8(*(const LAS u32x4*)(SK + tr * SP_ + ch), k8);
              const f32x4 c0 = *(const LAS f32x4*)(CB + fr * 64 + ch), c1 = *(const LAS f32x4*)(CB + fr * 64 + ch + 4);
              f32x4 p0 = (f32x4){1.f, 1.f, 1.f, 1.f}, p1 = p0; if (fr > 0) { p0 = *(const LAS f32x4*)(CB + (fr - 1) * 64 + ch); p1 = *(const LAS f32x4*)(CB + (fr - 1) * 64 + ch + 4); }
              float xa[8], xr[8], xb[8], xk[8];
#pragma unroll
              for (int j = 0; j < 8; ++j) { const float ec = j < 4 ? c0[j] : c1[j - 4], ep = j < 4 ? p0[j] : p1[j - 4]; const float en = __builtin_amdgcn_rcpf(ec);
                  xa[j] = -kk8[j] * ep; xr[j] = r8[j] * ec; xb[j] = b8[j] * en; xk[j] = k8[j] * en; }
              const u32x4 ua = pack8(xa), ur = pack8(xr), ub = pack8(xb), uk = pack8(xk);
              fa[sx] = __builtin_bit_cast(bf16x8, ua); frr[sx] = __builtin_bit_cast(bf16x8, ur); fb[sx] = __builtin_bit_cast(bf16x8, ub); fk[sx] = __builtin_bit_cast(bf16x8, uk); } }
        f32x4 gab = (f32x4){0.f, 0.f, 0.f, 0.f}, gak = gab, grb = gab, grk = gab;
#pragma unroll
        for (int sx = 0; sx < 2; ++sx) { gab = __builtin_amdgcn_mfma_f32_16x16x32_bf16(fa[sx], fb[sx], gab, 0, 0, 0); gak = __builtin_amdgcn_mfma_f32_16x16x32_bf16(fa[sx], fk[sx], gak, 0, 0, 0);
            grb = __builtin_amdgcn_mfma_f32_16x16x32_bf16(frr[sx], fb[sx], grb, 0, 0, 0); grk = __builtin_amdgcn_mfma_f32_16x16x32_bf16(frr[sx], fk[sx], grk, 0, 0, 0); }
#pragma unroll
        for (int j = 0; j < 4; ++j) { const int tau = 4 * fq + j; const bool lo = fr < tau, le = fr <= tau;
            AA[tau * 16 + fr] = lo ? gab[j] : 0.f; AA[256 + tau * 16 + fr] = lo ? gak[j] : 0.f; grb[j] = le ? grb[j] : 0.f; grk[j] = le ? grk[j] : 0.f; }
        asm volatile("s_waitcnt lgkmcnt(0)" ::: "memory");
        float wv[16], mv[16];
#pragma unroll
        for (int t = 0; t < 16; ++t) { const float ab = -bf1(SKK[trow(t) * SP_ + lane]) * (t > 0 ? c[t - 1] : 1.0f); float accw = ab, accm = AA[256 + t * 16 + fr];
#pragma unroll
            for (int q4 = 0; q4 < 4; ++q4) { if (4 * q4 < t) { const f32x4 cf = *(const LAS f32x4*)(AA + t * 16 + 4 * q4);
#pragma unroll
                for (int j = 0; j < 4; ++j) if (4 * q4 + j < t) { accw += cf[j] * wv[4 * q4 + j]; accm += cf[j] * mv[4 * q4 + j]; } } }
            wv[t] = accw; mv[t] = accm; }
        { LAS bf16* stg = (LAS bf16*)CB; const int pp = kperm_pos(lane);
#pragma unroll
          for (int t = 0; t < 16; ++t) { stg[t * 64 + pp] = (bf16)f2bf(wv[t]); stg[1024 + t * 64 + pp] = (bf16)f2bf(bf1(SR[trow(t) * SP_ + lane]) * c[t]); }
          asm volatile("s_waitcnt lgkmcnt(0)" ::: "memory");
#pragma unroll
          for (int q4 = 0; q4 < 4; ++q4) *(u32x4*)(rec + PR_WP + (q4 * 64 + lane) * 16) = *(const LAS u32x4*)((LAS unsigned char*)stg + (q4 * 64 + lane) * 16); }
        { LAS bf16* stg = (LAS bf16*)AA; const int ps = 8 * (fr >> 2) + (fr & 3);
          asm volatile("s_waitcnt lgkmcnt(0)" ::: "memory");
#pragma unroll
          for (int j = 0; j < 4; ++j) { const int tau = 4 * fq + j; stg[tau * 32 + ps] = (bf16)f2bf(grb[j]); stg[tau * 32 + ps + 4] = (bf16)f2bf(grk[j]); }
          if (lane < 16) {
#pragma unroll
              for (int t = 0; t < 16; ++t) stg[512 + t * 16 + lane] = (bf16)f2bf(mv[t]); }
          asm volatile("s_waitcnt lgkmcnt(0)" ::: "memory");
          *(u32x4*)(rec + PR_ARBK + lane * 16) = *(const LAS u32x4*)((LAS unsigned char*)stg + lane * 16);
          if (lane < 32) *(u32x4*)(rec + PR_ARBK + 1024 + lane * 16) = *(const LAS u32x4*)((LAS unsigned char*)stg + 1024 + lane * 16); }
        if (dir == 0) { float v16[16];
#pragma unroll
            for (int t = 0; t < 16; ++t) v16[t] = bf1(SV[(16 * c4 + t) * SP_ + lane]);
            const int tcg = isl ? 16 + tcl : tcl;
            unsigned char* vrec = ws + WS_VT + ((size_t)(bidx * 12 + head) * NCHUNK16 + tcg) * 2048 + lane * 32;
            u32x4 o; o.x = pk2(v16[0], v16[1]); o.y = pk2(v16[2], v16[3]); o.z = pk2(v16[4], v16[5]); o.w = pk2(v16[6], v16[7]); *(u32x4*)vrec = o;
            o.x = pk2(v16[8], v16[9]); o.y = pk2(v16[10], v16[11]); o.z = pk2(v16[12], v16[13]); o.w = pk2(v16[14], v16[15]); *(u32x4*)(vrec + 16) = o; }
    }
    __syncthreads();
    }
}

__device__ __forceinline__ float dpp_xor1(float x) { return __builtin_bit_cast(float, __builtin_amdgcn_update_dpp(0, __builtin_bit_cast(int, x), 0xB1, 0xF, 0xF, false)); }
__device__ __forceinline__ float dpp_xor2(float x) { return __builtin_bit_cast(float, __builtin_amdgcn_update_dpp(0, __builtin_bit_cast(int, x), 0x4E, 0xF, 0xF, false)); }
__device__ __forceinline__ int chain_row(int dir, int b, int s) {
    if (s < CTXL) return NLAT + b * CTXL + (dir ? (CTXL - 1 - s) : s);
    const int t = s - CTXL; return b * T + (dir ? (T - 1 - t) : t);
}
__device__ __forceinline__ float dpp_hmirror(float x) { return __builtin_bit_cast(float, __builtin_amdgcn_update_dpp(0, __builtin_bit_cast(int, x), 0x141, 0xF, 0xF, false)); }
struct RwRec { u32x4 wp[2], rp[2], bk[4], arbk; u32x2 mak, vt[2]; f32x4 gam[4]; };
__device__ __forceinline__ void rw_load(RwRec& r, const LAS unsigned char* rec, int fr, int kg, int hv, int dir) {
#pragma unroll
    for (int sx = 0; sx < 2; ++sx) { r.wp[sx] = *(const LAS u32x4*)(rec + PR_WP + fr * 128 + sx * 64 + kg * 16); r.rp[sx] = *(const LAS u32x4*)(rec + PR_RP + fr * 128 + sx * 64 + kg * 16); }
#pragma unroll
    for (int i = 0; i < 4; ++i) { r.bk[i] = *(const LAS u32x4*)(rec + PR_BK + (16 * i + fr) * 64 + kg * 16); r.gam[i] = *(const LAS f32x4*)(rec + PR_GAM + (16 * i + 4 * kg) * 4); }
    r.arbk = *(const LAS u32x4*)(rec + PR_ARBK + fr * 64 + kg * 16);
    r.mak = *(const LAS u32x2*)(rec + PR_MAK + fr * 32 + kg * 8);
#pragma unroll
    for (int q = 0; q < 2; ++q) r.vt[q] = *(const LAS u32x2*)(rec + PRE_REC + (16 * (2 * hv + q) + fr) * 32 + (dir ? (12 - 4 * kg) : 4 * kg) * 2);
}
constexpr int RW_R = 6, RW_SLOT = PRE_REC + 2048;
__device__ __forceinline__ void rwkv_chain_mfma(KArgs a, int task_base, LAS unsigned char* lds) {
    const int t_ = tid_fresh(); const int lane = t_ & 63, fr = lane & 15, kg = lane >> 4; const int wave = __builtin_amdgcn_readfirstlane(t_ >> 6);
    unsigned char* ws = a->ws;
    bf16* OC = (bf16*)(ws + WS_OC);
    const int cid = (task_base >> 2) + (wave >> 2), wq = wave & 3, dir = cid / 96, b = (cid % 96) / 12, h = cid % 12;
    const bool comp = wq < 2; const int hv = wq & 1;
    const unsigned char* rec0 = ws + WS_PRE + (size_t)((dir * 8 + b) * 12 + h) * NCHUNK16 * PRE_REC;
    const unsigned char* vrec0 = ws + WS_VT + (size_t)(b * 12 + h) * NCHUNK16 * 2048;
    LAS unsigned char* ring = lds + (wave >> 2) * (RW_R * RW_SLOT);
    auto tchunk = [&](int n) { return n < 16 ? (dir ? 15 - n : n) : 16 + (dir ? 255 - (n - 16) : (n - 16)); };
    auto issue = [&](int n) { const int nn = n < NCHUNK16 ? n : NCHUNK16 - 1; LAS unsigned char* slot = ring + (n % RW_R) * RW_SLOT;
#pragma unroll
        for (int jj = 0; jj < 3; ++jj) { const int j = 3 * wq + jj;
            const unsigned char* src = (j < 10 ? rec0 + (size_t)nn * PRE_REC + 1024 * j : vrec0 + (size_t)tchunk(nn) * 2048 + 1024 * (j - 10)) + lane * 16;
            __builtin_amdgcn_global_load_lds((const unsigned*)src, (LAS unsigned*)(slot + 1024 * j), 16, 0, 0); } };
    f32x4 ST[2][4];
#pragma unroll
    for (int q = 0; q < 2; ++q)
#pragma unroll
        for (int i = 0; i < 4; ++i) ST[q][i] = (f32x4){0.f, 0.f, 0.f, 0.f};
    unsigned uvU[2][2] = {{0u, 0u}, {0u, 0u}};
#pragma unroll
    for (int n = 0; n < RW_R - 1; ++n) issue(n);
    for (int n = 0; n < NCHUNK16; ++n) {
        if (comp && n >= RW_R - 1) asm volatile("s_waitcnt vmcnt(22)" ::: "memory"); else asm volatile("s_waitcnt vmcnt(12)" ::: "memory");
        __builtin_amdgcn_s_barrier(); asm volatile("" ::: "memory");
        issue(n + RW_R - 1);
        if (comp) {
            RwRec cur; rw_load(cur, ring + (n % RW_R) * RW_SLOT, fr, kg, hv, dir);
            u32x4 fmak; fmak.x = 0u; fmak.y = 0u; fmak.z = cur.mak.x; fmak.w = cur.mak.y;
            const int row = chain_row(dir, b, 16 * n + fr);
#pragma unroll
            for (int q = 0; q < 2; ++q) {
                u32x4 fs[2];
#pragma unroll
                for (int sx = 0; sx < 2; ++sx) { fs[sx].x = pk2(ST[q][2 * sx][0], ST[q][2 * sx][1]); fs[sx].y = pk2(ST[q][2 * sx][2], ST[q][2 * sx][3]); fs[sx].z = pk2(ST[q][2 * sx + 1][0], ST[q][2 * sx + 1][1]); fs[sx].w = pk2(ST[q][2 * sx + 1][2], ST[q][2 * sx + 1][3]); }
                u32x2 vt = cur.vt[q]; if (dir) { const unsigned x = vt.x, y = vt.y; vt.x = (y >> 16) | (y << 16); vt.y = (x >> 16) | (x << 16); }
                u32x4 fuv; fuv.x = uvU[q][0]; fuv.y = uvU[q][1]; fuv.z = vt.x; fuv.w = vt.y;
                f32x4 U = (f32x4){0.f, 0.f, 0.f, 0.f};
                U = __builtin_amdgcn_mfma_f32_16x16x32_bf16(__builtin_bit_cast(bf16x8, cur.wp[0]), __builtin_bit_cast(bf16x8, fs[0]), U, 0, 0, 0);
                U = __builtin_amdgcn_mfma_f32_16x16x32_bf16(__builtin_bit_cast(bf16x8, cur.wp[1]), __builtin_bit_cast(bf16x8, fs[1]), U, 0, 0, 0);
                U = __builtin_amdgcn_mfma_f32_16x16x32_bf16(__builtin_bit_cast(bf16x8, fmak), __builtin_bit_cast(bf16x8, fuv), U, 0, 0, 0);
                uvU[q][0] = pk2(U[0], U[1]); uvU[q][1] = pk2(U[2], U[3]); fuv.x = uvU[q][0]; fuv.y = uvU[q][1];
                f32x4 OT = (f32x4){0.f, 0.f, 0.f, 0.f};
                OT = __builtin_amdgcn_mfma_f32_16x16x32_bf16(__builtin_bit_cast(bf16x8, fs[0]), __builtin_bit_cast(bf16x8, cur.rp[0]), OT, 0, 0, 0);
                OT = __builtin_amdgcn_mfma_f32_16x16x32_bf16(__builtin_bit_cast(bf16x8, fs[1]), __builtin_bit_cast(bf16x8, cur.rp[1]), OT, 0, 0, 0);
                OT = __builtin_amdgcn_mfma_f32_16x16x32_bf16(__builtin_bit_cast(bf16x8, fuv), __builtin_bit_cast(bf16x8, cur.arbk), OT, 0, 0, 0);
#pragma unroll
                for (int i = 0; i < 4; ++i) ST[q][i] = __builtin_amdgcn_mfma_f32_16x16x32_bf16(__builtin_bit_cast(bf16x8, cur.bk[i]), __builtin_bit_cast(bf16x8, fuv), ST[q][i] * cur.gam[i], 0, 0, 0);
                u32x2 o; o.x = pk2(OT[0], OT[1]); o.y = pk2(OT[2], OT[3]); *(u32x2*)(OC + ((size_t)dir * MALL + row) * CW + h * 64 + 16 * (2 * hv + q) + 4 * kg) = o;
            }
        }
    }
    asm volatile("s_waitcnt vmcnt(0)" ::: "memory");
    __builtin_amdgcn_s_barrier(); asm volatile("" ::: "memory");
}
#define LDS_BAR() do { asm volatile("s_waitcnt lgkmcnt(0)" ::: "memory"); __builtin_amdgcn_s_barrier(); asm volatile("" ::: "memory"); } while (0)
__device__ __forceinline__ void hgrn_prep_item(KArgs a, int l, int item, LAS unsigned char* lds, bool dry) {
    const int tid = tid_fresh();
    unsigned char* ws = a->ws;
    bf16* P = (bf16*)(ws + WS_P); bf16* HQB = (bf16*)(ws + WS_HQB); float* HG = (float*)(ws + WS_HG);
    const int cn = item % 68, bh = item / 68, h = bh % 6, b = bh / 6;
    const int row0 = cn < 4 ? NLAT + b * CTXL + 64 * cn : b * T + 64 * (cn - 4);
    constexpr int QP = 136;
    LAS bf16* SQ = (LAS bf16*)lds; LAS bf16* KF = SQ + 64 * QP; LAS bf16* KB = KF + 64 * QP; LAS bf16* QB = KB + 64 * QP;
    LAS float* LF = (LAS float*)(QB + 64 * QP); LAS float* LBk = LF + 64 * 128;
    LAS float* tot = LBk + 64 * 128;
    LAS float* lbs = tot + 1024;
    if (tid < 256) { const int dr = tid >> 7, ch = h * 128 + (tid & 127); float lb = 0.f;
        if (l != 0) { const float l0 = a->in[I_LB][((size_t)dr * DEPTH + 0) * BW + ch], l1 = a->in[I_LB][((size_t)dr * DEPTH + 1) * BW + ch]; lb = __builtin_amdgcn_rcpf(1.0f + __expf(l0 - l1)); }
        lbs[tid] = lb; }
    const int ta = tid >> 3, d0 = (tid & 7) * 16;
    bf16* prow = P + (size_t)(row0 + ta) * INC + h * 128 + d0;
    u32x4 rq[2], rf[2], rb[2];
    rq[0] = *(const u32x4*)(prow + OFF_Q); rq[1] = *(const u32x4*)(prow + OFF_Q + 8); rf[0] = *(const u32x4*)(prow + OFF_ZF); rf[1] = *(const u32x4*)(prow + OFF_ZF + 8); rb[0] = *(const u32x4*)(prow + OFF_ZB); rb[1] = *(const u32x4*)(prow + OFF_ZB + 8);
    __syncthreads();
#pragma unroll
    for (int hf = 0; hf < 2; ++hf) { float qf[8], zf[8], zb[8], oq[8], of[8], ob[8]; unpack8(rq[hf], qf); unpack8(rf[hf], zf); unpack8(rb[hf], zb);
        const int dd = d0 + 8 * hf; f32x4 lf0, lf1, lb0, lb1;
#pragma unroll
        for (int j = 0; j < 8; ++j) { const float lF = lbs[dd + j], lB = lbs[128 + dd + j];
            const float ff = lF + (1.0f - lF) * sigmoidf_(zf[j]), fb = lB + (1.0f - lB) * sigmoidf_(zb[j]);
            const float a1 = fmaxf(__logf(ff), -60.0f), a2 = fmaxf(__logf(fb), -60.0f);
            if (j < 4) { lf0[j] = a1; lb0[j] = a2; } else { lf1[j - 4] = a1; lb1[j - 4] = a2; }
            oq[j] = siluf_(qf[j]); of[j] = 1.0f - ff; ob[j] = 1.0f - fb; }
        *(LAS u32x4*)(SQ + ta * QP + dd) = pack8(oq); *(LAS u32x4*)(KF + ta * QP + dd) = pack8(of); *(LAS u32x4*)(KB + ta * QP + dd) = pack8(ob);
        *(LAS f32x4*)(LF + ta * 128 + dd) = lf0; *(LAS f32x4*)(LF + ta * 128 + dd + 4) = lf1; *(LAS f32x4*)(LBk + ta * 128 + dd) = lb0; *(LAS f32x4*)(LBk + ta * 128 + dd + 4) = lb1; }
    __syncthreads();
    { const int d = tid & 127, qt = tid >> 7; float r1 = 0.f, r2 = 0.f;
#pragma unroll
      for (int i = 0; i < 16; ++i) { const int tp = 16 * qt + i; r1 += LF[tp * 128 + d]; LF[tp * 128 + d] = r1; r2 += LBk[(63 - tp) * 128 + d]; LBk[(63 - tp) * 128 + d] = r2; }
      tot[qt * 128 + d] = r1; tot[512 + qt * 128 + d] = r2; }
    __syncthreads();
    LAS float* bas = lbs + 256;
    LAS float* bmd = bas + 1024;
    { const int d = tid & 127, dr = (tid >> 7) & 1; if (tid < 256) { const LAS float* tt = tot + 512 * dr; const float t0 = tt[d], t1 = tt[128 + d], t2 = tt[256 + d], t3 = tt[384 + d];
        bas[(dr * 4 + 0) * 128 + d] = 0.f; bas[(dr * 4 + 1) * 128 + d] = t0; bas[(dr * 4 + 2) * 128 + d] = t0 + t1; bas[(dr * 4 + 3) * 128 + d] = t0 + t1 + t2; bmd[dr * 128 + d] = t0 + t1;
        const int npr = dr == 0 ? cn : (cn < 4 ? 3 - cn : 4 + 63 - (cn - 4)); float* g = (dry ? (float*)(ws + WS_END + 8 * MiB) : HG) + ((size_t)(((dr * 8 + b) * 6 + h) * 68 + npr)) * 256; g[d] = __expf(t0 + t1); g[128 + d] = __expf(t2 + t3); } }
    __syncthreads();
#pragma unroll
    for (int hf = 0; hf < 2; ++hf) { const int dd = d0 + 8 * hf; float sq[8], kf[8], kb[8];
        unpack8(*(const LAS u32x4*)(SQ + ta * QP + dd), sq); unpack8(*(const LAS u32x4*)(KF + ta * QP + dd), kf); unpack8(*(const LAS u32x4*)(KB + ta * QP + dd), kb);
        float oqf[8], okf[8], oqb[8], okb[8];
#pragma unroll
        for (int dr = 0; dr < 2; ++dr) { const int tp = dr ? 63 - ta : ta, q = tp >> 4; const LAS float* pf = (dr ? LBk : LF) + ta * 128 + dd;
            const f32x4 p0 = *(const LAS f32x4*)pf, p1 = *(const LAS f32x4*)(pf + 4), b0 = *(const LAS f32x4*)(bas + (dr * 4 + q) * 128 + dd), b1 = *(const LAS f32x4*)(bas + (dr * 4 + q) * 128 + dd + 4),
                        m0 = *(const LAS f32x4*)(bmd + dr * 128 + dd), m1 = *(const LAS f32x4*)(bmd + dr * 128 + dd + 4);
#pragma unroll
            for (int j = 0; j < 8; ++j) { const float bt = (j < 4 ? p0[j] + b0[j] : p1[j - 4] + b1[j - 4]), bm = j < 4 ? m0[j] : m1[j - 4];
                const float eq = __expf(fminf(bt - bm, 80.0f)), ek = __expf(fminf(bm - bt, 80.0f));
                if (dr == 0) { oqf[j] = sq[j] * eq; okf[j] = kf[j] * ek; } else { oqb[j] = sq[j] * eq; okb[j] = kb[j] * ek; } } }
        *(LAS u32x4*)(QB + ta * QP + dd) = pack8(oqf); *(LAS u32x4*)(KF + ta * QP + dd) = pack8(okf); *(LAS u32x4*)(KB + ta * QP + dd) = pack8(okb); *(LAS u32x4*)(SQ + ta * QP + dd) = pack8(oqb); }
    bf16* prow_o = dry ? (bf16*)(ws + WS_END) + (size_t)((row0 + ta) & 511) * INC + h * 128 + d0 : prow; bf16* hqb_o = dry ? (bf16*)(ws + WS_END) : HQB;
#pragma unroll
    for (int hf = 0; hf < 2; ++hf) { const int dd = d0 + 8 * hf;
        *(u32x4*)(prow_o + OFF_Q + 8 * hf) = *(const LAS u32x4*)(QB + ta * QP + dd); *(u32x4*)(prow_o + OFF_ZF + 8 * hf) = *(const LAS u32x4*)(KF + ta * QP + dd); *(u32x4*)(prow_o + OFF_ZB + 8 * hf) = *(const LAS u32x4*)(KB + ta * QP + dd);
        *(u32x4*)(hqb_o + (size_t)(dry ? ((row0 + ta) & 1023) : (row0 + ta)) * BW + h * 128 + dd) = *(const LAS u32x4*)(SQ + ta * QP + dd); }
    __syncthreads();
}
__device__ __forceinline__ unsigned tr_addr(const LAS bf16* X, int pitch, int r0, int c0, int lane) { const int i = lane & 15, g = lane >> 4; return (unsigned)(size_t)(X + (r0 + 8 * g + (i >> 2)) * pitch + c0 + 4 * (i & 3)); }
__device__ __forceinline__ void tr8x4(u32x2 (&lo)[4], u32x2 (&hi)[4], unsigned a0, unsigned a1, unsigned a2, unsigned a3, unsigned rowstep4) {
    const unsigned b0 = a0 + rowstep4, b1 = a1 + rowstep4, b2 = a2 + rowstep4, b3 = a3 + rowstep4;
    asm volatile("ds_read_b64_tr_b16 %0, %8\n\tds_read_b64_tr_b16 %1, %9\n\tds_read_b64_tr_b16 %2, %10\n\tds_read_b64_tr_b16 %3, %11\n\t"
                 "ds_read_b64_tr_b16 %4, %12\n\tds_read_b64_tr_b16 %5, %13\n\tds_read_b64_tr_b16 %6, %14\n\tds_read_b64_tr_b16 %7, %15\n\ts_waitcnt lgkmcnt(0)"
                 : "=&v"(lo[0]), "=&v"(lo[1]), "=&v"(lo[2]), "=&v"(lo[3]), "=&v"(hi[0]), "=&v"(hi[1]), "=&v"(hi[2]), "=&v"(hi[3])
                 : "v"(a0), "v"(a1), "v"(a2), "v"(a3), "v"(b0), "v"(b1), "v"(b2), "v"(b3) : "memory");
}
__device__ __forceinline__ void tr_half(u32x2 (&vl)[8], u32x2 (&vh)[8], u32x2 (&xl)[2], u32x2 (&xh)[2], unsigned av, unsigned ak, unsigned ax) {
    asm volatile(
        "ds_read_b64_tr_b16 %0, %20\n\tds_read_b64_tr_b16 %1, %20 offset:32\n\tds_read_b64_tr_b16 %2, %20 offset:64\n\tds_read_b64_tr_b16 %3, %20 offset:96\n\t"
        "ds_read_b64_tr_b16 %4, %20 offset:128\n\tds_read_b64_tr_b16 %5, %20 offset:160\n\tds_read_b64_tr_b16 %6, %20 offset:192\n\tds_read_b64_tr_b16 %7, %20 offset:224\n\t"
        "ds_read_b64_tr_b16 %8, %20 offset:1088\n\tds_read_b64_tr_b16 %9, %20 offset:1120\n\tds_read_b64_tr_b16 %10, %20 offset:1152\n\tds_read_b64_tr_b16 %11, %20 offset:1184\n\t"
        "ds_read_b64_tr_b16 %12, %20 offset:1216\n\tds_read_b64_tr_b16 %13, %20 offset:1248\n\tds_read_b64_tr_b16 %14, %20 offset:1280\n\tds_read_b64_tr_b16 %15, %20 offset:1312\n\t"
        "ds_read_b64_tr_b16 %16, %21\n\tds_read_b64_tr_b16 %17, %22\n\tds_read_b64_tr_b16 %18, %21 offset:1088\n\tds_read_b64_tr_b16 %19, %22 offset:1088\n\ts_waitcnt lgkmcnt(0)"
        : "=&v"(vl[0]), "=&v"(vl[1]), "=&v"(vl[2]), "=&v"(vl[3]), "=&v"(vl[4]), "=&v"(vl[5]), "=&v"(vl[6]), "=&v"(vl[7]),
          "=&v"(vh[0]), "=&v"(vh[1]), "=&v"(vh[2]), "=&v"(vh[3]), "=&v"(vh[4]), "=&v"(vh[5]), "=&v"(vh[6]), "=&v"(vh[7]),
          "=&v"(xl[0]), "=&v"(xl[1]), "=&v"(xh[0]), "=&v"(xh[1])
        : "v"(av), "v"(ak), "v"(ax) : "memory");
}
__device__ __forceinline__ bf16x8 mk8(u32x2 lo, u32x2 hi) { u32x4 v; v.x = lo.x; v.y = lo.y; v.z = hi.x; v.w = hi.y; return __builtin_bit_cast(bf16x8, v); }
__device__ __forceinline__ void hgrn_chain_lean(KArgs a, int cid, LAS unsigned char* lds) {
    const int tid = tid_fresh(), lane = tid & 63, wave = tid >> 6, fr = lane & 15, fq = lane >> 4;
    unsigned char* ws = a->ws;
    const bf16* P = (const bf16*)(ws + WS_P); const bf16* HQB = (const bf16*)(ws + WS_HQB); const float* HG = (const float*)(ws + WS_HG); bf16* OB = (bf16*)(ws + WS_OB);
    const int dir = cid / 48, b = (cid % 48) / 6, h = cid % 6;
    constexpr int QP = 136, SP = 72;
    LAS bf16* qs = (LAS bf16*)lds;
    LAS bf16* ks = qs + 64 * QP;
    LAS bf16* vs = ks + 64 * QP;
    LAS bf16* pl = vs + 64 * QP;
    LAS bf16* sT = pl + 64 * SP;
    LAS float* gm = (LAS float*)(sT + 128 * QP);
    const int ta = tid >> 3, d0 = (tid & 7) * 16;
    const int koff = dir ? OFF_ZB : OFF_ZF;
    f32x4 S[8];
#pragma unroll
    for (int vt = 0; vt < 8; ++vt) S[vt] = (f32x4){0.f, 0.f, 0.f, 0.f};
    u32x4 rq[2], rk[2], rv[2]; float rg = 0.f;
    auto load_chunk = [&](int n) { const int row = chain_row(dir, b, 64 * n + ta); const bf16* pr = P + (size_t)row * INC + h * 128 + d0;
        const bf16* qr = dir ? HQB + (size_t)row * BW + h * 128 + d0 : pr + OFF_Q;
        rq[0] = *(const u32x4*)qr; rq[1] = *(const u32x4*)(qr + 8); rk[0] = *(const u32x4*)(pr + koff); rk[1] = *(const u32x4*)(pr + koff + 8); rv[0] = *(const u32x4*)(pr + OFF_I); rv[1] = *(const u32x4*)(pr + OFF_I + 8);
        if (tid < 256) rg = HG[((size_t)(((dir * 8 + b) * 6 + h) * 68 + n)) * 256 + tid]; };
    load_chunk(0);
    constexpr int NCH = (CTXL + T) / 64;
    for (int n = 0; n < NCH; ++n) {
        const int s0 = n * 64;
        *(LAS u32x4*)(qs + ta * QP + d0) = rq[0]; *(LAS u32x4*)(qs + ta * QP + d0 + 8) = rq[1]; *(LAS u32x4*)(ks + ta * QP + d0) = rk[0]; *(LAS u32x4*)(ks + ta * QP + d0 + 8) = rk[1];
        *(LAS u32x4*)(vs + ta * QP + d0) = rv[0]; *(LAS u32x4*)(vs + ta * QP + d0 + 8) = rv[1]; if (tid < 256) gm[tid] = rg;
        if (n + 1 < NCH) load_chunk(n + 1);
        LDS_BAR();
        { const f32x4 g4 = *(const LAS f32x4*)(gm + 16 * wave + 4 * fq);
#pragma unroll
          for (int vt = 0; vt < 8; ++vt) { S[vt] = S[vt] * g4; u32x2 o; o.x = pk2(S[vt][0], S[vt][1]); o.y = pk2(S[vt][2], S[vt][3]); *(LAS u32x2*)(sT + (16 * vt + fr) * QP + 16 * wave + 4 * fq) = o; } }
        { const int tt = wave >> 1;
#pragma unroll
          for (int u = 0; u < 2; ++u) { const int sg = 2 * (wave & 1) + u; f32x4 acc = (f32x4){0.f, 0.f, 0.f, 0.f};
              if (sg <= tt) {
#pragma unroll
                  for (int kq = 0; kq < 4; ++kq) { const bf16x8 af = *(const LAS bf16x8*)(ks + (16 * sg + fr) * QP + 32 * kq + 8 * fq), bfm = *(const LAS bf16x8*)(qs + (16 * tt + fr) * QP + 32 * kq + 8 * fq);
                      acc = __builtin_amdgcn_mfma_f32_16x16x32_bf16(af, bfm, acc, 0, 0, 0); }
                  if (sg == tt) {
#pragma unroll
                      for (int j = 0; j < 4; ++j) if (4 * fq + j > fr) acc[j] = 0.f; }
              }
              u32x2 o; o.x = pk2(acc[0], acc[1]); o.y = pk2(acc[2], acc[3]); *(LAS u32x2*)(pl + (16 * tt + fr) * SP + 16 * sg + 4 * fq) = o; } }
        LDS_BAR();
        f32x4 oacc[4];
#pragma unroll
        for (int tt = 0; tt < 4; ++tt) { f32x4 acc = (f32x4){0.f, 0.f, 0.f, 0.f};
#pragma unroll
            for (int kq = 0; kq < 4; ++kq) { const bf16x8 af = *(const LAS bf16x8*)(sT + (16 * wave + fr) * QP + 32 * kq + 8 * fq), bfm = *(const LAS bf16x8*)(qs + (16 * tt + fr) * QP + 32 * kq + 8 * fq);
                acc = __builtin_amdgcn_mfma_f32_16x16x32_bf16(af, bfm, acc, 0, 0, 0); }
            oacc[tt] = acc; }
        const unsigned rs4 = (unsigned)(4 * QP * 2);
#pragma unroll
        for (int kq = 0; kq < 2; ++kq) {
            u32x2 vl_[8], vh_[8], xl_[2], xh_[2];
            static_assert(QP == 136, "tr_half's immediates assume 272-byte rows");
            tr_half(vl_, vh_, xl_, xh_, tr_addr(vs, QP, 32 * kq, 0, lane), tr_addr(ks, QP, 32 * kq, 16 * wave, lane), tr_addr(vs, QP, 32 * kq, 16 * wave, lane));
            __builtin_amdgcn_sched_barrier(0);
            { const bf16x8 af = mk8(xl_[1], xh_[1]);
#pragma unroll
              for (int tt = 0; tt < 4; ++tt) { const bf16x8 bfm = *(const LAS bf16x8*)(pl + (16 * tt + fr) * SP + 32 * kq + 8 * fq); oacc[tt] = __builtin_amdgcn_mfma_f32_16x16x32_bf16(af, bfm, oacc[tt], 0, 0, 0); } }
            { const bf16x8 af = mk8(xl_[0], xh_[0]);
#pragma unroll
              for (int vt = 0; vt < 8; ++vt) S[vt] = __builtin_amdgcn_mfma_f32_16x16x32_bf16(af, mk8(vl_[vt], vh_[vt]), S[vt], 0, 0, 0); }
        }
#pragma unroll
        for (int tt = 0; tt < 4; ++tt) { const int row = chain_row(dir, b, s0 + 16 * tt + fr);
            u32x2 o; o.x = pk2(oacc[tt][0], oacc[tt][1]); o.y = pk2(oacc[tt][2], oacc[tt][3]); *(u32x2*)(OB + ((size_t)dir * MALL + row) * BW + h * 128 + 16 * wave + 4 * fq) = o; }
        { const f32x4 ge = *(const LAS f32x4*)(gm + 128 + 16 * wave + 4 * fq);
#pragma unroll
          for (int vt = 0; vt < 8; ++vt) S[vt] = S[vt] * ge; }
        LDS_BAR();
    }
}
__device__ __forceinline__ void hgrn_chain_mfma(KArgs a, int l, int cid, LAS unsigned char* lds) {
    const int tid = tid_fresh(), lane = tid & 63, wave = tid >> 6, fr = lane & 15, fq = lane >> 4;
    unsigned char* ws = a->ws;
    const bf16* P = (const bf16*)(ws + WS_P); bf16* OB = (bf16*)(ws + WS_OB);
    const int dir = cid / 48, b = (cid % 48) / 6, h = cid % 6;
    constexpr int QP = 136, SP = 72;
    LAS bf16* qs = (LAS bf16*)lds;
    LAS bf16* ks = qs + 64 * QP;
    LAS bf16* kT = ks + 64 * QP;
    LAS bf16* vT = kT + 128 * SP;
    LAS bf16* pl = vT + 128 * SP;
    LAS bf16* sT = pl + 64 * SP;
    LAS float* tot = (LAS float*)(sT + 128 * QP);
    LAS float* gmid = tot + 512;
    LAS float* gend = gmid + 128;
    LAS float* lbs = gend + 128;
    LAS float* lfb = (LAS float*)sT;
    const int d = tid & 127, qt = tid >> 7;
    const int tau_a = tid >> 3, d0 = (tid & 7) * 16;
    if (tid < 128) { const int ch = h * 128 + tid; float lb = 0.f;
        if (l != 0) { const float l0 = a->in[I_LB][((size_t)dir * DEPTH + 0) * BW + ch], l1 = a->in[I_LB][((size_t)dir * DEPTH + 1) * BW + ch]; lb = 1.0f / (1.0f + __expf(l0 - l1)); }
        lbs[tid] = lb; }
    f32x4 S[8];
#pragma unroll
    for (int vt = 0; vt < 8; ++vt) S[vt] = (f32x4){0.f, 0.f, 0.f, 0.f};
    const int zoff = dir ? OFF_ZB : OFF_ZF;
    u32x4 rq[2], ri[2], rz[2];
    { const bf16* pr = P + (size_t)chain_row(dir, b, tau_a) * INC + h * 128 + d0;
      rq[0] = *(const u32x4*)(pr + OFF_Q); rq[1] = *(const u32x4*)(pr + OFF_Q + 8); ri[0] = *(const u32x4*)(pr + OFF_I); ri[1] = *(const u32x4*)(pr + OFF_I + 8); rz[0] = *(const u32x4*)(pr + zoff); rz[1] = *(const u32x4*)(pr + zoff + 8); }
    __syncthreads();
    constexpr int NCH = (CTXL + T) / 64;
    for (int n = 0; n < NCH; ++n) {
        const int s0 = n * 64;
#pragma unroll
        for (int hf = 0; hf < 2; ++hf) { float qf[8], zf[8], oq[8], ok[8]; unpack8(rq[hf], qf); unpack8(rz[hf], zf);
            const int dd = d0 + 8 * hf; const f32x4 lb0 = *(const LAS f32x4*)(lbs + dd), lb1 = *(const LAS f32x4*)(lbs + dd + 4); f32x4 lf0, lf1;
#pragma unroll
            for (int j = 0; j < 8; ++j) { const float lb = j < 4 ? lb0[j] : lb1[j - 4]; const float f = lb + (1.0f - lb) * sigmoidf_(zf[j]); const float lf = fmaxf(__logf(f), -60.0f);
                if (j < 4) lf0[j] = lf; else lf1[j - 4] = lf; oq[j] = siluf_(qf[j]); ok[j] = 1.0f - f; }
            *(LAS u32x4*)(qs + tau_a * QP + dd) = pack8(oq); *(LAS u32x4*)(ks + tau_a * QP + dd) = pack8(ok);
            *(LAS f32x4*)(lfb + tau_a * 128 + dd) = lf0; *(LAS f32x4*)(lfb + tau_a * 128 + dd + 4) = lf1;
            const u32x4 vv = ri[hf];
            vT[(dd + 0) * SP + tau_a] = (bf16)(vv.x & 0xffffu); vT[(dd + 1) * SP + tau_a] = (bf16)(vv.x >> 16); vT[(dd + 2) * SP + tau_a] = (bf16)(vv.y & 0xffffu); vT[(dd + 3) * SP + tau_a] = (bf16)(vv.y >> 16);
            vT[(dd + 4) * SP + tau_a] = (bf16)(vv.z & 0xffffu); vT[(dd + 5) * SP + tau_a] = (bf16)(vv.z >> 16); vT[(dd + 6) * SP + tau_a] = (bf16)(vv.w & 0xffffu); vT[(dd + 7) * SP + tau_a] = (bf16)(vv.w >> 16); }
        if (n + 1 < NCH) { const bf16* pr = P + (size_t)chain_row(dir, b, s0 + 64 + tau_a) * INC + h * 128 + d0;
            rq[0] = *(const u32x4*)(pr + OFF_Q); rq[1] = *(const u32x4*)(pr + OFF_Q + 8); ri[0] = *(const u32x4*)(pr + OFF_I); ri[1] = *(const u32x4*)(pr + OFF_I + 8); rz[0] = *(const u32x4*)(pr + zoff); rz[1] = *(const u32x4*)(pr + zoff + 8); }
        LDS_BAR();
        float cs[16];
        { float run = 0.f;
#pragma unroll
          for (int i = 0; i < 16; ++i) { run += lfb[(16 * qt + i) * 128 + d]; cs[i] = run; }
          tot[qt * 128 + d] = run; }
        LDS_BAR();
        { const float t0 = tot[d], t1 = tot[128 + d], t2 = tot[256 + d], t3 = tot[384 + d];
          const float bmid = t0 + t1, btot = bmid + t2 + t3; const float base = (qt > 0 ? t0 : 0.f) + (qt > 1 ? t1 : 0.f) + (qt > 2 ? t2 : 0.f);
          if (qt == 0) { gmid[d] = __expf(bmid); gend[d] = __expf(btot - bmid); }
#pragma unroll
          for (int i = 0; i < 16; ++i) { const int tau = 16 * qt + i; const float bt = base + cs[i];
              const float eq = __expf(fminf(bt - bmid, 80.0f)), ek = __expf(fminf(bmid - bt, 80.0f));
              const bf16 qb = (bf16)f2bf(bf1(qs[tau * QP + d]) * eq), kb = (bf16)f2bf(bf1(ks[tau * QP + d]) * ek);
              qs[tau * QP + d] = qb; ks[tau * QP + d] = kb; kT[d * SP + tau] = kb; } }
        LDS_BAR();
        { const f32x4 gm = *(const LAS f32x4*)(gmid + 16 * wave + 4 * fq);
#pragma unroll
          for (int vt = 0; vt < 8; ++vt) { S[vt] = S[vt] * gm; u32x2 o; o.x = pk2(S[vt][0], S[vt][1]); o.y = pk2(S[vt][2], S[vt][3]); *(LAS u32x2*)(sT + (16 * vt + fr) * QP + 16 * wave + 4 * fq) = o; } }
        { const int tt = wave >> 1;
#pragma unroll
          for (int u = 0; u < 2; ++u) { const int sg = 2 * (wave & 1) + u; f32x4 acc = (f32x4){0.f, 0.f, 0.f, 0.f};
              if (sg <= tt) {
#pragma unroll
                  for (int kq = 0; kq < 4; ++kq) { const bf16x8 af = *(const LAS bf16x8*)(ks + (16 * sg + fr) * QP + 32 * kq + 8 * fq), bfm = *(const LAS bf16x8*)(qs + (16 * tt + fr) * QP + 32 * kq + 8 * fq);
                      acc = __builtin_amdgcn_mfma_f32_16x16x32_bf16(af, bfm, acc, 0, 0, 0); }
                  if (sg == tt) {
#pragma unroll
                      for (int j = 0; j < 4; ++j) if (4 * fq + j > fr) acc[j] = 0.f; }
              }
              u32x2 o; o.x = pk2(acc[0], acc[1]); o.y = pk2(acc[2], acc[3]); *(LAS u32x2*)(pl + (16 * tt + fr) * SP + 16 * sg + 4 * fq) = o; } }
        LDS_BAR();
#pragma unroll
        for (int tt = 0; tt < 4; ++tt) { f32x4 acc = (f32x4){0.f, 0.f, 0.f, 0.f};
#pragma unroll
            for (int kq = 0; kq < 2; ++kq) { const bf16x8 af = *(const LAS bf16x8*)(vT + (16 * wave + fr) * SP + 32 * kq + 8 * fq), bfm = *(const LAS bf16x8*)(pl + (16 * tt + fr) * SP + 32 * kq + 8 * fq);
                acc = __builtin_amdgcn_mfma_f32_16x16x32_bf16(af, bfm, acc, 0, 0, 0); }
#pragma unroll
            for (int kq = 0; kq < 4; ++kq) { const bf16x8 af = *(const LAS bf16x8*)(sT + (16 * wave + fr) * QP + 32 * kq + 8 * fq), bfm = *(const LAS bf16x8*)(qs + (16 * tt + fr) * QP + 32 * kq + 8 * fq);
                acc = __builtin_amdgcn_mfma_f32_16x16x32_bf16(af, bfm, acc, 0, 0, 0); }
            const int row = chain_row(dir, b, s0 + 16 * tt + fr);
            u32x2 o; o.x = pk2(acc[0], acc[1]); o.y = pk2(acc[2], acc[3]); *(u32x2*)(OB + ((size_t)dir * MALL + row) * BW + h * 128 + 16 * wave + 4 * fq) = o; }
        { const f32x4 ge = *(const LAS f32x4*)(gend + 16 * wave + 4 * fq);
#pragma unroll
          for (int kq = 0; kq < 2; ++kq) { const bf16x8 af = *(const LAS bf16x8*)(kT + (16 * wave + fr) * SP + 32 * kq + 8 * fq);
#pragma unroll
              for (int vt = 0; vt < 8; ++vt) { const bf16x8 bfm = *(const LAS bf16x8*)(vT + (16 * vt + fr) * SP + 32 * kq + 8 * fq); S[vt] = __builtin_amdgcn_mfma_f32_16x16x32_bf16(af, bfm, S[vt], 0, 0, 0); } }
#pragma unroll
          for (int vt = 0; vt < 8; ++vt) S[vt] = S[vt] * ge; }
        LDS_BAR();
    }
}
__device__ __forceinline__ void hgrn_chain(KArgs a, int l, int cid, LAS unsigned char* lds) {
    const int tid = tid_fresh();
    unsigned char* ws = a->ws;
    const bf16* P = (const bf16*)(ws + WS_P); bf16* OB = (bf16*)(ws + WS_OB);
    const int dir = cid / 48, b = (cid % 48) / 6, h = cid % 6;
    LAS float* tq = (LAS float*)lds;
    LAS float* tk = tq + 16 * 128;
    LAS float* tf = tk + 16 * 128;
    LAS float* tv = tf + 16 * 128;
    LAS float* ot = tv + 16 * 128;
    const int v = tid >> 2, q = tid & 3;
    float S[32];
#pragma unroll
    for (int j = 0; j < 32; ++j) S[j] = 0.f;
    const int sst = tid >> 5, sc4 = (tid & 31) * 4;
    float lb[4];
#pragma unroll
    for (int j = 0; j < 4; ++j) { const int ch = h * 128 + sc4 + j;
        if (l == 0) lb[j] = 0.f; else { const float l0 = a->in[I_LB][((size_t)dir * DEPTH + 0) * BW + ch], l1 = a->in[I_LB][((size_t)dir * DEPTH + 1) * BW + ch]; lb[j] = 1.0f / (1.0f + __expf(l0 - l1)); } }
    for (int s0 = 0; s0 < CTXL + T; s0 += 16) {
        { const int row = chain_row(dir, b, s0 + sst); const bf16* pr = P + (size_t)row * INC + h * 128 + sc4;
          const u32x2 pq = *(const u32x2*)(pr + OFF_Q), pi = *(const u32x2*)(pr + OFF_I), pz = *(const u32x2*)(pr + (dir ? OFF_ZB : OFF_ZF));
          const float qf[4] = {bflo(pq.x), bfhi(pq.x), bflo(pq.y), bfhi(pq.y)}, vf[4] = {bflo(pi.x), bfhi(pi.x), bflo(pi.y), bfhi(pi.y)}, zf[4] = {bflo(pz.x), bfhi(pz.x), bflo(pz.y), bfhi(pz.y)};
          f32x4 oq, ok, of, ov;
#pragma unroll
          for (int j = 0; j < 4; ++j) { const float f = lb[j] + (1.0f - lb[j]) * sigmoidf_(zf[j]); oq[j] = siluf_(qf[j]); of[j] = f; ok[j] = 1.0f - f; ov[j] = vf[j]; }
          *(LAS f32x4*)(tq + sst * 128 + sc4) = oq; *(LAS f32x4*)(tk + sst * 128 + sc4) = ok; *(LAS f32x4*)(tf + sst * 128 + sc4) = of; *(LAS f32x4*)(tv + sst * 128 + sc4) = ov; }
        LDS_BAR();
        for (int st = 0; st < 16; ++st) {
            const float vv = tv[st * 128 + v]; float o0 = 0.f, o1 = 0.f;
#pragma unroll
            for (int j = 0; j < 8; ++j) { const f32x4 fq4 = *(const LAS f32x4*)(tf + st * 128 + q * 32 + 4 * j), kq4 = *(const LAS f32x4*)(tk + st * 128 + q * 32 + 4 * j), qq4 = *(const LAS f32x4*)(tq + st * 128 + q * 32 + 4 * j);
#pragma unroll
                for (int i = 0; i < 4; ++i) { const float sn = fq4[i] * S[4 * j + i] + kq4[i] * vv; S[4 * j + i] = sn; if (i & 1) o1 += qq4[i] * sn; else o0 += qq4[i] * sn; } }
            float o = o0 + o1; o += dpp_xor1(o); o += dpp_xor2(o);
            if (q == 0) ot[st * 128 + v] = o;
        }
        LDS_BAR();
        if (tid < 256) { const int st = tid >> 4, part = tid & 15; const int row = chain_row(dir, b, s0 + st); const LAS float* op = ot + st * 128 + part * 8;
            float f[8];
#pragma unroll
            for (int j = 0; j < 8; ++j) f[j] = op[j];
            *(u32x4*)(OB + ((size_t)dir * MALL + row) * BW + h * 128 + part * 8) = pack8(f); }
    }
    LDS_BAR();
}

__device__ __forceinline__ float grp_sum32(float v) { v += __shfl_xor(v, 1); v += __shfl_xor(v, 2); v += __shfl_xor(v, 4); v += __shfl_xor(v, 8); v += __shfl_xor(v, 16); return v; }
__device__ __forceinline__ float grp_sum16(float v) { v += __shfl_xor(v, 1); v += __shfl_xor(v, 2); v += __shfl_xor(v, 4); v += __shfl_xor(v, 8); return v; }
__device__ __forceinline__ void phase_finalize(KArgs a, int l, bool dry) {
    const int tid_ = tid_fresh(); const int lane = tid_ & 63, wave = tid_ >> 6, gw = blockIdx.x * 8 + wave, NGW = gridDim.x * 8;
    unsigned char* ws = a->ws;
    const bf16* P = (const bf16*)(ws + WS_P); const bf16* OB = (const bf16*)(ws + WS_OB); const bf16* OC = (const bf16*)(ws + WS_OC); bf16* Y = (bf16*)(ws + WS_Y);
    unsigned char* Yo = dry ? ws + WS_END : ws + WS_Y8;
    const int nrows = (l == DEPTH - 1) ? NLAT : MALL;
    const int rpw = (nrows + NGW - 1) / NGW; const int r0 = gw * rpw, r1 = (r0 + rpw < nrows) ? r0 + rpw : nrows;
    f32x4 hng[3], gng[3], gnb[3];
#pragma unroll
    for (int k = 0; k < 3; ++k) { const int c = 256 * k + 4 * lane; hng[k] = *(const f32x4*)(a->in[I_HNG] + (size_t)l * BW + c);
        gng[k] = *(const f32x4*)(a->in[I_GNGG] + (size_t)l * CW + c); gnb[k] = *(const f32x4*)(a->in[I_GNB] + (size_t)l * CW + c); }
    for (int row = r0; row < r1; ++row) {
        const int orow = dry ? (row & 2047) : row;
        u32x2 bf_[3], bb_[3], bg_[3], cf_[3], cb_[3], cv_[3], cg_[3];
#pragma unroll
        for (int k = 0; k < 3; ++k) { const int c = 256 * k + 4 * lane;
            bf_[k] = *(const u32x2*)(OB + (size_t)row * BW + c); bb_[k] = *(const u32x2*)(OB + ((size_t)MALL + row) * BW + c); bg_[k] = *(const u32x2*)(P + (size_t)row * INC + OFF_OG + c);
            cf_[k] = *(const u32x2*)(OC + (size_t)row * CW + c); cb_[k] = *(const u32x2*)(OC + ((size_t)MALL + row) * CW + c);
            cv_[k] = *(const u32x2*)(Y + (size_t)row * D + 512 + c);
            cg_[k] = *(const u32x2*)(Y + (size_t)row * D + 1280 + c); }
#pragma unroll
        for (int k = 0; k < 3; ++k) { const int c = 256 * k + 4 * lane;
            { float o[4] = {bflo(bf_[k].x) + bflo(bb_[k].x), bfhi(bf_[k].x) + bfhi(bb_[k].x), bflo(bf_[k].y) + bflo(bb_[k].y), bfhi(bf_[k].y) + bfhi(bb_[k].y)};
              const float ss = grp_sum32((o[0] * o[0] + o[1] * o[1]) + (o[2] * o[2] + o[3] * o[3])); const float rstd = 1.0f / sqrtf(ss * (1.0f / 128.0f) + NORM_EPS);
              const float g4[4] = {bflo(bg_[k].x), bfhi(bg_[k].x), bflo(bg_[k].y), bfhi(bg_[k].y)}; float y[4];
#pragma unroll
              for (int j = 0; j < 4; ++j) y[j] = o[j] * rstd * hng[k][j] * sigmoidf_(g4[j]);
              *(unsigned*)(Yo + (size_t)orow * D + 512 + c) = pk4_fp8(y[0], y[1], y[2], y[3]); }
            { float o[4] = {bflo(cf_[k].x) + bflo(cb_[k].x), bfhi(cf_[k].x) + bfhi(cb_[k].x), bflo(cf_[k].y) + bflo(cb_[k].y), bfhi(cf_[k].y) + bfhi(cb_[k].y)};
              const float v4[4] = {bflo(cv_[k].x), bfhi(cv_[k].x), bflo(cv_[k].y), bfhi(cv_[k].y)}, g4[4] = {bflo(cg_[k].x), bfhi(cg_[k].x), bflo(cg_[k].y), bfhi(cg_[k].y)};
              const float mean = grp_sum16((o[0] + o[1]) + (o[2] + o[3])) * (1.0f / 64.0f);
              float dl[4]; float sq = 0.f;
#pragma unroll
              for (int j = 0; j < 4; ++j) { dl[j] = o[j] - mean; sq += dl[j] * dl[j]; }
              const float var = grp_sum16(sq) * (1.0f / 64.0f); const float rs = 1.0f / sqrtf(var + GN_EPS); float y[4];
#pragma unroll
              for (int j = 0; j < 4; ++j) y[j] = (dl[j] * rs * gng[k][j] + gnb[k][j] + v4[j]) * g4[j];
              *(unsigned*)(Yo + (size_t)orow * D + 1280 + c) = pk4_fp8(y[0], y[1], y[2], y[3]); }
        }
    }
}

__global__ void __launch_bounds__(NTHREADS, 2) mk_fwd(Args args_unused) {
    extern __shared__ __attribute__((aligned(16))) unsigned char lds_raw[];
    LAS unsigned char* lds = (LAS unsigned char*)lds_raw;
    volatile LAS unsigned* misc = (volatile LAS unsigned*)(lds + LDS_MISC);
    const int tid = threadIdx.x, G = gridDim.x;
    if (tid < 64) misc[tid] = 0u;
    __syncthreads();
    XcdBarrier bar; bar.bar = nullptr; bar.x = 0; bar.st = nullptr;
    int lo, hi;
    { KArgs a = kargs(); lo = a->ph_lo; hi = a->ph_hi; unsigned* ctl = (unsigned*)(a->ws + WS_CTL); bar.bar = ctl + CW_BAR; if (!MK_MULTI) bar = xcd_barrier_post(ctl + CW_BAR, misc + 8); }
    const int cvirt = (G % 8 == 0) ? ((int)blockIdx.x % 8) * (G / 8) + (int)blockIdx.x / 8 : (int)blockIdx.x;
#define IN(k) (lo <= (k) && (k) < hi)
#define PM(b) ((PHMASK >> (b)) & 1)
#define REP(b) _Pragma("unroll 1") for (int rep_ = 0; rep_ < 1 + ((PROBE_DUP >> (b)) & 1); ++rep_)
#define SEAM(k) do { if (!MK_MULTI && IN(k) && IN((k) + 1)) { xcd_barrier(bar); if ((PROBE_DUP >> 13) & 1) xcd_barrier(bar); } } while (0)

    if (PM(0) && IN(0)) REP(0) { phase_prologue(kargs(), lds); } SEAM(0);

#pragma unroll 1
    for (int l = 0; l < DEPTH; ++l) {
        const int pb = 1 + 9 * l;
        const bool lastl = (l == DEPTH - 1);
        if (PM(1) && IN(pb + 0)) { if ((PROBE_DUP >> 1) & 1) { if (l == 0) phase_norm1<0>(kargs(), l, true); else phase_norm1<1>(kargs(), l, true); } if (l == 0) phase_norm1<0>(kargs(), l, false); else { phase_norm1<1>(kargs(), l, false); __syncthreads(); convert_moe(kargs(), l, lds); __syncthreads(); } } SEAM(pb + 0);
        if (PM(2) && IN(pb + 1)) REP(2) {
            KArgs a = kargs(); unsigned char* ws = a->ws;
            pg8::Gemm g{(const bf16*)(ws + WS_H), (const bf16*)(ws + WS_WIN + (size_t)l * INC * D), MALL, INC, D / 2};
            pg8::StaticOrder S; S.init(MALL, INC, G, (int)blockIdx.x);
            pg8::EpiBf16 E{(bf16*)(ws + WS_P), INC};
            pg8::gemm_phase8<pg8::EpiBf16, pg8::StaticOrder, false, false>(lds, g, S, E, nullptr);
        } SEAM(pb + 1);
        if (PM(3) && IN(pb + 2)) {
            const int ngm = lastl ? 1024 : 1088;
            unsigned* qhead = (unsigned*)(kargs()->ws + WS_CTL) + CW_PREPQ + 64 * l;
            const int n_rw = 544 * 3, n_hg = 3264, n_all = (G == 256) ? n_rw + n_hg : n_rw + n_hg + ngm;
            for (;;) {
                if (threadIdx.x == 0) misc[16] = __hip_atomic_fetch_add(qhead, 1u, __ATOMIC_RELAXED, __HIP_MEMORY_SCOPE_AGENT);
                __syncthreads();
                const int it = (int)misc[16];
                if (it >= n_all) break;
                if (it < n_rw) { _Pragma("unroll 1") for (int r2 = 0; r2 < 1 + ((PROBE_DUP >> 15) & 1); ++r2) rwkv_prep_item(kargs(), l, it / 3, it % 3, lds); }
                else if (it < n_rw + n_hg) { if ((PROBE_DUP >> 16) & 1) hgrn_prep_item(kargs(), l, it - n_rw, lds, true); hgrn_prep_item(kargs(), l, it - n_rw, lds, false); }
                else { _Pragma("unroll 1") for (int r2 = 0; r2 < 1 + ((PROBE_DUP >> 14) & 1); ++r2) gmlp_item(kargs(), l, it - n_rw - n_hg, lds); }
            }
            __syncthreads();
        } SEAM(pb + 2);
        if (PM(4) && IN(pb + 3)) REP(4) {
            if (G == 256) { const int bx = blockIdx.x;
                if (bx < 96) { _Pragma("unroll 1") for (int r2 = 0; r2 < 1 + ((PROBE_DUP >> 12) & 1); ++r2) rwkv_chain_mfma(kargs(), bx * 8, lds); }
                else if (bx < 192) { _Pragma("unroll 1") for (int r2 = 0; r2 < 1 + ((PROBE_DUP >> 11) & 1); ++r2) hgrn_chain_lean(kargs(), bx - 96, lds); }
                if (bx < 96 || bx >= 192) {
                    unsigned* gq = (unsigned*)(kargs()->ws + WS_CTL) + CW_GMQ + 64 * l; const int ngm2 = lastl ? 1024 : 1088;
                    for (;;) { if (threadIdx.x == 0) misc[17] = __hip_atomic_fetch_add(gq, 1u, __ATOMIC_RELAXED, __HIP_MEMORY_SCOPE_AGENT);
                        __syncthreads(); const int it = (int)misc[17]; if (it >= ngm2) break; gmlp_item(kargs(), l, it, lds); }
                    __syncthreads(); } }
            else { for (int it = blockIdx.x; it < 192; it += G) { if (it < 96) rwkv_chain_mfma(kargs(), it * 8, lds); else hgrn_chain_lean(kargs(), it - 96, lds); } }
        } SEAM(pb + 3);
        if (PM(5) && IN(pb + 4)) { if ((PROBE_DUP >> 5) & 1) phase_finalize(kargs(), l, true); phase_finalize(kargs(), l, false); } SEAM(pb + 4);
        if (PM(6) && IN(pb + 5)) REP(6) {
            KArgs a = kargs(); unsigned char* ws = a->ws;
            const int Mo = lastl ? NLAT : MALL;
            pg8::Gemm g{(const bf16*)(ws + WS_Y8), (const bf16*)(ws + WS_WOUT + (size_t)l * D * D), Mo, D, D / 2};
            pg8::StaticOrder S; S.init(Mo, D, G, (int)blockIdx.x);
            const float* xl = l == 0 ? a->in[I_X] : (const float*)(ws + WS_X); const float* xc = l == 0 ? a->in[I_CTX] : (const float*)(ws + WS_X) + (size_t)NLAT * D;
            pg8::EpiResid E{xl, xc, (float*)(ws + WS_X), (const float*)(ws + WS_MOD) + (size_t)l * 9 * 12288 + 2 * D};
            pg8::gemm_phase8<pg8::EpiResid, pg8::StaticOrder, true, false>(lds, g, S, E, nullptr);
        } SEAM(pb + 5);
        if (PM(7) && IN(pb + 6)) { if ((PROBE_DUP >> 7) & 1) phase_norm2_router(kargs(), l, true, lds); phase_norm2_router(kargs(), l, false, lds); } SEAM(pb + 6);
        if (PM(8) && IN(pb + 7)) REP(8) {
            KArgs a = kargs(); unsigned char* ws = a->ws;
            moe_tables<false>(a, l, lds, cvirt);
            pg8::Gemm g{(const bf16*)(ws + WS_H), (const bf16*)(ws + WS_WGU), 0, 2048, D / 2};
            pg8::MoeOrder S{(const LAS int*)(lds + LDS_TP), G, cvirt, (unsigned)(2048 * D)};
            pg8::EpiSwiglu E{ws + WS_ACT};
            pg8::gemm_phase8<pg8::EpiSwiglu, pg8::MoeOrder, false, true>(lds, g, S, E, (const LAS unsigned*)(lds + LDS_TAB));
        } SEAM(pb + 7);
        if (PM(9) && IN(pb + 8)) REP(9) {
            KArgs a = kargs(); unsigned char* ws = a->ws;
            moe_tables<true>(a, l, lds, cvirt);
            pg8::Gemm g{(const bf16*)(ws + WS_ACT), (const bf16*)(ws + WS_WDN), 0, D, DE / 2};
            pg8::MoeOrder S{(const LAS int*)(lds + LDS_TP), G, cvirt, (unsigned)(D * DE)};
            pg8::EpiDown E{ws + WS_YK, (const LAS unsigned*)(lds + LDS_TAB), (const LAS float*)(lds + LDS_TABW)};
            pg8::gemm_phase8<pg8::EpiDown, pg8::MoeOrder, false, false>(lds, g, S, E, nullptr);
        } SEAM(pb + 8);
    }
    if (PM(10) && IN(1 + 9 * DEPTH)) { if ((PROBE_DUP >> 10) & 1) phase_norm1<2>(kargs(), DEPTH, true); phase_norm1<2>(kargs(), DEPTH, false); }
#undef IN
#undef SEAM
}

extern "C" void kernel_launch(void* const* d_in, const int* in_sizes, int n_in, void* d_out, int out_size, void* d_ws, size_t ws_size, hipStream_t stream) {
    static int grid = 0;
    if (grid == 0) {
        if (n_in != 31 || ws_size < WS_END) { fprintf(stderr, "kernel_launch: unexpected n_in %d / ws %zu (need %zu)\n", n_in, ws_size, (size_t)WS_END); grid = -1; return; }
        int dev = 0, cus = 0, per_cu = 0;
        hipGetDevice(&dev); hipDeviceGetAttribute(&cus, hipDeviceAttributeMultiprocessorCount, dev);
        if (hipFuncSetAttribute((const void*)mk_fwd, hipFuncAttributeMaxDynamicSharedMemorySize, LDS_BYTES) != hipSuccess) { fprintf(stderr, "kernel_launch: hipFuncSetAttribute failed\n"); grid = -1; return; }
        if (hipOccupancyMaxActiveBlocksPerMultiprocessor(&per_cu, (const void*)mk_fwd, NTHREADS, LDS_BYTES) != hipSuccess || per_cu < 1) fprintf(stderr, "kernel_launch: occupancy query says %d\n", per_cu);
        (void)hipGetLastError();
        grid = cus > 0 ? cus : 256;
    }
    if (grid < 0) return;
    hipMemsetAsync((char*)d_ws + WS_CTL, 0, CTL_ZERO_BYTES, stream);
    Args a{};
    for (int i = 0; i < 31; ++i) a.in[i] = (const float*)d_in[i];
    a.out = (float*)d_out; a.ws = (unsigned char*)d_ws;
    constexpr int NPH = 2 + 9 * DEPTH;
#if MK_MULTI
    for (int p = 0; p < NPH; ++p) { a.ph_lo = p; a.ph_hi = p + 1; hipLaunchKernelGGL(mk_fwd, dim3(grid), dim3(NTHREADS), LDS_BYTES, stream, a); }
#else
    a.ph_lo = 0; a.ph_hi = NPH; hipLaunchKernelGGL(mk_fwd, dim3(grid), dim3(NTHREADS), LDS_BYTES, stream, a);
#endif
}
```

```cpp
#include <hip/hip_runtime.h>
#include <cstdio>
#include <cstdint>

#ifndef PHMASK
#define PHMASK 0xFFFF
#endif
#ifndef PROBE_DUP
#define PROBE_DUP 0
#endif
#ifndef MK_MULTI
#define MK_MULTI 0
#endif

#define GAS __attribute__((address_space(1)))
#define LAS __attribute__((address_space(3)))
typedef unsigned short bf16;
typedef short bf16x8 __attribute__((ext_vector_type(8)));
typedef float f32x4 __attribute__((ext_vector_type(4)));
typedef float f32x2 __attribute__((ext_vector_type(2)));
typedef unsigned u32x4 __attribute__((ext_vector_type(4)));
typedef unsigned u32x2 __attribute__((ext_vector_type(2)));

constexpr int D = 2048, NB = 8, T = 4096, CTXL = 256, DEPTH = 2;
constexpr int NLAT = NB * T, NCTX = NB * CTXL, MALL = NLAT + NCTX;
constexpr int INC = 7424;
constexpr int OFF_U = 0, OFF_V = 512, OFF_Q = 1024, OFF_I = 1792, OFF_ZF = 2560, OFF_ZB = 3328, OFF_OG = 4096;
constexpr int OFF_C = 4864;
constexpr int BW = 768, CW = 768, CCOLS = 2560;
constexpr int NE = 16, DE = 1024;
constexpr int PC2W = 7 * 768;
constexpr int NTHREADS = 512;
constexpr float NORM_EPS = 1e-6f, GN_EPS = 64e-5f, DECAY_SCALE = 0.60653065971263342f;

constexpr size_t MiB = 1u << 20;
constexpr size_t WS_CTL = 0, CTL_ZERO_BYTES = 1 * MiB;
constexpr size_t WS_MOD = 1 * MiB;
constexpr size_t WS_SMALLW = 2 * MiB;
constexpr size_t SW_WUP = 0, SW_AUP = SW_WUP + (size_t)2 * 2 * 768 * 64 * 2, SW_GUP = SW_AUP + (size_t)2 * 768 * 64 * 2, SW_GWS = SW_GUP + (size_t)2 * 768 * 128 * 2;
constexpr size_t WS_WIN = 4 * MiB, WS_WOUT = 62 * MiB, WS_WGU = 78 * MiB, WS_WDN = 142 * MiB, WS_Y8 = 174 * MiB;
constexpr size_t WS_X = 270 * MiB, WS_H = 542 * MiB, WS_Y = 678 * MiB, WS_P = 814 * MiB, WS_PRE = 1307 * MiB, WS_VT = 1817 * MiB, WS_OC = 1868 * MiB, WS_HQB = 1970 * MiB, WS_HG = 2021 * MiB, WS_END = 2028 * MiB;
constexpr int PRE_REC = 10240, PR_WP = 0, PR_RP = 2048, PR_BK = 4096, PR_ARBK = 8192, PR_MAK = 9216, PR_GAM = 9728, NCHUNK16 = 272;
constexpr size_t WS_OB = WS_H;
constexpr size_t WS_ACT = WS_P, WS_YK = WS_P + 144 * MiB, WS_RIDX = WS_P + 416 * MiB, WS_RW = WS_RIDX + 3 * MiB;
static_assert(WS_RW + 3 * MiB <= WS_PRE, "moe overlay");
constexpr int MAXSLOT_TILES = 288;
constexpr int CW_BAR = 4096;
constexpr int CW_GMQ = 30720;
constexpr int CW_PREPQ = 28672;
constexpr int CW_CNT = 16384;

constexpr int LDS_STAGE = 0, LDS_TAB = 131072, LDS_TABW = LDS_TAB + 9 * 1024, LDS_TP = LDS_TABW + 9 * 1024, LDS_MISC = 150528, LDS_BYTES = 152 * 1024;
static_assert(LDS_TP + 128 <= LDS_MISC, "lds map");

typedef __bf16 bf16x2_t __attribute__((ext_vector_type(2)));
__device__ __forceinline__ unsigned pk2(float lo, float hi) { const f32x2 v = {lo, hi}; return __builtin_bit_cast(unsigned, __builtin_convertvector(v, bf16x2_t)); }
__device__ __forceinline__ unsigned f2bf(float f) { return pk2(f, f) & 0xffffu; }
__device__ __forceinline__ unsigned pk4_fp8(float a, float b, float c, float d) {
    a = __builtin_amdgcn_fmed3f(a, -448.f, 448.f); b = __builtin_amdgcn_fmed3f(b, -448.f, 448.f); c = __builtin_amdgcn_fmed3f(c, -448.f, 448.f); d = __builtin_amdgcn_fmed3f(d, -448.f, 448.f);
    int p = 0; p = __builtin_amdgcn_cvt_pk_fp8_f32(a, b, p, false); p = __builtin_amdgcn_cvt_pk_fp8_f32(c, d, p, true); return (unsigned)p; }
__device__ __forceinline__ float bflo(unsigned u) { return __builtin_bit_cast(float, u << 16); }
__device__ __forceinline__ float bfhi(unsigned u) { return __builtin_bit_cast(float, u & 0xffff0000u); }
__device__ __forceinline__ float bf1(bf16 b) { return __builtin_bit_cast(float, ((unsigned)b) << 16); }
__device__ __forceinline__ float sigmoidf_(float x) { return __builtin_amdgcn_rcpf(1.0f + __expf(-x)); }
__device__ __forceinline__ float siluf_(float x) { return x * __builtin_amdgcn_rcpf(1.0f + __expf(-x)); }
__device__ __forceinline__ float geluf_(float v) {
    const float av = fabsf(v), t = __builtin_amdgcn_rcpf(av * 0.2316418882f + 1.0f);
    float q = t * 0.5307027145f + (-0.7265760135f); q = q * t + 0.7107068705f; q = q * t + (-0.142248368f); q = q * t + 0.127414796f; q = q * t;
    const float e = __builtin_amdgcn_exp2f((v * v) * (-0.72134752044f)); const float m = v * (q * e); return v < 0.f ? m : v - m; }
__device__ __forceinline__ float wave_sum(float v) {
#pragma unroll
    for (int o = 1; o < 64; o <<= 1) v += __shfl_xor(v, o);
    return v;
}
__device__ __forceinline__ int tid_fresh() { int t = threadIdx.x; asm volatile("" : "+v"(t)); return t; }
__device__ __forceinline__ void unpack8(const u32x4 v, float (&f)[8]) {
    f[0] = bflo(v.x); f[1] = bfhi(v.x); f[2] = bflo(v.y); f[3] = bfhi(v.y); f[4] = bflo(v.z); f[5] = bfhi(v.z); f[6] = bflo(v.w); f[7] = bfhi(v.w);
}
__device__ __forceinline__ u32x4 pack8(const float (&f)[8]) { u32x4 v; v.x = pk2(f[0], f[1]); v.y = pk2(f[2], f[3]); v.z = pk2(f[4], f[5]); v.w = pk2(f[6], f[7]); return v; }
__device__ __forceinline__ int modrow_of(int row) { return row < NLAT ? (row >> 12) : 8; }

#define XB_TMO      128
#define XB_XCNT(j)  (256  + 64 * (j))
#define XB_XSUB(j)  (1280 + 64 * (j))
#define XB_XGEN(j)  (2304 + 64 * (j))
#define XB_TOP      3328
#define XB_TOPGEN   3392
#define XCD_BAR_WORDS 3456
#define XB_SPIN_CAP (1u << 18)
__device__ __forceinline__ unsigned xb_ld(unsigned* p)              { return __hip_atomic_load(p, __ATOMIC_RELAXED, __HIP_MEMORY_SCOPE_AGENT); }
__device__ __forceinline__ unsigned xb_add(unsigned* p, unsigned v) { return __hip_atomic_fetch_add(p, v, __ATOMIC_RELAXED, __HIP_MEMORY_SCOPE_AGENT); }
__device__ __forceinline__ unsigned xb_xcc_id() { return (unsigned)__builtin_amdgcn_s_getreg((3 << 11) | 20) & 0xFu; }
#define XB_SPIN(cond, bar) do { unsigned _sp = 0; while (cond) { __builtin_amdgcn_s_sleep(1); \
    if ((++_sp & 255u) == 0u) { if (xb_ld(&(bar)[XB_TMO])) break; if (_sp > XB_SPIN_CAP) { atomicAdd(&(bar)[XB_TMO], 1u); break; } } } } while (0)
struct XcdBarrier { unsigned* bar; unsigned x; volatile LAS unsigned* st; };
__device__ __forceinline__ XcdBarrier xcd_barrier_post(unsigned* bar, volatile LAS unsigned* st) {
    XcdBarrier b; b.bar = bar; b.x = xb_xcc_id(); b.st = st;
    if (threadIdx.x == 0) (void)xb_add(&bar[XB_XCNT(b.x)], 1u);
    return b;
}
__device__ __forceinline__ void xcd_barrier_complete(unsigned* bar, unsigned x, unsigned& nloc, unsigned& nx) {
    const unsigned G = gridDim.x * gridDim.y * gridDim.z;
    unsigned sum, cnt, mine, sp = 0u;
    for (;;) {
        sum = 0u; cnt = 0u; mine = 0u;
#pragma unroll
        for (unsigned j = 0; j < 16; ++j) { const unsigned c = xb_ld(&bar[XB_XCNT(j)]); sum += c; cnt += (c > 0u) ? 1u : 0u; mine = (j == x) ? c : mine; }
        if (sum == G) break;
        __builtin_amdgcn_s_sleep(1);
        if ((++sp & 255u) == 0u) { if (xb_ld(&bar[XB_TMO])) break; if (sp > XB_SPIN_CAP) { atomicAdd(&bar[XB_TMO], 1u); break; } }
    }
    nloc = mine > 0u ? mine : 1u; nx = cnt > 0u ? cnt : 1u;
}
__device__ __forceinline__ void xcd_barrier(const XcdBarrier& b) {
    asm volatile("s_waitcnt vmcnt(0)" ::: "memory");
    __syncthreads();
    if (threadIdx.x == 0) {
        unsigned* bar = b.bar;
        __builtin_amdgcn_s_waitcnt(0);
        unsigned nloc = b.st[0], nx = b.st[1];
        if (nloc == 0u) { xcd_barrier_complete(bar, b.x, nloc, nx); b.st[0] = nloc; b.st[1] = nx; }
        const unsigned old = xb_add(&bar[XB_XSUB(b.x)], 1u);
        const unsigned gen = old / nloc;
        if (old + 1u == (gen + 1u) * nloc) {
            __builtin_amdgcn_fence(__ATOMIC_RELEASE, "agent");
            asm volatile("s_waitcnt vmcnt(0)" ::: "memory");
            const unsigned og = xb_add(&bar[XB_TOP], 1u);
            const unsigned tg = og / nx;
            if (og + 1u == (tg + 1u) * nx) xb_add(&bar[XB_TOPGEN], 1u);
            else XB_SPIN(xb_ld(&bar[XB_TOPGEN]) == tg, bar);
            __builtin_amdgcn_fence(__ATOMIC_ACQUIRE, "agent");
            xb_add(&bar[XB_XGEN(b.x)], 1u);
            asm volatile("s_waitcnt vmcnt(0)" ::: "memory");
        } else {
            XB_SPIN(xb_ld(&bar[XB_XGEN(b.x)]) == gen, bar);
            __builtin_amdgcn_fence(__ATOMIC_ACQUIRE, "agent");
            asm volatile("s_waitcnt vmcnt(0)" ::: "memory");
        }
    }
    __syncthreads();
}

namespace pg8 {
constexpr int BM = 256, BK = 64, HALF = 128, HTB = HALF * BK * 2, STAGE_BYTES = 8 * HTB, NXCD = 8, WGM = 8;
__host__ __device__ __forceinline__ int lds_byte(int r, int c) { const int st = (r >> 4) * 2 + (c >> 5), rr = r & 15, cc = c & 31, ob = rr * 64 + cc * 2; return st * 1024 + (ob ^ (((ob >> 9) & 1) << 5)); }
__host__ __device__ __forceinline__ void stage_rc(int b, int& R, int& C) { const int st = b / 1024, sb = b % 1024, swz = sb ^ (((sb >> 9) & 1) << 5); R = (st >> 1) * 16 + swz / 64; C = (st & 1) * 32 + (swz % 64) / 2; }
__host__ __device__ __forceinline__ int perm32(int rho) { const int n = rho >> 4, i = rho & 15; return 8 * (i >> 2) + 4 * n + (i & 3); }

struct Unit { int pm, pn, e, aux; };
struct Gemm { const bf16* A; const bf16* Bt; int M, N, K; };

struct StaticOrder {
    int nM, nN, nwg, G, c;
    __device__ void init(int M, int N, int G_, int c_) { nM = M / BM; nN = N / BM; nwg = nM * nN; G = G_; c = c_; }
    __device__ bool next(int i, Unit& u) const {
        const long L = (long)i * G + c; if (L >= nwg) return false;
        int wgid = (int)L; { const int q = nwg / NXCD, r = nwg % NXCD, xcd = wgid % NXCD, off = wgid / NXCD; wgid = (xcd < r ? xcd * (q + 1) : r * (q + 1) + (xcd - r) * q) + off; }
        const int nig = WGM * nN, gid = wgid / nig, fm = gid * WGM, gsz = (nM - fm) < WGM ? (nM - fm) : WGM;
        u.pm = fm + ((wgid % nig) % gsz); u.pn = (wgid % nig) / gsz; u.e = 0; u.aux = 0; return true;
    }
    __device__ __forceinline__ unsigned b_off(const Unit& u, unsigned tstep) const { return (unsigned)u.pn * tstep; }
};
struct MoeOrder {
    const LAS int* tp; int G, c; unsigned estride;
    __device__ bool next(int i, Unit& u) const {
        const int L = i * G + c; const int ntot = tp[16] * 8; if (L >= ntot) return false;
        const int tile = L >> 3; int e = 0;
#pragma unroll
        for (int j = 1; j < 16; ++j) e += (tile >= tp[j]) ? 1 : 0;
        u.pm = tile; u.pn = L & 7; u.e = e; u.aux = i; return true;
    }
    __device__ __forceinline__ unsigned b_off(const Unit& u, unsigned tstep) const { return (unsigned)u.e * estride + (unsigned)u.pn * tstep; }
};

#define PG8_LAS __attribute__((address_space(3)))
template <class Epi, class Sched, bool ALIGN_EPI, bool GATHER>
__device__ __forceinline__ void gemm_phase(PG8_LAS unsigned char* lds, const Gemm g, const Sched& S, const Epi& E, const PG8_LAS unsigned* tabA) {
    const int tid = tid_fresh(), wid = __builtin_amdgcn_readfirstlane(tid >> 6), lane = tid & 63, wr = wid >> 2, wc = wid & 3, fr = lane & 15, fq = lane >> 4;
    const int K = g.K, nt = K / BK;
    int sR[2], sC[2];
    unsigned voffB[2];
#pragma unroll
    for (int i = 0; i < 2; ++i) { int R, C; stage_rc(tid * 16 + i * 8192, R, C); sR[i] = R; sC[i] = C; const int Rb = Epi::PERM ? ((R & ~31) + perm32(R & 31)) : R;
        voffB[i] = (unsigned)(Rb * K + C) * 2u; }
    const unsigned kstep = (unsigned)(BK * 2);
    const unsigned hstep = (unsigned)(HALF * K * 2);
    const unsigned tstep = 2u * hstep;
    const unsigned ldsw = (unsigned)wid * 1024u;
    const char* const baseA = (const char*)g.A; const char* const baseB = (const char*)g.Bt;
    const int aoff = lds_byte(wr * 64 + fr, fq * 8), boff = lds_byte(wc * 32 + fr, fq * 8);
#define PG8_SA(b, h) (((b) * 2 + (h)) * HTB)
#define PG8_SB(b, h) ((4 + (b) * 2 + (h)) * HTB)
#define PG8_STAGE(bufoff, gbase, uoff, voff) do { _Pragma("unroll") for (int _i = 0; _i < 2; ++_i) \
        __builtin_amdgcn_global_load_lds((const unsigned*)((gbase) + (size_t)(unsigned)((uoff) + (voff)[_i])), (PG8_LAS unsigned*)(lds + (bufoff) + ldsw + _i * 8192), 16, 0, 0); } while (0)
#define PG8_LDA(dst, b, h) do { _Pragma("unroll") for (int m = 0; m < 4; ++m) _Pragma("unroll") for (int k = 0; k < 2; ++k) dst[m][k] = *(const PG8_LAS bf16x8*)(lds + PG8_SA(b, h) + aoff + m * 2048 + k * 1024); } while (0)
#define PG8_LDB(dst, b, h) do { _Pragma("unroll") for (int n = 0; n < 2; ++n) _Pragma("unroll") for (int k = 0; k < 2; ++k) dst[n][k] = *(const PG8_LAS bf16x8*)(lds + PG8_SB(b, h) + boff + n * 2048 + k * 1024); } while (0)
#define PG8_MMA(ai, bj, At, Bt) do { __builtin_amdgcn_s_setprio(1); _Pragma("unroll") for (int m = 0; m < 4; ++m) _Pragma("unroll") for (int n = 0; n < 2; ++n) _Pragma("unroll") for (int k = 0; k < 2; ++k) \
        acc[ai][bj][m][n] = __builtin_amdgcn_mfma_f32_16x16x32_bf16(Bt[n][k], At[m][k], acc[ai][bj][m][n], 0, 0, 0); __builtin_amdgcn_s_setprio(0); } while (0)
#define PG8_WAIT_V(n) asm volatile("s_waitcnt vmcnt(" #n ")" ::: "memory")
#define PG8_WAIT_L(n) asm volatile("s_waitcnt lgkmcnt(" #n ")" ::: "memory")
#define PG8_BAR __builtin_amdgcn_s_barrier()
#define PG8_SCHED __builtin_amdgcn_sched_barrier(0)
    Unit cur, nxt; int ui = 0;
    if (!S.next(0, cur)) return;
    f32x4 acc[2][2][4][2];
#pragma unroll
    for (int a = 0; a < 2; ++a)
#pragma unroll
        for (int b = 0; b < 2; ++b)
#pragma unroll
            for (int m = 0; m < 4; ++m)
#pragma unroll
                for (int n = 0; n < 2; ++n) acc[a][b][m][n] = (f32x4){0.f, 0.f, 0.f, 0.f};
    bf16x8 At[4][2], B0[2][2], B1[2][2];
    unsigned vA0[2], vA1[2], nA0[2], nA1[2];
    unsigned uA, uB = S.b_off(cur, tstep);
    if constexpr (GATHER) { uA = 0u;
#pragma unroll
        for (int i = 0; i < 2; ++i) { vA0[i] = tabA[cur.aux * 256 + sR[i]] + (unsigned)sC[i] * 2u; vA1[i] = tabA[cur.aux * 256 + 128 + sR[i]] + (unsigned)sC[i] * 2u; }
    } else { uA = (unsigned)cur.pm * tstep;
#pragma unroll
        for (int i = 0; i < 2; ++i) { vA0[i] = (unsigned)(sR[i] * K + sC[i]) * 2u; vA1[i] = vA0[i] + hstep; }
    }
    PG8_STAGE(PG8_SB(0, 0), baseB, uB, voffB); PG8_STAGE(PG8_SB(0, 1), baseB, uB + hstep, voffB); PG8_STAGE(PG8_SA(0, 0), baseA, uA, vA0); PG8_STAGE(PG8_SA(0, 1), baseA, uA, vA1);
    if (wr == 1) PG8_BAR;
    PG8_WAIT_V(2); PG8_BAR;
    PG8_STAGE(PG8_SB(1, 0), baseB, uB + kstep, voffB); PG8_STAGE(PG8_SA(1, 0), baseA, uA + kstep, vA0); PG8_STAGE(PG8_SB(1, 1), baseB, uB + hstep + kstep, voffB);
    PG8_WAIT_V(6); PG8_BAR;
    for (;;) {
        const bool has_next = S.next(ui + 1, nxt);
        unsigned nuA, nuB = has_next ? S.b_off(nxt, tstep) : uB;
        if constexpr (GATHER) { nuA = 0u;
#pragma unroll
            for (int i = 0; i < 2; ++i) { if (has_next) { nA0[i] = tabA[nxt.aux * 256 + sR[i]] + (unsigned)sC[i] * 2u; nA1[i] = tabA[nxt.aux * 256 + 128 + sR[i]] + (unsigned)sC[i] * 2u; } else { nA0[i] = vA0[i]; nA1[i] = vA1[i]; } }
        } else { nuA = has_next ? (unsigned)nxt.pm * tstep : uA;
#pragma unroll
            for (int i = 0; i < 2; ++i) { nA0[i] = vA0[i]; nA1[i] = vA1[i]; }
        }
#pragma unroll 1
        for (int t = 0; t < nt; t += 2) {
            const bool last = (t == nt - 2);
            const unsigned a1 = uA + (unsigned)(t + 1) * kstep;
            const unsigned a2 = last ? nuA : uA + (unsigned)(t + 2) * kstep; const unsigned b2 = last ? nuB : uB + (unsigned)(t + 2) * kstep;
            const unsigned a3 = a2 + kstep; const unsigned b3 = b2 + kstep;
            unsigned w0[2], w1[2];
#pragma unroll
            for (int i = 0; i < 2; ++i) { w0[i] = (GATHER && last) ? nA0[i] : vA0[i]; w1[i] = (GATHER && last) ? nA1[i] : vA1[i]; }
            PG8_LDB(B0, 0, 0); PG8_LDB(B1, 0, 1); PG8_SCHED; PG8_LDA(At, 0, 0); PG8_STAGE(PG8_SA(1, 1), baseA, a1, vA1);
            PG8_WAIT_V(8); PG8_WAIT_L(0); PG8_BAR; PG8_MMA(0, 0, At, B0); PG8_MMA(0, 1, At, B1); PG8_BAR; PG8_SCHED;
            PG8_LDA(At, 0, 1); PG8_STAGE(PG8_SB(0, 0), baseB, b2, voffB); PG8_STAGE(PG8_SB(0, 1), baseB, b2 + hstep, voffB); PG8_STAGE(PG8_SA(0, 0), baseA, a2, w0);
            PG8_WAIT_V(8); PG8_WAIT_L(0); PG8_BAR; PG8_MMA(1, 0, At, B0); PG8_MMA(1, 1, At, B1); PG8_BAR; PG8_SCHED;
            PG8_LDB(B0, 1, 0); PG8_LDB(B1, 1, 1); PG8_SCHED; PG8_LDA(At, 1, 0); PG8_STAGE(PG8_SA(0, 1), baseA, a2, w1);
            PG8_WAIT_V(8); PG8_WAIT_L(0); PG8_BAR; PG8_MMA(0, 0, At, B0); PG8_MMA(0, 1, At, B1); PG8_BAR; PG8_SCHED;
            PG8_LDA(At, 1, 1); PG8_STAGE(PG8_SB(1, 0), baseB, b3, voffB); PG8_STAGE(PG8_SB(1, 1), baseB, b3 + hstep, voffB); PG8_STAGE(PG8_SA(1, 0), baseA, a3, w0);
            PG8_WAIT_V(8); PG8_WAIT_L(0); PG8_BAR; PG8_MMA(1, 0, At, B0); PG8_MMA(1, 1, At, B1); PG8_BAR; PG8_SCHED;
        }
        if constexpr (ALIGN_EPI) { if (wr == 0) PG8_BAR; }
        E(acc, cur, wr, wc, fr, fq);
        if (!has_next) break;
#pragma unroll
        for (int a = 0; a < 2; ++a)
#pragma unroll
            for (int b = 0; b < 2; ++b)
#pragma unroll
                for (int m = 0; m < 4; ++m)
#pragma unroll
                    for (int n = 0; n < 2; ++n) acc[a][b][m][n] = (f32x4){0.f, 0.f, 0.f, 0.f};
        cur = nxt; uA = nuA; uB = nuB; ++ui;
#pragma unroll
        for (int i = 0; i < 2; ++i) { vA0[i] = nA0[i]; vA1[i] = nA1[i]; }
        if constexpr (ALIGN_EPI) { if (wr == 1) PG8_BAR; }
    }
    PG8_WAIT_V(0);
    if constexpr (!ALIGN_EPI) { if (wr == 0) PG8_BAR; }
    PG8_BAR;
#undef PG8_SA
#undef PG8_SB
#undef PG8_STAGE
#undef PG8_LDA
#undef PG8_LDB
#undef PG8_MMA
#undef PG8_WAIT_V
#undef PG8_WAIT_L
#undef PG8_BAR
#undef PG8_SCHED
}

typedef int i32x8v __attribute__((ext_vector_type(8)));
typedef int i32x4v __attribute__((ext_vector_type(4)));
template <class Epi, class Sched, bool ALIGN_EPI, bool GATHER>
__device__ __forceinline__ void gemm_phase8(PG8_LAS unsigned char* lds, const Gemm g, const Sched& S, const Epi& E, const PG8_LAS unsigned* tabA) {
    const int tid = tid_fresh(), wid = __builtin_amdgcn_readfirstlane(tid >> 6), lane = tid & 63, wr = wid >> 2, wc = wid & 3, fr = lane & 15, fq = lane >> 4;
    const int K = g.K, nt = K / BK;
    int sR[2], sC[2];
    unsigned voffB[2];
#pragma unroll
    for (int i = 0; i < 2; ++i) { int R, C; stage_rc(tid * 16 + i * 8192, R, C); sR[i] = R; sC[i] = C; const int Rb = Epi::PERM ? ((R & ~31) + perm32(R & 31)) : R;
        voffB[i] = (unsigned)(Rb * K + C) * 2u; }
    const unsigned kstep = (unsigned)(BK * 2);
    const unsigned hstep = (unsigned)(HALF * K * 2);
    const unsigned tstep = 2u * hstep;
    const unsigned ldsw = (unsigned)wid * 1024u;
    const char* const baseA = (const char*)g.A; const char* const baseB = (const char*)g.Bt;
    const int aoff = lds_byte(wr * 64 + fr, 32 * (fq >> 1) + 16 * (fq & 1)), boff = lds_byte(wc * 32 + fr, 32 * (fq >> 1) + 16 * (fq & 1));
#define PG8_SA(b, h) (((b) * 2 + (h)) * HTB)
#define PG8_SB(b, h) ((4 + (b) * 2 + (h)) * HTB)
#define PG8_STAGE(bufoff, gbase, uoff, voff) do { _Pragma("unroll") for (int _i = 0; _i < 2; ++_i) \
        __builtin_amdgcn_global_load_lds((const unsigned*)((gbase) + (size_t)(unsigned)((uoff) + (voff)[_i])), (PG8_LAS unsigned*)(lds + (bufoff) + ldsw + _i * 8192), 16, 0, 0); } while (0)
#define PG8_LD32(p) __builtin_shufflevector(*(const PG8_LAS i32x4v*)(p), *(const PG8_LAS i32x4v*)((p) + 16), 0, 1, 2, 3, 4, 5, 6, 7)
#define PG8_LDA(dst, b, h) do { _Pragma("unroll") for (int m = 0; m < 4; ++m) dst[m] = PG8_LD32(lds + PG8_SA(b, h) + aoff + m * 2048); } while (0)
#define PG8_LDB(dst, b, h) do { _Pragma("unroll") for (int n = 0; n < 2; ++n) dst[n] = PG8_LD32(lds + PG8_SB(b, h) + boff + n * 2048); } while (0)
#define PG8_MMA(ai, bj, At, Bt) do { __builtin_amdgcn_s_setprio(1); _Pragma("unroll") for (int m = 0; m < 4; ++m) _Pragma("unroll") for (int n = 0; n < 2; ++n) \
        asm volatile("v_mfma_scale_f32_16x16x128_f8f6f4 %0, %1, %2, %0, %3, %4 op_sel_hi:[0,0,0]" : "+v"(acc[ai][bj][m][n]) : "v"(Bt[n]), "v"(At[m]), "v"(scw), "v"(sca)); __builtin_amdgcn_s_setprio(0); } while (0)
#define PG8_MFMA_DRAIN asm volatile("s_nop 15\n\ts_nop 15\n\ts_nop 15" ::: "memory")
#define PG8_WAIT_V(n) asm volatile("s_waitcnt vmcnt(" #n ")" ::: "memory")
#define PG8_WAIT_L(n) asm volatile("s_waitcnt lgkmcnt(" #n ")" ::: "memory")
#define PG8_BAR __builtin_amdgcn_s_barrier()
#define PG8_SCHED __builtin_amdgcn_sched_barrier(0)
    Unit cur, nxt; int ui = 0;
    if (!S.next(0, cur)) return;
    f32x4 acc[2][2][4][2];
#pragma unroll
    for (int a = 0; a < 2; ++a)
#pragma unroll
        for (int b = 0; b < 2; ++b)
#pragma unroll
            for (int m = 0; m < 4; ++m)
#pragma unroll
                for (int n = 0; n < 2; ++n) acc[a][b][m][n] = (f32x4){0.f, 0.f, 0.f, 0.f};
    i32x8v At[4], B0[2], B1[2];
    int scw = 0x7a7a7a7a, sca = 0x7f7f7f7f;
    asm volatile("" : "+v"(scw), "+v"(sca));
    unsigned vA0[2], vA1[2], nA0[2], nA1[2];
    unsigned uA, uB = S.b_off(cur, tstep);
    if constexpr (GATHER) { uA = 0u;
#pragma unroll
        for (int i = 0; i < 2; ++i) { vA0[i] = tabA[cur.aux * 256 + sR[i]] + (unsigned)sC[i] * 2u; vA1[i] = tabA[cur.aux * 256 + 128 + sR[i]] + (unsigned)sC[i] * 2u; }
    } else { uA = (unsigned)cur.pm * tstep;
#pragma unroll
        for (int i = 0; i < 2; ++i) { vA0[i] = (unsigned)(sR[i] * K + sC[i]) * 2u; vA1[i] = vA0[i] + hstep; }
    }
    PG8_STAGE(PG8_SB(0, 0), baseB, uB, voffB); PG8_STAGE(PG8_SB(0, 1), baseB, uB + hstep, voffB); PG8_STAGE(PG8_SA(0, 0), baseA, uA, vA0); PG8_STAGE(PG8_SA(0, 1), baseA, uA, vA1);
    if (wr == 1) PG8_BAR;
    PG8_WAIT_V(2); PG8_BAR;
    PG8_STAGE(PG8_SB(1, 0), baseB, uB + kstep, voffB); PG8_STAGE(PG8_SA(1, 0), baseA, uA + kstep, vA0); PG8_STAGE(PG8_SB(1, 1), baseB, uB + hstep + kstep, voffB);
    PG8_WAIT_V(6); PG8_BAR;
    for (;;) {
        const bool has_next = S.next(ui + 1, nxt);
        unsigned nuA, nuB = has_next ? S.b_off(nxt, tstep) : uB;
        if constexpr (GATHER) { nuA = 0u;
#pragma unroll
            for (int i = 0; i < 2; ++i) { if (has_next) { nA0[i] = tabA[nxt.aux * 256 + sR[i]] + (unsigned)sC[i] * 2u; nA1[i] = tabA[nxt.aux * 256 + 128 + sR[i]] + (unsigned)sC[i] * 2u; } else { nA0[i] = vA0[i]; nA1[i] = vA1[i]; } }
        } else { nuA = has_next ? (unsigned)nxt.pm * tstep : uA;
#pragma unroll
            for (int i = 0; i < 2; ++i) { nA0[i] = vA0[i]; nA1[i] = vA1[i]; }
        }
#pragma unroll 1
        for (int t = 0; t < nt; t += 2) {
            const bool last = (t == nt - 2);
            const unsigned a1 = uA + (unsigned)(t + 1) * kstep;
            const unsigned a2 = last ? nuA : uA + (unsigned)(t + 2) * kstep; const unsigned b2 = last ? nuB : uB + (unsigned)(t + 2) * kstep;
            const unsigned a3 = a2 + kstep; const unsigned b3 = b2 + kstep;
            unsigned w0[2], w1[2];
#pragma unroll
            for (int i = 0; i < 2; ++i) { w0[i] = (GATHER && last) ? nA0[i] : vA0[i]; w1[i] = (GATHER && last) ? nA1[i] : vA1[i]; }
            PG8_LDB(B0, 0, 0); PG8_LDB(B1, 0, 1); PG8_SCHED; PG8_LDA(At, 0, 0); PG8_STAGE(PG8_SA(1, 1), baseA, a1, vA1);
            PG8_WAIT_V(8); PG8_WAIT_L(0); PG8_BAR; PG8_MMA(0, 0, At, B0); PG8_MMA(0, 1, At, B1); PG8_BAR; PG8_SCHED;
            PG8_LDA(At, 0, 1); PG8_STAGE(PG8_SB(0, 0), baseB, b2, voffB); PG8_STAGE(PG8_SB(0, 1), baseB, b2 + hstep, voffB); PG8_STAGE(PG8_SA(0, 0), baseA, a2, w0);
            PG8_WAIT_V(8); PG8_WAIT_L(0); PG8_BAR; PG8_MMA(1, 0, At, B0); PG8_MMA(1, 1, At, B1); PG8_BAR; PG8_SCHED;
            PG8_LDB(B0, 1, 0); PG8_LDB(B1, 1, 1); PG8_SCHED; PG8_LDA(At, 1, 0); PG8_STAGE(PG8_SA(0, 1), baseA, a2, w1);
            PG8_WAIT_V(8); PG8_WAIT_L(0); PG8_BAR; PG8_MMA(0, 0, At, B0); PG8_MMA(0, 1, At, B1); PG8_BAR; PG8_SCHED;
            PG8_LDA(At, 1, 1); PG8_STAGE(PG8_SB(1, 0), baseB, b3, voffB); PG8_STAGE(PG8_SB(1, 1), baseB, b3 + hstep, voffB); PG8_STAGE(PG8_SA(1, 0), baseA, a3, w0);
            PG8_WAIT_V(8); PG8_WAIT_L(0); PG8_BAR; PG8_MMA(1, 0, At, B0); PG8_MMA(1, 1, At, B1); PG8_BAR; PG8_SCHED;
        }
        if constexpr (ALIGN_EPI) { if (wr == 0) PG8_BAR; }
        PG8_MFMA_DRAIN;
        { const int l2 = tid_fresh() & 63; E(acc, cur, wr, wc, l2 & 15, l2 >> 4); }
        if (!has_next) break;
#pragma unroll
        for (int a = 0; a < 2; ++a)
#pragma unroll
            for (int b = 0; b < 2; ++b)
#pragma unroll
                for (int m = 0; m < 4; ++m)
#pragma unroll
                    for (int n = 0; n < 2; ++n) acc[a][b][m][n] = (f32x4){0.f, 0.f, 0.f, 0.f};
        cur = nxt; uA = nuA; uB = nuB; ++ui;
#pragma unroll
        for (int i = 0; i < 2; ++i) { vA0[i] = nA0[i]; vA1[i] = nA1[i]; }
        if constexpr (ALIGN_EPI) { if (wr == 1) PG8_BAR; }
    }
    PG8_WAIT_V(0);
    if constexpr (!ALIGN_EPI) { if (wr == 0) PG8_BAR; }
    PG8_BAR;
#undef PG8_SA
#undef PG8_SB
#undef PG8_STAGE
#undef PG8_LDA
#undef PG8_LD32
#undef PG8_LDB
#undef PG8_MMA
#undef PG8_MFMA_DRAIN
#undef PG8_WAIT_V
#undef PG8_WAIT_L
#undef PG8_BAR
#undef PG8_SCHED
}

__device__ __forceinline__ unsigned cvt_pk_bf16(float lo, float hi) { return pk2(lo, hi); }

struct EpiBf16 {
    static constexpr bool PERM = true;
    bf16* O; int ldc;
    __device__ __forceinline__ void operator()(const f32x4 (&acc)[2][2][4][2], const Unit& u, int wr, int wc, int fr, int fq) const {
        const int row0 = u.pm * BM + wr * 64 + fr; const int col0 = u.pn * BM + wc * 32 + 8 * fq;
#pragma unroll
        for (int ai = 0; ai < 2; ++ai)
#pragma unroll
            for (int m = 0; m < 4; ++m) { bf16* rowp = O + (size_t)(row0 + ai * HALF + m * 16) * ldc + col0;
#pragma unroll
                for (int bj = 0; bj < 2; ++bj) { const f32x4 v0 = acc[ai][bj][m][0], v1 = acc[ai][bj][m][1];
                    u32x4 w; w.x = cvt_pk_bf16(v0[0], v0[1]); w.y = cvt_pk_bf16(v0[2], v0[3]); w.z = cvt_pk_bf16(v1[0], v1[1]); w.w = cvt_pk_bf16(v1[2], v1[3]);
                    *(u32x4*)(rowp + bj * HALF) = w; } }
    }
};
struct EpiResid {
    static constexpr bool PERM = true;
    const float* xl; const float* xc; bf16* X; const float* gate; bool f32base;
    __device__ __forceinline__ void operator()(const f32x4 (&acc)[2][2][4][2], const Unit& u, int wr, int wc, int fr, int fq) const {
        const int rt = u.pm * BM; const bool isl = rt < NLAT;
        const float* base = isl ? xl + (size_t)rt * D : xc + (size_t)(rt - NLAT) * D;
        const float* gp = gate + (size_t)(isl ? (rt >> 12) : 8) * 12288;
        const int rl0 = wr * 64 + fr, col0 = u.pn * BM + wc * 32 + 8 * fq;
#pragma unroll
        for (int ai = 0; ai < 2; ++ai)
#pragma unroll
            for (int m = 0; m < 4; ++m) { const int rl = rl0 + ai * HALF + m * 16; const float* bp = base + (size_t)rl * D + col0; bf16* op = X + (size_t)(rt + rl) * D + col0;
#pragma unroll
                for (int bj = 0; bj < 2; ++bj) { f32x4 b0, b1;
                    if (f32base) { b0 = *(const f32x4*)(bp + bj * HALF); b1 = *(const f32x4*)(bp + bj * HALF + 4); }
                    else { const u32x4 t = *(const u32x4*)(op + bj * HALF); b0 = (f32x4){bflo(t.x), bfhi(t.x), bflo(t.y), bfhi(t.y)}; b1 = (f32x4){bflo(t.z), bfhi(t.z), bflo(t.w), bfhi(t.w)}; }
                    const f32x4 g0 = *(const f32x4*)(gp + col0 + bj * HALF), g1 = *(const f32x4*)(gp + col0 + bj * HALF + 4);
                    const f32x4 r0 = b0 + g0 * acc[ai][bj][m][0], r1 = b1 + g1 * acc[ai][bj][m][1];
                    u32x4 w; w.x = cvt_pk_bf16(r0[0], r0[1]); w.y = cvt_pk_bf16(r0[2], r0[3]); w.z = cvt_pk_bf16(r1[0], r1[1]); w.w = cvt_pk_bf16(r1[2], r1[3]);
                    *(u32x4*)(op + bj * HALF) = w; }
                asm volatile("" ::: "memory"); }
    }
};
struct EpiSwiglu {
    static constexpr bool PERM = true;
    unsigned char* O;
    __device__ __forceinline__ void operator()(const f32x4 (&acc)[2][2][4][2], const Unit& u, int wr, int wc, int fr, int fq) const {
        const int row0 = u.pm * BM + wr * 64 + fr; const int col0 = u.pn * 128 + wc * 32 + 8 * fq;
#pragma unroll
        for (int ai = 0; ai < 2; ++ai)
#pragma unroll
            for (int m = 0; m < 4; ++m) { unsigned char* rowp = O + (size_t)(row0 + ai * HALF + m * 16) * DE + col0;
                float o[8];
#pragma unroll
                for (int n = 0; n < 2; ++n)
#pragma unroll
                    for (int j = 0; j < 4; ++j) { const float gt = acc[ai][0][m][n][j], up = acc[ai][1][m][n][j]; o[n * 4 + j] = gt * __builtin_amdgcn_rcpf(1.0f + __expf(-gt)) * up; }
                u32x2 w; w.x = pk4_fp8(o[0], o[1], o[2], o[3]); w.y = pk4_fp8(o[4], o[5], o[6], o[7]);
                *(u32x2*)rowp = w; }
    }
};
struct EpiDown {
    static constexpr bool PERM = true;
    unsigned char* YK; const PG8_LAS unsigned* tab; const PG8_LAS float* tabw;
    __device__ __forceinline__ void operator()(const f32x4 (&acc)[2][2][4][2], const Unit& u, int wr, int wc, int fr, int fq) const {
        const int rl0 = wr * 64 + fr; const int col0 = u.pn * BM + wc * 32 + 8 * fq;
#pragma unroll
        for (int ai = 0; ai < 2; ++ai)
#pragma unroll
            for (int m = 0; m < 4; ++m) { const int rl = rl0 + ai * HALF + m * 16; const unsigned ent = tab[u.aux * 256 + rl]; const float w = tabw[u.aux * 256 + rl];
                if (!(ent & 0x40000000u)) { unsigned char* rowp = YK + ((size_t)(ent >> 31) * MALL + (ent & 0xffffu)) * D + col0;
#pragma unroll
                    for (int bj = 0; bj < 2; ++bj) { const f32x4 v0 = acc[ai][bj][m][0] * w, v1 = acc[ai][bj][m][1] * w;
                        u32x2 q; q.x = pk4_fp8(v0[0], v0[1], v0[2], v0[3]); q.y = pk4_fp8(v1[0], v1[1], v1[2], v1[3]);
                        *(u32x2*)(rowp + bj * HALF) = q; } }
                asm volatile("" ::: "memory"); }
    }
};
}

struct Args { const float* in[31]; float* out; unsigned char* ws; int ph_lo, ph_hi; };
typedef const __attribute__((address_space(4))) Args* KArgs;
__device__ __forceinline__ KArgs kargs() { KArgs p = (KArgs)__builtin_amdgcn_kernarg_segment_ptr(); asm volatile("" : "+s"(p)); return p; }
#define AIN(i) (a->in[i])
enum { I_X = 0, I_C, I_CTX, I_CCTX, I_ADAW, I_ADAB, I_N1G, I_N2G, I_WIN, I_WOUT, I_GNG, I_GWS, I_GB, I_LB, I_HNG, I_MU, I_W0, I_WUP, I_A0, I_AUP, I_GUP, I_KK, I_KA, I_RK, I_GNGG, I_GNB, I_RW, I_RB, I_WGU, I_WDN, I_FNG };

__device__ __forceinline__ void p0_transpose_item(const float* W, int K, int N, bf16* WT, int n_row0, LAS float* scr, int kb, int nb, int lane) {
    const int k0 = 64 * kb, n0 = 32 * nb;
#pragma unroll 8
    for (int i = 0; i < 32; ++i) { const int kk = 2 * i + (lane >> 5); scr[kk * 33 + (lane & 31)] = W[(size_t)(k0 + kk) * N + n0 + (lane & 31)]; }
    asm volatile("s_waitcnt lgkmcnt(0)" ::: "memory");
    const int c = lane & 7;
#pragma unroll
    for (int j = 0; j < 4; ++j) { const int n = (lane >> 3) + 8 * j; const LAS float* s = scr + (8 * c) * 33 + n;
        u32x4 o; o.x = pk2(s[0 * 33], s[1 * 33]); o.y = pk2(s[2 * 33], s[3 * 33]); o.z = pk2(s[4 * 33], s[5 * 33]); o.w = pk2(s[6 * 33], s[7 * 33]);
        *(u32x4*)(WT + (size_t)(n_row0 + n) * K + k0 + 8 * c) = o; }
    asm volatile("s_waitcnt lgkmcnt(0)" ::: "memory");
}

__device__ __forceinline__ void p0_transpose_item8(const float* W, int K, int N, unsigned char* WT, int n_row0, LAS float* scr, int kb, int nb, int lane) {
    const int k0 = 64 * kb, n0 = 32 * nb;
    { const int c4 = (lane & 7) * 4;
      f32x4 t[8];
#pragma unroll
      for (int i = 0; i < 8; ++i) t[i] = *(const f32x4*)(W + (size_t)(k0 + 8 * i + (lane >> 3)) * N + n0 + c4);
#pragma unroll
      for (int i = 0; i < 8; ++i) { LAS float* d = scr + (8 * i + (lane >> 3)) * 33 + c4; d[0] = t[i][0]; d[1] = t[i][1]; d[2] = t[i][2]; d[3] = t[i][3]; } }
    asm volatile("s_waitcnt lgkmcnt(0)" ::: "memory");
    const int c = lane & 7;
#pragma unroll
    for (int j = 0; j < 4; ++j) { const int n = (lane >> 3) + 8 * j; const LAS float* sp = scr + (8 * c) * 33 + n;
        u32x2 o; o.x = pk4_fp8(sp[0 * 33] * 32.f, sp[1 * 33] * 32.f, sp[2 * 33] * 32.f, sp[3 * 33] * 32.f); o.y = pk4_fp8(sp[4 * 33] * 32.f, sp[5 * 33] * 32.f, sp[6 * 33] * 32.f, sp[7 * 33] * 32.f);
        *(u32x2*)(WT + (size_t)(n_row0 + n) * K + k0 + 8 * c) = o; }
    asm volatile("s_waitcnt lgkmcnt(0)" ::: "memory");
}
__device__ __forceinline__ void convert_moe(KArgs a, int l, LAS unsigned char* lds) {
    const int tid = tid_fresh(), lane = tid & 63, wave = tid >> 6;
    const int gw = blockIdx.x * 8 + wave, NGW = gridDim.x * 8;
    unsigned char* ws = a->ws;
    LAS float* scr = (LAS float*)(lds + wave * 16384);
    constexpr int I_GU = 32 * 64, I_DN = 16 * 64, N2 = 16 * I_GU, N3 = N2 + 16 * I_DN;
    for (int it = gw; it < N3; it += NGW) {
        if (it < N2) { const int e = it / I_GU, r = it % I_GU, kb = r / 64, nb = r % 64;
            const int n0 = 32 * nb, hh = n0 >> 10, nn = n0 & 1023, row0 = 256 * (nn >> 7) + 128 * hh + (nn & 127);
            p0_transpose_item8(a->in[I_WGU] + (size_t)(l * NE + e) * D * 2048, D, 2048, ws + WS_WGU + (size_t)e * 2048 * D, row0, scr, kb, nb, lane); }
        else { const int q = it - N2, e = q / I_DN, r = q % I_DN, kb = r / 64, nb = r % 64;
            p0_transpose_item8(a->in[I_WDN] + (size_t)(l * NE + e) * DE * D, DE, D, ws + WS_WDN + (size_t)e * D * DE, 32 * nb, scr, kb, nb, lane); }
    }
}
__device__ __forceinline__ void phase_prologue(KArgs a, LAS unsigned char* lds) {
    const int tid = tid_fresh(), lane = tid & 63, wave = tid >> 6;
    const int G = gridDim.x, gw = blockIdx.x * 8 + wave, NGW = G * 8;
    unsigned char* ws = a->ws;
    LAS float* scr = (LAS float*)(lds + wave * 16384);
    constexpr int I_IN = 32 * 232, I_OUT = 32 * 64;
    constexpr int N0 = 2 * I_IN, N1 = N0 + 2 * I_OUT;
    for (int it = gw; it < N1; it += NGW) {
        if (it < N0) { const int l = it / I_IN, r = it % I_IN, kb = r / 232, nb = r % 232;
            p0_transpose_item8(a->in[I_WIN] + (size_t)l * D * INC, D, INC, ws + WS_WIN + (size_t)l * INC * D, 32 * nb, scr, kb, nb, lane); }
        else { const int q = it - N0, l = q / I_OUT, r = q % I_OUT, kb = r / 64, nb = r % 64;
            p0_transpose_item8(a->in[I_WOUT] + (size_t)l * D * D, D, D, ws + WS_WOUT + (size_t)l * D * D, 32 * nb, scr, kb, nb, lane); }
    }
    convert_moe(a, 0, lds);
    {
        const int gt = blockIdx.x * NTHREADS + tid, NGT = G * NTHREADS;
        bf16* wup = (bf16*)(ws + WS_SMALLW + SW_WUP); bf16* aup = (bf16*)(ws + WS_SMALLW + SW_AUP); bf16* gup = (bf16*)(ws + WS_SMALLW + SW_GUP); bf16* gws = (bf16*)(ws + WS_SMALLW + SW_GWS);
        for (int i = gt; i < 2 * 2 * 768 * 64; i += NGT) { const int k = i & 63, n = (i >> 6) % 768, ld = i / (768 * 64); wup[i] = (bf16)f2bf(a->in[I_WUP][((size_t)ld * 64 + k) * 768 + n]); }
        for (int i = gt; i < 2 * 768 * 64; i += NGT) { const int k = i & 63, n = (i >> 6) % 768, l = i / (768 * 64); aup[i] = (bf16)f2bf(a->in[I_AUP][((size_t)l * 64 + k) * 768 + n]); }
        for (int i = gt; i < 2 * 768 * 128; i += NGT) { const int k = i & 127, n = (i >> 7) % 768, l = i / (768 * 128); gup[i] = (bf16)f2bf(a->in[I_GUP][((size_t)l * 128 + k) * 768 + n]); }
        for (int i = gt; i < 2 * 4 * 128 * 128; i += NGT) gws[i] = (bf16)f2bf(a->in[I_GWS][i]);
    }
    __syncthreads();
    {
        LAS float* sv = (LAS float*)lds;
        LAS float* red = (LAS float*)(lds + 73728);
        for (int i = tid; i < 9 * D; i += NTHREADS) { const int r = i / D, k = i % D; const float v = r < 8 ? a->in[I_C][r * D + k] : a->in[I_CCTX][k]; sv[i] = siluf_(v); }
        __syncthreads();
        float* mod = (float*)(ws + WS_MOD);
        for (int it = blockIdx.x; it < 2 * 96; it += G) {
            const int l = it / 96, cb = it % 96, cq = tid & 31, kg = tid >> 5;
            const float* wp = a->in[I_ADAW] + (size_t)l * D * 12288 + (size_t)(kg * 128) * 12288 + cb * 128 + cq * 4;
            f32x4 acc[9];
#pragma unroll
            for (int r = 0; r < 9; ++r) acc[r] = (f32x4){0.f, 0.f, 0.f, 0.f};
#pragma unroll 4
            for (int k = 0; k < 128; ++k) { const f32x4 w = *(const f32x4*)(wp + (size_t)k * 12288);
#pragma unroll
                for (int r = 0; r < 9; ++r) acc[r] += w * sv[r * D + kg * 128 + k]; }
#pragma unroll
            for (int r = 0; r < 9; ++r) *(LAS f32x4*)(red + ((kg * 9 + r) * 128 + cq * 4)) = acc[r];
            __syncthreads();
            for (int o = tid; o < 9 * 128; o += NTHREADS) { const int r = o / 128, c = o % 128; float s = a->in[I_ADAB][(size_t)l * 12288 + cb * 128 + c];
#pragma unroll
                for (int q = 0; q < 16; ++q) s += red[(q * 9 + r) * 128 + c];
                mod[((size_t)l * 9 + r) * 12288 + cb * 128 + c] = s; }
            __syncthreads();
        }
    }
}

template <int MODE>
__device__ __forceinline__ void phase_norm1(KArgs a, int l, bool dry) {
    const int tid_ = tid_fresh(); const int lane = tid_ & 63, wave = tid_ >> 6, gw = blockIdx.x * 8 + wave, NGW = gridDim.x * 8;
    unsigned char* ws = a->ws;
    const float* mod = (const float*)(ws + WS_MOD);
    bf16* X = (bf16*)(ws + WS_X); bf16* H = (bf16*)(ws + WS_H); const bf16* YK = (const bf16*)(ws + WS_YK);
    bf16* Xo = dry ? (bf16*)(ws + WS_END) : X; bf16* Ho = dry ? (bf16*)(ws + WS_END) : H; float* Oo = dry ? (float*)(ws + WS_END) : a->out;
    const int nrows = (MODE == 2) ? NLAT : MALL;
    const int rpw = (nrows + NGW - 1) / NGW; const int r0 = gw * rpw, r1 = (r0 + rpw < nrows) ? r0 + rpw : nrows;
    f32x4 ck[8], cs[8], cg[8]; int cur_mr = -1;
    for (int row = r0; row < r1; ++row) {
        const int mr = modrow_of(row); const int orow = dry ? (row & 2047) : row;
        if (mr != cur_mr) { cur_mr = mr;
#pragma unroll
            for (int j = 0; j < 8; ++j) { const int c = 4 * lane + 256 * j;
                if (MODE == 2) ck[j] = *(const f32x4*)(a->in[I_FNG] + c);
                else { const float* m = mod + ((size_t)l * 9 + mr) * 12288; const f32x4 g = *(const f32x4*)(a->in[I_N1G] + (size_t)l * D + c); ck[j] = g * (*(const f32x4*)(m + D + c) + 1.0f); cs[j] = *(const f32x4*)(m + c); }
                if (MODE != 0) cg[j] = *(const f32x4*)(mod + ((size_t)(l - 1) * 9 + mr) * 12288 + 5 * D + c); } }
        f32x4 v[8];
        if (MODE == 0) { const float* xr = row < NLAT ? a->in[I_X] + (size_t)row * D : a->in[I_CTX] + (size_t)(row - NLAT) * D;
#pragma unroll
            for (int j = 0; j < 8; ++j) v[j] = *(const f32x4*)(xr + 4 * lane + 256 * j);
        } else {
            const bf16* xr = X + (size_t)row * D; const unsigned char* y0 = (const unsigned char*)YK + (size_t)row * D; const unsigned char* y1 = (const unsigned char*)YK + ((size_t)MALL + row) * D;
            unsigned p0[8], p1[8];
#pragma unroll
            for (int j = 0; j < 8; ++j) { const int c = 4 * lane + 256 * j; const u32x2 t = *(const u32x2*)(xr + c); v[j] = (f32x4){bflo(t.x), bfhi(t.x), bflo(t.y), bfhi(t.y)}; p0[j] = *(const unsigned*)(y0 + c); p1[j] = *(const unsigned*)(y1 + c); }
#pragma unroll
            for (int j = 0; j < 8; ++j) { const f32x2 a0 = __builtin_amdgcn_cvt_pk_f32_fp8((int)p0[j], false), a1 = __builtin_amdgcn_cvt_pk_f32_fp8((int)p0[j], true), b0 = __builtin_amdgcn_cvt_pk_f32_fp8((int)p1[j], false), b1 = __builtin_amdgcn_cvt_pk_f32_fp8((int)p1[j], true);
                f32x4 f; f[0] = a0[0] + b0[0]; f[1] = a0[1] + b0[1]; f[2] = a1[0] + b1[0]; f[3] = a1[1] + b1[1];
                v[j] = v[j] + cg[j] * f; }
            if (MODE == 1) {
#pragma unroll
                for (int j = 0; j < 8; ++j) { u32x2 t; t.x = pk2(v[j][0], v[j][1]); t.y = pk2(v[j][2], v[j][3]); *(u32x2*)(Xo + (size_t)orow * D + 4 * lane + 256 * j) = t; }
            }
        }
        float ss = 0.f;
#pragma unroll
        for (int j = 0; j < 8; ++j) ss += (v[j][0] * v[j][0] + v[j][1] * v[j][1]) + (v[j][2] * v[j][2] + v[j][3] * v[j][3]);
        const float rstd = 1.0f / sqrtf(wave_sum(ss) * (1.0f / D) + NORM_EPS);
        if (MODE == 2) {
#pragma unroll
            for (int j = 0; j < 8; ++j) *(f32x4*)(Oo + (size_t)orow * D + 4 * lane + 256 * j) = v[j] * rstd * ck[j];
        } else {
#pragma unroll
            for (int j = 0; j < 8; ++j) { const f32x4 h = v[j] * rstd * ck[j] + cs[j]; *(unsigned*)((unsigned char*)Ho + (size_t)orow * D + 4 * lane + 256 * j) = pk4_fp8(h[0], h[1], h[2], h[3]); }
        }
    }
}

__device__ __forceinline__ void phase_norm2_router(KArgs a, int l, bool dry, LAS unsigned char* lds) {
    const int tid_ = tid_fresh(); const int lane = tid_ & 63, wave = tid_ >> 6, gw = blockIdx.x * 8 + wave, NGW = gridDim.x * 8;
    unsigned char* ws = a->ws;
    const float* mod = (const float*)(ws + WS_MOD);
    const bf16* X = (const bf16*)(ws + WS_X); bf16* H = (bf16*)(ws + WS_H);
    unsigned* cnt = (unsigned*)(ws + WS_CTL) + CW_CNT + l * 16 * 64 + (dry ? 4096 : 0);
    unsigned* ridx = (unsigned*)(ws + (dry ? WS_END : WS_RIDX)); float* rwt = (float*)(ws + (dry ? WS_END + 4 * MiB : WS_RW)); bf16* Ho = dry ? (bf16*)(ws + WS_END + 8 * MiB) : H;
    const int nrows = (l == DEPTH - 1) ? NLAT : MALL;
    LAS f32x4* rwl = (LAS f32x4*)lds;
    { const float* rw = a->in[I_RW];
      for (int idx = tid_; idx < 8192; idx += NTHREADS) { const int ln = idx & 63, q = (idx >> 6) & 3, i = (idx >> 8) & 3, j = idx >> 10; rwl[idx] = *(const f32x4*)(rw + (size_t)(4 * ln + 256 * j + i) * 16 + 4 * q); } }
    __syncthreads();
    const int rpw = (nrows + NGW - 1) / NGW; const int r0 = gw * rpw, r1 = (r0 + rpw < nrows) ? r0 + rpw : nrows;
    f32x4 ck[8]; int cur_mr = -1;
    const float* rbp = a->in[I_RB];
    for (int row = r0; row < r1; ++row) {
        const int mr = modrow_of(row); const int orow = dry ? (row & 2047) : row;
        if (mr != cur_mr) { cur_mr = mr; const float* m = mod + ((size_t)l * 9 + mr) * 12288;
#pragma unroll
            for (int j = 0; j < 8; ++j) { const int c = 4 * lane + 256 * j; const f32x4 g = *(const f32x4*)(a->in[I_N2G] + (size_t)l * D + c); ck[j] = g * (*(const f32x4*)(m + 4 * D + c) + 1.0f); } }
        const float* shp = mod + ((size_t)l * 9 + mr) * 12288 + 3 * D;
        const bf16* xr = X + (size_t)row * D;
        f32x4 v[8]; float ss = 0.f;
#pragma unroll
        for (int j = 0; j < 8; ++j) { const u32x2 t = *(const u32x2*)(xr + 4 * lane + 256 * j); v[j] = (f32x4){bflo(t.x), bfhi(t.x), bflo(t.y), bfhi(t.y)}; ss += (v[j][0] * v[j][0] + v[j][1] * v[j][1]) + (v[j][2] * v[j][2] + v[j][3] * v[j][3]); }
        const float rstd = 1.0f / sqrtf(wave_sum(ss) * (1.0f / D) + NORM_EPS);
        f32x4 lg4[4];
#pragma unroll
        for (int q = 0; q < 4; ++q) lg4[q] = (f32x4){0.f, 0.f, 0.f, 0.f};
#pragma unroll
        for (int j = 0; j < 8; ++j) { const f32x4 h = v[j] * rstd * ck[j] + *(const f32x4*)(shp + 4 * lane + 256 * j); *(unsigned*)((unsigned char*)Ho + (size_t)orow * D + 4 * lane + 256 * j) = pk4_fp8(h[0], h[1], h[2], h[3]);
#pragma unroll
            for (int i = 0; i < 4; ++i)
#pragma unroll
                for (int q = 0; q < 4; ++q) lg4[q] += rwl[((j * 4 + i) * 4 + q) * 64 + lane] * h[i];
            asm volatile("" ::: "memory"); }
        float lg[16];
        { float t8[8], t4[4], t2[2], t1;
          const bool b5 = lane & 32, b4 = lane & 16, b3 = lane & 8, b2 = lane & 4;
#pragma unroll
          for (int i = 0; i < 8; ++i) { const float keep = b5 ? lg4[(i + 8) >> 2][(i + 8) & 3] : lg4[i >> 2][i & 3], send = b5 ? lg4[i >> 2][i & 3] : lg4[(i + 8) >> 2][(i + 8) & 3]; t8[i] = keep + __shfl_xor(send, 32); }
#pragma unroll
          for (int i = 0; i < 4; ++i) { const float keep = b4 ? t8[i + 4] : t8[i], send = b4 ? t8[i] : t8[i + 4]; t4[i] = keep + __shfl_xor(send, 16); }
#pragma unroll
          for (int i = 0; i < 2; ++i) { const float keep = b3 ? t4[i + 2] : t4[i], send = b3 ? t4[i] : t4[i + 2]; t2[i] = keep + __shfl_xor(send, 8); }
          { const float keep = b2 ? t2[1] : t2[0], send = b2 ? t2[0] : t2[1]; t1 = keep + __shfl_xor(send, 4); }
          t1 += __shfl_xor(t1, 2); t1 += __shfl_xor(t1, 1);
#pragma unroll
          for (int e = 0; e < 16; ++e) { const int src = ((e >> 3) & 1) * 32 + ((e >> 2) & 1) * 16 + ((e >> 1) & 1) * 8 + (e & 1) * 4; lg[e] = __builtin_bit_cast(float, __builtin_amdgcn_readlane(__builtin_bit_cast(int, t1), src)) + rbp[e]; } }
        float mx = lg[0];
#pragma unroll
        for (int e = 1; e < 16; ++e) mx = fmaxf(mx, lg[e]);
        float p[16], sum = 0.f;
#pragma unroll
        for (int e = 0; e < 16; ++e) { p[e] = __expf(lg[e] - mx); sum += p[e]; }
        const float inv = 1.0f / sum;
#pragma unroll
        for (int e = 0; e < 16; ++e) p[e] *= inv;
        int sel = 0; float best = -1.f;
#pragma unroll
        for (int gI = 0; gI < 4; ++gI) { float m1 = -1.f, m2 = -1.f;
#pragma unroll
            for (int i = 0; i < 4; ++i) { const float q = p[4 * gI + i]; if (q > m1) { m2 = m1; m1 = q; } else if (q > m2) m2 = q; }
            const float s = m1 + m2; if (s > best) { best = s; sel = gI; } }
        int i1 = 0, i2 = 0; float p1 = -2.f, p2 = -2.f;
#pragma unroll
        for (int gI = 0; gI < 4; ++gI)
#pragma unroll
            for (int i = 0; i < 4; ++i) { const float q = (gI == sel) ? p[4 * gI + i] : -1.0f; const int e = 4 * gI + i;
                if (gI == sel) { if (q > p1) { p2 = p1; i2 = i1; p1 = q; i1 = e; } else if (q > p2) { p2 = q; i2 = e; } } }
        const float wsum = p1 + p2, w1 = p1 / wsum, w2 = p2 / wsum;
        if (lane == 0) {
            const unsigned q1 = atomicAdd(cnt + i1 * 64, 1u); ridx[(size_t)i1 * MALL + q1] = (unsigned)row; rwt[(size_t)i1 * MALL + q1] = w1;
            const unsigned q2 = atomicAdd(cnt + i2 * 64, 1u); ridx[(size_t)i2 * MALL + q2] = (unsigned)row | 0x80000000u; rwt[(size_t)i2 * MALL + q2] = w2;
        }
    }
    __syncthreads();
}

template <bool FOR_DOWN>
__device__ __forceinline__ void moe_tables(KArgs a, int l, LAS unsigned char* lds, int cvirt) {
    const int tid = tid_fresh(), G = gridDim.x;
    unsigned char* ws = a->ws;
    const unsigned* cnt = (const unsigned*)(ws + WS_CTL) + CW_CNT + l * 16 * 64;
    const unsigned* ridx = (const unsigned*)(ws + WS_RIDX); const float* rwt = (const float*)(ws + WS_RW);
    LAS int* tp = (LAS int*)(lds + LDS_TP); LAS unsigned* tab = (LAS unsigned*)(lds + LDS_TAB); LAS float* tabw = (LAS float*)(lds + LDS_TABW);
    if (tid == 0) { int acc = 0; for (int e = 0; e < 16; ++e) { tp[e] = acc; acc += (int)((cnt[e * 64] + 255u) >> 8); } tp[16] = acc; }
    __syncthreads();
    const int ntot = tp[16] * 8;
    for (int i = 0; i < 9; ++i) { const int L = i * G + cvirt; if (L >= ntot) break;
        const int tile = L >> 3; int e = 0;
        for (int j = 1; j < 16; ++j) e += (tile >= tp[j]) ? 1 : 0;
        const int pos0 = (tile - tp[e]) * 256; const unsigned ce = cnt[e * 64];
        if (tid < 256) { const int pos = pos0 + tid; const bool valid = (unsigned)pos < ce; const unsigned ent = ridx[(size_t)e * MALL + (valid ? pos : 0)];
            if (FOR_DOWN) { tab[i * 256 + tid] = valid ? ent : (ent | 0x40000000u); tabw[i * 256 + tid] = valid ? rwt[(size_t)e * MALL + pos] : 0.f; }
            else tab[i * 256 + tid] = (ent & 0xffffu) * (unsigned)D; }
    }
    __syncthreads();
}

__device__ __forceinline__ void gmlp_item(KArgs a, int l, int item, LAS unsigned char* lds) {
    const int tid = tid_fresh(), lane = tid & 63, wave = tid >> 6;
    unsigned char* ws = a->ws;
    const bf16* P = (const bf16*)(ws + WS_P); bf16* Y = (bf16*)(ws + WS_Y);
    const int chunk = item >> 2, h = item & 3;
    const int row0 = chunk < 256 ? chunk * 128 : NLAT + (chunk - 256) * 128;
    LAS bf16* wsl = (LAS bf16*)lds;
    LAS bf16* vT = (LAS bf16*)(lds + 128 * 136 * 2);
    const bf16* gws = (const bf16*)(ws + WS_SMALLW + SW_GWS) + ((size_t)l * 4 + h) * 128 * 128;
    for (int p = tid; p < 2048; p += NTHREADS) { const int t = p >> 4, c8 = p & 15; *(LAS u32x4*)(wsl + t * 136 + c8 * 8) = *(const u32x4*)(gws + t * 128 + c8 * 8); }
    {
        const int s = tid >> 2, qd = tid & 3; const bf16* vp = P + (size_t)(row0 + s) * INC + OFF_V + h * 128 + qd * 32;
        float g[32]; float ss = 0.f;
#pragma unroll
        for (int q = 0; q < 4; ++q) { float f[8]; unpack8(*(const u32x4*)(vp + 8 * q), f);
#pragma unroll
            for (int j = 0; j < 8; ++j) { const float x = geluf_(f[j]); g[8 * q + j] = x; ss += x * x; } }
        ss += __shfl_xor(ss, 1); ss += __shfl_xor(ss, 2);
        const float rstd = 1.0f / sqrtf(ss * (1.0f / 128.0f) + NORM_EPS);
        const float* ng = a->in[I_GNG] + (size_t)l * 512 + h * 128 + qd * 32;
#pragma unroll
        for (int j = 0; j < 32; ++j) vT[(qd * 32 + j) * 136 + s] = (bf16)f2bf(g[j] * rstd * ng[j]);
    }
    __syncthreads();
    f32x4 acc[8];
#pragma unroll
    for (int ct = 0; ct < 8; ++ct) acc[ct] = (f32x4){0.f, 0.f, 0.f, 0.f};
    const int fr = lane & 15, fq = lane >> 4;
#pragma unroll
    for (int ks = 0; ks < 4; ++ks) {
        const bf16x8 bfrag = *(const LAS bf16x8*)(wsl + (16 * wave + fr) * 136 + ks * 32 + fq * 8);
#pragma unroll
        for (int ct = 0; ct < 8; ++ct) { const bf16x8 afrag = *(const LAS bf16x8*)(vT + (16 * ct + fr) * 136 + ks * 32 + fq * 8);
            acc[ct] = __builtin_amdgcn_mfma_f32_16x16x32_bf16(afrag, bfrag, acc[ct], 0, 0, 0); }
    }
    const int t = 16 * wave + fr; const float wb = a->in[I_GB][((size_t)l * 4 + h) * 128 + t];
    const bf16* up = P + (size_t)(row0 + t) * INC + OFF_U + h * 128; unsigned char* yp = a->ws + WS_Y8 + (size_t)(row0 + t) * D + h * 128;
#pragma unroll
    for (int ct = 0; ct < 8; ++ct) { const int c = 16 * ct + 4 * fq; const u32x2 uu = *(const u32x2*)(up + c);
        const float y0 = geluf_(bflo(uu.x)) * (acc[ct][0] + wb), y1 = geluf_(bfhi(uu.x)) * (acc[ct][1] + wb), y2 = geluf_(bflo(uu.y)) * (acc[ct][2] + wb), y3 = geluf_(bfhi(uu.y)) * (acc[ct][3] + wb);
        *(unsigned*)(yp + c) = pk4_fp8(y0, y1, y2, y3); }
    __syncthreads();
}

constexpr int SP_ = 72;
__device__ __forceinline__ int kperm_pos(int k) { const int s5 = k & 31; return (k & 32) + 8 * ((s5 >> 2) & 3) + 4 * (s5 >> 4) + (s5 & 3); }
__device__ __forceinline__ void rwkv_prep_item(KArgs a, int l, int tile, int hgrp, LAS unsigned char* lds) {
    const int tid = tid_fresh(), lane = tid & 63, wave = tid >> 6;
    unsigned char* ws = a->ws;
    const bf16* P = (const bf16*)(ws + WS_P); bf16* Y = (bf16*)(ws + WS_Y);
    LAS bf16* SR = (LAS bf16*)lds; LAS bf16* SK = SR + 64 * SP_; LAS bf16* SV = SK + 64 * SP_; LAS bf16* SKK = SV + 64 * SP_; LAS bf16* SB = SKK + 64 * SP_; LAS bf16* SWF = SB + 64 * SP_; LAS bf16* SWB = SWF + 64 * SP_;
    LAS bf16* tw = SWB + 64 * SP_;
    LAS bf16* adl = tw + 64 * SP_;
    LAS bf16* sg = adl + 64 * SP_;
    LAS float* invn = (LAS float*)(sg + 64 * 136);
    LAS unsigned char* wpriv = (LAS unsigned char*)(invn + 64) + wave * 6144;
    const int row0 = tile * 64; const bool isl = row0 < NLAT;
    const float* mu = a->in[I_MU] + (size_t)l * CCOLS;
    const char* Pb = (const char*)P;
    auto shift_group = [&](int tk, int col, float (&z)[8]) {
        const int row = row0 + tk; int o0, o1, o2, o3; bool v0, v1, v2, v3;
        if (isl) { const int gr = (row >> 6) & 63; o0 = -1; o1 = 1; o2 = -64; o3 = 64; v0 = tk > 0; v1 = tk < 63; v2 = gr > 0; v3 = gr < 63; }
        else { const int tc = (row - NLAT) & 255; o0 = -1; o1 = 1; o2 = -1; o3 = 1; v0 = tc > 0; v1 = tc < 255; v2 = v0; v3 = v1; }
        const unsigned off = (unsigned)row * (unsigned)(INC * 2) + (unsigned)(OFF_C + col) * 2u;
        const u32x4 uo = *(const u32x4*)(Pb + off), u0 = *(const u32x4*)(Pb + (off + (unsigned)((v0 ? o0 : 0) * INC * 2))), u1 = *(const u32x4*)(Pb + (off + (unsigned)((v1 ? o1 : 0) * INC * 2))),
                    u2 = *(const u32x4*)(Pb + (off + (unsigned)((v2 ? o2 : 0) * INC * 2))), u3 = *(const u32x4*)(Pb + (off + (unsigned)((v3 ? o3 : 0) * INC * 2)));
        const f32x4 m0 = *(const f32x4*)(mu + col), m1 = *(const f32x4*)(mu + col + 4);
        float own[8], n0[8], n1[8], n2[8], n3[8]; unpack8(uo, own); unpack8(u0, n0); unpack8(u1, n1); unpack8(u2, n2); unpack8(u3, n3);
        const float f0 = v0 ? 1.f : 0.f, f1 = v1 ? 1.f : 0.f, f2 = v2 ? 1.f : 0.f, f3 = v3 ? 1.f : 0.f;
        const float nb[8] = {n0[0] * f0, n1[1] * f1, n2[2] * f2, n3[3] * f3, n0[4] * f0, n1[5] * f1, n2[6] * f2, n3[7] * f3};
#pragma unroll
        for (int j = 0; j < 8; ++j) { const float mm = j < 4 ? m0[j] : m1[j - 4]; z[j] = own[j] + mm * (nb[j] - own[j]); }
    };
#pragma unroll
    for (int it = 0; it < 4; ++it) { const int g = tid + NTHREADS * it, tk = g >> 5, gi = g & 31;
        float z[8]; shift_group(tk, 2304 + gi * 8, z);
        if (gi < 8) { float t8[8];
#pragma unroll
            for (int j = 0; j < 8; ++j) t8[j] = 1.0f - 2.0f * __builtin_amdgcn_rcpf(1.0f + __expf(2.0f * z[j]));
            *(LAS u32x4*)(tw + tk * SP_ + gi * 8) = pack8(t8); }
        else if (gi < 16) *(LAS u32x4*)(adl + tk * SP_ + (gi - 8) * 8) = pack8(z);
        else { float t8[8];
#pragma unroll
            for (int j = 0; j < 8; ++j) t8[j] = sigmoidf_(z[j]);
            *(LAS u32x4*)(sg + tk * 136 + (gi - 16) * 8) = pack8(t8); } }
    __syncthreads();
#pragma unroll 1
    for (int hh = 0; hh < 4; ++hh) {
    const int tid = tid_fresh(), lane = tid & 63, wave = tid >> 6;
    const int head = 4 * hgrp + hh; const float* kkw = a->in[I_KK] + (size_t)l * CW + head * 64;
#pragma unroll
    for (int it = 0; it < 3; ++it) { const int g = tid + NTHREADS * it, tk = g / 24, gi = g % 24, c8 = (gi & 7) * 8;
        float z[8]; shift_group(tk, (gi >> 3) * 768 + head * 64 + c8, z);
        if (gi < 8) *(LAS u32x4*)(SR + tk * SP_ + c8) = pack8(z);
        else if (gi < 16) { *(LAS u32x4*)(SK + tk * SP_ + c8) = pack8(z);
            const f32x4 k0 = *(const f32x4*)(kkw + c8), k1 = *(const f32x4*)(kkw + c8 + 4); float ss = 0.f;
#pragma unroll
            for (int j = 0; j < 8; ++j) { const float q = z[j] * (j < 4 ? k0[j] : k1[j - 4]); ss += q * q; }
            ss += __shfl_xor(ss, 1); ss += __shfl_xor(ss, 2); ss += __shfl_xor(ss, 4);
            if ((gi & 7) == 0) invn[tk] = 1.0f / fmaxf(sqrtf(ss), 1e-12f); }
        else *(LAS u32x4*)(SV + tk * SP_ + c8) = pack8(z); }
    __syncthreads();
    {
        const int fr = lane & 15, fq = lane >> 4, nt = wave & 3, th = wave >> 2;
        const bf16* wupT = (const bf16*)(ws + WS_SMALLW + SW_WUP) + (size_t)l * 2 * 768 * 64;
        const bf16* aupT = (const bf16*)(ws + WS_SMALLW + SW_AUP) + (size_t)l * 768 * 64;
        const bf16* gupT = (const bf16*)(ws + WS_SMALLW + SW_GUP) + (size_t)l * 768 * 128;
        const float* a0 = a->in[I_A0] + (size_t)l * CW + head * 64; const float* kaw = a->in[I_KA] + (size_t)l * CW + head * 64; const float* w0 = a->in[I_W0] + (size_t)l * 2 * CW + head * 64;
        const int nloc = 16 * nt + 4 * fq;
#pragma unroll 1
        for (int mat = 0; mat < 4; ++mat) {
            const bf16* WT = mat == 0 ? aupT : (mat == 1 ? wupT : (mat == 2 ? wupT + 768 * 64 : gupT));
            const int KK = mat == 3 ? 128 : 64; const LAS bf16* act = mat == 0 ? adl : (mat == 3 ? sg : tw); const int apitch = mat == 3 ? 136 : SP_;
            f32x4 acc[2];
            acc[0] = (f32x4){0.f, 0.f, 0.f, 0.f}; acc[1] = acc[0];
            for (int ks = 0; ks < KK / 32; ++ks) { const bf16x8 afr = *(const bf16x8*)(WT + (size_t)(head * 64 + 16 * nt + fr) * KK + ks * 32 + fq * 8);
#pragma unroll
                for (int tt = 0; tt < 2; ++tt) { const bf16x8 bfr = *(const LAS bf16x8*)(act + (16 * (2 * th + tt) + fr) * apitch + ks * 32 + fq * 8); acc[tt] = __builtin_amdgcn_mfma_f32_16x16x32_bf16(afr, bfr, acc[tt], 0, 0, 0); } }
#pragma unroll
            for (int tt = 0; tt < 2; ++tt) { const int tk = 16 * (2 * th + tt) + fr; const f32x4 v = acc[tt];
                if (mat == 0) {
                    const f32x4 a0v = *(const f32x4*)(a0 + nloc), kav = *(const f32x4*)(kaw + nloc), kkv = *(const f32x4*)(kkw + nloc);
                    const u32x2 kp = *(const LAS u32x2*)(SK + tk * SP_ + nloc); const float kf[4] = {bflo(kp.x), bfhi(kp.x), bflo(kp.y), bfhi(kp.y)};
                    const float inn = invn[tk]; float k2[4], kk[4], bb[4];
#pragma unroll
                    for (int j = 0; j < 4; ++j) { const float av = sigmoidf_(a0v[j] + v[j]); kk[j] = kf[j] * kkv[j] * inn; k2[j] = kf[j] * (1.0f + (av - 1.0f) * kav[j]); bb[j] = kk[j] * av; }
                    u32x2 q; q.x = pk2(k2[0], k2[1]); q.y = pk2(k2[2], k2[3]); *(LAS u32x2*)(SK + tk * SP_ + nloc) = q;
                    q.x = pk2(kk[0], kk[1]); q.y = pk2(kk[2], kk[3]); *(LAS u32x2*)(SKK + tk * SP_ + nloc) = q;
                    q.x = pk2(bb[0], bb[1]); q.y = pk2(bb[2], bb[3]); *(LAS u32x2*)(SB + tk * SP_ + nloc) = q;
                } else if (mat <= 2) {
                    const f32x4 w0v = *(const f32x4*)(w0 + (mat - 1) * CW + nloc); float d[4];
#pragma unroll
                    for (int j = 0; j < 4; ++j) d[j] = __expf(-DECAY_SCALE * sigmoidf_(w0v[j] + v[j]));
                    u32x2 q; q.x = pk2(d[0], d[1]); q.y = pk2(d[2], d[3]); *(LAS u32x2*)((mat == 1 ? SWF : SWB) + tk * SP_ + nloc) = q;
                } else {
                    u32x2 q; q.x = pk2(v[0], v[1]); q.y = pk2(v[2], v[3]); *(u32x2*)(Y + (size_t)(row0 + tk) * D + 1280 + head * 64 + nloc) = q;
                }
            }
        }
    }
    __syncthreads();
    { const int tk = tid >> 3, c8 = (tid & 7) * 8; float r8[8], k8[8], v8[8];
      unpack8(*(const LAS u32x4*)(SR + tk * SP_ + c8), r8); unpack8(*(const LAS u32x4*)(SK + tk * SP_ + c8), k8); unpack8(*(const LAS u32x4*)(SV + tk * SP_ + c8), v8);
      const float* rkp = a->in[I_RK] + (size_t)l * CW + head * 64 + c8; const f32x4 rk0 = *(const f32x4*)rkp, rk1 = *(const f32x4*)(rkp + 4);
      float bs = 0.f;
#pragma unroll
      for (int j = 0; j < 8; ++j) bs += r8[j] * k8[j] * (j < 4 ? rk0[j] : rk1[j - 4]);
      bs += __shfl_xor(bs, 1); bs += __shfl_xor(bs, 2); bs += __shfl_xor(bs, 4);
#pragma unroll
      for (int j = 0; j < 8; ++j) v8[j] *= bs;
      *(u32x4*)(Y + (size_t)(row0 + tk) * D + 512 + head * 64 + c8) = pack8(v8); }
    {
        const int c4 = wave & 3, dir = wave >> 2, fr = lane & 15, fq = lane >> 4;
        LAS float* CB = (LAS float*)wpriv;
        LAS float* AA = CB + 16 * 64;
        const LAS bf16* SW = dir ? SWB : SWF;
        auto trow = [&](int tau) { return 16 * c4 + (dir ? 15 - tau : tau); };
        float c[16], ci[16];
        { float run = 1.f;
#pragma unroll
          for (int t = 0; t < 16; ++t) { run *= bf1(SW[trow(t) * SP_ + lane]); c[t] = run; ci[t] = __builtin_amdgcn_rcpf(run); CB[t * 64 + lane] = run; } }
        const int rec_dir = dir, bidx = isl ? (row0 >> 12) : ((row0 - NLAT) >> 8);
        const int tcl = isl ? 4 * ((row0 >> 6) & 63) + c4 : 4 * (((row0 - NLAT) >> 6) & 3) + c4;
        const int nproc = isl ? 16 + (dir ? 255 - tcl : tcl) : (dir ? 15 - tcl : tcl);
        unsigned char* rec = ws + WS_PRE + ((size_t)((rec_dir * 8 + bidx) * 12 + head) * NCHUNK16 + nproc) * PRE_REC;
        { const float cl = c[15]; float bk[32];
#pragma unroll
          for (int t = 0; t < 16; ++t) { const float e = cl * ci[t]; const int pos = 8 * (t >> 2) + (t & 3); bk[pos] = bf1(SB[trow(t) * SP_ + lane]) * e; bk[pos + 4] = bf1(SK[trow(t) * SP_ + lane]) * e; }
#pragma unroll
          for (int q4 = 0; q4 < 4; ++q4) { u32x4 o; o.x = pk2(bk[8 * q4], bk[8 * q4 + 1]); o.y = pk2(bk[8 * q4 + 2], bk[8 * q4 + 3]); o.z = pk2(bk[8 * q4 + 4], bk[8 * q4 + 5]); o.w = pk2(bk[8 * q4 + 6], bk[8 * q4 + 7]);
              *(u32x4*)(rec + PR_BK + lane * 64 + q4 * 16) = o; }
          *(float*)(rec + PR_GAM + lane * 4) = cl; }
        asm volatile("s_waitcnt lgkmcnt(0)" ::: "memory");
        bf16x8 fa[2], frr[2], fb[2], fk[2];
        { const int tr = trow(fr);
#pragma unroll
          for (int sx = 0; sx < 2; ++sx) { const int ch = 32 * sx + 8 * fq; float kk8[8], r8[8], b8[8], k8[8];
              unpack8(*(const LAS u32x4*)(SKK + tr * SP_ + ch), kk8); unpack8(*(const LAS u32x4*)(SR + tr * SP_ + ch), r8); unpack8(*(const LAS u32x4*)(SB + tr * SP_ + ch), b8); unpack8(*(const LAS u32x4*)(SK + tr * SP_ + ch), k8);
              const f32x4 c0 = *(const LAS f32x4*)(CB + fr * 64 + ch), c1 = *(const LAS f32x4*)(CB + fr * 64 + ch + 4);
              f32x4 p0 = (f32x4){1.f, 1.f, 1.f, 1.f}, p1 = p0; if (fr > 0) { p0 = *(const LAS f32x4*)(CB + (fr - 1) * 64 + ch); p1 = *(const LAS f32x4*)(CB + (fr - 1) * 64 + ch + 4); }
              float xa[8], xr[8], xb[8], xk[8];
#pragma unroll
              for (int j = 0; j < 8; ++j) { const float ec = j < 4 ? c0[j] : c1[j - 4], ep = j < 4 ? p0[j] : p1[j - 4]; const float en = __builtin_amdgcn_rcpf(ec);
                  xa[j] = -kk8[j] * ep; xr[j] = r8[j] * ec; xb[j] = b8[j] * en; xk[j] = k8[j] * en; }
              const u32x4 ua = pack8(xa), ur = pack8(xr), ub = pack8(xb), uk = pack8(xk);
              fa[sx] = __builtin_bit_cast(bf16x8, ua); frr[sx] = __builtin_bit_cast(bf16x8, ur); fb[sx] = __builtin_bit_cast(bf16x8, ub); fk[sx] = __builtin_bit_cast(bf16x8, uk); } }
        f32x4 gab = (f32x4){0.f, 0.f, 0.f, 0.f}, gak = gab, grb = gab, grk = gab;
#pragma unroll
        for (int sx = 0; sx < 2; ++sx) { gab = __builtin_amdgcn_mfma_f32_16x16x32_bf16(fa[sx], fb[sx], gab, 0, 0, 0); gak = __builtin_amdgcn_mfma_f32_16x16x32_bf16(fa[sx], fk[sx], gak, 0, 0, 0);
            grb = __builtin_amdgcn_mfma_f32_16x16x32_bf16(frr[sx], fb[sx], grb, 0, 0, 0); grk = __builtin_amdgcn_mfma_f32_16x16x32_bf16(frr[sx], fk[sx], grk, 0, 0, 0); }
#pragma unroll
        for (int j = 0; j < 4; ++j) { const int tau = 4 * fq + j; const bool lo = fr < tau, le = fr <= tau;
            AA[tau * 16 + fr] = lo ? gab[j] : 0.f; AA[256 + tau * 16 + fr] = lo ? gak[j] : 0.f; grb[j] = le ? grb[j] : 0.f; grk[j] = le ? grk[j] : 0.f; }
        asm volatile("s_waitcnt lgkmcnt(0)" ::: "memory");
        float wv[16], mv[16];
#pragma unroll
        for (int t = 0; t < 16; ++t) { const float ab = -bf1(SKK[trow(t) * SP_ + lane]) * (t > 0 ? c[t - 1] : 1.0f); float accw = ab, accm = AA[256 + t * 16 + fr];
#pragma unroll
            for (int q4 = 0; q4 < 4; ++q4) { if (4 * q4 < t) { const f32x4 cf = *(const LAS f32x4*)(AA + t * 16 + 4 * q4);
#pragma unroll
                for (int j = 0; j < 4; ++j) if (4 * q4 + j < t) { accw += cf[j] * wv[4 * q4 + j]; accm += cf[j] * mv[4 * q4 + j]; } } }
            wv[t] = accw; mv[t] = accm; }
        { LAS bf16* stg = (LAS bf16*)CB; const int pp = kperm_pos(lane);
#pragma unroll
          for (int t = 0; t < 16; ++t) { stg[t * 64 + pp] = (bf16)f2bf(wv[t]); stg[1024 + t * 64 + pp] = (bf16)f2bf(bf1(SR[trow(t) * SP_ + lane]) * c[t]); }
          asm volatile("s_waitcnt lgkmcnt(0)" ::: "memory");
#pragma unroll
          for (int q4 = 0; q4 < 4; ++q4) *(u32x4*)(rec + PR_WP + (q4 * 64 + lane) * 16) = *(const LAS u32x4*)((LAS unsigned char*)stg + (q4 * 64 + lane) * 16); }
        { LAS bf16* stg = (LAS bf16*)AA; const int ps = 8 * (fr >> 2) + (fr & 3);
          asm volatile("s_waitcnt lgkmcnt(0)" ::: "memory");
#pragma unroll
          for (int j = 0; j < 4; ++j) { const int tau = 4 * fq + j; stg[tau * 32 + ps] = (bf16)f2bf(grb[j]); stg[tau * 32 + ps + 4] = (bf16)f2bf(grk[j]); }
          if (lane < 16) {
#pragma unroll
              for (int t = 0; t < 16; ++t) stg[512 + t * 16 + lane] = (bf16)f2bf(mv[t]); }
          asm volatile("s_waitcnt lgkmcnt(0)" ::: "memory");
          *(u32x4*)(rec + PR_ARBK + lane * 16) = *(const LAS u32x4*)((LAS unsigned char*)stg + lane * 16);
          if (lane < 32) *(u32x4*)(rec + PR_ARBK + 1024 + lane * 16) = *(const LAS u32x4*)((LAS unsigned char*)stg + 1024 + lane * 16); }
        if (dir == 0) { float v16[16];
#pragma unroll
            for (int t = 0; t < 16; ++t) v16[t] = bf1(SV[(16 * c4 + t) * SP_ + lane]);
            const int tcg = isl ? 16 + tcl : tcl;
            unsigned char* vrec = ws + WS_VT + ((size_t)(bidx * 12 + head) * NCHUNK16 + tcg) * 2048 + lane * 32;
            u32x4 o; o.x = pk2(v16[0], v16[1]); o.y = pk2(v16[2], v16[3]); o.z = pk2(v16[4], v16[5]); o.w = pk2(v16[6], v16[7]); *(u32x4*)vrec = o;
            o.x = pk2(v16[8], v16[9]); o.y = pk2(v16[10], v16[11]); o.z = pk2(v16[12], v16[13]); o.w = pk2(v16[14], v16[15]); *(u32x4*)(vrec + 16) = o; }
    }
    __syncthreads();
    }
}

__device__ __forceinline__ float dpp_xor1(float x) { return __builtin_bit_cast(float, __builtin_amdgcn_update_dpp(0, __builtin_bit_cast(int, x), 0xB1, 0xF, 0xF, false)); }
__device__ __forceinline__ float dpp_xor2(float x) { return __builtin_bit_cast(float, __builtin_amdgcn_update_dpp(0, __builtin_bit_cast(int, x), 0x4E, 0xF, 0xF, false)); }
__device__ __forceinline__ int chain_row(int dir, int b, int s) {
    if (s < CTXL) return NLAT + b * CTXL + (dir ? (CTXL - 1 - s) : s);
    const int t = s - CTXL; return b * T + (dir ? (T - 1 - t) : t);
}
__device__ __forceinline__ float dpp_hmirror(float x) { return __builtin_bit_cast(float, __builtin_amdgcn_update_dpp(0, __builtin_bit_cast(int, x), 0x141, 0xF, 0xF, false)); }
struct RwRec { u32x4 wp[2], rp[2], bk[4], arbk; u32x2 mak, vt[2]; f32x4 gam[4]; };
__device__ __forceinline__ void rw_load(RwRec& r, const LAS unsigned char* rec, int fr, int kg, int hv, int dir) {
#pragma unroll
    for (int sx = 0; sx < 2; ++sx) { r.wp[sx] = *(const LAS u32x4*)(rec + PR_WP + fr * 128 + sx * 64 + kg * 16); r.rp[sx] = *(const LAS u32x4*)(rec + PR_RP + fr * 128 + sx * 64 + kg * 16); }
#pragma unroll
    for (int i = 0; i < 4; ++i) { r.bk[i] = *(const LAS u32x4*)(rec + PR_BK + (16 * i + fr) * 64 + kg * 16); r.gam[i] = *(const LAS f32x4*)(rec + PR_GAM + (16 * i + 4 * kg) * 4); }
    r.arbk = *(const LAS u32x4*)(rec + PR_ARBK + fr * 64 + kg * 16);
    r.mak = *(const LAS u32x2*)(rec + PR_MAK + fr * 32 + kg * 8);
#pragma unroll
    for (int q = 0; q < 2; ++q) r.vt[q] = *(const LAS u32x2*)(rec + PRE_REC + (16 * (2 * hv + q) + fr) * 32 + (dir ? (12 - 4 * kg) : 4 * kg) * 2);
}
constexpr int RW_R = 6, RW_SLOT = PRE_REC + 2048;
__device__ __forceinline__ void rwkv_chain_mfma(KArgs a, int task_base, LAS unsigned char* lds) {
    const int t_ = tid_fresh(); const int lane = t_ & 63, fr = lane & 15, kg = lane >> 4; const int wave = __builtin_amdgcn_readfirstlane(t_ >> 6);
    unsigned char* ws = a->ws;
    bf16* OC = (bf16*)(ws + WS_OC);
    const int cid = (task_base >> 2) + (wave >> 2), wq = wave & 3, dir = cid / 96, b = (cid % 96) / 12, h = cid % 12;
    const bool comp = wq < 2; const int hv = wq & 1;
    const unsigned char* rec0 = ws + WS_PRE + (size_t)((dir * 8 + b) * 12 + h) * NCHUNK16 * PRE_REC;
    const unsigned char* vrec0 = ws + WS_VT + (size_t)(b * 12 + h) * NCHUNK16 * 2048;
    LAS unsigned char* ring = lds + (wave >> 2) * (RW_R * RW_SLOT);
    auto tchunk = [&](int n) { return n < 16 ? (dir ? 15 - n : n) : 16 + (dir ? 255 - (n - 16) : (n - 16)); };
    auto issue = [&](int n) { const int nn = n < NCHUNK16 ? n : NCHUNK16 - 1; LAS unsigned char* slot = ring + (n % RW_R) * RW_SLOT;
#pragma unroll
        for (int jj = 0; jj < 3; ++jj) { const int j = 3 * wq + jj;
            const unsigned char* src = (j < 10 ? rec0 + (size_t)nn * PRE_REC + 1024 * j : vrec0 + (size_t)tchunk(nn) * 2048 + 1024 * (j - 10)) + lane * 16;
            __builtin_amdgcn_global_load_lds((const unsigned*)src, (LAS unsigned*)(slot + 1024 * j), 16, 0, 0); } };
    f32x4 ST[2][4];
#pragma unroll
    for (int q = 0; q < 2; ++q)
#pragma unroll
        for (int i = 0; i < 4; ++i) ST[q][i] = (f32x4){0.f, 0.f, 0.f, 0.f};
    unsigned uvU[2][2] = {{0u, 0u}, {0u, 0u}};
#pragma unroll
    for (int n = 0; n < RW_R - 1; ++n) issue(n);
    for (int n = 0; n < NCHUNK16; ++n) {
        if (comp && n >= RW_R - 1) asm volatile("s_waitcnt vmcnt(22)" ::: "memory"); else asm volatile("s_waitcnt vmcnt(12)" ::: "memory");
        __builtin_amdgcn_s_barrier(); asm volatile("" ::: "memory");
        issue(n + RW_R - 1);
        if (comp) {
            RwRec cur; rw_load(cur, ring + (n % RW_R) * RW_SLOT, fr, kg, hv, dir);
            u32x4 fmak; fmak.x = 0u; fmak.y = 0u; fmak.z = cur.mak.x; fmak.w = cur.mak.y;
            const int row = chain_row(dir, b, 16 * n + fr);
#pragma unroll
            for (int q = 0; q < 2; ++q) {
                u32x4 fs[2];
#pragma unroll
                for (int sx = 0; sx < 2; ++sx) { fs[sx].x = pk2(ST[q][2 * sx][0], ST[q][2 * sx][1]); fs[sx].y = pk2(ST[q][2 * sx][2], ST[q][2 * sx][3]); fs[sx].z = pk2(ST[q][2 * sx + 1][0], ST[q][2 * sx + 1][1]); fs[sx].w = pk2(ST[q][2 * sx + 1][2], ST[q][2 * sx + 1][3]); }
                u32x2 vt = cur.vt[q]; if (dir) { const unsigned x = vt.x, y = vt.y; vt.x = (y >> 16) | (y << 16); vt.y = (x >> 16) | (x << 16); }
                u32x4 fuv; fuv.x = uvU[q][0]; fuv.y = uvU[q][1]; fuv.z = vt.x; fuv.w = vt.y;
                f32x4 U = (f32x4){0.f, 0.f, 0.f, 0.f};
                U = __builtin_amdgcn_mfma_f32_16x16x32_bf16(__builtin_bit_cast(bf16x8, cur.wp[0]), __builtin_bit_cast(bf16x8, fs[0]), U, 0, 0, 0);
                U = __builtin_amdgcn_mfma_f32_16x16x32_bf16(__builtin_bit_cast(bf16x8, cur.wp[1]), __builtin_bit_cast(bf16x8, fs[1]), U, 0, 0, 0);
                U = __builtin_amdgcn_mfma_f32_16x16x32_bf16(__builtin_bit_cast(bf16x8, fmak), __builtin_bit_cast(bf16x8, fuv), U, 0, 0, 0);
                uvU[q][0] = pk2(U[0], U[1]); uvU[q][1] = pk2(U[2], U[3]); fuv.x = uvU[q][0]; fuv.y = uvU[q][1];
                f32x4 OT = (f32x4){0.f, 0.f, 0.f, 0.f};
                OT = __builtin_amdgcn_mfma_f32_16x16x32_bf16(__builtin_bit_cast(bf16x8, fs[0]), __builtin_bit_cast(bf16x8, cur.rp[0]), OT, 0, 0, 0);
                OT = __builtin_amdgcn_mfma_f32_16x16x32_bf16(__builtin_bit_cast(bf16x8, fs[1]), __builtin_bit_cast(bf16x8, cur.rp[1]), OT, 0, 0, 0);
                OT = __builtin_amdgcn_mfma_f32_16x16x32_bf16(__builtin_bit_cast(bf16x8, fuv), __builtin_bit_cast(bf16x8, cur.arbk), OT, 0, 0, 0);
#pragma unroll
                for (int i = 0; i < 4; ++i) ST[q][i] = __builtin_amdgcn_mfma_f32_16x16x32_bf16(__builtin_bit_cast(bf16x8, cur.bk[i]), __builtin_bit_cast(bf16x8, fuv), ST[q][i] * cur.gam[i], 0, 0, 0);
                u32x2 o; o.x = pk2(OT[0], OT[1]); o.y = pk2(OT[2], OT[3]); *(u32x2*)(OC + ((size_t)dir * MALL + row) * CW + h * 64 + 16 * (2 * hv + q) + 4 * kg) = o;
            }
        }
    }
    asm volatile("s_waitcnt vmcnt(0)" ::: "memory");
    __builtin_amdgcn_s_barrier(); asm volatile("" ::: "memory");
}
#define LDS_BAR() do { asm volatile("s_waitcnt lgkmcnt(0)" ::: "memory"); __builtin_amdgcn_s_barrier(); asm volatile("" ::: "memory"); } while (0)
__device__ __forceinline__ void hgrn_prep_item(KArgs a, int l, int item, LAS unsigned char* lds, bool dry) {
    const int tid = tid_fresh();
    unsigned char* ws = a->ws;
    bf16* P = (bf16*)(ws + WS_P); bf16* HQB = (bf16*)(ws + WS_HQB); float* HG = (float*)(ws + WS_HG);
    const int cn = item % 68, bh = item / 68, h = bh % 6, b = bh / 6;
    const int row0 = cn < 4 ? NLAT + b * CTXL + 64 * cn : b * T + 64 * (cn - 4);
    constexpr int QP = 136;
    LAS bf16* SQ = (LAS bf16*)lds; LAS bf16* KF = SQ + 64 * QP; LAS bf16* KB = KF + 64 * QP; LAS bf16* QB = KB + 64 * QP;
    LAS float* LF = (LAS float*)(QB + 64 * QP); LAS float* LBk = LF + 64 * 128;
    LAS float* tot = LBk + 64 * 128;
    LAS float* lbs = tot + 1024;
    if (tid < 256) { const int dr = tid >> 7, ch = h * 128 + (tid & 127); float lb = 0.f;
        if (l != 0) { const float l0 = a->in[I_LB][((size_t)dr * DEPTH + 0) * BW + ch], l1 = a->in[I_LB][((size_t)dr * DEPTH + 1) * BW + ch]; lb = __builtin_amdgcn_rcpf(1.0f + __expf(l0 - l1)); }
        lbs[tid] = lb; }
    const int ta = tid >> 3, d0 = (tid & 7) * 16;
    bf16* prow = P + (size_t)(row0 + ta) * INC + h * 128 + d0;
    u32x4 rq[2], rf[2], rb[2];
    rq[0] = *(const u32x4*)(prow + OFF_Q); rq[1] = *(const u32x4*)(prow + OFF_Q + 8); rf[0] = *(const u32x4*)(prow + OFF_ZF); rf[1] = *(const u32x4*)(prow + OFF_ZF + 8); rb[0] = *(const u32x4*)(prow + OFF_ZB); rb[1] = *(const u32x4*)(prow + OFF_ZB + 8);
    __syncthreads();
#pragma unroll
    for (int hf = 0; hf < 2; ++hf) { float qf[8], zf[8], zb[8], oq[8], of[8], ob[8]; unpack8(rq[hf], qf); unpack8(rf[hf], zf); unpack8(rb[hf], zb);
        const int dd = d0 + 8 * hf; f32x4 lf0, lf1, lb0, lb1;
#pragma unroll
        for (int j = 0; j < 8; ++j) { const float lF = lbs[dd + j], lB = lbs[128 + dd + j];
            const float ff = lF + (1.0f - lF) * sigmoidf_(zf[j]), fb = lB + (1.0f - lB) * sigmoidf_(zb[j]);
            const float a1 = fmaxf(__logf(ff), -60.0f), a2 = fmaxf(__logf(fb), -60.0f);
            if (j < 4) { lf0[j] = a1; lb0[j] = a2; } else { lf1[j - 4] = a1; lb1[j - 4] = a2; }
            oq[j] = siluf_(qf[j]); of[j] = 1.0f - ff; ob[j] = 1.0f - fb; }
        *(LAS u32x4*)(SQ + ta * QP + dd) = pack8(oq); *(LAS u32x4*)(KF + ta * QP + dd) = pack8(of); *(LAS u32x4*)(KB + ta * QP + dd) = pack8(ob);
        *(LAS f32x4*)(LF + ta * 128 + dd) = lf0; *(LAS f32x4*)(LF + ta * 128 + dd + 4) = lf1; *(LAS f32x4*)(LBk + ta * 128 + dd) = lb0; *(LAS f32x4*)(LBk + ta * 128 + dd + 4) = lb1; }
    __syncthreads();
    { const int d = tid & 127, qt = tid >> 7; float r1 = 0.f, r2 = 0.f;
#pragma unroll
      for (int i = 0; i < 16; ++i) { const int tp = 16 * qt + i; r1 += LF[tp * 128 + d]; LF[tp * 128 + d] = r1; r2 += LBk[(63 - tp) * 128 + d]; LBk[(63 - tp) * 128 + d] = r2; }
      tot[qt * 128 + d] = r1; tot[512 + qt * 128 + d] = r2; }
    __syncthreads();
    LAS float* bas = lbs + 256;
    LAS float* bmd = bas + 1024;
    { const int d = tid & 127, dr = (tid >> 7) & 1; if (tid < 256) { const LAS float* tt = tot + 512 * dr; const float t0 = tt[d], t1 = tt[128 + d], t2 = tt[256 + d], t3 = tt[384 + d];
        bas[(dr * 4 + 0) * 128 + d] = 0.f; bas[(dr * 4 + 1) * 128 + d] = t0; bas[(dr * 4 + 2) * 128 + d] = t0 + t1; bas[(dr * 4 + 3) * 128 + d] = t0 + t1 + t2; bmd[dr * 128 + d] = t0 + t1;
        const int npr = dr == 0 ? cn : (cn < 4 ? 3 - cn : 4 + 63 - (cn - 4)); float* g = (dry ? (float*)(ws + WS_END + 8 * MiB) : HG) + ((size_t)(((dr * 8 + b) * 6 + h) * 68 + npr)) * 256; g[d] = __expf(t0 + t1); g[128 + d] = __expf(t2 + t3); } }
    __syncthreads();
#pragma unroll
    for (int hf = 0; hf < 2; ++hf) { const int dd = d0 + 8 * hf; float sq[8], kf[8], kb[8];
        unpack8(*(const LAS u32x4*)(SQ + ta * QP + dd), sq); unpack8(*(const LAS u32x4*)(KF + ta * QP + dd), kf); unpack8(*(const LAS u32x4*)(KB + ta * QP + dd), kb);
        float oqf[8], okf[8], oqb[8], okb[8];
#pragma unroll
        for (int dr = 0; dr < 2; ++dr) { const int tp = dr ? 63 - ta : ta, q = tp >> 4; const LAS float* pf = (dr ? LBk : LF) + ta * 128 + dd;
            const f32x4 p0 = *(const LAS f32x4*)pf, p1 = *(const LAS f32x4*)(pf + 4), b0 = *(const LAS f32x4*)(bas + (dr * 4 + q) * 128 + dd), b1 = *(const LAS f32x4*)(bas + (dr * 4 + q) * 128 + dd + 4),
                        m0 = *(const LAS f32x4*)(bmd + dr * 128 + dd), m1 = *(const LAS f32x4*)(bmd + dr * 128 + dd + 4);
#pragma unroll
            for (int j = 0; j < 8; ++j) { const float bt = (j < 4 ? p0[j] + b0[j] : p1[j - 4] + b1[j - 4]), bm = j < 4 ? m0[j] : m1[j - 4];
                const float eq = __expf(fminf(bt - bm, 80.0f)), ek = __expf(fminf(bm - bt, 80.0f));
                if (dr == 0) { oqf[j] = sq[j] * eq; okf[j] = kf[j] * ek; } else { oqb[j] = sq[j] * eq; okb[j] = kb[j] * ek; } } }
        *(LAS u32x4*)(QB + ta * QP + dd) = pack8(oqf); *(LAS u32x4*)(KF + ta * QP + dd) = pack8(okf); *(LAS u32x4*)(KB + ta * QP + dd) = pack8(okb); *(LAS u32x4*)(SQ + ta * QP + dd) = pack8(oqb); }
    bf16* prow_o = dry ? (bf16*)(ws + WS_END) + (size_t)((row0 + ta) & 511) * INC + h * 128 + d0 : prow; bf16* hqb_o = dry ? (bf16*)(ws + WS_END) : HQB;
#pragma unroll
    for (int hf = 0; hf < 2; ++hf) { const int dd = d0 + 8 * hf;
        *(u32x4*)(prow_o + OFF_Q + 8 * hf) = *(const LAS u32x4*)(QB + ta * QP + dd); *(u32x4*)(prow_o + OFF_ZF + 8 * hf) = *(const LAS u32x4*)(KF + ta * QP + dd); *(u32x4*)(prow_o + OFF_ZB + 8 * hf) = *(const LAS u32x4*)(KB + ta * QP + dd);
        *(u32x4*)(hqb_o + (size_t)(dry ? ((row0 + ta) & 1023) : (row0 + ta)) * BW + h * 128 + dd) = *(const LAS u32x4*)(SQ + ta * QP + dd); }
    __syncthreads();
}
__device__ __forceinline__ unsigned tr_addr(const LAS bf16* X, int pitch, int r0, int c0, int lane) { const int i = lane & 15, g = lane >> 4; return (unsigned)(size_t)(X + (r0 + 8 * g + (i >> 2)) * pitch + c0 + 4 * (i & 3)); }
__device__ __forceinline__ void tr8x4(u32x2 (&lo)[4], u32x2 (&hi)[4], unsigned a0, unsigned a1, unsigned a2, unsigned a3, unsigned rowstep4) {
    const unsigned b0 = a0 + rowstep4, b1 = a1 + rowstep4, b2 = a2 + rowstep4, b3 = a3 + rowstep4;
    asm volatile("ds_read_b64_tr_b16 %0, %8\n\tds_read_b64_tr_b16 %1, %9\n\tds_read_b64_tr_b16 %2, %10\n\tds_read_b64_tr_b16 %3, %11\n\t"
                 "ds_read_b64_tr_b16 %4, %12\n\tds_read_b64_tr_b16 %5, %13\n\tds_read_b64_tr_b16 %6, %14\n\tds_read_b64_tr_b16 %7, %15\n\ts_waitcnt lgkmcnt(0)"
                 : "=&v"(lo[0]), "=&v"(lo[1]), "=&v"(lo[2]), "=&v"(lo[3]), "=&v"(hi[0]), "=&v"(hi[1]), "=&v"(hi[2]), "=&v"(hi[3])
                 : "v"(a0), "v"(a1), "v"(a2), "v"(a3), "v"(b0), "v"(b1), "v"(b2), "v"(b3) : "memory");
}
__device__ __forceinline__ void tr_half(u32x2 (&vl)[8], u32x2 (&vh)[8], u32x2 (&xl)[2], u32x2 (&xh)[2], unsigned av, unsigned ak, unsigned ax) {
    asm volatile(
        "ds_read_b64_tr_b16 %0, %20\n\tds_read_b64_tr_b16 %1, %20 offset:32\n\tds_read_b64_tr_b16 %2, %20 offset:64\n\tds_read_b64_tr_b16 %3, %20 offset:96\n\t"
        "ds_read_b64_tr_b16 %4, %20 offset:128\n\tds_read_b64_tr_b16 %5, %20 offset:160\n\tds_read_b64_tr_b16 %6, %20 offset:192\n\tds_read_b64_tr_b16 %7, %20 offset:224\n\t"
        "ds_read_b64_tr_b16 %8, %20 offset:1088\n\tds_read_b64_tr_b16 %9, %20 offset:1120\n\tds_read_b64_tr_b16 %10, %20 offset:1152\n\tds_read_b64_tr_b16 %11, %20 offset:1184\n\t"
        "ds_read_b64_tr_b16 %12, %20 offset:1216\n\tds_read_b64_tr_b16 %13, %20 offset:1248\n\tds_read_b64_tr_b16 %14, %20 offset:1280\n\tds_read_b64_tr_b16 %15, %20 offset:1312\n\t"
        "ds_read_b64_tr_b16 %16, %21\n\tds_read_b64_tr_b16 %17, %22\n\tds_read_b64_tr_b16 %18, %21 offset:1088\n\tds_read_b64_tr_b16 %19, %22 offset:1088\n\ts_waitcnt lgkmcnt(0)"
        : "=&v"(vl[0]), "=&v"(vl[1]), "=&v"(vl[2]), "=&v"(vl[3]), "=&v"(vl[4]), "=&v"(vl[5]), "=&v"(vl[6]), "=&v"(vl[7]),
          "=&v"(vh[0]), "=&v"(vh[1]), "=&v"(vh[2]), "=&v"(vh[3]), "=&v"(vh[4]), "=&v"(vh[5]), "=&v"(vh[6]), "=&v"(vh[7]),
          "=&v"(xl[0]), "=&v"(xl[1]), "=&v"(xh[0]), "=&v"(xh[1])
        : "v"(av), "v"(ak), "v"(ax) : "memory");
}
__device__ __forceinline__ bf16x8 mk8(u32x2 lo, u32x2 hi) { u32x4 v; v.x = lo.x; v.y = lo.y; v.z = hi.x; v.w = hi.y; return __builtin_bit_cast(bf16x8, v); }
__device__ __forceinline__ void hgrn_chain_lean(KArgs a, int cid, LAS unsigned char* lds) {
    const int tid = tid_fresh(), lane = tid & 63, wave = tid >> 6, fr = lane & 15, fq = lane >> 4;
    unsigned char* ws = a->ws;
    const bf16* P = (const bf16*)(ws + WS_P); const bf16* HQB = (const bf16*)(ws + WS_HQB); const float* HG = (const float*)(ws + WS_HG); bf16* OB = (bf16*)(ws + WS_OB);
    const int dir = cid / 48, b = (cid % 48) / 6, h = cid % 6;
    constexpr int QP = 136, SP = 72;
    LAS bf16* qs = (LAS bf16*)lds;
    LAS bf16* ks = qs + 64 * QP;
    LAS bf16* vs = ks + 64 * QP;
    LAS bf16* pl = vs + 64 * QP;
    LAS bf16* sT = pl + 64 * SP;
    LAS float* gm = (LAS float*)(sT + 128 * QP);
    const int ta = tid >> 3, d0 = (tid & 7) * 16;
    const int koff = dir ? OFF_ZB : OFF_ZF;
    f32x4 S[8];
#pragma unroll
    for (int vt = 0; vt < 8; ++vt) S[vt] = (f32x4){0.f, 0.f, 0.f, 0.f};
    u32x4 rq[2], rk[2], rv[2]; float rg = 0.f;
    auto load_chunk = [&](int n) { const int row = chain_row(dir, b, 64 * n + ta); const bf16* pr = P + (size_t)row * INC + h * 128 + d0;
        const bf16* qr = dir ? HQB + (size_t)row * BW + h * 128 + d0 : pr + OFF_Q;
        rq[0] = *(const u32x4*)qr; rq[1] = *(const u32x4*)(qr + 8); rk[0] = *(const u32x4*)(pr + koff); rk[1] = *(const u32x4*)(pr + koff + 8); rv[0] = *(const u32x4*)(pr + OFF_I); rv[1] = *(const u32x4*)(pr + OFF_I + 8);
        if (tid < 256) rg = HG[((size_t)(((dir * 8 + b) * 6 + h) * 68 + n)) * 256 + tid]; };
    load_chunk(0);
    constexpr int NCH = (CTXL + T) / 64;
    for (int n = 0; n < NCH; ++n) {
        const int s0 = n * 64;
        *(LAS u32x4*)(qs + ta * QP + d0) = rq[0]; *(LAS u32x4*)(qs + ta * QP + d0 + 8) = rq[1]; *(LAS u32x4*)(ks + ta * QP + d0) = rk[0]; *(LAS u32x4*)(ks + ta * QP + d0 + 8) = rk[1];
        *(LAS u32x4*)(vs + ta * QP + d0) = rv[0]; *(LAS u32x4*)(vs + ta * QP + d0 + 8) = rv[1]; if (tid < 256) gm[tid] = rg;
        if (n + 1 < NCH) load_chunk(n + 1);
        LDS_BAR();
        { const f32x4 g4 = *(const LAS f32x4*)(gm + 16 * wave + 4 * fq);
#pragma unroll
          for (int vt = 0; vt < 8; ++vt) { S[vt] = S[vt] * g4; u32x2 o; o.x = pk2(S[vt][0], S[vt][1]); o.y = pk2(S[vt][2], S[vt][3]); *(LAS u32x2*)(sT + (16 * vt + fr) * QP + 16 * wave + 4 * fq) = o; } }
        { const int tt = wave >> 1;
#pragma unroll
          for (int u = 0; u < 2; ++u) { const int sg = 2 * (wave & 1) + u; f32x4 acc = (f32x4){0.f, 0.f, 0.f, 0.f};
              if (sg <= tt) {
#pragma unroll
                  for (int kq = 0; kq < 4; ++kq) { const bf16x8 af = *(const LAS bf16x8*)(ks + (16 * sg + fr) * QP + 32 * kq + 8 * fq), bfm = *(const LAS bf16x8*)(qs + (16 * tt + fr) * QP + 32 * kq + 8 * fq);
                      acc = __builtin_amdgcn_mfma_f32_16x16x32_bf16(af, bfm, acc, 0, 0, 0); }
                  if (sg == tt) {
#pragma unroll
                      for (int j = 0; j < 4; ++j) if (4 * fq + j > fr) acc[j] = 0.f; }
              }
              u32x2 o; o.x = pk2(acc[0], acc[1]); o.y = pk2(acc[2], acc[3]); *(LAS u32x2*)(pl + (16 * tt + fr) * SP + 16 * sg + 4 * fq) = o; } }
        LDS_BAR();
        f32x4 oacc[4];
#pragma unroll
        for (int tt = 0; tt < 4; ++tt) { f32x4 acc = (f32x4){0.f, 0.f, 0.f, 0.f};
#pragma unroll
            for (int kq = 0; kq < 4; ++kq) { const bf16x8 af = *(const LAS bf16x8*)(sT + (16 * wave + fr) * QP + 32 * kq + 8 * fq), bfm = *(const LAS bf16x8*)(qs + (16 * tt + fr) * QP + 32 * kq + 8 * fq);
                acc = __builtin_amdgcn_mfma_f32_16x16x32_bf16(af, bfm, acc, 0, 0, 0); }
            oacc[tt] = acc; }
        const unsigned rs4 = (unsigned)(4 * QP * 2);
#pragma unroll
        for (int kq = 0; kq < 2; ++kq) {
            u32x2 vl_[8], vh_[8], xl_[2], xh_[2];
            static_assert(QP == 136, "tr_half's immediates assume 272-byte rows");
            tr_half(vl_, vh_, xl_, xh_, tr_addr(vs, QP, 32 * kq, 0, lane), tr_addr(ks, QP, 32 * kq, 16 * wave, lane), tr_addr(vs, QP, 32 * kq, 16 * wave, lane));
            __builtin_amdgcn_sched_barrier(0);
            { const bf16x8 af = mk8(xl_[1], xh_[1]);
#pragma unroll
              for (int tt = 0; tt < 4; ++tt) { const bf16x8 bfm = *(const LAS bf16x8*)(pl + (16 * tt + fr) * SP + 32 * kq + 8 * fq); oacc[tt] = __builtin_amdgcn_mfma_f32_16x16x32_bf16(af, bfm, oacc[tt], 0, 0, 0); } }
            { const bf16x8 af = mk8(xl_[0], xh_[0]);
#pragma unroll
              for (int vt = 0; vt < 8; ++vt) S[vt] = __builtin_amdgcn_mfma_f32_16x16x32_bf16(af, mk8(vl_[vt], vh_[vt]), S[vt], 0, 0, 0); }
        }
#pragma unroll
        for (int tt = 0; tt < 4; ++tt) { const int row = chain_row(dir, b, s0 + 16 * tt + fr);
            u32x2 o; o.x = pk2(oacc[tt][0], oacc[tt][1]); o.y = pk2(oacc[tt][2], oacc[tt][3]); *(u32x2*)(OB + ((size_t)dir * MALL + row) * BW + h * 128 + 16 * wave + 4 * fq) = o; }
        { const f32x4 ge = *(const LAS f32x4*)(gm + 128 + 16 * wave + 4 * fq);
#pragma unroll
          for (int vt = 0; vt < 8; ++vt) S[vt] = S[vt] * ge; }
        LDS_BAR();
    }
}
__device__ __forceinline__ void hgrn_chain_mfma(KArgs a, int l, int cid, LAS unsigned char* lds) {
    const int tid = tid_fresh(), lane = tid & 63, wave = tid >> 6, fr = lane & 15, fq = lane >> 4;
    unsigned char* ws = a->ws;
    const bf16* P = (const bf16*)(ws + WS_P); bf16* OB = (bf16*)(ws + WS_OB);
    const int dir = cid / 48, b = (cid % 48) / 6, h = cid % 6;
    constexpr int QP = 136, SP = 72;
    LAS bf16* qs = (LAS bf16*)lds;
    LAS bf16* ks = qs + 64 * QP;
    LAS bf16* kT = ks + 64 * QP;
    LAS bf16* vT = kT + 128 * SP;
    LAS bf16* pl = vT + 128 * SP;
    LAS bf16* sT = pl + 64 * SP;
    LAS float* tot = (LAS float*)(sT + 128 * QP);
    LAS float* gmid = tot + 512;
    LAS float* gend = gmid + 128;
    LAS float* lbs = gend + 128;
    LAS float* lfb = (LAS float*)sT;
    const int d = tid & 127, qt = tid >> 7;
    const int tau_a = tid >> 3, d0 = (tid & 7) * 16;
    if (tid < 128) { const int ch = h * 128 + tid; float lb = 0.f;
        if (l != 0) { const float l0 = a->in[I_LB][((size_t)dir * DEPTH + 0) * BW + ch], l1 = a->in[I_LB][((size_t)dir * DEPTH + 1) * BW + ch]; lb = 1.0f / (1.0f + __expf(l0 - l1)); }
        lbs[tid] = lb; }
    f32x4 S[8];
#pragma unroll
    for (int vt = 0; vt < 8; ++vt) S[vt] = (f32x4){0.f, 0.f, 0.f, 0.f};
    const int zoff = dir ? OFF_ZB : OFF_ZF;
    u32x4 rq[2], ri[2], rz[2];
    { const bf16* pr = P + (size_t)chain_row(dir, b, tau_a) * INC + h * 128 + d0;
      rq[0] = *(const u32x4*)(pr + OFF_Q); rq[1] = *(const u32x4*)(pr + OFF_Q + 8); ri[0] = *(const u32x4*)(pr + OFF_I); ri[1] = *(const u32x4*)(pr + OFF_I + 8); rz[0] = *(const u32x4*)(pr + zoff); rz[1] = *(const u32x4*)(pr + zoff + 8); }
    __syncthreads();
    constexpr int NCH = (CTXL + T) / 64;
    for (int n = 0; n < NCH; ++n) {
        const int s0 = n * 64;
#pragma unroll
        for (int hf = 0; hf < 2; ++hf) { float qf[8], zf[8], oq[8], ok[8]; unpack8(rq[hf], qf); unpack8(rz[hf], zf);
            const int dd = d0 + 8 * hf; const f32x4 lb0 = *(const LAS f32x4*)(lbs + dd), lb1 = *(const LAS f32x4*)(lbs + dd + 4); f32x4 lf0, lf1;
#pragma unroll
            for (int j = 0; j < 8; ++j) { const float lb = j < 4 ? lb0[j] : lb1[j - 4]; const float f = lb + (1.0f - lb) * sigmoidf_(zf[j]); const float lf = fmaxf(__logf(f), -60.0f);
                if (j < 4) lf0[j] = lf; else lf1[j - 4] = lf; oq[j] = siluf_(qf[j]); ok[j] = 1.0f - f; }
            *(LAS u32x4*)(qs + tau_a * QP + dd) = pack8(oq); *(LAS u32x4*)(ks + tau_a * QP + dd) = pack8(ok);
            *(LAS f32x4*)(lfb + tau_a * 128 + dd) = lf0; *(LAS f32x4*)(lfb + tau_a * 128 + dd + 4) = lf1;
            const u32x4 vv = ri[hf];
            vT[(dd + 0) * SP + tau_a] = (bf16)(vv.x & 0xffffu); vT[(dd + 1) * SP + tau_a] = (bf16)(vv.x >> 16); vT[(dd + 2) * SP + tau_a] = (bf16)(vv.y & 0xffffu); vT[(dd + 3) * SP + tau_a] = (bf16)(vv.y >> 16);
            vT[(dd + 4) * SP + tau_a] = (bf16)(vv.z & 0xffffu); vT[(dd + 5) * SP + tau_a] = (bf16)(vv.z >> 16); vT[(dd + 6) * SP + tau_a] = (bf16)(vv.w & 0xffffu); vT[(dd + 7) * SP + tau_a] = (bf16)(vv.w >> 16); }
        if (n + 1 < NCH) { const bf16* pr = P + (size_t)chain_row(dir, b, s0 + 64 + tau_a) * INC + h * 128 + d0;
            rq[0] = *(const u32x4*)(pr + OFF_Q); rq[1] = *(const u32x4*)(pr + OFF_Q + 8); ri[0] = *(const u32x4*)(pr + OFF_I); ri[1] = *(const u32x4*)(pr + OFF_I + 8); rz[0] = *(const u32x4*)(pr + zoff); rz[1] = *(const u32x4*)(pr + zoff + 8); }
        LDS_BAR();
        float cs[16];
        { float run = 0.f;
#pragma unroll
          for (int i = 0; i < 16; ++i) { run += lfb[(16 * qt + i) * 128 + d]; cs[i] = run; }
          tot[qt * 128 + d] = run; }
        LDS_BAR();
        { const float t0 = tot[d], t1 = tot[128 + d], t2 = tot[256 + d], t3 = tot[384 + d];
          const float bmid = t0 + t1, btot = bmid + t2 + t3; const float base = (qt > 0 ? t0 : 0.f) + (qt > 1 ? t1 : 0.f) + (qt > 2 ? t2 : 0.f);
          if (qt == 0) { gmid[d] = __expf(bmid); gend[d] = __expf(btot - bmid); }
#pragma unroll
          for (int i = 0; i < 16; ++i) { const int tau = 16 * qt + i; const float bt = base + cs[i];
              const float eq = __expf(fminf(bt - bmid, 80.0f)), ek = __expf(fminf(bmid - bt, 80.0f));
              const bf16 qb = (bf16)f2bf(bf1(qs[tau * QP + d]) * eq), kb = (bf16)f2bf(bf1(ks[tau * QP + d]) * ek);
              qs[tau * QP + d] = qb; ks[tau * QP + d] = kb; kT[d * SP + tau] = kb; } }
        LDS_BAR();
        { const f32x4 gm = *(const LAS f32x4*)(gmid + 16 * wave + 4 * fq);
#pragma unroll
          for (int vt = 0; vt < 8; ++vt) { S[vt] = S[vt] * gm; u32x2 o; o.x = pk2(S[vt][0], S[vt][1]); o.y = pk2(S[vt][2], S[vt][3]); *(LAS u32x2*)(sT + (16 * vt + fr) * QP + 16 * wave + 4 * fq) = o; } }
        { const int tt = wave >> 1;
#pragma unroll
          for (int u = 0; u < 2; ++u) { const int sg = 2 * (wave & 1) + u; f32x4 acc = (f32x4){0.f, 0.f, 0.f, 0.f};
              if (sg <= tt) {
#pragma unroll
                  for (int kq = 0; kq < 4; ++kq) { const bf16x8 af = *(const LAS bf16x8*)(ks + (16 * sg + fr) * QP + 32 * kq + 8 * fq), bfm = *(const LAS bf16x8*)(qs + (16 * tt + fr) * QP + 32 * kq + 8 * fq);
                      acc = __builtin_amdgcn_mfma_f32_16x16x32_bf16(af, bfm, acc, 0, 0, 0); }
                  if (sg == tt) {
#pragma unroll
                      for (int j = 0; j < 4; ++j) if (4 * fq + j > fr) acc[j] = 0.f; }
              }
              u32x2 o; o.x = pk2(acc[0], acc[1]); o.y = pk2(acc[2], acc[3]); *(LAS u32x2*)(pl + (16 * tt + fr) * SP + 16 * sg + 4 * fq) = o; } }
        LDS_BAR();
#pragma unroll
        for (int tt = 0; tt < 4; ++tt) { f32x4 acc = (f32x4){0.f, 0.f, 0.f, 0.f};
#pragma unroll
            for (int kq = 0; kq < 2; ++kq) { const bf16x8 af = *(const LAS bf16x8*)(vT + (16 * wave + fr) * SP + 32 * kq + 8 * fq), bfm = *(const LAS bf16x8*)(pl + (16 * tt + fr) * SP + 32 * kq + 8 * fq);
                acc = __builtin_amdgcn_mfma_f32_16x16x32_bf16(af, bfm, acc, 0, 0, 0); }
#pragma unroll
            for (int kq = 0; kq < 4; ++kq) { const bf16x8 af = *(const LAS bf16x8*)(sT + (16 * wave + fr) * QP + 32 * kq + 8 * fq), bfm = *(const LAS bf16x8*)(qs + (16 * tt + fr) * QP + 32 * kq + 8 * fq);
                acc = __builtin_amdgcn_mfma_f32_16x16x32_bf16(af, bfm, acc, 0, 0, 0); }
            const int row = chain_row(dir, b, s0 + 16 * tt + fr);
            u32x2 o; o.x = pk2(acc[0], acc[1]); o.y = pk2(acc[2], acc[3]); *(u32x2*)(OB + ((size_t)dir * MALL + row) * BW + h * 128 + 16 * wave + 4 * fq) = o; }
        { const f32x4 ge = *(const LAS f32x4*)(gend + 16 * wave + 4 * fq);
#pragma unroll
          for (int kq = 0; kq < 2; ++kq) { const bf16x8 af = *(const LAS bf16x8*)(kT + (16 * wave + fr) * SP + 32 * kq + 8 * fq);
#pragma unroll
              for (int vt = 0; vt < 8; ++vt) { const bf16x8 bfm = *(const LAS bf16x8*)(vT + (16 * vt + fr) * SP + 32 * kq + 8 * fq); S[vt] = __builtin_amdgcn_mfma_f32_16x16x32_bf16(af, bfm, S[vt], 0, 0, 0); } }
#pragma unroll
          for (int vt = 0; vt < 8; ++vt) S[vt] = S[vt] * ge; }
        LDS_BAR();
    }
}
__device__ __forceinline__ void hgrn_chain(KArgs a, int l, int cid, LAS unsigned char* lds) {
    const int tid = tid_fresh();
    unsigned char* ws = a->ws;
    const bf16* P = (const bf16*)(ws + WS_P); bf16* OB = (bf16*)(ws + WS_OB);
    const int dir = cid / 48, b = (cid % 48) / 6, h = cid % 6;
    LAS float* tq = (LAS float*)lds;
    LAS float* tk = tq + 16 * 128;
    LAS float* tf = tk + 16 * 128;
    LAS float* tv = tf + 16 * 128;
    LAS float* ot = tv + 16 * 128;
    const int v = tid >> 2, q = tid & 3;
    float S[32];
#pragma unroll
    for (int j = 0; j < 32; ++j) S[j] = 0.f;
    const int sst = tid >> 5, sc4 = (tid & 31) * 4;
    float lb[4];
#pragma unroll
    for (int j = 0; j < 4; ++j) { const int ch = h * 128 + sc4 + j;
        if (l == 0) lb[j] = 0.f; else { const float l0 = a->in[I_LB][((size_t)dir * DEPTH + 0) * BW + ch], l1 = a->in[I_LB][((size_t)dir * DEPTH + 1) * BW + ch]; lb[j] = 1.0f / (1.0f + __expf(l0 - l1)); } }
    for (int s0 = 0; s0 < CTXL + T; s0 += 16) {
        { const int row = chain_row(dir, b, s0 + sst); const bf16* pr = P + (size_t)row * INC + h * 128 + sc4;
          const u32x2 pq = *(const u32x2*)(pr + OFF_Q), pi = *(const u32x2*)(pr + OFF_I), pz = *(const u32x2*)(pr + (dir ? OFF_ZB : OFF_ZF));
          const float qf[4] = {bflo(pq.x), bfhi(pq.x), bflo(pq.y), bfhi(pq.y)}, vf[4] = {bflo(pi.x), bfhi(pi.x), bflo(pi.y), bfhi(pi.y)}, zf[4] = {bflo(pz.x), bfhi(pz.x), bflo(pz.y), bfhi(pz.y)};
          f32x4 oq, ok, of, ov;
#pragma unroll
          for (int j = 0; j < 4; ++j) { const float f = lb[j] + (1.0f - lb[j]) * sigmoidf_(zf[j]); oq[j] = siluf_(qf[j]); of[j] = f; ok[j] = 1.0f - f; ov[j] = vf[j]; }
          *(LAS f32x4*)(tq + sst * 128 + sc4) = oq; *(LAS f32x4*)(tk + sst * 128 + sc4) = ok; *(LAS f32x4*)(tf + sst * 128 + sc4) = of; *(LAS f32x4*)(tv + sst * 128 + sc4) = ov; }
        LDS_BAR();
        for (int st = 0; st < 16; ++st) {
            const float vv = tv[st * 128 + v]; float o0 = 0.f, o1 = 0.f;
#pragma unroll
            for (int j = 0; j < 8; ++j) { const f32x4 fq4 = *(const LAS f32x4*)(tf + st * 128 + q * 32 + 4 * j), kq4 = *(const LAS f32x4*)(tk + st * 128 + q * 32 + 4 * j), qq4 = *(const LAS f32x4*)(tq + st * 128 + q * 32 + 4 * j);
#pragma unroll
                for (int i = 0; i < 4; ++i) { const float sn = fq4[i] * S[4 * j + i] + kq4[i] * vv; S[4 * j + i] = sn; if (i & 1) o1 += qq4[i] * sn; else o0 += qq4[i] * sn; } }
            float o = o0 + o1; o += dpp_xor1(o); o += dpp_xor2(o);
            if (q == 0) ot[st * 128 + v] = o;
        }
        LDS_BAR();
        if (tid < 256) { const int st = tid >> 4, part = tid & 15; const int row = chain_row(dir, b, s0 + st); const LAS float* op = ot + st * 128 + part * 8;
            float f[8];
#pragma unroll
            for (int j = 0; j < 8; ++j) f[j] = op[j];
            *(u32x4*)(OB + ((size_t)dir * MALL + row) * BW + h * 128 + part * 8) = pack8(f); }
    }
    LDS_BAR();
}

__device__ __forceinline__ float grp_sum32(float v) { v += __shfl_xor(v, 1); v += __shfl_xor(v, 2); v += __shfl_xor(v, 4); v += __shfl_xor(v, 8); v += __shfl_xor(v, 16); return v; }
__device__ __forceinline__ float grp_sum16(float v) { v += __shfl_xor(v, 1); v += __shfl_xor(v, 2); v += __shfl_xor(v, 4); v += __shfl_xor(v, 8); return v; }
__device__ __forceinline__ void phase_finalize(KArgs a, int l, bool dry) {
    const int tid_ = tid_fresh(); const int lane = tid_ & 63, wave = tid_ >> 6, gw = blockIdx.x * 8 + wave, NGW = gridDim.x * 8;
    unsigned char* ws = a->ws;
    const bf16* P = (const bf16*)(ws + WS_P); const bf16* OB = (const bf16*)(ws + WS_OB); const bf16* OC = (const bf16*)(ws + WS_OC); bf16* Y = (bf16*)(ws + WS_Y);
    unsigned char* Yo = dry ? ws + WS_END : ws + WS_Y8;
    const int nrows = (l == DEPTH - 1) ? NLAT : MALL;
    const int rpw = (nrows + NGW - 1) / NGW; const int r0 = gw * rpw, r1 = (r0 + rpw < nrows) ? r0 + rpw : nrows;
    f32x4 hng[3], gng[3], gnb[3];
#pragma unroll
    for (int k = 0; k < 3; ++k) { const int c = 256 * k + 4 * lane; hng[k] = *(const f32x4*)(a->in[I_HNG] + (size_t)l * BW + c);
        gng[k] = *(const f32x4*)(a->in[I_GNGG] + (size_t)l * CW + c); gnb[k] = *(const f32x4*)(a->in[I_GNB] + (size_t)l * CW + c); }
    for (int row = r0; row < r1; ++row) {
        const int orow = dry ? (row & 2047) : row;
        u32x2 bf_[3], bb_[3], bg_[3], cf_[3], cb_[3], cv_[3], cg_[3];
#pragma unroll
        for (int k = 0; k < 3; ++k) { const int c = 256 * k + 4 * lane;
            bf_[k] = *(const u32x2*)(OB + (size_t)row * BW + c); bb_[k] = *(const u32x2*)(OB + ((size_t)MALL + row) * BW + c); bg_[k] = *(const u32x2*)(P + (size_t)row * INC + OFF_OG + c);
            cf_[k] = *(const u32x2*)(OC + (size_t)row * CW + c); cb_[k] = *(const u32x2*)(OC + ((size_t)MALL + row) * CW + c);
            cv_[k] = *(const u32x2*)(Y + (size_t)row * D + 512 + c);
            cg_[k] = *(const u32x2*)(Y + (size_t)row * D + 1280 + c); }
#pragma unroll
        for (int k = 0; k < 3; ++k) { const int c = 256 * k + 4 * lane;
            { float o[4] = {bflo(bf_[k].x) + bflo(bb_[k].x), bfhi(bf_[k].x) + bfhi(bb_[k].x), bflo(bf_[k].y) + bflo(bb_[k].y), bfhi(bf_[k].y) + bfhi(bb_[k].y)};
              const float ss = grp_sum32((o[0] * o[0] + o[1] * o[1]) + (o[2] * o[2] + o[3] * o[3])); const float rstd = 1.0f / sqrtf(ss * (1.0f / 128.0f) + NORM_EPS);
              const float g4[4] = {bflo(bg_[k].x), bfhi(bg_[k].x), bflo(bg_[k].y), bfhi(bg_[k].y)}; float y[4];
#pragma unroll
              for (int j = 0; j < 4; ++j) y[j] = o[j] * rstd * hng[k][j] * sigmoidf_(g4[j]);
              *(unsigned*)(Yo + (size_t)orow * D + 512 + c) = pk4_fp8(y[0], y[1], y[2], y[3]); }
            { float o[4] = {bflo(cf_[k].x) + bflo(cb_[k].x), bfhi(cf_[k].x) + bfhi(cb_[k].x), bflo(cf_[k].y) + bflo(cb_[k].y), bfhi(cf_[k].y) + bfhi(cb_[k].y)};
              const float v4[4] = {bflo(cv_[k].x), bfhi(cv_[k].x), bflo(cv_[k].y), bfhi(cv_[k].y)}, g4[4] = {bflo(cg_[k].x), bfhi(cg_[k].x), bflo(cg_[k].y), bfhi(cg_[k].y)};
              const float mean = grp_sum16((o[0] + o[1]) + (o[2] + o[3])) * (1.0f / 64.0f);
              float dl[4]; float sq = 0.f;
#pragma unroll
              for (int j = 0; j < 4; ++j) { dl[j] = o[j] - mean; sq += dl[j] * dl[j]; }
              const float var = grp_sum16(sq) * (1.0f / 64.0f); const float rs = 1.0f / sqrtf(var + GN_EPS); float y[4];
#pragma unroll
              for (int j = 0; j < 4; ++j) y[j] = (dl[j] * rs * gng[k][j] + gnb[k][j] + v4[j]) * g4[j];
              *(unsigned*)(Yo + (size_t)orow * D + 1280 + c) = pk4_fp8(y[0], y[1], y[2], y[3]); }
        }
    }
}

__global__ void __launch_bounds__(NTHREADS, 2) mk_fwd(Args args_unused) {
    extern __shared__ __attribute__((aligned(16))) unsigned char lds_raw[];
    LAS unsigned char* lds = (LAS unsigned char*)lds_raw;
    volatile LAS unsigned* misc = (volatile LAS unsigned*)(lds + LDS_MISC);
    const int tid = threadIdx.x, G = gridDim.x;
    if (tid < 64) misc[tid] = 0u;
    __syncthreads();
    XcdBarrier bar; bar.bar = nullptr; bar.x = 0; bar.st = nullptr;
    int lo, hi;
    { KArgs a = kargs(); lo = a->ph_lo; hi = a->ph_hi; unsigned* ctl = (unsigned*)(a->ws + WS_CTL); bar.bar = ctl + CW_BAR; if (!MK_MULTI) bar = xcd_barrier_post(ctl + CW_BAR, misc + 8); }
    const int cvirt = (G % 8 == 0) ? ((int)blockIdx.x % 8) * (G / 8) + (int)blockIdx.x / 8 : (int)blockIdx.x;
#define IN(k) (lo <= (k) && (k) < hi)
#define PM(b) ((PHMASK >> (b)) & 1)
#define REP(b) _Pragma("unroll 1") for (int rep_ = 0; rep_ < 1 + ((PROBE_DUP >> (b)) & 1); ++rep_)
#define SEAM(k) do { if (!MK_MULTI && IN(k) && IN((k) + 1)) { xcd_barrier(bar); if ((PROBE_DUP >> 13) & 1) xcd_barrier(bar); } } while (0)

    if (PM(0) && IN(0)) REP(0) { phase_prologue(kargs(), lds); } SEAM(0);

#pragma unroll 1
    for (int l = 0; l < DEPTH; ++l) {
        const int pb = 1 + 9 * l;
        const bool lastl = (l == DEPTH - 1);
        if (PM(1) && IN(pb + 0)) { if ((PROBE_DUP >> 1) & 1) { if (l == 0) phase_norm1<0>(kargs(), l, true); else phase_norm1<1>(kargs(), l, true); } if (l == 0) phase_norm1<0>(kargs(), l, false); else { phase_norm1<1>(kargs(), l, false); __syncthreads(); convert_moe(kargs(), l, lds); __syncthreads(); } } SEAM(pb + 0);
        if (PM(2) && IN(pb + 1)) REP(2) {
            KArgs a = kargs(); unsigned char* ws = a->ws;
            pg8::Gemm g{(const bf16*)(ws + WS_H), (const bf16*)(ws + WS_WIN + (size_t)l * INC * D), MALL, INC, D / 2};
            pg8::StaticOrder S; S.init(MALL, INC, G, (int)blockIdx.x);
            pg8::EpiBf16 E{(bf16*)(ws + WS_P), INC};
            pg8::gemm_phase8<pg8::EpiBf16, pg8::StaticOrder, false, false>(lds, g, S, E, nullptr);
        } SEAM(pb + 1);
        if (PM(3) && IN(pb + 2)) {
            const int ngm = lastl ? 1024 : 1088;
            unsigned* qhead = (unsigned*)(kargs()->ws + WS_CTL) + CW_PREPQ + 64 * l;
            const int n_rw = 544 * 3, n_hg = 3264, n_all = (G == 256) ? n_rw + n_hg : n_rw + n_hg + ngm;
            for (;;) {
                if (threadIdx.x == 0) misc[16] = __hip_atomic_fetch_add(qhead, 1u, __ATOMIC_RELAXED, __HIP_MEMORY_SCOPE_AGENT);
                __syncthreads();
                const int it = (int)misc[16];
                if (it >= n_all) break;
                if (it < n_rw) { _Pragma("unroll 1") for (int r2 = 0; r2 < 1 + ((PROBE_DUP >> 15) & 1); ++r2) rwkv_prep_item(kargs(), l, it / 3, it % 3, lds); }
                else if (it < n_rw + n_hg) { if ((PROBE_DUP >> 16) & 1) hgrn_prep_item(kargs(), l, it - n_rw, lds, true); hgrn_prep_item(kargs(), l, it - n_rw, lds, false); }
                else { _Pragma("unroll 1") for (int r2 = 0; r2 < 1 + ((PROBE_DUP >> 14) & 1); ++r2) gmlp_item(kargs(), l, it - n_rw - n_hg, lds); }
            }
            __syncthreads();
        } SEAM(pb + 2);
        if (PM(4) && IN(pb + 3)) REP(4) {
            if (G == 256) { const int bx = blockIdx.x;
                if (bx < 96) { _Pragma("unroll 1") for (int r2 = 0; r2 < 1 + ((PROBE_DUP >> 12) & 1); ++r2) rwkv_chain_mfma(kargs(), bx * 8, lds); }
                else if (bx < 192) { _Pragma("unroll 1") for (int r2 = 0; r2 < 1 + ((PROBE_DUP >> 11) & 1); ++r2) hgrn_chain_lean(kargs(), bx - 96, lds); }
                if (bx < 96 || bx >= 192) {
                    unsigned* gq = (unsigned*)(kargs()->ws + WS_CTL) + CW_GMQ + 64 * l; const int ngm2 = lastl ? 1024 : 1088;
                    for (;;) { if (threadIdx.x == 0) misc[17] = __hip_atomic_fetch_add(gq, 1u, __ATOMIC_RELAXED, __HIP_MEMORY_SCOPE_AGENT);
                        __syncthreads(); const int it = (int)misc[17]; if (it >= ngm2) break; gmlp_item(kargs(), l, it, lds); }
                    __syncthreads(); } }
            else { for (int it = blockIdx.x; it < 192; it += G) { if (it < 96) rwkv_chain_mfma(kargs(), it * 8, lds); else hgrn_chain_lean(kargs(), it - 96, lds); } }
        } SEAM(pb + 3);
        if (PM(5) && IN(pb + 4)) { if ((PROBE_DUP >> 5) & 1) phase_finalize(kargs(), l, true); phase_finalize(kargs(), l, false); } SEAM(pb + 4);
        if (PM(6) && IN(pb + 5)) REP(6) {
            KArgs a = kargs(); unsigned char* ws = a->ws;
            const int Mo = lastl ? NLAT : MALL;
            pg8::Gemm g{(const bf16*)(ws + WS_Y8), (const bf16*)(ws + WS_WOUT + (size_t)l * D * D), Mo, D, D / 2};
            pg8::StaticOrder S; S.init(Mo, D, G, (int)blockIdx.x);
            const float* xl = a->in[I_X]; const float* xc = a->in[I_CTX];
            pg8::EpiResid E{xl, xc, (bf16*)(ws + WS_X), (const float*)(ws + WS_MOD) + (size_t)l * 9 * 12288 + 2 * D, l == 0};
            pg8::gemm_phase8<pg8::EpiResid, pg8::StaticOrder, true, false>(lds, g, S, E, nullptr);
        } SEAM(pb + 5);
        if (PM(7) && IN(pb + 6)) { if ((PROBE_DUP >> 7) & 1) phase_norm2_router(kargs(), l, true, lds); phase_norm2_router(kargs(), l, false, lds); } SEAM(pb + 6);
        if (PM(8) && IN(pb + 7)) REP(8) {
            KArgs a = kargs(); unsigned char* ws = a->ws;
            moe_tables<false>(a, l, lds, cvirt);
            pg8::Gemm g{(const bf16*)(ws + WS_H), (const bf16*)(ws + WS_WGU), 0, 2048, D / 2};
            pg8::MoeOrder S{(const LAS int*)(lds + LDS_TP), G, cvirt, (unsigned)(2048 * D)};
            pg8::EpiSwiglu E{ws + WS_ACT};
            pg8::gemm_phase8<pg8::EpiSwiglu, pg8::MoeOrder, false, true>(lds, g, S, E, (const LAS unsigned*)(lds + LDS_TAB));
        } SEAM(pb + 7);
        if (PM(9) && IN(pb + 8)) REP(9) {
            KArgs a = kargs(); unsigned char* ws = a->ws;
            moe_tables<true>(a, l, lds, cvirt);
            pg8::Gemm g{(const bf16*)(ws + WS_ACT), (const bf16*)(ws + WS_WDN), 0, D, DE / 2};
            pg8::MoeOrder S{(const LAS int*)(lds + LDS_TP), G, cvirt, (unsigned)(D * DE)};
            pg8::EpiDown E{ws + WS_YK, (const LAS unsigned*)(lds + LDS_TAB), (const LAS float*)(lds + LDS_TABW)};
            pg8::gemm_phase8<pg8::EpiDown, pg8::MoeOrder, false, false>(lds, g, S, E, nullptr);
        } SEAM(pb + 8);
    }
    if (PM(10) && IN(1 + 9 * DEPTH)) { if ((PROBE_DUP >> 10) & 1) phase_norm1<2>(kargs(), DEPTH, true); phase_norm1<2>(kargs(), DEPTH, false); }
#undef IN
#undef SEAM
}

extern "C" void kernel_launch(void* const* d_in, const int* in_sizes, int n_in, void* d_out, int out_size, void* d_ws, size_t ws_size, hipStream_t stream) {
    static int grid = 0;
    if (grid == 0) {
        if (n_in != 31 || ws_size < WS_END) { fprintf(stderr, "kernel_launch: unexpected n_in %d / ws %zu (need %zu)\n", n_in, ws_size, (size_t)WS_END); grid = -1; return; }
        int dev = 0, cus = 0, per_cu = 0;
        hipGetDevice(&dev); hipDeviceGetAttribute(&cus, hipDeviceAttributeMultiprocessorCount, dev);
        if (hipFuncSetAttribute((const void*)mk_fwd, hipFuncAttributeMaxDynamicSharedMemorySize, LDS_BYTES) != hipSuccess) { fprintf(stderr, "kernel_launch: hipFuncSetAttribute failed\n"); grid = -1; return; }
        if (hipOccupancyMaxActiveBlocksPerMultiprocessor(&per_cu, (const void*)mk_fwd, NTHREADS, LDS_BYTES) != hipSuccess || per_cu < 1) fprintf(stderr, "kernel_launch: occupancy query says %d\n", per_cu);
        (void)hipGetLastError();
        grid = cus > 0 ? cus : 256;
    }
    if (grid < 0) return;
    hipMemsetAsync((char*)d_ws + WS_CTL, 0, CTL_ZERO_BYTES, stream);
    Args a{};
    for (int i = 0; i < 31; ++i) a.in[i] = (const float*)d_in[i];
    a.out = (float*)d_out; a.ws = (unsigned char*)d_ws;
    constexpr int NPH = 2 + 9 * DEPTH;
#if MK_MULTI
    for (int p = 0; p < NPH; ++p) { a.ph_lo = p; a.ph_hi = p + 1; hipLaunchKernelGGL(mk_fwd, dim3(grid), dim3(NTHREADS), LDS_BYTES, stream, a); }
#else
    a.ph_lo = 0; a.ph_hi = NPH; hipLaunchKernelGGL(mk_fwd, dim3(grid), dim3(NTHREADS), LDS_BYTES, stream, a);
#endif
}
```

```cpp
#include <hip/hip_runtime.h>
#include <cstdio>
#include <cstdint>

#ifndef PHMASK
#define PHMASK 0xFFFF
#endif
#ifndef PROBE_DUP
#define PROBE_DUP 0
#endif
#ifndef MK_MULTI
#define MK_MULTI 0
#endif

#define GAS __attribute__((address_space(1)))
#define LAS __attribute__((address_space(3)))
typedef unsigned short bf16;
typedef short bf16x8 __attribute__((ext_vector_type(8)));
typedef float f32x4 __attribute__((ext_vector_type(4)));
typedef float f32x2 __attribute__((ext_vector_type(2)));
typedef unsigned u32x4 __attribute__((ext_vector_type(4)));
typedef unsigned u32x2 __attribute__((ext_vector_type(2)));

constexpr int D = 2048, NB = 8, T = 4096, CTXL = 256, DEPTH = 2;
constexpr int NLAT = NB * T, NCTX = NB * CTXL, MALL = NLAT + NCTX;
constexpr int INC = 7424;
constexpr int OFF_U = 0, OFF_V = 512, OFF_Q = 1024, OFF_I = 1792, OFF_ZF = 2560, OFF_ZB = 3328, OFF_OG = 4096;
constexpr int OFF_C = 4864;
constexpr int BW = 768, CW = 768, CCOLS = 2560;
constexpr int NE = 16, DE = 1024;
constexpr int PC2W = 7 * 768;
constexpr int NTHREADS = 512;
constexpr float NORM_EPS = 1e-6f, GN_EPS = 64e-5f, DECAY_SCALE = 0.60653065971263342f;

constexpr size_t MiB = 1u << 20;
constexpr size_t WS_CTL = 0, CTL_ZERO_BYTES = 1 * MiB;
constexpr size_t WS_MOD = 1 * MiB;
constexpr size_t WS_SMALLW = 2 * MiB;
constexpr size_t SW_WUP = 0, SW_AUP = SW_WUP + (size_t)2 * 2 * 768 * 64 * 2, SW_GUP = SW_AUP + (size_t)2 * 768 * 64 * 2, SW_GWS = SW_GUP + (size_t)2 * 768 * 128 * 2;
constexpr size_t WS_WIN = 4 * MiB, WS_WOUT = 62 * MiB, WS_WGU = 78 * MiB, WS_WDN = 142 * MiB, WS_Y8 = 174 * MiB;
constexpr size_t WS_X = 270 * MiB, WS_H = 542 * MiB, WS_Y = 678 * MiB, WS_P = 814 * MiB, WS_PRE = 1307 * MiB, WS_VT = 1817 * MiB, WS_OC = 1868 * MiB, WS_HQB = 1970 * MiB, WS_HG = 2021 * MiB, WS_END = 2028 * MiB;
constexpr int PRE_REC = 10240, PR_WP = 0, PR_RP = 2048, PR_BK = 4096, PR_ARBK = 8192, PR_MAK = 9216, PR_GAM = 9728, NCHUNK16 = 272;
constexpr size_t WS_OB = WS_H;
constexpr size_t WS_ACT = WS_P, WS_YK = WS_P + 144 * MiB, WS_RIDX = WS_P + 416 * MiB, WS_RW = WS_RIDX + 3 * MiB;
static_assert(WS_RW + 3 * MiB <= WS_PRE, "moe overlay");
constexpr int MAXSLOT_TILES = 288;
constexpr int CW_BAR = 4096;
constexpr int CW_GMQ = 30720;
constexpr int CW_PREPQ = 28672;
constexpr int CW_CNT = 16384;

constexpr int LDS_STAGE = 0, LDS_TAB = 131072, LDS_TABW = LDS_TAB + 9 * 1024, LDS_TP = LDS_TABW + 9 * 1024, LDS_MISC = 150528, LDS_BYTES = 152 * 1024;
static_assert(LDS_TP + 128 <= LDS_MISC, "lds map");

typedef __bf16 bf16x2_t __attribute__((ext_vector_type(2)));
__device__ __forceinline__ unsigned pk2(float lo, float hi) { const f32x2 v = {lo, hi}; return __builtin_bit_cast(unsigned, __builtin_convertvector(v, bf16x2_t)); }
__device__ __forceinline__ unsigned f2bf(float f) { return pk2(f, f) & 0xffffu; }
__device__ __forceinline__ unsigned pk4_fp8(float a, float b, float c, float d) {
    a = __builtin_amdgcn_fmed3f(a, -448.f, 448.f); b = __builtin_amdgcn_fmed3f(b, -448.f, 448.f); c = __builtin_amdgcn_fmed3f(c, -448.f, 448.f); d = __builtin_amdgcn_fmed3f(d, -448.f, 448.f);
    int p = 0; p = __builtin_amdgcn_cvt_pk_fp8_f32(a, b, p, false); p = __builtin_amdgcn_cvt_pk_fp8_f32(c, d, p, true); return (unsigned)p; }
__device__ __forceinline__ float bflo(unsigned u) { return __builtin_bit_cast(float, u << 16); }
__device__ __forceinline__ float bfhi(unsigned u) { return __builtin_bit_cast(float, u & 0xffff0000u); }
__device__ __forceinline__ float bf1(bf16 b) { return __builtin_bit_cast(float, ((unsigned)b) << 16); }
__device__ __forceinline__ float sigmoidf_(float x) { return __builtin_amdgcn_rcpf(1.0f + __expf(-x)); }
__device__ __forceinline__ float siluf_(float x) { return x * __builtin_amdgcn_rcpf(1.0f + __expf(-x)); }
__device__ __forceinline__ float geluf_(float v) {
    const float av = fabsf(v), t = __builtin_amdgcn_rcpf(av * 0.2316418882f + 1.0f);
    float q = t * 0.5307027145f + (-0.7265760135f); q = q * t + 0.7107068705f; q = q * t + (-0.142248368f); q = q * t + 0.127414796f; q = q * t;
    const float e = __builtin_amdgcn_exp2f((v * v) * (-0.72134752044f)); const float m = v * (q * e); return v < 0.f ? m : v - m; }
__device__ __forceinline__ float wave_sum(float v) {
#pragma unroll
    for (int o = 1; o < 64; o <<= 1) v += __shfl_xor(v, o);
    return v;
}
__device__ __forceinline__ int tid_fresh() { int t = threadIdx.x; asm volatile("" : "+v"(t)); return t; }
__device__ __forceinline__ void unpack8(const u32x4 v, float (&f)[8]) {
    f[0] = bflo(v.x); f[1] = bfhi(v.x); f[2] = bflo(v.y); f[3] = bfhi(v.y); f[4] = bflo(v.z); f[5] = bfhi(v.z); f[6] = bflo(v.w); f[7] = bfhi(v.w);
}
__device__ __forceinline__ u32x4 pack8(const float (&f)[8]) { u32x4 v; v.x = pk2(f[0], f[1]); v.y = pk2(f[2], f[3]); v.z = pk2(f[4], f[5]); v.w = pk2(f[6], f[7]); return v; }
__device__ __forceinline__ int modrow_of(int row) { return row < NLAT ? (row >> 12) : 8; }

#define XB_TMO      128
#define XB_XCNT(j)  (256  + 64 * (j))
#define XB_XSUB(j)  (1280 + 64 * (j))
#define XB_XGEN(j)  (2304 + 64 * (j))
#define XB_TOP      3328
#define XB_TOPGEN   3392
#define XCD_BAR_WORDS 3456
#define XB_SPIN_CAP (1u << 18)
__device__ __forceinline__ unsigned xb_ld(unsigned* p)              { return __hip_atomic_load(p, __ATOMIC_RELAXED, __HIP_MEMORY_SCOPE_AGENT); }
__device__ __forceinline__ unsigned xb_add(unsigned* p, unsigned v) { return __hip_atomic_fetch_add(p, v, __ATOMIC_RELAXED, __HIP_MEMORY_SCOPE_AGENT); }
__device__ __forceinline__ unsigned xb_xcc_id() { return (unsigned)__builtin_amdgcn_s_getreg((3 << 11) | 20) & 0xFu; }
#define XB_SPIN(cond, bar) do { unsigned _sp = 0; while (cond) { __builtin_amdgcn_s_sleep(1); \
    if ((++_sp & 255u) == 0u) { if (xb_ld(&(bar)[XB_TMO])) break; if (_sp > XB_SPIN_CAP) { atomicAdd(&(bar)[XB_TMO], 1u); break; } } } } while (0)
struct XcdBarrier { unsigned* bar; unsigned x; volatile LAS unsigned* st; };
__device__ __forceinline__ XcdBarrier xcd_barrier_post(unsigned* bar, volatile LAS unsigned* st) {
    XcdBarrier b; b.bar = bar; b.x = xb_xcc_id(); b.st = st;
    if (threadIdx.x == 0) (void)xb_add(&bar[XB_XCNT(b.x)], 1u);
    return b;
}
__device__ __forceinline__ void xcd_barrier_complete(unsigned* bar, unsigned x, unsigned& nloc, unsigned& nx) {
    const unsigned G = gridDim.x * gridDim.y * gridDim.z;
    unsigned sum, cnt, mine, sp = 0u;
    for (;;) {
        sum = 0u; cnt = 0u; mine = 0u;
#pragma unroll
        for (unsigned j = 0; j < 16; ++j) { const unsigned c = xb_ld(&bar[XB_XCNT(j)]); sum += c; cnt += (c > 0u) ? 1u : 0u; mine = (j == x) ? c : mine; }
        if (sum == G) break;
        __builtin_amdgcn_s_sleep(1);
        if ((++sp & 255u) == 0u) { if (xb_ld(&bar[XB_TMO])) break; if (sp > XB_SPIN_CAP) { atomicAdd(&bar[XB_TMO], 1u); break; } }
    }
    nloc = mine > 0u ? mine : 1u; nx = cnt > 0u ? cnt : 1u;
}
__device__ __forceinline__ void xcd_barrier(const XcdBarrier& b) {
    asm volatile("s_waitcnt vmcnt(0)" ::: "memory");
    __syncthreads();
    if (threadIdx.x == 0) {
        unsigned* bar = b.bar;
        __builtin_amdgcn_s_waitcnt(0);
        unsigned nloc = b.st[0], nx = b.st[1];
        if (nloc == 0u) { xcd_barrier_complete(bar, b.x, nloc, nx); b.st[0] = nloc; b.st[1] = nx; }
        const unsigned old = xb_add(&bar[XB_XSUB(b.x)], 1u);
        const unsigned gen = old / nloc;
        if (old + 1u == (gen + 1u) * nloc) {
            __builtin_amdgcn_fence(__ATOMIC_RELEASE, "agent");
            asm volatile("s_waitcnt vmcnt(0)" ::: "memory");
            const unsigned og = xb_add(&bar[XB_TOP], 1u);
            const unsigned tg = og / nx;
            if (og + 1u == (tg + 1u) * nx) xb_add(&bar[XB_TOPGEN], 1u);
            else XB_SPIN(xb_ld(&bar[XB_TOPGEN]) == tg, bar);
            __builtin_amdgcn_fence(__ATOMIC_ACQUIRE, "agent");
            xb_add(&bar[XB_XGEN(b.x)], 1u);
            asm volatile("s_waitcnt vmcnt(0)" ::: "memory");
        } else {
            XB_SPIN(xb_ld(&bar[XB_XGEN(b.x)]) == gen, bar);
            __builtin_amdgcn_fence(__ATOMIC_ACQUIRE, "agent");
            asm volatile("s_waitcnt vmcnt(0)" ::: "memory");
        }
    }
    __syncthreads();
}

namespace pg8 {
constexpr int BM = 256, BK = 64, HALF = 128, HTB = HALF * BK * 2, STAGE_BYTES = 8 * HTB, NXCD = 8, WGM = 8;
__host__ __device__ __forceinline__ int lds_byte(int r, int c) { const int st = (r >> 4) * 2 + (c >> 5), rr = r & 15, cc = c & 31, ob = rr * 64 + cc * 2; return st * 1024 + (ob ^ (((ob >> 9) & 1) << 5)); }
__host__ __device__ __forceinline__ void stage_rc(int b, int& R, int& C) { const int st = b / 1024, sb = b % 1024, swz = sb ^ (((sb >> 9) & 1) << 5); R = (st >> 1) * 16 + swz / 64; C = (st & 1) * 32 + (swz % 64) / 2; }
__host__ __device__ __forceinline__ int perm32(int rho) { const int n = rho >> 4, i = rho & 15; return 8 * (i >> 2) + 4 * n + (i & 3); }

struct Unit { int pm, pn, e, aux; };
struct Gemm { const bf16* A; const bf16* Bt; int M, N, K; };

struct StaticOrder {
    int nM, nN, nwg, G, c;
    __device__ void init(int M, int N, int G_, int c_) { nM = M / BM; nN = N / BM; nwg = nM * nN; G = G_; c = c_; }
    __device__ bool next(int i, Unit& u) const {
        const long L = (long)i * G + c; if (L >= nwg) return false;
        int wgid = (int)L; { const int q = nwg / NXCD, r = nwg % NXCD, xcd = wgid % NXCD, off = wgid / NXCD; wgid = (xcd < r ? xcd * (q + 1) : r * (q + 1) + (xcd - r) * q) + off; }
        const int nig = WGM * nN, gid = wgid / nig, fm = gid * WGM, gsz = (nM - fm) < WGM ? (nM - fm) : WGM;
        u.pm = fm + ((wgid % nig) % gsz); u.pn = (wgid % nig) / gsz; u.e = 0; u.aux = 0; return true;
    }
    __device__ __forceinline__ unsigned b_off(const Unit& u, unsigned tstep) const { return (unsigned)u.pn * tstep; }
};
struct MoeOrder {
    const LAS int* tp; int G, c; unsigned estride;
    __device__ bool next(int i, Unit& u) const {
        const int L = i * G + c; const int ntot = tp[16] * 8; if (L >= ntot) return false;
        const int tile = L >> 3; int e = 0;
#pragma unroll
        for (int j = 1; j < 16; ++j) e += (tile >= tp[j]) ? 1 : 0;
        u.pm = tile; u.pn = L & 7; u.e = e; u.aux = i; return true;
    }
    __device__ __forceinline__ unsigned b_off(const Unit& u, unsigned tstep) const { return (unsigned)u.e * estride + (unsigned)u.pn * tstep; }
};

#define PG8_LAS __attribute__((address_space(3)))
template <class Epi, class Sched, bool ALIGN_EPI, bool GATHER>
__device__ __forceinline__ void gemm_phase(PG8_LAS unsigned char* lds, const Gemm g, const Sched& S, const Epi& E, const PG8_LAS unsigned* tabA) {
    const int tid = tid_fresh(), wid = __builtin_amdgcn_readfirstlane(tid >> 6), lane = tid & 63, wr = wid >> 2, wc = wid & 3, fr = lane & 15, fq = lane >> 4;
    const int K = g.K, nt = K / BK;
    int sR[2], sC[2];
    unsigned voffB[2];
#pragma unroll
    for (int i = 0; i < 2; ++i) { int R, C; stage_rc(tid * 16 + i * 8192, R, C); sR[i] = R; sC[i] = C; const int Rb = Epi::PERM ? ((R & ~31) + perm32(R & 31)) : R;
        voffB[i] = (unsigned)(Rb * K + C) * 2u; }
    const unsigned kstep = (unsigned)(BK * 2);
    const unsigned hstep = (unsigned)(HALF * K * 2);
    const unsigned tstep = 2u * hstep;
    const unsigned ldsw = (unsigned)wid * 1024u;
    const char* const baseA = (const char*)g.A; const char* const baseB = (const char*)g.Bt;
    const int aoff = lds_byte(wr * 64 + fr, fq * 8), boff = lds_byte(wc * 32 + fr, fq * 8);
#define PG8_SA(b, h) (((b) * 2 + (h)) * HTB)
#define PG8_SB(b, h) ((4 + (b) * 2 + (h)) * HTB)
#define PG8_STAGE(bufoff, gbase, uoff, voff) do { _Pragma("unroll") for (int _i = 0; _i < 2; ++_i) \
        __builtin_amdgcn_global_load_lds((const unsigned*)((gbase) + (size_t)(unsigned)((uoff) + (voff)[_i])), (PG8_LAS unsigned*)(lds + (bufoff) + ldsw + _i * 8192), 16, 0, 0); } while (0)
#define PG8_LDA(dst, b, h) do { _Pragma("unroll") for (int m = 0; m < 4; ++m) _Pragma("unroll") for (int k = 0; k < 2; ++k) dst[m][k] = *(const PG8_LAS bf16x8*)(lds + PG8_SA(b, h) + aoff + m * 2048 + k * 1024); } while (0)
#define PG8_LDB(dst, b, h) do { _Pragma("unroll") for (int n = 0; n < 2; ++n) _Pragma("unroll") for (int k = 0; k < 2; ++k) dst[n][k] = *(const PG8_LAS bf16x8*)(lds + PG8_SB(b, h) + boff + n * 2048 + k * 1024); } while (0)
#define PG8_MMA(ai, bj, At, Bt) do { __builtin_amdgcn_s_setprio(1); _Pragma("unroll") for (int m = 0; m < 4; ++m) _Pragma("unroll") for (int n = 0; n < 2; ++n) _Pragma("unroll") for (int k = 0; k < 2; ++k) \
        acc[ai][bj][m][n] = __builtin_amdgcn_mfma_f32_16x16x32_bf16(Bt[n][k], At[m][k], acc[ai][bj][m][n], 0, 0, 0); __builtin_amdgcn_s_setprio(0); } while (0)
#define PG8_WAIT_V(n) asm volatile("s_waitcnt vmcnt(" #n ")" ::: "memory")
#define PG8_WAIT_L(n) asm volatile("s_waitcnt lgkmcnt(" #n ")" ::: "memory")
#define PG8_BAR __builtin_amdgcn_s_barrier()
#define PG8_SCHED __builtin_amdgcn_sched_barrier(0)
    Unit cur, nxt; int ui = 0;
    if (!S.next(0, cur)) return;
    f32x4 acc[2][2][4][2];
#pragma unroll
    for (int a = 0; a < 2; ++a)
#pragma unroll
        for (int b = 0; b < 2; ++b)
#pragma unroll
            for (int m = 0; m < 4; ++m)
#pragma unroll
                for (int n = 0; n < 2; ++n) acc[a][b][m][n] = (f32x4){0.f, 0.f, 0.f, 0.f};
    bf16x8 At[4][2], B0[2][2], B1[2][2];
    unsigned vA0[2], vA1[2], nA0[2], nA1[2];
    unsigned uA, uB = S.b_off(cur, tstep);
    if constexpr (GATHER) { uA = 0u;
#pragma unroll
        for (int i = 0; i < 2; ++i) { vA0[i] = tabA[cur.aux * 256 + sR[i]] + (unsigned)sC[i] * 2u; vA1[i] = tabA[cur.aux * 256 + 128 + sR[i]] + (unsigned)sC[i] * 2u; }
    } else { uA = (unsigned)cur.pm * tstep;
#pragma unroll
        for (int i = 0; i < 2; ++i) { vA0[i] = (unsigned)(sR[i] * K + sC[i]) * 2u; vA1[i] = vA0[i] + hstep; }
    }
    PG8_STAGE(PG8_SB(0, 0), baseB, uB, voffB); PG8_STAGE(PG8_SB(0, 1), baseB, uB + hstep, voffB); PG8_STAGE(PG8_SA(0, 0), baseA, uA, vA0); PG8_STAGE(PG8_SA(0, 1), baseA, uA, vA1);
    if (wr == 1) PG8_BAR;
    PG8_WAIT_V(2); PG8_BAR;
    PG8_STAGE(PG8_SB(1, 0), baseB, uB + kstep, voffB); PG8_STAGE(PG8_SA(1, 0), baseA, uA + kstep, vA0); PG8_STAGE(PG8_SB(1, 1), baseB, uB + hstep + kstep, voffB);
    PG8_WAIT_V(6); PG8_BAR;
    for (;;) {
        const bool has_next = S.next(ui + 1, nxt);
        unsigned nuA, nuB = has_next ? S.b_off(nxt, tstep) : uB;
        if constexpr (GATHER) { nuA = 0u;
#pragma unroll
            for (int i = 0; i < 2; ++i) { if (has_next) { nA0[i] = tabA[nxt.aux * 256 + sR[i]] + (unsigned)sC[i] * 2u; nA1[i] = tabA[nxt.aux * 256 + 128 + sR[i]] + (unsigned)sC[i] * 2u; } else { nA0[i] = vA0[i]; nA1[i] = vA1[i]; } }
        } else { nuA = has_next ? (unsigned)nxt.pm * tstep : uA;
#pragma unroll
            for (int i = 0; i < 2; ++i) { nA0[i] = vA0[i]; nA1[i] = vA1[i]; }
        }
#pragma unroll 1
        for (int t = 0; t < nt; t += 2) {
            const bool last = (t == nt - 2);
            const unsigned a1 = uA + (unsigned)(t + 1) * kstep;
            const unsigned a2 = last ? nuA : uA + (unsigned)(t + 2) * kstep; const unsigned b2 = last ? nuB : uB + (unsigned)(t + 2) * kstep;
            const unsigned a3 = a2 + kstep; const unsigned b3 = b2 + kstep;
            unsigned w0[2], w1[2];
#pragma unroll
            for (int i = 0; i < 2; ++i) { w0[i] = (GATHER && last) ? nA0[i] : vA0[i]; w1[i] = (GATHER && last) ? nA1[i] : vA1[i]; }
            PG8_LDB(B0, 0, 0); PG8_LDB(B1, 0, 1); PG8_SCHED; PG8_LDA(At, 0, 0); PG8_STAGE(PG8_SA(1, 1), baseA, a1, vA1);
            PG8_WAIT_V(8); PG8_WAIT_L(0); PG8_BAR; PG8_MMA(0, 0, At, B0); PG8_MMA(0, 1, At, B1); PG8_BAR; PG8_SCHED;
            PG8_LDA(At, 0, 1); PG8_STAGE(PG8_SB(0, 0), baseB, b2, voffB); PG8_STAGE(PG8_SB(0, 1), baseB, b2 + hstep, voffB); PG8_STAGE(PG8_SA(0, 0), baseA, a2, w0);
            PG8_WAIT_V(8); PG8_WAIT_L(0); PG8_BAR; PG8_MMA(1, 0, At, B0); PG8_MMA(1, 1, At, B1); PG8_BAR; PG8_SCHED;
            PG8_LDB(B0, 1, 0); PG8_LDB(B1, 1, 1); PG8_SCHED; PG8_LDA(At, 1, 0); PG8_STAGE(PG8_SA(0, 1), baseA, a2, w1);
            PG8_WAIT_V(8); PG8_WAIT_L(0); PG8_BAR; PG8_MMA(0, 0, At, B0); PG8_MMA(0, 1, At, B1); PG8_BAR; PG8_SCHED;
            PG8_LDA(At, 1, 1); PG8_STAGE(PG8_SB(1, 0), baseB, b3, voffB); PG8_STAGE(PG8_SB(1, 1), baseB, b3 + hstep, voffB); PG8_STAGE(PG8_SA(1, 0), baseA, a3, w0);
            PG8_WAIT_V(8); PG8_WAIT_L(0); PG8_BAR; PG8_MMA(1, 0, At, B0); PG8_MMA(1, 1, At, B1); PG8_BAR; PG8_SCHED;
        }
        if constexpr (ALIGN_EPI) { if (wr == 0) PG8_BAR; }
        E(acc, cur, wr, wc, fr, fq);
        if (!has_next) break;
#pragma unroll
        for (int a = 0; a < 2; ++a)
#pragma unroll
            for (int b = 0; b < 2; ++b)
#pragma unroll
                for (int m = 0; m < 4; ++m)
#pragma unroll
                    for (int n = 0; n < 2; ++n) acc[a][b][m][n] = (f32x4){0.f, 0.f, 0.f, 0.f};
        cur = nxt; uA = nuA; uB = nuB; ++ui;
#pragma unroll
        for (int i = 0; i < 2; ++i) { vA0[i] = nA0[i]; vA1[i] = nA1[i]; }
        if constexpr (ALIGN_EPI) { if (wr == 1) PG8_BAR; }
    }
    PG8_WAIT_V(0);
    if constexpr (!ALIGN_EPI) { if (wr == 0) PG8_BAR; }
    PG8_BAR;
#undef PG8_SA
#undef PG8_SB
#undef PG8_STAGE
#undef PG8_LDA
#undef PG8_LDB
#undef PG8_MMA
#undef PG8_WAIT_V
#undef PG8_WAIT_L
#undef PG8_BAR
#undef PG8_SCHED
}

typedef int i32x8v __attribute__((ext_vector_type(8)));
typedef int i32x4v __attribute__((ext_vector_type(4)));
template <class Epi, class Sched, bool ALIGN_EPI, bool GATHER>
__device__ __forceinline__ void gemm_phase8(PG8_LAS unsigned char* lds, const Gemm g, const Sched& S, const Epi& E, const PG8_LAS unsigned* tabA) {
    const int tid = tid_fresh(), wid = __builtin_amdgcn_readfirstlane(tid >> 6), lane = tid & 63, wr = wid >> 2, wc = wid & 3, fr = lane & 15, fq = lane >> 4;
    const int K = g.K, nt = K / BK;
    int sR[2], sC[2];
    unsigned voffB[2];
#pragma unroll
    for (int i = 0; i < 2; ++i) { int R, C; stage_rc(tid * 16 + i * 8192, R, C); sR[i] = R; sC[i] = C; const int Rb = Epi::PERM ? ((R & ~31) + perm32(R & 31)) : R;
        voffB[i] = (unsigned)(Rb * K + C) * 2u; }
    const unsigned kstep = (unsigned)(BK * 2);
    const unsigned hstep = (unsigned)(HALF * K * 2);
    const unsigned tstep = 2u * hstep;
    const unsigned ldsw = (unsigned)wid * 1024u;
    const char* const baseA = (const char*)g.A; const char* const baseB = (const char*)g.Bt;
    const int kc = 32 * (fq >> 1) + 8 * (fq & 1);
    const int aoff = lds_byte(wr * 64 + fr, kc), aoff2 = lds_byte(wr * 64 + fr, kc + 16), boff = lds_byte(wc * 32 + fr, kc), boff2 = lds_byte(wc * 32 + fr, kc + 16);
#define PG8_SA(b, h) (((b) * 2 + (h)) * HTB)
#define PG8_SB(b, h) ((4 + (b) * 2 + (h)) * HTB)
#define PG8_STAGE(bufoff, gbase, uoff, voff) do { _Pragma("unroll") for (int _i = 0; _i < 2; ++_i) \
        __builtin_amdgcn_global_load_lds((const unsigned*)((gbase) + (size_t)(unsigned)((uoff) + (voff)[_i])), (PG8_LAS unsigned*)(lds + (bufoff) + ldsw + _i * 8192), 16, 0, 0); } while (0)
#define PG8_LD32(p, q) __builtin_shufflevector(*(const PG8_LAS i32x4v*)(p), *(const PG8_LAS i32x4v*)(q), 0, 1, 2, 3, 4, 5, 6, 7)
#define PG8_LDA(dst, b, h) do { _Pragma("unroll") for (int m = 0; m < 4; ++m) dst[m] = PG8_LD32(lds + PG8_SA(b, h) + aoff + m * 2048, lds + PG8_SA(b, h) + aoff2 + m * 2048); } while (0)
#define PG8_LDB(dst, b, h) do { _Pragma("unroll") for (int n = 0; n < 2; ++n) dst[n] = PG8_LD32(lds + PG8_SB(b, h) + boff + n * 2048, lds + PG8_SB(b, h) + boff2 + n * 2048); } while (0)
#define PG8_MMA(ai, bj, At, Bt) do { __builtin_amdgcn_s_setprio(1); _Pragma("unroll") for (int m = 0; m < 4; ++m) _Pragma("unroll") for (int n = 0; n < 2; ++n) \
        asm volatile("v_mfma_scale_f32_16x16x128_f8f6f4 %0, %1, %2, %0, %3, %4 op_sel_hi:[0,0,0]" : "+v"(acc[ai][bj][m][n]) : "v"(Bt[n]), "v"(At[m]), "v"(scw), "v"(sca)); __builtin_amdgcn_s_setprio(0); } while (0)
#define PG8_MFMA_DRAIN asm volatile("s_nop 15\n\ts_nop 15\n\ts_nop 15" ::: "memory")
#define PG8_WAIT_V(n) asm volatile("s_waitcnt vmcnt(" #n ")" ::: "memory")
#define PG8_WAIT_L(n) asm volatile("s_waitcnt lgkmcnt(" #n ")" ::: "memory")
#define PG8_BAR __builtin_amdgcn_s_barrier()
#define PG8_SCHED __builtin_amdgcn_sched_barrier(0)
    Unit cur, nxt; int ui = 0;
    if (!S.next(0, cur)) return;
    f32x4 acc[2][2][4][2];
#pragma unroll
    for (int a = 0; a < 2; ++a)
#pragma unroll
        for (int b = 0; b < 2; ++b)
#pragma unroll
            for (int m = 0; m < 4; ++m)
#pragma unroll
                for (int n = 0; n < 2; ++n) acc[a][b][m][n] = (f32x4){0.f, 0.f, 0.f, 0.f};
    i32x8v At[4], B0[2], B1[2];
    int scw = 0x7a7a7a7a, sca = 0x7f7f7f7f;
    asm volatile("" : "+v"(scw), "+v"(sca));
    unsigned vA0[2], vA1[2], nA0[2], nA1[2];
    unsigned uA, uB = S.b_off(cur, tstep);
    if constexpr (GATHER) { uA = 0u;
#pragma unroll
        for (int i = 0; i < 2; ++i) { vA0[i] = tabA[cur.aux * 256 + sR[i]] + (unsigned)sC[i] * 2u; vA1[i] = tabA[cur.aux * 256 + 128 + sR[i]] + (unsigned)sC[i] * 2u; }
    } else { uA = (unsigned)cur.pm * tstep;
#pragma unroll
        for (int i = 0; i < 2; ++i) { vA0[i] = (unsigned)(sR[i] * K + sC[i]) * 2u; vA1[i] = vA0[i] + hstep; }
    }
    PG8_STAGE(PG8_SB(0, 0), baseB, uB, voffB); PG8_STAGE(PG8_SB(0, 1), baseB, uB + hstep, voffB); PG8_STAGE(PG8_SA(0, 0), baseA, uA, vA0); PG8_STAGE(PG8_SA(0, 1), baseA, uA, vA1);
    if (wr == 1) PG8_BAR;
    PG8_WAIT_V(2); PG8_BAR;
    PG8_STAGE(PG8_SB(1, 0), baseB, uB + kstep, voffB); PG8_STAGE(PG8_SA(1, 0), baseA, uA + kstep, vA0); PG8_STAGE(PG8_SB(1, 1), baseB, uB + hstep + kstep, voffB);
    PG8_WAIT_V(6); PG8_BAR;
    for (;;) {
        const bool has_next = S.next(ui + 1, nxt);
        unsigned nuA, nuB = has_next ? S.b_off(nxt, tstep) : uB;
        if constexpr (GATHER) { nuA = 0u;
#pragma unroll
            for (int i = 0; i < 2; ++i) { if (has_next) { nA0[i] = tabA[nxt.aux * 256 + sR[i]] + (unsigned)sC[i] * 2u; nA1[i] = tabA[nxt.aux * 256 + 128 + sR[i]] + (unsigned)sC[i] * 2u; } else { nA0[i] = vA0[i]; nA1[i] = vA1[i]; } }
        } else { nuA = has_next ? (unsigned)nxt.pm * tstep : uA;
#pragma unroll
            for (int i = 0; i < 2; ++i) { nA0[i] = vA0[i]; nA1[i] = vA1[i]; }
        }
#pragma unroll 1
        for (int t = 0; t < nt; t += 2) {
            const bool last = (t == nt - 2);
            const unsigned a1 = uA + (unsigned)(t + 1) * kstep;
            const unsigned a2 = last ? nuA : uA + (unsigned)(t + 2) * kstep; const unsigned b2 = last ? nuB : uB + (unsigned)(t + 2) * kstep;
            const unsigned a3 = a2 + kstep; const unsigned b3 = b2 + kstep;
            unsigned w0[2], w1[2];
#pragma unroll
            for (int i = 0; i < 2; ++i) { w0[i] = (GATHER && last) ? nA0[i] : vA0[i]; w1[i] = (GATHER && last) ? nA1[i] : vA1[i]; }
            PG8_LDB(B0, 0, 0); PG8_LDB(B1, 0, 1); PG8_SCHED; PG8_LDA(At, 0, 0); PG8_STAGE(PG8_SA(1, 1), baseA, a1, vA1);
            PG8_WAIT_V(8); PG8_WAIT_L(0); PG8_BAR; PG8_MMA(0, 0, At, B0); PG8_MMA(0, 1, At, B1); PG8_BAR; PG8_SCHED;
            PG8_LDA(At, 0, 1); PG8_STAGE(PG8_SB(0, 0), baseB, b2, voffB); PG8_STAGE(PG8_SB(0, 1), baseB, b2 + hstep, voffB); PG8_STAGE(PG8_SA(0, 0), baseA, a2, w0);
            PG8_WAIT_V(8); PG8_WAIT_L(0); PG8_BAR; PG8_MMA(1, 0, At, B0); PG8_MMA(1, 1, At, B1); PG8_BAR; PG8_SCHED;
            PG8_LDB(B0, 1, 0); PG8_LDB(B1, 1, 1); PG8_SCHED; PG8_LDA(At, 1, 0); PG8_STAGE(PG8_SA(0, 1), baseA, a2, w1);
            PG8_WAIT_V(8); PG8_WAIT_L(0); PG8_BAR; PG8_MMA(0, 0, At, B0); PG8_MMA(0, 1, At, B1); PG8_BAR; PG8_SCHED;
            PG8_LDA(At, 1, 1); PG8_STAGE(PG8_SB(1, 0), baseB, b3, voffB); PG8_STAGE(PG8_SB(1, 1), baseB, b3 + hstep, voffB); PG8_STAGE(PG8_SA(1, 0), baseA, a3, w0);
            PG8_WAIT_V(8); PG8_WAIT_L(0); PG8_BAR; PG8_MMA(1, 0, At, B0); PG8_MMA(1, 1, At, B1); PG8_BAR; PG8_SCHED;
        }
        if constexpr (ALIGN_EPI) { if (wr == 0) PG8_BAR; }
        PG8_MFMA_DRAIN;
        { const int l2 = tid_fresh() & 63; E(acc, cur, wr, wc, l2 & 15, l2 >> 4); }
        if (!has_next) break;
#pragma unroll
        for (int a = 0; a < 2; ++a)
#pragma unroll
            for (int b = 0; b < 2; ++b)
#pragma unroll
                for (int m = 0; m < 4; ++m)
#pragma unroll
                    for (int n = 0; n < 2; ++n) acc[a][b][m][n] = (f32x4){0.f, 0.f, 0.f, 0.f};
        cur = nxt; uA = nuA; uB = nuB; ++ui;
#pragma unroll
        for (int i = 0; i < 2; ++i) { vA0[i] = nA0[i]; vA1[i] = nA1[i]; }
        if constexpr (ALIGN_EPI) { if (wr == 1) PG8_BAR; }
    }
    PG8_WAIT_V(0);
    if constexpr (!ALIGN_EPI) { if (wr == 0) PG8_BAR; }
    PG8_BAR;
#undef PG8_SA
#undef PG8_SB
#undef PG8_STAGE
#undef PG8_LDA
#undef PG8_LD32
#undef PG8_LDB
#undef PG8_MMA
#undef PG8_MFMA_DRAIN
#undef PG8_WAIT_V
#undef PG8_WAIT_L
#undef PG8_BAR
#undef PG8_SCHED
}

__device__ __forceinline__ unsigned cvt_pk_bf16(float lo, float hi) { return pk2(lo, hi); }

struct EpiBf16 {
    static constexpr bool PERM = true;
    bf16* O; int ldc;
    __device__ __forceinline__ void operator()(const f32x4 (&acc)[2][2][4][2], const Unit& u, int wr, int wc, int fr, int fq) const {
        const int row0 = u.pm * BM + wr * 64 + fr; const int col0 = u.pn * BM + wc * 32 + 8 * fq;
#pragma unroll
        for (int ai = 0; ai < 2; ++ai)
#pragma unroll
            for (int m = 0; m < 4; ++m) { bf16* rowp = O + (size_t)(row0 + ai * HALF + m * 16) * ldc + col0;
#pragma unroll
                for (int bj = 0; bj < 2; ++bj) { const f32x4 v0 = acc[ai][bj][m][0], v1 = acc[ai][bj][m][1];
                    u32x4 w; w.x = cvt_pk_bf16(v0[0], v0[1]); w.y = cvt_pk_bf16(v0[2], v0[3]); w.z = cvt_pk_bf16(v1[0], v1[1]); w.w = cvt_pk_bf16(v1[2], v1[3]);
                    *(u32x4*)(rowp + bj * HALF) = w; } }
    }
};
struct EpiResid {
    static constexpr bool PERM = true;
    const float* xl; const float* xc; bf16* X; const float* gate; bool f32base;
    __device__ __forceinline__ void operator()(const f32x4 (&acc)[2][2][4][2], const Unit& u, int wr, int wc, int fr, int fq) const {
        const int rt = u.pm * BM; const bool isl = rt < NLAT;
        const float* base = isl ? xl + (size_t)rt * D : xc + (size_t)(rt - NLAT) * D;
        const float* gp = gate + (size_t)(isl ? (rt >> 12) : 8) * 12288;
        const int rl0 = wr * 64 + fr, col0 = u.pn * BM + wc * 32 + 8 * fq;
#pragma unroll
        for (int ai = 0; ai < 2; ++ai)
#pragma unroll
            for (int m = 0; m < 4; ++m) { const int rl = rl0 + ai * HALF + m * 16; const float* bp = base + (size_t)rl * D + col0; bf16* op = X + (size_t)(rt + rl) * D + col0;
#pragma unroll
                for (int bj = 0; bj < 2; ++bj) { f32x4 b0, b1;
                    if (f32base) { b0 = *(const f32x4*)(bp + bj * HALF); b1 = *(const f32x4*)(bp + bj * HALF + 4); }
                    else { const u32x4 t = *(const u32x4*)(op + bj * HALF); b0 = (f32x4){bflo(t.x), bfhi(t.x), bflo(t.y), bfhi(t.y)}; b1 = (f32x4){bflo(t.z), bfhi(t.z), bflo(t.w), bfhi(t.w)}; }
                    const f32x4 g0 = *(const f32x4*)(gp + col0 + bj * HALF), g1 = *(const f32x4*)(gp + col0 + bj * HALF + 4);
                    const f32x4 r0 = b0 + g0 * acc[ai][bj][m][0], r1 = b1 + g1 * acc[ai][bj][m][1];
                    u32x4 w; w.x = cvt_pk_bf16(r0[0], r0[1]); w.y = cvt_pk_bf16(r0[2], r0[3]); w.z = cvt_pk_bf16(r1[0], r1[1]); w.w = cvt_pk_bf16(r1[2], r1[3]);
                    *(u32x4*)(op + bj * HALF) = w; }
                asm volatile("" ::: "memory"); }
    }
};
struct EpiSwiglu {
    static constexpr bool PERM = true;
    unsigned char* O;
    __device__ __forceinline__ void operator()(const f32x4 (&acc)[2][2][4][2], const Unit& u, int wr, int wc, int fr, int fq) const {
        const int row0 = u.pm * BM + wr * 64 + fr; const int col0 = u.pn * 128 + wc * 32 + 8 * fq;
#pragma unroll
        for (int ai = 0; ai < 2; ++ai)
#pragma unroll
            for (int m = 0; m < 4; ++m) { unsigned char* rowp = O + (size_t)(row0 + ai * HALF + m * 16) * DE + col0;
                float o[8];
#pragma unroll
                for (int n = 0; n < 2; ++n)
#pragma unroll
                    for (int j = 0; j < 4; ++j) { const float gt = acc[ai][0][m][n][j], up = acc[ai][1][m][n][j]; o[n * 4 + j] = gt * __builtin_amdgcn_rcpf(1.0f + __expf(-gt)) * up; }
                u32x2 w; w.x = pk4_fp8(o[0], o[1], o[2], o[3]); w.y = pk4_fp8(o[4], o[5], o[6], o[7]);
                *(u32x2*)rowp = w; }
    }
};
struct EpiDown {
    static constexpr bool PERM = true;
    unsigned char* YK; const PG8_LAS unsigned* tab; const PG8_LAS float* tabw;
    __device__ __forceinline__ void operator()(const f32x4 (&acc)[2][2][4][2], const Unit& u, int wr, int wc, int fr, int fq) const {
        const int rl0 = wr * 64 + fr; const int col0 = u.pn * BM + wc * 32 + 8 * fq;
#pragma unroll
        for (int ai = 0; ai < 2; ++ai)
#pragma unroll
            for (int m = 0; m < 4; ++m) { const int rl = rl0 + ai * HALF + m * 16; const unsigned ent = tab[u.aux * 256 + rl]; const float w = tabw[u.aux * 256 + rl];
                if (!(ent & 0x40000000u)) { unsigned char* rowp = YK + ((size_t)(ent >> 31) * MALL + (ent & 0xffffu)) * D + col0;
#pragma unroll
                    for (int bj = 0; bj < 2; ++bj) { const f32x4 v0 = acc[ai][bj][m][0] * w, v1 = acc[ai][bj][m][1] * w;
                        u32x2 q; q.x = pk4_fp8(v0[0], v0[1], v0[2], v0[3]); q.y = pk4_fp8(v1[0], v1[1], v1[2], v1[3]);
                        *(u32x2*)(rowp + bj * HALF) = q; } }
                asm volatile("" ::: "memory"); }
    }
};
}

struct Args { const float* in[31]; float* out; unsigned char* ws; int ph_lo, ph_hi; };
typedef const __attribute__((address_space(4))) Args* KArgs;
__device__ __forceinline__ KArgs kargs() { KArgs p = (KArgs)__builtin_amdgcn_kernarg_segment_ptr(); asm volatile("" : "+s"(p)); return p; }
#define AIN(i) (a->in[i])
enum { I_X = 0, I_C, I_CTX, I_CCTX, I_ADAW, I_ADAB, I_N1G, I_N2G, I_WIN, I_WOUT, I_GNG, I_GWS, I_GB, I_LB, I_HNG, I_MU, I_W0, I_WUP, I_A0, I_AUP, I_GUP, I_KK, I_KA, I_RK, I_GNGG, I_GNB, I_RW, I_RB, I_WGU, I_WDN, I_FNG };

__device__ __forceinline__ void p0_transpose_item(const float* W, int K, int N, bf16* WT, int n_row0, LAS float* scr, int kb, int nb, int lane) {
    const int k0 = 64 * kb, n0 = 32 * nb;
#pragma unroll 8
    for (int i = 0; i < 32; ++i) { const int kk = 2 * i + (lane >> 5); scr[kk * 33 + (lane & 31)] = W[(size_t)(k0 + kk) * N + n0 + (lane & 31)]; }
    asm volatile("s_waitcnt lgkmcnt(0)" ::: "memory");
    const int c = lane & 7;
#pragma unroll
    for (int j = 0; j < 4; ++j) { const int n = (lane >> 3) + 8 * j; const LAS float* s = scr + (8 * c) * 33 + n;
        u32x4 o; o.x = pk2(s[0 * 33], s[1 * 33]); o.y = pk2(s[2 * 33], s[3 * 33]); o.z = pk2(s[4 * 33], s[5 * 33]); o.w = pk2(s[6 * 33], s[7 * 33]);
        *(u32x4*)(WT + (size_t)(n_row0 + n) * K + k0 + 8 * c) = o; }
    asm volatile("s_waitcnt lgkmcnt(0)" ::: "memory");
}

__device__ __forceinline__ void p0_transpose_item8(const float* W, int K, int N, unsigned char* WT, int n_row0, LAS float* scr, int kb, int nb, int lane) {
    const int k0 = 64 * kb, n0 = 32 * nb;
    { const int c4 = (lane & 7) * 4;
      f32x4 t[8];
#pragma unroll
      for (int i = 0; i < 8; ++i) t[i] = *(const f32x4*)(W + (size_t)(k0 + 8 * i + (lane >> 3)) * N + n0 + c4);
#pragma unroll
      for (int i = 0; i < 8; ++i) { LAS float* d = scr + (8 * i + (lane >> 3)) * 33 + c4; d[0] = t[i][0]; d[1] = t[i][1]; d[2] = t[i][2]; d[3] = t[i][3]; } }
    asm volatile("s_waitcnt lgkmcnt(0)" ::: "memory");
    const int c = lane & 7;
#pragma unroll
    for (int j = 0; j < 4; ++j) { const int n = (lane >> 3) + 8 * j; const LAS float* sp = scr + (8 * c) * 33 + n;
        u32x2 o; o.x = pk4_fp8(sp[0 * 33] * 32.f, sp[1 * 33] * 32.f, sp[2 * 33] * 32.f, sp[3 * 33] * 32.f); o.y = pk4_fp8(sp[4 * 33] * 32.f, sp[5 * 33] * 32.f, sp[6 * 33] * 32.f, sp[7 * 33] * 32.f);
        *(u32x2*)(WT + (size_t)(n_row0 + n) * K + k0 + 8 * c) = o; }
    asm volatile("s_waitcnt lgkmcnt(0)" ::: "memory");
}
__device__ __forceinline__ void convert_moe(KArgs a, int l, LAS unsigned char* lds) {
    const int tid = tid_fresh(), lane = tid & 63, wave = tid >> 6;
    const int gw = blockIdx.x * 8 + wave, NGW = gridDim.x * 8;
    unsigned char* ws = a->ws;
    LAS float* scr = (LAS float*)(lds + wave * 16384);
    constexpr int I_GU = 32 * 64, I_DN = 16 * 64, N2 = 16 * I_GU, N3 = N2 + 16 * I_DN;
    for (int it = gw; it < N3; it += NGW) {
        if (it < N2) { const int e = it / I_GU, r = it % I_GU, kb = r / 64, nb = r % 64;
            const int n0 = 32 * nb, hh = n0 >> 10, nn = n0 & 1023, row0 = 256 * (nn >> 7) + 128 * hh + (nn & 127);
            p0_transpose_item8(a->in[I_WGU] + (size_t)(l * NE + e) * D * 2048, D, 2048, ws + WS_WGU + (size_t)e * 2048 * D, row0, scr, kb, nb, lane); }
        else { const int q = it - N2, e = q / I_DN, r = q % I_DN, kb = r / 64, nb = r % 64;
            p0_transpose_item8(a->in[I_WDN] + (size_t)(l * NE + e) * DE * D, DE, D, ws + WS_WDN + (size_t)e * D * DE, 32 * nb, scr, kb, nb, lane); }
    }
}
__device__ __forceinline__ void phase_prologue(KArgs a, LAS unsigned char* lds) {
    const int tid = tid_fresh(), lane = tid & 63, wave = tid >> 6;
    const int G = gridDim.x, gw = blockIdx.x * 8 + wave, NGW = G * 8;
    unsigned char* ws = a->ws;
    LAS float* scr = (LAS float*)(lds + wave * 16384);
    constexpr int I_IN = 32 * 232, I_OUT = 32 * 64;
    constexpr int N0 = 2 * I_IN, N1 = N0 + 2 * I_OUT;
    for (int it = gw; it < N1; it += NGW) {
        if (it < N0) { const int l = it / I_IN, r = it % I_IN, kb = r / 232, nb = r % 232;
            p0_transpose_item8(a->in[I_WIN] + (size_t)l * D * INC, D, INC, ws + WS_WIN + (size_t)l * INC * D, 32 * nb, scr, kb, nb, lane); }
        else { const int q = it - N0, l = q / I_OUT, r = q % I_OUT, kb = r / 64, nb = r % 64;
            p0_transpose_item8(a->in[I_WOUT] + (size_t)l * D * D, D, D, ws + WS_WOUT + (size_t)l * D * D, 32 * nb, scr, kb, nb, lane); }
    }
    convert_moe(a, 0, lds);
    {
        const int gt = blockIdx.x * NTHREADS + tid, NGT = G * NTHREADS;
        bf16* wup = (bf16*)(ws + WS_SMALLW + SW_WUP); bf16* aup = (bf16*)(ws + WS_SMALLW + SW_AUP); bf16* gup = (bf16*)(ws + WS_SMALLW + SW_GUP); bf16* gws = (bf16*)(ws + WS_SMALLW + SW_GWS);
        for (int i = gt; i < 2 * 2 * 768 * 64; i += NGT) { const int k = i & 63, n = (i >> 6) % 768, ld = i / (768 * 64); wup[i] = (bf16)f2bf(a->in[I_WUP][((size_t)ld * 64 + k) * 768 + n]); }
        for (int i = gt; i < 2 * 768 * 64; i += NGT) { const int k = i & 63, n = (i >> 6) % 768, l = i / (768 * 64); aup[i] = (bf16)f2bf(a->in[I_AUP][((size_t)l * 64 + k) * 768 + n]); }
        for (int i = gt; i < 2 * 768 * 128; i += NGT) { const int k = i & 127, n = (i >> 7) % 768, l = i / (768 * 128); gup[i] = (bf16)f2bf(a->in[I_GUP][((size_t)l * 128 + k) * 768 + n]); }
        for (int i = gt; i < 2 * 4 * 128 * 128; i += NGT) gws[i] = (bf16)f2bf(a->in[I_GWS][i]);
    }
    __syncthreads();
    {
        LAS float* sv = (LAS float*)lds;
        LAS float* red = (LAS float*)(lds + 73728);
        for (int i = tid; i < 9 * D; i += NTHREADS) { const int r = i / D, k = i % D; const float v = r < 8 ? a->in[I_C][r * D + k] : a->in[I_CCTX][k]; sv[i] = siluf_(v); }
        __syncthreads();
        float* mod = (float*)(ws + WS_MOD);
        for (int it = blockIdx.x; it < 2 * 96; it += G) {
            const int l = it / 96, cb = it % 96, cq = tid & 31, kg = tid >> 5;
            const float* wp = a->in[I_ADAW] + (size_t)l * D * 12288 + (size_t)(kg * 128) * 12288 + cb * 128 + cq * 4;
            f32x4 acc[9];
#pragma unroll
            for (int r = 0; r < 9; ++r) acc[r] = (f32x4){0.f, 0.f, 0.f, 0.f};
#pragma unroll 4
            for (int k = 0; k < 128; ++k) { const f32x4 w = *(const f32x4*)(wp + (size_t)k * 12288);
#pragma unroll
                for (int r = 0; r < 9; ++r) acc[r] += w * sv[r * D + kg * 128 + k]; }
#pragma unroll
            for (int r = 0; r < 9; ++r) *(LAS f32x4*)(red + ((kg * 9 + r) * 128 + cq * 4)) = acc[r];
            __syncthreads();
            for (int o = tid; o < 9 * 128; o += NTHREADS) { const int r = o / 128, c = o % 128; float s = a->in[I_ADAB][(size_t)l * 12288 + cb * 128 + c];
#pragma unroll
                for (int q = 0; q < 16; ++q) s += red[(q * 9 + r) * 128 + c];
                mod[((size_t)l * 9 + r) * 12288 + cb * 128 + c] = s; }
            __syncthreads();
        }
    }
}

template <int MODE>
__device__ __forceinline__ void phase_norm1(KArgs a, int l, bool dry) {
    const int tid_ = tid_fresh(); const int lane = tid_ & 63, wave = tid_ >> 6, gw = blockIdx.x * 8 + wave, NGW = gridDim.x * 8;
    unsigned char* ws = a->ws;
    const float* mod = (const float*)(ws + WS_MOD);
    bf16* X = (bf16*)(ws + WS_X); bf16* H = (bf16*)(ws + WS_H); const bf16* YK = (const bf16*)(ws + WS_YK);
    bf16* Xo = dry ? (bf16*)(ws + WS_END) : X; bf16* Ho = dry ? (bf16*)(ws + WS_END) : H; float* Oo = dry ? (float*)(ws + WS_END) : a->out;
    const int nrows = (MODE == 2) ? NLAT : MALL;
    const int rpw = (nrows + NGW - 1) / NGW; const int r0 = gw * rpw, r1 = (r0 + rpw < nrows) ? r0 + rpw : nrows;
    f32x4 ck[8], cs[8], cg[8]; int cur_mr = -1;
    for (int row = r0; row < r1; ++row) {
        const int mr = modrow_of(row); const int orow = dry ? (row & 2047) : row;
        if (mr != cur_mr) { cur_mr = mr;
#pragma unroll
            for (int j = 0; j < 8; ++j) { const int c = 4 * lane + 256 * j;
                if (MODE == 2) ck[j] = *(const f32x4*)(a->in[I_FNG] + c);
                else { const float* m = mod + ((size_t)l * 9 + mr) * 12288; const f32x4 g = *(const f32x4*)(a->in[I_N1G] + (size_t)l * D + c); ck[j] = g * (*(const f32x4*)(m + D + c) + 1.0f); cs[j] = *(const f32x4*)(m + c); }
                if (MODE != 0) cg[j] = *(const f32x4*)(mod + ((size_t)(l - 1) * 9 + mr) * 12288 + 5 * D + c); } }
        f32x4 v[8];
        if (MODE == 0) { const float* xr = row < NLAT ? a->in[I_X] + (size_t)row * D : a->in[I_CTX] + (size_t)(row - NLAT) * D;
#pragma unroll
            for (int j = 0; j < 8; ++j) v[j] = *(const f32x4*)(xr + 4 * lane + 256 * j);
        } else {
            const bf16* xr = X + (size_t)row * D; const unsigned char* y0 = (const unsigned char*)YK + (size_t)row * D; const unsigned char* y1 = (const unsigned char*)YK + ((size_t)MALL + row) * D;
            unsigned p0[8], p1[8];
#pragma unroll
            for (int j = 0; j < 8; ++j) { const int c = 4 * lane + 256 * j; const u32x2 t = *(const u32x2*)(xr + c); v[j] = (f32x4){bflo(t.x), bfhi(t.x), bflo(t.y), bfhi(t.y)}; p0[j] = *(const unsigned*)(y0 + c); p1[j] = *(const unsigned*)(y1 + c); }
#pragma unroll
            for (int j = 0; j < 8; ++j) { const f32x2 a0 = __builtin_amdgcn_cvt_pk_f32_fp8((int)p0[j], false), a1 = __builtin_amdgcn_cvt_pk_f32_fp8((int)p0[j], true), b0 = __builtin_amdgcn_cvt_pk_f32_fp8((int)p1[j], false), b1 = __builtin_amdgcn_cvt_pk_f32_fp8((int)p1[j], true);
                f32x4 f; f[0] = a0[0] + b0[0]; f[1] = a0[1] + b0[1]; f[2] = a1[0] + b1[0]; f[3] = a1[1] + b1[1];
                v[j] = v[j] + cg[j] * f; }
            if (MODE == 1) {
#pragma unroll
                for (int j = 0; j < 8; ++j) { u32x2 t; t.x = pk2(v[j][0], v[j][1]); t.y = pk2(v[j][2], v[j][3]); *(u32x2*)(Xo + (size_t)orow * D + 4 * lane + 256 * j) = t; }
            }
        }
        float ss = 0.f;
#pragma unroll
        for (int j = 0; j < 8; ++j) ss += (v[j][0] * v[j][0] + v[j][1] * v[j][1]) + (v[j][2] * v[j][2] + v[j][3] * v[j][3]);
        const float rstd = 1.0f / sqrtf(wave_sum(ss) * (1.0f / D) + NORM_EPS);
        if (MODE == 2) {
#pragma unroll
            for (int j = 0; j < 8; ++j) *(f32x4*)(Oo + (size_t)orow * D + 4 * lane + 256 * j) = v[j] * rstd * ck[j];
        } else {
#pragma unroll
            for (int j = 0; j < 8; ++j) { const f32x4 h = v[j] * rstd * ck[j] + cs[j]; *(unsigned*)((unsigned char*)Ho + (size_t)orow * D + 4 * lane + 256 * j) = pk4_fp8(h[0], h[1], h[2], h[3]); }
        }
    }
}

__device__ __forceinline__ void phase_norm2_router(KArgs a, int l, bool dry, LAS unsigned char* lds) {
    const int tid_ = tid_fresh(); const int lane = tid_ & 63, wave = tid_ >> 6, gw = blockIdx.x * 8 + wave, NGW = gridDim.x * 8;
    unsigned char* ws = a->ws;
    const float* mod = (const float*)(ws + WS_MOD);
    const bf16* X = (const bf16*)(ws + WS_X); bf16* H = (bf16*)(ws + WS_H);
    unsigned* cnt = (unsigned*)(ws + WS_CTL) + CW_CNT + l * 16 * 64 + (dry ? 4096 : 0);
    unsigned* ridx = (unsigned*)(ws + (dry ? WS_END : WS_RIDX)); float* rwt = (float*)(ws + (dry ? WS_END + 4 * MiB : WS_RW)); bf16* Ho = dry ? (bf16*)(ws + WS_END + 8 * MiB) : H;
    const int nrows = (l == DEPTH - 1) ? NLAT : MALL;
    LAS f32x4* rwl = (LAS f32x4*)lds;
    { const float* rw = a->in[I_RW];
      for (int idx = tid_; idx < 8192; idx += NTHREADS) { const int ln = idx & 63, q = (idx >> 6) & 3, i = (idx >> 8) & 3, j = idx >> 10; rwl[idx] = *(const f32x4*)(rw + (size_t)(4 * ln + 256 * j + i) * 16 + 4 * q); } }
    __syncthreads();
    const int rpw = (nrows + NGW - 1) / NGW; const int r0 = gw * rpw, r1 = (r0 + rpw < nrows) ? r0 + rpw : nrows;
    f32x4 ck[8]; int cur_mr = -1;
    const float* rbp = a->in[I_RB];
    for (int row = r0; row < r1; ++row) {
        const int mr = modrow_of(row); const int orow = dry ? (row & 2047) : row;
        if (mr != cur_mr) { cur_mr = mr; const float* m = mod + ((size_t)l * 9 + mr) * 12288;
#pragma unroll
            for (int j = 0; j < 8; ++j) { const int c = 4 * lane + 256 * j; const f32x4 g = *(const f32x4*)(a->in[I_N2G] + (size_t)l * D + c); ck[j] = g * (*(const f32x4*)(m + 4 * D + c) + 1.0f); } }
        const float* shp = mod + ((size_t)l * 9 + mr) * 12288 + 3 * D;
        const bf16* xr = X + (size_t)row * D;
        f32x4 v[8]; float ss = 0.f;
#pragma unroll
        for (int j = 0; j < 8; ++j) { const u32x2 t = *(const u32x2*)(xr + 4 * lane + 256 * j); v[j] = (f32x4){bflo(t.x), bfhi(t.x), bflo(t.y), bfhi(t.y)}; ss += (v[j][0] * v[j][0] + v[j][1] * v[j][1]) + (v[j][2] * v[j][2] + v[j][3] * v[j][3]); }
        const float rstd = 1.0f / sqrtf(wave_sum(ss) * (1.0f / D) + NORM_EPS);
        f32x4 lg4[4];
#pragma unroll
        for (int q = 0; q < 4; ++q) lg4[q] = (f32x4){0.f, 0.f, 0.f, 0.f};
#pragma unroll
        for (int j = 0; j < 8; ++j) { const f32x4 h = v[j] * rstd * ck[j] + *(const f32x4*)(shp + 4 * lane + 256 * j); *(unsigned*)((unsigned char*)Ho + (size_t)orow * D + 4 * lane + 256 * j) = pk4_fp8(h[0], h[1], h[2], h[3]);
#pragma unroll
            for (int i = 0; i < 4; ++i)
#pragma unroll
                for (int q = 0; q < 4; ++q) lg4[q] += rwl[((j * 4 + i) * 4 + q) * 64 + lane] * h[i];
            asm volatile("" ::: "memory"); }
        float lg[16];
        { float t8[8], t4[4], t2[2], t1;
          const bool b5 = lane & 32, b4 = lane & 16, b3 = lane & 8, b2 = lane & 4;
#pragma unroll
          for (int i = 0; i < 8; ++i) { const float keep = b5 ? lg4[(i + 8) >> 2][(i + 8) & 3] : lg4[i >> 2][i & 3], send = b5 ? lg4[i >> 2][i & 3] : lg4[(i + 8) >> 2][(i + 8) & 3]; t8[i] = keep + __shfl_xor(send, 32); }
#pragma unroll
          for (int i = 0; i < 4; ++i) { const float keep = b4 ? t8[i + 4] : t8[i], send = b4 ? t8[i] : t8[i + 4]; t4[i] = keep + __shfl_xor(send, 16); }
#pragma unroll
          for (int i = 0; i < 2; ++i) { const float keep = b3 ? t4[i + 2] : t4[i], send = b3 ? t4[i] : t4[i + 2]; t2[i] = keep + __shfl_xor(send, 8); }
          { const float keep = b2 ? t2[1] : t2[0], send = b2 ? t2[0] : t2[1]; t1 = keep + __shfl_xor(send, 4); }
          t1 += __shfl_xor(t1, 2); t1 += __shfl_xor(t1, 1);
#pragma unroll
          for (int e = 0; e < 16; ++e) { const int src = ((e >> 3) & 1) * 32 + ((e >> 2) & 1) * 16 + ((e >> 1) & 1) * 8 + (e & 1) * 4; lg[e] = __builtin_bit_cast(float, __builtin_amdgcn_readlane(__builtin_bit_cast(int, t1), src)) + rbp[e]; } }
        float mx = lg[0];
#pragma unroll
        for (int e = 1; e < 16; ++e) mx = fmaxf(mx, lg[e]);
        float p[16], sum = 0.f;
#pragma unroll
        for (int e = 0; e < 16; ++e) { p[e] = __expf(lg[e] - mx); sum += p[e]; }
        const float inv = 1.0f / sum;
#pragma unroll
        for (int e = 0; e < 16; ++e) p[e] *= inv;
        int sel = 0; float best = -1.f;
#pragma unroll
        for (int gI = 0; gI < 4; ++gI) { float m1 = -1.f, m2 = -1.f;
#pragma unroll
            for (int i = 0; i < 4; ++i) { const float q = p[4 * gI + i]; if (q > m1) { m2 = m1; m1 = q; } else if (q > m2) m2 = q; }
            const float s = m1 + m2; if (s > best) { best = s; sel = gI; } }
        int i1 = 0, i2 = 0; float p1 = -2.f, p2 = -2.f;
#pragma unroll
        for (int gI = 0; gI < 4; ++gI)
#pragma unroll
            for (int i = 0; i < 4; ++i) { const float q = (gI == sel) ? p[4 * gI + i] : -1.0f; const int e = 4 * gI + i;
                if (gI == sel) { if (q > p1) { p2 = p1; i2 = i1; p1 = q; i1 = e; } else if (q > p2) { p2 = q; i2 = e; } } }
        const float wsum = p1 + p2, w1 = p1 / wsum, w2 = p2 / wsum;
        if (lane == 0) {
            const unsigned q1 = atomicAdd(cnt + i1 * 64, 1u); ridx[(size_t)i1 * MALL + q1] = (unsigned)row; rwt[(size_t)i1 * MALL + q1] = w1;
            const unsigned q2 = atomicAdd(cnt + i2 * 64, 1u); ridx[(size_t)i2 * MALL + q2] = (unsigned)row | 0x80000000u; rwt[(size_t)i2 * MALL + q2] = w2;
        }
    }
    __syncthreads();
}

template <bool FOR_DOWN>
__device__ __forceinline__ void moe_tables(KArgs a, int l, LAS unsigned char* lds, int cvirt) {
    const int tid = tid_fresh(), G = gridDim.x;
    unsigned char* ws = a->ws;
    const unsigned* cnt = (const unsigned*)(ws + WS_CTL) + CW_CNT + l * 16 * 64;
    const unsigned* ridx = (const unsigned*)(ws + WS_RIDX); const float* rwt = (const float*)(ws + WS_RW);
    LAS int* tp = (LAS int*)(lds + LDS_TP); LAS unsigned* tab = (LAS unsigned*)(lds + LDS_TAB); LAS float* tabw = (LAS float*)(lds + LDS_TABW);
    if (tid == 0) { int acc = 0; for (int e = 0; e < 16; ++e) { tp[e] = acc; acc += (int)((cnt[e * 64] + 255u) >> 8); } tp[16] = acc; }
    __syncthreads();
    const int ntot = tp[16] * 8;
    for (int i = 0; i < 9; ++i) { const int L = i * G + cvirt; if (L >= ntot) break;
        const int tile = L >> 3; int e = 0;
        for (int j = 1; j < 16; ++j) e += (tile >= tp[j]) ? 1 : 0;
        const int pos0 = (tile - tp[e]) * 256; const unsigned ce = cnt[e * 64];
        if (tid < 256) { const int pos = pos0 + tid; const bool valid = (unsigned)pos < ce; const unsigned ent = ridx[(size_t)e * MALL + (valid ? pos : 0)];
            if (FOR_DOWN) { tab[i * 256 + tid] = valid ? ent : (ent | 0x40000000u); tabw[i * 256 + tid] = valid ? rwt[(size_t)e * MALL + pos] : 0.f; }
            else tab[i * 256 + tid] = (ent & 0xffffu) * (unsigned)D; }
    }
    __syncthreads();
}

#define LDS_BAR() do { asm volatile("s_waitcnt lgkmcnt(0)" ::: "memory"); __builtin_amdgcn_s_barrier(); asm volatile("" ::: "memory"); } while (0)
__device__ __forceinline__ void gmlp_item(KArgs a, int l, int item, LAS unsigned char* lds) {
    const int tid = tid_fresh(), lane = tid & 63, wave = tid >> 6;
    unsigned char* ws = a->ws;
    const bf16* P = (const bf16*)(ws + WS_P); bf16* Y = (bf16*)(ws + WS_Y);
    const int chunk = item >> 2, h = item & 3;
    const int row0 = chunk < 256 ? chunk * 128 : NLAT + (chunk - 256) * 128;
    LAS bf16* wsl = (LAS bf16*)lds;
    LAS bf16* vT = (LAS bf16*)(lds + 128 * 136 * 2);
    const bf16* gws = (const bf16*)(ws + WS_SMALLW + SW_GWS) + ((size_t)l * 4 + h) * 128 * 128;
    for (int p = tid; p < 2048; p += NTHREADS) { const int t = p >> 4, c8 = p & 15; *(LAS u32x4*)(wsl + t * 136 + c8 * 8) = *(const u32x4*)(gws + t * 128 + c8 * 8); }
    {
        const int s = tid >> 2, qd = tid & 3; const bf16* vp = P + (size_t)(row0 + s) * INC + OFF_V + h * 128 + qd * 32;
        float g[32]; float ss = 0.f;
#pragma unroll
        for (int q = 0; q < 4; ++q) { float f[8]; unpack8(*(const u32x4*)(vp + 8 * q), f);
#pragma unroll
            for (int j = 0; j < 8; ++j) { const float x = geluf_(f[j]); g[8 * q + j] = x; ss += x * x; } }
        ss += __shfl_xor(ss, 1); ss += __shfl_xor(ss, 2);
        const float rstd = 1.0f / sqrtf(ss * (1.0f / 128.0f) + NORM_EPS);
        const float* ng = a->in[I_GNG] + (size_t)l * 512 + h * 128 + qd * 32;
#pragma unroll
        for (int j = 0; j < 32; ++j) vT[(qd * 32 + j) * 136 + s] = (bf16)f2bf(g[j] * rstd * ng[j]);
    }
    LDS_BAR();
    f32x4 acc[8];
#pragma unroll
    for (int ct = 0; ct < 8; ++ct) acc[ct] = (f32x4){0.f, 0.f, 0.f, 0.f};
    const int fr = lane & 15, fq = lane >> 4;
#pragma unroll
    for (int ks = 0; ks < 4; ++ks) {
        const bf16x8 bfrag = *(const LAS bf16x8*)(wsl + (16 * wave + fr) * 136 + ks * 32 + fq * 8);
#pragma unroll
        for (int ct = 0; ct < 8; ++ct) { const bf16x8 afrag = *(const LAS bf16x8*)(vT + (16 * ct + fr) * 136 + ks * 32 + fq * 8);
            acc[ct] = __builtin_amdgcn_mfma_f32_16x16x32_bf16(afrag, bfrag, acc[ct], 0, 0, 0); }
    }
    const int t = 16 * wave + fr; const float wb = a->in[I_GB][((size_t)l * 4 + h) * 128 + t];
    const bf16* up = P + (size_t)(row0 + t) * INC + OFF_U + h * 128; unsigned char* yp = a->ws + WS_Y8 + (size_t)(row0 + t) * D + h * 128;
#pragma unroll
    for (int ct = 0; ct < 8; ++ct) { const int c = 16 * ct + 4 * fq; const u32x2 uu = *(const u32x2*)(up + c);
        const float y0 = geluf_(bflo(uu.x)) * (acc[ct][0] + wb), y1 = geluf_(bfhi(uu.x)) * (acc[ct][1] + wb), y2 = geluf_(bflo(uu.y)) * (acc[ct][2] + wb), y3 = geluf_(bfhi(uu.y)) * (acc[ct][3] + wb);
        *(unsigned*)(yp + c) = pk4_fp8(y0, y1, y2, y3); }
    LDS_BAR();
}

constexpr int SP_ = 72;
__device__ __forceinline__ int kperm_pos(int k) { const int s5 = k & 31; return (k & 32) + 8 * ((s5 >> 2) & 3) + 4 * (s5 >> 4) + (s5 & 3); }
#ifndef RWP_SKIP
#define RWP_SKIP 0
#endif
__device__ __forceinline__ void rwkv_prep_item(KArgs a, int l, int tile, int hgrp, LAS unsigned char* lds, int skip = 0) {
    const int tid = tid_fresh(), lane = tid & 63, wave = tid >> 6;
    unsigned char* ws = a->ws;
    const bf16* P = (const bf16*)(ws + WS_P); bf16* Y = (bf16*)(ws + WS_Y);
    LAS bf16* SR = (LAS bf16*)lds; LAS bf16* SK = SR + 64 * SP_; LAS bf16* SV = SK + 64 * SP_; LAS bf16* SKK = SV + 64 * SP_; LAS bf16* SB = SKK + 64 * SP_; LAS bf16* SWF = SB + 64 * SP_; LAS bf16* SWB = SWF + 64 * SP_;
    LAS bf16* tw = SWB + 64 * SP_;
    LAS bf16* adl = tw + 64 * SP_;
    LAS bf16* sg = adl + 64 * SP_;
    LAS float* invn = (LAS float*)(sg + 64 * 136);
    LAS unsigned char* wpriv = (LAS unsigned char*)(invn + 64) + wave * 6144;
    const int row0 = tile * 64; const bool isl = row0 < NLAT;
    const float* mu = a->in[I_MU] + (size_t)l * CCOLS;
    const char* Pb = (const char*)P;
    auto shift_group = [&](int tk, int col, float (&z)[8]) {
        const int row = row0 + tk; int o0, o1, o2, o3; bool v0, v1, v2, v3;
        if (isl) { const int gr = (row >> 6) & 63; o0 = -1; o1 = 1; o2 = -64; o3 = 64; v0 = tk > 0; v1 = tk < 63; v2 = gr > 0; v3 = gr < 63; }
        else { const int tc = (row - NLAT) & 255; o0 = -1; o1 = 1; o2 = -1; o3 = 1; v0 = tc > 0; v1 = tc < 255; v2 = v0; v3 = v1; }
        const unsigned off = (unsigned)row * (unsigned)(INC * 2) + (unsigned)(OFF_C + col) * 2u;
        const u32x4 uo = *(const u32x4*)(Pb + off), u0 = *(const u32x4*)(Pb + (off + (unsigned)((v0 ? o0 : 0) * INC * 2))), u1 = *(const u32x4*)(Pb + (off + (unsigned)((v1 ? o1 : 0) * INC * 2))),
                    u2 = *(const u32x4*)(Pb + (off + (unsigned)((v2 ? o2 : 0) * INC * 2))), u3 = *(const u32x4*)(Pb + (off + (unsigned)((v3 ? o3 : 0) * INC * 2)));
        const f32x4 m0 = *(const f32x4*)(mu + col), m1 = *(const f32x4*)(mu + col + 4);
        float own[8], n0[8], n1[8], n2[8], n3[8]; unpack8(uo, own); unpack8(u0, n0); unpack8(u1, n1); unpack8(u2, n2); unpack8(u3, n3);
        const float f0 = v0 ? 1.f : 0.f, f1 = v1 ? 1.f : 0.f, f2 = v2 ? 1.f : 0.f, f3 = v3 ? 1.f : 0.f;
        const float nb[8] = {n0[0] * f0, n1[1] * f1, n2[2] * f2, n3[3] * f3, n0[4] * f0, n1[5] * f1, n2[6] * f2, n3[7] * f3};
#pragma unroll
        for (int j = 0; j < 8; ++j) { const float mm = j < 4 ? m0[j] : m1[j - 4]; z[j] = own[j] + mm * (nb[j] - own[j]); }
    };
#pragma unroll
    for (int it = 0; it < 4; ++it) { const int g = tid + NTHREADS * it, tk = g >> 5, gi = g & 31;
        float z[8]; shift_group(tk, 2304 + gi * 8, z);
        if (gi < 8) { float t8[8];
#pragma unroll
            for (int j = 0; j < 8; ++j) t8[j] = 1.0f - 2.0f * __builtin_amdgcn_rcpf(1.0f + __expf(2.0f * z[j]));
            *(LAS u32x4*)(tw + tk * SP_ + gi * 8) = pack8(t8); }
        else if (gi < 16) *(LAS u32x4*)(adl + tk * SP_ + (gi - 8) * 8) = pack8(z);
        else { float t8[8];
#pragma unroll
            for (int j = 0; j < 8; ++j) t8[j] = sigmoidf_(z[j]);
            *(LAS u32x4*)(sg + tk * 136 + (gi - 16) * 8) = pack8(t8); } }
    LDS_BAR();
#pragma unroll 1
    for (int hh = 0; hh < 4; ++hh) {
    const int tid = tid_fresh(), lane = tid & 63, wave = tid >> 6;
    const int head = 4 * hgrp + hh; const float* kkw = a->in[I_KK] + (size_t)l * CW + head * 64;
    const int nloc = 16 * (wave & 3) + 4 * (lane >> 4);
    bf16x8 wfa[2], wfw0[2], wfw1[2], wfg[4]; f32x4 a0v, kav, kkv, w0a, w0b, rk0, rk1;
    { const int wrow = head * 64 + 16 * (wave & 3) + (lane & 15), ko = (lane >> 4) * 8;
      const bf16* wupT = (const bf16*)(ws + WS_SMALLW + SW_WUP) + (size_t)l * 2 * 768 * 64;
      const bf16* aupT = (const bf16*)(ws + WS_SMALLW + SW_AUP) + (size_t)l * 768 * 64;
      const bf16* gupT = (const bf16*)(ws + WS_SMALLW + SW_GUP) + (size_t)l * 768 * 128;
#pragma unroll
      for (int ks = 0; ks < 2; ++ks) { wfa[ks] = *(const bf16x8*)(aupT + (size_t)wrow * 64 + ks * 32 + ko); wfw0[ks] = *(const bf16x8*)(wupT + (size_t)wrow * 64 + ks * 32 + ko); wfw1[ks] = *(const bf16x8*)(wupT + 768 * 64 + (size_t)wrow * 64 + ks * 32 + ko); }
#pragma unroll
      for (int ks = 0; ks < 4; ++ks) wfg[ks] = *(const bf16x8*)(gupT + (size_t)wrow * 128 + ks * 32 + ko);
      const size_t hc = (size_t)l * CW + head * 64 + nloc;
      a0v = *(const f32x4*)(a->in[I_A0] + hc); kav = *(const f32x4*)(a->in[I_KA] + hc); kkv = *(const f32x4*)(kkw + nloc);
      w0a = *(const f32x4*)(a->in[I_W0] + (size_t)l * 2 * CW + head * 64 + nloc); w0b = *(const f32x4*)(a->in[I_W0] + (size_t)l * 2 * CW + CW + head * 64 + nloc);
      const float* rkp = a->in[I_RK] + (size_t)l * CW + head * 64 + (tid & 7) * 8; rk0 = *(const f32x4*)rkp; rk1 = *(const f32x4*)(rkp + 4); }
#pragma unroll
    for (int it = 0; it < 3; ++it) { const int g = tid + NTHREADS * it, tk = g / 24, gi = g % 24, c8 = (gi & 7) * 8;
        float z[8]; shift_group(tk, (gi >> 3) * 768 + head * 64 + c8, z);
        if (gi < 8) *(LAS u32x4*)(SR + tk * SP_ + c8) = pack8(z);
        else if (gi < 16) { *(LAS u32x4*)(SK + tk * SP_ + c8) = pack8(z);
            const f32x4 k0 = *(const f32x4*)(kkw + c8), k1 = *(const f32x4*)(kkw + c8 + 4); float ss = 0.f;
#pragma unroll
            for (int j = 0; j < 8; ++j) { const float q = z[j] * (j < 4 ? k0[j] : k1[j - 4]); ss += q * q; }
            ss += __shfl_xor(ss, 1); ss += __shfl_xor(ss, 2); ss += __shfl_xor(ss, 4);
            if ((gi & 7) == 0) invn[tk] = 1.0f / fmaxf(sqrtf(ss), 1e-12f); }
        else *(LAS u32x4*)(SV + tk * SP_ + c8) = pack8(z); }
    LDS_BAR();
    if (!(skip & 2)) {
        const int fr = lane & 15, fq = lane >> 4, th = wave >> 2;
        f32x4 ac[4][2];
#pragma unroll
        for (int tt = 0; tt < 2; ++tt) { const int ro = (16 * (2 * th + tt) + fr);
            f32x4 z4 = (f32x4){0.f, 0.f, 0.f, 0.f}; ac[0][tt] = z4; ac[1][tt] = z4; ac[2][tt] = z4; ac[3][tt] = z4;
#pragma unroll
            for (int ks = 0; ks < 2; ++ks) { const bf16x8 ba = *(const LAS bf16x8*)(adl + ro * SP_ + ks * 32 + fq * 8), bt = *(const LAS bf16x8*)(tw + ro * SP_ + ks * 32 + fq * 8);
                ac[0][tt] = __builtin_amdgcn_mfma_f32_16x16x32_bf16(wfa[ks], ba, ac[0][tt], 0, 0, 0);
                ac[1][tt] = __builtin_amdgcn_mfma_f32_16x16x32_bf16(wfw0[ks], bt, ac[1][tt], 0, 0, 0);
                ac[2][tt] = __builtin_amdgcn_mfma_f32_16x16x32_bf16(wfw1[ks], bt, ac[2][tt], 0, 0, 0); }
#pragma unroll
            for (int ks = 0; ks < 4; ++ks) { const bf16x8 bg = *(const LAS bf16x8*)(sg + ro * 136 + ks * 32 + fq * 8); ac[3][tt] = __builtin_amdgcn_mfma_f32_16x16x32_bf16(wfg[ks], bg, ac[3][tt], 0, 0, 0); } }
#pragma unroll
        for (int tt = 0; tt < 2; ++tt) { const int tk = 16 * (2 * th + tt) + fr;
            { const f32x4 v = ac[0][tt];
              const u32x2 kp = *(const LAS u32x2*)(SK + tk * SP_ + nloc); const float kf[4] = {bflo(kp.x), bfhi(kp.x), bflo(kp.y), bfhi(kp.y)};
              const float inn = invn[tk]; float k2[4], kk[4], bb[4];
#pragma unroll
              for (int j = 0; j < 4; ++j) { const float av = sigmoidf_(a0v[j] + v[j]); kk[j] = kf[j] * kkv[j] * inn; k2[j] = kf[j] * (1.0f + (av - 1.0f) * kav[j]); bb[j] = kk[j] * av; }
              u32x2 q; q.x = pk2(k2[0], k2[1]); q.y = pk2(k2[2], k2[3]); *(LAS u32x2*)(SK + tk * SP_ + nloc) = q;
              q.x = pk2(kk[0], kk[1]); q.y = pk2(kk[2], kk[3]); *(LAS u32x2*)(SKK + tk * SP_ + nloc) = q;
              q.x = pk2(bb[0], bb[1]); q.y = pk2(bb[2], bb[3]); *(LAS u32x2*)(SB + tk * SP_ + nloc) = q; }
#pragma unroll
            for (int mat = 1; mat <= 2; ++mat) { const f32x4 v = ac[mat][tt]; const f32x4 w0v = mat == 1 ? w0a : w0b; float d[4];
#pragma unroll
                for (int j = 0; j < 4; ++j) d[j] = __expf(-DECAY_SCALE * sigmoidf_(w0v[j] + v[j]));
                u32x2 q; q.x = pk2(d[0], d[1]); q.y = pk2(d[2], d[3]); *(LAS u32x2*)((mat == 1 ? SWF : SWB) + tk * SP_ + nloc) = q; }
            { const f32x4 v = ac[3][tt]; u32x2 q; q.x = pk2(v[0], v[1]); q.y = pk2(v[2], v[3]); *(u32x2*)(Y + (size_t)(row0 + tk) * D + 1280 + head * 64 + nloc) = q; }
        }
    }
    LDS_BAR();
    if (!(skip & 4)) { const int tk = tid >> 3, c8 = (tid & 7) * 8; float r8[8], k8[8], v8[8];
      unpack8(*(const LAS u32x4*)(SR + tk * SP_ + c8), r8); unpack8(*(const LAS u32x4*)(SK + tk * SP_ + c8), k8); unpack8(*(const LAS u32x4*)(SV + tk * SP_ + c8), v8);
      float bs = 0.f;
#pragma unroll
      for (int j = 0; j < 8; ++j) bs += r8[j] * k8[j] * (j < 4 ? rk0[j] : rk1[j - 4]);
      bs += __shfl_xor(bs, 1); bs += __shfl_xor(bs, 2); bs += __shfl_xor(bs, 4);
#pragma unroll
      for (int j = 0; j < 8; ++j) v8[j] *= bs;
      *(u32x4*)(Y + (size_t)(row0 + tk) * D + 512 + head * 64 + c8) = pack8(v8); }
    if (!(skip & 1)) {
        const int c4 = wave & 3, dir = wave >> 2, fr = lane & 15, fq = lane >> 4;
        LAS float* CB = (LAS float*)wpriv;
        LAS float* AA = CB + 16 * 64;
        const LAS bf16* SW = dir ? SWB : SWF;
        auto trow = [&](int tau) { return 16 * c4 + (dir ? 15 - tau : tau); };
        float c[16], ci[16];
        { float run = 1.f;
#pragma unroll
          for (int t = 0; t < 16; ++t) { run *= bf1(SW[trow(t) * SP_ + lane]); c[t] = run; ci[t] = __builtin_amdgcn_rcpf(run); CB[t * 64 + lane] = run; } }
        const int rec_dir = dir, bidx = isl ? (row0 >> 12) : ((row0 - NLAT) >> 8);
        const int tcl = isl ? 4 * ((row0 >> 6) & 63) + c4 : 4 * (((row0 - NLAT) >> 6) & 3) + c4;
        const int nproc = isl ? 16 + (dir ? 255 - tcl : tcl) : (dir ? 15 - tcl : tcl);
        unsigned char* rec = ws + WS_PRE + ((size_t)((rec_dir * 8 + bidx) * 12 + head) * NCHUNK16 + nproc) * PRE_REC;
        { const float cl = c[15]; float bk[32];
#pragma unroll
          for (int t = 0; t < 16; ++t) { const float e = cl * ci[t]; const int pos = 8 * (t >> 2) + (t & 3); bk[pos] = bf1(SB[trow(t) * SP_ + lane]) * e; bk[pos + 4] = bf1(SK[trow(t) * SP_ + lane]) * e; }
#pragma unroll
          for (int q4 = 0; q4 < 4; ++q4) { u32x4 o; o.x = pk2(bk[8 * q4], bk[8 * q4 + 1]); o.y = pk2(bk[8 * q4 + 2], bk[8 * q4 + 3]); o.z = pk2(bk[8 * q4 + 4], bk[8 * q4 + 5]); o.w = pk2(bk[8 * q4 + 6], bk[8 * q4 + 7]);
              *(u32x4*)(rec + PR_BK + lane * 64 + q4 * 16) = o; }
          *(float*)(rec + PR_GAM + lane * 4) = cl; }
        asm volatile("s_waitcnt lgkmcnt(0)" ::: "memory");
        bf16x8 fa[2], frr[2], fb[2], fk[2];
        { const int tr = trow(fr);
#pragma unroll
          for (int sx = 0; sx < 2; ++sx) { const int ch = 32 * sx + 8 * fq; float kk8[8], r8[8], b8[8], k8[8];
              unpack8(*(const LAS u32x4*)(SKK + tr * SP_ + ch), kk8); unpack8(*(const LAS u32x4*)(SR + tr * SP_ + ch), r8); unpack8(*(const LAS u32x4*)(SB + tr * SP_ + ch), b8); unpack8(*(const LAS u32x4*)(SK + tr * SP_ + ch), k8);
              const f32x4 c0 = *(const LAS f32x4*)(CB + fr * 64 + ch), c1 = *(const LAS f32x4*)(CB + fr * 64 + ch + 4);
              f32x4 p0 = (f32x4){1.f, 1.f, 1.f, 1.f}, p1 = p0; if (fr > 0) { p0 = *(const LAS f32x4*)(CB + (fr - 1) * 64 + ch); p1 = *(const LAS f32x4*)(CB + (fr - 1) * 64 + ch + 4); }
              float xa[8], xr[8], xb[8], xk[8];
#pragma unroll
              for (int j = 0; j < 8; ++j) { const float ec = j < 4 ? c0[j] : c1[j - 4], ep = j < 4 ? p0[j] : p1[j - 4]; const float en = __builtin_amdgcn_rcpf(ec);
                  xa[j] = -kk8[j] * ep; xr[j] = r8[j] * ec; xb[j] = b8[j] * en; xk[j] = k8[j] * en; }
              const u32x4 ua = pack8(xa), ur = pack8(xr), ub = pack8(xb), uk = pack8(xk);
              fa[sx] = __builtin_bit_cast(bf16x8, ua); frr[sx] = __builtin_bit_cast(bf16x8, ur); fb[sx] = __builtin_bit_cast(bf16x8, ub); fk[sx] = __builtin_bit_cast(bf16x8, uk); } }
        f32x4 gab = (f32x4){0.f, 0.f, 0.f, 0.f}, gak = gab, grb = gab, grk = gab;
#pragma unroll
        for (int sx = 0; sx < 2; ++sx) { gab = __builtin_amdgcn_mfma_f32_16x16x32_bf16(fa[sx], fb[sx], gab, 0, 0, 0); gak = __builtin_amdgcn_mfma_f32_16x16x32_bf16(fa[sx], fk[sx], gak, 0, 0, 0);
            grb = __builtin_amdgcn_mfma_f32_16x16x32_bf16(frr[sx], fb[sx], grb, 0, 0, 0); grk = __builtin_amdgcn_mfma_f32_16x16x32_bf16(frr[sx], fk[sx], grk, 0, 0, 0); }
#pragma unroll
        for (int j = 0; j < 4; ++j) { const int tau = 4 * fq + j; const bool lo = fr < tau, le = fr <= tau;
            AA[tau * 16 + fr] = lo ? gab[j] : 0.f; AA[256 + tau * 16 + fr] = lo ? gak[j] : 0.f; grb[j] = le ? grb[j] : 0.f; grk[j] = le ? grk[j] : 0.f; }
        asm volatile("s_waitcnt lgkmcnt(0)" ::: "memory");
        float wv[16], mv[16];
#pragma unroll
        for (int t = 0; t < 16; ++t) { const float ab = -bf1(SKK[trow(t) * SP_ + lane]) * (t > 0 ? c[t - 1] : 1.0f); float accw = ab, accm = AA[256 + t * 16 + fr];
#pragma unroll
            for (int q4 = 0; q4 < 4; ++q4) { if (4 * q4 < t) { const f32x4 cf = *(const LAS f32x4*)(AA + t * 16 + 4 * q4);
#pragma unroll
                for (int j = 0; j < 4; ++j) if (4 * q4 + j < t) { accw += cf[j] * wv[4 * q4 + j]; accm += cf[j] * mv[4 * q4 + j]; } } }
            wv[t] = accw; mv[t] = accm; }
        { LAS bf16* stg = (LAS bf16*)CB; const int pp = kperm_pos(lane);
#pragma unroll
          for (int t = 0; t < 16; ++t) { stg[t * 64 + pp] = (bf16)f2bf(wv[t]); stg[1024 + t * 64 + pp] = (bf16)f2bf(bf1(SR[trow(t) * SP_ + lane]) * c[t]); }
          asm volatile("s_waitcnt lgkmcnt(0)" ::: "memory");
#pragma unroll
          for (int q4 = 0; q4 < 4; ++q4) *(u32x4*)(rec + PR_WP + (q4 * 64 + lane) * 16) = *(const LAS u32x4*)((LAS unsigned char*)stg + (q4 * 64 + lane) * 16); }
        { LAS bf16* stg = (LAS bf16*)AA; const int ps = 8 * (fr >> 2) + (fr & 3);
          asm volatile("s_waitcnt lgkmcnt(0)" ::: "memory");
#pragma unroll
          for (int j = 0; j < 4; ++j) { const int tau = 4 * fq + j; stg[tau * 32 + ps] = (bf16)f2bf(grb[j]); stg[tau * 32 + ps + 4] = (bf16)f2bf(grk[j]); }
          if (lane < 16) {
#pragma unroll
              for (int t = 0; t < 16; ++t) stg[512 + t * 16 + lane] = (bf16)f2bf(mv[t]); }
          asm volatile("s_waitcnt lgkmcnt(0)" ::: "memory");
          *(u32x4*)(rec + PR_ARBK + lane * 16) = *(const LAS u32x4*)((LAS unsigned char*)stg + lane * 16);
          if (lane < 32) *(u32x4*)(rec + PR_ARBK + 1024 + lane * 16) = *(const LAS u32x4*)((LAS unsigned char*)stg + 1024 + lane * 16); }
        if (dir == 0) { float v16[16];
#pragma unroll
            for (int t = 0; t < 16; ++t) v16[t] = bf1(SV[(16 * c4 + t) * SP_ + lane]);
            const int tcg = isl ? 16 + tcl : tcl;
            unsigned char* vrec = ws + WS_VT + ((size_t)(bidx * 12 + head) * NCHUNK16 + tcg) * 2048 + lane * 32;
            u32x4 o; o.x = pk2(v16[0], v16[1]); o.y = pk2(v16[2], v16[3]); o.z = pk2(v16[4], v16[5]); o.w = pk2(v16[6], v16[7]); *(u32x4*)vrec = o;
            o.x = pk2(v16[8], v16[9]); o.y = pk2(v16[10], v16[11]); o.z = pk2(v16[12], v16[13]); o.w = pk2(v16[14], v16[15]); *(u32x4*)(vrec + 16) = o; }
    }
    LDS_BAR();
    }
}

__device__ __forceinline__ float dpp_xor1(float x) { return __builtin_bit_cast(float, __builtin_amdgcn_update_dpp(0, __builtin_bit_cast(int, x), 0xB1, 0xF, 0xF, false)); }
__device__ __forceinline__ float dpp_xor2(float x) { return __builtin_bit_cast(float, __builtin_amdgcn_update_dpp(0, __builtin_bit_cast(int, x), 0x4E, 0xF, 0xF, false)); }
__device__ __forceinline__ int chain_row(int dir, int b, int s) {
    if (s < CTXL) return NLAT + b * CTXL + (dir ? (CTXL - 1 - s) : s);
    const int t = s - CTXL; return b * T + (dir ? (T - 1 - t) : t);
}
__device__ __forceinline__ float dpp_hmirror(float x) { return __builtin_bit_cast(float, __builtin_amdgcn_update_dpp(0, __builtin_bit_cast(int, x), 0x141, 0xF, 0xF, false)); }
struct RwRec { u32x4 wp[2], rp[2], bk[4], arbk; u32x2 mak, vt[2]; f32x4 gam[4]; };
__device__ __forceinline__ void rw_load(RwRec& r, const LAS unsigned char* rec, int fr, int kg, int hv, int dir) {
#pragma unroll
    for (int sx = 0; sx < 2; ++sx) { r.wp[sx] = *(const LAS u32x4*)(rec + PR_WP + fr * 128 + sx * 64 + kg * 16); r.rp[sx] = *(const LAS u32x4*)(rec + PR_RP + fr * 128 + sx * 64 + kg * 16); }
#pragma unroll
    for (int i = 0; i < 4; ++i) { r.bk[i] = *(const LAS u32x4*)(rec + PR_BK + (16 * i + fr) * 64 + kg * 16); r.gam[i] = *(const LAS f32x4*)(rec + PR_GAM + (16 * i + 4 * kg) * 4); }
    r.arbk = *(const LAS u32x4*)(rec + PR_ARBK + fr * 64 + kg * 16);
    r.mak = *(const LAS u32x2*)(rec + PR_MAK + fr * 32 + kg * 8);
#pragma unroll
    for (int q = 0; q < 2; ++q) r.vt[q] = *(const LAS u32x2*)(rec + PRE_REC + (16 * (2 * hv + q) + fr) * 32 + (dir ? (12 - 4 * kg) : 4 * kg) * 2);
}
constexpr int RW_R = 6, RW_SLOT = PRE_REC + 2048;
__device__ __forceinline__ void rwkv_chain_mfma(KArgs a, int task_base, LAS unsigned char* lds) {
    const int t_ = tid_fresh(); const int lane = t_ & 63, fr = lane & 15, kg = lane >> 4; const int wave = __builtin_amdgcn_readfirstlane(t_ >> 6);
    unsigned char* ws = a->ws;
    bf16* OC = (bf16*)(ws + WS_OC);
    const int cid = (task_base >> 2) + (wave >> 2), wq = wave & 3, dir = cid / 96, b = (cid % 96) / 12, h = cid % 12;
    const bool comp = wq < 2; const int hv = wq & 1;
    const unsigned char* rec0 = ws + WS_PRE + (size_t)((dir * 8 + b) * 12 + h) * NCHUNK16 * PRE_REC;
    const unsigned char* vrec0 = ws + WS_VT + (size_t)(b * 12 + h) * NCHUNK16 * 2048;
    LAS unsigned char* ring = lds + (wave >> 2) * (RW_R * RW_SLOT);
    auto tchunk = [&](int n) { return n < 16 ? (dir ? 15 - n : n) : 16 + (dir ? 255 - (n - 16) : (n - 16)); };
    auto issue = [&](int n) { const int nn = n < NCHUNK16 ? n : NCHUNK16 - 1; LAS unsigned char* slot = ring + (n % RW_R) * RW_SLOT;
#pragma unroll
        for (int jj = 0; jj < 3; ++jj) { const int j = 3 * wq + jj;
            const unsigned char* src = (j < 10 ? rec0 + (size_t)nn * PRE_REC + 1024 * j : vrec0 + (size_t)tchunk(nn) * 2048 + 1024 * (j - 10)) + lane * 16;
            __builtin_amdgcn_global_load_lds((const unsigned*)src, (LAS unsigned*)(slot + 1024 * j), 16, 0, 0); } };
    f32x4 ST[2][4];
#pragma unroll
    for (int q = 0; q < 2; ++q)
#pragma unroll
        for (int i = 0; i < 4; ++i) ST[q][i] = (f32x4){0.f, 0.f, 0.f, 0.f};
    unsigned uvU[2][2] = {{0u, 0u}, {0u, 0u}};
#pragma unroll
    for (int n = 0; n < RW_R - 1; ++n) issue(n);
    for (int n = 0; n < NCHUNK16; ++n) {
        if (comp && n >= RW_R - 1) asm volatile("s_waitcnt vmcnt(22)" ::: "memory"); else asm volatile("s_waitcnt vmcnt(12)" ::: "memory");
        __builtin_amdgcn_s_barrier(); asm volatile("" ::: "memory");
        issue(n + RW_R - 1);
        if (comp) {
            RwRec cur; rw_load(cur, ring + (n % RW_R) * RW_SLOT, fr, kg, hv, dir);
            u32x4 fmak; fmak.x = 0u; fmak.y = 0u; fmak.z = cur.mak.x; fmak.w = cur.mak.y;
            const int row = chain_row(dir, b, 16 * n + fr);
#pragma unroll
            for (int q = 0; q < 2; ++q) {
                u32x4 fs[2];
#pragma unroll
                for (int sx = 0; sx < 2; ++sx) { fs[sx].x = pk2(ST[q][2 * sx][0], ST[q][2 * sx][1]); fs[sx].y = pk2(ST[q][2 * sx][2], ST[q][2 * sx][3]); fs[sx].z = pk2(ST[q][2 * sx + 1][0], ST[q][2 * sx + 1][1]); fs[sx].w = pk2(ST[q][2 * sx + 1][2], ST[q][2 * sx + 1][3]); }
                u32x2 vt = cur.vt[q]; if (dir) { const unsigned x = vt.x, y = vt.y; vt.x = (y >> 16) | (y << 16); vt.y = (x >> 16) | (x << 16); }
                u32x4 fuv; fuv.x = uvU[q][0]; fuv.y = uvU[q][1]; fuv.z = vt.x; fuv.w = vt.y;
                f32x4 U = (f32x4){0.f, 0.f, 0.f, 0.f};
                U = __builtin_amdgcn_mfma_f32_16x16x32_bf16(__builtin_bit_cast(bf16x8, cur.wp[0]), __builtin_bit_cast(bf16x8, fs[0]), U, 0, 0, 0);
                U = __builtin_amdgcn_mfma_f32_16x16x32_bf16(__builtin_bit_cast(bf16x8, cur.wp[1]), __builtin_bit_cast(bf16x8, fs[1]), U, 0, 0, 0);
                U = __builtin_amdgcn_mfma_f32_16x16x32_bf16(__builtin_bit_cast(bf16x8, fmak), __builtin_bit_cast(bf16x8, fuv), U, 0, 0, 0);
                uvU[q][0] = pk2(U[0], U[1]); uvU[q][1] = pk2(U[2], U[3]); fuv.x = uvU[q][0]; fuv.y = uvU[q][1];
                f32x4 OT = (f32x4){0.f, 0.f, 0.f, 0.f};
                OT = __builtin_amdgcn_mfma_f32_16x16x32_bf16(__builtin_bit_cast(bf16x8, fs[0]), __builtin_bit_cast(bf16x8, cur.rp[0]), OT, 0, 0, 0);
                OT = __builtin_amdgcn_mfma_f32_16x16x32_bf16(__builtin_bit_cast(bf16x8, fs[1]), __builtin_bit_cast(bf16x8, cur.rp[1]), OT, 0, 0, 0);
                OT = __builtin_amdgcn_mfma_f32_16x16x32_bf16(__builtin_bit_cast(bf16x8, fuv), __builtin_bit_cast(bf16x8, cur.arbk), OT, 0, 0, 0);
#pragma unroll
                for (int i = 0; i < 4; ++i) ST[q][i] = __builtin_amdgcn_mfma_f32_16x16x32_bf16(__builtin_bit_cast(bf16x8, cur.bk[i]), __builtin_bit_cast(bf16x8, fuv), ST[q][i] * cur.gam[i], 0, 0, 0);
                u32x2 o; o.x = pk2(OT[0], OT[1]); o.y = pk2(OT[2], OT[3]); *(u32x2*)(OC + ((size_t)dir * MALL + row) * CW + h * 64 + 16 * (2 * hv + q) + 4 * kg) = o;
            }
        }
    }
    asm volatile("s_waitcnt vmcnt(0)" ::: "memory");
    __builtin_amdgcn_s_barrier(); asm volatile("" ::: "memory");
}
__device__ __forceinline__ void hgrn_prep_item(KArgs a, int l, int item, LAS unsigned char* lds, bool dry) {
    const int tid = tid_fresh();
    unsigned char* ws = a->ws;
    bf16* P = (bf16*)(ws + WS_P); bf16* HQB = (bf16*)(ws + WS_HQB); float* HG = (float*)(ws + WS_HG);
    const int cn = item % 68, bh = item / 68, h = bh % 6, b = bh / 6;
    const int row0 = cn < 4 ? NLAT + b * CTXL + 64 * cn : b * T + 64 * (cn - 4);
    constexpr int QP = 136;
    LAS bf16* SQ = (LAS bf16*)lds; LAS bf16* KF = SQ + 64 * QP; LAS bf16* KB = KF + 64 * QP; LAS bf16* QB = KB + 64 * QP;
    LAS float* LF = (LAS float*)(QB + 64 * QP); LAS float* LBk = LF + 64 * 128;
    LAS float* tot = LBk + 64 * 128;
    LAS float* lbs = tot + 1024;
    if (tid < 256) { const int dr = tid >> 7, ch = h * 128 + (tid & 127); float lb = 0.f;
        if (l != 0) { const float l0 = a->in[I_LB][((size_t)dr * DEPTH + 0) * BW + ch], l1 = a->in[I_LB][((size_t)dr * DEPTH + 1) * BW + ch]; lb = __builtin_amdgcn_rcpf(1.0f + __expf(l0 - l1)); }
        lbs[tid] = lb; }
    const int ta = tid >> 3, d0 = (tid & 7) * 16;
    bf16* prow = P + (size_t)(row0 + ta) * INC + h * 128 + d0;
    u32x4 rq[2], rf[2], rb[2];
    rq[0] = *(const u32x4*)(prow + OFF_Q); rq[1] = *(const u32x4*)(prow + OFF_Q + 8); rf[0] = *(const u32x4*)(prow + OFF_ZF); rf[1] = *(const u32x4*)(prow + OFF_ZF + 8); rb[0] = *(const u32x4*)(prow + OFF_ZB); rb[1] = *(const u32x4*)(prow + OFF_ZB + 8);
    LDS_BAR();
#pragma unroll
    for (int hf = 0; hf < 2; ++hf) { float qf[8], zf[8], zb[8], oq[8], of[8], ob[8]; unpack8(rq[hf], qf); unpack8(rf[hf], zf); unpack8(rb[hf], zb);
        const int dd = d0 + 8 * hf; f32x4 lf0, lf1, lb0, lb1;
#pragma unroll
        for (int j = 0; j < 8; ++j) { const float lF = lbs[dd + j], lB = lbs[128 + dd + j];
            const float ff = lF + (1.0f - lF) * sigmoidf_(zf[j]), fb = lB + (1.0f - lB) * sigmoidf_(zb[j]);
            const float a1 = fmaxf(__logf(ff), -60.0f), a2 = fmaxf(__logf(fb), -60.0f);
            if (j < 4) { lf0[j] = a1; lb0[j] = a2; } else { lf1[j - 4] = a1; lb1[j - 4] = a2; }
            oq[j] = siluf_(qf[j]); of[j] = 1.0f - ff; ob[j] = 1.0f - fb; }
        *(LAS u32x4*)(SQ + ta * QP + dd) = pack8(oq); *(LAS u32x4*)(KF + ta * QP + dd) = pack8(of); *(LAS u32x4*)(KB + ta * QP + dd) = pack8(ob);
        *(LAS f32x4*)(LF + ta * 128 + dd) = lf0; *(LAS f32x4*)(LF + ta * 128 + dd + 4) = lf1; *(LAS f32x4*)(LBk + ta * 128 + dd) = lb0; *(LAS f32x4*)(LBk + ta * 128 + dd + 4) = lb1; }
    LDS_BAR();
    { const int d = tid & 127, qt = tid >> 7; float r1 = 0.f, r2 = 0.f;
#pragma unroll
      for (int i = 0; i < 16; ++i) { const int tp = 16 * qt + i; r1 += LF[tp * 128 + d]; LF[tp * 128 + d] = r1; r2 += LBk[(63 - tp) * 128 + d]; LBk[(63 - tp) * 128 + d] = r2; }
      tot[qt * 128 + d] = r1; tot[512 + qt * 128 + d] = r2; }
    LDS_BAR();
    LAS float* bas = lbs + 256;
    LAS float* bmd = bas + 1024;
    { const int d = tid & 127, dr = (tid >> 7) & 1; if (tid < 256) { const LAS float* tt = tot + 512 * dr; const float t0 = tt[d], t1 = tt[128 + d], t2 = tt[256 + d], t3 = tt[384 + d];
        bas[(dr * 4 + 0) * 128 + d] = 0.f; bas[(dr * 4 + 1) * 128 + d] = t0; bas[(dr * 4 + 2) * 128 + d] = t0 + t1; bas[(dr * 4 + 3) * 128 + d] = t0 + t1 + t2; bmd[dr * 128 + d] = t0 + t1;
        const int npr = dr == 0 ? cn : (cn < 4 ? 3 - cn : 4 + 63 - (cn - 4)); float* g = (dry ? (float*)(ws + WS_END + 8 * MiB) : HG) + ((size_t)(((dr * 8 + b) * 6 + h) * 68 + npr)) * 256; g[d] = __expf(t0 + t1); g[128 + d] = __expf(t2 + t3); } }
    LDS_BAR();
#pragma unroll
    for (int hf = 0; hf < 2; ++hf) { const int dd = d0 + 8 * hf; float sq[8], kf[8], kb[8];
        unpack8(*(const LAS u32x4*)(SQ + ta * QP + dd), sq); unpack8(*(const LAS u32x4*)(KF + ta * QP + dd), kf); unpack8(*(const LAS u32x4*)(KB + ta * QP + dd), kb);
        float oqf[8], okf[8], oqb[8], okb[8];
#pragma unroll
        for (int dr = 0; dr < 2; ++dr) { const int tp = dr ? 63 - ta : ta, q = tp >> 4; const LAS float* pf = (dr ? LBk : LF) + ta * 128 + dd;
            const f32x4 p0 = *(const LAS f32x4*)pf, p1 = *(const LAS f32x4*)(pf + 4), b0 = *(const LAS f32x4*)(bas + (dr * 4 + q) * 128 + dd), b1 = *(const LAS f32x4*)(bas + (dr * 4 + q) * 128 + dd + 4),
                        m0 = *(const LAS f32x4*)(bmd + dr * 128 + dd), m1 = *(const LAS f32x4*)(bmd + dr * 128 + dd + 4);
#pragma unroll
            for (int j = 0; j < 8; ++j) { const float bt = (j < 4 ? p0[j] + b0[j] : p1[j - 4] + b1[j - 4]), bm = j < 4 ? m0[j] : m1[j - 4];
                const float eq = __expf(fminf(bt - bm, 80.0f)), ek = __expf(fminf(bm - bt, 80.0f));
                if (dr == 0) { oqf[j] = sq[j] * eq; okf[j] = kf[j] * ek; } else { oqb[j] = sq[j] * eq; okb[j] = kb[j] * ek; } } }
        *(LAS u32x4*)(QB + ta * QP + dd) = pack8(oqf); *(LAS u32x4*)(KF + ta * QP + dd) = pack8(okf); *(LAS u32x4*)(KB + ta * QP + dd) = pack8(okb); *(LAS u32x4*)(SQ + ta * QP + dd) = pack8(oqb); }
    bf16* prow_o = dry ? (bf16*)(ws + WS_END) + (size_t)((row0 + ta) & 511) * INC + h * 128 + d0 : prow; bf16* hqb_o = dry ? (bf16*)(ws + WS_END) : HQB;
#pragma unroll
    for (int hf = 0; hf < 2; ++hf) { const int dd = d0 + 8 * hf;
        *(u32x4*)(prow_o + OFF_Q + 8 * hf) = *(const LAS u32x4*)(QB + ta * QP + dd); *(u32x4*)(prow_o + OFF_ZF + 8 * hf) = *(const LAS u32x4*)(KF + ta * QP + dd); *(u32x4*)(prow_o + OFF_ZB + 8 * hf) = *(const LAS u32x4*)(KB + ta * QP + dd);
        *(u32x4*)(hqb_o + (size_t)(dry ? ((row0 + ta) & 1023) : (row0 + ta)) * BW + h * 128 + dd) = *(const LAS u32x4*)(SQ + ta * QP + dd); }
    LDS_BAR();
}
__device__ __forceinline__ unsigned tr_addr(const LAS bf16* X, int pitch, int r0, int c0, int lane) { const int i = lane & 15, g = lane >> 4; return (unsigned)(size_t)(X + (r0 + 8 * g + (i >> 2)) * pitch + c0 + 4 * (i & 3)); }
__device__ __forceinline__ void tr8x4(u32x2 (&lo)[4], u32x2 (&hi)[4], unsigned a0, unsigned a1, unsigned a2, unsigned a3, unsigned rowstep4) {
    const unsigned b0 = a0 + rowstep4, b1 = a1 + rowstep4, b2 = a2 + rowstep4, b3 = a3 + rowstep4;
    asm volatile("ds_read_b64_tr_b16 %0, %8\n\tds_read_b64_tr_b16 %1, %9\n\tds_read_b64_tr_b16 %2, %10\n\tds_read_b64_tr_b16 %3, %11\n\t"
                 "ds_read_b64_tr_b16 %4, %12\n\tds_read_b64_tr_b16 %5, %13\n\tds_read_b64_tr_b16 %6, %14\n\tds_read_b64_tr_b16 %7, %15\n\ts_waitcnt lgkmcnt(0)"
                 : "=&v"(lo[0]), "=&v"(lo[1]), "=&v"(lo[2]), "=&v"(lo[3]), "=&v"(hi[0]), "=&v"(hi[1]), "=&v"(hi[2]), "=&v"(hi[3])
                 : "v"(a0), "v"(a1), "v"(a2), "v"(a3), "v"(b0), "v"(b1), "v"(b2), "v"(b3) : "memory");
}
__device__ __forceinline__ void tr_half(u32x2 (&vl)[8], u32x2 (&vh)[8], u32x2 (&xl)[2], u32x2 (&xh)[2], unsigned av, unsigned ak, unsigned ax) {
    asm volatile(
        "ds_read_b64_tr_b16 %0, %20\n\tds_read_b64_tr_b16 %1, %20 offset:32\n\tds_read_b64_tr_b16 %2, %20 offset:64\n\tds_read_b64_tr_b16 %3, %20 offset:96\n\t"
        "ds_read_b64_tr_b16 %4, %20 offset:128\n\tds_read_b64_tr_b16 %5, %20 offset:160\n\tds_read_b64_tr_b16 %6, %20 offset:192\n\tds_read_b64_tr_b16 %7, %20 offset:224\n\t"
        "ds_read_b64_tr_b16 %8, %20 offset:1088\n\tds_read_b64_tr_b16 %9, %20 offset:1120\n\tds_read_b64_tr_b16 %10, %20 offset:1152\n\tds_read_b64_tr_b16 %11, %20 offset:1184\n\t"
        "ds_read_b64_tr_b16 %12, %20 offset:1216\n\tds_read_b64_tr_b16 %13, %20 offset:1248\n\tds_read_b64_tr_b16 %14, %20 offset:1280\n\tds_read_b64_tr_b16 %15, %20 offset:1312\n\t"
        "ds_read_b64_tr_b16 %16, %21\n\tds_read_b64_tr_b16 %17, %22\n\tds_read_b64_tr_b16 %18, %21 offset:1088\n\tds_read_b64_tr_b16 %19, %22 offset:1088\n\ts_waitcnt lgkmcnt(0)"
        : "=&v"(vl[0]), "=&v"(vl[1]), "=&v"(vl[2]), "=&v"(vl[3]), "=&v"(vl[4]), "=&v"(vl[5]), "=&v"(vl[6]), "=&v"(vl[7]),
          "=&v"(vh[0]), "=&v"(vh[1]), "=&v"(vh[2]), "=&v"(vh[3]), "=&v"(vh[4]), "=&v"(vh[5]), "=&v"(vh[6]), "=&v"(vh[7]),
          "=&v"(xl[0]), "=&v"(xl[1]), "=&v"(xh[0]), "=&v"(xh[1])
        : "v"(av), "v"(ak), "v"(ax) : "memory");
}
__device__ __forceinline__ bf16x8 mk8(u32x2 lo, u32x2 hi) { u32x4 v; v.x = lo.x; v.y = lo.y; v.z = hi.x; v.w = hi.y; return __builtin_bit_cast(bf16x8, v); }
__device__ __forceinline__ void hgrn_chain_lean(KArgs a, int cid, LAS unsigned char* lds) {
    const int tid = tid_fresh(), lane = tid & 63, wave = tid >> 6, fr = lane & 15, fq = lane >> 4;
    unsigned char* ws = a->ws;
    const bf16* P = (const bf16*)(ws + WS_P); const bf16* HQB = (const bf16*)(ws + WS_HQB); const float* HG = (const float*)(ws + WS_HG); bf16* OB = (bf16*)(ws + WS_OB);
    const int dir = cid / 48, b = (cid % 48) / 6, h = cid % 6;
    constexpr int QP = 136, SP = 72;
    LAS bf16* qs = (LAS bf16*)lds;
    LAS bf16* ks = qs + 64 * QP;
    LAS bf16* vs = ks + 64 * QP;
    LAS bf16* pl = vs + 64 * QP;
    LAS bf16* sT = pl + 64 * SP;
    LAS float* gm = (LAS float*)(sT + 128 * QP);
    const int ta = tid >> 3, d0 = (tid & 7) * 16;
    const int koff = dir ? OFF_ZB : OFF_ZF;
    f32x4 S[8];
#pragma unroll
    for (int vt = 0; vt < 8; ++vt) S[vt] = (f32x4){0.f, 0.f, 0.f, 0.f};
    u32x4 rq[2], rk[2], rv[2]; float rg = 0.f;
    auto load_chunk = [&](int n) { const int row = chain_row(dir, b, 64 * n + ta); const bf16* pr = P + (size_t)row * INC + h * 128 + d0;
        const bf16* qr = dir ? HQB + (size_t)row * BW + h * 128 + d0 : pr + OFF_Q;
        rq[0] = *(const u32x4*)qr; rq[1] = *(const u32x4*)(qr + 8); rk[0] = *(const u32x4*)(pr + koff); rk[1] = *(const u32x4*)(pr + koff + 8); rv[0] = *(const u32x4*)(pr + OFF_I); rv[1] = *(const u32x4*)(pr + OFF_I + 8);
        if (tid < 256) rg = HG[((size_t)(((dir * 8 + b) * 6 + h) * 68 + n)) * 256 + tid]; };
    load_chunk(0);
    constexpr int NCH = (CTXL + T) / 64;
    for (int n = 0; n < NCH; ++n) {
        const int s0 = n * 64;
        *(LAS u32x4*)(qs + ta * QP + d0) = rq[0]; *(LAS u32x4*)(qs + ta * QP + d0 + 8) = rq[1]; *(LAS u32x4*)(ks + ta * QP + d0) = rk[0]; *(LAS u32x4*)(ks + ta * QP + d0 + 8) = rk[1];
        *(LAS u32x4*)(vs + ta * QP + d0) = rv[0]; *(LAS u32x4*)(vs + ta * QP + d0 + 8) = rv[1]; if (tid < 256) gm[tid] = rg;
        if (n + 1 < NCH) load_chunk(n + 1);
        LDS_BAR();
        { const f32x4 g4 = *(const LAS f32x4*)(gm + 16 * wave + 4 * fq);
#pragma unroll
          for (int vt = 0; vt < 8; ++vt) { S[vt] = S[vt] * g4; u32x2 o; o.x = pk2(S[vt][0], S[vt][1]); o.y = pk2(S[vt][2], S[vt][3]); *(LAS u32x2*)(sT + (16 * vt + fr) * QP + 16 * wave + 4 * fq) = o; } }
        { const int tt = wave >> 1;
#pragma unroll
          for (int u = 0; u < 2; ++u) { const int sg = 2 * (wave & 1) + u; f32x4 acc = (f32x4){0.f, 0.f, 0.f, 0.f};
              if (sg <= tt) {
#pragma unroll
                  for (int kq = 0; kq < 4; ++kq) { const bf16x8 af = *(const LAS bf16x8*)(ks + (16 * sg + fr) * QP + 32 * kq + 8 * fq), bfm = *(const LAS bf16x8*)(qs + (16 * tt + fr) * QP + 32 * kq + 8 * fq);
                      acc = __builtin_amdgcn_mfma_f32_16x16x32_bf16(af, bfm, acc, 0, 0, 0); }
                  if (sg == tt) {
#pragma unroll
                      for (int j = 0; j < 4; ++j) if (4 * fq + j > fr) acc[j] = 0.f; }
              }
              u32x2 o; o.x = pk2(acc[0], acc[1]); o.y = pk2(acc[2], acc[3]); *(LAS u32x2*)(pl + (16 * tt + fr) * SP + 16 * sg + 4 * fq) = o; } }
        LDS_BAR();
        f32x4 oacc[4];
#pragma unroll
        for (int tt = 0; tt < 4; ++tt) { f32x4 acc = (f32x4){0.f, 0.f, 0.f, 0.f};
#pragma unroll
            for (int kq = 0; kq < 4; ++kq) { const bf16x8 af = *(const LAS bf16x8*)(sT + (16 * wave + fr) * QP + 32 * kq + 8 * fq), bfm = *(const LAS bf16x8*)(qs + (16 * tt + fr) * QP + 32 * kq + 8 * fq);
                acc = __builtin_amdgcn_mfma_f32_16x16x32_bf16(af, bfm, acc, 0, 0, 0); }
            oacc[tt] = acc; }
        const unsigned rs4 = (unsigned)(4 * QP * 2);
#pragma unroll
        for (int kq = 0; kq < 2; ++kq) {
            u32x2 vl_[8], vh_[8], xl_[2], xh_[2];
            static_assert(QP == 136, "tr_half's immediates assume 272-byte rows");
            tr_half(vl_, vh_, xl_, xh_, tr_addr(vs, QP, 32 * kq, 0, lane), tr_addr(ks, QP, 32 * kq, 16 * wave, lane), tr_addr(vs, QP, 32 * kq, 16 * wave, lane));
            __builtin_amdgcn_sched_barrier(0);
            { const bf16x8 af = mk8(xl_[1], xh_[1]);
#pragma unroll
              for (int tt = 0; tt < 4; ++tt) { const bf16x8 bfm = *(const LAS bf16x8*)(pl + (16 * tt + fr) * SP + 32 * kq + 8 * fq); oacc[tt] = __builtin_amdgcn_mfma_f32_16x16x32_bf16(af, bfm, oacc[tt], 0, 0, 0); } }
            { const bf16x8 af = mk8(xl_[0], xh_[0]);
#pragma unroll
              for (int vt = 0; vt < 8; ++vt) S[vt] = __builtin_amdgcn_mfma_f32_16x16x32_bf16(af, mk8(vl_[vt], vh_[vt]), S[vt], 0, 0, 0); }
        }
#pragma unroll
        for (int tt = 0; tt < 4; ++tt) { const int row = chain_row(dir, b, s0 + 16 * tt + fr);
            u32x2 o; o.x = pk2(oacc[tt][0], oacc[tt][1]); o.y = pk2(oacc[tt][2], oacc[tt][3]); *(u32x2*)(OB + ((size_t)dir * MALL + row) * BW + h * 128 + 16 * wave + 4 * fq) = o; }
        { const f32x4 ge = *(const LAS f32x4*)(gm + 128 + 16 * wave + 4 * fq);
#pragma unroll
          for (int vt = 0; vt < 8; ++vt) S[vt] = S[vt] * ge; }
        LDS_BAR();
    }
}
__device__ __forceinline__ void hgrn_chain_mfma(KArgs a, int l, int cid, LAS unsigned char* lds) {
    const int tid = tid_fresh(), lane = tid & 63, wave = tid >> 6, fr = lane & 15, fq = lane >> 4;
    unsigned char* ws = a->ws;
    const bf16* P = (const bf16*)(ws + WS_P); bf16* OB = (bf16*)(ws + WS_OB);
    const int dir = cid / 48, b = (cid % 48) / 6, h = cid % 6;
    constexpr int QP = 136, SP = 72;
    LAS bf16* qs = (LAS bf16*)lds;
    LAS bf16* ks = qs + 64 * QP;
    LAS bf16* kT = ks + 64 * QP;
    LAS bf16* vT = kT + 128 * SP;
    LAS bf16* pl = vT + 128 * SP;
    LAS bf16* sT = pl + 64 * SP;
    LAS float* tot = (LAS float*)(sT + 128 * QP);
    LAS float* gmid = tot + 512;
    LAS float* gend = gmid + 128;
    LAS float* lbs = gend + 128;
    LAS float* lfb = (LAS float*)sT;
    const int d = tid & 127, qt = tid >> 7;
    const int tau_a = tid >> 3, d0 = (tid & 7) * 16;
    if (tid < 128) { const int ch = h * 128 + tid; float lb = 0.f;
        if (l != 0) { const float l0 = a->in[I_LB][((size_t)dir * DEPTH + 0) * BW + ch], l1 = a->in[I_LB][((size_t)dir * DEPTH + 1) * BW + ch]; lb = 1.0f / (1.0f + __expf(l0 - l1)); }
        lbs[tid] = lb; }
    f32x4 S[8];
#pragma unroll
    for (int vt = 0; vt < 8; ++vt) S[vt] = (f32x4){0.f, 0.f, 0.f, 0.f};
    const int zoff = dir ? OFF_ZB : OFF_ZF;
    u32x4 rq[2], ri[2], rz[2];
    { const bf16* pr = P + (size_t)chain_row(dir, b, tau_a) * INC + h * 128 + d0;
      rq[0] = *(const u32x4*)(pr + OFF_Q); rq[1] = *(const u32x4*)(pr + OFF_Q + 8); ri[0] = *(const u32x4*)(pr + OFF_I); ri[1] = *(const u32x4*)(pr + OFF_I + 8); rz[0] = *(const u32x4*)(pr + zoff); rz[1] = *(const u32x4*)(pr + zoff + 8); }
    __syncthreads();
    constexpr int NCH = (CTXL + T) / 64;
    for (int n = 0; n < NCH; ++n) {
        const int s0 = n * 64;
#pragma unroll
        for (int hf = 0; hf < 2; ++hf) { float qf[8], zf[8], oq[8], ok[8]; unpack8(rq[hf], qf); unpack8(rz[hf], zf);
            const int dd = d0 + 8 * hf; const f32x4 lb0 = *(const LAS f32x4*)(lbs + dd), lb1 = *(const LAS f32x4*)(lbs + dd + 4); f32x4 lf0, lf1;
#pragma unroll
            for (int j = 0; j < 8; ++j) { const float lb = j < 4 ? lb0[j] : lb1[j - 4]; const float f = lb + (1.0f - lb) * sigmoidf_(zf[j]); const float lf = fmaxf(__logf(f), -60.0f);
                if (j < 4) lf0[j] = lf; else lf1[j - 4] = lf; oq[j] = siluf_(qf[j]); ok[j] = 1.0f - f; }
            *(LAS u32x4*)(qs + tau_a * QP + dd) = pack8(oq); *(LAS u32x4*)(ks + tau_a * QP + dd) = pack8(ok);
            *(LAS f32x4*)(lfb + tau_a * 128 + dd) = lf0; *(LAS f32x4*)(lfb + tau_a * 128 + dd + 4) = lf1;
            const u32x4 vv = ri[hf];
            vT[(dd + 0) * SP + tau_a] = (bf16)(vv.x & 0xffffu); vT[(dd + 1) * SP + tau_a] = (bf16)(vv.x >> 16); vT[(dd + 2) * SP + tau_a] = (bf16)(vv.y & 0xffffu); vT[(dd + 3) * SP + tau_a] = (bf16)(vv.y >> 16);
            vT[(dd + 4) * SP + tau_a] = (bf16)(vv.z & 0xffffu); vT[(dd + 5) * SP + tau_a] = (bf16)(vv.z >> 16); vT[(dd + 6) * SP + tau_a] = (bf16)(vv.w & 0xffffu); vT[(dd + 7) * SP + tau_a] = (bf16)(vv.w >> 16); }
        if (n + 1 < NCH) { const bf16* pr = P + (size_t)chain_row(dir, b, s0 + 64 + tau_a) * INC + h * 128 + d0;
            rq[0] = *(const u32x4*)(pr + OFF_Q); rq[1] = *(const u32x4*)(pr + OFF_Q + 8); ri[0] = *(const u32x4*)(pr + OFF_I); ri[1] = *(const u32x4*)(pr + OFF_I + 8); rz[0] = *(const u32x4*)(pr + zoff); rz[1] = *(const u32x4*)(pr + zoff + 8); }
        LDS_BAR();
        float cs[16];
        { float run = 0.f;
#pragma unroll
          for (int i = 0; i < 16; ++i) { run += lfb[(16 * qt + i) * 128 + d]; cs[i] = run; }
          tot[qt * 128 + d] = run; }
        LDS_BAR();
        { const float t0 = tot[d], t1 = tot[128 + d], t2 = tot[256 + d], t3 = tot[384 + d];
          const float bmid = t0 + t1, btot = bmid + t2 + t3; const float base = (qt > 0 ? t0 : 0.f) + (qt > 1 ? t1 : 0.f) + (qt > 2 ? t2 : 0.f);
          if (qt == 0) { gmid[d] = __expf(bmid); gend[d] = __expf(btot - bmid); }
#pragma unroll
          for (int i = 0; i < 16; ++i) { const int tau = 16 * qt + i; const float bt = base + cs[i];
              const float eq = __expf(fminf(bt - bmid, 80.0f)), ek = __expf(fminf(bmid - bt, 80.0f));
              const bf16 qb = (bf16)f2bf(bf1(qs[tau * QP + d]) * eq), kb = (bf16)f2bf(bf1(ks[tau * QP + d]) * ek);
              qs[tau * QP + d] = qb; ks[tau * QP + d] = kb; kT[d * SP + tau] = kb; } }
        LDS_BAR();
        { const f32x4 gm = *(const LAS f32x4*)(gmid + 16 * wave + 4 * fq);
#pragma unroll
          for (int vt = 0; vt < 8; ++vt) { S[vt] = S[vt] * gm; u32x2 o; o.x = pk2(S[vt][0], S[vt][1]); o.y = pk2(S[vt][2], S[vt][3]); *(LAS u32x2*)(sT + (16 * vt + fr) * QP + 16 * wave + 4 * fq) = o; } }
        { const int tt = wave >> 1;
#pragma unroll
          for (int u = 0; u < 2; ++u) { const int sg = 2 * (wave & 1) + u; f32x4 acc = (f32x4){0.f, 0.f, 0.f, 0.f};
              if (sg <= tt) {
#pragma unroll
                  for (int kq = 0; kq < 4; ++kq) { const bf16x8 af = *(const LAS bf16x8*)(ks + (16 * sg + fr) * QP + 32 * kq + 8 * fq), bfm = *(const LAS bf16x8*)(qs + (16 * tt + fr) * QP + 32 * kq + 8 * fq);
                      acc = __builtin_amdgcn_mfma_f32_16x16x32_bf16(af, bfm, acc, 0, 0, 0); }
                  if (sg == tt) {
#pragma unroll
                      for (int j = 0; j < 4; ++j) if (4 * fq + j > fr) acc[j] = 0.f; }
              }
              u32x2 o; o.x = pk2(acc[0], acc[1]); o.y = pk2(acc[2], acc[3]); *(LAS u32x2*)(pl + (16 * tt + fr) * SP + 16 * sg + 4 * fq) = o; } }
        LDS_BAR();
#pragma unroll
        for (int tt = 0; tt < 4; ++tt) { f32x4 acc = (f32x4){0.f, 0.f, 0.f, 0.f};
#pragma unroll
            for (int kq = 0; kq < 2; ++kq) { const bf16x8 af = *(const LAS bf16x8*)(vT + (16 * wave + fr) * SP + 32 * kq + 8 * fq), bfm = *(const LAS bf16x8*)(pl + (16 * tt + fr) * SP + 32 * kq + 8 * fq);
                acc = __builtin_amdgcn_mfma_f32_16x16x32_bf16(af, bfm, acc, 0, 0, 0); }
#pragma unroll
            for (int kq = 0; kq < 4; ++kq) { const bf16x8 af = *(const LAS bf16x8*)(sT + (16 * wave + fr) * QP + 32 * kq + 8 * fq), bfm = *(const LAS bf16x8*)(qs + (16 * tt + fr) * QP + 32 * kq + 8 * fq);
                acc = __builtin_amdgcn_mfma_f32_16x16x32_bf16(af, bfm, acc, 0, 0, 0); }
            const int row = chain_row(dir, b, s0 + 16 * tt + fr);
            u32x2 o; o.x = pk2(acc[0], acc[1]); o.y = pk2(acc[2], acc[3]); *(u32x2*)(OB + ((size_t)dir * MALL + row) * BW + h * 128 + 16 * wave + 4 * fq) = o; }
        { const f32x4 ge = *(const LAS f32x4*)(gend + 16 * wave + 4 * fq);
#pragma unroll
          for (int kq = 0; kq < 2; ++kq) { const bf16x8 af = *(const LAS bf16x8*)(kT + (16 * wave + fr) * SP + 32 * kq + 8 * fq);
#pragma unroll
              for (int vt = 0; vt < 8; ++vt) { const bf16x8 bfm = *(const LAS bf16x8*)(vT + (16 * vt + fr) * SP + 32 * kq + 8 * fq); S[vt] = __builtin_amdgcn_mfma_f32_16x16x32_bf16(af, bfm, S[vt], 0, 0, 0); } }
#pragma unroll
          for (int vt = 0; vt < 8; ++vt) S[vt] = S[vt] * ge; }
        LDS_BAR();
    }
}
__device__ __forceinline__ void hgrn_chain(KArgs a, int l, int cid, LAS unsigned char* lds) {
    const int tid = tid_fresh();
    unsigned char* ws = a->ws;
    const bf16* P = (const bf16*)(ws + WS_P); bf16* OB = (bf16*)(ws + WS_OB);
    const int dir = cid / 48, b = (cid % 48) / 6, h = cid % 6;
    LAS float* tq = (LAS float*)lds;
    LAS float* tk = tq + 16 * 128;
    LAS float* tf = tk + 16 * 128;
    LAS float* tv = tf + 16 * 128;
    LAS float* ot = tv + 16 * 128;
    const int v = tid >> 2, q = tid & 3;
    float S[32];
#pragma unroll
    for (int j = 0; j < 32; ++j) S[j] = 0.f;
    const int sst = tid >> 5, sc4 = (tid & 31) * 4;
    float lb[4];
#pragma unroll
    for (int j = 0; j < 4; ++j) { const int ch = h * 128 + sc4 + j;
        if (l == 0) lb[j] = 0.f; else { const float l0 = a->in[I_LB][((size_t)dir * DEPTH + 0) * BW + ch], l1 = a->in[I_LB][((size_t)dir * DEPTH + 1) * BW + ch]; lb[j] = 1.0f / (1.0f + __expf(l0 - l1)); } }
    for (int s0 = 0; s0 < CTXL + T; s0 += 16) {
        { const int row = chain_row(dir, b, s0 + sst); const bf16* pr = P + (size_t)row * INC + h * 128 + sc4;
          const u32x2 pq = *(const u32x2*)(pr + OFF_Q), pi = *(const u32x2*)(pr + OFF_I), pz = *(const u32x2*)(pr + (dir ? OFF_ZB : OFF_ZF));
          const float qf[4] = {bflo(pq.x), bfhi(pq.x), bflo(pq.y), bfhi(pq.y)}, vf[4] = {bflo(pi.x), bfhi(pi.x), bflo(pi.y), bfhi(pi.y)}, zf[4] = {bflo(pz.x), bfhi(pz.x), bflo(pz.y), bfhi(pz.y)};
          f32x4 oq, ok, of, ov;
#pragma unroll
          for (int j = 0; j < 4; ++j) { const float f = lb[j] + (1.0f - lb[j]) * sigmoidf_(zf[j]); oq[j] = siluf_(qf[j]); of[j] = f; ok[j] = 1.0f - f; ov[j] = vf[j]; }
          *(LAS f32x4*)(tq + sst * 128 + sc4) = oq; *(LAS f32x4*)(tk + sst * 128 + sc4) = ok; *(LAS f32x4*)(tf + sst * 128 + sc4) = of; *(LAS f32x4*)(tv + sst * 128 + sc4) = ov; }
        LDS_BAR();
        for (int st = 0; st < 16; ++st) {
            const float vv = tv[st * 128 + v]; float o0 = 0.f, o1 = 0.f;
#pragma unroll
            for (int j = 0; j < 8; ++j) { const f32x4 fq4 = *(const LAS f32x4*)(tf + st * 128 + q * 32 + 4 * j), kq4 = *(const LAS f32x4*)(tk + st * 128 + q * 32 + 4 * j), qq4 = *(const LAS f32x4*)(tq + st * 128 + q * 32 + 4 * j);
#pragma unroll
                for (int i = 0; i < 4; ++i) { const float sn = fq4[i] * S[4 * j + i] + kq4[i] * vv; S[4 * j + i] = sn; if (i & 1) o1 += qq4[i] * sn; else o0 += qq4[i] * sn; } }
            float o = o0 + o1; o += dpp_xor1(o); o += dpp_xor2(o);
            if (q == 0) ot[st * 128 + v] = o;
        }
        LDS_BAR();
        if (tid < 256) { const int st = tid >> 4, part = tid & 15; const int row = chain_row(dir, b, s0 + st); const LAS float* op = ot + st * 128 + part * 8;
            float f[8];
#pragma unroll
            for (int j = 0; j < 8; ++j) f[j] = op[j];
            *(u32x4*)(OB + ((size_t)dir * MALL + row) * BW + h * 128 + part * 8) = pack8(f); }
    }
    LDS_BAR();
}

__device__ __forceinline__ float grp_sum32(float v) { v += __shfl_xor(v, 1); v += __shfl_xor(v, 2); v += __shfl_xor(v, 4); v += __shfl_xor(v, 8); v += __shfl_xor(v, 16); return v; }
__device__ __forceinline__ float grp_sum16(float v) { v += __shfl_xor(v, 1); v += __shfl_xor(v, 2); v += __shfl_xor(v, 4); v += __shfl_xor(v, 8); return v; }
__device__ __forceinline__ void phase_finalize(KArgs a, int l, bool dry) {
    const int tid_ = tid_fresh(); const int lane = tid_ & 63, wave = tid_ >> 6, gw = blockIdx.x * 8 + wave, NGW = gridDim.x * 8;
    unsigned char* ws = a->ws;
    const bf16* P = (const bf16*)(ws + WS_P); const bf16* OB = (const bf16*)(ws + WS_OB); const bf16* OC = (const bf16*)(ws + WS_OC); bf16* Y = (bf16*)(ws + WS_Y);
    unsigned char* Yo = dry ? ws + WS_END : ws + WS_Y8;
    const int nrows = (l == DEPTH - 1) ? NLAT : MALL;
    const int rpw = (nrows + NGW - 1) / NGW; const int r0 = gw * rpw, r1 = (r0 + rpw < nrows) ? r0 + rpw : nrows;
    f32x4 hng[3], gng[3], gnb[3];
#pragma unroll
    for (int k = 0; k < 3; ++k) { const int c = 256 * k + 4 * lane; hng[k] = *(const f32x4*)(a->in[I_HNG] + (size_t)l * BW + c);
        gng[k] = *(const f32x4*)(a->in[I_GNGG] + (size_t)l * CW + c); gnb[k] = *(const f32x4*)(a->in[I_GNB] + (size_t)l * CW + c); }
    for (int row = r0; row < r1; ++row) {
        const int orow = dry ? (row & 2047) : row;
        u32x2 bf_[3], bb_[3], bg_[3], cf_[3], cb_[3], cv_[3], cg_[3];
#pragma unroll
        for (int k = 0; k < 3; ++k) { const int c = 256 * k + 4 * lane;
            bf_[k] = *(const u32x2*)(OB + (size_t)row * BW + c); bb_[k] = *(const u32x2*)(OB + ((size_t)MALL + row) * BW + c); bg_[k] = *(const u32x2*)(P + (size_t)row * INC + OFF_OG + c);
            cf_[k] = *(const u32x2*)(OC + (size_t)row * CW + c); cb_[k] = *(const u32x2*)(OC + ((size_t)MALL + row) * CW + c);
            cv_[k] = *(const u32x2*)(Y + (size_t)row * D + 512 + c);
            cg_[k] = *(const u32x2*)(Y + (size_t)row * D + 1280 + c); }
#pragma unroll
        for (int k = 0; k < 3; ++k) { const int c = 256 * k + 4 * lane;
            { float o[4] = {bflo(bf_[k].x) + bflo(bb_[k].x), bfhi(bf_[k].x) + bfhi(bb_[k].x), bflo(bf_[k].y) + bflo(bb_[k].y), bfhi(bf_[k].y) + bfhi(bb_[k].y)};
              const float ss = grp_sum32((o[0] * o[0] + o[1] * o[1]) + (o[2] * o[2] + o[3] * o[3])); const float rstd = 1.0f / sqrtf(ss * (1.0f / 128.0f) + NORM_EPS);
              const float g4[4] = {bflo(bg_[k].x), bfhi(bg_[k].x), bflo(bg_[k].y), bfhi(bg_[k].y)}; float y[4];
#pragma unroll
              for (int j = 0; j < 4; ++j) y[j] = o[j] * rstd * hng[k][j] * sigmoidf_(g4[j]);
              *(unsigned*)(Yo + (size_t)orow * D + 512 + c) = pk4_fp8(y[0], y[1], y[2], y[3]); }
            { float o[4] = {bflo(cf_[k].x) + bflo(cb_[k].x), bfhi(cf_[k].x) + bfhi(cb_[k].x), bflo(cf_[k].y) + bflo(cb_[k].y), bfhi(cf_[k].y) + bfhi(cb_[k].y)};
              const float v4[4] = {bflo(cv_[k].x), bfhi(cv_[k].x), bflo(cv_[k].y), bfhi(cv_[k].y)}, g4[4] = {bflo(cg_[k].x), bfhi(cg_[k].x), bflo(cg_[k].y), bfhi(cg_[k].y)};
              const float mean = grp_sum16((o[0] + o[1]) + (o[2] + o[3])) * (1.0f / 64.0f);
              float dl[4]; float sq = 0.f;
#pragma unroll
              for (int j = 0; j < 4; ++j) { dl[j] = o[j] - mean; sq += dl[j] * dl[j]; }
              const float var = grp_sum16(sq) * (1.0f / 64.0f); const float rs = 1.0f / sqrtf(var + GN_EPS); float y[4];
#pragma unroll
              for (int j = 0; j < 4; ++j) y[j] = (dl[j] * rs * gng[k][j] + gnb[k][j] + v4[j]) * g4[j];
              *(unsigned*)(Yo + (size_t)orow * D + 1280 + c) = pk4_fp8(y[0], y[1], y[2], y[3]); }
        }
    }
}

__global__ void __launch_bounds__(NTHREADS, 2) mk_fwd(Args args_unused) {
    extern __shared__ __attribute__((aligned(16))) unsigned char lds_raw[];
    LAS unsigned char* lds = (LAS unsigned char*)lds_raw;
    volatile LAS unsigned* misc = (volatile LAS unsigned*)(lds + LDS_MISC);
    const int tid = threadIdx.x, G = gridDim.x;
    if (tid < 64) misc[tid] = 0u;
    __syncthreads();
    XcdBarrier bar; bar.bar = nullptr; bar.x = 0; bar.st = nullptr;
    int lo, hi;
    { KArgs a = kargs(); lo = a->ph_lo; hi = a->ph_hi; unsigned* ctl = (unsigned*)(a->ws + WS_CTL); bar.bar = ctl + CW_BAR; if (!MK_MULTI) bar = xcd_barrier_post(ctl + CW_BAR, misc + 8); }
    const int cvirt = (G % 8 == 0) ? ((int)blockIdx.x % 8) * (G / 8) + (int)blockIdx.x / 8 : (int)blockIdx.x;
#define IN(k) (lo <= (k) && (k) < hi)
#define PM(b) ((PHMASK >> (b)) & 1)
#define REP(b) _Pragma("unroll 1") for (int rep_ = 0; rep_ < 1 + ((PROBE_DUP >> (b)) & 1); ++rep_)
#define SEAM(k) do { if (!MK_MULTI && IN(k) && IN((k) + 1)) { xcd_barrier(bar); if ((PROBE_DUP >> 13) & 1) xcd_barrier(bar); } } while (0)

    if (PM(0) && IN(0)) REP(0) { phase_prologue(kargs(), lds); } SEAM(0);

#pragma unroll 1
    for (int l = 0; l < DEPTH; ++l) {
        const int pb = 1 + 9 * l;
        const bool lastl = (l == DEPTH - 1);
        if (PM(1) && IN(pb + 0)) { if ((PROBE_DUP >> 1) & 1) { if (l == 0) phase_norm1<0>(kargs(), l, true); else phase_norm1<1>(kargs(), l, true); } if (l == 0) phase_norm1<0>(kargs(), l, false); else { phase_norm1<1>(kargs(), l, false); __syncthreads(); convert_moe(kargs(), l, lds); __syncthreads(); } } SEAM(pb + 0);
        if (PM(2) && IN(pb + 1)) REP(2) {
            KArgs a = kargs(); unsigned char* ws = a->ws;
            pg8::Gemm g{(const bf16*)(ws + WS_H), (const bf16*)(ws + WS_WIN + (size_t)l * INC * D), MALL, INC, D / 2};
            pg8::StaticOrder S; S.init(MALL, INC, G, (int)blockIdx.x);
            pg8::EpiBf16 E{(bf16*)(ws + WS_P), INC};
            pg8::gemm_phase8<pg8::EpiBf16, pg8::StaticOrder, false, false>(lds, g, S, E, nullptr);
        } SEAM(pb + 1);
        if (PM(3) && IN(pb + 2)) {
            const int ngm = lastl ? 1024 : 1088;
            unsigned* qhead = (unsigned*)(kargs()->ws + WS_CTL) + CW_PREPQ + 64 * l;
            const int n_rw = 544 * 3, n_hg = 3264, n_all = (G == 256) ? n_rw + n_hg : n_rw + n_hg + ngm;
            for (;;) {
                if (threadIdx.x == 0) misc[16] = __hip_atomic_fetch_add(qhead, 1u, __ATOMIC_RELAXED, __HIP_MEMORY_SCOPE_AGENT);
                LDS_BAR();
                const int it = (int)misc[16];
                if (it >= n_all) break;
                if (it < n_rw) { _Pragma("unroll 1") for (int r2 = 0; r2 < 1 + ((PROBE_DUP >> 15) & 1); ++r2) rwkv_prep_item(kargs(), l, it / 3, it % 3, lds, (((PROBE_DUP >> 15) & 1) && r2 == 0) ? RWP_SKIP : 0); }
                else if (it < n_rw + n_hg) { if ((PROBE_DUP >> 16) & 1) hgrn_prep_item(kargs(), l, it - n_rw, lds, true); hgrn_prep_item(kargs(), l, it - n_rw, lds, false); }
                else { _Pragma("unroll 1") for (int r2 = 0; r2 < 1 + ((PROBE_DUP >> 14) & 1); ++r2) gmlp_item(kargs(), l, it - n_rw - n_hg, lds); }
            }
            __syncthreads();
        } SEAM(pb + 2);
        if (PM(4) && IN(pb + 3)) REP(4) {
            if (G == 256) { const int bx = blockIdx.x;
                if (bx < 96) { _Pragma("unroll 1") for (int r2 = 0; r2 < 1 + ((PROBE_DUP >> 12) & 1); ++r2) rwkv_chain_mfma(kargs(), bx * 8, lds); }
                else if (bx < 192) { _Pragma("unroll 1") for (int r2 = 0; r2 < 1 + ((PROBE_DUP >> 11) & 1); ++r2) hgrn_chain_lean(kargs(), bx - 96, lds); }
                if (bx < 96 || bx >= 192) {
                    unsigned* gq = (unsigned*)(kargs()->ws + WS_CTL) + CW_GMQ + 64 * l; const int ngm2 = lastl ? 1024 : 1088;
                    for (;;) { if (threadIdx.x == 0) misc[17] = __hip_atomic_fetch_add(gq, 1u, __ATOMIC_RELAXED, __HIP_MEMORY_SCOPE_AGENT);
                        LDS_BAR(); const int it = (int)misc[17]; if (it >= ngm2) break; gmlp_item(kargs(), l, it, lds); }
                    __syncthreads(); } }
            else { for (int it = blockIdx.x; it < 192; it += G) { if (it < 96) rwkv_chain_mfma(kargs(), it * 8, lds); else hgrn_chain_lean(kargs(), it - 96, lds); } }
        } SEAM(pb + 3);
        if (PM(5) && IN(pb + 4)) { if ((PROBE_DUP >> 5) & 1) phase_finalize(kargs(), l, true); phase_finalize(kargs(), l, false); } SEAM(pb + 4);
        if (PM(6) && IN(pb + 5)) REP(6) {
            KArgs a = kargs(); unsigned char* ws = a->ws;
            const int Mo = lastl ? NLAT : MALL;
            pg8::Gemm g{(const bf16*)(ws + WS_Y8), (const bf16*)(ws + WS_WOUT + (size_t)l * D * D), Mo, D, D / 2};
            pg8::StaticOrder S; S.init(Mo, D, G, (int)blockIdx.x);
            const float* xl = a->in[I_X]; const float* xc = a->in[I_CTX];
            pg8::EpiResid E{xl, xc, (bf16*)(ws + WS_X), (const float*)(ws + WS_MOD) + (size_t)l * 9 * 12288 + 2 * D, l == 0};
            pg8::gemm_phase8<pg8::EpiResid, pg8::StaticOrder, true, false>(lds, g, S, E, nullptr);
        } SEAM(pb + 5);
        if (PM(7) && IN(pb + 6)) { if ((PROBE_DUP >> 7) & 1) phase_norm2_router(kargs(), l, true, lds); phase_norm2_router(kargs(), l, false, lds); } SEAM(pb + 6);
        if (PM(8) && IN(pb + 7)) REP(8) {
            KArgs a = kargs(); unsigned char* ws = a->ws;
            moe_tables<false>(a, l, lds, cvirt);
            pg8::Gemm g{(const bf16*)(ws + WS_H), (const bf16*)(ws + WS_WGU), 0, 2048, D / 2};
            pg8::MoeOrder S{(const LAS int*)(lds + LDS_TP), G, cvirt, (unsigned)(2048 * D)};
            pg8::EpiSwiglu E{ws + WS_ACT};
            pg8::gemm_phase8<pg8::EpiSwiglu, pg8::MoeOrder, false, true>(lds, g, S, E, (const LAS unsigned*)(lds + LDS_TAB));
        } SEAM(pb + 7);
        if (PM(9) && IN(pb + 8)) REP(9) {
            KArgs a = kargs(); unsigned char* ws = a->ws;
            moe_tables<true>(a, l, lds, cvirt);
            pg8::Gemm g{(const bf16*)(ws + WS_ACT), (const bf16*)(ws + WS_WDN), 0, D, DE / 2};
            pg8::MoeOrder S{(const LAS int*)(lds + LDS_TP), G, cvirt, (unsigned)(D * DE)};
            pg8::EpiDown E{ws + WS_YK, (const LAS unsigned*)(lds + LDS_TAB), (const LAS float*)(lds + LDS_TABW)};
            pg8::gemm_phase8<pg8::EpiDown, pg8::MoeOrder, false, false>(lds, g, S, E, nullptr);
        } SEAM(pb + 8);
    }
    if (PM(10) && IN(1 + 9 * DEPTH)) { if ((PROBE_DUP >> 10) & 1) phase_norm1<2>(kargs(), DEPTH, true); phase_norm1<2>(kargs(), DEPTH, false); }
#undef IN
#undef SEAM
}

extern "C" void kernel_launch(void* const* d_in, const int* in_sizes, int n_in, void* d_out, int out_size, void* d_ws, size_t ws_size, hipStream_t stream) {
    static int grid = 0;
    if (grid == 0) {
        if (n_in != 31 || ws_size < WS_END) { fprintf(stderr, "kernel_launch: unexpected n_in %d / ws %zu (need %zu)\n", n_in, ws_size, (size_t)WS_END); grid = -1; return; }
        int dev = 0, cus = 0, per_cu = 0;
        hipGetDevice(&dev); hipDeviceGetAttribute(&cus, hipDeviceAttributeMultiprocessorCount, dev);
        if (hipFuncSetAttribute((const void*)mk_fwd, hipFuncAttributeMaxDynamicSharedMemorySize, LDS_BYTES) != hipSuccess) { fprintf(stderr, "kernel_launch: hipFuncSetAttribute failed\n"); grid = -1; return; }
        if (hipOccupancyMaxActiveBlocksPerMultiprocessor(&per_cu, (const void*)mk_fwd, NTHREADS, LDS_BYTES) != hipSuccess || per_cu < 1) fprintf(stderr, "kernel_launch: occupancy query says %d\n", per_cu);
        (void)hipGetLastError();
        grid = cus > 0 ? cus : 256;
    }
    if (grid < 0) return;
    hipMemsetAsync((char*)d_ws + WS_CTL, 0, CTL_ZERO_BYTES, stream);
    Args a{};
    for (int i = 0; i < 31; ++i) a.in[i] = (const float*)d_in[i];
    a.out = (float*)d_out; a.ws = (unsigned char*)d_ws;
    constexpr int NPH = 2 + 9 * DEPTH;
#if MK_MULTI
    for (int p = 0; p < NPH; ++p) { a.ph_lo = p; a.ph_hi = p + 1; hipLaunchKernelGGL(mk_fwd, dim3(grid), dim3(NTHREADS), LDS_BYTES, stream, a); }
#else
    a.ph_lo = 0; a.ph_hi = NPH; hipLaunchKernelGGL(mk_fwd, dim3(grid), dim3(NTHREADS), LDS_BYTES, stream, a);
#endif
}
```

```cpp
#include <hip/hip_runtime.h>
#include <cstdio>
#include <cstdint>

#ifndef PHMASK
#define PHMASK 0xFFFF
#endif
#ifndef PROBE_DUP
#define PROBE_DUP 0
#endif
#ifndef MK_MULTI
#define MK_MULTI 0
#endif

#define GAS __attribute__((address_space(1)))
#define LAS __attribute__((address_space(3)))
typedef unsigned short bf16;
typedef short bf16x8 __attribute__((ext_vector_type(8)));
typedef float f32x4 __attribute__((ext_vector_type(4)));
typedef float f32x2 __attribute__((ext_vector_type(2)));
typedef unsigned u32x4 __attribute__((ext_vector_type(4)));
typedef unsigned u32x2 __attribute__((ext_vector_type(2)));

constexpr int D = 2048, NB = 8, T = 4096, CTXL = 256, DEPTH = 2;
constexpr int NLAT = NB * T, NCTX = NB * CTXL, MALL = NLAT + NCTX;
constexpr int INC = 7424;
constexpr int OFF_U = 0, OFF_V = 512, OFF_Q = 1024, OFF_I = 1792, OFF_ZF = 2560, OFF_ZB = 3328, OFF_OG = 4096;
constexpr int OFF_C = 4864;
constexpr int BW = 768, CW = 768, CCOLS = 2560;
constexpr int NE = 16, DE = 1024;
constexpr int PC2W = 7 * 768;
constexpr int NTHREADS = 512;
constexpr float NORM_EPS = 1e-6f, GN_EPS = 64e-5f, DECAY_SCALE = 0.60653065971263342f;

constexpr size_t MiB = 1u << 20;
constexpr size_t WS_CTL = 0, CTL_ZERO_BYTES = 1 * MiB;
constexpr size_t WS_MOD = 1 * MiB;
constexpr size_t WS_SMALLW = 2 * MiB;
constexpr size_t SW_WUP = 0, SW_AUP = SW_WUP + (size_t)2 * 2 * 768 * 64 * 2, SW_GUP = SW_AUP + (size_t)2 * 768 * 64 * 2, SW_GWS = SW_GUP + (size_t)2 * 768 * 128 * 2;
constexpr size_t WS_WIN = 4 * MiB, WS_WOUT = 62 * MiB, WS_WGU = 78 * MiB, WS_WDN = 142 * MiB, WS_Y8 = 174 * MiB;
constexpr size_t WS_X = 270 * MiB, WS_H = 542 * MiB, WS_Y = 678 * MiB, WS_P = 814 * MiB, WS_PRE = 1307 * MiB, WS_VT = 1817 * MiB, WS_OC = 1868 * MiB, WS_HQB = 1970 * MiB, WS_HG = 2021 * MiB, WS_END = 2028 * MiB;
constexpr int PRE_REC = 10240, PR_WP = 0, PR_RP = 2048, PR_BK = 4096, PR_ARBK = 8192, PR_MAK = 9216, PR_GAM = 9728, NCHUNK16 = 272;
constexpr size_t WS_OB = WS_H;
constexpr size_t WS_ACT = WS_P, WS_YK = WS_P + 144 * MiB, WS_RIDX = WS_P + 416 * MiB, WS_RW = WS_RIDX + 3 * MiB;
static_assert(WS_RW + 3 * MiB <= WS_PRE, "moe overlay");
constexpr int MAXSLOT_TILES = 288;
constexpr int CW_BAR = 4096;
constexpr int CW_GMQ = 30720;
constexpr int CW_PREPQ = 28672;
constexpr int CW_CNT = 16384;

constexpr int LDS_STAGE = 0, LDS_TAB = 131072, LDS_TABW = LDS_TAB + 9 * 1024, LDS_TP = LDS_TABW + 9 * 1024, LDS_MISC = 150528, LDS_BYTES = 152 * 1024;
static_assert(LDS_TP + 128 <= LDS_MISC, "lds map");

typedef __bf16 bf16x2_t __attribute__((ext_vector_type(2)));
__device__ __forceinline__ unsigned pk2(float lo, float hi) { const f32x2 v = {lo, hi}; return __builtin_bit_cast(unsigned, __builtin_convertvector(v, bf16x2_t)); }
__device__ __forceinline__ unsigned f2bf(float f) { return pk2(f, f) & 0xffffu; }
__device__ __forceinline__ unsigned pk4_fp8(float a, float b, float c, float d) {
    a = __builtin_amdgcn_fmed3f(a, -448.f, 448.f); b = __builtin_amdgcn_fmed3f(b, -448.f, 448.f); c = __builtin_amdgcn_fmed3f(c, -448.f, 448.f); d = __builtin_amdgcn_fmed3f(d, -448.f, 448.f);
    int p = 0; p = __builtin_amdgcn_cvt_pk_fp8_f32(a, b, p, false); p = __builtin_amdgcn_cvt_pk_fp8_f32(c, d, p, true); return (unsigned)p; }
__device__ __forceinline__ float bflo(unsigned u) { return __builtin_bit_cast(float, u << 16); }
__device__ __forceinline__ float bfhi(unsigned u) { return __builtin_bit_cast(float, u & 0xffff0000u); }
__device__ __forceinline__ float bf1(bf16 b) { return __builtin_bit_cast(float, ((unsigned)b) << 16); }
__device__ __forceinline__ float sigmoidf_(float x) { return __builtin_amdgcn_rcpf(1.0f + __expf(-x)); }
__device__ __forceinline__ float siluf_(float x) { return x * __builtin_amdgcn_rcpf(1.0f + __expf(-x)); }
__device__ __forceinline__ float geluf_(float v) {
    const float av = fabsf(v), t = __builtin_amdgcn_rcpf(av * 0.2316418882f + 1.0f);
    float q = t * 0.5307027145f + (-0.7265760135f); q = q * t + 0.7107068705f; q = q * t + (-0.142248368f); q = q * t + 0.127414796f; q = q * t;
    const float e = __builtin_amdgcn_exp2f((v * v) * (-0.72134752044f)); const float m = v * (q * e); return v < 0.f ? m : v - m; }
__device__ __forceinline__ float wave_sum(float v) {
#pragma unroll
    for (int o = 1; o < 64; o <<= 1) v += __shfl_xor(v, o);
    return v;
}
__device__ __forceinline__ int tid_fresh() { int t = threadIdx.x; asm volatile("" : "+v"(t)); return t; }
__device__ __forceinline__ void unpack8(const u32x4 v, float (&f)[8]) {
    f[0] = bflo(v.x); f[1] = bfhi(v.x); f[2] = bflo(v.y); f[3] = bfhi(v.y); f[4] = bflo(v.z); f[5] = bfhi(v.z); f[6] = bflo(v.w); f[7] = bfhi(v.w);
}
__device__ __forceinline__ u32x4 pack8(const float (&f)[8]) { u32x4 v; v.x = pk2(f[0], f[1]); v.y = pk2(f[2], f[3]); v.z = pk2(f[4], f[5]); v.w = pk2(f[6], f[7]); return v; }
__device__ __forceinline__ int modrow_of(int row) { return row < NLAT ? (row >> 12) : 8; }

#define XB_TMO      128
#define XB_XCNT(j)  (256  + 64 * (j))
#define XB_XSUB(j)  (1280 + 64 * (j))
#define XB_XGEN(j)  (2304 + 64 * (j))
#define XB_TOP      3328
#define XB_TOPGEN   3392
#define XCD_BAR_WORDS 3456
#define XB_SPIN_CAP (1u << 18)
__device__ __forceinline__ unsigned xb_ld(unsigned* p)              { return __hip_atomic_load(p, __ATOMIC_RELAXED, __HIP_MEMORY_SCOPE_AGENT); }
__device__ __forceinline__ unsigned xb_add(unsigned* p, unsigned v) { return __hip_atomic_fetch_add(p, v, __ATOMIC_RELAXED, __HIP_MEMORY_SCOPE_AGENT); }
__device__ __forceinline__ unsigned xb_xcc_id() { return (unsigned)__builtin_amdgcn_s_getreg((3 << 11) | 20) & 0xFu; }
#define XB_SPIN(cond, bar) do { unsigned _sp = 0; while (cond) { __builtin_amdgcn_s_sleep(1); \
    if ((++_sp & 255u) == 0u) { if (xb_ld(&(bar)[XB_TMO])) break; if (_sp > XB_SPIN_CAP) { atomicAdd(&(bar)[XB_TMO], 1u); break; } } } } while (0)
struct XcdBarrier { unsigned* bar; unsigned x; volatile LAS unsigned* st; };
__device__ __forceinline__ XcdBarrier xcd_barrier_post(unsigned* bar, volatile LAS unsigned* st) {
    XcdBarrier b; b.bar = bar; b.x = xb_xcc_id(); b.st = st;
    if (threadIdx.x == 0) (void)xb_add(&bar[XB_XCNT(b.x)], 1u);
    return b;
}
__device__ __forceinline__ void xcd_barrier_complete(unsigned* bar, unsigned x, unsigned& nloc, unsigned& nx) {
    const unsigned G = gridDim.x * gridDim.y * gridDim.z;
    unsigned sum, cnt, mine, sp = 0u;
    for (;;) {
        sum = 0u; cnt = 0u; mine = 0u;
#pragma unroll
        for (unsigned j = 0; j < 16; ++j) { const unsigned c = xb_ld(&bar[XB_XCNT(j)]); sum += c; cnt += (c > 0u) ? 1u : 0u; mine = (j == x) ? c : mine; }
        if (sum == G) break;
        __builtin_amdgcn_s_sleep(1);
        if ((++sp & 255u) == 0u) { if (xb_ld(&bar[XB_TMO])) break; if (sp > XB_SPIN_CAP) { atomicAdd(&bar[XB_TMO], 1u); break; } }
    }
    nloc = mine > 0u ? mine : 1u; nx = cnt > 0u ? cnt : 1u;
}
__device__ __forceinline__ void xcd_barrier(const XcdBarrier& b) {
    asm volatile("s_waitcnt vmcnt(0)" ::: "memory");
    __syncthreads();
    if (threadIdx.x == 0) {
        unsigned* bar = b.bar;
        __builtin_amdgcn_s_waitcnt(0);
        unsigned nloc = b.st[0], nx = b.st[1];
        if (nloc == 0u) { xcd_barrier_complete(bar, b.x, nloc, nx); b.st[0] = nloc; b.st[1] = nx; }
        const unsigned old = xb_add(&bar[XB_XSUB(b.x)], 1u);
        const unsigned gen = old / nloc;
        if (old + 1u == (gen + 1u) * nloc) {
            __builtin_amdgcn_fence(__ATOMIC_RELEASE, "agent");
            asm volatile("s_waitcnt vmcnt(0)" ::: "memory");
            const unsigned og = xb_add(&bar[XB_TOP], 1u);
            const unsigned tg = og / nx;
            if (og + 1u == (tg + 1u) * nx) xb_add(&bar[XB_TOPGEN], 1u);
            else XB_SPIN(xb_ld(&bar[XB_TOPGEN]) == tg, bar);
            __builtin_amdgcn_fence(__ATOMIC_ACQUIRE, "agent");
            xb_add(&bar[XB_XGEN(b.x)], 1u);
            asm volatile("s_waitcnt vmcnt(0)" ::: "memory");
        } else {
            XB_SPIN(xb_ld(&bar[XB_XGEN(b.x)]) == gen, bar);
            __builtin_amdgcn_fence(__ATOMIC_ACQUIRE, "agent");
            asm volatile("s_waitcnt vmcnt(0)" ::: "memory");
        }
    }
    __syncthreads();
}

namespace pg8 {
constexpr int BM = 256, BK = 64, HALF = 128, HTB = HALF * BK * 2, STAGE_BYTES = 8 * HTB, NXCD = 8, WGM = 8;
__host__ __device__ __forceinline__ int lds_byte(int r, int c) { const int st = (r >> 4) * 2 + (c >> 5), rr = r & 15, cc = c & 31, ob = rr * 64 + cc * 2; return st * 1024 + (ob ^ (((ob >> 9) & 1) << 5)); }
__host__ __device__ __forceinline__ void stage_rc(int b, int& R, int& C) { const int st = b / 1024, sb = b % 1024, swz = sb ^ (((sb >> 9) & 1) << 5); R = (st >> 1) * 16 + swz / 64; C = (st & 1) * 32 + (swz % 64) / 2; }
__host__ __device__ __forceinline__ int perm32(int rho) { const int n = rho >> 4, i = rho & 15; return 8 * (i >> 2) + 4 * n + (i & 3); }

struct Unit { int pm, pn, e, aux; };
struct Gemm { const bf16* A; const bf16* Bt; int M, N, K; };

struct StaticOrder {
    int nM, nN, nwg, G, c;
    __device__ void init(int M, int N, int G_, int c_) { nM = M / BM; nN = N / BM; nwg = nM * nN; G = G_; c = c_; }
    __device__ bool next(int i, Unit& u) const {
        const long L = (long)i * G + c; if (L >= nwg) return false;
        int wgid = (int)L; { const int q = nwg / NXCD, r = nwg % NXCD, xcd = wgid % NXCD, off = wgid / NXCD; wgid = (xcd < r ? xcd * (q + 1) : r * (q + 1) + (xcd - r) * q) + off; }
        const int nig = WGM * nN, gid = wgid / nig, fm = gid * WGM, gsz = (nM - fm) < WGM ? (nM - fm) : WGM;
        u.pm = fm + ((wgid % nig) % gsz); u.pn = (wgid % nig) / gsz; u.e = 0; u.aux = 0; return true;
    }
    __device__ __forceinline__ unsigned b_off(const Unit& u, unsigned tstep) const { return (unsigned)u.pn * tstep; }
};
struct MoeOrder {
    const LAS int* tp; int G, c; unsigned estride;
    __device__ bool next(int i, Unit& u) const {
        const int L = i * G + c; const int ntot = tp[16] * 8; if (L >= ntot) return false;
        const int tile = L >> 3; int e = 0;
#pragma unroll
        for (int j = 1; j < 16; ++j) e += (tile >= tp[j]) ? 1 : 0;
        u.pm = tile; u.pn = L & 7; u.e = e; u.aux = i; return true;
    }
    __device__ __forceinline__ unsigned b_off(const Unit& u, unsigned tstep) const { return (unsigned)u.e * estride + (unsigned)u.pn * tstep; }
};

#define PG8_LAS __attribute__((address_space(3)))
template <class Epi, class Sched, bool ALIGN_EPI, bool GATHER>
__device__ __forceinline__ void gemm_phase(PG8_LAS unsigned char* lds, const Gemm g, const Sched& S, const Epi& E, const PG8_LAS unsigned* tabA) {
    const int tid = tid_fresh(), wid = __builtin_amdgcn_readfirstlane(tid >> 6), lane = tid & 63, wr = wid >> 2, wc = wid & 3, fr = lane & 15, fq = lane >> 4;
    const int K = g.K, nt = K / BK;
    int sR[2], sC[2];
    unsigned voffB[2];
#pragma unroll
    for (int i = 0; i < 2; ++i) { int R, C; stage_rc(tid * 16 + i * 8192, R, C); sR[i] = R; sC[i] = C; const int Rb = Epi::PERM ? ((R & ~31) + perm32(R & 31)) : R;
        voffB[i] = (unsigned)(Rb * K + C) * 2u; }
    const unsigned kstep = (unsigned)(BK * 2);
    const unsigned hstep = (unsigned)(HALF * K * 2);
    const unsigned tstep = 2u * hstep;
    const unsigned ldsw = (unsigned)wid * 1024u;
    const char* const baseA = (const char*)g.A; const char* const baseB = (const char*)g.Bt;
    const int aoff = lds_byte(wr * 64 + fr, fq * 8), boff = lds_byte(wc * 32 + fr, fq * 8);
#define PG8_SA(b, h) (((b) * 2 + (h)) * HTB)
#define PG8_SB(b, h) ((4 + (b) * 2 + (h)) * HTB)
#define PG8_STAGE(bufoff, gbase, uoff, voff) do { _Pragma("unroll") for (int _i = 0; _i < 2; ++_i) \
        __builtin_amdgcn_global_load_lds((const unsigned*)((gbase) + (size_t)(unsigned)((uoff) + (voff)[_i])), (PG8_LAS unsigned*)(lds + (bufoff) + ldsw + _i * 8192), 16, 0, 0); } while (0)
#define PG8_LDA(dst, b, h) do { _Pragma("unroll") for (int m = 0; m < 4; ++m) _Pragma("unroll") for (int k = 0; k < 2; ++k) dst[m][k] = *(const PG8_LAS bf16x8*)(lds + PG8_SA(b, h) + aoff + m * 2048 + k * 1024); } while (0)
#define PG8_LDB(dst, b, h) do { _Pragma("unroll") for (int n = 0; n < 2; ++n) _Pragma("unroll") for (int k = 0; k < 2; ++k) dst[n][k] = *(const PG8_LAS bf16x8*)(lds + PG8_SB(b, h) + boff + n * 2048 + k * 1024); } while (0)
#define PG8_MMA(ai, bj, At, Bt) do { __builtin_amdgcn_s_setprio(1); _Pragma("unroll") for (int m = 0; m < 4; ++m) _Pragma("unroll") for (int n = 0; n < 2; ++n) _Pragma("unroll") for (int k = 0; k < 2; ++k) \
        acc[ai][bj][m][n] = __builtin_amdgcn_mfma_f32_16x16x32_bf16(Bt[n][k], At[m][k], acc[ai][bj][m][n], 0, 0, 0); __builtin_amdgcn_s_setprio(0); } while (0)
#define PG8_WAIT_V(n) asm volatile("s_waitcnt vmcnt(" #n ")" ::: "memory")
#define PG8_WAIT_L(n) asm volatile("s_waitcnt lgkmcnt(" #n ")" ::: "memory")
#define PG8_BAR __builtin_amdgcn_s_barrier()
#define PG8_SCHED __builtin_amdgcn_sched_barrier(0)
    Unit cur, nxt; int ui = 0;
    if (!S.next(0, cur)) return;
    f32x4 acc[2][2][4][2];
#pragma unroll
    for (int a = 0; a < 2; ++a)
#pragma unroll
        for (int b = 0; b < 2; ++b)
#pragma unroll
            for (int m = 0; m < 4; ++m)
#pragma unroll
                for (int n = 0; n < 2; ++n) acc[a][b][m][n] = (f32x4){0.f, 0.f, 0.f, 0.f};
    bf16x8 At[4][2], B0[2][2], B1[2][2];
    unsigned vA0[2], vA1[2], nA0[2], nA1[2];
    unsigned uA, uB = S.b_off(cur, tstep);
    if constexpr (GATHER) { uA = 0u;
#pragma unroll
        for (int i = 0; i < 2; ++i) { vA0[i] = tabA[cur.aux * 256 + sR[i]] + (unsigned)sC[i] * 2u; vA1[i] = tabA[cur.aux * 256 + 128 + sR[i]] + (unsigned)sC[i] * 2u; }
    } else { uA = (unsigned)cur.pm * tstep;
#pragma unroll
        for (int i = 0; i < 2; ++i) { vA0[i] = (unsigned)(sR[i] * K + sC[i]) * 2u; vA1[i] = vA0[i] + hstep; }
    }
    PG8_STAGE(PG8_SB(0, 0), baseB, uB, voffB); PG8_STAGE(PG8_SB(0, 1), baseB, uB + hstep, voffB); PG8_STAGE(PG8_SA(0, 0), baseA, uA, vA0); PG8_STAGE(PG8_SA(0, 1), baseA, uA, vA1);
    if (wr == 1) PG8_BAR;
    PG8_WAIT_V(2); PG8_BAR;
    PG8_STAGE(PG8_SB(1, 0), baseB, uB + kstep, voffB); PG8_STAGE(PG8_SA(1, 0), baseA, uA + kstep, vA0); PG8_STAGE(PG8_SB(1, 1), baseB, uB + hstep + kstep, voffB);
    PG8_WAIT_V(6); PG8_BAR;
    for (;;) {
        const bool has_next = S.next(ui + 1, nxt);
        unsigned nuA, nuB = has_next ? S.b_off(nxt, tstep) : uB;
        if constexpr (GATHER) { nuA = 0u;
#pragma unroll
            for (int i = 0; i < 2; ++i) { if (has_next) { nA0[i] = tabA[nxt.aux * 256 + sR[i]] + (unsigned)sC[i] * 2u; nA1[i] = tabA[nxt.aux * 256 + 128 + sR[i]] + (unsigned)sC[i] * 2u; } else { nA0[i] = vA0[i]; nA1[i] = vA1[i]; } }
        } else { nuA = has_next ? (unsigned)nxt.pm * tstep : uA;
#pragma unroll
            for (int i = 0; i < 2; ++i) { nA0[i] = vA0[i]; nA1[i] = vA1[i]; }
        }
#pragma unroll 1
        for (int t = 0; t < nt; t += 2) {
            const bool last = (t == nt - 2);
            const unsigned a1 = uA + (unsigned)(t + 1) * kstep;
            const unsigned a2 = last ? nuA : uA + (unsigned)(t + 2) * kstep; const unsigned b2 = last ? nuB : uB + (unsigned)(t + 2) * kstep;
            const unsigned a3 = a2 + kstep; const unsigned b3 = b2 + kstep;
            unsigned w0[2], w1[2];
#pragma unroll
            for (int i = 0; i < 2; ++i) { w0[i] = (GATHER && last) ? nA0[i] : vA0[i]; w1[i] = (GATHER && last) ? nA1[i] : vA1[i]; }
            PG8_LDB(B0, 0, 0); PG8_LDB(B1, 0, 1); PG8_SCHED; PG8_LDA(At, 0, 0); PG8_STAGE(PG8_SA(1, 1), baseA, a1, vA1);
            PG8_WAIT_V(8); PG8_WAIT_L(0); PG8_BAR; PG8_MMA(0, 0, At, B0); PG8_MMA(0, 1, At, B1); PG8_BAR; PG8_SCHED;
            PG8_LDA(At, 0, 1); PG8_STAGE(PG8_SB(0, 0), baseB, b2, voffB); PG8_STAGE(PG8_SB(0, 1), baseB, b2 + hstep, voffB); PG8_STAGE(PG8_SA(0, 0), baseA, a2, w0);
            PG8_WAIT_V(8); PG8_WAIT_L(0); PG8_BAR; PG8_MMA(1, 0, At, B0); PG8_MMA(1, 1, At, B1); PG8_BAR; PG8_SCHED;
            PG8_LDB(B0, 1, 0); PG8_LDB(B1, 1, 1); PG8_SCHED; PG8_LDA(At, 1, 0); PG8_STAGE(PG8_SA(0, 1), baseA, a2, w1);
            PG8_WAIT_V(8); PG8_WAIT_L(0); PG8_BAR; PG8_MMA(0, 0, At, B0); PG8_MMA(0, 1, At, B1); PG8_BAR; PG8_SCHED;
            PG8_LDA(At, 1, 1); PG8_STAGE(PG8_SB(1, 0), baseB, b3, voffB); PG8_STAGE(PG8_SB(1, 1), baseB, b3 + hstep, voffB); PG8_STAGE(PG8_SA(1, 0), baseA, a3, w0);
            PG8_WAIT_V(8); PG8_WAIT_L(0); PG8_BAR; PG8_MMA(1, 0, At, B0); PG8_MMA(1, 1, At, B1); PG8_BAR; PG8_SCHED;
        }
        if constexpr (ALIGN_EPI) { if (wr == 0) PG8_BAR; }
        E(acc, cur, wr, wc, fr, fq);
        if (!has_next) break;
#pragma unroll
        for (int a = 0; a < 2; ++a)
#pragma unroll
            for (int b = 0; b < 2; ++b)
#pragma unroll
                for (int m = 0; m < 4; ++m)
#pragma unroll
                    for (int n = 0; n < 2; ++n) acc[a][b][m][n] = (f32x4){0.f, 0.f, 0.f, 0.f};
        cur = nxt; uA = nuA; uB = nuB; ++ui;
#pragma unroll
        for (int i = 0; i < 2; ++i) { vA0[i] = nA0[i]; vA1[i] = nA1[i]; }
        if constexpr (ALIGN_EPI) { if (wr == 1) PG8_BAR; }
    }
    PG8_WAIT_V(0);
    if constexpr (!ALIGN_EPI) { if (wr == 0) PG8_BAR; }
    PG8_BAR;
#undef PG8_SA
#undef PG8_SB
#undef PG8_STAGE
#undef PG8_LDA
#undef PG8_LDB
#undef PG8_MMA
#undef PG8_WAIT_V
#undef PG8_WAIT_L
#undef PG8_BAR
#undef PG8_SCHED
}

typedef int i32x8v __attribute__((ext_vector_type(8)));
typedef int i32x4v __attribute__((ext_vector_type(4)));
template <class Epi, class Sched, bool ALIGN_EPI, bool GATHER>
__device__ __forceinline__ void gemm_phase8(PG8_LAS unsigned char* lds, const Gemm g, const Sched& S, const Epi& E, const PG8_LAS unsigned* tabA) {
    const int tid = tid_fresh(), wid = __builtin_amdgcn_readfirstlane(tid >> 6), lane = tid & 63, wr = wid >> 2, wc = wid & 3, fr = lane & 15, fq = lane >> 4;
    const int K = g.K, nt = K / BK;
    int sR[2], sC[2];
    unsigned voffB[2];
#pragma unroll
    for (int i = 0; i < 2; ++i) { int R, C; stage_rc(tid * 16 + i * 8192, R, C); sR[i] = R; sC[i] = C; const int Rb = Epi::PERM ? ((R & ~31) + perm32(R & 31)) : R;
        voffB[i] = (unsigned)(Rb * K + C) * 2u; }
    const unsigned kstep = (unsigned)(BK * 2);
    const unsigned hstep = (unsigned)(HALF * K * 2);
    const unsigned tstep = 2u * hstep;
    const unsigned ldsw = (unsigned)wid * 1024u;
    const char* const baseA = (const char*)g.A; const char* const baseB = (const char*)g.Bt;
    const int kc = 32 * (fq >> 1) + 8 * (fq & 1);
    const int aoff = lds_byte(wr * 64 + fr, kc), aoff2 = lds_byte(wr * 64 + fr, kc + 16), boff = lds_byte(wc * 32 + fr, kc), boff2 = lds_byte(wc * 32 + fr, kc + 16);
#define PG8_SA(b, h) (((b) * 2 + (h)) * HTB)
#define PG8_SB(b, h) ((4 + (b) * 2 + (h)) * HTB)
#define PG8_STAGE(bufoff, gbase, uoff, voff) do { _Pragma("unroll") for (int _i = 0; _i < 2; ++_i) \
        __builtin_amdgcn_global_load_lds((const unsigned*)((gbase) + (size_t)(unsigned)((uoff) + (voff)[_i])), (PG8_LAS unsigned*)(lds + (bufoff) + ldsw + _i * 8192), 16, 0, 0); } while (0)
#define PG8_LD32(p, q) __builtin_shufflevector(*(const PG8_LAS i32x4v*)(p), *(const PG8_LAS i32x4v*)(q), 0, 1, 2, 3, 4, 5, 6, 7)
#define PG8_LDA(dst, b, h) do { _Pragma("unroll") for (int m = 0; m < 4; ++m) dst[m] = PG8_LD32(lds + PG8_SA(b, h) + aoff + m * 2048, lds + PG8_SA(b, h) + aoff2 + m * 2048); } while (0)
#define PG8_LDB(dst, b, h) do { _Pragma("unroll") for (int n = 0; n < 2; ++n) dst[n] = PG8_LD32(lds + PG8_SB(b, h) + boff + n * 2048, lds + PG8_SB(b, h) + boff2 + n * 2048); } while (0)
#define PG8_MMA(ai, bj, At, Bt) do { __builtin_amdgcn_s_setprio(1); _Pragma("unroll") for (int m = 0; m < 4; ++m) _Pragma("unroll") for (int n = 0; n < 2; ++n) \
        asm volatile("v_mfma_scale_f32_16x16x128_f8f6f4 %0, %1, %2, %0, %3, %4 op_sel_hi:[0,0,0]" : "+v"(acc[ai][bj][m][n]) : "v"(Bt[n]), "v"(At[m]), "v"(scw), "v"(sca)); __builtin_amdgcn_s_setprio(0); } while (0)
#define PG8_MFMA_DRAIN asm volatile("s_nop 15\n\ts_nop 15\n\ts_nop 15" ::: "memory")
#define PG8_WAIT_V(n) asm volatile("s_waitcnt vmcnt(" #n ")" ::: "memory")
#define PG8_WAIT_L(n) asm volatile("s_waitcnt lgkmcnt(" #n ")" ::: "memory")
#define PG8_BAR __builtin_amdgcn_s_barrier()
#define PG8_SCHED __builtin_amdgcn_sched_barrier(0)
    Unit cur, nxt; int ui = 0;
    if (!S.next(0, cur)) return;
    f32x4 acc[2][2][4][2];
#pragma unroll
    for (int a = 0; a < 2; ++a)
#pragma unroll
        for (int b = 0; b < 2; ++b)
#pragma unroll
            for (int m = 0; m < 4; ++m)
#pragma unroll
                for (int n = 0; n < 2; ++n) acc[a][b][m][n] = (f32x4){0.f, 0.f, 0.f, 0.f};
    i32x8v At[4], B0[2], B1[2];
    int scw = 0x7a7a7a7a, sca = 0x7f7f7f7f;
    asm volatile("" : "+v"(scw), "+v"(sca));
    unsigned vA0[2], vA1[2], nA0[2], nA1[2];
    unsigned uA, uB = S.b_off(cur, tstep);
    if constexpr (GATHER) { uA = 0u;
#pragma unroll
        for (int i = 0; i < 2; ++i) { vA0[i] = tabA[cur.aux * 256 + sR[i]] + (unsigned)sC[i] * 2u; vA1[i] = tabA[cur.aux * 256 + 128 + sR[i]] + (unsigned)sC[i] * 2u; }
    } else { uA = (unsigned)cur.pm * tstep;
#pragma unroll
        for (int i = 0; i < 2; ++i) { vA0[i] = (unsigned)(sR[i] * K + sC[i]) * 2u; vA1[i] = vA0[i] + hstep; }
    }
    PG8_STAGE(PG8_SB(0, 0), baseB, uB, voffB); PG8_STAGE(PG8_SB(0, 1), baseB, uB + hstep, voffB); PG8_STAGE(PG8_SA(0, 0), baseA, uA, vA0); PG8_STAGE(PG8_SA(0, 1), baseA, uA, vA1);
    if (wr == 1) PG8_BAR;
    PG8_WAIT_V(2); PG8_BAR;
    PG8_STAGE(PG8_SB(1, 0), baseB, uB + kstep, voffB); PG8_STAGE(PG8_SA(1, 0), baseA, uA + kstep, vA0); PG8_STAGE(PG8_SB(1, 1), baseB, uB + hstep + kstep, voffB);
    PG8_WAIT_V(6); PG8_BAR;
    for (;;) {
        const bool has_next = S.next(ui + 1, nxt);
        unsigned nuA, nuB = has_next ? S.b_off(nxt, tstep) : uB;
        if constexpr (GATHER) { nuA = 0u;
#pragma unroll
            for (int i = 0; i < 2; ++i) { if (has_next) { nA0[i] = tabA[nxt.aux * 256 + sR[i]] + (unsigned)sC[i] * 2u; nA1[i] = tabA[nxt.aux * 256 + 128 + sR[i]] + (unsigned)sC[i] * 2u; } else { nA0[i] = vA0[i]; nA1[i] = vA1[i]; } }
        } else { nuA = has_next ? (unsigned)nxt.pm * tstep : uA;
#pragma unroll
            for (int i = 0; i < 2; ++i) { nA0[i] = vA0[i]; nA1[i] = vA1[i]; }
        }
#pragma unroll 1
        for (int t = 0; t < nt; t += 2) {
            const bool last = (t == nt - 2);
            const unsigned a1 = uA + (unsigned)(t + 1) * kstep;
            const unsigned a2 = last ? nuA : uA + (unsigned)(t + 2) * kstep; const unsigned b2 = last ? nuB : uB + (unsigned)(t + 2) * kstep;
            const unsigned a3 = a2 + kstep; const unsigned b3 = b2 + kstep;
            unsigned w0[2], w1[2];
#pragma unroll
            for (int i = 0; i < 2; ++i) { w0[i] = (GATHER && last) ? nA0[i] : vA0[i]; w1[i] = (GATHER && last) ? nA1[i] : vA1[i]; }
            PG8_LDB(B0, 0, 0); PG8_LDB(B1, 0, 1); PG8_SCHED; PG8_LDA(At, 0, 0); PG8_STAGE(PG8_SA(1, 1), baseA, a1, vA1);
            PG8_WAIT_V(8); PG8_WAIT_L(0); PG8_BAR; PG8_MMA(0, 0, At, B0); PG8_MMA(0, 1, At, B1); PG8_BAR; PG8_SCHED;
            PG8_LDA(At, 0, 1); PG8_STAGE(PG8_SB(0, 0), baseB, b2, voffB); PG8_STAGE(PG8_SB(0, 1), baseB, b2 + hstep, voffB); PG8_STAGE(PG8_SA(0, 0), baseA, a2, w0);
            PG8_WAIT_V(8); PG8_WAIT_L(0); PG8_BAR; PG8_MMA(1, 0, At, B0); PG8_MMA(1, 1, At, B1); PG8_BAR; PG8_SCHED;
            PG8_LDB(B0, 1, 0); PG8_LDB(B1, 1, 1); PG8_SCHED; PG8_LDA(At, 1, 0); PG8_STAGE(PG8_SA(0, 1), baseA, a2, w1);
            PG8_WAIT_V(8); PG8_WAIT_L(0); PG8_BAR; PG8_MMA(0, 0, At, B0); PG8_MMA(0, 1, At, B1); PG8_BAR; PG8_SCHED;
            PG8_LDA(At, 1, 1); PG8_STAGE(PG8_SB(1, 0), baseB, b3, voffB); PG8_STAGE(PG8_SB(1, 1), baseB, b3 + hstep, voffB); PG8_STAGE(PG8_SA(1, 0), baseA, a3, w0);
            PG8_WAIT_V(8); PG8_WAIT_L(0); PG8_BAR; PG8_MMA(1, 0, At, B0); PG8_MMA(1, 1, At, B1); PG8_BAR; PG8_SCHED;
        }
        if constexpr (ALIGN_EPI) { if (wr == 0) PG8_BAR; }
        PG8_MFMA_DRAIN;
        { const int l2 = tid_fresh() & 63; E(acc, cur, wr, wc, l2 & 15, l2 >> 4); }
        if (!has_next) break;
#pragma unroll
        for (int a = 0; a < 2; ++a)
#pragma unroll
            for (int b = 0; b < 2; ++b)
#pragma unroll
                for (int m = 0; m < 4; ++m)
#pragma unroll
                    for (int n = 0; n < 2; ++n) acc[a][b][m][n] = (f32x4){0.f, 0.f, 0.f, 0.f};
        cur = nxt; uA = nuA; uB = nuB; ++ui;
#pragma unroll
        for (int i = 0; i < 2; ++i) { vA0[i] = nA0[i]; vA1[i] = nA1[i]; }
        if constexpr (ALIGN_EPI) { if (wr == 1) PG8_BAR; }
    }
    PG8_WAIT_V(0);
    if constexpr (!ALIGN_EPI) { if (wr == 0) PG8_BAR; }
    PG8_BAR;
#undef PG8_SA
#undef PG8_SB
#undef PG8_STAGE
#undef PG8_LDA
#undef PG8_LD32
#undef PG8_LDB
#undef PG8_MMA
#undef PG8_MFMA_DRAIN
#undef PG8_WAIT_V
#undef PG8_WAIT_L
#undef PG8_BAR
#undef PG8_SCHED
}

__device__ __forceinline__ unsigned cvt_pk_bf16(float lo, float hi) { return pk2(lo, hi); }

struct EpiBf16 {
    static constexpr bool PERM = true;
    bf16* O; int ldc;
    __device__ __forceinline__ void operator()(const f32x4 (&acc)[2][2][4][2], const Unit& u, int wr, int wc, int fr, int fq) const {
        const int row0 = u.pm * BM + wr * 64 + fr; const int col0 = u.pn * BM + wc * 32 + 8 * fq;
#pragma unroll
        for (int ai = 0; ai < 2; ++ai)
#pragma unroll
            for (int m = 0; m < 4; ++m) { bf16* rowp = O + (size_t)(row0 + ai * HALF + m * 16) * ldc + col0;
#pragma unroll
                for (int bj = 0; bj < 2; ++bj) { const f32x4 v0 = acc[ai][bj][m][0], v1 = acc[ai][bj][m][1];
                    u32x4 w; w.x = cvt_pk_bf16(v0[0], v0[1]); w.y = cvt_pk_bf16(v0[2], v0[3]); w.z = cvt_pk_bf16(v1[0], v1[1]); w.w = cvt_pk_bf16(v1[2], v1[3]);
                    *(u32x4*)(rowp + bj * HALF) = w; } }
    }
};
struct EpiResid {
    static constexpr bool PERM = true;
    const float* xl; const float* xc; bf16* X; const float* gate; bool f32base;
    __device__ __forceinline__ void operator()(const f32x4 (&acc)[2][2][4][2], const Unit& u, int wr, int wc, int fr, int fq) const {
        const int rt = u.pm * BM; const bool isl = rt < NLAT;
        const float* base = isl ? xl + (size_t)rt * D : xc + (size_t)(rt - NLAT) * D;
        const float* gp = gate + (size_t)(isl ? (rt >> 12) : 8) * 12288;
        const int rl0 = wr * 64 + fr, col0 = u.pn * BM + wc * 32 + 8 * fq;
#pragma unroll
        for (int ai = 0; ai < 2; ++ai)
#pragma unroll
            for (int m = 0; m < 4; ++m) { const int rl = rl0 + ai * HALF + m * 16; const float* bp = base + (size_t)rl * D + col0; bf16* op = X + (size_t)(rt + rl) * D + col0;
#pragma unroll
                for (int bj = 0; bj < 2; ++bj) { f32x4 b0, b1;
                    if (f32base) { b0 = *(const f32x4*)(bp + bj * HALF); b1 = *(const f32x4*)(bp + bj * HALF + 4); }
                    else { const u32x4 t = *(const u32x4*)(op + bj * HALF); b0 = (f32x4){bflo(t.x), bfhi(t.x), bflo(t.y), bfhi(t.y)}; b1 = (f32x4){bflo(t.z), bfhi(t.z), bflo(t.w), bfhi(t.w)}; }
                    const f32x4 g0 = *(const f32x4*)(gp + col0 + bj * HALF), g1 = *(const f32x4*)(gp + col0 + bj * HALF + 4);
                    const f32x4 r0 = b0 + g0 * acc[ai][bj][m][0], r1 = b1 + g1 * acc[ai][bj][m][1];
                    u32x4 w; w.x = cvt_pk_bf16(r0[0], r0[1]); w.y = cvt_pk_bf16(r0[2], r0[3]); w.z = cvt_pk_bf16(r1[0], r1[1]); w.w = cvt_pk_bf16(r1[2], r1[3]);
                    *(u32x4*)(op + bj * HALF) = w; }
                asm volatile("" ::: "memory"); }
    }
};
struct EpiSwiglu {
    static constexpr bool PERM = true;
    unsigned char* O;
    __device__ __forceinline__ void operator()(const f32x4 (&acc)[2][2][4][2], const Unit& u, int wr, int wc, int fr, int fq) const {
        const int row0 = u.pm * BM + wr * 64 + fr; const int col0 = u.pn * 128 + wc * 32 + 8 * fq;
#pragma unroll
        for (int ai = 0; ai < 2; ++ai)
#pragma unroll
            for (int m = 0; m < 4; ++m) { unsigned char* rowp = O + (size_t)(row0 + ai * HALF + m * 16) * DE + col0;
                float o[8];
#pragma unroll
                for (int n = 0; n < 2; ++n)
#pragma unroll
                    for (int j = 0; j < 4; ++j) { const float gt = acc[ai][0][m][n][j], up = acc[ai][1][m][n][j]; o[n * 4 + j] = gt * __builtin_amdgcn_rcpf(1.0f + __expf(-gt)) * up; }
                u32x2 w; w.x = pk4_fp8(o[0], o[1], o[2], o[3]); w.y = pk4_fp8(o[4], o[5], o[6], o[7]);
                *(u32x2*)rowp = w; }
    }
};
struct EpiDown {
    static constexpr bool PERM = true;
    unsigned char* YK; const PG8_LAS unsigned* tab; const PG8_LAS float* tabw;
    __device__ __forceinline__ void operator()(const f32x4 (&acc)[2][2][4][2], const Unit& u, int wr, int wc, int fr, int fq) const {
        const int rl0 = wr * 64 + fr; const int col0 = u.pn * BM + wc * 32 + 8 * fq;
#pragma unroll
        for (int ai = 0; ai < 2; ++ai)
#pragma unroll
            for (int m = 0; m < 4; ++m) { const int rl = rl0 + ai * HALF + m * 16; const unsigned ent = tab[u.aux * 256 + rl]; const float w = tabw[u.aux * 256 + rl];
                if (!(ent & 0x40000000u)) { unsigned char* rowp = YK + ((size_t)(ent >> 31) * MALL + (ent & 0xffffu)) * D + col0;
#pragma unroll
                    for (int bj = 0; bj < 2; ++bj) { const f32x4 v0 = acc[ai][bj][m][0] * w, v1 = acc[ai][bj][m][1] * w;
                        u32x2 q; q.x = pk4_fp8(v0[0], v0[1], v0[2], v0[3]); q.y = pk4_fp8(v1[0], v1[1], v1[2], v1[3]);
                        *(u32x2*)(rowp + bj * HALF) = q; } }
                asm volatile("" ::: "memory"); }
    }
};
}

struct Args { const float* in[31]; float* out; unsigned char* ws; int ph_lo, ph_hi; };
typedef const __attribute__((address_space(4))) Args* KArgs;
__device__ __forceinline__ KArgs kargs() { KArgs p = (KArgs)__builtin_amdgcn_kernarg_segment_ptr(); asm volatile("" : "+s"(p)); return p; }
#define AIN(i) (a->in[i])
enum { I_X = 0, I_C, I_CTX, I_CCTX, I_ADAW, I_ADAB, I_N1G, I_N2G, I_WIN, I_WOUT, I_GNG, I_GWS, I_GB, I_LB, I_HNG, I_MU, I_W0, I_WUP, I_A0, I_AUP, I_GUP, I_KK, I_KA, I_RK, I_GNGG, I_GNB, I_RW, I_RB, I_WGU, I_WDN, I_FNG };

__device__ __forceinline__ void p0_transpose_item(const float* W, int K, int N, bf16* WT, int n_row0, LAS float* scr, int kb, int nb, int lane) {
    const int k0 = 64 * kb, n0 = 32 * nb;
#pragma unroll 8
    for (int i = 0; i < 32; ++i) { const int kk = 2 * i + (lane >> 5); scr[kk * 33 + (lane & 31)] = W[(size_t)(k0 + kk) * N + n0 + (lane & 31)]; }
    asm volatile("s_waitcnt lgkmcnt(0)" ::: "memory");
    const int c = lane & 7;
#pragma unroll
    for (int j = 0; j < 4; ++j) { const int n = (lane >> 3) + 8 * j; const LAS float* s = scr + (8 * c) * 33 + n;
        u32x4 o; o.x = pk2(s[0 * 33], s[1 * 33]); o.y = pk2(s[2 * 33], s[3 * 33]); o.z = pk2(s[4 * 33], s[5 * 33]); o.w = pk2(s[6 * 33], s[7 * 33]);
        *(u32x4*)(WT + (size_t)(n_row0 + n) * K + k0 + 8 * c) = o; }
    asm volatile("s_waitcnt lgkmcnt(0)" ::: "memory");
}

__device__ __forceinline__ void p0_transpose_item8(const float* W, int K, int N, unsigned char* WT, int n_row0, LAS float* scr, int kb, int nb, int lane) {
    const int k0 = 64 * kb, n0 = 32 * nb;
    { const int c4 = (lane & 7) * 4;
      f32x4 t[8];
#pragma unroll
      for (int i = 0; i < 8; ++i) t[i] = *(const f32x4*)(W + (size_t)(k0 + 8 * i + (lane >> 3)) * N + n0 + c4);
#pragma unroll
      for (int i = 0; i < 8; ++i) { LAS float* d = scr + (8 * i + (lane >> 3)) * 33 + c4; d[0] = t[i][0]; d[1] = t[i][1]; d[2] = t[i][2]; d[3] = t[i][3]; } }
    asm volatile("s_waitcnt lgkmcnt(0)" ::: "memory");
    const int c = lane & 7;
#pragma unroll
    for (int j = 0; j < 4; ++j) { const int n = (lane >> 3) + 8 * j; const LAS float* sp = scr + (8 * c) * 33 + n;
        u32x2 o; o.x = pk4_fp8(sp[0 * 33] * 32.f, sp[1 * 33] * 32.f, sp[2 * 33] * 32.f, sp[3 * 33] * 32.f); o.y = pk4_fp8(sp[4 * 33] * 32.f, sp[5 * 33] * 32.f, sp[6 * 33] * 32.f, sp[7 * 33] * 32.f);
        *(u32x2*)(WT + (size_t)(n_row0 + n) * K + k0 + 8 * c) = o; }
    asm volatile("s_waitcnt lgkmcnt(0)" ::: "memory");
}
__device__ __forceinline__ void convert_moe(KArgs a, int l, LAS unsigned char* lds) {
    const int tid = tid_fresh(), lane = tid & 63, wave = tid >> 6;
    const int gw = blockIdx.x * 8 + wave, NGW = gridDim.x * 8;
    unsigned char* ws = a->ws;
    LAS float* scr = (LAS float*)(lds + wave * 16384);
    constexpr int I_GU = 32 * 64, I_DN = 16 * 64, N2 = 16 * I_GU, N3 = N2 + 16 * I_DN;
    for (int it = gw; it < N3; it += NGW) {
        if (it < N2) { const int e = it / I_GU, r = it % I_GU, kb = r / 64, nb = r % 64;
            const int n0 = 32 * nb, hh = n0 >> 10, nn = n0 & 1023, row0 = 256 * (nn >> 7) + 128 * hh + (nn & 127);
            p0_transpose_item8(a->in[I_WGU] + (size_t)(l * NE + e) * D * 2048, D, 2048, ws + WS_WGU + (size_t)e * 2048 * D, row0, scr, kb, nb, lane); }
        else { const int q = it - N2, e = q / I_DN, r = q % I_DN, kb = r / 64, nb = r % 64;
            p0_transpose_item8(a->in[I_WDN] + (size_t)(l * NE + e) * DE * D, DE, D, ws + WS_WDN + (size_t)e * D * DE, 32 * nb, scr, kb, nb, lane); }
    }
}
__device__ __forceinline__ void phase_prologue(KArgs a, LAS unsigned char* lds) {
    const int tid = tid_fresh(), lane = tid & 63, wave = tid >> 6;
    const int G = gridDim.x, gw = blockIdx.x * 8 + wave, NGW = G * 8;
    unsigned char* ws = a->ws;
    LAS float* scr = (LAS float*)(lds + wave * 16384);
    constexpr int I_IN = 32 * 232, I_OUT = 32 * 64;
    constexpr int N0 = 2 * I_IN, N1 = N0 + 2 * I_OUT;
    for (int it = gw; it < N1; it += NGW) {
        if (it < N0) { const int l = it / I_IN, r = it % I_IN, kb = r / 232, nb = r % 232;
            p0_transpose_item8(a->in[I_WIN] + (size_t)l * D * INC, D, INC, ws + WS_WIN + (size_t)l * INC * D, 32 * nb, scr, kb, nb, lane); }
        else { const int q = it - N0, l = q / I_OUT, r = q % I_OUT, kb = r / 64, nb = r % 64;
            p0_transpose_item8(a->in[I_WOUT] + (size_t)l * D * D, D, D, ws + WS_WOUT + (size_t)l * D * D, 32 * nb, scr, kb, nb, lane); }
    }
    convert_moe(a, 0, lds);
    {
        const int gt = blockIdx.x * NTHREADS + tid, NGT = G * NTHREADS;
        bf16* wup = (bf16*)(ws + WS_SMALLW + SW_WUP); bf16* aup = (bf16*)(ws + WS_SMALLW + SW_AUP); bf16* gup = (bf16*)(ws + WS_SMALLW + SW_GUP); bf16* gws = (bf16*)(ws + WS_SMALLW + SW_GWS);
        for (int i = gt; i < 2 * 2 * 768 * 64; i += NGT) { const int k = i & 63, n = (i >> 6) % 768, ld = i / (768 * 64); wup[i] = (bf16)f2bf(a->in[I_WUP][((size_t)ld * 64 + k) * 768 + n]); }
        for (int i = gt; i < 2 * 768 * 64; i += NGT) { const int k = i & 63, n = (i >> 6) % 768, l = i / (768 * 64); aup[i] = (bf16)f2bf(a->in[I_AUP][((size_t)l * 64 + k) * 768 + n]); }
        for (int i = gt; i < 2 * 768 * 128; i += NGT) { const int k = i & 127, n = (i >> 7) % 768, l = i / (768 * 128); gup[i] = (bf16)f2bf(a->in[I_GUP][((size_t)l * 128 + k) * 768 + n]); }
        for (int i = gt; i < 2 * 4 * 128 * 128; i += NGT) gws[i] = (bf16)f2bf(a->in[I_GWS][i]);
    }
    __syncthreads();
    {
        LAS float* sv = (LAS float*)lds;
        LAS float* red = (LAS float*)(lds + 73728);
        for (int i = tid; i < 9 * D; i += NTHREADS) { const int r = i / D, k = i % D; const float v = r < 8 ? a->in[I_C][r * D + k] : a->in[I_CCTX][k]; sv[i] = siluf_(v); }
        __syncthreads();
        float* mod = (float*)(ws + WS_MOD);
        for (int it = blockIdx.x; it < 2 * 96; it += G) {
            const int l = it / 96, cb = it % 96, cq = tid & 31, kg = tid >> 5;
            const float* wp = a->in[I_ADAW] + (size_t)l * D * 12288 + (size_t)(kg * 128) * 12288 + cb * 128 + cq * 4;
            f32x4 acc[9];
#pragma unroll
            for (int r = 0; r < 9; ++r) acc[r] = (f32x4){0.f, 0.f, 0.f, 0.f};
#pragma unroll 4
            for (int k = 0; k < 128; ++k) { const f32x4 w = *(const f32x4*)(wp + (size_t)k * 12288);
#pragma unroll
                for (int r = 0; r < 9; ++r) acc[r] += w * sv[r * D + kg * 128 + k]; }
#pragma unroll
            for (int r = 0; r < 9; ++r) *(LAS f32x4*)(red + ((kg * 9 + r) * 128 + cq * 4)) = acc[r];
            __syncthreads();
            for (int o = tid; o < 9 * 128; o += NTHREADS) { const int r = o / 128, c = o % 128; float s = a->in[I_ADAB][(size_t)l * 12288 + cb * 128 + c];
#pragma unroll
                for (int q = 0; q < 16; ++q) s += red[(q * 9 + r) * 128 + c];
                mod[((size_t)l * 9 + r) * 12288 + cb * 128 + c] = s; }
            __syncthreads();
        }
    }
}

template <int MODE>
__device__ __forceinline__ void phase_norm1(KArgs a, int l, bool dry) {
    const int tid_ = tid_fresh(); const int lane = tid_ & 63, wave = tid_ >> 6, gw = blockIdx.x * 8 + wave, NGW = gridDim.x * 8;
    unsigned char* ws = a->ws;
    const float* mod = (const float*)(ws + WS_MOD);
    bf16* X = (bf16*)(ws + WS_X); bf16* H = (bf16*)(ws + WS_H); const bf16* YK = (const bf16*)(ws + WS_YK);
    bf16* Xo = dry ? (bf16*)(ws + WS_END) : X; bf16* Ho = dry ? (bf16*)(ws + WS_END) : H; float* Oo = dry ? (float*)(ws + WS_END) : a->out;
    const int nrows = (MODE == 2) ? NLAT : MALL;
    const int rpw = (nrows + NGW - 1) / NGW; const int r0 = gw * rpw, r1 = (r0 + rpw < nrows) ? r0 + rpw : nrows;
    f32x4 ck[8], cs[8], cg[8]; int cur_mr = -1;
    for (int row = r0; row < r1; ++row) {
        const int mr = modrow_of(row); const int orow = dry ? (row & 2047) : row;
        if (mr != cur_mr) { cur_mr = mr;
#pragma unroll
            for (int j = 0; j < 8; ++j) { const int c = 4 * lane + 256 * j;
                if (MODE == 2) ck[j] = *(const f32x4*)(a->in[I_FNG] + c);
                else { const float* m = mod + ((size_t)l * 9 + mr) * 12288; const f32x4 g = *(const f32x4*)(a->in[I_N1G] + (size_t)l * D + c); ck[j] = g * (*(const f32x4*)(m + D + c) + 1.0f); cs[j] = *(const f32x4*)(m + c); }
                if (MODE != 0) cg[j] = *(const f32x4*)(mod + ((size_t)(l - 1) * 9 + mr) * 12288 + 5 * D + c); } }
        f32x4 v[8];
        if (MODE == 0) { const float* xr = row < NLAT ? a->in[I_X] + (size_t)row * D : a->in[I_CTX] + (size_t)(row - NLAT) * D;
#pragma unroll
            for (int j = 0; j < 8; ++j) v[j] = *(const f32x4*)(xr + 4 * lane + 256 * j);
        } else {
            const bf16* xr = X + (size_t)row * D; const unsigned char* y0 = (const unsigned char*)YK + (size_t)row * D; const unsigned char* y1 = (const unsigned char*)YK + ((size_t)MALL + row) * D;
            unsigned p0[8], p1[8];
#pragma unroll
            for (int j = 0; j < 8; ++j) { const int c = 4 * lane + 256 * j; const u32x2 t = *(const u32x2*)(xr + c); v[j] = (f32x4){bflo(t.x), bfhi(t.x), bflo(t.y), bfhi(t.y)}; p0[j] = *(const unsigned*)(y0 + c); p1[j] = *(const unsigned*)(y1 + c); }
#pragma unroll
            for (int j = 0; j < 8; ++j) { const f32x2 a0 = __builtin_amdgcn_cvt_pk_f32_fp8((int)p0[j], false), a1 = __builtin_amdgcn_cvt_pk_f32_fp8((int)p0[j], true), b0 = __builtin_amdgcn_cvt_pk_f32_fp8((int)p1[j], false), b1 = __builtin_amdgcn_cvt_pk_f32_fp8((int)p1[j], true);
                f32x4 f; f[0] = a0[0] + b0[0]; f[1] = a0[1] + b0[1]; f[2] = a1[0] + b1[0]; f[3] = a1[1] + b1[1];
                v[j] = v[j] + cg[j] * f; }
            if (MODE == 1) {
#pragma unroll
                for (int j = 0; j < 8; ++j) { u32x2 t; t.x = pk2(v[j][0], v[j][1]); t.y = pk2(v[j][2], v[j][3]); *(u32x2*)(Xo + (size_t)orow * D + 4 * lane + 256 * j) = t; }
            }
        }
        float ss = 0.f;
#pragma unroll
        for (int j = 0; j < 8; ++j) ss += (v[j][0] * v[j][0] + v[j][1] * v[j][1]) + (v[j][2] * v[j][2] + v[j][3] * v[j][3]);
        const float rstd = 1.0f / sqrtf(wave_sum(ss) * (1.0f / D) + NORM_EPS);
        if (MODE == 2) {
#pragma unroll
            for (int j = 0; j < 8; ++j) *(f32x4*)(Oo + (size_t)orow * D + 4 * lane + 256 * j) = v[j] * rstd * ck[j];
        } else {
#pragma unroll
            for (int j = 0; j < 8; ++j) { const f32x4 h = v[j] * rstd * ck[j] + cs[j]; *(unsigned*)((unsigned char*)Ho + (size_t)orow * D + 4 * lane + 256 * j) = pk4_fp8(h[0], h[1], h[2], h[3]); }
        }
    }
}

__device__ __forceinline__ void phase_norm2_router(KArgs a, int l, bool dry, LAS unsigned char* lds) {
    const int tid_ = tid_fresh(); const int lane = tid_ & 63, wave = tid_ >> 6, gw = blockIdx.x * 8 + wave, NGW = gridDim.x * 8;
    unsigned char* ws = a->ws;
    const float* mod = (const float*)(ws + WS_MOD);
    const bf16* X = (const bf16*)(ws + WS_X); bf16* H = (bf16*)(ws + WS_H);
    unsigned* cnt = (unsigned*)(ws + WS_CTL) + CW_CNT + l * 16 * 64 + (dry ? 4096 : 0);
    unsigned* ridx = (unsigned*)(ws + (dry ? WS_END : WS_RIDX)); float* rwt = (float*)(ws + (dry ? WS_END + 4 * MiB : WS_RW)); bf16* Ho = dry ? (bf16*)(ws + WS_END + 8 * MiB) : H;
    const int nrows = (l == DEPTH - 1) ? NLAT : MALL;
    LAS f32x4* rwl = (LAS f32x4*)lds;
    { const float* rw = a->in[I_RW];
      for (int idx = tid_; idx < 8192; idx += NTHREADS) { const int ln = idx & 63, q = (idx >> 6) & 3, i = (idx >> 8) & 3, j = idx >> 10; rwl[idx] = *(const f32x4*)(rw + (size_t)(4 * ln + 256 * j + i) * 16 + 4 * q); } }
    __syncthreads();
    const int rpw = (nrows + NGW - 1) / NGW; const int r0 = gw * rpw, r1 = (r0 + rpw < nrows) ? r0 + rpw : nrows;
    f32x4 ck[8]; int cur_mr = -1;
    const float* rbp = a->in[I_RB];
    for (int row = r0; row < r1; ++row) {
        const int mr = modrow_of(row); const int orow = dry ? (row & 2047) : row;
        if (mr != cur_mr) { cur_mr = mr; const float* m = mod + ((size_t)l * 9 + mr) * 12288;
#pragma unroll
            for (int j = 0; j < 8; ++j) { const int c = 4 * lane + 256 * j; const f32x4 g = *(const f32x4*)(a->in[I_N2G] + (size_t)l * D + c); ck[j] = g * (*(const f32x4*)(m + 4 * D + c) + 1.0f); } }
        const float* shp = mod + ((size_t)l * 9 + mr) * 12288 + 3 * D;
        const bf16* xr = X + (size_t)row * D;
        f32x4 v[8]; float ss = 0.f;
#pragma unroll
        for (int j = 0; j < 8; ++j) { const u32x2 t = *(const u32x2*)(xr + 4 * lane + 256 * j); v[j] = (f32x4){bflo(t.x), bfhi(t.x), bflo(t.y), bfhi(t.y)}; ss += (v[j][0] * v[j][0] + v[j][1] * v[j][1]) + (v[j][2] * v[j][2] + v[j][3] * v[j][3]); }
        const float rstd = 1.0f / sqrtf(wave_sum(ss) * (1.0f / D) + NORM_EPS);
        f32x4 lg4[4];
#pragma unroll
        for (int q = 0; q < 4; ++q) lg4[q] = (f32x4){0.f, 0.f, 0.f, 0.f};
#pragma unroll
        for (int j = 0; j < 8; ++j) { const f32x4 h = v[j] * rstd * ck[j] + *(const f32x4*)(shp + 4 * lane + 256 * j); *(unsigned*)((unsigned char*)Ho + (size_t)orow * D + 4 * lane + 256 * j) = pk4_fp8(h[0], h[1], h[2], h[3]);
#pragma unroll
            for (int i = 0; i < 4; ++i)
#pragma unroll
                for (int q = 0; q < 4; ++q) lg4[q] += rwl[((j * 4 + i) * 4 + q) * 64 + lane] * h[i];
            asm volatile("" ::: "memory"); }
        float lg[16];
        { float t8[8], t4[4], t2[2], t1;
          const bool b5 = lane & 32, b4 = lane & 16, b3 = lane & 8, b2 = lane & 4;
#pragma unroll
          for (int i = 0; i < 8; ++i) { const float keep = b5 ? lg4[(i + 8) >> 2][(i + 8) & 3] : lg4[i >> 2][i & 3], send = b5 ? lg4[i >> 2][i & 3] : lg4[(i + 8) >> 2][(i + 8) & 3]; t8[i] = keep + __shfl_xor(send, 32); }
#pragma unroll
          for (int i = 0; i < 4; ++i) { const float keep = b4 ? t8[i + 4] : t8[i], send = b4 ? t8[i] : t8[i + 4]; t4[i] = keep + __shfl_xor(send, 16); }
#pragma unroll
          for (int i = 0; i < 2; ++i) { const float keep = b3 ? t4[i + 2] : t4[i], send = b3 ? t4[i] : t4[i + 2]; t2[i] = keep + __shfl_xor(send, 8); }
          { const float keep = b2 ? t2[1] : t2[0], send = b2 ? t2[0] : t2[1]; t1 = keep + __shfl_xor(send, 4); }
          t1 += __shfl_xor(t1, 2); t1 += __shfl_xor(t1, 1);
#pragma unroll
          for (int e = 0; e < 16; ++e) { const int src = ((e >> 3) & 1) * 32 + ((e >> 2) & 1) * 16 + ((e >> 1) & 1) * 8 + (e & 1) * 4; lg[e] = __builtin_bit_cast(float, __builtin_amdgcn_readlane(__builtin_bit_cast(int, t1), src)) + rbp[e]; } }
        float mx = lg[0];
#pragma unroll
        for (int e = 1; e < 16; ++e) mx = fmaxf(mx, lg[e]);
        float p[16], sum = 0.f;
#pragma unroll
        for (int e = 0; e < 16; ++e) { p[e] = __expf(lg[e] - mx); sum += p[e]; }
        const float inv = 1.0f / sum;
#pragma unroll
        for (int e = 0; e < 16; ++e) p[e] *= inv;
        int sel = 0; float best = -1.f;
#pragma unroll
        for (int gI = 0; gI < 4; ++gI) { float m1 = -1.f, m2 = -1.f;
#pragma unroll
            for (int i = 0; i < 4; ++i) { const float q = p[4 * gI + i]; if (q > m1) { m2 = m1; m1 = q; } else if (q > m2) m2 = q; }
            const float s = m1 + m2; if (s > best) { best = s; sel = gI; } }
        int i1 = 0, i2 = 0; float p1 = -2.f, p2 = -2.f;
#pragma unroll
        for (int gI = 0; gI < 4; ++gI)
#pragma unroll
            for (int i = 0; i < 4; ++i) { const float q = (gI == sel) ? p[4 * gI + i] : -1.0f; const int e = 4 * gI + i;
                if (gI == sel) { if (q > p1) { p2 = p1; i2 = i1; p1 = q; i1 = e; } else if (q > p2) { p2 = q; i2 = e; } } }
        const float wsum = p1 + p2, w1 = p1 / wsum, w2 = p2 / wsum;
        if (lane == 0) {
            const unsigned q1 = atomicAdd(cnt + i1 * 64, 1u); ridx[(size_t)i1 * MALL + q1] = (unsigned)row; rwt[(size_t)i1 * MALL + q1] = w1;
            const unsigned q2 = atomicAdd(cnt + i2 * 64, 1u); ridx[(size_t)i2 * MALL + q2] = (unsigned)row | 0x80000000u; rwt[(size_t)i2 * MALL + q2] = w2;
        }
    }
    __syncthreads();
}

template <bool FOR_DOWN>
__device__ __forceinline__ void moe_tables(KArgs a, int l, LAS unsigned char* lds, int cvirt) {
    const int tid = tid_fresh(), G = gridDim.x;
    unsigned char* ws = a->ws;
    const unsigned* cnt = (const unsigned*)(ws + WS_CTL) + CW_CNT + l * 16 * 64;
    const unsigned* ridx = (const unsigned*)(ws + WS_RIDX); const float* rwt = (const float*)(ws + WS_RW);
    LAS int* tp = (LAS int*)(lds + LDS_TP); LAS unsigned* tab = (LAS unsigned*)(lds + LDS_TAB); LAS float* tabw = (LAS float*)(lds + LDS_TABW);
    if (tid == 0) { int acc = 0; for (int e = 0; e < 16; ++e) { tp[e] = acc; acc += (int)((cnt[e * 64] + 255u) >> 8); } tp[16] = acc; }
    __syncthreads();
    const int ntot = tp[16] * 8;
    for (int i = 0; i < 9; ++i) { const int L = i * G + cvirt; if (L >= ntot) break;
        const int tile = L >> 3; int e = 0;
        for (int j = 1; j < 16; ++j) e += (tile >= tp[j]) ? 1 : 0;
        const int pos0 = (tile - tp[e]) * 256; const unsigned ce = cnt[e * 64];
        if (tid < 256) { const int pos = pos0 + tid; const bool valid = (unsigned)pos < ce; const unsigned ent = ridx[(size_t)e * MALL + (valid ? pos : 0)];
            if (FOR_DOWN) { tab[i * 256 + tid] = valid ? ent : (ent | 0x40000000u); tabw[i * 256 + tid] = valid ? rwt[(size_t)e * MALL + pos] : 0.f; }
            else tab[i * 256 + tid] = (ent & 0xffffu) * (unsigned)D; }
    }
    __syncthreads();
}

#define LDS_BAR() do { asm volatile("s_waitcnt lgkmcnt(0)" ::: "memory"); __builtin_amdgcn_s_barrier(); asm volatile("" ::: "memory"); } while (0)
__device__ __forceinline__ void l2_touch(const void* p, LAS unsigned char* lds) { __builtin_amdgcn_global_load_lds((const unsigned*)p, (LAS unsigned*)(lds + LDS_MISC + 2048), 4, 0, 0); }
__device__ __forceinline__ void rwkv_prep_touch(KArgs a, int tile, int hgrp, LAS unsigned char* lds) {
    const int tid = tid_fresh(); const char* Pb = (const char*)(a->ws + WS_P);
    const int row0 = tile * 64; const bool isl = row0 < NLAT; const int gr = (row0 >> 6) & 63;
#pragma unroll
    for (int i = 0; i < 6; ++i) { const int idx = tid + NTHREADS * i, rr = idx >> 4, ln = idx & 15, blk = rr >> 6;
        const int row = row0 + (rr & 63) + (blk == 1 ? -64 : (blk == 2 ? 64 : 0));
        const bool ok = blk == 0 || (isl && (blk == 1 ? gr > 0 : gr < 63));
        const int col = ln < 12 ? (ln >> 2) * 768 + hgrp * 256 + (ln & 3) * 64 : 2304 + (ln - 12) * 64;
        if (ok) l2_touch(Pb + (size_t)row * (INC * 2) + (size_t)(OFF_C + col) * 2, lds); }
}
__device__ __forceinline__ void hgrn_prep_touch(KArgs a, int item, LAS unsigned char* lds) {
    const int tid = tid_fresh(); const char* Pb = (const char*)(a->ws + WS_P);
    const int cn = item % 68, bh = item / 68, h = bh % 6, b = bh / 6;
    const int row0 = cn < 4 ? NLAT + b * CTXL + 64 * cn : b * T + 64 * (cn - 4);
    if (tid < 384) { const int rr = tid / 6, part = tid % 6, st = part >> 1; const int col = (st == 0 ? OFF_Q : (st == 1 ? OFF_ZF : OFF_ZB)) + h * 128 + (part & 1) * 64;
        l2_touch(Pb + (size_t)(row0 + rr) * (INC * 2) + (size_t)col * 2, lds); }
}
constexpr int PREP_N_RW = 544 * 3, PREP_N_HG = 3264;
__device__ __forceinline__ void prep_touch(KArgs a, int nx, LAS unsigned char* lds) { if (nx < PREP_N_RW) rwkv_prep_touch(a, nx / 3, nx % 3, lds); else if (nx < PREP_N_RW + PREP_N_HG) hgrn_prep_touch(a, nx - PREP_N_RW, lds); }
__device__ __forceinline__ void gmlp_item(KArgs a, int l, int item, LAS unsigned char* lds) {
    const int tid = tid_fresh(), lane = tid & 63, wave = tid >> 6;
    unsigned char* ws = a->ws;
    const bf16* P = (const bf16*)(ws + WS_P); bf16* Y = (bf16*)(ws + WS_Y);
    const int chunk = item >> 2, h = item & 3;
    const int row0 = chunk < 256 ? chunk * 128 : NLAT + (chunk - 256) * 128;
    LAS bf16* wsl = (LAS bf16*)lds;
    LAS bf16* vT = (LAS bf16*)(lds + 128 * 136 * 2);
    const bf16* gws = (const bf16*)(ws + WS_SMALLW + SW_GWS) + ((size_t)l * 4 + h) * 128 * 128;
    for (int p = tid; p < 2048; p += NTHREADS) { const int t = p >> 4, c8 = p & 15; *(LAS u32x4*)(wsl + t * 136 + c8 * 8) = *(const u32x4*)(gws + t * 128 + c8 * 8); }
    {
        const int s = tid >> 2, qd = tid & 3; const bf16* vp = P + (size_t)(row0 + s) * INC + OFF_V + h * 128 + qd * 32;
        float g[32]; float ss = 0.f;
#pragma unroll
        for (int q = 0; q < 4; ++q) { float f[8]; unpack8(*(const u32x4*)(vp + 8 * q), f);
#pragma unroll
            for (int j = 0; j < 8; ++j) { const float x = geluf_(f[j]); g[8 * q + j] = x; ss += x * x; } }
        ss += __shfl_xor(ss, 1); ss += __shfl_xor(ss, 2);
        const float rstd = 1.0f / sqrtf(ss * (1.0f / 128.0f) + NORM_EPS);
        const float* ng = a->in[I_GNG] + (size_t)l * 512 + h * 128 + qd * 32;
#pragma unroll
        for (int j = 0; j < 32; ++j) vT[(qd * 32 + j) * 136 + s] = (bf16)f2bf(g[j] * rstd * ng[j]);
    }
    LDS_BAR();
    f32x4 acc[8];
#pragma unroll
    for (int ct = 0; ct < 8; ++ct) acc[ct] = (f32x4){0.f, 0.f, 0.f, 0.f};
    const int fr = lane & 15, fq = lane >> 4;
#pragma unroll
    for (int ks = 0; ks < 4; ++ks) {
        const bf16x8 bfrag = *(const LAS bf16x8*)(wsl + (16 * wave + fr) * 136 + ks * 32 + fq * 8);
#pragma unroll
        for (int ct = 0; ct < 8; ++ct) { const bf16x8 afrag = *(const LAS bf16x8*)(vT + (16 * ct + fr) * 136 + ks * 32 + fq * 8);
            acc[ct] = __builtin_amdgcn_mfma_f32_16x16x32_bf16(afrag, bfrag, acc[ct], 0, 0, 0); }
    }
    const int t = 16 * wave + fr; const float wb = a->in[I_GB][((size_t)l * 4 + h) * 128 + t];
    const bf16* up = P + (size_t)(row0 + t) * INC + OFF_U + h * 128; unsigned char* yp = a->ws + WS_Y8 + (size_t)(row0 + t) * D + h * 128;
#pragma unroll
    for (int ct = 0; ct < 8; ++ct) { const int c = 16 * ct + 4 * fq; const u32x2 uu = *(const u32x2*)(up + c);
        const float y0 = geluf_(bflo(uu.x)) * (acc[ct][0] + wb), y1 = geluf_(bfhi(uu.x)) * (acc[ct][1] + wb), y2 = geluf_(bflo(uu.y)) * (acc[ct][2] + wb), y3 = geluf_(bfhi(uu.y)) * (acc[ct][3] + wb);
        *(unsigned*)(yp + c) = pk4_fp8(y0, y1, y2, y3); }
    LDS_BAR();
}

constexpr int SP_ = 72;
__device__ __forceinline__ int kperm_pos(int k) { const int s5 = k & 31; return (k & 32) + 8 * ((s5 >> 2) & 3) + 4 * (s5 >> 4) + (s5 & 3); }
#ifndef RWP_SKIP
#define RWP_SKIP 0
#endif
__device__ __forceinline__ void rwkv_prep_item(KArgs a, int l, int tile, int hgrp, LAS unsigned char* lds, int skip = 0, int nx = 0x7fffffff) {
    const int tid = tid_fresh(), lane = tid & 63, wave = tid >> 6;
    unsigned char* ws = a->ws;
    const bf16* P = (const bf16*)(ws + WS_P); bf16* Y = (bf16*)(ws + WS_Y);
    LAS bf16* SR = (LAS bf16*)lds; LAS bf16* SK = SR + 64 * SP_; LAS bf16* SV = SK + 64 * SP_; LAS bf16* SKK = SV + 64 * SP_; LAS bf16* SB = SKK + 64 * SP_; LAS bf16* SWF = SB + 64 * SP_; LAS bf16* SWB = SWF + 64 * SP_;
    LAS bf16* tw = SWB + 64 * SP_;
    LAS bf16* adl = tw + 64 * SP_;
    LAS bf16* sg = adl + 64 * SP_;
    LAS float* invn = (LAS float*)(sg + 64 * 136);
    LAS unsigned char* wpriv = (LAS unsigned char*)(invn + 64) + wave * 6144;
    const int row0 = tile * 64; const bool isl = row0 < NLAT;
    const float* mu = a->in[I_MU] + (size_t)l * CCOLS;
    const char* Pb = (const char*)P;
    auto shift_group = [&](int tk, int col, float (&z)[8]) {
        const int row = row0 + tk; int o0, o1, o2, o3; bool v0, v1, v2, v3;
        if (isl) { const int gr = (row >> 6) & 63; o0 = -1; o1 = 1; o2 = -64; o3 = 64; v0 = tk > 0; v1 = tk < 63; v2 = gr > 0; v3 = gr < 63; }
        else { const int tc = (row - NLAT) & 255; o0 = -1; o1 = 1; o2 = -1; o3 = 1; v0 = tc > 0; v1 = tc < 255; v2 = v0; v3 = v1; }
        const unsigned off = (unsigned)row * (unsigned)(INC * 2) + (unsigned)(OFF_C + col) * 2u;
        const u32x4 uo = *(const u32x4*)(Pb + off), u0 = *(const u32x4*)(Pb + (off + (unsigned)((v0 ? o0 : 0) * INC * 2))), u1 = *(const u32x4*)(Pb + (off + (unsigned)((v1 ? o1 : 0) * INC * 2))),
                    u2 = *(const u32x4*)(Pb + (off + (unsigned)((v2 ? o2 : 0) * INC * 2))), u3 = *(const u32x4*)(Pb + (off + (unsigned)((v3 ? o3 : 0) * INC * 2)));
        const f32x4 m0 = *(const f32x4*)(mu + col), m1 = *(const f32x4*)(mu + col + 4);
        float own[8], n0[8], n1[8], n2[8], n3[8]; unpack8(uo, own); unpack8(u0, n0); unpack8(u1, n1); unpack8(u2, n2); unpack8(u3, n3);
        const float f0 = v0 ? 1.f : 0.f, f1 = v1 ? 1.f : 0.f, f2 = v2 ? 1.f : 0.f, f3 = v3 ? 1.f : 0.f;
        const float nb[8] = {n0[0] * f0, n1[1] * f1, n2[2] * f2, n3[3] * f3, n0[4] * f0, n1[5] * f1, n2[6] * f2, n3[7] * f3};
#pragma unroll
        for (int j = 0; j < 8; ++j) { const float mm = j < 4 ? m0[j] : m1[j - 4]; z[j] = own[j] + mm * (nb[j] - own[j]); }
    };
#pragma unroll
    for (int it = 0; it < 4; ++it) { const int g = tid + NTHREADS * it, tk = g >> 5, gi = g & 31;
        float z[8]; shift_group(tk, 2304 + gi * 8, z);
        if (gi < 8) { float t8[8];
#pragma unroll
            for (int j = 0; j < 8; ++j) t8[j] = 1.0f - 2.0f * __builtin_amdgcn_rcpf(1.0f + __expf(2.0f * z[j]));
            *(LAS u32x4*)(tw + tk * SP_ + gi * 8) = pack8(t8); }
        else if (gi < 16) *(LAS u32x4*)(adl + tk * SP_ + (gi - 8) * 8) = pack8(z);
        else { float t8[8];
#pragma unroll
            for (int j = 0; j < 8; ++j) t8[j] = sigmoidf_(z[j]);
            *(LAS u32x4*)(sg + tk * 136 + (gi - 16) * 8) = pack8(t8); } }
    LDS_BAR();
#pragma unroll 1
    for (int hh = 0; hh < 4; ++hh) {
    const int tid = tid_fresh(), lane = tid & 63, wave = tid >> 6;
    const int head = 4 * hgrp + hh; const float* kkw = a->in[I_KK] + (size_t)l * CW + head * 64;
    const int nloc = 16 * (wave & 3) + 4 * (lane >> 4);
    bf16x8 wfa[2], wfw0[2], wfw1[2], wfg[4]; f32x4 a0v, kav, kkv, w0a, w0b, rk0, rk1;
    { const int wrow = head * 64 + 16 * (wave & 3) + (lane & 15), ko = (lane >> 4) * 8;
      const bf16* wupT = (const bf16*)(ws + WS_SMALLW + SW_WUP) + (size_t)l * 2 * 768 * 64;
      const bf16* aupT = (const bf16*)(ws + WS_SMALLW + SW_AUP) + (size_t)l * 768 * 64;
      const bf16* gupT = (const bf16*)(ws + WS_SMALLW + SW_GUP) + (size_t)l * 768 * 128;
#pragma unroll
      for (int ks = 0; ks < 2; ++ks) { wfa[ks] = *(const bf16x8*)(aupT + (size_t)wrow * 64 + ks * 32 + ko); wfw0[ks] = *(const bf16x8*)(wupT + (size_t)wrow * 64 + ks * 32 + ko); wfw1[ks] = *(const bf16x8*)(wupT + 768 * 64 + (size_t)wrow * 64 + ks * 32 + ko); }
#pragma unroll
      for (int ks = 0; ks < 4; ++ks) wfg[ks] = *(const bf16x8*)(gupT + (size_t)wrow * 128 + ks * 32 + ko);
      const size_t hc = (size_t)l * CW + head * 64 + nloc;
      a0v = *(const f32x4*)(a->in[I_A0] + hc); kav = *(const f32x4*)(a->in[I_KA] + hc); kkv = *(const f32x4*)(kkw + nloc);
      w0a = *(const f32x4*)(a->in[I_W0] + (size_t)l * 2 * CW + head * 64 + nloc); w0b = *(const f32x4*)(a->in[I_W0] + (size_t)l * 2 * CW + CW + head * 64 + nloc);
      const float* rkp = a->in[I_RK] + (size_t)l * CW + head * 64 + (tid & 7) * 8; rk0 = *(const f32x4*)rkp; rk1 = *(const f32x4*)(rkp + 4); }
#pragma unroll
    for (int it = 0; it < 3; ++it) { const int g = tid + NTHREADS * it, tk = g / 24, gi = g % 24, c8 = (gi & 7) * 8;
        float z[8]; shift_group(tk, (gi >> 3) * 768 + head * 64 + c8, z);
        if (gi < 8) *(LAS u32x4*)(SR + tk * SP_ + c8) = pack8(z);
        else if (gi < 16) { *(LAS u32x4*)(SK + tk * SP_ + c8) = pack8(z);
            const f32x4 k0 = *(const f32x4*)(kkw + c8), k1 = *(const f32x4*)(kkw + c8 + 4); float ss = 0.f;
#pragma unroll
            for (int j = 0; j < 8; ++j) { const float q = z[j] * (j < 4 ? k0[j] : k1[j - 4]); ss += q * q; }
            ss += __shfl_xor(ss, 1); ss += __shfl_xor(ss, 2); ss += __shfl_xor(ss, 4);
            if ((gi & 7) == 0) invn[tk] = 1.0f / fmaxf(sqrtf(ss), 1e-12f); }
        else *(LAS u32x4*)(SV + tk * SP_ + c8) = pack8(z); }
    LDS_BAR();
    if (hh == 0) prep_touch(a, nx, lds);
    if (!(skip & 2)) {
        const int fr = lane & 15, fq = lane >> 4, th = wave >> 2;
        f32x4 ac[4][2];
#pragma unroll
        for (int tt = 0; tt < 2; ++tt) { const int ro = (16 * (2 * th + tt) + fr);
            f32x4 z4 = (f32x4){0.f, 0.f, 0.f, 0.f}; ac[0][tt] = z4; ac[1][tt] = z4; ac[2][tt] = z4; ac[3][tt] = z4;
#pragma unroll
            for (int ks = 0; ks < 2; ++ks) { const bf16x8 ba = *(const LAS bf16x8*)(adl + ro * SP_ + ks * 32 + fq * 8), bt = *(const LAS bf16x8*)(tw + ro * SP_ + ks * 32 + fq * 8);
                ac[0][tt] = __builtin_amdgcn_mfma_f32_16x16x32_bf16(wfa[ks], ba, ac[0][tt], 0, 0, 0);
                ac[1][tt] = __builtin_amdgcn_mfma_f32_16x16x32_bf16(wfw0[ks], bt, ac[1][tt], 0, 0, 0);
                ac[2][tt] = __builtin_amdgcn_mfma_f32_16x16x32_bf16(wfw1[ks], bt, ac[2][tt], 0, 0, 0); }
#pragma unroll
            for (int ks = 0; ks < 4; ++ks) { const bf16x8 bg = *(const LAS bf16x8*)(sg + ro * 136 + ks * 32 + fq * 8); ac[3][tt] = __builtin_amdgcn_mfma_f32_16x16x32_bf16(wfg[ks], bg, ac[3][tt], 0, 0, 0); } }
#pragma unroll
        for (int tt = 0; tt < 2; ++tt) { const int tk = 16 * (2 * th + tt) + fr;
            { const f32x4 v = ac[0][tt];
              const u32x2 kp = *(const LAS u32x2*)(SK + tk * SP_ + nloc); const float kf[4] = {bflo(kp.x), bfhi(kp.x), bflo(kp.y), bfhi(kp.y)};
              const float inn = invn[tk]; float k2[4], kk[4], bb[4];
#pragma unroll
              for (int j = 0; j < 4; ++j) { const float av = sigmoidf_(a0v[j] + v[j]); kk[j] = kf[j] * kkv[j] * inn; k2[j] = kf[j] * (1.0f + (av - 1.0f) * kav[j]); bb[j] = kk[j] * av; }
              u32x2 q; q.x = pk2(k2[0], k2[1]); q.y = pk2(k2[2], k2[3]); *(LAS u32x2*)(SK + tk * SP_ + nloc) = q;
              q.x = pk2(kk[0], kk[1]); q.y = pk2(kk[2], kk[3]); *(LAS u32x2*)(SKK + tk * SP_ + nloc) = q;
              q.x = pk2(bb[0], bb[1]); q.y = pk2(bb[2], bb[3]); *(LAS u32x2*)(SB + tk * SP_ + nloc) = q; }
#pragma unroll
            for (int mat = 1; mat <= 2; ++mat) { const f32x4 v = ac[mat][tt]; const f32x4 w0v = mat == 1 ? w0a : w0b; float d[4];
#pragma unroll
                for (int j = 0; j < 4; ++j) d[j] = __expf(-DECAY_SCALE * sigmoidf_(w0v[j] + v[j]));
                u32x2 q; q.x = pk2(d[0], d[1]); q.y = pk2(d[2], d[3]); *(LAS u32x2*)((mat == 1 ? SWF : SWB) + tk * SP_ + nloc) = q; }
            { const f32x4 v = ac[3][tt]; u32x2 q; q.x = pk2(v[0], v[1]); q.y = pk2(v[2], v[3]); *(u32x2*)(Y + (size_t)(row0 + tk) * D + 1280 + head * 64 + nloc) = q; }
        }
    }
    LDS_BAR();
    if (!(skip & 4)) { const int tk = tid >> 3, c8 = (tid & 7) * 8; float r8[8], k8[8], v8[8];
      unpack8(*(const LAS u32x4*)(SR + tk * SP_ + c8), r8); unpack8(*(const LAS u32x4*)(SK + tk * SP_ + c8), k8); unpack8(*(const LAS u32x4*)(SV + tk * SP_ + c8), v8);
      float bs = 0.f;
#pragma unroll
      for (int j = 0; j < 8; ++j) bs += r8[j] * k8[j] * (j < 4 ? rk0[j] : rk1[j - 4]);
      bs += __shfl_xor(bs, 1); bs += __shfl_xor(bs, 2); bs += __shfl_xor(bs, 4);
#pragma unroll
      for (int j = 0; j < 8; ++j) v8[j] *= bs;
      *(u32x4*)(Y + (size_t)(row0 + tk) * D + 512 + head * 64 + c8) = pack8(v8); }
    if (!(skip & 1)) {
        const int c4 = wave & 3, dir = wave >> 2, fr = lane & 15, fq = lane >> 4;
        LAS float* CB = (LAS float*)wpriv;
        LAS float* AA = CB + 16 * 64;
        const LAS bf16* SW = dir ? SWB : SWF;
        auto trow = [&](int tau) { return 16 * c4 + (dir ? 15 - tau : tau); };
        float c[16], ci[16];
        { float run = 1.f;
#pragma unroll
          for (int t = 0; t < 16; ++t) { run *= bf1(SW[trow(t) * SP_ + lane]); c[t] = run; ci[t] = __builtin_amdgcn_rcpf(run); CB[t * 64 + lane] = run; } }
        const int rec_dir = dir, bidx = isl ? (row0 >> 12) : ((row0 - NLAT) >> 8);
        const int tcl = isl ? 4 * ((row0 >> 6) & 63) + c4 : 4 * (((row0 - NLAT) >> 6) & 3) + c4;
        const int nproc = isl ? 16 + (dir ? 255 - tcl : tcl) : (dir ? 15 - tcl : tcl);
        unsigned char* rec = ws + WS_PRE + ((size_t)((rec_dir * 8 + bidx) * 12 + head) * NCHUNK16 + nproc) * PRE_REC;
        { const float cl = c[15]; float bk[32];
#pragma unroll
          for (int t = 0; t < 16; ++t) { const float e = cl * ci[t]; const int pos = 8 * (t >> 2) + (t & 3); bk[pos] = bf1(SB[trow(t) * SP_ + lane]) * e; bk[pos + 4] = bf1(SK[trow(t) * SP_ + lane]) * e; }
#pragma unroll
          for (int q4 = 0; q4 < 4; ++q4) { u32x4 o; o.x = pk2(bk[8 * q4], bk[8 * q4 + 1]); o.y = pk2(bk[8 * q4 + 2], bk[8 * q4 + 3]); o.z = pk2(bk[8 * q4 + 4], bk[8 * q4 + 5]); o.w = pk2(bk[8 * q4 + 6], bk[8 * q4 + 7]);
              *(u32x4*)(rec + PR_BK + lane * 64 + q4 * 16) = o; }
          *(float*)(rec + PR_GAM + lane * 4) = cl; }
        asm volatile("s_waitcnt lgkmcnt(0)" ::: "memory");
        bf16x8 fa[2], frr[2], fb[2], fk[2];
        { const int tr = trow(fr);
#pragma unroll
          for (int sx = 0; sx < 2; ++sx) { const int ch = 32 * sx + 8 * fq; float kk8[8], r8[8], b8[8], k8[8];
              unpack8(*(const LAS u32x4*)(SKK + tr * SP_ + ch), kk8); unpack8(*(const LAS u32x4*)(SR + tr * SP_ + ch), r8); unpack8(*(const LAS u32x4*)(SB + tr * SP_ + ch), b8); unpack8(*(const LAS u32x4*)(SK + tr * SP_ + ch), k8);
              const f32x4 c0 = *(const LAS f32x4*)(CB + fr * 64 + ch), c1 = *(const LAS f32x4*)(CB + fr * 64 + ch + 4);
              f32x4 p0 = (f32x4){1.f, 1.f, 1.f, 1.f}, p1 = p0; if (fr > 0) { p0 = *(const LAS f32x4*)(CB + (fr - 1) * 64 + ch); p1 = *(const LAS f32x4*)(CB + (fr - 1) * 64 + ch + 4); }
              float xa[8], xr[8], xb[8], xk[8];
#pragma unroll
              for (int j = 0; j < 8; ++j) { const float ec = j < 4 ? c0[j] : c1[j - 4], ep = j < 4 ? p0[j] : p1[j - 4]; const float en = __builtin_amdgcn_rcpf(ec);
                  xa[j] = -kk8[j] * ep; xr[j] = r8[j] * ec; xb[j] = b8[j] * en; xk[j] = k8[j] * en; }
              const u32x4 ua = pack8(xa), ur = pack8(xr), ub = pack8(xb), uk = pack8(xk);
              fa[sx] = __builtin_bit_cast(bf16x8, ua); frr[sx] = __builtin_bit_cast(bf16x8, ur); fb[sx] = __builtin_bit_cast(bf16x8, ub); fk[sx] = __builtin_bit_cast(bf16x8, uk); } }
        f32x4 gab = (f32x4){0.f, 0.f, 0.f, 0.f}, gak = gab, grb = gab, grk = gab;
#pragma unroll
        for (int sx = 0; sx < 2; ++sx) { gab = __builtin_amdgcn_mfma_f32_16x16x32_bf16(fa[sx], fb[sx], gab, 0, 0, 0); gak = __builtin_amdgcn_mfma_f32_16x16x32_bf16(fa[sx], fk[sx], gak, 0, 0, 0);
            grb = __builtin_amdgcn_mfma_f32_16x16x32_bf16(frr[sx], fb[sx], grb, 0, 0, 0); grk = __builtin_amdgcn_mfma_f32_16x16x32_bf16(frr[sx], fk[sx], grk, 0, 0, 0); }
#pragma unroll
        for (int j = 0; j < 4; ++j) { const int tau = 4 * fq + j; const bool lo = fr < tau, le = fr <= tau;
            AA[tau * 16 + fr] = lo ? gab[j] : 0.f; AA[256 + tau * 16 + fr] = lo ? gak[j] : 0.f; grb[j] = le ? grb[j] : 0.f; grk[j] = le ? grk[j] : 0.f; }
        asm volatile("s_waitcnt lgkmcnt(0)" ::: "memory");
        float wv[16], mv[16];
#pragma unroll
        for (int t = 0; t < 16; ++t) { const float ab = -bf1(SKK[trow(t) * SP_ + lane]) * (t > 0 ? c[t - 1] : 1.0f); float accw = ab, accm = AA[256 + t * 16 + fr];
#pragma unroll
            for (int q4 = 0; q4 < 4; ++q4) { if (4 * q4 < t) { const f32x4 cf = *(const LAS f32x4*)(AA + t * 16 + 4 * q4);
#pragma unroll
                for (int j = 0; j < 4; ++j) if (4 * q4 + j < t) { accw += cf[j] * wv[4 * q4 + j]; accm += cf[j] * mv[4 * q4 + j]; } } }
            wv[t] = accw; mv[t] = accm; }
        { LAS bf16* stg = (LAS bf16*)CB; const int pp = kperm_pos(lane);
#pragma unroll
          for (int t = 0; t < 16; ++t) { stg[t * 64 + pp] = (bf16)f2bf(wv[t]); stg[1024 + t * 64 + pp] = (bf16)f2bf(bf1(SR[trow(t) * SP_ + lane]) * c[t]); }
          asm volatile("s_waitcnt lgkmcnt(0)" ::: "memory");
#pragma unroll
          for (int q4 = 0; q4 < 4; ++q4) *(u32x4*)(rec + PR_WP + (q4 * 64 + lane) * 16) = *(const LAS u32x4*)((LAS unsigned char*)stg + (q4 * 64 + lane) * 16); }
        { LAS bf16* stg = (LAS bf16*)AA; const int ps = 8 * (fr >> 2) + (fr & 3);
          asm volatile("s_waitcnt lgkmcnt(0)" ::: "memory");
#pragma unroll
          for (int j = 0; j < 4; ++j) { const int tau = 4 * fq + j; stg[tau * 32 + ps] = (bf16)f2bf(grb[j]); stg[tau * 32 + ps + 4] = (bf16)f2bf(grk[j]); }
          if (lane < 16) {
#pragma unroll
              for (int t = 0; t < 16; ++t) stg[512 + t * 16 + lane] = (bf16)f2bf(mv[t]); }
          asm volatile("s_waitcnt lgkmcnt(0)" ::: "memory");
          *(u32x4*)(rec + PR_ARBK + lane * 16) = *(const LAS u32x4*)((LAS unsigned char*)stg + lane * 16);
          if (lane < 32) *(u32x4*)(rec + PR_ARBK + 1024 + lane * 16) = *(const LAS u32x4*)((LAS unsigned char*)stg + 1024 + lane * 16); }
        if (dir == 0) { float v16[16];
#pragma unroll
            for (int t = 0; t < 16; ++t) v16[t] = bf1(SV[(16 * c4 + t) * SP_ + lane]);
            const int tcg = isl ? 16 + tcl : tcl;
            unsigned char* vrec = ws + WS_VT + ((size_t)(bidx * 12 + head) * NCHUNK16 + tcg) * 2048 + lane * 32;
            u32x4 o; o.x = pk2(v16[0], v16[1]); o.y = pk2(v16[2], v16[3]); o.z = pk2(v16[4], v16[5]); o.w = pk2(v16[6], v16[7]); *(u32x4*)vrec = o;
            o.x = pk2(v16[8], v16[9]); o.y = pk2(v16[10], v16[11]); o.z = pk2(v16[12], v16[13]); o.w = pk2(v16[14], v16[15]); *(u32x4*)(vrec + 16) = o; }
    }
    LDS_BAR();
    }
}

__device__ __forceinline__ float dpp_xor1(float x) { return __builtin_bit_cast(float, __builtin_amdgcn_update_dpp(0, __builtin_bit_cast(int, x), 0xB1, 0xF, 0xF, false)); }
__device__ __forceinline__ float dpp_xor2(float x) { return __builtin_bit_cast(float, __builtin_amdgcn_update_dpp(0, __builtin_bit_cast(int, x), 0x4E, 0xF, 0xF, false)); }
__device__ __forceinline__ int chain_row(int dir, int b, int s) {
    if (s < CTXL) return NLAT + b * CTXL + (dir ? (CTXL - 1 - s) : s);
    const int t = s - CTXL; return b * T + (dir ? (T - 1 - t) : t);
}
__device__ __forceinline__ float dpp_hmirror(float x) { return __builtin_bit_cast(float, __builtin_amdgcn_update_dpp(0, __builtin_bit_cast(int, x), 0x141, 0xF, 0xF, false)); }
struct RwRec { u32x4 wp[2], rp[2], bk[4], arbk; u32x2 mak, vt[2]; f32x4 gam[4]; };
__device__ __forceinline__ void rw_load(RwRec& r, const LAS unsigned char* rec, int fr, int kg, int hv, int dir) {
#pragma unroll
    for (int sx = 0; sx < 2; ++sx) { r.wp[sx] = *(const LAS u32x4*)(rec + PR_WP + fr * 128 + sx * 64 + kg * 16); r.rp[sx] = *(const LAS u32x4*)(rec + PR_RP + fr * 128 + sx * 64 + kg * 16); }
#pragma unroll
    for (int i = 0; i < 4; ++i) { r.bk[i] = *(const LAS u32x4*)(rec + PR_BK + (16 * i + fr) * 64 + kg * 16); r.gam[i] = *(const LAS f32x4*)(rec + PR_GAM + (16 * i + 4 * kg) * 4); }
    r.arbk = *(const LAS u32x4*)(rec + PR_ARBK + fr * 64 + kg * 16);
    r.mak = *(const LAS u32x2*)(rec + PR_MAK + fr * 32 + kg * 8);
#pragma unroll
    for (int q = 0; q < 2; ++q) r.vt[q] = *(const LAS u32x2*)(rec + PRE_REC + (16 * (2 * hv + q) + fr) * 32 + (dir ? (12 - 4 * kg) : 4 * kg) * 2);
}
constexpr int RW_R = 6, RW_SLOT = PRE_REC + 2048;
__device__ __forceinline__ void rwkv_chain_mfma(KArgs a, int task_base, LAS unsigned char* lds) {
    const int t_ = tid_fresh(); const int lane = t_ & 63, fr = lane & 15, kg = lane >> 4; const int wave = __builtin_amdgcn_readfirstlane(t_ >> 6);
    unsigned char* ws = a->ws;
    bf16* OC = (bf16*)(ws + WS_OC);
    const int cid = (task_base >> 2) + (wave >> 2), wq = wave & 3, dir = cid / 96, b = (cid % 96) / 12, h = cid % 12;
    const bool comp = wq < 2; const int hv = wq & 1;
    const unsigned char* rec0 = ws + WS_PRE + (size_t)((dir * 8 + b) * 12 + h) * NCHUNK16 * PRE_REC;
    const unsigned char* vrec0 = ws + WS_VT + (size_t)(b * 12 + h) * NCHUNK16 * 2048;
    LAS unsigned char* ring = lds + (wave >> 2) * (RW_R * RW_SLOT);
    auto tchunk = [&](int n) { return n < 16 ? (dir ? 15 - n : n) : 16 + (dir ? 255 - (n - 16) : (n - 16)); };
    auto issue = [&](int n) { const int nn = n < NCHUNK16 ? n : NCHUNK16 - 1; LAS unsigned char* slot = ring + (n % RW_R) * RW_SLOT;
#pragma unroll
        for (int jj = 0; jj < 3; ++jj) { const int j = 3 * wq + jj;
            const unsigned char* src = (j < 10 ? rec0 + (size_t)nn * PRE_REC + 1024 * j : vrec0 + (size_t)tchunk(nn) * 2048 + 1024 * (j - 10)) + lane * 16;
            __builtin_amdgcn_global_load_lds((const unsigned*)src, (LAS unsigned*)(slot + 1024 * j), 16, 0, 0); } };
    f32x4 ST[2][4];
#pragma unroll
    for (int q = 0; q < 2; ++q)
#pragma unroll
        for (int i = 0; i < 4; ++i) ST[q][i] = (f32x4){0.f, 0.f, 0.f, 0.f};
    unsigned uvU[2][2] = {{0u, 0u}, {0u, 0u}};
#pragma unroll
    for (int n = 0; n < RW_R - 1; ++n) issue(n);
    for (int n = 0; n < NCHUNK16; ++n) {
        if (comp && n >= RW_R - 1) asm volatile("s_waitcnt vmcnt(22)" ::: "memory"); else asm volatile("s_waitcnt vmcnt(12)" ::: "memory");
        __builtin_amdgcn_s_barrier(); asm volatile("" ::: "memory");
        issue(n + RW_R - 1);
        if (comp) {
            RwRec cur; rw_load(cur, ring + (n % RW_R) * RW_SLOT, fr, kg, hv, dir);
            u32x4 fmak; fmak.x = 0u; fmak.y = 0u; fmak.z = cur.mak.x; fmak.w = cur.mak.y;
            const int row = chain_row(dir, b, 16 * n + fr);
#pragma unroll
            for (int q = 0; q < 2; ++q) {
                u32x4 fs[2];
#pragma unroll
                for (int sx = 0; sx < 2; ++sx) { fs[sx].x = pk2(ST[q][2 * sx][0], ST[q][2 * sx][1]); fs[sx].y = pk2(ST[q][2 * sx][2], ST[q][2 * sx][3]); fs[sx].z = pk2(ST[q][2 * sx + 1][0], ST[q][2 * sx + 1][1]); fs[sx].w = pk2(ST[q][2 * sx + 1][2], ST[q][2 * sx + 1][3]); }
                u32x2 vt = cur.vt[q]; if (dir) { const unsigned x = vt.x, y = vt.y; vt.x = (y >> 16) | (y << 16); vt.y = (x >> 16) | (x << 16); }
                u32x4 fuv; fuv.x = uvU[q][0]; fuv.y = uvU[q][1]; fuv.z = vt.x; fuv.w = vt.y;
                f32x4 U = (f32x4){0.f, 0.f, 0.f, 0.f};
                U = __builtin_amdgcn_mfma_f32_16x16x32_bf16(__builtin_bit_cast(bf16x8, cur.wp[0]), __builtin_bit_cast(bf16x8, fs[0]), U, 0, 0, 0);
                U = __builtin_amdgcn_mfma_f32_16x16x32_bf16(__builtin_bit_cast(bf16x8, cur.wp[1]), __builtin_bit_cast(bf16x8, fs[1]), U, 0, 0, 0);
                U = __builtin_amdgcn_mfma_f32_16x16x32_bf16(__builtin_bit_cast(bf16x8, fmak), __builtin_bit_cast(bf16x8, fuv), U, 0, 0, 0);
                uvU[q][0] = pk2(U[0], U[1]); uvU[q][1] = pk2(U[2], U[3]); fuv.x = uvU[q][0]; fuv.y = uvU[q][1];
                f32x4 OT = (f32x4){0.f, 0.f, 0.f, 0.f};
                OT = __builtin_amdgcn_mfma_f32_16x16x32_bf16(__builtin_bit_cast(bf16x8, fs[0]), __builtin_bit_cast(bf16x8, cur.rp[0]), OT, 0, 0, 0);
                OT = __builtin_amdgcn_mfma_f32_16x16x32_bf16(__builtin_bit_cast(bf16x8, fs[1]), __builtin_bit_cast(bf16x8, cur.rp[1]), OT, 0, 0, 0);
                OT = __builtin_amdgcn_mfma_f32_16x16x32_bf16(__builtin_bit_cast(bf16x8, fuv), __builtin_bit_cast(bf16x8, cur.arbk), OT, 0, 0, 0);
#pragma unroll
                for (int i = 0; i < 4; ++i) ST[q][i] = __builtin_amdgcn_mfma_f32_16x16x32_bf16(__builtin_bit_cast(bf16x8, cur.bk[i]), __builtin_bit_cast(bf16x8, fuv), ST[q][i] * cur.gam[i], 0, 0, 0);
                u32x2 o; o.x = pk2(OT[0], OT[1]); o.y = pk2(OT[2], OT[3]); *(u32x2*)(OC + ((size_t)dir * MALL + row) * CW + h * 64 + 16 * (2 * hv + q) + 4 * kg) = o;
            }
        }
    }
    asm volatile("s_waitcnt vmcnt(0)" ::: "memory");
    __builtin_amdgcn_s_barrier(); asm volatile("" ::: "memory");
}
__device__ __forceinline__ void hgrn_prep_item(KArgs a, int l, int item, LAS unsigned char* lds, bool dry, int nx = 0x7fffffff) {
    const int tid = tid_fresh();
    unsigned char* ws = a->ws;
    bf16* P = (bf16*)(ws + WS_P); bf16* HQB = (bf16*)(ws + WS_HQB); float* HG = (float*)(ws + WS_HG);
    const int cn = item % 68, bh = item / 68, h = bh % 6, b = bh / 6;
    const int row0 = cn < 4 ? NLAT + b * CTXL + 64 * cn : b * T + 64 * (cn - 4);
    constexpr int QP = 136;
    LAS bf16* SQ = (LAS bf16*)lds; LAS bf16* KF = SQ + 64 * QP; LAS bf16* KB = KF + 64 * QP; LAS bf16* QB = KB + 64 * QP;
    LAS float* LF = (LAS float*)(QB + 64 * QP); LAS float* LBk = LF + 64 * 128;
    LAS float* tot = LBk + 64 * 128;
    LAS float* lbs = tot + 1024;
    if (tid < 256) { const int dr = tid >> 7, ch = h * 128 + (tid & 127); float lb = 0.f;
        if (l != 0) { const float l0 = a->in[I_LB][((size_t)dr * DEPTH + 0) * BW + ch], l1 = a->in[I_LB][((size_t)dr * DEPTH + 1) * BW + ch]; lb = __builtin_amdgcn_rcpf(1.0f + __expf(l0 - l1)); }
        lbs[tid] = lb; }
    const int ta = tid >> 3, d0 = (tid & 7) * 16;
    bf16* prow = P + (size_t)(row0 + ta) * INC + h * 128 + d0;
    u32x4 rq[2], rf[2], rb[2];
    rq[0] = *(const u32x4*)(prow + OFF_Q); rq[1] = *(const u32x4*)(prow + OFF_Q + 8); rf[0] = *(const u32x4*)(prow + OFF_ZF); rf[1] = *(const u32x4*)(prow + OFF_ZF + 8); rb[0] = *(const u32x4*)(prow + OFF_ZB); rb[1] = *(const u32x4*)(prow + OFF_ZB + 8);
    LDS_BAR();
#pragma unroll
    for (int hf = 0; hf < 2; ++hf) { float qf[8], zf[8], zb[8], oq[8], of[8], ob[8]; unpack8(rq[hf], qf); unpack8(rf[hf], zf); unpack8(rb[hf], zb);
        const int dd = d0 + 8 * hf; f32x4 lf0, lf1, lb0, lb1;
#pragma unroll
        for (int j = 0; j < 8; ++j) { const float lF = lbs[dd + j], lB = lbs[128 + dd + j];
            const float ff = lF + (1.0f - lF) * sigmoidf_(zf[j]), fb = lB + (1.0f - lB) * sigmoidf_(zb[j]);
            const float a1 = fmaxf(__logf(ff), -60.0f), a2 = fmaxf(__logf(fb), -60.0f);
            if (j < 4) { lf0[j] = a1; lb0[j] = a2; } else { lf1[j - 4] = a1; lb1[j - 4] = a2; }
            oq[j] = siluf_(qf[j]); of[j] = 1.0f - ff; ob[j] = 1.0f - fb; }
        *(LAS u32x4*)(SQ + ta * QP + dd) = pack8(oq); *(LAS u32x4*)(KF + ta * QP + dd) = pack8(of); *(LAS u32x4*)(KB + ta * QP + dd) = pack8(ob);
        *(LAS f32x4*)(LF + ta * 128 + dd) = lf0; *(LAS f32x4*)(LF + ta * 128 + dd + 4) = lf1; *(LAS f32x4*)(LBk + ta * 128 + dd) = lb0; *(LAS f32x4*)(LBk + ta * 128 + dd + 4) = lb1; }
    LDS_BAR();
    prep_touch(a, nx, lds);
    { const int d = tid & 127, qt = tid >> 7; float r1 = 0.f, r2 = 0.f;
#pragma unroll
      for (int i = 0; i < 16; ++i) { const int tp = 16 * qt + i; r1 += LF[tp * 128 + d]; LF[tp * 128 + d] = r1; r2 += LBk[(63 - tp) * 128 + d]; LBk[(63 - tp) * 128 + d] = r2; }
      tot[qt * 128 + d] = r1; tot[512 + qt * 128 + d] = r2; }
    LDS_BAR();
    LAS float* bas = lbs + 256;
    LAS float* bmd = bas + 1024;
    { const int d = tid & 127, dr = (tid >> 7) & 1; if (tid < 256) { const LAS float* tt = tot + 512 * dr; const float t0 = tt[d], t1 = tt[128 + d], t2 = tt[256 + d], t3 = tt[384 + d];
        bas[(dr * 4 + 0) * 128 + d] = 0.f; bas[(dr * 4 + 1) * 128 + d] = t0; bas[(dr * 4 + 2) * 128 + d] = t0 + t1; bas[(dr * 4 + 3) * 128 + d] = t0 + t1 + t2; bmd[dr * 128 + d] = t0 + t1;
        const int npr = dr == 0 ? cn : (cn < 4 ? 3 - cn : 4 + 63 - (cn - 4)); float* g = (dry ? (float*)(ws + WS_END + 8 * MiB) : HG) + ((size_t)(((dr * 8 + b) * 6 + h) * 68 + npr)) * 256; g[d] = __expf(t0 + t1); g[128 + d] = __expf(t2 + t3); } }
    LDS_BAR();
#pragma unroll
    for (int hf = 0; hf < 2; ++hf) { const int dd = d0 + 8 * hf; float sq[8], kf[8], kb[8];
        unpack8(*(const LAS u32x4*)(SQ + ta * QP + dd), sq); unpack8(*(const LAS u32x4*)(KF + ta * QP + dd), kf); unpack8(*(const LAS u32x4*)(KB + ta * QP + dd), kb);
        float oqf[8], okf[8], oqb[8], okb[8];
#pragma unroll
        for (int dr = 0; dr < 2; ++dr) { const int tp = dr ? 63 - ta : ta, q = tp >> 4; const LAS float* pf = (dr ? LBk : LF) + ta * 128 + dd;
            const f32x4 p0 = *(const LAS f32x4*)pf, p1 = *(const LAS f32x4*)(pf + 4), b0 = *(const LAS f32x4*)(bas + (dr * 4 + q) * 128 + dd), b1 = *(const LAS f32x4*)(bas + (dr * 4 + q) * 128 + dd + 4),
                        m0 = *(const LAS f32x4*)(bmd + dr * 128 + dd), m1 = *(const LAS f32x4*)(bmd + dr * 128 + dd + 4);
#pragma unroll
            for (int j = 0; j < 8; ++j) { const float bt = (j < 4 ? p0[j] + b0[j] : p1[j - 4] + b1[j - 4]), bm = j < 4 ? m0[j] : m1[j - 4];
                const float eq = __expf(fminf(bt - bm, 80.0f)), ek = __expf(fminf(bm - bt, 80.0f));
                if (dr == 0) { oqf[j] = sq[j] * eq; okf[j] = kf[j] * ek; } else { oqb[j] = sq[j] * eq; okb[j] = kb[j] * ek; } } }
        *(LAS u32x4*)(QB + ta * QP + dd) = pack8(oqf); *(LAS u32x4*)(KF + ta * QP + dd) = pack8(okf); *(LAS u32x4*)(KB + ta * QP + dd) = pack8(okb); *(LAS u32x4*)(SQ + ta * QP + dd) = pack8(oqb); }
    bf16* prow_o = dry ? (bf16*)(ws + WS_END) + (size_t)((row0 + ta) & 511) * INC + h * 128 + d0 : prow; bf16* hqb_o = dry ? (bf16*)(ws + WS_END) : HQB;
#pragma unroll
    for (int hf = 0; hf < 2; ++hf) { const int dd = d0 + 8 * hf;
        *(u32x4*)(prow_o + OFF_Q + 8 * hf) = *(const LAS u32x4*)(QB + ta * QP + dd); *(u32x4*)(prow_o + OFF_ZF + 8 * hf) = *(const LAS u32x4*)(KF + ta * QP + dd); *(u32x4*)(prow_o + OFF_ZB + 8 * hf) = *(const LAS u32x4*)(KB + ta * QP + dd);
        *(u32x4*)(hqb_o + (size_t)(dry ? ((row0 + ta) & 1023) : (row0 + ta)) * BW + h * 128 + dd) = *(const LAS u32x4*)(SQ + ta * QP + dd); }
    LDS_BAR();
}
__device__ __forceinline__ unsigned tr_addr(const LAS bf16* X, int pitch, int r0, int c0, int lane) { const int i = lane & 15, g = lane >> 4; return (unsigned)(size_t)(X + (r0 + 8 * g + (i >> 2)) * pitch + c0 + 4 * (i & 3)); }
__device__ __forceinline__ void tr8x4(u32x2 (&lo)[4], u32x2 (&hi)[4], unsigned a0, unsigned a1, unsigned a2, unsigned a3, unsigned rowstep4) {
    const unsigned b0 = a0 + rowstep4, b1 = a1 + rowstep4, b2 = a2 + rowstep4, b3 = a3 + rowstep4;
    asm volatile("ds_read_b64_tr_b16 %0, %8\n\tds_read_b64_tr_b16 %1, %9\n\tds_read_b64_tr_b16 %2, %10\n\tds_read_b64_tr_b16 %3, %11\n\t"
                 "ds_read_b64_tr_b16 %4, %12\n\tds_read_b64_tr_b16 %5, %13\n\tds_read_b64_tr_b16 %6, %14\n\tds_read_b64_tr_b16 %7, %15\n\ts_waitcnt lgkmcnt(0)"
                 : "=&v"(lo[0]), "=&v"(lo[1]), "=&v"(lo[2]), "=&v"(lo[3]), "=&v"(hi[0]), "=&v"(hi[1]), "=&v"(hi[2]), "=&v"(hi[3])
                 : "v"(a0), "v"(a1), "v"(a2), "v"(a3), "v"(b0), "v"(b1), "v"(b2), "v"(b3) : "memory");
}
__device__ __forceinline__ void tr_half(u32x2 (&vl)[8], u32x2 (&vh)[8], u32x2 (&xl)[2], u32x2 (&xh)[2], unsigned av, unsigned ak, unsigned ax) {
    asm volatile(
        "ds_read_b64_tr_b16 %0, %20\n\tds_read_b64_tr_b16 %1, %20 offset:32\n\tds_read_b64_tr_b16 %2, %20 offset:64\n\tds_read_b64_tr_b16 %3, %20 offset:96\n\t"
        "ds_read_b64_tr_b16 %4, %20 offset:128\n\tds_read_b64_tr_b16 %5, %20 offset:160\n\tds_read_b64_tr_b16 %6, %20 offset:192\n\tds_read_b64_tr_b16 %7, %20 offset:224\n\t"
        "ds_read_b64_tr_b16 %8, %20 offset:1088\n\tds_read_b64_tr_b16 %9, %20 offset:1120\n\tds_read_b64_tr_b16 %10, %20 offset:1152\n\tds_read_b64_tr_b16 %11, %20 offset:1184\n\t"
        "ds_read_b64_tr_b16 %12, %20 offset:1216\n\tds_read_b64_tr_b16 %13, %20 offset:1248\n\tds_read_b64_tr_b16 %14, %20 offset:1280\n\tds_read_b64_tr_b16 %15, %20 offset:1312\n\t"
        "ds_read_b64_tr_b16 %16, %21\n\tds_read_b64_tr_b16 %17, %22\n\tds_read_b64_tr_b16 %18, %21 offset:1088\n\tds_read_b64_tr_b16 %19, %22 offset:1088\n\ts_waitcnt lgkmcnt(0)"
        : "=&v"(vl[0]), "=&v"(vl[1]), "=&v"(vl[2]), "=&v"(vl[3]), "=&v"(vl[4]), "=&v"(vl[5]), "=&v"(vl[6]), "=&v"(vl[7]),
          "=&v"(vh[0]), "=&v"(vh[1]), "=&v"(vh[2]), "=&v"(vh[3]), "=&v"(vh[4]), "=&v"(vh[5]), "=&v"(vh[6]), "=&v"(vh[7]),
          "=&v"(xl[0]), "=&v"(xl[1]), "=&v"(xh[0]), "=&v"(xh[1])
        : "v"(av), "v"(ak), "v"(ax) : "memory");
}
__device__ __forceinline__ bf16x8 mk8(u32x2 lo, u32x2 hi) { u32x4 v; v.x = lo.x; v.y = lo.y; v.z = hi.x; v.w = hi.y; return __builtin_bit_cast(bf16x8, v); }
__device__ __forceinline__ void hgrn_chain_lean(KArgs a, int cid, LAS unsigned char* lds) {
    const int tid = tid_fresh(), lane = tid & 63, wave = tid >> 6, fr = lane & 15, fq = lane >> 4;
    unsigned char* ws = a->ws;
    const bf16* P = (const bf16*)(ws + WS_P); const bf16* HQB = (const bf16*)(ws + WS_HQB); const float* HG = (const float*)(ws + WS_HG); bf16* OB = (bf16*)(ws + WS_OB);
    const int dir = cid / 48, b = (cid % 48) / 6, h = cid % 6;
    constexpr int QP = 136, SP = 72;
    LAS bf16* qs = (LAS bf16*)lds;
    LAS bf16* ks = qs + 64 * QP;
    LAS bf16* vs = ks + 64 * QP;
    LAS bf16* pl = vs + 64 * QP;
    LAS bf16* sT = pl + 64 * SP;
    LAS float* gm = (LAS float*)(sT + 128 * QP);
    const int ta = tid >> 3, d0 = (tid & 7) * 16;
    const int koff = dir ? OFF_ZB : OFF_ZF;
    f32x4 S[8];
#pragma unroll
    for (int vt = 0; vt < 8; ++vt) S[vt] = (f32x4){0.f, 0.f, 0.f, 0.f};
    u32x4 rq[2], rk[2], rv[2]; float rg = 0.f;
    auto load_chunk = [&](int n) { const int row = chain_row(dir, b, 64 * n + ta); const bf16* pr = P + (size_t)row * INC + h * 128 + d0;
        const bf16* qr = dir ? HQB + (size_t)row * BW + h * 128 + d0 : pr + OFF_Q;
        rq[0] = *(const u32x4*)qr; rq[1] = *(const u32x4*)(qr + 8); rk[0] = *(const u32x4*)(pr + koff); rk[1] = *(const u32x4*)(pr + koff + 8); rv[0] = *(const u32x4*)(pr + OFF_I); rv[1] = *(const u32x4*)(pr + OFF_I + 8);
        if (tid < 256) rg = HG[((size_t)(((dir * 8 + b) * 6 + h) * 68 + n)) * 256 + tid]; };
    load_chunk(0);
    constexpr int NCH = (CTXL + T) / 64;
    for (int n = 0; n < NCH; ++n) {
        const int s0 = n * 64;
        *(LAS u32x4*)(qs + ta * QP + d0) = rq[0]; *(LAS u32x4*)(qs + ta * QP + d0 + 8) = rq[1]; *(LAS u32x4*)(ks + ta * QP + d0) = rk[0]; *(LAS u32x4*)(ks + ta * QP + d0 + 8) = rk[1];
        *(LAS u32x4*)(vs + ta * QP + d0) = rv[0]; *(LAS u32x4*)(vs + ta * QP + d0 + 8) = rv[1]; if (tid < 256) gm[tid] = rg;
        if (n + 1 < NCH) load_chunk(n + 1);
        LDS_BAR();
        { const f32x4 g4 = *(const LAS f32x4*)(gm + 16 * wave + 4 * fq);
#pragma unroll
          for (int vt = 0; vt < 8; ++vt) { S[vt] = S[vt] * g4; u32x2 o; o.x = pk2(S[vt][0], S[vt][1]); o.y = pk2(S[vt][2], S[vt][3]); *(LAS u32x2*)(sT + (16 * vt + fr) * QP + 16 * wave + 4 * fq) = o; } }
        { const int tt = wave >> 1;
#pragma unroll
          for (int u = 0; u < 2; ++u) { const int sg = 2 * (wave & 1) + u; f32x4 acc = (f32x4){0.f, 0.f, 0.f, 0.f};
              if (sg <= tt) {
#pragma unroll
                  for (int kq = 0; kq < 4; ++kq) { const bf16x8 af = *(const LAS bf16x8*)(ks + (16 * sg + fr) * QP + 32 * kq + 8 * fq), bfm = *(const LAS bf16x8*)(qs + (16 * tt + fr) * QP + 32 * kq + 8 * fq);
                      acc = __builtin_amdgcn_mfma_f32_16x16x32_bf16(af, bfm, acc, 0, 0, 0); }
                  if (sg == tt) {
#pragma unroll
                      for (int j = 0; j < 4; ++j) if (4 * fq + j > fr) acc[j] = 0.f; }
              }
              u32x2 o; o.x = pk2(acc[0], acc[1]); o.y = pk2(acc[2], acc[3]); *(LAS u32x2*)(pl + (16 * tt + fr) * SP + 16 * sg + 4 * fq) = o; } }
        LDS_BAR();
        f32x4 oacc[4];
#pragma unroll
        for (int tt = 0; tt < 4; ++tt) { f32x4 acc = (f32x4){0.f, 0.f, 0.f, 0.f};
#pragma unroll
            for (int kq = 0; kq < 4; ++kq) { const bf16x8 af = *(const LAS bf16x8*)(sT + (16 * wave + fr) * QP + 32 * kq + 8 * fq), bfm = *(const LAS bf16x8*)(qs + (16 * tt + fr) * QP + 32 * kq + 8 * fq);
                acc = __builtin_amdgcn_mfma_f32_16x16x32_bf16(af, bfm, acc, 0, 0, 0); }
            oacc[tt] = acc; }
        const unsigned rs4 = (unsigned)(4 * QP * 2);
#pragma unroll
        for (int kq = 0; kq < 2; ++kq) {
            u32x2 vl_[8], vh_[8], xl_[2], xh_[2];
            static_assert(QP == 136, "tr_half's immediates assume 272-byte rows");
            tr_half(vl_, vh_, xl_, xh_, tr_addr(vs, QP, 32 * kq, 0, lane), tr_addr(ks, QP, 32 * kq, 16 * wave, lane), tr_addr(vs, QP, 32 * kq, 16 * wave, lane));
            __builtin_amdgcn_sched_barrier(0);
            { const bf16x8 af = mk8(xl_[1], xh_[1]);
#pragma unroll
              for (int tt = 0; tt < 4; ++tt) { const bf16x8 bfm = *(const LAS bf16x8*)(pl + (16 * tt + fr) * SP + 32 * kq + 8 * fq); oacc[tt] = __builtin_amdgcn_mfma_f32_16x16x32_bf16(af, bfm, oacc[tt], 0, 0, 0); } }
            { const bf16x8 af = mk8(xl_[0], xh_[0]);
#pragma unroll
              for (int vt = 0; vt < 8; ++vt) S[vt] = __builtin_amdgcn_mfma_f32_16x16x32_bf16(af, mk8(vl_[vt], vh_[vt]), S[vt], 0, 0, 0); }
        }
#pragma unroll
        for (int tt = 0; tt < 4; ++tt) { const int row = chain_row(dir, b, s0 + 16 * tt + fr);
            u32x2 o; o.x = pk2(oacc[tt][0], oacc[tt][1]); o.y = pk2(oacc[tt][2], oacc[tt][3]); *(u32x2*)(OB + ((size_t)dir * MALL + row) * BW + h * 128 + 16 * wave + 4 * fq) = o; }
        { const f32x4 ge = *(const LAS f32x4*)(gm + 128 + 16 * wave + 4 * fq);
#pragma unroll
          for (int vt = 0; vt < 8; ++vt) S[vt] = S[vt] * ge; }
        LDS_BAR();
    }
}
__device__ __forceinline__ void hgrn_chain_mfma(KArgs a, int l, int cid, LAS unsigned char* lds) {
    const int tid = tid_fresh(), lane = tid & 63, wave = tid >> 6, fr = lane & 15, fq = lane >> 4;
    unsigned char* ws = a->ws;
    const bf16* P = (const bf16*)(ws + WS_P); bf16* OB = (bf16*)(ws + WS_OB);
    const int dir = cid / 48, b = (cid % 48) / 6, h = cid % 6;
    constexpr int QP = 136, SP = 72;
    LAS bf16* qs = (LAS bf16*)lds;
    LAS bf16* ks = qs + 64 * QP;
    LAS bf16* kT = ks + 64 * QP;
    LAS bf16* vT = kT + 128 * SP;
    LAS bf16* pl = vT + 128 * SP;
    LAS bf16* sT = pl + 64 * SP;
    LAS float* tot = (LAS float*)(sT + 128 * QP);
    LAS float* gmid = tot + 512;
    LAS float* gend = gmid + 128;
    LAS float* lbs = gend + 128;
    LAS float* lfb = (LAS float*)sT;
    const int d = tid & 127, qt = tid >> 7;
    const int tau_a = tid >> 3, d0 = (tid & 7) * 16;
    if (tid < 128) { const int ch = h * 128 + tid; float lb = 0.f;
        if (l != 0) { const float l0 = a->in[I_LB][((size_t)dir * DEPTH + 0) * BW + ch], l1 = a->in[I_LB][((size_t)dir * DEPTH + 1) * BW + ch]; lb = 1.0f / (1.0f + __expf(l0 - l1)); }
        lbs[tid] = lb; }
    f32x4 S[8];
#pragma unroll
    for (int vt = 0; vt < 8; ++vt) S[vt] = (f32x4){0.f, 0.f, 0.f, 0.f};
    const int zoff = dir ? OFF_ZB : OFF_ZF;
    u32x4 rq[2], ri[2], rz[2];
    { const bf16* pr = P + (size_t)chain_row(dir, b, tau_a) * INC + h * 128 + d0;
      rq[0] = *(const u32x4*)(pr + OFF_Q); rq[1] = *(const u32x4*)(pr + OFF_Q + 8); ri[0] = *(const u32x4*)(pr + OFF_I); ri[1] = *(const u32x4*)(pr + OFF_I + 8); rz[0] = *(const u32x4*)(pr + zoff); rz[1] = *(const u32x4*)(pr + zoff + 8); }
    __syncthreads();
    constexpr int NCH = (CTXL + T) / 64;
    for (int n = 0; n < NCH; ++n) {
        const int s0 = n * 64;
#pragma unroll
        for (int hf = 0; hf < 2; ++hf) { float qf[8], zf[8], oq[8], ok[8]; unpack8(rq[hf], qf); unpack8(rz[hf], zf);
            const int dd = d0 + 8 * hf; const f32x4 lb0 = *(const LAS f32x4*)(lbs + dd), lb1 = *(const LAS f32x4*)(lbs + dd + 4); f32x4 lf0, lf1;
#pragma unroll
            for (int j = 0; j < 8; ++j) { const float lb = j < 4 ? lb0[j] : lb1[j - 4]; const float f = lb + (1.0f - lb) * sigmoidf_(zf[j]); const float lf = fmaxf(__logf(f), -60.0f);
                if (j < 4) lf0[j] = lf; else lf1[j - 4] = lf; oq[j] = siluf_(qf[j]); ok[j] = 1.0f - f; }
            *(LAS u32x4*)(qs + tau_a * QP + dd) = pack8(oq); *(LAS u32x4*)(ks + tau_a * QP + dd) = pack8(ok);
            *(LAS f32x4*)(lfb + tau_a * 128 + dd) = lf0; *(LAS f32x4*)(lfb + tau_a * 128 + dd + 4) = lf1;
            const u32x4 vv = ri[hf];
            vT[(dd + 0) * SP + tau_a] = (bf16)(vv.x & 0xffffu); vT[(dd + 1) * SP + tau_a] = (bf16)(vv.x >> 16); vT[(dd + 2) * SP + tau_a] = (bf16)(vv.y & 0xffffu); vT[(dd + 3) * SP + tau_a] = (bf16)(vv.y >> 16);
            vT[(dd + 4) * SP + tau_a] = (bf16)(vv.z & 0xffffu); vT[(dd + 5) * SP + tau_a] = (bf16)(vv.z >> 16); vT[(dd + 6) * SP + tau_a] = (bf16)(vv.w & 0xffffu); vT[(dd + 7) * SP + tau_a] = (bf16)(vv.w >> 16); }
        if (n + 1 < NCH) { const bf16* pr = P + (size_t)chain_row(dir, b, s0 + 64 + tau_a) * INC + h * 128 + d0;
            rq[0] = *(const u32x4*)(pr + OFF_Q); rq[1] = *(const u32x4*)(pr + OFF_Q + 8); ri[0] = *(const u32x4*)(pr + OFF_I); ri[1] = *(const u32x4*)(pr + OFF_I + 8); rz[0] = *(const u32x4*)(pr + zoff); rz[1] = *(const u32x4*)(pr + zoff + 8); }
        LDS_BAR();
        float cs[16];
        { float run = 0.f;
#pragma unroll
          for (int i = 0; i < 16; ++i) { run += lfb[(16 * qt + i) * 128 + d]; cs[i] = run; }
          tot[qt * 128 + d] = run; }
        LDS_BAR();
        { const float t0 = tot[d], t1 = tot[128 + d], t2 = tot[256 + d], t3 = tot[384 + d];
          const float bmid = t0 + t1, btot = bmid + t2 + t3; const float base = (qt > 0 ? t0 : 0.f) + (qt > 1 ? t1 : 0.f) + (qt > 2 ? t2 : 0.f);
          if (qt == 0) { gmid[d] = __expf(bmid); gend[d] = __expf(btot - bmid); }
#pragma unroll
          for (int i = 0; i < 16; ++i) { const int tau = 16 * qt + i; const float bt = base + cs[i];
              const float eq = __expf(fminf(bt - bmid, 80.0f)), ek = __expf(fminf(bmid - bt, 80.0f));
              const bf16 qb = (bf16)f2bf(bf1(qs[tau * QP + d]) * eq), kb = (bf16)f2bf(bf1(ks[tau * QP + d]) * ek);
              qs[tau * QP + d] = qb; ks[tau * QP + d] = kb; kT[d * SP + tau] = kb; } }
        LDS_BAR();
        { const f32x4 gm = *(const LAS f32x4*)(gmid + 16 * wave + 4 * fq);
#pragma unroll
          for (int vt = 0; vt < 8; ++vt) { S[vt] = S[vt] * gm; u32x2 o; o.x = pk2(S[vt][0], S[vt][1]); o.y = pk2(S[vt][2], S[vt][3]); *(LAS u32x2*)(sT + (16 * vt + fr) * QP + 16 * wave + 4 * fq) = o; } }
        { const int tt = wave >> 1;
#pragma unroll
          for (int u = 0; u < 2; ++u) { const int sg = 2 * (wave & 1) + u; f32x4 acc = (f32x4){0.f, 0.f, 0.f, 0.f};
              if (sg <= tt) {
#pragma unroll
                  for (int kq = 0; kq < 4; ++kq) { const bf16x8 af = *(const LAS bf16x8*)(ks + (16 * sg + fr) * QP + 32 * kq + 8 * fq), bfm = *(const LAS bf16x8*)(qs + (16 * tt + fr) * QP + 32 * kq + 8 * fq);
                      acc = __builtin_amdgcn_mfma_f32_16x16x32_bf16(af, bfm, acc, 0, 0, 0); }
                  if (sg == tt) {
#pragma unroll
                      for (int j = 0; j < 4; ++j) if (4 * fq + j > fr) acc[j] = 0.f; }
              }
              u32x2 o; o.x = pk2(acc[0], acc[1]); o.y = pk2(acc[2], acc[3]); *(LAS u32x2*)(pl + (16 * tt + fr) * SP + 16 * sg + 4 * fq) = o; } }
        LDS_BAR();
#pragma unroll
        for (int tt = 0; tt < 4; ++tt) { f32x4 acc = (f32x4){0.f, 0.f, 0.f, 0.f};
#pragma unroll
            for (int kq = 0; kq < 2; ++kq) { const bf16x8 af = *(const LAS bf16x8*)(vT + (16 * wave + fr) * SP + 32 * kq + 8 * fq), bfm = *(const LAS bf16x8*)(pl + (16 * tt + fr) * SP + 32 * kq + 8 * fq);
                acc = __builtin_amdgcn_mfma_f32_16x16x32_bf16(af, bfm, acc, 0, 0, 0); }
#pragma unroll
            for (int kq = 0; kq < 4; ++kq) { const bf16x8 af = *(const LAS bf16x8*)(sT + (16 * wave + fr) * QP + 32 * kq + 8 * fq), bfm = *(const LAS bf16x8*)(qs + (16 * tt + fr) * QP + 32 * kq + 8 * fq);
                acc = __builtin_amdgcn_mfma_f32_16x16x32_bf16(af, bfm, acc, 0, 0, 0); }
            const int row = chain_row(dir, b, s0 + 16 * tt + fr);
            u32x2 o; o.x = pk2(acc[0], acc[1]); o.y = pk2(acc[2], acc[3]); *(u32x2*)(OB + ((size_t)dir * MALL + row) * BW + h * 128 + 16 * wave + 4 * fq) = o; }
        { const f32x4 ge = *(const LAS f32x4*)(gend + 16 * wave + 4 * fq);
#pragma unroll
          for (int kq = 0; kq < 2; ++kq) { const bf16x8 af = *(const LAS bf16x8*)(kT + (16 * wave + fr) * SP + 32 * kq + 8 * fq);
#pragma unroll
              for (int vt = 0; vt < 8; ++vt) { const bf16x8 bfm = *(const LAS bf16x8*)(vT + (16 * vt + fr) * SP + 32 * kq + 8 * fq); S[vt] = __builtin_amdgcn_mfma_f32_16x16x32_bf16(af, bfm, S[vt], 0, 0, 0); } }
#pragma unroll
          for (int vt = 0; vt < 8; ++vt) S[vt] = S[vt] * ge; }
        LDS_BAR();
    }
}
__device__ __forceinline__ void hgrn_chain(KArgs a, int l, int cid, LAS unsigned char* lds) {
    const int tid = tid_fresh();
    unsigned char* ws = a->ws;
    const bf16* P = (const bf16*)(ws + WS_P); bf16* OB = (bf16*)(ws + WS_OB);
    const int dir = cid / 48, b = (cid % 48) / 6, h = cid % 6;
    LAS float* tq = (LAS float*)lds;
    LAS float* tk = tq + 16 * 128;
    LAS float* tf = tk + 16 * 128;
    LAS float* tv = tf + 16 * 128;
    LAS float* ot = tv + 16 * 128;
    const int v = tid >> 2, q = tid & 3;
    float S[32];
#pragma unroll
    for (int j = 0; j < 32; ++j) S[j] = 0.f;
    const int sst = tid >> 5, sc4 = (tid & 31) * 4;
    float lb[4];
#pragma unroll
    for (int j = 0; j < 4; ++j) { const int ch = h * 128 + sc4 + j;
        if (l == 0) lb[j] = 0.f; else { const float l0 = a->in[I_LB][((size_t)dir * DEPTH + 0) * BW + ch], l1 = a->in[I_LB][((size_t)dir * DEPTH + 1) * BW + ch]; lb[j] = 1.0f / (1.0f + __expf(l0 - l1)); } }
    for (int s0 = 0; s0 < CTXL + T; s0 += 16) {
        { const int row = chain_row(dir, b, s0 + sst); const bf16* pr = P + (size_t)row * INC + h * 128 + sc4;
          const u32x2 pq = *(const u32x2*)(pr + OFF_Q), pi = *(const u32x2*)(pr + OFF_I), pz = *(const u32x2*)(pr + (dir ? OFF_ZB : OFF_ZF));
          const float qf[4] = {bflo(pq.x), bfhi(pq.x), bflo(pq.y), bfhi(pq.y)}, vf[4] = {bflo(pi.x), bfhi(pi.x), bflo(pi.y), bfhi(pi.y)}, zf[4] = {bflo(pz.x), bfhi(pz.x), bflo(pz.y), bfhi(pz.y)};
          f32x4 oq, ok, of, ov;
#pragma unroll
          for (int j = 0; j < 4; ++j) { const float f = lb[j] + (1.0f - lb[j]) * sigmoidf_(zf[j]); oq[j] = siluf_(qf[j]); of[j] = f; ok[j] = 1.0f - f; ov[j] = vf[j]; }
          *(LAS f32x4*)(tq + sst * 128 + sc4) = oq; *(LAS f32x4*)(tk + sst * 128 + sc4) = ok; *(LAS f32x4*)(tf + sst * 128 + sc4) = of; *(LAS f32x4*)(tv + sst * 128 + sc4) = ov; }
        LDS_BAR();
        for (int st = 0; st < 16; ++st) {
            const float vv = tv[st * 128 + v]; float o0 = 0.f, o1 = 0.f;
#pragma unroll
            for (int j = 0; j < 8; ++j) { const f32x4 fq4 = *(const LAS f32x4*)(tf + st * 128 + q * 32 + 4 * j), kq4 = *(const LAS f32x4*)(tk + st * 128 + q * 32 + 4 * j), qq4 = *(const LAS f32x4*)(tq + st * 128 + q * 32 + 4 * j);
#pragma unroll
                for (int i = 0; i < 4; ++i) { const float sn = fq4[i] * S[4 * j + i] + kq4[i] * vv; S[4 * j + i] = sn; if (i & 1) o1 += qq4[i] * sn; else o0 += qq4[i] * sn; } }
            float o = o0 + o1; o += dpp_xor1(o); o += dpp_xor2(o);
            if (q == 0) ot[st * 128 + v] = o;
        }
        LDS_BAR();
        if (tid < 256) { const int st = tid >> 4, part = tid & 15; const int row = chain_row(dir, b, s0 + st); const LAS float* op = ot + st * 128 + part * 8;
            float f[8];
#pragma unroll
            for (int j = 0; j < 8; ++j) f[j] = op[j];
            *(u32x4*)(OB + ((size_t)dir * MALL + row) * BW + h * 128 + part * 8) = pack8(f); }
    }
    LDS_BAR();
}

__device__ __forceinline__ float grp_sum32(float v) { v += __shfl_xor(v, 1); v += __shfl_xor(v, 2); v += __shfl_xor(v, 4); v += __shfl_xor(v, 8); v += __shfl_xor(v, 16); return v; }
__device__ __forceinline__ float grp_sum16(float v) { v += __shfl_xor(v, 1); v += __shfl_xor(v, 2); v += __shfl_xor(v, 4); v += __shfl_xor(v, 8); return v; }
__device__ __forceinline__ void phase_finalize(KArgs a, int l, bool dry) {
    const int tid_ = tid_fresh(); const int lane = tid_ & 63, wave = tid_ >> 6, gw = blockIdx.x * 8 + wave, NGW = gridDim.x * 8;
    unsigned char* ws = a->ws;
    const bf16* P = (const bf16*)(ws + WS_P); const bf16* OB = (const bf16*)(ws + WS_OB); const bf16* OC = (const bf16*)(ws + WS_OC); bf16* Y = (bf16*)(ws + WS_Y);
    unsigned char* Yo = dry ? ws + WS_END : ws + WS_Y8;
    const int nrows = (l == DEPTH - 1) ? NLAT : MALL;
    const int rpw = (nrows + NGW - 1) / NGW; const int r0 = gw * rpw, r1 = (r0 + rpw < nrows) ? r0 + rpw : nrows;
    f32x4 hng[3], gng[3], gnb[3];
#pragma unroll
    for (int k = 0; k < 3; ++k) { const int c = 256 * k + 4 * lane; hng[k] = *(const f32x4*)(a->in[I_HNG] + (size_t)l * BW + c);
        gng[k] = *(const f32x4*)(a->in[I_GNGG] + (size_t)l * CW + c); gnb[k] = *(const f32x4*)(a->in[I_GNB] + (size_t)l * CW + c); }
    for (int row = r0; row < r1; ++row) {
        const int orow = dry ? (row & 2047) : row;
        u32x2 bf_[3], bb_[3], bg_[3], cf_[3], cb_[3], cv_[3], cg_[3];
#pragma unroll
        for (int k = 0; k < 3; ++k) { const int c = 256 * k + 4 * lane;
            bf_[k] = *(const u32x2*)(OB + (size_t)row * BW + c); bb_[k] = *(const u32x2*)(OB + ((size_t)MALL + row) * BW + c); bg_[k] = *(const u32x2*)(P + (size_t)row * INC + OFF_OG + c);
            cf_[k] = *(const u32x2*)(OC + (size_t)row * CW + c); cb_[k] = *(const u32x2*)(OC + ((size_t)MALL + row) * CW + c);
            cv_[k] = *(const u32x2*)(Y + (size_t)row * D + 512 + c);
            cg_[k] = *(const u32x2*)(Y + (size_t)row * D + 1280 + c); }
#pragma unroll
        for (int k = 0; k < 3; ++k) { const int c = 256 * k + 4 * lane;
            { float o[4] = {bflo(bf_[k].x) + bflo(bb_[k].x), bfhi(bf_[k].x) + bfhi(bb_[k].x), bflo(bf_[k].y) + bflo(bb_[k].y), bfhi(bf_[k].y) + bfhi(bb_[k].y)};
              const float ss = grp_sum32((o[0] * o[0] + o[1] * o[1]) + (o[2] * o[2] + o[3] * o[3])); const float rstd = 1.0f / sqrtf(ss * (1.0f / 128.0f) + NORM_EPS);
              const float g4[4] = {bflo(bg_[k].x), bfhi(bg_[k].x), bflo(bg_[k].y), bfhi(bg_[k].y)}; float y[4];
#pragma unroll
              for (int j = 0; j < 4; ++j) y[j] = o[j] * rstd * hng[k][j] * sigmoidf_(g4[j]);
              *(unsigned*)(Yo + (size_t)orow * D + 512 + c) = pk4_fp8(y[0], y[1], y[2], y[3]); }
            { float o[4] = {bflo(cf_[k].x) + bflo(cb_[k].x), bfhi(cf_[k].x) + bfhi(cb_[k].x), bflo(cf_[k].y) + bflo(cb_[k].y), bfhi(cf_[k].y) + bfhi(cb_[k].y)};
              const float v4[4] = {bflo(cv_[k].x), bfhi(cv_[k].x), bflo(cv_[k].y), bfhi(cv_[k].y)}, g4[4] = {bflo(cg_[k].x), bfhi(cg_[k].x), bflo(cg_[k].y), bfhi(cg_[k].y)};
              const float mean = grp_sum16((o[0] + o[1]) + (o[2] + o[3])) * (1.0f / 64.0f);
              float dl[4]; float sq = 0.f;
#pragma unroll
              for (int j = 0; j < 4; ++j) { dl[j] = o[j] - mean; sq += dl[j] * dl[j]; }
              const float var = grp_sum16(sq) * (1.0f / 64.0f); const float rs = 1.0f / sqrtf(var + GN_EPS); float y[4];
#pragma unroll
              for (int j = 0; j < 4; ++j) y[j] = (dl[j] * rs * gng[k][j] + gnb[k][j] + v4[j]) * g4[j];
              *(unsigned*)(Yo + (size_t)orow * D + 1280 + c) = pk4_fp8(y[0], y[1], y[2], y[3]); }
        }
    }
}

__global__ void __launch_bounds__(NTHREADS, 2) mk_fwd(Args args_unused) {
    extern __shared__ __attribute__((aligned(16))) unsigned char lds_raw[];
    LAS unsigned char* lds = (LAS unsigned char*)lds_raw;
    volatile LAS unsigned* misc = (volatile LAS unsigned*)(lds + LDS_MISC);
    const int tid = threadIdx.x, G = gridDim.x;
    if (tid < 64) misc[tid] = 0u;
    __syncthreads();
    XcdBarrier bar; bar.bar = nullptr; bar.x = 0; bar.st = nullptr;
    int lo, hi;
    { KArgs a = kargs(); lo = a->ph_lo; hi = a->ph_hi; unsigned* ctl = (unsigned*)(a->ws + WS_CTL); bar.bar = ctl + CW_BAR; if (!MK_MULTI) bar = xcd_barrier_post(ctl + CW_BAR, misc + 8); }
    const int cvirt = (G % 8 == 0) ? ((int)blockIdx.x % 8) * (G / 8) + (int)blockIdx.x / 8 : (int)blockIdx.x;
#define IN(k) (lo <= (k) && (k) < hi)
#define PM(b) ((PHMASK >> (b)) & 1)
#define REP(b) _Pragma("unroll 1") for (int rep_ = 0; rep_ < 1 + ((PROBE_DUP >> (b)) & 1); ++rep_)
#define SEAM(k) do { if (!MK_MULTI && IN(k) && IN((k) + 1)) { xcd_barrier(bar); if ((PROBE_DUP >> 13) & 1) xcd_barrier(bar); } } while (0)

    if (PM(0) && IN(0)) REP(0) { phase_prologue(kargs(), lds); } SEAM(0);

#pragma unroll 1
    for (int l = 0; l < DEPTH; ++l) {
        const int pb = 1 + 9 * l;
        const bool lastl = (l == DEPTH - 1);
        if (PM(1) && IN(pb + 0)) { if ((PROBE_DUP >> 1) & 1) { if (l == 0) phase_norm1<0>(kargs(), l, true); else phase_norm1<1>(kargs(), l, true); } if (l == 0) phase_norm1<0>(kargs(), l, false); else { phase_norm1<1>(kargs(), l, false); __syncthreads(); convert_moe(kargs(), l, lds); __syncthreads(); } } SEAM(pb + 0);
        if (PM(2) && IN(pb + 1)) REP(2) {
            KArgs a = kargs(); unsigned char* ws = a->ws;
            pg8::Gemm g{(const bf16*)(ws + WS_H), (const bf16*)(ws + WS_WIN + (size_t)l * INC * D), MALL, INC, D / 2};
            pg8::StaticOrder S; S.init(MALL, INC, G, (int)blockIdx.x);
            pg8::EpiBf16 E{(bf16*)(ws + WS_P), INC};
            pg8::gemm_phase8<pg8::EpiBf16, pg8::StaticOrder, false, false>(lds, g, S, E, nullptr);
        } SEAM(pb + 1);
        if (PM(3) && IN(pb + 2)) {
            const int ngm = lastl ? 1024 : 1088;
            unsigned* qhead = (unsigned*)(kargs()->ws + WS_CTL) + CW_PREPQ + 64 * l;
            const int n_rw = PREP_N_RW, n_hg = PREP_N_HG, n_all = (G == 256) ? n_rw + n_hg : n_rw + n_hg + ngm;
            auto grab = [&]() -> int { if (threadIdx.x == 0) misc[16] = __hip_atomic_fetch_add(qhead, 1u, __ATOMIC_RELAXED, __HIP_MEMORY_SCOPE_AGENT); LDS_BAR(); return (int)misc[16]; };
            int it = grab();
            while (it < n_all) {
                const int nx = grab();
                if (it < n_rw) { _Pragma("unroll 1") for (int r2 = 0; r2 < 1 + ((PROBE_DUP >> 15) & 1); ++r2) rwkv_prep_item(kargs(), l, it / 3, it % 3, lds, (((PROBE_DUP >> 15) & 1) && r2 == 0) ? RWP_SKIP : 0, nx); }
                else if (it < n_rw + n_hg) { if ((PROBE_DUP >> 16) & 1) hgrn_prep_item(kargs(), l, it - n_rw, lds, true); hgrn_prep_item(kargs(), l, it - n_rw, lds, false, nx); }
                else { _Pragma("unroll 1") for (int r2 = 0; r2 < 1 + ((PROBE_DUP >> 14) & 1); ++r2) gmlp_item(kargs(), l, it - n_rw - n_hg, lds); }
                it = nx;
            }
            __syncthreads();
        } SEAM(pb + 2);
        if (PM(4) && IN(pb + 3)) REP(4) {
            if (G == 256) { const int bx = blockIdx.x;
                if (bx < 96) { _Pragma("unroll 1") for (int r2 = 0; r2 < 1 + ((PROBE_DUP >> 12) & 1); ++r2) rwkv_chain_mfma(kargs(), bx * 8, lds); }
                else if (bx < 192) { _Pragma("unroll 1") for (int r2 = 0; r2 < 1 + ((PROBE_DUP >> 11) & 1); ++r2) hgrn_chain_lean(kargs(), bx - 96, lds); }
                if (bx < 96 || bx >= 192) {
                    unsigned* gq = (unsigned*)(kargs()->ws + WS_CTL) + CW_GMQ + 64 * l; const int ngm2 = lastl ? 1024 : 1088;
                    for (;;) { if (threadIdx.x == 0) misc[17] = __hip_atomic_fetch_add(gq, 1u, __ATOMIC_RELAXED, __HIP_MEMORY_SCOPE_AGENT);
                        LDS_BAR(); const int it = (int)misc[17]; if (it >= ngm2) break; gmlp_item(kargs(), l, it, lds); }
                    __syncthreads(); } }
            else { for (int it = blockIdx.x; it < 192; it += G) { if (it < 96) rwkv_chain_mfma(kargs(), it * 8, lds); else hgrn_chain_lean(kargs(), it - 96, lds); } }
        } SEAM(pb + 3);
        if (PM(5) && IN(pb + 4)) { if ((PROBE_DUP >> 5) & 1) phase_finalize(kargs(), l, true); phase_finalize(kargs(), l, false); } SEAM(pb + 4);
        if (PM(6) && IN(pb + 5)) REP(6) {
            KArgs a = kargs(); unsigned char* ws = a->ws;
            const int Mo = lastl ? NLAT : MALL;
            pg8::Gemm g{(const bf16*)(ws + WS_Y8), (const bf16*)(ws + WS_WOUT + (size_t)l * D * D), Mo, D, D / 2};
            pg8::StaticOrder S; S.init(Mo, D, G, (int)blockIdx.x);
            const float* xl = a->in[I_X]; const float* xc = a->in[I_CTX];
            pg8::EpiResid E{xl, xc, (bf16*)(ws + WS_X), (const float*)(ws + WS_MOD) + (size_t)l * 9 * 12288 + 2 * D, l == 0};
            pg8::gemm_phase8<pg8::EpiResid, pg8::StaticOrder, true, false>(lds, g, S, E, nullptr);
        } SEAM(pb + 5);
        if (PM(7) && IN(pb + 6)) { if ((PROBE_DUP >> 7) & 1) phase_norm2_router(kargs(), l, true, lds); phase_norm2_router(kargs(), l, false, lds); } SEAM(pb + 6);
        if (PM(8) && IN(pb + 7)) REP(8) {
            KArgs a = kargs(); unsigned char* ws = a->ws;
            moe_tables<false>(a, l, lds, cvirt);
            pg8::Gemm g{(const bf16*)(ws + WS_H), (const bf16*)(ws + WS_WGU), 0, 2048, D / 2};
            pg8::MoeOrder S{(const LAS int*)(lds + LDS_TP), G, cvirt, (unsigned)(2048 * D)};
            pg8::EpiSwiglu E{ws + WS_ACT};
            pg8::gemm_phase8<pg8::EpiSwiglu, pg8::MoeOrder, false, true>(lds, g, S, E, (const LAS unsigned*)(lds + LDS_TAB));
        } SEAM(pb + 7);
        if (PM(9) && IN(pb + 8)) REP(9) {
            KArgs a = kargs(); unsigned char* ws = a->ws;
            moe_tables<true>(a, l, lds, cvirt);
            pg8::Gemm g{(const bf16*)(ws + WS_ACT), (const bf16*)(ws + WS_WDN), 0, D, DE / 2};
            pg8::MoeOrder S{(const LAS int*)(lds + LDS_TP), G, cvirt, (unsigned)(D * DE)};
            pg8::EpiDown E{ws + WS_YK, (const LAS unsigned*)(lds + LDS_TAB), (const LAS float*)(lds + LDS_TABW)};
            pg8::gemm_phase8<pg8::EpiDown, pg8::MoeOrder, false, false>(lds, g, S, E, nullptr);
        } SEAM(pb + 8);
    }
    if (PM(10) && IN(1 + 9 * DEPTH)) { if ((PROBE_DUP >> 10) & 1) phase_norm1<2>(kargs(), DEPTH, true); phase_norm1<2>(kargs(), DEPTH, false); }
#undef IN
#undef SEAM
}

extern "C" void kernel_launch(void* const* d_in, const int* in_sizes, int n_in, void* d_out, int out_size, void* d_ws, size_t ws_size, hipStream_t stream) {
    static int grid = 0;
    if (grid == 0) {
        if (n_in != 31 || ws_size < WS_END) { fprintf(stderr, "kernel_launch: unexpected n_in %d / ws %zu (need %zu)\n", n_in, ws_size, (size_t)WS_END); grid = -1; return; }
        int dev = 0, cus = 0, per_cu = 0;
        hipGetDevice(&dev); hipDeviceGetAttribute(&cus, hipDeviceAttributeMultiprocessorCount, dev);
        if (hipFuncSetAttribute((const void*)mk_fwd, hipFuncAttributeMaxDynamicSharedMemorySize, LDS_BYTES) != hipSuccess) { fprintf(stderr, "kernel_launch: hipFuncSetAttribute failed\n"); grid = -1; return; }
        if (hipOccupancyMaxActiveBlocksPerMultiprocessor(&per_cu, (const void*)mk_fwd, NTHREADS, LDS_BYTES) != hipSuccess || per_cu < 1) fprintf(stderr, "kernel_launch: occupancy query says %d\n", per_cu);
        (void)hipGetLastError();
        grid = cus > 0 ? cus : 256;
    }
    if (grid < 0) return;
    hipMemsetAsync((char*)d_ws + WS_CTL, 0, CTL_ZERO_BYTES, stream);
    Args a{};
    for (int i = 0; i < 31; ++i) a.in[i] = (const float*)d_in[i];
    a.out = (float*)d_out; a.ws = (unsigned char*)d_ws;
    constexpr int NPH = 2 + 9 * DEPTH;
#if MK_MULTI
    for (int p = 0; p < NPH; ++p) { a.ph_lo = p; a.ph_hi = p + 1; hipLaunchKernelGGL(mk_fwd, dim3(grid), dim3(NTHREADS), LDS_BYTES, stream, a); }
#else
    a.ph_lo = 0; a.ph_hi = NPH; hipLaunchKernelGGL(mk_fwd, dim3(grid), dim3(NTHREADS), LDS_BYTES, stream, a);
#endif
}
```
